# Optimizing an MI355X kernel written in HIP

```python
import jax
import jax.numpy as jnp
from jax import lax
import numpy as np

D_MODEL = 1024
BATCH = 2
SEQ = 8192
DEPTH = 2

GRID_W = 64
CTX_LEN = 256
N_MIXERS = 4
GROUP_W = D_MODEL // N_MIXERS
HEAD_DIM = 64
N_Q_HEADS = GROUP_W // HEAD_DIM
N_KV_HEADS = 2
Q_PER_KV = N_Q_HEADS // N_KV_HEADS
KV_W = N_KV_HEADS * HEAD_DIM
ATTN_SCALE = HEAD_DIM ** -0.5
Q_BLOCK = 128
WINDOW = 128
ROPE_THETA = 10000.0
ROPE_FREQS = HEAD_DIM // 4
CONV_WIDTH = 31
CONV_PAD = CONV_WIDTH // 2
HGRN_HEADS = 4
HGRN_KEY = GROUP_W // HGRN_HEADS
HGRN_VAL = GROUP_W // HGRN_HEADS
SCAN_CHUNK = 64
N_EXPERTS = 64
TOP_K = 8
N_EXPERT_GROUPS = 8
TOPK_GROUPS = 4
EXPERT_HIDDEN = 256
SHARED_HIDDEN = 256
ROUTED_SCALE = 2.5
MOE_BLOCK = 128
EPS = 1e-6
F32 = jnp.float32
IN_SPLITS = (GROUP_W, KV_W, KV_W, GROUP_W, KV_W, KV_W, GROUP_W, GROUP_W,
             GROUP_W, GROUP_W, GROUP_W, GROUP_W, GROUP_W)
D_IN = sum(IN_SPLITS)

kernel_name = 'hybrid_parallel_heads_dit_block'


def rms_norm(x, g):
    xf = x.astype(F32)
    y = xf * lax.rsqrt(jnp.mean(xf * xf, axis=-1, keepdims=True) + EPS)
    return (y * g.astype(F32)).astype(x.dtype)


def layer_norm(x, g, b):
    xf = x.astype(F32)
    xc = xf - jnp.mean(xf, axis=-1, keepdims=True)
    y = xc * lax.rsqrt(jnp.mean(xc * xc, axis=-1, keepdims=True) + EPS)
    return (y * g.astype(F32) + b.astype(F32)).astype(x.dtype)


def modulate(h, shift, scale):
    return h * (1.0 + scale) + shift


def split_cols(p):
    cuts = [int(v) for v in np.cumsum(IN_SPLITS)[:-1]]
    return jnp.split(p, cuts, axis=-1)


def split_heads(t, n_heads, dim):
    return t.reshape(t.shape[:-1] + (n_heads, dim))


def axial_rope(n):
    n_rows = n // GRID_W
    row = jnp.broadcast_to(jnp.arange(n_rows)[:, None], (n_rows, GRID_W)).reshape(n)
    col = jnp.broadcast_to(jnp.arange(GRID_W)[None, :], (n_rows, GRID_W)).reshape(n)
    inv_freq = jnp.power(ROPE_THETA, -jnp.arange(ROPE_FREQS, dtype=F32) / ROPE_FREQS)
    ang = jnp.stack([row.astype(F32)[:, None] * inv_freq,
                     col.astype(F32)[:, None] * inv_freq], axis=1)
    return jnp.cos(ang), jnp.sin(ang)


def apply_rope(x, rope):
    cos, sin = rope
    b, n, h, _ = x.shape
    xr = x.astype(F32).reshape(b, n, h, 2, 2, ROPE_FREQS)
    x1, x2 = xr[..., 0, :], xr[..., 1, :]
    cs, sn = cos[None, :, None], sin[None, :, None]
    out = jnp.stack([x1 * cs - x2 * sn, x1 * sn + x2 * cs], axis=-2)
    return out.reshape(b, n, h, HEAD_DIM).astype(x.dtype)


def attn_heads(qx, kx, vx, q_gain, k_gain, rope=None):
    q = rms_norm(split_heads(qx, N_Q_HEADS, HEAD_DIM), q_gain)
    k = rms_norm(split_heads(kx, N_KV_HEADS, HEAD_DIM), k_gain)
    if rope is not None:
        q, k = apply_rope(q, rope), apply_rope(k, rope)
    return q, k, split_heads(vx, N_KV_HEADS, HEAD_DIM)


def ctx_attention(q_c, k_c, v_c, sink=None):
    b, l = q_c.shape[:2]
    qg = q_c.reshape(b, l, N_KV_HEADS, Q_PER_KV, HEAD_DIM)
    s = jnp.einsum('bqkgd,bskd->bkgqs', qg, k_c, preferred_element_type=F32) * ATTN_SCALE
    if sink is not None:
        s_sink = jnp.broadcast_to(sink.astype(F32).reshape(1, N_KV_HEADS, Q_PER_KV, 1, 1), s.shape[:-1] + (1,))
        s = jnp.concatenate([s, s_sink], axis=-1)
    p = jax.nn.softmax(s, axis=-1)[..., :l].astype(v_c.dtype)
    return jnp.einsum('bkgqs,bskd->bqkgd', p, v_c).reshape(b, l, GROUP_W)


def global_attention(q, k, v, k_c, v_c):
    b, n = q.shape[:2]
    nb = n // Q_BLOCK
    k_all = jnp.concatenate([k, k_c], axis=1)
    v_all = jnp.concatenate([v, v_c], axis=1)
    q_blocks = q.reshape(b, nb, Q_BLOCK, N_KV_HEADS, Q_PER_KV, HEAD_DIM).transpose(1, 0, 2, 3, 4, 5)

    def block(qb):
        s = jnp.einsum('bqkgd,bskd->bkgqs', qb, k_all, preferred_element_type=F32) * ATTN_SCALE
        p = jax.nn.softmax(s, axis=-1).astype(v_all.dtype)
        return jnp.einsum('bkgqs,bskd->bqkgd', p, v_all)

    o = lax.map(block, q_blocks)
    return o.transpose(1, 0, 2, 3, 4, 5).reshape(b, n, GROUP_W)


def window_attention(q, k, v, k_c, v_c, sink):
    b, n = q.shape[:2]
    l = k_c.shape[1]
    nb = n // Q_BLOCK
    span = 3 * Q_BLOCK

    def band(t):
        tp = jnp.pad(t, ((0, 0), (WINDOW, WINDOW), (0, 0), (0, 0)))
        tp = tp.reshape(b, nb + 2, Q_BLOCK, N_KV_HEADS, HEAD_DIM)
        return jnp.concatenate([tp[:, :-2], tp[:, 1:-1], tp[:, 2:]], axis=2)

    kb, vb = band(k), band(v)
    qb = q.reshape(b, nb, Q_BLOCK, N_KV_HEADS, Q_PER_KV, HEAD_DIM)
    s_loc = jnp.einsum('bnqkgd,bnskd->bnkgqs', qb, kb, preferred_element_type=F32) * ATTN_SCALE
    q_pos = jnp.arange(nb)[:, None] * Q_BLOCK + jnp.arange(Q_BLOCK)[None, :]
    k_pos = jnp.arange(nb)[:, None] * Q_BLOCK - WINDOW + jnp.arange(span)[None, :]
    inside = ((jnp.abs(q_pos[:, :, None] - k_pos[:, None, :]) <= WINDOW)
              & (k_pos[:, None, :] >= 0) & (k_pos[:, None, :] < n))
    s_loc = jnp.where(inside[None, :, None, None], s_loc, -jnp.inf)
    s_ctx = jnp.einsum('bnqkgd,bskd->bnkgqs', qb, k_c, preferred_element_type=F32) * ATTN_SCALE
    s_sink = jnp.broadcast_to(sink.astype(F32).reshape(1, 1, N_KV_HEADS, Q_PER_KV, 1, 1), s_loc.shape[:-1] + (1,))
    p = jax.nn.softmax(jnp.concatenate([s_loc, s_ctx, s_sink], axis=-1), axis=-1).astype(v.dtype)
    o = (jnp.einsum('bnkgqs,bnskd->bnqkgd', p[..., :span], vb)
         + jnp.einsum('bnkgqs,bskd->bnqkgd', p[..., span:span + l], v_c))
    return o.reshape(b, n, GROUP_W)


def conformer_conv(val, gate, dw_w, dw_b, ln_g, ln_b, pw_w, pw_b):
    h = val * jax.nn.sigmoid(gate)
    h = lax.conv_general_dilated(h, dw_w[:, None, :].astype(h.dtype), window_strides=(1,),
                                 padding=[(CONV_PAD, CONV_PAD)],
                                 dimension_numbers=('NWC', 'WIO', 'NWC'),
                                 feature_group_count=GROUP_W) + dw_b
    h = jax.nn.silu(layer_norm(h, ln_g, ln_b))
    return h @ pw_w + pw_b


def gla_chunk_scan(q, k, v, logf, s0):
    b, n, h, _ = q.shape
    dv = v.shape[-1]
    nc = n // SCAN_CHUNK

    def chunks(t):
        return t.astype(F32).reshape(b, nc, SCAN_CHUNK, h, t.shape[-1]).transpose(1, 0, 3, 2, 4)

    lower = jnp.tril(jnp.ones((SCAN_CHUNK, SCAN_CHUNK), dtype=bool))[:, :, None]

    def step(state, inp):
        qc, kc, vc, gc = inp
        cum = jnp.cumsum(gc, axis=2)
        last = cum[:, :, -1:, :]
        rel = cum[:, :, :, None, :] - cum[:, :, None, :, :]
        decay = jnp.exp(jnp.where(lower, rel, -jnp.inf))
        scores = jnp.einsum('bhtd,bhsd,bhtsd->bhts', qc, kc, decay)
        out = (jnp.einsum('bhtd,bhde->bhte', qc * jnp.exp(cum), state)
               + jnp.einsum('bhts,bhse->bhte', scores, vc))
        new_state = (jnp.exp(last[:, :, 0, :])[..., None] * state
                     + jnp.einsum('bhsd,bhse->bhde', kc * jnp.exp(last - cum), vc))
        return new_state, out

    final, out = lax.scan(step, s0, (chunks(q), chunks(k), chunks(v), chunks(logf)))
    return out.transpose(1, 0, 3, 2, 4).reshape(b, n, h, dv), final


def hgrn_gates(f_logits, lb):
    z = f_logits.astype(F32)
    logf = jnp.logaddexp(jax.nn.log_sigmoid(z), jnp.log(lb) + jax.nn.log_sigmoid(-z))
    return (1.0 - lb) * jax.nn.sigmoid(-z), logf


def hgrn_out(o, g, onorm_g):
    y = rms_norm(o, onorm_g) * jax.nn.silu(split_heads(g, HGRN_HEADS, HGRN_VAL).astype(F32))
    return y.reshape(g.shape).astype(g.dtype)


def hgrn2_mixer(qx, ix, ffx, fbx, gx, qc, ic, ffc, fbc, gc, lb_fwd, lb_bwd, onorm_g, with_ctx):
    b = qx.shape[0]
    s0 = jnp.zeros((b, HGRN_HEADS, HGRN_KEY, HGRN_VAL), F32)
    o_lat, o_ctx = 0.0, 0.0
    for f_lat, f_ctx, lb, reverse in ((ffx, ffc, lb_fwd, False), (fbx, fbc, lb_bwd, True)):
        def orient(t):
            return jnp.flip(t, axis=1) if reverse else t
        k_c, logf_c = hgrn_gates(split_heads(orient(f_ctx), HGRN_HEADS, HGRN_KEY), lb)
        out_c, state = gla_chunk_scan(split_heads(orient(qc), HGRN_HEADS, HGRN_KEY), k_c,
                                      split_heads(orient(ic), HGRN_HEADS, HGRN_VAL), logf_c, s0)
        k_x, logf_x = hgrn_gates(split_heads(orient(f_lat), HGRN_HEADS, HGRN_KEY), lb)
        out_x, _ = gla_chunk_scan(split_heads(orient(qx), HGRN_HEADS, HGRN_KEY), k_x,
                                  split_heads(orient(ix), HGRN_HEADS, HGRN_VAL), logf_x, state)
        o_lat = o_lat + orient(out_x)
        if with_ctx:
            o_ctx = o_ctx + orient(out_c)
    y_lat = hgrn_out(o_lat, gx, onorm_g)
    y_ctx = hgrn_out(o_ctx, gc, onorm_g) if with_ctx else None
    return y_lat, y_ctx


def routed_experts(h, idx, w, w_gate, w_up, w_down):
    t, d = h.shape
    a = t * TOP_K
    flat_e = idx.reshape(a)
    order = jnp.argsort(flat_e)
    sorted_e = flat_e[order]
    counts = jnp.bincount(flat_e, length=N_EXPERTS)
    starts = jnp.cumsum(counts) - counts
    padded = (counts + MOE_BLOCK - 1) // MOE_BLOCK * MOE_BLOCK
    pad_ends = jnp.cumsum(padded)
    pad_starts = pad_ends - padded
    dest = pad_starts[sorted_e] + jnp.arange(a) - starts[sorted_e]
    n_blocks = -(-(a + N_EXPERTS * (MOE_BLOCK - 1)) // MOE_BLOCK)
    n_slots = n_blocks * MOE_BLOCK
    slot_src = jnp.full((n_slots,), a, jnp.int32).at[dest].set(order.astype(jnp.int32))
    valid = slot_src < a
    src = jnp.minimum(slot_src, a - 1)
    slot_tok = jnp.where(valid, src // TOP_K, 0)
    slot_w = jnp.where(valid, w.reshape(a)[src], 0.0).astype(h.dtype)
    block_e = jnp.minimum(jnp.searchsorted(pad_ends, jnp.arange(n_blocks) * MOE_BLOCK, side='right'), N_EXPERTS - 1)

    def run_block(args):
        tok, wt, e = args
        xb = h[tok]
        hid = jax.nn.silu(xb @ w_gate[e]) * (xb @ w_up[e])
        return (hid @ w_down[e]) * wt[:, None]

    y = lax.map(run_block, (slot_tok.reshape(n_blocks, MOE_BLOCK), slot_w.reshape(n_blocks, MOE_BLOCK), block_e))
    return jax.ops.segment_sum(y.reshape(n_slots, d), slot_tok, num_segments=t)


def moe_ffn(h, router_w, router_bias, w_gate, w_up, w_down, sh_gate, sh_up, sh_down):
    t = h.shape[0]
    scores = jax.nn.sigmoid(jnp.matmul(h, router_w, preferred_element_type=F32))
    sel = scores + router_bias.astype(F32)
    grouped = sel.reshape(t, N_EXPERT_GROUPS, N_EXPERTS // N_EXPERT_GROUPS)
    group_score = lax.top_k(grouped, 2)[0].sum(-1)
    _, top_groups = lax.top_k(group_score, TOPK_GROUPS)
    group_keep = (top_groups[..., None] == jnp.arange(N_EXPERT_GROUPS)).any(axis=1)
    expert_keep = jnp.repeat(group_keep, N_EXPERTS // N_EXPERT_GROUPS, axis=-1)
    _, idx = lax.top_k(jnp.where(expert_keep, sel, -jnp.inf), TOP_K)
    w = jnp.take_along_axis(scores, idx, axis=-1)
    w = w / jnp.sum(w, axis=-1, keepdims=True) * ROUTED_SCALE
    shared = (jax.nn.silu(h @ sh_gate) * (h @ sh_up)) @ sh_down
    return routed_experts(h, idx, w, w_gate, w_up, w_down) + shared


def hybrid_layer(x, cx, c, c_ctx, rope, w_mod, b_mod, norm1_g, norm2_g, w_in, w_out,
                 gqa_q_gain, gqa_k_gain, win_q_gain, win_k_gain, win_sink,
                 conv_dw_w, conv_dw_b, conv_ln_g, conv_ln_b, conv_pw_w, conv_pw_b,
                 lb_fwd, lb_bwd, hgrn_onorm_g, router_w, router_bias,
                 exp_w_gate, exp_w_up, exp_w_down, sh_w_gate, sh_w_up, sh_w_down, with_ctx):
    b, n, d = x.shape
    l = cx.shape[1]
    mx = (jax.nn.silu(c) @ w_mod + b_mod).reshape(b, 6, d).transpose(1, 0, 2)[:, :, None, :]
    mc = (jax.nn.silu(c_ctx) @ w_mod + b_mod).reshape(6, 1, 1, d)

    hx = modulate(rms_norm(x, norm1_g), mx[0], mx[1])
    hc = modulate(rms_norm(cx, norm1_g), mc[0], mc[1])
    (gq, gk, gv, wq, wk, wv, cv_val, cv_gate, rq, ri, rf_f, rf_b, rg) = split_cols(hx @ w_in)
    (gq_c, gk_c, gv_c, wq_c, wk_c, wv_c, cv_val_c, cv_gate_c,
     rq_c, ri_c, rf_f_c, rf_b_c, rg_c) = split_cols(hc @ w_in)

    q, k, v = attn_heads(gq, gk, gv, gqa_q_gain, gqa_k_gain, rope)
    gq_h, gk_h, gv_h = attn_heads(gq_c, gk_c, gv_c, gqa_q_gain, gqa_k_gain)
    y_glob = global_attention(q, k, v, gk_h, gv_h)

    y_conv = conformer_conv(cv_val, cv_gate, conv_dw_w, conv_dw_b, conv_ln_g, conv_ln_b, conv_pw_w, conv_pw_b)

    q, k, v = attn_heads(wq, wk, wv, win_q_gain, win_k_gain, rope)
    wq_h, wk_h, wv_h = attn_heads(wq_c, wk_c, wv_c, win_q_gain, win_k_gain)
    y_win = window_attention(q, k, v, wk_h, wv_h, win_sink)

    y_rec, yc_rec = hgrn2_mixer(rq, ri, rf_f, rf_b, rg, rq_c, ri_c, rf_f_c, rf_b_c, rg_c,
                                lb_fwd, lb_bwd, hgrn_onorm_g, with_ctx)

    x = x + mx[2] * (jnp.concatenate([y_glob, y_conv, y_win, y_rec], axis=-1) @ w_out)
    tokens = modulate(rms_norm(x, norm2_g), mx[3], mx[4]).reshape(b * n, d)
    if with_ctx:
        yc_glob = ctx_attention(gq_h, gk_h, gv_h)
        yc_conv = conformer_conv(cv_val_c, cv_gate_c, conv_dw_w, conv_dw_b, conv_ln_g, conv_ln_b, conv_pw_w, conv_pw_b)
        yc_win = ctx_attention(wq_h, wk_h, wv_h, win_sink)
        cx = cx + mc[2] * (jnp.concatenate([yc_glob, yc_conv, yc_win, yc_rec], axis=-1) @ w_out)
        hc2 = modulate(rms_norm(cx, norm2_g), mc[3], mc[4]).reshape(b * l, d)
        tokens = jnp.concatenate([tokens, hc2], axis=0)

    f = moe_ffn(tokens, router_w, router_bias, exp_w_gate, exp_w_up, exp_w_down, sh_w_gate, sh_w_up, sh_w_down)
    x = x + mx[5] * f[:b * n].reshape(b, n, d)
    if with_ctx:
        cx = cx + mc[5] * f[b * n:].reshape(b, l, d)
    return x, cx


def setup_inputs(seed: int = 0) -> dict:
    key = jax.random.key(seed)
    ks = jax.random.split(key, 31)
    d = D_MODEL

    def nrm(k, shape, s):
        return jax.random.normal(k, shape, F32) * s

    return {
        'x': nrm(ks[0], (BATCH, SEQ, d), 1.0),
        'c': nrm(ks[1], (BATCH, d), 1.0),
        'ctx': nrm(ks[2], (BATCH, CTX_LEN, d), 1.0),
        'c_ctx': nrm(ks[3], (d,), 1.0),
        'w_mod': nrm(ks[4], (DEPTH, d, 6 * d), 0.5 * d ** -0.5),
        'b_mod': nrm(ks[5], (DEPTH, 6 * d), 0.01),
        'norm1_g': 1.0 + nrm(ks[6], (DEPTH, d), 0.1),
        'norm2_g': 1.0 + nrm(ks[7], (DEPTH, d), 0.1),
        'w_in': nrm(ks[8], (DEPTH, d, D_IN), d ** -0.5),
        'w_out': nrm(ks[9], (DEPTH, N_MIXERS * GROUP_W, d), (N_MIXERS * GROUP_W) ** -0.5),
        'gqa_q_gain': 1.0 + nrm(ks[10], (DEPTH, HEAD_DIM), 0.1),
        'gqa_k_gain': 1.0 + nrm(ks[11], (DEPTH, HEAD_DIM), 0.1),
        'win_q_gain': 1.0 + nrm(ks[12], (DEPTH, HEAD_DIM), 0.1),
        'win_k_gain': 1.0 + nrm(ks[13], (DEPTH, HEAD_DIM), 0.1),
        'win_sink': nrm(ks[14], (DEPTH, N_Q_HEADS), 1.0),
        'conv_dw_w': nrm(ks[15], (DEPTH, CONV_WIDTH, GROUP_W), CONV_WIDTH ** -0.5),
        'conv_dw_b': nrm(ks[16], (DEPTH, GROUP_W), 0.01),
        'conv_ln_g': 1.0 + nrm(ks[17], (DEPTH, GROUP_W), 0.1),
        'conv_ln_b': nrm(ks[18], (DEPTH, GROUP_W), 0.01),
        'conv_pw_w': nrm(ks[19], (DEPTH, GROUP_W, GROUP_W), GROUP_W ** -0.5),
        'conv_pw_b': nrm(ks[20], (DEPTH, GROUP_W), 0.01),
        'hgrn_lb_logits': nrm(ks[21], (2, DEPTH, HGRN_HEADS * HGRN_KEY), 1.0),
        'hgrn_onorm_g': 1.0 + nrm(ks[22], (DEPTH, HGRN_VAL), 0.1),
        'router_w': nrm(ks[23], (DEPTH, d, N_EXPERTS), d ** -0.5),
        'router_bias': nrm(ks[24], (DEPTH, N_EXPERTS), 0.01),
        'exp_w_gate': nrm(ks[25], (DEPTH, N_EXPERTS, d, EXPERT_HIDDEN), d ** -0.5),
        'exp_w_up': nrm(ks[26], (DEPTH, N_EXPERTS, d, EXPERT_HIDDEN), d ** -0.5),
        'exp_w_down': nrm(ks[27], (DEPTH, N_EXPERTS, EXPERT_HIDDEN, d), EXPERT_HIDDEN ** -0.5),
        'sh_w_gate': nrm(ks[28], (DEPTH, d, SHARED_HIDDEN), d ** -0.5),
        'sh_w_up': nrm(ks[29], (DEPTH, d, SHARED_HIDDEN), d ** -0.5),
        'sh_w_down': nrm(ks[30], (DEPTH, SHARED_HIDDEN, d), SHARED_HIDDEN ** -0.5),
    }


def reference(x, c, ctx, c_ctx, w_mod, b_mod, norm1_g, norm2_g, w_in, w_out,
              gqa_q_gain, gqa_k_gain, win_q_gain, win_k_gain, win_sink,
              conv_dw_w, conv_dw_b, conv_ln_g, conv_ln_b, conv_pw_w, conv_pw_b,
              hgrn_lb_logits, hgrn_onorm_g, router_w, router_bias,
              exp_w_gate, exp_w_up, exp_w_down, sh_w_gate, sh_w_up, sh_w_down):
    rope = axial_rope(x.shape[1])
    lb = jnp.cumsum(jax.nn.softmax(hgrn_lb_logits.astype(F32), axis=1), axis=1)
    lb = (lb - lb[:, :1]).reshape(2, DEPTH, HGRN_HEADS, HGRN_KEY)
    cx = ctx
    for layer in range(DEPTH):
        x, cx = hybrid_layer(
            x, cx, c, c_ctx, rope, w_mod[layer], b_mod[layer], norm1_g[layer], norm2_g[layer],
            w_in[layer], w_out[layer], gqa_q_gain[layer], gqa_k_gain[layer],
            win_q_gain[layer], win_k_gain[layer], win_sink[layer],
            conv_dw_w[layer], conv_dw_b[layer], conv_ln_g[layer], conv_ln_b[layer],
            conv_pw_w[layer], conv_pw_b[layer], lb[0, layer], lb[1, layer], hgrn_onorm_g[layer],
            router_w[layer], router_bias[layer], exp_w_gate[layer], exp_w_up[layer], exp_w_down[layer],
            sh_w_gate[layer], sh_w_up[layer], sh_w_down[layer], layer < DEPTH - 1)
    return x
```

```cpp
#include <hip/hip_runtime.h>
#include <hip/hip_bf16.h>
#include <cmath>
#include <cstdint>
#include <cstdio>

#define LAS __attribute__((address_space(3)))

typedef unsigned short bf16_t;
typedef short bf16x8 __attribute__((ext_vector_type(8)));
typedef float f32x4 __attribute__((ext_vector_type(4)));
typedef unsigned u32x4 __attribute__((ext_vector_type(4)));
typedef unsigned u32x2 __attribute__((ext_vector_type(2)));

constexpr int D = 1024, NB = 2, NSEQ = 8192, NCTX = 256, DEPTH = 2;
constexpr int R_LAT = NB * NSEQ, R_CTX = NB * NCTX, R_ALL = R_LAT + R_CTX;
constexpr int DIN = 2816;
constexpr int NKEY = NSEQ + NCTX;
constexpr int NE = 64, TOPK = 8;
constexpr int MAXSLOT = 151552;
constexpr int HROWS = MAXSLOT + R_ALL;
constexpr int NCHUNK = 132;
constexpr float EPS = 1e-6f;
constexpr float TOK8_SCALE = 8.f, WGU8_SCALE = 256.f, H8_SCALE = 16.f, WD8_SCALE = 128.f;
constexpr float GU_DESCALE = 1.f / (TOK8_SCALE * WGU8_SCALE), DN_DESCALE = 1.f / (H8_SCALE * WD8_SCALE);
constexpr float Y8_SCALE = 32.f;
constexpr float QSCALE = 0.125f * 1.4426950408889634f;
constexpr float LOG2E = 1.4426950408889634f;

#ifndef FAST_HGRN
#define FAST_HGRN 1
#endif
constexpr int C_GQ = 0, C_GK = 256, C_GV = 384, C_WQ = 512, C_WK = 768, C_WV = 896, C_CVV = 1024, C_CVG = 1280, C_RQ = 1536, C_RI = 1792, C_RFF = 2048, C_RFB = 2304, C_RG = 2560;

constexpr size_t MiB = (size_t)1 << 20;
constexpr size_t WS_CTL = 0, CTL_ZERO_BYTES = 64 * 1024;
constexpr size_t WS_MOD = 1 * MiB;
constexpr size_t WS_LB = WS_MOD + 256 * 1024;
constexpr size_t WS_ROPE = WS_MOD + 512 * 1024;
constexpr size_t WS_TOKE = 2 * MiB, WS_TOKP = 3 * MiB, WS_TOKW = 4 * MiB, WS_TOKS = 5 * MiB;
constexpr size_t WS_SLOTT = 6 * MiB, WS_SLOTW = 7 * MiB;
constexpr size_t WS_X = 8 * MiB;
constexpr size_t WS_WD = 74 * MiB;
constexpr size_t WS_Z = 107 * MiB;
constexpr size_t Z_A = WS_Z + 0 * MiB;
constexpr size_t Z_WGU = WS_Z + 33 * MiB;
constexpr size_t Z_WIN = WS_Z + 98 * MiB;
constexpr size_t Z_WOUT = WS_Z + 104 * MiB;
constexpr size_t Z_WPW = WS_Z + 106 * MiB;
__host__ __device__ constexpr size_t wgu_off(int l) { return WS_Z + 33 * MiB + (size_t)l * 34078720; }
__host__ __device__ constexpr size_t wd_off(int l) { return 74 * MiB + (size_t)l * 17039360; }
__host__ __device__ constexpr size_t win_off(int l) { return l == 0 ? WS_Z + 98 * MiB : WS_Z + (302 + 42) * MiB; }
__host__ __device__ constexpr size_t wout_off(int l) { return l == 0 ? WS_Z + 104 * MiB : WS_Z + (302 + 48) * MiB; }
__host__ __device__ constexpr size_t wpw_off(int l) { return l == 0 ? WS_Z + 106 * MiB : WS_Z + (302 + 51) * MiB; }
constexpr size_t Z_P = WS_Z + 107 * MiB;
constexpr size_t Z_YCAT = WS_Z + 198 * MiB;
constexpr size_t Z_QG = WS_Z + 231 * MiB, Z_QW = WS_Z + 239 * MiB;
constexpr size_t Z_KG = WS_Z + 247 * MiB, Z_VG = WS_Z + 252 * MiB, Z_KW = WS_Z + 257 * MiB, Z_VW = WS_Z + 262 * MiB;
constexpr size_t Z_QGC = WS_Z + 267 * MiB, Z_QWC = Z_QGC + 512 * 1024;
constexpr size_t Z_U = WS_Z + 268 * MiB;
constexpr size_t Z_G = WS_Z + 301 * MiB;
constexpr size_t Z_Y = WS_Z + 107 * MiB;
constexpr size_t Z_H = WS_Z + 302 * MiB;
constexpr size_t WS_END = WS_Z + 385 * MiB;
constexpr size_t WS_EXPL = WS_END, WS_EXPW = WS_END + 5 * MiB, WS_END2 = WS_END + 10 * MiB;
static_assert(Z_H + (size_t)HROWS * 512 <= WS_END, "H fits");
static_assert(Z_Y + (size_t)MAXSLOT * 1024 <= Z_U, "Y8 below the HGRN state buffers");
static_assert(Z_P + (size_t)R_ALL * DIN * 2 <= Z_YCAT, "P fits");

constexpr int CW_BAR = 0;
constexpr int CW_CNT = 4096;

constexpr int LDS_BYTES = 147456;
constexpr int NTHREADS = 512;

struct Params {
    const float* in[31];
    float* out;
    unsigned char* ws;
    int ph_lo, ph_hi;
};

typedef const __attribute__((address_space(4))) Params* KP;
__device__ __forceinline__ KP kparams() { KP k = (KP)__builtin_amdgcn_kernarg_segment_ptr(); asm volatile("" : "+s"(k)); return k; }

__device__ __forceinline__ int tid_() { int t = threadIdx.x; asm volatile("" : "+v"(t)); return t; }
__device__ __forceinline__ int bid_() { int b = blockIdx.x; asm volatile("" : "+s"(b)); return b; }
__device__ __forceinline__ int gsz_() { int g = gridDim.x; asm volatile("" : "+s"(g)); return g; }

__device__ __forceinline__ unsigned f2bf(float f) { unsigned u = __float_as_uint(f); return (u + 0x7fffu + ((u >> 16) & 1u)) >> 16; }
__device__ __forceinline__ float bf2f(unsigned h) { return __uint_as_float(h << 16); }
__device__ __forceinline__ unsigned pk2(float lo, float hi) { unsigned r; asm("v_cvt_pk_bf16_f32 %0, %1, %2" : "=v"(r) : "v"(lo), "v"(hi)); return r; }
__device__ __forceinline__ void unpack8(const u32x4 r, f32x4& lo, f32x4& hi) { lo.x = bf2f(r.x & 0xffffu); lo.y = bf2f(r.x >> 16); lo.z = bf2f(r.y & 0xffffu); lo.w = bf2f(r.y >> 16); hi.x = bf2f(r.z & 0xffffu); hi.y = bf2f(r.z >> 16); hi.z = bf2f(r.w & 0xffffu); hi.w = bf2f(r.w >> 16); }
__device__ __forceinline__ float wave_sum(float v) {
#pragma unroll
    for (int o = 1; o < 64; o <<= 1) v += __shfl_xor(v, o);
    return v;
}
__device__ __forceinline__ float clamp8(float v) { return fminf(fmaxf(v, -440.f), 440.f); }
__device__ __forceinline__ float sigmoid_(float x) { return __builtin_amdgcn_rcpf(1.f + __expf(-x)); }
__device__ __forceinline__ float silu_(float x) { return x * sigmoid_(x); }

__device__ __forceinline__ const float* xrow_src(KP p, int l, int row) {
    if (l == 0) return (row < R_LAT) ? p->in[0] + (size_t)row * D : p->in[2] + (size_t)(row - R_LAT) * D;
    return (const float*)(p->ws + WS_X) + (size_t)row * D;
}
__device__ __forceinline__ const float* mod_vec(KP p, int l, int row, int i) {
    const int r = (row < R_LAT) ? (row >> 13) : 2;
    return (const float*)(p->ws + WS_MOD) + ((size_t)l * 3 + r) * 6144 + i * 1024;
}

#define XB_TMO      128
#define XB_XCNT(j)  (256  + 64 * (j))
#define XB_XSUB(j)  (1280 + 64 * (j))
#define XB_XGEN(j)  (2304 + 64 * (j))
#define XB_TOP      3328
#define XB_TOPGEN   3392
#define XCD_BAR_WORDS 3456
#define XB_SPIN_CAP (1u << 18)
__device__ __forceinline__ unsigned xb_ld(unsigned* p)              { return __hip_atomic_load(p, __ATOMIC_RELAXED, __HIP_MEMORY_SCOPE_AGENT); }
__device__ __forceinline__ unsigned xb_add(unsigned* p, unsigned v) { return __hip_atomic_fetch_add(p, v, __ATOMIC_RELAXED, __HIP_MEMORY_SCOPE_AGENT); }
__device__ __forceinline__ unsigned xb_xcc_id() { return (unsigned)__builtin_amdgcn_s_getreg((3 << 11) | 20) & 0xFu; }
#define XB_SPIN(cond, bar) do { unsigned _sp = 0; while (cond) { __builtin_amdgcn_s_sleep(1); \
    if ((++_sp & 255u) == 0u) { if (xb_ld(&(bar)[XB_TMO])) break; if (_sp > XB_SPIN_CAP) { atomicAdd(&(bar)[XB_TMO], 1u); break; } } } } while (0)
struct XcdBarrier { unsigned* bar; unsigned x; volatile LAS unsigned* st; };
__device__ __forceinline__ XcdBarrier xcd_barrier_post(unsigned* bar, volatile LAS unsigned* st) {
    XcdBarrier b; b.bar = bar; b.x = xb_xcc_id(); b.st = st;
    if (threadIdx.x == 0) (void)xb_add(&bar[XB_XCNT(b.x)], 1u);
    return b;
}
__device__ __forceinline__ void xcd_barrier_complete(unsigned* bar, unsigned x, unsigned& nloc, unsigned& nx) {
    const unsigned G = gridDim.x * gridDim.y * gridDim.z;
    unsigned sum, cnt, mine, sp = 0u;
    for (;;) {
        sum = 0u; cnt = 0u; mine = 0u;
#pragma unroll
        for (unsigned j = 0; j < 16; ++j) { const unsigned c = xb_ld(&bar[XB_XCNT(j)]); sum += c; cnt += (c > 0u) ? 1u : 0u; mine = (j == x) ? c : mine; }
        if (sum == G) break;
        __builtin_amdgcn_s_sleep(1);
        if ((++sp & 255u) == 0u) { if (xb_ld(&bar[XB_TMO])) break; if (sp > XB_SPIN_CAP) { atomicAdd(&bar[XB_TMO], 1u); break; } }
    }
    nloc = mine > 0u ? mine : 1u; nx = cnt > 0u ? cnt : 1u;
}
__device__ __forceinline__ void xcd_barrier(const XcdBarrier& b) {
    asm volatile("s_waitcnt vmcnt(0)" ::: "memory");
    __syncthreads();
    if (threadIdx.x == 0) {
        unsigned* bar = b.bar;
        __builtin_amdgcn_s_waitcnt(0);
        unsigned nloc = b.st[0], nx = b.st[1];
        if (nloc == 0u) { xcd_barrier_complete(bar, b.x, nloc, nx); b.st[0] = nloc; b.st[1] = nx; }
        const unsigned old = xb_add(&bar[XB_XSUB(b.x)], 1u);
        const unsigned gen = old / nloc;
        if (old + 1u == (gen + 1u) * nloc) {
            __builtin_amdgcn_fence(__ATOMIC_RELEASE, "agent");
            asm volatile("s_waitcnt vmcnt(0)" ::: "memory");
            const unsigned og = xb_add(&bar[XB_TOP], 1u);
            const unsigned tg = og / nx;
            if (og + 1u == (tg + 1u) * nx) xb_add(&bar[XB_TOPGEN], 1u);
            else XB_SPIN(xb_ld(&bar[XB_TOPGEN]) == tg, bar);
            __builtin_amdgcn_fence(__ATOMIC_ACQUIRE, "agent");
            xb_add(&bar[XB_XGEN(b.x)], 1u);
            asm volatile("s_waitcnt vmcnt(0)" ::: "memory");
        } else {
            XB_SPIN(xb_ld(&bar[XB_XGEN(b.x)]) == gen, bar);
            __builtin_amdgcn_fence(__ATOMIC_ACQUIRE, "agent");
            asm volatile("s_waitcnt vmcnt(0)" ::: "memory");
        }
    }
    __syncthreads();
}

__device__ __forceinline__ void ph_pro(KP p, unsigned char* lds) {
    float* sc = (float*)lds;
    float* red = sc + 3 * 1024;
    const int tid = tid_(), lane = tid & 63, wid = tid >> 6;
    for (int i = tid; i < 3 * 1024; i += NTHREADS) { const int r = i >> 10, k = i & 1023; const float v = (r < 2) ? p->in[1][r * 1024 + k] : p->in[3][k]; sc[i] = silu_(v); }
    __syncthreads();
    float* mod = (float*)(p->ws + WS_MOD);
    for (int item = bid_(); item < DEPTH * 96; item += gsz_()) {
        const int l = item / 96, j0 = (item % 96) * 64;
        const float* w = p->in[4] + (size_t)l * 1024 * 6144;
        float a0 = 0.f, a1 = 0.f, a2 = 0.f;
        const int k0 = wid * 128;
#pragma unroll 1
        for (int k = k0; k < k0 + 128; k += 16) { float wv[16];
#pragma unroll
            for (int u = 0; u < 16; ++u) wv[u] = w[(size_t)(k + u) * 6144 + j0 + lane];
#pragma unroll
            for (int u = 0; u < 16; ++u) { a0 += sc[k + u] * wv[u]; a1 += sc[1024 + k + u] * wv[u]; a2 += sc[2048 + k + u] * wv[u]; } }
        red[(wid * 3 + 0) * 64 + lane] = a0; red[(wid * 3 + 1) * 64 + lane] = a1; red[(wid * 3 + 2) * 64 + lane] = a2;
        __syncthreads();
        if (tid < 192) { const int r = tid >> 6; float s = 0.f;
            for (int w8 = 0; w8 < 8; ++w8) s += red[(w8 * 3 + r) * 64 + lane];
            mod[((size_t)l * 3 + r) * 6144 + j0 + lane] = s + p->in[5][l * 6144 + j0 + lane]; }
        __syncthreads();
    }
    if (bid_() == 0) {
        float* rt = (float*)(p->ws + WS_ROPE);
        for (int i = tid; i < 128 * 16; i += NTHREADS) { const int pos = i >> 4, f = i & 15; const float inv = powf(10000.f, -(float)f * (1.f / 16.f)); float sn, cs; sincosf((float)pos * inv, &sn, &cs);
            rt[pos * 32 + f] = cs; rt[pos * 32 + 16 + f] = sn; }
    }
    if (bid_() == gsz_() - 1) {
        float* lb = (float*)(p->ws + WS_LB);
        for (int i = tid; i < 2 * 2 * 256; i += NTHREADS) { const int l = i >> 9, dir = (i >> 8) & 1, ch = i & 255;
            const float* lg = p->in[21];
            const float l0 = lg[(dir * 2 + 0) * 256 + ch], l1 = lg[(dir * 2 + 1) * 256 + ch]; const float m = fmaxf(l0, l1);
            const float e0 = expf(l0 - m), e1 = expf(l1 - m);
            lb[i] = (l == 0) ? 0.f : e1 / (e0 + e1); }
    }
}

constexpr int CVT_E1 = 1050, CVT_E2 = 2850;
struct CvtTile { const float* src; bf16_t* dst; int K, N, k0, n0, blk, bstride, boff; float f8scale; };
__device__ __forceinline__ int cvt_total() { return 16 * 44 + 16 * 16 + 4 * 4 + 2 * (64 * 64) + 2 * 64 + 64 * 64 + 64; }
__device__ __forceinline__ CvtTile cvt_decode(KP p, int l, int g) {
    bf16_t* Wgu = (bf16_t*)(p->ws + wgu_off(l)); bf16_t* Wd = (bf16_t*)(p->ws + wd_off(l));
    CvtTile t; int per, tn, r;
    if (g < 704) { r = g; t = {p->in[8] + (size_t)l * 1024 * DIN, (bf16_t*)(p->ws + win_off(l)), 1024, DIN, 0, 0, DIN, 0, 0, 0.f}; tn = 44; per = 704; }
    else if ((g -= 704) < 256) { r = g; t = {p->in[9] + (size_t)l * 1024 * 1024, (bf16_t*)(p->ws + wout_off(l)), 1024, 1024, 0, 0, 1024, 0, 0, 0.f}; tn = 16; per = 256; }
    else if ((g -= 256) < 16) { r = g; t = {p->in[19] + (size_t)l * 65536, (bf16_t*)(p->ws + wpw_off(l)), 256, 256, 0, 0, 256, 0, 0, 0.f}; tn = 4; per = 16; }
    else if ((g -= 16) < 4096) { const int m = g >> 6; r = g & 63; t = {p->in[25] + ((size_t)l * 64 + m) * 262144, (bf16_t*)((unsigned char*)Wgu + (size_t)m * 524288), 1024, 256, 0, 0, 128, 256, 0, WGU8_SCALE}; tn = 4; per = 64; }
    else if ((g -= 4096) < 4096) { const int m = g >> 6; r = g & 63; t = {p->in[26] + ((size_t)l * 64 + m) * 262144, (bf16_t*)((unsigned char*)Wgu + (size_t)m * 524288), 1024, 256, 0, 0, 128, 256, 128, WGU8_SCALE}; tn = 4; per = 64; }
    else if ((g -= 4096) < 64) { r = g; t = {p->in[28] + (size_t)l * 262144, (bf16_t*)((unsigned char*)Wgu + (size_t)64 * 524288), 1024, 256, 0, 0, 128, 256, 0, WGU8_SCALE}; tn = 4; per = 64; }
    else if ((g -= 64) < 64) { r = g; t = {p->in[29] + (size_t)l * 262144, (bf16_t*)((unsigned char*)Wgu + (size_t)64 * 524288), 1024, 256, 0, 0, 128, 256, 128, WGU8_SCALE}; tn = 4; per = 64; }
    else if ((g -= 64) < 4096) { const int m = g >> 6; r = g & 63; t = {p->in[27] + ((size_t)l * 64 + m) * 262144, (bf16_t*)((unsigned char*)Wd + (size_t)m * 262144), 256, 1024, 0, 0, 1024, 0, 0, WD8_SCALE}; tn = 16; per = 64; }
    else { g -= 4096; r = g; t = {p->in[30] + (size_t)l * 262144, (bf16_t*)((unsigned char*)Wd + (size_t)64 * 262144), 256, 1024, 0, 0, 1024, 0, 0, WD8_SCALE}; tn = 16; per = 64; }
    (void)per; t.k0 = (r / tn) * 64; t.n0 = (r % tn) * 64; return t;
}
__device__ __forceinline__ void ph_cvt(KP p, int l, unsigned char* lds, int first = 0, int nwg = 0, int t0 = 0, int t1 = 1 << 30) {
    float* tb = (float*)lds;
    const int tid = tid_(), G = nwg ? nwg : gsz_(), total = t1 < cvt_total() ? t1 : cvt_total();
    const int r0 = tid >> 4, c0 = (tid & 15) * 4, nn = tid >> 3, kc = (tid & 7) * 8;
    int g = bid_() - first, buf = 0;
    if (g < 0) return;
    g += t0;
    if (g >= total) return;
    CvtTile T = cvt_decode(p, l, g);
    f32x4 v0 = *(const f32x4*)(T.src + (size_t)(T.k0 + r0) * T.N + T.n0 + c0), v1 = *(const f32x4*)(T.src + (size_t)(T.k0 + r0 + 32) * T.N + T.n0 + c0);
    for (;;) {
        float* t = tb + buf * (64 * 65);
        t[r0 * 65 + c0] = v0.x; t[r0 * 65 + c0 + 1] = v0.y; t[r0 * 65 + c0 + 2] = v0.z; t[r0 * 65 + c0 + 3] = v0.w;
        t[(r0 + 32) * 65 + c0] = v1.x; t[(r0 + 32) * 65 + c0 + 1] = v1.y; t[(r0 + 32) * 65 + c0 + 2] = v1.z; t[(r0 + 32) * 65 + c0 + 3] = v1.w;
        const CvtTile C = T; const int gn = g + G; const bool more = gn < total;
        if (more) { T = cvt_decode(p, l, gn);
            v0 = *(const f32x4*)(T.src + (size_t)(T.k0 + r0) * T.N + T.n0 + c0); v1 = *(const f32x4*)(T.src + (size_t)(T.k0 + r0 + 32) * T.N + T.n0 + c0); }
        __syncthreads();
        { const int n = C.n0 + nn; const int drow = (n / C.blk) * C.bstride + C.boff + (n % C.blk);
          if (C.f8scale != 0.f) { const float sc = C.f8scale;
              int w0 = __builtin_amdgcn_cvt_pk_fp8_f32(clamp8(t[(kc + 0) * 65 + nn] * sc), clamp8(t[(kc + 1) * 65 + nn] * sc), 0, false); w0 = __builtin_amdgcn_cvt_pk_fp8_f32(clamp8(t[(kc + 2) * 65 + nn] * sc), clamp8(t[(kc + 3) * 65 + nn] * sc), w0, true);
              int w1 = __builtin_amdgcn_cvt_pk_fp8_f32(clamp8(t[(kc + 4) * 65 + nn] * sc), clamp8(t[(kc + 5) * 65 + nn] * sc), 0, false); w1 = __builtin_amdgcn_cvt_pk_fp8_f32(clamp8(t[(kc + 6) * 65 + nn] * sc), clamp8(t[(kc + 7) * 65 + nn] * sc), w1, true);
              u32x2 o8; o8.x = (unsigned)w0; o8.y = (unsigned)w1;
              *(u32x2*)((unsigned char*)C.dst + (size_t)drow * C.K + C.k0 + kc) = o8;
          } else {
          u32x4 o; o.x = pk2(t[(kc + 0) * 65 + nn], t[(kc + 1) * 65 + nn]); o.y = pk2(t[(kc + 2) * 65 + nn], t[(kc + 3) * 65 + nn]);
          o.z = pk2(t[(kc + 4) * 65 + nn], t[(kc + 5) * 65 + nn]); o.w = pk2(t[(kc + 6) * 65 + nn], t[(kc + 7) * 65 + nn]);
          *(u32x4*)(C.dst + (size_t)drow * C.K + C.k0 + kc) = o; } }
        if (!more) break;
        g = gn; buf ^= 1;
    }
    __syncthreads();
}
__device__ __forceinline__ void norm_mod_row(const float* xrow, const float* g, const float* shift, const float* scale, bf16_t* orow, float* fout, int lane) {
    f32x4 v[4]; float s = 0.f;
#pragma unroll
    for (int j = 0; j < 4; ++j) { v[j] = ((const f32x4*)xrow)[lane + 64 * j]; s += v[j].x * v[j].x + v[j].y * v[j].y + v[j].z * v[j].z + v[j].w * v[j].w; }
    const float rinv = rsqrtf(wave_sum(s) * (1.f / D) + EPS);
#pragma unroll
    for (int j = 0; j < 4; ++j) { const int idx = lane + 64 * j;
        const f32x4 gg = ((const f32x4*)g)[idx], sh = ((const f32x4*)shift)[idx], sc = ((const f32x4*)scale)[idx];
        f32x4 y; y.x = v[j].x * rinv * gg.x * (1.f + sc.x) + sh.x; y.y = v[j].y * rinv * gg.y * (1.f + sc.y) + sh.y;
        y.z = v[j].z * rinv * gg.z * (1.f + sc.z) + sh.z; y.w = v[j].w * rinv * gg.w * (1.f + sc.w) + sh.w;
        u32x2 o; o.x = pk2(y.x, y.y); o.y = pk2(y.z, y.w);
        ((u32x2*)orow)[idx] = o;
        if (fout) ((f32x4*)fout)[idx] = y; }
}
__device__ __forceinline__ void ph_norm1(KP p, int l, unsigned char* lds) {
    if (l == 0) ph_cvt(p, l, lds);
    const int tid = tid_(), lane = tid & 63, wid = tid >> 6;
    bf16_t* A = (bf16_t*)(p->ws + Z_A);
    const float* g = p->in[6] + l * D;
    if (l == 0) { for (int row = bid_() * 8 + wid; row < R_ALL; row += gsz_() * 8)
        norm_mod_row(xrow_src(p, l, row), g, mod_vec(p, l, row, 0), mod_vec(p, l, row, 1), A + (size_t)row * D, nullptr, lane); }
    else { const bf16_t* X = (const bf16_t*)(p->ws + WS_X);
        for (int row = bid_() * 8 + wid; row < R_ALL; row += gsz_() * 8) {
            const float* shift = mod_vec(p, l, row, 0); const float* scale = mod_vec(p, l, row, 1);
            f32x4 v[4]; unpack8(*(const u32x4*)(X + (size_t)row * D + lane * 8), v[0], v[1]); unpack8(*(const u32x4*)(X + (size_t)row * D + 512 + lane * 8), v[2], v[3]);
            float ss = 0.f;
#pragma unroll
            for (int j = 0; j < 4; ++j) ss += v[j].x * v[j].x + v[j].y * v[j].y + v[j].z * v[j].z + v[j].w * v[j].w;
            const float rinv = rsqrtf(wave_sum(ss) * (1.f / D) + EPS);
#pragma unroll
            for (int h = 0; h < 2; ++h) { const int c0 = h * 512 + lane * 8; unsigned o[4];
#pragma unroll
                for (int q = 0; q < 2; ++q) { const f32x4 gg = *(const f32x4*)(g + c0 + 4 * q), sh = *(const f32x4*)(shift + c0 + 4 * q), sc = *(const f32x4*)(scale + c0 + 4 * q);
                    const f32x4 y = v[2 * h + q] * rinv * gg * (sc + 1.f) + sh; o[2 * q] = pk2(y.x, y.y); o[2 * q + 1] = pk2(y.z, y.w); }
                *(u32x4*)(A + (size_t)row * D + c0) = (u32x4){o[0], o[1], o[2], o[3]}; } } }
}

template <int NBJ, class ARow, class Epi>
__device__ __forceinline__ void gemm_simple_tile(const bf16_t* A, const ARow& arow, const bf16_t* Bt, int K, int row0, int colb0, int bjstride, const Epi& epi) {
    const int tid = tid_(), lane = tid & 63, wid = tid >> 6, wr = wid >> 1, wc = wid & 1, fr = lane & 15, fq = lane >> 4;
    f32x4 acc[2][NBJ][4];
#pragma unroll
    for (int i = 0; i < 2; ++i)
#pragma unroll
        for (int b = 0; b < NBJ; ++b)
#pragma unroll
            for (int j = 0; j < 4; ++j) acc[i][b][j] = (f32x4){0.f, 0.f, 0.f, 0.f};
    const bf16_t* ap[2];
#pragma unroll
    for (int i = 0; i < 2; ++i) ap[i] = A + (size_t)arow(row0 + wr * 32 + i * 16 + fr) * K + fq * 8;
    const bf16_t* bp = Bt + (size_t)(colb0 + wc * 64 + fr) * K + fq * 8;
    for (int k = 0; k < K; k += 32) {
        bf16x8 a[2];
#pragma unroll
        for (int i = 0; i < 2; ++i) a[i] = *(const bf16x8*)(ap[i] + k);
#pragma unroll
        for (int b = 0; b < NBJ; ++b)
#pragma unroll
            for (int j = 0; j < 4; ++j) { const bf16x8 bv = *(const bf16x8*)(bp + (size_t)(b * bjstride + j * 16) * K + k);
#pragma unroll
                for (int i = 0; i < 2; ++i) acc[i][b][j] = __builtin_amdgcn_mfma_f32_16x16x32_bf16(a[i], bv, acc[i][b][j], 0, 0, 0); }
    }
#pragma unroll
    for (int i = 0; i < 2; ++i)
#pragma unroll
        for (int j = 0; j < 4; ++j)
#pragma unroll
            for (int r = 0; r < 4; ++r) { const int row = row0 + wr * 32 + i * 16 + fq * 4 + r, col = wc * 64 + j * 16 + fr;
                epi(row, col, acc[i][0][j][r], acc[i][NBJ - 1][j][r]); }
}
struct RowId { __device__ __forceinline__ int operator()(int r) const { return r; } };
struct RowGather { const int* idx; __device__ __forceinline__ int operator()(int r) const { return idx[r]; } };

__device__ __forceinline__ void ph_inproj(KP p, int l, unsigned char* lds) {
    const bf16_t* A = (const bf16_t*)(p->ws + Z_A); const bf16_t* Bt = (const bf16_t*)(p->ws + Z_WIN); bf16_t* P = (bf16_t*)(p->ws + Z_P);
    constexpr int TM = R_ALL / 128, TN = DIN / 128;
    for (int it = bid_(); it < TM * TN; it += gsz_()) { const int mt = it / TN, nt = it % TN;
        auto epi = [&](int row, int col, float v, float) { P[(size_t)row * DIN + nt * 128 + col] = (bf16_t)f2bf(v); };
        gemm_simple_tile<1>(A, RowId{}, Bt, 1024, mt * 128, nt * 128, 0, epi); }
}

namespace pg8 {
constexpr int BM = 256, BK = 64, HALF = 128, HTB = HALF * BK * 2, STAGE_BYTES = 8 * HTB, NXCD = 8, WGM = 8;
__host__ __device__ __forceinline__ int lds_byte(int r, int c) { const int st = (r >> 4) * 2 + (c >> 5), rr = r & 15, cc = c & 31, ob = rr * 64 + cc * 2; return st * 1024 + (ob ^ (((ob >> 9) & 1) << 5)); }
__host__ __device__ __forceinline__ void stage_rc(int b, int& R, int& C) { const int st = b / 1024, sb = b % 1024, swz = sb ^ (((sb >> 9) & 1) << 5); R = (st >> 1) * 16 + swz / 64; C = (st & 1) * 32 + (swz % 64) / 2; }
__host__ __device__ __forceinline__ int perm32(int rho) { const int n = rho >> 4, i = rho & 15; return 8 * (i >> 2) + 4 * n + (i & 3); }
struct Unit { int pm, pn, ord; };
struct Gemm { const bf16_t* A; const bf16_t* Bt; int M, N, K; };
struct StaticOrder {
    int nM, nN, nwg, G, c;
    __host__ __device__ void init(int M, int N, int G_, int c_) { nM = M / BM; nN = N / BM; nwg = nM * nN; G = G_; c = c_; }
    __host__ __device__ bool next(int i, Unit& u) const {
        const long L = (long)i * G + c; if (L >= nwg) return false;
        int wgid = (int)L; { const int q = nwg / NXCD, r = nwg % NXCD, xcd = wgid % NXCD, off = wgid / NXCD; wgid = (xcd < r ? xcd * (q + 1) : r * (q + 1) + (xcd - r) * q) + off; }
        const int nig = WGM * nN, gid = wgid / nig, fm = gid * WGM, gsz = (nM - fm) < WGM ? (nM - fm) : WGM;
        u.pm = fm + ((wgid % nig) % gsz); u.pn = (wgid % nig) / gsz; u.ord = i; return true;
    }
};
__device__ __forceinline__ unsigned cvt_pk_bf16(float lo, float hi) { unsigned r; asm volatile("v_cvt_pk_bf16_f32 %0, %1, %2" : "=v"(r) : "v"(lo), "v"(hi)); return r; }

typedef int i32x4v __attribute__((ext_vector_type(4)));
typedef int i32x8v __attribute__((ext_vector_type(8)));
__device__ __forceinline__ i32x8v cat8(bf16x8 lo, bf16x8 hi) { const i32x4v a = __builtin_bit_cast(i32x4v, lo), b = __builtin_bit_cast(i32x4v, hi); return __builtin_shufflevector(a, b, 0, 1, 2, 3, 4, 5, 6, 7); }
__device__ __forceinline__ void glds16_s(const void* sbase, unsigned voff, unsigned lds_dst) { unsigned keep;
    asm volatile("s_mov_b32 %0, m0\n\ts_mov_b32 m0, %3\n\ts_nop 0\n\tglobal_load_lds_dwordx4 %1, %2\n\ts_mov_b32 m0, %0" : "=&s"(keep) : "v"(voff), "s"(sbase), "s"(lds_dst) : "memory"); }
template <class Epi, class Sched, bool GATHER, bool FP8 = false>
__device__ __forceinline__ void gemm_phase(LAS unsigned char* lds, const Gemm g, const Sched& S, const Epi& E, const LAS int* rtab) {
    const int tid = tid_(), wid = __builtin_amdgcn_readfirstlane(tid >> 6), lane = tid & 63, wr = wid >> 2, wc = wid & 3, fr = lane & 15, fq = lane >> 4;
    const int KB = FP8 ? g.K : g.K * 2, nt = KB / 128;
    unsigned voffA[2], voffB[2]; int RA[2], CA[2];
#pragma unroll
    for (int i = 0; i < 2; ++i) { int R, C; stage_rc(tid * 16 + i * 8192, R, C); const int Rb = (R & ~31) + perm32(R & 31);
        voffA[i] = (unsigned)(R * KB + C * 2); voffB[i] = (unsigned)(Rb * KB + C * 2); RA[i] = R; CA[i] = C; }
    const size_t kstep = (size_t)128;
    const size_t hstep = (size_t)HALF * KB;
    const size_t hstepA = GATHER ? 0 : hstep;
    const size_t tstep = 2 * hstep;
    const unsigned ldsw = (unsigned)wid * 1024u;
    const unsigned ldsb = (unsigned)__builtin_amdgcn_readfirstlane((int)((unsigned)(size_t)lds + ldsw));
    const int aoff = lds_byte(wr * 64 + fr, fq * 8), boff = lds_byte(wc * 32 + fr, fq * 8);
#define PG8_SA(b, h) (((b) * 2 + (h)) * HTB)
#define PG8_SB(b, h) ((4 + (b) * 2 + (h)) * HTB)
#define PG8_STAGE(bufoff, gbase, voff) do { _Pragma("unroll") for (int _i = 0; _i < 2; ++_i) { if constexpr (FP8) glds16_s((const void*)(gbase), (voff)[_i], ldsb + (unsigned)((bufoff) + _i * 8192)); \
        else __builtin_amdgcn_global_load_lds((const unsigned*)((const char*)(gbase) + (voff)[_i]), (LAS unsigned*)(lds + (bufoff) + ldsw + _i * 8192), 16, 0, 0); } } while (0)
#define PG8_LDA(dst, b, h) do { _Pragma("unroll") for (int m = 0; m < 4; ++m) { if constexpr (FP8) dst##8[m] = cat8(*(const LAS bf16x8*)(lds + PG8_SA(b, h) + aoff + m * 2048), *(const LAS bf16x8*)(lds + PG8_SA(b, h) + aoff + m * 2048 + 1024)); \
        else { _Pragma("unroll") for (int k = 0; k < 2; ++k) dst[m][k] = *(const LAS bf16x8*)(lds + PG8_SA(b, h) + aoff + m * 2048 + k * 1024); } } } while (0)
#define PG8_LDB(dst, b, h) do { _Pragma("unroll") for (int n = 0; n < 2; ++n) { if constexpr (FP8) dst##8[n] = cat8(*(const LAS bf16x8*)(lds + PG8_SB(b, h) + boff + n * 2048), *(const LAS bf16x8*)(lds + PG8_SB(b, h) + boff + n * 2048 + 1024)); \
        else { _Pragma("unroll") for (int k = 0; k < 2; ++k) dst[n][k] = *(const LAS bf16x8*)(lds + PG8_SB(b, h) + boff + n * 2048 + k * 1024); } } } while (0)
#define PG8_MMA(ai, bj, At, Bt) do { __builtin_amdgcn_s_setprio(1); _Pragma("unroll") for (int m = 0; m < 4; ++m) _Pragma("unroll") for (int n = 0; n < 2; ++n) { \
        if constexpr (FP8) acc[ai][bj][m][n] = __builtin_amdgcn_mfma_scale_f32_16x16x128_f8f6f4(Bt##8[n], At##8[m], acc[ai][bj][m][n], 0, 0, 0, 0x7F7F7F7F, 0, 0x7F7F7F7F); \
        else { _Pragma("unroll") for (int k = 0; k < 2; ++k) acc[ai][bj][m][n] = __builtin_amdgcn_mfma_f32_16x16x32_bf16(Bt[n][k], At[m][k], acc[ai][bj][m][n], 0, 0, 0); } } \
        if constexpr (FP8) { asm volatile("" : "+v"(acc[ai][bj][0][0]), "+v"(acc[ai][bj][0][1]), "+v"(acc[ai][bj][1][0]), "+v"(acc[ai][bj][1][1]), "+v"(acc[ai][bj][2][0]), "+v"(acc[ai][bj][2][1]), "+v"(acc[ai][bj][3][0]), "+v"(acc[ai][bj][3][1])); } \
        __builtin_amdgcn_s_setprio(0); } while (0)
#define PG8_WAIT_V(n) asm volatile("s_waitcnt vmcnt(" #n ")" ::: "memory")
#define PG8_WAIT_L(n) asm volatile("s_waitcnt lgkmcnt(" #n ")" ::: "memory")
#define PG8_BAR __builtin_amdgcn_s_barrier()
#define PG8_SCHED __builtin_amdgcn_sched_barrier(0)
#define PG8_STAGE_A(bufoff, gbase, ord, h) do { unsigned _o[2]; if constexpr (GATHER) { int _t = tid; asm volatile("" : "+v"(_t));   \
            _Pragma("unroll") for (int _i = 0; _i < 2; ++_i) { int _R, _C; stage_rc(_t * 16 + _i * 8192, _R, _C); _o[_i] = (unsigned)(rtab[(ord) * 256 + (h) * 128 + _R] * KB + _C * 2); } } \
        else { _o[0] = voffA[0]; _o[1] = voffA[1]; } PG8_STAGE(bufoff, gbase, _o); } while (0)
    Unit cur, nxt; int ui = 0;
    if (!S.next(0, cur)) return;
    f32x4 acc[2][2][4][2];
#pragma unroll
    for (int a = 0; a < 2; ++a)
#pragma unroll
        for (int b = 0; b < 2; ++b)
#pragma unroll
            for (int m = 0; m < 4; ++m)
#pragma unroll
                for (int n = 0; n < 2; ++n) acc[a][b][m][n] = (f32x4){0.f, 0.f, 0.f, 0.f};
    bf16x8 At[4][2], B0[2][2], B1[2][2]; i32x8v At8[4], B08[2], B18[2];
    const char* cA = GATHER ? (const char*)g.A : (const char*)g.A + (size_t)cur.pm * tstep; const char* cB = (const char*)g.Bt + (size_t)cur.pn * tstep;
    PG8_STAGE(PG8_SB(0, 0), cB, voffB); PG8_STAGE(PG8_SB(0, 1), cB + hstep, voffB); PG8_STAGE_A(PG8_SA(0, 0), cA, 0, 0); PG8_STAGE_A(PG8_SA(0, 1), cA + hstepA, 0, 1);
    if (wr == 1) PG8_BAR;
    PG8_WAIT_V(2); PG8_BAR;
    PG8_STAGE(PG8_SB(1, 0), cB + kstep, voffB); PG8_STAGE_A(PG8_SA(1, 0), cA + kstep, 0, 0); PG8_STAGE(PG8_SB(1, 1), cB + hstep + kstep, voffB);
    PG8_WAIT_V(6); PG8_BAR;
    for (;;) {
        const bool has_next = S.next(ui + 1, nxt);
        const char* nA = GATHER ? (const char*)g.A : (has_next ? (const char*)g.A + (size_t)nxt.pm * tstep : cA); const char* nB = has_next ? (const char*)g.Bt + (size_t)nxt.pn * tstep : cB;
#pragma unroll 1
        for (int t = 0; t < nt; t += 2) {
            const bool last = (t == nt - 2);
            const char* a1 = cA + (size_t)(t + 1) * kstep;
            const char* a2 = last ? nA : cA + (size_t)(t + 2) * kstep; const char* b2 = last ? nB : cB + (size_t)(t + 2) * kstep;
            const char* a3 = a2 + kstep; const char* b3 = b2 + kstep;
            const int on = (last && has_next) ? ui + 1 : ui;
            PG8_LDB(B0, 0, 0); PG8_LDB(B1, 0, 1); PG8_SCHED; PG8_LDA(At, 0, 0); PG8_STAGE_A(PG8_SA(1, 1), a1 + hstepA, ui, 1);
            PG8_WAIT_V(8); PG8_WAIT_L(0); PG8_BAR; PG8_MMA(0, 0, At, B0); PG8_MMA(0, 1, At, B1); PG8_BAR; PG8_SCHED;
            PG8_LDA(At, 0, 1); PG8_STAGE(PG8_SB(0, 0), b2, voffB); PG8_STAGE(PG8_SB(0, 1), b2 + hstep, voffB); PG8_STAGE_A(PG8_SA(0, 0), a2, on, 0);
            PG8_WAIT_V(8); PG8_WAIT_L(0); PG8_BAR; PG8_MMA(1, 0, At, B0); PG8_MMA(1, 1, At, B1); PG8_BAR; PG8_SCHED;
            PG8_LDB(B0, 1, 0); PG8_LDB(B1, 1, 1); PG8_SCHED; PG8_LDA(At, 1, 0); PG8_STAGE_A(PG8_SA(0, 1), a2 + hstepA, on, 1);
            PG8_WAIT_V(8); PG8_WAIT_L(0); PG8_BAR; PG8_MMA(0, 0, At, B0); PG8_MMA(0, 1, At, B1); PG8_BAR; PG8_SCHED;
            PG8_LDA(At, 1, 1); PG8_STAGE(PG8_SB(1, 0), b3, voffB); PG8_STAGE(PG8_SB(1, 1), b3 + hstep, voffB); PG8_STAGE_A(PG8_SA(1, 0), a3, on, 0);
            PG8_WAIT_V(8); PG8_WAIT_L(0); PG8_BAR; PG8_MMA(1, 0, At, B0); PG8_MMA(1, 1, At, B1); PG8_BAR; PG8_SCHED;
        }
        if (wr == 0) PG8_BAR;
        E(acc, cur, wr, wc, fr, fq);
        if (!has_next) break;
#pragma unroll
        for (int a = 0; a < 2; ++a)
#pragma unroll
            for (int b = 0; b < 2; ++b)
#pragma unroll
                for (int m = 0; m < 4; ++m)
#pragma unroll
                    for (int n = 0; n < 2; ++n) acc[a][b][m][n] = (f32x4){0.f, 0.f, 0.f, 0.f};
        cur = nxt; cA = nA; cB = nB; ++ui;
        if (wr == 1) PG8_BAR;
    }
    PG8_WAIT_V(0);
    PG8_BAR;
#undef PG8_SA
#undef PG8_SB
#undef PG8_STAGE
#undef PG8_LDA
#undef PG8_LDB
#undef PG8_MMA
#undef PG8_WAIT_V
#undef PG8_WAIT_L
#undef PG8_BAR
#undef PG8_SCHED
#undef PG8_STAGE_A
}
struct EpiBf16 {
    bf16_t* O; int ldc, ncolt; size_t slab;
    __device__ __forceinline__ void operator()(const f32x4 (&acc)[2][2][4][2], const Unit& u, int wr, int wc, int fr, int fq) const {
        const int row0 = u.pm * BM + wr * 64 + fr; const size_t col0 = (size_t)(u.pn % ncolt) * slab + wc * 32 + 8 * fq;
#pragma unroll
        for (int ai = 0; ai < 2; ++ai)
#pragma unroll
            for (int m = 0; m < 4; ++m) { bf16_t* rowp = O + (size_t)(row0 + ai * HALF + m * 16) * ldc + col0;
#pragma unroll
                for (int bj = 0; bj < 2; ++bj) { const f32x4 v0 = acc[ai][bj][m][0], v1 = acc[ai][bj][m][1];
                    u32x4 w; w.x = cvt_pk_bf16(v0[0], v0[1]); w.y = cvt_pk_bf16(v0[2], v0[3]); w.z = cvt_pk_bf16(v1[0], v1[1]); w.w = cvt_pk_bf16(v1[2], v1[3]);
                    *(u32x4*)(rowp + bj * HALF) = w; } }
    }
};
struct EpiRes {
    bf16_t* X; const float* xlat; const float* xctx; const float* modl; int pm_shift; float ascale;
    __device__ __forceinline__ void operator()(const f32x4 (&acc)[2][2][4][2], const Unit& u, int wr, int wc, int fr, int fq) const {
        const int pm = u.pm - pm_shift; const int rsel = pm < 64 ? (pm >> 5) : 2;
        const int row0 = pm * BM + wr * 64 + fr, col0 = (u.pn & 3) * BM + wc * 32 + 8 * fq;
        const float* gate = modl + (size_t)rsel * 6144 + col0;
        const float* xs = xlat ? (pm < 64 ? xlat + (size_t)row0 * D : xctx + (size_t)(row0 - R_LAT) * D) + col0 : nullptr;
        bf16_t* xo = X + (size_t)row0 * D + col0;
#pragma unroll
        for (int bj = 0; bj < 2; ++bj) { const f32x4 g0 = *(const f32x4*)(gate + bj * HALF) * ascale, g1 = *(const f32x4*)(gate + bj * HALF + 4) * ascale;
#pragma unroll
            for (int ai = 0; ai < 2; ++ai)
#pragma unroll
                for (int m = 0; m < 4; ++m) { const size_t o = (size_t)(ai * HALF + m * 16) * D + bj * HALF;
                    f32x4 x0, x1;
                    if (xs) { x0 = *(const f32x4*)(xs + o); x1 = *(const f32x4*)(xs + o + 4); } else unpack8(*(const u32x4*)(xo + o), x0, x1);
                    const f32x4 y0 = x0 + g0 * acc[ai][bj][m][0], y1 = x1 + g1 * acc[ai][bj][m][1];
                    u32x4 w; w.x = cvt_pk_bf16(y0[0], y0[1]); w.y = cvt_pk_bf16(y0[2], y0[3]); w.z = cvt_pk_bf16(y1[0], y1[1]); w.w = cvt_pk_bf16(y1[2], y1[3]);
                    *(u32x4*)(xo + o) = w; } }
    }
};
struct EpiGU8 {
    unsigned char* H8; const LAS float* wtab;
    __device__ __forceinline__ void operator()(const f32x4 (&acc)[2][2][4][2], const Unit& u, int wr, int wc, int fr, int fq) const {
        asm volatile("" : "+v"(fr), "+v"(fq));
        const int row0 = u.pm * BM + wr * 64 + fr, col0 = (u.pn & 1) * 128 + wc * 32 + 8 * fq;
#pragma unroll
        for (int ai = 0; ai < 2; ++ai)
#pragma unroll
            for (int m = 0; m < 4; ++m) { const int row = row0 + ai * HALF + m * 16; const float w = wtab[u.ord * 256 + wr * 64 + fr + ai * HALF + m * 16] * H8_SCALE;
                float h[8];
#pragma unroll
                for (int n = 0; n < 2; ++n)
#pragma unroll
                    for (int j = 0; j < 4; ++j) { const float gv = acc[ai][0][m][n][j] * GU_DESCALE, uv = acc[ai][1][m][n][j] * GU_DESCALE;
                        h[n * 4 + j] = fminf(fmaxf(gv * __builtin_amdgcn_rcpf(1.f + __expf(-gv)) * uv * w, -440.f), 440.f); }
                int w0 = __builtin_amdgcn_cvt_pk_fp8_f32(h[0], h[1], 0, false); w0 = __builtin_amdgcn_cvt_pk_fp8_f32(h[2], h[3], w0, true);
                int w1 = __builtin_amdgcn_cvt_pk_fp8_f32(h[4], h[5], 0, false); w1 = __builtin_amdgcn_cvt_pk_fp8_f32(h[6], h[7], w1, true);
                u32x2 o; o.x = (unsigned)w0; o.y = (unsigned)w1;
                *(u32x2*)(H8 + (size_t)row * 256 + col0) = o; }
    }
};
struct EpiGU {
    bf16_t* H; const float* slot_w;
    __device__ __forceinline__ void operator()(const f32x4 (&acc)[2][2][4][2], const Unit& u, int wr, int wc, int fr, int fq) const {
        const int row0 = u.pm * BM + wr * 64 + fr, col0 = (u.pn & 1) * 128 + wc * 32 + 8 * fq;
#pragma unroll
        for (int ai = 0; ai < 2; ++ai)
#pragma unroll
            for (int m = 0; m < 4; ++m) { const int row = row0 + ai * HALF + m * 16; const float w = slot_w[row];
                float h[8];
#pragma unroll
                for (int n = 0; n < 2; ++n)
#pragma unroll
                    for (int j = 0; j < 4; ++j) { const float gv = acc[ai][0][m][n][j], uv = acc[ai][1][m][n][j]; h[n * 4 + j] = gv / (1.f + __expf(-gv)) * uv * w; }
                u32x4 o; o.x = cvt_pk_bf16(h[0], h[1]); o.y = cvt_pk_bf16(h[2], h[3]); o.z = cvt_pk_bf16(h[4], h[5]); o.w = cvt_pk_bf16(h[6], h[7]);
                *(u32x4*)(H + (size_t)row * 256 + col0) = o; }
    }
};
struct EpiY8 {
    unsigned char* Y8;
    __device__ __forceinline__ void operator()(const f32x4 (&acc)[2][2][4][2], const Unit& u, int wr, int wc, int fr, int fq) const {
        const int row0 = u.pm * BM + wr * 64 + fr; unsigned char* base = Y8 + ((size_t)(u.pn & 3) * MAXSLOT + row0) * 256 + wc * 32 + 8 * fq;
#pragma unroll
        for (int ai = 0; ai < 2; ++ai)
#pragma unroll
            for (int m = 0; m < 4; ++m)
#pragma unroll
                for (int bj = 0; bj < 2; ++bj) { f32x4 v0 = acc[ai][bj][m][0] * (Y8_SCALE * DN_DESCALE), v1 = acc[ai][bj][m][1] * (Y8_SCALE * DN_DESCALE);
#pragma unroll
                    for (int q = 0; q < 4; ++q) { v0[q] = fminf(fmaxf(v0[q], -440.f), 440.f); v1[q] = fminf(fmaxf(v1[q], -440.f), 440.f); }
                    int w0 = __builtin_amdgcn_cvt_pk_fp8_f32(v0[0], v0[1], 0, false); w0 = __builtin_amdgcn_cvt_pk_fp8_f32(v0[2], v0[3], w0, true);
                    int w1 = __builtin_amdgcn_cvt_pk_fp8_f32(v1[0], v1[1], 0, false); w1 = __builtin_amdgcn_cvt_pk_fp8_f32(v1[2], v1[3], w1, true);
                    u32x2 o; o.x = (unsigned)w0; o.y = (unsigned)w1;
                    *(u32x2*)(base + (size_t)(ai * HALF + m * 16) * 256 + bj * HALF) = o; }
    }
};
struct EpiDown {
    bf16_t* Y; bf16_t* X; const float* modl5;
    __device__ __forceinline__ void operator()(const f32x4 (&acc)[2][2][4][2], const Unit& u, int wr, int wc, int fr, int fq) const {
        if (u.pm < MAXSLOT / 256) { const EpiY8 e{(unsigned char*)Y}; e(acc, u, wr, wc, fr, fq); }
        else { const EpiRes e{X, nullptr, nullptr, modl5, MAXSLOT / 256, DN_DESCALE}; e(acc, u, wr, wc, fr, fq); }
    }
};
}


__device__ __forceinline__ void ph_inproj_f(KP p, int l, unsigned char* lds) {
    pg8::Gemm g{(const bf16_t*)(p->ws + Z_A), (const bf16_t*)(p->ws + win_off(l)), R_ALL, DIN, 1024};
    pg8::StaticOrder S; S.init(R_ALL, DIN, gsz_(), bid_());
    pg8::EpiBf16 E{(bf16_t*)(p->ws + Z_P), DIN, DIN / 256, 256};
    pg8::gemm_phase<pg8::EpiBf16, pg8::StaticOrder, false>((LAS unsigned char*)lds, g, S, E, nullptr);
    if (l == 0 && DEPTH > 1 && gsz_() == 256) { __syncthreads(); ph_cvt(p, 1, lds, 214, 42, 0, CVT_E1); }
}
__device__ __forceinline__ void ph_outproj_f(KP p, int l, unsigned char* lds) {
    const int T = (l == 0) ? R_ALL : R_LAT;
    pg8::Gemm g{(const bf16_t*)(p->ws + Z_YCAT), (const bf16_t*)(p->ws + wout_off(l)), T, 1024, 1024};
    pg8::StaticOrder S; S.init(T, 1024, gsz_(), bid_());
    bf16_t* X = (bf16_t*)(p->ws + WS_X);
    pg8::EpiRes E{X, l == 0 ? p->in[0] : nullptr, l == 0 ? p->in[2] : nullptr, (const float*)(p->ws + WS_MOD) + (size_t)l * 3 * 6144 + 2 * 1024, 0, 1.f};
    pg8::gemm_phase<pg8::EpiRes, pg8::StaticOrder, false>((LAS unsigned char*)lds, g, S, E, nullptr);
    if (l == 0 && DEPTH > 1) {
        const int G = gsz_(); __syncthreads();
        if (G == 256) ph_cvt(p, 1, lds, 8, 248, CVT_E2, 1 << 30); else ph_cvt(p, 1, lds); }
}
struct QkvLane { f32x4 gg0, gg1, gw0, gw1; };
__device__ __forceinline__ QkvLane qkv_lane_consts(KP p, int l, int lane) {
    QkvLane c; const int dch = (lane & 7) * 8; const int isk = lane >= 32;
    const float* gq = p->in[isk ? 11 : 10] + l * 64 + dch; const float* wq = p->in[isk ? 13 : 12] + l * 64 + dch;
    c.gg0 = *(const f32x4*)gq; c.gg1 = *(const f32x4*)(gq + 4); c.gw0 = *(const f32x4*)wq; c.gw1 = *(const f32x4*)(wq + 4); return c;
}
__device__ __forceinline__ void prep_qkv_row(KP p, int l, int row, int lane, const QkvLane& qc) {
    const bf16_t* pr = (const bf16_t*)(p->ws + Z_P) + (size_t)row * DIN;
    const bool isctx = row >= R_LAT; const int b = isctx ? ((row - R_LAT) >> 8) : (row >> 13), t = isctx ? ((row - R_LAT) & 255) : (row & 8191);
    const size_t krow = (size_t)b * NKEY + (isctx ? NSEQ + t : t);
    const int l7 = lane & 7, axis = l7 >> 2, half = (l7 >> 1) & 1;
    f32x4 cs0 = (f32x4){1.f, 1.f, 1.f, 1.f}, cs1 = cs0, sn0 = (f32x4){0.f, 0.f, 0.f, 0.f}, sn1 = sn0;
    if (!isctx) { const int pos = axis == 0 ? (t >> 6) : (t & 63); const float* rt = (const float*)(p->ws + WS_ROPE) + pos * 32 + (lane & 1) * 8;
        cs0 = *(const f32x4*)rt; cs1 = *(const f32x4*)(rt + 4); sn0 = *(const f32x4*)(rt + 16); sn1 = *(const f32x4*)(rt + 20); }
    const u32x4 ra = *(const u32x4*)(pr + lane * 8), rb = *(const u32x4*)(pr + 512 + lane * 8);
#pragma unroll
    for (int grp = 0; grp < 2; ++grp) {
        const u32x4 r = grp ? rb : ra;
        bf16_t* Qd = (bf16_t*)(p->ws + (isctx ? (grp ? Z_QWC : Z_QGC) : (grp ? Z_QW : Z_QG))) + (size_t)(isctx ? (b * NCTX + t) : row) * 256;
        bf16_t* Kd = (bf16_t*)(p->ws + (grp ? Z_KW : Z_KG)) + krow * 128; bf16_t* Vd = (bf16_t*)(p->ws + (grp ? Z_VW : Z_VG)) + krow * 128;
        if (lane >= 48) { *(u32x4*)(Vd + (lane - 48) * 8) = r; continue; }
        float x[8] = {bf2f(r.x & 0xffffu), bf2f(r.x >> 16), bf2f(r.y & 0xffffu), bf2f(r.y >> 16), bf2f(r.z & 0xffffu), bf2f(r.z >> 16), bf2f(r.w & 0xffffu), bf2f(r.w >> 16)};
        float ss = 0.f;
#pragma unroll
        for (int i = 0; i < 8; ++i) ss += x[i] * x[i];
        ss += __shfl_xor(ss, 1); ss += __shfl_xor(ss, 2); ss += __shfl_xor(ss, 4);
        const float rinv = rsqrtf(ss * (1.f / 64.f) + EPS);
        const f32x4 g0 = grp ? qc.gw0 : qc.gg0, g1 = grp ? qc.gw1 : qc.gg1;
        const float gv[8] = {g0.x, g0.y, g0.z, g0.w, g1.x, g1.y, g1.z, g1.w};
        const float cv[8] = {cs0.x, cs0.y, cs0.z, cs0.w, cs1.x, cs1.y, cs1.z, cs1.w}, sv[8] = {sn0.x, sn0.y, sn0.z, sn0.w, sn1.x, sn1.y, sn1.z, sn1.w};
        const float qs = (lane < 32) ? QSCALE : 1.f;
        float y[8];
#pragma unroll
        for (int i = 0; i < 8; ++i) { const float v = x[i] * rinv * gv[i]; const float o = __shfl_xor(v, 2);
            y[i] = ((half == 0) ? (v * cv[i] - o * sv[i]) : (o * sv[i] + v * cv[i])) * qs; }
        u32x4 ov; ov.x = pk2(y[0], y[1]); ov.y = pk2(y[2], y[3]); ov.z = pk2(y[4], y[5]); ov.w = pk2(y[6], y[7]);
        if (lane < 32) *(u32x4*)(Qd + lane * 8) = ov; else *(u32x4*)(Kd + (lane - 32) * 8) = ov;
    }
}

template <int R> __device__ __forceinline__ void dw_rows(const float* hcol, const float (&wj)[31], float (&acc)[32]) {
    if constexpr (R < 62) {
        const float hv = hcol[R * 256];
        constexpr int T0 = (R - 30 > 0) ? R - 30 : 0, T1 = (R < 31) ? R : 31;
#pragma unroll
        for (int tt = T0; tt <= T1; ++tt) acc[tt] += hv * wj[R - tt];
        dw_rows<R + 1>(hcol, wj, acc);
    }
}
__device__ __forceinline__ void conv_tile(KP p, int l, unsigned char* lds, int seq_row0, int seqlen, int t0) {
    float* hb = (float*)lds;
    const int tid = tid_(), lane = tid & 63, wid = tid >> 6;
    const bf16_t* P = (const bf16_t*)(p->ws + Z_P);
    for (int i = tid; i < 94 * 32; i += NTHREADS) { const int r = i >> 5, c8 = (i & 31) * 8, t = t0 - 15 + r;
        f32x4 h0 = (f32x4){0.f, 0.f, 0.f, 0.f}, h1 = h0;
        if (t >= 0 && t < seqlen) { const bf16_t* pr = P + (size_t)(seq_row0 + t) * DIN;
            const u32x4 vv = *(const u32x4*)(pr + C_CVV + c8), gg = *(const u32x4*)(pr + C_CVG + c8);
            h0.x = bf2f(vv.x & 0xffffu) * sigmoid_(bf2f(gg.x & 0xffffu)); h0.y = bf2f(vv.x >> 16) * sigmoid_(bf2f(gg.x >> 16));
            h0.z = bf2f(vv.y & 0xffffu) * sigmoid_(bf2f(gg.y & 0xffffu)); h0.w = bf2f(vv.y >> 16) * sigmoid_(bf2f(gg.y >> 16));
            h1.x = bf2f(vv.z & 0xffffu) * sigmoid_(bf2f(gg.z & 0xffffu)); h1.y = bf2f(vv.z >> 16) * sigmoid_(bf2f(gg.z >> 16));
            h1.z = bf2f(vv.w & 0xffffu) * sigmoid_(bf2f(gg.w & 0xffffu)); h1.w = bf2f(vv.w >> 16) * sigmoid_(bf2f(gg.w >> 16)); }
        *(f32x4*)(hb + r * 256 + c8) = h0; *(f32x4*)(hb + r * 256 + c8 + 4) = h1; }
    __syncthreads();
    { const int c = tid & 255, hf = tid >> 8;
      const float* w = p->in[15] + (size_t)l * 31 * 256 + c; const float bias = p->in[16][l * 256 + c];
      float wj[31];
#pragma unroll
      for (int j = 0; j < 31; ++j) wj[j] = w[j * 256];
      float acc[32];
#pragma unroll
      for (int tt = 0; tt < 32; ++tt) acc[tt] = bias;
      dw_rows<0>(hb + hf * 32 * 256 + c, wj, acc);
      __syncthreads();
#pragma unroll
      for (int tt = 0; tt < 32; ++tt) hb[(hf * 32 + tt) * 256 + c] = acc[tt];
    }
    __syncthreads();
    constexpr int AS = 264;
    bf16_t* ab = (bf16_t*)(lds + 94 * 256 * 4);
    for (int tt = wid; tt < 64; tt += 8) { const float* r = hb + tt * 256; const f32x4 v = ((const f32x4*)r)[lane];
        const float mean = wave_sum(v.x + v.y + v.z + v.w) * (1.f / 256.f);
        const float dx = v.x - mean, dy = v.y - mean, dz = v.z - mean, dw = v.w - mean;
        const float rstd = rsqrtf(wave_sum(dx * dx + dy * dy + dz * dz + dw * dw) * (1.f / 256.f) + EPS);
        const f32x4 g = ((const f32x4*)(p->in[17] + l * 256))[lane], bb = ((const f32x4*)(p->in[18] + l * 256))[lane];
        u32x2 o; o.x = pk2(silu_(dx * rstd * g.x + bb.x), silu_(dy * rstd * g.y + bb.y)); o.y = pk2(silu_(dz * rstd * g.z + bb.z), silu_(dw * rstd * g.w + bb.w));
        *(u32x2*)(ab + tt * AS + lane * 4) = o; }
    __syncthreads();
    { const int fr = lane & 15, fq = lane >> 4;
      const bf16_t* Wt = (const bf16_t*)(p->ws + wpw_off(l));
      bf16x8 bw[2][8];
#pragma unroll
      for (int j = 0; j < 2; ++j)
#pragma unroll
          for (int ks = 0; ks < 8; ++ks) bw[j][ks] = *(const bf16x8*)(Wt + (size_t)((wid * 2 + j) * 16 + fr) * 256 + ks * 32 + fq * 8);
      const float bias0 = p->in[20][l * 256 + wid * 32 + fr], bias1 = p->in[20][l * 256 + wid * 32 + 16 + fr];
      bf16_t* Y = (bf16_t*)(p->ws + Z_YCAT);
#pragma unroll 1
      for (int tr = 0; tr < 4; ++tr) { f32x4 a0 = (f32x4){0.f, 0.f, 0.f, 0.f}, a1 = a0;
#pragma unroll
          for (int ks = 0; ks < 8; ++ks) { const bf16x8 av = *(const bf16x8*)(ab + (tr * 16 + fr) * AS + ks * 32 + fq * 8);
              a0 = __builtin_amdgcn_mfma_f32_16x16x32_bf16(av, bw[0][ks], a0, 0, 0, 0); a1 = __builtin_amdgcn_mfma_f32_16x16x32_bf16(av, bw[1][ks], a1, 0, 0, 0); }
#pragma unroll
          for (int r = 0; r < 4; ++r) { const int t = t0 + tr * 16 + fq * 4 + r; bf16_t* yr = Y + (size_t)(seq_row0 + t) * D + 256 + wid * 32 + fr;
              yr[0] = (bf16_t)f2bf(a0[r] + bias0); yr[16] = (bf16_t)f2bf(a1[r] + bias1); } }
    }
    __syncthreads();
}

__device__ __forceinline__ int hgrn_chunk_row0(int b, int dir, int j) {
    if (j < 4) { const int cj = dir ? 3 - j : j; return R_LAT + b * NCTX + cj * 64; }
    const int jj = j - 4, cj = dir ? 127 - jj : jj; return b * NSEQ + cj * 64;
}
__device__ __forceinline__ void hgrn_load_chunk(KP p, int l, int row0, int dir, int head, float* qs, float* vs, float* ks, float* cs) {
    const int tid = tid_();
    const bf16_t* P = (const bf16_t*)(p->ws + Z_P);
    const float* lbv = (const float*)(p->ws + WS_LB) + (l * 2 + dir) * 256 + head * 64;
    for (int i = tid; i < 4096; i += NTHREADS) { const int tau = i >> 6, d = i & 63; const int row = row0 + (dir ? 63 - tau : tau);
        const bf16_t* pr = P + (size_t)row * DIN + head * 64 + d;
        if (qs) qs[i] = bf2f(pr[C_RQ]);
        vs[i] = bf2f(pr[C_RI]);
        const float z = bf2f(pr[dir ? C_RFB : C_RFF]); const float lb = lbv[d];
        const float lsp = fminf(z, 0.f) - log1pf(__expf(-fabsf(z)));
        float logf = lsp;
        if (lb > 0.f) { const float a = lsp, bq = __logf(lb) + (lsp - z); const float mx = fmaxf(a, bq); logf = mx + log1pf(__expf(-fabsf(a - bq))); }
        ks[i] = (1.f - lb) * sigmoid_(-z);
        cs[i] = logf; }
    __syncthreads();
    if (tid < 64) { float c = 0.f; for (int tau = 0; tau < 64; ++tau) { c += cs[tau * 64 + tid]; cs[tau * 64 + tid] = c; } }
    __syncthreads();
}
__device__ __forceinline__ void hgrn_pass1_unit(KP p, int l, unsigned char* lds, int unit) {
    float* vs = (float*)lds; float* ks = vs + 4096; float* cs = ks + 4096;
    const int tid = tid_();
    const int j = unit % NCHUNK, seq = unit / NCHUNK, dir = seq & 1, head = (seq >> 1) & 3, b = seq >> 3;
    hgrn_load_chunk(p, l, hgrn_chunk_row0(b, dir, j), dir, head, nullptr, vs, ks, cs);
    for (int i = tid; i < 4096; i += NTHREADS) { const int d = i & 63; ks[i] *= __expf(cs[63 * 64 + d] - cs[i]); }
    __syncthreads();
    float* U = (float*)(p->ws + Z_U) + ((size_t)seq * NCHUNK + j) * 4096; float* Gv = (float*)(p->ws + Z_G) + ((size_t)seq * NCHUNK + j) * 64;
    { const int d = tid >> 3, e0 = (tid & 7) * 8; float acc[8];
#pragma unroll
      for (int e = 0; e < 8; ++e) acc[e] = 0.f;
      for (int tau = 0; tau < 64; ++tau) { const float kv = ks[tau * 64 + d];
#pragma unroll
          for (int e = 0; e < 8; ++e) acc[e] += kv * vs[tau * 64 + e0 + e]; }
#pragma unroll
      for (int e = 0; e < 8; ++e) U[d * 64 + e0 + e] = acc[e]; }
    if (tid < 64) Gv[tid] = __expf(cs[63 * 64 + tid]);
    __syncthreads();
}
constexpr int HS = 72;
constexpr int HL_TOT = 0, HL_OSUM = 2048, HL_T0 = 18432, HL_TB = 64 * HS * 2;
__device__ __forceinline__ f32x4 mm64(const bf16_t* A, const bf16_t* Bt, int tr, int tc, int fr, int fq, f32x4 acc) {
#pragma unroll
    for (int k0 = 0; k0 < 64; k0 += 32) { const bf16x8 a = *(const bf16x8*)(A + (tr * 16 + fr) * HS + k0 + fq * 8), b = *(const bf16x8*)(Bt + (tc * 16 + fr) * HS + k0 + fq * 8);
        acc = __builtin_amdgcn_mfma_f32_16x16x32_bf16(a, b, acc, 0, 0, 0); }
    return acc;
}
__device__ __forceinline__ void hgrn_load8(KP p, int row0, int dir, int head, int tid, float (&q)[8], float (&vv)[8], float (&z)[8]) {
    const int d = tid & 63, seg = tid >> 6;
    const bf16_t* P = (const bf16_t*)(p->ws + Z_P);
#pragma unroll
    for (int i = 0; i < 8; ++i) { const int tau = seg * 8 + i; const int row = row0 + (dir ? 63 - tau : tau);
        const bf16_t* pr = P + (size_t)row * DIN + head * 64 + d;
        q[i] = bf2f(pr[C_RQ]); vv[i] = bf2f(pr[C_RI]); z[i] = bf2f(pr[dir ? C_RFB : C_RFF]); }
}
__device__ __forceinline__ void hgrn_gate8(KP p, int l, int dir, int head, int tid, float* tot, const float (&z)[8], float (&kg)[8], float (&c)[8], float& m, float& cl) {
    const int d = tid & 63, seg = tid >> 6;
    const float lb = ((const float*)(p->ws + WS_LB))[(l * 2 + dir) * 256 + head * 64 + d];
    float run = 0.f;
#pragma unroll
    for (int i = 0; i < 8; ++i) {
        const float ez = __expf(-fabsf(z[i])), rz = __builtin_amdgcn_rcpf(1.f + ez); const float sg = (z[i] >= 0.f) ? rz : ez * rz;
        const float f = lb + (1.f - lb) * sg;
        kg[i] = 1.f - f;
        run += __logf(f); c[i] = run; }
    tot[seg * 64 + d] = run;
    __syncthreads();
    float off = 0.f; m = 0.f; cl = 0.f;
#pragma unroll
    for (int s2 = 0; s2 < 8; ++s2) { const float t = tot[s2 * 64 + d]; if (s2 < seg) off += t; if (s2 < 4) m += t; cl += t; }
#pragma unroll
    for (int i = 0; i < 8; ++i) c[i] += off;
}
__device__ __forceinline__ u32x4 pack8(const float (&x)[8]) { u32x4 o; o.x = pk2(x[0], x[1]); o.y = pk2(x[2], x[3]); o.z = pk2(x[4], x[5]); o.w = pk2(x[6], x[7]); return o; }
__device__ __forceinline__ void hgrn_pass1_f(KP p, int l, unsigned char* lds, int unit) {
    const int tid = tid_(), lane = tid & 63, wid = tid >> 6, fr = lane & 15, fq = lane >> 4, d = tid & 63, seg = tid >> 6;
    float* tot = (float*)(lds + HL_TOT); bf16_t* Vt = (bf16_t*)(lds + HL_T0); bf16_t* KbT = (bf16_t*)(lds + HL_T0 + HL_TB);
    const int j = unit % NCHUNK, seq = unit / NCHUNK, dir = seq & 1, head = (seq >> 1) & 3, b = seq >> 3;
    float q[8], vv[8], z[8], kg[8], c[8], m, cl;
    hgrn_load8(p, hgrn_chunk_row0(b, dir, j), dir, head, tid, q, vv, z);
    hgrn_gate8(p, l, dir, head, tid, tot, z, kg, c, m, cl);
    float kb[8];
#pragma unroll
    for (int i = 0; i < 8; ++i) kb[i] = kg[i] * __expf(cl - c[i]);
    *(u32x4*)(Vt + d * HS + seg * 8) = pack8(vv);
    *(u32x4*)(KbT + d * HS + seg * 8) = pack8(kb);
    float* U = (float*)(p->ws + Z_U) + ((size_t)seq * NCHUNK + j) * 4096; float* Gv = (float*)(p->ws + Z_G) + ((size_t)seq * NCHUNK + j) * 64;
    if (seg == 0) Gv[d] = __expf(cl);
    __syncthreads();
    const int tr = wid >> 1;
#pragma unroll
    for (int t2 = 0; t2 < 2; ++t2) { const int tc = (wid & 1) * 2 + t2;
        const f32x4 acc = mm64(Vt, KbT, tr, tc, fr, fq, (f32x4){0.f, 0.f, 0.f, 0.f});
#pragma unroll
        for (int r = 0; r < 4; ++r) U[(tr * 16 + fq * 4 + r) * 64 + tc * 16 + fr] = acc[r]; }
    __syncthreads();
}
struct HgrnIn1 { float v[8], zf[8], zb[8]; };
__device__ __forceinline__ void hgrn_p1_load(KP p, int unit, int tid, HgrnIn1& r) {
    const int cpos = unit % NCHUNK, head = (unit / NCHUNK) & 3, b = unit / (NCHUNK * 4), d = tid & 63, seg = tid >> 6;
    const int row0 = (cpos < 4) ? R_LAT + b * NCTX + cpos * 64 : b * NSEQ + (cpos - 4) * 64;
    const bf16_t* P = (const bf16_t*)(p->ws + Z_P) + (size_t)(row0 + seg * 8) * DIN + head * 64 + d;
#pragma unroll
    for (int i = 0; i < 8; ++i) { const bf16_t* pr = P + (size_t)i * DIN; r.v[i] = bf2f(pr[C_RI]); r.zf[i] = bf2f(pr[C_RFF]); r.zb[i] = bf2f(pr[C_RFB]); }
}
__device__ __forceinline__ void hgrn_p1_compute(KP p, int l, unsigned char* lds, int unit, int tid, const HgrnIn1& r) {
    const int lane = tid & 63, wid = tid >> 6, fr = lane & 15, fq = lane >> 4, d = tid & 63, seg = tid >> 6;
    float* totf = (float*)(lds + HL_TOT); float* totb = (float*)(lds + HL_OSUM);
    bf16_t* Vt = (bf16_t*)(lds + HL_T0); bf16_t* KfT = (bf16_t*)(lds + HL_T0 + HL_TB); bf16_t* KbT = (bf16_t*)(lds + HL_T0 + 2 * HL_TB);
    const int cpos = unit % NCHUNK, head = (unit / NCHUNK) & 3, b = unit / (NCHUNK * 4);
    const float* lbp = (const float*)(p->ws + WS_LB) + (l * 2) * 256 + head * 64 + d; const float lbf = lbp[0], lbb = lbp[256];
    float kf[8], kb[8], cf[8], cb[8], lfb[8], runf = 0.f, runb = 0.f;
#pragma unroll
    for (int i = 0; i < 8; ++i) {
        { const float z = r.zf[i], ez = __expf(-fabsf(z)), rz = __builtin_amdgcn_rcpf(1.f + ez), sg = (z >= 0.f) ? rz : ez * rz, f = lbf + (1.f - lbf) * sg; kf[i] = 1.f - f; runf += __logf(f); cf[i] = runf; }
        { const float z = r.zb[i], ez = __expf(-fabsf(z)), rz = __builtin_amdgcn_rcpf(1.f + ez), sg = (z >= 0.f) ? rz : ez * rz, f = lbb + (1.f - lbb) * sg; kb[i] = 1.f - f; lfb[i] = __logf(f); runb += lfb[i]; cb[i] = runb; } }
    totf[seg * 64 + d] = runf; totb[seg * 64 + d] = runb;
    __syncthreads();
    float offf = 0.f, offb = 0.f, clf = 0.f, clb = 0.f;
#pragma unroll
    for (int s2 = 0; s2 < 8; ++s2) { const float tf = totf[s2 * 64 + d], tb = totb[s2 * 64 + d]; if (s2 < seg) { offf += tf; offb += tb; } clf += tf; clb += tb; }
#pragma unroll
    for (int i = 0; i < 8; ++i) { kf[i] *= __expf(clf - (cf[i] + offf)); kb[i] *= __expf(cb[i] + offb - lfb[i]); }
    *(u32x4*)(Vt + d * HS + seg * 8) = pack8(r.v);
    *(u32x4*)(KfT + d * HS + seg * 8) = pack8(kf);
    *(u32x4*)(KbT + d * HS + seg * 8) = pack8(kb);
    const int jf = cpos, jb = (cpos < 4) ? 3 - cpos : 4 + 127 - (cpos - 4); const int seqf = (b * 4 + head) * 2;
    bf16_t* Uf = (bf16_t*)(p->ws + Z_U) + ((size_t)seqf * NCHUNK + jf) * 4096; bf16_t* Ub = (bf16_t*)(p->ws + Z_U) + ((size_t)(seqf + 1) * NCHUNK + jb) * 4096;
    float* Gf = (float*)(p->ws + Z_G) + ((size_t)seqf * NCHUNK + jf) * 64; float* Gb = (float*)(p->ws + Z_G) + ((size_t)(seqf + 1) * NCHUNK + jb) * 64;
    if (seg == 0) { Gf[d] = __expf(clf); Gb[d] = __expf(clb); }
    __syncthreads();
    const int tr = wid >> 1;
#pragma unroll
    for (int t2 = 0; t2 < 2; ++t2) { const int tc = (wid & 1) * 2 + t2;
        const f32x4 af = mm64(Vt, KfT, tr, tc, fr, fq, (f32x4){0.f, 0.f, 0.f, 0.f}), ab = mm64(Vt, KbT, tr, tc, fr, fq, (f32x4){0.f, 0.f, 0.f, 0.f});
#pragma unroll
        for (int q = 0; q < 4; ++q) { const int o = (tr * 16 + fq * 4 + q) * 64 + tc * 16 + fr; Uf[o] = (bf16_t)f2bf(af[q]); Ub[o] = (bf16_t)f2bf(ab[q]); } }
    __syncthreads();
}
__device__ __forceinline__ void hgrn_pass1_run(KP p, int l, unsigned char* lds, int u0, int un, int ustep) {
    if (un <= 0) return;
    const int tid = tid_();
    HgrnIn1 cur; hgrn_p1_load(p, u0, tid, cur);
    for (int k = 0; k < un; ++k) { const int u = u0 + k * ustep;
        HgrnIn1 nxt = cur; if (k + 1 < un) hgrn_p1_load(p, u + ustep, tid, nxt);
        hgrn_p1_compute(p, l, lds, u, tid, cur);
        cur = nxt; }
}
__device__ __forceinline__ void hgrn_scan_f(KP p) {
    const int tid = tid_();
    if (tid >= 256) return;
    for (int gi = bid_() * 256 + tid; gi < 16 * 4096; gi += gsz_() * 256) {
    const int seq = gi >> 12, ed = gi & 4095, d = ed & 63;
    bf16_t* U = (bf16_t*)(p->ws + Z_U) + (size_t)seq * NCHUNK * 4096 + ed; const float* Gv = (const float*)(p->ws + Z_G) + (size_t)seq * NCHUNK * 64 + d;
    float S = 0.f;
#pragma unroll 1
    for (int j = 0; j < NCHUNK; j += 12) {
        float u[12], g[12];
#pragma unroll
        for (int q = 0; q < 12; ++q) { u[q] = bf2f(U[(size_t)(j + q) * 4096]); g[q] = Gv[(j + q) * 64]; }
#pragma unroll
        for (int q = 0; q < 12; ++q) { U[(size_t)(j + q) * 4096] = (bf16_t)f2bf(S); S = g[q] * S + u[q]; }
    }
    }
}
struct HgrnIn3 { float q[8], v[8], zf[8], zb[8], gg[8]; u32x4 sf, sb; };
__device__ __forceinline__ void hgrn_p3_load(KP p, int unit, int tid, HgrnIn3& r) {
    const int cpos = unit % NCHUNK, head = (unit / NCHUNK) & 3, b = unit / (NCHUNK * 4), d = tid & 63, seg = tid >> 6;
    const int row0 = (cpos < 4) ? R_LAT + b * NCTX + cpos * 64 : b * NSEQ + (cpos - 4) * 64;
    const bf16_t* P = (const bf16_t*)(p->ws + Z_P) + (size_t)(row0 + seg * 8) * DIN + head * 64 + d;
#pragma unroll
    for (int i = 0; i < 8; ++i) { const bf16_t* pr = P + (size_t)i * DIN; r.q[i] = bf2f(pr[C_RQ]); r.v[i] = bf2f(pr[C_RI]); r.zf[i] = bf2f(pr[C_RFF]); r.zb[i] = bf2f(pr[C_RFB]);
        r.gg[i] = bf2f(((const bf16_t*)(p->ws + Z_P))[(size_t)(row0 + seg + 8 * i) * DIN + C_RG + head * 64 + d]); }
    const int jf = cpos, jb = (cpos < 4) ? 3 - cpos : 4 + 127 - (cpos - 4); const int seqf = (b * 4 + head) * 2;
    const bf16_t* U = (const bf16_t*)(p->ws + Z_U);
    r.sf = *(const u32x4*)(U + ((size_t)seqf * NCHUNK + jf) * 4096 + tid * 8); r.sb = *(const u32x4*)(U + ((size_t)(seqf + 1) * NCHUNK + jb) * 4096 + tid * 8);
}
__device__ __forceinline__ void hgrn_p3_compute(KP p, int l, unsigned char* lds, int unit, int tid, const HgrnIn3& r) {
    const int lane = tid & 63, wid = tid >> 6, fr = lane & 15, fq = lane >> 4, d = tid & 63, seg = tid >> 6;
    float* tot = (float*)(lds + HL_TOT); float* os = (float*)(lds + HL_OSUM);
    bf16_t* Qt = (bf16_t*)(lds + HL_T0); bf16_t* Kt = (bf16_t*)(lds + HL_T0 + HL_TB); bf16_t* Qb = (bf16_t*)(lds + HL_T0 + 2 * HL_TB);
    bf16_t* St = (bf16_t*)(lds + HL_T0 + 3 * HL_TB); bf16_t* Vt = (bf16_t*)(lds + HL_T0 + 4 * HL_TB); bf16_t* Sc = (bf16_t*)(lds + HL_T0 + 5 * HL_TB);
    const int cpos = unit % NCHUNK, head = (unit / NCHUNK) & 3, b = unit / (NCHUNK * 4);
    const int row0 = (cpos < 4) ? R_LAT + b * NCTX + cpos * 64 : b * NSEQ + (cpos - 4) * 64;
    const int tr = wid >> 1;
    const float* lbp = (const float*)(p->ws + WS_LB) + (l * 2) * 256 + head * 64 + d;
#pragma unroll
    for (int dir = 0; dir < 2; ++dir) {
        const float lb = lbp[dir * 256];
        float kg[8], c[8], run = 0.f;
#pragma unroll
        for (int ii = 0; ii < 8; ++ii) { const int i = dir ? 7 - ii : ii;
            const float z = dir ? r.zb[i] : r.zf[i];
            const float ez = __expf(-fabsf(z)), rz = __builtin_amdgcn_rcpf(1.f + ez), sg = (z >= 0.f) ? rz : ez * rz, f = lb + (1.f - lb) * sg;
            kg[i] = 1.f - f; run += __logf(f); c[i] = run; }
        tot[seg * 64 + d] = run;
        __syncthreads();
        float off = 0.f, m = 0.f;
#pragma unroll
        for (int s2 = 0; s2 < 8; ++s2) { const float t = tot[s2 * 64 + d]; if (dir ? (s2 > seg) : (s2 < seg)) off += t; if (dir ? (s2 >= 4) : (s2 < 4)) m += t; }
        float vr[8];
#pragma unroll
        for (int i = 0; i < 8; ++i) { const float ci = c[i] + off; const int tau = dir ? 63 - (seg * 8 + i) : seg * 8 + i; const float qv = r.q[i];
            Qt[tau * HS + d] = (bf16_t)f2bf(qv * __expf(fminf(ci - m, 80.f)));
            Kt[tau * HS + d] = (bf16_t)f2bf(kg[i] * __expf(fminf(m - ci, 80.f)));
            Qb[tau * HS + d] = (bf16_t)f2bf(qv * __expf(ci));
            vr[i] = dir ? r.v[7 - i] : r.v[i]; }
        *(u32x4*)(Vt + d * HS + (dir ? 7 - seg : seg) * 8) = pack8(vr);
        *(u32x4*)(St + (tid >> 3) * HS + (tid & 7) * 8) = dir ? r.sb : r.sf;
        __syncthreads();
        f32x4 oacc[2];
#pragma unroll
        for (int t2 = 0; t2 < 2; ++t2) { const int tc = (wid & 1) * 2 + t2;
            oacc[t2] = mm64(Qb, St, tr, tc, fr, fq, (f32x4){0.f, 0.f, 0.f, 0.f});
            f32x4 sacc = (f32x4){0.f, 0.f, 0.f, 0.f};
            if (tc <= tr) sacc = mm64(Qt, Kt, tr, tc, fr, fq, sacc);
#pragma unroll
            for (int q = 0; q < 4; ++q) { const int tau = tr * 16 + fq * 4 + q, sig = tc * 16 + fr; Sc[tau * HS + sig] = (bf16_t)f2bf(sig <= tau ? sacc[q] : 0.f); } }
        __syncthreads();
#pragma unroll
        for (int t2 = 0; t2 < 2; ++t2) { const int tc = (wid & 1) * 2 + t2;
            oacc[t2] = mm64(Sc, Vt, tr, tc, fr, fq, oacc[t2]);
#pragma unroll
            for (int q = 0; q < 4; ++q) { const int tau = tr * 16 + fq * 4 + q, e = tc * 16 + fr, tok = dir ? 63 - tau : tau;
                if (dir == 0) os[tok * 64 + e] = oacc[t2][q]; else os[tok * 64 + e] += oacc[t2][q]; } }
        __syncthreads();
    }
    bf16_t* Y = (bf16_t*)(p->ws + Z_YCAT); const float ong = p->in[22][l * 64 + lane];
#pragma unroll
    for (int i = 0; i < 8; ++i) { const int tok = wid + 8 * i; const float v = os[tok * 64 + lane];
        const float y = v * rsqrtf(wave_sum(v * v) * (1.f / 64.f) + EPS) * ong;
        Y[(size_t)(row0 + tok) * D + 768 + head * 64 + lane] = (bf16_t)f2bf(y * silu_(r.gg[i])); }
    __syncthreads();
}
__device__ __forceinline__ int hgrn_p3_unit(int k) { if (k < 1024) { const int bh = k >> 7, c = k & 127; return bh * NCHUNK + 4 + c; } const int k2 = k - 1024; return (k2 >> 2) * NCHUNK + (k2 & 3); }
__device__ __forceinline__ void hgrn_pass3_run(KP p, int l, unsigned char* lds) {
    const int tid = tid_(), G = gsz_(), nunits = 1024 + (l == 0 ? 32 : 0);
    int k = bid_(); if (k >= nunits) return;
    HgrnIn3 cur; hgrn_p3_load(p, hgrn_p3_unit(k), tid, cur);
    for (;;) { const int kn = k + G; const bool more = kn < nunits;
        HgrnIn3 nxt = cur; if (more) hgrn_p3_load(p, hgrn_p3_unit(kn), tid, nxt);
        hgrn_p3_compute(p, l, lds, hgrn_p3_unit(k), tid, cur);
        if (!more) break;
        cur = nxt; k = kn; }
}
__device__ __forceinline__ void ph_prep(KP p, int l, unsigned char* lds) {
    const int tid = tid_(), lane = tid & 63, wid = tid >> 6, bid = bid_(), G = gsz_();
    const int nconv = 256 + (l == 0 ? 8 : 0);
    for (int it = bid; it < nconv; it += G) {
        if (it < 256) conv_tile(p, l, lds, (it >> 7) * NSEQ, NSEQ, (it & 127) * 64);
        else { const int c = it - 256; conv_tile(p, l, lds, R_LAT + (c >> 2) * NCTX, NCTX, (c & 3) * 64); } }
    if (G == 256) {
        const int u0 = bid < 8 ? 2 * bid : bid < 56 ? 16 + 5 * (bid - 8) : 256 + 4 * (bid - 56), un = bid < 8 ? 2 : bid < 56 ? 5 : 4;
        hgrn_pass1_run(p, l, lds, u0, un, 1);
        const int g0 = bid < 104 ? 8 * bid : bid < 168 ? 832 + 9 * (bid - 104) : 1408 + 8 * (bid - 168), gn = (bid >= 104 && bid < 168) ? 9 : 8;
        const QkvLane qc = qkv_lane_consts(p, l, lane);
        for (int g = g0; g < g0 + gn; ++g) prep_qkv_row(p, l, g * 8 + wid, lane, qc);
    } else {
        hgrn_pass1_run(p, l, lds, bid, (8 * NCHUNK - bid + G - 1) / G, G);
        const QkvLane qc = qkv_lane_consts(p, l, lane);
        for (int row = bid * 8 + wid; row < R_ALL; row += G * 8) prep_qkv_row(p, l, row, lane, qc);
    }
}

__device__ __forceinline__ void hgrn_scan(KP p) {
    const int gi = bid_() * NTHREADS + tid_();
    if (gi >= 16 * 4096) return;
    const int seq = gi >> 12, de = gi & 4095, d = de >> 6;
    float* U = (float*)(p->ws + Z_U) + (size_t)seq * NCHUNK * 4096 + de; const float* Gv = (const float*)(p->ws + Z_G) + (size_t)seq * NCHUNK * 64 + d;
    float S = 0.f;
    for (int j = 0; j < NCHUNK; j += 4) {
        float u[4], g[4];
#pragma unroll
        for (int q = 0; q < 4; ++q) { u[q] = U[(size_t)(j + q) * 4096]; g[q] = Gv[(j + q) * 64]; }
#pragma unroll
        for (int q = 0; q < 4; ++q) { U[(size_t)(j + q) * 4096] = S; S = g[q] * S + u[q]; }
    }
}
__device__ __forceinline__ void attn_simple_unit(unsigned char* lds, const bf16_t* Qrow0  , const bf16_t* Kb, const bf16_t* Vb  ,
                                                 int mode, int NT, int first_key, int q0, bool use_sink, float sink_log2, bf16_t* Orow0  ) {
    float* Ks = (float*)lds; float* Vs = Ks + 4096;
    const int tid = tid_();
    float q[64], o[64], m = -INFINITY, lsum = 0.f;
    if (tid < 256) {
#pragma unroll
        for (int d = 0; d < 64; ++d) { q[d] = bf2f(Qrow0[(size_t)tid * 256 + d]); o[d] = 0.f; }
    }
    for (int tt = 0; tt < NT; ++tt) {
        int key0, pos0 = 0; bool masked = false;
        if (mode == 0) key0 = first_key + 64 * tt;
        else if (tt < 4) key0 = NSEQ + 64 * tt;
        else { pos0 = q0 - 128 + 64 * (tt - 4); key0 = pos0 < 0 ? 0 : (pos0 > NSEQ - 64 ? NSEQ - 64 : pos0); masked = true; }
        __syncthreads();
        for (int i = tid; i < 4096; i += NTHREADS) { const int kk = i >> 6, d = i & 63; Ks[i] = bf2f(Kb[(size_t)(key0 + kk) * 128 + d]); Vs[i] = bf2f(Vb[(size_t)(key0 + kk) * 128 + d]); }
        __syncthreads();
        if (tid < 256) {
            for (int kk = 0; kk < 64; ++kk) {
                if (masked) { const int kp = pos0 + kk, qp = q0 + tid; const int df = qp - kp; if (kp < 0 || kp >= NSEQ || df > 128 || df < -128) continue; }
                float s = 0.f;
#pragma unroll
                for (int d = 0; d < 64; ++d) s += q[d] * Ks[kk * 64 + d];
                if (s > m) { const float f = exp2f(m - s); lsum *= f;
#pragma unroll
                    for (int d = 0; d < 64; ++d) o[d] *= f;
                    m = s; }
                const float pe = exp2f(s - m); lsum += pe;
#pragma unroll
                for (int d = 0; d < 64; ++d) o[d] += pe * Vs[kk * 64 + d];
            }
        }
    }
    if (tid < 256) {
        if (use_sink) lsum += exp2f(sink_log2 - m);
        const float inv = 1.f / lsum;
#pragma unroll
        for (int d = 0; d < 64; ++d) Orow0[(size_t)tid * D + d] = (bf16_t)f2bf(o[d] * inv);
    }
    __syncthreads();
}
__device__ __forceinline__ void ph_attn(KP p, int l, unsigned char* lds) {
    hgrn_scan(p);
    bf16_t* Y = (bf16_t*)(p->ws + Z_YCAT);
    const bf16_t* Qg = (const bf16_t*)(p->ws + Z_QG); const bf16_t* Qw = (const bf16_t*)(p->ws + Z_QW); const bf16_t* Qgc = (const bf16_t*)(p->ws + Z_QGC); const bf16_t* Qwc = (const bf16_t*)(p->ws + Z_QWC);
    const bf16_t* Kg = (const bf16_t*)(p->ws + Z_KG); const bf16_t* Kw = (const bf16_t*)(p->ws + Z_KW); const bf16_t* Vg = (const bf16_t*)(p->ws + Z_VG); const bf16_t* Vw = (const bf16_t*)(p->ws + Z_VW);
    const int nunits = 512 + (l == 0 ? 16 : 0);
    for (int u = bid_(); u < nunits; u += gsz_()) {
        if (u < 256) {
            const int qb = u & 31, h = (u >> 5) & 3, b = u >> 7, row0 = b * NSEQ + qb * 256;
            attn_simple_unit(lds, Qg + (size_t)row0 * 256 + h * 64, Kg + (size_t)b * NKEY * 128 + (h >> 1) * 64, Vg + (size_t)b * NKEY * 128 + (h >> 1) * 64, 0, NKEY / 64, 0, qb * 256, false, 0.f, Y + (size_t)row0 * D + h * 64);
        } else if (u < 512) {
            const int v = u - 256, qb = v & 31, h = (v >> 5) & 3, b = v >> 7, row0 = b * NSEQ + qb * 256;
            attn_simple_unit(lds, Qw + (size_t)row0 * 256 + h * 64, Kw + (size_t)b * NKEY * 128 + (h >> 1) * 64, Vw + (size_t)b * NKEY * 128 + (h >> 1) * 64, 1, 12, 0, qb * 256, true, p->in[14][l * 4 + h] * LOG2E, Y + (size_t)row0 * D + 512 + h * 64);
        } else {
            const int v = u - 512, h = v & 3, b = (v >> 2) & 1, win = v >> 3, row0 = R_LAT + b * NCTX;
            const bf16_t* Qc = (win ? Qwc : Qgc) + (size_t)(b * NCTX) * 256 + h * 64;
            const bf16_t* Kc = (win ? Kw : Kg) + (size_t)b * NKEY * 128 + (h >> 1) * 64; const bf16_t* Vc = (win ? Vw : Vg) + (size_t)b * NKEY * 128 + (h >> 1) * 64;
            attn_simple_unit(lds, Qc, Kc, Vc, 0, 4, NSEQ, 0, win != 0, p->in[14][l * 4 + h] * LOG2E, Y + (size_t)row0 * D + (win ? 512 : 0) + h * 64);
        }
    }
}

namespace attn_body {
using bf16=__hip_bfloat16;
using bf16x8=__attribute__((ext_vector_type(8)))short;
using s16x4=__attribute__((ext_vector_type(4)))short;
using f32x16=__attribute__((ext_vector_type(16)))float;
using u32x4=__attribute__((ext_vector_type(4)))unsigned;
constexpr int D=64, QP=256, KP=128, OP=1024;
constexpr int NW=8,QBLK=32,QB=QBLK*NW,KVBLK=64;
__device__ __forceinline__ int crow(int r,int hi){return (r&3)+8*(r>>2)+4*hi;}
#define SBAR() __builtin_amdgcn_sched_barrier(0)
__device__ __forceinline__ void wmask(f32x16&p0,f32x16&p1,int tb,int qrel,int hi,int q0){
  const float NEG=-INFINITY; const int kb=64*tb+4*hi;
  #pragma unroll
  for(int r=0;r<16;++r){const int kl=kb+(r&3)+8*(r>>2); const int kp=q0-128+kl;
    if(kl<qrel||kl>qrel+256||kp<0||kp>=NSEQ)p0[r]=NEG;
    if(kl+32<qrel||kl+32>qrel+256||kp+32<0||kp+32>=NSEQ)p1[r]=NEG;}
}

constexpr int NSLOT=3, SLOTB=8192;
constexpr int LDS_K=0, LDS_V=NSLOT*SLOTB, LDS_WS=2*NSLOT*SLOTB, LDS_OST=LDS_WS+NW*64*4, LDS_BYTES=LDS_OST+NW*4096;
constexpr float C2=0.125f*1.4426950408889634f;
__device__ __forceinline__ void glds16(const void*gsrc,unsigned lds_dst){unsigned keep;
  asm volatile("s_mov_b32 %0, m0\n\ts_mov_b32 m0, %2\n\ts_nop 0\n\tglobal_load_lds_dwordx4 %1, off\n\ts_mov_b32 m0, %0":"=&s"(keep):"v"(gsrc),"s"(lds_dst):"memory");}
__device__ __forceinline__ float max3f(float a,float b,float c){float r;asm("v_max3_f32 %0, %1, %2, %3":"=v"(r):"v"(a),"v"(b),"v"(c));return r;}
__device__ __forceinline__ float max2f(float a,float b){float r;asm("v_max_f32_e32 %0, %1, %2":"=v"(r):"v"(a),"v"(b));return r;}
__device__ __forceinline__ float fadd_s(float a,float b){float r;asm("v_add_f32_e32 %0, %1, %2":"=v"(r):"v"(a),"v"(b));return r;}
__device__ __forceinline__ float fsub_s(float a,float b){float r;asm("v_sub_f32_e32 %0, %1, %2":"=v"(r):"v"(a),"v"(b));return r;}
typedef float f32x2_t __attribute__((ext_vector_type(2))); typedef __bf16 bf16x2_t __attribute__((ext_vector_type(2)));
__device__ __forceinline__ unsigned cvtpk_s(float lo,float hi){f32x2_t v={lo,hi};bf16x2_t b=__builtin_convertvector(v,bf16x2_t);return __builtin_bit_cast(unsigned,b);}
#define WAIT_BAR(N) asm volatile("s_waitcnt vmcnt(" #N ") lgkmcnt(0)\n\ts_barrier":::"memory")

__device__ __forceinline__ void qkt(f32x16&p0,f32x16&p1,const char*Kslot,const bf16x8*qr,const f32x16&negm,int r32,int hi){
  const char*kb=Kslot+hi*1024+r32*16;
  #pragma unroll
  for(int d0=0;d0<4;++d0){
    const bf16x8 b0=*reinterpret_cast<const bf16x8*>(kb+d0*2048);
    const bf16x8 b1=*reinterpret_cast<const bf16x8*>(kb+d0*2048+512);
    if(d0==0){p0=__builtin_amdgcn_mfma_f32_32x32x16_bf16(b0,qr[0],negm,0,0,0);p1=__builtin_amdgcn_mfma_f32_32x32x16_bf16(b1,qr[0],negm,0,0,0);}
    else{p0=__builtin_amdgcn_mfma_f32_32x32x16_bf16(b0,qr[d0],p0,0,0,0);p1=__builtin_amdgcn_mfma_f32_32x32x16_bf16(b1,qr[d0],p1,0,0,0);}}
}
typedef __attribute__((address_space(3))) const char* lds_cptr;
typedef short v4i16_t __attribute__((ext_vector_type(4)));
__device__ __forceinline__ void kload8(bf16x8*kf,lds_cptr kp){
  kf[0]=*(const __attribute__((address_space(3))) bf16x8*)(kp);      kf[1]=*(const __attribute__((address_space(3))) bf16x8*)(kp+512);
  kf[2]=*(const __attribute__((address_space(3))) bf16x8*)(kp+2048); kf[3]=*(const __attribute__((address_space(3))) bf16x8*)(kp+2560);
  kf[4]=*(const __attribute__((address_space(3))) bf16x8*)(kp+4096); kf[5]=*(const __attribute__((address_space(3))) bf16x8*)(kp+4608);
  kf[6]=*(const __attribute__((address_space(3))) bf16x8*)(kp+6144); kf[7]=*(const __attribute__((address_space(3))) bf16x8*)(kp+6656);
}
__device__ __forceinline__ void kload2(bf16x8*kf,lds_cptr kp,int j){ kf[2*j]=*(const __attribute__((address_space(3))) bf16x8*)(kp+j*2048); kf[2*j+1]=*(const __attribute__((address_space(3))) bf16x8*)(kp+j*2048+512); }
__device__ __forceinline__ s16x4 vtr(lds_cptr p){ return __builtin_bit_cast(s16x4,__builtin_amdgcn_ds_read_tr16_b64_v4i16((__attribute__((address_space(3))) v4i16_t*)p)); }
__device__ __forceinline__ float rowmax(const f32x16&p0,const f32x16&p1){
  float a=max3f(p0[0],p0[1],p1[0]),b=max3f(p0[2],p0[3],p1[1]);a=max3f(a,p1[2],p1[3]);
  #pragma unroll
  for(int r=4;r<16;r+=4){a=max3f(a,p0[r],p0[r+1]);b=max3f(b,p0[r+2],p0[r+3]);a=max3f(a,p1[r],p1[r+1]);b=max3f(b,p1[r+2],p1[r+3]);}
  const float m=max2f(a,b);
  auto rr=__builtin_amdgcn_permlane32_swap(__float_as_uint(m),__float_as_uint(m),false,false);
  return max2f(__uint_as_float(rr[0]),__uint_as_float(rr[1]));
}
__device__ __forceinline__ void pv(f32x16*o,int vb,bf16x8 pa0,bf16x8 pa1,bf16x8 pa2,bf16x8 pa3){
  #pragma unroll
  for(int d0=0;d0<2;++d0){s16x4 lo[4],hi[4];
    #pragma unroll
    for(int ks=0;ks<4;++ks){
      asm volatile("ds_read_b64_tr_b16 %0,%1 offset:%c2":"=&v"(lo[ks]):"v"(vb),"i"(d0*4096+ks*1024):"memory");
      asm volatile("ds_read_b64_tr_b16 %0,%1 offset:%c2":"=&v"(hi[ks]):"v"(vb),"i"(d0*4096+ks*1024+512):"memory");}
    asm volatile("s_waitcnt lgkmcnt(0)":::"memory");SBAR();
    #define PK(k) (bf16x8){lo[k][0],lo[k][1],lo[k][2],lo[k][3],hi[k][0],hi[k][1],hi[k][2],hi[k][3]}
    o[d0]=__builtin_amdgcn_mfma_f32_32x32x16_bf16(pa0,PK(0),o[d0],0,0,0);
    o[d0]=__builtin_amdgcn_mfma_f32_32x32x16_bf16(pa1,PK(1),o[d0],0,0,0);
    o[d0]=__builtin_amdgcn_mfma_f32_32x32x16_bf16(pa2,PK(2),o[d0],0,0,0);
    o[d0]=__builtin_amdgcn_mfma_f32_32x32x16_bf16(pa3,PK(3),o[d0],0,0,0);
    #undef PK
  }
}

#ifndef ATTN_STORE16
#define ATTN_STORE16(p,v) (*(u32x4*)(p)=(v))
#endif
template<int MODE,int NMASKT,int THRL> __device__ __forceinline__ void attn_unit(const bf16*Q0,const bf16*__restrict__ Kh,const bf16*__restrict__ Vh,bf16*O0,int NT,int key_first,int q0,bool use_sink,float sink_l2,char*shm){
  const int tid=tid_(),lane=tid&63,r32=lane&31,hi=lane>>5; const int wid=__builtin_amdgcn_readfirstlane(tid>>6);
  const bf16*Qw=Q0+(long)(wid*QBLK)*QP;
  auto krow=[&](int t)->long{ if(MODE==0) return (long)key_first+64*t; if(t<4) return (long)NSEQ+64*t; int p=q0-128+64*(t-4); p=p<0?0:(p>NSEQ-64?NSEQ-64:p); return (long)p; };
  const unsigned lds0=(unsigned)(uintptr_t)shm;
  float*wsf=(float*)(shm+LDS_WS)+wid*64;
  const bf16*ksrc=Kh+(long)lane*KP+wid*8;
  const bf16*vsrc=Vh+(long)(16*(wid&3)+(lane>>2))*KP+(wid>>2)*32+(lane&3)*8;
  const unsigned kdst=lds0+LDS_K+wid*1024, vdst=lds0+LDS_V+wid*1024;
  #define DMA_K(t,slot) glds16(ksrc+krow(t)*KP,(unsigned)__builtin_amdgcn_readfirstlane(kdst+(slot)))
  #define DMA_V(t,slot) glds16(vsrc+krow(t)*KP,(unsigned)__builtin_amdgcn_readfirstlane(vdst+(slot)))
  const int vb0=(int)(lds0+LDS_V)+((lane>>4)&1)*32+(lane&3)*8+(4*hi+((lane&15)>>2))*64;
  const char*Kbase=shm+LDS_K; bf16x8 kf[8];
  const lds_cptr shm3=(lds_cptr)shm; const lds_cptr kp0=shm3+LDS_K+hi*1024+r32*16; const lds_cptr vp0=shm3+LDS_V+((lane>>4)&1)*32+(lane&3)*8+(4*hi+((lane&15)>>2))*64;
  DMA_K(0,0);DMA_V(0,0);DMA_K(1,SLOTB);
  bf16x8 qr[4];
  #pragma unroll
  for(int d0=0;d0<4;++d0)qr[d0]=*reinterpret_cast<const bf16x8*>(&Qw[(long)r32*QP+d0*16+hi*8]);
  float mhat=0.f,l_reg=0.f;f32x16 o[2];o[0]=f32x16{};o[1]=f32x16{};f32x16 negm=f32x16{};asm volatile("":"+v"(negm));
  const int qrel=wid*QBLK+r32;
  #define CMASK(P0,P1,t) do{ if(NMASKT>0){int jb_=(t)-(NT-NMASKT); if(jb_>=0)wmask(P0,P1,jb_,qrel,hi,q0);} }while(0)
  bool resc=false;
  #define START(P0,P1) do{ const float rm=rowmax(P0,P1); resc=false; \
    { const float dl=rm; mhat=fadd_s(mhat,dl); \
      _Pragma("unroll") for(int r=0;r<16;++r){P0[r]=fsub_s(P0[r],dl);P1[r]=fsub_s(P1[r],dl);} \
      _Pragma("unroll") for(int r=0;r<16;++r)negm[r]=-mhat; asm volatile("":"+v"(negm)); } \
    _Pragma("unroll") for(int r=0;r<16;++r)P0[r]=__builtin_amdgcn_exp2f(P0[r]); }while(0)
  #define RESC() do{ if(resc){ asm volatile("s_waitcnt lgkmcnt(0)":::"memory"); \
      _Pragma("unroll") for(int d_=0;d_<2;++d_) _Pragma("unroll") for(int r=0;r<16;++r)o[d_][r]*=wsf[crow(r,hi)]; } }while(0)
  f32x16 pA0,pA1,pB0,pB1;
  int sl_prev=0,sl_cur=0,sl_next=SLOTB;
  #define ROT() do{sl_prev=sl_cur;sl_cur=sl_next;sl_next=(sl_next==(NSLOT-1)*SLOTB)?0:sl_next+SLOTB;}while(0)
  DMA_K(2,2*SLOTB);
  WAIT_BAR(3);
  qkt(pA0,pA1,Kbase,qr,negm,r32,hi);asm volatile("s_nop 15\n\ts_nop 7":"+v"(pA0),"+v"(pA1));CMASK(pA0,pA1,0);
  START(pA0,pA1);
  _Pragma("unroll") for(int r=0;r<16;++r)pA1[r]=__builtin_amdgcn_exp2f(pA1[r]);
  WAIT_BAR(0);
  DMA_K(3,0);DMA_V(1,SLOTB);
  ROT();
  kload8(kf,kp0+sl_cur);
  WAIT_BAR(2);
  s16x4 vlo[8],vhi[8]; u32x4 pw0,pw1,pw2,pw3;
  #define PKW(P,B) cvtpk_s(P[B],P[B+1])
  #define PAF(k) __builtin_bit_cast(bf16x8,pw##k)
  #define VFR(i) (bf16x8){vlo[i][0],vlo[i][1],vlo[i][2],vlo[i][3],vhi[i][0],vhi[i][1],vhi[i][2],vhi[i][3]}
  #define PIN(x) asm volatile("":"+v"(x))
  #define MX3(a,b,c) __builtin_fmaxf(__builtin_fmaxf((a),(b)),(c))
  #define GAPA(MF,A0,A1,A2,A3,W0,W1,PW) do{ MF; sacc+=A0; sacc+=A1; sacc+=A2; sacc+=A3; PIN(sacc); W0; W1; PIN(PW); SBAR(); }while(0)
  #define EX(v) __builtin_amdgcn_exp2f(v)
  #define GAPB(MF,X,B) do{ MF; X[B]=EX(X[B]); X[B+1]=EX(X[B+1]); X[B+2]=EX(X[B+2]); X[B+3]=EX(X[B+3]); PIN(X); SBAR(); }while(0)
  #define VRD(i) do{ vlo[i]=vtr(vp_+(((i)>>2)*4096+((i)&3)*1024)); vhi[i]=vtr(vp_+(((i)>>2)*4096+((i)&3)*1024+512)); }while(0)
  #define KRD(G,j) do{ if(G){ kload2(kf,kp0+sl_next,j); SBAR(); } }while(0)
  #define STEP(C0,C1,P0,P1,t,GK,GV,GL) do{ SBAR(); \
    const lds_cptr vp_=vp0+sl_prev; \
    VRD(0); SBAR(); float sacc=(P0[0]+P0[1]); \
    GAPA(C0=__builtin_amdgcn_mfma_f32_32x32x16_bf16(kf[0],qr[0],negm,0,0,0), P0[2],P0[3],P0[4],P0[5],     pw0[0]=PKW(P0,0), pw0[1]=PKW(P0,2), pw0); \
    VRD(4); SBAR(); GAPA(C1=__builtin_amdgcn_mfma_f32_32x32x16_bf16(kf[1],qr[0],negm,0,0,0), P0[6],P0[7],P0[8],P0[9],     pw0[2]=PKW(P0,4), pw0[3]=PKW(P0,6), pw0); \
    VRD(1); SBAR(); GAPA(C0=__builtin_amdgcn_mfma_f32_32x32x16_bf16(kf[2],qr[1],C0,0,0,0),   P0[10],P0[11],P0[12],P0[13], pw1[0]=PKW(P0,8), pw1[1]=PKW(P0,10), pw1); \
    VRD(5); SBAR(); GAPA(C1=__builtin_amdgcn_mfma_f32_32x32x16_bf16(kf[3],qr[1],C1,0,0,0),   P0[14],P0[15],P1[0],P1[1],   pw1[2]=PKW(P0,12),pw1[3]=PKW(P0,14), pw1); \
    VRD(2); SBAR(); GAPA(C0=__builtin_amdgcn_mfma_f32_32x32x16_bf16(kf[4],qr[2],C0,0,0,0),   P1[2],P1[3],P1[4],P1[5],     pw2[0]=PKW(P1,0), pw2[1]=PKW(P1,2), pw2); \
    VRD(6); SBAR(); GAPA(C1=__builtin_amdgcn_mfma_f32_32x32x16_bf16(kf[5],qr[2],C1,0,0,0),   P1[6],P1[7],P1[8],P1[9],     pw2[2]=PKW(P1,4), pw2[3]=PKW(P1,6), pw2); \
    VRD(3); SBAR(); GAPA(C0=__builtin_amdgcn_mfma_f32_32x32x16_bf16(kf[6],qr[3],C0,0,0,0),   P1[10],P1[11],P1[12],P1[13], pw3[0]=PKW(P1,8), pw3[1]=PKW(P1,10), pw3); \
    VRD(7); SBAR(); GAPA(C1=__builtin_amdgcn_mfma_f32_32x32x16_bf16(kf[7],qr[3],C1,0,0,0),   P1[14],P1[15],0.f,0.f,       pw3[2]=PKW(P1,12),pw3[3]=PKW(P1,14), pw3); \
    l_reg+=sacc; \
    if(GK){DMA_K((t)+3,sl_cur);} if(GV){DMA_V((t)+1,sl_next);} \
    CMASK(C0,C1,t); \
    { float a=MX3(C0[0],C0[1],C1[0]),b=MX3(C0[2],C0[3],C1[1]); a=MX3(a,C1[2],C1[3]); \
      _Pragma("unroll") for(int r=4;r<16;r+=4){a=MX3(a,C0[r],C0[r+1]);b=MX3(b,C0[r+2],C0[r+3]);a=MX3(a,C1[r],C1[r+1]);b=MX3(b,C1[r+2],C1[r+3]);} \
      float rm=__builtin_fmaxf(a,b); { auto rr=__builtin_amdgcn_permlane32_swap(__float_as_uint(rm),__float_as_uint(rm),false,false); rm=__builtin_fmaxf(__uint_as_float(rr[0]),__uint_as_float(rr[1])); } \
      resc=false; \
      if(__builtin_expect(__any(rm>(float)THRL),0)){ const float dl=__builtin_fmaxf(rm,0.f); mhat+=dl; \
        _Pragma("unroll") for(int r=0;r<16;++r){C0[r]-=dl;C1[r]-=dl;} \
        _Pragma("unroll") for(int r=0;r<16;++r)negm[r]=-mhat; asm volatile("":"+v"(negm)); \
        const float f=__builtin_amdgcn_exp2f(-dl); l_reg*=f; if(hi==0)wsf[r32]=f; resc=true; } } \
    SBAR(); \
    GAPB(o[0]=__builtin_amdgcn_mfma_f32_32x32x16_bf16(PAF(0),VFR(0),o[0],0,0,0), C0,0); \
    GAPB(o[1]=__builtin_amdgcn_mfma_f32_32x32x16_bf16(PAF(0),VFR(4),o[1],0,0,0), C0,4); \
    KRD(GL,0); GAPB(o[0]=__builtin_amdgcn_mfma_f32_32x32x16_bf16(PAF(1),VFR(1),o[0],0,0,0), C0,8); \
    KRD(GL,1); GAPB(o[1]=__builtin_amdgcn_mfma_f32_32x32x16_bf16(PAF(1),VFR(5),o[1],0,0,0), C0,12); \
    KRD(GL,2); GAPB(o[0]=__builtin_amdgcn_mfma_f32_32x32x16_bf16(PAF(2),VFR(2),o[0],0,0,0), C1,0); \
    KRD(GL,3); GAPB(o[1]=__builtin_amdgcn_mfma_f32_32x32x16_bf16(PAF(2),VFR(6),o[1],0,0,0), C1,4); \
    GAPB(o[0]=__builtin_amdgcn_mfma_f32_32x32x16_bf16(PAF(3),VFR(3),o[0],0,0,0), C1,8); \
    GAPB(o[1]=__builtin_amdgcn_mfma_f32_32x32x16_bf16(PAF(3),VFR(7),o[1],0,0,0), C1,12); \
    }while(0)
  int t=1;
  #undef CMASK
  #define CMASK(P0,P1,t) do{}while(0)
  for(;t+1+(NMASKT>4?NMASKT:4)<NT;t+=2){
    STEP(pB0,pB1,pA0,pA1,t,true,true,true);     WAIT_BAR(2); RESC(); ROT();
    STEP(pA0,pA1,pB0,pB1,t+1,true,true,true);   WAIT_BAR(2); RESC(); ROT();
  }
  #undef CMASK
  #define CMASK(P0,P1,t) do{ if(NMASKT>0){int jb_=(t)-(NT-NMASKT); if(jb_>=0)wmask(P0,P1,jb_,qrel,hi,q0);} }while(0)
  #define ENDW(tt) do{ if((tt)+3<NT){WAIT_BAR(2);} else if((tt)+2<NT){WAIT_BAR(1);} else {WAIT_BAR(0);} }while(0)
  for(;t+1<NT;t+=2){
    STEP(pB0,pB1,pA0,pA1,t,(t+3<NT),(t+1<NT),(t+1<NT));       ENDW(t);   RESC(); ROT();
    STEP(pA0,pA1,pB0,pB1,t+1,(t+4<NT),(t+2<NT),(t+2<NT));     ENDW(t+1); RESC(); ROT();
  }
  STEP(pB0,pB1,pA0,pA1,NT-1,false,false,false); RESC();
  { float sacc=pB0[0]+pB0[1]; _Pragma("unroll") for(int r=2;r<16;++r)sacc+=pB0[r]; _Pragma("unroll") for(int r=0;r<16;++r)sacc+=pB1[r]; l_reg+=sacc;
    pw0=(u32x4){PKW(pB0,0),PKW(pB0,2),PKW(pB0,4),PKW(pB0,6)};pw1=(u32x4){PKW(pB0,8),PKW(pB0,10),PKW(pB0,12),PKW(pB0,14)};pw2=(u32x4){PKW(pB1,0),PKW(pB1,2),PKW(pB1,4),PKW(pB1,6)};pw3=(u32x4){PKW(pB1,8),PKW(pB1,10),PKW(pB1,12),PKW(pB1,14)};
    SBAR(); pv(o,vb0+sl_cur,PAF(0),PAF(1),PAF(2),PAF(3)); }
  #undef PKW
  #undef PAF
  #undef VFR
  #undef PIN
  #undef MX3
  #undef GAPA
  #undef GAPB
  #undef EX
  #undef VRD
  #undef KRD
  #undef STEP
  #undef ENDW
  {auto rr=__builtin_amdgcn_permlane32_swap(__float_as_uint(l_reg),__float_as_uint(l_reg),false,false);l_reg=__uint_as_float(rr[0])+__uint_as_float(rr[1]);}
  if(use_sink)l_reg+=__builtin_amdgcn_exp2f(sink_l2-mhat);
  if(hi==0)wsf[32+r32]=l_reg;asm volatile("s_waitcnt lgkmcnt(0)":::"memory");
  float rli[16];
  #pragma unroll
  for(int r=0;r<16;++r)rli[r]=__builtin_amdgcn_rcpf(wsf[32+crow(r,hi)]);
  bf16*Ow=O0+(long)(wid*QBLK)*OP;
  { bf16*stg=(bf16*)(shm+LDS_OST)+wid*2048;
    #pragma unroll
    for(int r=0;r<16;++r){const int orow=crow(r,hi);
      #pragma unroll
      for(int d0=0;d0<2;++d0)stg[orow*64+d0*32+r32]=__float2bfloat16(o[d0][r]*rli[r]);}
    asm volatile("s_waitcnt lgkmcnt(0)":::"memory");
    #pragma unroll
    for(int i=0;i<4;++i){const int row=i*8+(lane>>3),ch=lane&7; const u32x4 v=*(const u32x4*)(stg+row*64+ch*8); ATTN_STORE16(Ow+(long)row*OP+ch*8,v);} }
  asm volatile("s_waitcnt lgkmcnt(0)\n\ts_barrier":::"memory");
  #undef DMA_K
  #undef DMA_V
  #undef CMASK
  #undef START
  #undef RESC
  #undef ROT
}
constexpr int ATTN_LDS_BYTES=LDS_BYTES;
#undef SBAR
#undef WAIT_BAR
}

__device__ __forceinline__ void ph_attn_f(KP p, int l, unsigned char* lds, bool do_scan = true) {
    if (do_scan) { if (FAST_HGRN) hgrn_scan_f(p); else hgrn_scan(p); }
    using attn_body::bf16;
    bf16* Y = (bf16*)(p->ws + Z_YCAT);
    const bf16* Qg = (const bf16*)(p->ws + Z_QG); const bf16* Qw = (const bf16*)(p->ws + Z_QW); const bf16* Qgc = (const bf16*)(p->ws + Z_QGC); const bf16* Qwc = (const bf16*)(p->ws + Z_QWC);
    const bf16* Kg = (const bf16*)(p->ws + Z_KG); const bf16* Kw = (const bf16*)(p->ws + Z_KW); const bf16* Vg = (const bf16*)(p->ws + Z_VG); const bf16* Vw = (const bf16*)(p->ws + Z_VW);
    const int G = gsz_(), bid = bid_();
    __syncthreads();
    for (int vb = bid; vb < 256; vb += G) {
        const int v = (G == 256) ? (((vb & 7) >> 1) * 64 + (vb & 1) * 32 + (vb >> 3)) : vb;
        const int b = v >> 7, kvh = (v >> 6) & 1, h = kvh * 2 + ((v >> 5) & 1), qb = v & 31, row0 = b * NSEQ + qb * 256;
        const size_t kvo = (size_t)b * NKEY * 128 + kvh * 64;
        attn_body::attn_unit<0, 0, 8>(Qg + (size_t)row0 * 256 + h * 64, Kg + kvo, Vg + kvo, Y + (size_t)row0 * D + h * 64, NKEY / 64, 0, 0, false, 0.f, (char*)lds);
        attn_body::attn_unit<1, 8, 8>(Qw + (size_t)row0 * 256 + h * 64, Kw + kvo, Vw + kvo, Y + (size_t)row0 * D + 512 + h * 64, 12, 0, qb * 256, true, p->in[14][l * 4 + h] * LOG2E, (char*)lds);
    }
    if (l == 0) for (int v = bid; v < 16; v += G) {
        const int h = v & 3, b = (v >> 2) & 1, win = v >> 3, row0 = R_LAT + b * NCTX;
        const size_t kvo = (size_t)b * NKEY * 128 + (h >> 1) * 64;
        attn_body::attn_unit<0, 0, 8>((win ? Qwc : Qgc) + (size_t)(b * NCTX) * 256 + h * 64, (win ? Kw : Kg) + kvo, (win ? Vw : Vg) + kvo, Y + (size_t)row0 * D + (win ? 512 : 0) + h * 64, 4, NSEQ, 0, win != 0, p->in[14][l * 4 + h] * LOG2E, (char*)lds);
    }
}

__device__ __forceinline__ void hgrn_pass3_unit(KP p, int l, unsigned char* lds, int unit) {
    float* qs = (float*)lds; float* vs = qs + 4096; float* ks = vs + 4096; float* cs = ks + 4096; float* Ss = cs + 4096; float* sc = Ss + 4096; float* os = sc + 4096;
    const int tid = tid_(), lane = tid & 63, wid = tid >> 6;
    const int cpos = unit % NCHUNK, head = (unit / NCHUNK) & 3, b = unit / (NCHUNK * 4);
    const int row0 = (cpos < 4) ? R_LAT + b * NCTX + cpos * 64 : b * NSEQ + (cpos - 4) * 64;
    for (int i = tid; i < 4096; i += NTHREADS) os[i] = 0.f;
    for (int dir = 0; dir < 2; ++dir) {
        const int j = (cpos < 4) ? (dir ? 3 - cpos : cpos) : 4 + (dir ? 127 - (cpos - 4) : (cpos - 4));
        const int seq = (b * 4 + head) * 2 + dir;
        __syncthreads();
        hgrn_load_chunk(p, l, row0, dir, head, qs, vs, ks, cs);
        const float* Sg = (const float*)(p->ws + Z_U) + ((size_t)seq * NCHUNK + j) * 4096;
        for (int i = tid; i < 4096; i += NTHREADS) Ss[i] = Sg[i];
        for (int i = tid; i < 4096; i += NTHREADS) { const int tau = i >> 6, sig = i & 63; float a = 0.f;
            if (sig <= tau) { for (int d = 0; d < 64; ++d) a += qs[tau * 64 + d] * ks[sig * 64 + d] * __expf(cs[tau * 64 + d] - cs[sig * 64 + d]); }
            sc[i] = a; }
        __syncthreads();
        { const int tau = tid >> 3, e0 = (tid & 7) * 8; float acc[8];
#pragma unroll
          for (int e = 0; e < 8; ++e) acc[e] = 0.f;
          for (int d = 0; d < 64; ++d) { const float qv = qs[tau * 64 + d] * __expf(cs[tau * 64 + d]);
#pragma unroll
              for (int e = 0; e < 8; ++e) acc[e] += qv * Ss[d * 64 + e0 + e]; }
          for (int sig = 0; sig <= tau; ++sig) { const float sv = sc[tau * 64 + sig];
#pragma unroll
              for (int e = 0; e < 8; ++e) acc[e] += sv * vs[sig * 64 + e0 + e]; }
          const int tok = dir ? 63 - tau : tau;
#pragma unroll
          for (int e = 0; e < 8; ++e) os[tok * 64 + e0 + e] += acc[e]; }
        __syncthreads();
    }
    const bf16_t* P = (const bf16_t*)(p->ws + Z_P); bf16_t* Y = (bf16_t*)(p->ws + Z_YCAT);
    for (int tok = wid; tok < 64; tok += 8) { const float v = os[tok * 64 + lane];
        const float y = v * rsqrtf(wave_sum(v * v) * (1.f / 64.f) + EPS) * p->in[22][l * 64 + lane];
        const float g = bf2f(P[(size_t)(row0 + tok) * DIN + C_RG + head * 64 + lane]);
        Y[(size_t)(row0 + tok) * D + 768 + head * 64 + lane] = (bf16_t)f2bf(y * silu_(g)); }
    __syncthreads();
}
__device__ __forceinline__ void ph_hgrn3(KP p, int l, unsigned char* lds) {
    hgrn_pass3_run(p, l, lds);
    if (l == 0 && DEPTH > 1 && gsz_() == 256) { __syncthreads(); ph_cvt(p, 1, lds, 32, 224, CVT_E1, CVT_E2); }
}

__device__ __forceinline__ void ph_outproj(KP p, int l, unsigned char* lds) {
    const bf16_t* A = (const bf16_t*)(p->ws + Z_YCAT); const bf16_t* Bt = (const bf16_t*)(p->ws + Z_WOUT); float* X = (float*)(p->ws + WS_X);
    const int T = (l == 0) ? R_ALL : R_LAT; const int TM = T / 128, TN = 8;
    for (int it = bid_(); it < TM * TN; it += gsz_()) { const int mt = it / TN, nt = it % TN;
        auto epi = [&](int row, int col, float v, float) { const int c = nt * 128 + col; X[(size_t)row * D + c] = xrow_src(p, l, row)[c] + mod_vec(p, l, row, 2)[c] * v; };
        gemm_simple_tile<1>(A, RowId{}, Bt, 1024, mt * 128, nt * 128, 0, epi); }
}

__device__ __forceinline__ void ph_norm2(KP p, int l, unsigned char* lds, int cnt_off = 0) {
    constexpr int RS = 1032, NSTG = 80;
    const int T = (l == 0) ? R_ALL : R_LAT;
    bf16_t* AH = (bf16_t*)lds; bf16_t* AL = AH + 16 * RS;
    float* PART = (float*)(lds + 2 * 16 * RS * 2); float* LOG = PART + 8 * 16 * 64;
    int* hist = (int*)(LOG + 16 * 64); int* hbase = hist + 64; int* s_e = hbase + 64; int* s_r = s_e + NSTG * 8; float* s_w = (float*)(s_r + NSTG * 8); float* msb = s_w + NSTG * 8;
    const int tid = tid_(), lane = tid & 63, wid = tid >> 6, fr = lane & 15, fq = lane >> 4, bid = bid_(), G = gsz_();
    bf16_t* Tok = (bf16_t*)(p->ws + Z_A); const bf16_t* X = (const bf16_t*)(p->ws + WS_X);
    const float* g2 = p->in[7] + l * D; const float* rw = p->in[23] + (size_t)l * 1024 * 64; const float* rbias = p->in[24] + l * 64;
    unsigned* cnt = (unsigned*)(p->ws + WS_CTL) + CW_CNT + cnt_off + l * 64;
    int* tok_e = (int*)(p->ws + WS_TOKE); int* tok_p = (int*)(p->ws + WS_TOKP); int* expl = (int*)(p->ws + WS_EXPL); float* expw = (float*)(p->ws + WS_EXPW);
    bf16x8 bh[4][4], bl[4][4];
#pragma unroll
    for (int t = 0; t < 4; ++t)
#pragma unroll
        for (int k = 0; k < 4; ++k) { float v[8], lo[8];
#pragma unroll
            for (int j = 0; j < 8; ++j) v[j] = rw[(size_t)((wid * 4 + k) * 32 + fq * 8 + j) * 64 + t * 16 + fr];
            const u32x4 hh = pack8(v);
            const float hf[8] = {bf2f(hh.x & 0xffffu), bf2f(hh.x >> 16), bf2f(hh.y & 0xffffu), bf2f(hh.y >> 16), bf2f(hh.z & 0xffffu), bf2f(hh.z >> 16), bf2f(hh.w & 0xffffu), bf2f(hh.w >> 16)};
#pragma unroll
            for (int j = 0; j < 8; ++j) lo[j] = v[j] - hf[j];
            const u32x4 ll = pack8(lo);
            bh[t][k] = __builtin_bit_cast(bf16x8, hh); bl[t][k] = __builtin_bit_cast(bf16x8, ll); }
    const float mybias = rbias[lane];
    const int rpb = (T + G - 1) / G;
    for (int base = bid * rpb; base < T; base += G * rpb) {
        const int r1 = (base + rpb < T) ? base + rpb : T;
        if (tid < 64) hist[tid] = 0;
        for (int s0 = base; s0 < r1; s0 += 16) {
#pragma unroll
            for (int j2 = 0; j2 < 2; ++j2) { const int lr = wid * 2 + j2, row = s0 + lr;
                if (row < r1) {
                    const bf16_t* xrow = X + (size_t)row * D; const float* shift = mod_vec(p, l, row, 3); const float* scale = mod_vec(p, l, row, 4);
                    f32x4 v[4]; float ssq = 0.f;
#pragma unroll
                    for (int j = 0; j < 4; ++j) { const u32x2 r2 = ((const u32x2*)xrow)[lane + 64 * j]; v[j].x = bf2f(r2.x & 0xffffu); v[j].y = bf2f(r2.x >> 16); v[j].z = bf2f(r2.y & 0xffffu); v[j].w = bf2f(r2.y >> 16); ssq += v[j].x * v[j].x + v[j].y * v[j].y + v[j].z * v[j].z + v[j].w * v[j].w; }
                    const float rinv = rsqrtf(wave_sum(ssq) * (1.f / D) + EPS);
#pragma unroll
                    for (int j = 0; j < 4; ++j) { const int idx = lane + 64 * j;
                        const f32x4 gg = ((const f32x4*)g2)[idx], sh = ((const f32x4*)shift)[idx], sc = ((const f32x4*)scale)[idx];
                        f32x4 y; y.x = v[j].x * rinv * gg.x * (1.f + sc.x) + sh.x; y.y = v[j].y * rinv * gg.y * (1.f + sc.y) + sh.y;
                        y.z = v[j].z * rinv * gg.z * (1.f + sc.z) + sh.z; y.w = v[j].w * rinv * gg.w * (1.f + sc.w) + sh.w;
                        u32x2 h; h.x = pk2(y.x, y.y); h.y = pk2(y.z, y.w);
                        u32x2 lw; lw.x = pk2(y.x - bf2f(h.x & 0xffffu), y.y - bf2f(h.x >> 16)); lw.y = pk2(y.z - bf2f(h.y & 0xffffu), y.w - bf2f(h.y >> 16));
                        { int t8 = __builtin_amdgcn_cvt_pk_fp8_f32(clamp8(y.x * TOK8_SCALE), clamp8(y.y * TOK8_SCALE), 0, false); t8 = __builtin_amdgcn_cvt_pk_fp8_f32(clamp8(y.z * TOK8_SCALE), clamp8(y.w * TOK8_SCALE), t8, true);
                          ((unsigned*)((unsigned char*)Tok + (size_t)row * D))[idx] = (unsigned)t8; }
                        *(u32x2*)(AH + lr * RS + idx * 4) = h; *(u32x2*)(AL + lr * RS + idx * 4) = lw; }
                } else {
#pragma unroll
                    for (int j = 0; j < 4; ++j) { const int idx = lane + 64 * j; const u32x2 z = {0u, 0u}; *(u32x2*)(AH + lr * RS + idx * 4) = z; *(u32x2*)(AL + lr * RS + idx * 4) = z; } } }
            __syncthreads();
            { f32x4 acc[4];
#pragma unroll
              for (int t = 0; t < 4; ++t) acc[t] = (f32x4){0.f, 0.f, 0.f, 0.f};
#pragma unroll
              for (int k = 0; k < 4; ++k) { const int ko = (wid * 4 + k) * 32 + fq * 8;
                  const bf16x8 ah = *(const bf16x8*)(AH + fr * RS + ko), al = *(const bf16x8*)(AL + fr * RS + ko);
#pragma unroll
                  for (int t = 0; t < 4; ++t) { acc[t] = __builtin_amdgcn_mfma_f32_16x16x32_bf16(ah, bh[t][k], acc[t], 0, 0, 0);
                      acc[t] = __builtin_amdgcn_mfma_f32_16x16x32_bf16(ah, bl[t][k], acc[t], 0, 0, 0); acc[t] = __builtin_amdgcn_mfma_f32_16x16x32_bf16(al, bh[t][k], acc[t], 0, 0, 0); } }
#pragma unroll
              for (int t = 0; t < 4; ++t)
#pragma unroll
                  for (int r = 0; r < 4; ++r) PART[(wid * 16 + fq * 4 + r) * 64 + t * 16 + fr] = acc[t][r]; }
            __syncthreads();
#pragma unroll
            for (int q = 0; q < 2; ++q) { const int o = tid + q * NTHREADS; float a = 0.f;
#pragma unroll
                for (int w8 = 0; w8 < 8; ++w8) a += PART[w8 * 1024 + o];
                LOG[o] = a; }
            __syncthreads();
#pragma unroll 1
            for (int j2 = 0; j2 < 2; ++j2) { const int lr = wid * 2 + j2, row = s0 + lr;
                if (row >= r1) continue;
                const int sr = row - base;
                float score = sigmoid_(LOG[lr * 64 + lane]); score = (score == score) ? score : 0.f;
                const float sel = score + mybias;
                const int e = lane, g = e >> 3;
                int rg = 0;
#pragma unroll
                for (int i = 1; i < 8; ++i) { const int src = (lane & ~7) | ((lane + i) & 7); const float o = __shfl(sel, src); rg += (o > sel) || (o == sel && src < e); }
                float top2 = (rg < 2) ? sel : 0.f;
                top2 += __shfl_xor(top2, 1); top2 += __shfl_xor(top2, 2); top2 += __shfl_xor(top2, 4);
                int grank = 0;
#pragma unroll
                for (int i = 1; i < 8; ++i) { const int og = (g + i) & 7; const float o = __shfl(top2, og * 8); grank += (o > top2) || (o == top2 && og < g); }
                const bool keep = grank < 4;
                const float ms = keep ? sel : -INFINITY;
                float* mrow = msb + wid * 64;
                mrow[lane] = ms;
                __builtin_amdgcn_wave_barrier();
                int rk = 0;
#pragma unroll 4
                for (int i = 0; i < 16; ++i) { const f32x4 o = *(const f32x4*)(mrow + 4 * i);
                    rk += (o.x > ms) || (o.x == ms && 4 * i + 0 < e); rk += (o.y > ms) || (o.y == ms && 4 * i + 1 < e);
                    rk += (o.z > ms) || (o.z == ms && 4 * i + 2 < e); rk += (o.w > ms) || (o.w == ms && 4 * i + 3 < e); }
                __builtin_amdgcn_wave_barrier();
                const bool chosen = keep && rk < 8;
                const float wsum = wave_sum(chosen ? score : 0.f);
                if (chosen) { const int r = atomicAdd(&hist[e], 1); s_e[sr * 8 + rk] = e; s_r[sr * 8 + rk] = r; s_w[sr * 8 + rk] = score / wsum * 2.5f; } }
        }
        __syncthreads();
        if (tid < 64) { const int h = hist[tid]; hbase[tid] = h ? (int)atomicAdd(&cnt[tid], (unsigned)h) : 0; }
        __syncthreads();
        for (int i = tid; i < (r1 - base) * 8; i += NTHREADS) { const int e = s_e[i]; const size_t o = (size_t)base * 8 + i;
            const int pos = hbase[e] + s_r[i]; tok_e[o] = e; tok_p[o] = pos; expl[(size_t)e * R_ALL + pos] = base + (i >> 3); expw[(size_t)e * R_ALL + pos] = s_w[i]; }
        __syncthreads();
    }
}

__device__ __forceinline__ void moe_pad_starts(KP p, int l, int* ps) {
    const unsigned* cnt = (const unsigned*)(p->ws + WS_CTL) + CW_CNT + l * 64;
    if (tid_() == 0) { int acc = 0; for (int e = 0; e < 64; ++e) { ps[e] = acc; acc += (int)((cnt[e] + 255u) / 256u) * 256; } ps[64] = acc; }
    __syncthreads();
}
__device__ __forceinline__ int moe_expert_of_row(const int* ps, int row) { int e = 0; while (e < 63 && row >= ps[e + 1]) ++e; return e; }

__device__ __forceinline__ void ph_slots(KP p, int l, unsigned char* lds) {
    const int T = (l == 0) ? R_ALL : R_LAT;
    int* ps = (int*)lds; moe_pad_starts(p, l, ps);
    const unsigned* cnt = (const unsigned*)(p->ws + WS_CTL) + CW_CNT + l * 64;
    const int* tok_e = (const int*)(p->ws + WS_TOKE); const int* tok_p = (const int*)(p->ws + WS_TOKP); const float* tok_w = (const float*)(p->ws + WS_TOKW);
    int* tok_s = (int*)(p->ws + WS_TOKS); int* slot_t = (int*)(p->ws + WS_SLOTT); float* slot_w = (float*)(p->ws + WS_SLOTW);
    for (int i = bid_() * NTHREADS + tid_(); i < T * 8; i += gsz_() * NTHREADS) { const int e = tok_e[i], slot = ps[e] + tok_p[i]; tok_s[i] = slot; slot_t[slot] = i >> 3; slot_w[slot] = tok_w[i]; }
    for (int i = bid_() * NTHREADS + tid_(); i < T; i += gsz_() * NTHREADS) { slot_t[MAXSLOT + i] = i; slot_w[MAXSLOT + i] = 1.f; }
    for (int i = bid_() * NTHREADS + tid_(); i < 64 * 256; i += gsz_() * NTHREADS) { const int e = i >> 8, j = i & 255; const int r = ps[e] + (int)cnt[e] + j; if (r < ps[e + 1]) { slot_t[r] = 0; slot_w[r] = 0.f; } }
    __syncthreads();
}

__device__ __forceinline__ void ph_gateup(KP p, int l, unsigned char* lds) {
    const int T = (l == 0) ? R_ALL : R_LAT;
    int* ps = (int*)lds; moe_pad_starts(p, l, ps);
    const bf16_t* Tok = (const bf16_t*)(p->ws + Z_A); const bf16_t* Wgu = (const bf16_t*)(p->ws + Z_WGU); bf16_t* H = (bf16_t*)(p->ws + Z_H);
    const int* slot_t = (const int*)(p->ws + WS_SLOTT); const float* slot_w = (const float*)(p->ws + WS_SLOTW);
    const int n128 = ps[64] / 128, nitems = (n128 + T / 128) * 2;
    for (int it = bid_(); it < nitems; it += gsz_()) { const int rt = it >> 1, pn = it & 1;
        if (rt < n128) { const int e = moe_expert_of_row(ps, rt * 128);
            auto epi = [&](int row, int col, float g, float u) { H[(size_t)row * 256 + pn * 128 + col] = (bf16_t)f2bf(silu_(g) * u * slot_w[row]); };
            gemm_simple_tile<2>(Tok, RowGather{slot_t}, Wgu + (size_t)e * 524288, 1024, rt * 128, pn * 256, 128, epi);
        } else { const int t0 = (rt - n128) * 128;
            auto epi = [&](int row, int col, float g, float u) { H[(size_t)(MAXSLOT + row) * 256 + pn * 128 + col] = (bf16_t)f2bf(silu_(g) * u); };
            gemm_simple_tile<2>(Tok, RowId{}, Wgu + (size_t)64 * 524288, 1024, t0, pn * 256, 128, epi); }
    }
}
__device__ __forceinline__ void ph_down(KP p, int l, unsigned char* lds) {
    const int T = (l == 0) ? R_ALL : R_LAT;
    int* ps = (int*)lds; moe_pad_starts(p, l, ps);
    const bf16_t* H = (const bf16_t*)(p->ws + Z_H); const bf16_t* Wd = (const bf16_t*)(p->ws + WS_WD); bf16_t* Y = (bf16_t*)(p->ws + Z_Y); float* X = (float*)(p->ws + WS_X);
    const int n128 = ps[64] / 128, nitems = (n128 + T / 128) * 8;
    for (int it = bid_(); it < nitems; it += gsz_()) { const int rt = it >> 3, nt = it & 7;
        if (rt < n128) { const int e = moe_expert_of_row(ps, rt * 128);
            auto epi = [&](int row, int col, float v, float) { Y[(size_t)row * D + nt * 128 + col] = (bf16_t)f2bf(v); };
            gemm_simple_tile<1>(H, RowId{}, Wd + (size_t)e * 262144, 256, rt * 128, nt * 128, 0, epi);
        } else { const int t0 = (rt - n128) * 128;
            auto epi = [&](int row, int col, float v, float) { const int t = row - MAXSLOT, c = nt * 128 + col; X[(size_t)t * D + c] += mod_vec(p, l, t, 5)[c] * v; };
            gemm_simple_tile<1>(H, RowId{}, Wd + (size_t)64 * 262144, 256, MAXSLOT + t0, nt * 128, 0, epi); }
    }
}
__device__ __forceinline__ void ph_combine(KP p, int l, unsigned char* lds) {
    typedef float f32x2 __attribute__((ext_vector_type(2)));
    const int T = (l == 0) ? R_ALL : R_LAT;
    const int tid = tid_(), lane = tid & 63, wid = tid >> 6;
    const unsigned char* Y8 = (const unsigned char*)(p->ws + Z_Y); bf16_t* X = (bf16_t*)(p->ws + WS_X); const int* tok_e = (const int*)(p->ws + WS_TOKE); const int* tok_p = (const int*)(p->ws + WS_TOKP);
    int* ps = (int*)lds; moe_pad_starts(p, l, ps);
    const size_t yoff = (size_t)(lane >> 4) * MAXSLOT * 256 + (lane & 15) * 16;
    for (int row = bid_() * 8 + wid; row < T; row += gsz_() * 8) {
        const float* g5 = mod_vec(p, l, row, 5) + lane * 16;
        bf16_t* xr = X + (size_t)row * D + lane * 16;
        const int myslot = ps[tok_e[row * 8 + (lane & 7)]] + tok_p[row * 8 + (lane & 7)];
        u32x4 yv[8];
#pragma unroll
        for (int k = 0; k < 8; ++k) { const int sl = __shfl(myslot, k); yv[k] = *(const u32x4*)(Y8 + yoff + (size_t)sl * 256); }
        f32x4 xv[4], gv[4];
#pragma unroll
        for (int q = 0; q < 4; ++q) gv[q] = *(const f32x4*)(g5 + 4 * q);
        unpack8(*(const u32x4*)xr, xv[0], xv[1]); unpack8(*(const u32x4*)(xr + 8), xv[2], xv[3]);
        float a[16];
#pragma unroll
        for (int q = 0; q < 16; ++q) a[q] = 0.f;
#pragma unroll
        for (int k = 0; k < 8; ++k) { const unsigned w[4] = {yv[k].x, yv[k].y, yv[k].z, yv[k].w};
#pragma unroll
            for (int q = 0; q < 4; ++q) { const f32x2 lo = __builtin_amdgcn_cvt_pk_f32_fp8((int)w[q], false), hi = __builtin_amdgcn_cvt_pk_f32_fp8((int)w[q], true);
                a[4 * q] += lo.x; a[4 * q + 1] += lo.y; a[4 * q + 2] += hi.x; a[4 * q + 3] += hi.y; } }
#pragma unroll
        for (int q = 0; q < 4; ++q) { f32x4 av; av.x = a[4 * q]; av.y = a[4 * q + 1]; av.z = a[4 * q + 2]; av.w = a[4 * q + 3]; xv[q] = xv[q] + gv[q] * (av * (1.f / Y8_SCALE)); }
        if (l == DEPTH - 1) { float* dst = p->out + (size_t)row * D + lane * 16;
#pragma unroll
            for (int q = 0; q < 4; ++q) *(f32x4*)(dst + 4 * q) = xv[q]; }
        else { *(u32x4*)xr = (u32x4){pk2(xv[0].x, xv[0].y), pk2(xv[0].z, xv[0].w), pk2(xv[1].x, xv[1].y), pk2(xv[1].z, xv[1].w)};
               *(u32x4*)(xr + 8) = (u32x4){pk2(xv[2].x, xv[2].y), pk2(xv[2].z, xv[2].w), pk2(xv[3].x, xv[3].y), pk2(xv[3].z, xv[3].w)}; }
    }
}
struct MoeSched {
    int ntr, nrt, npn, G, c; const LAS int* tile_e;
    __device__ __forceinline__ bool next(int i, pg8::Unit& u) const {
        const int L = i * G + c; if (L >= nrt * npn) return false;
        const int rt = L / npn, pp = L % npn; const bool routed = rt < ntr;
        const int e = routed ? __builtin_amdgcn_readfirstlane(tile_e[rt]) : 64;
        u.pm = routed ? rt : MAXSLOT / 256 + (rt - ntr); u.pn = e * npn + pp; u.ord = i; return true;
    }
};
constexpr int MOE_UNITS = 6;
constexpr int LDS_RTAB = 131072, LDS_WTAB = LDS_RTAB + MOE_UNITS * 1024, LDS_TILE_E = LDS_WTAB + MOE_UNITS * 1024, LDS_PS = LDS_TILE_E + 2400;
static_assert(LDS_PS + 129 * 4 <= LDS_BYTES - 16, "MoE tables fit above the staging buffers");
__device__ __forceinline__ MoeSched moe_setup(KP p, int l, unsigned char* lds, int npn, bool gather) {
    const int T = (l == 0) ? R_ALL : R_LAT;
    int* ps = (int*)(lds + LDS_PS); int* cl = ps + 65;
    const unsigned* cnt = (const unsigned*)(p->ws + WS_CTL) + CW_CNT + l * 64;
    const int tid = tid_();
    if (tid < 64) cl[tid] = (int)cnt[tid];
    moe_pad_starts(p, l, ps);
    LAS int* tile_e = (LAS int*)((LAS unsigned char*)lds + LDS_TILE_E); LAS int* rtab = (LAS int*)((LAS unsigned char*)lds + LDS_RTAB); LAS float* wtab = (LAS float*)((LAS unsigned char*)lds + LDS_WTAB);
    const int ntr = ps[64] / 256;
    for (int rt = tid; rt < ntr; rt += NTHREADS) tile_e[rt] = moe_expert_of_row(ps, rt * 256);
    __syncthreads();
    MoeSched S{ntr, ntr + T / 256, npn, gsz_(), bid_(), tile_e};
    if (gather) { const int* expl = (const int*)(p->ws + WS_EXPL); const float* expw = (const float*)(p->ws + WS_EXPW); pg8::Unit u;
        for (int i = 0; i < MOE_UNITS && S.next(i, u); ++i) for (int r = tid; r < 256; r += NTHREADS) {
            int tok; float w;
            if (u.pm < MAXSLOT / 256) { const int e = tile_e[u.pm], pos = u.pm * 256 + r - ps[e]; const bool valid = pos < cl[e];
                tok = valid ? expl[(size_t)e * R_ALL + pos] : 0; w = valid ? expw[(size_t)e * R_ALL + pos] : 0.f; }
            else { tok = (u.pm - MAXSLOT / 256) * 256 + r; w = 1.f; }
            rtab[i * 256 + r] = tok; wtab[i * 256 + r] = w; } }
    __syncthreads();
    return S;
}
__device__ __forceinline__ void ph_gateup_f(KP p, int l, unsigned char* lds) {
    const MoeSched S = moe_setup(p, l, lds, 2, true);
    pg8::Gemm g{(const bf16_t*)(p->ws + Z_A), (const bf16_t*)(p->ws + wgu_off(l)), 0, 0, 1024};
    pg8::EpiGU8 E{(unsigned char*)(p->ws + Z_H), (const LAS float*)((LAS unsigned char*)lds + LDS_WTAB)};
    pg8::gemm_phase<pg8::EpiGU8, MoeSched, true, true>((LAS unsigned char*)lds, g, S, E, (const LAS int*)((LAS unsigned char*)lds + LDS_RTAB));
}
__device__ __forceinline__ void ph_down_f(KP p, int l, unsigned char* lds) {
    const MoeSched S = moe_setup(p, l, lds, 4, false);
    pg8::Gemm g{(const bf16_t*)(p->ws + Z_H), (const bf16_t*)(p->ws + wd_off(l)), 0, 0, 256};
    bf16_t* X = (bf16_t*)(p->ws + WS_X);
    pg8::EpiDown E{(bf16_t*)(p->ws + Z_Y), X, (const float*)(p->ws + WS_MOD) + (size_t)l * 3 * 6144 + 5 * 1024};
    pg8::gemm_phase<pg8::EpiDown, MoeSched, false, true>((LAS unsigned char*)lds, g, S, E, nullptr);
}

#ifndef FAST_ATTN
#define FAST_ATTN 1
#endif
#ifndef FAST_GEMM
#define FAST_GEMM 15
#endif
constexpr int PH_PER_LAYER = 10, N_PHASES = 1 + DEPTH * PH_PER_LAYER;
__global__ void __launch_bounds__(NTHREADS, 2) mega(Params parg) {
    extern __shared__ __attribute__((aligned(16))) unsigned char lds[];
    const int lo = parg.ph_lo, hi = parg.ph_hi;
    volatile LAS unsigned* xbw = (volatile LAS unsigned*)(lds + LDS_BYTES - 16);
    if (threadIdx.x == 0) { xbw[0] = 0u; xbw[1] = 0u; xbw[2] = 0u; xbw[3] = 0u; }
    __syncthreads();
    XcdBarrier bar; bar.bar = (unsigned*)(parg.ws + WS_CTL) + CW_BAR; bar.x = 0; bar.st = xbw;
    if (hi - lo > 1) bar = xcd_barrier_post((unsigned*)(parg.ws + WS_CTL) + CW_BAR, xbw);
#ifdef PHMASK
#define IN(k) ((((PHMASK) >> ((k) == 0 ? 0 : ((k) - 1) % PH_PER_LAYER + 1)) & 1) && lo <= (k) && (k) < hi)
#else
#define IN(k) (lo <= (k) && (k) < hi)
#endif
#define SEAM(k) do { if (IN(k) && IN((k) + 1)) xcd_barrier(bar); } while (0)
    if (IN(0)) { ph_pro(kparams(), lds); } SEAM(0);
#pragma unroll
    for (int l = 0; l < DEPTH; ++l) {
        const int b0 = 1 + l * PH_PER_LAYER;
        if (IN(b0 + 0)) { ph_norm1(kparams(), l, lds); } SEAM(b0 + 0);
        if (IN(b0 + 1)) { ph_inproj_f(kparams(), l, lds); } SEAM(b0 + 1);
        if (IN(b0 + 2)) { ph_prep(kparams(), l, lds); } SEAM(b0 + 2);
        if (IN(b0 + 3)) { ph_attn_f(kparams(), l, lds); } SEAM(b0 + 3);
        if (IN(b0 + 4)) { ph_hgrn3(kparams(), l, lds); } SEAM(b0 + 4);
        if (IN(b0 + 5)) { ph_outproj_f(kparams(), l, lds); } SEAM(b0 + 5);
        if (IN(b0 + 6)) { ph_norm2(kparams(), l, lds); } SEAM(b0 + 6);
        if (IN(b0 + 7)) { ph_gateup_f(kparams(), l, lds); } SEAM(b0 + 7);
        if (IN(b0 + 8)) { ph_down_f(kparams(), l, lds); } SEAM(b0 + 8);
        if (IN(b0 + 9)) { ph_combine(kparams(), l, lds); } SEAM(b0 + 9);
    }
#undef IN
#undef SEAM
}

#ifndef MK_ONE_LAUNCH
#define MK_ONE_LAUNCH 1
#endif
extern "C" void kernel_launch(void* const* d_in, const int* in_sizes, int n_in, void* d_out, int out_size, void* d_ws, size_t ws_size, hipStream_t stream) {
    static int grid = 0;
    if (grid == 0) {
        if (n_in != 31 || ws_size < WS_END2) { fprintf(stderr, "kernel_launch: unexpected n_in %d or ws_size %zu (< %zu)\n", n_in, ws_size, (size_t)WS_END2); grid = -1; return; }
        int dev = 0, cus = 0, per_cu = 0;
        if (hipGetDevice(&dev) != hipSuccess || hipDeviceGetAttribute(&cus, hipDeviceAttributeMultiprocessorCount, dev) != hipSuccess) { grid = -1; return; }
        if (hipFuncSetAttribute((const void*)mega, hipFuncAttributeMaxDynamicSharedMemorySize, LDS_BYTES) != hipSuccess) { fprintf(stderr, "kernel_launch: hipFuncSetAttribute failed\n"); grid = -1; return; }
        if (hipOccupancyMaxActiveBlocksPerMultiprocessor(&per_cu, (const void*)mega, NTHREADS, LDS_BYTES) != hipSuccess || per_cu < 1) fprintf(stderr, "kernel_launch: occupancy query says %d\n", per_cu);
        (void)hipGetLastError();
        grid = cus;
    }
    if (grid < 0) return;
    (void)hipMemsetAsync((char*)d_ws + WS_CTL, 0, CTL_ZERO_BYTES, stream);
    Params p{};
    for (int i = 0; i < 31; ++i) p.in[i] = (const float*)d_in[i];
    p.out = (float*)d_out; p.ws = (unsigned char*)d_ws;
#if MK_ONE_LAUNCH
    p.ph_lo = 0; p.ph_hi = N_PHASES;
    hipLaunchKernelGGL(mega, dim3(grid), dim3(NTHREADS), LDS_BYTES, stream, p);
#else
    for (int k = 0; k < N_PHASES; ++k) { p.ph_lo = k; p.ph_hi = k + 1; hipLaunchKernelGGL(mega, dim3(grid), dim3(NTHREADS), LDS_BYTES, stream, p); }
#endif
}
```

```cpp
#include <hip/hip_runtime.h>
#include <hip/hip_bf16.h>
#include <cmath>
#include <cstdint>
#include <cstdio>

#define LAS __attribute__((address_space(3)))

typedef unsigned short bf16_t;
typedef short bf16x8 __attribute__((ext_vector_type(8)));
typedef float f32x4 __attribute__((ext_vector_type(4)));
typedef unsigned u32x4 __attribute__((ext_vector_type(4)));
typedef unsigned u32x2 __attribute__((ext_vector_type(2)));

constexpr int D = 1024, NB = 2, NSEQ = 8192, NCTX = 256, DEPTH = 2;
constexpr int R_LAT = NB * NSEQ, R_CTX = NB * NCTX, R_ALL = R_LAT + R_CTX;
constexpr int DIN = 2816;
constexpr int NKEY = NSEQ + NCTX;
constexpr int NE = 64, TOPK = 8;
constexpr int MAXSLOT = 151552;
constexpr int HROWS = MAXSLOT + R_ALL;
constexpr int NCHUNK = 132;
constexpr float EPS = 1e-6f;
constexpr float TOK8_SCALE = 8.f, WGU8_SCALE = 256.f, H8_SCALE = 16.f, WD8_SCALE = 128.f;
constexpr float GU_DESCALE = 1.f / (TOK8_SCALE * WGU8_SCALE), DN_DESCALE = 1.f / (H8_SCALE * WD8_SCALE);
constexpr float Y8_SCALE = 32.f;
constexpr float QSCALE = 0.125f * 1.4426950408889634f;
constexpr float LOG2E = 1.4426950408889634f;

#ifndef FAST_HGRN
#define FAST_HGRN 1
#endif
constexpr int C_GQ = 0, C_GK = 256, C_GV = 384, C_WQ = 512, C_WK = 768, C_WV = 896, C_CVV = 1024, C_CVG = 1280, C_RQ = 1536, C_RI = 1792, C_RFF = 2048, C_RFB = 2304, C_RG = 2560;

constexpr size_t MiB = (size_t)1 << 20;
constexpr size_t WS_CTL = 0, CTL_ZERO_BYTES = 64 * 1024;
constexpr size_t WS_MOD = 1 * MiB;
constexpr size_t WS_LB = WS_MOD + 256 * 1024;
constexpr size_t WS_ROPE = WS_MOD + 512 * 1024;
constexpr size_t WS_TOKE = 2 * MiB, WS_TOKP = 3 * MiB, WS_TOKW = 4 * MiB, WS_TOKS = 5 * MiB;
constexpr size_t WS_SLOTT = 6 * MiB, WS_SLOTW = 7 * MiB;
constexpr size_t WS_X = 8 * MiB;
constexpr size_t WS_WD = 74 * MiB;
constexpr size_t WS_Z = 107 * MiB;
constexpr size_t Z_A = WS_Z + 0 * MiB;
constexpr size_t Z_WGU = WS_Z + 33 * MiB;
constexpr size_t Z_WIN = WS_Z + 98 * MiB;
constexpr size_t Z_WOUT = WS_Z + 104 * MiB;
constexpr size_t Z_WPW = WS_Z + 106 * MiB;
__host__ __device__ constexpr size_t wgu_off(int l) { return WS_Z + 33 * MiB + (size_t)l * 34078720; }
__host__ __device__ constexpr size_t wd_off(int l) { return 74 * MiB + (size_t)l * 17039360; }
__host__ __device__ constexpr size_t win_off(int l) { return l == 0 ? WS_Z + 98 * MiB : WS_Z + (302 + 42) * MiB; }
__host__ __device__ constexpr size_t wout_off(int l) { return l == 0 ? WS_Z + 104 * MiB : WS_Z + (302 + 48) * MiB; }
__host__ __device__ constexpr size_t wpw_off(int l) { return l == 0 ? WS_Z + 106 * MiB : WS_Z + (302 + 51) * MiB; }
constexpr size_t Z_P = WS_Z + 107 * MiB;
constexpr size_t Z_YCAT = WS_Z + 198 * MiB;
constexpr size_t Z_QG = WS_Z + 231 * MiB, Z_QW = WS_Z + 239 * MiB;
constexpr size_t Z_KG = WS_Z + 247 * MiB, Z_VG = WS_Z + 252 * MiB, Z_KW = WS_Z + 257 * MiB, Z_VW = WS_Z + 262 * MiB;
constexpr size_t Z_QGC = WS_Z + 267 * MiB, Z_QWC = Z_QGC + 512 * 1024;
constexpr size_t Z_U = WS_Z + 268 * MiB;
constexpr size_t Z_G = WS_Z + 301 * MiB;
constexpr size_t Z_Y = WS_Z + 107 * MiB;
constexpr size_t Z_H = WS_Z + 302 * MiB;
constexpr size_t WS_END = WS_Z + 385 * MiB;
constexpr size_t WS_EXPL = WS_END, WS_EXPW = WS_END + 5 * MiB, WS_END2 = WS_END + 10 * MiB;
static_assert(Z_H + (size_t)HROWS * 512 <= WS_END, "H fits");
static_assert(Z_Y + (size_t)MAXSLOT * 1024 <= Z_U, "Y8 below the HGRN state buffers");
static_assert(Z_P + (size_t)R_ALL * DIN * 2 <= Z_YCAT, "P fits");

constexpr int CW_BAR = 0;
constexpr int CW_CNT = 4096;

constexpr int LDS_BYTES = 147456;
constexpr int NTHREADS = 512;

struct Params {
    const float* in[31];
    float* out;
    unsigned char* ws;
    int ph_lo, ph_hi;
};

typedef const __attribute__((address_space(4))) Params* KP;
__device__ __forceinline__ KP kparams() { KP k = (KP)__builtin_amdgcn_kernarg_segment_ptr(); asm volatile("" : "+s"(k)); return k; }

__device__ __forceinline__ int tid_() { int t = threadIdx.x; asm volatile("" : "+v"(t)); return t; }
__device__ __forceinline__ int bid_() { int b = blockIdx.x; asm volatile("" : "+s"(b)); return b; }
__device__ __forceinline__ int gsz_() { int g = gridDim.x; asm volatile("" : "+s"(g)); return g; }

__device__ __forceinline__ unsigned f2bf(float f) { unsigned u = __float_as_uint(f); return (u + 0x7fffu + ((u >> 16) & 1u)) >> 16; }
__device__ __forceinline__ float bf2f(unsigned h) { return __uint_as_float(h << 16); }
__device__ __forceinline__ unsigned pk2(float lo, float hi) { unsigned r; asm("v_cvt_pk_bf16_f32 %0, %1, %2" : "=v"(r) : "v"(lo), "v"(hi)); return r; }
__device__ __forceinline__ void unpack8(const u32x4 r, f32x4& lo, f32x4& hi) { lo.x = bf2f(r.x & 0xffffu); lo.y = bf2f(r.x >> 16); lo.z = bf2f(r.y & 0xffffu); lo.w = bf2f(r.y >> 16); hi.x = bf2f(r.z & 0xffffu); hi.y = bf2f(r.z >> 16); hi.z = bf2f(r.w & 0xffffu); hi.w = bf2f(r.w >> 16); }
__device__ __forceinline__ float wave_sum(float v) {
#pragma unroll
    for (int o = 1; o < 64; o <<= 1) v += __shfl_xor(v, o);
    return v;
}
__device__ __forceinline__ float clamp8(float v) { return fminf(fmaxf(v, -440.f), 440.f); }
__device__ __forceinline__ float sigmoid_(float x) { return __builtin_amdgcn_rcpf(1.f + __expf(-x)); }
__device__ __forceinline__ float silu_(float x) { return x * sigmoid_(x); }

__device__ __forceinline__ const float* xrow_src(KP p, int l, int row) {
    if (l == 0) return (row < R_LAT) ? p->in[0] + (size_t)row * D : p->in[2] + (size_t)(row - R_LAT) * D;
    return (const float*)(p->ws + WS_X) + (size_t)row * D;
}
__device__ __forceinline__ const float* mod_vec(KP p, int l, int row, int i) {
    const int r = (row < R_LAT) ? (row >> 13) : 2;
    return (const float*)(p->ws + WS_MOD) + ((size_t)l * 3 + r) * 6144 + i * 1024;
}

#define XB_TMO      128
#define XB_XCNT(j)  (256  + 64 * (j))
#define XB_XSUB(j)  (1280 + 64 * (j))
#define XB_XGEN(j)  (2304 + 64 * (j))
#define XB_TOP      3328
#define XB_TOPGEN   3392
#define XCD_BAR_WORDS 3456
#define XB_SPIN_CAP (1u << 18)
__device__ __forceinline__ unsigned xb_ld(unsigned* p)              { return __hip_atomic_load(p, __ATOMIC_RELAXED, __HIP_MEMORY_SCOPE_AGENT); }
__device__ __forceinline__ unsigned xb_add(unsigned* p, unsigned v) { return __hip_atomic_fetch_add(p, v, __ATOMIC_RELAXED, __HIP_MEMORY_SCOPE_AGENT); }
__device__ __forceinline__ unsigned xb_xcc_id() { return (unsigned)__builtin_amdgcn_s_getreg((3 << 11) | 20) & 0xFu; }
#define XB_SPIN(cond, bar) do { unsigned _sp = 0; while (cond) { __builtin_amdgcn_s_sleep(1); \
    if ((++_sp & 255u) == 0u) { if (xb_ld(&(bar)[XB_TMO])) break; if (_sp > XB_SPIN_CAP) { atomicAdd(&(bar)[XB_TMO], 1u); break; } } } } while (0)
struct XcdBarrier { unsigned* bar; unsigned x; volatile LAS unsigned* st; };
__device__ __forceinline__ XcdBarrier xcd_barrier_post(unsigned* bar, volatile LAS unsigned* st) {
    XcdBarrier b; b.bar = bar; b.x = xb_xcc_id(); b.st = st;
    if (threadIdx.x == 0) (void)xb_add(&bar[XB_XCNT(b.x)], 1u);
    return b;
}
__device__ __forceinline__ void xcd_barrier_complete(unsigned* bar, unsigned x, unsigned& nloc, unsigned& nx) {
    const unsigned G = gridDim.x * gridDim.y * gridDim.z;
    unsigned sum, cnt, mine, sp = 0u;
    for (;;) {
        sum = 0u; cnt = 0u; mine = 0u;
#pragma unroll
        for (unsigned j = 0; j < 16; ++j) { const unsigned c = xb_ld(&bar[XB_XCNT(j)]); sum += c; cnt += (c > 0u) ? 1u : 0u; mine = (j == x) ? c : mine; }
        if (sum == G) break;
        __builtin_amdgcn_s_sleep(1);
        if ((++sp & 255u) == 0u) { if (xb_ld(&bar[XB_TMO])) break; if (sp > XB_SPIN_CAP) { atomicAdd(&bar[XB_TMO], 1u); break; } }
    }
    nloc = mine > 0u ? mine : 1u; nx = cnt > 0u ? cnt : 1u;
}
__device__ __forceinline__ void xcd_barrier(const XcdBarrier& b) {
    asm volatile("s_waitcnt vmcnt(0)" ::: "memory");
    __syncthreads();
    if (threadIdx.x == 0) {
        unsigned* bar = b.bar;
        __builtin_amdgcn_s_waitcnt(0);
        unsigned nloc = b.st[0], nx = b.st[1];
        if (nloc == 0u) { xcd_barrier_complete(bar, b.x, nloc, nx); b.st[0] = nloc; b.st[1] = nx; }
        const unsigned old = xb_add(&bar[XB_XSUB(b.x)], 1u);
        const unsigned gen = old / nloc;
        if (old + 1u == (gen + 1u) * nloc) {
            __builtin_amdgcn_fence(__ATOMIC_RELEASE, "agent");
            asm volatile("s_waitcnt vmcnt(0)" ::: "memory");
            const unsigned og = xb_add(&bar[XB_TOP], 1u);
            const unsigned tg = og / nx;
            if (og + 1u == (tg + 1u) * nx) xb_add(&bar[XB_TOPGEN], 1u);
            else XB_SPIN(xb_ld(&bar[XB_TOPGEN]) == tg, bar);
            __builtin_amdgcn_fence(__ATOMIC_ACQUIRE, "agent");
            xb_add(&bar[XB_XGEN(b.x)], 1u);
            asm volatile("s_waitcnt vmcnt(0)" ::: "memory");
        } else {
            XB_SPIN(xb_ld(&bar[XB_XGEN(b.x)]) == gen, bar);
            __builtin_amdgcn_fence(__ATOMIC_ACQUIRE, "agent");
            asm volatile("s_waitcnt vmcnt(0)" ::: "memory");
        }
    }
    __syncthreads();
}

__device__ __forceinline__ void ph_pro(KP p, unsigned char* lds) {
    float* sc = (float*)lds;
    float* red = sc + 3 * 1024;
    const int tid = tid_(), lane = tid & 63, wid = tid >> 6;
    for (int i = tid; i < 3 * 1024; i += NTHREADS) { const int r = i >> 10, k = i & 1023; const float v = (r < 2) ? p->in[1][r * 1024 + k] : p->in[3][k]; sc[i] = silu_(v); }
    __syncthreads();
    float* mod = (float*)(p->ws + WS_MOD);
    for (int item = bid_(); item < DEPTH * 96; item += gsz_()) {
        const int l = item / 96, j0 = (item % 96) * 64;
        const float* w = p->in[4] + (size_t)l * 1024 * 6144;
        float a0 = 0.f, a1 = 0.f, a2 = 0.f;
        const int k0 = wid * 128;
#pragma unroll 1
        for (int k = k0; k < k0 + 128; k += 16) { float wv[16];
#pragma unroll
            for (int u = 0; u < 16; ++u) wv[u] = w[(size_t)(k + u) * 6144 + j0 + lane];
#pragma unroll
            for (int u = 0; u < 16; ++u) { a0 += sc[k + u] * wv[u]; a1 += sc[1024 + k + u] * wv[u]; a2 += sc[2048 + k + u] * wv[u]; } }
        red[(wid * 3 + 0) * 64 + lane] = a0; red[(wid * 3 + 1) * 64 + lane] = a1; red[(wid * 3 + 2) * 64 + lane] = a2;
        __syncthreads();
        if (tid < 192) { const int r = tid >> 6; float s = 0.f;
            for (int w8 = 0; w8 < 8; ++w8) s += red[(w8 * 3 + r) * 64 + lane];
            mod[((size_t)l * 3 + r) * 6144 + j0 + lane] = s + p->in[5][l * 6144 + j0 + lane]; }
        __syncthreads();
    }
    if (bid_() == 0) {
        float* rt = (float*)(p->ws + WS_ROPE);
        for (int i = tid; i < 128 * 16; i += NTHREADS) { const int pos = i >> 4, f = i & 15; const float inv = powf(10000.f, -(float)f * (1.f / 16.f)); float sn, cs; sincosf((float)pos * inv, &sn, &cs);
            rt[pos * 32 + f] = cs; rt[pos * 32 + 16 + f] = sn; }
    }
    if (bid_() == gsz_() - 1) {
        float* lb = (float*)(p->ws + WS_LB);
        for (int i = tid; i < 2 * 2 * 256; i += NTHREADS) { const int l = i >> 9, dir = (i >> 8) & 1, ch = i & 255;
            const float* lg = p->in[21];
            const float l0 = lg[(dir * 2 + 0) * 256 + ch], l1 = lg[(dir * 2 + 1) * 256 + ch]; const float m = fmaxf(l0, l1);
            const float e0 = expf(l0 - m), e1 = expf(l1 - m);
            lb[i] = (l == 0) ? 0.f : e1 / (e0 + e1); }
    }
}

constexpr int CVT_E1 = 1050, CVT_E2 = 2850;
struct CvtTile { const float* src; bf16_t* dst; int K, N, k0, n0, blk, bstride, boff; float f8scale; };
__device__ __forceinline__ int cvt_total() { return 16 * 44 + 16 * 16 + 4 * 4 + 2 * (64 * 64) + 2 * 64 + 64 * 64 + 64; }
__device__ __forceinline__ CvtTile cvt_decode(KP p, int l, int g) {
    bf16_t* Wgu = (bf16_t*)(p->ws + wgu_off(l)); bf16_t* Wd = (bf16_t*)(p->ws + wd_off(l));
    CvtTile t; int per, tn, r;
    if (g < 704) { r = g; t = {p->in[8] + (size_t)l * 1024 * DIN, (bf16_t*)(p->ws + win_off(l)), 1024, DIN, 0, 0, DIN, 0, 0, 0.f}; tn = 44; per = 704; }
    else if ((g -= 704) < 256) { r = g; t = {p->in[9] + (size_t)l * 1024 * 1024, (bf16_t*)(p->ws + wout_off(l)), 1024, 1024, 0, 0, 1024, 0, 0, 0.f}; tn = 16; per = 256; }
    else if ((g -= 256) < 16) { r = g; t = {p->in[19] + (size_t)l * 65536, (bf16_t*)(p->ws + wpw_off(l)), 256, 256, 0, 0, 256, 0, 0, 0.f}; tn = 4; per = 16; }
    else if ((g -= 16) < 4096) { const int m = g >> 6; r = g & 63; t = {p->in[25] + ((size_t)l * 64 + m) * 262144, (bf16_t*)((unsigned char*)Wgu + (size_t)m * 524288), 1024, 256, 0, 0, 128, 256, 0, WGU8_SCALE}; tn = 4; per = 64; }
    else if ((g -= 4096) < 4096) { const int m = g >> 6; r = g & 63; t = {p->in[26] + ((size_t)l * 64 + m) * 262144, (bf16_t*)((unsigned char*)Wgu + (size_t)m * 524288), 1024, 256, 0, 0, 128, 256, 128, WGU8_SCALE}; tn = 4; per = 64; }
    else if ((g -= 4096) < 64) { r = g; t = {p->in[28] + (size_t)l * 262144, (bf16_t*)((unsigned char*)Wgu + (size_t)64 * 524288), 1024, 256, 0, 0, 128, 256, 0, WGU8_SCALE}; tn = 4; per = 64; }
    else if ((g -= 64) < 64) { r = g; t = {p->in[29] + (size_t)l * 262144, (bf16_t*)((unsigned char*)Wgu + (size_t)64 * 524288), 1024, 256, 0, 0, 128, 256, 128, WGU8_SCALE}; tn = 4; per = 64; }
    else if ((g -= 64) < 4096) { const int m = g >> 6; r = g & 63; t = {p->in[27] + ((size_t)l * 64 + m) * 262144, (bf16_t*)((unsigned char*)Wd + (size_t)m * 262144), 256, 1024, 0, 0, 1024, 0, 0, WD8_SCALE}; tn = 16; per = 64; }
    else { g -= 4096; r = g; t = {p->in[30] + (size_t)l * 262144, (bf16_t*)((unsigned char*)Wd + (size_t)64 * 262144), 256, 1024, 0, 0, 1024, 0, 0, WD8_SCALE}; tn = 16; per = 64; }
    (void)per; t.k0 = (r / tn) * 64; t.n0 = (r % tn) * 64; return t;
}
__device__ __forceinline__ void ph_cvt(KP p, int l, unsigned char* lds, int first = 0, int nwg = 0, int t0 = 0, int t1 = 1 << 30) {
    float* tb = (float*)lds;
    const int tid = tid_(), G = nwg ? nwg : gsz_(), total = t1 < cvt_total() ? t1 : cvt_total();
    const int r0 = tid >> 4, c0 = (tid & 15) * 4, nn = tid >> 3, kc = (tid & 7) * 8;
    int g = bid_() - first, buf = 0;
    if (g < 0) return;
    g += t0;
    if (g >= total) return;
    CvtTile T = cvt_decode(p, l, g);
    f32x4 v0 = *(const f32x4*)(T.src + (size_t)(T.k0 + r0) * T.N + T.n0 + c0), v1 = *(const f32x4*)(T.src + (size_t)(T.k0 + r0 + 32) * T.N + T.n0 + c0);
    for (;;) {
        float* t = tb + buf * (64 * 65);
        t[r0 * 65 + c0] = v0.x; t[r0 * 65 + c0 + 1] = v0.y; t[r0 * 65 + c0 + 2] = v0.z; t[r0 * 65 + c0 + 3] = v0.w;
        t[(r0 + 32) * 65 + c0] = v1.x; t[(r0 + 32) * 65 + c0 + 1] = v1.y; t[(r0 + 32) * 65 + c0 + 2] = v1.z; t[(r0 + 32) * 65 + c0 + 3] = v1.w;
        const CvtTile C = T; const int gn = g + G; const bool more = gn < total;
        if (more) { T = cvt_decode(p, l, gn);
            v0 = *(const f32x4*)(T.src + (size_t)(T.k0 + r0) * T.N + T.n0 + c0); v1 = *(const f32x4*)(T.src + (size_t)(T.k0 + r0 + 32) * T.N + T.n0 + c0); }
        __syncthreads();
        { const int n = C.n0 + nn; const int drow = (n / C.blk) * C.bstride + C.boff + (n % C.blk);
          if (C.f8scale != 0.f) { const float sc = C.f8scale;
              int w0 = __builtin_amdgcn_cvt_pk_fp8_f32(clamp8(t[(kc + 0) * 65 + nn] * sc), clamp8(t[(kc + 1) * 65 + nn] * sc), 0, false); w0 = __builtin_amdgcn_cvt_pk_fp8_f32(clamp8(t[(kc + 2) * 65 + nn] * sc), clamp8(t[(kc + 3) * 65 + nn] * sc), w0, true);
              int w1 = __builtin_amdgcn_cvt_pk_fp8_f32(clamp8(t[(kc + 4) * 65 + nn] * sc), clamp8(t[(kc + 5) * 65 + nn] * sc), 0, false); w1 = __builtin_amdgcn_cvt_pk_fp8_f32(clamp8(t[(kc + 6) * 65 + nn] * sc), clamp8(t[(kc + 7) * 65 + nn] * sc), w1, true);
              u32x2 o8; o8.x = (unsigned)w0; o8.y = (unsigned)w1;
              *(u32x2*)((unsigned char*)C.dst + (size_t)drow * C.K + C.k0 + kc) = o8;
          } else {
          u32x4 o; o.x = pk2(t[(kc + 0) * 65 + nn], t[(kc + 1) * 65 + nn]); o.y = pk2(t[(kc + 2) * 65 + nn], t[(kc + 3) * 65 + nn]);
          o.z = pk2(t[(kc + 4) * 65 + nn], t[(kc + 5) * 65 + nn]); o.w = pk2(t[(kc + 6) * 65 + nn], t[(kc + 7) * 65 + nn]);
          *(u32x4*)(C.dst + (size_t)drow * C.K + C.k0 + kc) = o; } }
        if (!more) break;
        g = gn; buf ^= 1;
    }
    __syncthreads();
}
__device__ __forceinline__ void norm_mod_row(const float* xrow, const float* g, const float* shift, const float* scale, bf16_t* orow, float* fout, int lane) {
    f32x4 v[4]; float s = 0.f;
#pragma unroll
    for (int j = 0; j < 4; ++j) { v[j] = ((const f32x4*)xrow)[lane + 64 * j]; s += v[j].x * v[j].x + v[j].y * v[j].y + v[j].z * v[j].z + v[j].w * v[j].w; }
    const float rinv = rsqrtf(wave_sum(s) * (1.f / D) + EPS);
#pragma unroll
    for (int j = 0; j < 4; ++j) { const int idx = lane + 64 * j;
        const f32x4 gg = ((const f32x4*)g)[idx], sh = ((const f32x4*)shift)[idx], sc = ((const f32x4*)scale)[idx];
        f32x4 y; y.x = v[j].x * rinv * gg.x * (1.f + sc.x) + sh.x; y.y = v[j].y * rinv * gg.y * (1.f + sc.y) + sh.y;
        y.z = v[j].z * rinv * gg.z * (1.f + sc.z) + sh.z; y.w = v[j].w * rinv * gg.w * (1.f + sc.w) + sh.w;
        u32x2 o; o.x = pk2(y.x, y.y); o.y = pk2(y.z, y.w);
        ((u32x2*)orow)[idx] = o;
        if (fout) ((f32x4*)fout)[idx] = y; }
}
__device__ __forceinline__ void ph_norm1(KP p, int l, unsigned char* lds) {
    if (l == 0) ph_cvt(p, l, lds);
    const int tid = tid_(), lane = tid & 63, wid = tid >> 6;
    bf16_t* A = (bf16_t*)(p->ws + Z_A);
    const float* g = p->in[6] + l * D;
    if (l == 0) { for (int row = bid_() * 8 + wid; row < R_ALL; row += gsz_() * 8)
        norm_mod_row(xrow_src(p, l, row), g, mod_vec(p, l, row, 0), mod_vec(p, l, row, 1), A + (size_t)row * D, nullptr, lane); }
    else { const bf16_t* X = (const bf16_t*)(p->ws + WS_X);
        for (int row = bid_() * 8 + wid; row < R_ALL; row += gsz_() * 8) {
            const float* shift = mod_vec(p, l, row, 0); const float* scale = mod_vec(p, l, row, 1);
            f32x4 v[4]; unpack8(*(const u32x4*)(X + (size_t)row * D + lane * 8), v[0], v[1]); unpack8(*(const u32x4*)(X + (size_t)row * D + 512 + lane * 8), v[2], v[3]);
            float ss = 0.f;
#pragma unroll
            for (int j = 0; j < 4; ++j) ss += v[j].x * v[j].x + v[j].y * v[j].y + v[j].z * v[j].z + v[j].w * v[j].w;
            const float rinv = rsqrtf(wave_sum(ss) * (1.f / D) + EPS);
#pragma unroll
            for (int h = 0; h < 2; ++h) { const int c0 = h * 512 + lane * 8; unsigned o[4];
#pragma unroll
                for (int q = 0; q < 2; ++q) { const f32x4 gg = *(const f32x4*)(g + c0 + 4 * q), sh = *(const f32x4*)(shift + c0 + 4 * q), sc = *(const f32x4*)(scale + c0 + 4 * q);
                    const f32x4 y = v[2 * h + q] * rinv * gg * (sc + 1.f) + sh; o[2 * q] = pk2(y.x, y.y); o[2 * q + 1] = pk2(y.z, y.w); }
                *(u32x4*)(A + (size_t)row * D + c0) = (u32x4){o[0], o[1], o[2], o[3]}; } } }
}

template <int NBJ, class ARow, class Epi>
__device__ __forceinline__ void gemm_simple_tile(const bf16_t* A, const ARow& arow, const bf16_t* Bt, int K, int row0, int colb0, int bjstride, const Epi& epi) {
    const int tid = tid_(), lane = tid & 63, wid = tid >> 6, wr = wid >> 1, wc = wid & 1, fr = lane & 15, fq = lane >> 4;
    f32x4 acc[2][NBJ][4];
#pragma unroll
    for (int i = 0; i < 2; ++i)
#pragma unroll
        for (int b = 0; b < NBJ; ++b)
#pragma unroll
            for (int j = 0; j < 4; ++j) acc[i][b][j] = (f32x4){0.f, 0.f, 0.f, 0.f};
    const bf16_t* ap[2];
#pragma unroll
    for (int i = 0; i < 2; ++i) ap[i] = A + (size_t)arow(row0 + wr * 32 + i * 16 + fr) * K + fq * 8;
    const bf16_t* bp = Bt + (size_t)(colb0 + wc * 64 + fr) * K + fq * 8;
    for (int k = 0; k < K; k += 32) {
        bf16x8 a[2];
#pragma unroll
        for (int i = 0; i < 2; ++i) a[i] = *(const bf16x8*)(ap[i] + k);
#pragma unroll
        for (int b = 0; b < NBJ; ++b)
#pragma unroll
            for (int j = 0; j < 4; ++j) { const bf16x8 bv = *(const bf16x8*)(bp + (size_t)(b * bjstride + j * 16) * K + k);
#pragma unroll
                for (int i = 0; i < 2; ++i) acc[i][b][j] = __builtin_amdgcn_mfma_f32_16x16x32_bf16(a[i], bv, acc[i][b][j], 0, 0, 0); }
    }
#pragma unroll
    for (int i = 0; i < 2; ++i)
#pragma unroll
        for (int j = 0; j < 4; ++j)
#pragma unroll
            for (int r = 0; r < 4; ++r) { const int row = row0 + wr * 32 + i * 16 + fq * 4 + r, col = wc * 64 + j * 16 + fr;
                epi(row, col, acc[i][0][j][r], acc[i][NBJ - 1][j][r]); }
}
struct RowId { __device__ __forceinline__ int operator()(int r) const { return r; } };
struct RowGather { const int* idx; __device__ __forceinline__ int operator()(int r) const { return idx[r]; } };

__device__ __forceinline__ void ph_inproj(KP p, int l, unsigned char* lds) {
    const bf16_t* A = (const bf16_t*)(p->ws + Z_A); const bf16_t* Bt = (const bf16_t*)(p->ws + Z_WIN); bf16_t* P = (bf16_t*)(p->ws + Z_P);
    constexpr int TM = R_ALL / 128, TN = DIN / 128;
    for (int it = bid_(); it < TM * TN; it += gsz_()) { const int mt = it / TN, nt = it % TN;
        auto epi = [&](int row, int col, float v, float) { P[(size_t)row * DIN + nt * 128 + col] = (bf16_t)f2bf(v); };
        gemm_simple_tile<1>(A, RowId{}, Bt, 1024, mt * 128, nt * 128, 0, epi); }
}

namespace pg8 {
constexpr int BM = 256, BK = 64, HALF = 128, HTB = HALF * BK * 2, STAGE_BYTES = 8 * HTB, NXCD = 8, WGM = 8;
__host__ __device__ __forceinline__ int lds_byte(int r, int c) { const int st = (r >> 4) * 2 + (c >> 5), rr = r & 15, cc = c & 31, ob = rr * 64 + cc * 2; return st * 1024 + (ob ^ (((ob >> 9) & 1) << 5)); }
__host__ __device__ __forceinline__ void stage_rc(int b, int& R, int& C) { const int st = b / 1024, sb = b % 1024, swz = sb ^ (((sb >> 9) & 1) << 5); R = (st >> 1) * 16 + swz / 64; C = (st & 1) * 32 + (swz % 64) / 2; }
__host__ __device__ __forceinline__ int perm32(int rho) { const int n = rho >> 4, i = rho & 15; return 8 * (i >> 2) + 4 * n + (i & 3); }
struct Unit { int pm, pn, ord; };
struct Gemm { const bf16_t* A; const bf16_t* Bt; int M, N, K; };
struct StaticOrder {
    int nM, nN, nwg, G, c;
    __host__ __device__ void init(int M, int N, int G_, int c_) { nM = M / BM; nN = N / BM; nwg = nM * nN; G = G_; c = c_; }
    __host__ __device__ bool next(int i, Unit& u) const {
        const long L = (long)i * G + c; if (L >= nwg) return false;
        int wgid = (int)L; { const int q = nwg / NXCD, r = nwg % NXCD, xcd = wgid % NXCD, off = wgid / NXCD; wgid = (xcd < r ? xcd * (q + 1) : r * (q + 1) + (xcd - r) * q) + off; }
        const int nig = WGM * nN, gid = wgid / nig, fm = gid * WGM, gsz = (nM - fm) < WGM ? (nM - fm) : WGM;
        u.pm = fm + ((wgid % nig) % gsz); u.pn = (wgid % nig) / gsz; u.ord = i; return true;
    }
};
__device__ __forceinline__ unsigned cvt_pk_bf16(float lo, float hi) { unsigned r; asm volatile("v_cvt_pk_bf16_f32 %0, %1, %2" : "=v"(r) : "v"(lo), "v"(hi)); return r; }

typedef int i32x4v __attribute__((ext_vector_type(4)));
typedef int i32x8v __attribute__((ext_vector_type(8)));
__device__ __forceinline__ i32x8v cat8(bf16x8 lo, bf16x8 hi) { const i32x4v a = __builtin_bit_cast(i32x4v, lo), b = __builtin_bit_cast(i32x4v, hi); return __builtin_shufflevector(a, b, 0, 1, 2, 3, 4, 5, 6, 7); }
__device__ __forceinline__ void glds16_s(const void* sbase, unsigned voff, unsigned lds_dst) { unsigned keep;
    asm volatile("s_mov_b32 %0, m0\n\ts_mov_b32 m0, %3\n\ts_nop 0\n\tglobal_load_lds_dwordx4 %1, %2\n\ts_mov_b32 m0, %0" : "=&s"(keep) : "v"(voff), "s"(sbase), "s"(lds_dst) : "memory"); }
template <class Epi, class Sched, bool GATHER, bool FP8 = false>
__device__ __forceinline__ void gemm_phase(LAS unsigned char* lds, const Gemm g, const Sched& S, const Epi& E, const LAS int* rtab) {
    const int tid = tid_(), wid = __builtin_amdgcn_readfirstlane(tid >> 6), lane = tid & 63, wr = wid >> 2, wc = wid & 3, fr = lane & 15, fq = lane >> 4;
    const int KB = FP8 ? g.K : g.K * 2, nt = KB / 128;
    unsigned voffA[2], voffB[2]; int RA[2], CA[2];
#pragma unroll
    for (int i = 0; i < 2; ++i) { int R, C; stage_rc(tid * 16 + i * 8192, R, C); const int Rb = (R & ~31) + perm32(R & 31);
        voffA[i] = (unsigned)(R * KB + C * 2); voffB[i] = (unsigned)(Rb * KB + C * 2); RA[i] = R; CA[i] = C; }
    unsigned rcpk = 0; if constexpr (GATHER) { rcpk = (unsigned)(RA[0] * 4) | ((unsigned)(CA[0] * 2) << 16); asm volatile("" : "+v"(rcpk)); }
    const size_t kstep = (size_t)128;
    const size_t hstep = (size_t)HALF * KB;
    const size_t hstepA = GATHER ? 0 : hstep;
    const size_t tstep = 2 * hstep;
    const unsigned ldsw = (unsigned)wid * 1024u;
    const unsigned ldsb = (unsigned)__builtin_amdgcn_readfirstlane((int)((unsigned)(size_t)lds + ldsw));
    const int aoff = lds_byte(wr * 64 + fr, fq * 8), boff = lds_byte(wc * 32 + fr, fq * 8);
#define PG8_SA(b, h) (((b) * 2 + (h)) * HTB)
#define PG8_SB(b, h) ((4 + (b) * 2 + (h)) * HTB)
#define PG8_STAGE(bufoff, gbase, voff) do { _Pragma("unroll") for (int _i = 0; _i < 2; ++_i) { if constexpr (FP8) glds16_s((const void*)(gbase), (voff)[_i], ldsb + (unsigned)((bufoff) + _i * 8192)); \
        else __builtin_amdgcn_global_load_lds((const unsigned*)((const char*)(gbase) + (voff)[_i]), (LAS unsigned*)(lds + (bufoff) + ldsw + _i * 8192), 16, 0, 0); } } while (0)
#define PG8_LDA(dst, b, h) do { _Pragma("unroll") for (int m = 0; m < 4; ++m) { if constexpr (FP8) dst##8[m] = cat8(*(const LAS bf16x8*)(lds + PG8_SA(b, h) + aoff + m * 2048), *(const LAS bf16x8*)(lds + PG8_SA(b, h) + aoff + m * 2048 + 1024)); \
        else { _Pragma("unroll") for (int k = 0; k < 2; ++k) dst[m][k] = *(const LAS bf16x8*)(lds + PG8_SA(b, h) + aoff + m * 2048 + k * 1024); } } } while (0)
#define PG8_LDB(dst, b, h) do { _Pragma("unroll") for (int n = 0; n < 2; ++n) { if constexpr (FP8) dst##8[n] = cat8(*(const LAS bf16x8*)(lds + PG8_SB(b, h) + boff + n * 2048), *(const LAS bf16x8*)(lds + PG8_SB(b, h) + boff + n * 2048 + 1024)); \
        else { _Pragma("unroll") for (int k = 0; k < 2; ++k) dst[n][k] = *(const LAS bf16x8*)(lds + PG8_SB(b, h) + boff + n * 2048 + k * 1024); } } } while (0)
#define PG8_MMA(ai, bj, At, Bt) do { __builtin_amdgcn_s_setprio(1); _Pragma("unroll") for (int m = 0; m < 4; ++m) _Pragma("unroll") for (int n = 0; n < 2; ++n) { \
        if constexpr (FP8) acc[ai][bj][m][n] = __builtin_amdgcn_mfma_scale_f32_16x16x128_f8f6f4(Bt##8[n], At##8[m], acc[ai][bj][m][n], 0, 0, 0, 0x7F7F7F7F, 0, 0x7F7F7F7F); \
        else { _Pragma("unroll") for (int k = 0; k < 2; ++k) acc[ai][bj][m][n] = __builtin_amdgcn_mfma_f32_16x16x32_bf16(Bt[n][k], At[m][k], acc[ai][bj][m][n], 0, 0, 0); } } \
        if constexpr (FP8) { asm volatile("" : "+v"(acc[ai][bj][0][0]), "+v"(acc[ai][bj][0][1]), "+v"(acc[ai][bj][1][0]), "+v"(acc[ai][bj][1][1]), "+v"(acc[ai][bj][2][0]), "+v"(acc[ai][bj][2][1]), "+v"(acc[ai][bj][3][0]), "+v"(acc[ai][bj][3][1])); } \
        __builtin_amdgcn_s_setprio(0); } while (0)
#define PG8_WAIT_V(n) asm volatile("s_waitcnt vmcnt(" #n ")" ::: "memory")
#define PG8_WAIT_L(n) asm volatile("s_waitcnt lgkmcnt(" #n ")" ::: "memory")
#define PG8_BAR __builtin_amdgcn_s_barrier()
#define PG8_SCHED __builtin_amdgcn_sched_barrier(0)
#define PG8_STAGE_A(bufoff, gbase, ord, h) do { unsigned _o[2]; if constexpr (GATHER) {   \
            unsigned _pk = rcpk; asm volatile("" : "+v"(_pk));   \
            const LAS unsigned char* _rp = (const LAS unsigned char*)rtab + ((ord) * 1024 + (h) * 512) + (_pk & 0xffffu); const unsigned _c2 = _pk >> 16; \
            _Pragma("unroll") for (int _i = 0; _i < 2; ++_i) _o[_i] = __umul24((unsigned)*(const LAS int*)(_rp + _i * 256), (unsigned)KB) + _c2; } \
        else { _o[0] = voffA[0]; _o[1] = voffA[1]; } PG8_STAGE(bufoff, gbase, _o); } while (0)
    Unit cur, nxt; int ui = 0;
    if (!S.next(0, cur)) return;
    f32x4 acc[2][2][4][2];
#pragma unroll
    for (int a = 0; a < 2; ++a)
#pragma unroll
        for (int b = 0; b < 2; ++b)
#pragma unroll
            for (int m = 0; m < 4; ++m)
#pragma unroll
                for (int n = 0; n < 2; ++n) acc[a][b][m][n] = (f32x4){0.f, 0.f, 0.f, 0.f};
    bf16x8 At[4][2], B0[2][2], B1[2][2]; i32x8v At8[4], B08[2], B18[2];
    const char* cA = GATHER ? (const char*)g.A : (const char*)g.A + (size_t)cur.pm * tstep; const char* cB = (const char*)g.Bt + (size_t)cur.pn * tstep;
    PG8_STAGE(PG8_SB(0, 0), cB, voffB); PG8_STAGE(PG8_SB(0, 1), cB + hstep, voffB); PG8_STAGE_A(PG8_SA(0, 0), cA, 0, 0); PG8_STAGE_A(PG8_SA(0, 1), cA + hstepA, 0, 1);
    if (wr == 1) PG8_BAR;
    PG8_WAIT_V(2); PG8_BAR;
    PG8_STAGE(PG8_SB(1, 0), cB + kstep, voffB); PG8_STAGE_A(PG8_SA(1, 0), cA + kstep, 0, 0); PG8_STAGE(PG8_SB(1, 1), cB + hstep + kstep, voffB);
    PG8_WAIT_V(6); PG8_BAR;
    for (;;) {
        const bool has_next = S.next(ui + 1, nxt);
        const char* nA = GATHER ? (const char*)g.A : (has_next ? (const char*)g.A + (size_t)nxt.pm * tstep : cA); const char* nB = has_next ? (const char*)g.Bt + (size_t)nxt.pn * tstep : cB;
#pragma unroll 1
        for (int t = 0; t < nt; t += 2) {
            const bool last = (t == nt - 2);
            const char* a1 = cA + (size_t)(t + 1) * kstep;
            const char* a2 = last ? nA : cA + (size_t)(t + 2) * kstep; const char* b2 = last ? nB : cB + (size_t)(t + 2) * kstep;
            const char* a3 = a2 + kstep; const char* b3 = b2 + kstep;
            const int on = (last && has_next) ? ui + 1 : ui;
            PG8_LDB(B0, 0, 0); PG8_LDB(B1, 0, 1); PG8_SCHED; PG8_LDA(At, 0, 0); PG8_STAGE_A(PG8_SA(1, 1), a1 + hstepA, ui, 1);
            PG8_WAIT_V(8); PG8_WAIT_L(0); PG8_BAR; PG8_MMA(0, 0, At, B0); PG8_MMA(0, 1, At, B1); PG8_BAR; PG8_SCHED;
            PG8_LDA(At, 0, 1); PG8_STAGE(PG8_SB(0, 0), b2, voffB); PG8_STAGE(PG8_SB(0, 1), b2 + hstep, voffB); PG8_STAGE_A(PG8_SA(0, 0), a2, on, 0);
            PG8_WAIT_V(8); PG8_WAIT_L(0); PG8_BAR; PG8_MMA(1, 0, At, B0); PG8_MMA(1, 1, At, B1); PG8_BAR; PG8_SCHED;
            PG8_LDB(B0, 1, 0); PG8_LDB(B1, 1, 1); PG8_SCHED; PG8_LDA(At, 1, 0); PG8_STAGE_A(PG8_SA(0, 1), a2 + hstepA, on, 1);
            PG8_WAIT_V(8); PG8_WAIT_L(0); PG8_BAR; PG8_MMA(0, 0, At, B0); PG8_MMA(0, 1, At, B1); PG8_BAR; PG8_SCHED;
            PG8_LDA(At, 1, 1); PG8_STAGE(PG8_SB(1, 0), b3, voffB); PG8_STAGE(PG8_SB(1, 1), b3 + hstep, voffB); PG8_STAGE_A(PG8_SA(1, 0), a3, on, 0);
            PG8_WAIT_V(8); PG8_WAIT_L(0); PG8_BAR; PG8_MMA(1, 0, At, B0); PG8_MMA(1, 1, At, B1); PG8_BAR; PG8_SCHED;
        }
        if (wr == 0) PG8_BAR;
        E(acc, cur, wr, wc, fr, fq);
        if (!has_next) break;
#pragma unroll
        for (int a = 0; a < 2; ++a)
#pragma unroll
            for (int b = 0; b < 2; ++b)
#pragma unroll
                for (int m = 0; m < 4; ++m)
#pragma unroll
                    for (int n = 0; n < 2; ++n) acc[a][b][m][n] = (f32x4){0.f, 0.f, 0.f, 0.f};
        cur = nxt; cA = nA; cB = nB; ++ui;
        if (wr == 1) PG8_BAR;
    }
    PG8_WAIT_V(0);
    PG8_BAR;
#undef PG8_SA
#undef PG8_SB
#undef PG8_STAGE
#undef PG8_LDA
#undef PG8_LDB
#undef PG8_MMA
#undef PG8_WAIT_V
#undef PG8_WAIT_L
#undef PG8_BAR
#undef PG8_SCHED
#undef PG8_STAGE_A
}
struct EpiBf16 {
    bf16_t* O; int ldc, ncolt; size_t slab;
    __device__ __forceinline__ void operator()(const f32x4 (&acc)[2][2][4][2], const Unit& u, int wr, int wc, int fr, int fq) const {
        const int row0 = u.pm * BM + wr * 64 + fr; const size_t col0 = (size_t)(u.pn % ncolt) * slab + wc * 32 + 8 * fq;
#pragma unroll
        for (int ai = 0; ai < 2; ++ai)
#pragma unroll
            for (int m = 0; m < 4; ++m) { bf16_t* rowp = O + (size_t)(row0 + ai * HALF + m * 16) * ldc + col0;
#pragma unroll
                for (int bj = 0; bj < 2; ++bj) { const f32x4 v0 = acc[ai][bj][m][0], v1 = acc[ai][bj][m][1];
                    u32x4 w; w.x = cvt_pk_bf16(v0[0], v0[1]); w.y = cvt_pk_bf16(v0[2], v0[3]); w.z = cvt_pk_bf16(v1[0], v1[1]); w.w = cvt_pk_bf16(v1[2], v1[3]);
                    *(u32x4*)(rowp + bj * HALF) = w; } }
    }
};
struct EpiRes {
    bf16_t* X; const float* xlat; const float* xctx; const float* modl; int pm_shift; float ascale;
    __device__ __forceinline__ void operator()(const f32x4 (&acc)[2][2][4][2], const Unit& u, int wr, int wc, int fr, int fq) const {
        const int pm = u.pm - pm_shift; const int rsel = pm < 64 ? (pm >> 5) : 2;
        const int row0 = pm * BM + wr * 64 + fr, col0 = (u.pn & 3) * BM + wc * 32 + 8 * fq;
        const float* gate = modl + (size_t)rsel * 6144 + col0;
        const float* xs = xlat ? (pm < 64 ? xlat + (size_t)row0 * D : xctx + (size_t)(row0 - R_LAT) * D) + col0 : nullptr;
        bf16_t* xo = X + (size_t)row0 * D + col0;
#pragma unroll
        for (int bj = 0; bj < 2; ++bj) { const f32x4 g0 = *(const f32x4*)(gate + bj * HALF) * ascale, g1 = *(const f32x4*)(gate + bj * HALF + 4) * ascale;
#pragma unroll
            for (int ai = 0; ai < 2; ++ai)
#pragma unroll
                for (int m = 0; m < 4; ++m) { const size_t o = (size_t)(ai * HALF + m * 16) * D + bj * HALF;
                    f32x4 x0, x1;
                    if (xs) { x0 = *(const f32x4*)(xs + o); x1 = *(const f32x4*)(xs + o + 4); } else unpack8(*(const u32x4*)(xo + o), x0, x1);
                    const f32x4 y0 = x0 + g0 * acc[ai][bj][m][0], y1 = x1 + g1 * acc[ai][bj][m][1];
                    u32x4 w; w.x = cvt_pk_bf16(y0[0], y0[1]); w.y = cvt_pk_bf16(y0[2], y0[3]); w.z = cvt_pk_bf16(y1[0], y1[1]); w.w = cvt_pk_bf16(y1[2], y1[3]);
                    *(u32x4*)(xo + o) = w; } }
    }
};
struct EpiGU8 {
    unsigned char* H8; const LAS float* wtab;
    __device__ __forceinline__ void operator()(const f32x4 (&acc)[2][2][4][2], const Unit& u, int wr, int wc, int fr, int fq) const {
        asm volatile("" : "+v"(fr), "+v"(fq));
        const int row0 = u.pm * BM + wr * 64 + fr, col0 = (u.pn & 1) * 128 + wc * 32 + 8 * fq;
#pragma unroll
        for (int ai = 0; ai < 2; ++ai)
#pragma unroll
            for (int m = 0; m < 4; ++m) { const int row = row0 + ai * HALF + m * 16; const float w = wtab[u.ord * 256 + wr * 64 + fr + ai * HALF + m * 16] * H8_SCALE;
                float h[8];
#pragma unroll
                for (int n = 0; n < 2; ++n)
#pragma unroll
                    for (int j = 0; j < 4; ++j) { const float gv = acc[ai][0][m][n][j] * GU_DESCALE, uv = acc[ai][1][m][n][j] * GU_DESCALE;
                        h[n * 4 + j] = fminf(fmaxf(gv * __builtin_amdgcn_rcpf(1.f + __expf(-gv)) * uv * w, -440.f), 440.f); }
                int w0 = __builtin_amdgcn_cvt_pk_fp8_f32(h[0], h[1], 0, false); w0 = __builtin_amdgcn_cvt_pk_fp8_f32(h[2], h[3], w0, true);
                int w1 = __builtin_amdgcn_cvt_pk_fp8_f32(h[4], h[5], 0, false); w1 = __builtin_amdgcn_cvt_pk_fp8_f32(h[6], h[7], w1, true);
                u32x2 o; o.x = (unsigned)w0; o.y = (unsigned)w1;
                *(u32x2*)(H8 + (size_t)row * 256 + col0) = o; }
    }
};
struct EpiGU {
    bf16_t* H; const float* slot_w;
    __device__ __forceinline__ void operator()(const f32x4 (&acc)[2][2][4][2], const Unit& u, int wr, int wc, int fr, int fq) const {
        const int row0 = u.pm * BM + wr * 64 + fr, col0 = (u.pn & 1) * 128 + wc * 32 + 8 * fq;
#pragma unroll
        for (int ai = 0; ai < 2; ++ai)
#pragma unroll
            for (int m = 0; m < 4; ++m) { const int row = row0 + ai * HALF + m * 16; const float w = slot_w[row];
                float h[8];
#pragma unroll
                for (int n = 0; n < 2; ++n)
#pragma unroll
                    for (int j = 0; j < 4; ++j) { const float gv = acc[ai][0][m][n][j], uv = acc[ai][1][m][n][j]; h[n * 4 + j] = gv / (1.f + __expf(-gv)) * uv * w; }
                u32x4 o; o.x = cvt_pk_bf16(h[0], h[1]); o.y = cvt_pk_bf16(h[2], h[3]); o.z = cvt_pk_bf16(h[4], h[5]); o.w = cvt_pk_bf16(h[6], h[7]);
                *(u32x4*)(H + (size_t)row * 256 + col0) = o; }
    }
};
struct EpiY8 {
    unsigned char* Y8;
    __device__ __forceinline__ void operator()(const f32x4 (&acc)[2][2][4][2], const Unit& u, int wr, int wc, int fr, int fq) const {
        const int row0 = u.pm * BM + wr * 64 + fr; unsigned char* base = Y8 + ((size_t)(u.pn & 3) * MAXSLOT + row0) * 256 + wc * 32 + 8 * fq;
#pragma unroll
        for (int ai = 0; ai < 2; ++ai)
#pragma unroll
            for (int m = 0; m < 4; ++m)
#pragma unroll
                for (int bj = 0; bj < 2; ++bj) { f32x4 v0 = acc[ai][bj][m][0] * (Y8_SCALE * DN_DESCALE), v1 = acc[ai][bj][m][1] * (Y8_SCALE * DN_DESCALE);
#pragma unroll
                    for (int q = 0; q < 4; ++q) { v0[q] = fminf(fmaxf(v0[q], -440.f), 440.f); v1[q] = fminf(fmaxf(v1[q], -440.f), 440.f); }
                    int w0 = __builtin_amdgcn_cvt_pk_fp8_f32(v0[0], v0[1], 0, false); w0 = __builtin_amdgcn_cvt_pk_fp8_f32(v0[2], v0[3], w0, true);
                    int w1 = __builtin_amdgcn_cvt_pk_fp8_f32(v1[0], v1[1], 0, false); w1 = __builtin_amdgcn_cvt_pk_fp8_f32(v1[2], v1[3], w1, true);
                    u32x2 o; o.x = (unsigned)w0; o.y = (unsigned)w1;
                    *(u32x2*)(base + (size_t)(ai * HALF + m * 16) * 256 + bj * HALF) = o; }
    }
};
struct EpiDown {
    bf16_t* Y; bf16_t* X; const float* modl5;
    __device__ __forceinline__ void operator()(const f32x4 (&acc)[2][2][4][2], const Unit& u, int wr, int wc, int fr, int fq) const {
        if (u.pm < MAXSLOT / 256) { const EpiY8 e{(unsigned char*)Y}; e(acc, u, wr, wc, fr, fq); }
        else { const EpiRes e{X, nullptr, nullptr, modl5, MAXSLOT / 256, DN_DESCALE}; e(acc, u, wr, wc, fr, fq); }
    }
};
}


__device__ __forceinline__ void ph_inproj_f(KP p, int l, unsigned char* lds) {
    pg8::Gemm g{(const bf16_t*)(p->ws + Z_A), (const bf16_t*)(p->ws + win_off(l)), R_ALL, DIN, 1024};
    pg8::StaticOrder S; S.init(R_ALL, DIN, gsz_(), bid_());
    pg8::EpiBf16 E{(bf16_t*)(p->ws + Z_P), DIN, DIN / 256, 256};
    pg8::gemm_phase<pg8::EpiBf16, pg8::StaticOrder, false>((LAS unsigned char*)lds, g, S, E, nullptr);
    if (l == 0 && DEPTH > 1 && gsz_() == 256) { __syncthreads(); ph_cvt(p, 1, lds, 214, 42, 0, CVT_E1); }
}
__device__ __forceinline__ void ph_outproj_f(KP p, int l, unsigned char* lds) {
    const int T = (l == 0) ? R_ALL : R_LAT;
    pg8::Gemm g{(const bf16_t*)(p->ws + Z_YCAT), (const bf16_t*)(p->ws + wout_off(l)), T, 1024, 1024};
    pg8::StaticOrder S; S.init(T, 1024, gsz_(), bid_());
    bf16_t* X = (bf16_t*)(p->ws + WS_X);
    pg8::EpiRes E{X, l == 0 ? p->in[0] : nullptr, l == 0 ? p->in[2] : nullptr, (const float*)(p->ws + WS_MOD) + (size_t)l * 3 * 6144 + 2 * 1024, 0, 1.f};
    pg8::gemm_phase<pg8::EpiRes, pg8::StaticOrder, false>((LAS unsigned char*)lds, g, S, E, nullptr);
    if (l == 0 && DEPTH > 1) {
        const int G = gsz_(); __syncthreads();
        if (G == 256) ph_cvt(p, 1, lds, 8, 248, CVT_E2, 1 << 30); else ph_cvt(p, 1, lds); }
}
struct QkvLane { f32x4 gg0, gg1, gw0, gw1; };
__device__ __forceinline__ QkvLane qkv_lane_consts(KP p, int l, int lane) {
    QkvLane c; const int dch = (lane & 7) * 8; const int isk = lane >= 32;
    const float* gq = p->in[isk ? 11 : 10] + l * 64 + dch; const float* wq = p->in[isk ? 13 : 12] + l * 64 + dch;
    c.gg0 = *(const f32x4*)gq; c.gg1 = *(const f32x4*)(gq + 4); c.gw0 = *(const f32x4*)wq; c.gw1 = *(const f32x4*)(wq + 4); return c;
}
__device__ __forceinline__ void prep_qkv_row(KP p, int l, int row, int lane, const QkvLane& qc) {
    const bf16_t* pr = (const bf16_t*)(p->ws + Z_P) + (size_t)row * DIN;
    const bool isctx = row >= R_LAT; const int b = isctx ? ((row - R_LAT) >> 8) : (row >> 13), t = isctx ? ((row - R_LAT) & 255) : (row & 8191);
    const size_t krow = (size_t)b * NKEY + (isctx ? NSEQ + t : t);
    const int l7 = lane & 7, axis = l7 >> 2, half = (l7 >> 1) & 1;
    f32x4 cs0 = (f32x4){1.f, 1.f, 1.f, 1.f}, cs1 = cs0, sn0 = (f32x4){0.f, 0.f, 0.f, 0.f}, sn1 = sn0;
    if (!isctx) { const int pos = axis == 0 ? (t >> 6) : (t & 63); const float* rt = (const float*)(p->ws + WS_ROPE) + pos * 32 + (lane & 1) * 8;
        cs0 = *(const f32x4*)rt; cs1 = *(const f32x4*)(rt + 4); sn0 = *(const f32x4*)(rt + 16); sn1 = *(const f32x4*)(rt + 20); }
    const u32x4 ra = *(const u32x4*)(pr + lane * 8), rb = *(const u32x4*)(pr + 512 + lane * 8);
#pragma unroll
    for (int grp = 0; grp < 2; ++grp) {
        const u32x4 r = grp ? rb : ra;
        bf16_t* Qd = (bf16_t*)(p->ws + (isctx ? (grp ? Z_QWC : Z_QGC) : (grp ? Z_QW : Z_QG))) + (size_t)(isctx ? (b * NCTX + t) : row) * 256;
        bf16_t* Kd = (bf16_t*)(p->ws + (grp ? Z_KW : Z_KG)) + krow * 128; bf16_t* Vd = (bf16_t*)(p->ws + (grp ? Z_VW : Z_VG)) + krow * 128;
        if (lane >= 48) { *(u32x4*)(Vd + (lane - 48) * 8) = r; continue; }
        float x[8] = {bf2f(r.x & 0xffffu), bf2f(r.x >> 16), bf2f(r.y & 0xffffu), bf2f(r.y >> 16), bf2f(r.z & 0xffffu), bf2f(r.z >> 16), bf2f(r.w & 0xffffu), bf2f(r.w >> 16)};
        float ss = 0.f;
#pragma unroll
        for (int i = 0; i < 8; ++i) ss += x[i] * x[i];
        ss += __shfl_xor(ss, 1); ss += __shfl_xor(ss, 2); ss += __shfl_xor(ss, 4);
        const float rinv = rsqrtf(ss * (1.f / 64.f) + EPS);
        const f32x4 g0 = grp ? qc.gw0 : qc.gg0, g1 = grp ? qc.gw1 : qc.gg1;
        const float gv[8] = {g0.x, g0.y, g0.z, g0.w, g1.x, g1.y, g1.z, g1.w};
        const float cv[8] = {cs0.x, cs0.y, cs0.z, cs0.w, cs1.x, cs1.y, cs1.z, cs1.w}, sv[8] = {sn0.x, sn0.y, sn0.z, sn0.w, sn1.x, sn1.y, sn1.z, sn1.w};
        const float qs = (lane < 32) ? QSCALE : 1.f;
        float y[8];
#pragma unroll
        for (int i = 0; i < 8; ++i) { const float v = x[i] * rinv * gv[i]; const float o = __shfl_xor(v, 2);
            y[i] = ((half == 0) ? (v * cv[i] - o * sv[i]) : (o * sv[i] + v * cv[i])) * qs; }
        u32x4 ov; ov.x = pk2(y[0], y[1]); ov.y = pk2(y[2], y[3]); ov.z = pk2(y[4], y[5]); ov.w = pk2(y[6], y[7]);
        if (lane < 32) *(u32x4*)(Qd + lane * 8) = ov; else *(u32x4*)(Kd + (lane - 32) * 8) = ov;
    }
}

template <int R> __device__ __forceinline__ void dw_rows(const float* hcol, const float (&wj)[31], float (&acc)[32]) {
    if constexpr (R < 62) {
        const float hv = hcol[R * 256];
        constexpr int T0 = (R - 30 > 0) ? R - 30 : 0, T1 = (R < 31) ? R : 31;
#pragma unroll
        for (int tt = T0; tt <= T1; ++tt) acc[tt] += hv * wj[R - tt];
        dw_rows<R + 1>(hcol, wj, acc);
    }
}
__device__ __forceinline__ void conv_tile(KP p, int l, unsigned char* lds, int seq_row0, int seqlen, int t0) {
    float* hb = (float*)lds;
    const int tid = tid_(), lane = tid & 63, wid = tid >> 6;
    const bf16_t* P = (const bf16_t*)(p->ws + Z_P);
    for (int i = tid; i < 94 * 32; i += NTHREADS) { const int r = i >> 5, c8 = (i & 31) * 8, t = t0 - 15 + r;
        f32x4 h0 = (f32x4){0.f, 0.f, 0.f, 0.f}, h1 = h0;
        if (t >= 0 && t < seqlen) { const bf16_t* pr = P + (size_t)(seq_row0 + t) * DIN;
            const u32x4 vv = *(const u32x4*)(pr + C_CVV + c8), gg = *(const u32x4*)(pr + C_CVG + c8);
            h0.x = bf2f(vv.x & 0xffffu) * sigmoid_(bf2f(gg.x & 0xffffu)); h0.y = bf2f(vv.x >> 16) * sigmoid_(bf2f(gg.x >> 16));
            h0.z = bf2f(vv.y & 0xffffu) * sigmoid_(bf2f(gg.y & 0xffffu)); h0.w = bf2f(vv.y >> 16) * sigmoid_(bf2f(gg.y >> 16));
            h1.x = bf2f(vv.z & 0xffffu) * sigmoid_(bf2f(gg.z & 0xffffu)); h1.y = bf2f(vv.z >> 16) * sigmoid_(bf2f(gg.z >> 16));
            h1.z = bf2f(vv.w & 0xffffu) * sigmoid_(bf2f(gg.w & 0xffffu)); h1.w = bf2f(vv.w >> 16) * sigmoid_(bf2f(gg.w >> 16)); }
        *(f32x4*)(hb + r * 256 + c8) = h0; *(f32x4*)(hb + r * 256 + c8 + 4) = h1; }
    __syncthreads();
    { const int c = tid & 255, hf = tid >> 8;
      const float* w = p->in[15] + (size_t)l * 31 * 256 + c; const float bias = p->in[16][l * 256 + c];
      float wj[31];
#pragma unroll
      for (int j = 0; j < 31; ++j) wj[j] = w[j * 256];
      float acc[32];
#pragma unroll
      for (int tt = 0; tt < 32; ++tt) acc[tt] = bias;
      dw_rows<0>(hb + hf * 32 * 256 + c, wj, acc);
      __syncthreads();
#pragma unroll
      for (int tt = 0; tt < 32; ++tt) hb[(hf * 32 + tt) * 256 + c] = acc[tt];
    }
    __syncthreads();
    constexpr int AS = 264;
    bf16_t* ab = (bf16_t*)(lds + 94 * 256 * 4);
    for (int tt = wid; tt < 64; tt += 8) { const float* r = hb + tt * 256; const f32x4 v = ((const f32x4*)r)[lane];
        const float mean = wave_sum(v.x + v.y + v.z + v.w) * (1.f / 256.f);
        const float dx = v.x - mean, dy = v.y - mean, dz = v.z - mean, dw = v.w - mean;
        const float rstd = rsqrtf(wave_sum(dx * dx + dy * dy + dz * dz + dw * dw) * (1.f / 256.f) + EPS);
        const f32x4 g = ((const f32x4*)(p->in[17] + l * 256))[lane], bb = ((const f32x4*)(p->in[18] + l * 256))[lane];
        u32x2 o; o.x = pk2(silu_(dx * rstd * g.x + bb.x), silu_(dy * rstd * g.y + bb.y)); o.y = pk2(silu_(dz * rstd * g.z + bb.z), silu_(dw * rstd * g.w + bb.w));
        *(u32x2*)(ab + tt * AS + lane * 4) = o; }
    __syncthreads();
    { const int fr = lane & 15, fq = lane >> 4;
      const bf16_t* Wt = (const bf16_t*)(p->ws + wpw_off(l));
      bf16x8 bw[2][8];
#pragma unroll
      for (int j = 0; j < 2; ++j)
#pragma unroll
          for (int ks = 0; ks < 8; ++ks) bw[j][ks] = *(const bf16x8*)(Wt + (size_t)((wid * 2 + j) * 16 + fr) * 256 + ks * 32 + fq * 8);
      const float bias0 = p->in[20][l * 256 + wid * 32 + fr], bias1 = p->in[20][l * 256 + wid * 32 + 16 + fr];
      bf16_t* Y = (bf16_t*)(p->ws + Z_YCAT);
#pragma unroll 1
      for (int tr = 0; tr < 4; ++tr) { f32x4 a0 = (f32x4){0.f, 0.f, 0.f, 0.f}, a1 = a0;
#pragma unroll
          for (int ks = 0; ks < 8; ++ks) { const bf16x8 av = *(const bf16x8*)(ab + (tr * 16 + fr) * AS + ks * 32 + fq * 8);
              a0 = __builtin_amdgcn_mfma_f32_16x16x32_bf16(av, bw[0][ks], a0, 0, 0, 0); a1 = __builtin_amdgcn_mfma_f32_16x16x32_bf16(av, bw[1][ks], a1, 0, 0, 0); }
#pragma unroll
          for (int r = 0; r < 4; ++r) { const int t = t0 + tr * 16 + fq * 4 + r; bf16_t* yr = Y + (size_t)(seq_row0 + t) * D + 256 + wid * 32 + fr;
              yr[0] = (bf16_t)f2bf(a0[r] + bias0); yr[16] = (bf16_t)f2bf(a1[r] + bias1); } }
    }
    __syncthreads();
}

__device__ __forceinline__ int hgrn_chunk_row0(int b, int dir, int j) {
    if (j < 4) { const int cj = dir ? 3 - j : j; return R_LAT + b * NCTX + cj * 64; }
    const int jj = j - 4, cj = dir ? 127 - jj : jj; return b * NSEQ + cj * 64;
}
__device__ __forceinline__ void hgrn_load_chunk(KP p, int l, int row0, int dir, int head, float* qs, float* vs, float* ks, float* cs) {
    const int tid = tid_();
    const bf16_t* P = (const bf16_t*)(p->ws + Z_P);
    const float* lbv = (const float*)(p->ws + WS_LB) + (l * 2 + dir) * 256 + head * 64;
    for (int i = tid; i < 4096; i += NTHREADS) { const int tau = i >> 6, d = i & 63; const int row = row0 + (dir ? 63 - tau : tau);
        const bf16_t* pr = P + (size_t)row * DIN + head * 64 + d;
        if (qs) qs[i] = bf2f(pr[C_RQ]);
        vs[i] = bf2f(pr[C_RI]);
        const float z = bf2f(pr[dir ? C_RFB : C_RFF]); const float lb = lbv[d];
        const float lsp = fminf(z, 0.f) - log1pf(__expf(-fabsf(z)));
        float logf = lsp;
        if (lb > 0.f) { const float a = lsp, bq = __logf(lb) + (lsp - z); const float mx = fmaxf(a, bq); logf = mx + log1pf(__expf(-fabsf(a - bq))); }
        ks[i] = (1.f - lb) * sigmoid_(-z);
        cs[i] = logf; }
    __syncthreads();
    if (tid < 64) { float c = 0.f; for (int tau = 0; tau < 64; ++tau) { c += cs[tau * 64 + tid]; cs[tau * 64 + tid] = c; } }
    __syncthreads();
}
__device__ __forceinline__ void hgrn_pass1_unit(KP p, int l, unsigned char* lds, int unit) {
    float* vs = (float*)lds; float* ks = vs + 4096; float* cs = ks + 4096;
    const int tid = tid_();
    const int j = unit % NCHUNK, seq = unit / NCHUNK, dir = seq & 1, head = (seq >> 1) & 3, b = seq >> 3;
    hgrn_load_chunk(p, l, hgrn_chunk_row0(b, dir, j), dir, head, nullptr, vs, ks, cs);
    for (int i = tid; i < 4096; i += NTHREADS) { const int d = i & 63; ks[i] *= __expf(cs[63 * 64 + d] - cs[i]); }
    __syncthreads();
    float* U = (float*)(p->ws + Z_U) + ((size_t)seq * NCHUNK + j) * 4096; float* Gv = (float*)(p->ws + Z_G) + ((size_t)seq * NCHUNK + j) * 64;
    { const int d = tid >> 3, e0 = (tid & 7) * 8; float acc[8];
#pragma unroll
      for (int e = 0; e < 8; ++e) acc[e] = 0.f;
      for (int tau = 0; tau < 64; ++tau) { const float kv = ks[tau * 64 + d];
#pragma unroll
          for (int e = 0; e < 8; ++e) acc[e] += kv * vs[tau * 64 + e0 + e]; }
#pragma unroll
      for (int e = 0; e < 8; ++e) U[d * 64 + e0 + e] = acc[e]; }
    if (tid < 64) Gv[tid] = __expf(cs[63 * 64 + tid]);
    __syncthreads();
}
constexpr int HS = 72;
constexpr int HL_TOT = 0, HL_OSUM = 2048, HL_T0 = 18432, HL_TB = 64 * HS * 2;
__device__ __forceinline__ f32x4 mm64(const bf16_t* A, const bf16_t* Bt, int tr, int tc, int fr, int fq, f32x4 acc) {
#pragma unroll
    for (int k0 = 0; k0 < 64; k0 += 32) { const bf16x8 a = *(const bf16x8*)(A + (tr * 16 + fr) * HS + k0 + fq * 8), b = *(const bf16x8*)(Bt + (tc * 16 + fr) * HS + k0 + fq * 8);
        acc = __builtin_amdgcn_mfma_f32_16x16x32_bf16(a, b, acc, 0, 0, 0); }
    return acc;
}
__device__ __forceinline__ void hgrn_load8(KP p, int row0, int dir, int head, int tid, float (&q)[8], float (&vv)[8], float (&z)[8]) {
    const int d = tid & 63, seg = tid >> 6;
    const bf16_t* P = (const bf16_t*)(p->ws + Z_P);
#pragma unroll
    for (int i = 0; i < 8; ++i) { const int tau = seg * 8 + i; const int row = row0 + (dir ? 63 - tau : tau);
        const bf16_t* pr = P + (size_t)row * DIN + head * 64 + d;
        q[i] = bf2f(pr[C_RQ]); vv[i] = bf2f(pr[C_RI]); z[i] = bf2f(pr[dir ? C_RFB : C_RFF]); }
}
__device__ __forceinline__ void hgrn_gate8(KP p, int l, int dir, int head, int tid, float* tot, const float (&z)[8], float (&kg)[8], float (&c)[8], float& m, float& cl) {
    const int d = tid & 63, seg = tid >> 6;
    const float lb = ((const float*)(p->ws + WS_LB))[(l * 2 + dir) * 256 + head * 64 + d];
    float run = 0.f;
#pragma unroll
    for (int i = 0; i < 8; ++i) {
        const float ez = __expf(-fabsf(z[i])), rz = __builtin_amdgcn_rcpf(1.f + ez); const float sg = (z[i] >= 0.f) ? rz : ez * rz;
        const float f = lb + (1.f - lb) * sg;
        kg[i] = 1.f - f;
        run += __logf(f); c[i] = run; }
    tot[seg * 64 + d] = run;
    __syncthreads();
    float off = 0.f; m = 0.f; cl = 0.f;
#pragma unroll
    for (int s2 = 0; s2 < 8; ++s2) { const float t = tot[s2 * 64 + d]; if (s2 < seg) off += t; if (s2 < 4) m += t; cl += t; }
#pragma unroll
    for (int i = 0; i < 8; ++i) c[i] += off;
}
__device__ __forceinline__ u32x4 pack8(const float (&x)[8]) { u32x4 o; o.x = pk2(x[0], x[1]); o.y = pk2(x[2], x[3]); o.z = pk2(x[4], x[5]); o.w = pk2(x[6], x[7]); return o; }
__device__ __forceinline__ void hgrn_pass1_f(KP p, int l, unsigned char* lds, int unit) {
    const int tid = tid_(), lane = tid & 63, wid = tid >> 6, fr = lane & 15, fq = lane >> 4, d = tid & 63, seg = tid >> 6;
    float* tot = (float*)(lds + HL_TOT); bf16_t* Vt = (bf16_t*)(lds + HL_T0); bf16_t* KbT = (bf16_t*)(lds + HL_T0 + HL_TB);
    const int j = unit % NCHUNK, seq = unit / NCHUNK, dir = seq & 1, head = (seq >> 1) & 3, b = seq >> 3;
    float q[8], vv[8], z[8], kg[8], c[8], m, cl;
    hgrn_load8(p, hgrn_chunk_row0(b, dir, j), dir, head, tid, q, vv, z);
    hgrn_gate8(p, l, dir, head, tid, tot, z, kg, c, m, cl);
    float kb[8];
#pragma unroll
    for (int i = 0; i < 8; ++i) kb[i] = kg[i] * __expf(cl - c[i]);
    *(u32x4*)(Vt + d * HS + seg * 8) = pack8(vv);
    *(u32x4*)(KbT + d * HS + seg * 8) = pack8(kb);
    float* U = (float*)(p->ws + Z_U) + ((size_t)seq * NCHUNK + j) * 4096; float* Gv = (float*)(p->ws + Z_G) + ((size_t)seq * NCHUNK + j) * 64;
    if (seg == 0) Gv[d] = __expf(cl);
    __syncthreads();
    const int tr = wid >> 1;
#pragma unroll
    for (int t2 = 0; t2 < 2; ++t2) { const int tc = (wid & 1) * 2 + t2;
        const f32x4 acc = mm64(Vt, KbT, tr, tc, fr, fq, (f32x4){0.f, 0.f, 0.f, 0.f});
#pragma unroll
        for (int r = 0; r < 4; ++r) U[(tr * 16 + fq * 4 + r) * 64 + tc * 16 + fr] = acc[r]; }
    __syncthreads();
}
struct HgrnIn1 { float v[8], zf[8], zb[8]; };
__device__ __forceinline__ void hgrn_p1_load(KP p, int unit, int tid, HgrnIn1& r) {
    const int cpos = unit % NCHUNK, head = (unit / NCHUNK) & 3, b = unit / (NCHUNK * 4), d = tid & 63, seg = tid >> 6;
    const int row0 = (cpos < 4) ? R_LAT + b * NCTX + cpos * 64 : b * NSEQ + (cpos - 4) * 64;
    const bf16_t* P = (const bf16_t*)(p->ws + Z_P) + (size_t)(row0 + seg * 8) * DIN + head * 64 + d;
#pragma unroll
    for (int i = 0; i < 8; ++i) { const bf16_t* pr = P + (size_t)i * DIN; r.v[i] = bf2f(pr[C_RI]); r.zf[i] = bf2f(pr[C_RFF]); r.zb[i] = bf2f(pr[C_RFB]); }
}
__device__ __forceinline__ void hgrn_p1_compute(KP p, int l, unsigned char* lds, int unit, int tid, const HgrnIn1& r) {
    const int lane = tid & 63, wid = tid >> 6, fr = lane & 15, fq = lane >> 4, d = tid & 63, seg = tid >> 6;
    float* totf = (float*)(lds + HL_TOT); float* totb = (float*)(lds + HL_OSUM);
    bf16_t* Vt = (bf16_t*)(lds + HL_T0); bf16_t* KfT = (bf16_t*)(lds + HL_T0 + HL_TB); bf16_t* KbT = (bf16_t*)(lds + HL_T0 + 2 * HL_TB);
    const int cpos = unit % NCHUNK, head = (unit / NCHUNK) & 3, b = unit / (NCHUNK * 4);
    const float* lbp = (const float*)(p->ws + WS_LB) + (l * 2) * 256 + head * 64 + d; const float lbf = lbp[0], lbb = lbp[256];
    float kf[8], kb[8], cf[8], cb[8], lfb[8], runf = 0.f, runb = 0.f;
#pragma unroll
    for (int i = 0; i < 8; ++i) {
        { const float z = r.zf[i], ez = __expf(-fabsf(z)), rz = __builtin_amdgcn_rcpf(1.f + ez), sg = (z >= 0.f) ? rz : ez * rz, f = lbf + (1.f - lbf) * sg; kf[i] = 1.f - f; runf += __logf(f); cf[i] = runf; }
        { const float z = r.zb[i], ez = __expf(-fabsf(z)), rz = __builtin_amdgcn_rcpf(1.f + ez), sg = (z >= 0.f) ? rz : ez * rz, f = lbb + (1.f - lbb) * sg; kb[i] = 1.f - f; lfb[i] = __logf(f); runb += lfb[i]; cb[i] = runb; } }
    totf[seg * 64 + d] = runf; totb[seg * 64 + d] = runb;
    __syncthreads();
    float offf = 0.f, offb = 0.f, clf = 0.f, clb = 0.f;
#pragma unroll
    for (int s2 = 0; s2 < 8; ++s2) { const float tf = totf[s2 * 64 + d], tb = totb[s2 * 64 + d]; if (s2 < seg) { offf += tf; offb += tb; } clf += tf; clb += tb; }
#pragma unroll
    for (int i = 0; i < 8; ++i) { kf[i] *= __expf(clf - (cf[i] + offf)); kb[i] *= __expf(cb[i] + offb - lfb[i]); }
    *(u32x4*)(Vt + d * HS + seg * 8) = pack8(r.v);
    *(u32x4*)(KfT + d * HS + seg * 8) = pack8(kf);
    *(u32x4*)(KbT + d * HS + seg * 8) = pack8(kb);
    const int jf = cpos, jb = (cpos < 4) ? 3 - cpos : 4 + 127 - (cpos - 4); const int seqf = (b * 4 + head) * 2;
    bf16_t* Uf = (bf16_t*)(p->ws + Z_U) + ((size_t)seqf * NCHUNK + jf) * 4096; bf16_t* Ub = (bf16_t*)(p->ws + Z_U) + ((size_t)(seqf + 1) * NCHUNK + jb) * 4096;
    float* Gf = (float*)(p->ws + Z_G) + ((size_t)seqf * NCHUNK + jf) * 64; float* Gb = (float*)(p->ws + Z_G) + ((size_t)(seqf + 1) * NCHUNK + jb) * 64;
    if (seg == 0) { Gf[d] = __expf(clf); Gb[d] = __expf(clb); }
    __syncthreads();
    const int tr = wid >> 1;
#pragma unroll
    for (int t2 = 0; t2 < 2; ++t2) { const int tc = (wid & 1) * 2 + t2;
        const f32x4 af = mm64(Vt, KfT, tr, tc, fr, fq, (f32x4){0.f, 0.f, 0.f, 0.f}), ab = mm64(Vt, KbT, tr, tc, fr, fq, (f32x4){0.f, 0.f, 0.f, 0.f});
#pragma unroll
        for (int q = 0; q < 4; ++q) { const int o = (tr * 16 + fq * 4 + q) * 64 + tc * 16 + fr; Uf[o] = (bf16_t)f2bf(af[q]); Ub[o] = (bf16_t)f2bf(ab[q]); } }
    __syncthreads();
}
__device__ __forceinline__ void hgrn_pass1_run(KP p, int l, unsigned char* lds, int u0, int un, int ustep) {
    if (un <= 0) return;
    const int tid = tid_();
    HgrnIn1 cur; hgrn_p1_load(p, u0, tid, cur);
    for (int k = 0; k < un; ++k) { const int u = u0 + k * ustep;
        HgrnIn1 nxt = cur; if (k + 1 < un) hgrn_p1_load(p, u + ustep, tid, nxt);
        hgrn_p1_compute(p, l, lds, u, tid, cur);
        cur = nxt; }
}
__device__ __forceinline__ void hgrn_scan_f(KP p) {
    const int tid = tid_();
    if (tid >= 256) return;
    for (int gi = bid_() * 256 + tid; gi < 16 * 4096; gi += gsz_() * 256) {
    const int seq = gi >> 12, ed = gi & 4095, d = ed & 63;
    bf16_t* U = (bf16_t*)(p->ws + Z_U) + (size_t)seq * NCHUNK * 4096 + ed; const float* Gv = (const float*)(p->ws + Z_G) + (size_t)seq * NCHUNK * 64 + d;
    float S = 0.f;
#pragma unroll 1
    for (int j = 0; j < NCHUNK; j += 12) {
        float u[12], g[12];
#pragma unroll
        for (int q = 0; q < 12; ++q) { u[q] = bf2f(U[(size_t)(j + q) * 4096]); g[q] = Gv[(j + q) * 64]; }
#pragma unroll
        for (int q = 0; q < 12; ++q) { U[(size_t)(j + q) * 4096] = (bf16_t)f2bf(S); S = g[q] * S + u[q]; }
    }
    }
}
struct HgrnIn3 { float q[8], v[8], zf[8], zb[8], gg[8]; u32x4 sf, sb; };
__device__ __forceinline__ void hgrn_p3_load(KP p, int unit, int tid, HgrnIn3& r) {
    const int cpos = unit % NCHUNK, head = (unit / NCHUNK) & 3, b = unit / (NCHUNK * 4), d = tid & 63, seg = tid >> 6;
    const int row0 = (cpos < 4) ? R_LAT + b * NCTX + cpos * 64 : b * NSEQ + (cpos - 4) * 64;
    const bf16_t* P = (const bf16_t*)(p->ws + Z_P) + (size_t)(row0 + seg * 8) * DIN + head * 64 + d;
#pragma unroll
    for (int i = 0; i < 8; ++i) { const bf16_t* pr = P + (size_t)i * DIN; r.q[i] = bf2f(pr[C_RQ]); r.v[i] = bf2f(pr[C_RI]); r.zf[i] = bf2f(pr[C_RFF]); r.zb[i] = bf2f(pr[C_RFB]);
        r.gg[i] = bf2f(((const bf16_t*)(p->ws + Z_P))[(size_t)(row0 + seg + 8 * i) * DIN + C_RG + head * 64 + d]); }
    const int jf = cpos, jb = (cpos < 4) ? 3 - cpos : 4 + 127 - (cpos - 4); const int seqf = (b * 4 + head) * 2;
    const bf16_t* U = (const bf16_t*)(p->ws + Z_U);
    r.sf = *(const u32x4*)(U + ((size_t)seqf * NCHUNK + jf) * 4096 + tid * 8); r.sb = *(const u32x4*)(U + ((size_t)(seqf + 1) * NCHUNK + jb) * 4096 + tid * 8);
}
__device__ __forceinline__ void hgrn_p3_compute(KP p, int l, unsigned char* lds, int unit, int tid, const HgrnIn3& r) {
    const int lane = tid & 63, wid = tid >> 6, fr = lane & 15, fq = lane >> 4, d = tid & 63, seg = tid >> 6;
    float* tot = (float*)(lds + HL_TOT); float* os = (float*)(lds + HL_OSUM);
    bf16_t* Qt = (bf16_t*)(lds + HL_T0); bf16_t* Kt = (bf16_t*)(lds + HL_T0 + HL_TB); bf16_t* Qb = (bf16_t*)(lds + HL_T0 + 2 * HL_TB);
    bf16_t* St = (bf16_t*)(lds + HL_T0 + 3 * HL_TB); bf16_t* Vt = (bf16_t*)(lds + HL_T0 + 4 * HL_TB); bf16_t* Sc = (bf16_t*)(lds + HL_T0 + 5 * HL_TB);
    const int cpos = unit % NCHUNK, head = (unit / NCHUNK) & 3, b = unit / (NCHUNK * 4);
    const int row0 = (cpos < 4) ? R_LAT + b * NCTX + cpos * 64 : b * NSEQ + (cpos - 4) * 64;
    const int tr = wid >> 1;
    const float* lbp = (const float*)(p->ws + WS_LB) + (l * 2) * 256 + head * 64 + d;
#pragma unroll
    for (int dir = 0; dir < 2; ++dir) {
        const float lb = lbp[dir * 256];
        float kg[8], c[8], run = 0.f;
#pragma unroll
        for (int ii = 0; ii < 8; ++ii) { const int i = dir ? 7 - ii : ii;
            const float z = dir ? r.zb[i] : r.zf[i];
            const float ez = __expf(-fabsf(z)), rz = __builtin_amdgcn_rcpf(1.f + ez), sg = (z >= 0.f) ? rz : ez * rz, f = lb + (1.f - lb) * sg;
            kg[i] = 1.f - f; run += __logf(f); c[i] = run; }
        tot[seg * 64 + d] = run;
        __syncthreads();
        float off = 0.f, m = 0.f;
#pragma unroll
        for (int s2 = 0; s2 < 8; ++s2) { const float t = tot[s2 * 64 + d]; if (dir ? (s2 > seg) : (s2 < seg)) off += t; if (dir ? (s2 >= 4) : (s2 < 4)) m += t; }
        float vr[8];
#pragma unroll
        for (int i = 0; i < 8; ++i) { const float ci = c[i] + off; const int tau = dir ? 63 - (seg * 8 + i) : seg * 8 + i; const float qv = r.q[i];
            Qt[tau * HS + d] = (bf16_t)f2bf(qv * __expf(fminf(ci - m, 80.f)));
            Kt[tau * HS + d] = (bf16_t)f2bf(kg[i] * __expf(fminf(m - ci, 80.f)));
            Qb[tau * HS + d] = (bf16_t)f2bf(qv * __expf(ci));
            vr[i] = dir ? r.v[7 - i] : r.v[i]; }
        *(u32x4*)(Vt + d * HS + (dir ? 7 - seg : seg) * 8) = pack8(vr);
        *(u32x4*)(St + (tid >> 3) * HS + (tid & 7) * 8) = dir ? r.sb : r.sf;
        __syncthreads();
        f32x4 oacc[2];
#pragma unroll
        for (int t2 = 0; t2 < 2; ++t2) { const int tc = (wid & 1) * 2 + t2;
            oacc[t2] = mm64(Qb, St, tr, tc, fr, fq, (f32x4){0.f, 0.f, 0.f, 0.f});
            f32x4 sacc = (f32x4){0.f, 0.f, 0.f, 0.f};
            if (tc <= tr) sacc = mm64(Qt, Kt, tr, tc, fr, fq, sacc);
#pragma unroll
            for (int q = 0; q < 4; ++q) { const int tau = tr * 16 + fq * 4 + q, sig = tc * 16 + fr; Sc[tau * HS + sig] = (bf16_t)f2bf(sig <= tau ? sacc[q] : 0.f); } }
        __syncthreads();
#pragma unroll
        for (int t2 = 0; t2 < 2; ++t2) { const int tc = (wid & 1) * 2 + t2;
            oacc[t2] = mm64(Sc, Vt, tr, tc, fr, fq, oacc[t2]);
#pragma unroll
            for (int q = 0; q < 4; ++q) { const int tau = tr * 16 + fq * 4 + q, e = tc * 16 + fr, tok = dir ? 63 - tau : tau;
                if (dir == 0) os[tok * 64 + e] = oacc[t2][q]; else os[tok * 64 + e] += oacc[t2][q]; } }
        __syncthreads();
    }
    bf16_t* Y = (bf16_t*)(p->ws + Z_YCAT); const float ong = p->in[22][l * 64 + lane];
#pragma unroll
    for (int i = 0; i < 8; ++i) { const int tok = wid + 8 * i; const float v = os[tok * 64 + lane];
        const float y = v * rsqrtf(wave_sum(v * v) * (1.f / 64.f) + EPS) * ong;
        Y[(size_t)(row0 + tok) * D + 768 + head * 64 + lane] = (bf16_t)f2bf(y * silu_(r.gg[i])); }
    __syncthreads();
}
__device__ __forceinline__ int hgrn_p3_unit(int k) { if (k < 1024) { const int bh = k >> 7, c = k & 127; return bh * NCHUNK + 4 + c; } const int k2 = k - 1024; return (k2 >> 2) * NCHUNK + (k2 & 3); }
__device__ __forceinline__ void hgrn_pass3_run(KP p, int l, unsigned char* lds) {
    const int tid = tid_(), G = gsz_(), nunits = 1024 + (l == 0 ? 32 : 0);
    int k = bid_(); if (k >= nunits) return;
    HgrnIn3 cur; hgrn_p3_load(p, hgrn_p3_unit(k), tid, cur);
    for (;;) { const int kn = k + G; const bool more = kn < nunits;
        HgrnIn3 nxt = cur; if (more) hgrn_p3_load(p, hgrn_p3_unit(kn), tid, nxt);
        hgrn_p3_compute(p, l, lds, hgrn_p3_unit(k), tid, cur);
        if (!more) break;
        cur = nxt; k = kn; }
}
__device__ __forceinline__ void ph_prep(KP p, int l, unsigned char* lds) {
    const int tid = tid_(), lane = tid & 63, wid = tid >> 6, bid = bid_(), G = gsz_();
    const int nconv = 256 + (l == 0 ? 8 : 0);
    for (int it = bid; it < nconv; it += G) {
        if (it < 256) conv_tile(p, l, lds, (it >> 7) * NSEQ, NSEQ, (it & 127) * 64);
        else { const int c = it - 256; conv_tile(p, l, lds, R_LAT + (c >> 2) * NCTX, NCTX, (c & 3) * 64); } }
    if (G == 256) {
        const int u0 = bid < 8 ? 2 * bid : bid < 56 ? 16 + 5 * (bid - 8) : 256 + 4 * (bid - 56), un = bid < 8 ? 2 : bid < 56 ? 5 : 4;
        hgrn_pass1_run(p, l, lds, u0, un, 1);
        const int g0 = bid < 104 ? 8 * bid : bid < 168 ? 832 + 9 * (bid - 104) : 1408 + 8 * (bid - 168), gn = (bid >= 104 && bid < 168) ? 9 : 8;
        const QkvLane qc = qkv_lane_consts(p, l, lane);
        for (int g = g0; g < g0 + gn; ++g) prep_qkv_row(p, l, g * 8 + wid, lane, qc);
    } else {
        hgrn_pass1_run(p, l, lds, bid, (8 * NCHUNK - bid + G - 1) / G, G);
        const QkvLane qc = qkv_lane_consts(p, l, lane);
        for (int row = bid * 8 + wid; row < R_ALL; row += G * 8) prep_qkv_row(p, l, row, lane, qc);
    }
}

__device__ __forceinline__ void hgrn_scan(KP p) {
    const int gi = bid_() * NTHREADS + tid_();
    if (gi >= 16 * 4096) return;
    const int seq = gi >> 12, de = gi & 4095, d = de >> 6;
    float* U = (float*)(p->ws + Z_U) + (size_t)seq * NCHUNK * 4096 + de; const float* Gv = (const float*)(p->ws + Z_G) + (size_t)seq * NCHUNK * 64 + d;
    float S = 0.f;
    for (int j = 0; j < NCHUNK; j += 4) {
        float u[4], g[4];
#pragma unroll
        for (int q = 0; q < 4; ++q) { u[q] = U[(size_t)(j + q) * 4096]; g[q] = Gv[(j + q) * 64]; }
#pragma unroll
        for (int q = 0; q < 4; ++q) { U[(size_t)(j + q) * 4096] = S; S = g[q] * S + u[q]; }
    }
}
__device__ __forceinline__ void attn_simple_unit(unsigned char* lds, const bf16_t* Qrow0  , const bf16_t* Kb, const bf16_t* Vb  ,
                                                 int mode, int NT, int first_key, int q0, bool use_sink, float sink_log2, bf16_t* Orow0  ) {
    float* Ks = (float*)lds; float* Vs = Ks + 4096;
    const int tid = tid_();
    float q[64], o[64], m = -INFINITY, lsum = 0.f;
    if (tid < 256) {
#pragma unroll
        for (int d = 0; d < 64; ++d) { q[d] = bf2f(Qrow0[(size_t)tid * 256 + d]); o[d] = 0.f; }
    }
    for (int tt = 0; tt < NT; ++tt) {
        int key0, pos0 = 0; bool masked = false;
        if (mode == 0) key0 = first_key + 64 * tt;
        else if (tt < 4) key0 = NSEQ + 64 * tt;
        else { pos0 = q0 - 128 + 64 * (tt - 4); key0 = pos0 < 0 ? 0 : (pos0 > NSEQ - 64 ? NSEQ - 64 : pos0); masked = true; }
        __syncthreads();
        for (int i = tid; i < 4096; i += NTHREADS) { const int kk = i >> 6, d = i & 63; Ks[i] = bf2f(Kb[(size_t)(key0 + kk) * 128 + d]); Vs[i] = bf2f(Vb[(size_t)(key0 + kk) * 128 + d]); }
        __syncthreads();
        if (tid < 256) {
            for (int kk = 0; kk < 64; ++kk) {
                if (masked) { const int kp = pos0 + kk, qp = q0 + tid; const int df = qp - kp; if (kp < 0 || kp >= NSEQ || df > 128 || df < -128) continue; }
                float s = 0.f;
#pragma unroll
                for (int d = 0; d < 64; ++d) s += q[d] * Ks[kk * 64 + d];
                if (s > m) { const float f = exp2f(m - s); lsum *= f;
#pragma unroll
                    for (int d = 0; d < 64; ++d) o[d] *= f;
                    m = s; }
                const float pe = exp2f(s - m); lsum += pe;
#pragma unroll
                for (int d = 0; d < 64; ++d) o[d] += pe * Vs[kk * 64 + d];
            }
        }
    }
    if (tid < 256) {
        if (use_sink) lsum += exp2f(sink_log2 - m);
        const float inv = 1.f / lsum;
#pragma unroll
        for (int d = 0; d < 64; ++d) Orow0[(size_t)tid * D + d] = (bf16_t)f2bf(o[d] * inv);
    }
    __syncthreads();
}
__device__ __forceinline__ void ph_attn(KP p, int l, unsigned char* lds) {
    hgrn_scan(p);
    bf16_t* Y = (bf16_t*)(p->ws + Z_YCAT);
    const bf16_t* Qg = (const bf16_t*)(p->ws + Z_QG); const bf16_t* Qw = (const bf16_t*)(p->ws + Z_QW); const bf16_t* Qgc = (const bf16_t*)(p->ws + Z_QGC); const bf16_t* Qwc = (const bf16_t*)(p->ws + Z_QWC);
    const bf16_t* Kg = (const bf16_t*)(p->ws + Z_KG); const bf16_t* Kw = (const bf16_t*)(p->ws + Z_KW); const bf16_t* Vg = (const bf16_t*)(p->ws + Z_VG); const bf16_t* Vw = (const bf16_t*)(p->ws + Z_VW);
    const int nunits = 512 + (l == 0 ? 16 : 0);
    for (int u = bid_(); u < nunits; u += gsz_()) {
        if (u < 256) {
            const int qb = u & 31, h = (u >> 5) & 3, b = u >> 7, row0 = b * NSEQ + qb * 256;
            attn_simple_unit(lds, Qg + (size_t)row0 * 256 + h * 64, Kg + (size_t)b * NKEY * 128 + (h >> 1) * 64, Vg + (size_t)b * NKEY * 128 + (h >> 1) * 64, 0, NKEY / 64, 0, qb * 256, false, 0.f, Y + (size_t)row0 * D + h * 64);
        } else if (u < 512) {
            const int v = u - 256, qb = v & 31, h = (v >> 5) & 3, b = v >> 7, row0 = b * NSEQ + qb * 256;
            attn_simple_unit(lds, Qw + (size_t)row0 * 256 + h * 64, Kw + (size_t)b * NKEY * 128 + (h >> 1) * 64, Vw + (size_t)b * NKEY * 128 + (h >> 1) * 64, 1, 12, 0, qb * 256, true, p->in[14][l * 4 + h] * LOG2E, Y + (size_t)row0 * D + 512 + h * 64);
        } else {
            const int v = u - 512, h = v & 3, b = (v >> 2) & 1, win = v >> 3, row0 = R_LAT + b * NCTX;
            const bf16_t* Qc = (win ? Qwc : Qgc) + (size_t)(b * NCTX) * 256 + h * 64;
            const bf16_t* Kc = (win ? Kw : Kg) + (size_t)b * NKEY * 128 + (h >> 1) * 64; const bf16_t* Vc = (win ? Vw : Vg) + (size_t)b * NKEY * 128 + (h >> 1) * 64;
            attn_simple_unit(lds, Qc, Kc, Vc, 0, 4, NSEQ, 0, win != 0, p->in[14][l * 4 + h] * LOG2E, Y + (size_t)row0 * D + (win ? 512 : 0) + h * 64);
        }
    }
}

namespace attn_body {
using bf16=__hip_bfloat16;
using bf16x8=__attribute__((ext_vector_type(8)))short;
using s16x4=__attribute__((ext_vector_type(4)))short;
using f32x16=__attribute__((ext_vector_type(16)))float;
using u32x4=__attribute__((ext_vector_type(4)))unsigned;
constexpr int D=64, QP=256, KP=128, OP=1024;
constexpr int NW=8,QBLK=32,QB=QBLK*NW,KVBLK=64;
__device__ __forceinline__ int crow(int r,int hi){return (r&3)+8*(r>>2)+4*hi;}
#define SBAR() __builtin_amdgcn_sched_barrier(0)
__device__ __forceinline__ void wmask(f32x16&p0,f32x16&p1,int tb,int qrel,int hi,int q0){
  const float NEG=-INFINITY; const int kb=64*tb+4*hi;
  #pragma unroll
  for(int r=0;r<16;++r){const int kl=kb+(r&3)+8*(r>>2); const int kp=q0-128+kl;
    if(kl<qrel||kl>qrel+256||kp<0||kp>=NSEQ)p0[r]=NEG;
    if(kl+32<qrel||kl+32>qrel+256||kp+32<0||kp+32>=NSEQ)p1[r]=NEG;}
}

constexpr int NSLOT=3, SLOTB=8192;
constexpr int LDS_K=0, LDS_V=NSLOT*SLOTB, LDS_WS=2*NSLOT*SLOTB, LDS_OST=LDS_WS+NW*64*4, LDS_BYTES=LDS_OST+NW*4096;
constexpr float C2=0.125f*1.4426950408889634f;
__device__ __forceinline__ void glds16(const void*gsrc,unsigned lds_dst){unsigned keep;
  asm volatile("s_mov_b32 %0, m0\n\ts_mov_b32 m0, %2\n\ts_nop 0\n\tglobal_load_lds_dwordx4 %1, off\n\ts_mov_b32 m0, %0":"=&s"(keep):"v"(gsrc),"s"(lds_dst):"memory");}
__device__ __forceinline__ float max3f(float a,float b,float c){float r;asm("v_max3_f32 %0, %1, %2, %3":"=v"(r):"v"(a),"v"(b),"v"(c));return r;}
__device__ __forceinline__ float max2f(float a,float b){float r;asm("v_max_f32_e32 %0, %1, %2":"=v"(r):"v"(a),"v"(b));return r;}
__device__ __forceinline__ float fadd_s(float a,float b){float r;asm("v_add_f32_e32 %0, %1, %2":"=v"(r):"v"(a),"v"(b));return r;}
__device__ __forceinline__ float fsub_s(float a,float b){float r;asm("v_sub_f32_e32 %0, %1, %2":"=v"(r):"v"(a),"v"(b));return r;}
typedef float f32x2_t __attribute__((ext_vector_type(2))); typedef __bf16 bf16x2_t __attribute__((ext_vector_type(2)));
__device__ __forceinline__ unsigned cvtpk_s(float lo,float hi){f32x2_t v={lo,hi};bf16x2_t b=__builtin_convertvector(v,bf16x2_t);return __builtin_bit_cast(unsigned,b);}
#define WAIT_BAR(N) asm volatile("s_waitcnt vmcnt(" #N ") lgkmcnt(0)\n\ts_barrier":::"memory")

__device__ __forceinline__ void qkt(f32x16&p0,f32x16&p1,const char*Kslot,const bf16x8*qr,const f32x16&negm,int r32,int hi){
  const char*kb=Kslot+hi*1024+r32*16;
  #pragma unroll
  for(int d0=0;d0<4;++d0){
    const bf16x8 b0=*reinterpret_cast<const bf16x8*>(kb+d0*2048);
    const bf16x8 b1=*reinterpret_cast<const bf16x8*>(kb+d0*2048+512);
    if(d0==0){p0=__builtin_amdgcn_mfma_f32_32x32x16_bf16(b0,qr[0],negm,0,0,0);p1=__builtin_amdgcn_mfma_f32_32x32x16_bf16(b1,qr[0],negm,0,0,0);}
    else{p0=__builtin_amdgcn_mfma_f32_32x32x16_bf16(b0,qr[d0],p0,0,0,0);p1=__builtin_amdgcn_mfma_f32_32x32x16_bf16(b1,qr[d0],p1,0,0,0);}}
}
typedef __attribute__((address_space(3))) const char* lds_cptr;
typedef short v4i16_t __attribute__((ext_vector_type(4)));
__device__ __forceinline__ void kload8(bf16x8*kf,lds_cptr kp){
  kf[0]=*(const __attribute__((address_space(3))) bf16x8*)(kp);      kf[1]=*(const __attribute__((address_space(3))) bf16x8*)(kp+512);
  kf[2]=*(const __attribute__((address_space(3))) bf16x8*)(kp+2048); kf[3]=*(const __attribute__((address_space(3))) bf16x8*)(kp+2560);
  kf[4]=*(const __attribute__((address_space(3))) bf16x8*)(kp+4096); kf[5]=*(const __attribute__((address_space(3))) bf16x8*)(kp+4608);
  kf[6]=*(const __attribute__((address_space(3))) bf16x8*)(kp+6144); kf[7]=*(const __attribute__((address_space(3))) bf16x8*)(kp+6656);
}
__device__ __forceinline__ void kload2(bf16x8*kf,lds_cptr kp,int j){ kf[2*j]=*(const __attribute__((address_space(3))) bf16x8*)(kp+j*2048); kf[2*j+1]=*(const __attribute__((address_space(3))) bf16x8*)(kp+j*2048+512); }
__device__ __forceinline__ s16x4 vtr(lds_cptr p){ return __builtin_bit_cast(s16x4,__builtin_amdgcn_ds_read_tr16_b64_v4i16((__attribute__((address_space(3))) v4i16_t*)p)); }
__device__ __forceinline__ float rowmax(const f32x16&p0,const f32x16&p1){
  float a=max3f(p0[0],p0[1],p1[0]),b=max3f(p0[2],p0[3],p1[1]);a=max3f(a,p1[2],p1[3]);
  #pragma unroll
  for(int r=4;r<16;r+=4){a=max3f(a,p0[r],p0[r+1]);b=max3f(b,p0[r+2],p0[r+3]);a=max3f(a,p1[r],p1[r+1]);b=max3f(b,p1[r+2],p1[r+3]);}
  const float m=max2f(a,b);
  auto rr=__builtin_amdgcn_permlane32_swap(__float_as_uint(m),__float_as_uint(m),false,false);
  return max2f(__uint_as_float(rr[0]),__uint_as_float(rr[1]));
}
__device__ __forceinline__ void pv(f32x16*o,int vb,bf16x8 pa0,bf16x8 pa1,bf16x8 pa2,bf16x8 pa3){
  #pragma unroll
  for(int d0=0;d0<2;++d0){s16x4 lo[4],hi[4];
    #pragma unroll
    for(int ks=0;ks<4;++ks){
      asm volatile("ds_read_b64_tr_b16 %0,%1 offset:%c2":"=&v"(lo[ks]):"v"(vb),"i"(d0*4096+ks*1024):"memory");
      asm volatile("ds_read_b64_tr_b16 %0,%1 offset:%c2":"=&v"(hi[ks]):"v"(vb),"i"(d0*4096+ks*1024+512):"memory");}
    asm volatile("s_waitcnt lgkmcnt(0)":::"memory");SBAR();
    #define PK(k) (bf16x8){lo[k][0],lo[k][1],lo[k][2],lo[k][3],hi[k][0],hi[k][1],hi[k][2],hi[k][3]}
    o[d0]=__builtin_amdgcn_mfma_f32_32x32x16_bf16(pa0,PK(0),o[d0],0,0,0);
    o[d0]=__builtin_amdgcn_mfma_f32_32x32x16_bf16(pa1,PK(1),o[d0],0,0,0);
    o[d0]=__builtin_amdgcn_mfma_f32_32x32x16_bf16(pa2,PK(2),o[d0],0,0,0);
    o[d0]=__builtin_amdgcn_mfma_f32_32x32x16_bf16(pa3,PK(3),o[d0],0,0,0);
    #undef PK
  }
}

#ifndef ATTN_STORE16
#define ATTN_STORE16(p,v) (*(u32x4*)(p)=(v))
#endif
template<int MODE,int NMASKT,int THRL> __device__ __forceinline__ void attn_unit(const bf16*Q0,const bf16*__restrict__ Kh,const bf16*__restrict__ Vh,bf16*O0,int NT,int key_first,int q0,bool use_sink,float sink_l2,char*shm){
  const int tid=tid_(),lane=tid&63,r32=lane&31,hi=lane>>5; const int wid=__builtin_amdgcn_readfirstlane(tid>>6);
  const bf16*Qw=Q0+(long)(wid*QBLK)*QP;
  auto krow=[&](int t)->long{ if(MODE==0) return (long)key_first+64*t; if(t<4) return (long)NSEQ+64*t; int p=q0-128+64*(t-4); p=p<0?0:(p>NSEQ-64?NSEQ-64:p); return (long)p; };
  const unsigned lds0=(unsigned)(uintptr_t)shm;
  float*wsf=(float*)(shm+LDS_WS)+wid*64;
  const bf16*ksrc=Kh+(long)lane*KP+wid*8;
  const bf16*vsrc=Vh+(long)(16*(wid&3)+(lane>>2))*KP+(wid>>2)*32+(lane&3)*8;
  const unsigned kdst=lds0+LDS_K+wid*1024, vdst=lds0+LDS_V+wid*1024;
  #define DMA_K(t,slot) glds16(ksrc+krow(t)*KP,(unsigned)__builtin_amdgcn_readfirstlane(kdst+(slot)))
  #define DMA_V(t,slot) glds16(vsrc+krow(t)*KP,(unsigned)__builtin_amdgcn_readfirstlane(vdst+(slot)))
  const int vb0=(int)(lds0+LDS_V)+((lane>>4)&1)*32+(lane&3)*8+(4*hi+((lane&15)>>2))*64;
  const char*Kbase=shm+LDS_K; bf16x8 kf[8];
  const lds_cptr shm3=(lds_cptr)shm; const lds_cptr kp0=shm3+LDS_K+hi*1024+r32*16; const lds_cptr vp0=shm3+LDS_V+((lane>>4)&1)*32+(lane&3)*8+(4*hi+((lane&15)>>2))*64;
  DMA_K(0,0);DMA_V(0,0);DMA_K(1,SLOTB);
  bf16x8 qr[4];
  #pragma unroll
  for(int d0=0;d0<4;++d0)qr[d0]=*reinterpret_cast<const bf16x8*>(&Qw[(long)r32*QP+d0*16+hi*8]);
  float mhat=0.f,l_reg=0.f;f32x16 o[2];o[0]=f32x16{};o[1]=f32x16{};f32x16 negm=f32x16{};asm volatile("":"+v"(negm));
  const int qrel=wid*QBLK+r32;
  #define CMASK(P0,P1,t) do{ if(NMASKT>0){int jb_=(t)-(NT-NMASKT); if(jb_>=0)wmask(P0,P1,jb_,qrel,hi,q0);} }while(0)
  bool resc=false;
  #define START(P0,P1) do{ const float rm=rowmax(P0,P1); resc=false; \
    { const float dl=rm; mhat=fadd_s(mhat,dl); \
      _Pragma("unroll") for(int r=0;r<16;++r){P0[r]=fsub_s(P0[r],dl);P1[r]=fsub_s(P1[r],dl);} \
      _Pragma("unroll") for(int r=0;r<16;++r)negm[r]=-mhat; asm volatile("":"+v"(negm)); } \
    _Pragma("unroll") for(int r=0;r<16;++r)P0[r]=__builtin_amdgcn_exp2f(P0[r]); }while(0)
  #define RESC() do{ if(resc){ asm volatile("s_waitcnt lgkmcnt(0)":::"memory"); \
      _Pragma("unroll") for(int d_=0;d_<2;++d_) _Pragma("unroll") for(int r=0;r<16;++r)o[d_][r]*=wsf[crow(r,hi)]; } }while(0)
  f32x16 pA0,pA1,pB0,pB1;
  int sl_prev=0,sl_cur=0,sl_next=SLOTB;
  #define ROT() do{sl_prev=sl_cur;sl_cur=sl_next;sl_next=(sl_next==(NSLOT-1)*SLOTB)?0:sl_next+SLOTB;}while(0)
  DMA_K(2,2*SLOTB);
  WAIT_BAR(3);
  qkt(pA0,pA1,Kbase,qr,negm,r32,hi);asm volatile("s_nop 15\n\ts_nop 7":"+v"(pA0),"+v"(pA1));CMASK(pA0,pA1,0);
  START(pA0,pA1);
  _Pragma("unroll") for(int r=0;r<16;++r)pA1[r]=__builtin_amdgcn_exp2f(pA1[r]);
  WAIT_BAR(0);
  DMA_K(3,0);DMA_V(1,SLOTB);
  ROT();
  kload8(kf,kp0+sl_cur);
  WAIT_BAR(2);
  s16x4 vlo[8],vhi[8]; u32x4 pw0,pw1,pw2,pw3;
  #define PKW(P,B) cvtpk_s(P[B],P[B+1])
  #define PAF(k) __builtin_bit_cast(bf16x8,pw##k)
  #define VFR(i) (bf16x8){vlo[i][0],vlo[i][1],vlo[i][2],vlo[i][3],vhi[i][0],vhi[i][1],vhi[i][2],vhi[i][3]}
  #define PIN(x) asm volatile("":"+v"(x))
  #define MX3(a,b,c) __builtin_fmaxf(__builtin_fmaxf((a),(b)),(c))
  #define GAPA(MF,A0,A1,A2,A3,W0,W1,PW) do{ MF; sacc+=A0; sacc+=A1; sacc+=A2; sacc+=A3; PIN(sacc); W0; W1; PIN(PW); SBAR(); }while(0)
  #define EX(v) __builtin_amdgcn_exp2f(v)
  #define GAPB(MF,X,B) do{ MF; X[B]=EX(X[B]); X[B+1]=EX(X[B+1]); X[B+2]=EX(X[B+2]); X[B+3]=EX(X[B+3]); PIN(X); SBAR(); }while(0)
  #define VRD(i) do{ vlo[i]=vtr(vp_+(((i)>>2)*4096+((i)&3)*1024)); vhi[i]=vtr(vp_+(((i)>>2)*4096+((i)&3)*1024+512)); }while(0)
  #define KRD(G,j) do{ if(G){ kload2(kf,kp0+sl_next,j); SBAR(); } }while(0)
  #define STEP(C0,C1,P0,P1,t,GK,GV,GL) do{ SBAR(); \
    const lds_cptr vp_=vp0+sl_prev; \
    VRD(0); SBAR(); float sacc=(P0[0]+P0[1]); \
    GAPA(C0=__builtin_amdgcn_mfma_f32_32x32x16_bf16(kf[0],qr[0],negm,0,0,0), P0[2],P0[3],P0[4],P0[5],     pw0[0]=PKW(P0,0), pw0[1]=PKW(P0,2), pw0); \
    VRD(4); SBAR(); GAPA(C1=__builtin_amdgcn_mfma_f32_32x32x16_bf16(kf[1],qr[0],negm,0,0,0), P0[6],P0[7],P0[8],P0[9],     pw0[2]=PKW(P0,4), pw0[3]=PKW(P0,6), pw0); \
    VRD(1); SBAR(); GAPA(C0=__builtin_amdgcn_mfma_f32_32x32x16_bf16(kf[2],qr[1],C0,0,0,0),   P0[10],P0[11],P0[12],P0[13], pw1[0]=PKW(P0,8), pw1[1]=PKW(P0,10), pw1); \
    VRD(5); SBAR(); GAPA(C1=__builtin_amdgcn_mfma_f32_32x32x16_bf16(kf[3],qr[1],C1,0,0,0),   P0[14],P0[15],P1[0],P1[1],   pw1[2]=PKW(P0,12),pw1[3]=PKW(P0,14), pw1); \
    VRD(2); SBAR(); GAPA(C0=__builtin_amdgcn_mfma_f32_32x32x16_bf16(kf[4],qr[2],C0,0,0,0),   P1[2],P1[3],P1[4],P1[5],     pw2[0]=PKW(P1,0), pw2[1]=PKW(P1,2), pw2); \
    VRD(6); SBAR(); GAPA(C1=__builtin_amdgcn_mfma_f32_32x32x16_bf16(kf[5],qr[2],C1,0,0,0),   P1[6],P1[7],P1[8],P1[9],     pw2[2]=PKW(P1,4), pw2[3]=PKW(P1,6), pw2); \
    VRD(3); SBAR(); GAPA(C0=__builtin_amdgcn_mfma_f32_32x32x16_bf16(kf[6],qr[3],C0,0,0,0),   P1[10],P1[11],P1[12],P1[13], pw3[0]=PKW(P1,8), pw3[1]=PKW(P1,10), pw3); \
    VRD(7); SBAR(); GAPA(C1=__builtin_amdgcn_mfma_f32_32x32x16_bf16(kf[7],qr[3],C1,0,0,0),   P1[14],P1[15],0.f,0.f,       pw3[2]=PKW(P1,12),pw3[3]=PKW(P1,14), pw3); \
    l_reg+=sacc; \
    if(GK){DMA_K((t)+3,sl_cur);} if(GV){DMA_V((t)+1,sl_next);} \
    CMASK(C0,C1,t); \
    { float a=MX3(C0[0],C0[1],C1[0]),b=MX3(C0[2],C0[3],C1[1]); a=MX3(a,C1[2],C1[3]); \
      _Pragma("unroll") for(int r=4;r<16;r+=4){a=MX3(a,C0[r],C0[r+1]);b=MX3(b,C0[r+2],C0[r+3]);a=MX3(a,C1[r],C1[r+1]);b=MX3(b,C1[r+2],C1[r+3]);} \
      float rm=__builtin_fmaxf(a,b); { auto rr=__builtin_amdgcn_permlane32_swap(__float_as_uint(rm),__float_as_uint(rm),false,false); rm=__builtin_fmaxf(__uint_as_float(rr[0]),__uint_as_float(rr[1])); } \
      resc=false; \
      if(__builtin_expect(__any(rm>(float)THRL),0)){ const float dl=__builtin_fmaxf(rm,0.f); mhat+=dl; \
        _Pragma("unroll") for(int r=0;r<16;++r){C0[r]-=dl;C1[r]-=dl;} \
        _Pragma("unroll") for(int r=0;r<16;++r)negm[r]=-mhat; asm volatile("":"+v"(negm)); \
        const float f=__builtin_amdgcn_exp2f(-dl); l_reg*=f; if(hi==0)wsf[r32]=f; resc=true; } } \
    SBAR(); \
    GAPB(o[0]=__builtin_amdgcn_mfma_f32_32x32x16_bf16(PAF(0),VFR(0),o[0],0,0,0), C0,0); \
    GAPB(o[1]=__builtin_amdgcn_mfma_f32_32x32x16_bf16(PAF(0),VFR(4),o[1],0,0,0), C0,4); \
    KRD(GL,0); GAPB(o[0]=__builtin_amdgcn_mfma_f32_32x32x16_bf16(PAF(1),VFR(1),o[0],0,0,0), C0,8); \
    KRD(GL,1); GAPB(o[1]=__builtin_amdgcn_mfma_f32_32x32x16_bf16(PAF(1),VFR(5),o[1],0,0,0), C0,12); \
    KRD(GL,2); GAPB(o[0]=__builtin_amdgcn_mfma_f32_32x32x16_bf16(PAF(2),VFR(2),o[0],0,0,0), C1,0); \
    KRD(GL,3); GAPB(o[1]=__builtin_amdgcn_mfma_f32_32x32x16_bf16(PAF(2),VFR(6),o[1],0,0,0), C1,4); \
    GAPB(o[0]=__builtin_amdgcn_mfma_f32_32x32x16_bf16(PAF(3),VFR(3),o[0],0,0,0), C1,8); \
    GAPB(o[1]=__builtin_amdgcn_mfma_f32_32x32x16_bf16(PAF(3),VFR(7),o[1],0,0,0), C1,12); \
    }while(0)
  int t=1;
  #undef CMASK
  #define CMASK(P0,P1,t) do{}while(0)
  for(;t+1+(NMASKT>4?NMASKT:4)<NT;t+=2){
    STEP(pB0,pB1,pA0,pA1,t,true,true,true);     WAIT_BAR(2); RESC(); ROT();
    STEP(pA0,pA1,pB0,pB1,t+1,true,true,true);   WAIT_BAR(2); RESC(); ROT();
  }
  #undef CMASK
  #define CMASK(P0,P1,t) do{ if(NMASKT>0){int jb_=(t)-(NT-NMASKT); if(jb_>=0)wmask(P0,P1,jb_,qrel,hi,q0);} }while(0)
  #define ENDW(tt) do{ if((tt)+3<NT){WAIT_BAR(2);} else if((tt)+2<NT){WAIT_BAR(1);} else {WAIT_BAR(0);} }while(0)
  for(;t+1<NT;t+=2){
    STEP(pB0,pB1,pA0,pA1,t,(t+3<NT),(t+1<NT),(t+1<NT));       ENDW(t);   RESC(); ROT();
    STEP(pA0,pA1,pB0,pB1,t+1,(t+4<NT),(t+2<NT),(t+2<NT));     ENDW(t+1); RESC(); ROT();
  }
  STEP(pB0,pB1,pA0,pA1,NT-1,false,false,false); RESC();
  { float sacc=pB0[0]+pB0[1]; _Pragma("unroll") for(int r=2;r<16;++r)sacc+=pB0[r]; _Pragma("unroll") for(int r=0;r<16;++r)sacc+=pB1[r]; l_reg+=sacc;
    pw0=(u32x4){PKW(pB0,0),PKW(pB0,2),PKW(pB0,4),PKW(pB0,6)};pw1=(u32x4){PKW(pB0,8),PKW(pB0,10),PKW(pB0,12),PKW(pB0,14)};pw2=(u32x4){PKW(pB1,0),PKW(pB1,2),PKW(pB1,4),PKW(pB1,6)};pw3=(u32x4){PKW(pB1,8),PKW(pB1,10),PKW(pB1,12),PKW(pB1,14)};
    SBAR(); pv(o,vb0+sl_cur,PAF(0),PAF(1),PAF(2),PAF(3)); }
  #undef PKW
  #undef PAF
  #undef VFR
  #undef PIN
  #undef MX3
  #undef GAPA
  #undef GAPB
  #undef EX
  #undef VRD
  #undef KRD
  #undef STEP
  #undef ENDW
  {auto rr=__builtin_amdgcn_permlane32_swap(__float_as_uint(l_reg),__float_as_uint(l_reg),false,false);l_reg=__uint_as_float(rr[0])+__uint_as_float(rr[1]);}
  if(use_sink)l_reg+=__builtin_amdgcn_exp2f(sink_l2-mhat);
  if(hi==0)wsf[32+r32]=l_reg;asm volatile("s_waitcnt lgkmcnt(0)":::"memory");
  float rli[16];
  #pragma unroll
  for(int r=0;r<16;++r)rli[r]=__builtin_amdgcn_rcpf(wsf[32+crow(r,hi)]);
  bf16*Ow=O0+(long)(wid*QBLK)*OP;
  { bf16*stg=(bf16*)(shm+LDS_OST)+wid*2048;
    #pragma unroll
    for(int r=0;r<16;++r){const int orow=crow(r,hi);
      #pragma unroll
      for(int d0=0;d0<2;++d0)stg[orow*64+d0*32+r32]=__float2bfloat16(o[d0][r]*rli[r]);}
    asm volatile("s_waitcnt lgkmcnt(0)":::"memory");
    #pragma unroll
    for(int i=0;i<4;++i){const int row=i*8+(lane>>3),ch=lane&7; const u32x4 v=*(const u32x4*)(stg+row*64+ch*8); ATTN_STORE16(Ow+(long)row*OP+ch*8,v);} }
  asm volatile("s_waitcnt lgkmcnt(0)\n\ts_barrier":::"memory");
  #undef DMA_K
  #undef DMA_V
  #undef CMASK
  #undef START
  #undef RESC
  #undef ROT
}
constexpr int ATTN_LDS_BYTES=LDS_BYTES;
#undef SBAR
#undef WAIT_BAR
}

__device__ __forceinline__ void ph_attn_f(KP p, int l, unsigned char* lds, bool do_scan = true) {
    if (do_scan) { if (FAST_HGRN) hgrn_scan_f(p); else hgrn_scan(p); }
    using attn_body::bf16;
    bf16* Y = (bf16*)(p->ws + Z_YCAT);
    const bf16* Qg = (const bf16*)(p->ws + Z_QG); const bf16* Qw = (const bf16*)(p->ws + Z_QW); const bf16* Qgc = (const bf16*)(p->ws + Z_QGC); const bf16* Qwc = (const bf16*)(p->ws + Z_QWC);
    const bf16* Kg = (const bf16*)(p->ws + Z_KG); const bf16* Kw = (const bf16*)(p->ws + Z_KW); const bf16* Vg = (const bf16*)(p->ws + Z_VG); const bf16* Vw = (const bf16*)(p->ws + Z_VW);
    const int G = gsz_(), bid = bid_();
    __syncthreads();
    for (int vb = bid; vb < 256; vb += G) {
        const int v = (G == 256) ? (((vb & 7) >> 1) * 64 + (vb & 1) * 32 + (vb >> 3)) : vb;
        const int b = v >> 7, kvh = (v >> 6) & 1, h = kvh * 2 + ((v >> 5) & 1), qb = v & 31, row0 = b * NSEQ + qb * 256;
        const size_t kvo = (size_t)b * NKEY * 128 + kvh * 64;
        attn_body::attn_unit<0, 0, 8>(Qg + (size_t)row0 * 256 + h * 64, Kg + kvo, Vg + kvo, Y + (size_t)row0 * D + h * 64, NKEY / 64, 0, 0, false, 0.f, (char*)lds);
        attn_body::attn_unit<1, 8, 8>(Qw + (size_t)row0 * 256 + h * 64, Kw + kvo, Vw + kvo, Y + (size_t)row0 * D + 512 + h * 64, 12, 0, qb * 256, true, p->in[14][l * 4 + h] * LOG2E, (char*)lds);
    }
    if (l == 0) for (int v = bid; v < 16; v += G) {
        const int h = v & 3, b = (v >> 2) & 1, win = v >> 3, row0 = R_LAT + b * NCTX;
        const size_t kvo = (size_t)b * NKEY * 128 + (h >> 1) * 64;
        attn_body::attn_unit<0, 0, 8>((win ? Qwc : Qgc) + (size_t)(b * NCTX) * 256 + h * 64, (win ? Kw : Kg) + kvo, (win ? Vw : Vg) + kvo, Y + (size_t)row0 * D + (win ? 512 : 0) + h * 64, 4, NSEQ, 0, win != 0, p->in[14][l * 4 + h] * LOG2E, (char*)lds);
    }
}

__device__ __forceinline__ void hgrn_pass3_unit(KP p, int l, unsigned char* lds, int unit) {
    float* qs = (float*)lds; float* vs = qs + 4096; float* ks = vs + 4096; float* cs = ks + 4096; float* Ss = cs + 4096; float* sc = Ss + 4096; float* os = sc + 4096;
    const int tid = tid_(), lane = tid & 63, wid = tid >> 6;
    const int cpos = unit % NCHUNK, head = (unit / NCHUNK) & 3, b = unit / (NCHUNK * 4);
    const int row0 = (cpos < 4) ? R_LAT + b * NCTX + cpos * 64 : b * NSEQ + (cpos - 4) * 64;
    for (int i = tid; i < 4096; i += NTHREADS) os[i] = 0.f;
    for (int dir = 0; dir < 2; ++dir) {
        const int j = (cpos < 4) ? (dir ? 3 - cpos : cpos) : 4 + (dir ? 127 - (cpos - 4) : (cpos - 4));
        const int seq = (b * 4 + head) * 2 + dir;
        __syncthreads();
        hgrn_load_chunk(p, l, row0, dir, head, qs, vs, ks, cs);
        const float* Sg = (const float*)(p->ws + Z_U) + ((size_t)seq * NCHUNK + j) * 4096;
        for (int i = tid; i < 4096; i += NTHREADS) Ss[i] = Sg[i];
        for (int i = tid; i < 4096; i += NTHREADS) { const int tau = i >> 6, sig = i & 63; float a = 0.f;
            if (sig <= tau) { for (int d = 0; d < 64; ++d) a += qs[tau * 64 + d] * ks[sig * 64 + d] * __expf(cs[tau * 64 + d] - cs[sig * 64 + d]); }
            sc[i] = a; }
        __syncthreads();
        { const int tau = tid >> 3, e0 = (tid & 7) * 8; float acc[8];
#pragma unroll
          for (int e = 0; e < 8; ++e) acc[e] = 0.f;
          for (int d = 0; d < 64; ++d) { const float qv = qs[tau * 64 + d] * __expf(cs[tau * 64 + d]);
#pragma unroll
              for (int e = 0; e < 8; ++e) acc[e] += qv * Ss[d * 64 + e0 + e]; }
          for (int sig = 0; sig <= tau; ++sig) { const float sv = sc[tau * 64 + sig];
#pragma unroll
              for (int e = 0; e < 8; ++e) acc[e] += sv * vs[sig * 64 + e0 + e]; }
          const int tok = dir ? 63 - tau : tau;
#pragma unroll
          for (int e = 0; e < 8; ++e) os[tok * 64 + e0 + e] += acc[e]; }
        __syncthreads();
    }
    const bf16_t* P = (const bf16_t*)(p->ws + Z_P); bf16_t* Y = (bf16_t*)(p->ws + Z_YCAT);
    for (int tok = wid; tok < 64; tok += 8) { const float v = os[tok * 64 + lane];
        const float y = v * rsqrtf(wave_sum(v * v) * (1.f / 64.f) + EPS) * p->in[22][l * 64 + lane];
        const float g = bf2f(P[(size_t)(row0 + tok) * DIN + C_RG + head * 64 + lane]);
        Y[(size_t)(row0 + tok) * D + 768 + head * 64 + lane] = (bf16_t)f2bf(y * silu_(g)); }
    __syncthreads();
}
__device__ __forceinline__ void ph_hgrn3(KP p, int l, unsigned char* lds) {
    hgrn_pass3_run(p, l, lds);
    if (l == 0 && DEPTH > 1 && gsz_() == 256) { __syncthreads(); ph_cvt(p, 1, lds, 32, 224, CVT_E1, CVT_E2); }
}

__device__ __forceinline__ void ph_outproj(KP p, int l, unsigned char* lds) {
    const bf16_t* A = (const bf16_t*)(p->ws + Z_YCAT); const bf16_t* Bt = (const bf16_t*)(p->ws + Z_WOUT); float* X = (float*)(p->ws + WS_X);
    const int T = (l == 0) ? R_ALL : R_LAT; const int TM = T / 128, TN = 8;
    for (int it = bid_(); it < TM * TN; it += gsz_()) { const int mt = it / TN, nt = it % TN;
        auto epi = [&](int row, int col, float v, float) { const int c = nt * 128 + col; X[(size_t)row * D + c] = xrow_src(p, l, row)[c] + mod_vec(p, l, row, 2)[c] * v; };
        gemm_simple_tile<1>(A, RowId{}, Bt, 1024, mt * 128, nt * 128, 0, epi); }
}

__device__ __forceinline__ void ph_norm2(KP p, int l, unsigned char* lds, int cnt_off = 0) {
    constexpr int RS = 1032, NSTG = 80;
    const int T = (l == 0) ? R_ALL : R_LAT;
    bf16_t* AH = (bf16_t*)lds; bf16_t* AL = AH + 16 * RS;
    float* PART = (float*)(lds + 2 * 16 * RS * 2); float* LOG = PART + 8 * 16 * 64;
    int* hist = (int*)(LOG + 16 * 64); int* hbase = hist + 64; int* s_e = hbase + 64; int* s_r = s_e + NSTG * 8; float* s_w = (float*)(s_r + NSTG * 8); float* msb = s_w + NSTG * 8;
    const int tid = tid_(), lane = tid & 63, wid = tid >> 6, fr = lane & 15, fq = lane >> 4, bid = bid_(), G = gsz_();
    bf16_t* Tok = (bf16_t*)(p->ws + Z_A); const bf16_t* X = (const bf16_t*)(p->ws + WS_X);
    const float* g2 = p->in[7] + l * D; const float* rw = p->in[23] + (size_t)l * 1024 * 64; const float* rbias = p->in[24] + l * 64;
    unsigned* cnt = (unsigned*)(p->ws + WS_CTL) + CW_CNT + cnt_off + l * 64;
    int* tok_e = (int*)(p->ws + WS_TOKE); int* tok_p = (int*)(p->ws + WS_TOKP); int* expl = (int*)(p->ws + WS_EXPL); float* expw = (float*)(p->ws + WS_EXPW);
    bf16x8 bh[4][4], bl[4][4];
#pragma unroll
    for (int t = 0; t < 4; ++t)
#pragma unroll
        for (int k = 0; k < 4; ++k) { float v[8], lo[8];
#pragma unroll
            for (int j = 0; j < 8; ++j) v[j] = rw[(size_t)((wid * 4 + k) * 32 + fq * 8 + j) * 64 + t * 16 + fr];
            const u32x4 hh = pack8(v);
            const float hf[8] = {bf2f(hh.x & 0xffffu), bf2f(hh.x >> 16), bf2f(hh.y & 0xffffu), bf2f(hh.y >> 16), bf2f(hh.z & 0xffffu), bf2f(hh.z >> 16), bf2f(hh.w & 0xffffu), bf2f(hh.w >> 16)};
#pragma unroll
            for (int j = 0; j < 8; ++j) lo[j] = v[j] - hf[j];
            const u32x4 ll = pack8(lo);
            bh[t][k] = __builtin_bit_cast(bf16x8, hh); bl[t][k] = __builtin_bit_cast(bf16x8, ll); }
    const float mybias = rbias[lane];
    const int rpb = (T + G - 1) / G;
    for (int base = bid * rpb; base < T; base += G * rpb) {
        const int r1 = (base + rpb < T) ? base + rpb : T;
        if (tid < 64) hist[tid] = 0;
        for (int s0 = base; s0 < r1; s0 += 16) {
#pragma unroll
            for (int j2 = 0; j2 < 2; ++j2) { const int lr = wid * 2 + j2, row = s0 + lr;
                if (row < r1) {
                    const bf16_t* xrow = X + (size_t)row * D; const float* shift = mod_vec(p, l, row, 3); const float* scale = mod_vec(p, l, row, 4);
                    f32x4 v[4]; float ssq = 0.f;
#pragma unroll
                    for (int j = 0; j < 4; ++j) { const u32x2 r2 = ((const u32x2*)xrow)[lane + 64 * j]; v[j].x = bf2f(r2.x & 0xffffu); v[j].y = bf2f(r2.x >> 16); v[j].z = bf2f(r2.y & 0xffffu); v[j].w = bf2f(r2.y >> 16); ssq += v[j].x * v[j].x + v[j].y * v[j].y + v[j].z * v[j].z + v[j].w * v[j].w; }
                    const float rinv = rsqrtf(wave_sum(ssq) * (1.f / D) + EPS);
#pragma unroll
                    for (int j = 0; j < 4; ++j) { const int idx = lane + 64 * j;
                        const f32x4 gg = ((const f32x4*)g2)[idx], sh = ((const f32x4*)shift)[idx], sc = ((const f32x4*)scale)[idx];
                        f32x4 y; y.x = v[j].x * rinv * gg.x * (1.f + sc.x) + sh.x; y.y = v[j].y * rinv * gg.y * (1.f + sc.y) + sh.y;
                        y.z = v[j].z * rinv * gg.z * (1.f + sc.z) + sh.z; y.w = v[j].w * rinv * gg.w * (1.f + sc.w) + sh.w;
                        u32x2 h; h.x = pk2(y.x, y.y); h.y = pk2(y.z, y.w);
                        u32x2 lw; lw.x = pk2(y.x - bf2f(h.x & 0xffffu), y.y - bf2f(h.x >> 16)); lw.y = pk2(y.z - bf2f(h.y & 0xffffu), y.w - bf2f(h.y >> 16));
                        { int t8 = __builtin_amdgcn_cvt_pk_fp8_f32(clamp8(y.x * TOK8_SCALE), clamp8(y.y * TOK8_SCALE), 0, false); t8 = __builtin_amdgcn_cvt_pk_fp8_f32(clamp8(y.z * TOK8_SCALE), clamp8(y.w * TOK8_SCALE), t8, true);
                          ((unsigned*)((unsigned char*)Tok + (size_t)row * D))[idx] = (unsigned)t8; }
                        *(u32x2*)(AH + lr * RS + idx * 4) = h; *(u32x2*)(AL + lr * RS + idx * 4) = lw; }
                } else {
#pragma unroll
                    for (int j = 0; j < 4; ++j) { const int idx = lane + 64 * j; const u32x2 z = {0u, 0u}; *(u32x2*)(AH + lr * RS + idx * 4) = z; *(u32x2*)(AL + lr * RS + idx * 4) = z; } } }
            __syncthreads();
            { f32x4 acc[4];
#pragma unroll
              for (int t = 0; t < 4; ++t) acc[t] = (f32x4){0.f, 0.f, 0.f, 0.f};
#pragma unroll
              for (int k = 0; k < 4; ++k) { const int ko = (wid * 4 + k) * 32 + fq * 8;
                  const bf16x8 ah = *(const bf16x8*)(AH + fr * RS + ko), al = *(const bf16x8*)(AL + fr * RS + ko);
#pragma unroll
                  for (int t = 0; t < 4; ++t) { acc[t] = __builtin_amdgcn_mfma_f32_16x16x32_bf16(ah, bh[t][k], acc[t], 0, 0, 0);
                      acc[t] = __builtin_amdgcn_mfma_f32_16x16x32_bf16(ah, bl[t][k], acc[t], 0, 0, 0); acc[t] = __builtin_amdgcn_mfma_f32_16x16x32_bf16(al, bh[t][k], acc[t], 0, 0, 0); } }
#pragma unroll
              for (int t = 0; t < 4; ++t)
#pragma unroll
                  for (int r = 0; r < 4; ++r) PART[(wid * 16 + fq * 4 + r) * 64 + t * 16 + fr] = acc[t][r]; }
            __syncthreads();
#pragma unroll
            for (int q = 0; q < 2; ++q) { const int o = tid + q * NTHREADS; float a = 0.f;
#pragma unroll
                for (int w8 = 0; w8 < 8; ++w8) a += PART[w8 * 1024 + o];
                LOG[o] = a; }
            __syncthreads();
#pragma unroll 1
            for (int j2 = 0; j2 < 2; ++j2) { const int lr = wid * 2 + j2, row = s0 + lr;
                if (row >= r1) continue;
                const int sr = row - base;
                const float score = sigmoid_(LOG[lr * 64 + lane]), sel = score + mybias;
                const int e = lane, g = e >> 3;
                int rg = 0;
#pragma unroll
                for (int i = 1; i < 8; ++i) { const int src = (lane & ~7) | ((lane + i) & 7); const float o = __shfl(sel, src); rg += (o > sel) || (o == sel && src < e); }
                float top2 = (rg < 2) ? sel : 0.f;
                top2 += __shfl_xor(top2, 1); top2 += __shfl_xor(top2, 2); top2 += __shfl_xor(top2, 4);
                int grank = 0;
#pragma unroll
                for (int i = 1; i < 8; ++i) { const int og = (g + i) & 7; const float o = __shfl(top2, og * 8); grank += (o > top2) || (o == top2 && og < g); }
                const bool keep = grank < 4;
                const float ms = keep ? sel : -INFINITY;
                float* mrow = msb + wid * 64;
                mrow[lane] = ms;
                __builtin_amdgcn_wave_barrier();
                int rk = 0;
#pragma unroll 4
                for (int i = 0; i < 16; ++i) { const f32x4 o = *(const f32x4*)(mrow + 4 * i);
                    rk += (o.x > ms) || (o.x == ms && 4 * i + 0 < e); rk += (o.y > ms) || (o.y == ms && 4 * i + 1 < e);
                    rk += (o.z > ms) || (o.z == ms && 4 * i + 2 < e); rk += (o.w > ms) || (o.w == ms && 4 * i + 3 < e); }
                __builtin_amdgcn_wave_barrier();
                const bool chosen = keep && rk < 8;
                const float wsum = wave_sum(chosen ? score : 0.f);
                if (chosen) { const int r = atomicAdd(&hist[e], 1); s_e[sr * 8 + rk] = e; s_r[sr * 8 + rk] = r; s_w[sr * 8 + rk] = score / wsum * 2.5f; } }
        }
        __syncthreads();
        if (tid < 64) { const int h = hist[tid]; hbase[tid] = h ? (int)atomicAdd(&cnt[tid], (unsigned)h) : 0; }
        __syncthreads();
        for (int i = tid; i < (r1 - base) * 8; i += NTHREADS) { const int e = s_e[i]; const size_t o = (size_t)base * 8 + i;
            const int pos = hbase[e] + s_r[i]; tok_e[o] = e; tok_p[o] = pos; expl[(size_t)e * R_ALL + pos] = base + (i >> 3); expw[(size_t)e * R_ALL + pos] = s_w[i]; }
        __syncthreads();
    }
}

__device__ __forceinline__ void moe_pad_starts(KP p, int l, int* ps) {
    const unsigned* cnt = (const unsigned*)(p->ws + WS_CTL) + CW_CNT + l * 64;
    if (tid_() == 0) { int acc = 0; for (int e = 0; e < 64; ++e) { ps[e] = acc; acc += (int)((cnt[e] + 255u) / 256u) * 256; } ps[64] = acc; }
    __syncthreads();
}
__device__ __forceinline__ int moe_expert_of_row(const int* ps, int row) { int e = 0; while (e < 63 && row >= ps[e + 1]) ++e; return e; }

__device__ __forceinline__ void ph_slots(KP p, int l, unsigned char* lds) {
    const int T = (l == 0) ? R_ALL : R_LAT;
    int* ps = (int*)lds; moe_pad_starts(p, l, ps);
    const unsigned* cnt = (const unsigned*)(p->ws + WS_CTL) + CW_CNT + l * 64;
    const int* tok_e = (const int*)(p->ws + WS_TOKE); const int* tok_p = (const int*)(p->ws + WS_TOKP); const float* tok_w = (const float*)(p->ws + WS_TOKW);
    int* tok_s = (int*)(p->ws + WS_TOKS); int* slot_t = (int*)(p->ws + WS_SLOTT); float* slot_w = (float*)(p->ws + WS_SLOTW);
    for (int i = bid_() * NTHREADS + tid_(); i < T * 8; i += gsz_() * NTHREADS) { const int e = tok_e[i], slot = ps[e] + tok_p[i]; tok_s[i] = slot; slot_t[slot] = i >> 3; slot_w[slot] = tok_w[i]; }
    for (int i = bid_() * NTHREADS + tid_(); i < T; i += gsz_() * NTHREADS) { slot_t[MAXSLOT + i] = i; slot_w[MAXSLOT + i] = 1.f; }
    for (int i = bid_() * NTHREADS + tid_(); i < 64 * 256; i += gsz_() * NTHREADS) { const int e = i >> 8, j = i & 255; const int r = ps[e] + (int)cnt[e] + j; if (r < ps[e + 1]) { slot_t[r] = 0; slot_w[r] = 0.f; } }
    __syncthreads();
}

__device__ __forceinline__ void ph_gateup(KP p, int l, unsigned char* lds) {
    const int T = (l == 0) ? R_ALL : R_LAT;
    int* ps = (int*)lds; moe_pad_starts(p, l, ps);
    const bf16_t* Tok = (const bf16_t*)(p->ws + Z_A); const bf16_t* Wgu = (const bf16_t*)(p->ws + Z_WGU); bf16_t* H = (bf16_t*)(p->ws + Z_H);
    const int* slot_t = (const int*)(p->ws + WS_SLOTT); const float* slot_w = (const float*)(p->ws + WS_SLOTW);
    const int n128 = ps[64] / 128, nitems = (n128 + T / 128) * 2;
    for (int it = bid_(); it < nitems; it += gsz_()) { const int rt = it >> 1, pn = it & 1;
        if (rt < n128) { const int e = moe_expert_of_row(ps, rt * 128);
            auto epi = [&](int row, int col, float g, float u) { H[(size_t)row * 256 + pn * 128 + col] = (bf16_t)f2bf(silu_(g) * u * slot_w[row]); };
            gemm_simple_tile<2>(Tok, RowGather{slot_t}, Wgu + (size_t)e * 524288, 1024, rt * 128, pn * 256, 128, epi);
        } else { const int t0 = (rt - n128) * 128;
            auto epi = [&](int row, int col, float g, float u) { H[(size_t)(MAXSLOT + row) * 256 + pn * 128 + col] = (bf16_t)f2bf(silu_(g) * u); };
            gemm_simple_tile<2>(Tok, RowId{}, Wgu + (size_t)64 * 524288, 1024, t0, pn * 256, 128, epi); }
    }
}
__device__ __forceinline__ void ph_down(KP p, int l, unsigned char* lds) {
    const int T = (l == 0) ? R_ALL : R_LAT;
    int* ps = (int*)lds; moe_pad_starts(p, l, ps);
    const bf16_t* H = (const bf16_t*)(p->ws + Z_H); const bf16_t* Wd = (const bf16_t*)(p->ws + WS_WD); bf16_t* Y = (bf16_t*)(p->ws + Z_Y); float* X = (float*)(p->ws + WS_X);
    const int n128 = ps[64] / 128, nitems = (n128 + T / 128) * 8;
    for (int it = bid_(); it < nitems; it += gsz_()) { const int rt = it >> 3, nt = it & 7;
        if (rt < n128) { const int e = moe_expert_of_row(ps, rt * 128);
            auto epi = [&](int row, int col, float v, float) { Y[(size_t)row * D + nt * 128 + col] = (bf16_t)f2bf(v); };
            gemm_simple_tile<1>(H, RowId{}, Wd + (size_t)e * 262144, 256, rt * 128, nt * 128, 0, epi);
        } else { const int t0 = (rt - n128) * 128;
            auto epi = [&](int row, int col, float v, float) { const int t = row - MAXSLOT, c = nt * 128 + col; X[(size_t)t * D + c] += mod_vec(p, l, t, 5)[c] * v; };
            gemm_simple_tile<1>(H, RowId{}, Wd + (size_t)64 * 262144, 256, MAXSLOT + t0, nt * 128, 0, epi); }
    }
}
__device__ __forceinline__ void ph_combine(KP p, int l, unsigned char* lds) {
    typedef float f32x2 __attribute__((ext_vector_type(2)));
    const int T = (l == 0) ? R_ALL : R_LAT;
    const int tid = tid_(), lane = tid & 63, wid = tid >> 6;
    const unsigned char* Y8 = (const unsigned char*)(p->ws + Z_Y); bf16_t* X = (bf16_t*)(p->ws + WS_X); const int* tok_e = (const int*)(p->ws + WS_TOKE); const int* tok_p = (const int*)(p->ws + WS_TOKP);
    int* ps = (int*)lds; moe_pad_starts(p, l, ps);
    const size_t yoff = (size_t)(lane >> 4) * MAXSLOT * 256 + (lane & 15) * 16;
    for (int row = bid_() * 8 + wid; row < T; row += gsz_() * 8) {
        const float* g5 = mod_vec(p, l, row, 5) + lane * 16;
        bf16_t* xr = X + (size_t)row * D + lane * 16;
        const int myslot = ps[tok_e[row * 8 + (lane & 7)]] + tok_p[row * 8 + (lane & 7)];
        u32x4 yv[8];
#pragma unroll
        for (int k = 0; k < 8; ++k) { const int sl = __shfl(myslot, k); yv[k] = *(const u32x4*)(Y8 + yoff + (size_t)sl * 256); }
        f32x4 xv[4], gv[4];
#pragma unroll
        for (int q = 0; q < 4; ++q) gv[q] = *(const f32x4*)(g5 + 4 * q);
        unpack8(*(const u32x4*)xr, xv[0], xv[1]); unpack8(*(const u32x4*)(xr + 8), xv[2], xv[3]);
        float a[16];
#pragma unroll
        for (int q = 0; q < 16; ++q) a[q] = 0.f;
#pragma unroll
        for (int k = 0; k < 8; ++k) { const unsigned w[4] = {yv[k].x, yv[k].y, yv[k].z, yv[k].w};
#pragma unroll
            for (int q = 0; q < 4; ++q) { const f32x2 lo = __builtin_amdgcn_cvt_pk_f32_fp8((int)w[q], false), hi = __builtin_amdgcn_cvt_pk_f32_fp8((int)w[q], true);
                a[4 * q] += lo.x; a[4 * q + 1] += lo.y; a[4 * q + 2] += hi.x; a[4 * q + 3] += hi.y; } }
#pragma unroll
        for (int q = 0; q < 4; ++q) { f32x4 av; av.x = a[4 * q]; av.y = a[4 * q + 1]; av.z = a[4 * q + 2]; av.w = a[4 * q + 3]; xv[q] = xv[q] + gv[q] * (av * (1.f / Y8_SCALE)); }
        if (l == DEPTH - 1) { float* dst = p->out + (size_t)row * D + lane * 16;
#pragma unroll
            for (int q = 0; q < 4; ++q) *(f32x4*)(dst + 4 * q) = xv[q]; }
        else { *(u32x4*)xr = (u32x4){pk2(xv[0].x, xv[0].y), pk2(xv[0].z, xv[0].w), pk2(xv[1].x, xv[1].y), pk2(xv[1].z, xv[1].w)};
               *(u32x4*)(xr + 8) = (u32x4){pk2(xv[2].x, xv[2].y), pk2(xv[2].z, xv[2].w), pk2(xv[3].x, xv[3].y), pk2(xv[3].z, xv[3].w)}; }
    }
}
struct MoeSched {
    int ntr, nrt, npn, G, c; const LAS int* tile_e;
    __device__ __forceinline__ bool next(int i, pg8::Unit& u) const {
        const int L = i * G + c; if (L >= nrt * npn) return false;
        const int rt = L / npn, pp = L % npn; const bool routed = rt < ntr;
        const int e = routed ? __builtin_amdgcn_readfirstlane(tile_e[rt]) : 64;
        u.pm = routed ? rt : MAXSLOT / 256 + (rt - ntr); u.pn = e * npn + pp; u.ord = i; return true;
    }
};
constexpr int MOE_UNITS = 6;
constexpr int LDS_RTAB = 131072, LDS_WTAB = LDS_RTAB + MOE_UNITS * 1024, LDS_TILE_E = LDS_WTAB + MOE_UNITS * 1024, LDS_PS = LDS_TILE_E + 2400;
static_assert(LDS_PS + 129 * 4 <= LDS_BYTES - 16, "MoE tables fit above the staging buffers");
__device__ __forceinline__ MoeSched moe_setup(KP p, int l, unsigned char* lds, int npn, bool gather) {
    const int T = (l == 0) ? R_ALL : R_LAT;
    int* ps = (int*)(lds + LDS_PS); int* cl = ps + 65;
    const unsigned* cnt = (const unsigned*)(p->ws + WS_CTL) + CW_CNT + l * 64;
    const int tid = tid_();
    if (tid < 64) cl[tid] = (int)cnt[tid];
    moe_pad_starts(p, l, ps);
    LAS int* tile_e = (LAS int*)((LAS unsigned char*)lds + LDS_TILE_E); LAS int* rtab = (LAS int*)((LAS unsigned char*)lds + LDS_RTAB); LAS float* wtab = (LAS float*)((LAS unsigned char*)lds + LDS_WTAB);
    const int ntr = ps[64] / 256;
    for (int rt = tid; rt < ntr; rt += NTHREADS) tile_e[rt] = moe_expert_of_row(ps, rt * 256);
    __syncthreads();
    MoeSched S{ntr, ntr + T / 256, npn, gsz_(), bid_(), tile_e};
    if (gather) { const int* expl = (const int*)(p->ws + WS_EXPL); const float* expw = (const float*)(p->ws + WS_EXPW); pg8::Unit u;
        for (int i = 0; i < MOE_UNITS && S.next(i, u); ++i) for (int r = tid; r < 256; r += NTHREADS) {
            int tok; float w;
            if (u.pm < MAXSLOT / 256) { const int e = tile_e[u.pm], pos = u.pm * 256 + r - ps[e]; const bool valid = pos < cl[e];
                tok = valid ? expl[(size_t)e * R_ALL + pos] : 0; w = valid ? expw[(size_t)e * R_ALL + pos] : 0.f; }
            else { tok = (u.pm - MAXSLOT / 256) * 256 + r; w = 1.f; }
            rtab[i * 256 + r] = tok; wtab[i * 256 + r] = w; } }
    __syncthreads();
    return S;
}
__device__ __forceinline__ void ph_gateup_f(KP p, int l, unsigned char* lds) {
    const MoeSched S = moe_setup(p, l, lds, 2, true);
    pg8::Gemm g{(const bf16_t*)(p->ws + Z_A), (const bf16_t*)(p->ws + wgu_off(l)), 0, 0, 1024};
    pg8::EpiGU8 E{(unsigned char*)(p->ws + Z_H), (const LAS float*)((LAS unsigned char*)lds + LDS_WTAB)};
    pg8::gemm_phase<pg8::EpiGU8, MoeSched, true, true>((LAS unsigned char*)lds, g, S, E, (const LAS int*)((LAS unsigned char*)lds + LDS_RTAB));
}
__device__ __forceinline__ void ph_down_f(KP p, int l, unsigned char* lds) {
    const MoeSched S = moe_setup(p, l, lds, 4, false);
    pg8::Gemm g{(const bf16_t*)(p->ws + Z_H), (const bf16_t*)(p->ws + wd_off(l)), 0, 0, 256};
    bf16_t* X = (bf16_t*)(p->ws + WS_X);
    pg8::EpiDown E{(bf16_t*)(p->ws + Z_Y), X, (const float*)(p->ws + WS_MOD) + (size_t)l * 3 * 6144 + 5 * 1024};
    pg8::gemm_phase<pg8::EpiDown, MoeSched, false, true>((LAS unsigned char*)lds, g, S, E, nullptr);
}

#ifndef FAST_ATTN
#define FAST_ATTN 1
#endif
#ifndef FAST_GEMM
#define FAST_GEMM 15
#endif
constexpr int PH_PER_LAYER = 10, N_PHASES = 1 + DEPTH * PH_PER_LAYER;
__global__ void __launch_bounds__(NTHREADS, 2) mega(Params parg) {
    extern __shared__ __attribute__((aligned(16))) unsigned char lds[];
    const int lo = parg.ph_lo, hi = parg.ph_hi;
    volatile LAS unsigned* xbw = (volatile LAS unsigned*)(lds + LDS_BYTES - 16);
    if (threadIdx.x == 0) { xbw[0] = 0u; xbw[1] = 0u; xbw[2] = 0u; xbw[3] = 0u; }
    __syncthreads();
    XcdBarrier bar; bar.bar = (unsigned*)(parg.ws + WS_CTL) + CW_BAR; bar.x = 0; bar.st = xbw;
    if (hi - lo > 1) bar = xcd_barrier_post((unsigned*)(parg.ws + WS_CTL) + CW_BAR, xbw);
#ifdef PHMASK
#define IN(k) ((((PHMASK) >> ((k) == 0 ? 0 : ((k) - 1) % PH_PER_LAYER + 1)) & 1) && lo <= (k) && (k) < hi)
#else
#define IN(k) (lo <= (k) && (k) < hi)
#endif
#define SEAM(k) do { if (IN(k) && IN((k) + 1)) xcd_barrier(bar); } while (0)
    if (IN(0)) { ph_pro(kparams(), lds); } SEAM(0);
#pragma unroll
    for (int l = 0; l < DEPTH; ++l) {
        const int b0 = 1 + l * PH_PER_LAYER;
        if (IN(b0 + 0)) { ph_norm1(kparams(), l, lds); } SEAM(b0 + 0);
        if (IN(b0 + 1)) { ph_inproj_f(kparams(), l, lds); } SEAM(b0 + 1);
        if (IN(b0 + 2)) { ph_prep(kparams(), l, lds); } SEAM(b0 + 2);
        if (IN(b0 + 3)) { ph_attn_f(kparams(), l, lds); } SEAM(b0 + 3);
        if (IN(b0 + 4)) { ph_hgrn3(kparams(), l, lds); } SEAM(b0 + 4);
        if (IN(b0 + 5)) { ph_outproj_f(kparams(), l, lds); } SEAM(b0 + 5);
        if (IN(b0 + 6)) { ph_norm2(kparams(), l, lds); } SEAM(b0 + 6);
        if (IN(b0 + 7)) { ph_gateup_f(kparams(), l, lds); } SEAM(b0 + 7);
        if (IN(b0 + 8)) { ph_down_f(kparams(), l, lds); } SEAM(b0 + 8);
        if (IN(b0 + 9)) { ph_combine(kparams(), l, lds); } SEAM(b0 + 9);
    }
#undef IN
#undef SEAM
}

#ifndef MK_ONE_LAUNCH
#define MK_ONE_LAUNCH 1
#endif
extern "C" void kernel_launch(void* const* d_in, const int* in_sizes, int n_in, void* d_out, int out_size, void* d_ws, size_t ws_size, hipStream_t stream) {
    static int grid = 0;
    if (grid == 0) {
        if (n_in != 31 || ws_size < WS_END2) { fprintf(stderr, "kernel_launch: unexpected n_in %d or ws_size %zu (< %zu)\n", n_in, ws_size, (size_t)WS_END2); grid = -1; return; }
        int dev = 0, cus = 0, per_cu = 0;
        if (hipGetDevice(&dev) != hipSuccess || hipDeviceGetAttribute(&cus, hipDeviceAttributeMultiprocessorCount, dev) != hipSuccess) { grid = -1; return; }
        if (hipFuncSetAttribute((const void*)mega, hipFuncAttributeMaxDynamicSharedMemorySize, LDS_BYTES) != hipSuccess) { fprintf(stderr, "kernel_launch: hipFuncSetAttribute failed\n"); grid = -1; return; }
        if (hipOccupancyMaxActiveBlocksPerMultiprocessor(&per_cu, (const void*)mega, NTHREADS, LDS_BYTES) != hipSuccess || per_cu < 1) fprintf(stderr, "kernel_launch: occupancy query says %d\n", per_cu);
        (void)hipGetLastError();
        grid = cus;
    }
    if (grid < 0) return;
    (void)hipMemsetAsync((char*)d_ws + WS_CTL, 0, CTL_ZERO_BYTES, stream);
    Params p{};
    for (int i = 0; i < 31; ++i) p.in[i] = (const float*)d_in[i];
    p.out = (float*)d_out; p.ws = (unsigned char*)d_ws;
#if MK_ONE_LAUNCH
    p.ph_lo = 0; p.ph_hi = N_PHASES;
    hipLaunchKernelGGL(mega, dim3(grid), dim3(NTHREADS), LDS_BYTES, stream, p);
#else
    for (int k = 0; k < N_PHASES; ++k) { p.ph_lo = k; p.ph_hi = k + 1; hipLaunchKernelGGL(mega, dim3(grid), dim3(NTHREADS), LDS_BYTES, stream, p); }
#endif
}
```

```cpp
#include <hip/hip_runtime.h>
#include <hip/hip_bf16.h>
#include <cmath>
#include <cstdint>
#include <cstdio>

#define LAS __attribute__((address_space(3)))

typedef unsigned short bf16_t;
typedef short bf16x8 __attribute__((ext_vector_type(8)));
typedef float f32x4 __attribute__((ext_vector_type(4)));
typedef unsigned u32x4 __attribute__((ext_vector_type(4)));
typedef unsigned u32x2 __attribute__((ext_vector_type(2)));

constexpr int D = 1024, NB = 2, NSEQ = 8192, NCTX = 256, DEPTH = 2;
constexpr int R_LAT = NB * NSEQ, R_CTX = NB * NCTX, R_ALL = R_LAT + R_CTX;
constexpr int DIN = 2816;
constexpr int NKEY = NSEQ + NCTX;
constexpr int NE = 64, TOPK = 8;
constexpr int MAXSLOT = 151552;
constexpr int HROWS = MAXSLOT + R_ALL;
constexpr int NCHUNK = 132;
constexpr float EPS = 1e-6f;
constexpr float TOK8_SCALE = 8.f, WGU8_SCALE = 256.f, H8_SCALE = 16.f, WD8_SCALE = 128.f;
constexpr float GU_DESCALE = 1.f / (TOK8_SCALE * WGU8_SCALE), DN_DESCALE = 1.f / (H8_SCALE * WD8_SCALE);
constexpr float Y8_SCALE = 32.f;
constexpr float QSCALE = 0.125f * 1.4426950408889634f;
constexpr float LOG2E = 1.4426950408889634f;

#ifndef FAST_HGRN
#define FAST_HGRN 1
#endif
constexpr int C_GQ = 0, C_GK = 256, C_GV = 384, C_WQ = 512, C_WK = 768, C_WV = 896, C_CVV = 1024, C_CVG = 1280, C_RQ = 1536, C_RI = 1792, C_RFF = 2048, C_RFB = 2304, C_RG = 2560;

constexpr size_t MiB = (size_t)1 << 20;
constexpr size_t WS_CTL = 0, CTL_ZERO_BYTES = 64 * 1024;
constexpr size_t WS_MOD = 1 * MiB;
constexpr size_t WS_LB = WS_MOD + 256 * 1024;
constexpr size_t WS_ROPE = WS_MOD + 512 * 1024;
constexpr size_t WS_TOKE = 2 * MiB, WS_TOKP = 3 * MiB, WS_TOKW = 4 * MiB, WS_TOKS = 5 * MiB;
constexpr size_t WS_SLOTT = 6 * MiB, WS_SLOTW = 7 * MiB;
constexpr size_t WS_X = 8 * MiB;
constexpr size_t WS_WD = 74 * MiB;
constexpr size_t WS_Z = 107 * MiB;
constexpr size_t Z_A = WS_Z + 0 * MiB;
constexpr size_t Z_WGU = WS_Z + 33 * MiB;
constexpr size_t Z_WIN = WS_Z + 98 * MiB;
constexpr size_t Z_WOUT = WS_Z + 104 * MiB;
constexpr size_t Z_WPW = WS_Z + 106 * MiB;
__host__ __device__ constexpr size_t wgu_off(int l) { return WS_Z + 33 * MiB + (size_t)l * 34078720; }
__host__ __device__ constexpr size_t wd_off(int l) { return 74 * MiB + (size_t)l * 17039360; }
__host__ __device__ constexpr size_t win_off(int l) { return l == 0 ? WS_Z + 98 * MiB : WS_Z + (302 + 42) * MiB; }
__host__ __device__ constexpr size_t wout_off(int l) { return l == 0 ? WS_Z + 104 * MiB : WS_Z + (302 + 48) * MiB; }
__host__ __device__ constexpr size_t wpw_off(int l) { return l == 0 ? WS_Z + 106 * MiB : WS_Z + (302 + 51) * MiB; }
constexpr size_t Z_P = WS_Z + 107 * MiB;
constexpr size_t Z_YCAT = WS_Z + 198 * MiB;
constexpr size_t Z_QG = WS_Z + 231 * MiB, Z_QW = WS_Z + 239 * MiB;
constexpr size_t Z_KG = WS_Z + 247 * MiB, Z_VG = WS_Z + 252 * MiB, Z_KW = WS_Z + 257 * MiB, Z_VW = WS_Z + 262 * MiB;
constexpr size_t Z_QGC = WS_Z + 267 * MiB, Z_QWC = Z_QGC + 512 * 1024;
constexpr size_t Z_U = WS_Z + 268 * MiB;
constexpr size_t Z_G = WS_Z + 301 * MiB;
constexpr size_t Z_Y = WS_Z + 107 * MiB;
constexpr size_t Z_H = WS_Z + 302 * MiB;
constexpr size_t WS_END = WS_Z + 385 * MiB;
constexpr size_t WS_EXPL = WS_END, WS_EXPW = WS_END + 5 * MiB, WS_END2 = WS_END + 10 * MiB;
static_assert(Z_H + (size_t)HROWS * 512 <= WS_END, "H fits");
static_assert(Z_Y + (size_t)MAXSLOT * 1024 <= Z_U, "Y8 below the HGRN state buffers");
static_assert(Z_P + (size_t)R_ALL * DIN * 2 <= Z_YCAT, "P fits");

constexpr int CW_BAR = 0;
constexpr int CW_CNT = 4096;

constexpr int LDS_BYTES = 147456;
constexpr int NTHREADS = 512;

struct Params {
    const float* in[31];
    float* out;
    unsigned char* ws;
    int ph_lo, ph_hi;
};

typedef const __attribute__((address_space(4))) Params* KP;
__device__ __forceinline__ KP kparams() { KP k = (KP)__builtin_amdgcn_kernarg_segment_ptr(); asm volatile("" : "+s"(k)); return k; }

constexpr int LDS_WVTAB_OFF = 147456 - 16 - 256;
__device__ __forceinline__ int hwkey_() { return (int)__builtin_amdgcn_s_getreg((5 << 11) | 4) & 63; }
__device__ __forceinline__ int tid_() { extern __shared__ __attribute__((aligned(16))) unsigned char lds_all[];
    const int w = __builtin_amdgcn_readfirstlane(*(const LAS int*)((LAS unsigned char*)lds_all + LDS_WVTAB_OFF + 4 * hwkey_()));
    int t = (w << 6) | (int)__builtin_amdgcn_mbcnt_hi(~0u, __builtin_amdgcn_mbcnt_lo(~0u, 0u)); asm volatile("" : "+v"(t)); return t; }
__device__ __forceinline__ int bid_() { int b = blockIdx.x; asm volatile("" : "+s"(b)); return b; }
__device__ __forceinline__ int gsz_() { int g = gridDim.x; asm volatile("" : "+s"(g)); return g; }

__device__ __forceinline__ unsigned f2bf(float f) { unsigned u = __float_as_uint(f); return (u + 0x7fffu + ((u >> 16) & 1u)) >> 16; }
__device__ __forceinline__ float bf2f(unsigned h) { return __uint_as_float(h << 16); }
__device__ __forceinline__ unsigned pk2(float lo, float hi) { unsigned r; asm("v_cvt_pk_bf16_f32 %0, %1, %2" : "=v"(r) : "v"(lo), "v"(hi)); return r; }
__device__ __forceinline__ void unpack8(const u32x4 r, f32x4& lo, f32x4& hi) { lo.x = bf2f(r.x & 0xffffu); lo.y = bf2f(r.x >> 16); lo.z = bf2f(r.y & 0xffffu); lo.w = bf2f(r.y >> 16); hi.x = bf2f(r.z & 0xffffu); hi.y = bf2f(r.z >> 16); hi.z = bf2f(r.w & 0xffffu); hi.w = bf2f(r.w >> 16); }
__device__ __forceinline__ float wave_sum(float v) {
#pragma unroll
    for (int o = 1; o < 64; o <<= 1) v += __shfl_xor(v, o);
    return v;
}
__device__ __forceinline__ float clamp8(float v) { return fminf(fmaxf(v, -440.f), 440.f); }
__device__ __forceinline__ float sigmoid_(float x) { return __builtin_amdgcn_rcpf(1.f + __expf(-x)); }
__device__ __forceinline__ float silu_(float x) { return x * sigmoid_(x); }

__device__ __forceinline__ const float* xrow_src(KP p, int l, int row) {
    if (l == 0) return (row < R_LAT) ? p->in[0] + (size_t)row * D : p->in[2] + (size_t)(row - R_LAT) * D;
    return (const float*)(p->ws + WS_X) + (size_t)row * D;
}
__device__ __forceinline__ const float* mod_vec(KP p, int l, int row, int i) {
    const int r = (row < R_LAT) ? (row >> 13) : 2;
    return (const float*)(p->ws + WS_MOD) + ((size_t)l * 3 + r) * 6144 + i * 1024;
}

#define XB_TMO      128
#define XB_XCNT(j)  (256  + 64 * (j))
#define XB_XSUB(j)  (1280 + 64 * (j))
#define XB_XGEN(j)  (2304 + 64 * (j))
#define XB_TOP      3328
#define XB_TOPGEN   3392
#define XCD_BAR_WORDS 3456
#define XB_SPIN_CAP (1u << 18)
__device__ __forceinline__ unsigned xb_ld(unsigned* p)              { return __hip_atomic_load(p, __ATOMIC_RELAXED, __HIP_MEMORY_SCOPE_AGENT); }
__device__ __forceinline__ unsigned xb_add(unsigned* p, unsigned v) { return __hip_atomic_fetch_add(p, v, __ATOMIC_RELAXED, __HIP_MEMORY_SCOPE_AGENT); }
__device__ __forceinline__ unsigned xb_xcc_id() { return (unsigned)__builtin_amdgcn_s_getreg((3 << 11) | 20) & 0xFu; }
#define XB_SPIN(cond, bar) do { unsigned _sp = 0; while (cond) { __builtin_amdgcn_s_sleep(1); \
    if ((++_sp & 255u) == 0u) { if (xb_ld(&(bar)[XB_TMO])) break; if (_sp > XB_SPIN_CAP) { atomicAdd(&(bar)[XB_TMO], 1u); break; } } } } while (0)
struct XcdBarrier { unsigned* bar; unsigned x; volatile LAS unsigned* st; };
__device__ __forceinline__ XcdBarrier xcd_barrier_post(unsigned* bar, volatile LAS unsigned* st) {
    XcdBarrier b; b.bar = bar; b.x = xb_xcc_id(); b.st = st;
    if (tid_() == 0) (void)xb_add(&bar[XB_XCNT(b.x)], 1u);
    return b;
}
__device__ __forceinline__ void xcd_barrier_complete(unsigned* bar, unsigned x, unsigned& nloc, unsigned& nx) {
    const unsigned G = gridDim.x * gridDim.y * gridDim.z;
    unsigned sum, cnt, mine, sp = 0u;
    for (;;) {
        sum = 0u; cnt = 0u; mine = 0u;
#pragma unroll
        for (unsigned j = 0; j < 16; ++j) { const unsigned c = xb_ld(&bar[XB_XCNT(j)]); sum += c; cnt += (c > 0u) ? 1u : 0u; mine = (j == x) ? c : mine; }
        if (sum == G) break;
        __builtin_amdgcn_s_sleep(1);
        if ((++sp & 255u) == 0u) { if (xb_ld(&bar[XB_TMO])) break; if (sp > XB_SPIN_CAP) { atomicAdd(&bar[XB_TMO], 1u); break; } }
    }
    nloc = mine > 0u ? mine : 1u; nx = cnt > 0u ? cnt : 1u;
}
__device__ __forceinline__ void xcd_barrier(const XcdBarrier& b) {
    asm volatile("s_waitcnt vmcnt(0)" ::: "memory");
    __syncthreads();
    if (tid_() == 0) {
        unsigned* bar = b.bar;
        __builtin_amdgcn_s_waitcnt(0);
        unsigned nloc = b.st[0], nx = b.st[1];
        if (nloc == 0u) { xcd_barrier_complete(bar, b.x, nloc, nx); b.st[0] = nloc; b.st[1] = nx; }
        const unsigned old = xb_add(&bar[XB_XSUB(b.x)], 1u);
        const unsigned gen = old / nloc;
        if (old + 1u == (gen + 1u) * nloc) {
            __builtin_amdgcn_fence(__ATOMIC_RELEASE, "agent");
            asm volatile("s_waitcnt vmcnt(0)" ::: "memory");
            const unsigned og = xb_add(&bar[XB_TOP], 1u);
            const unsigned tg = og / nx;
            if (og + 1u == (tg + 1u) * nx) xb_add(&bar[XB_TOPGEN], 1u);
            else XB_SPIN(xb_ld(&bar[XB_TOPGEN]) == tg, bar);
            __builtin_amdgcn_fence(__ATOMIC_ACQUIRE, "agent");
            xb_add(&bar[XB_XGEN(b.x)], 1u);
            asm volatile("s_waitcnt vmcnt(0)" ::: "memory");
        } else {
            XB_SPIN(xb_ld(&bar[XB_XGEN(b.x)]) == gen, bar);
            __builtin_amdgcn_fence(__ATOMIC_ACQUIRE, "agent");
            asm volatile("s_waitcnt vmcnt(0)" ::: "memory");
        }
    }
    __syncthreads();
}

__device__ __forceinline__ void ph_pro(KP p, unsigned char* lds) {
    float* sc = (float*)lds;
    float* red = sc + 3 * 1024;
    const int tid = tid_(), lane = tid & 63, wid = tid >> 6;
    for (int i = tid; i < 3 * 1024; i += NTHREADS) { const int r = i >> 10, k = i & 1023; const float v = (r < 2) ? p->in[1][r * 1024 + k] : p->in[3][k]; sc[i] = silu_(v); }
    __syncthreads();
    float* mod = (float*)(p->ws + WS_MOD);
    for (int item = bid_(); item < DEPTH * 96; item += gsz_()) {
        const int l = item / 96, j0 = (item % 96) * 64;
        const float* w = p->in[4] + (size_t)l * 1024 * 6144;
        float a0 = 0.f, a1 = 0.f, a2 = 0.f;
        const int k0 = wid * 128;
#pragma unroll 1
        for (int k = k0; k < k0 + 128; k += 16) { float wv[16];
#pragma unroll
            for (int u = 0; u < 16; ++u) wv[u] = w[(size_t)(k + u) * 6144 + j0 + lane];
#pragma unroll
            for (int u = 0; u < 16; ++u) { a0 += sc[k + u] * wv[u]; a1 += sc[1024 + k + u] * wv[u]; a2 += sc[2048 + k + u] * wv[u]; } }
        red[(wid * 3 + 0) * 64 + lane] = a0; red[(wid * 3 + 1) * 64 + lane] = a1; red[(wid * 3 + 2) * 64 + lane] = a2;
        __syncthreads();
        if (tid < 192) { const int r = tid >> 6; float s = 0.f;
            for (int w8 = 0; w8 < 8; ++w8) s += red[(w8 * 3 + r) * 64 + lane];
            mod[((size_t)l * 3 + r) * 6144 + j0 + lane] = s + p->in[5][l * 6144 + j0 + lane]; }
        __syncthreads();
    }
    if (bid_() == 0) {
        float* rt = (float*)(p->ws + WS_ROPE);
        for (int i = tid; i < 128 * 16; i += NTHREADS) { const int pos = i >> 4, f = i & 15; const float inv = powf(10000.f, -(float)f * (1.f / 16.f)); float sn, cs; sincosf((float)pos * inv, &sn, &cs);
            rt[pos * 32 + f] = cs; rt[pos * 32 + 16 + f] = sn; }
    }
    if (bid_() == gsz_() - 1) {
        float* lb = (float*)(p->ws + WS_LB);
        for (int i = tid; i < 2 * 2 * 256; i += NTHREADS) { const int l = i >> 9, dir = (i >> 8) & 1, ch = i & 255;
            const float* lg = p->in[21];
            const float l0 = lg[(dir * 2 + 0) * 256 + ch], l1 = lg[(dir * 2 + 1) * 256 + ch]; const float m = fmaxf(l0, l1);
            const float e0 = expf(l0 - m), e1 = expf(l1 - m);
            lb[i] = (l == 0) ? 0.f : e1 / (e0 + e1); }
    }
}

constexpr int CVT_E1 = 1050, CVT_E2 = 2850;
struct CvtTile { const float* src; bf16_t* dst; int K, N, k0, n0, blk, bstride, boff; float f8scale; };
__device__ __forceinline__ int cvt_total() { return 16 * 44 + 16 * 16 + 4 * 4 + 2 * (64 * 64) + 2 * 64 + 64 * 64 + 64; }
__device__ __forceinline__ CvtTile cvt_decode(KP p, int l, int g) {
    bf16_t* Wgu = (bf16_t*)(p->ws + wgu_off(l)); bf16_t* Wd = (bf16_t*)(p->ws + wd_off(l));
    CvtTile t; int per, tn, r;
    if (g < 704) { r = g; t = {p->in[8] + (size_t)l * 1024 * DIN, (bf16_t*)(p->ws + win_off(l)), 1024, DIN, 0, 0, DIN, 0, 0, 0.f}; tn = 44; per = 704; }
    else if ((g -= 704) < 256) { r = g; t = {p->in[9] + (size_t)l * 1024 * 1024, (bf16_t*)(p->ws + wout_off(l)), 1024, 1024, 0, 0, 1024, 0, 0, 0.f}; tn = 16; per = 256; }
    else if ((g -= 256) < 16) { r = g; t = {p->in[19] + (size_t)l * 65536, (bf16_t*)(p->ws + wpw_off(l)), 256, 256, 0, 0, 256, 0, 0, 0.f}; tn = 4; per = 16; }
    else if ((g -= 16) < 4096) { const int m = g >> 6; r = g & 63; t = {p->in[25] + ((size_t)l * 64 + m) * 262144, (bf16_t*)((unsigned char*)Wgu + (size_t)m * 524288), 1024, 256, 0, 0, 128, 256, 0, WGU8_SCALE}; tn = 4; per = 64; }
    else if ((g -= 4096) < 4096) { const int m = g >> 6; r = g & 63; t = {p->in[26] + ((size_t)l * 64 + m) * 262144, (bf16_t*)((unsigned char*)Wgu + (size_t)m * 524288), 1024, 256, 0, 0, 128, 256, 128, WGU8_SCALE}; tn = 4; per = 64; }
    else if ((g -= 4096) < 64) { r = g; t = {p->in[28] + (size_t)l * 262144, (bf16_t*)((unsigned char*)Wgu + (size_t)64 * 524288), 1024, 256, 0, 0, 128, 256, 0, WGU8_SCALE}; tn = 4; per = 64; }
    else if ((g -= 64) < 64) { r = g; t = {p->in[29] + (size_t)l * 262144, (bf16_t*)((unsigned char*)Wgu + (size_t)64 * 524288), 1024, 256, 0, 0, 128, 256, 128, WGU8_SCALE}; tn = 4; per = 64; }
    else if ((g -= 64) < 4096) { const int m = g >> 6; r = g & 63; t = {p->in[27] + ((size_t)l * 64 + m) * 262144, (bf16_t*)((unsigned char*)Wd + (size_t)m * 262144), 256, 1024, 0, 0, 1024, 0, 0, WD8_SCALE}; tn = 16; per = 64; }
    else { g -= 4096; r = g; t = {p->in[30] + (size_t)l * 262144, (bf16_t*)((unsigned char*)Wd + (size_t)64 * 262144), 256, 1024, 0, 0, 1024, 0, 0, WD8_SCALE}; tn = 16; per = 64; }
    (void)per; t.k0 = (r / tn) * 64; t.n0 = (r % tn) * 64; return t;
}
__device__ __forceinline__ void ph_cvt(KP p, int l, unsigned char* lds, int first = 0, int nwg = 0, int t0 = 0, int t1 = 1 << 30) {
    float* tb = (float*)lds;
    const int tid = tid_(), G = nwg ? nwg : gsz_(), total = t1 < cvt_total() ? t1 : cvt_total();
    const int r0 = tid >> 4, c0 = (tid & 15) * 4, nn = tid >> 3, kc = (tid & 7) * 8;
    int g = bid_() - first, buf = 0;
    if (g < 0) return;
    g += t0;
    if (g >= total) return;
    CvtTile T = cvt_decode(p, l, g);
    f32x4 v0 = *(const f32x4*)(T.src + (size_t)(T.k0 + r0) * T.N + T.n0 + c0), v1 = *(const f32x4*)(T.src + (size_t)(T.k0 + r0 + 32) * T.N + T.n0 + c0);
    for (;;) {
        float* t = tb + buf * (64 * 65);
        t[r0 * 65 + c0] = v0.x; t[r0 * 65 + c0 + 1] = v0.y; t[r0 * 65 + c0 + 2] = v0.z; t[r0 * 65 + c0 + 3] = v0.w;
        t[(r0 + 32) * 65 + c0] = v1.x; t[(r0 + 32) * 65 + c0 + 1] = v1.y; t[(r0 + 32) * 65 + c0 + 2] = v1.z; t[(r0 + 32) * 65 + c0 + 3] = v1.w;
        const CvtTile C = T; const int gn = g + G; const bool more = gn < total;
        if (more) { T = cvt_decode(p, l, gn);
            v0 = *(const f32x4*)(T.src + (size_t)(T.k0 + r0) * T.N + T.n0 + c0); v1 = *(const f32x4*)(T.src + (size_t)(T.k0 + r0 + 32) * T.N + T.n0 + c0); }
        __syncthreads();
        { const int n = C.n0 + nn; const int drow = (n / C.blk) * C.bstride + C.boff + (n % C.blk);
          if (C.f8scale != 0.f) { const float sc = C.f8scale;
              int w0 = __builtin_amdgcn_cvt_pk_fp8_f32(clamp8(t[(kc + 0) * 65 + nn] * sc), clamp8(t[(kc + 1) * 65 + nn] * sc), 0, false); w0 = __builtin_amdgcn_cvt_pk_fp8_f32(clamp8(t[(kc + 2) * 65 + nn] * sc), clamp8(t[(kc + 3) * 65 + nn] * sc), w0, true);
              int w1 = __builtin_amdgcn_cvt_pk_fp8_f32(clamp8(t[(kc + 4) * 65 + nn] * sc), clamp8(t[(kc + 5) * 65 + nn] * sc), 0, false); w1 = __builtin_amdgcn_cvt_pk_fp8_f32(clamp8(t[(kc + 6) * 65 + nn] * sc), clamp8(t[(kc + 7) * 65 + nn] * sc), w1, true);
              u32x2 o8; o8.x = (unsigned)w0; o8.y = (unsigned)w1;
              *(u32x2*)((unsigned char*)C.dst + (size_t)drow * C.K + C.k0 + kc) = o8;
          } else {
          u32x4 o; o.x = pk2(t[(kc + 0) * 65 + nn], t[(kc + 1) * 65 + nn]); o.y = pk2(t[(kc + 2) * 65 + nn], t[(kc + 3) * 65 + nn]);
          o.z = pk2(t[(kc + 4) * 65 + nn], t[(kc + 5) * 65 + nn]); o.w = pk2(t[(kc + 6) * 65 + nn], t[(kc + 7) * 65 + nn]);
          *(u32x4*)(C.dst + (size_t)drow * C.K + C.k0 + kc) = o; } }
        if (!more) break;
        g = gn; buf ^= 1;
    }
    __syncthreads();
}
__device__ __forceinline__ void norm_mod_row(const float* xrow, const float* g, const float* shift, const float* scale, bf16_t* orow, float* fout, int lane) {
    f32x4 v[4]; float s = 0.f;
#pragma unroll
    for (int j = 0; j < 4; ++j) { v[j] = ((const f32x4*)xrow)[lane + 64 * j]; s += v[j].x * v[j].x + v[j].y * v[j].y + v[j].z * v[j].z + v[j].w * v[j].w; }
    const float rinv = rsqrtf(wave_sum(s) * (1.f / D) + EPS);
#pragma unroll
    for (int j = 0; j < 4; ++j) { const int idx = lane + 64 * j;
        const f32x4 gg = ((const f32x4*)g)[idx], sh = ((const f32x4*)shift)[idx], sc = ((const f32x4*)scale)[idx];
        f32x4 y; y.x = v[j].x * rinv * gg.x * (1.f + sc.x) + sh.x; y.y = v[j].y * rinv * gg.y * (1.f + sc.y) + sh.y;
        y.z = v[j].z * rinv * gg.z * (1.f + sc.z) + sh.z; y.w = v[j].w * rinv * gg.w * (1.f + sc.w) + sh.w;
        u32x2 o; o.x = pk2(y.x, y.y); o.y = pk2(y.z, y.w);
        ((u32x2*)orow)[idx] = o;
        if (fout) ((f32x4*)fout)[idx] = y; }
}
__device__ __forceinline__ void ph_norm1(KP p, int l, unsigned char* lds) {
    if (l == 0) ph_cvt(p, l, lds);
    const int tid = tid_(), lane = tid & 63, wid = tid >> 6;
    bf16_t* A = (bf16_t*)(p->ws + Z_A);
    const float* g = p->in[6] + l * D;
    if (l == 0) { for (int row = bid_() * 8 + wid; row < R_ALL; row += gsz_() * 8)
        norm_mod_row(xrow_src(p, l, row), g, mod_vec(p, l, row, 0), mod_vec(p, l, row, 1), A + (size_t)row * D, nullptr, lane); }
    else { const bf16_t* X = (const bf16_t*)(p->ws + WS_X);
        for (int row = bid_() * 8 + wid; row < R_ALL; row += gsz_() * 8) {
            const float* shift = mod_vec(p, l, row, 0); const float* scale = mod_vec(p, l, row, 1);
            f32x4 v[4]; unpack8(*(const u32x4*)(X + (size_t)row * D + lane * 8), v[0], v[1]); unpack8(*(const u32x4*)(X + (size_t)row * D + 512 + lane * 8), v[2], v[3]);
            float ss = 0.f;
#pragma unroll
            for (int j = 0; j < 4; ++j) ss += v[j].x * v[j].x + v[j].y * v[j].y + v[j].z * v[j].z + v[j].w * v[j].w;
            const float rinv = rsqrtf(wave_sum(ss) * (1.f / D) + EPS);
#pragma unroll
            for (int h = 0; h < 2; ++h) { const int c0 = h * 512 + lane * 8; unsigned o[4];
#pragma unroll
                for (int q = 0; q < 2; ++q) { const f32x4 gg = *(const f32x4*)(g + c0 + 4 * q), sh = *(const f32x4*)(shift + c0 + 4 * q), sc = *(const f32x4*)(scale + c0 + 4 * q);
                    const f32x4 y = v[2 * h + q] * rinv * gg * (sc + 1.f) + sh; o[2 * q] = pk2(y.x, y.y); o[2 * q + 1] = pk2(y.z, y.w); }
                *(u32x4*)(A + (size_t)row * D + c0) = (u32x4){o[0], o[1], o[2], o[3]}; } } }
}

template <int NBJ, class ARow, class Epi>
__device__ __forceinline__ void gemm_simple_tile(const bf16_t* A, const ARow& arow, const bf16_t* Bt, int K, int row0, int colb0, int bjstride, const Epi& epi) {
    const int tid = tid_(), lane = tid & 63, wid = tid >> 6, wr = wid >> 1, wc = wid & 1, fr = lane & 15, fq = lane >> 4;
    f32x4 acc[2][NBJ][4];
#pragma unroll
    for (int i = 0; i < 2; ++i)
#pragma unroll
        for (int b = 0; b < NBJ; ++b)
#pragma unroll
            for (int j = 0; j < 4; ++j) acc[i][b][j] = (f32x4){0.f, 0.f, 0.f, 0.f};
    const bf16_t* ap[2];
#pragma unroll
    for (int i = 0; i < 2; ++i) ap[i] = A + (size_t)arow(row0 + wr * 32 + i * 16 + fr) * K + fq * 8;
    const bf16_t* bp = Bt + (size_t)(colb0 + wc * 64 + fr) * K + fq * 8;
    for (int k = 0; k < K; k += 32) {
        bf16x8 a[2];
#pragma unroll
        for (int i = 0; i < 2; ++i) a[i] = *(const bf16x8*)(ap[i] + k);
#pragma unroll
        for (int b = 0; b < NBJ; ++b)
#pragma unroll
            for (int j = 0; j < 4; ++j) { const bf16x8 bv = *(const bf16x8*)(bp + (size_t)(b * bjstride + j * 16) * K + k);
#pragma unroll
                for (int i = 0; i < 2; ++i) acc[i][b][j] = __builtin_amdgcn_mfma_f32_16x16x32_bf16(a[i], bv, acc[i][b][j], 0, 0, 0); }
    }
#pragma unroll
    for (int i = 0; i < 2; ++i)
#pragma unroll
        for (int j = 0; j < 4; ++j)
#pragma unroll
            for (int r = 0; r < 4; ++r) { const int row = row0 + wr * 32 + i * 16 + fq * 4 + r, col = wc * 64 + j * 16 + fr;
                epi(row, col, acc[i][0][j][r], acc[i][NBJ - 1][j][r]); }
}
struct RowId { __device__ __forceinline__ int operator()(int r) const { return r; } };
struct RowGather { const int* idx; __device__ __forceinline__ int operator()(int r) const { return idx[r]; } };

__device__ __forceinline__ void ph_inproj(KP p, int l, unsigned char* lds) {
    const bf16_t* A = (const bf16_t*)(p->ws + Z_A); const bf16_t* Bt = (const bf16_t*)(p->ws + Z_WIN); bf16_t* P = (bf16_t*)(p->ws + Z_P);
    constexpr int TM = R_ALL / 128, TN = DIN / 128;
    for (int it = bid_(); it < TM * TN; it += gsz_()) { const int mt = it / TN, nt = it % TN;
        auto epi = [&](int row, int col, float v, float) { P[(size_t)row * DIN + nt * 128 + col] = (bf16_t)f2bf(v); };
        gemm_simple_tile<1>(A, RowId{}, Bt, 1024, mt * 128, nt * 128, 0, epi); }
}

namespace pg8 {
constexpr int BM = 256, BK = 64, HALF = 128, HTB = HALF * BK * 2, STAGE_BYTES = 8 * HTB, NXCD = 8, WGM = 8;
__host__ __device__ __forceinline__ int lds_byte(int r, int c) { const int st = (r >> 4) * 2 + (c >> 5), rr = r & 15, cc = c & 31, ob = rr * 64 + cc * 2; return st * 1024 + (ob ^ (((ob >> 9) & 1) << 5)); }
__host__ __device__ __forceinline__ void stage_rc(int b, int& R, int& C) { const int st = b / 1024, sb = b % 1024, swz = sb ^ (((sb >> 9) & 1) << 5); R = (st >> 1) * 16 + swz / 64; C = (st & 1) * 32 + (swz % 64) / 2; }
__host__ __device__ __forceinline__ int perm32(int rho) { const int n = rho >> 4, i = rho & 15; return 8 * (i >> 2) + 4 * n + (i & 3); }
struct Unit { int pm, pn, ord; };
struct Gemm { const bf16_t* A; const bf16_t* Bt; int M, N, K; };
struct StaticOrder {
    int nM, nN, nwg, G, c;
    __host__ __device__ void init(int M, int N, int G_, int c_) { nM = M / BM; nN = N / BM; nwg = nM * nN; G = G_; c = c_; }
    __host__ __device__ bool next(int i, Unit& u) const {
        const long L = (long)i * G + c; if (L >= nwg) return false;
        int wgid = (int)L; { const int q = nwg / NXCD, r = nwg % NXCD, xcd = wgid % NXCD, off = wgid / NXCD; wgid = (xcd < r ? xcd * (q + 1) : r * (q + 1) + (xcd - r) * q) + off; }
        const int nig = WGM * nN, gid = wgid / nig, fm = gid * WGM, gsz = (nM - fm) < WGM ? (nM - fm) : WGM;
        u.pm = fm + ((wgid % nig) % gsz); u.pn = (wgid % nig) / gsz; u.ord = i; return true;
    }
};
__device__ __forceinline__ unsigned cvt_pk_bf16(float lo, float hi) { unsigned r; asm volatile("v_cvt_pk_bf16_f32 %0, %1, %2" : "=v"(r) : "v"(lo), "v"(hi)); return r; }

typedef int i32x4v __attribute__((ext_vector_type(4)));
typedef int i32x8v __attribute__((ext_vector_type(8)));
__device__ __forceinline__ i32x8v cat8(bf16x8 lo, bf16x8 hi) { const i32x4v a = __builtin_bit_cast(i32x4v, lo), b = __builtin_bit_cast(i32x4v, hi); return __builtin_shufflevector(a, b, 0, 1, 2, 3, 4, 5, 6, 7); }
__device__ __forceinline__ void glds16_s(const void* sbase, unsigned voff, unsigned lds_dst) { unsigned keep;
    asm volatile("s_mov_b32 %0, m0\n\ts_mov_b32 m0, %3\n\ts_nop 0\n\tglobal_load_lds_dwordx4 %1, %2\n\ts_mov_b32 m0, %0" : "=&s"(keep) : "v"(voff), "s"(sbase), "s"(lds_dst) : "memory"); }
template <class Epi, class Sched, bool GATHER, bool FP8 = false>
__device__ __forceinline__ void gemm_phase(LAS unsigned char* lds, const Gemm g, const Sched& S, const Epi& E, const LAS int* rtab) {
    const int tid = tid_(), wid = __builtin_amdgcn_readfirstlane(tid >> 6), lane = tid & 63, wr = wid >> 2, wc = wid & 3, fr = lane & 15, fq = lane >> 4;
    const int KB = FP8 ? g.K : g.K * 2, nt = KB / 128;
    unsigned voffA[2], voffB[2]; int RA[2], CA[2];
#pragma unroll
    for (int i = 0; i < 2; ++i) { int R, C; stage_rc(tid * 16 + i * 8192, R, C); const int Rb = (R & ~31) + perm32(R & 31);
        voffA[i] = (unsigned)(R * KB + C * 2); voffB[i] = (unsigned)(Rb * KB + C * 2); RA[i] = R; CA[i] = C; }
    unsigned rcpk = 0; if constexpr (GATHER) { rcpk = (unsigned)(RA[0] * 4) | ((unsigned)(CA[0] * 2) << 16); asm volatile("" : "+v"(rcpk)); }
    const size_t kstep = (size_t)128;
    const size_t hstep = (size_t)HALF * KB;
    const size_t hstepA = GATHER ? 0 : hstep;
    const size_t tstep = 2 * hstep;
    const unsigned ldsw = (unsigned)wid * 1024u;
    const unsigned ldsb = (unsigned)__builtin_amdgcn_readfirstlane((int)((unsigned)(size_t)lds + ldsw));
    const int aoff = lds_byte(wr * 64 + fr, fq * 8), boff = lds_byte(wc * 32 + fr, fq * 8);
#define PG8_SA(b, h) (((b) * 2 + (h)) * HTB)
#define PG8_SB(b, h) ((4 + (b) * 2 + (h)) * HTB)
#define PG8_STAGE(bufoff, gbase, voff) do { _Pragma("unroll") for (int _i = 0; _i < 2; ++_i) { if constexpr (FP8) glds16_s((const void*)(gbase), (voff)[_i], ldsb + (unsigned)((bufoff) + _i * 8192)); \
        else __builtin_amdgcn_global_load_lds((const unsigned*)((const char*)(gbase) + (voff)[_i]), (LAS unsigned*)(lds + (bufoff) + ldsw + _i * 8192), 16, 0, 0); } } while (0)
#define PG8_STAGE1(bufoff, gbase, v0) do {   \
        glds16_s((const void*)(gbase), (v0), ldsb + (unsigned)(bufoff)); glds16_s((const void*)((const char*)(gbase) + (size_t)64 * KB), (v0), ldsb + (unsigned)((bufoff) + 8192)); } while (0)
#define PG8_LDA(dst, b, h) do { _Pragma("unroll") for (int m = 0; m < 4; ++m) { if constexpr (FP8) dst##8[m] = cat8(*(const LAS bf16x8*)(lds + PG8_SA(b, h) + aoff + m * 2048), *(const LAS bf16x8*)(lds + PG8_SA(b, h) + aoff + m * 2048 + 1024)); \
        else { _Pragma("unroll") for (int k = 0; k < 2; ++k) dst[m][k] = *(const LAS bf16x8*)(lds + PG8_SA(b, h) + aoff + m * 2048 + k * 1024); } } } while (0)
#define PG8_LDB(dst, b, h) do { _Pragma("unroll") for (int n = 0; n < 2; ++n) { if constexpr (FP8) dst##8[n] = cat8(*(const LAS bf16x8*)(lds + PG8_SB(b, h) + boff + n * 2048), *(const LAS bf16x8*)(lds + PG8_SB(b, h) + boff + n * 2048 + 1024)); \
        else { _Pragma("unroll") for (int k = 0; k < 2; ++k) dst[n][k] = *(const LAS bf16x8*)(lds + PG8_SB(b, h) + boff + n * 2048 + k * 1024); } } } while (0)
#define PG8_MMA(ai, bj, At, Bt) do { __builtin_amdgcn_s_setprio(1); _Pragma("unroll") for (int m = 0; m < 4; ++m) _Pragma("unroll") for (int n = 0; n < 2; ++n) { \
        if constexpr (FP8) acc[ai][bj][m][n] = __builtin_amdgcn_mfma_scale_f32_16x16x128_f8f6f4(Bt##8[n], At##8[m], acc[ai][bj][m][n], 0, 0, 0, 0x7F7F7F7F, 0, 0x7F7F7F7F); \
        else { _Pragma("unroll") for (int k = 0; k < 2; ++k) acc[ai][bj][m][n] = __builtin_amdgcn_mfma_f32_16x16x32_bf16(Bt[n][k], At[m][k], acc[ai][bj][m][n], 0, 0, 0); } } \
        if constexpr (FP8) { asm volatile("" : "+v"(acc[ai][bj][0][0]), "+v"(acc[ai][bj][0][1]), "+v"(acc[ai][bj][1][0]), "+v"(acc[ai][bj][1][1]), "+v"(acc[ai][bj][2][0]), "+v"(acc[ai][bj][2][1]), "+v"(acc[ai][bj][3][0]), "+v"(acc[ai][bj][3][1])); } \
        __builtin_amdgcn_s_setprio(0); } while (0)
#define PG8_WAIT_V(n) asm volatile("s_waitcnt vmcnt(" #n ")" ::: "memory")
#define PG8_WAIT_L(n) asm volatile("s_waitcnt lgkmcnt(" #n ")" ::: "memory")
#define PG8_BAR __builtin_amdgcn_s_barrier()
#define PG8_SCHED __builtin_amdgcn_sched_barrier(0)
#define PG8_STAGE_A(bufoff, gbase, ord, h) do { unsigned _o[2]; if constexpr (GATHER) {   \
            unsigned _pk = rcpk; asm volatile("" : "+v"(_pk));   \
            const LAS unsigned char* _rp = (const LAS unsigned char*)rtab + ((ord) * 1024 + (h) * 512) + (_pk & 0xffffu); const unsigned _c2 = _pk >> 16; \
            _Pragma("unroll") for (int _i = 0; _i < 2; ++_i) _o[_i] = __umul24((unsigned)*(const LAS int*)(_rp + _i * 256), (unsigned)KB) + _c2; } \
        else { _o[0] = voffA[0]; _o[1] = voffA[1]; } if constexpr (FP8 && !GATHER) PG8_STAGE1(bufoff, gbase, voffA[0]); else PG8_STAGE(bufoff, gbase, _o); } while (0)
#define PG8_STAGE_B(bufoff, gbase) do { if constexpr (FP8) PG8_STAGE1(bufoff, gbase, voffB[0]); else PG8_STAGE(bufoff, gbase, voffB); } while (0)
    Unit cur, nxt; int ui = 0;
    if (!S.next(0, cur)) return;
    f32x4 acc[2][2][4][2];
#pragma unroll
    for (int a = 0; a < 2; ++a)
#pragma unroll
        for (int b = 0; b < 2; ++b)
#pragma unroll
            for (int m = 0; m < 4; ++m)
#pragma unroll
                for (int n = 0; n < 2; ++n) acc[a][b][m][n] = (f32x4){0.f, 0.f, 0.f, 0.f};
    bf16x8 At[4][2], B0[2][2], B1[2][2]; i32x8v At8[4], B08[2], B18[2];
    const char* cA = GATHER ? (const char*)g.A : (const char*)g.A + (size_t)cur.pm * tstep; const char* cB = (const char*)g.Bt + (size_t)cur.pn * tstep;
    PG8_STAGE_B(PG8_SB(0, 0), cB); PG8_STAGE_B(PG8_SB(0, 1), cB + hstep); PG8_STAGE_A(PG8_SA(0, 0), cA, 0, 0); PG8_STAGE_A(PG8_SA(0, 1), cA + hstepA, 0, 1);
    if (wr == 1) PG8_BAR;
    PG8_WAIT_V(2); PG8_BAR;
    PG8_STAGE_B(PG8_SB(1, 0), cB + kstep); PG8_STAGE_A(PG8_SA(1, 0), cA + kstep, 0, 0); PG8_STAGE_B(PG8_SB(1, 1), cB + hstep + kstep);
    PG8_WAIT_V(6); PG8_BAR;
    for (;;) {
        const bool has_next = S.next(ui + 1, nxt);
        const char* nA = GATHER ? (const char*)g.A : (has_next ? (const char*)g.A + (size_t)nxt.pm * tstep : cA); const char* nB = has_next ? (const char*)g.Bt + (size_t)nxt.pn * tstep : cB;
#pragma unroll 1
        for (int t = 0; t < nt; t += 2) {
            const bool last = (t == nt - 2);
            const char* a1 = cA + (size_t)(t + 1) * kstep;
            const char* a2 = last ? nA : cA + (size_t)(t + 2) * kstep; const char* b2 = last ? nB : cB + (size_t)(t + 2) * kstep;
            const char* a3 = a2 + kstep; const char* b3 = b2 + kstep;
            const int on = (last && has_next) ? ui + 1 : ui;
            PG8_LDB(B0, 0, 0); PG8_LDB(B1, 0, 1); PG8_SCHED; PG8_LDA(At, 0, 0); PG8_STAGE_A(PG8_SA(1, 1), a1 + hstepA, ui, 1);
            PG8_WAIT_V(8); PG8_WAIT_L(0); PG8_BAR; PG8_MMA(0, 0, At, B0); PG8_MMA(0, 1, At, B1); PG8_BAR; PG8_SCHED;
            PG8_LDA(At, 0, 1); PG8_STAGE_B(PG8_SB(0, 0), b2); PG8_STAGE_B(PG8_SB(0, 1), b2 + hstep); PG8_STAGE_A(PG8_SA(0, 0), a2, on, 0);
            PG8_WAIT_V(8); PG8_WAIT_L(0); PG8_BAR; PG8_MMA(1, 0, At, B0); PG8_MMA(1, 1, At, B1); PG8_BAR; PG8_SCHED;
            PG8_LDB(B0, 1, 0); PG8_LDB(B1, 1, 1); PG8_SCHED; PG8_LDA(At, 1, 0); PG8_STAGE_A(PG8_SA(0, 1), a2 + hstepA, on, 1);
            PG8_WAIT_V(8); PG8_WAIT_L(0); PG8_BAR; PG8_MMA(0, 0, At, B0); PG8_MMA(0, 1, At, B1); PG8_BAR; PG8_SCHED;
            PG8_LDA(At, 1, 1); PG8_STAGE_B(PG8_SB(1, 0), b3); PG8_STAGE_B(PG8_SB(1, 1), b3 + hstep); PG8_STAGE_A(PG8_SA(1, 0), a3, on, 0);
            PG8_WAIT_V(8); PG8_WAIT_L(0); PG8_BAR; PG8_MMA(1, 0, At, B0); PG8_MMA(1, 1, At, B1); PG8_BAR; PG8_SCHED;
        }
        if (wr == 0) PG8_BAR;
        E(acc, cur, wr, wc, fr, fq);
        if (!has_next) break;
#pragma unroll
        for (int a = 0; a < 2; ++a)
#pragma unroll
            for (int b = 0; b < 2; ++b)
#pragma unroll
                for (int m = 0; m < 4; ++m)
#pragma unroll
                    for (int n = 0; n < 2; ++n) acc[a][b][m][n] = (f32x4){0.f, 0.f, 0.f, 0.f};
        cur = nxt; cA = nA; cB = nB; ++ui;
        if (wr == 1) PG8_BAR;
    }
    PG8_WAIT_V(0);
    PG8_BAR;
#undef PG8_SA
#undef PG8_SB
#undef PG8_STAGE
#undef PG8_LDA
#undef PG8_LDB
#undef PG8_MMA
#undef PG8_WAIT_V
#undef PG8_WAIT_L
#undef PG8_BAR
#undef PG8_SCHED
#undef PG8_STAGE_A
#undef PG8_STAGE_B
#undef PG8_STAGE1
}
struct EpiBf16 {
    bf16_t* O; int ldc, ncolt; size_t slab;
    __device__ __forceinline__ void operator()(const f32x4 (&acc)[2][2][4][2], const Unit& u, int wr, int wc, int fr, int fq) const {
        const int row0 = u.pm * BM + wr * 64 + fr; const size_t col0 = (size_t)(u.pn % ncolt) * slab + wc * 32 + 8 * fq;
#pragma unroll
        for (int ai = 0; ai < 2; ++ai)
#pragma unroll
            for (int m = 0; m < 4; ++m) { bf16_t* rowp = O + (size_t)(row0 + ai * HALF + m * 16) * ldc + col0;
#pragma unroll
                for (int bj = 0; bj < 2; ++bj) { const f32x4 v0 = acc[ai][bj][m][0], v1 = acc[ai][bj][m][1];
                    u32x4 w; w.x = cvt_pk_bf16(v0[0], v0[1]); w.y = cvt_pk_bf16(v0[2], v0[3]); w.z = cvt_pk_bf16(v1[0], v1[1]); w.w = cvt_pk_bf16(v1[2], v1[3]);
                    *(u32x4*)(rowp + bj * HALF) = w; } }
    }
};
struct EpiRes {
    bf16_t* X; const float* xlat; const float* xctx; const float* modl; int pm_shift; float ascale;
    __device__ __forceinline__ void operator()(const f32x4 (&acc)[2][2][4][2], const Unit& u, int wr, int wc, int fr, int fq) const {
        const int pm = u.pm - pm_shift; const int rsel = pm < 64 ? (pm >> 5) : 2;
        const int row0 = pm * BM + wr * 64 + fr, col0 = (u.pn & 3) * BM + wc * 32 + 8 * fq;
        const float* gate = modl + (size_t)rsel * 6144 + col0;
        const float* xs = xlat ? (pm < 64 ? xlat + (size_t)row0 * D : xctx + (size_t)(row0 - R_LAT) * D) + col0 : nullptr;
        bf16_t* xo = X + (size_t)row0 * D + col0;
#pragma unroll
        for (int bj = 0; bj < 2; ++bj) { const f32x4 g0 = *(const f32x4*)(gate + bj * HALF) * ascale, g1 = *(const f32x4*)(gate + bj * HALF + 4) * ascale;
#pragma unroll
            for (int ai = 0; ai < 2; ++ai)
#pragma unroll
                for (int m = 0; m < 4; ++m) { const size_t o = (size_t)(ai * HALF + m * 16) * D + bj * HALF;
                    f32x4 x0, x1;
                    if (xs) { x0 = *(const f32x4*)(xs + o); x1 = *(const f32x4*)(xs + o + 4); } else unpack8(*(const u32x4*)(xo + o), x0, x1);
                    const f32x4 y0 = x0 + g0 * acc[ai][bj][m][0], y1 = x1 + g1 * acc[ai][bj][m][1];
                    u32x4 w; w.x = cvt_pk_bf16(y0[0], y0[1]); w.y = cvt_pk_bf16(y0[2], y0[3]); w.z = cvt_pk_bf16(y1[0], y1[1]); w.w = cvt_pk_bf16(y1[2], y1[3]);
                    *(u32x4*)(xo + o) = w; } }
    }
};
struct EpiGU8 {
    unsigned char* H8; const LAS float* wtab;
    __device__ __forceinline__ void operator()(const f32x4 (&acc)[2][2][4][2], const Unit& u, int wr, int wc, int fr, int fq) const {
        asm volatile("" : "+v"(fr), "+v"(fq));
        const int row0 = u.pm * BM + wr * 64 + fr, col0 = (u.pn & 1) * 128 + wc * 32 + 8 * fq;
#pragma unroll
        for (int ai = 0; ai < 2; ++ai)
#pragma unroll
            for (int m = 0; m < 4; ++m) { const int row = row0 + ai * HALF + m * 16; const float w = wtab[u.ord * 256 + wr * 64 + fr + ai * HALF + m * 16] * H8_SCALE;
                float h[8];
#pragma unroll
                for (int n = 0; n < 2; ++n)
#pragma unroll
                    for (int j = 0; j < 4; ++j) { const float gv = acc[ai][0][m][n][j] * GU_DESCALE, uv = acc[ai][1][m][n][j] * GU_DESCALE;
                        h[n * 4 + j] = fminf(fmaxf(gv * __builtin_amdgcn_rcpf(1.f + __expf(-gv)) * uv * w, -440.f), 440.f); }
                int w0 = __builtin_amdgcn_cvt_pk_fp8_f32(h[0], h[1], 0, false); w0 = __builtin_amdgcn_cvt_pk_fp8_f32(h[2], h[3], w0, true);
                int w1 = __builtin_amdgcn_cvt_pk_fp8_f32(h[4], h[5], 0, false); w1 = __builtin_amdgcn_cvt_pk_fp8_f32(h[6], h[7], w1, true);
                u32x2 o; o.x = (unsigned)w0; o.y = (unsigned)w1;
                *(u32x2*)(H8 + (size_t)row * 256 + col0) = o; }
    }
};
struct EpiGU {
    bf16_t* H; const float* slot_w;
    __device__ __forceinline__ void operator()(const f32x4 (&acc)[2][2][4][2], const Unit& u, int wr, int wc, int fr, int fq) const {
        const int row0 = u.pm * BM + wr * 64 + fr, col0 = (u.pn & 1) * 128 + wc * 32 + 8 * fq;
#pragma unroll
        for (int ai = 0; ai < 2; ++ai)
#pragma unroll
            for (int m = 0; m < 4; ++m) { const int row = row0 + ai * HALF + m * 16; const float w = slot_w[row];
                float h[8];
#pragma unroll
                for (int n = 0; n < 2; ++n)
#pragma unroll
                    for (int j = 0; j < 4; ++j) { const float gv = acc[ai][0][m][n][j], uv = acc[ai][1][m][n][j]; h[n * 4 + j] = gv / (1.f + __expf(-gv)) * uv * w; }
                u32x4 o; o.x = cvt_pk_bf16(h[0], h[1]); o.y = cvt_pk_bf16(h[2], h[3]); o.z = cvt_pk_bf16(h[4], h[5]); o.w = cvt_pk_bf16(h[6], h[7]);
                *(u32x4*)(H + (size_t)row * 256 + col0) = o; }
    }
};
struct EpiY8 {
    unsigned char* Y8;
    __device__ __forceinline__ void operator()(const f32x4 (&acc)[2][2][4][2], const Unit& u, int wr, int wc, int fr, int fq) const {
        const int row0 = u.pm * BM + wr * 64 + fr; unsigned char* base = Y8 + ((size_t)(u.pn & 3) * MAXSLOT + row0) * 256 + wc * 32 + 8 * fq;
#pragma unroll
        for (int ai = 0; ai < 2; ++ai)
#pragma unroll
            for (int m = 0; m < 4; ++m)
#pragma unroll
                for (int bj = 0; bj < 2; ++bj) { f32x4 v0 = acc[ai][bj][m][0] * (Y8_SCALE * DN_DESCALE), v1 = acc[ai][bj][m][1] * (Y8_SCALE * DN_DESCALE);
#pragma unroll
                    for (int q = 0; q < 4; ++q) { v0[q] = fminf(fmaxf(v0[q], -440.f), 440.f); v1[q] = fminf(fmaxf(v1[q], -440.f), 440.f); }
                    int w0 = __builtin_amdgcn_cvt_pk_fp8_f32(v0[0], v0[1], 0, false); w0 = __builtin_amdgcn_cvt_pk_fp8_f32(v0[2], v0[3], w0, true);
                    int w1 = __builtin_amdgcn_cvt_pk_fp8_f32(v1[0], v1[1], 0, false); w1 = __builtin_amdgcn_cvt_pk_fp8_f32(v1[2], v1[3], w1, true);
                    u32x2 o; o.x = (unsigned)w0; o.y = (unsigned)w1;
                    *(u32x2*)(base + (size_t)(ai * HALF + m * 16) * 256 + bj * HALF) = o; }
    }
};
struct EpiDown {
    bf16_t* Y; bf16_t* X; const float* modl5;
    __device__ __forceinline__ void operator()(const f32x4 (&acc)[2][2][4][2], const Unit& u, int wr, int wc, int fr, int fq) const {
        asm volatile("" : "+v"(fr), "+v"(fq));
        if (u.pm < MAXSLOT / 256) { const EpiY8 e{(unsigned char*)Y}; e(acc, u, wr, wc, fr, fq); }
        else { const EpiRes e{X, nullptr, nullptr, modl5, MAXSLOT / 256, DN_DESCALE}; e(acc, u, wr, wc, fr, fq); }
    }
};
}


__device__ __forceinline__ void ph_inproj_f(KP p, int l, unsigned char* lds) {
    pg8::Gemm g{(const bf16_t*)(p->ws + Z_A), (const bf16_t*)(p->ws + win_off(l)), R_ALL, DIN, 1024};
    pg8::StaticOrder S; S.init(R_ALL, DIN, gsz_(), bid_());
    pg8::EpiBf16 E{(bf16_t*)(p->ws + Z_P), DIN, DIN / 256, 256};
    pg8::gemm_phase<pg8::EpiBf16, pg8::StaticOrder, false>((LAS unsigned char*)lds, g, S, E, nullptr);
    if (l == 0 && DEPTH > 1 && gsz_() == 256) { __syncthreads(); ph_cvt(p, 1, lds, 214, 42, 0, CVT_E1); }
}
__device__ __forceinline__ void ph_outproj_f(KP p, int l, unsigned char* lds) {
    const int T = (l == 0) ? R_ALL : R_LAT;
    pg8::Gemm g{(const bf16_t*)(p->ws + Z_YCAT), (const bf16_t*)(p->ws + wout_off(l)), T, 1024, 1024};
    pg8::StaticOrder S; S.init(T, 1024, gsz_(), bid_());
    bf16_t* X = (bf16_t*)(p->ws + WS_X);
    pg8::EpiRes E{X, l == 0 ? p->in[0] : nullptr, l == 0 ? p->in[2] : nullptr, (const float*)(p->ws + WS_MOD) + (size_t)l * 3 * 6144 + 2 * 1024, 0, 1.f};
    pg8::gemm_phase<pg8::EpiRes, pg8::StaticOrder, false>((LAS unsigned char*)lds, g, S, E, nullptr);
    if (l == 0 && DEPTH > 1) {
        const int G = gsz_(); __syncthreads();
        if (G == 256) ph_cvt(p, 1, lds, 8, 248, CVT_E2, 1 << 30); else ph_cvt(p, 1, lds); }
}
struct QkvLane { f32x4 gg0, gg1, gw0, gw1; };
__device__ __forceinline__ QkvLane qkv_lane_consts(KP p, int l, int lane) {
    QkvLane c; const int dch = (lane & 7) * 8; const int isk = lane >= 32;
    const float* gq = p->in[isk ? 11 : 10] + l * 64 + dch; const float* wq = p->in[isk ? 13 : 12] + l * 64 + dch;
    c.gg0 = *(const f32x4*)gq; c.gg1 = *(const f32x4*)(gq + 4); c.gw0 = *(const f32x4*)wq; c.gw1 = *(const f32x4*)(wq + 4); return c;
}
__device__ __forceinline__ void prep_qkv_row(KP p, int l, int row, int lane, const QkvLane& qc) {
    const bf16_t* pr = (const bf16_t*)(p->ws + Z_P) + (size_t)row * DIN;
    const bool isctx = row >= R_LAT; const int b = isctx ? ((row - R_LAT) >> 8) : (row >> 13), t = isctx ? ((row - R_LAT) & 255) : (row & 8191);
    const size_t krow = (size_t)b * NKEY + (isctx ? NSEQ + t : t);
    const int l7 = lane & 7, axis = l7 >> 2, half = (l7 >> 1) & 1;
    f32x4 cs0 = (f32x4){1.f, 1.f, 1.f, 1.f}, cs1 = cs0, sn0 = (f32x4){0.f, 0.f, 0.f, 0.f}, sn1 = sn0;
    if (!isctx) { const int pos = axis == 0 ? (t >> 6) : (t & 63); const float* rt = (const float*)(p->ws + WS_ROPE) + pos * 32 + (lane & 1) * 8;
        cs0 = *(const f32x4*)rt; cs1 = *(const f32x4*)(rt + 4); sn0 = *(const f32x4*)(rt + 16); sn1 = *(const f32x4*)(rt + 20); }
    const u32x4 ra = *(const u32x4*)(pr + lane * 8), rb = *(const u32x4*)(pr + 512 + lane * 8);
#pragma unroll
    for (int grp = 0; grp < 2; ++grp) {
        const u32x4 r = grp ? rb : ra;
        bf16_t* Qd = (bf16_t*)(p->ws + (isctx ? (grp ? Z_QWC : Z_QGC) : (grp ? Z_QW : Z_QG))) + (size_t)(isctx ? (b * NCTX + t) : row) * 256;
        bf16_t* Kd = (bf16_t*)(p->ws + (grp ? Z_KW : Z_KG)) + krow * 128; bf16_t* Vd = (bf16_t*)(p->ws + (grp ? Z_VW : Z_VG)) + krow * 128;
        if (lane >= 48) { *(u32x4*)(Vd + (lane - 48) * 8) = r; continue; }
        float x[8] = {bf2f(r.x & 0xffffu), bf2f(r.x >> 16), bf2f(r.y & 0xffffu), bf2f(r.y >> 16), bf2f(r.z & 0xffffu), bf2f(r.z >> 16), bf2f(r.w & 0xffffu), bf2f(r.w >> 16)};
        float ss = 0.f;
#pragma unroll
        for (int i = 0; i < 8; ++i) ss += x[i] * x[i];
        ss += __shfl_xor(ss, 1); ss += __shfl_xor(ss, 2); ss += __shfl_xor(ss, 4);
        const float rinv = rsqrtf(ss * (1.f / 64.f) + EPS);
        const f32x4 g0 = grp ? qc.gw0 : qc.gg0, g1 = grp ? qc.gw1 : qc.gg1;
        const float gv[8] = {g0.x, g0.y, g0.z, g0.w, g1.x, g1.y, g1.z, g1.w};
        const float cv[8] = {cs0.x, cs0.y, cs0.z, cs0.w, cs1.x, cs1.y, cs1.z, cs1.w}, sv[8] = {sn0.x, sn0.y, sn0.z, sn0.w, sn1.x, sn1.y, sn1.z, sn1.w};
        const float qs = (lane < 32) ? QSCALE : 1.f;
        float y[8];
#pragma unroll
        for (int i = 0; i < 8; ++i) { const float v = x[i] * rinv * gv[i]; const float o = __shfl_xor(v, 2);
            y[i] = ((half == 0) ? (v * cv[i] - o * sv[i]) : (o * sv[i] + v * cv[i])) * qs; }
        u32x4 ov; ov.x = pk2(y[0], y[1]); ov.y = pk2(y[2], y[3]); ov.z = pk2(y[4], y[5]); ov.w = pk2(y[6], y[7]);
        if (lane < 32) *(u32x4*)(Qd + lane * 8) = ov; else *(u32x4*)(Kd + (lane - 32) * 8) = ov;
    }
}

template <int R> __device__ __forceinline__ void dw_rows(const float* hcol, const float (&wj)[31], float (&acc)[32]) {
    if constexpr (R < 62) {
        const float hv = hcol[R * 256];
        constexpr int T0 = (R - 30 > 0) ? R - 30 : 0, T1 = (R < 31) ? R : 31;
#pragma unroll
        for (int tt = T0; tt <= T1; ++tt) acc[tt] += hv * wj[R - tt];
        dw_rows<R + 1>(hcol, wj, acc);
    }
}
__device__ __forceinline__ void conv_tile(KP p, int l, unsigned char* lds, int seq_row0, int seqlen, int t0) {
    float* hb = (float*)lds;
    const int tid = tid_(), lane = tid & 63, wid = tid >> 6;
    const bf16_t* P = (const bf16_t*)(p->ws + Z_P);
    for (int i = tid; i < 94 * 32; i += NTHREADS) { const int r = i >> 5, c8 = (i & 31) * 8, t = t0 - 15 + r;
        f32x4 h0 = (f32x4){0.f, 0.f, 0.f, 0.f}, h1 = h0;
        if (t >= 0 && t < seqlen) { const bf16_t* pr = P + (size_t)(seq_row0 + t) * DIN;
            const u32x4 vv = *(const u32x4*)(pr + C_CVV + c8), gg = *(const u32x4*)(pr + C_CVG + c8);
            h0.x = bf2f(vv.x & 0xffffu) * sigmoid_(bf2f(gg.x & 0xffffu)); h0.y = bf2f(vv.x >> 16) * sigmoid_(bf2f(gg.x >> 16));
            h0.z = bf2f(vv.y & 0xffffu) * sigmoid_(bf2f(gg.y & 0xffffu)); h0.w = bf2f(vv.y >> 16) * sigmoid_(bf2f(gg.y >> 16));
            h1.x = bf2f(vv.z & 0xffffu) * sigmoid_(bf2f(gg.z & 0xffffu)); h1.y = bf2f(vv.z >> 16) * sigmoid_(bf2f(gg.z >> 16));
            h1.z = bf2f(vv.w & 0xffffu) * sigmoid_(bf2f(gg.w & 0xffffu)); h1.w = bf2f(vv.w >> 16) * sigmoid_(bf2f(gg.w >> 16)); }
        *(f32x4*)(hb + r * 256 + c8) = h0; *(f32x4*)(hb + r * 256 + c8 + 4) = h1; }
    __syncthreads();
    { const int c = tid & 255, hf = tid >> 8;
      const float* w = p->in[15] + (size_t)l * 31 * 256 + c; const float bias = p->in[16][l * 256 + c];
      float wj[31];
#pragma unroll
      for (int j = 0; j < 31; ++j) wj[j] = w[j * 256];
      float acc[32];
#pragma unroll
      for (int tt = 0; tt < 32; ++tt) acc[tt] = bias;
      dw_rows<0>(hb + hf * 32 * 256 + c, wj, acc);
      __syncthreads();
#pragma unroll
      for (int tt = 0; tt < 32; ++tt) hb[(hf * 32 + tt) * 256 + c] = acc[tt];
    }
    __syncthreads();
    constexpr int AS = 264;
    bf16_t* ab = (bf16_t*)(lds + 94 * 256 * 4);
    for (int tt = wid; tt < 64; tt += 8) { const float* r = hb + tt * 256; const f32x4 v = ((const f32x4*)r)[lane];
        const float mean = wave_sum(v.x + v.y + v.z + v.w) * (1.f / 256.f);
        const float dx = v.x - mean, dy = v.y - mean, dz = v.z - mean, dw = v.w - mean;
        const float rstd = rsqrtf(wave_sum(dx * dx + dy * dy + dz * dz + dw * dw) * (1.f / 256.f) + EPS);
        const f32x4 g = ((const f32x4*)(p->in[17] + l * 256))[lane], bb = ((const f32x4*)(p->in[18] + l * 256))[lane];
        u32x2 o; o.x = pk2(silu_(dx * rstd * g.x + bb.x), silu_(dy * rstd * g.y + bb.y)); o.y = pk2(silu_(dz * rstd * g.z + bb.z), silu_(dw * rstd * g.w + bb.w));
        *(u32x2*)(ab + tt * AS + lane * 4) = o; }
    __syncthreads();
    { const int fr = lane & 15, fq = lane >> 4;
      const bf16_t* Wt = (const bf16_t*)(p->ws + wpw_off(l));
      bf16x8 bw[2][8];
#pragma unroll
      for (int j = 0; j < 2; ++j)
#pragma unroll
          for (int ks = 0; ks < 8; ++ks) bw[j][ks] = *(const bf16x8*)(Wt + (size_t)((wid * 2 + j) * 16 + fr) * 256 + ks * 32 + fq * 8);
      const float bias0 = p->in[20][l * 256 + wid * 32 + fr], bias1 = p->in[20][l * 256 + wid * 32 + 16 + fr];
      bf16_t* Y = (bf16_t*)(p->ws + Z_YCAT);
#pragma unroll 1
      for (int tr = 0; tr < 4; ++tr) { f32x4 a0 = (f32x4){0.f, 0.f, 0.f, 0.f}, a1 = a0;
#pragma unroll
          for (int ks = 0; ks < 8; ++ks) { const bf16x8 av = *(const bf16x8*)(ab + (tr * 16 + fr) * AS + ks * 32 + fq * 8);
              a0 = __builtin_amdgcn_mfma_f32_16x16x32_bf16(av, bw[0][ks], a0, 0, 0, 0); a1 = __builtin_amdgcn_mfma_f32_16x16x32_bf16(av, bw[1][ks], a1, 0, 0, 0); }
#pragma unroll
          for (int r = 0; r < 4; ++r) { const int t = t0 + tr * 16 + fq * 4 + r; bf16_t* yr = Y + (size_t)(seq_row0 + t) * D + 256 + wid * 32 + fr;
              yr[0] = (bf16_t)f2bf(a0[r] + bias0); yr[16] = (bf16_t)f2bf(a1[r] + bias1); } }
    }
    __syncthreads();
}

__device__ __forceinline__ int hgrn_chunk_row0(int b, int dir, int j) {
    if (j < 4) { const int cj = dir ? 3 - j : j; return R_LAT + b * NCTX + cj * 64; }
    const int jj = j - 4, cj = dir ? 127 - jj : jj; return b * NSEQ + cj * 64;
}
__device__ __forceinline__ void hgrn_load_chunk(KP p, int l, int row0, int dir, int head, float* qs, float* vs, float* ks, float* cs) {
    const int tid = tid_();
    const bf16_t* P = (const bf16_t*)(p->ws + Z_P);
    const float* lbv = (const float*)(p->ws + WS_LB) + (l * 2 + dir) * 256 + head * 64;
    for (int i = tid; i < 4096; i += NTHREADS) { const int tau = i >> 6, d = i & 63; const int row = row0 + (dir ? 63 - tau : tau);
        const bf16_t* pr = P + (size_t)row * DIN + head * 64 + d;
        if (qs) qs[i] = bf2f(pr[C_RQ]);
        vs[i] = bf2f(pr[C_RI]);
        const float z = bf2f(pr[dir ? C_RFB : C_RFF]); const float lb = lbv[d];
        const float lsp = fminf(z, 0.f) - log1pf(__expf(-fabsf(z)));
        float logf = lsp;
        if (lb > 0.f) { const float a = lsp, bq = __logf(lb) + (lsp - z); const float mx = fmaxf(a, bq); logf = mx + log1pf(__expf(-fabsf(a - bq))); }
        ks[i] = (1.f - lb) * sigmoid_(-z);
        cs[i] = logf; }
    __syncthreads();
    if (tid < 64) { float c = 0.f; for (int tau = 0; tau < 64; ++tau) { c += cs[tau * 64 + tid]; cs[tau * 64 + tid] = c; } }
    __syncthreads();
}
__device__ __forceinline__ void hgrn_pass1_unit(KP p, int l, unsigned char* lds, int unit) {
    float* vs = (float*)lds; float* ks = vs + 4096; float* cs = ks + 4096;
    const int tid = tid_();
    const int j = unit % NCHUNK, seq = unit / NCHUNK, dir = seq & 1, head = (seq >> 1) & 3, b = seq >> 3;
    hgrn_load_chunk(p, l, hgrn_chunk_row0(b, dir, j), dir, head, nullptr, vs, ks, cs);
    for (int i = tid; i < 4096; i += NTHREADS) { const int d = i & 63; ks[i] *= __expf(cs[63 * 64 + d] - cs[i]); }
    __syncthreads();
    float* U = (float*)(p->ws + Z_U) + ((size_t)seq * NCHUNK + j) * 4096; float* Gv = (float*)(p->ws + Z_G) + ((size_t)seq * NCHUNK + j) * 64;
    { const int d = tid >> 3, e0 = (tid & 7) * 8; float acc[8];
#pragma unroll
      for (int e = 0; e < 8; ++e) acc[e] = 0.f;
      for (int tau = 0; tau < 64; ++tau) { const float kv = ks[tau * 64 + d];
#pragma unroll
          for (int e = 0; e < 8; ++e) acc[e] += kv * vs[tau * 64 + e0 + e]; }
#pragma unroll
      for (int e = 0; e < 8; ++e) U[d * 64 + e0 + e] = acc[e]; }
    if (tid < 64) Gv[tid] = __expf(cs[63 * 64 + tid]);
    __syncthreads();
}
constexpr int HS = 72;
constexpr int HL_TOT = 0, HL_OSUM = 2048, HL_T0 = 18432, HL_TB = 64 * HS * 2;
__device__ __forceinline__ f32x4 mm64(const bf16_t* A, const bf16_t* Bt, int tr, int tc, int fr, int fq, f32x4 acc) {
#pragma unroll
    for (int k0 = 0; k0 < 64; k0 += 32) { const bf16x8 a = *(const bf16x8*)(A + (tr * 16 + fr) * HS + k0 + fq * 8), b = *(const bf16x8*)(Bt + (tc * 16 + fr) * HS + k0 + fq * 8);
        acc = __builtin_amdgcn_mfma_f32_16x16x32_bf16(a, b, acc, 0, 0, 0); }
    return acc;
}
__device__ __forceinline__ void hgrn_load8(KP p, int row0, int dir, int head, int tid, float (&q)[8], float (&vv)[8], float (&z)[8]) {
    const int d = tid & 63, seg = tid >> 6;
    const bf16_t* P = (const bf16_t*)(p->ws + Z_P);
#pragma unroll
    for (int i = 0; i < 8; ++i) { const int tau = seg * 8 + i; const int row = row0 + (dir ? 63 - tau : tau);
        const bf16_t* pr = P + (size_t)row * DIN + head * 64 + d;
        q[i] = bf2f(pr[C_RQ]); vv[i] = bf2f(pr[C_RI]); z[i] = bf2f(pr[dir ? C_RFB : C_RFF]); }
}
__device__ __forceinline__ void hgrn_gate8(KP p, int l, int dir, int head, int tid, float* tot, const float (&z)[8], float (&kg)[8], float (&c)[8], float& m, float& cl) {
    const int d = tid & 63, seg = tid >> 6;
    const float lb = ((const float*)(p->ws + WS_LB))[(l * 2 + dir) * 256 + head * 64 + d];
    float run = 0.f;
#pragma unroll
    for (int i = 0; i < 8; ++i) {
        const float ez = __expf(-fabsf(z[i])), rz = __builtin_amdgcn_rcpf(1.f + ez); const float sg = (z[i] >= 0.f) ? rz : ez * rz;
        const float f = lb + (1.f - lb) * sg;
        kg[i] = 1.f - f;
        run += __logf(f); c[i] = run; }
    tot[seg * 64 + d] = run;
    __syncthreads();
    float off = 0.f; m = 0.f; cl = 0.f;
#pragma unroll
    for (int s2 = 0; s2 < 8; ++s2) { const float t = tot[s2 * 64 + d]; if (s2 < seg) off += t; if (s2 < 4) m += t; cl += t; }
#pragma unroll
    for (int i = 0; i < 8; ++i) c[i] += off;
}
__device__ __forceinline__ u32x4 pack8(const float (&x)[8]) { u32x4 o; o.x = pk2(x[0], x[1]); o.y = pk2(x[2], x[3]); o.z = pk2(x[4], x[5]); o.w = pk2(x[6], x[7]); return o; }
__device__ __forceinline__ void hgrn_pass1_f(KP p, int l, unsigned char* lds, int unit) {
    const int tid = tid_(), lane = tid & 63, wid = tid >> 6, fr = lane & 15, fq = lane >> 4, d = tid & 63, seg = tid >> 6;
    float* tot = (float*)(lds + HL_TOT); bf16_t* Vt = (bf16_t*)(lds + HL_T0); bf16_t* KbT = (bf16_t*)(lds + HL_T0 + HL_TB);
    const int j = unit % NCHUNK, seq = unit / NCHUNK, dir = seq & 1, head = (seq >> 1) & 3, b = seq >> 3;
    float q[8], vv[8], z[8], kg[8], c[8], m, cl;
    hgrn_load8(p, hgrn_chunk_row0(b, dir, j), dir, head, tid, q, vv, z);
    hgrn_gate8(p, l, dir, head, tid, tot, z, kg, c, m, cl);
    float kb[8];
#pragma unroll
    for (int i = 0; i < 8; ++i) kb[i] = kg[i] * __expf(cl - c[i]);
    *(u32x4*)(Vt + d * HS + seg * 8) = pack8(vv);
    *(u32x4*)(KbT + d * HS + seg * 8) = pack8(kb);
    float* U = (float*)(p->ws + Z_U) + ((size_t)seq * NCHUNK + j) * 4096; float* Gv = (float*)(p->ws + Z_G) + ((size_t)seq * NCHUNK + j) * 64;
    if (seg == 0) Gv[d] = __expf(cl);
    __syncthreads();
    const int tr = wid >> 1;
#pragma unroll
    for (int t2 = 0; t2 < 2; ++t2) { const int tc = (wid & 1) * 2 + t2;
        const f32x4 acc = mm64(Vt, KbT, tr, tc, fr, fq, (f32x4){0.f, 0.f, 0.f, 0.f});
#pragma unroll
        for (int r = 0; r < 4; ++r) U[(tr * 16 + fq * 4 + r) * 64 + tc * 16 + fr] = acc[r]; }
    __syncthreads();
}
struct HgrnIn1 { float v[8], zf[8], zb[8]; };
__device__ __forceinline__ void hgrn_p1_load(KP p, int unit, int tid, HgrnIn1& r) {
    const int cpos = unit % NCHUNK, head = (unit / NCHUNK) & 3, b = unit / (NCHUNK * 4), d = tid & 63, seg = tid >> 6;
    const int row0 = (cpos < 4) ? R_LAT + b * NCTX + cpos * 64 : b * NSEQ + (cpos - 4) * 64;
    const bf16_t* P = (const bf16_t*)(p->ws + Z_P) + (size_t)(row0 + seg * 8) * DIN + head * 64 + d;
#pragma unroll
    for (int i = 0; i < 8; ++i) { const bf16_t* pr = P + (size_t)i * DIN; r.v[i] = bf2f(pr[C_RI]); r.zf[i] = bf2f(pr[C_RFF]); r.zb[i] = bf2f(pr[C_RFB]); }
}
__device__ __forceinline__ void hgrn_p1_compute(KP p, int l, unsigned char* lds, int unit, int tid, const HgrnIn1& r) {
    const int lane = tid & 63, wid = tid >> 6, fr = lane & 15, fq = lane >> 4, d = tid & 63, seg = tid >> 6;
    float* totf = (float*)(lds + HL_TOT); float* totb = (float*)(lds + HL_OSUM);
    bf16_t* Vt = (bf16_t*)(lds + HL_T0); bf16_t* KfT = (bf16_t*)(lds + HL_T0 + HL_TB); bf16_t* KbT = (bf16_t*)(lds + HL_T0 + 2 * HL_TB);
    const int cpos = unit % NCHUNK, head = (unit / NCHUNK) & 3, b = unit / (NCHUNK * 4);
    const float* lbp = (const float*)(p->ws + WS_LB) + (l * 2) * 256 + head * 64 + d; const float lbf = lbp[0], lbb = lbp[256];
    float kf[8], kb[8], cf[8], cb[8], lfb[8], runf = 0.f, runb = 0.f;
#pragma unroll
    for (int i = 0; i < 8; ++i) {
        { const float z = r.zf[i], ez = __expf(-fabsf(z)), rz = __builtin_amdgcn_rcpf(1.f + ez), sg = (z >= 0.f) ? rz : ez * rz, f = lbf + (1.f - lbf) * sg; kf[i] = 1.f - f; runf += __logf(f); cf[i] = runf; }
        { const float z = r.zb[i], ez = __expf(-fabsf(z)), rz = __builtin_amdgcn_rcpf(1.f + ez), sg = (z >= 0.f) ? rz : ez * rz, f = lbb + (1.f - lbb) * sg; kb[i] = 1.f - f; lfb[i] = __logf(f); runb += lfb[i]; cb[i] = runb; } }
    totf[seg * 64 + d] = runf; totb[seg * 64 + d] = runb;
    __syncthreads();
    float offf = 0.f, offb = 0.f, clf = 0.f, clb = 0.f;
#pragma unroll
    for (int s2 = 0; s2 < 8; ++s2) { const float tf = totf[s2 * 64 + d], tb = totb[s2 * 64 + d]; if (s2 < seg) { offf += tf; offb += tb; } clf += tf; clb += tb; }
#pragma unroll
    for (int i = 0; i < 8; ++i) { kf[i] *= __expf(clf - (cf[i] + offf)); kb[i] *= __expf(cb[i] + offb - lfb[i]); }
    *(u32x4*)(Vt + d * HS + seg * 8) = pack8(r.v);
    *(u32x4*)(KfT + d * HS + seg * 8) = pack8(kf);
    *(u32x4*)(KbT + d * HS + seg * 8) = pack8(kb);
    const int jf = cpos, jb = (cpos < 4) ? 3 - cpos : 4 + 127 - (cpos - 4); const int seqf = (b * 4 + head) * 2;
    bf16_t* Uf = (bf16_t*)(p->ws + Z_U) + ((size_t)seqf * NCHUNK + jf) * 4096; bf16_t* Ub = (bf16_t*)(p->ws + Z_U) + ((size_t)(seqf + 1) * NCHUNK + jb) * 4096;
    float* Gf = (float*)(p->ws + Z_G) + ((size_t)seqf * NCHUNK + jf) * 64; float* Gb = (float*)(p->ws + Z_G) + ((size_t)(seqf + 1) * NCHUNK + jb) * 64;
    if (seg == 0) { Gf[d] = __expf(clf); Gb[d] = __expf(clb); }
    __syncthreads();
    const int tr = wid >> 1;
#pragma unroll
    for (int t2 = 0; t2 < 2; ++t2) { const int tc = (wid & 1) * 2 + t2;
        const f32x4 af = mm64(Vt, KfT, tr, tc, fr, fq, (f32x4){0.f, 0.f, 0.f, 0.f}), ab = mm64(Vt, KbT, tr, tc, fr, fq, (f32x4){0.f, 0.f, 0.f, 0.f});
#pragma unroll
        for (int q = 0; q < 4; ++q) { const int o = (tr * 16 + fq * 4 + q) * 64 + tc * 16 + fr; Uf[o] = (bf16_t)f2bf(af[q]); Ub[o] = (bf16_t)f2bf(ab[q]); } }
    __syncthreads();
}
__device__ __forceinline__ void hgrn_pass1_run(KP p, int l, unsigned char* lds, int u0, int un, int ustep) {
    if (un <= 0) return;
    const int tid = tid_();
    HgrnIn1 cur; hgrn_p1_load(p, u0, tid, cur);
    for (int k = 0; k < un; ++k) { const int u = u0 + k * ustep;
        HgrnIn1 nxt = cur; if (k + 1 < un) hgrn_p1_load(p, u + ustep, tid, nxt);
        hgrn_p1_compute(p, l, lds, u, tid, cur);
        cur = nxt; }
}
__device__ __forceinline__ void hgrn_scan_f(KP p) {
    const int tid = tid_();
    if (tid >= 256) return;
    for (int gi = bid_() * 256 + tid; gi < 16 * 4096; gi += gsz_() * 256) {
    const int seq = gi >> 12, ed = gi & 4095, d = ed & 63;
    bf16_t* U = (bf16_t*)(p->ws + Z_U) + (size_t)seq * NCHUNK * 4096 + ed; const float* Gv = (const float*)(p->ws + Z_G) + (size_t)seq * NCHUNK * 64 + d;
    float S = 0.f;
#pragma unroll 1
    for (int j = 0; j < NCHUNK; j += 12) {
        float u[12], g[12];
#pragma unroll
        for (int q = 0; q < 12; ++q) { u[q] = bf2f(U[(size_t)(j + q) * 4096]); g[q] = Gv[(j + q) * 64]; }
#pragma unroll
        for (int q = 0; q < 12; ++q) { U[(size_t)(j + q) * 4096] = (bf16_t)f2bf(S); S = g[q] * S + u[q]; }
    }
    }
}
struct HgrnIn3 { float q[8], v[8], zf[8], zb[8], gg[8]; u32x4 sf, sb; };
__device__ __forceinline__ void hgrn_p3_load(KP p, int unit, int tid, HgrnIn3& r) {
    const int cpos = unit % NCHUNK, head = (unit / NCHUNK) & 3, b = unit / (NCHUNK * 4), d = tid & 63, seg = tid >> 6;
    const int row0 = (cpos < 4) ? R_LAT + b * NCTX + cpos * 64 : b * NSEQ + (cpos - 4) * 64;
    const bf16_t* P = (const bf16_t*)(p->ws + Z_P) + (size_t)(row0 + seg * 8) * DIN + head * 64 + d;
#pragma unroll
    for (int i = 0; i < 8; ++i) { const bf16_t* pr = P + (size_t)i * DIN; r.q[i] = bf2f(pr[C_RQ]); r.v[i] = bf2f(pr[C_RI]); r.zf[i] = bf2f(pr[C_RFF]); r.zb[i] = bf2f(pr[C_RFB]);
        r.gg[i] = bf2f(((const bf16_t*)(p->ws + Z_P))[(size_t)(row0 + seg + 8 * i) * DIN + C_RG + head * 64 + d]); }
    const int jf = cpos, jb = (cpos < 4) ? 3 - cpos : 4 + 127 - (cpos - 4); const int seqf = (b * 4 + head) * 2;
    const bf16_t* U = (const bf16_t*)(p->ws + Z_U);
    r.sf = *(const u32x4*)(U + ((size_t)seqf * NCHUNK + jf) * 4096 + tid * 8); r.sb = *(const u32x4*)(U + ((size_t)(seqf + 1) * NCHUNK + jb) * 4096 + tid * 8);
}
__device__ __forceinline__ void hgrn_p3_compute(KP p, int l, unsigned char* lds, int unit, int tid, const HgrnIn3& r) {
    const int lane = tid & 63, wid = tid >> 6, fr = lane & 15, fq = lane >> 4, d = tid & 63, seg = tid >> 6;
    float* tot = (float*)(lds + HL_TOT); float* os = (float*)(lds + HL_OSUM);
    bf16_t* Qt = (bf16_t*)(lds + HL_T0); bf16_t* Kt = (bf16_t*)(lds + HL_T0 + HL_TB); bf16_t* Qb = (bf16_t*)(lds + HL_T0 + 2 * HL_TB);
    bf16_t* St = (bf16_t*)(lds + HL_T0 + 3 * HL_TB); bf16_t* Vt = (bf16_t*)(lds + HL_T0 + 4 * HL_TB); bf16_t* Sc = (bf16_t*)(lds + HL_T0 + 5 * HL_TB);
    const int cpos = unit % NCHUNK, head = (unit / NCHUNK) & 3, b = unit / (NCHUNK * 4);
    const int row0 = (cpos < 4) ? R_LAT + b * NCTX + cpos * 64 : b * NSEQ + (cpos - 4) * 64;
    const int tr = wid >> 1;
    const float* lbp = (const float*)(p->ws + WS_LB) + (l * 2) * 256 + head * 64 + d;
#pragma unroll
    for (int dir = 0; dir < 2; ++dir) {
        const float lb = lbp[dir * 256];
        float kg[8], c[8], run = 0.f;
#pragma unroll
        for (int ii = 0; ii < 8; ++ii) { const int i = dir ? 7 - ii : ii;
            const float z = dir ? r.zb[i] : r.zf[i];
            const float ez = __expf(-fabsf(z)), rz = __builtin_amdgcn_rcpf(1.f + ez), sg = (z >= 0.f) ? rz : ez * rz, f = lb + (1.f - lb) * sg;
            kg[i] = 1.f - f; run += __logf(f); c[i] = run; }
        tot[seg * 64 + d] = run;
        __syncthreads();
        float off = 0.f, m = 0.f;
#pragma unroll
        for (int s2 = 0; s2 < 8; ++s2) { const float t = tot[s2 * 64 + d]; if (dir ? (s2 > seg) : (s2 < seg)) off += t; if (dir ? (s2 >= 4) : (s2 < 4)) m += t; }
        float vr[8];
#pragma unroll
        for (int i = 0; i < 8; ++i) { const float ci = c[i] + off; const int tau = dir ? 63 - (seg * 8 + i) : seg * 8 + i; const float qv = r.q[i];
            Qt[tau * HS + d] = (bf16_t)f2bf(qv * __expf(fminf(ci - m, 80.f)));
            Kt[tau * HS + d] = (bf16_t)f2bf(kg[i] * __expf(fminf(m - ci, 80.f)));
            Qb[tau * HS + d] = (bf16_t)f2bf(qv * __expf(ci));
            vr[i] = dir ? r.v[7 - i] : r.v[i]; }
        *(u32x4*)(Vt + d * HS + (dir ? 7 - seg : seg) * 8) = pack8(vr);
        *(u32x4*)(St + (tid >> 3) * HS + (tid & 7) * 8) = dir ? r.sb : r.sf;
        __syncthreads();
        f32x4 oacc[2];
#pragma unroll
        for (int t2 = 0; t2 < 2; ++t2) { const int tc = (wid & 1) * 2 + t2;
            oacc[t2] = mm64(Qb, St, tr, tc, fr, fq, (f32x4){0.f, 0.f, 0.f, 0.f});
            f32x4 sacc = (f32x4){0.f, 0.f, 0.f, 0.f};
            if (tc <= tr) sacc = mm64(Qt, Kt, tr, tc, fr, fq, sacc);
#pragma unroll
            for (int q = 0; q < 4; ++q) { const int tau = tr * 16 + fq * 4 + q, sig = tc * 16 + fr; Sc[tau * HS + sig] = (bf16_t)f2bf(sig <= tau ? sacc[q] : 0.f); } }
        __syncthreads();
#pragma unroll
        for (int t2 = 0; t2 < 2; ++t2) { const int tc = (wid & 1) * 2 + t2;
            oacc[t2] = mm64(Sc, Vt, tr, tc, fr, fq, oacc[t2]);
#pragma unroll
            for (int q = 0; q < 4; ++q) { const int tau = tr * 16 + fq * 4 + q, e = tc * 16 + fr, tok = dir ? 63 - tau : tau;
                if (dir == 0) os[tok * 64 + e] = oacc[t2][q]; else os[tok * 64 + e] += oacc[t2][q]; } }
        __syncthreads();
    }
    bf16_t* Y = (bf16_t*)(p->ws + Z_YCAT); const float ong = p->in[22][l * 64 + lane];
#pragma unroll
    for (int i = 0; i < 8; ++i) { const int tok = wid + 8 * i; const float v = os[tok * 64 + lane];
        const float y = v * rsqrtf(wave_sum(v * v) * (1.f / 64.f) + EPS) * ong;
        Y[(size_t)(row0 + tok) * D + 768 + head * 64 + lane] = (bf16_t)f2bf(y * silu_(r.gg[i])); }
    __syncthreads();
}
__device__ __forceinline__ int hgrn_p3_unit(int k) { if (k < 1024) { const int bh = k >> 7, c = k & 127; return bh * NCHUNK + 4 + c; } const int k2 = k - 1024; return (k2 >> 2) * NCHUNK + (k2 & 3); }
__device__ __forceinline__ void hgrn_pass3_run(KP p, int l, unsigned char* lds) {
    const int tid = tid_(), G = gsz_(), nunits = 1024 + (l == 0 ? 32 : 0);
    int k = bid_(); if (k >= nunits) return;
    HgrnIn3 cur; hgrn_p3_load(p, hgrn_p3_unit(k), tid, cur);
    for (;;) { const int kn = k + G; const bool more = kn < nunits;
        HgrnIn3 nxt = cur; if (more) hgrn_p3_load(p, hgrn_p3_unit(kn), tid, nxt);
        hgrn_p3_compute(p, l, lds, hgrn_p3_unit(k), tid, cur);
        if (!more) break;
        cur = nxt; k = kn; }
}
__device__ __forceinline__ void ph_prep(KP p, int l, unsigned char* lds) {
    const int tid = tid_(), lane = tid & 63, wid = tid >> 6, bid = bid_(), G = gsz_();
    const int nconv = 256 + (l == 0 ? 8 : 0);
    for (int it = bid; it < nconv; it += G) {
        if (it < 256) conv_tile(p, l, lds, (it >> 7) * NSEQ, NSEQ, (it & 127) * 64);
        else { const int c = it - 256; conv_tile(p, l, lds, R_LAT + (c >> 2) * NCTX, NCTX, (c & 3) * 64); } }
    if (G == 256) {
        const int u0 = bid < 8 ? 2 * bid : bid < 56 ? 16 + 5 * (bid - 8) : 256 + 4 * (bid - 56), un = bid < 8 ? 2 : bid < 56 ? 5 : 4;
        hgrn_pass1_run(p, l, lds, u0, un, 1);
        const int g0 = bid < 104 ? 8 * bid : bid < 168 ? 832 + 9 * (bid - 104) : 1408 + 8 * (bid - 168), gn = (bid >= 104 && bid < 168) ? 9 : 8;
        const QkvLane qc = qkv_lane_consts(p, l, lane);
        for (int g = g0; g < g0 + gn; ++g) prep_qkv_row(p, l, g * 8 + wid, lane, qc);
    } else {
        hgrn_pass1_run(p, l, lds, bid, (8 * NCHUNK - bid + G - 1) / G, G);
        const QkvLane qc = qkv_lane_consts(p, l, lane);
        for (int row = bid * 8 + wid; row < R_ALL; row += G * 8) prep_qkv_row(p, l, row, lane, qc);
    }
}

__device__ __forceinline__ void hgrn_scan(KP p) {
    const int gi = bid_() * NTHREADS + tid_();
    if (gi >= 16 * 4096) return;
    const int seq = gi >> 12, de = gi & 4095, d = de >> 6;
    float* U = (float*)(p->ws + Z_U) + (size_t)seq * NCHUNK * 4096 + de; const float* Gv = (const float*)(p->ws + Z_G) + (size_t)seq * NCHUNK * 64 + d;
    float S = 0.f;
    for (int j = 0; j < NCHUNK; j += 4) {
        float u[4], g[4];
#pragma unroll
        for (int q = 0; q < 4; ++q) { u[q] = U[(size_t)(j + q) * 4096]; g[q] = Gv[(j + q) * 64]; }
#pragma unroll
        for (int q = 0; q < 4; ++q) { U[(size_t)(j + q) * 4096] = S; S = g[q] * S + u[q]; }
    }
}
__device__ __forceinline__ void attn_simple_unit(unsigned char* lds, const bf16_t* Qrow0  , const bf16_t* Kb, const bf16_t* Vb  ,
                                                 int mode, int NT, int first_key, int q0, bool use_sink, float sink_log2, bf16_t* Orow0  ) {
    float* Ks = (float*)lds; float* Vs = Ks + 4096;
    const int tid = tid_();
    float q[64], o[64], m = -INFINITY, lsum = 0.f;
    if (tid < 256) {
#pragma unroll
        for (int d = 0; d < 64; ++d) { q[d] = bf2f(Qrow0[(size_t)tid * 256 + d]); o[d] = 0.f; }
    }
    for (int tt = 0; tt < NT; ++tt) {
        int key0, pos0 = 0; bool masked = false;
        if (mode == 0) key0 = first_key + 64 * tt;
        else if (tt < 4) key0 = NSEQ + 64 * tt;
        else { pos0 = q0 - 128 + 64 * (tt - 4); key0 = pos0 < 0 ? 0 : (pos0 > NSEQ - 64 ? NSEQ - 64 : pos0); masked = true; }
        __syncthreads();
        for (int i = tid; i < 4096; i += NTHREADS) { const int kk = i >> 6, d = i & 63; Ks[i] = bf2f(Kb[(size_t)(key0 + kk) * 128 + d]); Vs[i] = bf2f(Vb[(size_t)(key0 + kk) * 128 + d]); }
        __syncthreads();
        if (tid < 256) {
            for (int kk = 0; kk < 64; ++kk) {
                if (masked) { const int kp = pos0 + kk, qp = q0 + tid; const int df = qp - kp; if (kp < 0 || kp >= NSEQ || df > 128 || df < -128) continue; }
                float s = 0.f;
#pragma unroll
                for (int d = 0; d < 64; ++d) s += q[d] * Ks[kk * 64 + d];
                if (s > m) { const float f = exp2f(m - s); lsum *= f;
#pragma unroll
                    for (int d = 0; d < 64; ++d) o[d] *= f;
                    m = s; }
                const float pe = exp2f(s - m); lsum += pe;
#pragma unroll
                for (int d = 0; d < 64; ++d) o[d] += pe * Vs[kk * 64 + d];
            }
        }
    }
    if (tid < 256) {
        if (use_sink) lsum += exp2f(sink_log2 - m);
        const float inv = 1.f / lsum;
#pragma unroll
        for (int d = 0; d < 64; ++d) Orow0[(size_t)tid * D + d] = (bf16_t)f2bf(o[d] * inv);
    }
    __syncthreads();
}
__device__ __forceinline__ void ph_attn(KP p, int l, unsigned char* lds) {
    hgrn_scan(p);
    bf16_t* Y = (bf16_t*)(p->ws + Z_YCAT);
    const bf16_t* Qg = (const bf16_t*)(p->ws + Z_QG); const bf16_t* Qw = (const bf16_t*)(p->ws + Z_QW); const bf16_t* Qgc = (const bf16_t*)(p->ws + Z_QGC); const bf16_t* Qwc = (const bf16_t*)(p->ws + Z_QWC);
    const bf16_t* Kg = (const bf16_t*)(p->ws + Z_KG); const bf16_t* Kw = (const bf16_t*)(p->ws + Z_KW); const bf16_t* Vg = (const bf16_t*)(p->ws + Z_VG); const bf16_t* Vw = (const bf16_t*)(p->ws + Z_VW);
    const int nunits = 512 + (l == 0 ? 16 : 0);
    for (int u = bid_(); u < nunits; u += gsz_()) {
        if (u < 256) {
            const int qb = u & 31, h = (u >> 5) & 3, b = u >> 7, row0 = b * NSEQ + qb * 256;
            attn_simple_unit(lds, Qg + (size_t)row0 * 256 + h * 64, Kg + (size_t)b * NKEY * 128 + (h >> 1) * 64, Vg + (size_t)b * NKEY * 128 + (h >> 1) * 64, 0, NKEY / 64, 0, qb * 256, false, 0.f, Y + (size_t)row0 * D + h * 64);
        } else if (u < 512) {
            const int v = u - 256, qb = v & 31, h = (v >> 5) & 3, b = v >> 7, row0 = b * NSEQ + qb * 256;
            attn_simple_unit(lds, Qw + (size_t)row0 * 256 + h * 64, Kw + (size_t)b * NKEY * 128 + (h >> 1) * 64, Vw + (size_t)b * NKEY * 128 + (h >> 1) * 64, 1, 12, 0, qb * 256, true, p->in[14][l * 4 + h] * LOG2E, Y + (size_t)row0 * D + 512 + h * 64);
        } else {
            const int v = u - 512, h = v & 3, b = (v >> 2) & 1, win = v >> 3, row0 = R_LAT + b * NCTX;
            const bf16_t* Qc = (win ? Qwc : Qgc) + (size_t)(b * NCTX) * 256 + h * 64;
            const bf16_t* Kc = (win ? Kw : Kg) + (size_t)b * NKEY * 128 + (h >> 1) * 64; const bf16_t* Vc = (win ? Vw : Vg) + (size_t)b * NKEY * 128 + (h >> 1) * 64;
            attn_simple_unit(lds, Qc, Kc, Vc, 0, 4, NSEQ, 0, win != 0, p->in[14][l * 4 + h] * LOG2E, Y + (size_t)row0 * D + (win ? 512 : 0) + h * 64);
        }
    }
}

namespace attn_body {
using bf16=__hip_bfloat16;
using bf16x8=__attribute__((ext_vector_type(8)))short;
using s16x4=__attribute__((ext_vector_type(4)))short;
using f32x16=__attribute__((ext_vector_type(16)))float;
using u32x4=__attribute__((ext_vector_type(4)))unsigned;
constexpr int D=64, QP=256, KP=128, OP=1024;
constexpr int NW=8,QBLK=32,QB=QBLK*NW,KVBLK=64;
__device__ __forceinline__ int crow(int r,int hi){return (r&3)+8*(r>>2)+4*hi;}
#define SBAR() __builtin_amdgcn_sched_barrier(0)
__device__ __forceinline__ void wmask(f32x16&p0,f32x16&p1,int tb,int qrel,int hi,int q0){
  const float NEG=-INFINITY; const int kb=64*tb+4*hi;
  #pragma unroll
  for(int r=0;r<16;++r){const int kl=kb+(r&3)+8*(r>>2); const int kp=q0-128+kl;
    if(kl<qrel||kl>qrel+256||kp<0||kp>=NSEQ)p0[r]=NEG;
    if(kl+32<qrel||kl+32>qrel+256||kp+32<0||kp+32>=NSEQ)p1[r]=NEG;}
}

constexpr int NSLOT=3, SLOTB=8192;
constexpr int LDS_K=0, LDS_V=NSLOT*SLOTB, LDS_WS=2*NSLOT*SLOTB, LDS_OST=LDS_WS+NW*64*4, LDS_BYTES=LDS_OST+NW*4096;
constexpr float C2=0.125f*1.4426950408889634f;
__device__ __forceinline__ void glds16(const void*gsrc,unsigned lds_dst){unsigned keep;
  asm volatile("s_mov_b32 %0, m0\n\ts_mov_b32 m0, %2\n\ts_nop 0\n\tglobal_load_lds_dwordx4 %1, off\n\ts_mov_b32 m0, %0":"=&s"(keep):"v"(gsrc),"s"(lds_dst):"memory");}
__device__ __forceinline__ float max3f(float a,float b,float c){float r;asm("v_max3_f32 %0, %1, %2, %3":"=v"(r):"v"(a),"v"(b),"v"(c));return r;}
__device__ __forceinline__ float max2f(float a,float b){float r;asm("v_max_f32_e32 %0, %1, %2":"=v"(r):"v"(a),"v"(b));return r;}
__device__ __forceinline__ float fadd_s(float a,float b){float r;asm("v_add_f32_e32 %0, %1, %2":"=v"(r):"v"(a),"v"(b));return r;}
__device__ __forceinline__ float fsub_s(float a,float b){float r;asm("v_sub_f32_e32 %0, %1, %2":"=v"(r):"v"(a),"v"(b));return r;}
typedef float f32x2_t __attribute__((ext_vector_type(2))); typedef __bf16 bf16x2_t __attribute__((ext_vector_type(2)));
__device__ __forceinline__ unsigned cvtpk_s(float lo,float hi){f32x2_t v={lo,hi};bf16x2_t b=__builtin_convertvector(v,bf16x2_t);return __builtin_bit_cast(unsigned,b);}
#define WAIT_BAR(N) asm volatile("s_waitcnt vmcnt(" #N ") lgkmcnt(0)\n\ts_barrier":::"memory")

__device__ __forceinline__ void qkt(f32x16&p0,f32x16&p1,const char*Kslot,const bf16x8*qr,const f32x16&negm,int r32,int hi){
  const char*kb=Kslot+hi*1024+r32*16;
  #pragma unroll
  for(int d0=0;d0<4;++d0){
    const bf16x8 b0=*reinterpret_cast<const bf16x8*>(kb+d0*2048);
    const bf16x8 b1=*reinterpret_cast<const bf16x8*>(kb+d0*2048+512);
    if(d0==0){p0=__builtin_amdgcn_mfma_f32_32x32x16_bf16(b0,qr[0],negm,0,0,0);p1=__builtin_amdgcn_mfma_f32_32x32x16_bf16(b1,qr[0],negm,0,0,0);}
    else{p0=__builtin_amdgcn_mfma_f32_32x32x16_bf16(b0,qr[d0],p0,0,0,0);p1=__builtin_amdgcn_mfma_f32_32x32x16_bf16(b1,qr[d0],p1,0,0,0);}}
}
typedef __attribute__((address_space(3))) const char* lds_cptr;
typedef short v4i16_t __attribute__((ext_vector_type(4)));
__device__ __forceinline__ void kload8(bf16x8*kf,lds_cptr kp){
  kf[0]=*(const __attribute__((address_space(3))) bf16x8*)(kp);      kf[1]=*(const __attribute__((address_space(3))) bf16x8*)(kp+512);
  kf[2]=*(const __attribute__((address_space(3))) bf16x8*)(kp+2048); kf[3]=*(const __attribute__((address_space(3))) bf16x8*)(kp+2560);
  kf[4]=*(const __attribute__((address_space(3))) bf16x8*)(kp+4096); kf[5]=*(const __attribute__((address_space(3))) bf16x8*)(kp+4608);
  kf[6]=*(const __attribute__((address_space(3))) bf16x8*)(kp+6144); kf[7]=*(const __attribute__((address_space(3))) bf16x8*)(kp+6656);
}
__device__ __forceinline__ void kload2(bf16x8*kf,lds_cptr kp,int j){ kf[2*j]=*(const __attribute__((address_space(3))) bf16x8*)(kp+j*2048); kf[2*j+1]=*(const __attribute__((address_space(3))) bf16x8*)(kp+j*2048+512); }
__device__ __forceinline__ s16x4 vtr(lds_cptr p){ return __builtin_bit_cast(s16x4,__builtin_amdgcn_ds_read_tr16_b64_v4i16((__attribute__((address_space(3))) v4i16_t*)p)); }
__device__ __forceinline__ float rowmax(const f32x16&p0,const f32x16&p1){
  float a=max3f(p0[0],p0[1],p1[0]),b=max3f(p0[2],p0[3],p1[1]);a=max3f(a,p1[2],p1[3]);
  #pragma unroll
  for(int r=4;r<16;r+=4){a=max3f(a,p0[r],p0[r+1]);b=max3f(b,p0[r+2],p0[r+3]);a=max3f(a,p1[r],p1[r+1]);b=max3f(b,p1[r+2],p1[r+3]);}
  const float m=max2f(a,b);
  auto rr=__builtin_amdgcn_permlane32_swap(__float_as_uint(m),__float_as_uint(m),false,false);
  return max2f(__uint_as_float(rr[0]),__uint_as_float(rr[1]));
}
__device__ __forceinline__ void pv(f32x16*o,int vb,bf16x8 pa0,bf16x8 pa1,bf16x8 pa2,bf16x8 pa3){
  #pragma unroll
  for(int d0=0;d0<2;++d0){s16x4 lo[4],hi[4];
    #pragma unroll
    for(int ks=0;ks<4;++ks){
      asm volatile("ds_read_b64_tr_b16 %0,%1 offset:%c2":"=&v"(lo[ks]):"v"(vb),"i"(d0*4096+ks*1024):"memory");
      asm volatile("ds_read_b64_tr_b16 %0,%1 offset:%c2":"=&v"(hi[ks]):"v"(vb),"i"(d0*4096+ks*1024+512):"memory");}
    asm volatile("s_waitcnt lgkmcnt(0)":::"memory");SBAR();
    #define PK(k) (bf16x8){lo[k][0],lo[k][1],lo[k][2],lo[k][3],hi[k][0],hi[k][1],hi[k][2],hi[k][3]}
    o[d0]=__builtin_amdgcn_mfma_f32_32x32x16_bf16(pa0,PK(0),o[d0],0,0,0);
    o[d0]=__builtin_amdgcn_mfma_f32_32x32x16_bf16(pa1,PK(1),o[d0],0,0,0);
    o[d0]=__builtin_amdgcn_mfma_f32_32x32x16_bf16(pa2,PK(2),o[d0],0,0,0);
    o[d0]=__builtin_amdgcn_mfma_f32_32x32x16_bf16(pa3,PK(3),o[d0],0,0,0);
    #undef PK
  }
}

#ifndef ATTN_STORE16
#define ATTN_STORE16(p,v) (*(u32x4*)(p)=(v))
#endif
template<int MODE,int NMASKT,int THRL> __device__ __forceinline__ void attn_unit(const bf16*Q0,const bf16*__restrict__ Kh,const bf16*__restrict__ Vh,bf16*O0,int NT,int key_first,int q0,bool use_sink,float sink_l2,char*shm){
  const int tid=tid_(),lane=tid&63,r32=lane&31,hi=lane>>5; const int wid=__builtin_amdgcn_readfirstlane(tid>>6);
  const bf16*Qw=Q0+(long)(wid*QBLK)*QP;
  auto krow=[&](int t)->long{ if(MODE==0) return (long)key_first+64*t; if(t<4) return (long)NSEQ+64*t; int p=q0-128+64*(t-4); p=p<0?0:(p>NSEQ-64?NSEQ-64:p); return (long)p; };
  const unsigned lds0=(unsigned)(uintptr_t)shm;
  float*wsf=(float*)(shm+LDS_WS)+wid*64;
  const bf16*ksrc=Kh+(long)lane*KP+wid*8;
  const bf16*vsrc=Vh+(long)(16*(wid&3)+(lane>>2))*KP+(wid>>2)*32+(lane&3)*8;
  const unsigned kdst=lds0+LDS_K+wid*1024, vdst=lds0+LDS_V+wid*1024;
  #define DMA_K(t,slot) glds16(ksrc+krow(t)*KP,(unsigned)__builtin_amdgcn_readfirstlane(kdst+(slot)))
  #define DMA_V(t,slot) glds16(vsrc+krow(t)*KP,(unsigned)__builtin_amdgcn_readfirstlane(vdst+(slot)))
  const int vb0=(int)(lds0+LDS_V)+((lane>>4)&1)*32+(lane&3)*8+(4*hi+((lane&15)>>2))*64;
  const char*Kbase=shm+LDS_K; bf16x8 kf[8];
  const lds_cptr shm3=(lds_cptr)shm; const lds_cptr kp0=shm3+LDS_K+hi*1024+r32*16; const lds_cptr vp0=shm3+LDS_V+((lane>>4)&1)*32+(lane&3)*8+(4*hi+((lane&15)>>2))*64;
  DMA_K(0,0);DMA_V(0,0);DMA_K(1,SLOTB);
  bf16x8 qr[4];
  #pragma unroll
  for(int d0=0;d0<4;++d0)qr[d0]=*reinterpret_cast<const bf16x8*>(&Qw[(long)r32*QP+d0*16+hi*8]);
  float mhat=0.f,l_reg=0.f;f32x16 o[2];o[0]=f32x16{};o[1]=f32x16{};f32x16 negm=f32x16{};asm volatile("":"+v"(negm));
  const int qrel=wid*QBLK+r32;
  #define CMASK(P0,P1,t) do{ if(NMASKT>0){int jb_=(t)-(NT-NMASKT); if(jb_>=0)wmask(P0,P1,jb_,qrel,hi,q0);} }while(0)
  bool resc=false;
  #define START(P0,P1) do{ const float rm=rowmax(P0,P1); resc=false; \
    { const float dl=rm; mhat=fadd_s(mhat,dl); \
      _Pragma("unroll") for(int r=0;r<16;++r){P0[r]=fsub_s(P0[r],dl);P1[r]=fsub_s(P1[r],dl);} \
      _Pragma("unroll") for(int r=0;r<16;++r)negm[r]=-mhat; asm volatile("":"+v"(negm)); } \
    _Pragma("unroll") for(int r=0;r<16;++r)P0[r]=__builtin_amdgcn_exp2f(P0[r]); }while(0)
  #define RESC() do{ if(resc){ asm volatile("s_waitcnt lgkmcnt(0)":::"memory"); \
      _Pragma("unroll") for(int d_=0;d_<2;++d_) _Pragma("unroll") for(int r=0;r<16;++r)o[d_][r]*=wsf[crow(r,hi)]; } }while(0)
  f32x16 pA0,pA1,pB0,pB1;
  int sl_prev=0,sl_cur=0,sl_next=SLOTB;
  #define ROT() do{sl_prev=sl_cur;sl_cur=sl_next;sl_next=(sl_next==(NSLOT-1)*SLOTB)?0:sl_next+SLOTB;}while(0)
  DMA_K(2,2*SLOTB);
  WAIT_BAR(3);
  qkt(pA0,pA1,Kbase,qr,negm,r32,hi);asm volatile("s_nop 15\n\ts_nop 7":"+v"(pA0),"+v"(pA1));CMASK(pA0,pA1,0);
  START(pA0,pA1);
  _Pragma("unroll") for(int r=0;r<16;++r)pA1[r]=__builtin_amdgcn_exp2f(pA1[r]);
  WAIT_BAR(0);
  DMA_K(3,0);DMA_V(1,SLOTB);
  ROT();
  kload8(kf,kp0+sl_cur);
  WAIT_BAR(2);
  s16x4 vlo[8],vhi[8]; u32x4 pw0,pw1,pw2,pw3;
  #define PKW(P,B) cvtpk_s(P[B],P[B+1])
  #define PAF(k) __builtin_bit_cast(bf16x8,pw##k)
  #define VFR(i) (bf16x8){vlo[i][0],vlo[i][1],vlo[i][2],vlo[i][3],vhi[i][0],vhi[i][1],vhi[i][2],vhi[i][3]}
  #define PIN(x) asm volatile("":"+v"(x))
  #define MX3(a,b,c) __builtin_fmaxf(__builtin_fmaxf((a),(b)),(c))
  #define GAPA(MF,A0,A1,A2,A3,W0,W1,PW) do{ MF; sacc+=A0; sacc+=A1; sacc+=A2; sacc+=A3; PIN(sacc); W0; W1; PIN(PW); SBAR(); }while(0)
  #define EX(v) __builtin_amdgcn_exp2f(v)
  #define GAPB(MF,X,B) do{ MF; X[B]=EX(X[B]); X[B+1]=EX(X[B+1]); X[B+2]=EX(X[B+2]); X[B+3]=EX(X[B+3]); PIN(X); SBAR(); }while(0)
  #define VRD(i) do{ vlo[i]=vtr(vp_+(((i)>>2)*4096+((i)&3)*1024)); vhi[i]=vtr(vp_+(((i)>>2)*4096+((i)&3)*1024+512)); }while(0)
  #define KRD(G,j) do{ if(G){ kload2(kf,kp0+sl_next,j); SBAR(); } }while(0)
  #define STEP(C0,C1,P0,P1,t,GK,GV,GL) do{ SBAR(); \
    const lds_cptr vp_=vp0+sl_prev; \
    VRD(0); SBAR(); float sacc=(P0[0]+P0[1]); \
    GAPA(C0=__builtin_amdgcn_mfma_f32_32x32x16_bf16(kf[0],qr[0],negm,0,0,0), P0[2],P0[3],P0[4],P0[5],     pw0[0]=PKW(P0,0), pw0[1]=PKW(P0,2), pw0); \
    VRD(4); SBAR(); GAPA(C1=__builtin_amdgcn_mfma_f32_32x32x16_bf16(kf[1],qr[0],negm,0,0,0), P0[6],P0[7],P0[8],P0[9],     pw0[2]=PKW(P0,4), pw0[3]=PKW(P0,6), pw0); \
    VRD(1); SBAR(); GAPA(C0=__builtin_amdgcn_mfma_f32_32x32x16_bf16(kf[2],qr[1],C0,0,0,0),   P0[10],P0[11],P0[12],P0[13], pw1[0]=PKW(P0,8), pw1[1]=PKW(P0,10), pw1); \
    VRD(5); SBAR(); GAPA(C1=__builtin_amdgcn_mfma_f32_32x32x16_bf16(kf[3],qr[1],C1,0,0,0),   P0[14],P0[15],P1[0],P1[1],   pw1[2]=PKW(P0,12),pw1[3]=PKW(P0,14), pw1); \
    VRD(2); SBAR(); GAPA(C0=__builtin_amdgcn_mfma_f32_32x32x16_bf16(kf[4],qr[2],C0,0,0,0),   P1[2],P1[3],P1[4],P1[5],     pw2[0]=PKW(P1,0), pw2[1]=PKW(P1,2), pw2); \
    VRD(6); SBAR(); GAPA(C1=__builtin_amdgcn_mfma_f32_32x32x16_bf16(kf[5],qr[2],C1,0,0,0),   P1[6],P1[7],P1[8],P1[9],     pw2[2]=PKW(P1,4), pw2[3]=PKW(P1,6), pw2); \
    VRD(3); SBAR(); GAPA(C0=__builtin_amdgcn_mfma_f32_32x32x16_bf16(kf[6],qr[3],C0,0,0,0),   P1[10],P1[11],P1[12],P1[13], pw3[0]=PKW(P1,8), pw3[1]=PKW(P1,10), pw3); \
    VRD(7); SBAR(); GAPA(C1=__builtin_amdgcn_mfma_f32_32x32x16_bf16(kf[7],qr[3],C1,0,0,0),   P1[14],P1[15],0.f,0.f,       pw3[2]=PKW(P1,12),pw3[3]=PKW(P1,14), pw3); \
    l_reg+=sacc; \
    if(GK){DMA_K((t)+3,sl_cur);} if(GV){DMA_V((t)+1,sl_next);} \
    CMASK(C0,C1,t); \
    { float a=MX3(C0[0],C0[1],C1[0]),b=MX3(C0[2],C0[3],C1[1]); a=MX3(a,C1[2],C1[3]); \
      _Pragma("unroll") for(int r=4;r<16;r+=4){a=MX3(a,C0[r],C0[r+1]);b=MX3(b,C0[r+2],C0[r+3]);a=MX3(a,C1[r],C1[r+1]);b=MX3(b,C1[r+2],C1[r+3]);} \
      float rm=__builtin_fmaxf(a,b); { auto rr=__builtin_amdgcn_permlane32_swap(__float_as_uint(rm),__float_as_uint(rm),false,false); rm=__builtin_fmaxf(__uint_as_float(rr[0]),__uint_as_float(rr[1])); } \
      resc=false; \
      if(__builtin_expect(__any(rm>(float)THRL),0)){ const float dl=__builtin_fmaxf(rm,0.f); mhat+=dl; \
        _Pragma("unroll") for(int r=0;r<16;++r){C0[r]-=dl;C1[r]-=dl;} \
        _Pragma("unroll") for(int r=0;r<16;++r)negm[r]=-mhat; asm volatile("":"+v"(negm)); \
        const float f=__builtin_amdgcn_exp2f(-dl); l_reg*=f; if(hi==0)wsf[r32]=f; resc=true; } } \
    SBAR(); \
    GAPB(o[0]=__builtin_amdgcn_mfma_f32_32x32x16_bf16(PAF(0),VFR(0),o[0],0,0,0), C0,0); \
    GAPB(o[1]=__builtin_amdgcn_mfma_f32_32x32x16_bf16(PAF(0),VFR(4),o[1],0,0,0), C0,4); \
    KRD(GL,0); GAPB(o[0]=__builtin_amdgcn_mfma_f32_32x32x16_bf16(PAF(1),VFR(1),o[0],0,0,0), C0,8); \
    KRD(GL,1); GAPB(o[1]=__builtin_amdgcn_mfma_f32_32x32x16_bf16(PAF(1),VFR(5),o[1],0,0,0), C0,12); \
    KRD(GL,2); GAPB(o[0]=__builtin_amdgcn_mfma_f32_32x32x16_bf16(PAF(2),VFR(2),o[0],0,0,0), C1,0); \
    KRD(GL,3); GAPB(o[1]=__builtin_amdgcn_mfma_f32_32x32x16_bf16(PAF(2),VFR(6),o[1],0,0,0), C1,4); \
    GAPB(o[0]=__builtin_amdgcn_mfma_f32_32x32x16_bf16(PAF(3),VFR(3),o[0],0,0,0), C1,8); \
    GAPB(o[1]=__builtin_amdgcn_mfma_f32_32x32x16_bf16(PAF(3),VFR(7),o[1],0,0,0), C1,12); \
    }while(0)
  int t=1;
  #undef CMASK
  #define CMASK(P0,P1,t) do{}while(0)
  for(;t+1+(NMASKT>4?NMASKT:4)<NT;t+=2){
    STEP(pB0,pB1,pA0,pA1,t,true,true,true);     WAIT_BAR(2); RESC(); ROT();
    STEP(pA0,pA1,pB0,pB1,t+1,true,true,true);   WAIT_BAR(2); RESC(); ROT();
  }
  #undef CMASK
  #define CMASK(P0,P1,t) do{ if(NMASKT>0){int jb_=(t)-(NT-NMASKT); if(jb_>=0)wmask(P0,P1,jb_,qrel,hi,q0);} }while(0)
  #define ENDW(tt) do{ if((tt)+3<NT){WAIT_BAR(2);} else if((tt)+2<NT){WAIT_BAR(1);} else {WAIT_BAR(0);} }while(0)
  for(;t+1<NT;t+=2){
    STEP(pB0,pB1,pA0,pA1,t,(t+3<NT),(t+1<NT),(t+1<NT));       ENDW(t);   RESC(); ROT();
    STEP(pA0,pA1,pB0,pB1,t+1,(t+4<NT),(t+2<NT),(t+2<NT));     ENDW(t+1); RESC(); ROT();
  }
  STEP(pB0,pB1,pA0,pA1,NT-1,false,false,false); RESC();
  { float sacc=pB0[0]+pB0[1]; _Pragma("unroll") for(int r=2;r<16;++r)sacc+=pB0[r]; _Pragma("unroll") for(int r=0;r<16;++r)sacc+=pB1[r]; l_reg+=sacc;
    pw0=(u32x4){PKW(pB0,0),PKW(pB0,2),PKW(pB0,4),PKW(pB0,6)};pw1=(u32x4){PKW(pB0,8),PKW(pB0,10),PKW(pB0,12),PKW(pB0,14)};pw2=(u32x4){PKW(pB1,0),PKW(pB1,2),PKW(pB1,4),PKW(pB1,6)};pw3=(u32x4){PKW(pB1,8),PKW(pB1,10),PKW(pB1,12),PKW(pB1,14)};
    SBAR(); pv(o,vb0+sl_cur,PAF(0),PAF(1),PAF(2),PAF(3)); }
  #undef PKW
  #undef PAF
  #undef VFR
  #undef PIN
  #undef MX3
  #undef GAPA
  #undef GAPB
  #undef EX
  #undef VRD
  #undef KRD
  #undef STEP
  #undef ENDW
  {auto rr=__builtin_amdgcn_permlane32_swap(__float_as_uint(l_reg),__float_as_uint(l_reg),false,false);l_reg=__uint_as_float(rr[0])+__uint_as_float(rr[1]);}
  if(use_sink)l_reg+=__builtin_amdgcn_exp2f(sink_l2-mhat);
  if(hi==0)wsf[32+r32]=l_reg;asm volatile("s_waitcnt lgkmcnt(0)":::"memory");
  float rli[16];
  #pragma unroll
  for(int r=0;r<16;++r)rli[r]=__builtin_amdgcn_rcpf(wsf[32+crow(r,hi)]);
  bf16*Ow=O0+(long)(wid*QBLK)*OP;
  { bf16*stg=(bf16*)(shm+LDS_OST)+wid*2048;
    #pragma unroll
    for(int r=0;r<16;++r){const int orow=crow(r,hi);
      #pragma unroll
      for(int d0=0;d0<2;++d0)stg[orow*64+d0*32+r32]=__float2bfloat16(o[d0][r]*rli[r]);}
    asm volatile("s_waitcnt lgkmcnt(0)":::"memory");
    #pragma unroll
    for(int i=0;i<4;++i){const int row=i*8+(lane>>3),ch=lane&7; const u32x4 v=*(const u32x4*)(stg+row*64+ch*8); ATTN_STORE16(Ow+(long)row*OP+ch*8,v);} }
  asm volatile("s_waitcnt lgkmcnt(0)\n\ts_barrier":::"memory");
  #undef DMA_K
  #undef DMA_V
  #undef CMASK
  #undef START
  #undef RESC
  #undef ROT
}
constexpr int ATTN_LDS_BYTES=LDS_BYTES;
#undef SBAR
#undef WAIT_BAR
}

__device__ __forceinline__ void ph_attn_f(KP p, int l, unsigned char* lds, bool do_scan = true) {
    if (do_scan) { if (FAST_HGRN) hgrn_scan_f(p); else hgrn_scan(p); }
    using attn_body::bf16;
    bf16* Y = (bf16*)(p->ws + Z_YCAT);
    const bf16* Qg = (const bf16*)(p->ws + Z_QG); const bf16* Qw = (const bf16*)(p->ws + Z_QW); const bf16* Qgc = (const bf16*)(p->ws + Z_QGC); const bf16* Qwc = (const bf16*)(p->ws + Z_QWC);
    const bf16* Kg = (const bf16*)(p->ws + Z_KG); const bf16* Kw = (const bf16*)(p->ws + Z_KW); const bf16* Vg = (const bf16*)(p->ws + Z_VG); const bf16* Vw = (const bf16*)(p->ws + Z_VW);
    const int G = gsz_(), bid = bid_();
    __syncthreads();
    for (int vb = bid; vb < 256; vb += G) {
        const int v = (G == 256) ? (((vb & 7) >> 1) * 64 + (vb & 1) * 32 + (vb >> 3)) : vb;
        const int b = v >> 7, kvh = (v >> 6) & 1, h = kvh * 2 + ((v >> 5) & 1), qb = v & 31, row0 = b * NSEQ + qb * 256;
        const size_t kvo = (size_t)b * NKEY * 128 + kvh * 64;
        attn_body::attn_unit<0, 0, 8>(Qg + (size_t)row0 * 256 + h * 64, Kg + kvo, Vg + kvo, Y + (size_t)row0 * D + h * 64, NKEY / 64, 0, 0, false, 0.f, (char*)lds);
        attn_body::attn_unit<1, 8, 8>(Qw + (size_t)row0 * 256 + h * 64, Kw + kvo, Vw + kvo, Y + (size_t)row0 * D + 512 + h * 64, 12, 0, qb * 256, true, p->in[14][l * 4 + h] * LOG2E, (char*)lds);
    }
    if (l == 0) for (int v = bid; v < 16; v += G) {
        const int h = v & 3, b = (v >> 2) & 1, win = v >> 3, row0 = R_LAT + b * NCTX;
        const size_t kvo = (size_t)b * NKEY * 128 + (h >> 1) * 64;
        attn_body::attn_unit<0, 0, 8>((win ? Qwc : Qgc) + (size_t)(b * NCTX) * 256 + h * 64, (win ? Kw : Kg) + kvo, (win ? Vw : Vg) + kvo, Y + (size_t)row0 * D + (win ? 512 : 0) + h * 64, 4, NSEQ, 0, win != 0, p->in[14][l * 4 + h] * LOG2E, (char*)lds);
    }
}

__device__ __forceinline__ void hgrn_pass3_unit(KP p, int l, unsigned char* lds, int unit) {
    float* qs = (float*)lds; float* vs = qs + 4096; float* ks = vs + 4096; float* cs = ks + 4096; float* Ss = cs + 4096; float* sc = Ss + 4096; float* os = sc + 4096;
    const int tid = tid_(), lane = tid & 63, wid = tid >> 6;
    const int cpos = unit % NCHUNK, head = (unit / NCHUNK) & 3, b = unit / (NCHUNK * 4);
    const int row0 = (cpos < 4) ? R_LAT + b * NCTX + cpos * 64 : b * NSEQ + (cpos - 4) * 64;
    for (int i = tid; i < 4096; i += NTHREADS) os[i] = 0.f;
    for (int dir = 0; dir < 2; ++dir) {
        const int j = (cpos < 4) ? (dir ? 3 - cpos : cpos) : 4 + (dir ? 127 - (cpos - 4) : (cpos - 4));
        const int seq = (b * 4 + head) * 2 + dir;
        __syncthreads();
        hgrn_load_chunk(p, l, row0, dir, head, qs, vs, ks, cs);
        const float* Sg = (const float*)(p->ws + Z_U) + ((size_t)seq * NCHUNK + j) * 4096;
        for (int i = tid; i < 4096; i += NTHREADS) Ss[i] = Sg[i];
        for (int i = tid; i < 4096; i += NTHREADS) { const int tau = i >> 6, sig = i & 63; float a = 0.f;
            if (sig <= tau) { for (int d = 0; d < 64; ++d) a += qs[tau * 64 + d] * ks[sig * 64 + d] * __expf(cs[tau * 64 + d] - cs[sig * 64 + d]); }
            sc[i] = a; }
        __syncthreads();
        { const int tau = tid >> 3, e0 = (tid & 7) * 8; float acc[8];
#pragma unroll
          for (int e = 0; e < 8; ++e) acc[e] = 0.f;
          for (int d = 0; d < 64; ++d) { const float qv = qs[tau * 64 + d] * __expf(cs[tau * 64 + d]);
#pragma unroll
              for (int e = 0; e < 8; ++e) acc[e] += qv * Ss[d * 64 + e0 + e]; }
          for (int sig = 0; sig <= tau; ++sig) { const float sv = sc[tau * 64 + sig];
#pragma unroll
              for (int e = 0; e < 8; ++e) acc[e] += sv * vs[sig * 64 + e0 + e]; }
          const int tok = dir ? 63 - tau : tau;
#pragma unroll
          for (int e = 0; e < 8; ++e) os[tok * 64 + e0 + e] += acc[e]; }
        __syncthreads();
    }
    const bf16_t* P = (const bf16_t*)(p->ws + Z_P); bf16_t* Y = (bf16_t*)(p->ws + Z_YCAT);
    for (int tok = wid; tok < 64; tok += 8) { const float v = os[tok * 64 + lane];
        const float y = v * rsqrtf(wave_sum(v * v) * (1.f / 64.f) + EPS) * p->in[22][l * 64 + lane];
        const float g = bf2f(P[(size_t)(row0 + tok) * DIN + C_RG + head * 64 + lane]);
        Y[(size_t)(row0 + tok) * D + 768 + head * 64 + lane] = (bf16_t)f2bf(y * silu_(g)); }
    __syncthreads();
}
__device__ __forceinline__ void ph_hgrn3(KP p, int l, unsigned char* lds) {
    hgrn_pass3_run(p, l, lds);
    if (l == 0 && DEPTH > 1 && gsz_() == 256) { __syncthreads(); ph_cvt(p, 1, lds, 32, 224, CVT_E1, CVT_E2); }
}

__device__ __forceinline__ void ph_outproj(KP p, int l, unsigned char* lds) {
    const bf16_t* A = (const bf16_t*)(p->ws + Z_YCAT); const bf16_t* Bt = (const bf16_t*)(p->ws + Z_WOUT); float* X = (float*)(p->ws + WS_X);
    const int T = (l == 0) ? R_ALL : R_LAT; const int TM = T / 128, TN = 8;
    for (int it = bid_(); it < TM * TN; it += gsz_()) { const int mt = it / TN, nt = it % TN;
        auto epi = [&](int row, int col, float v, float) { const int c = nt * 128 + col; X[(size_t)row * D + c] = xrow_src(p, l, row)[c] + mod_vec(p, l, row, 2)[c] * v; };
        gemm_simple_tile<1>(A, RowId{}, Bt, 1024, mt * 128, nt * 128, 0, epi); }
}

__device__ __forceinline__ void ph_norm2(KP p, int l, unsigned char* lds, int cnt_off = 0) {
    constexpr int RS = 1032, NSTG = 80;
    const int T = (l == 0) ? R_ALL : R_LAT;
    bf16_t* AH = (bf16_t*)lds; bf16_t* AL = AH + 16 * RS;
    float* PART = (float*)(lds + 2 * 16 * RS * 2); float* LOG = PART + 8 * 16 * 64;
    int* hist = (int*)(LOG + 16 * 64); int* hbase = hist + 64; int* s_e = hbase + 64; int* s_r = s_e + NSTG * 8; float* s_w = (float*)(s_r + NSTG * 8); float* msb = s_w + NSTG * 8;
    const int tid = tid_(), lane = tid & 63, wid = tid >> 6, fr = lane & 15, fq = lane >> 4, bid = bid_(), G = gsz_();
    bf16_t* Tok = (bf16_t*)(p->ws + Z_A); const bf16_t* X = (const bf16_t*)(p->ws + WS_X);
    const float* g2 = p->in[7] + l * D; const float* rw = p->in[23] + (size_t)l * 1024 * 64; const float* rbias = p->in[24] + l * 64;
    unsigned* cnt = (unsigned*)(p->ws + WS_CTL) + CW_CNT + cnt_off + l * 64;
    int* tok_e = (int*)(p->ws + WS_TOKE); int* tok_p = (int*)(p->ws + WS_TOKP); int* expl = (int*)(p->ws + WS_EXPL); float* expw = (float*)(p->ws + WS_EXPW);
    bf16x8 bh[4][4], bl[4][4];
#pragma unroll
    for (int t = 0; t < 4; ++t)
#pragma unroll
        for (int k = 0; k < 4; ++k) { float v[8], lo[8];
#pragma unroll
            for (int j = 0; j < 8; ++j) v[j] = rw[(size_t)((wid * 4 + k) * 32 + fq * 8 + j) * 64 + t * 16 + fr];
            const u32x4 hh = pack8(v);
            const float hf[8] = {bf2f(hh.x & 0xffffu), bf2f(hh.x >> 16), bf2f(hh.y & 0xffffu), bf2f(hh.y >> 16), bf2f(hh.z & 0xffffu), bf2f(hh.z >> 16), bf2f(hh.w & 0xffffu), bf2f(hh.w >> 16)};
#pragma unroll
            for (int j = 0; j < 8; ++j) lo[j] = v[j] - hf[j];
            const u32x4 ll = pack8(lo);
            bh[t][k] = __builtin_bit_cast(bf16x8, hh); bl[t][k] = __builtin_bit_cast(bf16x8, ll); }
    const float mybias = rbias[lane];
    const int rpb = (T + G - 1) / G;
    for (int base = bid * rpb; base < T; base += G * rpb) {
        const int r1 = (base + rpb < T) ? base + rpb : T;
        if (tid < 64) hist[tid] = 0;
        for (int s0 = base; s0 < r1; s0 += 16) {
#pragma unroll
            for (int j2 = 0; j2 < 2; ++j2) { const int lr = wid * 2 + j2, row = s0 + lr;
                if (row < r1) {
                    const bf16_t* xrow = X + (size_t)row * D; const float* shift = mod_vec(p, l, row, 3); const float* scale = mod_vec(p, l, row, 4);
                    f32x4 v[4]; float ssq = 0.f;
#pragma unroll
                    for (int j = 0; j < 4; ++j) { const u32x2 r2 = ((const u32x2*)xrow)[lane + 64 * j]; v[j].x = bf2f(r2.x & 0xffffu); v[j].y = bf2f(r2.x >> 16); v[j].z = bf2f(r2.y & 0xffffu); v[j].w = bf2f(r2.y >> 16); ssq += v[j].x * v[j].x + v[j].y * v[j].y + v[j].z * v[j].z + v[j].w * v[j].w; }
                    const float rinv = rsqrtf(wave_sum(ssq) * (1.f / D) + EPS);
#pragma unroll
                    for (int j = 0; j < 4; ++j) { const int idx = lane + 64 * j;
                        const f32x4 gg = ((const f32x4*)g2)[idx], sh = ((const f32x4*)shift)[idx], sc = ((const f32x4*)scale)[idx];
                        f32x4 y; y.x = v[j].x * rinv * gg.x * (1.f + sc.x) + sh.x; y.y = v[j].y * rinv * gg.y * (1.f + sc.y) + sh.y;
                        y.z = v[j].z * rinv * gg.z * (1.f + sc.z) + sh.z; y.w = v[j].w * rinv * gg.w * (1.f + sc.w) + sh.w;
                        u32x2 h; h.x = pk2(y.x, y.y); h.y = pk2(y.z, y.w);
                        u32x2 lw; lw.x = pk2(y.x - bf2f(h.x & 0xffffu), y.y - bf2f(h.x >> 16)); lw.y = pk2(y.z - bf2f(h.y & 0xffffu), y.w - bf2f(h.y >> 16));
                        { int t8 = __builtin_amdgcn_cvt_pk_fp8_f32(clamp8(y.x * TOK8_SCALE), clamp8(y.y * TOK8_SCALE), 0, false); t8 = __builtin_amdgcn_cvt_pk_fp8_f32(clamp8(y.z * TOK8_SCALE), clamp8(y.w * TOK8_SCALE), t8, true);
                          ((unsigned*)((unsigned char*)Tok + (size_t)row * D))[idx] = (unsigned)t8; }
                        *(u32x2*)(AH + lr * RS + idx * 4) = h; *(u32x2*)(AL + lr * RS + idx * 4) = lw; }
                } else {
#pragma unroll
                    for (int j = 0; j < 4; ++j) { const int idx = lane + 64 * j; const u32x2 z = {0u, 0u}; *(u32x2*)(AH + lr * RS + idx * 4) = z; *(u32x2*)(AL + lr * RS + idx * 4) = z; } } }
            __syncthreads();
            { f32x4 acc[4];
#pragma unroll
              for (int t = 0; t < 4; ++t) acc[t] = (f32x4){0.f, 0.f, 0.f, 0.f};
#pragma unroll
              for (int k = 0; k < 4; ++k) { const int ko = (wid * 4 + k) * 32 + fq * 8;
                  const bf16x8 ah = *(const bf16x8*)(AH + fr * RS + ko), al = *(const bf16x8*)(AL + fr * RS + ko);
#pragma unroll
                  for (int t = 0; t < 4; ++t) { acc[t] = __builtin_amdgcn_mfma_f32_16x16x32_bf16(ah, bh[t][k], acc[t], 0, 0, 0);
                      acc[t] = __builtin_amdgcn_mfma_f32_16x16x32_bf16(ah, bl[t][k], acc[t], 0, 0, 0); acc[t] = __builtin_amdgcn_mfma_f32_16x16x32_bf16(al, bh[t][k], acc[t], 0, 0, 0); } }
#pragma unroll
              for (int t = 0; t < 4; ++t)
#pragma unroll
                  for (int r = 0; r < 4; ++r) PART[(wid * 16 + fq * 4 + r) * 64 + t * 16 + fr] = acc[t][r]; }
            __syncthreads();
#pragma unroll
            for (int q = 0; q < 2; ++q) { const int o = tid + q * NTHREADS; float a = 0.f;
#pragma unroll
                for (int w8 = 0; w8 < 8; ++w8) a += PART[w8 * 1024 + o];
                LOG[o] = a; }
            __syncthreads();
#pragma unroll 1
            for (int j2 = 0; j2 < 2; ++j2) { const int lr = wid * 2 + j2, row = s0 + lr;
                if (row >= r1) continue;
                const int sr = row - base;
                const float score = sigmoid_(LOG[lr * 64 + lane]), sel = score + mybias;
                const int e = lane, g = e >> 3;
                int rg = 0;
#pragma unroll
                for (int i = 1; i < 8; ++i) { const int src = (lane & ~7) | ((lane + i) & 7); const float o = __shfl(sel, src); rg += (o > sel) || (o == sel && src < e); }
                float top2 = (rg < 2) ? sel : 0.f;
                top2 += __shfl_xor(top2, 1); top2 += __shfl_xor(top2, 2); top2 += __shfl_xor(top2, 4);
                int grank = 0;
#pragma unroll
                for (int i = 1; i < 8; ++i) { const int og = (g + i) & 7; const float o = __shfl(top2, og * 8); grank += (o > top2) || (o == top2 && og < g); }
                const bool keep = grank < 4;
                const float ms = keep ? sel : -INFINITY;
                float* mrow = msb + wid * 64;
                mrow[lane] = ms;
                __builtin_amdgcn_wave_barrier();
                int rk = 0;
#pragma unroll 4
                for (int i = 0; i < 16; ++i) { const f32x4 o = *(const f32x4*)(mrow + 4 * i);
                    rk += (o.x > ms) || (o.x == ms && 4 * i + 0 < e); rk += (o.y > ms) || (o.y == ms && 4 * i + 1 < e);
                    rk += (o.z > ms) || (o.z == ms && 4 * i + 2 < e); rk += (o.w > ms) || (o.w == ms && 4 * i + 3 < e); }
                __builtin_amdgcn_wave_barrier();
                const bool chosen = keep && rk < 8;
                const float wsum = wave_sum(chosen ? score : 0.f);
                if (chosen) { const int r = atomicAdd(&hist[e], 1); s_e[sr * 8 + rk] = e; s_r[sr * 8 + rk] = r; s_w[sr * 8 + rk] = score / wsum * 2.5f; } }
        }
        __syncthreads();
        if (tid < 64) { const int h = hist[tid]; hbase[tid] = h ? (int)atomicAdd(&cnt[tid], (unsigned)h) : 0; }
        __syncthreads();
        for (int i = tid; i < (r1 - base) * 8; i += NTHREADS) { const int e = s_e[i]; const size_t o = (size_t)base * 8 + i;
            const int pos = hbase[e] + s_r[i]; tok_e[o] = e; tok_p[o] = pos; expl[(size_t)e * R_ALL + pos] = base + (i >> 3); expw[(size_t)e * R_ALL + pos] = s_w[i]; }
        __syncthreads();
    }
}

__device__ __forceinline__ void moe_pad_starts(KP p, int l, int* ps) {
    const unsigned* cnt = (const unsigned*)(p->ws + WS_CTL) + CW_CNT + l * 64;
    const int tid = tid_();
    if (tid < 64) { const int v = (int)((cnt[tid] + 255u) >> 8) << 8; int incl = v;
#pragma unroll
        for (int d = 1; d < 64; d <<= 1) { const int o = __shfl_up(incl, d); if (tid >= d) incl += o; }
        ps[tid] = incl - v; if (tid == 63) ps[64] = incl; }
    __syncthreads();
}
__device__ __forceinline__ int moe_expert_of_row(const int* ps, int row) { int e = 0; while (e < 63 && row >= ps[e + 1]) ++e; return e; }

__device__ __forceinline__ void ph_slots(KP p, int l, unsigned char* lds) {
    const int T = (l == 0) ? R_ALL : R_LAT;
    int* ps = (int*)lds; moe_pad_starts(p, l, ps);
    const unsigned* cnt = (const unsigned*)(p->ws + WS_CTL) + CW_CNT + l * 64;
    const int* tok_e = (const int*)(p->ws + WS_TOKE); const int* tok_p = (const int*)(p->ws + WS_TOKP); const float* tok_w = (const float*)(p->ws + WS_TOKW);
    int* tok_s = (int*)(p->ws + WS_TOKS); int* slot_t = (int*)(p->ws + WS_SLOTT); float* slot_w = (float*)(p->ws + WS_SLOTW);
    for (int i = bid_() * NTHREADS + tid_(); i < T * 8; i += gsz_() * NTHREADS) { const int e = tok_e[i], slot = ps[e] + tok_p[i]; tok_s[i] = slot; slot_t[slot] = i >> 3; slot_w[slot] = tok_w[i]; }
    for (int i = bid_() * NTHREADS + tid_(); i < T; i += gsz_() * NTHREADS) { slot_t[MAXSLOT + i] = i; slot_w[MAXSLOT + i] = 1.f; }
    for (int i = bid_() * NTHREADS + tid_(); i < 64 * 256; i += gsz_() * NTHREADS) { const int e = i >> 8, j = i & 255; const int r = ps[e] + (int)cnt[e] + j; if (r < ps[e + 1]) { slot_t[r] = 0; slot_w[r] = 0.f; } }
    __syncthreads();
}

__device__ __forceinline__ void ph_gateup(KP p, int l, unsigned char* lds) {
    const int T = (l == 0) ? R_ALL : R_LAT;
    int* ps = (int*)lds; moe_pad_starts(p, l, ps);
    const bf16_t* Tok = (const bf16_t*)(p->ws + Z_A); const bf16_t* Wgu = (const bf16_t*)(p->ws + Z_WGU); bf16_t* H = (bf16_t*)(p->ws + Z_H);
    const int* slot_t = (const int*)(p->ws + WS_SLOTT); const float* slot_w = (const float*)(p->ws + WS_SLOTW);
    const int n128 = ps[64] / 128, nitems = (n128 + T / 128) * 2;
    for (int it = bid_(); it < nitems; it += gsz_()) { const int rt = it >> 1, pn = it & 1;
        if (rt < n128) { const int e = moe_expert_of_row(ps, rt * 128);
            auto epi = [&](int row, int col, float g, float u) { H[(size_t)row * 256 + pn * 128 + col] = (bf16_t)f2bf(silu_(g) * u * slot_w[row]); };
            gemm_simple_tile<2>(Tok, RowGather{slot_t}, Wgu + (size_t)e * 524288, 1024, rt * 128, pn * 256, 128, epi);
        } else { const int t0 = (rt - n128) * 128;
            auto epi = [&](int row, int col, float g, float u) { H[(size_t)(MAXSLOT + row) * 256 + pn * 128 + col] = (bf16_t)f2bf(silu_(g) * u); };
            gemm_simple_tile<2>(Tok, RowId{}, Wgu + (size_t)64 * 524288, 1024, t0, pn * 256, 128, epi); }
    }
}
__device__ __forceinline__ void ph_down(KP p, int l, unsigned char* lds) {
    const int T = (l == 0) ? R_ALL : R_LAT;
    int* ps = (int*)lds; moe_pad_starts(p, l, ps);
    const bf16_t* H = (const bf16_t*)(p->ws + Z_H); const bf16_t* Wd = (const bf16_t*)(p->ws + WS_WD); bf16_t* Y = (bf16_t*)(p->ws + Z_Y); float* X = (float*)(p->ws + WS_X);
    const int n128 = ps[64] / 128, nitems = (n128 + T / 128) * 8;
    for (int it = bid_(); it < nitems; it += gsz_()) { const int rt = it >> 3, nt = it & 7;
        if (rt < n128) { const int e = moe_expert_of_row(ps, rt * 128);
            auto epi = [&](int row, int col, float v, float) { Y[(size_t)row * D + nt * 128 + col] = (bf16_t)f2bf(v); };
            gemm_simple_tile<1>(H, RowId{}, Wd + (size_t)e * 262144, 256, rt * 128, nt * 128, 0, epi);
        } else { const int t0 = (rt - n128) * 128;
            auto epi = [&](int row, int col, float v, float) { const int t = row - MAXSLOT, c = nt * 128 + col; X[(size_t)t * D + c] += mod_vec(p, l, t, 5)[c] * v; };
            gemm_simple_tile<1>(H, RowId{}, Wd + (size_t)64 * 262144, 256, MAXSLOT + t0, nt * 128, 0, epi); }
    }
}
__device__ __forceinline__ void ph_combine(KP p, int l, unsigned char* lds) {
    typedef float f32x2 __attribute__((ext_vector_type(2)));
    const int T = (l == 0) ? R_ALL : R_LAT;
    const int tid = tid_(), lane = tid & 63, wid = tid >> 6;
    const unsigned char* Y8 = (const unsigned char*)(p->ws + Z_Y); bf16_t* X = (bf16_t*)(p->ws + WS_X); const int* tok_e = (const int*)(p->ws + WS_TOKE); const int* tok_p = (const int*)(p->ws + WS_TOKP);
    int* ps = (int*)lds; moe_pad_starts(p, l, ps);
    const size_t yoff = (size_t)(lane >> 4) * MAXSLOT * 256 + (lane & 15) * 16;
    for (int row = bid_() * 8 + wid; row < T; row += gsz_() * 8) {
        const float* g5 = mod_vec(p, l, row, 5) + lane * 16;
        bf16_t* xr = X + (size_t)row * D + lane * 16;
        const int myslot = ps[tok_e[row * 8 + (lane & 7)]] + tok_p[row * 8 + (lane & 7)];
        u32x4 yv[8];
#pragma unroll
        for (int k = 0; k < 8; ++k) { const int sl = __shfl(myslot, k); yv[k] = *(const u32x4*)(Y8 + yoff + (size_t)sl * 256); }
        f32x4 xv[4], gv[4];
#pragma unroll
        for (int q = 0; q < 4; ++q) gv[q] = *(const f32x4*)(g5 + 4 * q);
        unpack8(*(const u32x4*)xr, xv[0], xv[1]); unpack8(*(const u32x4*)(xr + 8), xv[2], xv[3]);
        float a[16];
#pragma unroll
        for (int q = 0; q < 16; ++q) a[q] = 0.f;
#pragma unroll
        for (int k = 0; k < 8; ++k) { const unsigned w[4] = {yv[k].x, yv[k].y, yv[k].z, yv[k].w};
#pragma unroll
            for (int q = 0; q < 4; ++q) { const f32x2 lo = __builtin_amdgcn_cvt_pk_f32_fp8((int)w[q], false), hi = __builtin_amdgcn_cvt_pk_f32_fp8((int)w[q], true);
                a[4 * q] += lo.x; a[4 * q + 1] += lo.y; a[4 * q + 2] += hi.x; a[4 * q + 3] += hi.y; } }
#pragma unroll
        for (int q = 0; q < 4; ++q) { f32x4 av; av.x = a[4 * q]; av.y = a[4 * q + 1]; av.z = a[4 * q + 2]; av.w = a[4 * q + 3]; xv[q] = xv[q] + gv[q] * (av * (1.f / Y8_SCALE)); }
        if (l == DEPTH - 1) { float* dst = p->out + (size_t)row * D + lane * 16;
#pragma unroll
            for (int q = 0; q < 4; ++q) *(f32x4*)(dst + 4 * q) = xv[q]; }
        else { *(u32x4*)xr = (u32x4){pk2(xv[0].x, xv[0].y), pk2(xv[0].z, xv[0].w), pk2(xv[1].x, xv[1].y), pk2(xv[1].z, xv[1].w)};
               *(u32x4*)(xr + 8) = (u32x4){pk2(xv[2].x, xv[2].y), pk2(xv[2].z, xv[2].w), pk2(xv[3].x, xv[3].y), pk2(xv[3].z, xv[3].w)}; }
    }
}
struct MoeSched {
    int ntr, nrt, npn, G, c; const LAS int* tile_e;
    __device__ __forceinline__ bool next(int i, pg8::Unit& u) const {
        const int L = i * G + c; if (L >= nrt * npn) return false;
        const int rt = L / npn, pp = L % npn; const bool routed = rt < ntr;
        const int e = routed ? __builtin_amdgcn_readfirstlane(tile_e[rt]) : 64;
        u.pm = routed ? rt : MAXSLOT / 256 + (rt - ntr); u.pn = e * npn + pp; u.ord = i; return true;
    }
};
constexpr int MOE_UNITS = 6;
constexpr int LDS_RTAB = 131072, LDS_WTAB = LDS_RTAB + MOE_UNITS * 1024, LDS_TILE_E = LDS_WTAB + MOE_UNITS * 1024, LDS_PS = LDS_TILE_E + 2400;
static_assert(LDS_PS + 129 * 4 <= LDS_BYTES - 16, "MoE tables fit above the staging buffers");
__device__ __forceinline__ MoeSched moe_setup(KP p, int l, unsigned char* lds, int npn, bool gather) {
    const int T = (l == 0) ? R_ALL : R_LAT;
    int* ps = (int*)(lds + LDS_PS); int* cl = ps + 65;
    const unsigned* cnt = (const unsigned*)(p->ws + WS_CTL) + CW_CNT + l * 64;
    const int tid = tid_();
    if (tid < 64) cl[tid] = (int)cnt[tid];
    moe_pad_starts(p, l, ps);
    LAS int* tile_e = (LAS int*)((LAS unsigned char*)lds + LDS_TILE_E); LAS int* rtab = (LAS int*)((LAS unsigned char*)lds + LDS_RTAB); LAS float* wtab = (LAS float*)((LAS unsigned char*)lds + LDS_WTAB);
    const int ntr = ps[64] / 256;
    for (int rt = tid; rt < ntr; rt += NTHREADS) tile_e[rt] = moe_expert_of_row(ps, rt * 256);
    __syncthreads();
    MoeSched S{ntr, ntr + T / 256, npn, gsz_(), bid_(), tile_e};
    if (gather) { const int* expl = (const int*)(p->ws + WS_EXPL); const float* expw = (const float*)(p->ws + WS_EXPW);
        int tok[3]; float w[3];
#pragma unroll
        for (int q = 0; q < 3; ++q) { const int idx = tid + q * NTHREADS, i = idx >> 8, r = idx & 255; tok[q] = 0; w[q] = 0.f;
            const int L = i * S.G + S.c;
            if (L < S.nrt * npn) { const int rt = L / npn;
                if (rt < S.ntr) { const int e = tile_e[rt], pos = rt * 256 + r - ps[e];
                    if (pos < cl[e]) { tok[q] = expl[(size_t)e * R_ALL + pos]; w[q] = expw[(size_t)e * R_ALL + pos]; } }
                else { tok[q] = (rt - S.ntr) * 256 + r; w[q] = 1.f; } } }
#pragma unroll
        for (int q = 0; q < 3; ++q) { const int idx = tid + q * NTHREADS; rtab[idx] = tok[q]; wtab[idx] = w[q]; } }
    __syncthreads();
    return S;
}
__device__ __forceinline__ void ph_gateup_f(KP p, int l, unsigned char* lds) {
    const MoeSched S = moe_setup(p, l, lds, 2, true);
    pg8::Gemm g{(const bf16_t*)(p->ws + Z_A), (const bf16_t*)(p->ws + wgu_off(l)), 0, 0, 1024};
    pg8::EpiGU8 E{(unsigned char*)(p->ws + Z_H), (const LAS float*)((LAS unsigned char*)lds + LDS_WTAB)};
    pg8::gemm_phase<pg8::EpiGU8, MoeSched, true, true>((LAS unsigned char*)lds, g, S, E, (const LAS int*)((LAS unsigned char*)lds + LDS_RTAB));
}
__device__ __forceinline__ void ph_down_f(KP p, int l, unsigned char* lds) {
    const MoeSched S = moe_setup(p, l, lds, 4, false);
    pg8::Gemm g{(const bf16_t*)(p->ws + Z_H), (const bf16_t*)(p->ws + wd_off(l)), 0, 0, 256};
    bf16_t* X = (bf16_t*)(p->ws + WS_X);
    pg8::EpiDown E{(bf16_t*)(p->ws + Z_Y), X, (const float*)(p->ws + WS_MOD) + (size_t)l * 3 * 6144 + 5 * 1024};
    pg8::gemm_phase<pg8::EpiDown, MoeSched, false, true>((LAS unsigned char*)lds, g, S, E, nullptr);
}

#ifndef FAST_ATTN
#define FAST_ATTN 1
#endif
#ifndef FAST_GEMM
#define FAST_GEMM 15
#endif
constexpr int PH_PER_LAYER = 10, N_PHASES = 1 + DEPTH * PH_PER_LAYER;
__global__ void __launch_bounds__(NTHREADS, 2) mega(Params parg) {
    extern __shared__ __attribute__((aligned(16))) unsigned char lds[];
    const int lo = parg.ph_lo, hi = parg.ph_hi;
    volatile LAS unsigned* xbw = (volatile LAS unsigned*)(lds + LDS_BYTES - 16);
    if (threadIdx.x == 0) { xbw[0] = 0u; xbw[1] = 0u; xbw[2] = 0u; xbw[3] = 0u; }
    if ((threadIdx.x & 63) == 0) *(volatile LAS int*)((LAS unsigned char*)lds + LDS_WVTAB_OFF + 4 * hwkey_()) = (int)(threadIdx.x >> 6);
    __syncthreads();
    XcdBarrier bar; bar.bar = (unsigned*)(parg.ws + WS_CTL) + CW_BAR; bar.x = 0; bar.st = xbw;
    if (hi - lo > 1) bar = xcd_barrier_post((unsigned*)(parg.ws + WS_CTL) + CW_BAR, xbw);
#ifdef PHMASK
#define IN(k) ((((PHMASK) >> ((k) == 0 ? 0 : ((k) - 1) % PH_PER_LAYER + 1)) & 1) && lo <= (k) && (k) < hi)
#else
#define IN(k) (lo <= (k) && (k) < hi)
#endif
#define SEAM(k) do { if (IN(k) && IN((k) + 1)) xcd_barrier(bar); } while (0)
    if (IN(0)) { ph_pro(kparams(), lds); } SEAM(0);
#pragma unroll
    for (int l = 0; l < DEPTH; ++l) {
        const int b0 = 1 + l * PH_PER_LAYER;
        if (IN(b0 + 0)) { ph_norm1(kparams(), l, lds); } SEAM(b0 + 0);
        if (IN(b0 + 1)) { ph_inproj_f(kparams(), l, lds); } SEAM(b0 + 1);
        if (IN(b0 + 2)) { ph_prep(kparams(), l, lds); } SEAM(b0 + 2);
        if (IN(b0 + 3)) { ph_attn_f(kparams(), l, lds); } SEAM(b0 + 3);
        if (IN(b0 + 4)) { ph_hgrn3(kparams(), l, lds); } SEAM(b0 + 4);
        if (IN(b0 + 5)) { ph_outproj_f(kparams(), l, lds); } SEAM(b0 + 5);
        if (IN(b0 + 6)) { ph_norm2(kparams(), l, lds); } SEAM(b0 + 6);
        if (IN(b0 + 7)) { ph_gateup_f(kparams(), l, lds); } SEAM(b0 + 7);
        if (IN(b0 + 8)) { ph_down_f(kparams(), l, lds); } SEAM(b0 + 8);
        if (IN(b0 + 9)) { ph_combine(kparams(), l, lds); } SEAM(b0 + 9);
    }
#undef IN
#undef SEAM
}

#ifndef MK_ONE_LAUNCH
#define MK_ONE_LAUNCH 1
#endif
extern "C" void kernel_launch(void* const* d_in, const int* in_sizes, int n_in, void* d_out, int out_size, void* d_ws, size_t ws_size, hipStream_t stream) {
    static int grid = 0;
    if (grid == 0) {
        if (n_in != 31 || ws_size < WS_END2) { fprintf(stderr, "kernel_launch: unexpected n_in %d or ws_size %zu (< %zu)\n", n_in, ws_size, (size_t)WS_END2); grid = -1; return; }
        int dev = 0, cus = 0, per_cu = 0;
        if (hipGetDevice(&dev) != hipSuccess || hipDeviceGetAttribute(&cus, hipDeviceAttributeMultiprocessorCount, dev) != hipSuccess) { grid = -1; return; }
        if (hipFuncSetAttribute((const void*)mega, hipFuncAttributeMaxDynamicSharedMemorySize, LDS_BYTES) != hipSuccess) { fprintf(stderr, "kernel_launch: hipFuncSetAttribute failed\n"); grid = -1; return; }
        if (hipOccupancyMaxActiveBlocksPerMultiprocessor(&per_cu, (const void*)mega, NTHREADS, LDS_BYTES) != hipSuccess || per_cu < 1) fprintf(stderr, "kernel_launch: occupancy query says %d\n", per_cu);
        (void)hipGetLastError();
        grid = cus;
    }
    if (grid < 0) return;
    (void)hipMemsetAsync((char*)d_ws + WS_CTL, 0, CTL_ZERO_BYTES, stream);
    Params p{};
    for (int i = 0; i < 31; ++i) p.in[i] = (const float*)d_in[i];
    p.out = (float*)d_out; p.ws = (unsigned char*)d_ws;
#if MK_ONE_LAUNCH
    p.ph_lo = 0; p.ph_hi = N_PHASES;
    hipLaunchKernelGGL(mega, dim3(grid), dim3(NTHREADS), LDS_BYTES, stream, p);
#else
    for (int k = 0; k < N_PHASES; ++k) { p.ph_lo = k; p.ph_hi = k + 1; hipLaunchKernelGGL(mega, dim3(grid), dim3(NTHREADS), LDS_BYTES, stream, p); }
#endif
}
```

```cpp
#include <hip/hip_runtime.h>
#include <hip/hip_bf16.h>
#include <cmath>
#include <cstdint>
#include <cstdio>

#define LAS __attribute__((address_space(3)))

typedef unsigned short bf16_t;
typedef short bf16x8 __attribute__((ext_vector_type(8)));
typedef float f32x4 __attribute__((ext_vector_type(4)));
typedef unsigned u32x4 __attribute__((ext_vector_type(4)));
typedef unsigned u32x2 __attribute__((ext_vector_type(2)));

constexpr int D = 1024, NB = 2, NSEQ = 8192, NCTX = 256, DEPTH = 2;
constexpr int R_LAT = NB * NSEQ, R_CTX = NB * NCTX, R_ALL = R_LAT + R_CTX;
constexpr int DIN = 2816;
constexpr int NKEY = NSEQ + NCTX;
constexpr int NE = 64, TOPK = 8;
constexpr int MAXSLOT = 151552;
constexpr int HROWS = MAXSLOT + R_ALL;
constexpr int NCHUNK = 132;
constexpr float EPS = 1e-6f;
constexpr float TOK8_SCALE = 8.f, WGU8_SCALE = 256.f, H8_SCALE = 16.f, WD8_SCALE = 128.f;
constexpr float GU_DESCALE = 1.f / (TOK8_SCALE * WGU8_SCALE), DN_DESCALE = 1.f / (H8_SCALE * WD8_SCALE);
constexpr float Y8_SCALE = 32.f;
constexpr float QSCALE = 0.125f * 1.4426950408889634f;
constexpr float LOG2E = 1.4426950408889634f;

#ifndef FAST_HGRN
#define FAST_HGRN 1
#endif
constexpr int C_GQ = 0, C_GK = 256, C_GV = 384, C_WQ = 512, C_WK = 768, C_WV = 896, C_CVV = 1024, C_CVG = 1280, C_RQ = 1536, C_RI = 1792, C_RFF = 2048, C_RFB = 2304, C_RG = 2560;

constexpr size_t MiB = (size_t)1 << 20;
constexpr size_t WS_CTL = 0, CTL_ZERO_BYTES = 64 * 1024;
constexpr size_t WS_MOD = 1 * MiB;
constexpr size_t WS_LB = WS_MOD + 256 * 1024;
constexpr size_t WS_ROPE = WS_MOD + 512 * 1024;
constexpr size_t WS_TOKE = 2 * MiB, WS_TOKP = 3 * MiB, WS_TOKW = 4 * MiB, WS_TOKS = 5 * MiB;
constexpr size_t WS_SLOTT = 6 * MiB, WS_SLOTW = 7 * MiB;
constexpr size_t WS_X = 8 * MiB;
constexpr size_t WS_WD = 74 * MiB;
constexpr size_t WS_Z = 107 * MiB;
constexpr size_t Z_A = WS_Z + 0 * MiB;
constexpr size_t Z_WGU = WS_Z + 33 * MiB;
constexpr size_t Z_WIN = WS_Z + 98 * MiB;
constexpr size_t Z_WOUT = WS_Z + 104 * MiB;
constexpr size_t Z_WPW = WS_Z + 106 * MiB;
__host__ __device__ constexpr size_t wgu_off(int l) { return WS_Z + 33 * MiB + (size_t)l * 34078720; }
__host__ __device__ constexpr size_t wd_off(int l) { return 74 * MiB + (size_t)l * 17039360; }
__host__ __device__ constexpr size_t win_off(int l) { return l == 0 ? WS_Z + 98 * MiB : WS_Z + (302 + 42) * MiB; }
__host__ __device__ constexpr size_t wout_off(int l) { return l == 0 ? WS_Z + 104 * MiB : WS_Z + (302 + 48) * MiB; }
__host__ __device__ constexpr size_t wpw_off(int l) { return l == 0 ? WS_Z + 106 * MiB : WS_Z + (302 + 51) * MiB; }
constexpr size_t Z_P = WS_Z + 107 * MiB;
constexpr size_t Z_YCAT = WS_Z + 198 * MiB;
constexpr size_t Z_QG = WS_Z + 231 * MiB, Z_QW = WS_Z + 239 * MiB;
constexpr size_t Z_KG = WS_Z + 247 * MiB, Z_VG = WS_Z + 252 * MiB, Z_KW = WS_Z + 257 * MiB, Z_VW = WS_Z + 262 * MiB;
constexpr size_t Z_QGC = WS_Z + 267 * MiB, Z_QWC = Z_QGC + 512 * 1024;
constexpr size_t Z_U = WS_Z + 268 * MiB;
constexpr size_t Z_G = WS_Z + 301 * MiB;
constexpr size_t Z_Y = WS_Z + 107 * MiB;
constexpr size_t Z_H = WS_Z + 302 * MiB;
constexpr size_t WS_END = WS_Z + 385 * MiB;
constexpr size_t WS_EXPL = WS_END, WS_EXPW = WS_END + 5 * MiB, WS_END2 = WS_END + 10 * MiB;
static_assert(Z_H + (size_t)HROWS * 512 <= WS_END, "H fits");
static_assert(Z_Y + (size_t)MAXSLOT * 1024 <= Z_U, "Y8 below the HGRN state buffers");
static_assert(Z_P + (size_t)R_ALL * DIN * 2 <= Z_YCAT, "P fits");

constexpr int CW_BAR = 0;
constexpr int CW_CNT = 4096;

constexpr int LDS_BYTES = 147456;
constexpr int NTHREADS = 512;

struct Params {
    const float* in[31];
    float* out;
    unsigned char* ws;
    int ph_lo, ph_hi;
};

typedef const __attribute__((address_space(4))) Params* KP;
__device__ __forceinline__ KP kparams() { KP k = (KP)__builtin_amdgcn_kernarg_segment_ptr(); asm volatile("" : "+s"(k)); return k; }

constexpr int LDS_WVTAB_OFF = 147456 - 16 - 256;
__device__ __forceinline__ int hwkey_() { return (int)__builtin_amdgcn_s_getreg((5 << 11) | 4) & 63; }
__device__ __forceinline__ int tid_() { extern __shared__ __attribute__((aligned(16))) unsigned char lds_all[];
    const int w = __builtin_amdgcn_readfirstlane(*(const LAS int*)((LAS unsigned char*)lds_all + LDS_WVTAB_OFF + 4 * hwkey_()));
    unsigned z; asm volatile("v_mov_b32 %0, 0" : "=v"(z));
    int t = (w << 6) | (int)__builtin_amdgcn_mbcnt_hi(~0u, __builtin_amdgcn_mbcnt_lo(~0u, z)); asm volatile("" : "+v"(t)); return t; }
__device__ __forceinline__ int bid_() { int b = blockIdx.x; asm volatile("" : "+s"(b)); return b; }
__device__ __forceinline__ int gsz_() { int g = gridDim.x; asm volatile("" : "+s"(g)); return g; }

__device__ __forceinline__ unsigned f2bf(float f) { unsigned u = __float_as_uint(f); return (u + 0x7fffu + ((u >> 16) & 1u)) >> 16; }
__device__ __forceinline__ float bf2f(unsigned h) { return __uint_as_float(h << 16); }
__device__ __forceinline__ unsigned pk2(float lo, float hi) { unsigned r; asm("v_cvt_pk_bf16_f32 %0, %1, %2" : "=v"(r) : "v"(lo), "v"(hi)); return r; }
__device__ __forceinline__ void unpack8(const u32x4 r, f32x4& lo, f32x4& hi) { lo.x = bf2f(r.x & 0xffffu); lo.y = bf2f(r.x >> 16); lo.z = bf2f(r.y & 0xffffu); lo.w = bf2f(r.y >> 16); hi.x = bf2f(r.z & 0xffffu); hi.y = bf2f(r.z >> 16); hi.z = bf2f(r.w & 0xffffu); hi.w = bf2f(r.w >> 16); }
__device__ __forceinline__ float wave_sum(float v) {
#pragma unroll
    for (int o = 1; o < 64; o <<= 1) v += __shfl_xor(v, o);
    return v;
}
__device__ __forceinline__ float clamp8(float v) { return fminf(fmaxf(v, -440.f), 440.f); }
__device__ __forceinline__ float sigmoid_(float x) { return __builtin_amdgcn_rcpf(1.f + __expf(-x)); }
__device__ __forceinline__ float silu_(float x) { return x * sigmoid_(x); }

__device__ __forceinline__ const float* xrow_src(KP p, int l, int row) {
    if (l == 0) return (row < R_LAT) ? p->in[0] + (size_t)row * D : p->in[2] + (size_t)(row - R_LAT) * D;
    return (const float*)(p->ws + WS_X) + (size_t)row * D;
}
__device__ __forceinline__ const float* mod_vec(KP p, int l, int row, int i) {
    const int r = (row < R_LAT) ? (row >> 13) : 2;
    return (const float*)(p->ws + WS_MOD) + ((size_t)l * 3 + r) * 6144 + i * 1024;
}

#define XB_TMO      128
#define XB_XCNT(j)  (256  + 64 * (j))
#define XB_XSUB(j)  (1280 + 64 * (j))
#define XB_XGEN(j)  (2304 + 64 * (j))
#define XB_TOP      3328
#define XB_TOPGEN   3392
#define XCD_BAR_WORDS 3456
#define XB_SPIN_CAP (1u << 18)
__device__ __forceinline__ unsigned xb_ld(unsigned* p)              { return __hip_atomic_load(p, __ATOMIC_RELAXED, __HIP_MEMORY_SCOPE_AGENT); }
__device__ __forceinline__ unsigned xb_add(unsigned* p, unsigned v) { return __hip_atomic_fetch_add(p, v, __ATOMIC_RELAXED, __HIP_MEMORY_SCOPE_AGENT); }
__device__ __forceinline__ unsigned xb_xcc_id() { return (unsigned)__builtin_amdgcn_s_getreg((3 << 11) | 20) & 0xFu; }
#define XB_SPIN(cond, bar) do { unsigned _sp = 0; while (cond) { __builtin_amdgcn_s_sleep(1); \
    if ((++_sp & 255u) == 0u) { if (xb_ld(&(bar)[XB_TMO])) break; if (_sp > XB_SPIN_CAP) { atomicAdd(&(bar)[XB_TMO], 1u); break; } } } } while (0)
struct XcdBarrier { unsigned* bar; unsigned x; volatile LAS unsigned* st; };
__device__ __forceinline__ XcdBarrier xcd_barrier_post(unsigned* bar, volatile LAS unsigned* st) {
    XcdBarrier b; b.bar = bar; b.x = xb_xcc_id(); b.st = st;
    if (tid_() == 0) (void)xb_add(&bar[XB_XCNT(b.x)], 1u);
    return b;
}
__device__ __forceinline__ void xcd_barrier_complete(unsigned* bar, unsigned x, unsigned& nloc, unsigned& nx) {
    const unsigned G = gridDim.x * gridDim.y * gridDim.z;
    unsigned sum, cnt, mine, sp = 0u;
    for (;;) {
        sum = 0u; cnt = 0u; mine = 0u;
#pragma unroll
        for (unsigned j = 0; j < 16; ++j) { const unsigned c = xb_ld(&bar[XB_XCNT(j)]); sum += c; cnt += (c > 0u) ? 1u : 0u; mine = (j == x) ? c : mine; }
        if (sum == G) break;
        __builtin_amdgcn_s_sleep(1);
        if ((++sp & 255u) == 0u) { if (xb_ld(&bar[XB_TMO])) break; if (sp > XB_SPIN_CAP) { atomicAdd(&bar[XB_TMO], 1u); break; } }
    }
    nloc = mine > 0u ? mine : 1u; nx = cnt > 0u ? cnt : 1u;
}
__device__ __forceinline__ void xcd_barrier(const XcdBarrier& b) {
    asm volatile("s_waitcnt vmcnt(0)" ::: "memory");
    __syncthreads();
    if (tid_() == 0) {
        unsigned* bar = b.bar;
        __builtin_amdgcn_s_waitcnt(0);
        unsigned nloc = b.st[0], nx = b.st[1];
        if (nloc == 0u) { xcd_barrier_complete(bar, b.x, nloc, nx); b.st[0] = nloc; b.st[1] = nx; }
        const unsigned old = xb_add(&bar[XB_XSUB(b.x)], 1u);
        const unsigned gen = old / nloc;
        if (old + 1u == (gen + 1u) * nloc) {
            __builtin_amdgcn_fence(__ATOMIC_RELEASE, "agent");
            asm volatile("s_waitcnt vmcnt(0)" ::: "memory");
            const unsigned og = xb_add(&bar[XB_TOP], 1u);
            const unsigned tg = og / nx;
            if (og + 1u == (tg + 1u) * nx) xb_add(&bar[XB_TOPGEN], 1u);
            else XB_SPIN(xb_ld(&bar[XB_TOPGEN]) == tg, bar);
            __builtin_amdgcn_fence(__ATOMIC_ACQUIRE, "agent");
            xb_add(&bar[XB_XGEN(b.x)], 1u);
            asm volatile("s_waitcnt vmcnt(0)" ::: "memory");
        } else {
            XB_SPIN(xb_ld(&bar[XB_XGEN(b.x)]) == gen, bar);
            __builtin_amdgcn_fence(__ATOMIC_ACQUIRE, "agent");
            asm volatile("s_waitcnt vmcnt(0)" ::: "memory");
        }
    }
    __syncthreads();
}

__device__ __forceinline__ void ph_pro(KP p, unsigned char* lds) {
    float* sc = (float*)lds;
    float* red = sc + 3 * 1024;
    const int tid = tid_(), lane = tid & 63, wid = tid >> 6;
    for (int i = tid; i < 3 * 1024; i += NTHREADS) { const int r = i >> 10, k = i & 1023; const float v = (r < 2) ? p->in[1][r * 1024 + k] : p->in[3][k]; sc[i] = silu_(v); }
    __syncthreads();
    float* mod = (float*)(p->ws + WS_MOD);
    for (int item = bid_(); item < DEPTH * 96; item += gsz_()) {
        const int l = item / 96, j0 = (item % 96) * 64;
        const float* w = p->in[4] + (size_t)l * 1024 * 6144;
        float a0 = 0.f, a1 = 0.f, a2 = 0.f;
        const int k0 = wid * 128;
#pragma unroll 1
        for (int k = k0; k < k0 + 128; k += 16) { float wv[16];
#pragma unroll
            for (int u = 0; u < 16; ++u) wv[u] = w[(size_t)(k + u) * 6144 + j0 + lane];
#pragma unroll
            for (int u = 0; u < 16; ++u) { a0 += sc[k + u] * wv[u]; a1 += sc[1024 + k + u] * wv[u]; a2 += sc[2048 + k + u] * wv[u]; } }
        red[(wid * 3 + 0) * 64 + lane] = a0; red[(wid * 3 + 1) * 64 + lane] = a1; red[(wid * 3 + 2) * 64 + lane] = a2;
        __syncthreads();
        if (tid < 192) { const int r = tid >> 6; float s = 0.f;
            for (int w8 = 0; w8 < 8; ++w8) s += red[(w8 * 3 + r) * 64 + lane];
            mod[((size_t)l * 3 + r) * 6144 + j0 + lane] = s + p->in[5][l * 6144 + j0 + lane]; }
        __syncthreads();
    }
    if (bid_() == 0) {
        float* rt = (float*)(p->ws + WS_ROPE);
        for (int i = tid; i < 128 * 16; i += NTHREADS) { const int pos = i >> 4, f = i & 15; const float inv = powf(10000.f, -(float)f * (1.f / 16.f)); float sn, cs; sincosf((float)pos * inv, &sn, &cs);
            rt[pos * 32 + f] = cs; rt[pos * 32 + 16 + f] = sn; }
    }
    if (bid_() == gsz_() - 1) {
        float* lb = (float*)(p->ws + WS_LB);
        for (int i = tid; i < 2 * 2 * 256; i += NTHREADS) { const int l = i >> 9, dir = (i >> 8) & 1, ch = i & 255;
            const float* lg = p->in[21];
            const float l0 = lg[(dir * 2 + 0) * 256 + ch], l1 = lg[(dir * 2 + 1) * 256 + ch]; const float m = fmaxf(l0, l1);
            const float e0 = expf(l0 - m), e1 = expf(l1 - m);
            lb[i] = (l == 0) ? 0.f : e1 / (e0 + e1); }
    }
}

constexpr int CVT_E1 = 1050, CVT_E2 = 2850;
struct CvtTile { const float* src; bf16_t* dst; int K, N, k0, n0, blk, bstride, boff; float f8scale; };
__device__ __forceinline__ int cvt_total() { return 16 * 44 + 16 * 16 + 4 * 4 + 2 * (64 * 64) + 2 * 64 + 64 * 64 + 64; }
__device__ __forceinline__ CvtTile cvt_decode(KP p, int l, int g) {
    bf16_t* Wgu = (bf16_t*)(p->ws + wgu_off(l)); bf16_t* Wd = (bf16_t*)(p->ws + wd_off(l));
    CvtTile t; int per, tn, r;
    if (g < 704) { r = g; t = {p->in[8] + (size_t)l * 1024 * DIN, (bf16_t*)(p->ws + win_off(l)), 1024, DIN, 0, 0, DIN, 0, 0, 0.f}; tn = 44; per = 704; }
    else if ((g -= 704) < 256) { r = g; t = {p->in[9] + (size_t)l * 1024 * 1024, (bf16_t*)(p->ws + wout_off(l)), 1024, 1024, 0, 0, 1024, 0, 0, 0.f}; tn = 16; per = 256; }
    else if ((g -= 256) < 16) { r = g; t = {p->in[19] + (size_t)l * 65536, (bf16_t*)(p->ws + wpw_off(l)), 256, 256, 0, 0, 256, 0, 0, 0.f}; tn = 4; per = 16; }
    else if ((g -= 16) < 4096) { const int m = g >> 6; r = g & 63; t = {p->in[25] + ((size_t)l * 64 + m) * 262144, (bf16_t*)((unsigned char*)Wgu + (size_t)m * 524288), 1024, 256, 0, 0, 128, 256, 0, WGU8_SCALE}; tn = 4; per = 64; }
    else if ((g -= 4096) < 4096) { const int m = g >> 6; r = g & 63; t = {p->in[26] + ((size_t)l * 64 + m) * 262144, (bf16_t*)((unsigned char*)Wgu + (size_t)m * 524288), 1024, 256, 0, 0, 128, 256, 128, WGU8_SCALE}; tn = 4; per = 64; }
    else if ((g -= 4096) < 64) { r = g; t = {p->in[28] + (size_t)l * 262144, (bf16_t*)((unsigned char*)Wgu + (size_t)64 * 524288), 1024, 256, 0, 0, 128, 256, 0, WGU8_SCALE}; tn = 4; per = 64; }
    else if ((g -= 64) < 64) { r = g; t = {p->in[29] + (size_t)l * 262144, (bf16_t*)((unsigned char*)Wgu + (size_t)64 * 524288), 1024, 256, 0, 0, 128, 256, 128, WGU8_SCALE}; tn = 4; per = 64; }
    else if ((g -= 64) < 4096) { const int m = g >> 6; r = g & 63; t = {p->in[27] + ((size_t)l * 64 + m) * 262144, (bf16_t*)((unsigned char*)Wd + (size_t)m * 262144), 256, 1024, 0, 0, 1024, 0, 0, WD8_SCALE}; tn = 16; per = 64; }
    else { g -= 4096; r = g; t = {p->in[30] + (size_t)l * 262144, (bf16_t*)((unsigned char*)Wd + (size_t)64 * 262144), 256, 1024, 0, 0, 1024, 0, 0, WD8_SCALE}; tn = 16; per = 64; }
    (void)per; t.k0 = (r / tn) * 64; t.n0 = (r % tn) * 64; return t;
}
__device__ __forceinline__ void ph_cvt(KP p, int l, unsigned char* lds, int first = 0, int nwg = 0, int t0 = 0, int t1 = 1 << 30) {
    float* tb = (float*)lds;
    const int tid = tid_(), G = nwg ? nwg : gsz_(), total = t1 < cvt_total() ? t1 : cvt_total();
    const int r0 = tid >> 4, c0 = (tid & 15) * 4, nn = tid >> 3, kc = (tid & 7) * 8;
    int g = bid_() - first, buf = 0;
    if (g < 0) return;
    g += t0;
    if (g >= total) return;
    CvtTile T = cvt_decode(p, l, g);
    f32x4 v0 = *(const f32x4*)(T.src + (size_t)(T.k0 + r0) * T.N + T.n0 + c0), v1 = *(const f32x4*)(T.src + (size_t)(T.k0 + r0 + 32) * T.N + T.n0 + c0);
    for (;;) {
        float* t = tb + buf * (64 * 65);
        t[r0 * 65 + c0] = v0.x; t[r0 * 65 + c0 + 1] = v0.y; t[r0 * 65 + c0 + 2] = v0.z; t[r0 * 65 + c0 + 3] = v0.w;
        t[(r0 + 32) * 65 + c0] = v1.x; t[(r0 + 32) * 65 + c0 + 1] = v1.y; t[(r0 + 32) * 65 + c0 + 2] = v1.z; t[(r0 + 32) * 65 + c0 + 3] = v1.w;
        const CvtTile C = T; const int gn = g + G; const bool more = gn < total;
        if (more) { T = cvt_decode(p, l, gn);
            v0 = *(const f32x4*)(T.src + (size_t)(T.k0 + r0) * T.N + T.n0 + c0); v1 = *(const f32x4*)(T.src + (size_t)(T.k0 + r0 + 32) * T.N + T.n0 + c0); }
        __syncthreads();
        { const int n = C.n0 + nn; const int drow = (n / C.blk) * C.bstride + C.boff + (n % C.blk);
          if (C.f8scale != 0.f) { const float sc = C.f8scale;
              int w0 = __builtin_amdgcn_cvt_pk_fp8_f32(clamp8(t[(kc + 0) * 65 + nn] * sc), clamp8(t[(kc + 1) * 65 + nn] * sc), 0, false); w0 = __builtin_amdgcn_cvt_pk_fp8_f32(clamp8(t[(kc + 2) * 65 + nn] * sc), clamp8(t[(kc + 3) * 65 + nn] * sc), w0, true);
              int w1 = __builtin_amdgcn_cvt_pk_fp8_f32(clamp8(t[(kc + 4) * 65 + nn] * sc), clamp8(t[(kc + 5) * 65 + nn] * sc), 0, false); w1 = __builtin_amdgcn_cvt_pk_fp8_f32(clamp8(t[(kc + 6) * 65 + nn] * sc), clamp8(t[(kc + 7) * 65 + nn] * sc), w1, true);
              u32x2 o8; o8.x = (unsigned)w0; o8.y = (unsigned)w1;
              *(u32x2*)((unsigned char*)C.dst + (size_t)drow * C.K + C.k0 + kc) = o8;
          } else {
          u32x4 o; o.x = pk2(t[(kc + 0) * 65 + nn], t[(kc + 1) * 65 + nn]); o.y = pk2(t[(kc + 2) * 65 + nn], t[(kc + 3) * 65 + nn]);
          o.z = pk2(t[(kc + 4) * 65 + nn], t[(kc + 5) * 65 + nn]); o.w = pk2(t[(kc + 6) * 65 + nn], t[(kc + 7) * 65 + nn]);
          *(u32x4*)(C.dst + (size_t)drow * C.K + C.k0 + kc) = o; } }
        if (!more) break;
        g = gn; buf ^= 1;
    }
    __syncthreads();
}
__device__ __forceinline__ void norm_mod_row(const float* xrow, const float* g, const float* shift, const float* scale, bf16_t* orow, float* fout, int lane) {
    f32x4 v[4]; float s = 0.f;
#pragma unroll
    for (int j = 0; j < 4; ++j) { v[j] = ((const f32x4*)xrow)[lane + 64 * j]; s += v[j].x * v[j].x + v[j].y * v[j].y + v[j].z * v[j].z + v[j].w * v[j].w; }
    const float rinv = rsqrtf(wave_sum(s) * (1.f / D) + EPS);
#pragma unroll
    for (int j = 0; j < 4; ++j) { const int idx = lane + 64 * j;
        const f32x4 gg = ((const f32x4*)g)[idx], sh = ((const f32x4*)shift)[idx], sc = ((const f32x4*)scale)[idx];
        f32x4 y; y.x = v[j].x * rinv * gg.x * (1.f + sc.x) + sh.x; y.y = v[j].y * rinv * gg.y * (1.f + sc.y) + sh.y;
        y.z = v[j].z * rinv * gg.z * (1.f + sc.z) + sh.z; y.w = v[j].w * rinv * gg.w * (1.f + sc.w) + sh.w;
        u32x2 o; o.x = pk2(y.x, y.y); o.y = pk2(y.z, y.w);
        ((u32x2*)orow)[idx] = o;
        if (fout) ((f32x4*)fout)[idx] = y; }
}
__device__ __forceinline__ void ph_norm1(KP p, int l, unsigned char* lds) {
    if (l == 0) ph_cvt(p, l, lds);
    const int tid = tid_(), lane = tid & 63, wid = tid >> 6;
    bf16_t* A = (bf16_t*)(p->ws + Z_A);
    const float* g = p->in[6] + l * D;
    if (l == 0) { for (int row = bid_() * 8 + wid; row < R_ALL; row += gsz_() * 8)
        norm_mod_row(xrow_src(p, l, row), g, mod_vec(p, l, row, 0), mod_vec(p, l, row, 1), A + (size_t)row * D, nullptr, lane); }
    else { const bf16_t* X = (const bf16_t*)(p->ws + WS_X);
        for (int row = bid_() * 8 + wid; row < R_ALL; row += gsz_() * 8) {
            const float* shift = mod_vec(p, l, row, 0); const float* scale = mod_vec(p, l, row, 1);
            f32x4 v[4]; unpack8(*(const u32x4*)(X + (size_t)row * D + lane * 8), v[0], v[1]); unpack8(*(const u32x4*)(X + (size_t)row * D + 512 + lane * 8), v[2], v[3]);
            float ss = 0.f;
#pragma unroll
            for (int j = 0; j < 4; ++j) ss += v[j].x * v[j].x + v[j].y * v[j].y + v[j].z * v[j].z + v[j].w * v[j].w;
            const float rinv = rsqrtf(wave_sum(ss) * (1.f / D) + EPS);
#pragma unroll
            for (int h = 0; h < 2; ++h) { const int c0 = h * 512 + lane * 8; unsigned o[4];
#pragma unroll
                for (int q = 0; q < 2; ++q) { const f32x4 gg = *(const f32x4*)(g + c0 + 4 * q), sh = *(const f32x4*)(shift + c0 + 4 * q), sc = *(const f32x4*)(scale + c0 + 4 * q);
                    const f32x4 y = v[2 * h + q] * rinv * gg * (sc + 1.f) + sh; o[2 * q] = pk2(y.x, y.y); o[2 * q + 1] = pk2(y.z, y.w); }
                *(u32x4*)(A + (size_t)row * D + c0) = (u32x4){o[0], o[1], o[2], o[3]}; } } }
}

template <int NBJ, class ARow, class Epi>
__device__ __forceinline__ void gemm_simple_tile(const bf16_t* A, const ARow& arow, const bf16_t* Bt, int K, int row0, int colb0, int bjstride, const Epi& epi) {
    const int tid = tid_(), lane = tid & 63, wid = tid >> 6, wr = wid >> 1, wc = wid & 1, fr = lane & 15, fq = lane >> 4;
    f32x4 acc[2][NBJ][4];
#pragma unroll
    for (int i = 0; i < 2; ++i)
#pragma unroll
        for (int b = 0; b < NBJ; ++b)
#pragma unroll
            for (int j = 0; j < 4; ++j) acc[i][b][j] = (f32x4){0.f, 0.f, 0.f, 0.f};
    const bf16_t* ap[2];
#pragma unroll
    for (int i = 0; i < 2; ++i) ap[i] = A + (size_t)arow(row0 + wr * 32 + i * 16 + fr) * K + fq * 8;
    const bf16_t* bp = Bt + (size_t)(colb0 + wc * 64 + fr) * K + fq * 8;
    for (int k = 0; k < K; k += 32) {
        bf16x8 a[2];
#pragma unroll
        for (int i = 0; i < 2; ++i) a[i] = *(const bf16x8*)(ap[i] + k);
#pragma unroll
        for (int b = 0; b < NBJ; ++b)
#pragma unroll
            for (int j = 0; j < 4; ++j) { const bf16x8 bv = *(const bf16x8*)(bp + (size_t)(b * bjstride + j * 16) * K + k);
#pragma unroll
                for (int i = 0; i < 2; ++i) acc[i][b][j] = __builtin_amdgcn_mfma_f32_16x16x32_bf16(a[i], bv, acc[i][b][j], 0, 0, 0); }
    }
#pragma unroll
    for (int i = 0; i < 2; ++i)
#pragma unroll
        for (int j = 0; j < 4; ++j)
#pragma unroll
            for (int r = 0; r < 4; ++r) { const int row = row0 + wr * 32 + i * 16 + fq * 4 + r, col = wc * 64 + j * 16 + fr;
                epi(row, col, acc[i][0][j][r], acc[i][NBJ - 1][j][r]); }
}
struct RowId { __device__ __forceinline__ int operator()(int r) const { return r; } };
struct RowGather { const int* idx; __device__ __forceinline__ int operator()(int r) const { return idx[r]; } };

__device__ __forceinline__ void ph_inproj(KP p, int l, unsigned char* lds) {
    const bf16_t* A = (const bf16_t*)(p->ws + Z_A); const bf16_t* Bt = (const bf16_t*)(p->ws + Z_WIN); bf16_t* P = (bf16_t*)(p->ws + Z_P);
    constexpr int TM = R_ALL / 128, TN = DIN / 128;
    for (int it = bid_(); it < TM * TN; it += gsz_()) { const int mt = it / TN, nt = it % TN;
        auto epi = [&](int row, int col, float v, float) { P[(size_t)row * DIN + nt * 128 + col] = (bf16_t)f2bf(v); };
        gemm_simple_tile<1>(A, RowId{}, Bt, 1024, mt * 128, nt * 128, 0, epi); }
}

namespace pg8 {
constexpr int BM = 256, BK = 64, HALF = 128, HTB = HALF * BK * 2, STAGE_BYTES = 8 * HTB, NXCD = 8, WGM = 8;
__host__ __device__ __forceinline__ int lds_byte(int r, int c) { const int st = (r >> 4) * 2 + (c >> 5), rr = r & 15, cc = c & 31, ob = rr * 64 + cc * 2; return st * 1024 + (ob ^ (((ob >> 9) & 1) << 5)); }
__host__ __device__ __forceinline__ void stage_rc(int b, int& R, int& C) { const int st = b / 1024, sb = b % 1024, swz = sb ^ (((sb >> 9) & 1) << 5); R = (st >> 1) * 16 + swz / 64; C = (st & 1) * 32 + (swz % 64) / 2; }
__host__ __device__ __forceinline__ int perm32(int rho) { const int n = rho >> 4, i = rho & 15; return 8 * (i >> 2) + 4 * n + (i & 3); }
struct Unit { int pm, pn, ord; };
struct Gemm { const bf16_t* A; const bf16_t* Bt; int M, N, K; };
struct StaticOrder {
    int nM, nN, nwg, G, c;
    __host__ __device__ void init(int M, int N, int G_, int c_) { nM = M / BM; nN = N / BM; nwg = nM * nN; G = G_; c = c_; }
    __host__ __device__ bool next(int i, Unit& u) const {
        const long L = (long)i * G + c; if (L >= nwg) return false;
        int wgid = (int)L; { const int q = nwg / NXCD, r = nwg % NXCD, xcd = wgid % NXCD, off = wgid / NXCD; wgid = (xcd < r ? xcd * (q + 1) : r * (q + 1) + (xcd - r) * q) + off; }
        const int nig = WGM * nN, gid = wgid / nig, fm = gid * WGM, gsz = (nM - fm) < WGM ? (nM - fm) : WGM;
        u.pm = fm + ((wgid % nig) % gsz); u.pn = (wgid % nig) / gsz; u.ord = i; return true;
    }
};
__device__ __forceinline__ unsigned cvt_pk_bf16(float lo, float hi) { unsigned r; asm volatile("v_cvt_pk_bf16_f32 %0, %1, %2" : "=v"(r) : "v"(lo), "v"(hi)); return r; }

typedef int i32x4v __attribute__((ext_vector_type(4)));
typedef int i32x8v __attribute__((ext_vector_type(8)));
__device__ __forceinline__ i32x8v cat8(bf16x8 lo, bf16x8 hi) { const i32x4v a = __builtin_bit_cast(i32x4v, lo), b = __builtin_bit_cast(i32x4v, hi); return __builtin_shufflevector(a, b, 0, 1, 2, 3, 4, 5, 6, 7); }
__device__ __forceinline__ void glds16_s(const void* sbase, unsigned voff, unsigned lds_dst) { unsigned keep;
    asm volatile("s_mov_b32 %0, m0\n\ts_mov_b32 m0, %3\n\ts_nop 0\n\tglobal_load_lds_dwordx4 %1, %2\n\ts_mov_b32 m0, %0" : "=&s"(keep) : "v"(voff), "s"(sbase), "s"(lds_dst) : "memory"); }
template <class Epi, class Sched, bool GATHER, bool FP8 = false>
__device__ __forceinline__ void gemm_phase(LAS unsigned char* lds, const Gemm g, const Sched& S, const Epi& E, const LAS int* rtab) {
    const int tid = tid_(), wid = __builtin_amdgcn_readfirstlane(tid >> 6), lane = tid & 63, wr = wid >> 2, wc = wid & 3, fr = lane & 15, fq = lane >> 4;
    const int KB = FP8 ? g.K : g.K * 2, nt = KB / 128;
    unsigned voffA[2], voffB[2]; int RA[2], CA[2];
#pragma unroll
    for (int i = 0; i < 2; ++i) { int R, C; stage_rc(tid * 16 + i * 8192, R, C); const int Rb = (R & ~31) + perm32(R & 31);
        voffA[i] = (unsigned)(R * KB + C * 2); voffB[i] = (unsigned)(Rb * KB + C * 2); RA[i] = R; CA[i] = C; }
    unsigned rcpk = 0; if constexpr (GATHER) { rcpk = (unsigned)(RA[0] * 4) | ((unsigned)(CA[0] * 2) << 16); asm volatile("" : "+v"(rcpk)); }
    const size_t kstep = (size_t)128;
    const size_t hstep = (size_t)HALF * KB;
    const size_t hstepA = GATHER ? 0 : hstep;
    const size_t tstep = 2 * hstep;
    const unsigned ldsw = (unsigned)wid * 1024u;
    const unsigned ldsb = (unsigned)__builtin_amdgcn_readfirstlane((int)((unsigned)(size_t)lds + ldsw));
    const int aoff = lds_byte(wr * 64 + fr, fq * 8), boff = lds_byte(wc * 32 + fr, fq * 8);
#define PG8_SA(b, h) (((b) * 2 + (h)) * HTB)
#define PG8_SB(b, h) ((4 + (b) * 2 + (h)) * HTB)
#define PG8_STAGE(bufoff, gbase, voff) do { _Pragma("unroll") for (int _i = 0; _i < 2; ++_i) { if constexpr (FP8) glds16_s((const void*)(gbase), (voff)[_i], ldsb + (unsigned)((bufoff) + _i * 8192)); \
        else __builtin_amdgcn_global_load_lds((const unsigned*)((const char*)(gbase) + (voff)[_i]), (LAS unsigned*)(lds + (bufoff) + ldsw + _i * 8192), 16, 0, 0); } } while (0)
#define PG8_STAGE1(bufoff, gbase, v0) do {   \
        glds16_s((const void*)(gbase), (v0), ldsb + (unsigned)(bufoff)); glds16_s((const void*)((const char*)(gbase) + (size_t)64 * KB), (v0), ldsb + (unsigned)((bufoff) + 8192)); } while (0)
#define PG8_LDA(dst, b, h) do { _Pragma("unroll") for (int m = 0; m < 4; ++m) { if constexpr (FP8) dst##8[m] = cat8(*(const LAS bf16x8*)(lds + PG8_SA(b, h) + aoff + m * 2048), *(const LAS bf16x8*)(lds + PG8_SA(b, h) + aoff + m * 2048 + 1024)); \
        else { _Pragma("unroll") for (int k = 0; k < 2; ++k) dst[m][k] = *(const LAS bf16x8*)(lds + PG8_SA(b, h) + aoff + m * 2048 + k * 1024); } } } while (0)
#define PG8_LDB(dst, b, h) do { _Pragma("unroll") for (int n = 0; n < 2; ++n) { if constexpr (FP8) dst##8[n] = cat8(*(const LAS bf16x8*)(lds + PG8_SB(b, h) + boff + n * 2048), *(const LAS bf16x8*)(lds + PG8_SB(b, h) + boff + n * 2048 + 1024)); \
        else { _Pragma("unroll") for (int k = 0; k < 2; ++k) dst[n][k] = *(const LAS bf16x8*)(lds + PG8_SB(b, h) + boff + n * 2048 + k * 1024); } } } while (0)
#define PG8_MMA(ai, bj, At, Bt) do { __builtin_amdgcn_s_setprio(1); _Pragma("unroll") for (int m = 0; m < 4; ++m) _Pragma("unroll") for (int n = 0; n < 2; ++n) { \
        if constexpr (FP8) acc[ai][bj][m][n] = __builtin_amdgcn_mfma_scale_f32_16x16x128_f8f6f4(Bt##8[n], At##8[m], acc[ai][bj][m][n], 0, 0, 0, 0x7F7F7F7F, 0, 0x7F7F7F7F); \
        else { _Pragma("unroll") for (int k = 0; k < 2; ++k) acc[ai][bj][m][n] = __builtin_amdgcn_mfma_f32_16x16x32_bf16(Bt[n][k], At[m][k], acc[ai][bj][m][n], 0, 0, 0); } } \
        if constexpr (FP8) { asm volatile("" : "+v"(acc[ai][bj][0][0]), "+v"(acc[ai][bj][0][1]), "+v"(acc[ai][bj][1][0]), "+v"(acc[ai][bj][1][1]), "+v"(acc[ai][bj][2][0]), "+v"(acc[ai][bj][2][1]), "+v"(acc[ai][bj][3][0]), "+v"(acc[ai][bj][3][1])); } \
        __builtin_amdgcn_s_setprio(0); } while (0)
#define PG8_WAIT_V(n) asm volatile("s_waitcnt vmcnt(" #n ")" ::: "memory")
#define PG8_WAIT_L(n) asm volatile("s_waitcnt lgkmcnt(" #n ")" ::: "memory")
#define PG8_BAR __builtin_amdgcn_s_barrier()
#define PG8_SCHED __builtin_amdgcn_sched_barrier(0)
#define PG8_STAGE_A(bufoff, gbase, ord, h) do { unsigned _o[2]; if constexpr (GATHER) {   \
            unsigned _pk = rcpk; asm volatile("" : "+v"(_pk));   \
            const LAS unsigned char* _rp = (const LAS unsigned char*)rtab + ((ord) * 1024 + (h) * 512) + (_pk & 0xffffu); const unsigned _c2 = _pk >> 16; \
            _Pragma("unroll") for (int _i = 0; _i < 2; ++_i) _o[_i] = __umul24((unsigned)*(const LAS int*)(_rp + _i * 256), (unsigned)KB) + _c2; } \
        else { _o[0] = voffA[0]; _o[1] = voffA[1]; } if constexpr (FP8 && !GATHER) PG8_STAGE1(bufoff, gbase, voffA[0]); else PG8_STAGE(bufoff, gbase, _o); } while (0)
#define PG8_STAGE_B(bufoff, gbase) do { if constexpr (FP8) PG8_STAGE1(bufoff, gbase, voffB[0]); else PG8_STAGE(bufoff, gbase, voffB); } while (0)
    Unit cur, nxt; int ui = 0;
    if (!S.next(0, cur)) return;
    f32x4 acc[2][2][4][2];
#pragma unroll
    for (int a = 0; a < 2; ++a)
#pragma unroll
        for (int b = 0; b < 2; ++b)
#pragma unroll
            for (int m = 0; m < 4; ++m)
#pragma unroll
                for (int n = 0; n < 2; ++n) acc[a][b][m][n] = (f32x4){0.f, 0.f, 0.f, 0.f};
    bf16x8 At[4][2], B0[2][2], B1[2][2]; i32x8v At8[4], B08[2], B18[2];
    const char* cA = GATHER ? (const char*)g.A : (const char*)g.A + (size_t)cur.pm * tstep; const char* cB = (const char*)g.Bt + (size_t)cur.pn * tstep;
    PG8_STAGE_B(PG8_SB(0, 0), cB); PG8_STAGE_B(PG8_SB(0, 1), cB + hstep); PG8_STAGE_A(PG8_SA(0, 0), cA, 0, 0); PG8_STAGE_A(PG8_SA(0, 1), cA + hstepA, 0, 1);
    if (wr == 1) PG8_BAR;
    PG8_WAIT_V(2); PG8_BAR;
    PG8_STAGE_B(PG8_SB(1, 0), cB + kstep); PG8_STAGE_A(PG8_SA(1, 0), cA + kstep, 0, 0); PG8_STAGE_B(PG8_SB(1, 1), cB + hstep + kstep);
    PG8_WAIT_V(6); PG8_BAR;
    for (;;) {
        const bool has_next = S.next(ui + 1, nxt);
        const char* nA = GATHER ? (const char*)g.A : (has_next ? (const char*)g.A + (size_t)nxt.pm * tstep : cA); const char* nB = has_next ? (const char*)g.Bt + (size_t)nxt.pn * tstep : cB;
#pragma unroll 1
        for (int t = 0; t < nt; t += 2) {
            const bool last = (t == nt - 2);
            const char* a1 = cA + (size_t)(t + 1) * kstep;
            const char* a2 = last ? nA : cA + (size_t)(t + 2) * kstep; const char* b2 = last ? nB : cB + (size_t)(t + 2) * kstep;
            const char* a3 = a2 + kstep; const char* b3 = b2 + kstep;
            const int on = (last && has_next) ? ui + 1 : ui;
            PG8_LDB(B0, 0, 0); PG8_LDB(B1, 0, 1); PG8_SCHED; PG8_LDA(At, 0, 0); PG8_STAGE_A(PG8_SA(1, 1), a1 + hstepA, ui, 1);
            PG8_WAIT_V(8); PG8_WAIT_L(0); PG8_BAR; PG8_MMA(0, 0, At, B0); PG8_MMA(0, 1, At, B1); PG8_BAR; PG8_SCHED;
            PG8_LDA(At, 0, 1); PG8_STAGE_B(PG8_SB(0, 0), b2); PG8_STAGE_B(PG8_SB(0, 1), b2 + hstep); PG8_STAGE_A(PG8_SA(0, 0), a2, on, 0);
            PG8_WAIT_V(8); PG8_WAIT_L(0); PG8_BAR; PG8_MMA(1, 0, At, B0); PG8_MMA(1, 1, At, B1); PG8_BAR; PG8_SCHED;
            PG8_LDB(B0, 1, 0); PG8_LDB(B1, 1, 1); PG8_SCHED; PG8_LDA(At, 1, 0); PG8_STAGE_A(PG8_SA(0, 1), a2 + hstepA, on, 1);
            PG8_WAIT_V(8); PG8_WAIT_L(0); PG8_BAR; PG8_MMA(0, 0, At, B0); PG8_MMA(0, 1, At, B1); PG8_BAR; PG8_SCHED;
            PG8_LDA(At, 1, 1); PG8_STAGE_B(PG8_SB(1, 0), b3); PG8_STAGE_B(PG8_SB(1, 1), b3 + hstep); PG8_STAGE_A(PG8_SA(1, 0), a3, on, 0);
            PG8_WAIT_V(8); PG8_WAIT_L(0); PG8_BAR; PG8_MMA(1, 0, At, B0); PG8_MMA(1, 1, At, B1); PG8_BAR; PG8_SCHED;
        }
        if (wr == 0) PG8_BAR;
        E(acc, cur, wr, wc, fr, fq);
        if (!has_next) break;
#pragma unroll
        for (int a = 0; a < 2; ++a)
#pragma unroll
            for (int b = 0; b < 2; ++b)
#pragma unroll
                for (int m = 0; m < 4; ++m)
#pragma unroll
                    for (int n = 0; n < 2; ++n) acc[a][b][m][n] = (f32x4){0.f, 0.f, 0.f, 0.f};
        cur = nxt; cA = nA; cB = nB; ++ui;
        if (wr == 1) PG8_BAR;
    }
    PG8_WAIT_V(0);
    PG8_BAR;
#undef PG8_SA
#undef PG8_SB
#undef PG8_STAGE
#undef PG8_LDA
#undef PG8_LDB
#undef PG8_MMA
#undef PG8_WAIT_V
#undef PG8_WAIT_L
#undef PG8_BAR
#undef PG8_SCHED
#undef PG8_STAGE_A
#undef PG8_STAGE_B
#undef PG8_STAGE1
}
struct EpiBf16 {
    bf16_t* O; int ldc, ncolt; size_t slab;
    __device__ __forceinline__ void operator()(const f32x4 (&acc)[2][2][4][2], const Unit& u, int wr, int wc, int fr, int fq) const {
        const int row0 = u.pm * BM + wr * 64 + fr; const size_t col0 = (size_t)(u.pn % ncolt) * slab + wc * 32 + 8 * fq;
#pragma unroll
        for (int ai = 0; ai < 2; ++ai)
#pragma unroll
            for (int m = 0; m < 4; ++m) { bf16_t* rowp = O + (size_t)(row0 + ai * HALF + m * 16) * ldc + col0;
#pragma unroll
                for (int bj = 0; bj < 2; ++bj) { const f32x4 v0 = acc[ai][bj][m][0], v1 = acc[ai][bj][m][1];
                    u32x4 w; w.x = cvt_pk_bf16(v0[0], v0[1]); w.y = cvt_pk_bf16(v0[2], v0[3]); w.z = cvt_pk_bf16(v1[0], v1[1]); w.w = cvt_pk_bf16(v1[2], v1[3]);
                    *(u32x4*)(rowp + bj * HALF) = w; } }
    }
};
struct EpiRes {
    bf16_t* X; const float* xlat; const float* xctx; const float* modl; int pm_shift; float ascale;
    __device__ __forceinline__ void operator()(const f32x4 (&acc)[2][2][4][2], const Unit& u, int wr, int wc, int fr, int fq) const {
        const int pm = u.pm - pm_shift; const int rsel = pm < 64 ? (pm >> 5) : 2;
        const int row0 = pm * BM + wr * 64 + fr, col0 = (u.pn & 3) * BM + wc * 32 + 8 * fq;
        const float* gate = modl + (size_t)rsel * 6144 + col0;
        const float* xs = xlat ? (pm < 64 ? xlat + (size_t)row0 * D : xctx + (size_t)(row0 - R_LAT) * D) + col0 : nullptr;
        bf16_t* xo = X + (size_t)row0 * D + col0;
#pragma unroll
        for (int bj = 0; bj < 2; ++bj) { const f32x4 g0 = *(const f32x4*)(gate + bj * HALF) * ascale, g1 = *(const f32x4*)(gate + bj * HALF + 4) * ascale;
#pragma unroll
            for (int ai = 0; ai < 2; ++ai)
#pragma unroll
                for (int m = 0; m < 4; ++m) { const size_t o = (size_t)(ai * HALF + m * 16) * D + bj * HALF;
                    f32x4 x0, x1;
                    if (xs) { x0 = *(const f32x4*)(xs + o); x1 = *(const f32x4*)(xs + o + 4); } else unpack8(*(const u32x4*)(xo + o), x0, x1);
                    const f32x4 y0 = x0 + g0 * acc[ai][bj][m][0], y1 = x1 + g1 * acc[ai][bj][m][1];
                    u32x4 w; w.x = cvt_pk_bf16(y0[0], y0[1]); w.y = cvt_pk_bf16(y0[2], y0[3]); w.z = cvt_pk_bf16(y1[0], y1[1]); w.w = cvt_pk_bf16(y1[2], y1[3]);
                    *(u32x4*)(xo + o) = w; } }
    }
};
struct EpiGU8 {
    unsigned char* H8; const LAS float* wtab;
    __device__ __forceinline__ void operator()(const f32x4 (&acc)[2][2][4][2], const Unit& u, int wr, int wc, int fr, int fq) const {
        asm volatile("" : "+v"(fr), "+v"(fq));
        const int row0 = u.pm * BM + wr * 64 + fr, col0 = (u.pn & 1) * 128 + wc * 32 + 8 * fq;
#pragma unroll
        for (int ai = 0; ai < 2; ++ai)
#pragma unroll
            for (int m = 0; m < 4; ++m) { const int row = row0 + ai * HALF + m * 16; const float w = wtab[u.ord * 256 + wr * 64 + fr + ai * HALF + m * 16] * H8_SCALE;
                float h[8];
#pragma unroll
                for (int n = 0; n < 2; ++n)
#pragma unroll
                    for (int j = 0; j < 4; ++j) { const float gv = acc[ai][0][m][n][j] * GU_DESCALE, uv = acc[ai][1][m][n][j] * GU_DESCALE;
                        h[n * 4 + j] = fminf(fmaxf(gv * __builtin_amdgcn_rcpf(1.f + __expf(-gv)) * uv * w, -440.f), 440.f); }
                int w0 = __builtin_amdgcn_cvt_pk_fp8_f32(h[0], h[1], 0, false); w0 = __builtin_amdgcn_cvt_pk_fp8_f32(h[2], h[3], w0, true);
                int w1 = __builtin_amdgcn_cvt_pk_fp8_f32(h[4], h[5], 0, false); w1 = __builtin_amdgcn_cvt_pk_fp8_f32(h[6], h[7], w1, true);
                u32x2 o; o.x = (unsigned)w0; o.y = (unsigned)w1;
                *(u32x2*)(H8 + (size_t)row * 256 + col0) = o; }
    }
};
struct EpiGU {
    bf16_t* H; const float* slot_w;
    __device__ __forceinline__ void operator()(const f32x4 (&acc)[2][2][4][2], const Unit& u, int wr, int wc, int fr, int fq) const {
        const int row0 = u.pm * BM + wr * 64 + fr, col0 = (u.pn & 1) * 128 + wc * 32 + 8 * fq;
#pragma unroll
        for (int ai = 0; ai < 2; ++ai)
#pragma unroll
            for (int m = 0; m < 4; ++m) { const int row = row0 + ai * HALF + m * 16; const float w = slot_w[row];
                float h[8];
#pragma unroll
                for (int n = 0; n < 2; ++n)
#pragma unroll
                    for (int j = 0; j < 4; ++j) { const float gv = acc[ai][0][m][n][j], uv = acc[ai][1][m][n][j]; h[n * 4 + j] = gv / (1.f + __expf(-gv)) * uv * w; }
                u32x4 o; o.x = cvt_pk_bf16(h[0], h[1]); o.y = cvt_pk_bf16(h[2], h[3]); o.z = cvt_pk_bf16(h[4], h[5]); o.w = cvt_pk_bf16(h[6], h[7]);
                *(u32x4*)(H + (size_t)row * 256 + col0) = o; }
    }
};
struct EpiY8 {
    unsigned char* Y8;
    __device__ __forceinline__ void operator()(const f32x4 (&acc)[2][2][4][2], const Unit& u, int wr, int wc, int fr, int fq) const {
        const int row0 = u.pm * BM + wr * 64 + fr; unsigned char* base = Y8 + ((size_t)(u.pn & 3) * MAXSLOT + row0) * 256 + wc * 32 + 8 * fq;
#pragma unroll
        for (int ai = 0; ai < 2; ++ai)
#pragma unroll
            for (int m = 0; m < 4; ++m)
#pragma unroll
                for (int bj = 0; bj < 2; ++bj) { f32x4 v0 = acc[ai][bj][m][0] * (Y8_SCALE * DN_DESCALE), v1 = acc[ai][bj][m][1] * (Y8_SCALE * DN_DESCALE);
#pragma unroll
                    for (int q = 0; q < 4; ++q) { v0[q] = fminf(fmaxf(v0[q], -440.f), 440.f); v1[q] = fminf(fmaxf(v1[q], -440.f), 440.f); }
                    int w0 = __builtin_amdgcn_cvt_pk_fp8_f32(v0[0], v0[1], 0, false); w0 = __builtin_amdgcn_cvt_pk_fp8_f32(v0[2], v0[3], w0, true);
                    int w1 = __builtin_amdgcn_cvt_pk_fp8_f32(v1[0], v1[1], 0, false); w1 = __builtin_amdgcn_cvt_pk_fp8_f32(v1[2], v1[3], w1, true);
                    u32x2 o; o.x = (unsigned)w0; o.y = (unsigned)w1;
                    *(u32x2*)(base + (size_t)(ai * HALF + m * 16) * 256 + bj * HALF) = o; }
    }
};
struct EpiDown {
    bf16_t* Y; bf16_t* X; const float* modl5;
    __device__ __forceinline__ void operator()(const f32x4 (&acc)[2][2][4][2], const Unit& u, int wr, int wc, int fr, int fq) const {
        asm volatile("" : "+v"(fr), "+v"(fq));
        if (u.pm < MAXSLOT / 256) { const EpiY8 e{(unsigned char*)Y}; e(acc, u, wr, wc, fr, fq); }
        else { const EpiRes e{X, nullptr, nullptr, modl5, MAXSLOT / 256, DN_DESCALE}; e(acc, u, wr, wc, fr, fq); }
    }
};
}


__device__ __forceinline__ void ph_inproj_f(KP p, int l, unsigned char* lds) {
    pg8::Gemm g{(const bf16_t*)(p->ws + Z_A), (const bf16_t*)(p->ws + win_off(l)), R_ALL, DIN, 1024};
    pg8::StaticOrder S; S.init(R_ALL, DIN, gsz_(), bid_());
    pg8::EpiBf16 E{(bf16_t*)(p->ws + Z_P), DIN, DIN / 256, 256};
    pg8::gemm_phase<pg8::EpiBf16, pg8::StaticOrder, false>((LAS unsigned char*)lds, g, S, E, nullptr);
    if (l == 0 && DEPTH > 1 && gsz_() == 256) { __syncthreads(); ph_cvt(p, 1, lds, 214, 42, 0, CVT_E1); }
}
__device__ __forceinline__ void ph_outproj_f(KP p, int l, unsigned char* lds) {
    const int T = (l == 0) ? R_ALL : R_LAT;
    pg8::Gemm g{(const bf16_t*)(p->ws + Z_YCAT), (const bf16_t*)(p->ws + wout_off(l)), T, 1024, 1024};
    pg8::StaticOrder S; S.init(T, 1024, gsz_(), bid_());
    bf16_t* X = (bf16_t*)(p->ws + WS_X);
    pg8::EpiRes E{X, l == 0 ? p->in[0] : nullptr, l == 0 ? p->in[2] : nullptr, (const float*)(p->ws + WS_MOD) + (size_t)l * 3 * 6144 + 2 * 1024, 0, 1.f};
    pg8::gemm_phase<pg8::EpiRes, pg8::StaticOrder, false>((LAS unsigned char*)lds, g, S, E, nullptr);
    if (l == 0 && DEPTH > 1) {
        const int G = gsz_(); __syncthreads();
        if (G == 256) ph_cvt(p, 1, lds, 8, 248, CVT_E2, 1 << 30); else ph_cvt(p, 1, lds); }
}
struct QkvLane { f32x4 gg0, gg1, gw0, gw1; };
__device__ __forceinline__ QkvLane qkv_lane_consts(KP p, int l, int lane) {
    QkvLane c; const int dch = (lane & 7) * 8; const int isk = lane >= 32;
    const float* gq = p->in[isk ? 11 : 10] + l * 64 + dch; const float* wq = p->in[isk ? 13 : 12] + l * 64 + dch;
    c.gg0 = *(const f32x4*)gq; c.gg1 = *(const f32x4*)(gq + 4); c.gw0 = *(const f32x4*)wq; c.gw1 = *(const f32x4*)(wq + 4); return c;
}
__device__ __forceinline__ void prep_qkv_row(KP p, int l, int row, int lane, const QkvLane& qc) {
    const bf16_t* pr = (const bf16_t*)(p->ws + Z_P) + (size_t)row * DIN;
    const bool isctx = row >= R_LAT; const int b = isctx ? ((row - R_LAT) >> 8) : (row >> 13), t = isctx ? ((row - R_LAT) & 255) : (row & 8191);
    const size_t krow = (size_t)b * NKEY + (isctx ? NSEQ + t : t);
    const int l7 = lane & 7, axis = l7 >> 2, half = (l7 >> 1) & 1;
    f32x4 cs0 = (f32x4){1.f, 1.f, 1.f, 1.f}, cs1 = cs0, sn0 = (f32x4){0.f, 0.f, 0.f, 0.f}, sn1 = sn0;
    if (!isctx) { const int pos = axis == 0 ? (t >> 6) : (t & 63); const float* rt = (const float*)(p->ws + WS_ROPE) + pos * 32 + (lane & 1) * 8;
        cs0 = *(const f32x4*)rt; cs1 = *(const f32x4*)(rt + 4); sn0 = *(const f32x4*)(rt + 16); sn1 = *(const f32x4*)(rt + 20); }
    const u32x4 ra = *(const u32x4*)(pr + lane * 8), rb = *(const u32x4*)(pr + 512 + lane * 8);
#pragma unroll
    for (int grp = 0; grp < 2; ++grp) {
        const u32x4 r = grp ? rb : ra;
        bf16_t* Qd = (bf16_t*)(p->ws + (isctx ? (grp ? Z_QWC : Z_QGC) : (grp ? Z_QW : Z_QG))) + (size_t)(isctx ? (b * NCTX + t) : row) * 256;
        bf16_t* Kd = (bf16_t*)(p->ws + (grp ? Z_KW : Z_KG)) + krow * 128; bf16_t* Vd = (bf16_t*)(p->ws + (grp ? Z_VW : Z_VG)) + krow * 128;
        if (lane >= 48) { *(u32x4*)(Vd + (lane - 48) * 8) = r; continue; }
        float x[8] = {bf2f(r.x & 0xffffu), bf2f(r.x >> 16), bf2f(r.y & 0xffffu), bf2f(r.y >> 16), bf2f(r.z & 0xffffu), bf2f(r.z >> 16), bf2f(r.w & 0xffffu), bf2f(r.w >> 16)};
        float ss = 0.f;
#pragma unroll
        for (int i = 0; i < 8; ++i) ss += x[i] * x[i];
        ss += __shfl_xor(ss, 1); ss += __shfl_xor(ss, 2); ss += __shfl_xor(ss, 4);
        const float rinv = rsqrtf(ss * (1.f / 64.f) + EPS);
        const f32x4 g0 = grp ? qc.gw0 : qc.gg0, g1 = grp ? qc.gw1 : qc.gg1;
        const float gv[8] = {g0.x, g0.y, g0.z, g0.w, g1.x, g1.y, g1.z, g1.w};
        const float cv[8] = {cs0.x, cs0.y, cs0.z, cs0.w, cs1.x, cs1.y, cs1.z, cs1.w}, sv[8] = {sn0.x, sn0.y, sn0.z, sn0.w, sn1.x, sn1.y, sn1.z, sn1.w};
        const float qs = (lane < 32) ? QSCALE : 1.f;
        float y[8];
#pragma unroll
        for (int i = 0; i < 8; ++i) { const float v = x[i] * rinv * gv[i]; const float o = __shfl_xor(v, 2);
            y[i] = ((half == 0) ? (v * cv[i] - o * sv[i]) : (o * sv[i] + v * cv[i])) * qs; }
        u32x4 ov; ov.x = pk2(y[0], y[1]); ov.y = pk2(y[2], y[3]); ov.z = pk2(y[4], y[5]); ov.w = pk2(y[6], y[7]);
        if (lane < 32) *(u32x4*)(Qd + lane * 8) = ov; else *(u32x4*)(Kd + (lane - 32) * 8) = ov;
    }
}

template <int R> __device__ __forceinline__ void dw_rows(const float* hcol, const float (&wj)[31], float (&acc)[32]) {
    if constexpr (R < 62) {
        const float hv = hcol[R * 256];
        constexpr int T0 = (R - 30 > 0) ? R - 30 : 0, T1 = (R < 31) ? R : 31;
#pragma unroll
        for (int tt = T0; tt <= T1; ++tt) acc[tt] += hv * wj[R - tt];
        dw_rows<R + 1>(hcol, wj, acc);
    }
}
__device__ __forceinline__ void conv_tile(KP p, int l, unsigned char* lds, int seq_row0, int seqlen, int t0) {
    float* hb = (float*)lds;
    const int tid = tid_(), lane = tid & 63, wid = tid >> 6;
    const bf16_t* P = (const bf16_t*)(p->ws + Z_P);
    for (int i = tid; i < 94 * 32; i += NTHREADS) { const int r = i >> 5, c8 = (i & 31) * 8, t = t0 - 15 + r;
        f32x4 h0 = (f32x4){0.f, 0.f, 0.f, 0.f}, h1 = h0;
        if (t >= 0 && t < seqlen) { const bf16_t* pr = P + (size_t)(seq_row0 + t) * DIN;
            const u32x4 vv = *(const u32x4*)(pr + C_CVV + c8), gg = *(const u32x4*)(pr + C_CVG + c8);
            h0.x = bf2f(vv.x & 0xffffu) * sigmoid_(bf2f(gg.x & 0xffffu)); h0.y = bf2f(vv.x >> 16) * sigmoid_(bf2f(gg.x >> 16));
            h0.z = bf2f(vv.y & 0xffffu) * sigmoid_(bf2f(gg.y & 0xffffu)); h0.w = bf2f(vv.y >> 16) * sigmoid_(bf2f(gg.y >> 16));
            h1.x = bf2f(vv.z & 0xffffu) * sigmoid_(bf2f(gg.z & 0xffffu)); h1.y = bf2f(vv.z >> 16) * sigmoid_(bf2f(gg.z >> 16));
            h1.z = bf2f(vv.w & 0xffffu) * sigmoid_(bf2f(gg.w & 0xffffu)); h1.w = bf2f(vv.w >> 16) * sigmoid_(bf2f(gg.w >> 16)); }
        *(f32x4*)(hb + r * 256 + c8) = h0; *(f32x4*)(hb + r * 256 + c8 + 4) = h1; }
    __syncthreads();
    { const int c = tid & 255, hf = tid >> 8;
      const float* w = p->in[15] + (size_t)l * 31 * 256 + c; const float bias = p->in[16][l * 256 + c];
      float wj[31];
#pragma unroll
      for (int j = 0; j < 31; ++j) wj[j] = w[j * 256];
      float acc[32];
#pragma unroll
      for (int tt = 0; tt < 32; ++tt) acc[tt] = bias;
      dw_rows<0>(hb + hf * 32 * 256 + c, wj, acc);
      __syncthreads();
#pragma unroll
      for (int tt = 0; tt < 32; ++tt) hb[(hf * 32 + tt) * 256 + c] = acc[tt];
    }
    __syncthreads();
    constexpr int AS = 264;
    bf16_t* ab = (bf16_t*)(lds + 94 * 256 * 4);
    for (int tt = wid; tt < 64; tt += 8) { const float* r = hb + tt * 256; const f32x4 v = ((const f32x4*)r)[lane];
        const float mean = wave_sum(v.x + v.y + v.z + v.w) * (1.f / 256.f);
        const float dx = v.x - mean, dy = v.y - mean, dz = v.z - mean, dw = v.w - mean;
        const float rstd = rsqrtf(wave_sum(dx * dx + dy * dy + dz * dz + dw * dw) * (1.f / 256.f) + EPS);
        const f32x4 g = ((const f32x4*)(p->in[17] + l * 256))[lane], bb = ((const f32x4*)(p->in[18] + l * 256))[lane];
        u32x2 o; o.x = pk2(silu_(dx * rstd * g.x + bb.x), silu_(dy * rstd * g.y + bb.y)); o.y = pk2(silu_(dz * rstd * g.z + bb.z), silu_(dw * rstd * g.w + bb.w));
        *(u32x2*)(ab + tt * AS + lane * 4) = o; }
    __syncthreads();
    { const int fr = lane & 15, fq = lane >> 4;
      const bf16_t* Wt = (const bf16_t*)(p->ws + wpw_off(l));
      bf16x8 bw[2][8];
#pragma unroll
      for (int j = 0; j < 2; ++j)
#pragma unroll
          for (int ks = 0; ks < 8; ++ks) bw[j][ks] = *(const bf16x8*)(Wt + (size_t)((wid * 2 + j) * 16 + fr) * 256 + ks * 32 + fq * 8);
      const float bias0 = p->in[20][l * 256 + wid * 32 + fr], bias1 = p->in[20][l * 256 + wid * 32 + 16 + fr];
      bf16_t* Y = (bf16_t*)(p->ws + Z_YCAT);
#pragma unroll 1
      for (int tr = 0; tr < 4; ++tr) { f32x4 a0 = (f32x4){0.f, 0.f, 0.f, 0.f}, a1 = a0;
#pragma unroll
          for (int ks = 0; ks < 8; ++ks) { const bf16x8 av = *(const bf16x8*)(ab + (tr * 16 + fr) * AS + ks * 32 + fq * 8);
              a0 = __builtin_amdgcn_mfma_f32_16x16x32_bf16(av, bw[0][ks], a0, 0, 0, 0); a1 = __builtin_amdgcn_mfma_f32_16x16x32_bf16(av, bw[1][ks], a1, 0, 0, 0); }
#pragma unroll
          for (int r = 0; r < 4; ++r) { const int t = t0 + tr * 16 + fq * 4 + r; bf16_t* yr = Y + (size_t)(seq_row0 + t) * D + 256 + wid * 32 + fr;
              yr[0] = (bf16_t)f2bf(a0[r] + bias0); yr[16] = (bf16_t)f2bf(a1[r] + bias1); } }
    }
    __syncthreads();
}

__device__ __forceinline__ int hgrn_chunk_row0(int b, int dir, int j) {
    if (j < 4) { const int cj = dir ? 3 - j : j; return R_LAT + b * NCTX + cj * 64; }
    const int jj = j - 4, cj = dir ? 127 - jj : jj; return b * NSEQ + cj * 64;
}
__device__ __forceinline__ void hgrn_load_chunk(KP p, int l, int row0, int dir, int head, float* qs, float* vs, float* ks, float* cs) {
    const int tid = tid_();
    const bf16_t* P = (const bf16_t*)(p->ws + Z_P);
    const float* lbv = (const float*)(p->ws + WS_LB) + (l * 2 + dir) * 256 + head * 64;
    for (int i = tid; i < 4096; i += NTHREADS) { const int tau = i >> 6, d = i & 63; const int row = row0 + (dir ? 63 - tau : tau);
        const bf16_t* pr = P + (size_t)row * DIN + head * 64 + d;
        if (qs) qs[i] = bf2f(pr[C_RQ]);
        vs[i] = bf2f(pr[C_RI]);
        const float z = bf2f(pr[dir ? C_RFB : C_RFF]); const float lb = lbv[d];
        const float lsp = fminf(z, 0.f) - log1pf(__expf(-fabsf(z)));
        float logf = lsp;
        if (lb > 0.f) { const float a = lsp, bq = __logf(lb) + (lsp - z); const float mx = fmaxf(a, bq); logf = mx + log1pf(__expf(-fabsf(a - bq))); }
        ks[i] = (1.f - lb) * sigmoid_(-z);
        cs[i] = logf; }
    __syncthreads();
    if (tid < 64) { float c = 0.f; for (int tau = 0; tau < 64; ++tau) { c += cs[tau * 64 + tid]; cs[tau * 64 + tid] = c; } }
    __syncthreads();
}
__device__ __forceinline__ void hgrn_pass1_unit(KP p, int l, unsigned char* lds, int unit) {
    float* vs = (float*)lds; float* ks = vs + 4096; float* cs = ks + 4096;
    const int tid = tid_();
    const int j = unit % NCHUNK, seq = unit / NCHUNK, dir = seq & 1, head = (seq >> 1) & 3, b = seq >> 3;
    hgrn_load_chunk(p, l, hgrn_chunk_row0(b, dir, j), dir, head, nullptr, vs, ks, cs);
    for (int i = tid; i < 4096; i += NTHREADS) { const int d = i & 63; ks[i] *= __expf(cs[63 * 64 + d] - cs[i]); }
    __syncthreads();
    float* U = (float*)(p->ws + Z_U) + ((size_t)seq * NCHUNK + j) * 4096; float* Gv = (float*)(p->ws + Z_G) + ((size_t)seq * NCHUNK + j) * 64;
    { const int d = tid >> 3, e0 = (tid & 7) * 8; float acc[8];
#pragma unroll
      for (int e = 0; e < 8; ++e) acc[e] = 0.f;
      for (int tau = 0; tau < 64; ++tau) { const float kv = ks[tau * 64 + d];
#pragma unroll
          for (int e = 0; e < 8; ++e) acc[e] += kv * vs[tau * 64 + e0 + e]; }
#pragma unroll
      for (int e = 0; e < 8; ++e) U[d * 64 + e0 + e] = acc[e]; }
    if (tid < 64) Gv[tid] = __expf(cs[63 * 64 + tid]);
    __syncthreads();
}
constexpr int HS = 72;
constexpr int HL_TOT = 0, HL_OSUM = 2048, HL_T0 = 18432, HL_TB = 64 * HS * 2;
__device__ __forceinline__ f32x4 mm64(const bf16_t* A, const bf16_t* Bt, int tr, int tc, int fr, int fq, f32x4 acc) {
#pragma unroll
    for (int k0 = 0; k0 < 64; k0 += 32) { const bf16x8 a = *(const bf16x8*)(A + (tr * 16 + fr) * HS + k0 + fq * 8), b = *(const bf16x8*)(Bt + (tc * 16 + fr) * HS + k0 + fq * 8);
        acc = __builtin_amdgcn_mfma_f32_16x16x32_bf16(a, b, acc, 0, 0, 0); }
    return acc;
}
__device__ __forceinline__ void hgrn_load8(KP p, int row0, int dir, int head, int tid, float (&q)[8], float (&vv)[8], float (&z)[8]) {
    const int d = tid & 63, seg = tid >> 6;
    const bf16_t* P = (const bf16_t*)(p->ws + Z_P);
#pragma unroll
    for (int i = 0; i < 8; ++i) { const int tau = seg * 8 + i; const int row = row0 + (dir ? 63 - tau : tau);
        const bf16_t* pr = P + (size_t)row * DIN + head * 64 + d;
        q[i] = bf2f(pr[C_RQ]); vv[i] = bf2f(pr[C_RI]); z[i] = bf2f(pr[dir ? C_RFB : C_RFF]); }
}
__device__ __forceinline__ void hgrn_gate8(KP p, int l, int dir, int head, int tid, float* tot, const float (&z)[8], float (&kg)[8], float (&c)[8], float& m, float& cl) {
    const int d = tid & 63, seg = tid >> 6;
    const float lb = ((const float*)(p->ws + WS_LB))[(l * 2 + dir) * 256 + head * 64 + d];
    float run = 0.f;
#pragma unroll
    for (int i = 0; i < 8; ++i) {
        const float ez = __expf(-fabsf(z[i])), rz = __builtin_amdgcn_rcpf(1.f + ez); const float sg = (z[i] >= 0.f) ? rz : ez * rz;
        const float f = lb + (1.f - lb) * sg;
        kg[i] = 1.f - f;
        run += __logf(f); c[i] = run; }
    tot[seg * 64 + d] = run;
    __syncthreads();
    float off = 0.f; m = 0.f; cl = 0.f;
#pragma unroll
    for (int s2 = 0; s2 < 8; ++s2) { const float t = tot[s2 * 64 + d]; if (s2 < seg) off += t; if (s2 < 4) m += t; cl += t; }
#pragma unroll
    for (int i = 0; i < 8; ++i) c[i] += off;
}
__device__ __forceinline__ u32x4 pack8(const float (&x)[8]) { u32x4 o; o.x = pk2(x[0], x[1]); o.y = pk2(x[2], x[3]); o.z = pk2(x[4], x[5]); o.w = pk2(x[6], x[7]); return o; }
__device__ __forceinline__ void hgrn_pass1_f(KP p, int l, unsigned char* lds, int unit) {
    const int tid = tid_(), lane = tid & 63, wid = tid >> 6, fr = lane & 15, fq = lane >> 4, d = tid & 63, seg = tid >> 6;
    float* tot = (float*)(lds + HL_TOT); bf16_t* Vt = (bf16_t*)(lds + HL_T0); bf16_t* KbT = (bf16_t*)(lds + HL_T0 + HL_TB);
    const int j = unit % NCHUNK, seq = unit / NCHUNK, dir = seq & 1, head = (seq >> 1) & 3, b = seq >> 3;
    float q[8], vv[8], z[8], kg[8], c[8], m, cl;
    hgrn_load8(p, hgrn_chunk_row0(b, dir, j), dir, head, tid, q, vv, z);
    hgrn_gate8(p, l, dir, head, tid, tot, z, kg, c, m, cl);
    float kb[8];
#pragma unroll
    for (int i = 0; i < 8; ++i) kb[i] = kg[i] * __expf(cl - c[i]);
    *(u32x4*)(Vt + d * HS + seg * 8) = pack8(vv);
    *(u32x4*)(KbT + d * HS + seg * 8) = pack8(kb);
    float* U = (float*)(p->ws + Z_U) + ((size_t)seq * NCHUNK + j) * 4096; float* Gv = (float*)(p->ws + Z_G) + ((size_t)seq * NCHUNK + j) * 64;
    if (seg == 0) Gv[d] = __expf(cl);
    __syncthreads();
    const int tr = wid >> 1;
#pragma unroll
    for (int t2 = 0; t2 < 2; ++t2) { const int tc = (wid & 1) * 2 + t2;
        const f32x4 acc = mm64(Vt, KbT, tr, tc, fr, fq, (f32x4){0.f, 0.f, 0.f, 0.f});
#pragma unroll
        for (int r = 0; r < 4; ++r) U[(tr * 16 + fq * 4 + r) * 64 + tc * 16 + fr] = acc[r]; }
    __syncthreads();
}
struct HgrnIn1 { float v[8], zf[8], zb[8]; };
__device__ __forceinline__ void hgrn_p1_load(KP p, int unit, int tid, HgrnIn1& r) {
    const int cpos = unit % NCHUNK, head = (unit / NCHUNK) & 3, b = unit / (NCHUNK * 4), d = tid & 63, seg = tid >> 6;
    const int row0 = (cpos < 4) ? R_LAT + b * NCTX + cpos * 64 : b * NSEQ + (cpos - 4) * 64;
    const bf16_t* P = (const bf16_t*)(p->ws + Z_P) + (size_t)(row0 + seg * 8) * DIN + head * 64 + d;
#pragma unroll
    for (int i = 0; i < 8; ++i) { const bf16_t* pr = P + (size_t)i * DIN; r.v[i] = bf2f(pr[C_RI]); r.zf[i] = bf2f(pr[C_RFF]); r.zb[i] = bf2f(pr[C_RFB]); }
}
__device__ __forceinline__ void hgrn_p1_compute(KP p, int l, unsigned char* lds, int unit, int tid, const HgrnIn1& r) {
    const int lane = tid & 63, wid = tid >> 6, fr = lane & 15, fq = lane >> 4, d = tid & 63, seg = tid >> 6;
    float* totf = (float*)(lds + HL_TOT); float* totb = (float*)(lds + HL_OSUM);
    bf16_t* Vt = (bf16_t*)(lds + HL_T0); bf16_t* KfT = (bf16_t*)(lds + HL_T0 + HL_TB); bf16_t* KbT = (bf16_t*)(lds + HL_T0 + 2 * HL_TB);
    const int cpos = unit % NCHUNK, head = (unit / NCHUNK) & 3, b = unit / (NCHUNK * 4);
    const float* lbp = (const float*)(p->ws + WS_LB) + (l * 2) * 256 + head * 64 + d; const float lbf = lbp[0], lbb = lbp[256];
    float kf[8], kb[8], cf[8], cb[8], lfb[8], runf = 0.f, runb = 0.f;
#pragma unroll
    for (int i = 0; i < 8; ++i) {
        { const float z = r.zf[i], ez = __expf(-fabsf(z)), rz = __builtin_amdgcn_rcpf(1.f + ez), sg = (z >= 0.f) ? rz : ez * rz, f = lbf + (1.f - lbf) * sg; kf[i] = 1.f - f; runf += __logf(f); cf[i] = runf; }
        { const float z = r.zb[i], ez = __expf(-fabsf(z)), rz = __builtin_amdgcn_rcpf(1.f + ez), sg = (z >= 0.f) ? rz : ez * rz, f = lbb + (1.f - lbb) * sg; kb[i] = 1.f - f; lfb[i] = __logf(f); runb += lfb[i]; cb[i] = runb; } }
    totf[seg * 64 + d] = runf; totb[seg * 64 + d] = runb;
    __syncthreads();
    float offf = 0.f, offb = 0.f, clf = 0.f, clb = 0.f;
#pragma unroll
    for (int s2 = 0; s2 < 8; ++s2) { const float tf = totf[s2 * 64 + d], tb = totb[s2 * 64 + d]; if (s2 < seg) { offf += tf; offb += tb; } clf += tf; clb += tb; }
#pragma unroll
    for (int i = 0; i < 8; ++i) { kf[i] *= __expf(clf - (cf[i] + offf)); kb[i] *= __expf(cb[i] + offb - lfb[i]); }
    *(u32x4*)(Vt + d * HS + seg * 8) = pack8(r.v);
    *(u32x4*)(KfT + d * HS + seg * 8) = pack8(kf);
    *(u32x4*)(KbT + d * HS + seg * 8) = pack8(kb);
    const int jf = cpos, jb = (cpos < 4) ? 3 - cpos : 4 + 127 - (cpos - 4); const int seqf = (b * 4 + head) * 2;
    bf16_t* Uf = (bf16_t*)(p->ws + Z_U) + ((size_t)seqf * NCHUNK + jf) * 4096; bf16_t* Ub = (bf16_t*)(p->ws + Z_U) + ((size_t)(seqf + 1) * NCHUNK + jb) * 4096;
    float* Gf = (float*)(p->ws + Z_G) + ((size_t)seqf * NCHUNK + jf) * 64; float* Gb = (float*)(p->ws + Z_G) + ((size_t)(seqf + 1) * NCHUNK + jb) * 64;
    if (seg == 0) { Gf[d] = __expf(clf); Gb[d] = __expf(clb); }
    __syncthreads();
    const int tr = wid >> 1;
#pragma unroll
    for (int t2 = 0; t2 < 2; ++t2) { const int tc = (wid & 1) * 2 + t2;
        const f32x4 af = mm64(Vt, KfT, tr, tc, fr, fq, (f32x4){0.f, 0.f, 0.f, 0.f}), ab = mm64(Vt, KbT, tr, tc, fr, fq, (f32x4){0.f, 0.f, 0.f, 0.f});
#pragma unroll
        for (int q = 0; q < 4; ++q) { const int o = (tr * 16 + fq * 4 + q) * 64 + tc * 16 + fr; Uf[o] = (bf16_t)f2bf(af[q]); Ub[o] = (bf16_t)f2bf(ab[q]); } }
    __syncthreads();
}
__device__ __forceinline__ void hgrn_pass1_run(KP p, int l, unsigned char* lds, int u0, int un, int ustep) {
    if (un <= 0) return;
    const int tid = tid_();
    HgrnIn1 cur; hgrn_p1_load(p, u0, tid, cur);
    for (int k = 0; k < un; ++k) { const int u = u0 + k * ustep;
        HgrnIn1 nxt = cur; if (k + 1 < un) hgrn_p1_load(p, u + ustep, tid, nxt);
        hgrn_p1_compute(p, l, lds, u, tid, cur);
        cur = nxt; }
}
__device__ __forceinline__ void hgrn_scan_f(KP p) {
    const int tid = tid_();
    if (tid >= 256) return;
    for (int gi = bid_() * 256 + tid; gi < 16 * 4096; gi += gsz_() * 256) {
    const int seq = gi >> 12, ed = gi & 4095, d = ed & 63;
    bf16_t* U = (bf16_t*)(p->ws + Z_U) + (size_t)seq * NCHUNK * 4096 + ed; const float* Gv = (const float*)(p->ws + Z_G) + (size_t)seq * NCHUNK * 64 + d;
    float S = 0.f;
#pragma unroll 1
    for (int j = 0; j < NCHUNK; j += 12) {
        float u[12], g[12];
#pragma unroll
        for (int q = 0; q < 12; ++q) { u[q] = bf2f(U[(size_t)(j + q) * 4096]); g[q] = Gv[(j + q) * 64]; }
#pragma unroll
        for (int q = 0; q < 12; ++q) { U[(size_t)(j + q) * 4096] = (bf16_t)f2bf(S); S = g[q] * S + u[q]; }
    }
    }
}
struct HgrnIn3 { float q[8], v[8], zf[8], zb[8], gg[8]; u32x4 sf, sb; };
__device__ __forceinline__ void hgrn_p3_load(KP p, int unit, int tid, HgrnIn3& r) {
    const int cpos = unit % NCHUNK, head = (unit / NCHUNK) & 3, b = unit / (NCHUNK * 4), d = tid & 63, seg = tid >> 6;
    const int row0 = (cpos < 4) ? R_LAT + b * NCTX + cpos * 64 : b * NSEQ + (cpos - 4) * 64;
    const bf16_t* P = (const bf16_t*)(p->ws + Z_P) + (size_t)(row0 + seg * 8) * DIN + head * 64 + d;
#pragma unroll
    for (int i = 0; i < 8; ++i) { const bf16_t* pr = P + (size_t)i * DIN; r.q[i] = bf2f(pr[C_RQ]); r.v[i] = bf2f(pr[C_RI]); r.zf[i] = bf2f(pr[C_RFF]); r.zb[i] = bf2f(pr[C_RFB]);
        r.gg[i] = bf2f(((const bf16_t*)(p->ws + Z_P))[(size_t)(row0 + seg + 8 * i) * DIN + C_RG + head * 64 + d]); }
    const int jf = cpos, jb = (cpos < 4) ? 3 - cpos : 4 + 127 - (cpos - 4); const int seqf = (b * 4 + head) * 2;
    const bf16_t* U = (const bf16_t*)(p->ws + Z_U);
    r.sf = *(const u32x4*)(U + ((size_t)seqf * NCHUNK + jf) * 4096 + tid * 8); r.sb = *(const u32x4*)(U + ((size_t)(seqf + 1) * NCHUNK + jb) * 4096 + tid * 8);
}
__device__ __forceinline__ void hgrn_p3_compute(KP p, int l, unsigned char* lds, int unit, int tid, const HgrnIn3& r) {
    const int lane = tid & 63, wid = tid >> 6, fr = lane & 15, fq = lane >> 4, d = tid & 63, seg = tid >> 6;
    float* tot = (float*)(lds + HL_TOT); float* os = (float*)(lds + HL_OSUM);
    bf16_t* Qt = (bf16_t*)(lds + HL_T0); bf16_t* Kt = (bf16_t*)(lds + HL_T0 + HL_TB); bf16_t* Qb = (bf16_t*)(lds + HL_T0 + 2 * HL_TB);
    bf16_t* St = (bf16_t*)(lds + HL_T0 + 3 * HL_TB); bf16_t* Vt = (bf16_t*)(lds + HL_T0 + 4 * HL_TB); bf16_t* Sc = (bf16_t*)(lds + HL_T0 + 5 * HL_TB);
    const int cpos = unit % NCHUNK, head = (unit / NCHUNK) & 3, b = unit / (NCHUNK * 4);
    const int row0 = (cpos < 4) ? R_LAT + b * NCTX + cpos * 64 : b * NSEQ + (cpos - 4) * 64;
    const int tr = wid >> 1;
    const float* lbp = (const float*)(p->ws + WS_LB) + (l * 2) * 256 + head * 64 + d;
#pragma unroll
    for (int dir = 0; dir < 2; ++dir) {
        const float lb = lbp[dir * 256];
        float kg[8], c[8], run = 0.f;
#pragma unroll
        for (int ii = 0; ii < 8; ++ii) { const int i = dir ? 7 - ii : ii;
            const float z = dir ? r.zb[i] : r.zf[i];
            const float ez = __expf(-fabsf(z)), rz = __builtin_amdgcn_rcpf(1.f + ez), sg = (z >= 0.f) ? rz : ez * rz, f = lb + (1.f - lb) * sg;
            kg[i] = 1.f - f; run += __logf(f); c[i] = run; }
        tot[seg * 64 + d] = run;
        __syncthreads();
        float off = 0.f, m = 0.f;
#pragma unroll
        for (int s2 = 0; s2 < 8; ++s2) { const float t = tot[s2 * 64 + d]; if (dir ? (s2 > seg) : (s2 < seg)) off += t; if (dir ? (s2 >= 4) : (s2 < 4)) m += t; }
        float vr[8];
#pragma unroll
        for (int i = 0; i < 8; ++i) { const float ci = c[i] + off; const int tau = dir ? 63 - (seg * 8 + i) : seg * 8 + i; const float qv = r.q[i];
            Qt[tau * HS + d] = (bf16_t)f2bf(qv * __expf(fminf(ci - m, 80.f)));
            Kt[tau * HS + d] = (bf16_t)f2bf(kg[i] * __expf(fminf(m - ci, 80.f)));
            Qb[tau * HS + d] = (bf16_t)f2bf(qv * __expf(ci));
            vr[i] = dir ? r.v[7 - i] : r.v[i]; }
        *(u32x4*)(Vt + d * HS + (dir ? 7 - seg : seg) * 8) = pack8(vr);
        *(u32x4*)(St + (tid >> 3) * HS + (tid & 7) * 8) = dir ? r.sb : r.sf;
        __syncthreads();
        f32x4 oacc[2];
#pragma unroll
        for (int t2 = 0; t2 < 2; ++t2) { const int tc = (wid & 1) * 2 + t2;
            oacc[t2] = mm64(Qb, St, tr, tc, fr, fq, (f32x4){0.f, 0.f, 0.f, 0.f});
            f32x4 sacc = (f32x4){0.f, 0.f, 0.f, 0.f};
            if (tc <= tr) sacc = mm64(Qt, Kt, tr, tc, fr, fq, sacc);
#pragma unroll
            for (int q = 0; q < 4; ++q) { const int tau = tr * 16 + fq * 4 + q, sig = tc * 16 + fr; Sc[tau * HS + sig] = (bf16_t)f2bf(sig <= tau ? sacc[q] : 0.f); } }
        __syncthreads();
#pragma unroll
        for (int t2 = 0; t2 < 2; ++t2) { const int tc = (wid & 1) * 2 + t2;
            oacc[t2] = mm64(Sc, Vt, tr, tc, fr, fq, oacc[t2]);
#pragma unroll
            for (int q = 0; q < 4; ++q) { const int tau = tr * 16 + fq * 4 + q, e = tc * 16 + fr, tok = dir ? 63 - tau : tau;
                if (dir == 0) os[tok * 64 + e] = oacc[t2][q]; else os[tok * 64 + e] += oacc[t2][q]; } }
        __syncthreads();
    }
    bf16_t* Y = (bf16_t*)(p->ws + Z_YCAT); const float ong = p->in[22][l * 64 + lane];
#pragma unroll
    for (int i = 0; i < 8; ++i) { const int tok = wid + 8 * i; const float v = os[tok * 64 + lane];
        const float y = v * rsqrtf(wave_sum(v * v) * (1.f / 64.f) + EPS) * ong;
        Y[(size_t)(row0 + tok) * D + 768 + head * 64 + lane] = (bf16_t)f2bf(y * silu_(r.gg[i])); }
    __syncthreads();
}
__device__ __forceinline__ int hgrn_p3_unit(int k) { if (k < 1024) { const int bh = k >> 7, c = k & 127; return bh * NCHUNK + 4 + c; } const int k2 = k - 1024; return (k2 >> 2) * NCHUNK + (k2 & 3); }
__device__ __forceinline__ void hgrn_pass3_run(KP p, int l, unsigned char* lds) {
    const int tid = tid_(), G = gsz_(), nunits = 1024 + (l == 0 ? 32 : 0);
    int k = bid_(); if (k >= nunits) return;
    HgrnIn3 cur; hgrn_p3_load(p, hgrn_p3_unit(k), tid, cur);
    for (;;) { const int kn = k + G; const bool more = kn < nunits;
        HgrnIn3 nxt = cur; if (more) hgrn_p3_load(p, hgrn_p3_unit(kn), tid, nxt);
        hgrn_p3_compute(p, l, lds, hgrn_p3_unit(k), tid, cur);
        if (!more) break;
        cur = nxt; k = kn; }
}
__device__ __forceinline__ void ph_prep(KP p, int l, unsigned char* lds) {
    const int tid = tid_(), lane = tid & 63, wid = tid >> 6, bid = bid_(), G = gsz_();
    const int nconv = 256 + (l == 0 ? 8 : 0);
    for (int it = bid; it < nconv; it += G) {
        if (it < 256) conv_tile(p, l, lds, (it >> 7) * NSEQ, NSEQ, (it & 127) * 64);
        else { const int c = it - 256; conv_tile(p, l, lds, R_LAT + (c >> 2) * NCTX, NCTX, (c & 3) * 64); } }
    if (G == 256) {
        const int u0 = bid < 8 ? 2 * bid : bid < 56 ? 16 + 5 * (bid - 8) : 256 + 4 * (bid - 56), un = bid < 8 ? 2 : bid < 56 ? 5 : 4;
        hgrn_pass1_run(p, l, lds, u0, un, 1);
        const int g0 = bid < 104 ? 8 * bid : bid < 168 ? 832 + 9 * (bid - 104) : 1408 + 8 * (bid - 168), gn = (bid >= 104 && bid < 168) ? 9 : 8;
        const QkvLane qc = qkv_lane_consts(p, l, lane);
        for (int g = g0; g < g0 + gn; ++g) prep_qkv_row(p, l, g * 8 + wid, lane, qc);
    } else {
        hgrn_pass1_run(p, l, lds, bid, (8 * NCHUNK - bid + G - 1) / G, G);
        const QkvLane qc = qkv_lane_consts(p, l, lane);
        for (int row = bid * 8 + wid; row < R_ALL; row += G * 8) prep_qkv_row(p, l, row, lane, qc);
    }
}

__device__ __forceinline__ void hgrn_scan(KP p) {
    const int gi = bid_() * NTHREADS + tid_();
    if (gi >= 16 * 4096) return;
    const int seq = gi >> 12, de = gi & 4095, d = de >> 6;
    float* U = (float*)(p->ws + Z_U) + (size_t)seq * NCHUNK * 4096 + de; const float* Gv = (const float*)(p->ws + Z_G) + (size_t)seq * NCHUNK * 64 + d;
    float S = 0.f;
    for (int j = 0; j < NCHUNK; j += 4) {
        float u[4], g[4];
#pragma unroll
        for (int q = 0; q < 4; ++q) { u[q] = U[(size_t)(j + q) * 4096]; g[q] = Gv[(j + q) * 64]; }
#pragma unroll
        for (int q = 0; q < 4; ++q) { U[(size_t)(j + q) * 4096] = S; S = g[q] * S + u[q]; }
    }
}
__device__ __forceinline__ void attn_simple_unit(unsigned char* lds, const bf16_t* Qrow0  , const bf16_t* Kb, const bf16_t* Vb  ,
                                                 int mode, int NT, int first_key, int q0, bool use_sink, float sink_log2, bf16_t* Orow0  ) {
    float* Ks = (float*)lds; float* Vs = Ks + 4096;
    const int tid = tid_();
    float q[64], o[64], m = -INFINITY, lsum = 0.f;
    if (tid < 256) {
#pragma unroll
        for (int d = 0; d < 64; ++d) { q[d] = bf2f(Qrow0[(size_t)tid * 256 + d]); o[d] = 0.f; }
    }
    for (int tt = 0; tt < NT; ++tt) {
        int key0, pos0 = 0; bool masked = false;
        if (mode == 0) key0 = first_key + 64 * tt;
        else if (tt < 4) key0 = NSEQ + 64 * tt;
        else { pos0 = q0 - 128 + 64 * (tt - 4); key0 = pos0 < 0 ? 0 : (pos0 > NSEQ - 64 ? NSEQ - 64 : pos0); masked = true; }
        __syncthreads();
        for (int i = tid; i < 4096; i += NTHREADS) { const int kk = i >> 6, d = i & 63; Ks[i] = bf2f(Kb[(size_t)(key0 + kk) * 128 + d]); Vs[i] = bf2f(Vb[(size_t)(key0 + kk) * 128 + d]); }
        __syncthreads();
        if (tid < 256) {
            for (int kk = 0; kk < 64; ++kk) {
                if (masked) { const int kp = pos0 + kk, qp = q0 + tid; const int df = qp - kp; if (kp < 0 || kp >= NSEQ || df > 128 || df < -128) continue; }
                float s = 0.f;
#pragma unroll
                for (int d = 0; d < 64; ++d) s += q[d] * Ks[kk * 64 + d];
                if (s > m) { const float f = exp2f(m - s); lsum *= f;
#pragma unroll
                    for (int d = 0; d < 64; ++d) o[d] *= f;
                    m = s; }
                const float pe = exp2f(s - m); lsum += pe;
#pragma unroll
                for (int d = 0; d < 64; ++d) o[d] += pe * Vs[kk * 64 + d];
            }
        }
    }
    if (tid < 256) {
        if (use_sink) lsum += exp2f(sink_log2 - m);
        const float inv = 1.f / lsum;
#pragma unroll
        for (int d = 0; d < 64; ++d) Orow0[(size_t)tid * D + d] = (bf16_t)f2bf(o[d] * inv);
    }
    __syncthreads();
}
__device__ __forceinline__ void ph_attn(KP p, int l, unsigned char* lds) {
    hgrn_scan(p);
    bf16_t* Y = (bf16_t*)(p->ws + Z_YCAT);
    const bf16_t* Qg = (const bf16_t*)(p->ws + Z_QG); const bf16_t* Qw = (const bf16_t*)(p->ws + Z_QW); const bf16_t* Qgc = (const bf16_t*)(p->ws + Z_QGC); const bf16_t* Qwc = (const bf16_t*)(p->ws + Z_QWC);
    const bf16_t* Kg = (const bf16_t*)(p->ws + Z_KG); const bf16_t* Kw = (const bf16_t*)(p->ws + Z_KW); const bf16_t* Vg = (const bf16_t*)(p->ws + Z_VG); const bf16_t* Vw = (const bf16_t*)(p->ws + Z_VW);
    const int nunits = 512 + (l == 0 ? 16 : 0);
    for (int u = bid_(); u < nunits; u += gsz_()) {
        if (u < 256) {
            const int qb = u & 31, h = (u >> 5) & 3, b = u >> 7, row0 = b * NSEQ + qb * 256;
            attn_simple_unit(lds, Qg + (size_t)row0 * 256 + h * 64, Kg + (size_t)b * NKEY * 128 + (h >> 1) * 64, Vg + (size_t)b * NKEY * 128 + (h >> 1) * 64, 0, NKEY / 64, 0, qb * 256, false, 0.f, Y + (size_t)row0 * D + h * 64);
        } else if (u < 512) {
            const int v = u - 256, qb = v & 31, h = (v >> 5) & 3, b = v >> 7, row0 = b * NSEQ + qb * 256;
            attn_simple_unit(lds, Qw + (size_t)row0 * 256 + h * 64, Kw + (size_t)b * NKEY * 128 + (h >> 1) * 64, Vw + (size_t)b * NKEY * 128 + (h >> 1) * 64, 1, 12, 0, qb * 256, true, p->in[14][l * 4 + h] * LOG2E, Y + (size_t)row0 * D + 512 + h * 64);
        } else {
            const int v = u - 512, h = v & 3, b = (v >> 2) & 1, win = v >> 3, row0 = R_LAT + b * NCTX;
            const bf16_t* Qc = (win ? Qwc : Qgc) + (size_t)(b * NCTX) * 256 + h * 64;
            const bf16_t* Kc = (win ? Kw : Kg) + (size_t)b * NKEY * 128 + (h >> 1) * 64; const bf16_t* Vc = (win ? Vw : Vg) + (size_t)b * NKEY * 128 + (h >> 1) * 64;
            attn_simple_unit(lds, Qc, Kc, Vc, 0, 4, NSEQ, 0, win != 0, p->in[14][l * 4 + h] * LOG2E, Y + (size_t)row0 * D + (win ? 512 : 0) + h * 64);
        }
    }
}

namespace attn_body {
using bf16=__hip_bfloat16;
using bf16x8=__attribute__((ext_vector_type(8)))short;
using s16x4=__attribute__((ext_vector_type(4)))short;
using f32x16=__attribute__((ext_vector_type(16)))float;
using u32x4=__attribute__((ext_vector_type(4)))unsigned;
constexpr int D=64, QP=256, KP=128, OP=1024;
constexpr int NW=8,QBLK=32,QB=QBLK*NW,KVBLK=64;
__device__ __forceinline__ int crow(int r,int hi){return (r&3)+8*(r>>2)+4*hi;}
#define SBAR() __builtin_amdgcn_sched_barrier(0)
__device__ __forceinline__ void wmask(f32x16&p0,f32x16&p1,int tb,int qrel,int hi,int q0){
  const float NEG=-INFINITY; const int kb=64*tb+4*hi;
  #pragma unroll
  for(int r=0;r<16;++r){const int kl=kb+(r&3)+8*(r>>2); const int kp=q0-128+kl;
    if(kl<qrel||kl>qrel+256||kp<0||kp>=NSEQ)p0[r]=NEG;
    if(kl+32<qrel||kl+32>qrel+256||kp+32<0||kp+32>=NSEQ)p1[r]=NEG;}
}

constexpr int NSLOT=3, SLOTB=8192;
constexpr int LDS_K=0, LDS_V=NSLOT*SLOTB, LDS_WS=2*NSLOT*SLOTB, LDS_OST=LDS_WS+NW*64*4, LDS_BYTES=LDS_OST+NW*4096;
constexpr float C2=0.125f*1.4426950408889634f;
__device__ __forceinline__ void glds16(const void*gsrc,unsigned lds_dst){unsigned keep;
  asm volatile("s_mov_b32 %0, m0\n\ts_mov_b32 m0, %2\n\ts_nop 0\n\tglobal_load_lds_dwordx4 %1, off\n\ts_mov_b32 m0, %0":"=&s"(keep):"v"(gsrc),"s"(lds_dst):"memory");}
__device__ __forceinline__ float max3f(float a,float b,float c){float r;asm("v_max3_f32 %0, %1, %2, %3":"=v"(r):"v"(a),"v"(b),"v"(c));return r;}
__device__ __forceinline__ float max2f(float a,float b){float r;asm("v_max_f32_e32 %0, %1, %2":"=v"(r):"v"(a),"v"(b));return r;}
__device__ __forceinline__ float fadd_s(float a,float b){float r;asm("v_add_f32_e32 %0, %1, %2":"=v"(r):"v"(a),"v"(b));return r;}
__device__ __forceinline__ float fsub_s(float a,float b){float r;asm("v_sub_f32_e32 %0, %1, %2":"=v"(r):"v"(a),"v"(b));return r;}
typedef float f32x2_t __attribute__((ext_vector_type(2))); typedef __bf16 bf16x2_t __attribute__((ext_vector_type(2)));
__device__ __forceinline__ unsigned cvtpk_s(float lo,float hi){f32x2_t v={lo,hi};bf16x2_t b=__builtin_convertvector(v,bf16x2_t);return __builtin_bit_cast(unsigned,b);}
#define WAIT_BAR(N) asm volatile("s_waitcnt vmcnt(" #N ") lgkmcnt(0)\n\ts_barrier":::"memory")

__device__ __forceinline__ void qkt(f32x16&p0,f32x16&p1,const char*Kslot,const bf16x8*qr,const f32x16&negm,int r32,int hi){
  const char*kb=Kslot+hi*1024+r32*16;
  #pragma unroll
  for(int d0=0;d0<4;++d0){
    const bf16x8 b0=*reinterpret_cast<const bf16x8*>(kb+d0*2048);
    const bf16x8 b1=*reinterpret_cast<const bf16x8*>(kb+d0*2048+512);
    if(d0==0){p0=__builtin_amdgcn_mfma_f32_32x32x16_bf16(b0,qr[0],negm,0,0,0);p1=__builtin_amdgcn_mfma_f32_32x32x16_bf16(b1,qr[0],negm,0,0,0);}
    else{p0=__builtin_amdgcn_mfma_f32_32x32x16_bf16(b0,qr[d0],p0,0,0,0);p1=__builtin_amdgcn_mfma_f32_32x32x16_bf16(b1,qr[d0],p1,0,0,0);}}
}
typedef __attribute__((address_space(3))) const char* lds_cptr;
typedef short v4i16_t __attribute__((ext_vector_type(4)));
__device__ __forceinline__ void kload8(bf16x8*kf,lds_cptr kp){
  kf[0]=*(const __attribute__((address_space(3))) bf16x8*)(kp);      kf[1]=*(const __attribute__((address_space(3))) bf16x8*)(kp+512);
  kf[2]=*(const __attribute__((address_space(3))) bf16x8*)(kp+2048); kf[3]=*(const __attribute__((address_space(3))) bf16x8*)(kp+2560);
  kf[4]=*(const __attribute__((address_space(3))) bf16x8*)(kp+4096); kf[5]=*(const __attribute__((address_space(3))) bf16x8*)(kp+4608);
  kf[6]=*(const __attribute__((address_space(3))) bf16x8*)(kp+6144); kf[7]=*(const __attribute__((address_space(3))) bf16x8*)(kp+6656);
}
__device__ __forceinline__ void kload2(bf16x8*kf,lds_cptr kp,int j){ kf[2*j]=*(const __attribute__((address_space(3))) bf16x8*)(kp+j*2048); kf[2*j+1]=*(const __attribute__((address_space(3))) bf16x8*)(kp+j*2048+512); }
__device__ __forceinline__ s16x4 vtr(lds_cptr p){ return __builtin_bit_cast(s16x4,__builtin_amdgcn_ds_read_tr16_b64_v4i16((__attribute__((address_space(3))) v4i16_t*)p)); }
__device__ __forceinline__ float rowmax(const f32x16&p0,const f32x16&p1){
  float a=max3f(p0[0],p0[1],p1[0]),b=max3f(p0[2],p0[3],p1[1]);a=max3f(a,p1[2],p1[3]);
  #pragma unroll
  for(int r=4;r<16;r+=4){a=max3f(a,p0[r],p0[r+1]);b=max3f(b,p0[r+2],p0[r+3]);a=max3f(a,p1[r],p1[r+1]);b=max3f(b,p1[r+2],p1[r+3]);}
  const float m=max2f(a,b);
  auto rr=__builtin_amdgcn_permlane32_swap(__float_as_uint(m),__float_as_uint(m),false,false);
  return max2f(__uint_as_float(rr[0]),__uint_as_float(rr[1]));
}
__device__ __forceinline__ void pv(f32x16*o,int vb,bf16x8 pa0,bf16x8 pa1,bf16x8 pa2,bf16x8 pa3){
  #pragma unroll
  for(int d0=0;d0<2;++d0){s16x4 lo[4],hi[4];
    #pragma unroll
    for(int ks=0;ks<4;++ks){
      asm volatile("ds_read_b64_tr_b16 %0,%1 offset:%c2":"=&v"(lo[ks]):"v"(vb),"i"(d0*4096+ks*1024):"memory");
      asm volatile("ds_read_b64_tr_b16 %0,%1 offset:%c2":"=&v"(hi[ks]):"v"(vb),"i"(d0*4096+ks*1024+512):"memory");}
    asm volatile("s_waitcnt lgkmcnt(0)":::"memory");SBAR();
    #define PK(k) (bf16x8){lo[k][0],lo[k][1],lo[k][2],lo[k][3],hi[k][0],hi[k][1],hi[k][2],hi[k][3]}
    o[d0]=__builtin_amdgcn_mfma_f32_32x32x16_bf16(pa0,PK(0),o[d0],0,0,0);
    o[d0]=__builtin_amdgcn_mfma_f32_32x32x16_bf16(pa1,PK(1),o[d0],0,0,0);
    o[d0]=__builtin_amdgcn_mfma_f32_32x32x16_bf16(pa2,PK(2),o[d0],0,0,0);
    o[d0]=__builtin_amdgcn_mfma_f32_32x32x16_bf16(pa3,PK(3),o[d0],0,0,0);
    #undef PK
  }
}

#ifndef ATTN_STORE16
#define ATTN_STORE16(p,v) (*(u32x4*)(p)=(v))
#endif
template<int MODE,int NMASKT,int THRL> __device__ __forceinline__ void attn_unit(const bf16*Q0,const bf16*__restrict__ Kh,const bf16*__restrict__ Vh,bf16*O0,int NT,int key_first,int q0,bool use_sink,float sink_l2,char*shm){
  const int tid=tid_(),lane=tid&63,r32=lane&31,hi=lane>>5; const int wid=__builtin_amdgcn_readfirstlane(tid>>6);
  const bf16*Qw=Q0+(long)(wid*QBLK)*QP;
  auto krow=[&](int t)->long{ if(MODE==0) return (long)key_first+64*t; if(t<4) return (long)NSEQ+64*t; int p=q0-128+64*(t-4); p=p<0?0:(p>NSEQ-64?NSEQ-64:p); return (long)p; };
  const unsigned lds0=(unsigned)(uintptr_t)shm;
  float*wsf=(float*)(shm+LDS_WS)+wid*64;
  const bf16*ksrc=Kh+(long)lane*KP+wid*8;
  const bf16*vsrc=Vh+(long)(16*(wid&3)+(lane>>2))*KP+(wid>>2)*32+(lane&3)*8;
  const unsigned kdst=lds0+LDS_K+wid*1024, vdst=lds0+LDS_V+wid*1024;
  #define DMA_K(t,slot) glds16(ksrc+krow(t)*KP,(unsigned)__builtin_amdgcn_readfirstlane(kdst+(slot)))
  #define DMA_V(t,slot) glds16(vsrc+krow(t)*KP,(unsigned)__builtin_amdgcn_readfirstlane(vdst+(slot)))
  const int vb0=(int)(lds0+LDS_V)+((lane>>4)&1)*32+(lane&3)*8+(4*hi+((lane&15)>>2))*64;
  const char*Kbase=shm+LDS_K; bf16x8 kf[8];
  const lds_cptr shm3=(lds_cptr)shm; const lds_cptr kp0=shm3+LDS_K+hi*1024+r32*16; const lds_cptr vp0=shm3+LDS_V+((lane>>4)&1)*32+(lane&3)*8+(4*hi+((lane&15)>>2))*64;
  DMA_K(0,0);DMA_V(0,0);DMA_K(1,SLOTB);
  bf16x8 qr[4];
  #pragma unroll
  for(int d0=0;d0<4;++d0)qr[d0]=*reinterpret_cast<const bf16x8*>(&Qw[(long)r32*QP+d0*16+hi*8]);
  float mhat=0.f,l_reg=0.f;f32x16 o[2];o[0]=f32x16{};o[1]=f32x16{};f32x16 negm=f32x16{};asm volatile("":"+v"(negm));
  const int qrel=wid*QBLK+r32;
  #define CMASK(P0,P1,t) do{ if(NMASKT>0){int jb_=(t)-(NT-NMASKT); if(jb_>=0)wmask(P0,P1,jb_,qrel,hi,q0);} }while(0)
  bool resc=false;
  #define START(P0,P1) do{ const float rm=rowmax(P0,P1); resc=false; \
    { const float dl=rm; mhat=fadd_s(mhat,dl); \
      _Pragma("unroll") for(int r=0;r<16;++r){P0[r]=fsub_s(P0[r],dl);P1[r]=fsub_s(P1[r],dl);} \
      _Pragma("unroll") for(int r=0;r<16;++r)negm[r]=-mhat; asm volatile("":"+v"(negm)); } \
    _Pragma("unroll") for(int r=0;r<16;++r)P0[r]=__builtin_amdgcn_exp2f(P0[r]); }while(0)
  #define RESC() do{ if(resc){ asm volatile("s_waitcnt lgkmcnt(0)":::"memory"); \
      _Pragma("unroll") for(int d_=0;d_<2;++d_) _Pragma("unroll") for(int r=0;r<16;++r)o[d_][r]*=wsf[crow(r,hi)]; } }while(0)
  f32x16 pA0,pA1,pB0,pB1;
  int sl_prev=0,sl_cur=0,sl_next=SLOTB;
  #define ROT() do{sl_prev=sl_cur;sl_cur=sl_next;sl_next=(sl_next==(NSLOT-1)*SLOTB)?0:sl_next+SLOTB;}while(0)
  DMA_K(2,2*SLOTB);
  WAIT_BAR(3);
  qkt(pA0,pA1,Kbase,qr,negm,r32,hi);asm volatile("s_nop 15\n\ts_nop 7":"+v"(pA0),"+v"(pA1));CMASK(pA0,pA1,0);
  START(pA0,pA1);
  _Pragma("unroll") for(int r=0;r<16;++r)pA1[r]=__builtin_amdgcn_exp2f(pA1[r]);
  WAIT_BAR(0);
  DMA_K(3,0);DMA_V(1,SLOTB);
  ROT();
  kload8(kf,kp0+sl_cur);
  WAIT_BAR(2);
  s16x4 vlo[8],vhi[8]; u32x4 pw0,pw1,pw2,pw3;
  #define PKW(P,B) cvtpk_s(P[B],P[B+1])
  #define PAF(k) __builtin_bit_cast(bf16x8,pw##k)
  #define VFR(i) (bf16x8){vlo[i][0],vlo[i][1],vlo[i][2],vlo[i][3],vhi[i][0],vhi[i][1],vhi[i][2],vhi[i][3]}
  #define PIN(x) asm volatile("":"+v"(x))
  #define MX3(a,b,c) __builtin_fmaxf(__builtin_fmaxf((a),(b)),(c))
  #define GAPA(MF,A0,A1,A2,A3,W0,W1,PW) do{ MF; sacc+=A0; sacc+=A1; sacc+=A2; sacc+=A3; PIN(sacc); W0; W1; PIN(PW); SBAR(); }while(0)
  #define EX(v) __builtin_amdgcn_exp2f(v)
  #define GAPB(MF,X,B) do{ MF; X[B]=EX(X[B]); X[B+1]=EX(X[B+1]); X[B+2]=EX(X[B+2]); X[B+3]=EX(X[B+3]); PIN(X); SBAR(); }while(0)
  #define VRD(i) do{ vlo[i]=vtr(vp_+(((i)>>2)*4096+((i)&3)*1024)); vhi[i]=vtr(vp_+(((i)>>2)*4096+((i)&3)*1024+512)); }while(0)
  #define KRD(G,j) do{ if(G){ kload2(kf,kp0+sl_next,j); SBAR(); } }while(0)
  #define STEP(C0,C1,P0,P1,t,GK,GV,GL) do{ SBAR(); \
    const lds_cptr vp_=vp0+sl_prev; \
    VRD(0); SBAR(); float sacc=(P0[0]+P0[1]); \
    GAPA(C0=__builtin_amdgcn_mfma_f32_32x32x16_bf16(kf[0],qr[0],negm,0,0,0), P0[2],P0[3],P0[4],P0[5],     pw0[0]=PKW(P0,0), pw0[1]=PKW(P0,2), pw0); \
    VRD(4); SBAR(); GAPA(C1=__builtin_amdgcn_mfma_f32_32x32x16_bf16(kf[1],qr[0],negm,0,0,0), P0[6],P0[7],P0[8],P0[9],     pw0[2]=PKW(P0,4), pw0[3]=PKW(P0,6), pw0); \
    VRD(1); SBAR(); GAPA(C0=__builtin_amdgcn_mfma_f32_32x32x16_bf16(kf[2],qr[1],C0,0,0,0),   P0[10],P0[11],P0[12],P0[13], pw1[0]=PKW(P0,8), pw1[1]=PKW(P0,10), pw1); \
    VRD(5); SBAR(); GAPA(C1=__builtin_amdgcn_mfma_f32_32x32x16_bf16(kf[3],qr[1],C1,0,0,0),   P0[14],P0[15],P1[0],P1[1],   pw1[2]=PKW(P0,12),pw1[3]=PKW(P0,14), pw1); \
    VRD(2); SBAR(); GAPA(C0=__builtin_amdgcn_mfma_f32_32x32x16_bf16(kf[4],qr[2],C0,0,0,0),   P1[2],P1[3],P1[4],P1[5],     pw2[0]=PKW(P1,0), pw2[1]=PKW(P1,2), pw2); \
    VRD(6); SBAR(); GAPA(C1=__builtin_amdgcn_mfma_f32_32x32x16_bf16(kf[5],qr[2],C1,0,0,0),   P1[6],P1[7],P1[8],P1[9],     pw2[2]=PKW(P1,4), pw2[3]=PKW(P1,6), pw2); \
    VRD(3); SBAR(); GAPA(C0=__builtin_amdgcn_mfma_f32_32x32x16_bf16(kf[6],qr[3],C0,0,0,0),   P1[10],P1[11],P1[12],P1[13], pw3[0]=PKW(P1,8), pw3[1]=PKW(P1,10), pw3); \
    VRD(7); SBAR(); GAPA(C1=__builtin_amdgcn_mfma_f32_32x32x16_bf16(kf[7],qr[3],C1,0,0,0),   P1[14],P1[15],0.f,0.f,       pw3[2]=PKW(P1,12),pw3[3]=PKW(P1,14), pw3); \
    l_reg+=sacc; \
    if(GK){DMA_K((t)+3,sl_cur);} if(GV){DMA_V((t)+1,sl_next);} \
    CMASK(C0,C1,t); \
    { float a=MX3(C0[0],C0[1],C1[0]),b=MX3(C0[2],C0[3],C1[1]); a=MX3(a,C1[2],C1[3]); \
      _Pragma("unroll") for(int r=4;r<16;r+=4){a=MX3(a,C0[r],C0[r+1]);b=MX3(b,C0[r+2],C0[r+3]);a=MX3(a,C1[r],C1[r+1]);b=MX3(b,C1[r+2],C1[r+3]);} \
      float rm=__builtin_fmaxf(a,b); { auto rr=__builtin_amdgcn_permlane32_swap(__float_as_uint(rm),__float_as_uint(rm),false,false); rm=__builtin_fmaxf(__uint_as_float(rr[0]),__uint_as_float(rr[1])); } \
      resc=false; \
      if(__builtin_expect(__any(rm>(float)THRL),0)){ const float dl=__builtin_fmaxf(rm,0.f); mhat+=dl; \
        _Pragma("unroll") for(int r=0;r<16;++r){C0[r]-=dl;C1[r]-=dl;} \
        _Pragma("unroll") for(int r=0;r<16;++r)negm[r]=-mhat; asm volatile("":"+v"(negm)); \
        const float f=__builtin_amdgcn_exp2f(-dl); l_reg*=f; if(hi==0)wsf[r32]=f; resc=true; } } \
    SBAR(); \
    GAPB(o[0]=__builtin_amdgcn_mfma_f32_32x32x16_bf16(PAF(0),VFR(0),o[0],0,0,0), C0,0); \
    GAPB(o[1]=__builtin_amdgcn_mfma_f32_32x32x16_bf16(PAF(0),VFR(4),o[1],0,0,0), C0,4); \
    KRD(GL,0); GAPB(o[0]=__builtin_amdgcn_mfma_f32_32x32x16_bf16(PAF(1),VFR(1),o[0],0,0,0), C0,8); \
    KRD(GL,1); GAPB(o[1]=__builtin_amdgcn_mfma_f32_32x32x16_bf16(PAF(1),VFR(5),o[1],0,0,0), C0,12); \
    KRD(GL,2); GAPB(o[0]=__builtin_amdgcn_mfma_f32_32x32x16_bf16(PAF(2),VFR(2),o[0],0,0,0), C1,0); \
    KRD(GL,3); GAPB(o[1]=__builtin_amdgcn_mfma_f32_32x32x16_bf16(PAF(2),VFR(6),o[1],0,0,0), C1,4); \
    GAPB(o[0]=__builtin_amdgcn_mfma_f32_32x32x16_bf16(PAF(3),VFR(3),o[0],0,0,0), C1,8); \
    GAPB(o[1]=__builtin_amdgcn_mfma_f32_32x32x16_bf16(PAF(3),VFR(7),o[1],0,0,0), C1,12); \
    }while(0)
  int t=1;
  #undef CMASK
  #define CMASK(P0,P1,t) do{}while(0)
  for(;t+1+(NMASKT>4?NMASKT:4)<NT;t+=2){
    STEP(pB0,pB1,pA0,pA1,t,true,true,true);     WAIT_BAR(2); RESC(); ROT();
    STEP(pA0,pA1,pB0,pB1,t+1,true,true,true);   WAIT_BAR(2); RESC(); ROT();
  }
  #undef CMASK
  #define CMASK(P0,P1,t) do{ if(NMASKT>0){int jb_=(t)-(NT-NMASKT); if(jb_>=0)wmask(P0,P1,jb_,qrel,hi,q0);} }while(0)
  #define ENDW(tt) do{ if((tt)+3<NT){WAIT_BAR(2);} else if((tt)+2<NT){WAIT_BAR(1);} else {WAIT_BAR(0);} }while(0)
  for(;t+1<NT;t+=2){
    STEP(pB0,pB1,pA0,pA1,t,(t+3<NT),(t+1<NT),(t+1<NT));       ENDW(t);   RESC(); ROT();
    STEP(pA0,pA1,pB0,pB1,t+1,(t+4<NT),(t+2<NT),(t+2<NT));     ENDW(t+1); RESC(); ROT();
  }
  STEP(pB0,pB1,pA0,pA1,NT-1,false,false,false); RESC();
  { float sacc=pB0[0]+pB0[1]; _Pragma("unroll") for(int r=2;r<16;++r)sacc+=pB0[r]; _Pragma("unroll") for(int r=0;r<16;++r)sacc+=pB1[r]; l_reg+=sacc;
    pw0=(u32x4){PKW(pB0,0),PKW(pB0,2),PKW(pB0,4),PKW(pB0,6)};pw1=(u32x4){PKW(pB0,8),PKW(pB0,10),PKW(pB0,12),PKW(pB0,14)};pw2=(u32x4){PKW(pB1,0),PKW(pB1,2),PKW(pB1,4),PKW(pB1,6)};pw3=(u32x4){PKW(pB1,8),PKW(pB1,10),PKW(pB1,12),PKW(pB1,14)};
    SBAR(); pv(o,vb0+sl_cur,PAF(0),PAF(1),PAF(2),PAF(3)); }
  #undef PKW
  #undef PAF
  #undef VFR
  #undef PIN
  #undef MX3
  #undef GAPA
  #undef GAPB
  #undef EX
  #undef VRD
  #undef KRD
  #undef STEP
  #undef ENDW
  {auto rr=__builtin_amdgcn_permlane32_swap(__float_as_uint(l_reg),__float_as_uint(l_reg),false,false);l_reg=__uint_as_float(rr[0])+__uint_as_float(rr[1]);}
  if(use_sink)l_reg+=__builtin_amdgcn_exp2f(sink_l2-mhat);
  if(hi==0)wsf[32+r32]=l_reg;asm volatile("s_waitcnt lgkmcnt(0)":::"memory");
  float rli[16];
  #pragma unroll
  for(int r=0;r<16;++r)rli[r]=__builtin_amdgcn_rcpf(wsf[32+crow(r,hi)]);
  bf16*Ow=O0+(long)(wid*QBLK)*OP;
  { bf16*stg=(bf16*)(shm+LDS_OST)+wid*2048;
    #pragma unroll
    for(int r=0;r<16;++r){const int orow=crow(r,hi);
      #pragma unroll
      for(int d0=0;d0<2;++d0)stg[orow*64+d0*32+r32]=__float2bfloat16(o[d0][r]*rli[r]);}
    asm volatile("s_waitcnt lgkmcnt(0)":::"memory");
    #pragma unroll
    for(int i=0;i<4;++i){const int row=i*8+(lane>>3),ch=lane&7; const u32x4 v=*(const u32x4*)(stg+row*64+ch*8); ATTN_STORE16(Ow+(long)row*OP+ch*8,v);} }
  asm volatile("s_waitcnt lgkmcnt(0)\n\ts_barrier":::"memory");
  #undef DMA_K
  #undef DMA_V
  #undef CMASK
  #undef START
  #undef RESC
  #undef ROT
}
constexpr int ATTN_LDS_BYTES=LDS_BYTES;
#undef SBAR
#undef WAIT_BAR
}

__device__ __forceinline__ void ph_attn_f(KP p, int l, unsigned char* lds, bool do_scan = true) {
    if (do_scan) { if (FAST_HGRN) hgrn_scan_f(p); else hgrn_scan(p); }
    using attn_body::bf16;
    bf16* Y = (bf16*)(p->ws + Z_YCAT);
    const bf16* Qg = (const bf16*)(p->ws + Z_QG); const bf16* Qw = (const bf16*)(p->ws + Z_QW); const bf16* Qgc = (const bf16*)(p->ws + Z_QGC); const bf16* Qwc = (const bf16*)(p->ws + Z_QWC);
    const bf16* Kg = (const bf16*)(p->ws + Z_KG); const bf16* Kw = (const bf16*)(p->ws + Z_KW); const bf16* Vg = (const bf16*)(p->ws + Z_VG); const bf16* Vw = (const bf16*)(p->ws + Z_VW);
    const int G = gsz_(), bid = bid_();
    __syncthreads();
    for (int vb = bid; vb < 256; vb += G) {
        const int v = (G == 256) ? (((vb & 7) >> 1) * 64 + (vb & 1) * 32 + (vb >> 3)) : vb;
        const int b = v >> 7, kvh = (v >> 6) & 1, h = kvh * 2 + ((v >> 5) & 1), qb = v & 31, row0 = b * NSEQ + qb * 256;
        const size_t kvo = (size_t)b * NKEY * 128 + kvh * 64;
        attn_body::attn_unit<0, 0, 8>(Qg + (size_t)row0 * 256 + h * 64, Kg + kvo, Vg + kvo, Y + (size_t)row0 * D + h * 64, NKEY / 64, 0, 0, false, 0.f, (char*)lds);
        attn_body::attn_unit<1, 8, 8>(Qw + (size_t)row0 * 256 + h * 64, Kw + kvo, Vw + kvo, Y + (size_t)row0 * D + 512 + h * 64, 12, 0, qb * 256, true, p->in[14][l * 4 + h] * LOG2E, (char*)lds);
    }
    if (l == 0) for (int v = bid; v < 16; v += G) {
        const int h = v & 3, b = (v >> 2) & 1, win = v >> 3, row0 = R_LAT + b * NCTX;
        const size_t kvo = (size_t)b * NKEY * 128 + (h >> 1) * 64;
        attn_body::attn_unit<0, 0, 8>((win ? Qwc : Qgc) + (size_t)(b * NCTX) * 256 + h * 64, (win ? Kw : Kg) + kvo, (win ? Vw : Vg) + kvo, Y + (size_t)row0 * D + (win ? 512 : 0) + h * 64, 4, NSEQ, 0, win != 0, p->in[14][l * 4 + h] * LOG2E, (char*)lds);
    }
}

__device__ __forceinline__ void hgrn_pass3_unit(KP p, int l, unsigned char* lds, int unit) {
    float* qs = (float*)lds; float* vs = qs + 4096; float* ks = vs + 4096; float* cs = ks + 4096; float* Ss = cs + 4096; float* sc = Ss + 4096; float* os = sc + 4096;
    const int tid = tid_(), lane = tid & 63, wid = tid >> 6;
    const int cpos = unit % NCHUNK, head = (unit / NCHUNK) & 3, b = unit / (NCHUNK * 4);
    const int row0 = (cpos < 4) ? R_LAT + b * NCTX + cpos * 64 : b * NSEQ + (cpos - 4) * 64;
    for (int i = tid; i < 4096; i += NTHREADS) os[i] = 0.f;
    for (int dir = 0; dir < 2; ++dir) {
        const int j = (cpos < 4) ? (dir ? 3 - cpos : cpos) : 4 + (dir ? 127 - (cpos - 4) : (cpos - 4));
        const int seq = (b * 4 + head) * 2 + dir;
        __syncthreads();
        hgrn_load_chunk(p, l, row0, dir, head, qs, vs, ks, cs);
        const float* Sg = (const float*)(p->ws + Z_U) + ((size_t)seq * NCHUNK + j) * 4096;
        for (int i = tid; i < 4096; i += NTHREADS) Ss[i] = Sg[i];
        for (int i = tid; i < 4096; i += NTHREADS) { const int tau = i >> 6, sig = i & 63; float a = 0.f;
            if (sig <= tau) { for (int d = 0; d < 64; ++d) a += qs[tau * 64 + d] * ks[sig * 64 + d] * __expf(cs[tau * 64 + d] - cs[sig * 64 + d]); }
            sc[i] = a; }
        __syncthreads();
        { const int tau = tid >> 3, e0 = (tid & 7) * 8; float acc[8];
#pragma unroll
          for (int e = 0; e < 8; ++e) acc[e] = 0.f;
          for (int d = 0; d < 64; ++d) { const float qv = qs[tau * 64 + d] * __expf(cs[tau * 64 + d]);
#pragma unroll
              for (int e = 0; e < 8; ++e) acc[e] += qv * Ss[d * 64 + e0 + e]; }
          for (int sig = 0; sig <= tau; ++sig) { const float sv = sc[tau * 64 + sig];
#pragma unroll
              for (int e = 0; e < 8; ++e) acc[e] += sv * vs[sig * 64 + e0 + e]; }
          const int tok = dir ? 63 - tau : tau;
#pragma unroll
          for (int e = 0; e < 8; ++e) os[tok * 64 + e0 + e] += acc[e]; }
        __syncthreads();
    }
    const bf16_t* P = (const bf16_t*)(p->ws + Z_P); bf16_t* Y = (bf16_t*)(p->ws + Z_YCAT);
    for (int tok = wid; tok < 64; tok += 8) { const float v = os[tok * 64 + lane];
        const float y = v * rsqrtf(wave_sum(v * v) * (1.f / 64.f) + EPS) * p->in[22][l * 64 + lane];
        const float g = bf2f(P[(size_t)(row0 + tok) * DIN + C_RG + head * 64 + lane]);
        Y[(size_t)(row0 + tok) * D + 768 + head * 64 + lane] = (bf16_t)f2bf(y * silu_(g)); }
    __syncthreads();
}
__device__ __forceinline__ void ph_hgrn3(KP p, int l, unsigned char* lds) {
    hgrn_pass3_run(p, l, lds);
    if (l == 0 && DEPTH > 1 && gsz_() == 256) { __syncthreads(); ph_cvt(p, 1, lds, 32, 224, CVT_E1, CVT_E2); }
}

__device__ __forceinline__ void ph_outproj(KP p, int l, unsigned char* lds) {
    const bf16_t* A = (const bf16_t*)(p->ws + Z_YCAT); const bf16_t* Bt = (const bf16_t*)(p->ws + Z_WOUT); float* X = (float*)(p->ws + WS_X);
    const int T = (l == 0) ? R_ALL : R_LAT; const int TM = T / 128, TN = 8;
    for (int it = bid_(); it < TM * TN; it += gsz_()) { const int mt = it / TN, nt = it % TN;
        auto epi = [&](int row, int col, float v, float) { const int c = nt * 128 + col; X[(size_t)row * D + c] = xrow_src(p, l, row)[c] + mod_vec(p, l, row, 2)[c] * v; };
        gemm_simple_tile<1>(A, RowId{}, Bt, 1024, mt * 128, nt * 128, 0, epi); }
}

__device__ __forceinline__ void ph_norm2(KP p, int l, unsigned char* lds, int cnt_off = 0) {
    constexpr int RS = 1032, NSTG = 80;
    const int T = (l == 0) ? R_ALL : R_LAT;
    bf16_t* AH = (bf16_t*)lds; bf16_t* AL = AH + 16 * RS;
    float* PART = (float*)(lds + 2 * 16 * RS * 2); float* LOG = PART + 8 * 16 * 64;
    int* hist = (int*)(LOG + 16 * 64); int* hbase = hist + 64; int* s_e = hbase + 64; int* s_r = s_e + NSTG * 8; float* s_w = (float*)(s_r + NSTG * 8); float* msb = s_w + NSTG * 8;
    const int tid = tid_(), lane = tid & 63, wid = tid >> 6, fr = lane & 15, fq = lane >> 4, bid = bid_(), G = gsz_();
    bf16_t* Tok = (bf16_t*)(p->ws + Z_A); const bf16_t* X = (const bf16_t*)(p->ws + WS_X);
    const float* g2 = p->in[7] + l * D; const float* rw = p->in[23] + (size_t)l * 1024 * 64; const float* rbias = p->in[24] + l * 64;
    unsigned* cnt = (unsigned*)(p->ws + WS_CTL) + CW_CNT + cnt_off + l * 64;
    int* tok_e = (int*)(p->ws + WS_TOKE); int* tok_p = (int*)(p->ws + WS_TOKP); int* expl = (int*)(p->ws + WS_EXPL); float* expw = (float*)(p->ws + WS_EXPW);
    bf16x8 bh[4][4], bl[4][4];
#pragma unroll
    for (int t = 0; t < 4; ++t)
#pragma unroll
        for (int k = 0; k < 4; ++k) { float v[8], lo[8];
#pragma unroll
            for (int j = 0; j < 8; ++j) v[j] = rw[(size_t)((wid * 4 + k) * 32 + fq * 8 + j) * 64 + t * 16 + fr];
            const u32x4 hh = pack8(v);
            const float hf[8] = {bf2f(hh.x & 0xffffu), bf2f(hh.x >> 16), bf2f(hh.y & 0xffffu), bf2f(hh.y >> 16), bf2f(hh.z & 0xffffu), bf2f(hh.z >> 16), bf2f(hh.w & 0xffffu), bf2f(hh.w >> 16)};
#pragma unroll
            for (int j = 0; j < 8; ++j) lo[j] = v[j] - hf[j];
            const u32x4 ll = pack8(lo);
            bh[t][k] = __builtin_bit_cast(bf16x8, hh); bl[t][k] = __builtin_bit_cast(bf16x8, ll); }
    const float mybias = rbias[lane];
    const int rpb = (T + G - 1) / G;
    for (int base = bid * rpb; base < T; base += G * rpb) {
        const int r1 = (base + rpb < T) ? base + rpb : T;
        if (tid < 64) hist[tid] = 0;
        for (int s0 = base; s0 < r1; s0 += 16) {
#pragma unroll
            for (int j2 = 0; j2 < 2; ++j2) { const int lr = wid * 2 + j2, row = s0 + lr;
                if (row < r1) {
                    const bf16_t* xrow = X + (size_t)row * D; const float* shift = mod_vec(p, l, row, 3); const float* scale = mod_vec(p, l, row, 4);
                    f32x4 v[4]; float ssq = 0.f;
#pragma unroll
                    for (int j = 0; j < 4; ++j) { const u32x2 r2 = ((const u32x2*)xrow)[lane + 64 * j]; v[j].x = bf2f(r2.x & 0xffffu); v[j].y = bf2f(r2.x >> 16); v[j].z = bf2f(r2.y & 0xffffu); v[j].w = bf2f(r2.y >> 16); ssq += v[j].x * v[j].x + v[j].y * v[j].y + v[j].z * v[j].z + v[j].w * v[j].w; }
                    const float rinv = rsqrtf(wave_sum(ssq) * (1.f / D) + EPS);
#pragma unroll
                    for (int j = 0; j < 4; ++j) { const int idx = lane + 64 * j;
                        const f32x4 gg = ((const f32x4*)g2)[idx], sh = ((const f32x4*)shift)[idx], sc = ((const f32x4*)scale)[idx];
                        f32x4 y; y.x = v[j].x * rinv * gg.x * (1.f + sc.x) + sh.x; y.y = v[j].y * rinv * gg.y * (1.f + sc.y) + sh.y;
                        y.z = v[j].z * rinv * gg.z * (1.f + sc.z) + sh.z; y.w = v[j].w * rinv * gg.w * (1.f + sc.w) + sh.w;
                        u32x2 h; h.x = pk2(y.x, y.y); h.y = pk2(y.z, y.w);
                        u32x2 lw; lw.x = pk2(y.x - bf2f(h.x & 0xffffu), y.y - bf2f(h.x >> 16)); lw.y = pk2(y.z - bf2f(h.y & 0xffffu), y.w - bf2f(h.y >> 16));
                        { int t8 = __builtin_amdgcn_cvt_pk_fp8_f32(clamp8(y.x * TOK8_SCALE), clamp8(y.y * TOK8_SCALE), 0, false); t8 = __builtin_amdgcn_cvt_pk_fp8_f32(clamp8(y.z * TOK8_SCALE), clamp8(y.w * TOK8_SCALE), t8, true);
                          ((unsigned*)((unsigned char*)Tok + (size_t)row * D))[idx] = (unsigned)t8; }
                        *(u32x2*)(AH + lr * RS + idx * 4) = h; *(u32x2*)(AL + lr * RS + idx * 4) = lw; }
                } else {
#pragma unroll
                    for (int j = 0; j < 4; ++j) { const int idx = lane + 64 * j; const u32x2 z = {0u, 0u}; *(u32x2*)(AH + lr * RS + idx * 4) = z; *(u32x2*)(AL + lr * RS + idx * 4) = z; } } }
            __syncthreads();
            { f32x4 acc[4];
#pragma unroll
              for (int t = 0; t < 4; ++t) acc[t] = (f32x4){0.f, 0.f, 0.f, 0.f};
#pragma unroll
              for (int k = 0; k < 4; ++k) { const int ko = (wid * 4 + k) * 32 + fq * 8;
                  const bf16x8 ah = *(const bf16x8*)(AH + fr * RS + ko), al = *(const bf16x8*)(AL + fr * RS + ko);
#pragma unroll
                  for (int t = 0; t < 4; ++t) { acc[t] = __builtin_amdgcn_mfma_f32_16x16x32_bf16(ah, bh[t][k], acc[t], 0, 0, 0);
                      acc[t] = __builtin_amdgcn_mfma_f32_16x16x32_bf16(ah, bl[t][k], acc[t], 0, 0, 0); acc[t] = __builtin_amdgcn_mfma_f32_16x16x32_bf16(al, bh[t][k], acc[t], 0, 0, 0); } }
#pragma unroll
              for (int t = 0; t < 4; ++t)
#pragma unroll
                  for (int r = 0; r < 4; ++r) PART[(wid * 16 + fq * 4 + r) * 64 + t * 16 + fr] = acc[t][r]; }
            __syncthreads();
#pragma unroll
            for (int q = 0; q < 2; ++q) { const int o = tid + q * NTHREADS; float a = 0.f;
#pragma unroll
                for (int w8 = 0; w8 < 8; ++w8) a += PART[w8 * 1024 + o];
                LOG[o] = a; }
            __syncthreads();
#pragma unroll 1
            for (int j2 = 0; j2 < 2; ++j2) { const int lr = wid * 2 + j2, row = s0 + lr;
                if (row >= r1) continue;
                const int sr = row - base;
                const float score = sigmoid_(LOG[lr * 64 + lane]), sel = score + mybias;
                const int e = lane, g = e >> 3;
                int rg = 0;
#pragma unroll
                for (int i = 1; i < 8; ++i) { const int src = (lane & ~7) | ((lane + i) & 7); const float o = __shfl(sel, src); rg += (o > sel) || (o == sel && src < e); }
                float top2 = (rg < 2) ? sel : 0.f;
                top2 += __shfl_xor(top2, 1); top2 += __shfl_xor(top2, 2); top2 += __shfl_xor(top2, 4);
                int grank = 0;
#pragma unroll
                for (int i = 1; i < 8; ++i) { const int og = (g + i) & 7; const float o = __shfl(top2, og * 8); grank += (o > top2) || (o == top2 && og < g); }
                const bool keep = grank < 4;
                const float ms = keep ? sel : -INFINITY;
                float* mrow = msb + wid * 64;
                mrow[lane] = ms;
                __builtin_amdgcn_wave_barrier();
                int rk = 0;
#pragma unroll 4
                for (int i = 0; i < 16; ++i) { const f32x4 o = *(const f32x4*)(mrow + 4 * i);
                    rk += (o.x > ms) || (o.x == ms && 4 * i + 0 < e); rk += (o.y > ms) || (o.y == ms && 4 * i + 1 < e);
                    rk += (o.z > ms) || (o.z == ms && 4 * i + 2 < e); rk += (o.w > ms) || (o.w == ms && 4 * i + 3 < e); }
                __builtin_amdgcn_wave_barrier();
                const bool chosen = keep && rk < 8;
                const float wsum = wave_sum(chosen ? score : 0.f);
                if (chosen) { const int r = atomicAdd(&hist[e], 1); s_e[sr * 8 + rk] = e; s_r[sr * 8 + rk] = r; s_w[sr * 8 + rk] = score / wsum * 2.5f; } }
        }
        __syncthreads();
        if (tid < 64) { const int h = hist[tid]; hbase[tid] = h ? (int)atomicAdd(&cnt[tid], (unsigned)h) : 0; }
        __syncthreads();
        for (int i = tid; i < (r1 - base) * 8; i += NTHREADS) { const int e = s_e[i]; const size_t o = (size_t)base * 8 + i;
            const int pos = hbase[e] + s_r[i]; tok_e[o] = e; tok_p[o] = pos; expl[(size_t)e * R_ALL + pos] = base + (i >> 3); expw[(size_t)e * R_ALL + pos] = s_w[i]; }
        __syncthreads();
    }
}

__device__ __forceinline__ void moe_pad_starts(KP p, int l, int* ps) {
    const unsigned* cnt = (const unsigned*)(p->ws + WS_CTL) + CW_CNT + l * 64;
    const int tid = tid_();
    if (tid < 64) { const int v = (int)((cnt[tid] + 255u) >> 8) << 8; int incl = v;
#pragma unroll
        for (int d = 1; d < 64; d <<= 1) { const int o = __shfl_up(incl, d); if (tid >= d) incl += o; }
        ps[tid] = incl - v; if (tid == 63) ps[64] = incl; }
    __syncthreads();
}
__device__ __forceinline__ int moe_expert_of_row(const int* ps, int row) { int e = 0; while (e < 63 && row >= ps[e + 1]) ++e; return e; }

__device__ __forceinline__ void ph_slots(KP p, int l, unsigned char* lds) {
    const int T = (l == 0) ? R_ALL : R_LAT;
    int* ps = (int*)lds; moe_pad_starts(p, l, ps);
    const unsigned* cnt = (const unsigned*)(p->ws + WS_CTL) + CW_CNT + l * 64;
    const int* tok_e = (const int*)(p->ws + WS_TOKE); const int* tok_p = (const int*)(p->ws + WS_TOKP); const float* tok_w = (const float*)(p->ws + WS_TOKW);
    int* tok_s = (int*)(p->ws + WS_TOKS); int* slot_t = (int*)(p->ws + WS_SLOTT); float* slot_w = (float*)(p->ws + WS_SLOTW);
    for (int i = bid_() * NTHREADS + tid_(); i < T * 8; i += gsz_() * NTHREADS) { const int e = tok_e[i], slot = ps[e] + tok_p[i]; tok_s[i] = slot; slot_t[slot] = i >> 3; slot_w[slot] = tok_w[i]; }
    for (int i = bid_() * NTHREADS + tid_(); i < T; i += gsz_() * NTHREADS) { slot_t[MAXSLOT + i] = i; slot_w[MAXSLOT + i] = 1.f; }
    for (int i = bid_() * NTHREADS + tid_(); i < 64 * 256; i += gsz_() * NTHREADS) { const int e = i >> 8, j = i & 255; const int r = ps[e] + (int)cnt[e] + j; if (r < ps[e + 1]) { slot_t[r] = 0; slot_w[r] = 0.f; } }
    __syncthreads();
}

__device__ __forceinline__ void ph_gateup(KP p, int l, unsigned char* lds) {
    const int T = (l == 0) ? R_ALL : R_LAT;
    int* ps = (int*)lds; moe_pad_starts(p, l, ps);
    const bf16_t* Tok = (const bf16_t*)(p->ws + Z_A); const bf16_t* Wgu = (const bf16_t*)(p->ws + Z_WGU); bf16_t* H = (bf16_t*)(p->ws + Z_H);
    const int* slot_t = (const int*)(p->ws + WS_SLOTT); const float* slot_w = (const float*)(p->ws + WS_SLOTW);
    const int n128 = ps[64] / 128, nitems = (n128 + T / 128) * 2;
    for (int it = bid_(); it < nitems; it += gsz_()) { const int rt = it >> 1, pn = it & 1;
        if (rt < n128) { const int e = moe_expert_of_row(ps, rt * 128);
            auto epi = [&](int row, int col, float g, float u) { H[(size_t)row * 256 + pn * 128 + col] = (bf16_t)f2bf(silu_(g) * u * slot_w[row]); };
            gemm_simple_tile<2>(Tok, RowGather{slot_t}, Wgu + (size_t)e * 524288, 1024, rt * 128, pn * 256, 128, epi);
        } else { const int t0 = (rt - n128) * 128;
            auto epi = [&](int row, int col, float g, float u) { H[(size_t)(MAXSLOT + row) * 256 + pn * 128 + col] = (bf16_t)f2bf(silu_(g) * u); };
            gemm_simple_tile<2>(Tok, RowId{}, Wgu + (size_t)64 * 524288, 1024, t0, pn * 256, 128, epi); }
    }
}
__device__ __forceinline__ void ph_down(KP p, int l, unsigned char* lds) {
    const int T = (l == 0) ? R_ALL : R_LAT;
    int* ps = (int*)lds; moe_pad_starts(p, l, ps);
    const bf16_t* H = (const bf16_t*)(p->ws + Z_H); const bf16_t* Wd = (const bf16_t*)(p->ws + WS_WD); bf16_t* Y = (bf16_t*)(p->ws + Z_Y); float* X = (float*)(p->ws + WS_X);
    const int n128 = ps[64] / 128, nitems = (n128 + T / 128) * 8;
    for (int it = bid_(); it < nitems; it += gsz_()) { const int rt = it >> 3, nt = it & 7;
        if (rt < n128) { const int e = moe_expert_of_row(ps, rt * 128);
            auto epi = [&](int row, int col, float v, float) { Y[(size_t)row * D + nt * 128 + col] = (bf16_t)f2bf(v); };
            gemm_simple_tile<1>(H, RowId{}, Wd + (size_t)e * 262144, 256, rt * 128, nt * 128, 0, epi);
        } else { const int t0 = (rt - n128) * 128;
            auto epi = [&](int row, int col, float v, float) { const int t = row - MAXSLOT, c = nt * 128 + col; X[(size_t)t * D + c] += mod_vec(p, l, t, 5)[c] * v; };
            gemm_simple_tile<1>(H, RowId{}, Wd + (size_t)64 * 262144, 256, MAXSLOT + t0, nt * 128, 0, epi); }
    }
}
__device__ __forceinline__ void ph_combine(KP p, int l, unsigned char* lds) {
    typedef float f32x2 __attribute__((ext_vector_type(2)));
    const int T = (l == 0) ? R_ALL : R_LAT;
    const int tid = tid_(), lane = tid & 63, wid = tid >> 6;
    const unsigned char* Y8 = (const unsigned char*)(p->ws + Z_Y); bf16_t* X = (bf16_t*)(p->ws + WS_X); const int* tok_e = (const int*)(p->ws + WS_TOKE); const int* tok_p = (const int*)(p->ws + WS_TOKP);
    int* ps = (int*)lds; moe_pad_starts(p, l, ps);
    const size_t yoff = (size_t)(lane >> 4) * MAXSLOT * 256 + (lane & 15) * 16;
    for (int row = bid_() * 8 + wid; row < T; row += gsz_() * 8) {
        const float* g5 = mod_vec(p, l, row, 5) + lane * 16;
        bf16_t* xr = X + (size_t)row * D + lane * 16;
        const int myslot = ps[tok_e[row * 8 + (lane & 7)]] + tok_p[row * 8 + (lane & 7)];
        u32x4 yv[8];
#pragma unroll
        for (int k = 0; k < 8; ++k) { const int sl = __shfl(myslot, k); yv[k] = *(const u32x4*)(Y8 + yoff + (size_t)sl * 256); }
        f32x4 xv[4], gv[4];
#pragma unroll
        for (int q = 0; q < 4; ++q) gv[q] = *(const f32x4*)(g5 + 4 * q);
        unpack8(*(const u32x4*)xr, xv[0], xv[1]); unpack8(*(const u32x4*)(xr + 8), xv[2], xv[3]);
        float a[16];
#pragma unroll
        for (int q = 0; q < 16; ++q) a[q] = 0.f;
#pragma unroll
        for (int k = 0; k < 8; ++k) { const unsigned w[4] = {yv[k].x, yv[k].y, yv[k].z, yv[k].w};
#pragma unroll
            for (int q = 0; q < 4; ++q) { const f32x2 lo = __builtin_amdgcn_cvt_pk_f32_fp8((int)w[q], false), hi = __builtin_amdgcn_cvt_pk_f32_fp8((int)w[q], true);
                a[4 * q] += lo.x; a[4 * q + 1] += lo.y; a[4 * q + 2] += hi.x; a[4 * q + 3] += hi.y; } }
#pragma unroll
        for (int q = 0; q < 4; ++q) { f32x4 av; av.x = a[4 * q]; av.y = a[4 * q + 1]; av.z = a[4 * q + 2]; av.w = a[4 * q + 3]; xv[q] = xv[q] + gv[q] * (av * (1.f / Y8_SCALE)); }
        if (l == DEPTH - 1) { float* dst = p->out + (size_t)row * D + lane * 16;
#pragma unroll
            for (int q = 0; q < 4; ++q) *(f32x4*)(dst + 4 * q) = xv[q]; }
        else { *(u32x4*)xr = (u32x4){pk2(xv[0].x, xv[0].y), pk2(xv[0].z, xv[0].w), pk2(xv[1].x, xv[1].y), pk2(xv[1].z, xv[1].w)};
               *(u32x4*)(xr + 8) = (u32x4){pk2(xv[2].x, xv[2].y), pk2(xv[2].z, xv[2].w), pk2(xv[3].x, xv[3].y), pk2(xv[3].z, xv[3].w)}; }
    }
}
struct MoeSched {
    int ntr, nrt, npn, G, c; const LAS int* tile_e;
    __device__ __forceinline__ bool map(int i, int& rt, int& pp) const {
        if (G == 256) { const int x = c & 7, j = c >> 3, tb = 32 / npn; rt = (i * 8 + x) * tb + j / npn; pp = j % npn; return rt < nrt; }
        const int L = i * G + c; if (L >= nrt * npn) return false;
        rt = L / npn; pp = L % npn; return true; }
    __device__ __forceinline__ bool next(int i, pg8::Unit& u) const {
        int rt, pp; if (!map(i, rt, pp)) return false;
        const bool routed = rt < ntr;
        const int e = routed ? __builtin_amdgcn_readfirstlane(tile_e[rt]) : 64;
        u.pm = routed ? rt : MAXSLOT / 256 + (rt - ntr); u.pn = e * npn + pp; u.ord = i; return true;
    }
};
constexpr int MOE_UNITS = 6;
constexpr int LDS_RTAB = 131072, LDS_WTAB = LDS_RTAB + MOE_UNITS * 1024, LDS_TILE_E = LDS_WTAB + MOE_UNITS * 1024, LDS_PS = LDS_TILE_E + 2400;
static_assert(LDS_PS + 129 * 4 <= LDS_BYTES - 16, "MoE tables fit above the staging buffers");
__device__ __forceinline__ MoeSched moe_setup(KP p, int l, unsigned char* lds, int npn, bool gather) {
    const int T = (l == 0) ? R_ALL : R_LAT;
    int* ps = (int*)(lds + LDS_PS); int* cl = ps + 65;
    const unsigned* cnt = (const unsigned*)(p->ws + WS_CTL) + CW_CNT + l * 64;
    const int tid = tid_();
    if (tid < 64) cl[tid] = (int)cnt[tid];
    moe_pad_starts(p, l, ps);
    LAS int* tile_e = (LAS int*)((LAS unsigned char*)lds + LDS_TILE_E); LAS int* rtab = (LAS int*)((LAS unsigned char*)lds + LDS_RTAB); LAS float* wtab = (LAS float*)((LAS unsigned char*)lds + LDS_WTAB);
    const int ntr = ps[64] / 256;
    for (int rt = tid; rt < ntr; rt += NTHREADS) tile_e[rt] = moe_expert_of_row(ps, rt * 256);
    __syncthreads();
    MoeSched S{ntr, ntr + T / 256, npn, gsz_(), bid_(), tile_e};
    if (gather) { const int* expl = (const int*)(p->ws + WS_EXPL); const float* expw = (const float*)(p->ws + WS_EXPW);
        int tok[3]; float w[3];
#pragma unroll
        for (int q = 0; q < 3; ++q) { const int idx = tid + q * NTHREADS, i = idx >> 8, r = idx & 255; tok[q] = 0; w[q] = 0.f;
            int rt, pp_;
            if (S.map(i, rt, pp_)) {
                if (rt < S.ntr) { const int e = tile_e[rt], pos = rt * 256 + r - ps[e];
                    if (pos < cl[e]) { tok[q] = expl[(size_t)e * R_ALL + pos]; w[q] = expw[(size_t)e * R_ALL + pos]; } }
                else { tok[q] = (rt - S.ntr) * 256 + r; w[q] = 1.f; } } }
#pragma unroll
        for (int q = 0; q < 3; ++q) { const int idx = tid + q * NTHREADS; rtab[idx] = tok[q]; wtab[idx] = w[q]; } }
    __syncthreads();
    return S;
}
__device__ __forceinline__ void ph_gateup_f(KP p, int l, unsigned char* lds) {
    const MoeSched S = moe_setup(p, l, lds, 2, true);
    pg8::Gemm g{(const bf16_t*)(p->ws + Z_A), (const bf16_t*)(p->ws + wgu_off(l)), 0, 0, 1024};
    pg8::EpiGU8 E{(unsigned char*)(p->ws + Z_H), (const LAS float*)((LAS unsigned char*)lds + LDS_WTAB)};
    pg8::gemm_phase<pg8::EpiGU8, MoeSched, true, true>((LAS unsigned char*)lds, g, S, E, (const LAS int*)((LAS unsigned char*)lds + LDS_RTAB));
}
__device__ __forceinline__ void ph_down_f(KP p, int l, unsigned char* lds) {
    const MoeSched S = moe_setup(p, l, lds, 4, false);
    pg8::Gemm g{(const bf16_t*)(p->ws + Z_H), (const bf16_t*)(p->ws + wd_off(l)), 0, 0, 256};
    bf16_t* X = (bf16_t*)(p->ws + WS_X);
    pg8::EpiDown E{(bf16_t*)(p->ws + Z_Y), X, (const float*)(p->ws + WS_MOD) + (size_t)l * 3 * 6144 + 5 * 1024};
    pg8::gemm_phase<pg8::EpiDown, MoeSched, false, true>((LAS unsigned char*)lds, g, S, E, nullptr);
}

#ifndef FAST_ATTN
#define FAST_ATTN 1
#endif
#ifndef FAST_GEMM
#define FAST_GEMM 15
#endif
constexpr int PH_PER_LAYER = 10, N_PHASES = 1 + DEPTH * PH_PER_LAYER;
__global__ void __launch_bounds__(NTHREADS, 2) mega(Params parg) {
    extern __shared__ __attribute__((aligned(16))) unsigned char lds[];
    const int lo = parg.ph_lo, hi = parg.ph_hi;
    volatile LAS unsigned* xbw = (volatile LAS unsigned*)(lds + LDS_BYTES - 16);
    if (threadIdx.x == 0) { xbw[0] = 0u; xbw[1] = 0u; xbw[2] = 0u; xbw[3] = 0u; }
    if ((threadIdx.x & 63) == 0) *(volatile LAS int*)((LAS unsigned char*)lds + LDS_WVTAB_OFF + 4 * hwkey_()) = (int)(threadIdx.x >> 6);
    __syncthreads();
    XcdBarrier bar; bar.bar = (unsigned*)(parg.ws + WS_CTL) + CW_BAR; bar.x = 0; bar.st = xbw;
    if (hi - lo > 1) bar = xcd_barrier_post((unsigned*)(parg.ws + WS_CTL) + CW_BAR, xbw);
#ifdef PHMASK
#define IN(k) ((((PHMASK) >> ((k) == 0 ? 0 : ((k) - 1) % PH_PER_LAYER + 1)) & 1) && lo <= (k) && (k) < hi)
#else
#define IN(k) (lo <= (k) && (k) < hi)
#endif
#define SEAM(k) do { if (IN(k) && IN((k) + 1)) xcd_barrier(bar); } while (0)
    if (IN(0)) { ph_pro(kparams(), lds); } SEAM(0);
#pragma unroll
    for (int l = 0; l < DEPTH; ++l) {
        const int b0 = 1 + l * PH_PER_LAYER;
        if (IN(b0 + 0)) { ph_norm1(kparams(), l, lds); } SEAM(b0 + 0);
        if (IN(b0 + 1)) { ph_inproj_f(kparams(), l, lds); } SEAM(b0 + 1);
        if (IN(b0 + 2)) { ph_prep(kparams(), l, lds); } SEAM(b0 + 2);
        if (IN(b0 + 3)) { ph_attn_f(kparams(), l, lds); } SEAM(b0 + 3);
        if (IN(b0 + 4)) { ph_hgrn3(kparams(), l, lds); } SEAM(b0 + 4);
        if (IN(b0 + 5)) { ph_outproj_f(kparams(), l, lds); } SEAM(b0 + 5);
        if (IN(b0 + 6)) { ph_norm2(kparams(), l, lds); } SEAM(b0 + 6);
        if (IN(b0 + 7)) { ph_gateup_f(kparams(), l, lds); } SEAM(b0 + 7);
        if (IN(b0 + 8)) { ph_down_f(kparams(), l, lds); } SEAM(b0 + 8);
        if (IN(b0 + 9)) { ph_combine(kparams(), l, lds); } SEAM(b0 + 9);
    }
#undef IN
#undef SEAM
}

#ifndef MK_ONE_LAUNCH
#define MK_ONE_LAUNCH 1
#endif
extern "C" void kernel_launch(void* const* d_in, const int* in_sizes, int n_in, void* d_out, int out_size, void* d_ws, size_t ws_size, hipStream_t stream) {
    static int grid = 0;
    if (grid == 0) {
        if (n_in != 31 || ws_size < WS_END2) { fprintf(stderr, "kernel_launch: unexpected n_in %d or ws_size %zu (< %zu)\n", n_in, ws_size, (size_t)WS_END2); grid = -1; return; }
        int dev = 0, cus = 0, per_cu = 0;
        if (hipGetDevice(&dev) != hipSuccess || hipDeviceGetAttribute(&cus, hipDeviceAttributeMultiprocessorCount, dev) != hipSuccess) { grid = -1; return; }
        if (hipFuncSetAttribute((const void*)mega, hipFuncAttributeMaxDynamicSharedMemorySize, LDS_BYTES) != hipSuccess) { fprintf(stderr, "kernel_launch: hipFuncSetAttribute failed\n"); grid = -1; return; }
        if (hipOccupancyMaxActiveBlocksPerMultiprocessor(&per_cu, (const void*)mega, NTHREADS, LDS_BYTES) != hipSuccess || per_cu < 1) fprintf(stderr, "kernel_launch: occupancy query says %d\n", per_cu);
        (void)hipGetLastError();
        grid = cus;
    }
    if (grid < 0) return;
    (void)hipMemsetAsync((char*)d_ws + WS_CTL, 0, CTL_ZERO_BYTES, stream);
    Params p{};
    for (int i = 0; i < 31; ++i) p.in[i] = (const float*)d_in[i];
    p.out = (float*)d_out; p.ws = (unsigned char*)d_ws;
#if MK_ONE_LAUNCH
    p.ph_lo = 0; p.ph_hi = N_PHASES;
    hipLaunchKernelGGL(mega, dim3(grid), dim3(NTHREADS), LDS_BYTES, stream, p);
#else
    for (int k = 0; k < N_PHASES; ++k) { p.ph_lo = k; p.ph_hi = k + 1; hipLaunchKernelGGL(mega, dim3(grid), dim3(NTHREADS), LDS_BYTES, stream, p); }
#endif
}
```

```cpp
#include <hip/hip_runtime.h>
#include <hip/hip_bf16.h>
#include <cmath>
#include <cstdint>
#include <cstdio>

#define LAS __attribute__((address_space(3)))

typedef unsigned short bf16_t;
typedef short bf16x8 __attribute__((ext_vector_type(8)));
typedef float f32x4 __attribute__((ext_vector_type(4)));
typedef unsigned u32x4 __attribute__((ext_vector_type(4)));
typedef unsigned u32x2 __attribute__((ext_vector_type(2)));

constexpr int D = 1024, NB = 2, NSEQ = 8192, NCTX = 256, DEPTH = 2;
constexpr int R_LAT = NB * NSEQ, R_CTX = NB * NCTX, R_ALL = R_LAT + R_CTX;
constexpr int DIN = 2816;
constexpr int NKEY = NSEQ + NCTX;
constexpr int NE = 64, TOPK = 8;
constexpr int MAXSLOT = 151552;
constexpr int HROWS = MAXSLOT + R_ALL;
constexpr int NCHUNK = 132;
constexpr float EPS = 1e-6f;
constexpr float TOK8_SCALE = 8.f, WGU8_SCALE = 256.f, H8_SCALE = 16.f, WD8_SCALE = 128.f;
constexpr float GU_DESCALE = 1.f / (TOK8_SCALE * WGU8_SCALE), DN_DESCALE = 1.f / (H8_SCALE * WD8_SCALE);
constexpr float Y8_SCALE = 32.f;
constexpr float QSCALE = 0.125f * 1.4426950408889634f;
constexpr float LOG2E = 1.4426950408889634f;

#ifndef FAST_HGRN
#define FAST_HGRN 1
#endif
constexpr int C_GQ = 0, C_GK = 256, C_GV = 384, C_WQ = 512, C_WK = 768, C_WV = 896, C_CVV = 1024, C_CVG = 1280, C_RQ = 1536, C_RI = 1792, C_RFF = 2048, C_RFB = 2304, C_RG = 2560;

constexpr size_t MiB = (size_t)1 << 20;
constexpr size_t WS_CTL = 0, CTL_ZERO_BYTES = 64 * 1024;
constexpr size_t WS_MOD = 1 * MiB;
constexpr size_t WS_LB = WS_MOD + 256 * 1024;
constexpr size_t WS_ROPE = WS_MOD + 512 * 1024;
constexpr size_t WS_TOKE = 2 * MiB, WS_TOKP = 3 * MiB, WS_TOKW = 4 * MiB, WS_TOKS = 5 * MiB;
constexpr size_t WS_SLOTT = 6 * MiB, WS_SLOTW = 7 * MiB;
constexpr size_t WS_X = 8 * MiB;
constexpr size_t WS_WD = 74 * MiB;
constexpr size_t WS_Z = 107 * MiB;
constexpr size_t Z_A = WS_Z + 0 * MiB;
constexpr size_t Z_WGU = WS_Z + 33 * MiB;
constexpr size_t Z_WIN = WS_Z + 98 * MiB;
constexpr size_t Z_WOUT = WS_Z + 104 * MiB;
constexpr size_t Z_WPW = WS_Z + 106 * MiB;
__host__ __device__ constexpr size_t wgu_off(int l) { return WS_Z + 33 * MiB + (size_t)l * 34078720; }
__host__ __device__ constexpr size_t wd_off(int l) { return 74 * MiB + (size_t)l * 17039360; }
__host__ __device__ constexpr size_t win_off(int l) { return l == 0 ? WS_Z + 98 * MiB : WS_Z + (302 + 42) * MiB; }
__host__ __device__ constexpr size_t wout_off(int l) { return l == 0 ? WS_Z + 104 * MiB : WS_Z + (302 + 48) * MiB; }
__host__ __device__ constexpr size_t wpw_off(int l) { return l == 0 ? WS_Z + 106 * MiB : WS_Z + (302 + 51) * MiB; }
constexpr size_t Z_P = WS_Z + 107 * MiB;
constexpr size_t Z_YCAT = WS_Z + 198 * MiB;
constexpr size_t Z_QG = WS_Z + 231 * MiB, Z_QW = WS_Z + 239 * MiB;
constexpr size_t Z_KG = WS_Z + 247 * MiB, Z_VG = WS_Z + 252 * MiB, Z_KW = WS_Z + 257 * MiB, Z_VW = WS_Z + 262 * MiB;
constexpr size_t Z_QGC = WS_Z + 267 * MiB, Z_QWC = Z_QGC + 512 * 1024;
constexpr size_t Z_U = WS_Z + 268 * MiB;
constexpr size_t Z_G = WS_Z + 301 * MiB;
constexpr size_t Z_Y = WS_Z + 107 * MiB;
constexpr size_t Z_H = WS_Z + 302 * MiB;
constexpr size_t WS_END = WS_Z + 385 * MiB;
constexpr size_t WS_EXPL = WS_END, WS_EXPW = WS_END + 5 * MiB, WS_END2 = WS_END + 10 * MiB;
static_assert(Z_H + (size_t)HROWS * 512 <= WS_END, "H fits");
static_assert(Z_Y + (size_t)MAXSLOT * 1024 <= Z_U, "Y8 below the HGRN state buffers");
static_assert(Z_P + (size_t)R_ALL * DIN * 2 <= Z_YCAT, "P fits");

constexpr int CW_BAR = 0;
constexpr int CW_CNT = 4096;

constexpr int LDS_BYTES = 147456;
constexpr int NTHREADS = 512;

struct Params {
    const float* in[31];
    float* out;
    unsigned char* ws;
    int ph_lo, ph_hi;
};

typedef const __attribute__((address_space(4))) Params* KP;
__device__ __forceinline__ KP kparams() { KP k = (KP)__builtin_amdgcn_kernarg_segment_ptr(); asm volatile("" : "+s"(k)); return k; }

constexpr int LDS_WVTAB_OFF = 147456 - 16 - 256;
__device__ __forceinline__ int hwkey_() { return (int)__builtin_amdgcn_s_getreg((5 << 11) | 4) & 63; }
__device__ __forceinline__ int tid_() { extern __shared__ __attribute__((aligned(16))) unsigned char lds_all[];
    const int w = __builtin_amdgcn_readfirstlane(*(const LAS int*)((LAS unsigned char*)lds_all + LDS_WVTAB_OFF + 4 * hwkey_()));
    unsigned z; asm volatile("v_mov_b32 %0, 0" : "=v"(z));
    int t = (w << 6) | (int)__builtin_amdgcn_mbcnt_hi(~0u, __builtin_amdgcn_mbcnt_lo(~0u, z)); asm volatile("" : "+v"(t)); return t; }
__device__ __forceinline__ int bid_() { int b = blockIdx.x; asm volatile("" : "+s"(b)); return b; }
__device__ __forceinline__ int gsz_() { int g = gridDim.x; asm volatile("" : "+s"(g)); return g; }

__device__ __forceinline__ unsigned f2bf(float f) { unsigned u = __float_as_uint(f); return (u + 0x7fffu + ((u >> 16) & 1u)) >> 16; }
__device__ __forceinline__ float bf2f(unsigned h) { return __uint_as_float(h << 16); }
__device__ __forceinline__ unsigned pk2(float lo, float hi) { unsigned r; asm("v_cvt_pk_bf16_f32 %0, %1, %2" : "=v"(r) : "v"(lo), "v"(hi)); return r; }
__device__ __forceinline__ void unpack8(const u32x4 r, f32x4& lo, f32x4& hi) { lo.x = bf2f(r.x & 0xffffu); lo.y = bf2f(r.x >> 16); lo.z = bf2f(r.y & 0xffffu); lo.w = bf2f(r.y >> 16); hi.x = bf2f(r.z & 0xffffu); hi.y = bf2f(r.z >> 16); hi.z = bf2f(r.w & 0xffffu); hi.w = bf2f(r.w >> 16); }
__device__ __forceinline__ float wave_sum(float v) {
#pragma unroll
    for (int o = 1; o < 64; o <<= 1) v += __shfl_xor(v, o);
    return v;
}
__device__ __forceinline__ float clamp8(float v) { return fminf(fmaxf(v, -440.f), 440.f); }
__device__ __forceinline__ float sigmoid_(float x) { return __builtin_amdgcn_rcpf(1.f + __expf(-x)); }
__device__ __forceinline__ float silu_(float x) { return x * sigmoid_(x); }

__device__ __forceinline__ const float* xrow_src(KP p, int l, int row) {
    if (l == 0) return (row < R_LAT) ? p->in[0] + (size_t)row * D : p->in[2] + (size_t)(row - R_LAT) * D;
    return (const float*)(p->ws + WS_X) + (size_t)row * D;
}
__device__ __forceinline__ const float* mod_vec(KP p, int l, int row, int i) {
    const int r = (row < R_LAT) ? (row >> 13) : 2;
    return (const float*)(p->ws + WS_MOD) + ((size_t)l * 3 + r) * 6144 + i * 1024;
}

#define XB_TMO      128
#define XB_XCNT(j)  (256  + 64 * (j))
#define XB_XSUB(j)  (1280 + 64 * (j))
#define XB_XGEN(j)  (2304 + 64 * (j))
#define XB_TOP      3328
#define XB_TOPGEN   3392
#define XCD_BAR_WORDS 3456
#define XB_SPIN_CAP (1u << 18)
__device__ __forceinline__ unsigned xb_ld(unsigned* p)              { return __hip_atomic_load(p, __ATOMIC_RELAXED, __HIP_MEMORY_SCOPE_AGENT); }
__device__ __forceinline__ unsigned xb_add(unsigned* p, unsigned v) { return __hip_atomic_fetch_add(p, v, __ATOMIC_RELAXED, __HIP_MEMORY_SCOPE_AGENT); }
__device__ __forceinline__ unsigned xb_xcc_id() { return (unsigned)__builtin_amdgcn_s_getreg((3 << 11) | 20) & 0xFu; }
#define XB_SPIN(cond, bar) do { unsigned _sp = 0; while (cond) { __builtin_amdgcn_s_sleep(1); \
    if ((++_sp & 255u) == 0u) { if (xb_ld(&(bar)[XB_TMO])) break; if (_sp > XB_SPIN_CAP) { atomicAdd(&(bar)[XB_TMO], 1u); break; } } } } while (0)
struct XcdBarrier { unsigned* bar; unsigned x; volatile LAS unsigned* st; };
__device__ __forceinline__ XcdBarrier xcd_barrier_post(unsigned* bar, volatile LAS unsigned* st) {
    XcdBarrier b; b.bar = bar; b.x = xb_xcc_id(); b.st = st;
    if (tid_() == 0) (void)xb_add(&bar[XB_XCNT(b.x)], 1u);
    return b;
}
__device__ __forceinline__ void xcd_barrier_complete(unsigned* bar, unsigned x, unsigned& nloc, unsigned& nx) {
    const unsigned G = gridDim.x * gridDim.y * gridDim.z;
    unsigned sum, cnt, mine, sp = 0u;
    for (;;) {
        sum = 0u; cnt = 0u; mine = 0u;
#pragma unroll
        for (unsigned j = 0; j < 16; ++j) { const unsigned c = xb_ld(&bar[XB_XCNT(j)]); sum += c; cnt += (c > 0u) ? 1u : 0u; mine = (j == x) ? c : mine; }
        if (sum == G) break;
        __builtin_amdgcn_s_sleep(1);
        if ((++sp & 255u) == 0u) { if (xb_ld(&bar[XB_TMO])) break; if (sp > XB_SPIN_CAP) { atomicAdd(&bar[XB_TMO], 1u); break; } }
    }
    nloc = mine > 0u ? mine : 1u; nx = cnt > 0u ? cnt : 1u;
}
__device__ __forceinline__ void xcd_barrier(const XcdBarrier& b) {
    asm volatile("s_waitcnt vmcnt(0)" ::: "memory");
    __syncthreads();
    if (tid_() == 0) {
        unsigned* bar = b.bar;
        __builtin_amdgcn_s_waitcnt(0);
        unsigned nloc = b.st[0], nx = b.st[1];
        if (nloc == 0u) { xcd_barrier_complete(bar, b.x, nloc, nx); b.st[0] = nloc; b.st[1] = nx; }
        const unsigned old = xb_add(&bar[XB_XSUB(b.x)], 1u);
        const unsigned gen = old / nloc;
        if (old + 1u == (gen + 1u) * nloc) {
            __builtin_amdgcn_fence(__ATOMIC_RELEASE, "agent");
            asm volatile("s_waitcnt vmcnt(0)" ::: "memory");
            const unsigned og = xb_add(&bar[XB_TOP], 1u);
            const unsigned tg = og / nx;
            if (og + 1u == (tg + 1u) * nx) xb_add(&bar[XB_TOPGEN], 1u);
            else XB_SPIN(xb_ld(&bar[XB_TOPGEN]) == tg, bar);
            __builtin_amdgcn_fence(__ATOMIC_ACQUIRE, "agent");
            xb_add(&bar[XB_XGEN(b.x)], 1u);
            asm volatile("s_waitcnt vmcnt(0)" ::: "memory");
        } else {
            XB_SPIN(xb_ld(&bar[XB_XGEN(b.x)]) == gen, bar);
            __builtin_amdgcn_fence(__ATOMIC_ACQUIRE, "agent");
            asm volatile("s_waitcnt vmcnt(0)" ::: "memory");
        }
    }
    __syncthreads();
}

__device__ __forceinline__ void ph_pro(KP p, unsigned char* lds) {
    float* sc = (float*)lds;
    float* red = sc + 3 * 1024;
    const int tid = tid_(), lane = tid & 63, wid = tid >> 6;
    for (int i = tid; i < 3 * 1024; i += NTHREADS) { const int r = i >> 10, k = i & 1023; const float v = (r < 2) ? p->in[1][r * 1024 + k] : p->in[3][k]; sc[i] = silu_(v); }
    __syncthreads();
    float* mod = (float*)(p->ws + WS_MOD);
    for (int item = bid_(); item < DEPTH * 96; item += gsz_()) {
        const int l = item / 96, j0 = (item % 96) * 64;
        const float* w = p->in[4] + (size_t)l * 1024 * 6144;
        float a0 = 0.f, a1 = 0.f, a2 = 0.f;
        const int k0 = wid * 128;
#pragma unroll 1
        for (int k = k0; k < k0 + 128; k += 16) { float wv[16];
#pragma unroll
            for (int u = 0; u < 16; ++u) wv[u] = w[(size_t)(k + u) * 6144 + j0 + lane];
#pragma unroll
            for (int u = 0; u < 16; ++u) { a0 += sc[k + u] * wv[u]; a1 += sc[1024 + k + u] * wv[u]; a2 += sc[2048 + k + u] * wv[u]; } }
        red[(wid * 3 + 0) * 64 + lane] = a0; red[(wid * 3 + 1) * 64 + lane] = a1; red[(wid * 3 + 2) * 64 + lane] = a2;
        __syncthreads();
        if (tid < 192) { const int r = tid >> 6; float s = 0.f;
            for (int w8 = 0; w8 < 8; ++w8) s += red[(w8 * 3 + r) * 64 + lane];
            mod[((size_t)l * 3 + r) * 6144 + j0 + lane] = s + p->in[5][l * 6144 + j0 + lane]; }
        __syncthreads();
    }
    if (bid_() == 0) {
        float* rt = (float*)(p->ws + WS_ROPE);
        for (int i = tid; i < 128 * 16; i += NTHREADS) { const int pos = i >> 4, f = i & 15; const float inv = powf(10000.f, -(float)f * (1.f / 16.f)); float sn, cs; sincosf((float)pos * inv, &sn, &cs);
            rt[pos * 32 + f] = cs; rt[pos * 32 + 16 + f] = sn; }
    }
    if (bid_() == gsz_() - 1) {
        float* lb = (float*)(p->ws + WS_LB);
        for (int i = tid; i < 2 * 2 * 256; i += NTHREADS) { const int l = i >> 9, dir = (i >> 8) & 1, ch = i & 255;
            const float* lg = p->in[21];
            const float l0 = lg[(dir * 2 + 0) * 256 + ch], l1 = lg[(dir * 2 + 1) * 256 + ch]; const float m = fmaxf(l0, l1);
            const float e0 = expf(l0 - m), e1 = expf(l1 - m);
            lb[i] = (l == 0) ? 0.f : e1 / (e0 + e1); }
    }
}

constexpr int CVT_E1 = 1050, CVT_E2 = 2850;
struct CvtTile { const float* src; bf16_t* dst; int K, N, k0, n0, blk, bstride, boff; float f8scale; int perm; };
__device__ __forceinline__ int cvt_total() { return 16 * 44 + 16 * 16 + 4 * 4 + 2 * (64 * 64) + 2 * 64 + 64 * 64 + 64; }
__device__ __forceinline__ CvtTile cvt_decode(KP p, int l, int g) {
    bf16_t* Wgu = (bf16_t*)(p->ws + wgu_off(l)); bf16_t* Wd = (bf16_t*)(p->ws + wd_off(l));
    CvtTile t; int per, tn, r;
    if (g < 704) { r = g; t = {p->in[8] + (size_t)l * 1024 * DIN, (bf16_t*)(p->ws + win_off(l)), 1024, DIN, 0, 0, DIN, 0, 0, 0.f}; tn = 44; per = 704; }
    else if ((g -= 704) < 256) { r = g; t = {p->in[9] + (size_t)l * 1024 * 1024, (bf16_t*)(p->ws + wout_off(l)), 1024, 1024, 0, 0, 1024, 0, 0, 0.f}; tn = 16; per = 256; }
    else if ((g -= 256) < 16) { r = g; t = {p->in[19] + (size_t)l * 65536, (bf16_t*)(p->ws + wpw_off(l)), 256, 256, 0, 0, 256, 0, 0, 0.f}; tn = 4; per = 16; }
    else if ((g -= 16) < 4096) { const int m = g >> 6; r = g & 63; t = {p->in[25] + ((size_t)l * 64 + m) * 262144, (bf16_t*)((unsigned char*)Wgu + (size_t)m * 524288), 1024, 256, 0, 0, 128, 256, 0, WGU8_SCALE}; tn = 4; per = 64; }
    else if ((g -= 4096) < 4096) { const int m = g >> 6; r = g & 63; t = {p->in[26] + ((size_t)l * 64 + m) * 262144, (bf16_t*)((unsigned char*)Wgu + (size_t)m * 524288), 1024, 256, 0, 0, 128, 256, 128, WGU8_SCALE}; tn = 4; per = 64; }
    else if ((g -= 4096) < 64) { r = g; t = {p->in[28] + (size_t)l * 262144, (bf16_t*)((unsigned char*)Wgu + (size_t)64 * 524288), 1024, 256, 0, 0, 128, 256, 0, WGU8_SCALE}; tn = 4; per = 64; }
    else if ((g -= 64) < 64) { r = g; t = {p->in[29] + (size_t)l * 262144, (bf16_t*)((unsigned char*)Wgu + (size_t)64 * 524288), 1024, 256, 0, 0, 128, 256, 128, WGU8_SCALE}; tn = 4; per = 64; }
    else if ((g -= 64) < 4096) { const int m = g >> 6; r = g & 63; t = {p->in[27] + ((size_t)l * 64 + m) * 262144, (bf16_t*)((unsigned char*)Wd + (size_t)m * 262144), 256, 1024, 0, 0, 1024, 0, 0, WD8_SCALE, 1}; tn = 16; per = 64; }
    else { g -= 4096; r = g; t = {p->in[30] + (size_t)l * 262144, (bf16_t*)((unsigned char*)Wd + (size_t)64 * 262144), 256, 1024, 0, 0, 1024, 0, 0, WD8_SCALE, 1}; tn = 16; per = 64; }
    (void)per; t.k0 = (r / tn) * 64; t.n0 = (r % tn) * 64; return t;
}
__device__ __forceinline__ void ph_cvt(KP p, int l, unsigned char* lds, int first = 0, int nwg = 0, int t0 = 0, int t1 = 1 << 30) {
    float* tb = (float*)lds;
    const int tid = tid_(), G = nwg ? nwg : gsz_(), total = t1 < cvt_total() ? t1 : cvt_total();
    const int r0 = tid >> 4, c0 = (tid & 15) * 4, nn = tid >> 3, kc = (tid & 7) * 8;
    int g = bid_() - first, buf = 0;
    if (g < 0) return;
    g += t0;
    if (g >= total) return;
    CvtTile T = cvt_decode(p, l, g);
    f32x4 v0 = *(const f32x4*)(T.src + (size_t)(T.k0 + r0) * T.N + T.n0 + c0), v1 = *(const f32x4*)(T.src + (size_t)(T.k0 + r0 + 32) * T.N + T.n0 + c0);
    for (;;) {
        float* t = tb + buf * (64 * 65);
        t[r0 * 65 + c0] = v0.x; t[r0 * 65 + c0 + 1] = v0.y; t[r0 * 65 + c0 + 2] = v0.z; t[r0 * 65 + c0 + 3] = v0.w;
        t[(r0 + 32) * 65 + c0] = v1.x; t[(r0 + 32) * 65 + c0 + 1] = v1.y; t[(r0 + 32) * 65 + c0 + 2] = v1.z; t[(r0 + 32) * 65 + c0 + 3] = v1.w;
        const CvtTile C = T; const int gn = g + G; const bool more = gn < total;
        if (more) { T = cvt_decode(p, l, gn);
            v0 = *(const f32x4*)(T.src + (size_t)(T.k0 + r0) * T.N + T.n0 + c0); v1 = *(const f32x4*)(T.src + (size_t)(T.k0 + r0 + 32) * T.N + T.n0 + c0); }
        __syncthreads();
        { const int n = C.n0 + nn; int drow = (n / C.blk) * C.bstride + C.boff + (n % C.blk);
          if (C.perm) drow = (n & ~255) + ((n >> 3) & 1) * 128 + ((n >> 6) & 3) * 32 + ((n >> 4) & 3) * 8 + (n & 7);
          if (C.f8scale != 0.f) { const float sc = C.f8scale;
              int w0 = __builtin_amdgcn_cvt_pk_fp8_f32(clamp8(t[(kc + 0) * 65 + nn] * sc), clamp8(t[(kc + 1) * 65 + nn] * sc), 0, false); w0 = __builtin_amdgcn_cvt_pk_fp8_f32(clamp8(t[(kc + 2) * 65 + nn] * sc), clamp8(t[(kc + 3) * 65 + nn] * sc), w0, true);
              int w1 = __builtin_amdgcn_cvt_pk_fp8_f32(clamp8(t[(kc + 4) * 65 + nn] * sc), clamp8(t[(kc + 5) * 65 + nn] * sc), 0, false); w1 = __builtin_amdgcn_cvt_pk_fp8_f32(clamp8(t[(kc + 6) * 65 + nn] * sc), clamp8(t[(kc + 7) * 65 + nn] * sc), w1, true);
              u32x2 o8; o8.x = (unsigned)w0; o8.y = (unsigned)w1;
              *(u32x2*)((unsigned char*)C.dst + (size_t)drow * C.K + C.k0 + kc) = o8;
          } else {
          u32x4 o; o.x = pk2(t[(kc + 0) * 65 + nn], t[(kc + 1) * 65 + nn]); o.y = pk2(t[(kc + 2) * 65 + nn], t[(kc + 3) * 65 + nn]);
          o.z = pk2(t[(kc + 4) * 65 + nn], t[(kc + 5) * 65 + nn]); o.w = pk2(t[(kc + 6) * 65 + nn], t[(kc + 7) * 65 + nn]);
          *(u32x4*)(C.dst + (size_t)drow * C.K + C.k0 + kc) = o; } }
        if (!more) break;
        g = gn; buf ^= 1;
    }
    __syncthreads();
}
__device__ __forceinline__ void norm_mod_row(const float* xrow, const float* g, const float* shift, const float* scale, bf16_t* orow, float* fout, int lane) {
    f32x4 v[4]; float s = 0.f;
#pragma unroll
    for (int j = 0; j < 4; ++j) { v[j] = ((const f32x4*)xrow)[lane + 64 * j]; s += v[j].x * v[j].x + v[j].y * v[j].y + v[j].z * v[j].z + v[j].w * v[j].w; }
    const float rinv = rsqrtf(wave_sum(s) * (1.f / D) + EPS);
#pragma unroll
    for (int j = 0; j < 4; ++j) { const int idx = lane + 64 * j;
        const f32x4 gg = ((const f32x4*)g)[idx], sh = ((const f32x4*)shift)[idx], sc = ((const f32x4*)scale)[idx];
        f32x4 y; y.x = v[j].x * rinv * gg.x * (1.f + sc.x) + sh.x; y.y = v[j].y * rinv * gg.y * (1.f + sc.y) + sh.y;
        y.z = v[j].z * rinv * gg.z * (1.f + sc.z) + sh.z; y.w = v[j].w * rinv * gg.w * (1.f + sc.w) + sh.w;
        u32x2 o; o.x = pk2(y.x, y.y); o.y = pk2(y.z, y.w);
        ((u32x2*)orow)[idx] = o;
        if (fout) ((f32x4*)fout)[idx] = y; }
}
__device__ __forceinline__ void ph_norm1(KP p, int l, unsigned char* lds) {
    if (l == 0) ph_cvt(p, l, lds);
    const int tid = tid_(), lane = tid & 63, wid = tid >> 6;
    bf16_t* A = (bf16_t*)(p->ws + Z_A);
    const float* g = p->in[6] + l * D;
    if (l == 0) { for (int row = bid_() * 8 + wid; row < R_ALL; row += gsz_() * 8)
        norm_mod_row(xrow_src(p, l, row), g, mod_vec(p, l, row, 0), mod_vec(p, l, row, 1), A + (size_t)row * D, nullptr, lane); }
    else { const bf16_t* X = (const bf16_t*)(p->ws + WS_X);
        for (int row = bid_() * 8 + wid; row < R_ALL; row += gsz_() * 8) {
            const float* shift = mod_vec(p, l, row, 0); const float* scale = mod_vec(p, l, row, 1);
            f32x4 v[4]; unpack8(*(const u32x4*)(X + (size_t)row * D + lane * 8), v[0], v[1]); unpack8(*(const u32x4*)(X + (size_t)row * D + 512 + lane * 8), v[2], v[3]);
            float ss = 0.f;
#pragma unroll
            for (int j = 0; j < 4; ++j) ss += v[j].x * v[j].x + v[j].y * v[j].y + v[j].z * v[j].z + v[j].w * v[j].w;
            const float rinv = rsqrtf(wave_sum(ss) * (1.f / D) + EPS);
#pragma unroll
            for (int h = 0; h < 2; ++h) { const int c0 = h * 512 + lane * 8; unsigned o[4];
#pragma unroll
                for (int q = 0; q < 2; ++q) { const f32x4 gg = *(const f32x4*)(g + c0 + 4 * q), sh = *(const f32x4*)(shift + c0 + 4 * q), sc = *(const f32x4*)(scale + c0 + 4 * q);
                    const f32x4 y = v[2 * h + q] * rinv * gg * (sc + 1.f) + sh; o[2 * q] = pk2(y.x, y.y); o[2 * q + 1] = pk2(y.z, y.w); }
                *(u32x4*)(A + (size_t)row * D + c0) = (u32x4){o[0], o[1], o[2], o[3]}; } } }
}

template <int NBJ, class ARow, class Epi>
__device__ __forceinline__ void gemm_simple_tile(const bf16_t* A, const ARow& arow, const bf16_t* Bt, int K, int row0, int colb0, int bjstride, const Epi& epi) {
    const int tid = tid_(), lane = tid & 63, wid = tid >> 6, wr = wid >> 1, wc = wid & 1, fr = lane & 15, fq = lane >> 4;
    f32x4 acc[2][NBJ][4];
#pragma unroll
    for (int i = 0; i < 2; ++i)
#pragma unroll
        for (int b = 0; b < NBJ; ++b)
#pragma unroll
            for (int j = 0; j < 4; ++j) acc[i][b][j] = (f32x4){0.f, 0.f, 0.f, 0.f};
    const bf16_t* ap[2];
#pragma unroll
    for (int i = 0; i < 2; ++i) ap[i] = A + (size_t)arow(row0 + wr * 32 + i * 16 + fr) * K + fq * 8;
    const bf16_t* bp = Bt + (size_t)(colb0 + wc * 64 + fr) * K + fq * 8;
    for (int k = 0; k < K; k += 32) {
        bf16x8 a[2];
#pragma unroll
        for (int i = 0; i < 2; ++i) a[i] = *(const bf16x8*)(ap[i] + k);
#pragma unroll
        for (int b = 0; b < NBJ; ++b)
#pragma unroll
            for (int j = 0; j < 4; ++j) { const bf16x8 bv = *(const bf16x8*)(bp + (size_t)(b * bjstride + j * 16) * K + k);
#pragma unroll
                for (int i = 0; i < 2; ++i) acc[i][b][j] = __builtin_amdgcn_mfma_f32_16x16x32_bf16(a[i], bv, acc[i][b][j], 0, 0, 0); }
    }
#pragma unroll
    for (int i = 0; i < 2; ++i)
#pragma unroll
        for (int j = 0; j < 4; ++j)
#pragma unroll
            for (int r = 0; r < 4; ++r) { const int row = row0 + wr * 32 + i * 16 + fq * 4 + r, col = wc * 64 + j * 16 + fr;
                epi(row, col, acc[i][0][j][r], acc[i][NBJ - 1][j][r]); }
}
struct RowId { __device__ __forceinline__ int operator()(int r) const { return r; } };
struct RowGather { const int* idx; __device__ __forceinline__ int operator()(int r) const { return idx[r]; } };

__device__ __forceinline__ void ph_inproj(KP p, int l, unsigned char* lds) {
    const bf16_t* A = (const bf16_t*)(p->ws + Z_A); const bf16_t* Bt = (const bf16_t*)(p->ws + Z_WIN); bf16_t* P = (bf16_t*)(p->ws + Z_P);
    constexpr int TM = R_ALL / 128, TN = DIN / 128;
    for (int it = bid_(); it < TM * TN; it += gsz_()) { const int mt = it / TN, nt = it % TN;
        auto epi = [&](int row, int col, float v, float) { P[(size_t)row * DIN + nt * 128 + col] = (bf16_t)f2bf(v); };
        gemm_simple_tile<1>(A, RowId{}, Bt, 1024, mt * 128, nt * 128, 0, epi); }
}

namespace pg8 {
constexpr int BM = 256, BK = 64, HALF = 128, HTB = HALF * BK * 2, STAGE_BYTES = 8 * HTB, NXCD = 8, WGM = 8;
__host__ __device__ __forceinline__ int lds_byte(int r, int c) { const int st = (r >> 4) * 2 + (c >> 5), rr = r & 15, cc = c & 31, ob = rr * 64 + cc * 2; return st * 1024 + (ob ^ (((ob >> 9) & 1) << 5)); }
__host__ __device__ __forceinline__ void stage_rc(int b, int& R, int& C) { const int st = b / 1024, sb = b % 1024, swz = sb ^ (((sb >> 9) & 1) << 5); R = (st >> 1) * 16 + swz / 64; C = (st & 1) * 32 + (swz % 64) / 2; }
__host__ __device__ __forceinline__ int perm32(int rho) { const int n = rho >> 4, i = rho & 15; return 8 * (i >> 2) + 4 * n + (i & 3); }
struct Unit { int pm, pn, ord; };
struct Gemm { const bf16_t* A; const bf16_t* Bt; int M, N, K; };
struct StaticOrder {
    int nM, nN, nwg, G, c;
    __host__ __device__ void init(int M, int N, int G_, int c_) { nM = M / BM; nN = N / BM; nwg = nM * nN; G = G_; c = c_; }
    __host__ __device__ bool next(int i, Unit& u) const {
        const long L = (long)i * G + c; if (L >= nwg) return false;
        int wgid = (int)L; { const int q = nwg / NXCD, r = nwg % NXCD, xcd = wgid % NXCD, off = wgid / NXCD; wgid = (xcd < r ? xcd * (q + 1) : r * (q + 1) + (xcd - r) * q) + off; }
        const int nig = WGM * nN, gid = wgid / nig, fm = gid * WGM, gsz = (nM - fm) < WGM ? (nM - fm) : WGM;
        u.pm = fm + ((wgid % nig) % gsz); u.pn = (wgid % nig) / gsz; u.ord = i; return true;
    }
};
__device__ __forceinline__ unsigned cvt_pk_bf16(float lo, float hi) { unsigned r; asm volatile("v_cvt_pk_bf16_f32 %0, %1, %2" : "=v"(r) : "v"(lo), "v"(hi)); return r; }

typedef int i32x4v __attribute__((ext_vector_type(4)));
typedef int i32x8v __attribute__((ext_vector_type(8)));
__device__ __forceinline__ i32x8v cat8(bf16x8 lo, bf16x8 hi) { const i32x4v a = __builtin_bit_cast(i32x4v, lo), b = __builtin_bit_cast(i32x4v, hi); return __builtin_shufflevector(a, b, 0, 1, 2, 3, 4, 5, 6, 7); }
__device__ __forceinline__ void glds16_s(const void* sbase, unsigned voff, unsigned lds_dst) { unsigned keep;
    asm volatile("s_mov_b32 %0, m0\n\ts_mov_b32 m0, %3\n\ts_nop 0\n\tglobal_load_lds_dwordx4 %1, %2\n\ts_mov_b32 m0, %0" : "=&s"(keep) : "v"(voff), "s"(sbase), "s"(lds_dst) : "memory"); }
template <class Epi, class Sched, bool GATHER, bool FP8 = false>
__device__ __forceinline__ void gemm_phase(LAS unsigned char* lds, const Gemm g, const Sched& S, const Epi& E, const LAS int* rtab) {
    const int tid = tid_(), wid = __builtin_amdgcn_readfirstlane(tid >> 6), lane = tid & 63, wr = wid >> 2, wc = wid & 3, fr = lane & 15, fq = lane >> 4;
    const int KB = FP8 ? g.K : g.K * 2, nt = KB / 128;
    unsigned voffA[2], voffB[2]; int RA[2], CA[2];
#pragma unroll
    for (int i = 0; i < 2; ++i) { int R, C; stage_rc(tid * 16 + i * 8192, R, C); const int Rb = (R & ~31) + perm32(R & 31);
        voffA[i] = (unsigned)(R * KB + C * 2); voffB[i] = (unsigned)(Rb * KB + C * 2); RA[i] = R; CA[i] = C; }
    unsigned rcpk = 0; if constexpr (GATHER) { rcpk = (unsigned)(RA[0] * 4) | ((unsigned)(CA[0] * 2) << 16); asm volatile("" : "+v"(rcpk)); }
    const size_t kstep = (size_t)128;
    const size_t hstep = (size_t)HALF * KB;
    const size_t hstepA = GATHER ? 0 : hstep;
    const size_t tstep = 2 * hstep;
    const unsigned ldsw = (unsigned)wid * 1024u;
    const unsigned ldsb = (unsigned)__builtin_amdgcn_readfirstlane((int)((unsigned)(size_t)lds + ldsw));
    const int aoff = lds_byte(wr * 64 + fr, fq * 8), boff = lds_byte(wc * 32 + fr, fq * 8);
#define PG8_SA(b, h) (((b) * 2 + (h)) * HTB)
#define PG8_SB(b, h) ((4 + (b) * 2 + (h)) * HTB)
#define PG8_STAGE(bufoff, gbase, voff) do { _Pragma("unroll") for (int _i = 0; _i < 2; ++_i) { if constexpr (FP8) glds16_s((const void*)(gbase), (voff)[_i], ldsb + (unsigned)((bufoff) + _i * 8192)); \
        else __builtin_amdgcn_global_load_lds((const unsigned*)((const char*)(gbase) + (voff)[_i]), (LAS unsigned*)(lds + (bufoff) + ldsw + _i * 8192), 16, 0, 0); } } while (0)
#define PG8_STAGE1(bufoff, gbase, v0) do {   \
        glds16_s((const void*)(gbase), (v0), ldsb + (unsigned)(bufoff)); glds16_s((const void*)((const char*)(gbase) + (size_t)64 * KB), (v0), ldsb + (unsigned)((bufoff) + 8192)); } while (0)
#define PG8_LDA(dst, b, h) do { _Pragma("unroll") for (int m = 0; m < 4; ++m) { if constexpr (FP8) dst##8[m] = cat8(*(const LAS bf16x8*)(lds + PG8_SA(b, h) + aoff + m * 2048), *(const LAS bf16x8*)(lds + PG8_SA(b, h) + aoff + m * 2048 + 1024)); \
        else { _Pragma("unroll") for (int k = 0; k < 2; ++k) dst[m][k] = *(const LAS bf16x8*)(lds + PG8_SA(b, h) + aoff + m * 2048 + k * 1024); } } } while (0)
#define PG8_LDB(dst, b, h) do { _Pragma("unroll") for (int n = 0; n < 2; ++n) { if constexpr (FP8) dst##8[n] = cat8(*(const LAS bf16x8*)(lds + PG8_SB(b, h) + boff + n * 2048), *(const LAS bf16x8*)(lds + PG8_SB(b, h) + boff + n * 2048 + 1024)); \
        else { _Pragma("unroll") for (int k = 0; k < 2; ++k) dst[n][k] = *(const LAS bf16x8*)(lds + PG8_SB(b, h) + boff + n * 2048 + k * 1024); } } } while (0)
#define PG8_MMA(ai, bj, At, Bt) do { __builtin_amdgcn_s_setprio(1); _Pragma("unroll") for (int m = 0; m < 4; ++m) _Pragma("unroll") for (int n = 0; n < 2; ++n) { \
        if constexpr (FP8) acc[ai][bj][m][n] = __builtin_amdgcn_mfma_scale_f32_16x16x128_f8f6f4(Bt##8[n], At##8[m], acc[ai][bj][m][n], 0, 0, 0, 0x7F7F7F7F, 0, 0x7F7F7F7F); \
        else { _Pragma("unroll") for (int k = 0; k < 2; ++k) acc[ai][bj][m][n] = __builtin_amdgcn_mfma_f32_16x16x32_bf16(Bt[n][k], At[m][k], acc[ai][bj][m][n], 0, 0, 0); } } \
        if constexpr (FP8) { asm volatile("" : "+v"(acc[ai][bj][0][0]), "+v"(acc[ai][bj][0][1]), "+v"(acc[ai][bj][1][0]), "+v"(acc[ai][bj][1][1]), "+v"(acc[ai][bj][2][0]), "+v"(acc[ai][bj][2][1]), "+v"(acc[ai][bj][3][0]), "+v"(acc[ai][bj][3][1])); } \
        __builtin_amdgcn_s_setprio(0); } while (0)
#define PG8_WAIT_V(n) asm volatile("s_waitcnt vmcnt(" #n ")" ::: "memory")
#define PG8_WAIT_L(n) asm volatile("s_waitcnt lgkmcnt(" #n ")" ::: "memory")
#define PG8_BAR __builtin_amdgcn_s_barrier()
#define PG8_SCHED __builtin_amdgcn_sched_barrier(0)
#define PG8_STAGE_A(bufoff, gbase, ord, h) do { unsigned _o[2]; if constexpr (GATHER) {   \
            unsigned _pk = rcpk; asm volatile("" : "+v"(_pk));   \
            const LAS unsigned char* _rp = (const LAS unsigned char*)rtab + ((ord) * 1024 + (h) * 512) + (_pk & 0xffffu); const unsigned _c2 = _pk >> 16; \
            _Pragma("unroll") for (int _i = 0; _i < 2; ++_i) _o[_i] = __umul24((unsigned)*(const LAS int*)(_rp + _i * 256), (unsigned)KB) + _c2; } \
        else { _o[0] = voffA[0]; _o[1] = voffA[1]; } if constexpr (FP8 && !GATHER) PG8_STAGE1(bufoff, gbase, voffA[0]); else PG8_STAGE(bufoff, gbase, _o); } while (0)
#define PG8_STAGE_B(bufoff, gbase) do { if constexpr (FP8) PG8_STAGE1(bufoff, gbase, voffB[0]); else PG8_STAGE(bufoff, gbase, voffB); } while (0)
    Unit cur, nxt; int ui = 0;
    if (!S.next(0, cur)) return;
    f32x4 acc[2][2][4][2];
#pragma unroll
    for (int a = 0; a < 2; ++a)
#pragma unroll
        for (int b = 0; b < 2; ++b)
#pragma unroll
            for (int m = 0; m < 4; ++m)
#pragma unroll
                for (int n = 0; n < 2; ++n) acc[a][b][m][n] = (f32x4){0.f, 0.f, 0.f, 0.f};
    bf16x8 At[4][2], B0[2][2], B1[2][2]; i32x8v At8[4], B08[2], B18[2];
    const char* cA = GATHER ? (const char*)g.A : (const char*)g.A + (size_t)cur.pm * tstep; const char* cB = (const char*)g.Bt + (size_t)cur.pn * tstep;
    PG8_STAGE_B(PG8_SB(0, 0), cB); PG8_STAGE_B(PG8_SB(0, 1), cB + hstep); PG8_STAGE_A(PG8_SA(0, 0), cA, 0, 0); PG8_STAGE_A(PG8_SA(0, 1), cA + hstepA, 0, 1);
    if (wr == 1) PG8_BAR;
    PG8_WAIT_V(2); PG8_BAR;
    PG8_STAGE_B(PG8_SB(1, 0), cB + kstep); PG8_STAGE_A(PG8_SA(1, 0), cA + kstep, 0, 0); PG8_STAGE_B(PG8_SB(1, 1), cB + hstep + kstep);
    PG8_WAIT_V(6); PG8_BAR;
    for (;;) {
        const bool has_next = S.next(ui + 1, nxt);
        const char* nA = GATHER ? (const char*)g.A : (has_next ? (const char*)g.A + (size_t)nxt.pm * tstep : cA); const char* nB = has_next ? (const char*)g.Bt + (size_t)nxt.pn * tstep : cB;
#pragma unroll 1
        for (int t = 0; t < nt; t += 2) {
            const bool last = (t == nt - 2);
            const char* a1 = cA + (size_t)(t + 1) * kstep;
            const char* a2 = last ? nA : cA + (size_t)(t + 2) * kstep; const char* b2 = last ? nB : cB + (size_t)(t + 2) * kstep;
            const char* a3 = a2 + kstep; const char* b3 = b2 + kstep;
            const int on = (last && has_next) ? ui + 1 : ui;
            PG8_LDB(B0, 0, 0); PG8_LDB(B1, 0, 1); PG8_SCHED; PG8_LDA(At, 0, 0); PG8_STAGE_A(PG8_SA(1, 1), a1 + hstepA, ui, 1);
            PG8_WAIT_V(8); PG8_WAIT_L(0); PG8_BAR; PG8_MMA(0, 0, At, B0); PG8_MMA(0, 1, At, B1); PG8_BAR; PG8_SCHED;
            PG8_LDA(At, 0, 1); PG8_STAGE_B(PG8_SB(0, 0), b2); PG8_STAGE_B(PG8_SB(0, 1), b2 + hstep); PG8_STAGE_A(PG8_SA(0, 0), a2, on, 0);
            PG8_WAIT_V(8); PG8_WAIT_L(0); PG8_BAR; PG8_MMA(1, 0, At, B0); PG8_MMA(1, 1, At, B1); PG8_BAR; PG8_SCHED;
            PG8_LDB(B0, 1, 0); PG8_LDB(B1, 1, 1); PG8_SCHED; PG8_LDA(At, 1, 0); PG8_STAGE_A(PG8_SA(0, 1), a2 + hstepA, on, 1);
            PG8_WAIT_V(8); PG8_WAIT_L(0); PG8_BAR; PG8_MMA(0, 0, At, B0); PG8_MMA(0, 1, At, B1); PG8_BAR; PG8_SCHED;
            PG8_LDA(At, 1, 1); PG8_STAGE_B(PG8_SB(1, 0), b3); PG8_STAGE_B(PG8_SB(1, 1), b3 + hstep); PG8_STAGE_A(PG8_SA(1, 0), a3, on, 0);
            PG8_WAIT_V(8); PG8_WAIT_L(0); PG8_BAR; PG8_MMA(1, 0, At, B0); PG8_MMA(1, 1, At, B1); PG8_BAR; PG8_SCHED;
        }
        if (wr == 0) PG8_BAR;
        E(acc, cur, wr, wc, fr, fq);
        if (!has_next) break;
#pragma unroll
        for (int a = 0; a < 2; ++a)
#pragma unroll
            for (int b = 0; b < 2; ++b)
#pragma unroll
                for (int m = 0; m < 4; ++m)
#pragma unroll
                    for (int n = 0; n < 2; ++n) acc[a][b][m][n] = (f32x4){0.f, 0.f, 0.f, 0.f};
        cur = nxt; cA = nA; cB = nB; ++ui;
        if (wr == 1) PG8_BAR;
    }
    PG8_WAIT_V(0);
    PG8_BAR;
#undef PG8_SA
#undef PG8_SB
#undef PG8_STAGE
#undef PG8_LDA
#undef PG8_LDB
#undef PG8_MMA
#undef PG8_WAIT_V
#undef PG8_WAIT_L
#undef PG8_BAR
#undef PG8_SCHED
#undef PG8_STAGE_A
#undef PG8_STAGE_B
#undef PG8_STAGE1
}
struct EpiBf16 {
    bf16_t* O; int ldc, ncolt; size_t slab;
    __device__ __forceinline__ void operator()(const f32x4 (&acc)[2][2][4][2], const Unit& u, int wr, int wc, int fr, int fq) const {
        const int row0 = u.pm * BM + wr * 64 + fr; const size_t col0 = (size_t)(u.pn % ncolt) * slab + wc * 32 + 8 * fq;
#pragma unroll
        for (int ai = 0; ai < 2; ++ai)
#pragma unroll
            for (int m = 0; m < 4; ++m) { bf16_t* rowp = O + (size_t)(row0 + ai * HALF + m * 16) * ldc + col0;
#pragma unroll
                for (int bj = 0; bj < 2; ++bj) { const f32x4 v0 = acc[ai][bj][m][0], v1 = acc[ai][bj][m][1];
                    u32x4 w; w.x = cvt_pk_bf16(v0[0], v0[1]); w.y = cvt_pk_bf16(v0[2], v0[3]); w.z = cvt_pk_bf16(v1[0], v1[1]); w.w = cvt_pk_bf16(v1[2], v1[3]);
                    *(u32x4*)(rowp + bj * HALF) = w; } }
    }
};
struct EpiRes {
    bf16_t* X; const float* xlat; const float* xctx; const float* modl; int pm_shift; float ascale; bool perm = false;
    __device__ __forceinline__ void operator()(const f32x4 (&acc)[2][2][4][2], const Unit& u, int wr, int wc, int fr, int fq) const {
        const int pm = u.pm - pm_shift; const int rsel = pm < 64 ? (pm >> 5) : 2;
        const int row0 = pm * BM + wr * 64 + fr, col0 = (u.pn & 3) * BM + (perm ? wc * 64 + 16 * fq : wc * 32 + 8 * fq), bjs = perm ? 8 : HALF;
        const float* gate = modl + (size_t)rsel * 6144 + col0;
        const float* xs = xlat ? (pm < 64 ? xlat + (size_t)row0 * D : xctx + (size_t)(row0 - R_LAT) * D) + col0 : nullptr;
        bf16_t* xo = X + (size_t)row0 * D + col0;
#pragma unroll
        for (int bj = 0; bj < 2; ++bj) { const f32x4 g0 = *(const f32x4*)(gate + bj * bjs) * ascale, g1 = *(const f32x4*)(gate + bj * bjs + 4) * ascale;
#pragma unroll
            for (int ai = 0; ai < 2; ++ai)
#pragma unroll
                for (int m = 0; m < 4; ++m) { const size_t o = (size_t)(ai * HALF + m * 16) * D + bj * bjs;
                    f32x4 x0, x1;
                    if (xs) { x0 = *(const f32x4*)(xs + o); x1 = *(const f32x4*)(xs + o + 4); } else unpack8(*(const u32x4*)(xo + o), x0, x1);
                    const f32x4 y0 = x0 + g0 * acc[ai][bj][m][0], y1 = x1 + g1 * acc[ai][bj][m][1];
                    u32x4 w; w.x = cvt_pk_bf16(y0[0], y0[1]); w.y = cvt_pk_bf16(y0[2], y0[3]); w.z = cvt_pk_bf16(y1[0], y1[1]); w.w = cvt_pk_bf16(y1[2], y1[3]);
                    *(u32x4*)(xo + o) = w; } }
    }
};
struct EpiGU8 {
    unsigned char* H8; const LAS float* wtab;
    __device__ __forceinline__ void operator()(const f32x4 (&acc)[2][2][4][2], const Unit& u, int wr, int wc, int fr, int fq) const {
        asm volatile("" : "+v"(fr), "+v"(fq));
        const int row0 = u.pm * BM + wr * 64 + fr, col0 = (u.pn & 1) * 128 + wc * 32 + 8 * fq;
#pragma unroll
        for (int ai = 0; ai < 2; ++ai)
#pragma unroll
            for (int m = 0; m < 4; ++m) { const int row = row0 + ai * HALF + m * 16; const float w = wtab[u.ord * 256 + wr * 64 + fr + ai * HALF + m * 16] * H8_SCALE;
                float h[8];
#pragma unroll
                for (int n = 0; n < 2; ++n)
#pragma unroll
                    for (int j = 0; j < 4; ++j) { const float gv = acc[ai][0][m][n][j] * GU_DESCALE, uv = acc[ai][1][m][n][j] * GU_DESCALE;
                        h[n * 4 + j] = fminf(fmaxf(gv * __builtin_amdgcn_rcpf(1.f + __expf(-gv)) * uv * w, -440.f), 440.f); }
                int w0 = __builtin_amdgcn_cvt_pk_fp8_f32(h[0], h[1], 0, false); w0 = __builtin_amdgcn_cvt_pk_fp8_f32(h[2], h[3], w0, true);
                int w1 = __builtin_amdgcn_cvt_pk_fp8_f32(h[4], h[5], 0, false); w1 = __builtin_amdgcn_cvt_pk_fp8_f32(h[6], h[7], w1, true);
                u32x2 o; o.x = (unsigned)w0; o.y = (unsigned)w1;
                *(u32x2*)(H8 + (size_t)row * 256 + col0) = o; }
    }
};
struct EpiGU {
    bf16_t* H; const float* slot_w;
    __device__ __forceinline__ void operator()(const f32x4 (&acc)[2][2][4][2], const Unit& u, int wr, int wc, int fr, int fq) const {
        const int row0 = u.pm * BM + wr * 64 + fr, col0 = (u.pn & 1) * 128 + wc * 32 + 8 * fq;
#pragma unroll
        for (int ai = 0; ai < 2; ++ai)
#pragma unroll
            for (int m = 0; m < 4; ++m) { const int row = row0 + ai * HALF + m * 16; const float w = slot_w[row];
                float h[8];
#pragma unroll
                for (int n = 0; n < 2; ++n)
#pragma unroll
                    for (int j = 0; j < 4; ++j) { const float gv = acc[ai][0][m][n][j], uv = acc[ai][1][m][n][j]; h[n * 4 + j] = gv / (1.f + __expf(-gv)) * uv * w; }
                u32x4 o; o.x = cvt_pk_bf16(h[0], h[1]); o.y = cvt_pk_bf16(h[2], h[3]); o.z = cvt_pk_bf16(h[4], h[5]); o.w = cvt_pk_bf16(h[6], h[7]);
                *(u32x4*)(H + (size_t)row * 256 + col0) = o; }
    }
};
struct EpiY8 {
    unsigned char* Y8;
    __device__ __forceinline__ void operator()(const f32x4 (&acc)[2][2][4][2], const Unit& u, int wr, int wc, int fr, int fq) const {
        const int row0 = u.pm * BM + wr * 64 + fr; unsigned char* base = Y8 + ((size_t)(u.pn & 3) * MAXSLOT + row0) * 256 + wc * 64 + 16 * fq;
#pragma unroll
        for (int ai = 0; ai < 2; ++ai)
#pragma unroll
            for (int m = 0; m < 4; ++m) { unsigned w[4];
#pragma unroll
                for (int bj = 0; bj < 2; ++bj) { f32x4 v0 = acc[ai][bj][m][0] * (Y8_SCALE * DN_DESCALE), v1 = acc[ai][bj][m][1] * (Y8_SCALE * DN_DESCALE);
#pragma unroll
                    for (int q = 0; q < 4; ++q) { v0[q] = fminf(fmaxf(v0[q], -440.f), 440.f); v1[q] = fminf(fmaxf(v1[q], -440.f), 440.f); }
                    int w0 = __builtin_amdgcn_cvt_pk_fp8_f32(v0[0], v0[1], 0, false); w0 = __builtin_amdgcn_cvt_pk_fp8_f32(v0[2], v0[3], w0, true);
                    int w1 = __builtin_amdgcn_cvt_pk_fp8_f32(v1[0], v1[1], 0, false); w1 = __builtin_amdgcn_cvt_pk_fp8_f32(v1[2], v1[3], w1, true);
                    w[2 * bj] = (unsigned)w0; w[2 * bj + 1] = (unsigned)w1; }
                *(u32x4*)(base + (size_t)(ai * HALF + m * 16) * 256) = (u32x4){w[0], w[1], w[2], w[3]}; }
    }
};
struct EpiDown {
    bf16_t* Y; bf16_t* X; const float* modl5;
    __device__ __forceinline__ void operator()(const f32x4 (&acc)[2][2][4][2], const Unit& u, int wr, int wc, int fr, int fq) const {
        asm volatile("" : "+v"(fr), "+v"(fq));
        if (u.pm < MAXSLOT / 256) { const EpiY8 e{(unsigned char*)Y}; e(acc, u, wr, wc, fr, fq); }
        else { const EpiRes e{X, nullptr, nullptr, modl5, MAXSLOT / 256, DN_DESCALE, true}; e(acc, u, wr, wc, fr, fq); }
    }
};
}


__device__ __forceinline__ void ph_inproj_f(KP p, int l, unsigned char* lds) {
    pg8::Gemm g{(const bf16_t*)(p->ws + Z_A), (const bf16_t*)(p->ws + win_off(l)), R_ALL, DIN, 1024};
    pg8::StaticOrder S; S.init(R_ALL, DIN, gsz_(), bid_());
    pg8::EpiBf16 E{(bf16_t*)(p->ws + Z_P), DIN, DIN / 256, 256};
    pg8::gemm_phase<pg8::EpiBf16, pg8::StaticOrder, false>((LAS unsigned char*)lds, g, S, E, nullptr);
    if (l == 0 && DEPTH > 1 && gsz_() == 256) { __syncthreads(); ph_cvt(p, 1, lds, 214, 42, 0, CVT_E1); }
}
__device__ __forceinline__ void ph_outproj_f(KP p, int l, unsigned char* lds) {
    const int T = (l == 0) ? R_ALL : R_LAT;
    pg8::Gemm g{(const bf16_t*)(p->ws + Z_YCAT), (const bf16_t*)(p->ws + wout_off(l)), T, 1024, 1024};
    pg8::StaticOrder S; S.init(T, 1024, gsz_(), bid_());
    bf16_t* X = (bf16_t*)(p->ws + WS_X);
    pg8::EpiRes E{X, l == 0 ? p->in[0] : nullptr, l == 0 ? p->in[2] : nullptr, (const float*)(p->ws + WS_MOD) + (size_t)l * 3 * 6144 + 2 * 1024, 0, 1.f};
    pg8::gemm_phase<pg8::EpiRes, pg8::StaticOrder, false>((LAS unsigned char*)lds, g, S, E, nullptr);
    if (l == 0 && DEPTH > 1) {
        const int G = gsz_(); __syncthreads();
        if (G == 256) ph_cvt(p, 1, lds, 8, 248, CVT_E2, 1 << 30); else ph_cvt(p, 1, lds); }
}
struct QkvLane { f32x4 gg0, gg1, gw0, gw1; };
__device__ __forceinline__ QkvLane qkv_lane_consts(KP p, int l, int lane) {
    QkvLane c; const int dch = (lane & 7) * 8; const int isk = lane >= 32;
    const float* gq = p->in[isk ? 11 : 10] + l * 64 + dch; const float* wq = p->in[isk ? 13 : 12] + l * 64 + dch;
    c.gg0 = *(const f32x4*)gq; c.gg1 = *(const f32x4*)(gq + 4); c.gw0 = *(const f32x4*)wq; c.gw1 = *(const f32x4*)(wq + 4); return c;
}
__device__ __forceinline__ void prep_qkv_row(KP p, int l, int row, int lane, const QkvLane& qc) {
    const bf16_t* pr = (const bf16_t*)(p->ws + Z_P) + (size_t)row * DIN;
    const bool isctx = row >= R_LAT; const int b = isctx ? ((row - R_LAT) >> 8) : (row >> 13), t = isctx ? ((row - R_LAT) & 255) : (row & 8191);
    const size_t krow = (size_t)b * NKEY + (isctx ? NSEQ + t : t);
    const int l7 = lane & 7, axis = l7 >> 2, half = (l7 >> 1) & 1;
    f32x4 cs0 = (f32x4){1.f, 1.f, 1.f, 1.f}, cs1 = cs0, sn0 = (f32x4){0.f, 0.f, 0.f, 0.f}, sn1 = sn0;
    if (!isctx) { const int pos = axis == 0 ? (t >> 6) : (t & 63); const float* rt = (const float*)(p->ws + WS_ROPE) + pos * 32 + (lane & 1) * 8;
        cs0 = *(const f32x4*)rt; cs1 = *(const f32x4*)(rt + 4); sn0 = *(const f32x4*)(rt + 16); sn1 = *(const f32x4*)(rt + 20); }
    const u32x4 ra = *(const u32x4*)(pr + lane * 8), rb = *(const u32x4*)(pr + 512 + lane * 8);
#pragma unroll
    for (int grp = 0; grp < 2; ++grp) {
        const u32x4 r = grp ? rb : ra;
        bf16_t* Qd = (bf16_t*)(p->ws + (isctx ? (grp ? Z_QWC : Z_QGC) : (grp ? Z_QW : Z_QG))) + (size_t)(isctx ? (b * NCTX + t) : row) * 256;
        bf16_t* Kd = (bf16_t*)(p->ws + (grp ? Z_KW : Z_KG)) + krow * 128; bf16_t* Vd = (bf16_t*)(p->ws + (grp ? Z_VW : Z_VG)) + krow * 128;
        if (lane >= 48) { *(u32x4*)(Vd + (lane - 48) * 8) = r; continue; }
        float x[8] = {bf2f(r.x & 0xffffu), bf2f(r.x >> 16), bf2f(r.y & 0xffffu), bf2f(r.y >> 16), bf2f(r.z & 0xffffu), bf2f(r.z >> 16), bf2f(r.w & 0xffffu), bf2f(r.w >> 16)};
        float ss = 0.f;
#pragma unroll
        for (int i = 0; i < 8; ++i) ss += x[i] * x[i];
        ss += __shfl_xor(ss, 1); ss += __shfl_xor(ss, 2); ss += __shfl_xor(ss, 4);
        const float rinv = rsqrtf(ss * (1.f / 64.f) + EPS);
        const f32x4 g0 = grp ? qc.gw0 : qc.gg0, g1 = grp ? qc.gw1 : qc.gg1;
        const float gv[8] = {g0.x, g0.y, g0.z, g0.w, g1.x, g1.y, g1.z, g1.w};
        const float cv[8] = {cs0.x, cs0.y, cs0.z, cs0.w, cs1.x, cs1.y, cs1.z, cs1.w}, sv[8] = {sn0.x, sn0.y, sn0.z, sn0.w, sn1.x, sn1.y, sn1.z, sn1.w};
        const float qs = (lane < 32) ? QSCALE : 1.f;
        float y[8];
#pragma unroll
        for (int i = 0; i < 8; ++i) { const float v = x[i] * rinv * gv[i]; const float o = __shfl_xor(v, 2);
            y[i] = ((half == 0) ? (v * cv[i] - o * sv[i]) : (o * sv[i] + v * cv[i])) * qs; }
        u32x4 ov; ov.x = pk2(y[0], y[1]); ov.y = pk2(y[2], y[3]); ov.z = pk2(y[4], y[5]); ov.w = pk2(y[6], y[7]);
        if (lane < 32) *(u32x4*)(Qd + lane * 8) = ov; else *(u32x4*)(Kd + (lane - 32) * 8) = ov;
    }
}

template <int R> __device__ __forceinline__ void dw_rows(const float* hcol, const float (&wj)[31], float (&acc)[32]) {
    if constexpr (R < 62) {
        const float hv = hcol[R * 256];
        constexpr int T0 = (R - 30 > 0) ? R - 30 : 0, T1 = (R < 31) ? R : 31;
#pragma unroll
        for (int tt = T0; tt <= T1; ++tt) acc[tt] += hv * wj[R - tt];
        dw_rows<R + 1>(hcol, wj, acc);
    }
}
__device__ __forceinline__ void conv_tile(KP p, int l, unsigned char* lds, int seq_row0, int seqlen, int t0) {
    float* hb = (float*)lds;
    const int tid = tid_(), lane = tid & 63, wid = tid >> 6;
    const bf16_t* P = (const bf16_t*)(p->ws + Z_P);
    for (int i = tid; i < 94 * 32; i += NTHREADS) { const int r = i >> 5, c8 = (i & 31) * 8, t = t0 - 15 + r;
        f32x4 h0 = (f32x4){0.f, 0.f, 0.f, 0.f}, h1 = h0;
        if (t >= 0 && t < seqlen) { const bf16_t* pr = P + (size_t)(seq_row0 + t) * DIN;
            const u32x4 vv = *(const u32x4*)(pr + C_CVV + c8), gg = *(const u32x4*)(pr + C_CVG + c8);
            h0.x = bf2f(vv.x & 0xffffu) * sigmoid_(bf2f(gg.x & 0xffffu)); h0.y = bf2f(vv.x >> 16) * sigmoid_(bf2f(gg.x >> 16));
            h0.z = bf2f(vv.y & 0xffffu) * sigmoid_(bf2f(gg.y & 0xffffu)); h0.w = bf2f(vv.y >> 16) * sigmoid_(bf2f(gg.y >> 16));
            h1.x = bf2f(vv.z & 0xffffu) * sigmoid_(bf2f(gg.z & 0xffffu)); h1.y = bf2f(vv.z >> 16) * sigmoid_(bf2f(gg.z >> 16));
            h1.z = bf2f(vv.w & 0xffffu) * sigmoid_(bf2f(gg.w & 0xffffu)); h1.w = bf2f(vv.w >> 16) * sigmoid_(bf2f(gg.w >> 16)); }
        *(f32x4*)(hb + r * 256 + c8) = h0; *(f32x4*)(hb + r * 256 + c8 + 4) = h1; }
    __syncthreads();
    { const int c = tid & 255, hf = tid >> 8;
      const float* w = p->in[15] + (size_t)l * 31 * 256 + c; const float bias = p->in[16][l * 256 + c];
      float wj[31];
#pragma unroll
      for (int j = 0; j < 31; ++j) wj[j] = w[j * 256];
      float acc[32];
#pragma unroll
      for (int tt = 0; tt < 32; ++tt) acc[tt] = bias;
      dw_rows<0>(hb + hf * 32 * 256 + c, wj, acc);
      __syncthreads();
#pragma unroll
      for (int tt = 0; tt < 32; ++tt) hb[(hf * 32 + tt) * 256 + c] = acc[tt];
    }
    __syncthreads();
    constexpr int AS = 264;
    bf16_t* ab = (bf16_t*)(lds + 94 * 256 * 4);
    for (int tt = wid; tt < 64; tt += 8) { const float* r = hb + tt * 256; const f32x4 v = ((const f32x4*)r)[lane];
        const float mean = wave_sum(v.x + v.y + v.z + v.w) * (1.f / 256.f);
        const float dx = v.x - mean, dy = v.y - mean, dz = v.z - mean, dw = v.w - mean;
        const float rstd = rsqrtf(wave_sum(dx * dx + dy * dy + dz * dz + dw * dw) * (1.f / 256.f) + EPS);
        const f32x4 g = ((const f32x4*)(p->in[17] + l * 256))[lane], bb = ((const f32x4*)(p->in[18] + l * 256))[lane];
        u32x2 o; o.x = pk2(silu_(dx * rstd * g.x + bb.x), silu_(dy * rstd * g.y + bb.y)); o.y = pk2(silu_(dz * rstd * g.z + bb.z), silu_(dw * rstd * g.w + bb.w));
        *(u32x2*)(ab + tt * AS + lane * 4) = o; }
    __syncthreads();
    { const int fr = lane & 15, fq = lane >> 4;
      const bf16_t* Wt = (const bf16_t*)(p->ws + wpw_off(l));
      bf16x8 bw[2][8];
#pragma unroll
      for (int j = 0; j < 2; ++j)
#pragma unroll
          for (int ks = 0; ks < 8; ++ks) bw[j][ks] = *(const bf16x8*)(Wt + (size_t)((wid * 2 + j) * 16 + fr) * 256 + ks * 32 + fq * 8);
      const float bias0 = p->in[20][l * 256 + wid * 32 + fr], bias1 = p->in[20][l * 256 + wid * 32 + 16 + fr];
      bf16_t* Y = (bf16_t*)(p->ws + Z_YCAT);
#pragma unroll 1
      for (int tr = 0; tr < 4; ++tr) { f32x4 a0 = (f32x4){0.f, 0.f, 0.f, 0.f}, a1 = a0;
#pragma unroll
          for (int ks = 0; ks < 8; ++ks) { const bf16x8 av = *(const bf16x8*)(ab + (tr * 16 + fr) * AS + ks * 32 + fq * 8);
              a0 = __builtin_amdgcn_mfma_f32_16x16x32_bf16(av, bw[0][ks], a0, 0, 0, 0); a1 = __builtin_amdgcn_mfma_f32_16x16x32_bf16(av, bw[1][ks], a1, 0, 0, 0); }
#pragma unroll
          for (int r = 0; r < 4; ++r) { const int t = t0 + tr * 16 + fq * 4 + r; bf16_t* yr = Y + (size_t)(seq_row0 + t) * D + 256 + wid * 32 + fr;
              yr[0] = (bf16_t)f2bf(a0[r] + bias0); yr[16] = (bf16_t)f2bf(a1[r] + bias1); } }
    }
    __syncthreads();
}

__device__ __forceinline__ int hgrn_chunk_row0(int b, int dir, int j) {
    if (j < 4) { const int cj = dir ? 3 - j : j; return R_LAT + b * NCTX + cj * 64; }
    const int jj = j - 4, cj = dir ? 127 - jj : jj; return b * NSEQ + cj * 64;
}
__device__ __forceinline__ void hgrn_load_chunk(KP p, int l, int row0, int dir, int head, float* qs, float* vs, float* ks, float* cs) {
    const int tid = tid_();
    const bf16_t* P = (const bf16_t*)(p->ws + Z_P);
    const float* lbv = (const float*)(p->ws + WS_LB) + (l * 2 + dir) * 256 + head * 64;
    for (int i = tid; i < 4096; i += NTHREADS) { const int tau = i >> 6, d = i & 63; const int row = row0 + (dir ? 63 - tau : tau);
        const bf16_t* pr = P + (size_t)row * DIN + head * 64 + d;
        if (qs) qs[i] = bf2f(pr[C_RQ]);
        vs[i] = bf2f(pr[C_RI]);
        const float z = bf2f(pr[dir ? C_RFB : C_RFF]); const float lb = lbv[d];
        const float lsp = fminf(z, 0.f) - log1pf(__expf(-fabsf(z)));
        float logf = lsp;
        if (lb > 0.f) { const float a = lsp, bq = __logf(lb) + (lsp - z); const float mx = fmaxf(a, bq); logf = mx + log1pf(__expf(-fabsf(a - bq))); }
        ks[i] = (1.f - lb) * sigmoid_(-z);
        cs[i] = logf; }
    __syncthreads();
    if (tid < 64) { float c = 0.f; for (int tau = 0; tau < 64; ++tau) { c += cs[tau * 64 + tid]; cs[tau * 64 + tid] = c; } }
    __syncthreads();
}
__device__ __forceinline__ void hgrn_pass1_unit(KP p, int l, unsigned char* lds, int unit) {
    float* vs = (float*)lds; float* ks = vs + 4096; float* cs = ks + 4096;
    const int tid = tid_();
    const int j = unit % NCHUNK, seq = unit / NCHUNK, dir = seq & 1, head = (seq >> 1) & 3, b = seq >> 3;
    hgrn_load_chunk(p, l, hgrn_chunk_row0(b, dir, j), dir, head, nullptr, vs, ks, cs);
    for (int i = tid; i < 4096; i += NTHREADS) { const int d = i & 63; ks[i] *= __expf(cs[63 * 64 + d] - cs[i]); }
    __syncthreads();
    float* U = (float*)(p->ws + Z_U) + ((size_t)seq * NCHUNK + j) * 4096; float* Gv = (float*)(p->ws + Z_G) + ((size_t)seq * NCHUNK + j) * 64;
    { const int d = tid >> 3, e0 = (tid & 7) * 8; float acc[8];
#pragma unroll
      for (int e = 0; e < 8; ++e) acc[e] = 0.f;
      for (int tau = 0; tau < 64; ++tau) { const float kv = ks[tau * 64 + d];
#pragma unroll
          for (int e = 0; e < 8; ++e) acc[e] += kv * vs[tau * 64 + e0 + e]; }
#pragma unroll
      for (int e = 0; e < 8; ++e) U[d * 64 + e0 + e] = acc[e]; }
    if (tid < 64) Gv[tid] = __expf(cs[63 * 64 + tid]);
    __syncthreads();
}
constexpr int HS = 72;
constexpr int HL_TOT = 0, HL_OSUM = 2048, HL_T0 = 18432, HL_TB = 64 * HS * 2;
__device__ __forceinline__ f32x4 mm64(const bf16_t* A, const bf16_t* Bt, int tr, int tc, int fr, int fq, f32x4 acc) {
#pragma unroll
    for (int k0 = 0; k0 < 64; k0 += 32) { const bf16x8 a = *(const bf16x8*)(A + (tr * 16 + fr) * HS + k0 + fq * 8), b = *(const bf16x8*)(Bt + (tc * 16 + fr) * HS + k0 + fq * 8);
        acc = __builtin_amdgcn_mfma_f32_16x16x32_bf16(a, b, acc, 0, 0, 0); }
    return acc;
}
__device__ __forceinline__ void hgrn_load8(KP p, int row0, int dir, int head, int tid, float (&q)[8], float (&vv)[8], float (&z)[8]) {
    const int d = tid & 63, seg = tid >> 6;
    const bf16_t* P = (const bf16_t*)(p->ws + Z_P);
#pragma unroll
    for (int i = 0; i < 8; ++i) { const int tau = seg * 8 + i; const int row = row0 + (dir ? 63 - tau : tau);
        const bf16_t* pr = P + (size_t)row * DIN + head * 64 + d;
        q[i] = bf2f(pr[C_RQ]); vv[i] = bf2f(pr[C_RI]); z[i] = bf2f(pr[dir ? C_RFB : C_RFF]); }
}
__device__ __forceinline__ void hgrn_gate8(KP p, int l, int dir, int head, int tid, float* tot, const float (&z)[8], float (&kg)[8], float (&c)[8], float& m, float& cl) {
    const int d = tid & 63, seg = tid >> 6;
    const float lb = ((const float*)(p->ws + WS_LB))[(l * 2 + dir) * 256 + head * 64 + d];
    float run = 0.f;
#pragma unroll
    for (int i = 0; i < 8; ++i) {
        const float ez = __expf(-fabsf(z[i])), rz = __builtin_amdgcn_rcpf(1.f + ez); const float sg = (z[i] >= 0.f) ? rz : ez * rz;
        const float f = lb + (1.f - lb) * sg;
        kg[i] = 1.f - f;
        run += __logf(f); c[i] = run; }
    tot[seg * 64 + d] = run;
    __syncthreads();
    float off = 0.f; m = 0.f; cl = 0.f;
#pragma unroll
    for (int s2 = 0; s2 < 8; ++s2) { const float t = tot[s2 * 64 + d]; if (s2 < seg) off += t; if (s2 < 4) m += t; cl += t; }
#pragma unroll
    for (int i = 0; i < 8; ++i) c[i] += off;
}
__device__ __forceinline__ u32x4 pack8(const float (&x)[8]) { u32x4 o; o.x = pk2(x[0], x[1]); o.y = pk2(x[2], x[3]); o.z = pk2(x[4], x[5]); o.w = pk2(x[6], x[7]); return o; }
__device__ __forceinline__ void hgrn_pass1_f(KP p, int l, unsigned char* lds, int unit) {
    const int tid = tid_(), lane = tid & 63, wid = tid >> 6, fr = lane & 15, fq = lane >> 4, d = tid & 63, seg = tid >> 6;
    float* tot = (float*)(lds + HL_TOT); bf16_t* Vt = (bf16_t*)(lds + HL_T0); bf16_t* KbT = (bf16_t*)(lds + HL_T0 + HL_TB);
    const int j = unit % NCHUNK, seq = unit / NCHUNK, dir = seq & 1, head = (seq >> 1) & 3, b = seq >> 3;
    float q[8], vv[8], z[8], kg[8], c[8], m, cl;
    hgrn_load8(p, hgrn_chunk_row0(b, dir, j), dir, head, tid, q, vv, z);
    hgrn_gate8(p, l, dir, head, tid, tot, z, kg, c, m, cl);
    float kb[8];
#pragma unroll
    for (int i = 0; i < 8; ++i) kb[i] = kg[i] * __expf(cl - c[i]);
    *(u32x4*)(Vt + d * HS + seg * 8) = pack8(vv);
    *(u32x4*)(KbT + d * HS + seg * 8) = pack8(kb);
    float* U = (float*)(p->ws + Z_U) + ((size_t)seq * NCHUNK + j) * 4096; float* Gv = (float*)(p->ws + Z_G) + ((size_t)seq * NCHUNK + j) * 64;
    if (seg == 0) Gv[d] = __expf(cl);
    __syncthreads();
    const int tr = wid >> 1;
#pragma unroll
    for (int t2 = 0; t2 < 2; ++t2) { const int tc = (wid & 1) * 2 + t2;
        const f32x4 acc = mm64(Vt, KbT, tr, tc, fr, fq, (f32x4){0.f, 0.f, 0.f, 0.f});
#pragma unroll
        for (int r = 0; r < 4; ++r) U[(tr * 16 + fq * 4 + r) * 64 + tc * 16 + fr] = acc[r]; }
    __syncthreads();
}
struct HgrnIn1 { float v[8], zf[8], zb[8]; };
__device__ __forceinline__ void hgrn_p1_load(KP p, int unit, int tid, HgrnIn1& r) {
    const int cpos = unit % NCHUNK, head = (unit / NCHUNK) & 3, b = unit / (NCHUNK * 4), d = tid & 63, seg = tid >> 6;
    const int row0 = (cpos < 4) ? R_LAT + b * NCTX + cpos * 64 : b * NSEQ + (cpos - 4) * 64;
    const bf16_t* P = (const bf16_t*)(p->ws + Z_P) + (size_t)(row0 + seg * 8) * DIN + head * 64 + d;
#pragma unroll
    for (int i = 0; i < 8; ++i) { const bf16_t* pr = P + (size_t)i * DIN; r.v[i] = bf2f(pr[C_RI]); r.zf[i] = bf2f(pr[C_RFF]); r.zb[i] = bf2f(pr[C_RFB]); }
}
__device__ __forceinline__ void hgrn_p1_compute(KP p, int l, unsigned char* lds, int unit, int tid, const HgrnIn1& r) {
    const int lane = tid & 63, wid = tid >> 6, fr = lane & 15, fq = lane >> 4, d = tid & 63, seg = tid >> 6;
    float* totf = (float*)(lds + HL_TOT); float* totb = (float*)(lds + HL_OSUM);
    bf16_t* Vt = (bf16_t*)(lds + HL_T0); bf16_t* KfT = (bf16_t*)(lds + HL_T0 + HL_TB); bf16_t* KbT = (bf16_t*)(lds + HL_T0 + 2 * HL_TB);
    const int cpos = unit % NCHUNK, head = (unit / NCHUNK) & 3, b = unit / (NCHUNK * 4);
    const float* lbp = (const float*)(p->ws + WS_LB) + (l * 2) * 256 + head * 64 + d; const float lbf = lbp[0], lbb = lbp[256];
    float kf[8], kb[8], cf[8], cb[8], lfb[8], runf = 0.f, runb = 0.f;
#pragma unroll
    for (int i = 0; i < 8; ++i) {
        { const float z = r.zf[i], ez = __expf(-fabsf(z)), rz = __builtin_amdgcn_rcpf(1.f + ez), sg = (z >= 0.f) ? rz : ez * rz, f = lbf + (1.f - lbf) * sg; kf[i] = 1.f - f; runf += __logf(f); cf[i] = runf; }
        { const float z = r.zb[i], ez = __expf(-fabsf(z)), rz = __builtin_amdgcn_rcpf(1.f + ez), sg = (z >= 0.f) ? rz : ez * rz, f = lbb + (1.f - lbb) * sg; kb[i] = 1.f - f; lfb[i] = __logf(f); runb += lfb[i]; cb[i] = runb; } }
    totf[seg * 64 + d] = runf; totb[seg * 64 + d] = runb;
    __syncthreads();
    float offf = 0.f, offb = 0.f, clf = 0.f, clb = 0.f;
#pragma unroll
    for (int s2 = 0; s2 < 8; ++s2) { const float tf = totf[s2 * 64 + d], tb = totb[s2 * 64 + d]; if (s2 < seg) { offf += tf; offb += tb; } clf += tf; clb += tb; }
#pragma unroll
    for (int i = 0; i < 8; ++i) { kf[i] *= __expf(clf - (cf[i] + offf)); kb[i] *= __expf(cb[i] + offb - lfb[i]); }
    *(u32x4*)(Vt + d * HS + seg * 8) = pack8(r.v);
    *(u32x4*)(KfT + d * HS + seg * 8) = pack8(kf);
    *(u32x4*)(KbT + d * HS + seg * 8) = pack8(kb);
    const int jf = cpos, jb = (cpos < 4) ? 3 - cpos : 4 + 127 - (cpos - 4); const int seqf = (b * 4 + head) * 2;
    bf16_t* Uf = (bf16_t*)(p->ws + Z_U) + ((size_t)seqf * NCHUNK + jf) * 4096; bf16_t* Ub = (bf16_t*)(p->ws + Z_U) + ((size_t)(seqf + 1) * NCHUNK + jb) * 4096;
    float* Gf = (float*)(p->ws + Z_G) + ((size_t)seqf * NCHUNK + jf) * 64; float* Gb = (float*)(p->ws + Z_G) + ((size_t)(seqf + 1) * NCHUNK + jb) * 64;
    if (seg == 0) { Gf[d] = __expf(clf); Gb[d] = __expf(clb); }
    __syncthreads();
    const int tr = wid >> 1;
#pragma unroll
    for (int t2 = 0; t2 < 2; ++t2) { const int tc = (wid & 1) * 2 + t2;
        const f32x4 af = mm64(Vt, KfT, tr, tc, fr, fq, (f32x4){0.f, 0.f, 0.f, 0.f}), ab = mm64(Vt, KbT, tr, tc, fr, fq, (f32x4){0.f, 0.f, 0.f, 0.f});
#pragma unroll
        for (int q = 0; q < 4; ++q) { const int o = (tr * 16 + fq * 4 + q) * 64 + tc * 16 + fr; Uf[o] = (bf16_t)f2bf(af[q]); Ub[o] = (bf16_t)f2bf(ab[q]); } }
    __syncthreads();
}
__device__ __forceinline__ void hgrn_pass1_run(KP p, int l, unsigned char* lds, int u0, int un, int ustep) {
    if (un <= 0) return;
    const int tid = tid_();
    HgrnIn1 cur; hgrn_p1_load(p, u0, tid, cur);
    for (int k = 0; k < un; ++k) { const int u = u0 + k * ustep;
        HgrnIn1 nxt = cur; if (k + 1 < un) hgrn_p1_load(p, u + ustep, tid, nxt);
        hgrn_p1_compute(p, l, lds, u, tid, cur);
        cur = nxt; }
}
__device__ __forceinline__ void hgrn_scan_f(KP p) {
    const int tid = tid_();
    if (tid >= 256) return;
    for (int gi = bid_() * 256 + tid; gi < 16 * 4096; gi += gsz_() * 256) {
    const int seq = gi >> 12, ed = gi & 4095, d = ed & 63;
    bf16_t* U = (bf16_t*)(p->ws + Z_U) + (size_t)seq * NCHUNK * 4096 + ed; const float* Gv = (const float*)(p->ws + Z_G) + (size_t)seq * NCHUNK * 64 + d;
    float S = 0.f;
#pragma unroll 1
    for (int j = 0; j < NCHUNK; j += 12) {
        float u[12], g[12];
#pragma unroll
        for (int q = 0; q < 12; ++q) { u[q] = bf2f(U[(size_t)(j + q) * 4096]); g[q] = Gv[(j + q) * 64]; }
#pragma unroll
        for (int q = 0; q < 12; ++q) { U[(size_t)(j + q) * 4096] = (bf16_t)f2bf(S); S = g[q] * S + u[q]; }
    }
    }
}
struct HgrnIn3 { float q[8], v[8], zf[8], zb[8], gg[8]; u32x4 sf, sb; };
__device__ __forceinline__ void hgrn_p3_load(KP p, int unit, int tid, HgrnIn3& r) {
    const int cpos = unit % NCHUNK, head = (unit / NCHUNK) & 3, b = unit / (NCHUNK * 4), d = tid & 63, seg = tid >> 6;
    const int row0 = (cpos < 4) ? R_LAT + b * NCTX + cpos * 64 : b * NSEQ + (cpos - 4) * 64;
    const bf16_t* P = (const bf16_t*)(p->ws + Z_P) + (size_t)(row0 + seg * 8) * DIN + head * 64 + d;
#pragma unroll
    for (int i = 0; i < 8; ++i) { const bf16_t* pr = P + (size_t)i * DIN; r.q[i] = bf2f(pr[C_RQ]); r.v[i] = bf2f(pr[C_RI]); r.zf[i] = bf2f(pr[C_RFF]); r.zb[i] = bf2f(pr[C_RFB]);
        r.gg[i] = bf2f(((const bf16_t*)(p->ws + Z_P))[(size_t)(row0 + seg + 8 * i) * DIN + C_RG + head * 64 + d]); }
    const int jf = cpos, jb = (cpos < 4) ? 3 - cpos : 4 + 127 - (cpos - 4); const int seqf = (b * 4 + head) * 2;
    const bf16_t* U = (const bf16_t*)(p->ws + Z_U);
    r.sf = *(const u32x4*)(U + ((size_t)seqf * NCHUNK + jf) * 4096 + tid * 8); r.sb = *(const u32x4*)(U + ((size_t)(seqf + 1) * NCHUNK + jb) * 4096 + tid * 8);
}
__device__ __forceinline__ void hgrn_p3_compute(KP p, int l, unsigned char* lds, int unit, int tid, const HgrnIn3& r) {
    const int lane = tid & 63, wid = tid >> 6, fr = lane & 15, fq = lane >> 4, d = tid & 63, seg = tid >> 6;
    float* tot = (float*)(lds + HL_TOT); float* os = (float*)(lds + HL_OSUM);
    bf16_t* Qt = (bf16_t*)(lds + HL_T0); bf16_t* Kt = (bf16_t*)(lds + HL_T0 + HL_TB); bf16_t* Qb = (bf16_t*)(lds + HL_T0 + 2 * HL_TB);
    bf16_t* St = (bf16_t*)(lds + HL_T0 + 3 * HL_TB); bf16_t* Vt = (bf16_t*)(lds + HL_T0 + 4 * HL_TB); bf16_t* Sc = (bf16_t*)(lds + HL_T0 + 5 * HL_TB);
    const int cpos = unit % NCHUNK, head = (unit / NCHUNK) & 3, b = unit / (NCHUNK * 4);
    const int row0 = (cpos < 4) ? R_LAT + b * NCTX + cpos * 64 : b * NSEQ + (cpos - 4) * 64;
    const int tr = wid >> 1;
    const float* lbp = (const float*)(p->ws + WS_LB) + (l * 2) * 256 + head * 64 + d;
#pragma unroll
    for (int dir = 0; dir < 2; ++dir) {
        const float lb = lbp[dir * 256];
        float kg[8], c[8], run = 0.f;
#pragma unroll
        for (int ii = 0; ii < 8; ++ii) { const int i = dir ? 7 - ii : ii;
            const float z = dir ? r.zb[i] : r.zf[i];
            const float ez = __expf(-fabsf(z)), rz = __builtin_amdgcn_rcpf(1.f + ez), sg = (z >= 0.f) ? rz : ez * rz, f = lb + (1.f - lb) * sg;
            kg[i] = 1.f - f; run += __logf(f); c[i] = run; }
        tot[seg * 64 + d] = run;
        __syncthreads();
        float off = 0.f, m = 0.f;
#pragma unroll
        for (int s2 = 0; s2 < 8; ++s2) { const float t = tot[s2 * 64 + d]; if (dir ? (s2 > seg) : (s2 < seg)) off += t; if (dir ? (s2 >= 4) : (s2 < 4)) m += t; }
        float vr[8];
#pragma unroll
        for (int i = 0; i < 8; ++i) { const float ci = c[i] + off; const int tau = dir ? 63 - (seg * 8 + i) : seg * 8 + i; const float qv = r.q[i];
            Qt[tau * HS + d] = (bf16_t)f2bf(qv * __expf(fminf(ci - m, 80.f)));
            Kt[tau * HS + d] = (bf16_t)f2bf(kg[i] * __expf(fminf(m - ci, 80.f)));
            Qb[tau * HS + d] = (bf16_t)f2bf(qv * __expf(ci));
            vr[i] = dir ? r.v[7 - i] : r.v[i]; }
        *(u32x4*)(Vt + d * HS + (dir ? 7 - seg : seg) * 8) = pack8(vr);
        *(u32x4*)(St + (tid >> 3) * HS + (tid & 7) * 8) = dir ? r.sb : r.sf;
        __syncthreads();
        f32x4 oacc[2];
#pragma unroll
        for (int t2 = 0; t2 < 2; ++t2) { const int tc = (wid & 1) * 2 + t2;
            oacc[t2] = mm64(Qb, St, tr, tc, fr, fq, (f32x4){0.f, 0.f, 0.f, 0.f});
            f32x4 sacc = (f32x4){0.f, 0.f, 0.f, 0.f};
            if (tc <= tr) sacc = mm64(Qt, Kt, tr, tc, fr, fq, sacc);
#pragma unroll
            for (int q = 0; q < 4; ++q) { const int tau = tr * 16 + fq * 4 + q, sig = tc * 16 + fr; Sc[tau * HS + sig] = (bf16_t)f2bf(sig <= tau ? sacc[q] : 0.f); } }
        __syncthreads();
#pragma unroll
        for (int t2 = 0; t2 < 2; ++t2) { const int tc = (wid & 1) * 2 + t2;
            oacc[t2] = mm64(Sc, Vt, tr, tc, fr, fq, oacc[t2]);
#pragma unroll
            for (int q = 0; q < 4; ++q) { const int tau = tr * 16 + fq * 4 + q, e = tc * 16 + fr, tok = dir ? 63 - tau : tau;
                if (dir == 0) os[tok * 64 + e] = oacc[t2][q]; else os[tok * 64 + e] += oacc[t2][q]; } }
        __syncthreads();
    }
    bf16_t* Y = (bf16_t*)(p->ws + Z_YCAT); const float ong = p->in[22][l * 64 + lane];
#pragma unroll
    for (int i = 0; i < 8; ++i) { const int tok = wid + 8 * i; const float v = os[tok * 64 + lane];
        const float y = v * rsqrtf(wave_sum(v * v) * (1.f / 64.f) + EPS) * ong;
        Y[(size_t)(row0 + tok) * D + 768 + head * 64 + lane] = (bf16_t)f2bf(y * silu_(r.gg[i])); }
    __syncthreads();
}
__device__ __forceinline__ int hgrn_p3_unit(int k) { if (k < 1024) { const int bh = k >> 7, c = k & 127; return bh * NCHUNK + 4 + c; } const int k2 = k - 1024; return (k2 >> 2) * NCHUNK + (k2 & 3); }
__device__ __forceinline__ void hgrn_pass3_run(KP p, int l, unsigned char* lds) {
    const int tid = tid_(), G = gsz_(), nunits = 1024 + (l == 0 ? 32 : 0);
    int k = bid_(); if (k >= nunits) return;
    HgrnIn3 cur; hgrn_p3_load(p, hgrn_p3_unit(k), tid, cur);
    for (;;) { const int kn = k + G; const bool more = kn < nunits;
        HgrnIn3 nxt = cur; if (more) hgrn_p3_load(p, hgrn_p3_unit(kn), tid, nxt);
        hgrn_p3_compute(p, l, lds, hgrn_p3_unit(k), tid, cur);
        if (!more) break;
        cur = nxt; k = kn; }
}
__device__ __forceinline__ void ph_prep(KP p, int l, unsigned char* lds) {
    const int tid = tid_(), lane = tid & 63, wid = tid >> 6, bid = bid_(), G = gsz_();
    const int nconv = 256 + (l == 0 ? 8 : 0);
    for (int it = bid; it < nconv; it += G) {
        if (it < 256) conv_tile(p, l, lds, (it >> 7) * NSEQ, NSEQ, (it & 127) * 64);
        else { const int c = it - 256; conv_tile(p, l, lds, R_LAT + (c >> 2) * NCTX, NCTX, (c & 3) * 64); } }
    if (G == 256) {
        const int u0 = bid < 8 ? 2 * bid : bid < 56 ? 16 + 5 * (bid - 8) : 256 + 4 * (bid - 56), un = bid < 8 ? 2 : bid < 56 ? 5 : 4;
        hgrn_pass1_run(p, l, lds, u0, un, 1);
        const int g0 = bid < 104 ? 8 * bid : bid < 168 ? 832 + 9 * (bid - 104) : 1408 + 8 * (bid - 168), gn = (bid >= 104 && bid < 168) ? 9 : 8;
        const QkvLane qc = qkv_lane_consts(p, l, lane);
        for (int g = g0; g < g0 + gn; ++g) prep_qkv_row(p, l, g * 8 + wid, lane, qc);
    } else {
        hgrn_pass1_run(p, l, lds, bid, (8 * NCHUNK - bid + G - 1) / G, G);
        const QkvLane qc = qkv_lane_consts(p, l, lane);
        for (int row = bid * 8 + wid; row < R_ALL; row += G * 8) prep_qkv_row(p, l, row, lane, qc);
    }
}

__device__ __forceinline__ void hgrn_scan(KP p) {
    const int gi = bid_() * NTHREADS + tid_();
    if (gi >= 16 * 4096) return;
    const int seq = gi >> 12, de = gi & 4095, d = de >> 6;
    float* U = (float*)(p->ws + Z_U) + (size_t)seq * NCHUNK * 4096 + de; const float* Gv = (const float*)(p->ws + Z_G) + (size_t)seq * NCHUNK * 64 + d;
    float S = 0.f;
    for (int j = 0; j < NCHUNK; j += 4) {
        float u[4], g[4];
#pragma unroll
        for (int q = 0; q < 4; ++q) { u[q] = U[(size_t)(j + q) * 4096]; g[q] = Gv[(j + q) * 64]; }
#pragma unroll
        for (int q = 0; q < 4; ++q) { U[(size_t)(j + q) * 4096] = S; S = g[q] * S + u[q]; }
    }
}
__device__ __forceinline__ void attn_simple_unit(unsigned char* lds, const bf16_t* Qrow0  , const bf16_t* Kb, const bf16_t* Vb  ,
                                                 int mode, int NT, int first_key, int q0, bool use_sink, float sink_log2, bf16_t* Orow0  ) {
    float* Ks = (float*)lds; float* Vs = Ks + 4096;
    const int tid = tid_();
    float q[64], o[64], m = -INFINITY, lsum = 0.f;
    if (tid < 256) {
#pragma unroll
        for (int d = 0; d < 64; ++d) { q[d] = bf2f(Qrow0[(size_t)tid * 256 + d]); o[d] = 0.f; }
    }
    for (int tt = 0; tt < NT; ++tt) {
        int key0, pos0 = 0; bool masked = false;
        if (mode == 0) key0 = first_key + 64 * tt;
        else if (tt < 4) key0 = NSEQ + 64 * tt;
        else { pos0 = q0 - 128 + 64 * (tt - 4); key0 = pos0 < 0 ? 0 : (pos0 > NSEQ - 64 ? NSEQ - 64 : pos0); masked = true; }
        __syncthreads();
        for (int i = tid; i < 4096; i += NTHREADS) { const int kk = i >> 6, d = i & 63; Ks[i] = bf2f(Kb[(size_t)(key0 + kk) * 128 + d]); Vs[i] = bf2f(Vb[(size_t)(key0 + kk) * 128 + d]); }
        __syncthreads();
        if (tid < 256) {
            for (int kk = 0; kk < 64; ++kk) {
                if (masked) { const int kp = pos0 + kk, qp = q0 + tid; const int df = qp - kp; if (kp < 0 || kp >= NSEQ || df > 128 || df < -128) continue; }
                float s = 0.f;
#pragma unroll
                for (int d = 0; d < 64; ++d) s += q[d] * Ks[kk * 64 + d];
                if (s > m) { const float f = exp2f(m - s); lsum *= f;
#pragma unroll
                    for (int d = 0; d < 64; ++d) o[d] *= f;
                    m = s; }
                const float pe = exp2f(s - m); lsum += pe;
#pragma unroll
                for (int d = 0; d < 64; ++d) o[d] += pe * Vs[kk * 64 + d];
            }
        }
    }
    if (tid < 256) {
        if (use_sink) lsum += exp2f(sink_log2 - m);
        const float inv = 1.f / lsum;
#pragma unroll
        for (int d = 0; d < 64; ++d) Orow0[(size_t)tid * D + d] = (bf16_t)f2bf(o[d] * inv);
    }
    __syncthreads();
}
__device__ __forceinline__ void ph_attn(KP p, int l, unsigned char* lds) {
    hgrn_scan(p);
    bf16_t* Y = (bf16_t*)(p->ws + Z_YCAT);
    const bf16_t* Qg = (const bf16_t*)(p->ws + Z_QG); const bf16_t* Qw = (const bf16_t*)(p->ws + Z_QW); const bf16_t* Qgc = (const bf16_t*)(p->ws + Z_QGC); const bf16_t* Qwc = (const bf16_t*)(p->ws + Z_QWC);
    const bf16_t* Kg = (const bf16_t*)(p->ws + Z_KG); const bf16_t* Kw = (const bf16_t*)(p->ws + Z_KW); const bf16_t* Vg = (const bf16_t*)(p->ws + Z_VG); const bf16_t* Vw = (const bf16_t*)(p->ws + Z_VW);
    const int nunits = 512 + (l == 0 ? 16 : 0);
    for (int u = bid_(); u < nunits; u += gsz_()) {
        if (u < 256) {
            const int qb = u & 31, h = (u >> 5) & 3, b = u >> 7, row0 = b * NSEQ + qb * 256;
            attn_simple_unit(lds, Qg + (size_t)row0 * 256 + h * 64, Kg + (size_t)b * NKEY * 128 + (h >> 1) * 64, Vg + (size_t)b * NKEY * 128 + (h >> 1) * 64, 0, NKEY / 64, 0, qb * 256, false, 0.f, Y + (size_t)row0 * D + h * 64);
        } else if (u < 512) {
            const int v = u - 256, qb = v & 31, h = (v >> 5) & 3, b = v >> 7, row0 = b * NSEQ + qb * 256;
            attn_simple_unit(lds, Qw + (size_t)row0 * 256 + h * 64, Kw + (size_t)b * NKEY * 128 + (h >> 1) * 64, Vw + (size_t)b * NKEY * 128 + (h >> 1) * 64, 1, 12, 0, qb * 256, true, p->in[14][l * 4 + h] * LOG2E, Y + (size_t)row0 * D + 512 + h * 64);
        } else {
            const int v = u - 512, h = v & 3, b = (v >> 2) & 1, win = v >> 3, row0 = R_LAT + b * NCTX;
            const bf16_t* Qc = (win ? Qwc : Qgc) + (size_t)(b * NCTX) * 256 + h * 64;
            const bf16_t* Kc = (win ? Kw : Kg) + (size_t)b * NKEY * 128 + (h >> 1) * 64; const bf16_t* Vc = (win ? Vw : Vg) + (size_t)b * NKEY * 128 + (h >> 1) * 64;
            attn_simple_unit(lds, Qc, Kc, Vc, 0, 4, NSEQ, 0, win != 0, p->in[14][l * 4 + h] * LOG2E, Y + (size_t)row0 * D + (win ? 512 : 0) + h * 64);
        }
    }
}

namespace attn_body {
using bf16=__hip_bfloat16;
using bf16x8=__attribute__((ext_vector_type(8)))short;
using s16x4=__attribute__((ext_vector_type(4)))short;
using f32x16=__attribute__((ext_vector_type(16)))float;
using u32x4=__attribute__((ext_vector_type(4)))unsigned;
constexpr int D=64, QP=256, KP=128, OP=1024;
constexpr int NW=8,QBLK=32,QB=QBLK*NW,KVBLK=64;
__device__ __forceinline__ int crow(int r,int hi){return (r&3)+8*(r>>2)+4*hi;}
#define SBAR() __builtin_amdgcn_sched_barrier(0)
__device__ __forceinline__ void wmask(f32x16&p0,f32x16&p1,int tb,int qrel,int hi,int q0){
  const float NEG=-INFINITY; const int kb=64*tb+4*hi;
  #pragma unroll
  for(int r=0;r<16;++r){const int kl=kb+(r&3)+8*(r>>2); const int kp=q0-128+kl;
    if(kl<qrel||kl>qrel+256||kp<0||kp>=NSEQ)p0[r]=NEG;
    if(kl+32<qrel||kl+32>qrel+256||kp+32<0||kp+32>=NSEQ)p1[r]=NEG;}
}

constexpr int NSLOT=3, SLOTB=8192;
constexpr int LDS_K=0, LDS_V=NSLOT*SLOTB, LDS_WS=2*NSLOT*SLOTB, LDS_OST=LDS_WS+NW*64*4, LDS_BYTES=LDS_OST+NW*4096;
constexpr float C2=0.125f*1.4426950408889634f;
__device__ __forceinline__ void glds16(const void*gsrc,unsigned lds_dst){unsigned keep;
  asm volatile("s_mov_b32 %0, m0\n\ts_mov_b32 m0, %2\n\ts_nop 0\n\tglobal_load_lds_dwordx4 %1, off\n\ts_mov_b32 m0, %0":"=&s"(keep):"v"(gsrc),"s"(lds_dst):"memory");}
__device__ __forceinline__ float max3f(float a,float b,float c){float r;asm("v_max3_f32 %0, %1, %2, %3":"=v"(r):"v"(a),"v"(b),"v"(c));return r;}
__device__ __forceinline__ float max2f(float a,float b){float r;asm("v_max_f32_e32 %0, %1, %2":"=v"(r):"v"(a),"v"(b));return r;}
__device__ __forceinline__ float fadd_s(float a,float b){float r;asm("v_add_f32_e32 %0, %1, %2":"=v"(r):"v"(a),"v"(b));return r;}
__device__ __forceinline__ float fsub_s(float a,float b){float r;asm("v_sub_f32_e32 %0, %1, %2":"=v"(r):"v"(a),"v"(b));return r;}
typedef float f32x2_t __attribute__((ext_vector_type(2))); typedef __bf16 bf16x2_t __attribute__((ext_vector_type(2)));
__device__ __forceinline__ unsigned cvtpk_s(float lo,float hi){f32x2_t v={lo,hi};bf16x2_t b=__builtin_convertvector(v,bf16x2_t);return __builtin_bit_cast(unsigned,b);}
#define WAIT_BAR(N) asm volatile("s_waitcnt vmcnt(" #N ") lgkmcnt(0)\n\ts_barrier":::"memory")

__device__ __forceinline__ void qkt(f32x16&p0,f32x16&p1,const char*Kslot,const bf16x8*qr,const f32x16&negm,int r32,int hi){
  const char*kb=Kslot+hi*1024+r32*16;
  #pragma unroll
  for(int d0=0;d0<4;++d0){
    const bf16x8 b0=*reinterpret_cast<const bf16x8*>(kb+d0*2048);
    const bf16x8 b1=*reinterpret_cast<const bf16x8*>(kb+d0*2048+512);
    if(d0==0){p0=__builtin_amdgcn_mfma_f32_32x32x16_bf16(b0,qr[0],negm,0,0,0);p1=__builtin_amdgcn_mfma_f32_32x32x16_bf16(b1,qr[0],negm,0,0,0);}
    else{p0=__builtin_amdgcn_mfma_f32_32x32x16_bf16(b0,qr[d0],p0,0,0,0);p1=__builtin_amdgcn_mfma_f32_32x32x16_bf16(b1,qr[d0],p1,0,0,0);}}
}
typedef __attribute__((address_space(3))) const char* lds_cptr;
typedef short v4i16_t __attribute__((ext_vector_type(4)));
__device__ __forceinline__ void kload8(bf16x8*kf,lds_cptr kp){
  kf[0]=*(const __attribute__((address_space(3))) bf16x8*)(kp);      kf[1]=*(const __attribute__((address_space(3))) bf16x8*)(kp+512);
  kf[2]=*(const __attribute__((address_space(3))) bf16x8*)(kp+2048); kf[3]=*(const __attribute__((address_space(3))) bf16x8*)(kp+2560);
  kf[4]=*(const __attribute__((address_space(3))) bf16x8*)(kp+4096); kf[5]=*(const __attribute__((address_space(3))) bf16x8*)(kp+4608);
  kf[6]=*(const __attribute__((address_space(3))) bf16x8*)(kp+6144); kf[7]=*(const __attribute__((address_space(3))) bf16x8*)(kp+6656);
}
__device__ __forceinline__ void kload2(bf16x8*kf,lds_cptr kp,int j){ kf[2*j]=*(const __attribute__((address_space(3))) bf16x8*)(kp+j*2048); kf[2*j+1]=*(const __attribute__((address_space(3))) bf16x8*)(kp+j*2048+512); }
__device__ __forceinline__ s16x4 vtr(lds_cptr p){ return __builtin_bit_cast(s16x4,__builtin_amdgcn_ds_read_tr16_b64_v4i16((__attribute__((address_space(3))) v4i16_t*)p)); }
__device__ __forceinline__ float rowmax(const f32x16&p0,const f32x16&p1){
  float a=max3f(p0[0],p0[1],p1[0]),b=max3f(p0[2],p0[3],p1[1]);a=max3f(a,p1[2],p1[3]);
  #pragma unroll
  for(int r=4;r<16;r+=4){a=max3f(a,p0[r],p0[r+1]);b=max3f(b,p0[r+2],p0[r+3]);a=max3f(a,p1[r],p1[r+1]);b=max3f(b,p1[r+2],p1[r+3]);}
  const float m=max2f(a,b);
  auto rr=__builtin_amdgcn_permlane32_swap(__float_as_uint(m),__float_as_uint(m),false,false);
  return max2f(__uint_as_float(rr[0]),__uint_as_float(rr[1]));
}
__device__ __forceinline__ void pv(f32x16*o,int vb,bf16x8 pa0,bf16x8 pa1,bf16x8 pa2,bf16x8 pa3){
  #pragma unroll
  for(int d0=0;d0<2;++d0){s16x4 lo[4],hi[4];
    #pragma unroll
    for(int ks=0;ks<4;++ks){
      asm volatile("ds_read_b64_tr_b16 %0,%1 offset:%c2":"=&v"(lo[ks]):"v"(vb),"i"(d0*4096+ks*1024):"memory");
      asm volatile("ds_read_b64_tr_b16 %0,%1 offset:%c2":"=&v"(hi[ks]):"v"(vb),"i"(d0*4096+ks*1024+512):"memory");}
    asm volatile("s_waitcnt lgkmcnt(0)":::"memory");SBAR();
    #define PK(k) (bf16x8){lo[k][0],lo[k][1],lo[k][2],lo[k][3],hi[k][0],hi[k][1],hi[k][2],hi[k][3]}
    o[d0]=__builtin_amdgcn_mfma_f32_32x32x16_bf16(pa0,PK(0),o[d0],0,0,0);
    o[d0]=__builtin_amdgcn_mfma_f32_32x32x16_bf16(pa1,PK(1),o[d0],0,0,0);
    o[d0]=__builtin_amdgcn_mfma_f32_32x32x16_bf16(pa2,PK(2),o[d0],0,0,0);
    o[d0]=__builtin_amdgcn_mfma_f32_32x32x16_bf16(pa3,PK(3),o[d0],0,0,0);
    #undef PK
  }
}

#ifndef ATTN_STORE16
#define ATTN_STORE16(p,v) (*(u32x4*)(p)=(v))
#endif
template<int MODE,int NMASKT,int THRL> __device__ __forceinline__ void attn_unit(const bf16*Q0,const bf16*__restrict__ Kh,const bf16*__restrict__ Vh,bf16*O0,int NT,int key_first,int q0,bool use_sink,float sink_l2,char*shm){
  const int tid=tid_(),lane=tid&63,r32=lane&31,hi=lane>>5; const int wid=__builtin_amdgcn_readfirstlane(tid>>6);
  const bf16*Qw=Q0+(long)(wid*QBLK)*QP;
  auto krow=[&](int t)->long{ if(MODE==0) return (long)key_first+64*t; if(t<4) return (long)NSEQ+64*t; int p=q0-128+64*(t-4); p=p<0?0:(p>NSEQ-64?NSEQ-64:p); return (long)p; };
  const unsigned lds0=(unsigned)(uintptr_t)shm;
  float*wsf=(float*)(shm+LDS_WS)+wid*64;
  const bf16*ksrc=Kh+(long)lane*KP+wid*8;
  const bf16*vsrc=Vh+(long)(16*(wid&3)+(lane>>2))*KP+(wid>>2)*32+(lane&3)*8;
  const unsigned kdst=lds0+LDS_K+wid*1024, vdst=lds0+LDS_V+wid*1024;
  #define DMA_K(t,slot) glds16(ksrc+krow(t)*KP,(unsigned)__builtin_amdgcn_readfirstlane(kdst+(slot)))
  #define DMA_V(t,slot) glds16(vsrc+krow(t)*KP,(unsigned)__builtin_amdgcn_readfirstlane(vdst+(slot)))
  const int vb0=(int)(lds0+LDS_V)+((lane>>4)&1)*32+(lane&3)*8+(4*hi+((lane&15)>>2))*64;
  const char*Kbase=shm+LDS_K; bf16x8 kf[8];
  const lds_cptr shm3=(lds_cptr)shm; const lds_cptr kp0=shm3+LDS_K+hi*1024+r32*16; const lds_cptr vp0=shm3+LDS_V+((lane>>4)&1)*32+(lane&3)*8+(4*hi+((lane&15)>>2))*64;
  DMA_K(0,0);DMA_V(0,0);DMA_K(1,SLOTB);
  bf16x8 qr[4];
  #pragma unroll
  for(int d0=0;d0<4;++d0)qr[d0]=*reinterpret_cast<const bf16x8*>(&Qw[(long)r32*QP+d0*16+hi*8]);
  float mhat=0.f,l_reg=0.f;f32x16 o[2];o[0]=f32x16{};o[1]=f32x16{};f32x16 negm=f32x16{};asm volatile("":"+v"(negm));
  const int qrel=wid*QBLK+r32;
  #define CMASK(P0,P1,t) do{ if(NMASKT>0){int jb_=(t)-(NT-NMASKT); if(jb_>=0)wmask(P0,P1,jb_,qrel,hi,q0);} }while(0)
  bool resc=false;
  #define START(P0,P1) do{ const float rm=rowmax(P0,P1); resc=false; \
    { const float dl=rm; mhat=fadd_s(mhat,dl); \
      _Pragma("unroll") for(int r=0;r<16;++r){P0[r]=fsub_s(P0[r],dl);P1[r]=fsub_s(P1[r],dl);} \
      _Pragma("unroll") for(int r=0;r<16;++r)negm[r]=-mhat; asm volatile("":"+v"(negm)); } \
    _Pragma("unroll") for(int r=0;r<16;++r)P0[r]=__builtin_amdgcn_exp2f(P0[r]); }while(0)
  #define RESC() do{ if(resc){ asm volatile("s_waitcnt lgkmcnt(0)":::"memory"); \
      _Pragma("unroll") for(int d_=0;d_<2;++d_) _Pragma("unroll") for(int r=0;r<16;++r)o[d_][r]*=wsf[crow(r,hi)]; } }while(0)
  f32x16 pA0,pA1,pB0,pB1;
  int sl_prev=0,sl_cur=0,sl_next=SLOTB;
  #define ROT() do{sl_prev=sl_cur;sl_cur=sl_next;sl_next=(sl_next==(NSLOT-1)*SLOTB)?0:sl_next+SLOTB;}while(0)
  DMA_K(2,2*SLOTB);
  WAIT_BAR(3);
  qkt(pA0,pA1,Kbase,qr,negm,r32,hi);asm volatile("s_nop 15\n\ts_nop 7":"+v"(pA0),"+v"(pA1));CMASK(pA0,pA1,0);
  START(pA0,pA1);
  _Pragma("unroll") for(int r=0;r<16;++r)pA1[r]=__builtin_amdgcn_exp2f(pA1[r]);
  WAIT_BAR(0);
  DMA_K(3,0);DMA_V(1,SLOTB);
  ROT();
  kload8(kf,kp0+sl_cur);
  WAIT_BAR(2);
  s16x4 vlo[8],vhi[8]; u32x4 pw0,pw1,pw2,pw3;
  #define PKW(P,B) cvtpk_s(P[B],P[B+1])
  #define PAF(k) __builtin_bit_cast(bf16x8,pw##k)
  #define VFR(i) (bf16x8){vlo[i][0],vlo[i][1],vlo[i][2],vlo[i][3],vhi[i][0],vhi[i][1],vhi[i][2],vhi[i][3]}
  #define PIN(x) asm volatile("":"+v"(x))
  #define MX3(a,b,c) __builtin_fmaxf(__builtin_fmaxf((a),(b)),(c))
  #define GAPA(MF,A0,A1,A2,A3,W0,W1,PW) do{ MF; sacc+=A0; sacc+=A1; sacc+=A2; sacc+=A3; PIN(sacc); W0; W1; PIN(PW); SBAR(); }while(0)
  #define EX(v) __builtin_amdgcn_exp2f(v)
  #define GAPB(MF,X,B) do{ MF; X[B]=EX(X[B]); X[B+1]=EX(X[B+1]); X[B+2]=EX(X[B+2]); X[B+3]=EX(X[B+3]); PIN(X); SBAR(); }while(0)
  #define VRD(i) do{ vlo[i]=vtr(vp_+(((i)>>2)*4096+((i)&3)*1024)); vhi[i]=vtr(vp_+(((i)>>2)*4096+((i)&3)*1024+512)); }while(0)
  #define KRD(G,j) do{ if(G){ kload2(kf,kp0+sl_next,j); SBAR(); } }while(0)
  #define STEP(C0,C1,P0,P1,t,GK,GV,GL) do{ SBAR(); \
    const lds_cptr vp_=vp0+sl_prev; \
    VRD(0); SBAR(); float sacc=(P0[0]+P0[1]); \
    GAPA(C0=__builtin_amdgcn_mfma_f32_32x32x16_bf16(kf[0],qr[0],negm,0,0,0), P0[2],P0[3],P0[4],P0[5],     pw0[0]=PKW(P0,0), pw0[1]=PKW(P0,2), pw0); \
    VRD(4); SBAR(); GAPA(C1=__builtin_amdgcn_mfma_f32_32x32x16_bf16(kf[1],qr[0],negm,0,0,0), P0[6],P0[7],P0[8],P0[9],     pw0[2]=PKW(P0,4), pw0[3]=PKW(P0,6), pw0); \
    VRD(1); SBAR(); GAPA(C0=__builtin_amdgcn_mfma_f32_32x32x16_bf16(kf[2],qr[1],C0,0,0,0),   P0[10],P0[11],P0[12],P0[13], pw1[0]=PKW(P0,8), pw1[1]=PKW(P0,10), pw1); \
    VRD(5); SBAR(); GAPA(C1=__builtin_amdgcn_mfma_f32_32x32x16_bf16(kf[3],qr[1],C1,0,0,0),   P0[14],P0[15],P1[0],P1[1],   pw1[2]=PKW(P0,12),pw1[3]=PKW(P0,14), pw1); \
    VRD(2); SBAR(); GAPA(C0=__builtin_amdgcn_mfma_f32_32x32x16_bf16(kf[4],qr[2],C0,0,0,0),   P1[2],P1[3],P1[4],P1[5],     pw2[0]=PKW(P1,0), pw2[1]=PKW(P1,2), pw2); \
    VRD(6); SBAR(); GAPA(C1=__builtin_amdgcn_mfma_f32_32x32x16_bf16(kf[5],qr[2],C1,0,0,0),   P1[6],P1[7],P1[8],P1[9],     pw2[2]=PKW(P1,4), pw2[3]=PKW(P1,6), pw2); \
    VRD(3); SBAR(); GAPA(C0=__builtin_amdgcn_mfma_f32_32x32x16_bf16(kf[6],qr[3],C0,0,0,0),   P1[10],P1[11],P1[12],P1[13], pw3[0]=PKW(P1,8), pw3[1]=PKW(P1,10), pw3); \
    VRD(7); SBAR(); GAPA(C1=__builtin_amdgcn_mfma_f32_32x32x16_bf16(kf[7],qr[3],C1,0,0,0),   P1[14],P1[15],0.f,0.f,       pw3[2]=PKW(P1,12),pw3[3]=PKW(P1,14), pw3); \
    l_reg+=sacc; \
    if(GK){DMA_K((t)+3,sl_cur);} if(GV){DMA_V((t)+1,sl_next);} \
    CMASK(C0,C1,t); \
    { float a=MX3(C0[0],C0[1],C1[0]),b=MX3(C0[2],C0[3],C1[1]); a=MX3(a,C1[2],C1[3]); \
      _Pragma("unroll") for(int r=4;r<16;r+=4){a=MX3(a,C0[r],C0[r+1]);b=MX3(b,C0[r+2],C0[r+3]);a=MX3(a,C1[r],C1[r+1]);b=MX3(b,C1[r+2],C1[r+3]);} \
      float rm=__builtin_fmaxf(a,b); { auto rr=__builtin_amdgcn_permlane32_swap(__float_as_uint(rm),__float_as_uint(rm),false,false); rm=__builtin_fmaxf(__uint_as_float(rr[0]),__uint_as_float(rr[1])); } \
      resc=false; \
      if(__builtin_expect(__any(rm>(float)THRL),0)){ const float dl=__builtin_fmaxf(rm,0.f); mhat+=dl; \
        _Pragma("unroll") for(int r=0;r<16;++r){C0[r]-=dl;C1[r]-=dl;} \
        _Pragma("unroll") for(int r=0;r<16;++r)negm[r]=-mhat; asm volatile("":"+v"(negm)); \
        const float f=__builtin_amdgcn_exp2f(-dl); l_reg*=f; if(hi==0)wsf[r32]=f; resc=true; } } \
    SBAR(); \
    GAPB(o[0]=__builtin_amdgcn_mfma_f32_32x32x16_bf16(PAF(0),VFR(0),o[0],0,0,0), C0,0); \
    GAPB(o[1]=__builtin_amdgcn_mfma_f32_32x32x16_bf16(PAF(0),VFR(4),o[1],0,0,0), C0,4); \
    KRD(GL,0); GAPB(o[0]=__builtin_amdgcn_mfma_f32_32x32x16_bf16(PAF(1),VFR(1),o[0],0,0,0), C0,8); \
    KRD(GL,1); GAPB(o[1]=__builtin_amdgcn_mfma_f32_32x32x16_bf16(PAF(1),VFR(5),o[1],0,0,0), C0,12); \
    KRD(GL,2); GAPB(o[0]=__builtin_amdgcn_mfma_f32_32x32x16_bf16(PAF(2),VFR(2),o[0],0,0,0), C1,0); \
    KRD(GL,3); GAPB(o[1]=__builtin_amdgcn_mfma_f32_32x32x16_bf16(PAF(2),VFR(6),o[1],0,0,0), C1,4); \
    GAPB(o[0]=__builtin_amdgcn_mfma_f32_32x32x16_bf16(PAF(3),VFR(3),o[0],0,0,0), C1,8); \
    GAPB(o[1]=__builtin_amdgcn_mfma_f32_32x32x16_bf16(PAF(3),VFR(7),o[1],0,0,0), C1,12); \
    }while(0)
  int t=1;
  #undef CMASK
  #define CMASK(P0,P1,t) do{}while(0)
  for(;t+1+(NMASKT>4?NMASKT:4)<NT;t+=2){
    STEP(pB0,pB1,pA0,pA1,t,true,true,true);     WAIT_BAR(2); RESC(); ROT();
    STEP(pA0,pA1,pB0,pB1,t+1,true,true,true);   WAIT_BAR(2); RESC(); ROT();
  }
  #undef CMASK
  #define CMASK(P0,P1,t) do{ if(NMASKT>0){int jb_=(t)-(NT-NMASKT); if(jb_>=0)wmask(P0,P1,jb_,qrel,hi,q0);} }while(0)
  #define ENDW(tt) do{ if((tt)+3<NT){WAIT_BAR(2);} else if((tt)+2<NT){WAIT_BAR(1);} else {WAIT_BAR(0);} }while(0)
  for(;t+1<NT;t+=2){
    STEP(pB0,pB1,pA0,pA1,t,(t+3<NT),(t+1<NT),(t+1<NT));       ENDW(t);   RESC(); ROT();
    STEP(pA0,pA1,pB0,pB1,t+1,(t+4<NT),(t+2<NT),(t+2<NT));     ENDW(t+1); RESC(); ROT();
  }
  STEP(pB0,pB1,pA0,pA1,NT-1,false,false,false); RESC();
  { float sacc=pB0[0]+pB0[1]; _Pragma("unroll") for(int r=2;r<16;++r)sacc+=pB0[r]; _Pragma("unroll") for(int r=0;r<16;++r)sacc+=pB1[r]; l_reg+=sacc;
    pw0=(u32x4){PKW(pB0,0),PKW(pB0,2),PKW(pB0,4),PKW(pB0,6)};pw1=(u32x4){PKW(pB0,8),PKW(pB0,10),PKW(pB0,12),PKW(pB0,14)};pw2=(u32x4){PKW(pB1,0),PKW(pB1,2),PKW(pB1,4),PKW(pB1,6)};pw3=(u32x4){PKW(pB1,8),PKW(pB1,10),PKW(pB1,12),PKW(pB1,14)};
    SBAR(); pv(o,vb0+sl_cur,PAF(0),PAF(1),PAF(2),PAF(3)); }
  #undef PKW
  #undef PAF
  #undef VFR
  #undef PIN
  #undef MX3
  #undef GAPA
  #undef GAPB
  #undef EX
  #undef VRD
  #undef KRD
  #undef STEP
  #undef ENDW
  {auto rr=__builtin_amdgcn_permlane32_swap(__float_as_uint(l_reg),__float_as_uint(l_reg),false,false);l_reg=__uint_as_float(rr[0])+__uint_as_float(rr[1]);}
  if(use_sink)l_reg+=__builtin_amdgcn_exp2f(sink_l2-mhat);
  if(hi==0)wsf[32+r32]=l_reg;asm volatile("s_waitcnt lgkmcnt(0)":::"memory");
  float rli[16];
  #pragma unroll
  for(int r=0;r<16;++r)rli[r]=__builtin_amdgcn_rcpf(wsf[32+crow(r,hi)]);
  bf16*Ow=O0+(long)(wid*QBLK)*OP;
  { bf16*stg=(bf16*)(shm+LDS_OST)+wid*2048;
    #pragma unroll
    for(int r=0;r<16;++r){const int orow=crow(r,hi);
      #pragma unroll
      for(int d0=0;d0<2;++d0)stg[orow*64+d0*32+r32]=__float2bfloat16(o[d0][r]*rli[r]);}
    asm volatile("s_waitcnt lgkmcnt(0)":::"memory");
    #pragma unroll
    for(int i=0;i<4;++i){const int row=i*8+(lane>>3),ch=lane&7; const u32x4 v=*(const u32x4*)(stg+row*64+ch*8); ATTN_STORE16(Ow+(long)row*OP+ch*8,v);} }
  asm volatile("s_waitcnt lgkmcnt(0)\n\ts_barrier":::"memory");
  #undef DMA_K
  #undef DMA_V
  #undef CMASK
  #undef START
  #undef RESC
  #undef ROT
}
constexpr int ATTN_LDS_BYTES=LDS_BYTES;
#undef SBAR
#undef WAIT_BAR
}

__device__ __forceinline__ void ph_attn_f(KP p, int l, unsigned char* lds, bool do_scan = true) {
    if (do_scan) { if (FAST_HGRN) hgrn_scan_f(p); else hgrn_scan(p); }
    using attn_body::bf16;
    bf16* Y = (bf16*)(p->ws + Z_YCAT);
    const bf16* Qg = (const bf16*)(p->ws + Z_QG); const bf16* Qw = (const bf16*)(p->ws + Z_QW); const bf16* Qgc = (const bf16*)(p->ws + Z_QGC); const bf16* Qwc = (const bf16*)(p->ws + Z_QWC);
    const bf16* Kg = (const bf16*)(p->ws + Z_KG); const bf16* Kw = (const bf16*)(p->ws + Z_KW); const bf16* Vg = (const bf16*)(p->ws + Z_VG); const bf16* Vw = (const bf16*)(p->ws + Z_VW);
    const int G = gsz_(), bid = bid_();
    __syncthreads();
    for (int vb = bid; vb < 256; vb += G) {
        const int v = (G == 256) ? (((vb & 7) >> 1) * 64 + (vb & 1) * 32 + (vb >> 3)) : vb;
        const int b = v >> 7, kvh = (v >> 6) & 1, h = kvh * 2 + ((v >> 5) & 1), qb = v & 31, row0 = b * NSEQ + qb * 256;
        const size_t kvo = (size_t)b * NKEY * 128 + kvh * 64;
        attn_body::attn_unit<0, 0, 8>(Qg + (size_t)row0 * 256 + h * 64, Kg + kvo, Vg + kvo, Y + (size_t)row0 * D + h * 64, NKEY / 64, 0, 0, false, 0.f, (char*)lds);
        attn_body::attn_unit<1, 8, 8>(Qw + (size_t)row0 * 256 + h * 64, Kw + kvo, Vw + kvo, Y + (size_t)row0 * D + 512 + h * 64, 12, 0, qb * 256, true, p->in[14][l * 4 + h] * LOG2E, (char*)lds);
    }
    if (l == 0) for (int v = bid; v < 16; v += G) {
        const int h = v & 3, b = (v >> 2) & 1, win = v >> 3, row0 = R_LAT + b * NCTX;
        const size_t kvo = (size_t)b * NKEY * 128 + (h >> 1) * 64;
        attn_body::attn_unit<0, 0, 8>((win ? Qwc : Qgc) + (size_t)(b * NCTX) * 256 + h * 64, (win ? Kw : Kg) + kvo, (win ? Vw : Vg) + kvo, Y + (size_t)row0 * D + (win ? 512 : 0) + h * 64, 4, NSEQ, 0, win != 0, p->in[14][l * 4 + h] * LOG2E, (char*)lds);
    }
}

__device__ __forceinline__ void hgrn_pass3_unit(KP p, int l, unsigned char* lds, int unit) {
    float* qs = (float*)lds; float* vs = qs + 4096; float* ks = vs + 4096; float* cs = ks + 4096; float* Ss = cs + 4096; float* sc = Ss + 4096; float* os = sc + 4096;
    const int tid = tid_(), lane = tid & 63, wid = tid >> 6;
    const int cpos = unit % NCHUNK, head = (unit / NCHUNK) & 3, b = unit / (NCHUNK * 4);
    const int row0 = (cpos < 4) ? R_LAT + b * NCTX + cpos * 64 : b * NSEQ + (cpos - 4) * 64;
    for (int i = tid; i < 4096; i += NTHREADS) os[i] = 0.f;
    for (int dir = 0; dir < 2; ++dir) {
        const int j = (cpos < 4) ? (dir ? 3 - cpos : cpos) : 4 + (dir ? 127 - (cpos - 4) : (cpos - 4));
        const int seq = (b * 4 + head) * 2 + dir;
        __syncthreads();
        hgrn_load_chunk(p, l, row0, dir, head, qs, vs, ks, cs);
        const float* Sg = (const float*)(p->ws + Z_U) + ((size_t)seq * NCHUNK + j) * 4096;
        for (int i = tid; i < 4096; i += NTHREADS) Ss[i] = Sg[i];
        for (int i = tid; i < 4096; i += NTHREADS) { const int tau = i >> 6, sig = i & 63; float a = 0.f;
            if (sig <= tau) { for (int d = 0; d < 64; ++d) a += qs[tau * 64 + d] * ks[sig * 64 + d] * __expf(cs[tau * 64 + d] - cs[sig * 64 + d]); }
            sc[i] = a; }
        __syncthreads();
        { const int tau = tid >> 3, e0 = (tid & 7) * 8; float acc[8];
#pragma unroll
          for (int e = 0; e < 8; ++e) acc[e] = 0.f;
          for (int d = 0; d < 64; ++d) { const float qv = qs[tau * 64 + d] * __expf(cs[tau * 64 + d]);
#pragma unroll
              for (int e = 0; e < 8; ++e) acc[e] += qv * Ss[d * 64 + e0 + e]; }
          for (int sig = 0; sig <= tau; ++sig) { const float sv = sc[tau * 64 + sig];
#pragma unroll
              for (int e = 0; e < 8; ++e) acc[e] += sv * vs[sig * 64 + e0 + e]; }
          const int tok = dir ? 63 - tau : tau;
#pragma unroll
          for (int e = 0; e < 8; ++e) os[tok * 64 + e0 + e] += acc[e]; }
        __syncthreads();
    }
    const bf16_t* P = (const bf16_t*)(p->ws + Z_P); bf16_t* Y = (bf16_t*)(p->ws + Z_YCAT);
    for (int tok = wid; tok < 64; tok += 8) { const float v = os[tok * 64 + lane];
        const float y = v * rsqrtf(wave_sum(v * v) * (1.f / 64.f) + EPS) * p->in[22][l * 64 + lane];
        const float g = bf2f(P[(size_t)(row0 + tok) * DIN + C_RG + head * 64 + lane]);
        Y[(size_t)(row0 + tok) * D + 768 + head * 64 + lane] = (bf16_t)f2bf(y * silu_(g)); }
    __syncthreads();
}
__device__ __forceinline__ void ph_hgrn3(KP p, int l, unsigned char* lds) {
    hgrn_pass3_run(p, l, lds);
    if (l == 0 && DEPTH > 1 && gsz_() == 256) { __syncthreads(); ph_cvt(p, 1, lds, 32, 224, CVT_E1, CVT_E2); }
}

__device__ __forceinline__ void ph_outproj(KP p, int l, unsigned char* lds) {
    const bf16_t* A = (const bf16_t*)(p->ws + Z_YCAT); const bf16_t* Bt = (const bf16_t*)(p->ws + Z_WOUT); float* X = (float*)(p->ws + WS_X);
    const int T = (l == 0) ? R_ALL : R_LAT; const int TM = T / 128, TN = 8;
    for (int it = bid_(); it < TM * TN; it += gsz_()) { const int mt = it / TN, nt = it % TN;
        auto epi = [&](int row, int col, float v, float) { const int c = nt * 128 + col; X[(size_t)row * D + c] = xrow_src(p, l, row)[c] + mod_vec(p, l, row, 2)[c] * v; };
        gemm_simple_tile<1>(A, RowId{}, Bt, 1024, mt * 128, nt * 128, 0, epi); }
}

__device__ __forceinline__ void ph_norm2(KP p, int l, unsigned char* lds, int cnt_off = 0) {
    constexpr int RS = 1032, NSTG = 80;
    const int T = (l == 0) ? R_ALL : R_LAT;
    bf16_t* AH = (bf16_t*)lds; bf16_t* AL = AH + 16 * RS;
    float* PART = (float*)(lds + 2 * 16 * RS * 2); float* LOG = PART + 8 * 16 * 64;
    int* hist = (int*)(LOG + 16 * 64); int* hbase = hist + 64; int* s_e = hbase + 64; int* s_r = s_e + NSTG * 8; float* s_w = (float*)(s_r + NSTG * 8); float* msb = s_w + NSTG * 8;
    const int tid = tid_(), lane = tid & 63, wid = tid >> 6, fr = lane & 15, fq = lane >> 4, bid = bid_(), G = gsz_();
    bf16_t* Tok = (bf16_t*)(p->ws + Z_A); const bf16_t* X = (const bf16_t*)(p->ws + WS_X);
    const float* g2 = p->in[7] + l * D; const float* rw = p->in[23] + (size_t)l * 1024 * 64; const float* rbias = p->in[24] + l * 64;
    unsigned* cnt = (unsigned*)(p->ws + WS_CTL) + CW_CNT + cnt_off + l * 64;
    int* tok_e = (int*)(p->ws + WS_TOKE); int* tok_p = (int*)(p->ws + WS_TOKP); int* expl = (int*)(p->ws + WS_EXPL); float* expw = (float*)(p->ws + WS_EXPW);
    bf16x8 bh[4][4], bl[4][4];
#pragma unroll
    for (int t = 0; t < 4; ++t)
#pragma unroll
        for (int k = 0; k < 4; ++k) { float v[8], lo[8];
#pragma unroll
            for (int j = 0; j < 8; ++j) v[j] = rw[(size_t)((wid * 4 + k) * 32 + fq * 8 + j) * 64 + t * 16 + fr];
            const u32x4 hh = pack8(v);
            const float hf[8] = {bf2f(hh.x & 0xffffu), bf2f(hh.x >> 16), bf2f(hh.y & 0xffffu), bf2f(hh.y >> 16), bf2f(hh.z & 0xffffu), bf2f(hh.z >> 16), bf2f(hh.w & 0xffffu), bf2f(hh.w >> 16)};
#pragma unroll
            for (int j = 0; j < 8; ++j) lo[j] = v[j] - hf[j];
            const u32x4 ll = pack8(lo);
            bh[t][k] = __builtin_bit_cast(bf16x8, hh); bl[t][k] = __builtin_bit_cast(bf16x8, ll); }
    const float mybias = rbias[lane];
    const int rpb = (T + G - 1) / G;
    for (int base = bid * rpb; base < T; base += G * rpb) {
        const int r1 = (base + rpb < T) ? base + rpb : T;
        if (tid < 64) hist[tid] = 0;
        for (int s0 = base; s0 < r1; s0 += 16) {
#pragma unroll
            for (int j2 = 0; j2 < 2; ++j2) { const int lr = wid * 2 + j2, row = s0 + lr;
                if (row < r1) {
                    const bf16_t* xrow = X + (size_t)row * D; const float* shift = mod_vec(p, l, row, 3); const float* scale = mod_vec(p, l, row, 4);
                    f32x4 v[4]; float ssq = 0.f;
#pragma unroll
                    for (int j = 0; j < 4; ++j) { const u32x2 r2 = ((const u32x2*)xrow)[lane + 64 * j]; v[j].x = bf2f(r2.x & 0xffffu); v[j].y = bf2f(r2.x >> 16); v[j].z = bf2f(r2.y & 0xffffu); v[j].w = bf2f(r2.y >> 16); ssq += v[j].x * v[j].x + v[j].y * v[j].y + v[j].z * v[j].z + v[j].w * v[j].w; }
                    const float rinv = rsqrtf(wave_sum(ssq) * (1.f / D) + EPS);
#pragma unroll
                    for (int j = 0; j < 4; ++j) { const int idx = lane + 64 * j;
                        const f32x4 gg = ((const f32x4*)g2)[idx], sh = ((const f32x4*)shift)[idx], sc = ((const f32x4*)scale)[idx];
                        f32x4 y; y.x = v[j].x * rinv * gg.x * (1.f + sc.x) + sh.x; y.y = v[j].y * rinv * gg.y * (1.f + sc.y) + sh.y;
                        y.z = v[j].z * rinv * gg.z * (1.f + sc.z) + sh.z; y.w = v[j].w * rinv * gg.w * (1.f + sc.w) + sh.w;
                        u32x2 h; h.x = pk2(y.x, y.y); h.y = pk2(y.z, y.w);
                        u32x2 lw; lw.x = pk2(y.x - bf2f(h.x & 0xffffu), y.y - bf2f(h.x >> 16)); lw.y = pk2(y.z - bf2f(h.y & 0xffffu), y.w - bf2f(h.y >> 16));
                        { int t8 = __builtin_amdgcn_cvt_pk_fp8_f32(clamp8(y.x * TOK8_SCALE), clamp8(y.y * TOK8_SCALE), 0, false); t8 = __builtin_amdgcn_cvt_pk_fp8_f32(clamp8(y.z * TOK8_SCALE), clamp8(y.w * TOK8_SCALE), t8, true);
                          ((unsigned*)((unsigned char*)Tok + (size_t)row * D))[idx] = (unsigned)t8; }
                        *(u32x2*)(AH + lr * RS + idx * 4) = h; *(u32x2*)(AL + lr * RS + idx * 4) = lw; }
                } else {
#pragma unroll
                    for (int j = 0; j < 4; ++j) { const int idx = lane + 64 * j; const u32x2 z = {0u, 0u}; *(u32x2*)(AH + lr * RS + idx * 4) = z; *(u32x2*)(AL + lr * RS + idx * 4) = z; } } }
            __syncthreads();
            { f32x4 acc[4];
#pragma unroll
              for (int t = 0; t < 4; ++t) acc[t] = (f32x4){0.f, 0.f, 0.f, 0.f};
#pragma unroll
              for (int k = 0; k < 4; ++k) { const int ko = (wid * 4 + k) * 32 + fq * 8;
                  const bf16x8 ah = *(const bf16x8*)(AH + fr * RS + ko), al = *(const bf16x8*)(AL + fr * RS + ko);
#pragma unroll
                  for (int t = 0; t < 4; ++t) { acc[t] = __builtin_amdgcn_mfma_f32_16x16x32_bf16(ah, bh[t][k], acc[t], 0, 0, 0);
                      acc[t] = __builtin_amdgcn_mfma_f32_16x16x32_bf16(ah, bl[t][k], acc[t], 0, 0, 0); acc[t] = __builtin_amdgcn_mfma_f32_16x16x32_bf16(al, bh[t][k], acc[t], 0, 0, 0); } }
#pragma unroll
              for (int t = 0; t < 4; ++t)
#pragma unroll
                  for (int r = 0; r < 4; ++r) PART[(wid * 16 + fq * 4 + r) * 64 + t * 16 + fr] = acc[t][r]; }
            __syncthreads();
#pragma unroll
            for (int q = 0; q < 2; ++q) { const int o = tid + q * NTHREADS; float a = 0.f;
#pragma unroll
                for (int w8 = 0; w8 < 8; ++w8) a += PART[w8 * 1024 + o];
                LOG[o] = a; }
            __syncthreads();
#pragma unroll 1
            for (int j2 = 0; j2 < 2; ++j2) { const int lr = wid * 2 + j2, row = s0 + lr;
                if (row >= r1) continue;
                const int sr = row - base;
                const float score = sigmoid_(LOG[lr * 64 + lane]), sel = score + mybias;
                const int e = lane, g = e >> 3;
                int rg = 0;
#pragma unroll
                for (int i = 1; i < 8; ++i) { const int src = (lane & ~7) | ((lane + i) & 7); const float o = __shfl(sel, src); rg += (o > sel) || (o == sel && src < e); }
                float top2 = (rg < 2) ? sel : 0.f;
                top2 += __shfl_xor(top2, 1); top2 += __shfl_xor(top2, 2); top2 += __shfl_xor(top2, 4);
                int grank = 0;
#pragma unroll
                for (int i = 1; i < 8; ++i) { const int og = (g + i) & 7; const float o = __shfl(top2, og * 8); grank += (o > top2) || (o == top2 && og < g); }
                const bool keep = grank < 4;
                const float ms = keep ? sel : -INFINITY;
                float* mrow = msb + wid * 64;
                mrow[lane] = ms;
                __builtin_amdgcn_wave_barrier();
                int rk = 0;
#pragma unroll 4
                for (int i = 0; i < 16; ++i) { const f32x4 o = *(const f32x4*)(mrow + 4 * i);
                    rk += (o.x > ms) || (o.x == ms && 4 * i + 0 < e); rk += (o.y > ms) || (o.y == ms && 4 * i + 1 < e);
                    rk += (o.z > ms) || (o.z == ms && 4 * i + 2 < e); rk += (o.w > ms) || (o.w == ms && 4 * i + 3 < e); }
                __builtin_amdgcn_wave_barrier();
                const bool chosen = keep && rk < 8;
                const float wsum = wave_sum(chosen ? score : 0.f);
                if (chosen) { const int r = atomicAdd(&hist[e], 1); s_e[sr * 8 + rk] = e; s_r[sr * 8 + rk] = r; s_w[sr * 8 + rk] = score / wsum * 2.5f; } }
        }
        __syncthreads();
        if (tid < 64) { const int h = hist[tid]; hbase[tid] = h ? (int)atomicAdd(&cnt[tid], (unsigned)h) : 0; }
        __syncthreads();
        for (int i = tid; i < (r1 - base) * 8; i += NTHREADS) { const int e = s_e[i]; const size_t o = (size_t)base * 8 + i;
            const int pos = hbase[e] + s_r[i]; tok_e[o] = e; tok_p[o] = pos; expl[(size_t)e * R_ALL + pos] = base + (i >> 3); expw[(size_t)e * R_ALL + pos] = s_w[i]; }
        __syncthreads();
    }
}

__device__ __forceinline__ void moe_pad_starts(KP p, int l, int* ps) {
    const unsigned* cnt = (const unsigned*)(p->ws + WS_CTL) + CW_CNT + l * 64;
    const int tid = tid_();
    if (tid < 64) { const int v = (int)((cnt[tid] + 255u) >> 8) << 8; int incl = v;
#pragma unroll
        for (int d = 1; d < 64; d <<= 1) { const int o = __shfl_up(incl, d); if (tid >= d) incl += o; }
        ps[tid] = incl - v; if (tid == 63) ps[64] = incl; }
    __syncthreads();
}
__device__ __forceinline__ int moe_expert_of_row(const int* ps, int row) { int e = 0; while (e < 63 && row >= ps[e + 1]) ++e; return e; }

__device__ __forceinline__ void ph_slots(KP p, int l, unsigned char* lds) {
    const int T = (l == 0) ? R_ALL : R_LAT;
    int* ps = (int*)lds; moe_pad_starts(p, l, ps);
    const unsigned* cnt = (const unsigned*)(p->ws + WS_CTL) + CW_CNT + l * 64;
    const int* tok_e = (const int*)(p->ws + WS_TOKE); const int* tok_p = (const int*)(p->ws + WS_TOKP); const float* tok_w = (const float*)(p->ws + WS_TOKW);
    int* tok_s = (int*)(p->ws + WS_TOKS); int* slot_t = (int*)(p->ws + WS_SLOTT); float* slot_w = (float*)(p->ws + WS_SLOTW);
    for (int i = bid_() * NTHREADS + tid_(); i < T * 8; i += gsz_() * NTHREADS) { const int e = tok_e[i], slot = ps[e] + tok_p[i]; tok_s[i] = slot; slot_t[slot] = i >> 3; slot_w[slot] = tok_w[i]; }
    for (int i = bid_() * NTHREADS + tid_(); i < T; i += gsz_() * NTHREADS) { slot_t[MAXSLOT + i] = i; slot_w[MAXSLOT + i] = 1.f; }
    for (int i = bid_() * NTHREADS + tid_(); i < 64 * 256; i += gsz_() * NTHREADS) { const int e = i >> 8, j = i & 255; const int r = ps[e] + (int)cnt[e] + j; if (r < ps[e + 1]) { slot_t[r] = 0; slot_w[r] = 0.f; } }
    __syncthreads();
}

__device__ __forceinline__ void ph_gateup(KP p, int l, unsigned char* lds) {
    const int T = (l == 0) ? R_ALL : R_LAT;
    int* ps = (int*)lds; moe_pad_starts(p, l, ps);
    const bf16_t* Tok = (const bf16_t*)(p->ws + Z_A); const bf16_t* Wgu = (const bf16_t*)(p->ws + Z_WGU); bf16_t* H = (bf16_t*)(p->ws + Z_H);
    const int* slot_t = (const int*)(p->ws + WS_SLOTT); const float* slot_w = (const float*)(p->ws + WS_SLOTW);
    const int n128 = ps[64] / 128, nitems = (n128 + T / 128) * 2;
    for (int it = bid_(); it < nitems; it += gsz_()) { const int rt = it >> 1, pn = it & 1;
        if (rt < n128) { const int e = moe_expert_of_row(ps, rt * 128);
            auto epi = [&](int row, int col, float g, float u) { H[(size_t)row * 256 + pn * 128 + col] = (bf16_t)f2bf(silu_(g) * u * slot_w[row]); };
            gemm_simple_tile<2>(Tok, RowGather{slot_t}, Wgu + (size_t)e * 524288, 1024, rt * 128, pn * 256, 128, epi);
        } else { const int t0 = (rt - n128) * 128;
            auto epi = [&](int row, int col, float g, float u) { H[(size_t)(MAXSLOT + row) * 256 + pn * 128 + col] = (bf16_t)f2bf(silu_(g) * u); };
            gemm_simple_tile<2>(Tok, RowId{}, Wgu + (size_t)64 * 524288, 1024, t0, pn * 256, 128, epi); }
    }
}
__device__ __forceinline__ void ph_down(KP p, int l, unsigned char* lds) {
    const int T = (l == 0) ? R_ALL : R_LAT;
    int* ps = (int*)lds; moe_pad_starts(p, l, ps);
    const bf16_t* H = (const bf16_t*)(p->ws + Z_H); const bf16_t* Wd = (const bf16_t*)(p->ws + WS_WD); bf16_t* Y = (bf16_t*)(p->ws + Z_Y); float* X = (float*)(p->ws + WS_X);
    const int n128 = ps[64] / 128, nitems = (n128 + T / 128) * 8;
    for (int it = bid_(); it < nitems; it += gsz_()) { const int rt = it >> 3, nt = it & 7;
        if (rt < n128) { const int e = moe_expert_of_row(ps, rt * 128);
            auto epi = [&](int row, int col, float v, float) { Y[(size_t)row * D + nt * 128 + col] = (bf16_t)f2bf(v); };
            gemm_simple_tile<1>(H, RowId{}, Wd + (size_t)e * 262144, 256, rt * 128, nt * 128, 0, epi);
        } else { const int t0 = (rt - n128) * 128;
            auto epi = [&](int row, int col, float v, float) { const int t = row - MAXSLOT, c = nt * 128 + col; X[(size_t)t * D + c] += mod_vec(p, l, t, 5)[c] * v; };
            gemm_simple_tile<1>(H, RowId{}, Wd + (size_t)64 * 262144, 256, MAXSLOT + t0, nt * 128, 0, epi); }
    }
}
__device__ __forceinline__ void ph_combine(KP p, int l, unsigned char* lds) {
    typedef float f32x2 __attribute__((ext_vector_type(2)));
    const int T = (l == 0) ? R_ALL : R_LAT;
    const int tid = tid_(), lane = tid & 63, wid = tid >> 6;
    const unsigned char* Y8 = (const unsigned char*)(p->ws + Z_Y); bf16_t* X = (bf16_t*)(p->ws + WS_X); const int* tok_e = (const int*)(p->ws + WS_TOKE); const int* tok_p = (const int*)(p->ws + WS_TOKP);
    int* ps = (int*)lds; moe_pad_starts(p, l, ps);
    const size_t yoff = (size_t)(lane >> 4) * MAXSLOT * 256 + (lane & 15) * 16;
    for (int row = bid_() * 8 + wid; row < T; row += gsz_() * 8) {
        const float* g5 = mod_vec(p, l, row, 5) + lane * 16;
        bf16_t* xr = X + (size_t)row * D + lane * 16;
        const int myslot = ps[tok_e[row * 8 + (lane & 7)]] + tok_p[row * 8 + (lane & 7)];
        u32x4 yv[8];
#pragma unroll
        for (int k = 0; k < 8; ++k) { const int sl = __shfl(myslot, k); yv[k] = *(const u32x4*)(Y8 + yoff + (size_t)sl * 256); }
        f32x4 xv[4], gv[4];
#pragma unroll
        for (int q = 0; q < 4; ++q) gv[q] = *(const f32x4*)(g5 + 4 * q);
        unpack8(*(const u32x4*)xr, xv[0], xv[1]); unpack8(*(const u32x4*)(xr + 8), xv[2], xv[3]);
        float a[16];
#pragma unroll
        for (int q = 0; q < 16; ++q) a[q] = 0.f;
#pragma unroll
        for (int k = 0; k < 8; ++k) { const unsigned w[4] = {yv[k].x, yv[k].y, yv[k].z, yv[k].w};
#pragma unroll
            for (int q = 0; q < 4; ++q) { const f32x2 lo = __builtin_amdgcn_cvt_pk_f32_fp8((int)w[q], false), hi = __builtin_amdgcn_cvt_pk_f32_fp8((int)w[q], true);
                a[4 * q] += lo.x; a[4 * q + 1] += lo.y; a[4 * q + 2] += hi.x; a[4 * q + 3] += hi.y; } }
#pragma unroll
        for (int q = 0; q < 4; ++q) { f32x4 av; av.x = a[4 * q]; av.y = a[4 * q + 1]; av.z = a[4 * q + 2]; av.w = a[4 * q + 3]; xv[q] = xv[q] + gv[q] * (av * (1.f / Y8_SCALE)); }
        if (l == DEPTH - 1) { float* dst = p->out + (size_t)row * D + lane * 16;
#pragma unroll
            for (int q = 0; q < 4; ++q) *(f32x4*)(dst + 4 * q) = xv[q]; }
        else { *(u32x4*)xr = (u32x4){pk2(xv[0].x, xv[0].y), pk2(xv[0].z, xv[0].w), pk2(xv[1].x, xv[1].y), pk2(xv[1].z, xv[1].w)};
               *(u32x4*)(xr + 8) = (u32x4){pk2(xv[2].x, xv[2].y), pk2(xv[2].z, xv[2].w), pk2(xv[3].x, xv[3].y), pk2(xv[3].z, xv[3].w)}; }
    }
}
struct MoeSched {
    int ntr, nrt, npn, G, c; const LAS int* tile_e;
    __device__ __forceinline__ bool map(int i, int& rt, int& pp) const {
        if (G == 256) { const int x = c & 7, j = c >> 3, tb = 32 / npn; rt = (i * 8 + x) * tb + j / npn; pp = j % npn; return rt < nrt; }
        const int L = i * G + c; if (L >= nrt * npn) return false;
        rt = L / npn; pp = L % npn; return true; }
    __device__ __forceinline__ bool next(int i, pg8::Unit& u) const {
        int rt, pp; if (!map(i, rt, pp)) return false;
        const bool routed = rt < ntr;
        const int e = routed ? __builtin_amdgcn_readfirstlane(tile_e[rt]) : 64;
        u.pm = routed ? rt : MAXSLOT / 256 + (rt - ntr); u.pn = e * npn + pp; u.ord = i; return true;
    }
};
constexpr int MOE_UNITS = 6;
constexpr int LDS_RTAB = 131072, LDS_WTAB = LDS_RTAB + MOE_UNITS * 1024, LDS_TILE_E = LDS_WTAB + MOE_UNITS * 1024, LDS_PS = LDS_TILE_E + 2400;
static_assert(LDS_PS + 129 * 4 <= LDS_BYTES - 16, "MoE tables fit above the staging buffers");
__device__ __forceinline__ MoeSched moe_setup(KP p, int l, unsigned char* lds, int npn, bool gather) {
    const int T = (l == 0) ? R_ALL : R_LAT;
    int* ps = (int*)(lds + LDS_PS); int* cl = ps + 65;
    const unsigned* cnt = (const unsigned*)(p->ws + WS_CTL) + CW_CNT + l * 64;
    const int tid = tid_();
    if (tid < 64) cl[tid] = (int)cnt[tid];
    moe_pad_starts(p, l, ps);
    LAS int* tile_e = (LAS int*)((LAS unsigned char*)lds + LDS_TILE_E); LAS int* rtab = (LAS int*)((LAS unsigned char*)lds + LDS_RTAB); LAS float* wtab = (LAS float*)((LAS unsigned char*)lds + LDS_WTAB);
    const int ntr = ps[64] / 256;
    for (int rt = tid; rt < ntr; rt += NTHREADS) tile_e[rt] = moe_expert_of_row(ps, rt * 256);
    __syncthreads();
    MoeSched S{ntr, ntr + T / 256, npn, gsz_(), bid_(), tile_e};
    if (gather) { const int* expl = (const int*)(p->ws + WS_EXPL); const float* expw = (const float*)(p->ws + WS_EXPW);
        int tok[3]; float w[3];
#pragma unroll
        for (int q = 0; q < 3; ++q) { const int idx = tid + q * NTHREADS, i = idx >> 8, r = idx & 255; tok[q] = 0; w[q] = 0.f;
            int rt, pp_;
            if (S.map(i, rt, pp_)) {
                if (rt < S.ntr) { const int e = tile_e[rt], pos = rt * 256 + r - ps[e];
                    if (pos < cl[e]) { tok[q] = expl[(size_t)e * R_ALL + pos]; w[q] = expw[(size_t)e * R_ALL + pos]; } }
                else { tok[q] = (rt - S.ntr) * 256 + r; w[q] = 1.f; } } }
#pragma unroll
        for (int q = 0; q < 3; ++q) { const int idx = tid + q * NTHREADS; rtab[idx] = tok[q]; wtab[idx] = w[q]; } }
    __syncthreads();
    return S;
}
__device__ __forceinline__ void ph_gateup_f(KP p, int l, unsigned char* lds) {
    const MoeSched S = moe_setup(p, l, lds, 2, true);
    pg8::Gemm g{(const bf16_t*)(p->ws + Z_A), (const bf16_t*)(p->ws + wgu_off(l)), 0, 0, 1024};
    pg8::EpiGU8 E{(unsigned char*)(p->ws + Z_H), (const LAS float*)((LAS unsigned char*)lds + LDS_WTAB)};
    pg8::gemm_phase<pg8::EpiGU8, MoeSched, true, true>((LAS unsigned char*)lds, g, S, E, (const LAS int*)((LAS unsigned char*)lds + LDS_RTAB));
}
__device__ __forceinline__ void ph_down_f(KP p, int l, unsigned char* lds) {
    const MoeSched S = moe_setup(p, l, lds, 4, false);
    pg8::Gemm g{(const bf16_t*)(p->ws + Z_H), (const bf16_t*)(p->ws + wd_off(l)), 0, 0, 256};
    bf16_t* X = (bf16_t*)(p->ws + WS_X);
    pg8::EpiDown E{(bf16_t*)(p->ws + Z_Y), X, (const float*)(p->ws + WS_MOD) + (size_t)l * 3 * 6144 + 5 * 1024};
    pg8::gemm_phase<pg8::EpiDown, MoeSched, false, true>((LAS unsigned char*)lds, g, S, E, nullptr);
}

#ifndef FAST_ATTN
#define FAST_ATTN 1
#endif
#ifndef FAST_GEMM
#define FAST_GEMM 15
#endif
constexpr int PH_PER_LAYER = 10, N_PHASES = 1 + DEPTH * PH_PER_LAYER;
__global__ void __launch_bounds__(NTHREADS, 2) mega(Params parg) {
    extern __shared__ __attribute__((aligned(16))) unsigned char lds[];
    const int lo = parg.ph_lo, hi = parg.ph_hi;
    volatile LAS unsigned* xbw = (volatile LAS unsigned*)(lds + LDS_BYTES - 16);
    if (threadIdx.x == 0) { xbw[0] = 0u; xbw[1] = 0u; xbw[2] = 0u; xbw[3] = 0u; }
    if ((threadIdx.x & 63) == 0) *(volatile LAS int*)((LAS unsigned char*)lds + LDS_WVTAB_OFF + 4 * hwkey_()) = (int)(threadIdx.x >> 6);
    __syncthreads();
    XcdBarrier bar; bar.bar = (unsigned*)(parg.ws + WS_CTL) + CW_BAR; bar.x = 0; bar.st = xbw;
    if (hi - lo > 1) bar = xcd_barrier_post((unsigned*)(parg.ws + WS_CTL) + CW_BAR, xbw);
#ifdef PHMASK
#define IN(k) ((((PHMASK) >> ((k) == 0 ? 0 : ((k) - 1) % PH_PER_LAYER + 1)) & 1) && lo <= (k) && (k) < hi)
#else
#define IN(k) (lo <= (k) && (k) < hi)
#endif
#define SEAM(k) do { if (IN(k) && IN((k) + 1)) xcd_barrier(bar); } while (0)
    if (IN(0)) { ph_pro(kparams(), lds); } SEAM(0);
#pragma unroll
    for (int l = 0; l < DEPTH; ++l) {
        const int b0 = 1 + l * PH_PER_LAYER;
        if (IN(b0 + 0)) { ph_norm1(kparams(), l, lds); } SEAM(b0 + 0);
        if (IN(b0 + 1)) { ph_inproj_f(kparams(), l, lds); } SEAM(b0 + 1);
        if (IN(b0 + 2)) { ph_prep(kparams(), l, lds); } SEAM(b0 + 2);
        if (IN(b0 + 3)) { ph_attn_f(kparams(), l, lds); } SEAM(b0 + 3);
        if (IN(b0 + 4)) { ph_hgrn3(kparams(), l, lds); } SEAM(b0 + 4);
        if (IN(b0 + 5)) { ph_outproj_f(kparams(), l, lds); } SEAM(b0 + 5);
        if (IN(b0 + 6)) { ph_norm2(kparams(), l, lds); } SEAM(b0 + 6);
        if (IN(b0 + 7)) { ph_gateup_f(kparams(), l, lds); } SEAM(b0 + 7);
        if (IN(b0 + 8)) { ph_down_f(kparams(), l, lds); } SEAM(b0 + 8);
        if (IN(b0 + 9)) { ph_combine(kparams(), l, lds); } SEAM(b0 + 9);
    }
#undef IN
#undef SEAM
}

#ifndef MK_ONE_LAUNCH
#define MK_ONE_LAUNCH 1
#endif
extern "C" void kernel_launch(void* const* d_in, const int* in_sizes, int n_in, void* d_out, int out_size, void* d_ws, size_t ws_size, hipStream_t stream) {
    static int grid = 0;
    if (grid == 0) {
        if (n_in != 31 || ws_size < WS_END2) { fprintf(stderr, "kernel_launch: unexpected n_in %d or ws_size %zu (< %zu)\n", n_in, ws_size, (size_t)WS_END2); grid = -1; return; }
        int dev = 0, cus = 0, per_cu = 0;
        if (hipGetDevice(&dev) != hipSuccess || hipDeviceGetAttribute(&cus, hipDeviceAttributeMultiprocessorCount, dev) != hipSuccess) { grid = -1; return; }
        if (hipFuncSetAttribute((const void*)mega, hipFuncAttributeMaxDynamicSharedMemorySize, LDS_BYTES) != hipSuccess) { fprintf(stderr, "kernel_launch: hipFuncSetAttribute failed\n"); grid = -1; return; }
        if (hipOccupancyMaxActiveBlocksPerMultiprocessor(&per_cu, (const void*)mega, NTHREADS, LDS_BYTES) != hipSuccess || per_cu < 1) fprintf(stderr, "kernel_launch: occupancy query says %d\n", per_cu);
        (void)hipGetLastError();
        grid = cus;
    }
    if (grid < 0) return;
    (void)hipMemsetAsync((char*)d_ws + WS_CTL, 0, CTL_ZERO_BYTES, stream);
    Params p{};
    for (int i = 0; i < 31; ++i) p.in[i] = (const float*)d_in[i];
    p.out = (float*)d_out; p.ws = (unsigned char*)d_ws;
#if MK_ONE_LAUNCH
    p.ph_lo = 0; p.ph_hi = N_PHASES;
    hipLaunchKernelGGL(mega, dim3(grid), dim3(NTHREADS), LDS_BYTES, stream, p);
#else
    for (int k = 0; k < N_PHASES; ++k) { p.ph_lo = k; p.ph_hi = k + 1; hipLaunchKernelGGL(mega, dim3(grid), dim3(NTHREADS), LDS_BYTES, stream, p); }
#endif
}
```

```cpp
#include <hip/hip_runtime.h>
#include <hip/hip_bf16.h>
#include <cmath>
#include <cstdint>
#include <cstdio>

#define LAS __attribute__((address_space(3)))

typedef unsigned short bf16_t;
typedef short bf16x8 __attribute__((ext_vector_type(8)));
typedef float f32x4 __attribute__((ext_vector_type(4)));
typedef unsigned u32x4 __attribute__((ext_vector_type(4)));
typedef unsigned u32x2 __attribute__((ext_vector_type(2)));

constexpr int D = 1024, NB = 2, NSEQ = 8192, NCTX = 256, DEPTH = 2;
constexpr int R_LAT = NB * NSEQ, R_CTX = NB * NCTX, R_ALL = R_LAT + R_CTX;
constexpr int DIN = 2816;
constexpr int NKEY = NSEQ + NCTX;
constexpr int NE = 64, TOPK = 8;
constexpr int MAXSLOT = 151552;
constexpr int HROWS = MAXSLOT + R_ALL;
constexpr int NCHUNK = 132;
constexpr float EPS = 1e-6f;
constexpr float TOK8_SCALE = 8.f, WGU8_SCALE = 256.f, H8_SCALE = 16.f, WD8_SCALE = 128.f;
constexpr float GU_DESCALE = 1.f / (TOK8_SCALE * WGU8_SCALE), DN_DESCALE = 1.f / (H8_SCALE * WD8_SCALE);
constexpr float Y8_SCALE = 32.f;
constexpr float QSCALE = 0.125f * 1.4426950408889634f;
constexpr float LOG2E = 1.4426950408889634f;

#ifndef FAST_HGRN
#define FAST_HGRN 1
#endif
constexpr int C_GQ = 0, C_GK = 256, C_GV = 384, C_WQ = 512, C_WK = 768, C_WV = 896, C_CVV = 1024, C_CVG = 1280, C_RQ = 1536, C_RI = 1792, C_RFF = 2048, C_RFB = 2304, C_RG = 2560;

constexpr size_t MiB = (size_t)1 << 20;
constexpr size_t WS_CTL = 0, CTL_ZERO_BYTES = 64 * 1024;
constexpr size_t WS_MOD = 1 * MiB;
constexpr size_t WS_LB = WS_MOD + 256 * 1024;
constexpr size_t WS_ROPE = WS_MOD + 512 * 1024;
constexpr size_t WS_TOKE = 2 * MiB, WS_TOKP = 3 * MiB, WS_TOKW = 4 * MiB, WS_TOKS = 5 * MiB;
constexpr size_t WS_SLOTT = 6 * MiB, WS_SLOTW = 7 * MiB;
constexpr size_t WS_X = 8 * MiB;
constexpr size_t WS_WD = 74 * MiB;
constexpr size_t WS_Z = 107 * MiB;
constexpr size_t Z_A = WS_Z + 0 * MiB;
constexpr size_t Z_WGU = WS_Z + 33 * MiB;
constexpr size_t Z_WIN = WS_Z + 98 * MiB;
constexpr size_t Z_WOUT = WS_Z + 104 * MiB;
constexpr size_t Z_WPW = WS_Z + 106 * MiB;
__host__ __device__ constexpr size_t wgu_off(int l) { return WS_Z + 33 * MiB + (size_t)l * 34078720; }
__host__ __device__ constexpr size_t wd_off(int l) { return 74 * MiB + (size_t)l * 17039360; }
__host__ __device__ constexpr size_t win_off(int l) { return l == 0 ? WS_Z + 98 * MiB : WS_Z + (302 + 42) * MiB; }
__host__ __device__ constexpr size_t wout_off(int l) { return l == 0 ? WS_Z + 104 * MiB : WS_Z + (302 + 48) * MiB; }
__host__ __device__ constexpr size_t wpw_off(int l) { return l == 0 ? WS_Z + 106 * MiB : WS_Z + (302 + 51) * MiB; }
constexpr size_t Z_P = WS_Z + 107 * MiB;
constexpr size_t Z_YCAT = WS_Z + 198 * MiB;
constexpr size_t Z_QG = WS_Z + 231 * MiB, Z_QW = WS_Z + 239 * MiB;
constexpr size_t Z_KG = WS_Z + 247 * MiB, Z_VG = WS_Z + 252 * MiB, Z_KW = WS_Z + 257 * MiB, Z_VW = WS_Z + 262 * MiB;
constexpr size_t Z_QGC = WS_Z + 267 * MiB, Z_QWC = Z_QGC + 512 * 1024;
constexpr size_t Z_U = WS_Z + 268 * MiB;
constexpr size_t Z_G = WS_Z + 301 * MiB;
constexpr size_t Z_Y = WS_Z + 107 * MiB;
constexpr size_t Z_H = WS_Z + 302 * MiB;
constexpr size_t WS_END = WS_Z + 385 * MiB;
constexpr size_t WS_EXPL = WS_END, WS_EXPW = WS_END + 5 * MiB, WS_END2 = WS_END + 10 * MiB;
static_assert(Z_H + (size_t)HROWS * 512 <= WS_END, "H fits");
static_assert(Z_Y + (size_t)MAXSLOT * 1024 <= Z_U, "Y8 below the HGRN state buffers");
static_assert(Z_P + (size_t)R_ALL * DIN * 2 <= Z_YCAT, "P fits");

constexpr int CW_BAR = 0;
constexpr int CW_CNT = 4096;

constexpr int LDS_BYTES = 147456;
constexpr int NTHREADS = 512;

struct Params {
    const float* in[31];
    float* out;
    unsigned char* ws;
    int ph_lo, ph_hi;
};

typedef const __attribute__((address_space(4))) Params* KP;
__device__ __forceinline__ KP kparams() { KP k = (KP)__builtin_amdgcn_kernarg_segment_ptr(); asm volatile("" : "+s"(k)); return k; }

constexpr int LDS_WVTAB_OFF = 147456 - 16 - 256;
__device__ __forceinline__ int hwkey_() { return (int)__builtin_amdgcn_s_getreg((5 << 11) | 4) & 63; }
__device__ __forceinline__ int tid_() { extern __shared__ __attribute__((aligned(16))) unsigned char lds_all[];
    const int w = __builtin_amdgcn_readfirstlane(*(const LAS int*)((LAS unsigned char*)lds_all + LDS_WVTAB_OFF + 4 * hwkey_()));
    unsigned z; asm volatile("v_mov_b32 %0, 0" : "=v"(z));
    int t = (w << 6) | (int)__builtin_amdgcn_mbcnt_hi(~0u, __builtin_amdgcn_mbcnt_lo(~0u, z)); asm volatile("" : "+v"(t)); return t; }
__device__ __forceinline__ int bid_() { int b = blockIdx.x; asm volatile("" : "+s"(b)); return b; }
__device__ __forceinline__ int gsz_() { int g = gridDim.x; asm volatile("" : "+s"(g)); return g; }

__device__ __forceinline__ unsigned f2bf(float f) { unsigned u = __float_as_uint(f); return (u + 0x7fffu + ((u >> 16) & 1u)) >> 16; }
__device__ __forceinline__ float bf2f(unsigned h) { return __uint_as_float(h << 16); }
__device__ __forceinline__ unsigned pk2(float lo, float hi) { unsigned r; asm("v_cvt_pk_bf16_f32 %0, %1, %2" : "=v"(r) : "v"(lo), "v"(hi)); return r; }
__device__ __forceinline__ void unpack8(const u32x4 r, f32x4& lo, f32x4& hi) { lo.x = bf2f(r.x & 0xffffu); lo.y = bf2f(r.x >> 16); lo.z = bf2f(r.y & 0xffffu); lo.w = bf2f(r.y >> 16); hi.x = bf2f(r.z & 0xffffu); hi.y = bf2f(r.z >> 16); hi.z = bf2f(r.w & 0xffffu); hi.w = bf2f(r.w >> 16); }
__device__ __forceinline__ float wave_sum(float v) {
#pragma unroll
    for (int o = 1; o < 64; o <<= 1) v += __shfl_xor(v, o);
    return v;
}
__device__ __forceinline__ float clamp8(float v) { return fminf(fmaxf(v, -440.f), 440.f); }
__device__ __forceinline__ float sigmoid_(float x) { return __builtin_amdgcn_rcpf(1.f + __expf(-x)); }
__device__ __forceinline__ float silu_(float x) { return x * sigmoid_(x); }

__device__ __forceinline__ const float* xrow_src(KP p, int l, int row) {
    if (l == 0) return (row < R_LAT) ? p->in[0] + (size_t)row * D : p->in[2] + (size_t)(row - R_LAT) * D;
    return (const float*)(p->ws + WS_X) + (size_t)row * D;
}
__device__ __forceinline__ const float* mod_vec(KP p, int l, int row, int i) {
    const int r = (row < R_LAT) ? (row >> 13) : 2;
    return (const float*)(p->ws + WS_MOD) + ((size_t)l * 3 + r) * 6144 + i * 1024;
}

#define XB_TMO      128
#define XB_XCNT(j)  (256  + 64 * (j))
#define XB_XSUB(j)  (1280 + 64 * (j))
#define XB_XGEN(j)  (2304 + 64 * (j))
#define XB_TOP      3328
#define XB_TOPGEN   3392
#define XCD_BAR_WORDS 3456
#define XB_SPIN_CAP (1u << 18)
__device__ __forceinline__ unsigned xb_ld(unsigned* p)              { return __hip_atomic_load(p, __ATOMIC_RELAXED, __HIP_MEMORY_SCOPE_AGENT); }
__device__ __forceinline__ unsigned xb_add(unsigned* p, unsigned v) { return __hip_atomic_fetch_add(p, v, __ATOMIC_RELAXED, __HIP_MEMORY_SCOPE_AGENT); }
__device__ __forceinline__ unsigned xb_xcc_id() { return (unsigned)__builtin_amdgcn_s_getreg((3 << 11) | 20) & 0xFu; }
#define XB_SPIN(cond, bar) do { unsigned _sp = 0; while (cond) { __builtin_amdgcn_s_sleep(1); \
    if ((++_sp & 255u) == 0u) { if (xb_ld(&(bar)[XB_TMO])) break; if (_sp > XB_SPIN_CAP) { atomicAdd(&(bar)[XB_TMO], 1u); break; } } } } while (0)
struct XcdBarrier { unsigned* bar; unsigned x; volatile LAS unsigned* st; };
__device__ __forceinline__ XcdBarrier xcd_barrier_post(unsigned* bar, volatile LAS unsigned* st) {
    XcdBarrier b; b.bar = bar; b.x = xb_xcc_id(); b.st = st;
    if (tid_() == 0) (void)xb_add(&bar[XB_XCNT(b.x)], 1u);
    return b;
}
__device__ __forceinline__ void xcd_barrier_complete(unsigned* bar, unsigned x, unsigned& nloc, unsigned& nx) {
    const unsigned G = gridDim.x * gridDim.y * gridDim.z;
    unsigned sum, cnt, mine, sp = 0u;
    for (;;) {
        sum = 0u; cnt = 0u; mine = 0u;
#pragma unroll
        for (unsigned j = 0; j < 16; ++j) { const unsigned c = xb_ld(&bar[XB_XCNT(j)]); sum += c; cnt += (c > 0u) ? 1u : 0u; mine = (j == x) ? c : mine; }
        if (sum == G) break;
        __builtin_amdgcn_s_sleep(1);
        if ((++sp & 255u) == 0u) { if (xb_ld(&bar[XB_TMO])) break; if (sp > XB_SPIN_CAP) { atomicAdd(&bar[XB_TMO], 1u); break; } }
    }
    nloc = mine > 0u ? mine : 1u; nx = cnt > 0u ? cnt : 1u;
}
__device__ __forceinline__ void xcd_barrier(const XcdBarrier& b) {
    asm volatile("s_waitcnt vmcnt(0)" ::: "memory");
    __syncthreads();
    if (tid_() == 0) {
        unsigned* bar = b.bar;
        __builtin_amdgcn_s_waitcnt(0);
        unsigned nloc = b.st[0], nx = b.st[1];
        if (nloc == 0u) { xcd_barrier_complete(bar, b.x, nloc, nx); b.st[0] = nloc; b.st[1] = nx; }
        const unsigned old = xb_add(&bar[XB_XSUB(b.x)], 1u);
        const unsigned gen = old / nloc;
        if (old + 1u == (gen + 1u) * nloc) {
            __builtin_amdgcn_fence(__ATOMIC_RELEASE, "agent");
            asm volatile("s_waitcnt vmcnt(0)" ::: "memory");
            const unsigned og = xb_add(&bar[XB_TOP], 1u);
            const unsigned tg = og / nx;
            if (og + 1u == (tg + 1u) * nx) xb_add(&bar[XB_TOPGEN], 1u);
            else XB_SPIN(xb_ld(&bar[XB_TOPGEN]) == tg, bar);
            __builtin_amdgcn_fence(__ATOMIC_ACQUIRE, "agent");
            xb_add(&bar[XB_XGEN(b.x)], 1u);
            asm volatile("s_waitcnt vmcnt(0)" ::: "memory");
        } else {
            XB_SPIN(xb_ld(&bar[XB_XGEN(b.x)]) == gen, bar);
            __builtin_amdgcn_fence(__ATOMIC_ACQUIRE, "agent");
            asm volatile("s_waitcnt vmcnt(0)" ::: "memory");
        }
    }
    __syncthreads();
}

__device__ __forceinline__ void ph_pro(KP p, unsigned char* lds) {
    float* sc = (float*)lds;
    float* red = sc + 3 * 1024;
    const int tid = tid_(), lane = tid & 63, wid = tid >> 6;
    for (int i = tid; i < 3 * 1024; i += NTHREADS) { const int r = i >> 10, k = i & 1023; const float v = (r < 2) ? p->in[1][r * 1024 + k] : p->in[3][k]; sc[i] = silu_(v); }
    __syncthreads();
    float* mod = (float*)(p->ws + WS_MOD);
    for (int item = bid_(); item < DEPTH * 96; item += gsz_()) {
        const int l = item / 96, j0 = (item % 96) * 64;
        const float* w = p->in[4] + (size_t)l * 1024 * 6144;
        float a0 = 0.f, a1 = 0.f, a2 = 0.f;
        const int k0 = wid * 128;
#pragma unroll 1
        for (int k = k0; k < k0 + 128; k += 16) { float wv[16];
#pragma unroll
            for (int u = 0; u < 16; ++u) wv[u] = w[(size_t)(k + u) * 6144 + j0 + lane];
#pragma unroll
            for (int u = 0; u < 16; ++u) { a0 += sc[k + u] * wv[u]; a1 += sc[1024 + k + u] * wv[u]; a2 += sc[2048 + k + u] * wv[u]; } }
        red[(wid * 3 + 0) * 64 + lane] = a0; red[(wid * 3 + 1) * 64 + lane] = a1; red[(wid * 3 + 2) * 64 + lane] = a2;
        __syncthreads();
        if (tid < 192) { const int r = tid >> 6; float s = 0.f;
            for (int w8 = 0; w8 < 8; ++w8) s += red[(w8 * 3 + r) * 64 + lane];
            mod[((size_t)l * 3 + r) * 6144 + j0 + lane] = s + p->in[5][l * 6144 + j0 + lane]; }
        __syncthreads();
    }
    if (bid_() == 0) {
        float* rt = (float*)(p->ws + WS_ROPE);
        for (int i = tid; i < 128 * 16; i += NTHREADS) { const int pos = i >> 4, f = i & 15; const float inv = powf(10000.f, -(float)f * (1.f / 16.f)); float sn, cs; sincosf((float)pos * inv, &sn, &cs);
            rt[pos * 32 + f] = cs; rt[pos * 32 + 16 + f] = sn; }
    }
    if (bid_() == gsz_() - 1) {
        float* lb = (float*)(p->ws + WS_LB);
        for (int i = tid; i < 2 * 2 * 256; i += NTHREADS) { const int l = i >> 9, dir = (i >> 8) & 1, ch = i & 255;
            const float* lg = p->in[21];
            const float l0 = lg[(dir * 2 + 0) * 256 + ch], l1 = lg[(dir * 2 + 1) * 256 + ch]; const float m = fmaxf(l0, l1);
            const float e0 = expf(l0 - m), e1 = expf(l1 - m);
            lb[i] = (l == 0) ? 0.f : e1 / (e0 + e1); }
    }
}

constexpr int CVT_E1 = 1050, CVT_E2 = 2850;
struct CvtTile { const float* src; bf16_t* dst; int K, N, k0, n0, blk, bstride, boff; float f8scale; int perm; };
__device__ __forceinline__ int cvt_total() { return 16 * 44 + 16 * 16 + 4 * 4 + 2 * (64 * 64) + 2 * 64 + 64 * 64 + 64; }
__device__ __forceinline__ CvtTile cvt_decode(KP p, int l, int g) {
    bf16_t* Wgu = (bf16_t*)(p->ws + wgu_off(l)); bf16_t* Wd = (bf16_t*)(p->ws + wd_off(l));
    CvtTile t; int per, tn, r;
    if (g < 704) { r = g; t = {p->in[8] + (size_t)l * 1024 * DIN, (bf16_t*)(p->ws + win_off(l)), 1024, DIN, 0, 0, DIN, 0, 0, 0.f}; tn = 44; per = 704; }
    else if ((g -= 704) < 256) { r = g; t = {p->in[9] + (size_t)l * 1024 * 1024, (bf16_t*)(p->ws + wout_off(l)), 1024, 1024, 0, 0, 1024, 0, 0, 0.f}; tn = 16; per = 256; }
    else if ((g -= 256) < 16) { r = g; t = {p->in[19] + (size_t)l * 65536, (bf16_t*)(p->ws + wpw_off(l)), 256, 256, 0, 0, 256, 0, 0, 0.f}; tn = 4; per = 16; }
    else if ((g -= 16) < 4096) { const int m = g >> 6; r = g & 63; t = {p->in[25] + ((size_t)l * 64 + m) * 262144, (bf16_t*)((unsigned char*)Wgu + (size_t)m * 524288), 1024, 256, 0, 0, 128, 256, 0, WGU8_SCALE}; tn = 4; per = 64; }
    else if ((g -= 4096) < 4096) { const int m = g >> 6; r = g & 63; t = {p->in[26] + ((size_t)l * 64 + m) * 262144, (bf16_t*)((unsigned char*)Wgu + (size_t)m * 524288), 1024, 256, 0, 0, 128, 256, 128, WGU8_SCALE}; tn = 4; per = 64; }
    else if ((g -= 4096) < 64) { r = g; t = {p->in[28] + (size_t)l * 262144, (bf16_t*)((unsigned char*)Wgu + (size_t)64 * 524288), 1024, 256, 0, 0, 128, 256, 0, WGU8_SCALE}; tn = 4; per = 64; }
    else if ((g -= 64) < 64) { r = g; t = {p->in[29] + (size_t)l * 262144, (bf16_t*)((unsigned char*)Wgu + (size_t)64 * 524288), 1024, 256, 0, 0, 128, 256, 128, WGU8_SCALE}; tn = 4; per = 64; }
    else if ((g -= 64) < 4096) { const int m = g >> 6; r = g & 63; t = {p->in[27] + ((size_t)l * 64 + m) * 262144, (bf16_t*)((unsigned char*)Wd + (size_t)m * 262144), 256, 1024, 0, 0, 1024, 0, 0, WD8_SCALE, 1}; tn = 16; per = 64; }
    else { g -= 4096; r = g; t = {p->in[30] + (size_t)l * 262144, (bf16_t*)((unsigned char*)Wd + (size_t)64 * 262144), 256, 1024, 0, 0, 1024, 0, 0, WD8_SCALE, 1}; tn = 16; per = 64; }
    (void)per; t.k0 = (r / tn) * 64; t.n0 = (r % tn) * 64; return t;
}
__device__ __forceinline__ void ph_cvt(KP p, int l, unsigned char* lds, int first = 0, int nwg = 0, int t0 = 0, int t1 = 1 << 30) {
    float* tb = (float*)lds;
    const int tid = tid_(), G = nwg ? nwg : gsz_(), total = t1 < cvt_total() ? t1 : cvt_total();
    const int r0 = tid >> 4, c0 = (tid & 15) * 4, nn = tid >> 3, kc = (tid & 7) * 8;
    int g = bid_() - first, buf = 0;
    if (g < 0) return;
    g += t0;
    if (g >= total) return;
    CvtTile T = cvt_decode(p, l, g);
    f32x4 v0 = *(const f32x4*)(T.src + (size_t)(T.k0 + r0) * T.N + T.n0 + c0), v1 = *(const f32x4*)(T.src + (size_t)(T.k0 + r0 + 32) * T.N + T.n0 + c0);
    for (;;) {
        float* t = tb + buf * (64 * 65);
        t[r0 * 65 + c0] = v0.x; t[r0 * 65 + c0 + 1] = v0.y; t[r0 * 65 + c0 + 2] = v0.z; t[r0 * 65 + c0 + 3] = v0.w;
        t[(r0 + 32) * 65 + c0] = v1.x; t[(r0 + 32) * 65 + c0 + 1] = v1.y; t[(r0 + 32) * 65 + c0 + 2] = v1.z; t[(r0 + 32) * 65 + c0 + 3] = v1.w;
        const CvtTile C = T; const int gn = g + G; const bool more = gn < total;
        if (more) { T = cvt_decode(p, l, gn);
            v0 = *(const f32x4*)(T.src + (size_t)(T.k0 + r0) * T.N + T.n0 + c0); v1 = *(const f32x4*)(T.src + (size_t)(T.k0 + r0 + 32) * T.N + T.n0 + c0); }
        __syncthreads();
        { const int n = C.n0 + nn; int drow = (n / C.blk) * C.bstride + C.boff + (n % C.blk);
          if (C.perm) drow = (n & ~255) + ((n >> 3) & 1) * 128 + ((n >> 6) & 3) * 32 + ((n >> 4) & 3) * 8 + (n & 7);
          if (C.f8scale != 0.f) { const float sc = C.f8scale;
              int w0 = __builtin_amdgcn_cvt_pk_fp8_f32(clamp8(t[(kc + 0) * 65 + nn] * sc), clamp8(t[(kc + 1) * 65 + nn] * sc), 0, false); w0 = __builtin_amdgcn_cvt_pk_fp8_f32(clamp8(t[(kc + 2) * 65 + nn] * sc), clamp8(t[(kc + 3) * 65 + nn] * sc), w0, true);
              int w1 = __builtin_amdgcn_cvt_pk_fp8_f32(clamp8(t[(kc + 4) * 65 + nn] * sc), clamp8(t[(kc + 5) * 65 + nn] * sc), 0, false); w1 = __builtin_amdgcn_cvt_pk_fp8_f32(clamp8(t[(kc + 6) * 65 + nn] * sc), clamp8(t[(kc + 7) * 65 + nn] * sc), w1, true);
              u32x2 o8; o8.x = (unsigned)w0; o8.y = (unsigned)w1;
              *(u32x2*)((unsigned char*)C.dst + (size_t)drow * C.K + C.k0 + kc) = o8;
          } else {
          u32x4 o; o.x = pk2(t[(kc + 0) * 65 + nn], t[(kc + 1) * 65 + nn]); o.y = pk2(t[(kc + 2) * 65 + nn], t[(kc + 3) * 65 + nn]);
          o.z = pk2(t[(kc + 4) * 65 + nn], t[(kc + 5) * 65 + nn]); o.w = pk2(t[(kc + 6) * 65 + nn], t[(kc + 7) * 65 + nn]);
          *(u32x4*)(C.dst + (size_t)drow * C.K + C.k0 + kc) = o; } }
        if (!more) break;
        g = gn; buf ^= 1;
    }
    __syncthreads();
}
__device__ __forceinline__ void norm_mod_row(const float* xrow, const float* g, const float* shift, const float* scale, bf16_t* orow, float* fout, int lane) {
    f32x4 v[4]; float s = 0.f;
#pragma unroll
    for (int j = 0; j < 4; ++j) { v[j] = ((const f32x4*)xrow)[lane + 64 * j]; s += v[j].x * v[j].x + v[j].y * v[j].y + v[j].z * v[j].z + v[j].w * v[j].w; }
    const float rinv = rsqrtf(wave_sum(s) * (1.f / D) + EPS);
#pragma unroll
    for (int j = 0; j < 4; ++j) { const int idx = lane + 64 * j;
        const f32x4 gg = ((const f32x4*)g)[idx], sh = ((const f32x4*)shift)[idx], sc = ((const f32x4*)scale)[idx];
        f32x4 y; y.x = v[j].x * rinv * gg.x * (1.f + sc.x) + sh.x; y.y = v[j].y * rinv * gg.y * (1.f + sc.y) + sh.y;
        y.z = v[j].z * rinv * gg.z * (1.f + sc.z) + sh.z; y.w = v[j].w * rinv * gg.w * (1.f + sc.w) + sh.w;
        u32x2 o; o.x = pk2(y.x, y.y); o.y = pk2(y.z, y.w);
        ((u32x2*)orow)[idx] = o;
        if (fout) ((f32x4*)fout)[idx] = y; }
}
__device__ __forceinline__ void ph_norm1(KP p, int l, unsigned char* lds) {
    if (l == 0) ph_cvt(p, l, lds);
    const int tid = tid_(), lane = tid & 63, wid = tid >> 6;
    bf16_t* A = (bf16_t*)(p->ws + Z_A);
    const float* g = p->in[6] + l * D;
    if (l == 0) { for (int row = bid_() * 8 + wid; row < R_ALL; row += gsz_() * 8)
        norm_mod_row(xrow_src(p, l, row), g, mod_vec(p, l, row, 0), mod_vec(p, l, row, 1), A + (size_t)row * D, nullptr, lane); }
    else { const bf16_t* X = (const bf16_t*)(p->ws + WS_X);
        for (int row = bid_() * 8 + wid; row < R_ALL; row += gsz_() * 8) {
            const float* shift = mod_vec(p, l, row, 0); const float* scale = mod_vec(p, l, row, 1);
            f32x4 v[4]; unpack8(*(const u32x4*)(X + (size_t)row * D + lane * 8), v[0], v[1]); unpack8(*(const u32x4*)(X + (size_t)row * D + 512 + lane * 8), v[2], v[3]);
            float ss = 0.f;
#pragma unroll
            for (int j = 0; j < 4; ++j) ss += v[j].x * v[j].x + v[j].y * v[j].y + v[j].z * v[j].z + v[j].w * v[j].w;
            const float rinv = rsqrtf(wave_sum(ss) * (1.f / D) + EPS);
#pragma unroll
            for (int h = 0; h < 2; ++h) { const int c0 = h * 512 + lane * 8; unsigned o[4];
#pragma unroll
                for (int q = 0; q < 2; ++q) { const f32x4 gg = *(const f32x4*)(g + c0 + 4 * q), sh = *(const f32x4*)(shift + c0 + 4 * q), sc = *(const f32x4*)(scale + c0 + 4 * q);
                    const f32x4 y = v[2 * h + q] * rinv * gg * (sc + 1.f) + sh; o[2 * q] = pk2(y.x, y.y); o[2 * q + 1] = pk2(y.z, y.w); }
                *(u32x4*)(A + (size_t)row * D + c0) = (u32x4){o[0], o[1], o[2], o[3]}; } } }
}

template <int NBJ, class ARow, class Epi>
__device__ __forceinline__ void gemm_simple_tile(const bf16_t* A, const ARow& arow, const bf16_t* Bt, int K, int row0, int colb0, int bjstride, const Epi& epi) {
    const int tid = tid_(), lane = tid & 63, wid = tid >> 6, wr = wid >> 1, wc = wid & 1, fr = lane & 15, fq = lane >> 4;
    f32x4 acc[2][NBJ][4];
#pragma unroll
    for (int i = 0; i < 2; ++i)
#pragma unroll
        for (int b = 0; b < NBJ; ++b)
#pragma unroll
            for (int j = 0; j < 4; ++j) acc[i][b][j] = (f32x4){0.f, 0.f, 0.f, 0.f};
    const bf16_t* ap[2];
#pragma unroll
    for (int i = 0; i < 2; ++i) ap[i] = A + (size_t)arow(row0 + wr * 32 + i * 16 + fr) * K + fq * 8;
    const bf16_t* bp = Bt + (size_t)(colb0 + wc * 64 + fr) * K + fq * 8;
    for (int k = 0; k < K; k += 32) {
        bf16x8 a[2];
#pragma unroll
        for (int i = 0; i < 2; ++i) a[i] = *(const bf16x8*)(ap[i] + k);
#pragma unroll
        for (int b = 0; b < NBJ; ++b)
#pragma unroll
            for (int j = 0; j < 4; ++j) { const bf16x8 bv = *(const bf16x8*)(bp + (size_t)(b * bjstride + j * 16) * K + k);
#pragma unroll
                for (int i = 0; i < 2; ++i) acc[i][b][j] = __builtin_amdgcn_mfma_f32_16x16x32_bf16(a[i], bv, acc[i][b][j], 0, 0, 0); }
    }
#pragma unroll
    for (int i = 0; i < 2; ++i)
#pragma unroll
        for (int j = 0; j < 4; ++j)
#pragma unroll
            for (int r = 0; r < 4; ++r) { const int row = row0 + wr * 32 + i * 16 + fq * 4 + r, col = wc * 64 + j * 16 + fr;
                epi(row, col, acc[i][0][j][r], acc[i][NBJ - 1][j][r]); }
}
struct RowId { __device__ __forceinline__ int operator()(int r) const { return r; } };
struct RowGather { const int* idx; __device__ __forceinline__ int operator()(int r) const { return idx[r]; } };

__device__ __forceinline__ void ph_inproj(KP p, int l, unsigned char* lds) {
    const bf16_t* A = (const bf16_t*)(p->ws + Z_A); const bf16_t* Bt = (const bf16_t*)(p->ws + Z_WIN); bf16_t* P = (bf16_t*)(p->ws + Z_P);
    constexpr int TM = R_ALL / 128, TN = DIN / 128;
    for (int it = bid_(); it < TM * TN; it += gsz_()) { const int mt = it / TN, nt = it % TN;
        auto epi = [&](int row, int col, float v, float) { P[(size_t)row * DIN + nt * 128 + col] = (bf16_t)f2bf(v); };
        gemm_simple_tile<1>(A, RowId{}, Bt, 1024, mt * 128, nt * 128, 0, epi); }
}

namespace pg8 {
constexpr int BM = 256, BK = 64, HALF = 128, HTB = HALF * BK * 2, STAGE_BYTES = 8 * HTB, NXCD = 8, WGM = 8;
__host__ __device__ __forceinline__ int lds_byte(int r, int c) { const int st = (r >> 4) * 2 + (c >> 5), rr = r & 15, cc = c & 31, ob = rr * 64 + cc * 2; return st * 1024 + (ob ^ (((ob >> 9) & 1) << 5)); }
__host__ __device__ __forceinline__ void stage_rc(int b, int& R, int& C) { const int st = b / 1024, sb = b % 1024, swz = sb ^ (((sb >> 9) & 1) << 5); R = (st >> 1) * 16 + swz / 64; C = (st & 1) * 32 + (swz % 64) / 2; }
__host__ __device__ __forceinline__ int perm32(int rho) { const int n = rho >> 4, i = rho & 15; return 8 * (i >> 2) + 4 * n + (i & 3); }
struct Unit { int pm, pn, ord; };
struct Gemm { const bf16_t* A; const bf16_t* Bt; int M, N, K; };
struct StaticOrder {
    int nM, nN, nwg, G, c;
    __host__ __device__ void init(int M, int N, int G_, int c_) { nM = M / BM; nN = N / BM; nwg = nM * nN; G = G_; c = c_; }
    __host__ __device__ bool next(int i, Unit& u) const {
        const long L = (long)i * G + c; if (L >= nwg) return false;
        int wgid = (int)L; { const int q = nwg / NXCD, r = nwg % NXCD, xcd = wgid % NXCD, off = wgid / NXCD; wgid = (xcd < r ? xcd * (q + 1) : r * (q + 1) + (xcd - r) * q) + off; }
        const int nig = WGM * nN, gid = wgid / nig, fm = gid * WGM, gsz = (nM - fm) < WGM ? (nM - fm) : WGM;
        u.pm = fm + ((wgid % nig) % gsz); u.pn = (wgid % nig) / gsz; u.ord = i; return true;
    }
};
__device__ __forceinline__ unsigned cvt_pk_bf16(float lo, float hi) { unsigned r; asm volatile("v_cvt_pk_bf16_f32 %0, %1, %2" : "=v"(r) : "v"(lo), "v"(hi)); return r; }

typedef int i32x4v __attribute__((ext_vector_type(4)));
typedef int i32x8v __attribute__((ext_vector_type(8)));
__device__ __forceinline__ i32x8v cat8(bf16x8 lo, bf16x8 hi) { const i32x4v a = __builtin_bit_cast(i32x4v, lo), b = __builtin_bit_cast(i32x4v, hi); return __builtin_shufflevector(a, b, 0, 1, 2, 3, 4, 5, 6, 7); }
__device__ __forceinline__ void glds16_s(const void* sbase, unsigned voff, unsigned lds_dst) { unsigned keep;
    asm volatile("s_mov_b32 %0, m0\n\ts_mov_b32 m0, %3\n\ts_nop 0\n\tglobal_load_lds_dwordx4 %1, %2\n\ts_mov_b32 m0, %0" : "=&s"(keep) : "v"(voff), "s"(sbase), "s"(lds_dst) : "memory"); }
template <class Epi, class Sched, bool GATHER, bool FP8 = false>
__device__ __forceinline__ void gemm_phase(LAS unsigned char* lds, const Gemm g, const Sched& S, const Epi& E, const LAS int* rtab) {
    const int tid = tid_(), wid = __builtin_amdgcn_readfirstlane(tid >> 6), lane = tid & 63, wr = wid >> 2, wc = wid & 3, fr = lane & 15, fq = lane >> 4;
    const int KB = FP8 ? g.K : g.K * 2, nt = KB / 128;
    unsigned voffA[2], voffB[2]; int RA[2], CA[2];
#pragma unroll
    for (int i = 0; i < 2; ++i) { int R, C; stage_rc(tid * 16 + i * 8192, R, C); const int Rb = (R & ~31) + perm32(R & 31);
        voffA[i] = (unsigned)(R * KB + C * 2); voffB[i] = (unsigned)(Rb * KB + C * 2); RA[i] = R; CA[i] = C; }
    unsigned rcpk = 0; if constexpr (GATHER) { rcpk = (unsigned)(RA[0] * 4) | ((unsigned)(CA[0] * 2) << 16); asm volatile("" : "+v"(rcpk)); }
    const size_t kstep = (size_t)128;
    const size_t hstep = (size_t)HALF * KB;
    const size_t hstepA = GATHER ? 0 : hstep;
    const size_t tstep = 2 * hstep;
    const unsigned ldsw = (unsigned)wid * 1024u;
    const unsigned ldsb = (unsigned)__builtin_amdgcn_readfirstlane((int)((unsigned)(size_t)lds + ldsw));
    const int aoff = lds_byte(wr * 64 + fr, fq * 8), boff = lds_byte(wc * 32 + fr, fq * 8);
#define PG8_SA(b, h) (((b) * 2 + (h)) * HTB)
#define PG8_SB(b, h) ((4 + (b) * 2 + (h)) * HTB)
#define PG8_STAGE(bufoff, gbase, voff) do { _Pragma("unroll") for (int _i = 0; _i < 2; ++_i) { if constexpr (FP8) glds16_s((const void*)(gbase), (voff)[_i], ldsb + (unsigned)((bufoff) + _i * 8192)); \
        else __builtin_amdgcn_global_load_lds((const unsigned*)((const char*)(gbase) + (voff)[_i]), (LAS unsigned*)(lds + (bufoff) + ldsw + _i * 8192), 16, 0, 0); } } while (0)
#define PG8_STAGE1(bufoff, gbase, v0) do {   \
        glds16_s((const void*)(gbase), (v0), ldsb + (unsigned)(bufoff)); glds16_s((const void*)((const char*)(gbase) + (size_t)64 * KB), (v0), ldsb + (unsigned)((bufoff) + 8192)); } while (0)
#define PG8_LDA(dst, b, h) do { _Pragma("unroll") for (int m = 0; m < 4; ++m) { if constexpr (FP8) dst##8[m] = cat8(*(const LAS bf16x8*)(lds + PG8_SA(b, h) + aoff + m * 2048), *(const LAS bf16x8*)(lds + PG8_SA(b, h) + aoff + m * 2048 + 1024)); \
        else { _Pragma("unroll") for (int k = 0; k < 2; ++k) dst[m][k] = *(const LAS bf16x8*)(lds + PG8_SA(b, h) + aoff + m * 2048 + k * 1024); } } } while (0)
#define PG8_LDB(dst, b, h) do { _Pragma("unroll") for (int n = 0; n < 2; ++n) { if constexpr (FP8) dst##8[n] = cat8(*(const LAS bf16x8*)(lds + PG8_SB(b, h) + boff + n * 2048), *(const LAS bf16x8*)(lds + PG8_SB(b, h) + boff + n * 2048 + 1024)); \
        else { _Pragma("unroll") for (int k = 0; k < 2; ++k) dst[n][k] = *(const LAS bf16x8*)(lds + PG8_SB(b, h) + boff + n * 2048 + k * 1024); } } } while (0)
#define PG8_MMA(ai, bj, At, Bt) do { __builtin_amdgcn_s_setprio(1); _Pragma("unroll") for (int m = 0; m < 4; ++m) _Pragma("unroll") for (int n = 0; n < 2; ++n) { \
        if constexpr (FP8) acc[ai][bj][m][n] = __builtin_amdgcn_mfma_scale_f32_16x16x128_f8f6f4(Bt##8[n], At##8[m], acc[ai][bj][m][n], 0, 0, 0, 0x7F7F7F7F, 0, 0x7F7F7F7F); \
        else { _Pragma("unroll") for (int k = 0; k < 2; ++k) acc[ai][bj][m][n] = __builtin_amdgcn_mfma_f32_16x16x32_bf16(Bt[n][k], At[m][k], acc[ai][bj][m][n], 0, 0, 0); } } \
        if constexpr (FP8) { asm volatile("" : "+v"(acc[ai][bj][0][0]), "+v"(acc[ai][bj][0][1]), "+v"(acc[ai][bj][1][0]), "+v"(acc[ai][bj][1][1]), "+v"(acc[ai][bj][2][0]), "+v"(acc[ai][bj][2][1]), "+v"(acc[ai][bj][3][0]), "+v"(acc[ai][bj][3][1])); } \
        __builtin_amdgcn_s_setprio(0); } while (0)
#define PG8_WAIT_V(n) asm volatile("s_waitcnt vmcnt(" #n ")" ::: "memory")
#define PG8_WAIT_L(n) asm volatile("s_waitcnt lgkmcnt(" #n ")" ::: "memory")
#define PG8_BAR __builtin_amdgcn_s_barrier()
#define PG8_SCHED __builtin_amdgcn_sched_barrier(0)
#define PG8_STAGE_A(bufoff, gbase, ord, h) do { unsigned _o[2]; if constexpr (GATHER) {   \
            unsigned _pk = rcpk; asm volatile("" : "+v"(_pk));   \
            const LAS unsigned char* _rp = (const LAS unsigned char*)rtab + ((ord) * 1024 + (h) * 512) + (_pk & 0xffffu); const unsigned _c2 = _pk >> 16; \
            _Pragma("unroll") for (int _i = 0; _i < 2; ++_i) _o[_i] = __umul24((unsigned)*(const LAS int*)(_rp + _i * 256), (unsigned)KB) + _c2; } \
        else { _o[0] = voffA[0]; _o[1] = voffA[1]; } if constexpr (FP8 && !GATHER) PG8_STAGE1(bufoff, gbase, voffA[0]); else PG8_STAGE(bufoff, gbase, _o); } while (0)
#define PG8_STAGE_B(bufoff, gbase) do { if constexpr (FP8) PG8_STAGE1(bufoff, gbase, voffB[0]); else PG8_STAGE(bufoff, gbase, voffB); } while (0)
    Unit cur, nxt; int ui = 0;
    if (!S.next(0, cur)) return;
    f32x4 acc[2][2][4][2];
#pragma unroll
    for (int a = 0; a < 2; ++a)
#pragma unroll
        for (int b = 0; b < 2; ++b)
#pragma unroll
            for (int m = 0; m < 4; ++m)
#pragma unroll
                for (int n = 0; n < 2; ++n) acc[a][b][m][n] = (f32x4){0.f, 0.f, 0.f, 0.f};
    bf16x8 At[4][2], B0[2][2], B1[2][2]; i32x8v At8[4], B08[2], B18[2];
    const char* cA = GATHER ? (const char*)g.A : (const char*)g.A + (size_t)cur.pm * tstep; const char* cB = (const char*)g.Bt + (size_t)cur.pn * tstep;
    PG8_STAGE_B(PG8_SB(0, 0), cB); PG8_STAGE_B(PG8_SB(0, 1), cB + hstep); PG8_STAGE_A(PG8_SA(0, 0), cA, 0, 0); PG8_STAGE_A(PG8_SA(0, 1), cA + hstepA, 0, 1);
    if (wr == 1) PG8_BAR;
    PG8_WAIT_V(2); PG8_BAR;
    PG8_STAGE_B(PG8_SB(1, 0), cB + kstep); PG8_STAGE_A(PG8_SA(1, 0), cA + kstep, 0, 0); PG8_STAGE_B(PG8_SB(1, 1), cB + hstep + kstep);
    PG8_WAIT_V(6); PG8_BAR;
    for (;;) {
        const bool has_next = S.next(ui + 1, nxt);
        const char* nA = GATHER ? (const char*)g.A : (has_next ? (const char*)g.A + (size_t)nxt.pm * tstep : cA); const char* nB = has_next ? (const char*)g.Bt + (size_t)nxt.pn * tstep : cB;
#pragma unroll 1
        for (int t = 0; t < nt; t += 2) {
            const bool last = (t == nt - 2);
            const char* a1 = cA + (size_t)(t + 1) * kstep;
            const char* a2 = last ? nA : cA + (size_t)(t + 2) * kstep; const char* b2 = last ? nB : cB + (size_t)(t + 2) * kstep;
            const char* a3 = a2 + kstep; const char* b3 = b2 + kstep;
            const int on = (last && has_next) ? ui + 1 : ui;
            PG8_LDB(B0, 0, 0); PG8_LDB(B1, 0, 1); PG8_SCHED; PG8_LDA(At, 0, 0); PG8_STAGE_A(PG8_SA(1, 1), a1 + hstepA, ui, 1);
            PG8_WAIT_V(8); PG8_WAIT_L(0); PG8_BAR; PG8_MMA(0, 0, At, B0); PG8_MMA(0, 1, At, B1); PG8_BAR; PG8_SCHED;
            PG8_LDA(At, 0, 1); PG8_STAGE_B(PG8_SB(0, 0), b2); PG8_STAGE_B(PG8_SB(0, 1), b2 + hstep); PG8_STAGE_A(PG8_SA(0, 0), a2, on, 0);
            PG8_WAIT_V(8); PG8_WAIT_L(0); PG8_BAR; PG8_MMA(1, 0, At, B0); PG8_MMA(1, 1, At, B1); PG8_BAR; PG8_SCHED;
            PG8_LDB(B0, 1, 0); PG8_LDB(B1, 1, 1); PG8_SCHED; PG8_LDA(At, 1, 0); PG8_STAGE_A(PG8_SA(0, 1), a2 + hstepA, on, 1);
            PG8_WAIT_V(8); PG8_WAIT_L(0); PG8_BAR; PG8_MMA(0, 0, At, B0); PG8_MMA(0, 1, At, B1); PG8_BAR; PG8_SCHED;
            PG8_LDA(At, 1, 1); PG8_STAGE_B(PG8_SB(1, 0), b3); PG8_STAGE_B(PG8_SB(1, 1), b3 + hstep); PG8_STAGE_A(PG8_SA(1, 0), a3, on, 0);
            PG8_WAIT_V(8); PG8_WAIT_L(0); PG8_BAR; PG8_MMA(1, 0, At, B0); PG8_MMA(1, 1, At, B1); PG8_BAR; PG8_SCHED;
        }
        if (wr == 0) PG8_BAR;
        E(acc, cur, wr, wc, fr, fq);
        if (!has_next) break;
#pragma unroll
        for (int a = 0; a < 2; ++a)
#pragma unroll
            for (int b = 0; b < 2; ++b)
#pragma unroll
                for (int m = 0; m < 4; ++m)
#pragma unroll
                    for (int n = 0; n < 2; ++n) acc[a][b][m][n] = (f32x4){0.f, 0.f, 0.f, 0.f};
        cur = nxt; cA = nA; cB = nB; ++ui;
        if (wr == 1) PG8_BAR;
    }
    PG8_WAIT_V(0);
    PG8_BAR;
#undef PG8_SA
#undef PG8_SB
#undef PG8_STAGE
#undef PG8_LDA
#undef PG8_LDB
#undef PG8_MMA
#undef PG8_WAIT_V
#undef PG8_WAIT_L
#undef PG8_BAR
#undef PG8_SCHED
#undef PG8_STAGE_A
#undef PG8_STAGE_B
#undef PG8_STAGE1
}
struct EpiBf16 {
    bf16_t* O; int ldc, ncolt; size_t slab;
    __device__ __forceinline__ void operator()(const f32x4 (&acc)[2][2][4][2], const Unit& u, int wr, int wc, int fr, int fq) const {
        const int row0 = u.pm * BM + wr * 64 + fr; const size_t col0 = (size_t)(u.pn % ncolt) * slab + wc * 32 + 8 * fq;
#pragma unroll
        for (int ai = 0; ai < 2; ++ai)
#pragma unroll
            for (int m = 0; m < 4; ++m) { bf16_t* rowp = O + (size_t)(row0 + ai * HALF + m * 16) * ldc + col0;
#pragma unroll
                for (int bj = 0; bj < 2; ++bj) { const f32x4 v0 = acc[ai][bj][m][0], v1 = acc[ai][bj][m][1];
                    u32x4 w; w.x = cvt_pk_bf16(v0[0], v0[1]); w.y = cvt_pk_bf16(v0[2], v0[3]); w.z = cvt_pk_bf16(v1[0], v1[1]); w.w = cvt_pk_bf16(v1[2], v1[3]);
                    *(u32x4*)(rowp + bj * HALF) = w; } }
    }
};
struct EpiRes {
    bf16_t* X; const float* xlat; const float* xctx; const float* modl; int pm_shift; float ascale; bool perm = false;
    __device__ __forceinline__ void operator()(const f32x4 (&acc)[2][2][4][2], const Unit& u, int wr, int wc, int fr, int fq) const {
        const int pm = u.pm - pm_shift; const int rsel = pm < 64 ? (pm >> 5) : 2;
        const int row0 = pm * BM + wr * 64 + fr, col0 = (u.pn & 3) * BM + (perm ? wc * 64 + 16 * fq : wc * 32 + 8 * fq), bjs = perm ? 8 : HALF;
        const float* gate = modl + (size_t)rsel * 6144 + col0;
        const float* xs = xlat ? (pm < 64 ? xlat + (size_t)row0 * D : xctx + (size_t)(row0 - R_LAT) * D) + col0 : nullptr;
        bf16_t* xo = X + (size_t)row0 * D + col0;
#pragma unroll
        for (int bj = 0; bj < 2; ++bj) { const f32x4 g0 = *(const f32x4*)(gate + bj * bjs) * ascale, g1 = *(const f32x4*)(gate + bj * bjs + 4) * ascale;
#pragma unroll
            for (int ai = 0; ai < 2; ++ai)
#pragma unroll
                for (int m = 0; m < 4; ++m) { const size_t o = (size_t)(ai * HALF + m * 16) * D + bj * bjs;
                    f32x4 x0, x1;
                    if (xs) { x0 = *(const f32x4*)(xs + o); x1 = *(const f32x4*)(xs + o + 4); } else unpack8(*(const u32x4*)(xo + o), x0, x1);
                    const f32x4 y0 = x0 + g0 * acc[ai][bj][m][0], y1 = x1 + g1 * acc[ai][bj][m][1];
                    u32x4 w; w.x = cvt_pk_bf16(y0[0], y0[1]); w.y = cvt_pk_bf16(y0[2], y0[3]); w.z = cvt_pk_bf16(y1[0], y1[1]); w.w = cvt_pk_bf16(y1[2], y1[3]);
                    *(u32x4*)(xo + o) = w; } }
    }
};
struct EpiGU8 {
    unsigned char* H8; const LAS float* wtab;
    __device__ __forceinline__ void operator()(const f32x4 (&acc)[2][2][4][2], const Unit& u, int wr, int wc, int fr, int fq) const {
        asm volatile("" : "+v"(fr), "+v"(fq));
        const int row0 = u.pm * BM + wr * 64 + fr, col0 = (u.pn & 1) * 128 + wc * 32 + 8 * fq;
#pragma unroll
        for (int ai = 0; ai < 2; ++ai)
#pragma unroll
            for (int m = 0; m < 4; ++m) { const int row = row0 + ai * HALF + m * 16; const float w = wtab[u.ord * 256 + wr * 64 + fr + ai * HALF + m * 16] * H8_SCALE;
                float h[8];
#pragma unroll
                for (int n = 0; n < 2; ++n)
#pragma unroll
                    for (int j = 0; j < 4; ++j) { const float gv = acc[ai][0][m][n][j] * GU_DESCALE, uv = acc[ai][1][m][n][j] * GU_DESCALE;
                        h[n * 4 + j] = fminf(fmaxf(gv * __builtin_amdgcn_rcpf(1.f + __expf(-gv)) * uv * w, -440.f), 440.f); }
                int w0 = __builtin_amdgcn_cvt_pk_fp8_f32(h[0], h[1], 0, false); w0 = __builtin_amdgcn_cvt_pk_fp8_f32(h[2], h[3], w0, true);
                int w1 = __builtin_amdgcn_cvt_pk_fp8_f32(h[4], h[5], 0, false); w1 = __builtin_amdgcn_cvt_pk_fp8_f32(h[6], h[7], w1, true);
                u32x2 o; o.x = (unsigned)w0; o.y = (unsigned)w1;
                *(u32x2*)(H8 + (size_t)row * 256 + col0) = o; }
    }
};
struct EpiGU {
    bf16_t* H; const float* slot_w;
    __device__ __forceinline__ void operator()(const f32x4 (&acc)[2][2][4][2], const Unit& u, int wr, int wc, int fr, int fq) const {
        const int row0 = u.pm * BM + wr * 64 + fr, col0 = (u.pn & 1) * 128 + wc * 32 + 8 * fq;
#pragma unroll
        for (int ai = 0; ai < 2; ++ai)
#pragma unroll
            for (int m = 0; m < 4; ++m) { const int row = row0 + ai * HALF + m * 16; const float w = slot_w[row];
                float h[8];
#pragma unroll
                for (int n = 0; n < 2; ++n)
#pragma unroll
                    for (int j = 0; j < 4; ++j) { const float gv = acc[ai][0][m][n][j], uv = acc[ai][1][m][n][j]; h[n * 4 + j] = gv / (1.f + __expf(-gv)) * uv * w; }
                u32x4 o; o.x = cvt_pk_bf16(h[0], h[1]); o.y = cvt_pk_bf16(h[2], h[3]); o.z = cvt_pk_bf16(h[4], h[5]); o.w = cvt_pk_bf16(h[6], h[7]);
                *(u32x4*)(H + (size_t)row * 256 + col0) = o; }
    }
};
struct EpiY8 {
    unsigned char* Y8;
    __device__ __forceinline__ void operator()(const f32x4 (&acc)[2][2][4][2], const Unit& u, int wr, int wc, int fr, int fq) const {
        const int row0 = u.pm * BM + wr * 64 + fr; unsigned char* base = Y8 + ((size_t)(u.pn & 3) * MAXSLOT + row0) * 256 + wc * 64 + 16 * fq;
#pragma unroll
        for (int ai = 0; ai < 2; ++ai)
#pragma unroll
            for (int m = 0; m < 4; ++m) { unsigned w[4];
#pragma unroll
                for (int bj = 0; bj < 2; ++bj) { f32x4 v0 = acc[ai][bj][m][0] * (Y8_SCALE * DN_DESCALE), v1 = acc[ai][bj][m][1] * (Y8_SCALE * DN_DESCALE);
#pragma unroll
                    for (int q = 0; q < 4; ++q) { v0[q] = fminf(fmaxf(v0[q], -440.f), 440.f); v1[q] = fminf(fmaxf(v1[q], -440.f), 440.f); }
                    int w0 = __builtin_amdgcn_cvt_pk_fp8_f32(v0[0], v0[1], 0, false); w0 = __builtin_amdgcn_cvt_pk_fp8_f32(v0[2], v0[3], w0, true);
                    int w1 = __builtin_amdgcn_cvt_pk_fp8_f32(v1[0], v1[1], 0, false); w1 = __builtin_amdgcn_cvt_pk_fp8_f32(v1[2], v1[3], w1, true);
                    w[2 * bj] = (unsigned)w0; w[2 * bj + 1] = (unsigned)w1; }
                *(u32x4*)(base + (size_t)(ai * HALF + m * 16) * 256) = (u32x4){w[0], w[1], w[2], w[3]}; }
    }
};
struct EpiDown {
    bf16_t* Y; bf16_t* X; const float* modl5;
    __device__ __forceinline__ void operator()(const f32x4 (&acc)[2][2][4][2], const Unit& u, int wr, int wc, int fr, int fq) const {
        asm volatile("" : "+v"(fr), "+v"(fq));
        if (u.pm < MAXSLOT / 256) { const EpiY8 e{(unsigned char*)Y}; e(acc, u, wr, wc, fr, fq); }
        else { const EpiRes e{X, nullptr, nullptr, modl5, MAXSLOT / 256, DN_DESCALE, true}; e(acc, u, wr, wc, fr, fq); }
    }
};
}


__device__ __forceinline__ void ph_inproj_f(KP p, int l, unsigned char* lds) {
    pg8::Gemm g{(const bf16_t*)(p->ws + Z_A), (const bf16_t*)(p->ws + win_off(l)), R_ALL, DIN, 1024};
    pg8::StaticOrder S; S.init(R_ALL, DIN, gsz_(), bid_());
    pg8::EpiBf16 E{(bf16_t*)(p->ws + Z_P), DIN, DIN / 256, 256};
    pg8::gemm_phase<pg8::EpiBf16, pg8::StaticOrder, false>((LAS unsigned char*)lds, g, S, E, nullptr);
    if (l == 0 && DEPTH > 1 && gsz_() == 256) { __syncthreads(); ph_cvt(p, 1, lds, 214, 42, 0, CVT_E1); }
}
__device__ __forceinline__ void ph_outproj_f(KP p, int l, unsigned char* lds) {
    const int T = (l == 0) ? R_ALL : R_LAT;
    pg8::Gemm g{(const bf16_t*)(p->ws + Z_YCAT), (const bf16_t*)(p->ws + wout_off(l)), T, 1024, 1024};
    pg8::StaticOrder S; S.init(T, 1024, gsz_(), bid_());
    bf16_t* X = (bf16_t*)(p->ws + WS_X);
    pg8::EpiRes E{X, l == 0 ? p->in[0] : nullptr, l == 0 ? p->in[2] : nullptr, (const float*)(p->ws + WS_MOD) + (size_t)l * 3 * 6144 + 2 * 1024, 0, 1.f};
    pg8::gemm_phase<pg8::EpiRes, pg8::StaticOrder, false>((LAS unsigned char*)lds, g, S, E, nullptr);
    if (l == 0 && DEPTH > 1) {
        const int G = gsz_(); __syncthreads();
        if (G == 256) ph_cvt(p, 1, lds, 8, 248, CVT_E2, 1 << 30); else ph_cvt(p, 1, lds); }
}
struct QkvLane { f32x4 gg0, gg1, gw0, gw1; };
__device__ __forceinline__ QkvLane qkv_lane_consts(KP p, int l, int lane) {
    QkvLane c; const int dch = (lane & 7) * 8; const int isk = lane >= 32;
    const float* gq = p->in[isk ? 11 : 10] + l * 64 + dch; const float* wq = p->in[isk ? 13 : 12] + l * 64 + dch;
    c.gg0 = *(const f32x4*)gq; c.gg1 = *(const f32x4*)(gq + 4); c.gw0 = *(const f32x4*)wq; c.gw1 = *(const f32x4*)(wq + 4); return c;
}
__device__ __forceinline__ void prep_qkv_row(KP p, int l, int row, int lane, const QkvLane& qc) {
    const bf16_t* pr = (const bf16_t*)(p->ws + Z_P) + (size_t)row * DIN;
    const bool isctx = row >= R_LAT; const int b = isctx ? ((row - R_LAT) >> 8) : (row >> 13), t = isctx ? ((row - R_LAT) & 255) : (row & 8191);
    const size_t krow = (size_t)b * NKEY + (isctx ? NSEQ + t : t);
    const int l7 = lane & 7, axis = l7 >> 2, half = (l7 >> 1) & 1;
    f32x4 cs0 = (f32x4){1.f, 1.f, 1.f, 1.f}, cs1 = cs0, sn0 = (f32x4){0.f, 0.f, 0.f, 0.f}, sn1 = sn0;
    if (!isctx) { const int pos = axis == 0 ? (t >> 6) : (t & 63); const float* rt = (const float*)(p->ws + WS_ROPE) + pos * 32 + (lane & 1) * 8;
        cs0 = *(const f32x4*)rt; cs1 = *(const f32x4*)(rt + 4); sn0 = *(const f32x4*)(rt + 16); sn1 = *(const f32x4*)(rt + 20); }
    const u32x4 ra = *(const u32x4*)(pr + lane * 8), rb = *(const u32x4*)(pr + 512 + lane * 8);
#pragma unroll
    for (int grp = 0; grp < 2; ++grp) {
        const u32x4 r = grp ? rb : ra;
        bf16_t* Qd = (bf16_t*)(p->ws + (isctx ? (grp ? Z_QWC : Z_QGC) : (grp ? Z_QW : Z_QG))) + (size_t)(isctx ? (b * NCTX + t) : row) * 256;
        bf16_t* Kd = (bf16_t*)(p->ws + (grp ? Z_KW : Z_KG)) + krow * 128; bf16_t* Vd = (bf16_t*)(p->ws + (grp ? Z_VW : Z_VG)) + krow * 128;
        if (lane >= 48) { *(u32x4*)(Vd + (lane - 48) * 8) = r; continue; }
        float x[8] = {bf2f(r.x & 0xffffu), bf2f(r.x >> 16), bf2f(r.y & 0xffffu), bf2f(r.y >> 16), bf2f(r.z & 0xffffu), bf2f(r.z >> 16), bf2f(r.w & 0xffffu), bf2f(r.w >> 16)};
        float ss = 0.f;
#pragma unroll
        for (int i = 0; i < 8; ++i) ss += x[i] * x[i];
        ss += __shfl_xor(ss, 1); ss += __shfl_xor(ss, 2); ss += __shfl_xor(ss, 4);
        const float rinv = rsqrtf(ss * (1.f / 64.f) + EPS);
        const f32x4 g0 = grp ? qc.gw0 : qc.gg0, g1 = grp ? qc.gw1 : qc.gg1;
        const float gv[8] = {g0.x, g0.y, g0.z, g0.w, g1.x, g1.y, g1.z, g1.w};
        const float cv[8] = {cs0.x, cs0.y, cs0.z, cs0.w, cs1.x, cs1.y, cs1.z, cs1.w}, sv[8] = {sn0.x, sn0.y, sn0.z, sn0.w, sn1.x, sn1.y, sn1.z, sn1.w};
        const float qs = (lane < 32) ? QSCALE : 1.f;
        float y[8];
#pragma unroll
        for (int i = 0; i < 8; ++i) { const float v = x[i] * rinv * gv[i]; const float o = __shfl_xor(v, 2);
            y[i] = ((half == 0) ? (v * cv[i] - o * sv[i]) : (o * sv[i] + v * cv[i])) * qs; }
        u32x4 ov; ov.x = pk2(y[0], y[1]); ov.y = pk2(y[2], y[3]); ov.z = pk2(y[4], y[5]); ov.w = pk2(y[6], y[7]);
        if (lane < 32) *(u32x4*)(Qd + lane * 8) = ov; else *(u32x4*)(Kd + (lane - 32) * 8) = ov;
    }
}

template <int R> __device__ __forceinline__ void dw_rows(const float* hcol, const float (&wj)[31], float (&acc)[32]) {
    if constexpr (R < 62) {
        const float hv = hcol[R * 256];
        constexpr int T0 = (R - 30 > 0) ? R - 30 : 0, T1 = (R < 31) ? R : 31;
#pragma unroll
        for (int tt = T0; tt <= T1; ++tt) acc[tt] += hv * wj[R - tt];
        dw_rows<R + 1>(hcol, wj, acc);
    }
}
__device__ __forceinline__ void conv_tile(KP p, int l, unsigned char* lds, int seq_row0, int seqlen, int t0) {
    float* hb = (float*)lds;
    const int tid = tid_(), lane = tid & 63, wid = tid >> 6;
    const bf16_t* P = (const bf16_t*)(p->ws + Z_P);
    for (int i = tid; i < 94 * 32; i += NTHREADS) { const int r = i >> 5, c8 = (i & 31) * 8, t = t0 - 15 + r;
        f32x4 h0 = (f32x4){0.f, 0.f, 0.f, 0.f}, h1 = h0;
        if (t >= 0 && t < seqlen) { const bf16_t* pr = P + (size_t)(seq_row0 + t) * DIN;
            const u32x4 vv = *(const u32x4*)(pr + C_CVV + c8), gg = *(const u32x4*)(pr + C_CVG + c8);
            h0.x = bf2f(vv.x & 0xffffu) * sigmoid_(bf2f(gg.x & 0xffffu)); h0.y = bf2f(vv.x >> 16) * sigmoid_(bf2f(gg.x >> 16));
            h0.z = bf2f(vv.y & 0xffffu) * sigmoid_(bf2f(gg.y & 0xffffu)); h0.w = bf2f(vv.y >> 16) * sigmoid_(bf2f(gg.y >> 16));
            h1.x = bf2f(vv.z & 0xffffu) * sigmoid_(bf2f(gg.z & 0xffffu)); h1.y = bf2f(vv.z >> 16) * sigmoid_(bf2f(gg.z >> 16));
            h1.z = bf2f(vv.w & 0xffffu) * sigmoid_(bf2f(gg.w & 0xffffu)); h1.w = bf2f(vv.w >> 16) * sigmoid_(bf2f(gg.w >> 16)); }
        *(f32x4*)(hb + r * 256 + c8) = h0; *(f32x4*)(hb + r * 256 + c8 + 4) = h1; }
    __syncthreads();
    { const int c = tid & 255, hf = tid >> 8;
      const float* w = p->in[15] + (size_t)l * 31 * 256 + c; const float bias = p->in[16][l * 256 + c];
      float wj[31];
#pragma unroll
      for (int j = 0; j < 31; ++j) wj[j] = w[j * 256];
      float acc[32];
#pragma unroll
      for (int tt = 0; tt < 32; ++tt) acc[tt] = bias;
      dw_rows<0>(hb + hf * 32 * 256 + c, wj, acc);
      __syncthreads();
#pragma unroll
      for (int tt = 0; tt < 32; ++tt) hb[(hf * 32 + tt) * 256 + c] = acc[tt];
    }
    __syncthreads();
    constexpr int AS = 264;
    bf16_t* ab = (bf16_t*)(lds + 94 * 256 * 4);
    for (int tt = wid; tt < 64; tt += 8) { const float* r = hb + tt * 256; const f32x4 v = ((const f32x4*)r)[lane];
        const float mean = wave_sum(v.x + v.y + v.z + v.w) * (1.f / 256.f);
        const float dx = v.x - mean, dy = v.y - mean, dz = v.z - mean, dw = v.w - mean;
        const float rstd = rsqrtf(wave_sum(dx * dx + dy * dy + dz * dz + dw * dw) * (1.f / 256.f) + EPS);
        const f32x4 g = ((const f32x4*)(p->in[17] + l * 256))[lane], bb = ((const f32x4*)(p->in[18] + l * 256))[lane];
        u32x2 o; o.x = pk2(silu_(dx * rstd * g.x + bb.x), silu_(dy * rstd * g.y + bb.y)); o.y = pk2(silu_(dz * rstd * g.z + bb.z), silu_(dw * rstd * g.w + bb.w));
        *(u32x2*)(ab + tt * AS + lane * 4) = o; }
    __syncthreads();
    { const int fr = lane & 15, fq = lane >> 4;
      const bf16_t* Wt = (const bf16_t*)(p->ws + wpw_off(l));
      bf16x8 bw[2][8];
#pragma unroll
      for (int j = 0; j < 2; ++j)
#pragma unroll
          for (int ks = 0; ks < 8; ++ks) bw[j][ks] = *(const bf16x8*)(Wt + (size_t)((wid * 2 + j) * 16 + fr) * 256 + ks * 32 + fq * 8);
      const float bias0 = p->in[20][l * 256 + wid * 32 + fr], bias1 = p->in[20][l * 256 + wid * 32 + 16 + fr];
      bf16_t* Y = (bf16_t*)(p->ws + Z_YCAT);
#pragma unroll 1
      for (int tr = 0; tr < 4; ++tr) { f32x4 a0 = (f32x4){0.f, 0.f, 0.f, 0.f}, a1 = a0;
#pragma unroll
          for (int ks = 0; ks < 8; ++ks) { const bf16x8 av = *(const bf16x8*)(ab + (tr * 16 + fr) * AS + ks * 32 + fq * 8);
              a0 = __builtin_amdgcn_mfma_f32_16x16x32_bf16(av, bw[0][ks], a0, 0, 0, 0); a1 = __builtin_amdgcn_mfma_f32_16x16x32_bf16(av, bw[1][ks], a1, 0, 0, 0); }
#pragma unroll
          for (int r = 0; r < 4; ++r) { const int t = t0 + tr * 16 + fq * 4 + r; bf16_t* yr = Y + (size_t)(seq_row0 + t) * D + 256 + wid * 32 + fr;
              yr[0] = (bf16_t)f2bf(a0[r] + bias0); yr[16] = (bf16_t)f2bf(a1[r] + bias1); } }
    }
    __syncthreads();
}

__device__ __forceinline__ int hgrn_chunk_row0(int b, int dir, int j) {
    if (j < 4) { const int cj = dir ? 3 - j : j; return R_LAT + b * NCTX + cj * 64; }
    const int jj = j - 4, cj = dir ? 127 - jj : jj; return b * NSEQ + cj * 64;
}
__device__ __forceinline__ void hgrn_load_chunk(KP p, int l, int row0, int dir, int head, float* qs, float* vs, float* ks, float* cs) {
    const int tid = tid_();
    const bf16_t* P = (const bf16_t*)(p->ws + Z_P);
    const float* lbv = (const float*)(p->ws + WS_LB) + (l * 2 + dir) * 256 + head * 64;
    for (int i = tid; i < 4096; i += NTHREADS) { const int tau = i >> 6, d = i & 63; const int row = row0 + (dir ? 63 - tau : tau);
        const bf16_t* pr = P + (size_t)row * DIN + head * 64 + d;
        if (qs) qs[i] = bf2f(pr[C_RQ]);
        vs[i] = bf2f(pr[C_RI]);
        const float z = bf2f(pr[dir ? C_RFB : C_RFF]); const float lb = lbv[d];
        const float lsp = fminf(z, 0.f) - log1pf(__expf(-fabsf(z)));
        float logf = lsp;
        if (lb > 0.f) { const float a = lsp, bq = __logf(lb) + (lsp - z); const float mx = fmaxf(a, bq); logf = mx + log1pf(__expf(-fabsf(a - bq))); }
        ks[i] = (1.f - lb) * sigmoid_(-z);
        cs[i] = logf; }
    __syncthreads();
    if (tid < 64) { float c = 0.f; for (int tau = 0; tau < 64; ++tau) { c += cs[tau * 64 + tid]; cs[tau * 64 + tid] = c; } }
    __syncthreads();
}
__device__ __forceinline__ void hgrn_pass1_unit(KP p, int l, unsigned char* lds, int unit) {
    float* vs = (float*)lds; float* ks = vs + 4096; float* cs = ks + 4096;
    const int tid = tid_();
    const int j = unit % NCHUNK, seq = unit / NCHUNK, dir = seq & 1, head = (seq >> 1) & 3, b = seq >> 3;
    hgrn_load_chunk(p, l, hgrn_chunk_row0(b, dir, j), dir, head, nullptr, vs, ks, cs);
    for (int i = tid; i < 4096; i += NTHREADS) { const int d = i & 63; ks[i] *= __expf(cs[63 * 64 + d] - cs[i]); }
    __syncthreads();
    float* U = (float*)(p->ws + Z_U) + ((size_t)seq * NCHUNK + j) * 4096; float* Gv = (float*)(p->ws + Z_G) + ((size_t)seq * NCHUNK + j) * 64;
    { const int d = tid >> 3, e0 = (tid & 7) * 8; float acc[8];
#pragma unroll
      for (int e = 0; e < 8; ++e) acc[e] = 0.f;
      for (int tau = 0; tau < 64; ++tau) { const float kv = ks[tau * 64 + d];
#pragma unroll
          for (int e = 0; e < 8; ++e) acc[e] += kv * vs[tau * 64 + e0 + e]; }
#pragma unroll
      for (int e = 0; e < 8; ++e) U[d * 64 + e0 + e] = acc[e]; }
    if (tid < 64) Gv[tid] = __expf(cs[63 * 64 + tid]);
    __syncthreads();
}
constexpr int HS = 72;
constexpr int HL_TOT = 0, HL_OSUM = 2048, HL_T0 = 18432, HL_TB = 64 * HS * 2;
__device__ __forceinline__ f32x4 mm64(const bf16_t* A, const bf16_t* Bt, int tr, int tc, int fr, int fq, f32x4 acc) {
#pragma unroll
    for (int k0 = 0; k0 < 64; k0 += 32) { const bf16x8 a = *(const bf16x8*)(A + (tr * 16 + fr) * HS + k0 + fq * 8), b = *(const bf16x8*)(Bt + (tc * 16 + fr) * HS + k0 + fq * 8);
        acc = __builtin_amdgcn_mfma_f32_16x16x32_bf16(a, b, acc, 0, 0, 0); }
    return acc;
}
__device__ __forceinline__ void hgrn_load8(KP p, int row0, int dir, int head, int tid, float (&q)[8], float (&vv)[8], float (&z)[8]) {
    const int d = tid & 63, seg = tid >> 6;
    const bf16_t* P = (const bf16_t*)(p->ws + Z_P);
#pragma unroll
    for (int i = 0; i < 8; ++i) { const int tau = seg * 8 + i; const int row = row0 + (dir ? 63 - tau : tau);
        const bf16_t* pr = P + (size_t)row * DIN + head * 64 + d;
        q[i] = bf2f(pr[C_RQ]); vv[i] = bf2f(pr[C_RI]); z[i] = bf2f(pr[dir ? C_RFB : C_RFF]); }
}
__device__ __forceinline__ void hgrn_gate8(KP p, int l, int dir, int head, int tid, float* tot, const float (&z)[8], float (&kg)[8], float (&c)[8], float& m, float& cl) {
    const int d = tid & 63, seg = tid >> 6;
    const float lb = ((const float*)(p->ws + WS_LB))[(l * 2 + dir) * 256 + head * 64 + d];
    float run = 0.f;
#pragma unroll
    for (int i = 0; i < 8; ++i) {
        const float ez = __expf(-fabsf(z[i])), rz = __builtin_amdgcn_rcpf(1.f + ez); const float sg = (z[i] >= 0.f) ? rz : ez * rz;
        const float f = lb + (1.f - lb) * sg;
        kg[i] = 1.f - f;
        run += __logf(f); c[i] = run; }
    tot[seg * 64 + d] = run;
    __syncthreads();
    float off = 0.f; m = 0.f; cl = 0.f;
#pragma unroll
    for (int s2 = 0; s2 < 8; ++s2) { const float t = tot[s2 * 64 + d]; if (s2 < seg) off += t; if (s2 < 4) m += t; cl += t; }
#pragma unroll
    for (int i = 0; i < 8; ++i) c[i] += off;
}
__device__ __forceinline__ u32x4 pack8(const float (&x)[8]) { u32x4 o; o.x = pk2(x[0], x[1]); o.y = pk2(x[2], x[3]); o.z = pk2(x[4], x[5]); o.w = pk2(x[6], x[7]); return o; }
__device__ __forceinline__ void hgrn_pass1_f(KP p, int l, unsigned char* lds, int unit) {
    const int tid = tid_(), lane = tid & 63, wid = tid >> 6, fr = lane & 15, fq = lane >> 4, d = tid & 63, seg = tid >> 6;
    float* tot = (float*)(lds + HL_TOT); bf16_t* Vt = (bf16_t*)(lds + HL_T0); bf16_t* KbT = (bf16_t*)(lds + HL_T0 + HL_TB);
    const int j = unit % NCHUNK, seq = unit / NCHUNK, dir = seq & 1, head = (seq >> 1) & 3, b = seq >> 3;
    float q[8], vv[8], z[8], kg[8], c[8], m, cl;
    hgrn_load8(p, hgrn_chunk_row0(b, dir, j), dir, head, tid, q, vv, z);
    hgrn_gate8(p, l, dir, head, tid, tot, z, kg, c, m, cl);
    float kb[8];
#pragma unroll
    for (int i = 0; i < 8; ++i) kb[i] = kg[i] * __expf(cl - c[i]);
    *(u32x4*)(Vt + d * HS + seg * 8) = pack8(vv);
    *(u32x4*)(KbT + d * HS + seg * 8) = pack8(kb);
    float* U = (float*)(p->ws + Z_U) + ((size_t)seq * NCHUNK + j) * 4096; float* Gv = (float*)(p->ws + Z_G) + ((size_t)seq * NCHUNK + j) * 64;
    if (seg == 0) Gv[d] = __expf(cl);
    __syncthreads();
    const int tr = wid >> 1;
#pragma unroll
    for (int t2 = 0; t2 < 2; ++t2) { const int tc = (wid & 1) * 2 + t2;
        const f32x4 acc = mm64(Vt, KbT, tr, tc, fr, fq, (f32x4){0.f, 0.f, 0.f, 0.f});
#pragma unroll
        for (int r = 0; r < 4; ++r) U[(tr * 16 + fq * 4 + r) * 64 + tc * 16 + fr] = acc[r]; }
    __syncthreads();
}
struct HgrnIn1 { float v[8], zf[8], zb[8]; };
__device__ __forceinline__ void hgrn_p1_load(KP p, int unit, int tid, HgrnIn1& r) {
    const int cpos = unit % NCHUNK, head = (unit / NCHUNK) & 3, b = unit / (NCHUNK * 4), d = tid & 63, seg = tid >> 6;
    const int row0 = (cpos < 4) ? R_LAT + b * NCTX + cpos * 64 : b * NSEQ + (cpos - 4) * 64;
    const bf16_t* P = (const bf16_t*)(p->ws + Z_P) + (size_t)(row0 + seg * 8) * DIN + head * 64 + d;
#pragma unroll
    for (int i = 0; i < 8; ++i) { const bf16_t* pr = P + (size_t)i * DIN; r.v[i] = bf2f(pr[C_RI]); r.zf[i] = bf2f(pr[C_RFF]); r.zb[i] = bf2f(pr[C_RFB]); }
}
__device__ __forceinline__ void hgrn_p1_compute(KP p, int l, unsigned char* lds, int unit, int tid, const HgrnIn1& r) {
    const int lane = tid & 63, wid = tid >> 6, fr = lane & 15, fq = lane >> 4, d = tid & 63, seg = tid >> 6;
    float* totf = (float*)(lds + HL_TOT); float* totb = (float*)(lds + HL_OSUM);
    bf16_t* Vt = (bf16_t*)(lds + HL_T0); bf16_t* KfT = (bf16_t*)(lds + HL_T0 + HL_TB); bf16_t* KbT = (bf16_t*)(lds + HL_T0 + 2 * HL_TB);
    const int cpos = unit % NCHUNK, head = (unit / NCHUNK) & 3, b = unit / (NCHUNK * 4);
    const float* lbp = (const float*)(p->ws + WS_LB) + (l * 2) * 256 + head * 64 + d; const float lbf = lbp[0], lbb = lbp[256];
    float kf[8], kb[8], cf[8], cb[8], lfb[8], runf = 0.f, runb = 0.f;
#pragma unroll
    for (int i = 0; i < 8; ++i) {
        { const float z = r.zf[i], ez = __expf(-fabsf(z)), rz = __builtin_amdgcn_rcpf(1.f + ez), sg = (z >= 0.f) ? rz : ez * rz, f = lbf + (1.f - lbf) * sg; kf[i] = 1.f - f; runf += __logf(f); cf[i] = runf; }
        { const float z = r.zb[i], ez = __expf(-fabsf(z)), rz = __builtin_amdgcn_rcpf(1.f + ez), sg = (z >= 0.f) ? rz : ez * rz, f = lbb + (1.f - lbb) * sg; kb[i] = 1.f - f; lfb[i] = __logf(f); runb += lfb[i]; cb[i] = runb; } }
    totf[seg * 64 + d] = runf; totb[seg * 64 + d] = runb;
    __syncthreads();
    float offf = 0.f, offb = 0.f, clf = 0.f, clb = 0.f;
#pragma unroll
    for (int s2 = 0; s2 < 8; ++s2) { const float tf = totf[s2 * 64 + d], tb = totb[s2 * 64 + d]; if (s2 < seg) { offf += tf; offb += tb; } clf += tf; clb += tb; }
#pragma unroll
    for (int i = 0; i < 8; ++i) { kf[i] *= __expf(clf - (cf[i] + offf)); kb[i] *= __expf(cb[i] + offb - lfb[i]); }
    *(u32x4*)(Vt + d * HS + seg * 8) = pack8(r.v);
    *(u32x4*)(KfT + d * HS + seg * 8) = pack8(kf);
    *(u32x4*)(KbT + d * HS + seg * 8) = pack8(kb);
    const int jf = cpos, jb = (cpos < 4) ? 3 - cpos : 4 + 127 - (cpos - 4); const int seqf = (b * 4 + head) * 2;
    bf16_t* Uf = (bf16_t*)(p->ws + Z_U) + ((size_t)seqf * NCHUNK + jf) * 4096; bf16_t* Ub = (bf16_t*)(p->ws + Z_U) + ((size_t)(seqf + 1) * NCHUNK + jb) * 4096;
    float* Gf = (float*)(p->ws + Z_G) + ((size_t)seqf * NCHUNK + jf) * 64; float* Gb = (float*)(p->ws + Z_G) + ((size_t)(seqf + 1) * NCHUNK + jb) * 64;
    if (seg == 0) { Gf[d] = __expf(clf); Gb[d] = __expf(clb); }
    __syncthreads();
    const int tr = wid >> 1;
#pragma unroll
    for (int t2 = 0; t2 < 2; ++t2) { const int tc = (wid & 1) * 2 + t2;
        const f32x4 af = mm64(Vt, KfT, tr, tc, fr, fq, (f32x4){0.f, 0.f, 0.f, 0.f}), ab = mm64(Vt, KbT, tr, tc, fr, fq, (f32x4){0.f, 0.f, 0.f, 0.f});
#pragma unroll
        for (int q = 0; q < 4; ++q) { const int o = (tr * 16 + fq * 4 + q) * 64 + tc * 16 + fr; Uf[o] = (bf16_t)f2bf(af[q]); Ub[o] = (bf16_t)f2bf(ab[q]); } }
    __syncthreads();
}
__device__ __forceinline__ void hgrn_pass1_run(KP p, int l, unsigned char* lds, int u0, int un, int ustep) {
    if (un <= 0) return;
    const int tid = tid_();
    HgrnIn1 cur; hgrn_p1_load(p, u0, tid, cur);
    for (int k = 0; k < un; ++k) { const int u = u0 + k * ustep;
        HgrnIn1 nxt = cur; if (k + 1 < un) hgrn_p1_load(p, u + ustep, tid, nxt);
        hgrn_p1_compute(p, l, lds, u, tid, cur);
        cur = nxt; }
}
__device__ __forceinline__ void hgrn_scan_f(KP p) {
    const int tid = tid_();
    if (tid >= 256) return;
    for (int gi = bid_() * 256 + tid; gi < 16 * 4096; gi += gsz_() * 256) {
    const int seq = gi >> 12, ed = gi & 4095, d = ed & 63;
    bf16_t* U = (bf16_t*)(p->ws + Z_U) + (size_t)seq * NCHUNK * 4096 + ed; const float* Gv = (const float*)(p->ws + Z_G) + (size_t)seq * NCHUNK * 64 + d;
    float S = 0.f;
#pragma unroll 1
    for (int j = 0; j < NCHUNK; j += 12) {
        float u[12], g[12];
#pragma unroll
        for (int q = 0; q < 12; ++q) { u[q] = bf2f(U[(size_t)(j + q) * 4096]); g[q] = Gv[(j + q) * 64]; }
#pragma unroll
        for (int q = 0; q < 12; ++q) { U[(size_t)(j + q) * 4096] = (bf16_t)f2bf(S); S = g[q] * S + u[q]; }
    }
    }
}
struct HgrnIn3 { float q[8], v[8], zf[8], zb[8], gg[8]; u32x4 sf, sb; };
__device__ __forceinline__ void hgrn_p3_load(KP p, int unit, int tid, HgrnIn3& r) {
    const int cpos = unit % NCHUNK, head = (unit / NCHUNK) & 3, b = unit / (NCHUNK * 4), d = tid & 63, seg = tid >> 6;
    const int row0 = (cpos < 4) ? R_LAT + b * NCTX + cpos * 64 : b * NSEQ + (cpos - 4) * 64;
    const bf16_t* P = (const bf16_t*)(p->ws + Z_P) + (size_t)(row0 + seg * 8) * DIN + head * 64 + d;
#pragma unroll
    for (int i = 0; i < 8; ++i) { const bf16_t* pr = P + (size_t)i * DIN; r.q[i] = bf2f(pr[C_RQ]); r.v[i] = bf2f(pr[C_RI]); r.zf[i] = bf2f(pr[C_RFF]); r.zb[i] = bf2f(pr[C_RFB]);
        r.gg[i] = bf2f(((const bf16_t*)(p->ws + Z_P))[(size_t)(row0 + seg + 8 * i) * DIN + C_RG + head * 64 + d]); }
    const int jf = cpos, jb = (cpos < 4) ? 3 - cpos : 4 + 127 - (cpos - 4); const int seqf = (b * 4 + head) * 2;
    const bf16_t* U = (const bf16_t*)(p->ws + Z_U);
    r.sf = *(const u32x4*)(U + ((size_t)seqf * NCHUNK + jf) * 4096 + tid * 8); r.sb = *(const u32x4*)(U + ((size_t)(seqf + 1) * NCHUNK + jb) * 4096 + tid * 8);
}
__device__ __forceinline__ void hgrn_p3_compute(KP p, int l, unsigned char* lds, int unit, int tid, const HgrnIn3& r) {
    const int lane = tid & 63, wid = tid >> 6, fr = lane & 15, fq = lane >> 4, d = tid & 63, seg = tid >> 6;
    constexpr int HL_D1 = HL_T0 + 6 * HL_TB, HL_TOT1 = HL_D1 + 6 * HL_TB;
    static_assert(HL_TOT1 + 2048 <= LDS_WVTAB_OFF, "HGRN pass-3 LDS fits below the wave table");
    float* os0 = (float*)(lds + HL_OSUM); float* os1 = (float*)(lds + HL_T0);
    const int cpos = unit % NCHUNK, head = (unit / NCHUNK) & 3, b = unit / (NCHUNK * 4);
    const int row0 = (cpos < 4) ? R_LAT + b * NCTX + cpos * 64 : b * NSEQ + (cpos - 4) * 64;
    const int tr = wid >> 1;
    const float* lbp = (const float*)(p->ws + WS_LB) + (l * 2) * 256 + head * 64 + d;
    float kg[2][8], c[2][8];
#pragma unroll
    for (int dir = 0; dir < 2; ++dir) { float* tot = (float*)(lds + (dir ? HL_TOT1 : HL_TOT));
        const float lb = lbp[dir * 256]; float run = 0.f;
#pragma unroll
        for (int ii = 0; ii < 8; ++ii) { const int i = dir ? 7 - ii : ii;
            const float z = dir ? r.zb[i] : r.zf[i];
            const float ez = __expf(-fabsf(z)), rz = __builtin_amdgcn_rcpf(1.f + ez), sg = (z >= 0.f) ? rz : ez * rz, f = lb + (1.f - lb) * sg;
            kg[dir][i] = 1.f - f; run += __logf(f); c[dir][i] = run; }
        tot[seg * 64 + d] = run; }
    __syncthreads();
#pragma unroll
    for (int dir = 0; dir < 2; ++dir) { const float* tot = (const float*)(lds + (dir ? HL_TOT1 : HL_TOT)); unsigned char* tb = lds + (dir ? HL_D1 : HL_T0);
        bf16_t* Qt = (bf16_t*)tb; bf16_t* Kt = (bf16_t*)(tb + HL_TB); bf16_t* Qb = (bf16_t*)(tb + 2 * HL_TB); bf16_t* St = (bf16_t*)(tb + 3 * HL_TB); bf16_t* Vt = (bf16_t*)(tb + 4 * HL_TB);
        float off = 0.f, m = 0.f;
#pragma unroll
        for (int s2 = 0; s2 < 8; ++s2) { const float t = tot[s2 * 64 + d]; if (dir ? (s2 > seg) : (s2 < seg)) off += t; if (dir ? (s2 >= 4) : (s2 < 4)) m += t; }
        float vr[8];
#pragma unroll
        for (int i = 0; i < 8; ++i) { const float ci = c[dir][i] + off; const int tau = dir ? 63 - (seg * 8 + i) : seg * 8 + i; const float qv = r.q[i];
            Qt[tau * HS + d] = (bf16_t)f2bf(qv * __expf(fminf(ci - m, 80.f)));
            Kt[tau * HS + d] = (bf16_t)f2bf(kg[dir][i] * __expf(fminf(m - ci, 80.f)));
            Qb[tau * HS + d] = (bf16_t)f2bf(qv * __expf(ci));
            vr[i] = dir ? r.v[7 - i] : r.v[i]; }
        *(u32x4*)(Vt + d * HS + (dir ? 7 - seg : seg) * 8) = pack8(vr);
        *(u32x4*)(St + (tid >> 3) * HS + (tid & 7) * 8) = dir ? r.sb : r.sf; }
    __syncthreads();
    f32x4 oacc[2][2];
#pragma unroll
    for (int dir = 0; dir < 2; ++dir) { unsigned char* tb = lds + (dir ? HL_D1 : HL_T0);
        const bf16_t* Qt = (const bf16_t*)tb; const bf16_t* Kt = (const bf16_t*)(tb + HL_TB); const bf16_t* Qb = (const bf16_t*)(tb + 2 * HL_TB); const bf16_t* St = (const bf16_t*)(tb + 3 * HL_TB); bf16_t* Sc = (bf16_t*)(tb + 5 * HL_TB);
#pragma unroll
        for (int t2 = 0; t2 < 2; ++t2) { const int tc = (wid & 1) * 2 + t2;
            oacc[dir][t2] = mm64(Qb, St, tr, tc, fr, fq, (f32x4){0.f, 0.f, 0.f, 0.f});
            f32x4 sacc = (f32x4){0.f, 0.f, 0.f, 0.f};
            if (tc <= tr) sacc = mm64(Qt, Kt, tr, tc, fr, fq, sacc);
#pragma unroll
            for (int q = 0; q < 4; ++q) { const int tau = tr * 16 + fq * 4 + q, sig = tc * 16 + fr; Sc[tau * HS + sig] = (bf16_t)f2bf(sig <= tau ? sacc[q] : 0.f); } } }
    __syncthreads();
#pragma unroll
    for (int dir = 0; dir < 2; ++dir) { unsigned char* tb = lds + (dir ? HL_D1 : HL_T0); const bf16_t* Vt = (const bf16_t*)(tb + 4 * HL_TB); const bf16_t* Sc = (const bf16_t*)(tb + 5 * HL_TB);
        float* os = dir ? os1 : os0;
#pragma unroll
        for (int t2 = 0; t2 < 2; ++t2) { const int tc = (wid & 1) * 2 + t2;
            const f32x4 o = mm64(Sc, Vt, tr, tc, fr, fq, oacc[dir][t2]);
#pragma unroll
            for (int q = 0; q < 4; ++q) { const int tau = tr * 16 + fq * 4 + q, e = tc * 16 + fr, tok = dir ? 63 - tau : tau; os[tok * 64 + e] = o[q]; } } }
    __syncthreads();
    bf16_t* Y = (bf16_t*)(p->ws + Z_YCAT); const float ong = p->in[22][l * 64 + lane];
#pragma unroll
    for (int i = 0; i < 8; ++i) { const int tok = wid + 8 * i; const float v = os0[tok * 64 + lane] + os1[tok * 64 + lane];
        const float y = v * rsqrtf(wave_sum(v * v) * (1.f / 64.f) + EPS) * ong;
        Y[(size_t)(row0 + tok) * D + 768 + head * 64 + lane] = (bf16_t)f2bf(y * silu_(r.gg[i])); }
    __syncthreads();
}
__device__ __forceinline__ int hgrn_p3_unit(int k) { if (k < 1024) { const int bh = k >> 7, c = k & 127; return bh * NCHUNK + 4 + c; } const int k2 = k - 1024; return (k2 >> 2) * NCHUNK + (k2 & 3); }
__device__ __forceinline__ void hgrn_pass3_run(KP p, int l, unsigned char* lds) {
    const int tid = tid_(), G = gsz_(), nunits = 1024 + (l == 0 ? 32 : 0);
    int k = bid_(); if (k >= nunits) return;
    HgrnIn3 cur; hgrn_p3_load(p, hgrn_p3_unit(k), tid, cur);
    for (;;) { const int kn = k + G; const bool more = kn < nunits;
        HgrnIn3 nxt = cur; if (more) hgrn_p3_load(p, hgrn_p3_unit(kn), tid, nxt);
        hgrn_p3_compute(p, l, lds, hgrn_p3_unit(k), tid, cur);
        if (!more) break;
        cur = nxt; k = kn; }
}
__device__ __forceinline__ void ph_prep(KP p, int l, unsigned char* lds) {
    const int tid = tid_(), lane = tid & 63, wid = tid >> 6, bid = bid_(), G = gsz_();
    const int nconv = 256 + (l == 0 ? 8 : 0);
    for (int it = bid; it < nconv; it += G) {
        if (it < 256) conv_tile(p, l, lds, (it >> 7) * NSEQ, NSEQ, (it & 127) * 64);
        else { const int c = it - 256; conv_tile(p, l, lds, R_LAT + (c >> 2) * NCTX, NCTX, (c & 3) * 64); } }
    if (G == 256) {
        const int u0 = bid < 8 ? 2 * bid : bid < 56 ? 16 + 5 * (bid - 8) : 256 + 4 * (bid - 56), un = bid < 8 ? 2 : bid < 56 ? 5 : 4;
        hgrn_pass1_run(p, l, lds, u0, un, 1);
        const int g0 = bid < 104 ? 8 * bid : bid < 168 ? 832 + 9 * (bid - 104) : 1408 + 8 * (bid - 168), gn = (bid >= 104 && bid < 168) ? 9 : 8;
        const QkvLane qc = qkv_lane_consts(p, l, lane);
        for (int g = g0; g < g0 + gn; ++g) prep_qkv_row(p, l, g * 8 + wid, lane, qc);
    } else {
        hgrn_pass1_run(p, l, lds, bid, (8 * NCHUNK - bid + G - 1) / G, G);
        const QkvLane qc = qkv_lane_consts(p, l, lane);
        for (int row = bid * 8 + wid; row < R_ALL; row += G * 8) prep_qkv_row(p, l, row, lane, qc);
    }
}

__device__ __forceinline__ void hgrn_scan(KP p) {
    const int gi = bid_() * NTHREADS + tid_();
    if (gi >= 16 * 4096) return;
    const int seq = gi >> 12, de = gi & 4095, d = de >> 6;
    float* U = (float*)(p->ws + Z_U) + (size_t)seq * NCHUNK * 4096 + de; const float* Gv = (const float*)(p->ws + Z_G) + (size_t)seq * NCHUNK * 64 + d;
    float S = 0.f;
    for (int j = 0; j < NCHUNK; j += 4) {
        float u[4], g[4];
#pragma unroll
        for (int q = 0; q < 4; ++q) { u[q] = U[(size_t)(j + q) * 4096]; g[q] = Gv[(j + q) * 64]; }
#pragma unroll
        for (int q = 0; q < 4; ++q) { U[(size_t)(j + q) * 4096] = S; S = g[q] * S + u[q]; }
    }
}
__device__ __forceinline__ void attn_simple_unit(unsigned char* lds, const bf16_t* Qrow0  , const bf16_t* Kb, const bf16_t* Vb  ,
                                                 int mode, int NT, int first_key, int q0, bool use_sink, float sink_log2, bf16_t* Orow0  ) {
    float* Ks = (float*)lds; float* Vs = Ks + 4096;
    const int tid = tid_();
    float q[64], o[64], m = -INFINITY, lsum = 0.f;
    if (tid < 256) {
#pragma unroll
        for (int d = 0; d < 64; ++d) { q[d] = bf2f(Qrow0[(size_t)tid * 256 + d]); o[d] = 0.f; }
    }
    for (int tt = 0; tt < NT; ++tt) {
        int key0, pos0 = 0; bool masked = false;
        if (mode == 0) key0 = first_key + 64 * tt;
        else if (tt < 4) key0 = NSEQ + 64 * tt;
        else { pos0 = q0 - 128 + 64 * (tt - 4); key0 = pos0 < 0 ? 0 : (pos0 > NSEQ - 64 ? NSEQ - 64 : pos0); masked = true; }
        __syncthreads();
        for (int i = tid; i < 4096; i += NTHREADS) { const int kk = i >> 6, d = i & 63; Ks[i] = bf2f(Kb[(size_t)(key0 + kk) * 128 + d]); Vs[i] = bf2f(Vb[(size_t)(key0 + kk) * 128 + d]); }
        __syncthreads();
        if (tid < 256) {
            for (int kk = 0; kk < 64; ++kk) {
                if (masked) { const int kp = pos0 + kk, qp = q0 + tid; const int df = qp - kp; if (kp < 0 || kp >= NSEQ || df > 128 || df < -128) continue; }
                float s = 0.f;
#pragma unroll
                for (int d = 0; d < 64; ++d) s += q[d] * Ks[kk * 64 + d];
                if (s > m) { const float f = exp2f(m - s); lsum *= f;
#pragma unroll
                    for (int d = 0; d < 64; ++d) o[d] *= f;
                    m = s; }
                const float pe = exp2f(s - m); lsum += pe;
#pragma unroll
                for (int d = 0; d < 64; ++d) o[d] += pe * Vs[kk * 64 + d];
            }
        }
    }
    if (tid < 256) {
        if (use_sink) lsum += exp2f(sink_log2 - m);
        const float inv = 1.f / lsum;
#pragma unroll
        for (int d = 0; d < 64; ++d) Orow0[(size_t)tid * D + d] = (bf16_t)f2bf(o[d] * inv);
    }
    __syncthreads();
}
__device__ __forceinline__ void ph_attn(KP p, int l, unsigned char* lds) {
    hgrn_scan(p);
    bf16_t* Y = (bf16_t*)(p->ws + Z_YCAT);
    const bf16_t* Qg = (const bf16_t*)(p->ws + Z_QG); const bf16_t* Qw = (const bf16_t*)(p->ws + Z_QW); const bf16_t* Qgc = (const bf16_t*)(p->ws + Z_QGC); const bf16_t* Qwc = (const bf16_t*)(p->ws + Z_QWC);
    const bf16_t* Kg = (const bf16_t*)(p->ws + Z_KG); const bf16_t* Kw = (const bf16_t*)(p->ws + Z_KW); const bf16_t* Vg = (const bf16_t*)(p->ws + Z_VG); const bf16_t* Vw = (const bf16_t*)(p->ws + Z_VW);
    const int nunits = 512 + (l == 0 ? 16 : 0);
    for (int u = bid_(); u < nunits; u += gsz_()) {
        if (u < 256) {
            const int qb = u & 31, h = (u >> 5) & 3, b = u >> 7, row0 = b * NSEQ + qb * 256;
            attn_simple_unit(lds, Qg + (size_t)row0 * 256 + h * 64, Kg + (size_t)b * NKEY * 128 + (h >> 1) * 64, Vg + (size_t)b * NKEY * 128 + (h >> 1) * 64, 0, NKEY / 64, 0, qb * 256, false, 0.f, Y + (size_t)row0 * D + h * 64);
        } else if (u < 512) {
            const int v = u - 256, qb = v & 31, h = (v >> 5) & 3, b = v >> 7, row0 = b * NSEQ + qb * 256;
            attn_simple_unit(lds, Qw + (size_t)row0 * 256 + h * 64, Kw + (size_t)b * NKEY * 128 + (h >> 1) * 64, Vw + (size_t)b * NKEY * 128 + (h >> 1) * 64, 1, 12, 0, qb * 256, true, p->in[14][l * 4 + h] * LOG2E, Y + (size_t)row0 * D + 512 + h * 64);
        } else {
            const int v = u - 512, h = v & 3, b = (v >> 2) & 1, win = v >> 3, row0 = R_LAT + b * NCTX;
            const bf16_t* Qc = (win ? Qwc : Qgc) + (size_t)(b * NCTX) * 256 + h * 64;
            const bf16_t* Kc = (win ? Kw : Kg) + (size_t)b * NKEY * 128 + (h >> 1) * 64; const bf16_t* Vc = (win ? Vw : Vg) + (size_t)b * NKEY * 128 + (h >> 1) * 64;
            attn_simple_unit(lds, Qc, Kc, Vc, 0, 4, NSEQ, 0, win != 0, p->in[14][l * 4 + h] * LOG2E, Y + (size_t)row0 * D + (win ? 512 : 0) + h * 64);
        }
    }
}

namespace attn_body {
using bf16=__hip_bfloat16;
using bf16x8=__attribute__((ext_vector_type(8)))short;
using s16x4=__attribute__((ext_vector_type(4)))short;
using f32x16=__attribute__((ext_vector_type(16)))float;
using u32x4=__attribute__((ext_vector_type(4)))unsigned;
constexpr int D=64, QP=256, KP=128, OP=1024;
constexpr int NW=8,QBLK=32,QB=QBLK*NW,KVBLK=64;
__device__ __forceinline__ int crow(int r,int hi){return (r&3)+8*(r>>2)+4*hi;}
#define SBAR() __builtin_amdgcn_sched_barrier(0)
__device__ __forceinline__ void wmask(f32x16&p0,f32x16&p1,int tb,int qrel,int hi,int q0){
  const float NEG=-INFINITY; const int kb=64*tb+4*hi;
  #pragma unroll
  for(int r=0;r<16;++r){const int kl=kb+(r&3)+8*(r>>2); const int kp=q0-128+kl;
    if(kl<qrel||kl>qrel+256||kp<0||kp>=NSEQ)p0[r]=NEG;
    if(kl+32<qrel||kl+32>qrel+256||kp+32<0||kp+32>=NSEQ)p1[r]=NEG;}
}

constexpr int NSLOT=3, SLOTB=8192;
constexpr int LDS_K=0, LDS_V=NSLOT*SLOTB, LDS_WS=2*NSLOT*SLOTB, LDS_OST=LDS_WS+NW*64*4, LDS_BYTES=LDS_OST+NW*4096;
constexpr float C2=0.125f*1.4426950408889634f;
__device__ __forceinline__ void glds16(const void*gsrc,unsigned lds_dst){unsigned keep;
  asm volatile("s_mov_b32 %0, m0\n\ts_mov_b32 m0, %2\n\ts_nop 0\n\tglobal_load_lds_dwordx4 %1, off\n\ts_mov_b32 m0, %0":"=&s"(keep):"v"(gsrc),"s"(lds_dst):"memory");}
__device__ __forceinline__ float max3f(float a,float b,float c){float r;asm("v_max3_f32 %0, %1, %2, %3":"=v"(r):"v"(a),"v"(b),"v"(c));return r;}
__device__ __forceinline__ float max2f(float a,float b){float r;asm("v_max_f32_e32 %0, %1, %2":"=v"(r):"v"(a),"v"(b));return r;}
__device__ __forceinline__ float fadd_s(float a,float b){float r;asm("v_add_f32_e32 %0, %1, %2":"=v"(r):"v"(a),"v"(b));return r;}
__device__ __forceinline__ float fsub_s(float a,float b){float r;asm("v_sub_f32_e32 %0, %1, %2":"=v"(r):"v"(a),"v"(b));return r;}
typedef float f32x2_t __attribute__((ext_vector_type(2))); typedef __bf16 bf16x2_t __attribute__((ext_vector_type(2)));
__device__ __forceinline__ unsigned cvtpk_s(float lo,float hi){f32x2_t v={lo,hi};bf16x2_t b=__builtin_convertvector(v,bf16x2_t);return __builtin_bit_cast(unsigned,b);}
#define WAIT_BAR(N) asm volatile("s_waitcnt vmcnt(" #N ") lgkmcnt(0)\n\ts_barrier":::"memory")

__device__ __forceinline__ void qkt(f32x16&p0,f32x16&p1,const char*Kslot,const bf16x8*qr,const f32x16&negm,int r32,int hi){
  const char*kb=Kslot+hi*1024+r32*16;
  #pragma unroll
  for(int d0=0;d0<4;++d0){
    const bf16x8 b0=*reinterpret_cast<const bf16x8*>(kb+d0*2048);
    const bf16x8 b1=*reinterpret_cast<const bf16x8*>(kb+d0*2048+512);
    if(d0==0){p0=__builtin_amdgcn_mfma_f32_32x32x16_bf16(b0,qr[0],negm,0,0,0);p1=__builtin_amdgcn_mfma_f32_32x32x16_bf16(b1,qr[0],negm,0,0,0);}
    else{p0=__builtin_amdgcn_mfma_f32_32x32x16_bf16(b0,qr[d0],p0,0,0,0);p1=__builtin_amdgcn_mfma_f32_32x32x16_bf16(b1,qr[d0],p1,0,0,0);}}
}
typedef __attribute__((address_space(3))) const char* lds_cptr;
typedef short v4i16_t __attribute__((ext_vector_type(4)));
__device__ __forceinline__ void kload8(bf16x8*kf,lds_cptr kp){
  kf[0]=*(const __attribute__((address_space(3))) bf16x8*)(kp);      kf[1]=*(const __attribute__((address_space(3))) bf16x8*)(kp+512);
  kf[2]=*(const __attribute__((address_space(3))) bf16x8*)(kp+2048); kf[3]=*(const __attribute__((address_space(3))) bf16x8*)(kp+2560);
  kf[4]=*(const __attribute__((address_space(3))) bf16x8*)(kp+4096); kf[5]=*(const __attribute__((address_space(3))) bf16x8*)(kp+4608);
  kf[6]=*(const __attribute__((address_space(3))) bf16x8*)(kp+6144); kf[7]=*(const __attribute__((address_space(3))) bf16x8*)(kp+6656);
}
__device__ __forceinline__ void kload2(bf16x8*kf,lds_cptr kp,int j){ kf[2*j]=*(const __attribute__((address_space(3))) bf16x8*)(kp+j*2048); kf[2*j+1]=*(const __attribute__((address_space(3))) bf16x8*)(kp+j*2048+512); }
__device__ __forceinline__ s16x4 vtr(lds_cptr p){ return __builtin_bit_cast(s16x4,__builtin_amdgcn_ds_read_tr16_b64_v4i16((__attribute__((address_space(3))) v4i16_t*)p)); }
__device__ __forceinline__ float rowmax(const f32x16&p0,const f32x16&p1){
  float a=max3f(p0[0],p0[1],p1[0]),b=max3f(p0[2],p0[3],p1[1]);a=max3f(a,p1[2],p1[3]);
  #pragma unroll
  for(int r=4;r<16;r+=4){a=max3f(a,p0[r],p0[r+1]);b=max3f(b,p0[r+2],p0[r+3]);a=max3f(a,p1[r],p1[r+1]);b=max3f(b,p1[r+2],p1[r+3]);}
  const float m=max2f(a,b);
  auto rr=__builtin_amdgcn_permlane32_swap(__float_as_uint(m),__float_as_uint(m),false,false);
  return max2f(__uint_as_float(rr[0]),__uint_as_float(rr[1]));
}
__device__ __forceinline__ void pv(f32x16*o,int vb,bf16x8 pa0,bf16x8 pa1,bf16x8 pa2,bf16x8 pa3){
  #pragma unroll
  for(int d0=0;d0<2;++d0){s16x4 lo[4],hi[4];
    #pragma unroll
    for(int ks=0;ks<4;++ks){
      asm volatile("ds_read_b64_tr_b16 %0,%1 offset:%c2":"=&v"(lo[ks]):"v"(vb),"i"(d0*4096+ks*1024):"memory");
      asm volatile("ds_read_b64_tr_b16 %0,%1 offset:%c2":"=&v"(hi[ks]):"v"(vb),"i"(d0*4096+ks*1024+512):"memory");}
    asm volatile("s_waitcnt lgkmcnt(0)":::"memory");SBAR();
    #define PK(k) (bf16x8){lo[k][0],lo[k][1],lo[k][2],lo[k][3],hi[k][0],hi[k][1],hi[k][2],hi[k][3]}
    o[d0]=__builtin_amdgcn_mfma_f32_32x32x16_bf16(pa0,PK(0),o[d0],0,0,0);
    o[d0]=__builtin_amdgcn_mfma_f32_32x32x16_bf16(pa1,PK(1),o[d0],0,0,0);
    o[d0]=__builtin_amdgcn_mfma_f32_32x32x16_bf16(pa2,PK(2),o[d0],0,0,0);
    o[d0]=__builtin_amdgcn_mfma_f32_32x32x16_bf16(pa3,PK(3),o[d0],0,0,0);
    #undef PK
  }
}

#ifndef ATTN_STORE16
#define ATTN_STORE16(p,v) (*(u32x4*)(p)=(v))
#endif
template<int MODE,int NMASKT,int THRL> __device__ __forceinline__ void attn_unit(const bf16*Q0,const bf16*__restrict__ Kh,const bf16*__restrict__ Vh,bf16*O0,int NT,int key_first,int q0,bool use_sink,float sink_l2,char*shm){
  const int tid=tid_(),lane=tid&63,r32=lane&31,hi=lane>>5; const int wid=__builtin_amdgcn_readfirstlane(tid>>6);
  const bf16*Qw=Q0+(long)(wid*QBLK)*QP;
  auto krow=[&](int t)->long{ if(MODE==0) return (long)key_first+64*t; if(t<4) return (long)NSEQ+64*t; int p=q0-128+64*(t-4); p=p<0?0:(p>NSEQ-64?NSEQ-64:p); return (long)p; };
  const unsigned lds0=(unsigned)(uintptr_t)shm;
  float*wsf=(float*)(shm+LDS_WS)+wid*64;
  const bf16*ksrc=Kh+(long)lane*KP+wid*8;
  const bf16*vsrc=Vh+(long)(16*(wid&3)+(lane>>2))*KP+(wid>>2)*32+(lane&3)*8;
  const unsigned kdst=lds0+LDS_K+wid*1024, vdst=lds0+LDS_V+wid*1024;
  #define DMA_K(t,slot) glds16(ksrc+krow(t)*KP,(unsigned)__builtin_amdgcn_readfirstlane(kdst+(slot)))
  #define DMA_V(t,slot) glds16(vsrc+krow(t)*KP,(unsigned)__builtin_amdgcn_readfirstlane(vdst+(slot)))
  const int vb0=(int)(lds0+LDS_V)+((lane>>4)&1)*32+(lane&3)*8+(4*hi+((lane&15)>>2))*64;
  const char*Kbase=shm+LDS_K; bf16x8 kf[8];
  const lds_cptr shm3=(lds_cptr)shm; const lds_cptr kp0=shm3+LDS_K+hi*1024+r32*16; const lds_cptr vp0=shm3+LDS_V+((lane>>4)&1)*32+(lane&3)*8+(4*hi+((lane&15)>>2))*64;
  DMA_K(0,0);DMA_V(0,0);DMA_K(1,SLOTB);
  bf16x8 qr[4];
  #pragma unroll
  for(int d0=0;d0<4;++d0)qr[d0]=*reinterpret_cast<const bf16x8*>(&Qw[(long)r32*QP+d0*16+hi*8]);
  float mhat=0.f,l_reg=0.f;f32x16 o[2];o[0]=f32x16{};o[1]=f32x16{};f32x16 negm=f32x16{};asm volatile("":"+v"(negm));
  const int qrel=wid*QBLK+r32;
  #define CMASK(P0,P1,t) do{ if(NMASKT>0){int jb_=(t)-(NT-NMASKT); if(jb_>=0)wmask(P0,P1,jb_,qrel,hi,q0);} }while(0)
  bool resc=false;
  #define START(P0,P1) do{ const float rm=rowmax(P0,P1); resc=false; \
    { const float dl=rm; mhat=fadd_s(mhat,dl); \
      _Pragma("unroll") for(int r=0;r<16;++r){P0[r]=fsub_s(P0[r],dl);P1[r]=fsub_s(P1[r],dl);} \
      _Pragma("unroll") for(int r=0;r<16;++r)negm[r]=-mhat; asm volatile("":"+v"(negm)); } \
    _Pragma("unroll") for(int r=0;r<16;++r)P0[r]=__builtin_amdgcn_exp2f(P0[r]); }while(0)
  #define RESC() do{ if(resc){ asm volatile("s_waitcnt lgkmcnt(0)":::"memory"); \
      _Pragma("unroll") for(int d_=0;d_<2;++d_) _Pragma("unroll") for(int r=0;r<16;++r)o[d_][r]*=wsf[crow(r,hi)]; } }while(0)
  f32x16 pA0,pA1,pB0,pB1;
  int sl_prev=0,sl_cur=0,sl_next=SLOTB;
  #define ROT() do{sl_prev=sl_cur;sl_cur=sl_next;sl_next=(sl_next==(NSLOT-1)*SLOTB)?0:sl_next+SLOTB;}while(0)
  DMA_K(2,2*SLOTB);
  WAIT_BAR(3);
  qkt(pA0,pA1,Kbase,qr,negm,r32,hi);asm volatile("s_nop 15\n\ts_nop 7":"+v"(pA0),"+v"(pA1));CMASK(pA0,pA1,0);
  START(pA0,pA1);
  _Pragma("unroll") for(int r=0;r<16;++r)pA1[r]=__builtin_amdgcn_exp2f(pA1[r]);
  WAIT_BAR(0);
  DMA_K(3,0);DMA_V(1,SLOTB);
  ROT();
  kload8(kf,kp0+sl_cur);
  WAIT_BAR(2);
  s16x4 vlo[8],vhi[8]; u32x4 pw0,pw1,pw2,pw3;
  #define PKW(P,B) cvtpk_s(P[B],P[B+1])
  #define PAF(k) __builtin_bit_cast(bf16x8,pw##k)
  #define VFR(i) (bf16x8){vlo[i][0],vlo[i][1],vlo[i][2],vlo[i][3],vhi[i][0],vhi[i][1],vhi[i][2],vhi[i][3]}
  #define PIN(x) asm volatile("":"+v"(x))
  #define MX3(a,b,c) __builtin_fmaxf(__builtin_fmaxf((a),(b)),(c))
  #define GAPA(MF,A0,A1,A2,A3,W0,W1,PW) do{ MF; sacc+=A0; sacc+=A1; sacc+=A2; sacc+=A3; PIN(sacc); W0; W1; PIN(PW); SBAR(); }while(0)
  #define EX(v) __builtin_amdgcn_exp2f(v)
  #define GAPB(MF,X,B) do{ MF; X[B]=EX(X[B]); X[B+1]=EX(X[B+1]); X[B+2]=EX(X[B+2]); X[B+3]=EX(X[B+3]); PIN(X); SBAR(); }while(0)
  #define VRD(i) do{ vlo[i]=vtr(vp_+(((i)>>2)*4096+((i)&3)*1024)); vhi[i]=vtr(vp_+(((i)>>2)*4096+((i)&3)*1024+512)); }while(0)
  #define KRD(G,j) do{ if(G){ kload2(kf,kp0+sl_next,j); SBAR(); } }while(0)
  #define STEP(C0,C1,P0,P1,t,GK,GV,GL) do{ SBAR(); \
    const lds_cptr vp_=vp0+sl_prev; \
    VRD(0); SBAR(); float sacc=(P0[0]+P0[1]); \
    GAPA(C0=__builtin_amdgcn_mfma_f32_32x32x16_bf16(kf[0],qr[0],negm,0,0,0), P0[2],P0[3],P0[4],P0[5],     pw0[0]=PKW(P0,0), pw0[1]=PKW(P0,2), pw0); \
    VRD(4); SBAR(); GAPA(C1=__builtin_amdgcn_mfma_f32_32x32x16_bf16(kf[1],qr[0],negm,0,0,0), P0[6],P0[7],P0[8],P0[9],     pw0[2]=PKW(P0,4), pw0[3]=PKW(P0,6), pw0); \
    VRD(1); SBAR(); GAPA(C0=__builtin_amdgcn_mfma_f32_32x32x16_bf16(kf[2],qr[1],C0,0,0,0),   P0[10],P0[11],P0[12],P0[13], pw1[0]=PKW(P0,8), pw1[1]=PKW(P0,10), pw1); \
    VRD(5); SBAR(); GAPA(C1=__builtin_amdgcn_mfma_f32_32x32x16_bf16(kf[3],qr[1],C1,0,0,0),   P0[14],P0[15],P1[0],P1[1],   pw1[2]=PKW(P0,12),pw1[3]=PKW(P0,14), pw1); \
    VRD(2); SBAR(); GAPA(C0=__builtin_amdgcn_mfma_f32_32x32x16_bf16(kf[4],qr[2],C0,0,0,0),   P1[2],P1[3],P1[4],P1[5],     pw2[0]=PKW(P1,0), pw2[1]=PKW(P1,2), pw2); \
    VRD(6); SBAR(); GAPA(C1=__builtin_amdgcn_mfma_f32_32x32x16_bf16(kf[5],qr[2],C1,0,0,0),   P1[6],P1[7],P1[8],P1[9],     pw2[2]=PKW(P1,4), pw2[3]=PKW(P1,6), pw2); \
    VRD(3); SBAR(); GAPA(C0=__builtin_amdgcn_mfma_f32_32x32x16_bf16(kf[6],qr[3],C0,0,0,0),   P1[10],P1[11],P1[12],P1[13], pw3[0]=PKW(P1,8), pw3[1]=PKW(P1,10), pw3); \
    VRD(7); SBAR(); GAPA(C1=__builtin_amdgcn_mfma_f32_32x32x16_bf16(kf[7],qr[3],C1,0,0,0),   P1[14],P1[15],0.f,0.f,       pw3[2]=PKW(P1,12),pw3[3]=PKW(P1,14), pw3); \
    l_reg+=sacc; \
    if(GK){DMA_K((t)+3,sl_cur);} if(GV){DMA_V((t)+1,sl_next);} \
    CMASK(C0,C1,t); \
    { float a=MX3(C0[0],C0[1],C1[0]),b=MX3(C0[2],C0[3],C1[1]); a=MX3(a,C1[2],C1[3]); \
      _Pragma("unroll") for(int r=4;r<16;r+=4){a=MX3(a,C0[r],C0[r+1]);b=MX3(b,C0[r+2],C0[r+3]);a=MX3(a,C1[r],C1[r+1]);b=MX3(b,C1[r+2],C1[r+3]);} \
      float rm=__builtin_fmaxf(a,b); { auto rr=__builtin_amdgcn_permlane32_swap(__float_as_uint(rm),__float_as_uint(rm),false,false); rm=__builtin_fmaxf(__uint_as_float(rr[0]),__uint_as_float(rr[1])); } \
      resc=false; \
      if(__builtin_expect(__any(rm>(float)THRL),0)){ const float dl=__builtin_fmaxf(rm,0.f); mhat+=dl; \
        _Pragma("unroll") for(int r=0;r<16;++r){C0[r]-=dl;C1[r]-=dl;} \
        _Pragma("unroll") for(int r=0;r<16;++r)negm[r]=-mhat; asm volatile("":"+v"(negm)); \
        const float f=__builtin_amdgcn_exp2f(-dl); l_reg*=f; if(hi==0)wsf[r32]=f; resc=true; } } \
    SBAR(); \
    GAPB(o[0]=__builtin_amdgcn_mfma_f32_32x32x16_bf16(PAF(0),VFR(0),o[0],0,0,0), C0,0); \
    GAPB(o[1]=__builtin_amdgcn_mfma_f32_32x32x16_bf16(PAF(0),VFR(4),o[1],0,0,0), C0,4); \
    KRD(GL,0); GAPB(o[0]=__builtin_amdgcn_mfma_f32_32x32x16_bf16(PAF(1),VFR(1),o[0],0,0,0), C0,8); \
    KRD(GL,1); GAPB(o[1]=__builtin_amdgcn_mfma_f32_32x32x16_bf16(PAF(1),VFR(5),o[1],0,0,0), C0,12); \
    KRD(GL,2); GAPB(o[0]=__builtin_amdgcn_mfma_f32_32x32x16_bf16(PAF(2),VFR(2),o[0],0,0,0), C1,0); \
    KRD(GL,3); GAPB(o[1]=__builtin_amdgcn_mfma_f32_32x32x16_bf16(PAF(2),VFR(6),o[1],0,0,0), C1,4); \
    GAPB(o[0]=__builtin_amdgcn_mfma_f32_32x32x16_bf16(PAF(3),VFR(3),o[0],0,0,0), C1,8); \
    GAPB(o[1]=__builtin_amdgcn_mfma_f32_32x32x16_bf16(PAF(3),VFR(7),o[1],0,0,0), C1,12); \
    }while(0)
  int t=1;
  #undef CMASK
  #define CMASK(P0,P1,t) do{}while(0)
  for(;t+1+(NMASKT>4?NMASKT:4)<NT;t+=2){
    STEP(pB0,pB1,pA0,pA1,t,true,true,true);     WAIT_BAR(2); RESC(); ROT();
    STEP(pA0,pA1,pB0,pB1,t+1,true,true,true);   WAIT_BAR(2); RESC(); ROT();
  }
  #undef CMASK
  #define CMASK(P0,P1,t) do{ if(NMASKT>0){int jb_=(t)-(NT-NMASKT); if(jb_>=0)wmask(P0,P1,jb_,qrel,hi,q0);} }while(0)
  #define ENDW(tt) do{ if((tt)+3<NT){WAIT_BAR(2);} else if((tt)+2<NT){WAIT_BAR(1);} else {WAIT_BAR(0);} }while(0)
  for(;t+1<NT;t+=2){
    STEP(pB0,pB1,pA0,pA1,t,(t+3<NT),(t+1<NT),(t+1<NT));       ENDW(t);   RESC(); ROT();
    STEP(pA0,pA1,pB0,pB1,t+1,(t+4<NT),(t+2<NT),(t+2<NT));     ENDW(t+1); RESC(); ROT();
  }
  STEP(pB0,pB1,pA0,pA1,NT-1,false,false,false); RESC();
  { float sacc=pB0[0]+pB0[1]; _Pragma("unroll") for(int r=2;r<16;++r)sacc+=pB0[r]; _Pragma("unroll") for(int r=0;r<16;++r)sacc+=pB1[r]; l_reg+=sacc;
    pw0=(u32x4){PKW(pB0,0),PKW(pB0,2),PKW(pB0,4),PKW(pB0,6)};pw1=(u32x4){PKW(pB0,8),PKW(pB0,10),PKW(pB0,12),PKW(pB0,14)};pw2=(u32x4){PKW(pB1,0),PKW(pB1,2),PKW(pB1,4),PKW(pB1,6)};pw3=(u32x4){PKW(pB1,8),PKW(pB1,10),PKW(pB1,12),PKW(pB1,14)};
    SBAR(); pv(o,vb0+sl_cur,PAF(0),PAF(1),PAF(2),PAF(3)); }
  #undef PKW
  #undef PAF
  #undef VFR
  #undef PIN
  #undef MX3
  #undef GAPA
  #undef GAPB
  #undef EX
  #undef VRD
  #undef KRD
  #undef STEP
  #undef ENDW
  {auto rr=__builtin_amdgcn_permlane32_swap(__float_as_uint(l_reg),__float_as_uint(l_reg),false,false);l_reg=__uint_as_float(rr[0])+__uint_as_float(rr[1]);}
  if(use_sink)l_reg+=__builtin_amdgcn_exp2f(sink_l2-mhat);
  if(hi==0)wsf[32+r32]=l_reg;asm volatile("s_waitcnt lgkmcnt(0)":::"memory");
  float rli[16];
  #pragma unroll
  for(int r=0;r<16;++r)rli[r]=__builtin_amdgcn_rcpf(wsf[32+crow(r,hi)]);
  bf16*Ow=O0+(long)(wid*QBLK)*OP;
  { bf16*stg=(bf16*)(shm+LDS_OST)+wid*2048;
    #pragma unroll
    for(int r=0;r<16;++r){const int orow=crow(r,hi);
      #pragma unroll
      for(int d0=0;d0<2;++d0)stg[orow*64+d0*32+r32]=__float2bfloat16(o[d0][r]*rli[r]);}
    asm volatile("s_waitcnt lgkmcnt(0)":::"memory");
    #pragma unroll
    for(int i=0;i<4;++i){const int row=i*8+(lane>>3),ch=lane&7; const u32x4 v=*(const u32x4*)(stg+row*64+ch*8); ATTN_STORE16(Ow+(long)row*OP+ch*8,v);} }
  asm volatile("s_waitcnt lgkmcnt(0)\n\ts_barrier":::"memory");
  #undef DMA_K
  #undef DMA_V
  #undef CMASK
  #undef START
  #undef RESC
  #undef ROT
}
constexpr int ATTN_LDS_BYTES=LDS_BYTES;
#undef SBAR
#undef WAIT_BAR
}

__device__ __forceinline__ void ph_attn_f(KP p, int l, unsigned char* lds, bool do_scan = true) {
    if (do_scan) { if (FAST_HGRN) hgrn_scan_f(p); else hgrn_scan(p); }
    using attn_body::bf16;
    bf16* Y = (bf16*)(p->ws + Z_YCAT);
    const bf16* Qg = (const bf16*)(p->ws + Z_QG); const bf16* Qw = (const bf16*)(p->ws + Z_QW); const bf16* Qgc = (const bf16*)(p->ws + Z_QGC); const bf16* Qwc = (const bf16*)(p->ws + Z_QWC);
    const bf16* Kg = (const bf16*)(p->ws + Z_KG); const bf16* Kw = (const bf16*)(p->ws + Z_KW); const bf16* Vg = (const bf16*)(p->ws + Z_VG); const bf16* Vw = (const bf16*)(p->ws + Z_VW);
    const int G = gsz_(), bid = bid_();
    __syncthreads();
    for (int vb = bid; vb < 256; vb += G) {
        const int v = (G == 256) ? (((vb & 7) >> 1) * 64 + (vb & 1) * 32 + (vb >> 3)) : vb;
        const int b = v >> 7, kvh = (v >> 6) & 1, h = kvh * 2 + ((v >> 5) & 1), qb = v & 31, row0 = b * NSEQ + qb * 256;
        const size_t kvo = (size_t)b * NKEY * 128 + kvh * 64;
        attn_body::attn_unit<0, 0, 8>(Qg + (size_t)row0 * 256 + h * 64, Kg + kvo, Vg + kvo, Y + (size_t)row0 * D + h * 64, NKEY / 64, 0, 0, false, 0.f, (char*)lds);
        attn_body::attn_unit<1, 8, 8>(Qw + (size_t)row0 * 256 + h * 64, Kw + kvo, Vw + kvo, Y + (size_t)row0 * D + 512 + h * 64, 12, 0, qb * 256, true, p->in[14][l * 4 + h] * LOG2E, (char*)lds);
    }
    if (l == 0) for (int v = bid; v < 16; v += G) {
        const int h = v & 3, b = (v >> 2) & 1, win = v >> 3, row0 = R_LAT + b * NCTX;
        const size_t kvo = (size_t)b * NKEY * 128 + (h >> 1) * 64;
        attn_body::attn_unit<0, 0, 8>((win ? Qwc : Qgc) + (size_t)(b * NCTX) * 256 + h * 64, (win ? Kw : Kg) + kvo, (win ? Vw : Vg) + kvo, Y + (size_t)row0 * D + (win ? 512 : 0) + h * 64, 4, NSEQ, 0, win != 0, p->in[14][l * 4 + h] * LOG2E, (char*)lds);
    }
}

__device__ __forceinline__ void hgrn_pass3_unit(KP p, int l, unsigned char* lds, int unit) {
    float* qs = (float*)lds; float* vs = qs + 4096; float* ks = vs + 4096; float* cs = ks + 4096; float* Ss = cs + 4096; float* sc = Ss + 4096; float* os = sc + 4096;
    const int tid = tid_(), lane = tid & 63, wid = tid >> 6;
    const int cpos = unit % NCHUNK, head = (unit / NCHUNK) & 3, b = unit / (NCHUNK * 4);
    const int row0 = (cpos < 4) ? R_LAT + b * NCTX + cpos * 64 : b * NSEQ + (cpos - 4) * 64;
    for (int i = tid; i < 4096; i += NTHREADS) os[i] = 0.f;
    for (int dir = 0; dir < 2; ++dir) {
        const int j = (cpos < 4) ? (dir ? 3 - cpos : cpos) : 4 + (dir ? 127 - (cpos - 4) : (cpos - 4));
        const int seq = (b * 4 + head) * 2 + dir;
        __syncthreads();
        hgrn_load_chunk(p, l, row0, dir, head, qs, vs, ks, cs);
        const float* Sg = (const float*)(p->ws + Z_U) + ((size_t)seq * NCHUNK + j) * 4096;
        for (int i = tid; i < 4096; i += NTHREADS) Ss[i] = Sg[i];
        for (int i = tid; i < 4096; i += NTHREADS) { const int tau = i >> 6, sig = i & 63; float a = 0.f;
            if (sig <= tau) { for (int d = 0; d < 64; ++d) a += qs[tau * 64 + d] * ks[sig * 64 + d] * __expf(cs[tau * 64 + d] - cs[sig * 64 + d]); }
            sc[i] = a; }
        __syncthreads();
        { const int tau = tid >> 3, e0 = (tid & 7) * 8; float acc[8];
#pragma unroll
          for (int e = 0; e < 8; ++e) acc[e] = 0.f;
          for (int d = 0; d < 64; ++d) { const float qv = qs[tau * 64 + d] * __expf(cs[tau * 64 + d]);
#pragma unroll
              for (int e = 0; e < 8; ++e) acc[e] += qv * Ss[d * 64 + e0 + e]; }
          for (int sig = 0; sig <= tau; ++sig) { const float sv = sc[tau * 64 + sig];
#pragma unroll
              for (int e = 0; e < 8; ++e) acc[e] += sv * vs[sig * 64 + e0 + e]; }
          const int tok = dir ? 63 - tau : tau;
#pragma unroll
          for (int e = 0; e < 8; ++e) os[tok * 64 + e0 + e] += acc[e]; }
        __syncthreads();
    }
    const bf16_t* P = (const bf16_t*)(p->ws + Z_P); bf16_t* Y = (bf16_t*)(p->ws + Z_YCAT);
    for (int tok = wid; tok < 64; tok += 8) { const float v = os[tok * 64 + lane];
        const float y = v * rsqrtf(wave_sum(v * v) * (1.f / 64.f) + EPS) * p->in[22][l * 64 + lane];
        const float g = bf2f(P[(size_t)(row0 + tok) * DIN + C_RG + head * 64 + lane]);
        Y[(size_t)(row0 + tok) * D + 768 + head * 64 + lane] = (bf16_t)f2bf(y * silu_(g)); }
    __syncthreads();
}
__device__ __forceinline__ void ph_hgrn3(KP p, int l, unsigned char* lds) {
    hgrn_pass3_run(p, l, lds);
    if (l == 0 && DEPTH > 1 && gsz_() == 256) { __syncthreads(); ph_cvt(p, 1, lds, 32, 224, CVT_E1, CVT_E2); }
}

__device__ __forceinline__ void ph_outproj(KP p, int l, unsigned char* lds) {
    const bf16_t* A = (const bf16_t*)(p->ws + Z_YCAT); const bf16_t* Bt = (const bf16_t*)(p->ws + Z_WOUT); float* X = (float*)(p->ws + WS_X);
    const int T = (l == 0) ? R_ALL : R_LAT; const int TM = T / 128, TN = 8;
    for (int it = bid_(); it < TM * TN; it += gsz_()) { const int mt = it / TN, nt = it % TN;
        auto epi = [&](int row, int col, float v, float) { const int c = nt * 128 + col; X[(size_t)row * D + c] = xrow_src(p, l, row)[c] + mod_vec(p, l, row, 2)[c] * v; };
        gemm_simple_tile<1>(A, RowId{}, Bt, 1024, mt * 128, nt * 128, 0, epi); }
}

__device__ __forceinline__ void ph_norm2(KP p, int l, unsigned char* lds, int cnt_off = 0) {
    constexpr int RS = 1032, NSTG = 80;
    const int T = (l == 0) ? R_ALL : R_LAT;
    bf16_t* AH = (bf16_t*)lds; bf16_t* AL = AH + 16 * RS;
    float* PART = (float*)(lds + 2 * 16 * RS * 2); float* LOG = PART + 8 * 16 * 64;
    int* hist = (int*)(LOG + 16 * 64); int* hbase = hist + 64; int* s_e = hbase + 64; int* s_r = s_e + NSTG * 8; float* s_w = (float*)(s_r + NSTG * 8); float* msb = s_w + NSTG * 8;
    const int tid = tid_(), lane = tid & 63, wid = tid >> 6, fr = lane & 15, fq = lane >> 4, bid = bid_(), G = gsz_();
    bf16_t* Tok = (bf16_t*)(p->ws + Z_A); const bf16_t* X = (const bf16_t*)(p->ws + WS_X);
    const float* g2 = p->in[7] + l * D; const float* rw = p->in[23] + (size_t)l * 1024 * 64; const float* rbias = p->in[24] + l * 64;
    unsigned* cnt = (unsigned*)(p->ws + WS_CTL) + CW_CNT + cnt_off + l * 64;
    int* tok_e = (int*)(p->ws + WS_TOKE); int* tok_p = (int*)(p->ws + WS_TOKP); int* expl = (int*)(p->ws + WS_EXPL); float* expw = (float*)(p->ws + WS_EXPW);
    bf16x8 bh[4][4], bl[4][4];
#pragma unroll
    for (int t = 0; t < 4; ++t)
#pragma unroll
        for (int k = 0; k < 4; ++k) { float v[8], lo[8];
#pragma unroll
            for (int j = 0; j < 8; ++j) v[j] = rw[(size_t)((wid * 4 + k) * 32 + fq * 8 + j) * 64 + t * 16 + fr];
            const u32x4 hh = pack8(v);
            const float hf[8] = {bf2f(hh.x & 0xffffu), bf2f(hh.x >> 16), bf2f(hh.y & 0xffffu), bf2f(hh.y >> 16), bf2f(hh.z & 0xffffu), bf2f(hh.z >> 16), bf2f(hh.w & 0xffffu), bf2f(hh.w >> 16)};
#pragma unroll
            for (int j = 0; j < 8; ++j) lo[j] = v[j] - hf[j];
            const u32x4 ll = pack8(lo);
            bh[t][k] = __builtin_bit_cast(bf16x8, hh); bl[t][k] = __builtin_bit_cast(bf16x8, ll); }
    const float mybias = rbias[lane];
    const int rpb = (T + G - 1) / G;
    for (int base = bid * rpb; base < T; base += G * rpb) {
        const int r1 = (base + rpb < T) ? base + rpb : T;
        if (tid < 64) hist[tid] = 0;
        for (int s0 = base; s0 < r1; s0 += 16) {
#pragma unroll
            for (int j2 = 0; j2 < 2; ++j2) { const int lr = wid * 2 + j2, row = s0 + lr;
                if (row < r1) {
                    const bf16_t* xrow = X + (size_t)row * D; const float* shift = mod_vec(p, l, row, 3); const float* scale = mod_vec(p, l, row, 4);
                    f32x4 v[4]; float ssq = 0.f;
#pragma unroll
                    for (int j = 0; j < 4; ++j) { const u32x2 r2 = ((const u32x2*)xrow)[lane + 64 * j]; v[j].x = bf2f(r2.x & 0xffffu); v[j].y = bf2f(r2.x >> 16); v[j].z = bf2f(r2.y & 0xffffu); v[j].w = bf2f(r2.y >> 16); ssq += v[j].x * v[j].x + v[j].y * v[j].y + v[j].z * v[j].z + v[j].w * v[j].w; }
                    const float rinv = rsqrtf(wave_sum(ssq) * (1.f / D) + EPS);
#pragma unroll
                    for (int j = 0; j < 4; ++j) { const int idx = lane + 64 * j;
                        const f32x4 gg = ((const f32x4*)g2)[idx], sh = ((const f32x4*)shift)[idx], sc = ((const f32x4*)scale)[idx];
                        f32x4 y; y.x = v[j].x * rinv * gg.x * (1.f + sc.x) + sh.x; y.y = v[j].y * rinv * gg.y * (1.f + sc.y) + sh.y;
                        y.z = v[j].z * rinv * gg.z * (1.f + sc.z) + sh.z; y.w = v[j].w * rinv * gg.w * (1.f + sc.w) + sh.w;
                        u32x2 h; h.x = pk2(y.x, y.y); h.y = pk2(y.z, y.w);
                        u32x2 lw; lw.x = pk2(y.x - bf2f(h.x & 0xffffu), y.y - bf2f(h.x >> 16)); lw.y = pk2(y.z - bf2f(h.y & 0xffffu), y.w - bf2f(h.y >> 16));
                        { int t8 = __builtin_amdgcn_cvt_pk_fp8_f32(clamp8(y.x * TOK8_SCALE), clamp8(y.y * TOK8_SCALE), 0, false); t8 = __builtin_amdgcn_cvt_pk_fp8_f32(clamp8(y.z * TOK8_SCALE), clamp8(y.w * TOK8_SCALE), t8, true);
                          ((unsigned*)((unsigned char*)Tok + (size_t)row * D))[idx] = (unsigned)t8; }
                        *(u32x2*)(AH + lr * RS + idx * 4) = h; *(u32x2*)(AL + lr * RS + idx * 4) = lw; }
                } else {
#pragma unroll
                    for (int j = 0; j < 4; ++j) { const int idx = lane + 64 * j; const u32x2 z = {0u, 0u}; *(u32x2*)(AH + lr * RS + idx * 4) = z; *(u32x2*)(AL + lr * RS + idx * 4) = z; } } }
            __syncthreads();
            { f32x4 acc[4];
#pragma unroll
              for (int t = 0; t < 4; ++t) acc[t] = (f32x4){0.f, 0.f, 0.f, 0.f};
#pragma unroll
              for (int k = 0; k < 4; ++k) { const int ko = (wid * 4 + k) * 32 + fq * 8;
                  const bf16x8 ah = *(const bf16x8*)(AH + fr * RS + ko), al = *(const bf16x8*)(AL + fr * RS + ko);
#pragma unroll
                  for (int t = 0; t < 4; ++t) { acc[t] = __builtin_amdgcn_mfma_f32_16x16x32_bf16(ah, bh[t][k], acc[t], 0, 0, 0);
                      acc[t] = __builtin_amdgcn_mfma_f32_16x16x32_bf16(ah, bl[t][k], acc[t], 0, 0, 0); acc[t] = __builtin_amdgcn_mfma_f32_16x16x32_bf16(al, bh[t][k], acc[t], 0, 0, 0); } }
#pragma unroll
              for (int t = 0; t < 4; ++t)
#pragma unroll
                  for (int r = 0; r < 4; ++r) PART[(wid * 16 + fq * 4 + r) * 64 + t * 16 + fr] = acc[t][r]; }
            __syncthreads();
#pragma unroll
            for (int q = 0; q < 2; ++q) { const int o = tid + q * NTHREADS; float a = 0.f;
#pragma unroll
                for (int w8 = 0; w8 < 8; ++w8) a += PART[w8 * 1024 + o];
                LOG[o] = a; }
            __syncthreads();
#pragma unroll 1
            for (int j2 = 0; j2 < 2; ++j2) { const int lr = wid * 2 + j2, row = s0 + lr;
                if (row >= r1) continue;
                const int sr = row - base;
                const float score = sigmoid_(LOG[lr * 64 + lane]), sel = score + mybias;
                const int e = lane, g = e >> 3;
                int rg = 0;
#pragma unroll
                for (int i = 1; i < 8; ++i) { const int src = (lane & ~7) | ((lane + i) & 7); const float o = __shfl(sel, src); rg += (o > sel) || (o == sel && src < e); }
                float top2 = (rg < 2) ? sel : 0.f;
                top2 += __shfl_xor(top2, 1); top2 += __shfl_xor(top2, 2); top2 += __shfl_xor(top2, 4);
                int grank = 0;
#pragma unroll
                for (int i = 1; i < 8; ++i) { const int og = (g + i) & 7; const float o = __shfl(top2, og * 8); grank += (o > top2) || (o == top2 && og < g); }
                const bool keep = grank < 4;
                const float ms = keep ? sel : -INFINITY;
                float* mrow = msb + wid * 64;
                mrow[lane] = ms;
                __builtin_amdgcn_wave_barrier();
                int rk = 0;
#pragma unroll 4
                for (int i = 0; i < 16; ++i) { const f32x4 o = *(const f32x4*)(mrow + 4 * i);
                    rk += (o.x > ms) || (o.x == ms && 4 * i + 0 < e); rk += (o.y > ms) || (o.y == ms && 4 * i + 1 < e);
                    rk += (o.z > ms) || (o.z == ms && 4 * i + 2 < e); rk += (o.w > ms) || (o.w == ms && 4 * i + 3 < e); }
                __builtin_amdgcn_wave_barrier();
                const bool chosen = keep && rk < 8;
                const float wsum = wave_sum(chosen ? score : 0.f);
                if (chosen) { const int r = atomicAdd(&hist[e], 1); s_e[sr * 8 + rk] = e; s_r[sr * 8 + rk] = r; s_w[sr * 8 + rk] = score / wsum * 2.5f; } }
        }
        __syncthreads();
        if (tid < 64) { const int h = hist[tid]; hbase[tid] = h ? (int)atomicAdd(&cnt[tid], (unsigned)h) : 0; }
        __syncthreads();
        for (int i = tid; i < (r1 - base) * 8; i += NTHREADS) { const int e = s_e[i]; const size_t o = (size_t)base * 8 + i;
            const int pos = hbase[e] + s_r[i]; tok_e[o] = e; tok_p[o] = pos; expl[(size_t)e * R_ALL + pos] = base + (i >> 3); expw[(size_t)e * R_ALL + pos] = s_w[i]; }
        __syncthreads();
    }
}

__device__ __forceinline__ void moe_pad_starts(KP p, int l, int* ps) {
    const unsigned* cnt = (const unsigned*)(p->ws + WS_CTL) + CW_CNT + l * 64;
    const int tid = tid_();
    if (tid < 64) { const int v = (int)((cnt[tid] + 255u) >> 8) << 8; int incl = v;
#pragma unroll
        for (int d = 1; d < 64; d <<= 1) { const int o = __shfl_up(incl, d); if (tid >= d) incl += o; }
        ps[tid] = incl - v; if (tid == 63) ps[64] = incl; }
    __syncthreads();
}
__device__ __forceinline__ int moe_expert_of_row(const int* ps, int row) { int e = 0; while (e < 63 && row >= ps[e + 1]) ++e; return e; }

__device__ __forceinline__ void ph_slots(KP p, int l, unsigned char* lds) {
    const int T = (l == 0) ? R_ALL : R_LAT;
    int* ps = (int*)lds; moe_pad_starts(p, l, ps);
    const unsigned* cnt = (const unsigned*)(p->ws + WS_CTL) + CW_CNT + l * 64;
    const int* tok_e = (const int*)(p->ws + WS_TOKE); const int* tok_p = (const int*)(p->ws + WS_TOKP); const float* tok_w = (const float*)(p->ws + WS_TOKW);
    int* tok_s = (int*)(p->ws + WS_TOKS); int* slot_t = (int*)(p->ws + WS_SLOTT); float* slot_w = (float*)(p->ws + WS_SLOTW);
    for (int i = bid_() * NTHREADS + tid_(); i < T * 8; i += gsz_() * NTHREADS) { const int e = tok_e[i], slot = ps[e] + tok_p[i]; tok_s[i] = slot; slot_t[slot] = i >> 3; slot_w[slot] = tok_w[i]; }
    for (int i = bid_() * NTHREADS + tid_(); i < T; i += gsz_() * NTHREADS) { slot_t[MAXSLOT + i] = i; slot_w[MAXSLOT + i] = 1.f; }
    for (int i = bid_() * NTHREADS + tid_(); i < 64 * 256; i += gsz_() * NTHREADS) { const int e = i >> 8, j = i & 255; const int r = ps[e] + (int)cnt[e] + j; if (r < ps[e + 1]) { slot_t[r] = 0; slot_w[r] = 0.f; } }
    __syncthreads();
}

__device__ __forceinline__ void ph_gateup(KP p, int l, unsigned char* lds) {
    const int T = (l == 0) ? R_ALL : R_LAT;
    int* ps = (int*)lds; moe_pad_starts(p, l, ps);
    const bf16_t* Tok = (const bf16_t*)(p->ws + Z_A); const bf16_t* Wgu = (const bf16_t*)(p->ws + Z_WGU); bf16_t* H = (bf16_t*)(p->ws + Z_H);
    const int* slot_t = (const int*)(p->ws + WS_SLOTT); const float* slot_w = (const float*)(p->ws + WS_SLOTW);
    const int n128 = ps[64] / 128, nitems = (n128 + T / 128) * 2;
    for (int it = bid_(); it < nitems; it += gsz_()) { const int rt = it >> 1, pn = it & 1;
        if (rt < n128) { const int e = moe_expert_of_row(ps, rt * 128);
            auto epi = [&](int row, int col, float g, float u) { H[(size_t)row * 256 + pn * 128 + col] = (bf16_t)f2bf(silu_(g) * u * slot_w[row]); };
            gemm_simple_tile<2>(Tok, RowGather{slot_t}, Wgu + (size_t)e * 524288, 1024, rt * 128, pn * 256, 128, epi);
        } else { const int t0 = (rt - n128) * 128;
            auto epi = [&](int row, int col, float g, float u) { H[(size_t)(MAXSLOT + row) * 256 + pn * 128 + col] = (bf16_t)f2bf(silu_(g) * u); };
            gemm_simple_tile<2>(Tok, RowId{}, Wgu + (size_t)64 * 524288, 1024, t0, pn * 256, 128, epi); }
    }
}
__device__ __forceinline__ void ph_down(KP p, int l, unsigned char* lds) {
    const int T = (l == 0) ? R_ALL : R_LAT;
    int* ps = (int*)lds; moe_pad_starts(p, l, ps);
    const bf16_t* H = (const bf16_t*)(p->ws + Z_H); const bf16_t* Wd = (const bf16_t*)(p->ws + WS_WD); bf16_t* Y = (bf16_t*)(p->ws + Z_Y); float* X = (float*)(p->ws + WS_X);
    const int n128 = ps[64] / 128, nitems = (n128 + T / 128) * 8;
    for (int it = bid_(); it < nitems; it += gsz_()) { const int rt = it >> 3, nt = it & 7;
        if (rt < n128) { const int e = moe_expert_of_row(ps, rt * 128);
            auto epi = [&](int row, int col, float v, float) { Y[(size_t)row * D + nt * 128 + col] = (bf16_t)f2bf(v); };
            gemm_simple_tile<1>(H, RowId{}, Wd + (size_t)e * 262144, 256, rt * 128, nt * 128, 0, epi);
        } else { const int t0 = (rt - n128) * 128;
            auto epi = [&](int row, int col, float v, float) { const int t = row - MAXSLOT, c = nt * 128 + col; X[(size_t)t * D + c] += mod_vec(p, l, t, 5)[c] * v; };
            gemm_simple_tile<1>(H, RowId{}, Wd + (size_t)64 * 262144, 256, MAXSLOT + t0, nt * 128, 0, epi); }
    }
}
__device__ __forceinline__ void ph_combine(KP p, int l, unsigned char* lds) {
    typedef float f32x2 __attribute__((ext_vector_type(2)));
    const int T = (l == 0) ? R_ALL : R_LAT;
    const int tid = tid_(), lane = tid & 63, wid = tid >> 6;
    const unsigned char* Y8 = (const unsigned char*)(p->ws + Z_Y); bf16_t* X = (bf16_t*)(p->ws + WS_X); const int* tok_e = (const int*)(p->ws + WS_TOKE); const int* tok_p = (const int*)(p->ws + WS_TOKP);
    int* ps = (int*)lds; moe_pad_starts(p, l, ps);
    const size_t yoff = (size_t)(lane >> 4) * MAXSLOT * 256 + (lane & 15) * 16;
    for (int row = bid_() * 8 + wid; row < T; row += gsz_() * 8) {
        const float* g5 = mod_vec(p, l, row, 5) + lane * 16;
        bf16_t* xr = X + (size_t)row * D + lane * 16;
        const int myslot = ps[tok_e[row * 8 + (lane & 7)]] + tok_p[row * 8 + (lane & 7)];
        u32x4 yv[8];
#pragma unroll
        for (int k = 0; k < 8; ++k) { const int sl = __shfl(myslot, k); yv[k] = *(const u32x4*)(Y8 + yoff + (size_t)sl * 256); }
        f32x4 xv[4], gv[4];
#pragma unroll
        for (int q = 0; q < 4; ++q) gv[q] = *(const f32x4*)(g5 + 4 * q);
        unpack8(*(const u32x4*)xr, xv[0], xv[1]); unpack8(*(const u32x4*)(xr + 8), xv[2], xv[3]);
        float a[16];
#pragma unroll
        for (int q = 0; q < 16; ++q) a[q] = 0.f;
#pragma unroll
        for (int k = 0; k < 8; ++k) { const unsigned w[4] = {yv[k].x, yv[k].y, yv[k].z, yv[k].w};
#pragma unroll
            for (int q = 0; q < 4; ++q) { const f32x2 lo = __builtin_amdgcn_cvt_pk_f32_fp8((int)w[q], false), hi = __builtin_amdgcn_cvt_pk_f32_fp8((int)w[q], true);
                a[4 * q] += lo.x; a[4 * q + 1] += lo.y; a[4 * q + 2] += hi.x; a[4 * q + 3] += hi.y; } }
#pragma unroll
        for (int q = 0; q < 4; ++q) { f32x4 av; av.x = a[4 * q]; av.y = a[4 * q + 1]; av.z = a[4 * q + 2]; av.w = a[4 * q + 3]; xv[q] = xv[q] + gv[q] * (av * (1.f / Y8_SCALE)); }
        if (l == DEPTH - 1) { float* dst = p->out + (size_t)row * D + lane * 16;
#pragma unroll
            for (int q = 0; q < 4; ++q) *(f32x4*)(dst + 4 * q) = xv[q]; }
        else { *(u32x4*)xr = (u32x4){pk2(xv[0].x, xv[0].y), pk2(xv[0].z, xv[0].w), pk2(xv[1].x, xv[1].y), pk2(xv[1].z, xv[1].w)};
               *(u32x4*)(xr + 8) = (u32x4){pk2(xv[2].x, xv[2].y), pk2(xv[2].z, xv[2].w), pk2(xv[3].x, xv[3].y), pk2(xv[3].z, xv[3].w)}; }
    }
}
struct MoeSched {
    int ntr, nrt, npn, G, c; const LAS int* tile_e;
    __device__ __forceinline__ bool map(int i, int& rt, int& pp) const {
        if (G == 256) { const int x = c & 7, j = c >> 3, tb = 32 / npn; rt = (i * 8 + x) * tb + j / npn; pp = j % npn; return rt < nrt; }
        const int L = i * G + c; if (L >= nrt * npn) return false;
        rt = L / npn; pp = L % npn; return true; }
    __device__ __forceinline__ bool next(int i, pg8::Unit& u) const {
        int rt, pp; if (!map(i, rt, pp)) return false;
        const bool routed = rt < ntr;
        const int e = routed ? __builtin_amdgcn_readfirstlane(tile_e[rt]) : 64;
        u.pm = routed ? rt : MAXSLOT / 256 + (rt - ntr); u.pn = e * npn + pp; u.ord = i; return true;
    }
};
constexpr int MOE_UNITS = 6;
constexpr int LDS_RTAB = 131072, LDS_WTAB = LDS_RTAB + MOE_UNITS * 1024, LDS_TILE_E = LDS_WTAB + MOE_UNITS * 1024, LDS_PS = LDS_TILE_E + 2400;
static_assert(LDS_PS + 129 * 4 <= LDS_BYTES - 16, "MoE tables fit above the staging buffers");
__device__ __forceinline__ MoeSched moe_setup(KP p, int l, unsigned char* lds, int npn, bool gather) {
    const int T = (l == 0) ? R_ALL : R_LAT;
    int* ps = (int*)(lds + LDS_PS); int* cl = ps + 65;
    const unsigned* cnt = (const unsigned*)(p->ws + WS_CTL) + CW_CNT + l * 64;
    const int tid = tid_();
    if (tid < 64) cl[tid] = (int)cnt[tid];
    moe_pad_starts(p, l, ps);
    LAS int* tile_e = (LAS int*)((LAS unsigned char*)lds + LDS_TILE_E); LAS int* rtab = (LAS int*)((LAS unsigned char*)lds + LDS_RTAB); LAS float* wtab = (LAS float*)((LAS unsigned char*)lds + LDS_WTAB);
    const int ntr = ps[64] / 256;
    for (int rt = tid; rt < ntr; rt += NTHREADS) tile_e[rt] = moe_expert_of_row(ps, rt * 256);
    __syncthreads();
    MoeSched S{ntr, ntr + T / 256, npn, gsz_(), bid_(), tile_e};
    if (gather) { const int* expl = (const int*)(p->ws + WS_EXPL); const float* expw = (const float*)(p->ws + WS_EXPW);
        int tok[3]; float w[3];
#pragma unroll
        for (int q = 0; q < 3; ++q) { const int idx = tid + q * NTHREADS, i = idx >> 8, r = idx & 255; tok[q] = 0; w[q] = 0.f;
            int rt, pp_;
            if (S.map(i, rt, pp_)) {
                if (rt < S.ntr) { const int e = tile_e[rt], pos = rt * 256 + r - ps[e];
                    if (pos < cl[e]) { tok[q] = expl[(size_t)e * R_ALL + pos]; w[q] = expw[(size_t)e * R_ALL + pos]; } }
                else { tok[q] = (rt - S.ntr) * 256 + r; w[q] = 1.f; } } }
#pragma unroll
        for (int q = 0; q < 3; ++q) { const int idx = tid + q * NTHREADS; rtab[idx] = tok[q]; wtab[idx] = w[q]; } }
    __syncthreads();
    return S;
}
__device__ __forceinline__ void ph_gateup_f(KP p, int l, unsigned char* lds) {
    const MoeSched S = moe_setup(p, l, lds, 2, true);
    pg8::Gemm g{(const bf16_t*)(p->ws + Z_A), (const bf16_t*)(p->ws + wgu_off(l)), 0, 0, 1024};
    pg8::EpiGU8 E{(unsigned char*)(p->ws + Z_H), (const LAS float*)((LAS unsigned char*)lds + LDS_WTAB)};
    pg8::gemm_phase<pg8::EpiGU8, MoeSched, true, true>((LAS unsigned char*)lds, g, S, E, (const LAS int*)((LAS unsigned char*)lds + LDS_RTAB));
}
__device__ __forceinline__ void ph_down_f(KP p, int l, unsigned char* lds) {
    const MoeSched S = moe_setup(p, l, lds, 4, false);
    pg8::Gemm g{(const bf16_t*)(p->ws + Z_H), (const bf16_t*)(p->ws + wd_off(l)), 0, 0, 256};
    bf16_t* X = (bf16_t*)(p->ws + WS_X);
    pg8::EpiDown E{(bf16_t*)(p->ws + Z_Y), X, (const float*)(p->ws + WS_MOD) + (size_t)l * 3 * 6144 + 5 * 1024};
    pg8::gemm_phase<pg8::EpiDown, MoeSched, false, true>((LAS unsigned char*)lds, g, S, E, nullptr);
}

#ifndef FAST_ATTN
#define FAST_ATTN 1
#endif
#ifndef FAST_GEMM
#define FAST_GEMM 15
#endif
constexpr int PH_PER_LAYER = 10, N_PHASES = 1 + DEPTH * PH_PER_LAYER;
__global__ void __launch_bounds__(NTHREADS, 2) mega(Params parg) {
    extern __shared__ __attribute__((aligned(16))) unsigned char lds[];
    const int lo = parg.ph_lo, hi = parg.ph_hi;
    volatile LAS unsigned* xbw = (volatile LAS unsigned*)(lds + LDS_BYTES - 16);
    if (threadIdx.x == 0) { xbw[0] = 0u; xbw[1] = 0u; xbw[2] = 0u; xbw[3] = 0u; }
    if ((threadIdx.x & 63) == 0) *(volatile LAS int*)((LAS unsigned char*)lds + LDS_WVTAB_OFF + 4 * hwkey_()) = (int)(threadIdx.x >> 6);
    __syncthreads();
    XcdBarrier bar; bar.bar = (unsigned*)(parg.ws + WS_CTL) + CW_BAR; bar.x = 0; bar.st = xbw;
    if (hi - lo > 1) bar = xcd_barrier_post((unsigned*)(parg.ws + WS_CTL) + CW_BAR, xbw);
#ifdef PHMASK
#define IN(k) ((((PHMASK) >> ((k) == 0 ? 0 : ((k) - 1) % PH_PER_LAYER + 1)) & 1) && lo <= (k) && (k) < hi)
#else
#define IN(k) (lo <= (k) && (k) < hi)
#endif
#define SEAM(k) do { if (IN(k) && IN((k) + 1)) xcd_barrier(bar); } while (0)
    if (IN(0)) { ph_pro(kparams(), lds); } SEAM(0);
#pragma unroll
    for (int l = 0; l < DEPTH; ++l) {
        const int b0 = 1 + l * PH_PER_LAYER;
        if (IN(b0 + 0)) { ph_norm1(kparams(), l, lds); } SEAM(b0 + 0);
        if (IN(b0 + 1)) { ph_inproj_f(kparams(), l, lds); } SEAM(b0 + 1);
        if (IN(b0 + 2)) { ph_prep(kparams(), l, lds); } SEAM(b0 + 2);
        if (IN(b0 + 3)) { ph_attn_f(kparams(), l, lds); } SEAM(b0 + 3);
        if (IN(b0 + 4)) { ph_hgrn3(kparams(), l, lds); } SEAM(b0 + 4);
        if (IN(b0 + 5)) { ph_outproj_f(kparams(), l, lds); } SEAM(b0 + 5);
        if (IN(b0 + 6)) { ph_norm2(kparams(), l, lds); } SEAM(b0 + 6);
        if (IN(b0 + 7)) { ph_gateup_f(kparams(), l, lds); } SEAM(b0 + 7);
        if (IN(b0 + 8)) { ph_down_f(kparams(), l, lds); } SEAM(b0 + 8);
        if (IN(b0 + 9)) { ph_combine(kparams(), l, lds); } SEAM(b0 + 9);
    }
#undef IN
#undef SEAM
}

#ifndef MK_ONE_LAUNCH
#define MK_ONE_LAUNCH 1
#endif
extern "C" void kernel_launch(void* const* d_in, const int* in_sizes, int n_in, void* d_out, int out_size, void* d_ws, size_t ws_size, hipStream_t stream) {
    static int grid = 0;
    if (grid == 0) {
        if (n_in != 31 || ws_size < WS_END2) { fprintf(stderr, "kernel_launch: unexpected n_in %d or ws_size %zu (< %zu)\n", n_in, ws_size, (size_t)WS_END2); grid = -1; return; }
        int dev = 0, cus = 0, per_cu = 0;
        if (hipGetDevice(&dev) != hipSuccess || hipDeviceGetAttribute(&cus, hipDeviceAttributeMultiprocessorCount, dev) != hipSuccess) { grid = -1; return; }
        if (hipFuncSetAttribute((const void*)mega, hipFuncAttributeMaxDynamicSharedMemorySize, LDS_BYTES) != hipSuccess) { fprintf(stderr, "kernel_launch: hipFuncSetAttribute failed\n"); grid = -1; return; }
        if (hipOccupancyMaxActiveBlocksPerMultiprocessor(&per_cu, (const void*)mega, NTHREADS, LDS_BYTES) != hipSuccess || per_cu < 1) fprintf(stderr, "kernel_launch: occupancy query says %d\n", per_cu);
        (void)hipGetLastError();
        grid = cus;
    }
    if (grid < 0) return;
    (void)hipMemsetAsync((char*)d_ws + WS_CTL, 0, CTL_ZERO_BYTES, stream);
    Params p{};
    for (int i = 0; i < 31; ++i) p.in[i] = (const float*)d_in[i];
    p.out = (float*)d_out; p.ws = (unsigned char*)d_ws;
#if MK_ONE_LAUNCH
    p.ph_lo = 0; p.ph_hi = N_PHASES;
    hipLaunchKernelGGL(mega, dim3(grid), dim3(NTHREADS), LDS_BYTES, stream, p);
#else
    for (int k = 0; k < N_PHASES; ++k) { p.ph_lo = k; p.ph_hi = k + 1; hipLaunchKernelGGL(mega, dim3(grid), dim3(NTHREADS), LDS_BYTES, stream, p); }
#endif
}
```

```cpp
#include <hip/hip_runtime.h>
#include <hip/hip_bf16.h>
#include <cmath>
#include <cstdint>
#include <cstdio>

#define LAS __attribute__((address_space(3)))

typedef unsigned short bf16_t;
typedef short bf16x8 __attribute__((ext_vector_type(8)));
typedef float f32x4 __attribute__((ext_vector_type(4)));
typedef unsigned u32x4 __attribute__((ext_vector_type(4)));
typedef unsigned u32x2 __attribute__((ext_vector_type(2)));

constexpr int D = 1024, NB = 2, NSEQ = 8192, NCTX = 256, DEPTH = 2;
constexpr int R_LAT = NB * NSEQ, R_CTX = NB * NCTX, R_ALL = R_LAT + R_CTX;
constexpr int DIN = 2816;
constexpr int NKEY = NSEQ + NCTX;
constexpr int NE = 64, TOPK = 8;
constexpr int MAXSLOT = 151552;
constexpr int HROWS = MAXSLOT + R_ALL;
constexpr int NCHUNK = 132;
constexpr float EPS = 1e-6f;
constexpr float TOK8_SCALE = 8.f, WGU8_SCALE = 256.f, H8_SCALE = 16.f, WD8_SCALE = 128.f;
constexpr float GU_DESCALE = 1.f / (TOK8_SCALE * WGU8_SCALE), DN_DESCALE = 1.f / (H8_SCALE * WD8_SCALE);
constexpr float Y8_SCALE = 32.f;
constexpr float QSCALE = 0.125f * 1.4426950408889634f;
constexpr float LOG2E = 1.4426950408889634f;

#ifndef FAST_HGRN
#define FAST_HGRN 1
#endif
constexpr int C_GQ = 0, C_GK = 256, C_GV = 384, C_WQ = 512, C_WK = 768, C_WV = 896, C_CVV = 1024, C_CVG = 1280, C_RQ = 1536, C_RI = 1792, C_RFF = 2048, C_RFB = 2304, C_RG = 2560;

constexpr size_t MiB = (size_t)1 << 20;
constexpr size_t WS_CTL = 0, CTL_ZERO_BYTES = 64 * 1024;
constexpr size_t WS_MOD = 1 * MiB;
constexpr size_t WS_LB = WS_MOD + 256 * 1024;
constexpr size_t WS_ROPE = WS_MOD + 512 * 1024;
constexpr size_t WS_TOKE = 2 * MiB, WS_TOKP = 3 * MiB, WS_TOKW = 4 * MiB, WS_TOKS = 5 * MiB;
constexpr size_t WS_SLOTT = 6 * MiB, WS_SLOTW = 7 * MiB;
constexpr size_t WS_X = 8 * MiB;
constexpr size_t WS_WD = 74 * MiB;
constexpr size_t WS_Z = 107 * MiB;
constexpr size_t Z_A = WS_Z + 0 * MiB;
constexpr size_t Z_WGU = WS_Z + 33 * MiB;
constexpr size_t Z_WIN = WS_Z + 98 * MiB;
constexpr size_t Z_WOUT = WS_Z + 104 * MiB;
constexpr size_t Z_WPW = WS_Z + 106 * MiB;
__host__ __device__ constexpr size_t wgu_off(int l) { return WS_Z + 33 * MiB + (size_t)l * 34078720; }
__host__ __device__ constexpr size_t wd_off(int l) { return 74 * MiB + (size_t)l * 17039360; }
__host__ __device__ constexpr size_t win_off(int l) { return l == 0 ? WS_Z + 98 * MiB : WS_Z + (302 + 42) * MiB; }
__host__ __device__ constexpr size_t wout_off(int l) { return l == 0 ? WS_Z + 104 * MiB : WS_Z + (302 + 48) * MiB; }
__host__ __device__ constexpr size_t wpw_off(int l) { return l == 0 ? WS_Z + 106 * MiB : WS_Z + (302 + 51) * MiB; }
constexpr size_t Z_P = WS_Z + 107 * MiB;
constexpr size_t Z_YCAT = WS_Z + 198 * MiB;
constexpr size_t Z_QG = WS_Z + 231 * MiB, Z_QW = WS_Z + 239 * MiB;
constexpr size_t Z_KG = WS_Z + 247 * MiB, Z_VG = WS_Z + 252 * MiB, Z_KW = WS_Z + 257 * MiB, Z_VW = WS_Z + 262 * MiB;
constexpr size_t Z_QGC = WS_Z + 267 * MiB, Z_QWC = Z_QGC + 512 * 1024;
constexpr size_t Z_U = WS_Z + 268 * MiB;
constexpr size_t Z_G = WS_Z + 301 * MiB;
constexpr size_t Z_Y = WS_Z + 107 * MiB;
constexpr size_t Z_H = WS_Z + 302 * MiB;
constexpr size_t WS_END = WS_Z + 385 * MiB;
constexpr size_t WS_EXPL = WS_END, WS_EXPW = WS_END + 5 * MiB, WS_END2 = WS_END + 10 * MiB;
static_assert(Z_H + (size_t)HROWS * 512 <= WS_END, "H fits");
static_assert(Z_Y + (size_t)MAXSLOT * 1024 <= Z_U, "Y8 below the HGRN state buffers");
static_assert(Z_P + (size_t)R_ALL * DIN * 2 <= Z_YCAT, "P fits");

constexpr int CW_BAR = 0;
constexpr int CW_CNT = 4096;

constexpr int LDS_BYTES = 147456;
constexpr int NTHREADS = 512;

struct Params {
    const float* in[31];
    float* out;
    unsigned char* ws;
    int ph_lo, ph_hi;
};

typedef const __attribute__((address_space(4))) Params* KP;
__device__ __forceinline__ KP kparams() { KP k = (KP)__builtin_amdgcn_kernarg_segment_ptr(); asm volatile("" : "+s"(k)); return k; }

constexpr int LDS_WVTAB_OFF = 147456 - 16 - 256;
__device__ __forceinline__ int hwkey_() { return (int)__builtin_amdgcn_s_getreg((5 << 11) | 4) & 63; }
__device__ __forceinline__ int tid_() { extern __shared__ __attribute__((aligned(16))) unsigned char lds_all[];
    const int w = __builtin_amdgcn_readfirstlane(*(const LAS int*)((LAS unsigned char*)lds_all + LDS_WVTAB_OFF + 4 * hwkey_()));
    unsigned z; asm volatile("v_mov_b32 %0, 0" : "=v"(z));
    int t = (w << 6) | (int)__builtin_amdgcn_mbcnt_hi(~0u, __builtin_amdgcn_mbcnt_lo(~0u, z)); asm volatile("" : "+v"(t)); return t; }
__device__ __forceinline__ int bid_() { int b = blockIdx.x; asm volatile("" : "+s"(b)); return b; }
__device__ __forceinline__ int gsz_() { int g = gridDim.x; asm volatile("" : "+s"(g)); return g; }

__device__ __forceinline__ unsigned f2bf(float f) { unsigned u = __float_as_uint(f); return (u + 0x7fffu + ((u >> 16) & 1u)) >> 16; }
__device__ __forceinline__ float bf2f(unsigned h) { return __uint_as_float(h << 16); }
__device__ __forceinline__ unsigned pk2(float lo, float hi) { unsigned r; asm("v_cvt_pk_bf16_f32 %0, %1, %2" : "=v"(r) : "v"(lo), "v"(hi)); return r; }
__device__ __forceinline__ void unpack8(const u32x4 r, f32x4& lo, f32x4& hi) { lo.x = bf2f(r.x & 0xffffu); lo.y = bf2f(r.x >> 16); lo.z = bf2f(r.y & 0xffffu); lo.w = bf2f(r.y >> 16); hi.x = bf2f(r.z & 0xffffu); hi.y = bf2f(r.z >> 16); hi.z = bf2f(r.w & 0xffffu); hi.w = bf2f(r.w >> 16); }
__device__ __forceinline__ float wave_sum(float v) {
#pragma unroll
    for (int o = 1; o < 64; o <<= 1) v += __shfl_xor(v, o);
    return v;
}
__device__ __forceinline__ float clamp8(float v) { return fminf(fmaxf(v, -440.f), 440.f); }
__device__ __forceinline__ float sigmoid_(float x) { return __builtin_amdgcn_rcpf(1.f + __expf(-x)); }
__device__ __forceinline__ float silu_(float x) { return x * sigmoid_(x); }

__device__ __forceinline__ const float* xrow_src(KP p, int l, int row) {
    if (l == 0) return (row < R_LAT) ? p->in[0] + (size_t)row * D : p->in[2] + (size_t)(row - R_LAT) * D;
    return (const float*)(p->ws + WS_X) + (size_t)row * D;
}
__device__ __forceinline__ const float* mod_vec(KP p, int l, int row, int i) {
    const int r = (row < R_LAT) ? (row >> 13) : 2;
    return (const float*)(p->ws + WS_MOD) + ((size_t)l * 3 + r) * 6144 + i * 1024;
}

#define XB_TMO      128
#define XB_XCNT(j)  (256  + 64 * (j))
#define XB_XSUB(j)  (1280 + 64 * (j))
#define XB_XGEN(j)  (2304 + 64 * (j))
#define XB_TOP      3328
#define XB_TOPGEN   3392
#define XCD_BAR_WORDS 3456
#define XB_SPIN_CAP (1u << 18)
__device__ __forceinline__ unsigned xb_ld(unsigned* p)              { return __hip_atomic_load(p, __ATOMIC_RELAXED, __HIP_MEMORY_SCOPE_AGENT); }
__device__ __forceinline__ unsigned xb_add(unsigned* p, unsigned v) { return __hip_atomic_fetch_add(p, v, __ATOMIC_RELAXED, __HIP_MEMORY_SCOPE_AGENT); }
__device__ __forceinline__ unsigned xb_xcc_id() { return (unsigned)__builtin_amdgcn_s_getreg((3 << 11) | 20) & 0xFu; }
#define XB_SPIN(cond, bar) do { unsigned _sp = 0; while (cond) { __builtin_amdgcn_s_sleep(1); \
    if ((++_sp & 255u) == 0u) { if (xb_ld(&(bar)[XB_TMO])) break; if (_sp > XB_SPIN_CAP) { atomicAdd(&(bar)[XB_TMO], 1u); break; } } } } while (0)
struct XcdBarrier { unsigned* bar; unsigned x; volatile LAS unsigned* st; };
__device__ __forceinline__ XcdBarrier xcd_barrier_post(unsigned* bar, volatile LAS unsigned* st) {
    XcdBarrier b; b.bar = bar; b.x = xb_xcc_id(); b.st = st;
    if (tid_() == 0) (void)xb_add(&bar[XB_XCNT(b.x)], 1u);
    return b;
}
__device__ __forceinline__ void xcd_barrier_complete(unsigned* bar, unsigned x, unsigned& nloc, unsigned& nx) {
    const unsigned G = gridDim.x * gridDim.y * gridDim.z;
    unsigned sum, cnt, mine, sp = 0u;
    for (;;) {
        sum = 0u; cnt = 0u; mine = 0u;
#pragma unroll
        for (unsigned j = 0; j < 16; ++j) { const unsigned c = xb_ld(&bar[XB_XCNT(j)]); sum += c; cnt += (c > 0u) ? 1u : 0u; mine = (j == x) ? c : mine; }
        if (sum == G) break;
        __builtin_amdgcn_s_sleep(1);
        if ((++sp & 255u) == 0u) { if (xb_ld(&bar[XB_TMO])) break; if (sp > XB_SPIN_CAP) { atomicAdd(&bar[XB_TMO], 1u); break; } }
    }
    nloc = mine > 0u ? mine : 1u; nx = cnt > 0u ? cnt : 1u;
}
__device__ __forceinline__ void xcd_barrier(const XcdBarrier& b) {
    asm volatile("s_waitcnt vmcnt(0)" ::: "memory");
    __syncthreads();
    if (tid_() == 0) {
        unsigned* bar = b.bar;
        __builtin_amdgcn_s_waitcnt(0);
        unsigned nloc = b.st[0], nx = b.st[1];
        if (nloc == 0u) { xcd_barrier_complete(bar, b.x, nloc, nx); b.st[0] = nloc; b.st[1] = nx; }
        const unsigned old = xb_add(&bar[XB_XSUB(b.x)], 1u);
        const unsigned gen = old / nloc;
        if (old + 1u == (gen + 1u) * nloc) {
            __builtin_amdgcn_fence(__ATOMIC_RELEASE, "agent");
            asm volatile("s_waitcnt vmcnt(0)" ::: "memory");
            const unsigned og = xb_add(&bar[XB_TOP], 1u);
            const unsigned tg = og / nx;
            if (og + 1u == (tg + 1u) * nx) xb_add(&bar[XB_TOPGEN], 1u);
            else XB_SPIN(xb_ld(&bar[XB_TOPGEN]) == tg, bar);
            __builtin_amdgcn_fence(__ATOMIC_ACQUIRE, "agent");
            xb_add(&bar[XB_XGEN(b.x)], 1u);
            asm volatile("s_waitcnt vmcnt(0)" ::: "memory");
        } else {
            XB_SPIN(xb_ld(&bar[XB_XGEN(b.x)]) == gen, bar);
            __builtin_amdgcn_fence(__ATOMIC_ACQUIRE, "agent");
            asm volatile("s_waitcnt vmcnt(0)" ::: "memory");
        }
    }
    __syncthreads();
}

__device__ __forceinline__ void ph_pro(KP p, unsigned char* lds) {
    float* sc = (float*)lds;
    float* red = sc + 3 * 1024;
    const int tid = tid_(), lane = tid & 63, wid = tid >> 6;
    for (int i = tid; i < 3 * 1024; i += NTHREADS) { const int r = i >> 10, k = i & 1023; const float v = (r < 2) ? p->in[1][r * 1024 + k] : p->in[3][k]; sc[i] = silu_(v); }
    __syncthreads();
    float* mod = (float*)(p->ws + WS_MOD);
    for (int item = bid_(); item < DEPTH * 96; item += gsz_()) {
        const int l = item / 96, j0 = (item % 96) * 64;
        const float* w = p->in[4] + (size_t)l * 1024 * 6144;
        float a0 = 0.f, a1 = 0.f, a2 = 0.f;
        const int k0 = wid * 128;
#pragma unroll 1
        for (int k = k0; k < k0 + 128; k += 16) { float wv[16];
#pragma unroll
            for (int u = 0; u < 16; ++u) wv[u] = w[(size_t)(k + u) * 6144 + j0 + lane];
#pragma unroll
            for (int u = 0; u < 16; ++u) { a0 += sc[k + u] * wv[u]; a1 += sc[1024 + k + u] * wv[u]; a2 += sc[2048 + k + u] * wv[u]; } }
        red[(wid * 3 + 0) * 64 + lane] = a0; red[(wid * 3 + 1) * 64 + lane] = a1; red[(wid * 3 + 2) * 64 + lane] = a2;
        __syncthreads();
        if (tid < 192) { const int r = tid >> 6; float s = 0.f;
            for (int w8 = 0; w8 < 8; ++w8) s += red[(w8 * 3 + r) * 64 + lane];
            mod[((size_t)l * 3 + r) * 6144 + j0 + lane] = s + p->in[5][l * 6144 + j0 + lane]; }
        __syncthreads();
    }
    if (bid_() == 0) {
        float* rt = (float*)(p->ws + WS_ROPE);
        for (int i = tid; i < 128 * 16; i += NTHREADS) { const int pos = i >> 4, f = i & 15; const float inv = powf(10000.f, -(float)f * (1.f / 16.f)); float sn, cs; sincosf((float)pos * inv, &sn, &cs);
            rt[pos * 32 + f] = cs; rt[pos * 32 + 16 + f] = sn; }
    }
    if (bid_() == gsz_() - 1) {
        float* lb = (float*)(p->ws + WS_LB);
        for (int i = tid; i < 2 * 2 * 256; i += NTHREADS) { const int l = i >> 9, dir = (i >> 8) & 1, ch = i & 255;
            const float* lg = p->in[21];
            const float l0 = lg[(dir * 2 + 0) * 256 + ch], l1 = lg[(dir * 2 + 1) * 256 + ch]; const float m = fmaxf(l0, l1);
            const float e0 = expf(l0 - m), e1 = expf(l1 - m);
            lb[i] = (l == 0) ? 0.f : e1 / (e0 + e1); }
    }
}

constexpr int CVT_E1 = 1050, CVT_E2 = 2850;
struct CvtTile { const float* src; bf16_t* dst; int K, N, k0, n0, blk, bstride, boff; float f8scale; int perm; };
__device__ __forceinline__ int cvt_total() { return 16 * 44 + 16 * 16 + 4 * 4 + 2 * (64 * 64) + 2 * 64 + 64 * 64 + 64; }
__device__ __forceinline__ CvtTile cvt_decode(KP p, int l, int g) {
    bf16_t* Wgu = (bf16_t*)(p->ws + wgu_off(l)); bf16_t* Wd = (bf16_t*)(p->ws + wd_off(l));
    CvtTile t; int per, tn, r;
    if (g < 704) { r = g; t = {p->in[8] + (size_t)l * 1024 * DIN, (bf16_t*)(p->ws + win_off(l)), 1024, DIN, 0, 0, DIN, 0, 0, 0.f}; tn = 44; per = 704; }
    else if ((g -= 704) < 256) { r = g; t = {p->in[9] + (size_t)l * 1024 * 1024, (bf16_t*)(p->ws + wout_off(l)), 1024, 1024, 0, 0, 1024, 0, 0, 0.f}; tn = 16; per = 256; }
    else if ((g -= 256) < 16) { r = g; t = {p->in[19] + (size_t)l * 65536, (bf16_t*)(p->ws + wpw_off(l)), 256, 256, 0, 0, 256, 0, 0, 0.f}; tn = 4; per = 16; }
    else if ((g -= 16) < 4096) { const int m = g >> 6; r = g & 63; t = {p->in[25] + ((size_t)l * 64 + m) * 262144, (bf16_t*)((unsigned char*)Wgu + (size_t)m * 524288), 1024, 256, 0, 0, 128, 256, 0, WGU8_SCALE}; tn = 4; per = 64; }
    else if ((g -= 4096) < 4096) { const int m = g >> 6; r = g & 63; t = {p->in[26] + ((size_t)l * 64 + m) * 262144, (bf16_t*)((unsigned char*)Wgu + (size_t)m * 524288), 1024, 256, 0, 0, 128, 256, 128, WGU8_SCALE}; tn = 4; per = 64; }
    else if ((g -= 4096) < 64) { r = g; t = {p->in[28] + (size_t)l * 262144, (bf16_t*)((unsigned char*)Wgu + (size_t)64 * 524288), 1024, 256, 0, 0, 128, 256, 0, WGU8_SCALE}; tn = 4; per = 64; }
    else if ((g -= 64) < 64) { r = g; t = {p->in[29] + (size_t)l * 262144, (bf16_t*)((unsigned char*)Wgu + (size_t)64 * 524288), 1024, 256, 0, 0, 128, 256, 128, WGU8_SCALE}; tn = 4; per = 64; }
    else if ((g -= 64) < 4096) { const int m = g >> 6; r = g & 63; t = {p->in[27] + ((size_t)l * 64 + m) * 262144, (bf16_t*)((unsigned char*)Wd + (size_t)m * 262144), 256, 1024, 0, 0, 1024, 0, 0, WD8_SCALE, 1}; tn = 16; per = 64; }
    else { g -= 4096; r = g; t = {p->in[30] + (size_t)l * 262144, (bf16_t*)((unsigned char*)Wd + (size_t)64 * 262144), 256, 1024, 0, 0, 1024, 0, 0, WD8_SCALE, 1}; tn = 16; per = 64; }
    (void)per; t.k0 = (r / tn) * 64; t.n0 = (r % tn) * 64; return t;
}
__device__ __forceinline__ void ph_cvt(KP p, int l, unsigned char* lds, int first = 0, int nwg = 0, int t0 = 0, int t1 = 1 << 30) {
    float* tb = (float*)lds;
    const int tid = tid_(), G = nwg ? nwg : gsz_(), total = t1 < cvt_total() ? t1 : cvt_total();
    const int r0 = tid >> 4, c0 = (tid & 15) * 4, nn = tid >> 3, kc = (tid & 7) * 8;
    int g = bid_() - first, buf = 0;
    if (g < 0) return;
    g += t0;
    if (g >= total) return;
    CvtTile T = cvt_decode(p, l, g);
    f32x4 v0 = *(const f32x4*)(T.src + (size_t)(T.k0 + r0) * T.N + T.n0 + c0), v1 = *(const f32x4*)(T.src + (size_t)(T.k0 + r0 + 32) * T.N + T.n0 + c0);
    for (;;) {
        float* t = tb + buf * (64 * 65);
        t[r0 * 65 + c0] = v0.x; t[r0 * 65 + c0 + 1] = v0.y; t[r0 * 65 + c0 + 2] = v0.z; t[r0 * 65 + c0 + 3] = v0.w;
        t[(r0 + 32) * 65 + c0] = v1.x; t[(r0 + 32) * 65 + c0 + 1] = v1.y; t[(r0 + 32) * 65 + c0 + 2] = v1.z; t[(r0 + 32) * 65 + c0 + 3] = v1.w;
        const CvtTile C = T; const int gn = g + G; const bool more = gn < total;
        if (more) { T = cvt_decode(p, l, gn);
            v0 = *(const f32x4*)(T.src + (size_t)(T.k0 + r0) * T.N + T.n0 + c0); v1 = *(const f32x4*)(T.src + (size_t)(T.k0 + r0 + 32) * T.N + T.n0 + c0); }
        __syncthreads();
        { const int n = C.n0 + nn; int drow = (n / C.blk) * C.bstride + C.boff + (n % C.blk);
          if (C.perm) drow = (n & ~255) + ((n >> 3) & 1) * 128 + ((n >> 6) & 3) * 32 + ((n >> 4) & 3) * 8 + (n & 7);
          if (C.f8scale != 0.f) { const float sc = C.f8scale;
              int w0 = __builtin_amdgcn_cvt_pk_fp8_f32(clamp8(t[(kc + 0) * 65 + nn] * sc), clamp8(t[(kc + 1) * 65 + nn] * sc), 0, false); w0 = __builtin_amdgcn_cvt_pk_fp8_f32(clamp8(t[(kc + 2) * 65 + nn] * sc), clamp8(t[(kc + 3) * 65 + nn] * sc), w0, true);
              int w1 = __builtin_amdgcn_cvt_pk_fp8_f32(clamp8(t[(kc + 4) * 65 + nn] * sc), clamp8(t[(kc + 5) * 65 + nn] * sc), 0, false); w1 = __builtin_amdgcn_cvt_pk_fp8_f32(clamp8(t[(kc + 6) * 65 + nn] * sc), clamp8(t[(kc + 7) * 65 + nn] * sc), w1, true);
              u32x2 o8; o8.x = (unsigned)w0; o8.y = (unsigned)w1;
              *(u32x2*)((unsigned char*)C.dst + (size_t)drow * C.K + C.k0 + kc) = o8;
          } else {
          u32x4 o; o.x = pk2(t[(kc + 0) * 65 + nn], t[(kc + 1) * 65 + nn]); o.y = pk2(t[(kc + 2) * 65 + nn], t[(kc + 3) * 65 + nn]);
          o.z = pk2(t[(kc + 4) * 65 + nn], t[(kc + 5) * 65 + nn]); o.w = pk2(t[(kc + 6) * 65 + nn], t[(kc + 7) * 65 + nn]);
          *(u32x4*)(C.dst + (size_t)drow * C.K + C.k0 + kc) = o; } }
        if (!more) break;
        g = gn; buf ^= 1;
    }
    __syncthreads();
}
__device__ __forceinline__ void norm_mod_row(const float* xrow, const float* g, const float* shift, const float* scale, bf16_t* orow, float* fout, int lane) {
    f32x4 v[4]; float s = 0.f;
#pragma unroll
    for (int j = 0; j < 4; ++j) { v[j] = ((const f32x4*)xrow)[lane + 64 * j]; s += v[j].x * v[j].x + v[j].y * v[j].y + v[j].z * v[j].z + v[j].w * v[j].w; }
    const float rinv = rsqrtf(wave_sum(s) * (1.f / D) + EPS);
#pragma unroll
    for (int j = 0; j < 4; ++j) { const int idx = lane + 64 * j;
        const f32x4 gg = ((const f32x4*)g)[idx], sh = ((const f32x4*)shift)[idx], sc = ((const f32x4*)scale)[idx];
        f32x4 y; y.x = v[j].x * rinv * gg.x * (1.f + sc.x) + sh.x; y.y = v[j].y * rinv * gg.y * (1.f + sc.y) + sh.y;
        y.z = v[j].z * rinv * gg.z * (1.f + sc.z) + sh.z; y.w = v[j].w * rinv * gg.w * (1.f + sc.w) + sh.w;
        u32x2 o; o.x = pk2(y.x, y.y); o.y = pk2(y.z, y.w);
        ((u32x2*)orow)[idx] = o;
        if (fout) ((f32x4*)fout)[idx] = y; }
}
__device__ __forceinline__ void ph_norm1(KP p, int l, unsigned char* lds) {
    if (l == 0) ph_cvt(p, l, lds);
    const int tid = tid_(), lane = tid & 63, wid = tid >> 6;
    bf16_t* A = (bf16_t*)(p->ws + Z_A);
    const float* g = p->in[6] + l * D;
    if (l == 0) { for (int row = bid_() * 8 + wid; row < R_ALL; row += gsz_() * 8)
        norm_mod_row(xrow_src(p, l, row), g, mod_vec(p, l, row, 0), mod_vec(p, l, row, 1), A + (size_t)row * D, nullptr, lane); }
    else { const bf16_t* X = (const bf16_t*)(p->ws + WS_X);
        for (int row = bid_() * 8 + wid; row < R_ALL; row += gsz_() * 8) {
            const float* shift = mod_vec(p, l, row, 0); const float* scale = mod_vec(p, l, row, 1);
            f32x4 v[4]; unpack8(*(const u32x4*)(X + (size_t)row * D + lane * 8), v[0], v[1]); unpack8(*(const u32x4*)(X + (size_t)row * D + 512 + lane * 8), v[2], v[3]);
            float ss = 0.f;
#pragma unroll
            for (int j = 0; j < 4; ++j) ss += v[j].x * v[j].x + v[j].y * v[j].y + v[j].z * v[j].z + v[j].w * v[j].w;
            const float rinv = rsqrtf(wave_sum(ss) * (1.f / D) + EPS);
#pragma unroll
            for (int h = 0; h < 2; ++h) { const int c0 = h * 512 + lane * 8; unsigned o[4];
#pragma unroll
                for (int q = 0; q < 2; ++q) { const f32x4 gg = *(const f32x4*)(g + c0 + 4 * q), sh = *(const f32x4*)(shift + c0 + 4 * q), sc = *(const f32x4*)(scale + c0 + 4 * q);
                    const f32x4 y = v[2 * h + q] * rinv * gg * (sc + 1.f) + sh; o[2 * q] = pk2(y.x, y.y); o[2 * q + 1] = pk2(y.z, y.w); }
                *(u32x4*)(A + (size_t)row * D + c0) = (u32x4){o[0], o[1], o[2], o[3]}; } } }
}

template <int NBJ, class ARow, class Epi>
__device__ __forceinline__ void gemm_simple_tile(const bf16_t* A, const ARow& arow, const bf16_t* Bt, int K, int row0, int colb0, int bjstride, const Epi& epi) {
    const int tid = tid_(), lane = tid & 63, wid = tid >> 6, wr = wid >> 1, wc = wid & 1, fr = lane & 15, fq = lane >> 4;
    f32x4 acc[2][NBJ][4];
#pragma unroll
    for (int i = 0; i < 2; ++i)
#pragma unroll
        for (int b = 0; b < NBJ; ++b)
#pragma unroll
            for (int j = 0; j < 4; ++j) acc[i][b][j] = (f32x4){0.f, 0.f, 0.f, 0.f};
    const bf16_t* ap[2];
#pragma unroll
    for (int i = 0; i < 2; ++i) ap[i] = A + (size_t)arow(row0 + wr * 32 + i * 16 + fr) * K + fq * 8;
    const bf16_t* bp = Bt + (size_t)(colb0 + wc * 64 + fr) * K + fq * 8;
    for (int k = 0; k < K; k += 32) {
        bf16x8 a[2];
#pragma unroll
        for (int i = 0; i < 2; ++i) a[i] = *(const bf16x8*)(ap[i] + k);
#pragma unroll
        for (int b = 0; b < NBJ; ++b)
#pragma unroll
            for (int j = 0; j < 4; ++j) { const bf16x8 bv = *(const bf16x8*)(bp + (size_t)(b * bjstride + j * 16) * K + k);
#pragma unroll
                for (int i = 0; i < 2; ++i) acc[i][b][j] = __builtin_amdgcn_mfma_f32_16x16x32_bf16(a[i], bv, acc[i][b][j], 0, 0, 0); }
    }
#pragma unroll
    for (int i = 0; i < 2; ++i)
#pragma unroll
        for (int j = 0; j < 4; ++j)
#pragma unroll
            for (int r = 0; r < 4; ++r) { const int row = row0 + wr * 32 + i * 16 + fq * 4 + r, col = wc * 64 + j * 16 + fr;
                epi(row, col, acc[i][0][j][r], acc[i][NBJ - 1][j][r]); }
}
struct RowId { __device__ __forceinline__ int operator()(int r) const { return r; } };
struct RowGather { const int* idx; __device__ __forceinline__ int operator()(int r) const { return idx[r]; } };

__device__ __forceinline__ void ph_inproj(KP p, int l, unsigned char* lds) {
    const bf16_t* A = (const bf16_t*)(p->ws + Z_A); const bf16_t* Bt = (const bf16_t*)(p->ws + Z_WIN); bf16_t* P = (bf16_t*)(p->ws + Z_P);
    constexpr int TM = R_ALL / 128, TN = DIN / 128;
    for (int it = bid_(); it < TM * TN; it += gsz_()) { const int mt = it / TN, nt = it % TN;
        auto epi = [&](int row, int col, float v, float) { P[(size_t)row * DIN + nt * 128 + col] = (bf16_t)f2bf(v); };
        gemm_simple_tile<1>(A, RowId{}, Bt, 1024, mt * 128, nt * 128, 0, epi); }
}

namespace pg8 {
constexpr int BM = 256, BK = 64, HALF = 128, HTB = HALF * BK * 2, STAGE_BYTES = 8 * HTB, NXCD = 8, WGM = 8;
__host__ __device__ __forceinline__ int lds_byte(int r, int c) { const int st = (r >> 4) * 2 + (c >> 5), rr = r & 15, cc = c & 31, ob = rr * 64 + cc * 2; return st * 1024 + (ob ^ (((ob >> 9) & 1) << 5)); }
__host__ __device__ __forceinline__ void stage_rc(int b, int& R, int& C) { const int st = b / 1024, sb = b % 1024, swz = sb ^ (((sb >> 9) & 1) << 5); R = (st >> 1) * 16 + swz / 64; C = (st & 1) * 32 + (swz % 64) / 2; }
__host__ __device__ __forceinline__ int perm32(int rho) { const int n = rho >> 4, i = rho & 15; return 8 * (i >> 2) + 4 * n + (i & 3); }
struct Unit { int pm, pn, ord; };
struct Gemm { const bf16_t* A; const bf16_t* Bt; int M, N, K; };
struct StaticOrder {
    int nM, nN, nwg, G, c;
    __host__ __device__ void init(int M, int N, int G_, int c_) { nM = M / BM; nN = N / BM; nwg = nM * nN; G = G_; c = c_; }
    __host__ __device__ bool next(int i, Unit& u) const {
        const long L = (long)i * G + c; if (L >= nwg) return false;
        int wgid = (int)L; { const int q = nwg / NXCD, r = nwg % NXCD, xcd = wgid % NXCD, off = wgid / NXCD; wgid = (xcd < r ? xcd * (q + 1) : r * (q + 1) + (xcd - r) * q) + off; }
        const int nig = WGM * nN, gid = wgid / nig, fm = gid * WGM, gsz = (nM - fm) < WGM ? (nM - fm) : WGM;
        u.pm = fm + ((wgid % nig) % gsz); u.pn = (wgid % nig) / gsz; u.ord = i; return true;
    }
};
__device__ __forceinline__ unsigned cvt_pk_bf16(float lo, float hi) { unsigned r; asm volatile("v_cvt_pk_bf16_f32 %0, %1, %2" : "=v"(r) : "v"(lo), "v"(hi)); return r; }

typedef int i32x4v __attribute__((ext_vector_type(4)));
typedef int i32x8v __attribute__((ext_vector_type(8)));
__device__ __forceinline__ i32x8v cat8(bf16x8 lo, bf16x8 hi) { const i32x4v a = __builtin_bit_cast(i32x4v, lo), b = __builtin_bit_cast(i32x4v, hi); return __builtin_shufflevector(a, b, 0, 1, 2, 3, 4, 5, 6, 7); }
__device__ __forceinline__ void glds16_s(const void* sbase, unsigned voff, unsigned lds_dst) { unsigned keep;
    asm volatile("s_mov_b32 %0, m0\n\ts_mov_b32 m0, %3\n\ts_nop 0\n\tglobal_load_lds_dwordx4 %1, %2\n\ts_mov_b32 m0, %0" : "=&s"(keep) : "v"(voff), "s"(sbase), "s"(lds_dst) : "memory"); }
template <class Epi, class Sched, bool GATHER, bool FP8 = false>
__device__ __forceinline__ void gemm_phase(LAS unsigned char* lds, const Gemm g, const Sched& S, const Epi& E, const LAS int* rtab) {
    const int tid = tid_(), wid = __builtin_amdgcn_readfirstlane(tid >> 6), lane = tid & 63, wr = wid >> 2, wc = wid & 3, fr = lane & 15, fq = lane >> 4;
    const int KB = FP8 ? g.K : g.K * 2, nt = KB / 128;
    unsigned voffA[2], voffB[2]; int RA[2], CA[2];
#pragma unroll
    for (int i = 0; i < 2; ++i) { int R, C; stage_rc(tid * 16 + i * 8192, R, C); const int Rb = (R & ~31) + perm32(R & 31);
        voffA[i] = (unsigned)(R * KB + C * 2); voffB[i] = (unsigned)(Rb * KB + C * 2); RA[i] = R; CA[i] = C; }
    unsigned rcpk = 0; if constexpr (GATHER) { rcpk = (unsigned)(RA[0] * 4) | ((unsigned)(CA[0] * 2) << 16); asm volatile("" : "+v"(rcpk)); }
    const size_t kstep = (size_t)128;
    const size_t hstep = (size_t)HALF * KB;
    const size_t hstepA = GATHER ? 0 : hstep;
    const size_t tstep = 2 * hstep;
    const unsigned ldsw = (unsigned)wid * 1024u;
    const unsigned ldsb = (unsigned)__builtin_amdgcn_readfirstlane((int)((unsigned)(size_t)lds + ldsw));
    const int aoff = lds_byte(wr * 64 + fr, fq * 8), boff = lds_byte(wc * 32 + fr, fq * 8);
#define PG8_SA(b, h) (((b) * 2 + (h)) * HTB)
#define PG8_SB(b, h) ((4 + (b) * 2 + (h)) * HTB)
#define PG8_STAGE(bufoff, gbase, voff) do { _Pragma("unroll") for (int _i = 0; _i < 2; ++_i) { if constexpr (FP8) glds16_s((const void*)(gbase), (voff)[_i], ldsb + (unsigned)((bufoff) + _i * 8192)); \
        else __builtin_amdgcn_global_load_lds((const unsigned*)((const char*)(gbase) + (voff)[_i]), (LAS unsigned*)(lds + (bufoff) + ldsw + _i * 8192), 16, 0, 0); } } while (0)
#define PG8_STAGE1(bufoff, gbase, v0) do {   \
        glds16_s((const void*)(gbase), (v0), ldsb + (unsigned)(bufoff)); glds16_s((const void*)((const char*)(gbase) + (size_t)64 * KB), (v0), ldsb + (unsigned)((bufoff) + 8192)); } while (0)
#define PG8_LDA(dst, b, h) do { _Pragma("unroll") for (int m = 0; m < 4; ++m) { if constexpr (FP8) dst##8[m] = cat8(*(const LAS bf16x8*)(lds + PG8_SA(b, h) + aoff + m * 2048), *(const LAS bf16x8*)(lds + PG8_SA(b, h) + aoff + m * 2048 + 1024)); \
        else { _Pragma("unroll") for (int k = 0; k < 2; ++k) dst[m][k] = *(const LAS bf16x8*)(lds + PG8_SA(b, h) + aoff + m * 2048 + k * 1024); } } } while (0)
#define PG8_LDB(dst, b, h) do { _Pragma("unroll") for (int n = 0; n < 2; ++n) { if constexpr (FP8) dst##8[n] = cat8(*(const LAS bf16x8*)(lds + PG8_SB(b, h) + boff + n * 2048), *(const LAS bf16x8*)(lds + PG8_SB(b, h) + boff + n * 2048 + 1024)); \
        else { _Pragma("unroll") for (int k = 0; k < 2; ++k) dst[n][k] = *(const LAS bf16x8*)(lds + PG8_SB(b, h) + boff + n * 2048 + k * 1024); } } } while (0)
#define PG8_MMA(ai, bj, At, Bt) do { __builtin_amdgcn_s_setprio(1); _Pragma("unroll") for (int m = 0; m < 4; ++m) _Pragma("unroll") for (int n = 0; n < 2; ++n) { \
        if constexpr (FP8) acc[ai][bj][m][n] = __builtin_amdgcn_mfma_scale_f32_16x16x128_f8f6f4(Bt##8[n], At##8[m], acc[ai][bj][m][n], 0, 0, 0, 0x7F7F7F7F, 0, 0x7F7F7F7F); \
        else { _Pragma("unroll") for (int k = 0; k < 2; ++k) acc[ai][bj][m][n] = __builtin_amdgcn_mfma_f32_16x16x32_bf16(Bt[n][k], At[m][k], acc[ai][bj][m][n], 0, 0, 0); } } \
        if constexpr (FP8) { asm volatile("" : "+v"(acc[ai][bj][0][0]), "+v"(acc[ai][bj][0][1]), "+v"(acc[ai][bj][1][0]), "+v"(acc[ai][bj][1][1]), "+v"(acc[ai][bj][2][0]), "+v"(acc[ai][bj][2][1]), "+v"(acc[ai][bj][3][0]), "+v"(acc[ai][bj][3][1])); } \
        __builtin_amdgcn_s_setprio(0); } while (0)
#define PG8_WAIT_V(n) asm volatile("s_waitcnt vmcnt(" #n ")" ::: "memory")
#define PG8_WAIT_L(n) asm volatile("s_waitcnt lgkmcnt(" #n ")" ::: "memory")
#define PG8_BAR __builtin_amdgcn_s_barrier()
#define PG8_SCHED __builtin_amdgcn_sched_barrier(0)
#define PG8_STAGE_A(bufoff, gbase, ord, h) do { unsigned _o[2]; if constexpr (GATHER) {   \
            unsigned _pk = rcpk; asm volatile("" : "+v"(_pk));   \
            const LAS unsigned char* _rp = (const LAS unsigned char*)rtab + ((ord) * 1024 + (h) * 512) + (_pk & 0xffffu); const unsigned _c2 = _pk >> 16; \
            _Pragma("unroll") for (int _i = 0; _i < 2; ++_i) _o[_i] = __umul24((unsigned)*(const LAS int*)(_rp + _i * 256), (unsigned)KB) + _c2; } \
        else { _o[0] = voffA[0]; _o[1] = voffA[1]; } if constexpr (FP8 && !GATHER) PG8_STAGE1(bufoff, gbase, voffA[0]); else PG8_STAGE(bufoff, gbase, _o); } while (0)
#define PG8_STAGE_B(bufoff, gbase) do { if constexpr (FP8) PG8_STAGE1(bufoff, gbase, voffB[0]); else PG8_STAGE(bufoff, gbase, voffB); } while (0)
    Unit cur, nxt; int ui = 0;
    if (!S.next(0, cur)) return;
    f32x4 acc[2][2][4][2];
#pragma unroll
    for (int a = 0; a < 2; ++a)
#pragma unroll
        for (int b = 0; b < 2; ++b)
#pragma unroll
            for (int m = 0; m < 4; ++m)
#pragma unroll
                for (int n = 0; n < 2; ++n) acc[a][b][m][n] = (f32x4){0.f, 0.f, 0.f, 0.f};
    bf16x8 At[4][2], B0[2][2], B1[2][2]; i32x8v At8[4], B08[2], B18[2];
    const char* cA = GATHER ? (const char*)g.A : (const char*)g.A + (size_t)cur.pm * tstep; const char* cB = (const char*)g.Bt + (size_t)cur.pn * tstep;
    PG8_STAGE_B(PG8_SB(0, 0), cB); PG8_STAGE_B(PG8_SB(0, 1), cB + hstep); PG8_STAGE_A(PG8_SA(0, 0), cA, 0, 0); PG8_STAGE_A(PG8_SA(0, 1), cA + hstepA, 0, 1);
    if (wr == 1) PG8_BAR;
    PG8_WAIT_V(2); PG8_BAR;
    PG8_STAGE_B(PG8_SB(1, 0), cB + kstep); PG8_STAGE_A(PG8_SA(1, 0), cA + kstep, 0, 0); PG8_STAGE_B(PG8_SB(1, 1), cB + hstep + kstep);
    PG8_WAIT_V(6); PG8_BAR;
    for (;;) {
        const bool has_next = S.next(ui + 1, nxt);
        const char* nA = GATHER ? (const char*)g.A : (has_next ? (const char*)g.A + (size_t)nxt.pm * tstep : cA); const char* nB = has_next ? (const char*)g.Bt + (size_t)nxt.pn * tstep : cB;
#pragma unroll 1
        for (int t = 0; t < nt; t += 2) {
            const bool last = (t == nt - 2);
            const char* a1 = cA + (size_t)(t + 1) * kstep;
            const char* a2 = last ? nA : cA + (size_t)(t + 2) * kstep; const char* b2 = last ? nB : cB + (size_t)(t + 2) * kstep;
            const char* a3 = a2 + kstep; const char* b3 = b2 + kstep;
            const int on = (last && has_next) ? ui + 1 : ui;
            PG8_LDB(B0, 0, 0); PG8_LDB(B1, 0, 1); PG8_SCHED; PG8_LDA(At, 0, 0); PG8_STAGE_A(PG8_SA(1, 1), a1 + hstepA, ui, 1);
            PG8_WAIT_V(8); PG8_WAIT_L(0); PG8_BAR; PG8_MMA(0, 0, At, B0); PG8_MMA(0, 1, At, B1); PG8_BAR; PG8_SCHED;
            PG8_LDA(At, 0, 1); PG8_STAGE_B(PG8_SB(0, 0), b2); PG8_STAGE_B(PG8_SB(0, 1), b2 + hstep); PG8_STAGE_A(PG8_SA(0, 0), a2, on, 0);
            PG8_WAIT_V(8); PG8_WAIT_L(0); PG8_BAR; PG8_MMA(1, 0, At, B0); PG8_MMA(1, 1, At, B1); PG8_BAR; PG8_SCHED;
            PG8_LDB(B0, 1, 0); PG8_LDB(B1, 1, 1); PG8_SCHED; PG8_LDA(At, 1, 0); PG8_STAGE_A(PG8_SA(0, 1), a2 + hstepA, on, 1);
            PG8_WAIT_V(8); PG8_WAIT_L(0); PG8_BAR; PG8_MMA(0, 0, At, B0); PG8_MMA(0, 1, At, B1); PG8_BAR; PG8_SCHED;
            PG8_LDA(At, 1, 1); PG8_STAGE_B(PG8_SB(1, 0), b3); PG8_STAGE_B(PG8_SB(1, 1), b3 + hstep); PG8_STAGE_A(PG8_SA(1, 0), a3, on, 0);
            PG8_WAIT_V(8); PG8_WAIT_L(0); PG8_BAR; PG8_MMA(1, 0, At, B0); PG8_MMA(1, 1, At, B1); PG8_BAR; PG8_SCHED;
        }
        if (wr == 0) PG8_BAR;
        E(acc, cur, wr, wc, fr, fq);
        if (!has_next) break;
#pragma unroll
        for (int a = 0; a < 2; ++a)
#pragma unroll
            for (int b = 0; b < 2; ++b)
#pragma unroll
                for (int m = 0; m < 4; ++m)
#pragma unroll
                    for (int n = 0; n < 2; ++n) acc[a][b][m][n] = (f32x4){0.f, 0.f, 0.f, 0.f};
        cur = nxt; cA = nA; cB = nB; ++ui;
        if (wr == 1) PG8_BAR;
    }
    PG8_WAIT_V(0);
    PG8_BAR;
#undef PG8_SA
#undef PG8_SB
#undef PG8_STAGE
#undef PG8_LDA
#undef PG8_LDB
#undef PG8_MMA
#undef PG8_WAIT_V
#undef PG8_WAIT_L
#undef PG8_BAR
#undef PG8_SCHED
#undef PG8_STAGE_A
#undef PG8_STAGE_B
#undef PG8_STAGE1
}
struct EpiBf16 {
    bf16_t* O; int ldc, ncolt; size_t slab;
    __device__ __forceinline__ void operator()(const f32x4 (&acc)[2][2][4][2], const Unit& u, int wr, int wc, int fr, int fq) const {
        const int row0 = u.pm * BM + wr * 64 + fr; const size_t col0 = (size_t)(u.pn % ncolt) * slab + wc * 32 + 8 * fq;
#pragma unroll
        for (int ai = 0; ai < 2; ++ai)
#pragma unroll
            for (int m = 0; m < 4; ++m) { bf16_t* rowp = O + (size_t)(row0 + ai * HALF + m * 16) * ldc + col0;
#pragma unroll
                for (int bj = 0; bj < 2; ++bj) { const f32x4 v0 = acc[ai][bj][m][0], v1 = acc[ai][bj][m][1];
                    u32x4 w; w.x = cvt_pk_bf16(v0[0], v0[1]); w.y = cvt_pk_bf16(v0[2], v0[3]); w.z = cvt_pk_bf16(v1[0], v1[1]); w.w = cvt_pk_bf16(v1[2], v1[3]);
                    *(u32x4*)(rowp + bj * HALF) = w; } }
    }
};
struct EpiRes {
    bf16_t* X; const float* xlat; const float* xctx; const float* modl; int pm_shift; float ascale; bool perm = false;
    __device__ __forceinline__ void operator()(const f32x4 (&acc)[2][2][4][2], const Unit& u, int wr, int wc, int fr, int fq) const {
        const int pm = u.pm - pm_shift; const int rsel = pm < 64 ? (pm >> 5) : 2;
        const int row0 = pm * BM + wr * 64 + fr, col0 = (u.pn & 3) * BM + (perm ? wc * 64 + 16 * fq : wc * 32 + 8 * fq), bjs = perm ? 8 : HALF;
        const float* gate = modl + (size_t)rsel * 6144 + col0;
        const float* xs = xlat ? (pm < 64 ? xlat + (size_t)row0 * D : xctx + (size_t)(row0 - R_LAT) * D) + col0 : nullptr;
        bf16_t* xo = X + (size_t)row0 * D + col0;
#pragma unroll
        for (int bj = 0; bj < 2; ++bj) { const f32x4 g0 = *(const f32x4*)(gate + bj * bjs) * ascale, g1 = *(const f32x4*)(gate + bj * bjs + 4) * ascale;
#pragma unroll
            for (int ai = 0; ai < 2; ++ai)
#pragma unroll
                for (int m = 0; m < 4; ++m) { const size_t o = (size_t)(ai * HALF + m * 16) * D + bj * bjs;
                    f32x4 x0, x1;
                    if (xs) { x0 = *(const f32x4*)(xs + o); x1 = *(const f32x4*)(xs + o + 4); } else unpack8(*(const u32x4*)(xo + o), x0, x1);
                    const f32x4 y0 = x0 + g0 * acc[ai][bj][m][0], y1 = x1 + g1 * acc[ai][bj][m][1];
                    u32x4 w; w.x = cvt_pk_bf16(y0[0], y0[1]); w.y = cvt_pk_bf16(y0[2], y0[3]); w.z = cvt_pk_bf16(y1[0], y1[1]); w.w = cvt_pk_bf16(y1[2], y1[3]);
                    *(u32x4*)(xo + o) = w; } }
    }
};
struct EpiGU8 {
    unsigned char* H8; const LAS float* wtab;
    __device__ __forceinline__ void operator()(const f32x4 (&acc)[2][2][4][2], const Unit& u, int wr, int wc, int fr, int fq) const {
        { const int t_ = tid_(); fr = t_ & 15; fq = (t_ >> 4) & 3; }
        const int row0 = u.pm * BM + wr * 64 + fr, col0 = (u.pn & 1) * 128 + wc * 32 + 8 * fq;
#pragma unroll
        for (int ai = 0; ai < 2; ++ai)
#pragma unroll
            for (int m = 0; m < 4; ++m) { const int row = row0 + ai * HALF + m * 16; const float w = wtab[u.ord * 256 + wr * 64 + fr + ai * HALF + m * 16] * H8_SCALE;
                float h[8];
#pragma unroll
                for (int n = 0; n < 2; ++n)
#pragma unroll
                    for (int j = 0; j < 4; ++j) { const float gv = acc[ai][0][m][n][j] * GU_DESCALE, uv = acc[ai][1][m][n][j] * GU_DESCALE;
                        h[n * 4 + j] = fminf(fmaxf(gv * __builtin_amdgcn_rcpf(1.f + __expf(-gv)) * uv * w, -440.f), 440.f); }
                int w0 = __builtin_amdgcn_cvt_pk_fp8_f32(h[0], h[1], 0, false); w0 = __builtin_amdgcn_cvt_pk_fp8_f32(h[2], h[3], w0, true);
                int w1 = __builtin_amdgcn_cvt_pk_fp8_f32(h[4], h[5], 0, false); w1 = __builtin_amdgcn_cvt_pk_fp8_f32(h[6], h[7], w1, true);
                u32x2 o; o.x = (unsigned)w0; o.y = (unsigned)w1;
                *(u32x2*)(H8 + (size_t)row * 256 + col0) = o; }
    }
};
struct EpiGU {
    bf16_t* H; const float* slot_w;
    __device__ __forceinline__ void operator()(const f32x4 (&acc)[2][2][4][2], const Unit& u, int wr, int wc, int fr, int fq) const {
        const int row0 = u.pm * BM + wr * 64 + fr, col0 = (u.pn & 1) * 128 + wc * 32 + 8 * fq;
#pragma unroll
        for (int ai = 0; ai < 2; ++ai)
#pragma unroll
            for (int m = 0; m < 4; ++m) { const int row = row0 + ai * HALF + m * 16; const float w = slot_w[row];
                float h[8];
#pragma unroll
                for (int n = 0; n < 2; ++n)
#pragma unroll
                    for (int j = 0; j < 4; ++j) { const float gv = acc[ai][0][m][n][j], uv = acc[ai][1][m][n][j]; h[n * 4 + j] = gv / (1.f + __expf(-gv)) * uv * w; }
                u32x4 o; o.x = cvt_pk_bf16(h[0], h[1]); o.y = cvt_pk_bf16(h[2], h[3]); o.z = cvt_pk_bf16(h[4], h[5]); o.w = cvt_pk_bf16(h[6], h[7]);
                *(u32x4*)(H + (size_t)row * 256 + col0) = o; }
    }
};
struct EpiY8 {
    unsigned char* Y8;
    __device__ __forceinline__ void operator()(const f32x4 (&acc)[2][2][4][2], const Unit& u, int wr, int wc, int fr, int fq) const {
        const int row0 = u.pm * BM + wr * 64 + fr; unsigned char* base = Y8 + ((size_t)(u.pn & 3) * MAXSLOT + row0) * 256 + wc * 64 + 16 * fq;
#pragma unroll
        for (int ai = 0; ai < 2; ++ai)
#pragma unroll
            for (int m = 0; m < 4; ++m) { unsigned w[4];
#pragma unroll
                for (int bj = 0; bj < 2; ++bj) { f32x4 v0 = acc[ai][bj][m][0] * (Y8_SCALE * DN_DESCALE), v1 = acc[ai][bj][m][1] * (Y8_SCALE * DN_DESCALE);
#pragma unroll
                    for (int q = 0; q < 4; ++q) { v0[q] = fminf(fmaxf(v0[q], -440.f), 440.f); v1[q] = fminf(fmaxf(v1[q], -440.f), 440.f); }
                    int w0 = __builtin_amdgcn_cvt_pk_fp8_f32(v0[0], v0[1], 0, false); w0 = __builtin_amdgcn_cvt_pk_fp8_f32(v0[2], v0[3], w0, true);
                    int w1 = __builtin_amdgcn_cvt_pk_fp8_f32(v1[0], v1[1], 0, false); w1 = __builtin_amdgcn_cvt_pk_fp8_f32(v1[2], v1[3], w1, true);
                    w[2 * bj] = (unsigned)w0; w[2 * bj + 1] = (unsigned)w1; }
                *(u32x4*)(base + (size_t)(ai * HALF + m * 16) * 256) = (u32x4){w[0], w[1], w[2], w[3]}; }
    }
};
struct EpiDown {
    bf16_t* Y; bf16_t* X; const float* modl5;
    __device__ __forceinline__ void operator()(const f32x4 (&acc)[2][2][4][2], const Unit& u, int wr, int wc, int fr, int fq) const {
        { const int t_ = tid_(); fr = t_ & 15; fq = (t_ >> 4) & 3; }
        if (u.pm < MAXSLOT / 256) { const EpiY8 e{(unsigned char*)Y}; e(acc, u, wr, wc, fr, fq); }
        else { const EpiRes e{X, nullptr, nullptr, modl5, MAXSLOT / 256, DN_DESCALE, true}; e(acc, u, wr, wc, fr, fq); }
    }
};
}


__device__ __forceinline__ void ph_inproj_f(KP p, int l, unsigned char* lds) {
    pg8::Gemm g{(const bf16_t*)(p->ws + Z_A), (const bf16_t*)(p->ws + win_off(l)), R_ALL, DIN, 1024};
    pg8::StaticOrder S; S.init(R_ALL, DIN, gsz_(), bid_());
    pg8::EpiBf16 E{(bf16_t*)(p->ws + Z_P), DIN, DIN / 256, 256};
    pg8::gemm_phase<pg8::EpiBf16, pg8::StaticOrder, false>((LAS unsigned char*)lds, g, S, E, nullptr);
    if (l == 0 && DEPTH > 1 && gsz_() == 256) { __syncthreads(); ph_cvt(p, 1, lds, 214, 42, 0, CVT_E1); }
}
__device__ __forceinline__ void ph_outproj_f(KP p, int l, unsigned char* lds) {
    const int T = (l == 0) ? R_ALL : R_LAT;
    pg8::Gemm g{(const bf16_t*)(p->ws + Z_YCAT), (const bf16_t*)(p->ws + wout_off(l)), T, 1024, 1024};
    pg8::StaticOrder S; S.init(T, 1024, gsz_(), bid_());
    bf16_t* X = (bf16_t*)(p->ws + WS_X);
    pg8::EpiRes E{X, l == 0 ? p->in[0] : nullptr, l == 0 ? p->in[2] : nullptr, (const float*)(p->ws + WS_MOD) + (size_t)l * 3 * 6144 + 2 * 1024, 0, 1.f};
    pg8::gemm_phase<pg8::EpiRes, pg8::StaticOrder, false>((LAS unsigned char*)lds, g, S, E, nullptr);
    if (l == 0 && DEPTH > 1) {
        const int G = gsz_(); __syncthreads();
        if (G == 256) ph_cvt(p, 1, lds, 8, 248, CVT_E2, 1 << 30); else ph_cvt(p, 1, lds); }
}
struct QkvLane { f32x4 gg0, gg1, gw0, gw1; };
__device__ __forceinline__ QkvLane qkv_lane_consts(KP p, int l, int lane) {
    QkvLane c; const int dch = (lane & 7) * 8; const int isk = lane >= 32;
    const float* gq = p->in[isk ? 11 : 10] + l * 64 + dch; const float* wq = p->in[isk ? 13 : 12] + l * 64 + dch;
    c.gg0 = *(const f32x4*)gq; c.gg1 = *(const f32x4*)(gq + 4); c.gw0 = *(const f32x4*)wq; c.gw1 = *(const f32x4*)(wq + 4); return c;
}
__device__ __forceinline__ void prep_qkv_row(KP p, int l, int row, int lane, const QkvLane& qc) {
    const bf16_t* pr = (const bf16_t*)(p->ws + Z_P) + (size_t)row * DIN;
    const bool isctx = row >= R_LAT; const int b = isctx ? ((row - R_LAT) >> 8) : (row >> 13), t = isctx ? ((row - R_LAT) & 255) : (row & 8191);
    const size_t krow = (size_t)b * NKEY + (isctx ? NSEQ + t : t);
    const int l7 = lane & 7, axis = l7 >> 2, half = (l7 >> 1) & 1;
    f32x4 cs0 = (f32x4){1.f, 1.f, 1.f, 1.f}, cs1 = cs0, sn0 = (f32x4){0.f, 0.f, 0.f, 0.f}, sn1 = sn0;
    if (!isctx) { const int pos = axis == 0 ? (t >> 6) : (t & 63); const float* rt = (const float*)(p->ws + WS_ROPE) + pos * 32 + (lane & 1) * 8;
        cs0 = *(const f32x4*)rt; cs1 = *(const f32x4*)(rt + 4); sn0 = *(const f32x4*)(rt + 16); sn1 = *(const f32x4*)(rt + 20); }
    const u32x4 ra = *(const u32x4*)(pr + lane * 8), rb = *(const u32x4*)(pr + 512 + lane * 8);
#pragma unroll
    for (int grp = 0; grp < 2; ++grp) {
        const u32x4 r = grp ? rb : ra;
        bf16_t* Qd = (bf16_t*)(p->ws + (isctx ? (grp ? Z_QWC : Z_QGC) : (grp ? Z_QW : Z_QG))) + (size_t)(isctx ? (b * NCTX + t) : row) * 256;
        bf16_t* Kd = (bf16_t*)(p->ws + (grp ? Z_KW : Z_KG)) + krow * 128; bf16_t* Vd = (bf16_t*)(p->ws + (grp ? Z_VW : Z_VG)) + krow * 128;
        if (lane >= 48) { *(u32x4*)(Vd + (lane - 48) * 8) = r; continue; }
        float x[8] = {bf2f(r.x & 0xffffu), bf2f(r.x >> 16), bf2f(r.y & 0xffffu), bf2f(r.y >> 16), bf2f(r.z & 0xffffu), bf2f(r.z >> 16), bf2f(r.w & 0xffffu), bf2f(r.w >> 16)};
        float ss = 0.f;
#pragma unroll
        for (int i = 0; i < 8; ++i) ss += x[i] * x[i];
        ss += __shfl_xor(ss, 1); ss += __shfl_xor(ss, 2); ss += __shfl_xor(ss, 4);
        const float rinv = rsqrtf(ss * (1.f / 64.f) + EPS);
        const f32x4 g0 = grp ? qc.gw0 : qc.gg0, g1 = grp ? qc.gw1 : qc.gg1;
        const float gv[8] = {g0.x, g0.y, g0.z, g0.w, g1.x, g1.y, g1.z, g1.w};
        const float cv[8] = {cs0.x, cs0.y, cs0.z, cs0.w, cs1.x, cs1.y, cs1.z, cs1.w}, sv[8] = {sn0.x, sn0.y, sn0.z, sn0.w, sn1.x, sn1.y, sn1.z, sn1.w};
        const float qs = (lane < 32) ? QSCALE : 1.f;
        float y[8];
#pragma unroll
        for (int i = 0; i < 8; ++i) { const float v = x[i] * rinv * gv[i]; const float o = __shfl_xor(v, 2);
            y[i] = ((half == 0) ? (v * cv[i] - o * sv[i]) : (o * sv[i] + v * cv[i])) * qs; }
        u32x4 ov; ov.x = pk2(y[0], y[1]); ov.y = pk2(y[2], y[3]); ov.z = pk2(y[4], y[5]); ov.w = pk2(y[6], y[7]);
        if (lane < 32) *(u32x4*)(Qd + lane * 8) = ov; else *(u32x4*)(Kd + (lane - 32) * 8) = ov;
    }
}

template <int R> __device__ __forceinline__ void dw_rows(const float* hcol, const float (&wj)[31], float (&acc)[32]) {
    if constexpr (R < 62) {
        const float hv = hcol[R * 256];
        constexpr int T0 = (R - 30 > 0) ? R - 30 : 0, T1 = (R < 31) ? R : 31;
#pragma unroll
        for (int tt = T0; tt <= T1; ++tt) acc[tt] += hv * wj[R - tt];
        dw_rows<R + 1>(hcol, wj, acc);
    }
}
__device__ __forceinline__ void conv_tile(KP p, int l, unsigned char* lds, int seq_row0, int seqlen, int t0) {
    float* hb = (float*)lds;
    const int tid = tid_(), lane = tid & 63, wid = tid >> 6;
    const bf16_t* P = (const bf16_t*)(p->ws + Z_P);
    for (int i = tid; i < 94 * 32; i += NTHREADS) { const int r = i >> 5, c8 = (i & 31) * 8, t = t0 - 15 + r;
        f32x4 h0 = (f32x4){0.f, 0.f, 0.f, 0.f}, h1 = h0;
        if (t >= 0 && t < seqlen) { const bf16_t* pr = P + (size_t)(seq_row0 + t) * DIN;
            const u32x4 vv = *(const u32x4*)(pr + C_CVV + c8), gg = *(const u32x4*)(pr + C_CVG + c8);
            h0.x = bf2f(vv.x & 0xffffu) * sigmoid_(bf2f(gg.x & 0xffffu)); h0.y = bf2f(vv.x >> 16) * sigmoid_(bf2f(gg.x >> 16));
            h0.z = bf2f(vv.y & 0xffffu) * sigmoid_(bf2f(gg.y & 0xffffu)); h0.w = bf2f(vv.y >> 16) * sigmoid_(bf2f(gg.y >> 16));
            h1.x = bf2f(vv.z & 0xffffu) * sigmoid_(bf2f(gg.z & 0xffffu)); h1.y = bf2f(vv.z >> 16) * sigmoid_(bf2f(gg.z >> 16));
            h1.z = bf2f(vv.w & 0xffffu) * sigmoid_(bf2f(gg.w & 0xffffu)); h1.w = bf2f(vv.w >> 16) * sigmoid_(bf2f(gg.w >> 16)); }
        *(f32x4*)(hb + r * 256 + c8) = h0; *(f32x4*)(hb + r * 256 + c8 + 4) = h1; }
    __syncthreads();
    { const int c = tid & 255, hf = tid >> 8;
      const float* w = p->in[15] + (size_t)l * 31 * 256 + c; const float bias = p->in[16][l * 256 + c];
      float wj[31];
#pragma unroll
      for (int j = 0; j < 31; ++j) wj[j] = w[j * 256];
      float acc[32];
#pragma unroll
      for (int tt = 0; tt < 32; ++tt) acc[tt] = bias;
      dw_rows<0>(hb + hf * 32 * 256 + c, wj, acc);
      __syncthreads();
#pragma unroll
      for (int tt = 0; tt < 32; ++tt) hb[(hf * 32 + tt) * 256 + c] = acc[tt];
    }
    __syncthreads();
    constexpr int AS = 264;
    bf16_t* ab = (bf16_t*)(lds + 94 * 256 * 4);
    for (int tt = wid; tt < 64; tt += 8) { const float* r = hb + tt * 256; const f32x4 v = ((const f32x4*)r)[lane];
        const float mean = wave_sum(v.x + v.y + v.z + v.w) * (1.f / 256.f);
        const float dx = v.x - mean, dy = v.y - mean, dz = v.z - mean, dw = v.w - mean;
        const float rstd = rsqrtf(wave_sum(dx * dx + dy * dy + dz * dz + dw * dw) * (1.f / 256.f) + EPS);
        const f32x4 g = ((const f32x4*)(p->in[17] + l * 256))[lane], bb = ((const f32x4*)(p->in[18] + l * 256))[lane];
        u32x2 o; o.x = pk2(silu_(dx * rstd * g.x + bb.x), silu_(dy * rstd * g.y + bb.y)); o.y = pk2(silu_(dz * rstd * g.z + bb.z), silu_(dw * rstd * g.w + bb.w));
        *(u32x2*)(ab + tt * AS + lane * 4) = o; }
    __syncthreads();
    { const int fr = lane & 15, fq = lane >> 4;
      const bf16_t* Wt = (const bf16_t*)(p->ws + wpw_off(l));
      bf16x8 bw[2][8];
#pragma unroll
      for (int j = 0; j < 2; ++j)
#pragma unroll
          for (int ks = 0; ks < 8; ++ks) bw[j][ks] = *(const bf16x8*)(Wt + (size_t)((wid * 2 + j) * 16 + fr) * 256 + ks * 32 + fq * 8);
      const float bias0 = p->in[20][l * 256 + wid * 32 + fr], bias1 = p->in[20][l * 256 + wid * 32 + 16 + fr];
      bf16_t* Y = (bf16_t*)(p->ws + Z_YCAT);
#pragma unroll 1
      for (int tr = 0; tr < 4; ++tr) { f32x4 a0 = (f32x4){0.f, 0.f, 0.f, 0.f}, a1 = a0;
#pragma unroll
          for (int ks = 0; ks < 8; ++ks) { const bf16x8 av = *(const bf16x8*)(ab + (tr * 16 + fr) * AS + ks * 32 + fq * 8);
              a0 = __builtin_amdgcn_mfma_f32_16x16x32_bf16(av, bw[0][ks], a0, 0, 0, 0); a1 = __builtin_amdgcn_mfma_f32_16x16x32_bf16(av, bw[1][ks], a1, 0, 0, 0); }
#pragma unroll
          for (int r = 0; r < 4; ++r) { const int t = t0 + tr * 16 + fq * 4 + r; bf16_t* yr = Y + (size_t)(seq_row0 + t) * D + 256 + wid * 32 + fr;
              yr[0] = (bf16_t)f2bf(a0[r] + bias0); yr[16] = (bf16_t)f2bf(a1[r] + bias1); } }
    }
    __syncthreads();
}

__device__ __forceinline__ int hgrn_chunk_row0(int b, int dir, int j) {
    if (j < 4) { const int cj = dir ? 3 - j : j; return R_LAT + b * NCTX + cj * 64; }
    const int jj = j - 4, cj = dir ? 127 - jj : jj; return b * NSEQ + cj * 64;
}
__device__ __forceinline__ void hgrn_load_chunk(KP p, int l, int row0, int dir, int head, float* qs, float* vs, float* ks, float* cs) {
    const int tid = tid_();
    const bf16_t* P = (const bf16_t*)(p->ws + Z_P);
    const float* lbv = (const float*)(p->ws + WS_LB) + (l * 2 + dir) * 256 + head * 64;
    for (int i = tid; i < 4096; i += NTHREADS) { const int tau = i >> 6, d = i & 63; const int row = row0 + (dir ? 63 - tau : tau);
        const bf16_t* pr = P + (size_t)row * DIN + head * 64 + d;
        if (qs) qs[i] = bf2f(pr[C_RQ]);
        vs[i] = bf2f(pr[C_RI]);
        const float z = bf2f(pr[dir ? C_RFB : C_RFF]); const float lb = lbv[d];
        const float lsp = fminf(z, 0.f) - log1pf(__expf(-fabsf(z)));
        float logf = lsp;
        if (lb > 0.f) { const float a = lsp, bq = __logf(lb) + (lsp - z); const float mx = fmaxf(a, bq); logf = mx + log1pf(__expf(-fabsf(a - bq))); }
        ks[i] = (1.f - lb) * sigmoid_(-z);
        cs[i] = logf; }
    __syncthreads();
    if (tid < 64) { float c = 0.f; for (int tau = 0; tau < 64; ++tau) { c += cs[tau * 64 + tid]; cs[tau * 64 + tid] = c; } }
    __syncthreads();
}
__device__ __forceinline__ void hgrn_pass1_unit(KP p, int l, unsigned char* lds, int unit) {
    float* vs = (float*)lds; float* ks = vs + 4096; float* cs = ks + 4096;
    const int tid = tid_();
    const int j = unit % NCHUNK, seq = unit / NCHUNK, dir = seq & 1, head = (seq >> 1) & 3, b = seq >> 3;
    hgrn_load_chunk(p, l, hgrn_chunk_row0(b, dir, j), dir, head, nullptr, vs, ks, cs);
    for (int i = tid; i < 4096; i += NTHREADS) { const int d = i & 63; ks[i] *= __expf(cs[63 * 64 + d] - cs[i]); }
    __syncthreads();
    float* U = (float*)(p->ws + Z_U) + ((size_t)seq * NCHUNK + j) * 4096; float* Gv = (float*)(p->ws + Z_G) + ((size_t)seq * NCHUNK + j) * 64;
    { const int d = tid >> 3, e0 = (tid & 7) * 8; float acc[8];
#pragma unroll
      for (int e = 0; e < 8; ++e) acc[e] = 0.f;
      for (int tau = 0; tau < 64; ++tau) { const float kv = ks[tau * 64 + d];
#pragma unroll
          for (int e = 0; e < 8; ++e) acc[e] += kv * vs[tau * 64 + e0 + e]; }
#pragma unroll
      for (int e = 0; e < 8; ++e) U[d * 64 + e0 + e] = acc[e]; }
    if (tid < 64) Gv[tid] = __expf(cs[63 * 64 + tid]);
    __syncthreads();
}
constexpr int HS = 72;
constexpr int HL_TOT = 0, HL_OSUM = 2048, HL_T0 = 18432, HL_TB = 64 * HS * 2;
__device__ __forceinline__ f32x4 mm64(const bf16_t* A, const bf16_t* Bt, int tr, int tc, int fr, int fq, f32x4 acc) {
#pragma unroll
    for (int k0 = 0; k0 < 64; k0 += 32) { const bf16x8 a = *(const bf16x8*)(A + (tr * 16 + fr) * HS + k0 + fq * 8), b = *(const bf16x8*)(Bt + (tc * 16 + fr) * HS + k0 + fq * 8);
        acc = __builtin_amdgcn_mfma_f32_16x16x32_bf16(a, b, acc, 0, 0, 0); }
    return acc;
}
__device__ __forceinline__ void hgrn_load8(KP p, int row0, int dir, int head, int tid, float (&q)[8], float (&vv)[8], float (&z)[8]) {
    const int d = tid & 63, seg = tid >> 6;
    const bf16_t* P = (const bf16_t*)(p->ws + Z_P);
#pragma unroll
    for (int i = 0; i < 8; ++i) { const int tau = seg * 8 + i; const int row = row0 + (dir ? 63 - tau : tau);
        const bf16_t* pr = P + (size_t)row * DIN + head * 64 + d;
        q[i] = bf2f(pr[C_RQ]); vv[i] = bf2f(pr[C_RI]); z[i] = bf2f(pr[dir ? C_RFB : C_RFF]); }
}
__device__ __forceinline__ void hgrn_gate8(KP p, int l, int dir, int head, int tid, float* tot, const float (&z)[8], float (&kg)[8], float (&c)[8], float& m, float& cl) {
    const int d = tid & 63, seg = tid >> 6;
    const float lb = ((const float*)(p->ws + WS_LB))[(l * 2 + dir) * 256 + head * 64 + d];
    float run = 0.f;
#pragma unroll
    for (int i = 0; i < 8; ++i) {
        const float ez = __expf(-fabsf(z[i])), rz = __builtin_amdgcn_rcpf(1.f + ez); const float sg = (z[i] >= 0.f) ? rz : ez * rz;
        const float f = lb + (1.f - lb) * sg;
        kg[i] = 1.f - f;
        run += __logf(f); c[i] = run; }
    tot[seg * 64 + d] = run;
    __syncthreads();
    float off = 0.f; m = 0.f; cl = 0.f;
#pragma unroll
    for (int s2 = 0; s2 < 8; ++s2) { const float t = tot[s2 * 64 + d]; if (s2 < seg) off += t; if (s2 < 4) m += t; cl += t; }
#pragma unroll
    for (int i = 0; i < 8; ++i) c[i] += off;
}
__device__ __forceinline__ u32x4 pack8(const float (&x)[8]) { u32x4 o; o.x = pk2(x[0], x[1]); o.y = pk2(x[2], x[3]); o.z = pk2(x[4], x[5]); o.w = pk2(x[6], x[7]); return o; }
__device__ __forceinline__ void hgrn_pass1_f(KP p, int l, unsigned char* lds, int unit) {
    const int tid = tid_(), lane = tid & 63, wid = tid >> 6, fr = lane & 15, fq = lane >> 4, d = tid & 63, seg = tid >> 6;
    float* tot = (float*)(lds + HL_TOT); bf16_t* Vt = (bf16_t*)(lds + HL_T0); bf16_t* KbT = (bf16_t*)(lds + HL_T0 + HL_TB);
    const int j = unit % NCHUNK, seq = unit / NCHUNK, dir = seq & 1, head = (seq >> 1) & 3, b = seq >> 3;
    float q[8], vv[8], z[8], kg[8], c[8], m, cl;
    hgrn_load8(p, hgrn_chunk_row0(b, dir, j), dir, head, tid, q, vv, z);
    hgrn_gate8(p, l, dir, head, tid, tot, z, kg, c, m, cl);
    float kb[8];
#pragma unroll
    for (int i = 0; i < 8; ++i) kb[i] = kg[i] * __expf(cl - c[i]);
    *(u32x4*)(Vt + d * HS + seg * 8) = pack8(vv);
    *(u32x4*)(KbT + d * HS + seg * 8) = pack8(kb);
    float* U = (float*)(p->ws + Z_U) + ((size_t)seq * NCHUNK + j) * 4096; float* Gv = (float*)(p->ws + Z_G) + ((size_t)seq * NCHUNK + j) * 64;
    if (seg == 0) Gv[d] = __expf(cl);
    __syncthreads();
    const int tr = wid >> 1;
#pragma unroll
    for (int t2 = 0; t2 < 2; ++t2) { const int tc = (wid & 1) * 2 + t2;
        const f32x4 acc = mm64(Vt, KbT, tr, tc, fr, fq, (f32x4){0.f, 0.f, 0.f, 0.f});
#pragma unroll
        for (int r = 0; r < 4; ++r) U[(tr * 16 + fq * 4 + r) * 64 + tc * 16 + fr] = acc[r]; }
    __syncthreads();
}
struct HgrnIn1 { float v[8], zf[8], zb[8]; };
__device__ __forceinline__ void hgrn_p1_load(KP p, int unit, int tid, HgrnIn1& r) {
    const int cpos = unit % NCHUNK, head = (unit / NCHUNK) & 3, b = unit / (NCHUNK * 4), d = tid & 63, seg = tid >> 6;
    const int row0 = (cpos < 4) ? R_LAT + b * NCTX + cpos * 64 : b * NSEQ + (cpos - 4) * 64;
    const bf16_t* P = (const bf16_t*)(p->ws + Z_P) + (size_t)(row0 + seg * 8) * DIN + head * 64 + d;
#pragma unroll
    for (int i = 0; i < 8; ++i) { const bf16_t* pr = P + (size_t)i * DIN; r.v[i] = bf2f(pr[C_RI]); r.zf[i] = bf2f(pr[C_RFF]); r.zb[i] = bf2f(pr[C_RFB]); }
}
__device__ __forceinline__ void hgrn_p1_compute(KP p, int l, unsigned char* lds, int unit, int tid, const HgrnIn1& r) {
    const int lane = tid & 63, wid = tid >> 6, fr = lane & 15, fq = lane >> 4, d = tid & 63, seg = tid >> 6;
    float* totf = (float*)(lds + HL_TOT); float* totb = (float*)(lds + HL_OSUM);
    bf16_t* Vt = (bf16_t*)(lds + HL_T0); bf16_t* KfT = (bf16_t*)(lds + HL_T0 + HL_TB); bf16_t* KbT = (bf16_t*)(lds + HL_T0 + 2 * HL_TB);
    const int cpos = unit % NCHUNK, head = (unit / NCHUNK) & 3, b = unit / (NCHUNK * 4);
    const float* lbp = (const float*)(p->ws + WS_LB) + (l * 2) * 256 + head * 64 + d; const float lbf = lbp[0], lbb = lbp[256];
    float kf[8], kb[8], cf[8], cb[8], lfb[8], runf = 0.f, runb = 0.f;
#pragma unroll
    for (int i = 0; i < 8; ++i) {
        { const float z = r.zf[i], ez = __expf(-fabsf(z)), rz = __builtin_amdgcn_rcpf(1.f + ez), sg = (z >= 0.f) ? rz : ez * rz, f = lbf + (1.f - lbf) * sg; kf[i] = 1.f - f; runf += __logf(f); cf[i] = runf; }
        { const float z = r.zb[i], ez = __expf(-fabsf(z)), rz = __builtin_amdgcn_rcpf(1.f + ez), sg = (z >= 0.f) ? rz : ez * rz, f = lbb + (1.f - lbb) * sg; kb[i] = 1.f - f; lfb[i] = __logf(f); runb += lfb[i]; cb[i] = runb; } }
    totf[seg * 64 + d] = runf; totb[seg * 64 + d] = runb;
    __syncthreads();
    float offf = 0.f, offb = 0.f, clf = 0.f, clb = 0.f;
#pragma unroll
    for (int s2 = 0; s2 < 8; ++s2) { const float tf = totf[s2 * 64 + d], tb = totb[s2 * 64 + d]; if (s2 < seg) { offf += tf; offb += tb; } clf += tf; clb += tb; }
#pragma unroll
    for (int i = 0; i < 8; ++i) { kf[i] *= __expf(clf - (cf[i] + offf)); kb[i] *= __expf(cb[i] + offb - lfb[i]); }
    *(u32x4*)(Vt + d * HS + seg * 8) = pack8(r.v);
    *(u32x4*)(KfT + d * HS + seg * 8) = pack8(kf);
    *(u32x4*)(KbT + d * HS + seg * 8) = pack8(kb);
    const int jf = cpos, jb = (cpos < 4) ? 3 - cpos : 4 + 127 - (cpos - 4); const int seqf = (b * 4 + head) * 2;
    bf16_t* Uf = (bf16_t*)(p->ws + Z_U) + ((size_t)seqf * NCHUNK + jf) * 4096; bf16_t* Ub = (bf16_t*)(p->ws + Z_U) + ((size_t)(seqf + 1) * NCHUNK + jb) * 4096;
    float* Gf = (float*)(p->ws + Z_G) + ((size_t)seqf * NCHUNK + jf) * 64; float* Gb = (float*)(p->ws + Z_G) + ((size_t)(seqf + 1) * NCHUNK + jb) * 64;
    if (seg == 0) { Gf[d] = __expf(clf); Gb[d] = __expf(clb); }
    __syncthreads();
    const int tr = wid >> 1;
#pragma unroll
    for (int t2 = 0; t2 < 2; ++t2) { const int tc = (wid & 1) * 2 + t2;
        const f32x4 af = mm64(Vt, KfT, tr, tc, fr, fq, (f32x4){0.f, 0.f, 0.f, 0.f}), ab = mm64(Vt, KbT, tr, tc, fr, fq, (f32x4){0.f, 0.f, 0.f, 0.f});
#pragma unroll
        for (int q = 0; q < 4; ++q) { const int o = (tr * 16 + fq * 4 + q) * 64 + tc * 16 + fr; Uf[o] = (bf16_t)f2bf(af[q]); Ub[o] = (bf16_t)f2bf(ab[q]); } }
    __syncthreads();
}
__device__ __forceinline__ void hgrn_pass1_run(KP p, int l, unsigned char* lds, int u0, int un, int ustep) {
    if (un <= 0) return;
    const int tid = tid_();
    HgrnIn1 cur; hgrn_p1_load(p, u0, tid, cur);
    for (int k = 0; k < un; ++k) { const int u = u0 + k * ustep;
        HgrnIn1 nxt = cur; if (k + 1 < un) hgrn_p1_load(p, u + ustep, tid, nxt);
        hgrn_p1_compute(p, l, lds, u, tid, cur);
        cur = nxt; }
}
__device__ __forceinline__ void hgrn_scan_f(KP p) {
    const int tid = tid_();
    if (tid >= 256) return;
    for (int gi = bid_() * 256 + tid; gi < 16 * 4096; gi += gsz_() * 256) {
    const int seq = gi >> 12, ed = gi & 4095, d = ed & 63;
    bf16_t* U = (bf16_t*)(p->ws + Z_U) + (size_t)seq * NCHUNK * 4096 + ed; const float* Gv = (const float*)(p->ws + Z_G) + (size_t)seq * NCHUNK * 64 + d;
    float S = 0.f;
#pragma unroll 1
    for (int j = 0; j < NCHUNK; j += 12) {
        float u[12], g[12];
#pragma unroll
        for (int q = 0; q < 12; ++q) { u[q] = bf2f(U[(size_t)(j + q) * 4096]); g[q] = Gv[(j + q) * 64]; }
#pragma unroll
        for (int q = 0; q < 12; ++q) { U[(size_t)(j + q) * 4096] = (bf16_t)f2bf(S); S = g[q] * S + u[q]; }
    }
    }
}
struct HgrnIn3 { float q[8], v[8], zf[8], zb[8], gg[8]; u32x4 sf, sb; };
__device__ __forceinline__ void hgrn_p3_load(KP p, int unit, int tid, HgrnIn3& r) {
    const int cpos = unit % NCHUNK, head = (unit / NCHUNK) & 3, b = unit / (NCHUNK * 4), d = tid & 63, seg = tid >> 6;
    const int row0 = (cpos < 4) ? R_LAT + b * NCTX + cpos * 64 : b * NSEQ + (cpos - 4) * 64;
    const bf16_t* P = (const bf16_t*)(p->ws + Z_P) + (size_t)(row0 + seg * 8) * DIN + head * 64 + d;
#pragma unroll
    for (int i = 0; i < 8; ++i) { const bf16_t* pr = P + (size_t)i * DIN; r.q[i] = bf2f(pr[C_RQ]); r.v[i] = bf2f(pr[C_RI]); r.zf[i] = bf2f(pr[C_RFF]); r.zb[i] = bf2f(pr[C_RFB]);
        r.gg[i] = bf2f(((const bf16_t*)(p->ws + Z_P))[(size_t)(row0 + seg + 8 * i) * DIN + C_RG + head * 64 + d]); }
    const int jf = cpos, jb = (cpos < 4) ? 3 - cpos : 4 + 127 - (cpos - 4); const int seqf = (b * 4 + head) * 2;
    const bf16_t* U = (const bf16_t*)(p->ws + Z_U);
    r.sf = *(const u32x4*)(U + ((size_t)seqf * NCHUNK + jf) * 4096 + tid * 8); r.sb = *(const u32x4*)(U + ((size_t)(seqf + 1) * NCHUNK + jb) * 4096 + tid * 8);
}
__device__ __forceinline__ void hgrn_p3_compute(KP p, int l, unsigned char* lds, int unit, int tid, const HgrnIn3& r) {
    const int lane = tid & 63, wid = tid >> 6, fr = lane & 15, fq = lane >> 4, d = tid & 63, seg = tid >> 6;
    constexpr int HL_D1 = HL_T0 + 6 * HL_TB, HL_TOT1 = HL_D1 + 6 * HL_TB;
    static_assert(HL_TOT1 + 2048 <= LDS_WVTAB_OFF, "HGRN pass-3 LDS fits below the wave table");
    float* os0 = (float*)(lds + HL_OSUM); float* os1 = (float*)(lds + HL_T0);
    const int cpos = unit % NCHUNK, head = (unit / NCHUNK) & 3, b = unit / (NCHUNK * 4);
    const int row0 = (cpos < 4) ? R_LAT + b * NCTX + cpos * 64 : b * NSEQ + (cpos - 4) * 64;
    const int tr = wid >> 1;
    const float* lbp = (const float*)(p->ws + WS_LB) + (l * 2) * 256 + head * 64 + d;
    float kg[2][8], c[2][8];
#pragma unroll
    for (int dir = 0; dir < 2; ++dir) { float* tot = (float*)(lds + (dir ? HL_TOT1 : HL_TOT));
        const float lb = lbp[dir * 256]; float run = 0.f;
#pragma unroll
        for (int ii = 0; ii < 8; ++ii) { const int i = dir ? 7 - ii : ii;
            const float z = dir ? r.zb[i] : r.zf[i];
            const float ez = __expf(-fabsf(z)), rz = __builtin_amdgcn_rcpf(1.f + ez), sg = (z >= 0.f) ? rz : ez * rz, f = lb + (1.f - lb) * sg;
            kg[dir][i] = 1.f - f; run += __logf(f); c[dir][i] = run; }
        tot[seg * 64 + d] = run; }
    __syncthreads();
#pragma unroll
    for (int dir = 0; dir < 2; ++dir) { const float* tot = (const float*)(lds + (dir ? HL_TOT1 : HL_TOT)); unsigned char* tb = lds + (dir ? HL_D1 : HL_T0);
        bf16_t* Qt = (bf16_t*)tb; bf16_t* Kt = (bf16_t*)(tb + HL_TB); bf16_t* Qb = (bf16_t*)(tb + 2 * HL_TB); bf16_t* St = (bf16_t*)(tb + 3 * HL_TB); bf16_t* Vt = (bf16_t*)(tb + 4 * HL_TB);
        float off = 0.f, m = 0.f;
#pragma unroll
        for (int s2 = 0; s2 < 8; ++s2) { const float t = tot[s2 * 64 + d]; if (dir ? (s2 > seg) : (s2 < seg)) off += t; if (dir ? (s2 >= 4) : (s2 < 4)) m += t; }
        float vr[8];
#pragma unroll
        for (int i = 0; i < 8; ++i) { const float ci = c[dir][i] + off; const int tau = dir ? 63 - (seg * 8 + i) : seg * 8 + i; const float qv = r.q[i];
            Qt[tau * HS + d] = (bf16_t)f2bf(qv * __expf(fminf(ci - m, 80.f)));
            Kt[tau * HS + d] = (bf16_t)f2bf(kg[dir][i] * __expf(fminf(m - ci, 80.f)));
            Qb[tau * HS + d] = (bf16_t)f2bf(qv * __expf(ci));
            vr[i] = dir ? r.v[7 - i] : r.v[i]; }
        *(u32x4*)(Vt + d * HS + (dir ? 7 - seg : seg) * 8) = pack8(vr);
        *(u32x4*)(St + (tid >> 3) * HS + (tid & 7) * 8) = dir ? r.sb : r.sf; }
    __syncthreads();
    f32x4 oacc[2][2];
#pragma unroll
    for (int dir = 0; dir < 2; ++dir) { unsigned char* tb = lds + (dir ? HL_D1 : HL_T0);
        const bf16_t* Qt = (const bf16_t*)tb; const bf16_t* Kt = (const bf16_t*)(tb + HL_TB); const bf16_t* Qb = (const bf16_t*)(tb + 2 * HL_TB); const bf16_t* St = (const bf16_t*)(tb + 3 * HL_TB); bf16_t* Sc = (bf16_t*)(tb + 5 * HL_TB);
#pragma unroll
        for (int t2 = 0; t2 < 2; ++t2) { const int tc = (wid & 1) * 2 + t2;
            oacc[dir][t2] = mm64(Qb, St, tr, tc, fr, fq, (f32x4){0.f, 0.f, 0.f, 0.f});
            f32x4 sacc = (f32x4){0.f, 0.f, 0.f, 0.f};
            if (tc <= tr) sacc = mm64(Qt, Kt, tr, tc, fr, fq, sacc);
#pragma unroll
            for (int q = 0; q < 4; ++q) { const int tau = tr * 16 + fq * 4 + q, sig = tc * 16 + fr; Sc[tau * HS + sig] = (bf16_t)f2bf(sig <= tau ? sacc[q] : 0.f); } } }
    __syncthreads();
#pragma unroll
    for (int dir = 0; dir < 2; ++dir) { unsigned char* tb = lds + (dir ? HL_D1 : HL_T0); const bf16_t* Vt = (const bf16_t*)(tb + 4 * HL_TB); const bf16_t* Sc = (const bf16_t*)(tb + 5 * HL_TB);
        float* os = dir ? os1 : os0;
#pragma unroll
        for (int t2 = 0; t2 < 2; ++t2) { const int tc = (wid & 1) * 2 + t2;
            const f32x4 o = mm64(Sc, Vt, tr, tc, fr, fq, oacc[dir][t2]);
#pragma unroll
            for (int q = 0; q < 4; ++q) { const int tau = tr * 16 + fq * 4 + q, e = tc * 16 + fr, tok = dir ? 63 - tau : tau; os[tok * 64 + e] = o[q]; } } }
    __syncthreads();
    bf16_t* Y = (bf16_t*)(p->ws + Z_YCAT); const float ong = p->in[22][l * 64 + lane];
#pragma unroll
    for (int i = 0; i < 8; ++i) { const int tok = wid + 8 * i; const float v = os0[tok * 64 + lane] + os1[tok * 64 + lane];
        const float y = v * rsqrtf(wave_sum(v * v) * (1.f / 64.f) + EPS) * ong;
        Y[(size_t)(row0 + tok) * D + 768 + head * 64 + lane] = (bf16_t)f2bf(y * silu_(r.gg[i])); }
    __syncthreads();
}
__device__ __forceinline__ int hgrn_p3_unit(int k) { if (k < 1024) { const int bh = k >> 7, c = k & 127; return bh * NCHUNK + 4 + c; } const int k2 = k - 1024; return (k2 >> 2) * NCHUNK + (k2 & 3); }
__device__ __forceinline__ void hgrn_pass3_run(KP p, int l, unsigned char* lds) {
    const int tid = tid_(), G = gsz_(), nunits = 1024 + (l == 0 ? 32 : 0);
    int k = bid_(); if (k >= nunits) return;
    HgrnIn3 cur; hgrn_p3_load(p, hgrn_p3_unit(k), tid, cur);
    for (;;) { const int kn = k + G; const bool more = kn < nunits;
        HgrnIn3 nxt = cur; if (more) hgrn_p3_load(p, hgrn_p3_unit(kn), tid, nxt);
        hgrn_p3_compute(p, l, lds, hgrn_p3_unit(k), tid, cur);
        if (!more) break;
        cur = nxt; k = kn; }
}
__device__ __forceinline__ void ph_prep(KP p, int l, unsigned char* lds) {
    const int tid = tid_(), lane = tid & 63, wid = tid >> 6, bid = bid_(), G = gsz_();
    const int nconv = 256 + (l == 0 ? 8 : 0);
    for (int it = bid; it < nconv; it += G) {
        if (it < 256) conv_tile(p, l, lds, (it >> 7) * NSEQ, NSEQ, (it & 127) * 64);
        else { const int c = it - 256; conv_tile(p, l, lds, R_LAT + (c >> 2) * NCTX, NCTX, (c & 3) * 64); } }
    if (G == 256) {
        const int u0 = bid < 8 ? 2 * bid : bid < 56 ? 16 + 5 * (bid - 8) : 256 + 4 * (bid - 56), un = bid < 8 ? 2 : bid < 56 ? 5 : 4;
        hgrn_pass1_run(p, l, lds, u0, un, 1);
        const int g0 = bid < 104 ? 8 * bid : bid < 168 ? 832 + 9 * (bid - 104) : 1408 + 8 * (bid - 168), gn = (bid >= 104 && bid < 168) ? 9 : 8;
        const QkvLane qc = qkv_lane_consts(p, l, lane);
        for (int g = g0; g < g0 + gn; ++g) prep_qkv_row(p, l, g * 8 + wid, lane, qc);
    } else {
        hgrn_pass1_run(p, l, lds, bid, (8 * NCHUNK - bid + G - 1) / G, G);
        const QkvLane qc = qkv_lane_consts(p, l, lane);
        for (int row = bid * 8 + wid; row < R_ALL; row += G * 8) prep_qkv_row(p, l, row, lane, qc);
    }
}

__device__ __forceinline__ void hgrn_scan(KP p) {
    const int gi = bid_() * NTHREADS + tid_();
    if (gi >= 16 * 4096) return;
    const int seq = gi >> 12, de = gi & 4095, d = de >> 6;
    float* U = (float*)(p->ws + Z_U) + (size_t)seq * NCHUNK * 4096 + de; const float* Gv = (const float*)(p->ws + Z_G) + (size_t)seq * NCHUNK * 64 + d;
    float S = 0.f;
    for (int j = 0; j < NCHUNK; j += 4) {
        float u[4], g[4];
#pragma unroll
        for (int q = 0; q < 4; ++q) { u[q] = U[(size_t)(j + q) * 4096]; g[q] = Gv[(j + q) * 64]; }
#pragma unroll
        for (int q = 0; q < 4; ++q) { U[(size_t)(j + q) * 4096] = S; S = g[q] * S + u[q]; }
    }
}
__device__ __forceinline__ void attn_simple_unit(unsigned char* lds, const bf16_t* Qrow0  , const bf16_t* Kb, const bf16_t* Vb  ,
                                                 int mode, int NT, int first_key, int q0, bool use_sink, float sink_log2, bf16_t* Orow0  ) {
    float* Ks = (float*)lds; float* Vs = Ks + 4096;
    const int tid = tid_();
    float q[64], o[64], m = -INFINITY, lsum = 0.f;
    if (tid < 256) {
#pragma unroll
        for (int d = 0; d < 64; ++d) { q[d] = bf2f(Qrow0[(size_t)tid * 256 + d]); o[d] = 0.f; }
    }
    for (int tt = 0; tt < NT; ++tt) {
        int key0, pos0 = 0; bool masked = false;
        if (mode == 0) key0 = first_key + 64 * tt;
        else if (tt < 4) key0 = NSEQ + 64 * tt;
        else { pos0 = q0 - 128 + 64 * (tt - 4); key0 = pos0 < 0 ? 0 : (pos0 > NSEQ - 64 ? NSEQ - 64 : pos0); masked = true; }
        __syncthreads();
        for (int i = tid; i < 4096; i += NTHREADS) { const int kk = i >> 6, d = i & 63; Ks[i] = bf2f(Kb[(size_t)(key0 + kk) * 128 + d]); Vs[i] = bf2f(Vb[(size_t)(key0 + kk) * 128 + d]); }
        __syncthreads();
        if (tid < 256) {
            for (int kk = 0; kk < 64; ++kk) {
                if (masked) { const int kp = pos0 + kk, qp = q0 + tid; const int df = qp - kp; if (kp < 0 || kp >= NSEQ || df > 128 || df < -128) continue; }
                float s = 0.f;
#pragma unroll
                for (int d = 0; d < 64; ++d) s += q[d] * Ks[kk * 64 + d];
                if (s > m) { const float f = exp2f(m - s); lsum *= f;
#pragma unroll
                    for (int d = 0; d < 64; ++d) o[d] *= f;
                    m = s; }
                const float pe = exp2f(s - m); lsum += pe;
#pragma unroll
                for (int d = 0; d < 64; ++d) o[d] += pe * Vs[kk * 64 + d];
            }
        }
    }
    if (tid < 256) {
        if (use_sink) lsum += exp2f(sink_log2 - m);
        const float inv = 1.f / lsum;
#pragma unroll
        for (int d = 0; d < 64; ++d) Orow0[(size_t)tid * D + d] = (bf16_t)f2bf(o[d] * inv);
    }
    __syncthreads();
}
__device__ __forceinline__ void ph_attn(KP p, int l, unsigned char* lds) {
    hgrn_scan(p);
    bf16_t* Y = (bf16_t*)(p->ws + Z_YCAT);
    const bf16_t* Qg = (const bf16_t*)(p->ws + Z_QG); const bf16_t* Qw = (const bf16_t*)(p->ws + Z_QW); const bf16_t* Qgc = (const bf16_t*)(p->ws + Z_QGC); const bf16_t* Qwc = (const bf16_t*)(p->ws + Z_QWC);
    const bf16_t* Kg = (const bf16_t*)(p->ws + Z_KG); const bf16_t* Kw = (const bf16_t*)(p->ws + Z_KW); const bf16_t* Vg = (const bf16_t*)(p->ws + Z_VG); const bf16_t* Vw = (const bf16_t*)(p->ws + Z_VW);
    const int nunits = 512 + (l == 0 ? 16 : 0);
    for (int u = bid_(); u < nunits; u += gsz_()) {
        if (u < 256) {
            const int qb = u & 31, h = (u >> 5) & 3, b = u >> 7, row0 = b * NSEQ + qb * 256;
            attn_simple_unit(lds, Qg + (size_t)row0 * 256 + h * 64, Kg + (size_t)b * NKEY * 128 + (h >> 1) * 64, Vg + (size_t)b * NKEY * 128 + (h >> 1) * 64, 0, NKEY / 64, 0, qb * 256, false, 0.f, Y + (size_t)row0 * D + h * 64);
        } else if (u < 512) {
            const int v = u - 256, qb = v & 31, h = (v >> 5) & 3, b = v >> 7, row0 = b * NSEQ + qb * 256;
            attn_simple_unit(lds, Qw + (size_t)row0 * 256 + h * 64, Kw + (size_t)b * NKEY * 128 + (h >> 1) * 64, Vw + (size_t)b * NKEY * 128 + (h >> 1) * 64, 1, 12, 0, qb * 256, true, p->in[14][l * 4 + h] * LOG2E, Y + (size_t)row0 * D + 512 + h * 64);
        } else {
            const int v = u - 512, h = v & 3, b = (v >> 2) & 1, win = v >> 3, row0 = R_LAT + b * NCTX;
            const bf16_t* Qc = (win ? Qwc : Qgc) + (size_t)(b * NCTX) * 256 + h * 64;
            const bf16_t* Kc = (win ? Kw : Kg) + (size_t)b * NKEY * 128 + (h >> 1) * 64; const bf16_t* Vc = (win ? Vw : Vg) + (size_t)b * NKEY * 128 + (h >> 1) * 64;
            attn_simple_unit(lds, Qc, Kc, Vc, 0, 4, NSEQ, 0, win != 0, p->in[14][l * 4 + h] * LOG2E, Y + (size_t)row0 * D + (win ? 512 : 0) + h * 64);
        }
    }
}

namespace attn_body {
using bf16=__hip_bfloat16;
using bf16x8=__attribute__((ext_vector_type(8)))short;
using s16x4=__attribute__((ext_vector_type(4)))short;
using f32x16=__attribute__((ext_vector_type(16)))float;
using u32x4=__attribute__((ext_vector_type(4)))unsigned;
constexpr int D=64, QP=256, KP=128, OP=1024;
constexpr int NW=8,QBLK=32,QB=QBLK*NW,KVBLK=64;
__device__ __forceinline__ int crow(int r,int hi){return (r&3)+8*(r>>2)+4*hi;}
#define SBAR() __builtin_amdgcn_sched_barrier(0)
__device__ __forceinline__ void wmask(f32x16&p0,f32x16&p1,int tb,int qrel,int hi,int q0){
  const float NEG=-INFINITY; const int kb=64*tb+4*hi;
  #pragma unroll
  for(int r=0;r<16;++r){const int kl=kb+(r&3)+8*(r>>2); const int kp=q0-128+kl;
    if(kl<qrel||kl>qrel+256||kp<0||kp>=NSEQ)p0[r]=NEG;
    if(kl+32<qrel||kl+32>qrel+256||kp+32<0||kp+32>=NSEQ)p1[r]=NEG;}
}

constexpr int NSLOT=3, SLOTB=8192;
constexpr int LDS_K=0, LDS_V=NSLOT*SLOTB, LDS_WS=2*NSLOT*SLOTB, LDS_OST=LDS_WS+NW*64*4, LDS_BYTES=LDS_OST+NW*4096;
constexpr float C2=0.125f*1.4426950408889634f;
__device__ __forceinline__ void glds16(const void*gsrc,unsigned lds_dst){unsigned keep;
  asm volatile("s_mov_b32 %0, m0\n\ts_mov_b32 m0, %2\n\ts_nop 0\n\tglobal_load_lds_dwordx4 %1, off\n\ts_mov_b32 m0, %0":"=&s"(keep):"v"(gsrc),"s"(lds_dst):"memory");}
__device__ __forceinline__ float max3f(float a,float b,float c){float r;asm("v_max3_f32 %0, %1, %2, %3":"=v"(r):"v"(a),"v"(b),"v"(c));return r;}
__device__ __forceinline__ float max2f(float a,float b){float r;asm("v_max_f32_e32 %0, %1, %2":"=v"(r):"v"(a),"v"(b));return r;}
__device__ __forceinline__ float fadd_s(float a,float b){float r;asm("v_add_f32_e32 %0, %1, %2":"=v"(r):"v"(a),"v"(b));return r;}
__device__ __forceinline__ float fsub_s(float a,float b){float r;asm("v_sub_f32_e32 %0, %1, %2":"=v"(r):"v"(a),"v"(b));return r;}
typedef float f32x2_t __attribute__((ext_vector_type(2))); typedef __bf16 bf16x2_t __attribute__((ext_vector_type(2)));
__device__ __forceinline__ unsigned cvtpk_s(float lo,float hi){f32x2_t v={lo,hi};bf16x2_t b=__builtin_convertvector(v,bf16x2_t);return __builtin_bit_cast(unsigned,b);}
#define WAIT_BAR(N) asm volatile("s_waitcnt vmcnt(" #N ") lgkmcnt(0)\n\ts_barrier":::"memory")

__device__ __forceinline__ void qkt(f32x16&p0,f32x16&p1,const char*Kslot,const bf16x8*qr,const f32x16&negm,int r32,int hi){
  const char*kb=Kslot+hi*1024+r32*16;
  #pragma unroll
  for(int d0=0;d0<4;++d0){
    const bf16x8 b0=*reinterpret_cast<const bf16x8*>(kb+d0*2048);
    const bf16x8 b1=*reinterpret_cast<const bf16x8*>(kb+d0*2048+512);
    if(d0==0){p0=__builtin_amdgcn_mfma_f32_32x32x16_bf16(b0,qr[0],negm,0,0,0);p1=__builtin_amdgcn_mfma_f32_32x32x16_bf16(b1,qr[0],negm,0,0,0);}
    else{p0=__builtin_amdgcn_mfma_f32_32x32x16_bf16(b0,qr[d0],p0,0,0,0);p1=__builtin_amdgcn_mfma_f32_32x32x16_bf16(b1,qr[d0],p1,0,0,0);}}
}
typedef __attribute__((address_space(3))) const char* lds_cptr;
typedef short v4i16_t __attribute__((ext_vector_type(4)));
__device__ __forceinline__ void kload8(bf16x8*kf,lds_cptr kp){
  kf[0]=*(const __attribute__((address_space(3))) bf16x8*)(kp);      kf[1]=*(const __attribute__((address_space(3))) bf16x8*)(kp+512);
  kf[2]=*(const __attribute__((address_space(3))) bf16x8*)(kp+2048); kf[3]=*(const __attribute__((address_space(3))) bf16x8*)(kp+2560);
  kf[4]=*(const __attribute__((address_space(3))) bf16x8*)(kp+4096); kf[5]=*(const __attribute__((address_space(3))) bf16x8*)(kp+4608);
  kf[6]=*(const __attribute__((address_space(3))) bf16x8*)(kp+6144); kf[7]=*(const __attribute__((address_space(3))) bf16x8*)(kp+6656);
}
__device__ __forceinline__ void kload2(bf16x8*kf,lds_cptr kp,int j){ kf[2*j]=*(const __attribute__((address_space(3))) bf16x8*)(kp+j*2048); kf[2*j+1]=*(const __attribute__((address_space(3))) bf16x8*)(kp+j*2048+512); }
__device__ __forceinline__ s16x4 vtr(lds_cptr p){ return __builtin_bit_cast(s16x4,__builtin_amdgcn_ds_read_tr16_b64_v4i16((__attribute__((address_space(3))) v4i16_t*)p)); }
__device__ __forceinline__ float rowmax(const f32x16&p0,const f32x16&p1){
  float a=max3f(p0[0],p0[1],p1[0]),b=max3f(p0[2],p0[3],p1[1]);a=max3f(a,p1[2],p1[3]);
  #pragma unroll
  for(int r=4;r<16;r+=4){a=max3f(a,p0[r],p0[r+1]);b=max3f(b,p0[r+2],p0[r+3]);a=max3f(a,p1[r],p1[r+1]);b=max3f(b,p1[r+2],p1[r+3]);}
  const float m=max2f(a,b);
  auto rr=__builtin_amdgcn_permlane32_swap(__float_as_uint(m),__float_as_uint(m),false,false);
  return max2f(__uint_as_float(rr[0]),__uint_as_float(rr[1]));
}
__device__ __forceinline__ void pv(f32x16*o,int vb,bf16x8 pa0,bf16x8 pa1,bf16x8 pa2,bf16x8 pa3){
  #pragma unroll
  for(int d0=0;d0<2;++d0){s16x4 lo[4],hi[4];
    #pragma unroll
    for(int ks=0;ks<4;++ks){
      asm volatile("ds_read_b64_tr_b16 %0,%1 offset:%c2":"=&v"(lo[ks]):"v"(vb),"i"(d0*4096+ks*1024):"memory");
      asm volatile("ds_read_b64_tr_b16 %0,%1 offset:%c2":"=&v"(hi[ks]):"v"(vb),"i"(d0*4096+ks*1024+512):"memory");}
    asm volatile("s_waitcnt lgkmcnt(0)":::"memory");SBAR();
    #define PK(k) (bf16x8){lo[k][0],lo[k][1],lo[k][2],lo[k][3],hi[k][0],hi[k][1],hi[k][2],hi[k][3]}
    o[d0]=__builtin_amdgcn_mfma_f32_32x32x16_bf16(pa0,PK(0),o[d0],0,0,0);
    o[d0]=__builtin_amdgcn_mfma_f32_32x32x16_bf16(pa1,PK(1),o[d0],0,0,0);
    o[d0]=__builtin_amdgcn_mfma_f32_32x32x16_bf16(pa2,PK(2),o[d0],0,0,0);
    o[d0]=__builtin_amdgcn_mfma_f32_32x32x16_bf16(pa3,PK(3),o[d0],0,0,0);
    #undef PK
  }
}

#ifndef ATTN_STORE16
#define ATTN_STORE16(p,v) (*(u32x4*)(p)=(v))
#endif
template<int MODE,int NMASKT,int THRL> __device__ __forceinline__ void attn_unit(const bf16*Q0,const bf16*__restrict__ Kh,const bf16*__restrict__ Vh,bf16*O0,int NT,int key_first,int q0,bool use_sink,float sink_l2,char*shm){
  const int tid=tid_(),lane=tid&63,r32=lane&31,hi=lane>>5; const int wid=__builtin_amdgcn_readfirstlane(tid>>6);
  const bf16*Qw=Q0+(long)(wid*QBLK)*QP;
  auto krow=[&](int t)->long{ if(MODE==0) return (long)key_first+64*t; if(t<4) return (long)NSEQ+64*t; int p=q0-128+64*(t-4); p=p<0?0:(p>NSEQ-64?NSEQ-64:p); return (long)p; };
  const unsigned lds0=(unsigned)(uintptr_t)shm;
  float*wsf=(float*)(shm+LDS_WS)+wid*64;
  const bf16*ksrc=Kh+(long)lane*KP+wid*8;
  const bf16*vsrc=Vh+(long)(16*(wid&3)+(lane>>2))*KP+(wid>>2)*32+(lane&3)*8;
  const unsigned kdst=lds0+LDS_K+wid*1024, vdst=lds0+LDS_V+wid*1024;
  #define DMA_K(t,slot) glds16(ksrc+krow(t)*KP,(unsigned)__builtin_amdgcn_readfirstlane(kdst+(slot)))
  #define DMA_V(t,slot) glds16(vsrc+krow(t)*KP,(unsigned)__builtin_amdgcn_readfirstlane(vdst+(slot)))
  const int vb0=(int)(lds0+LDS_V)+((lane>>4)&1)*32+(lane&3)*8+(4*hi+((lane&15)>>2))*64;
  const char*Kbase=shm+LDS_K; bf16x8 kf[8];
  const lds_cptr shm3=(lds_cptr)shm; const lds_cptr kp0=shm3+LDS_K+hi*1024+r32*16; const lds_cptr vp0=shm3+LDS_V+((lane>>4)&1)*32+(lane&3)*8+(4*hi+((lane&15)>>2))*64;
  DMA_K(0,0);DMA_V(0,0);DMA_K(1,SLOTB);
  bf16x8 qr[4];
  #pragma unroll
  for(int d0=0;d0<4;++d0)qr[d0]=*reinterpret_cast<const bf16x8*>(&Qw[(long)r32*QP+d0*16+hi*8]);
  float mhat=0.f,l_reg=0.f;f32x16 o[2];o[0]=f32x16{};o[1]=f32x16{};f32x16 negm=f32x16{};asm volatile("":"+v"(negm));
  const int qrel=wid*QBLK+r32;
  #define CMASK(P0,P1,t) do{ if(NMASKT>0){int jb_=(t)-(NT-NMASKT); if(jb_>=0)wmask(P0,P1,jb_,qrel,hi,q0);} }while(0)
  bool resc=false;
  #define START(P0,P1) do{ const float rm=rowmax(P0,P1); resc=false; \
    { const float dl=rm; mhat=fadd_s(mhat,dl); \
      _Pragma("unroll") for(int r=0;r<16;++r){P0[r]=fsub_s(P0[r],dl);P1[r]=fsub_s(P1[r],dl);} \
      _Pragma("unroll") for(int r=0;r<16;++r)negm[r]=-mhat; asm volatile("":"+v"(negm)); } \
    _Pragma("unroll") for(int r=0;r<16;++r)P0[r]=__builtin_amdgcn_exp2f(P0[r]); }while(0)
  #define RESC() do{ if(resc){ asm volatile("s_waitcnt lgkmcnt(0)":::"memory"); \
      _Pragma("unroll") for(int d_=0;d_<2;++d_) _Pragma("unroll") for(int r=0;r<16;++r)o[d_][r]*=wsf[crow(r,hi)]; } }while(0)
  f32x16 pA0,pA1,pB0,pB1;
  int sl_prev=0,sl_cur=0,sl_next=SLOTB;
  #define ROT() do{sl_prev=sl_cur;sl_cur=sl_next;sl_next=(sl_next==(NSLOT-1)*SLOTB)?0:sl_next+SLOTB;}while(0)
  DMA_K(2,2*SLOTB);
  WAIT_BAR(3);
  qkt(pA0,pA1,Kbase,qr,negm,r32,hi);asm volatile("s_nop 15\n\ts_nop 7":"+v"(pA0),"+v"(pA1));CMASK(pA0,pA1,0);
  START(pA0,pA1);
  _Pragma("unroll") for(int r=0;r<16;++r)pA1[r]=__builtin_amdgcn_exp2f(pA1[r]);
  WAIT_BAR(0);
  DMA_K(3,0);DMA_V(1,SLOTB);
  ROT();
  kload8(kf,kp0+sl_cur);
  WAIT_BAR(2);
  s16x4 vlo[8],vhi[8]; u32x4 pw0,pw1,pw2,pw3;
  #define PKW(P,B) cvtpk_s(P[B],P[B+1])
  #define PAF(k) __builtin_bit_cast(bf16x8,pw##k)
  #define VFR(i) (bf16x8){vlo[i][0],vlo[i][1],vlo[i][2],vlo[i][3],vhi[i][0],vhi[i][1],vhi[i][2],vhi[i][3]}
  #define PIN(x) asm volatile("":"+v"(x))
  #define MX3(a,b,c) __builtin_fmaxf(__builtin_fmaxf((a),(b)),(c))
  #define GAPA(MF,A0,A1,A2,A3,W0,W1,PW) do{ MF; sacc+=A0; sacc+=A1; sacc+=A2; sacc+=A3; PIN(sacc); W0; W1; PIN(PW); SBAR(); }while(0)
  #define EX(v) __builtin_amdgcn_exp2f(v)
  #define GAPB(MF,X,B) do{ MF; X[B]=EX(X[B]); X[B+1]=EX(X[B+1]); X[B+2]=EX(X[B+2]); X[B+3]=EX(X[B+3]); PIN(X); SBAR(); }while(0)
  #define VRD(i) do{ vlo[i]=vtr(vp_+(((i)>>2)*4096+((i)&3)*1024)); vhi[i]=vtr(vp_+(((i)>>2)*4096+((i)&3)*1024+512)); }while(0)
  #define KRD(G,j) do{ if(G){ kload2(kf,kp0+sl_next,j); SBAR(); } }while(0)
  #define STEP(C0,C1,P0,P1,t,GK,GV,GL) do{ SBAR(); \
    const lds_cptr vp_=vp0+sl_prev; \
    VRD(0); SBAR(); float sacc=(P0[0]+P0[1]); \
    GAPA(C0=__builtin_amdgcn_mfma_f32_32x32x16_bf16(kf[0],qr[0],negm,0,0,0), P0[2],P0[3],P0[4],P0[5],     pw0[0]=PKW(P0,0), pw0[1]=PKW(P0,2), pw0); \
    VRD(4); SBAR(); GAPA(C1=__builtin_amdgcn_mfma_f32_32x32x16_bf16(kf[1],qr[0],negm,0,0,0), P0[6],P0[7],P0[8],P0[9],     pw0[2]=PKW(P0,4), pw0[3]=PKW(P0,6), pw0); \
    VRD(1); SBAR(); GAPA(C0=__builtin_amdgcn_mfma_f32_32x32x16_bf16(kf[2],qr[1],C0,0,0,0),   P0[10],P0[11],P0[12],P0[13], pw1[0]=PKW(P0,8), pw1[1]=PKW(P0,10), pw1); \
    VRD(5); SBAR(); GAPA(C1=__builtin_amdgcn_mfma_f32_32x32x16_bf16(kf[3],qr[1],C1,0,0,0),   P0[14],P0[15],P1[0],P1[1],   pw1[2]=PKW(P0,12),pw1[3]=PKW(P0,14), pw1); \
    VRD(2); SBAR(); GAPA(C0=__builtin_amdgcn_mfma_f32_32x32x16_bf16(kf[4],qr[2],C0,0,0,0),   P1[2],P1[3],P1[4],P1[5],     pw2[0]=PKW(P1,0), pw2[1]=PKW(P1,2), pw2); \
    VRD(6); SBAR(); GAPA(C1=__builtin_amdgcn_mfma_f32_32x32x16_bf16(kf[5],qr[2],C1,0,0,0),   P1[6],P1[7],P1[8],P1[9],     pw2[2]=PKW(P1,4), pw2[3]=PKW(P1,6), pw2); \
    VRD(3); SBAR(); GAPA(C0=__builtin_amdgcn_mfma_f32_32x32x16_bf16(kf[6],qr[3],C0,0,0,0),   P1[10],P1[11],P1[12],P1[13], pw3[0]=PKW(P1,8), pw3[1]=PKW(P1,10), pw3); \
    VRD(7); SBAR(); GAPA(C1=__builtin_amdgcn_mfma_f32_32x32x16_bf16(kf[7],qr[3],C1,0,0,0),   P1[14],P1[15],0.f,0.f,       pw3[2]=PKW(P1,12),pw3[3]=PKW(P1,14), pw3); \
    l_reg+=sacc; \
    if(GK){DMA_K((t)+3,sl_cur);} if(GV){DMA_V((t)+1,sl_next);} \
    CMASK(C0,C1,t); \
    { float a=MX3(C0[0],C0[1],C1[0]),b=MX3(C0[2],C0[3],C1[1]); a=MX3(a,C1[2],C1[3]); \
      _Pragma("unroll") for(int r=4;r<16;r+=4){a=MX3(a,C0[r],C0[r+1]);b=MX3(b,C0[r+2],C0[r+3]);a=MX3(a,C1[r],C1[r+1]);b=MX3(b,C1[r+2],C1[r+3]);} \
      float rm=__builtin_fmaxf(a,b); { auto rr=__builtin_amdgcn_permlane32_swap(__float_as_uint(rm),__float_as_uint(rm),false,false); rm=__builtin_fmaxf(__uint_as_float(rr[0]),__uint_as_float(rr[1])); } \
      resc=false; \
      if(__builtin_expect(__any(rm>(float)THRL),0)){ const float dl=__builtin_fmaxf(rm,0.f); mhat+=dl; \
        _Pragma("unroll") for(int r=0;r<16;++r){C0[r]-=dl;C1[r]-=dl;} \
        _Pragma("unroll") for(int r=0;r<16;++r)negm[r]=-mhat; asm volatile("":"+v"(negm)); \
        const float f=__builtin_amdgcn_exp2f(-dl); l_reg*=f; if(hi==0)wsf[r32]=f; resc=true; } } \
    SBAR(); \
    GAPB(o[0]=__builtin_amdgcn_mfma_f32_32x32x16_bf16(PAF(0),VFR(0),o[0],0,0,0), C0,0); \
    GAPB(o[1]=__builtin_amdgcn_mfma_f32_32x32x16_bf16(PAF(0),VFR(4),o[1],0,0,0), C0,4); \
    KRD(GL,0); GAPB(o[0]=__builtin_amdgcn_mfma_f32_32x32x16_bf16(PAF(1),VFR(1),o[0],0,0,0), C0,8); \
    KRD(GL,1); GAPB(o[1]=__builtin_amdgcn_mfma_f32_32x32x16_bf16(PAF(1),VFR(5),o[1],0,0,0), C0,12); \
    KRD(GL,2); GAPB(o[0]=__builtin_amdgcn_mfma_f32_32x32x16_bf16(PAF(2),VFR(2),o[0],0,0,0), C1,0); \
    KRD(GL,3); GAPB(o[1]=__builtin_amdgcn_mfma_f32_32x32x16_bf16(PAF(2),VFR(6),o[1],0,0,0), C1,4); \
    GAPB(o[0]=__builtin_amdgcn_mfma_f32_32x32x16_bf16(PAF(3),VFR(3),o[0],0,0,0), C1,8); \
    GAPB(o[1]=__builtin_amdgcn_mfma_f32_32x32x16_bf16(PAF(3),VFR(7),o[1],0,0,0), C1,12); \
    }while(0)
  int t=1;
  #undef CMASK
  #define CMASK(P0,P1,t) do{}while(0)
  for(;t+1+(NMASKT>4?NMASKT:4)<NT;t+=2){
    STEP(pB0,pB1,pA0,pA1,t,true,true,true);     WAIT_BAR(2); RESC(); ROT();
    STEP(pA0,pA1,pB0,pB1,t+1,true,true,true);   WAIT_BAR(2); RESC(); ROT();
  }
  #undef CMASK
  #define CMASK(P0,P1,t) do{ if(NMASKT>0){int jb_=(t)-(NT-NMASKT); if(jb_>=0)wmask(P0,P1,jb_,qrel,hi,q0);} }while(0)
  #define ENDW(tt) do{ if((tt)+3<NT){WAIT_BAR(2);} else if((tt)+2<NT){WAIT_BAR(1);} else {WAIT_BAR(0);} }while(0)
  for(;t+1<NT;t+=2){
    STEP(pB0,pB1,pA0,pA1,t,(t+3<NT),(t+1<NT),(t+1<NT));       ENDW(t);   RESC(); ROT();
    STEP(pA0,pA1,pB0,pB1,t+1,(t+4<NT),(t+2<NT),(t+2<NT));     ENDW(t+1); RESC(); ROT();
  }
  STEP(pB0,pB1,pA0,pA1,NT-1,false,false,false); RESC();
  { float sacc=pB0[0]+pB0[1]; _Pragma("unroll") for(int r=2;r<16;++r)sacc+=pB0[r]; _Pragma("unroll") for(int r=0;r<16;++r)sacc+=pB1[r]; l_reg+=sacc;
    pw0=(u32x4){PKW(pB0,0),PKW(pB0,2),PKW(pB0,4),PKW(pB0,6)};pw1=(u32x4){PKW(pB0,8),PKW(pB0,10),PKW(pB0,12),PKW(pB0,14)};pw2=(u32x4){PKW(pB1,0),PKW(pB1,2),PKW(pB1,4),PKW(pB1,6)};pw3=(u32x4){PKW(pB1,8),PKW(pB1,10),PKW(pB1,12),PKW(pB1,14)};
    SBAR(); pv(o,vb0+sl_cur,PAF(0),PAF(1),PAF(2),PAF(3)); }
  #undef PKW
  #undef PAF
  #undef VFR
  #undef PIN
  #undef MX3
  #undef GAPA
  #undef GAPB
  #undef EX
  #undef VRD
  #undef KRD
  #undef STEP
  #undef ENDW
  {auto rr=__builtin_amdgcn_permlane32_swap(__float_as_uint(l_reg),__float_as_uint(l_reg),false,false);l_reg=__uint_as_float(rr[0])+__uint_as_float(rr[1]);}
  if(use_sink)l_reg+=__builtin_amdgcn_exp2f(sink_l2-mhat);
  if(hi==0)wsf[32+r32]=l_reg;asm volatile("s_waitcnt lgkmcnt(0)":::"memory");
  float rli[16];
  #pragma unroll
  for(int r=0;r<16;++r)rli[r]=__builtin_amdgcn_rcpf(wsf[32+crow(r,hi)]);
  bf16*Ow=O0+(long)(wid*QBLK)*OP;
  { bf16*stg=(bf16*)(shm+LDS_OST)+wid*2048;
    #pragma unroll
    for(int r=0;r<16;++r){const int orow=crow(r,hi);
      #pragma unroll
      for(int d0=0;d0<2;++d0)stg[orow*64+d0*32+r32]=__float2bfloat16(o[d0][r]*rli[r]);}
    asm volatile("s_waitcnt lgkmcnt(0)":::"memory");
    #pragma unroll
    for(int i=0;i<4;++i){const int row=i*8+(lane>>3),ch=lane&7; const u32x4 v=*(const u32x4*)(stg+row*64+ch*8); ATTN_STORE16(Ow+(long)row*OP+ch*8,v);} }
  asm volatile("s_waitcnt lgkmcnt(0)\n\ts_barrier":::"memory");
  #undef DMA_K
  #undef DMA_V
  #undef CMASK
  #undef START
  #undef RESC
  #undef ROT
}
constexpr int ATTN_LDS_BYTES=LDS_BYTES;
#undef SBAR
#undef WAIT_BAR
}

__device__ __forceinline__ void ph_attn_f(KP p, int l, unsigned char* lds, bool do_scan = true) {
    if (do_scan) { if (FAST_HGRN) hgrn_scan_f(p); else hgrn_scan(p); }
    using attn_body::bf16;
    bf16* Y = (bf16*)(p->ws + Z_YCAT);
    const bf16* Qg = (const bf16*)(p->ws + Z_QG); const bf16* Qw = (const bf16*)(p->ws + Z_QW); const bf16* Qgc = (const bf16*)(p->ws + Z_QGC); const bf16* Qwc = (const bf16*)(p->ws + Z_QWC);
    const bf16* Kg = (const bf16*)(p->ws + Z_KG); const bf16* Kw = (const bf16*)(p->ws + Z_KW); const bf16* Vg = (const bf16*)(p->ws + Z_VG); const bf16* Vw = (const bf16*)(p->ws + Z_VW);
    const int G = gsz_(), bid = bid_();
    __syncthreads();
    for (int vb = bid; vb < 256; vb += G) {
        const int v = (G == 256) ? (((vb & 7) >> 1) * 64 + (vb & 1) * 32 + (vb >> 3)) : vb;
        const int b = v >> 7, kvh = (v >> 6) & 1, h = kvh * 2 + ((v >> 5) & 1), qb = v & 31, row0 = b * NSEQ + qb * 256;
        const size_t kvo = (size_t)b * NKEY * 128 + kvh * 64;
        attn_body::attn_unit<0, 0, 8>(Qg + (size_t)row0 * 256 + h * 64, Kg + kvo, Vg + kvo, Y + (size_t)row0 * D + h * 64, NKEY / 64, 0, 0, false, 0.f, (char*)lds);
        attn_body::attn_unit<1, 8, 8>(Qw + (size_t)row0 * 256 + h * 64, Kw + kvo, Vw + kvo, Y + (size_t)row0 * D + 512 + h * 64, 12, 0, qb * 256, true, p->in[14][l * 4 + h] * LOG2E, (char*)lds);
    }
    if (l == 0) for (int v = bid; v < 16; v += G) {
        const int h = v & 3, b = (v >> 2) & 1, win = v >> 3, row0 = R_LAT + b * NCTX;
        const size_t kvo = (size_t)b * NKEY * 128 + (h >> 1) * 64;
        attn_body::attn_unit<0, 0, 8>((win ? Qwc : Qgc) + (size_t)(b * NCTX) * 256 + h * 64, (win ? Kw : Kg) + kvo, (win ? Vw : Vg) + kvo, Y + (size_t)row0 * D + (win ? 512 : 0) + h * 64, 4, NSEQ, 0, win != 0, p->in[14][l * 4 + h] * LOG2E, (char*)lds);
    }
}

__device__ __forceinline__ void hgrn_pass3_unit(KP p, int l, unsigned char* lds, int unit) {
    float* qs = (float*)lds; float* vs = qs + 4096; float* ks = vs + 4096; float* cs = ks + 4096; float* Ss = cs + 4096; float* sc = Ss + 4096; float* os = sc + 4096;
    const int tid = tid_(), lane = tid & 63, wid = tid >> 6;
    const int cpos = unit % NCHUNK, head = (unit / NCHUNK) & 3, b = unit / (NCHUNK * 4);
    const int row0 = (cpos < 4) ? R_LAT + b * NCTX + cpos * 64 : b * NSEQ + (cpos - 4) * 64;
    for (int i = tid; i < 4096; i += NTHREADS) os[i] = 0.f;
    for (int dir = 0; dir < 2; ++dir) {
        const int j = (cpos < 4) ? (dir ? 3 - cpos : cpos) : 4 + (dir ? 127 - (cpos - 4) : (cpos - 4));
        const int seq = (b * 4 + head) * 2 + dir;
        __syncthreads();
        hgrn_load_chunk(p, l, row0, dir, head, qs, vs, ks, cs);
        const float* Sg = (const float*)(p->ws + Z_U) + ((size_t)seq * NCHUNK + j) * 4096;
        for (int i = tid; i < 4096; i += NTHREADS) Ss[i] = Sg[i];
        for (int i = tid; i < 4096; i += NTHREADS) { const int tau = i >> 6, sig = i & 63; float a = 0.f;
            if (sig <= tau) { for (int d = 0; d < 64; ++d) a += qs[tau * 64 + d] * ks[sig * 64 + d] * __expf(cs[tau * 64 + d] - cs[sig * 64 + d]); }
            sc[i] = a; }
        __syncthreads();
        { const int tau = tid >> 3, e0 = (tid & 7) * 8; float acc[8];
#pragma unroll
          for (int e = 0; e < 8; ++e) acc[e] = 0.f;
          for (int d = 0; d < 64; ++d) { const float qv = qs[tau * 64 + d] * __expf(cs[tau * 64 + d]);
#pragma unroll
              for (int e = 0; e < 8; ++e) acc[e] += qv * Ss[d * 64 + e0 + e]; }
          for (int sig = 0; sig <= tau; ++sig) { const float sv = sc[tau * 64 + sig];
#pragma unroll
              for (int e = 0; e < 8; ++e) acc[e] += sv * vs[sig * 64 + e0 + e]; }
          const int tok = dir ? 63 - tau : tau;
#pragma unroll
          for (int e = 0; e < 8; ++e) os[tok * 64 + e0 + e] += acc[e]; }
        __syncthreads();
    }
    const bf16_t* P = (const bf16_t*)(p->ws + Z_P); bf16_t* Y = (bf16_t*)(p->ws + Z_YCAT);
    for (int tok = wid; tok < 64; tok += 8) { const float v = os[tok * 64 + lane];
        const float y = v * rsqrtf(wave_sum(v * v) * (1.f / 64.f) + EPS) * p->in[22][l * 64 + lane];
        const float g = bf2f(P[(size_t)(row0 + tok) * DIN + C_RG + head * 64 + lane]);
        Y[(size_t)(row0 + tok) * D + 768 + head * 64 + lane] = (bf16_t)f2bf(y * silu_(g)); }
    __syncthreads();
}
__device__ __forceinline__ void ph_hgrn3(KP p, int l, unsigned char* lds) {
    hgrn_pass3_run(p, l, lds);
    if (l == 0 && DEPTH > 1 && gsz_() == 256) { __syncthreads(); ph_cvt(p, 1, lds, 32, 224, CVT_E1, CVT_E2); }
}

__device__ __forceinline__ void ph_outproj(KP p, int l, unsigned char* lds) {
    const bf16_t* A = (const bf16_t*)(p->ws + Z_YCAT); const bf16_t* Bt = (const bf16_t*)(p->ws + Z_WOUT); float* X = (float*)(p->ws + WS_X);
    const int T = (l == 0) ? R_ALL : R_LAT; const int TM = T / 128, TN = 8;
    for (int it = bid_(); it < TM * TN; it += gsz_()) { const int mt = it / TN, nt = it % TN;
        auto epi = [&](int row, int col, float v, float) { const int c = nt * 128 + col; X[(size_t)row * D + c] = xrow_src(p, l, row)[c] + mod_vec(p, l, row, 2)[c] * v; };
        gemm_simple_tile<1>(A, RowId{}, Bt, 1024, mt * 128, nt * 128, 0, epi); }
}

__device__ __forceinline__ void ph_norm2(KP p, int l, unsigned char* lds, int cnt_off = 0) {
    constexpr int RS = 1032, NSTG = 80;
    const int T = (l == 0) ? R_ALL : R_LAT;
    bf16_t* AH = (bf16_t*)lds; bf16_t* AL = AH + 16 * RS;
    float* PART = (float*)(lds + 2 * 16 * RS * 2); float* LOG = PART + 8 * 16 * 64;
    int* hist = (int*)(LOG + 16 * 64); int* hbase = hist + 64; int* s_e = hbase + 64; int* s_r = s_e + NSTG * 8; float* s_w = (float*)(s_r + NSTG * 8); float* msb = s_w + NSTG * 8;
    const int tid = tid_(), lane = tid & 63, wid = tid >> 6, fr = lane & 15, fq = lane >> 4, bid = bid_(), G = gsz_();
    bf16_t* Tok = (bf16_t*)(p->ws + Z_A); const bf16_t* X = (const bf16_t*)(p->ws + WS_X);
    const float* g2 = p->in[7] + l * D; const float* rw = p->in[23] + (size_t)l * 1024 * 64; const float* rbias = p->in[24] + l * 64;
    unsigned* cnt = (unsigned*)(p->ws + WS_CTL) + CW_CNT + cnt_off + l * 64;
    int* tok_e = (int*)(p->ws + WS_TOKE); int* tok_p = (int*)(p->ws + WS_TOKP); int* expl = (int*)(p->ws + WS_EXPL); float* expw = (float*)(p->ws + WS_EXPW);
    bf16x8 bh[4][4], bl[4][4];
#pragma unroll
    for (int t = 0; t < 4; ++t)
#pragma unroll
        for (int k = 0; k < 4; ++k) { float v[8], lo[8];
#pragma unroll
            for (int j = 0; j < 8; ++j) v[j] = rw[(size_t)((wid * 4 + k) * 32 + fq * 8 + j) * 64 + t * 16 + fr];
            const u32x4 hh = pack8(v);
            const float hf[8] = {bf2f(hh.x & 0xffffu), bf2f(hh.x >> 16), bf2f(hh.y & 0xffffu), bf2f(hh.y >> 16), bf2f(hh.z & 0xffffu), bf2f(hh.z >> 16), bf2f(hh.w & 0xffffu), bf2f(hh.w >> 16)};
#pragma unroll
            for (int j = 0; j < 8; ++j) lo[j] = v[j] - hf[j];
            const u32x4 ll = pack8(lo);
            bh[t][k] = __builtin_bit_cast(bf16x8, hh); bl[t][k] = __builtin_bit_cast(bf16x8, ll); }
    const float mybias = rbias[lane];
    const int rpb = (T + G - 1) / G;
    for (int base = bid * rpb; base < T; base += G * rpb) {
        const int r1 = (base + rpb < T) ? base + rpb : T;
        if (tid < 64) hist[tid] = 0;
        for (int s0 = base; s0 < r1; s0 += 16) {
#pragma unroll
            for (int j2 = 0; j2 < 2; ++j2) { const int lr = wid * 2 + j2, row = s0 + lr;
                if (row < r1) {
                    const bf16_t* xrow = X + (size_t)row * D; const float* shift = mod_vec(p, l, row, 3); const float* scale = mod_vec(p, l, row, 4);
                    f32x4 v[4]; float ssq = 0.f;
#pragma unroll
                    for (int j = 0; j < 4; ++j) { const u32x2 r2 = ((const u32x2*)xrow)[lane + 64 * j]; v[j].x = bf2f(r2.x & 0xffffu); v[j].y = bf2f(r2.x >> 16); v[j].z = bf2f(r2.y & 0xffffu); v[j].w = bf2f(r2.y >> 16); ssq += v[j].x * v[j].x + v[j].y * v[j].y + v[j].z * v[j].z + v[j].w * v[j].w; }
                    const float rinv = rsqrtf(wave_sum(ssq) * (1.f / D) + EPS);
#pragma unroll
                    for (int j = 0; j < 4; ++j) { const int idx = lane + 64 * j;
                        const f32x4 gg = ((const f32x4*)g2)[idx], sh = ((const f32x4*)shift)[idx], sc = ((const f32x4*)scale)[idx];
                        f32x4 y; y.x = v[j].x * rinv * gg.x * (1.f + sc.x) + sh.x; y.y = v[j].y * rinv * gg.y * (1.f + sc.y) + sh.y;
                        y.z = v[j].z * rinv * gg.z * (1.f + sc.z) + sh.z; y.w = v[j].w * rinv * gg.w * (1.f + sc.w) + sh.w;
                        u32x2 h; h.x = pk2(y.x, y.y); h.y = pk2(y.z, y.w);
                        u32x2 lw; lw.x = pk2(y.x - bf2f(h.x & 0xffffu), y.y - bf2f(h.x >> 16)); lw.y = pk2(y.z - bf2f(h.y & 0xffffu), y.w - bf2f(h.y >> 16));
                        { int t8 = __builtin_amdgcn_cvt_pk_fp8_f32(clamp8(y.x * TOK8_SCALE), clamp8(y.y * TOK8_SCALE), 0, false); t8 = __builtin_amdgcn_cvt_pk_fp8_f32(clamp8(y.z * TOK8_SCALE), clamp8(y.w * TOK8_SCALE), t8, true);
                          ((unsigned*)((unsigned char*)Tok + (size_t)row * D))[idx] = (unsigned)t8; }
                        *(u32x2*)(AH + lr * RS + idx * 4) = h; *(u32x2*)(AL + lr * RS + idx * 4) = lw; }
                } else {
#pragma unroll
                    for (int j = 0; j < 4; ++j) { const int idx = lane + 64 * j; const u32x2 z = {0u, 0u}; *(u32x2*)(AH + lr * RS + idx * 4) = z; *(u32x2*)(AL + lr * RS + idx * 4) = z; } } }
            __syncthreads();
            { f32x4 acc[4];
#pragma unroll
              for (int t = 0; t < 4; ++t) acc[t] = (f32x4){0.f, 0.f, 0.f, 0.f};
#pragma unroll
              for (int k = 0; k < 4; ++k) { const int ko = (wid * 4 + k) * 32 + fq * 8;
                  const bf16x8 ah = *(const bf16x8*)(AH + fr * RS + ko), al = *(const bf16x8*)(AL + fr * RS + ko);
#pragma unroll
                  for (int t = 0; t < 4; ++t) { acc[t] = __builtin_amdgcn_mfma_f32_16x16x32_bf16(ah, bh[t][k], acc[t], 0, 0, 0);
                      acc[t] = __builtin_amdgcn_mfma_f32_16x16x32_bf16(ah, bl[t][k], acc[t], 0, 0, 0); acc[t] = __builtin_amdgcn_mfma_f32_16x16x32_bf16(al, bh[t][k], acc[t], 0, 0, 0); } }
#pragma unroll
              for (int t = 0; t < 4; ++t)
#pragma unroll
                  for (int r = 0; r < 4; ++r) PART[(wid * 16 + fq * 4 + r) * 64 + t * 16 + fr] = acc[t][r]; }
            __syncthreads();
#pragma unroll
            for (int q = 0; q < 2; ++q) { const int o = tid + q * NTHREADS; float a = 0.f;
#pragma unroll
                for (int w8 = 0; w8 < 8; ++w8) a += PART[w8 * 1024 + o];
                LOG[o] = a; }
            __syncthreads();
#pragma unroll 1
            for (int j2 = 0; j2 < 2; ++j2) { const int lr = wid * 2 + j2, row = s0 + lr;
                if (row >= r1) continue;
                const int sr = row - base;
                const float score = sigmoid_(LOG[lr * 64 + lane]), sel = score + mybias;
                const int e = lane, g = e >> 3;
                int rg = 0;
#pragma unroll
                for (int i = 1; i < 8; ++i) { const int src = (lane & ~7) | ((lane + i) & 7); const float o = __shfl(sel, src); rg += (o > sel) || (o == sel && src < e); }
                float top2 = (rg < 2) ? sel : 0.f;
                top2 += __shfl_xor(top2, 1); top2 += __shfl_xor(top2, 2); top2 += __shfl_xor(top2, 4);
                int grank = 0;
#pragma unroll
                for (int i = 1; i < 8; ++i) { const int og = (g + i) & 7; const float o = __shfl(top2, og * 8); grank += (o > top2) || (o == top2 && og < g); }
                const bool keep = grank < 4;
                const float ms = keep ? sel : -INFINITY;
                float* mrow = msb + wid * 64;
                mrow[lane] = ms;
                __builtin_amdgcn_wave_barrier();
                int rk = 0;
#pragma unroll 4
                for (int i = 0; i < 16; ++i) { const f32x4 o = *(const f32x4*)(mrow + 4 * i);
                    rk += (o.x > ms) || (o.x == ms && 4 * i + 0 < e); rk += (o.y > ms) || (o.y == ms && 4 * i + 1 < e);
                    rk += (o.z > ms) || (o.z == ms && 4 * i + 2 < e); rk += (o.w > ms) || (o.w == ms && 4 * i + 3 < e); }
                __builtin_amdgcn_wave_barrier();
                const bool chosen = keep && rk < 8;
                const float wsum = wave_sum(chosen ? score : 0.f);
                if (chosen) { const int r = atomicAdd(&hist[e], 1); s_e[sr * 8 + rk] = e; s_r[sr * 8 + rk] = r; s_w[sr * 8 + rk] = score / wsum * 2.5f; } }
        }
        __syncthreads();
        if (tid < 64) { const int h = hist[tid]; hbase[tid] = h ? (int)atomicAdd(&cnt[tid], (unsigned)h) : 0; }
        __syncthreads();
        for (int i = tid; i < (r1 - base) * 8; i += NTHREADS) { const int e = s_e[i]; const size_t o = (size_t)base * 8 + i;
            const int pos = hbase[e] + s_r[i]; tok_e[o] = e; tok_p[o] = pos; expl[(size_t)e * R_ALL + pos] = base + (i >> 3); expw[(size_t)e * R_ALL + pos] = s_w[i]; }
        __syncthreads();
    }
}

__device__ __forceinline__ void moe_pad_starts(KP p, int l, int* ps) {
    const unsigned* cnt = (const unsigned*)(p->ws + WS_CTL) + CW_CNT + l * 64;
    const int tid = tid_();
    if (tid < 64) { const int v = (int)((cnt[tid] + 255u) >> 8) << 8; int incl = v;
#pragma unroll
        for (int d = 1; d < 64; d <<= 1) { const int o = __shfl_up(incl, d); if (tid >= d) incl += o; }
        ps[tid] = incl - v; if (tid == 63) ps[64] = incl; }
    __syncthreads();
}
__device__ __forceinline__ int moe_expert_of_row(const int* ps, int row) { int e = 0;
#pragma unroll
    for (int step = 32; step >= 1; step >>= 1) if (row >= ps[e + step]) e += step;
    return e; }

__device__ __forceinline__ void ph_slots(KP p, int l, unsigned char* lds) {
    const int T = (l == 0) ? R_ALL : R_LAT;
    int* ps = (int*)lds; moe_pad_starts(p, l, ps);
    const unsigned* cnt = (const unsigned*)(p->ws + WS_CTL) + CW_CNT + l * 64;
    const int* tok_e = (const int*)(p->ws + WS_TOKE); const int* tok_p = (const int*)(p->ws + WS_TOKP); const float* tok_w = (const float*)(p->ws + WS_TOKW);
    int* tok_s = (int*)(p->ws + WS_TOKS); int* slot_t = (int*)(p->ws + WS_SLOTT); float* slot_w = (float*)(p->ws + WS_SLOTW);
    for (int i = bid_() * NTHREADS + tid_(); i < T * 8; i += gsz_() * NTHREADS) { const int e = tok_e[i], slot = ps[e] + tok_p[i]; tok_s[i] = slot; slot_t[slot] = i >> 3; slot_w[slot] = tok_w[i]; }
    for (int i = bid_() * NTHREADS + tid_(); i < T; i += gsz_() * NTHREADS) { slot_t[MAXSLOT + i] = i; slot_w[MAXSLOT + i] = 1.f; }
    for (int i = bid_() * NTHREADS + tid_(); i < 64 * 256; i += gsz_() * NTHREADS) { const int e = i >> 8, j = i & 255; const int r = ps[e] + (int)cnt[e] + j; if (r < ps[e + 1]) { slot_t[r] = 0; slot_w[r] = 0.f; } }
    __syncthreads();
}

__device__ __forceinline__ void ph_gateup(KP p, int l, unsigned char* lds) {
    const int T = (l == 0) ? R_ALL : R_LAT;
    int* ps = (int*)lds; moe_pad_starts(p, l, ps);
    const bf16_t* Tok = (const bf16_t*)(p->ws + Z_A); const bf16_t* Wgu = (const bf16_t*)(p->ws + Z_WGU); bf16_t* H = (bf16_t*)(p->ws + Z_H);
    const int* slot_t = (const int*)(p->ws + WS_SLOTT); const float* slot_w = (const float*)(p->ws + WS_SLOTW);
    const int n128 = ps[64] / 128, nitems = (n128 + T / 128) * 2;
    for (int it = bid_(); it < nitems; it += gsz_()) { const int rt = it >> 1, pn = it & 1;
        if (rt < n128) { const int e = moe_expert_of_row(ps, rt * 128);
            auto epi = [&](int row, int col, float g, float u) { H[(size_t)row * 256 + pn * 128 + col] = (bf16_t)f2bf(silu_(g) * u * slot_w[row]); };
            gemm_simple_tile<2>(Tok, RowGather{slot_t}, Wgu + (size_t)e * 524288, 1024, rt * 128, pn * 256, 128, epi);
        } else { const int t0 = (rt - n128) * 128;
            auto epi = [&](int row, int col, float g, float u) { H[(size_t)(MAXSLOT + row) * 256 + pn * 128 + col] = (bf16_t)f2bf(silu_(g) * u); };
            gemm_simple_tile<2>(Tok, RowId{}, Wgu + (size_t)64 * 524288, 1024, t0, pn * 256, 128, epi); }
    }
}
__device__ __forceinline__ void ph_down(KP p, int l, unsigned char* lds) {
    const int T = (l == 0) ? R_ALL : R_LAT;
    int* ps = (int*)lds; moe_pad_starts(p, l, ps);
    const bf16_t* H = (const bf16_t*)(p->ws + Z_H); const bf16_t* Wd = (const bf16_t*)(p->ws + WS_WD); bf16_t* Y = (bf16_t*)(p->ws + Z_Y); float* X = (float*)(p->ws + WS_X);
    const int n128 = ps[64] / 128, nitems = (n128 + T / 128) * 8;
    for (int it = bid_(); it < nitems; it += gsz_()) { const int rt = it >> 3, nt = it & 7;
        if (rt < n128) { const int e = moe_expert_of_row(ps, rt * 128);
            auto epi = [&](int row, int col, float v, float) { Y[(size_t)row * D + nt * 128 + col] = (bf16_t)f2bf(v); };
            gemm_simple_tile<1>(H, RowId{}, Wd + (size_t)e * 262144, 256, rt * 128, nt * 128, 0, epi);
        } else { const int t0 = (rt - n128) * 128;
            auto epi = [&](int row, int col, float v, float) { const int t = row - MAXSLOT, c = nt * 128 + col; X[(size_t)t * D + c] += mod_vec(p, l, t, 5)[c] * v; };
            gemm_simple_tile<1>(H, RowId{}, Wd + (size_t)64 * 262144, 256, MAXSLOT + t0, nt * 128, 0, epi); }
    }
}
__device__ __forceinline__ void ph_combine(KP p, int l, unsigned char* lds) {
    typedef float f32x2 __attribute__((ext_vector_type(2)));
    const int T = (l == 0) ? R_ALL : R_LAT;
    const int tid = tid_(), lane = tid & 63, wid = tid >> 6;
    const unsigned char* Y8 = (const unsigned char*)(p->ws + Z_Y); bf16_t* X = (bf16_t*)(p->ws + WS_X); const int* tok_e = (const int*)(p->ws + WS_TOKE); const int* tok_p = (const int*)(p->ws + WS_TOKP);
    int* ps = (int*)lds; moe_pad_starts(p, l, ps);
    const size_t yoff = (size_t)(lane >> 4) * MAXSLOT * 256 + (lane & 15) * 16;
    for (int row = bid_() * 8 + wid; row < T; row += gsz_() * 8) {
        const float* g5 = mod_vec(p, l, row, 5) + lane * 16;
        bf16_t* xr = X + (size_t)row * D + lane * 16;
        const int myslot = ps[tok_e[row * 8 + (lane & 7)]] + tok_p[row * 8 + (lane & 7)];
        u32x4 yv[8];
#pragma unroll
        for (int k = 0; k < 8; ++k) { const int sl = __shfl(myslot, k); yv[k] = *(const u32x4*)(Y8 + yoff + (size_t)sl * 256); }
        f32x4 xv[4], gv[4];
#pragma unroll
        for (int q = 0; q < 4; ++q) gv[q] = *(const f32x4*)(g5 + 4 * q);
        unpack8(*(const u32x4*)xr, xv[0], xv[1]); unpack8(*(const u32x4*)(xr + 8), xv[2], xv[3]);
        float a[16];
#pragma unroll
        for (int q = 0; q < 16; ++q) a[q] = 0.f;
#pragma unroll
        for (int k = 0; k < 8; ++k) { const unsigned w[4] = {yv[k].x, yv[k].y, yv[k].z, yv[k].w};
#pragma unroll
            for (int q = 0; q < 4; ++q) { const f32x2 lo = __builtin_amdgcn_cvt_pk_f32_fp8((int)w[q], false), hi = __builtin_amdgcn_cvt_pk_f32_fp8((int)w[q], true);
                a[4 * q] += lo.x; a[4 * q + 1] += lo.y; a[4 * q + 2] += hi.x; a[4 * q + 3] += hi.y; } }
#pragma unroll
        for (int q = 0; q < 4; ++q) { f32x4 av; av.x = a[4 * q]; av.y = a[4 * q + 1]; av.z = a[4 * q + 2]; av.w = a[4 * q + 3]; xv[q] = xv[q] + gv[q] * (av * (1.f / Y8_SCALE)); }
        if (l == DEPTH - 1) { float* dst = p->out + (size_t)row * D + lane * 16;
#pragma unroll
            for (int q = 0; q < 4; ++q) *(f32x4*)(dst + 4 * q) = xv[q]; }
        else { *(u32x4*)xr = (u32x4){pk2(xv[0].x, xv[0].y), pk2(xv[0].z, xv[0].w), pk2(xv[1].x, xv[1].y), pk2(xv[1].z, xv[1].w)};
               *(u32x4*)(xr + 8) = (u32x4){pk2(xv[2].x, xv[2].y), pk2(xv[2].z, xv[2].w), pk2(xv[3].x, xv[3].y), pk2(xv[3].z, xv[3].w)}; }
    }
}
struct MoeSched {
    int ntr, nrt, npn, G, c; const LAS int* tile_e;
    __device__ __forceinline__ bool map(int i, int& rt, int& pp) const {
        if (G == 256) { const int x = c & 7, j = c >> 3, tb = 32 / npn; rt = (i * 8 + x) * tb + j / npn; pp = j % npn; return rt < nrt; }
        const int L = i * G + c; if (L >= nrt * npn) return false;
        rt = L / npn; pp = L % npn; return true; }
    __device__ __forceinline__ bool next(int i, pg8::Unit& u) const {
        int rt, pp; if (!map(i, rt, pp)) return false;
        const bool routed = rt < ntr;
        const int e = routed ? __builtin_amdgcn_readfirstlane(tile_e[rt]) : 64;
        u.pm = routed ? rt : MAXSLOT / 256 + (rt - ntr); u.pn = e * npn + pp; u.ord = i; return true;
    }
};
constexpr int MOE_UNITS = 6;
constexpr int LDS_RTAB = 131072, LDS_WTAB = LDS_RTAB + MOE_UNITS * 1024, LDS_TILE_E = LDS_WTAB + MOE_UNITS * 1024, LDS_PS = LDS_TILE_E + 2400;
static_assert(LDS_PS + 129 * 4 <= LDS_BYTES - 16, "MoE tables fit above the staging buffers");
__device__ __forceinline__ MoeSched moe_setup(KP p, int l, unsigned char* lds, int npn, bool gather) {
    const int T = (l == 0) ? R_ALL : R_LAT;
    int* ps = (int*)(lds + LDS_PS); int* cl = ps + 65;
    const unsigned* cnt = (const unsigned*)(p->ws + WS_CTL) + CW_CNT + l * 64;
    const int tid = tid_();
    if (tid < 64) cl[tid] = (int)cnt[tid];
    moe_pad_starts(p, l, ps);
    LAS int* tile_e = (LAS int*)((LAS unsigned char*)lds + LDS_TILE_E); LAS int* rtab = (LAS int*)((LAS unsigned char*)lds + LDS_RTAB); LAS float* wtab = (LAS float*)((LAS unsigned char*)lds + LDS_WTAB);
    const int ntr = ps[64] / 256;
    for (int rt = tid; rt < ntr; rt += NTHREADS) tile_e[rt] = moe_expert_of_row(ps, rt * 256);
    __syncthreads();
    MoeSched S{ntr, ntr + T / 256, npn, gsz_(), bid_(), tile_e};
    if (gather) { const int* expl = (const int*)(p->ws + WS_EXPL); const float* expw = (const float*)(p->ws + WS_EXPW);
        int tok[3]; float w[3];
#pragma unroll
        for (int q = 0; q < 3; ++q) { const int idx = tid + q * NTHREADS, i = idx >> 8, r = idx & 255; tok[q] = 0; w[q] = 0.f;
            int rt, pp_;
            if (S.map(i, rt, pp_)) {
                if (rt < S.ntr) { const int e = tile_e[rt], pos = rt * 256 + r - ps[e];
                    if (pos < cl[e]) { tok[q] = expl[(size_t)e * R_ALL + pos]; w[q] = expw[(size_t)e * R_ALL + pos]; } }
                else { tok[q] = (rt - S.ntr) * 256 + r; w[q] = 1.f; } } }
#pragma unroll
        for (int q = 0; q < 3; ++q) { const int idx = tid + q * NTHREADS; rtab[idx] = tok[q]; wtab[idx] = w[q]; } }
    __syncthreads();
    return S;
}
__device__ __forceinline__ void ph_gateup_f(KP p, int l, unsigned char* lds) {
    const MoeSched S = moe_setup(p, l, lds, 2, true);
    pg8::Gemm g{(const bf16_t*)(p->ws + Z_A), (const bf16_t*)(p->ws + wgu_off(l)), 0, 0, 1024};
    pg8::EpiGU8 E{(unsigned char*)(p->ws + Z_H), (const LAS float*)((LAS unsigned char*)lds + LDS_WTAB)};
    pg8::gemm_phase<pg8::EpiGU8, MoeSched, true, true>((LAS unsigned char*)lds, g, S, E, (const LAS int*)((LAS unsigned char*)lds + LDS_RTAB));
}
__device__ __forceinline__ void ph_down_f(KP p, int l, unsigned char* lds) {
    const MoeSched S = moe_setup(p, l, lds, 4, false);
    pg8::Gemm g{(const bf16_t*)(p->ws + Z_H), (const bf16_t*)(p->ws + wd_off(l)), 0, 0, 256};
    bf16_t* X = (bf16_t*)(p->ws + WS_X);
    pg8::EpiDown E{(bf16_t*)(p->ws + Z_Y), X, (const float*)(p->ws + WS_MOD) + (size_t)l * 3 * 6144 + 5 * 1024};
    pg8::gemm_phase<pg8::EpiDown, MoeSched, false, true>((LAS unsigned char*)lds, g, S, E, nullptr);
}

#ifndef FAST_ATTN
#define FAST_ATTN 1
#endif
#ifndef FAST_GEMM
#define FAST_GEMM 15
#endif
constexpr int PH_PER_LAYER = 10, N_PHASES = 1 + DEPTH * PH_PER_LAYER;
__global__ void __launch_bounds__(NTHREADS, 2) mega(Params parg) {
    extern __shared__ __attribute__((aligned(16))) unsigned char lds[];
    const int lo = parg.ph_lo, hi = parg.ph_hi;
    volatile LAS unsigned* xbw = (volatile LAS unsigned*)(lds + LDS_BYTES - 16);
    if (threadIdx.x == 0) { xbw[0] = 0u; xbw[1] = 0u; xbw[2] = 0u; xbw[3] = 0u; }
    if ((threadIdx.x & 63) == 0) *(volatile LAS int*)((LAS unsigned char*)lds + LDS_WVTAB_OFF + 4 * hwkey_()) = (int)(threadIdx.x >> 6);
    __syncthreads();
    XcdBarrier bar; bar.bar = (unsigned*)(parg.ws + WS_CTL) + CW_BAR; bar.x = 0; bar.st = xbw;
    if (hi - lo > 1) bar = xcd_barrier_post((unsigned*)(parg.ws + WS_CTL) + CW_BAR, xbw);
#ifdef PHMASK
#define IN(k) ((((PHMASK) >> ((k) == 0 ? 0 : ((k) - 1) % PH_PER_LAYER + 1)) & 1) && lo <= (k) && (k) < hi)
#else
#define IN(k) (lo <= (k) && (k) < hi)
#endif
#define SEAM(k) do { if (IN(k) && IN((k) + 1)) xcd_barrier(bar); } while (0)
    if (IN(0)) { ph_pro(kparams(), lds); } SEAM(0);
#pragma unroll
    for (int l = 0; l < DEPTH; ++l) {
        const int b0 = 1 + l * PH_PER_LAYER;
        if (IN(b0 + 0)) { ph_norm1(kparams(), l, lds); } SEAM(b0 + 0);
        if (IN(b0 + 1)) { ph_inproj_f(kparams(), l, lds); } SEAM(b0 + 1);
        if (IN(b0 + 2)) { ph_prep(kparams(), l, lds); } SEAM(b0 + 2);
        if (IN(b0 + 3)) { ph_attn_f(kparams(), l, lds); } SEAM(b0 + 3);
        if (IN(b0 + 4)) { ph_hgrn3(kparams(), l, lds); } SEAM(b0 + 4);
        if (IN(b0 + 5)) { ph_outproj_f(kparams(), l, lds); } SEAM(b0 + 5);
        if (IN(b0 + 6)) { ph_norm2(kparams(), l, lds); } SEAM(b0 + 6);
        if (IN(b0 + 7)) { ph_gateup_f(kparams(), l, lds); } SEAM(b0 + 7);
        if (IN(b0 + 8)) { ph_down_f(kparams(), l, lds); } SEAM(b0 + 8);
        if (IN(b0 + 9)) { ph_combine(kparams(), l, lds); } SEAM(b0 + 9);
    }
#undef IN
#undef SEAM
}

#ifndef MK_ONE_LAUNCH
#define MK_ONE_LAUNCH 1
#endif
extern "C" void kernel_launch(void* const* d_in, const int* in_sizes, int n_in, void* d_out, int out_size, void* d_ws, size_t ws_size, hipStream_t stream) {
    static int grid = 0;
    if (grid == 0) {
        if (n_in != 31 || ws_size < WS_END2) { fprintf(stderr, "kernel_launch: unexpected n_in %d or ws_size %zu (< %zu)\n", n_in, ws_size, (size_t)WS_END2); grid = -1; return; }
        int dev = 0, cus = 0, per_cu = 0;
        if (hipGetDevice(&dev) != hipSuccess || hipDeviceGetAttribute(&cus, hipDeviceAttributeMultiprocessorCount, dev) != hipSuccess) { grid = -1; return; }
        if (hipFuncSetAttribute((const void*)mega, hipFuncAttributeMaxDynamicSharedMemorySize, LDS_BYTES) != hipSuccess) { fprintf(stderr, "kernel_launch: hipFuncSetAttribute failed\n"); grid = -1; return; }
        if (hipOccupancyMaxActiveBlocksPerMultiprocessor(&per_cu, (const void*)mega, NTHREADS, LDS_BYTES) != hipSuccess || per_cu < 1) fprintf(stderr, "kernel_launch: occupancy query says %d\n", per_cu);
        (void)hipGetLastError();
        grid = cus;
    }
    if (grid < 0) return;
    (void)hipMemsetAsync((char*)d_ws + WS_CTL, 0, CTL_ZERO_BYTES, stream);
    Params p{};
    for (int i = 0; i < 31; ++i) p.in[i] = (const float*)d_in[i];
    p.out = (float*)d_out; p.ws = (unsigned char*)d_ws;
#if MK_ONE_LAUNCH
    p.ph_lo = 0; p.ph_hi = N_PHASES;
    hipLaunchKernelGGL(mega, dim3(grid), dim3(NTHREADS), LDS_BYTES, stream, p);
#else
    for (int k = 0; k < N_PHASES; ++k) { p.ph_lo = k; p.ph_hi = k + 1; hipLaunchKernelGGL(mega, dim3(grid), dim3(NTHREADS), LDS_BYTES, stream, p); }
#endif
}
```

```cpp
#include <hip/hip_runtime.h>
#include <hip/hip_bf16.h>
#include <cmath>
#include <cstdint>
#include <cstdio>

#define LAS __attribute__((address_space(3)))

typedef unsigned short bf16_t;
typedef short bf16x8 __attribute__((ext_vector_type(8)));
typedef float f32x4 __attribute__((ext_vector_type(4)));
typedef unsigned u32x4 __attribute__((ext_vector_type(4)));
typedef unsigned u32x2 __attribute__((ext_vector_type(2)));

constexpr int D = 1024, NB = 2, NSEQ = 8192, NCTX = 256, DEPTH = 2;
constexpr int R_LAT = NB * NSEQ, R_CTX = NB * NCTX, R_ALL = R_LAT + R_CTX;
constexpr int DIN = 2816;
constexpr int NKEY = NSEQ + NCTX;
constexpr int NE = 64, TOPK = 8;
constexpr int MAXSLOT = 151552;
constexpr int HROWS = MAXSLOT + R_ALL;
constexpr int NCHUNK = 132;
constexpr float EPS = 1e-6f;
constexpr float TOK8_SCALE = 8.f, WGU8_SCALE = 256.f, H8_SCALE = 16.f, WD8_SCALE = 128.f;
constexpr float GU_DESCALE = 1.f / (TOK8_SCALE * WGU8_SCALE), DN_DESCALE = 1.f / (H8_SCALE * WD8_SCALE);
constexpr float Y8_SCALE = 32.f;
constexpr float QSCALE = 0.125f * 1.4426950408889634f;
constexpr float LOG2E = 1.4426950408889634f;

#ifndef FAST_HGRN
#define FAST_HGRN 1
#endif
constexpr int C_GQ = 0, C_GK = 256, C_GV = 384, C_WQ = 512, C_WK = 768, C_WV = 896, C_CVV = 1024, C_CVG = 1280, C_RQ = 1536, C_RI = 1792, C_RFF = 2048, C_RFB = 2304, C_RG = 2560;

constexpr size_t MiB = (size_t)1 << 20;
constexpr size_t WS_CTL = 0, CTL_ZERO_BYTES = 64 * 1024;
constexpr size_t WS_MOD = 1 * MiB;
constexpr size_t WS_LB = WS_MOD + 256 * 1024;
constexpr size_t WS_ROPE = WS_MOD + 512 * 1024;
constexpr size_t WS_TOKE = 2 * MiB, WS_TOKP = 3 * MiB, WS_TOKW = 4 * MiB, WS_TOKS = 5 * MiB;
constexpr size_t WS_SLOTT = 6 * MiB, WS_SLOTW = 7 * MiB;
constexpr size_t WS_RFRAG = 4 * MiB;
constexpr size_t WS_X = 8 * MiB;
constexpr size_t WS_WD = 74 * MiB;
constexpr size_t WS_Z = 107 * MiB;
constexpr size_t Z_A = WS_Z + 0 * MiB;
constexpr size_t Z_WGU = WS_Z + 33 * MiB;
constexpr size_t Z_WIN = WS_Z + 98 * MiB;
constexpr size_t Z_WOUT = WS_Z + 104 * MiB;
constexpr size_t Z_WPW = WS_Z + 106 * MiB;
__host__ __device__ constexpr size_t wgu_off(int l) { return WS_Z + 33 * MiB + (size_t)l * 34078720; }
__host__ __device__ constexpr size_t wd_off(int l) { return 74 * MiB + (size_t)l * 17039360; }
__host__ __device__ constexpr size_t win_off(int l) { return l == 0 ? WS_Z + 98 * MiB : WS_Z + (302 + 42) * MiB; }
__host__ __device__ constexpr size_t wout_off(int l) { return l == 0 ? WS_Z + 104 * MiB : WS_Z + (302 + 48) * MiB; }
__host__ __device__ constexpr size_t wpw_off(int l) { return l == 0 ? WS_Z + 106 * MiB : WS_Z + (302 + 51) * MiB; }
constexpr size_t Z_P = WS_Z + 107 * MiB;
constexpr size_t Z_YCAT = WS_Z + 198 * MiB;
constexpr size_t Z_QG = WS_Z + 231 * MiB, Z_QW = WS_Z + 239 * MiB;
constexpr size_t Z_KG = WS_Z + 247 * MiB, Z_VG = WS_Z + 252 * MiB, Z_KW = WS_Z + 257 * MiB, Z_VW = WS_Z + 262 * MiB;
constexpr size_t Z_QGC = WS_Z + 267 * MiB, Z_QWC = Z_QGC + 512 * 1024;
constexpr size_t Z_U = WS_Z + 268 * MiB;
constexpr size_t Z_G = WS_Z + 301 * MiB;
constexpr size_t Z_Y = WS_Z + 107 * MiB;
constexpr size_t Z_H = WS_Z + 302 * MiB;
constexpr size_t WS_END = WS_Z + 385 * MiB;
constexpr size_t WS_EXPL = WS_END, WS_EXPW = WS_END + 5 * MiB, WS_END2 = WS_END + 10 * MiB;
static_assert(Z_H + (size_t)HROWS * 512 <= WS_END, "H fits");
static_assert(Z_Y + (size_t)MAXSLOT * 1024 <= Z_U, "Y8 below the HGRN state buffers");
static_assert(Z_P + (size_t)R_ALL * DIN * 2 <= Z_YCAT, "P fits");

constexpr int CW_BAR = 0;
constexpr int CW_CNT = 4096;

constexpr int LDS_BYTES = 147456;
constexpr int NTHREADS = 512;

struct Params {
    const float* in[31];
    float* out;
    unsigned char* ws;
    int ph_lo, ph_hi;
};

typedef const __attribute__((address_space(4))) Params* KP;
__device__ __forceinline__ KP kparams() { KP k = (KP)__builtin_amdgcn_kernarg_segment_ptr(); asm volatile("" : "+s"(k)); return k; }

constexpr int LDS_WVTAB_OFF = 147456 - 16 - 256;
__device__ __forceinline__ int hwkey_() { return (int)__builtin_amdgcn_s_getreg((5 << 11) | 4) & 63; }
__device__ __forceinline__ int tid_() { extern __shared__ __attribute__((aligned(16))) unsigned char lds_all[];
    const int w = __builtin_amdgcn_readfirstlane(*(const LAS int*)((LAS unsigned char*)lds_all + LDS_WVTAB_OFF + 4 * hwkey_()));
    unsigned z; asm volatile("v_mov_b32 %0, 0" : "=v"(z));
    int t = (w << 6) | (int)__builtin_amdgcn_mbcnt_hi(~0u, __builtin_amdgcn_mbcnt_lo(~0u, z)); asm volatile("" : "+v"(t)); return t; }
__device__ __forceinline__ int bid_() { int b = blockIdx.x; asm volatile("" : "+s"(b)); return b; }
__device__ __forceinline__ int gsz_() { int g = gridDim.x; asm volatile("" : "+s"(g)); return g; }

__device__ __forceinline__ unsigned f2bf(float f) { unsigned u = __float_as_uint(f); return (u + 0x7fffu + ((u >> 16) & 1u)) >> 16; }
__device__ __forceinline__ float bf2f(unsigned h) { return __uint_as_float(h << 16); }
__device__ __forceinline__ unsigned pk2(float lo, float hi) { unsigned r; asm("v_cvt_pk_bf16_f32 %0, %1, %2" : "=v"(r) : "v"(lo), "v"(hi)); return r; }
__device__ __forceinline__ u32x4 pack8(const float (&x)[8]) { u32x4 o; o.x = pk2(x[0], x[1]); o.y = pk2(x[2], x[3]); o.z = pk2(x[4], x[5]); o.w = pk2(x[6], x[7]); return o; }
__device__ __forceinline__ void unpack8(const u32x4 r, f32x4& lo, f32x4& hi) { lo.x = bf2f(r.x & 0xffffu); lo.y = bf2f(r.x >> 16); lo.z = bf2f(r.y & 0xffffu); lo.w = bf2f(r.y >> 16); hi.x = bf2f(r.z & 0xffffu); hi.y = bf2f(r.z >> 16); hi.z = bf2f(r.w & 0xffffu); hi.w = bf2f(r.w >> 16); }
__device__ __forceinline__ float wave_sum(float v) {
#pragma unroll
    for (int o = 1; o < 64; o <<= 1) v += __shfl_xor(v, o);
    return v;
}
__device__ __forceinline__ float clamp8(float v) { return fminf(fmaxf(v, -440.f), 440.f); }
__device__ __forceinline__ float sigmoid_(float x) { return __builtin_amdgcn_rcpf(1.f + __expf(-x)); }
__device__ __forceinline__ float silu_(float x) { return x * sigmoid_(x); }

__device__ __forceinline__ const float* xrow_src(KP p, int l, int row) {
    if (l == 0) return (row < R_LAT) ? p->in[0] + (size_t)row * D : p->in[2] + (size_t)(row - R_LAT) * D;
    return (const float*)(p->ws + WS_X) + (size_t)row * D;
}
__device__ __forceinline__ const float* mod_vec(KP p, int l, int row, int i) {
    const int r = (row < R_LAT) ? (row >> 13) : 2;
    return (const float*)(p->ws + WS_MOD) + ((size_t)l * 3 + r) * 6144 + i * 1024;
}

#define XB_TMO      128
#define XB_XCNT(j)  (256  + 64 * (j))
#define XB_XSUB(j)  (1280 + 64 * (j))
#define XB_XGEN(j)  (2304 + 64 * (j))
#define XB_TOP      3328
#define XB_TOPGEN   3392
#define XCD_BAR_WORDS 3456
#define XB_SPIN_CAP (1u << 18)
__device__ __forceinline__ unsigned xb_ld(unsigned* p)              { return __hip_atomic_load(p, __ATOMIC_RELAXED, __HIP_MEMORY_SCOPE_AGENT); }
__device__ __forceinline__ unsigned xb_add(unsigned* p, unsigned v) { return __hip_atomic_fetch_add(p, v, __ATOMIC_RELAXED, __HIP_MEMORY_SCOPE_AGENT); }
__device__ __forceinline__ unsigned xb_xcc_id() { return (unsigned)__builtin_amdgcn_s_getreg((3 << 11) | 20) & 0xFu; }
#define XB_SPIN(cond, bar) do { unsigned _sp = 0; while (cond) { __builtin_amdgcn_s_sleep(1); \
    if ((++_sp & 255u) == 0u) { if (xb_ld(&(bar)[XB_TMO])) break; if (_sp > XB_SPIN_CAP) { atomicAdd(&(bar)[XB_TMO], 1u); break; } } } } while (0)
struct XcdBarrier { unsigned* bar; unsigned x; volatile LAS unsigned* st; };
__device__ __forceinline__ XcdBarrier xcd_barrier_post(unsigned* bar, volatile LAS unsigned* st) {
    XcdBarrier b; b.bar = bar; b.x = xb_xcc_id(); b.st = st;
    if (tid_() == 0) (void)xb_add(&bar[XB_XCNT(b.x)], 1u);
    return b;
}
__device__ __forceinline__ void xcd_barrier_complete(unsigned* bar, unsigned x, unsigned& nloc, unsigned& nx) {
    const unsigned G = gridDim.x * gridDim.y * gridDim.z;
    unsigned sum, cnt, mine, sp = 0u;
    for (;;) {
        sum = 0u; cnt = 0u; mine = 0u;
#pragma unroll
        for (unsigned j = 0; j < 16; ++j) { const unsigned c = xb_ld(&bar[XB_XCNT(j)]); sum += c; cnt += (c > 0u) ? 1u : 0u; mine = (j == x) ? c : mine; }
        if (sum == G) break;
        __builtin_amdgcn_s_sleep(1);
        if ((++sp & 255u) == 0u) { if (xb_ld(&bar[XB_TMO])) break; if (sp > XB_SPIN_CAP) { atomicAdd(&bar[XB_TMO], 1u); break; } }
    }
    nloc = mine > 0u ? mine : 1u; nx = cnt > 0u ? cnt : 1u;
}
__device__ __forceinline__ void xcd_barrier(const XcdBarrier& b) {
    asm volatile("s_waitcnt vmcnt(0)" ::: "memory");
    __syncthreads();
    if (tid_() == 0) {
        unsigned* bar = b.bar;
        __builtin_amdgcn_s_waitcnt(0);
        unsigned nloc = b.st[0], nx = b.st[1];
        if (nloc == 0u) { xcd_barrier_complete(bar, b.x, nloc, nx); b.st[0] = nloc; b.st[1] = nx; }
        const unsigned old = xb_add(&bar[XB_XSUB(b.x)], 1u);
        const unsigned gen = old / nloc;
        if (old + 1u == (gen + 1u) * nloc) {
            __builtin_amdgcn_fence(__ATOMIC_RELEASE, "agent");
            asm volatile("s_waitcnt vmcnt(0)" ::: "memory");
            const unsigned og = xb_add(&bar[XB_TOP], 1u);
            const unsigned tg = og / nx;
            if (og + 1u == (tg + 1u) * nx) xb_add(&bar[XB_TOPGEN], 1u);
            else XB_SPIN(xb_ld(&bar[XB_TOPGEN]) == tg, bar);
            __builtin_amdgcn_fence(__ATOMIC_ACQUIRE, "agent");
            xb_add(&bar[XB_XGEN(b.x)], 1u);
            asm volatile("s_waitcnt vmcnt(0)" ::: "memory");
        } else {
            XB_SPIN(xb_ld(&bar[XB_XGEN(b.x)]) == gen, bar);
            __builtin_amdgcn_fence(__ATOMIC_ACQUIRE, "agent");
            asm volatile("s_waitcnt vmcnt(0)" ::: "memory");
        }
    }
    __syncthreads();
}

__device__ __forceinline__ void ph_pro(KP p, unsigned char* lds) {
    float* sc = (float*)lds;
    float* red = sc + 3 * 1024;
    const int tid = tid_(), lane = tid & 63, wid = tid >> 6;
    for (int i = tid; i < 3 * 1024; i += NTHREADS) { const int r = i >> 10, k = i & 1023; const float v = (r < 2) ? p->in[1][r * 1024 + k] : p->in[3][k]; sc[i] = silu_(v); }
    __syncthreads();
    float* mod = (float*)(p->ws + WS_MOD);
    for (int item = bid_(); item < DEPTH * 96 + DEPTH * 8; item += gsz_()) {
        if (item >= DEPTH * 96) {
            const int fi = item - DEPTH * 96, lf = fi >> 3, w = fi & 7, fr = lane & 15, fq = lane >> 4; const float* rw = p->in[23] + (size_t)lf * 1024 * 64;
            u32x4* RF = (u32x4*)(p->ws + WS_RFRAG);
#pragma unroll
            for (int s = 0; s < 2; ++s) { const int tk = wid * 2 + s, t = tk >> 2, k = tk & 3; float v[8], lo[8];
#pragma unroll
                for (int j = 0; j < 8; ++j) v[j] = rw[(size_t)((w * 4 + k) * 32 + fq * 8 + j) * 64 + t * 16 + fr];
                const u32x4 hh = pack8(v);
                const float hf[8] = {bf2f(hh.x & 0xffffu), bf2f(hh.x >> 16), bf2f(hh.y & 0xffffu), bf2f(hh.y >> 16), bf2f(hh.z & 0xffffu), bf2f(hh.z >> 16), bf2f(hh.w & 0xffffu), bf2f(hh.w >> 16)};
#pragma unroll
                for (int j = 0; j < 8; ++j) lo[j] = v[j] - hf[j];
                const size_t o = ((size_t)(((lf * 8 + w) * 4 + t) * 4 + k) * 64 + lane) * 2;
                RF[o] = hh; RF[o + 1] = pack8(lo); }
            continue; }
        const int l = item / 96, j0 = (item % 96) * 64;
        const float* w = p->in[4] + (size_t)l * 1024 * 6144;
        float a0 = 0.f, a1 = 0.f, a2 = 0.f;
        const int k0 = wid * 128;
#pragma unroll 1
        for (int k = k0; k < k0 + 128; k += 16) { float wv[16];
#pragma unroll
            for (int u = 0; u < 16; ++u) wv[u] = w[(size_t)(k + u) * 6144 + j0 + lane];
#pragma unroll
            for (int u = 0; u < 16; ++u) { a0 += sc[k + u] * wv[u]; a1 += sc[1024 + k + u] * wv[u]; a2 += sc[2048 + k + u] * wv[u]; } }
        red[(wid * 3 + 0) * 64 + lane] = a0; red[(wid * 3 + 1) * 64 + lane] = a1; red[(wid * 3 + 2) * 64 + lane] = a2;
        __syncthreads();
        if (tid < 192) { const int r = tid >> 6; float s = 0.f;
            for (int w8 = 0; w8 < 8; ++w8) s += red[(w8 * 3 + r) * 64 + lane];
            mod[((size_t)l * 3 + r) * 6144 + j0 + lane] = s + p->in[5][l * 6144 + j0 + lane]; }
        __syncthreads();
    }
    if (bid_() == 0) {
        float* rt = (float*)(p->ws + WS_ROPE);
        for (int i = tid; i < 128 * 16; i += NTHREADS) { const int pos = i >> 4, f = i & 15; const float inv = powf(10000.f, -(float)f * (1.f / 16.f)); float sn, cs; sincosf((float)pos * inv, &sn, &cs);
            rt[pos * 32 + f] = cs; rt[pos * 32 + 16 + f] = sn; }
    }
    if (bid_() == gsz_() - 1) {
        float* lb = (float*)(p->ws + WS_LB);
        for (int i = tid; i < 2 * 2 * 256; i += NTHREADS) { const int l = i >> 9, dir = (i >> 8) & 1, ch = i & 255;
            const float* lg = p->in[21];
            const float l0 = lg[(dir * 2 + 0) * 256 + ch], l1 = lg[(dir * 2 + 1) * 256 + ch]; const float m = fmaxf(l0, l1);
            const float e0 = expf(l0 - m), e1 = expf(l1 - m);
            lb[i] = (l == 0) ? 0.f : e1 / (e0 + e1); }
    }
}

constexpr int CVT_E1 = 1050, CVT_E2 = 2850;
struct CvtTile { const float* src; bf16_t* dst; int K, N, k0, n0, blk, bstride, boff; float f8scale; int perm; };
__device__ __forceinline__ int cvt_total() { return 16 * 44 + 16 * 16 + 4 * 4 + 2 * (64 * 64) + 2 * 64 + 64 * 64 + 64; }
__device__ __forceinline__ CvtTile cvt_decode(KP p, int l, int g) {
    bf16_t* Wgu = (bf16_t*)(p->ws + wgu_off(l)); bf16_t* Wd = (bf16_t*)(p->ws + wd_off(l));
    CvtTile t; int per, tn, r;
    if (g < 704) { r = g; t = {p->in[8] + (size_t)l * 1024 * DIN, (bf16_t*)(p->ws + win_off(l)), 1024, DIN, 0, 0, DIN, 0, 0, 0.f}; tn = 44; per = 704; }
    else if ((g -= 704) < 256) { r = g; t = {p->in[9] + (size_t)l * 1024 * 1024, (bf16_t*)(p->ws + wout_off(l)), 1024, 1024, 0, 0, 1024, 0, 0, 0.f}; tn = 16; per = 256; }
    else if ((g -= 256) < 16) { r = g; t = {p->in[19] + (size_t)l * 65536, (bf16_t*)(p->ws + wpw_off(l)), 256, 256, 0, 0, 256, 0, 0, 0.f}; tn = 4; per = 16; }
    else if ((g -= 16) < 4096) { const int m = g >> 6; r = g & 63; t = {p->in[25] + ((size_t)l * 64 + m) * 262144, (bf16_t*)((unsigned char*)Wgu + (size_t)m * 524288), 1024, 256, 0, 0, 128, 256, 0, WGU8_SCALE}; tn = 4; per = 64; }
    else if ((g -= 4096) < 4096) { const int m = g >> 6; r = g & 63; t = {p->in[26] + ((size_t)l * 64 + m) * 262144, (bf16_t*)((unsigned char*)Wgu + (size_t)m * 524288), 1024, 256, 0, 0, 128, 256, 128, WGU8_SCALE}; tn = 4; per = 64; }
    else if ((g -= 4096) < 64) { r = g; t = {p->in[28] + (size_t)l * 262144, (bf16_t*)((unsigned char*)Wgu + (size_t)64 * 524288), 1024, 256, 0, 0, 128, 256, 0, WGU8_SCALE}; tn = 4; per = 64; }
    else if ((g -= 64) < 64) { r = g; t = {p->in[29] + (size_t)l * 262144, (bf16_t*)((unsigned char*)Wgu + (size_t)64 * 524288), 1024, 256, 0, 0, 128, 256, 128, WGU8_SCALE}; tn = 4; per = 64; }
    else if ((g -= 64) < 4096) { const int m = g >> 6; r = g & 63; t = {p->in[27] + ((size_t)l * 64 + m) * 262144, (bf16_t*)((unsigned char*)Wd + (size_t)m * 262144), 256, 1024, 0, 0, 1024, 0, 0, WD8_SCALE, 1}; tn = 16; per = 64; }
    else { g -= 4096; r = g; t = {p->in[30] + (size_t)l * 262144, (bf16_t*)((unsigned char*)Wd + (size_t)64 * 262144), 256, 1024, 0, 0, 1024, 0, 0, WD8_SCALE, 1}; tn = 16; per = 64; }
    (void)per; t.k0 = (r / tn) * 64; t.n0 = (r % tn) * 64; return t;
}
__device__ __forceinline__ void ph_cvt(KP p, int l, unsigned char* lds, int first = 0, int nwg = 0, int t0 = 0, int t1 = 1 << 30) {
    float* tb = (float*)lds;
    const int tid = tid_(), G = nwg ? nwg : gsz_(), total = t1 < cvt_total() ? t1 : cvt_total();
    const int r0 = tid >> 4, c0 = (tid & 15) * 4, nn = tid >> 3, kc = (tid & 7) * 8;
    int g = bid_() - first, buf = 0;
    if (g < 0) return;
    g += t0;
    if (g >= total) return;
    CvtTile T = cvt_decode(p, l, g);
    f32x4 v0 = *(const f32x4*)(T.src + (size_t)(T.k0 + r0) * T.N + T.n0 + c0), v1 = *(const f32x4*)(T.src + (size_t)(T.k0 + r0 + 32) * T.N + T.n0 + c0);
    for (;;) {
        float* t = tb + buf * (64 * 65);
        t[r0 * 65 + c0] = v0.x; t[r0 * 65 + c0 + 1] = v0.y; t[r0 * 65 + c0 + 2] = v0.z; t[r0 * 65 + c0 + 3] = v0.w;
        t[(r0 + 32) * 65 + c0] = v1.x; t[(r0 + 32) * 65 + c0 + 1] = v1.y; t[(r0 + 32) * 65 + c0 + 2] = v1.z; t[(r0 + 32) * 65 + c0 + 3] = v1.w;
        const CvtTile C = T; const int gn = g + G; const bool more = gn < total;
        if (more) { T = cvt_decode(p, l, gn);
            v0 = *(const f32x4*)(T.src + (size_t)(T.k0 + r0) * T.N + T.n0 + c0); v1 = *(const f32x4*)(T.src + (size_t)(T.k0 + r0 + 32) * T.N + T.n0 + c0); }
        __syncthreads();
        { const int n = C.n0 + nn; int drow = (n / C.blk) * C.bstride + C.boff + (n % C.blk);
          if (C.perm) drow = (n & ~255) + ((n >> 3) & 1) * 128 + ((n >> 6) & 3) * 32 + ((n >> 4) & 3) * 8 + (n & 7);
          if (C.f8scale != 0.f) { const float sc = C.f8scale;
              int w0 = __builtin_amdgcn_cvt_pk_fp8_f32(clamp8(t[(kc + 0) * 65 + nn] * sc), clamp8(t[(kc + 1) * 65 + nn] * sc), 0, false); w0 = __builtin_amdgcn_cvt_pk_fp8_f32(clamp8(t[(kc + 2) * 65 + nn] * sc), clamp8(t[(kc + 3) * 65 + nn] * sc), w0, true);
              int w1 = __builtin_amdgcn_cvt_pk_fp8_f32(clamp8(t[(kc + 4) * 65 + nn] * sc), clamp8(t[(kc + 5) * 65 + nn] * sc), 0, false); w1 = __builtin_amdgcn_cvt_pk_fp8_f32(clamp8(t[(kc + 6) * 65 + nn] * sc), clamp8(t[(kc + 7) * 65 + nn] * sc), w1, true);
              u32x2 o8; o8.x = (unsigned)w0; o8.y = (unsigned)w1;
              *(u32x2*)((unsigned char*)C.dst + (size_t)drow * C.K + C.k0 + kc) = o8;
          } else {
          u32x4 o; o.x = pk2(t[(kc + 0) * 65 + nn], t[(kc + 1) * 65 + nn]); o.y = pk2(t[(kc + 2) * 65 + nn], t[(kc + 3) * 65 + nn]);
          o.z = pk2(t[(kc + 4) * 65 + nn], t[(kc + 5) * 65 + nn]); o.w = pk2(t[(kc + 6) * 65 + nn], t[(kc + 7) * 65 + nn]);
          *(u32x4*)(C.dst + (size_t)drow * C.K + C.k0 + kc) = o; } }
        if (!more) break;
        g = gn; buf ^= 1;
    }
    __syncthreads();
}
__device__ __forceinline__ void norm_mod_row(const float* xrow, const float* g, const float* shift, const float* scale, bf16_t* orow, float* fout, int lane) {
    f32x4 v[4]; float s = 0.f;
#pragma unroll
    for (int j = 0; j < 4; ++j) { v[j] = ((const f32x4*)xrow)[lane + 64 * j]; s += v[j].x * v[j].x + v[j].y * v[j].y + v[j].z * v[j].z + v[j].w * v[j].w; }
    const float rinv = rsqrtf(wave_sum(s) * (1.f / D) + EPS);
#pragma unroll
    for (int j = 0; j < 4; ++j) { const int idx = lane + 64 * j;
        const f32x4 gg = ((const f32x4*)g)[idx], sh = ((const f32x4*)shift)[idx], sc = ((const f32x4*)scale)[idx];
        f32x4 y; y.x = v[j].x * rinv * gg.x * (1.f + sc.x) + sh.x; y.y = v[j].y * rinv * gg.y * (1.f + sc.y) + sh.y;
        y.z = v[j].z * rinv * gg.z * (1.f + sc.z) + sh.z; y.w = v[j].w * rinv * gg.w * (1.f + sc.w) + sh.w;
        u32x2 o; o.x = pk2(y.x, y.y); o.y = pk2(y.z, y.w);
        ((u32x2*)orow)[idx] = o;
        if (fout) ((f32x4*)fout)[idx] = y; }
}
__device__ __forceinline__ void ph_norm1(KP p, int l, unsigned char* lds) {
    if (l == 0) ph_cvt(p, l, lds);
    const int tid = tid_(), lane = tid & 63, wid = tid >> 6;
    bf16_t* A = (bf16_t*)(p->ws + Z_A);
    const float* g = p->in[6] + l * D;
    if (l == 0) { for (int row = bid_() * 8 + wid; row < R_ALL; row += gsz_() * 8)
        norm_mod_row(xrow_src(p, l, row), g, mod_vec(p, l, row, 0), mod_vec(p, l, row, 1), A + (size_t)row * D, nullptr, lane); }
    else { const bf16_t* X = (const bf16_t*)(p->ws + WS_X);
        for (int row = bid_() * 8 + wid; row < R_ALL; row += gsz_() * 8) {
            const float* shift = mod_vec(p, l, row, 0); const float* scale = mod_vec(p, l, row, 1);
            f32x4 v[4]; unpack8(*(const u32x4*)(X + (size_t)row * D + lane * 8), v[0], v[1]); unpack8(*(const u32x4*)(X + (size_t)row * D + 512 + lane * 8), v[2], v[3]);
            float ss = 0.f;
#pragma unroll
            for (int j = 0; j < 4; ++j) ss += v[j].x * v[j].x + v[j].y * v[j].y + v[j].z * v[j].z + v[j].w * v[j].w;
            const float rinv = rsqrtf(wave_sum(ss) * (1.f / D) + EPS);
#pragma unroll
            for (int h = 0; h < 2; ++h) { const int c0 = h * 512 + lane * 8; unsigned o[4];
#pragma unroll
                for (int q = 0; q < 2; ++q) { const f32x4 gg = *(const f32x4*)(g + c0 + 4 * q), sh = *(const f32x4*)(shift + c0 + 4 * q), sc = *(const f32x4*)(scale + c0 + 4 * q);
                    const f32x4 y = v[2 * h + q] * rinv * gg * (sc + 1.f) + sh; o[2 * q] = pk2(y.x, y.y); o[2 * q + 1] = pk2(y.z, y.w); }
                *(u32x4*)(A + (size_t)row * D + c0) = (u32x4){o[0], o[1], o[2], o[3]}; } } }
}

template <int NBJ, class ARow, class Epi>
__device__ __forceinline__ void gemm_simple_tile(const bf16_t* A, const ARow& arow, const bf16_t* Bt, int K, int row0, int colb0, int bjstride, const Epi& epi) {
    const int tid = tid_(), lane = tid & 63, wid = tid >> 6, wr = wid >> 1, wc = wid & 1, fr = lane & 15, fq = lane >> 4;
    f32x4 acc[2][NBJ][4];
#pragma unroll
    for (int i = 0; i < 2; ++i)
#pragma unroll
        for (int b = 0; b < NBJ; ++b)
#pragma unroll
            for (int j = 0; j < 4; ++j) acc[i][b][j] = (f32x4){0.f, 0.f, 0.f, 0.f};
    const bf16_t* ap[2];
#pragma unroll
    for (int i = 0; i < 2; ++i) ap[i] = A + (size_t)arow(row0 + wr * 32 + i * 16 + fr) * K + fq * 8;
    const bf16_t* bp = Bt + (size_t)(colb0 + wc * 64 + fr) * K + fq * 8;
    for (int k = 0; k < K; k += 32) {
        bf16x8 a[2];
#pragma unroll
        for (int i = 0; i < 2; ++i) a[i] = *(const bf16x8*)(ap[i] + k);
#pragma unroll
        for (int b = 0; b < NBJ; ++b)
#pragma unroll
            for (int j = 0; j < 4; ++j) { const bf16x8 bv = *(const bf16x8*)(bp + (size_t)(b * bjstride + j * 16) * K + k);
#pragma unroll
                for (int i = 0; i < 2; ++i) acc[i][b][j] = __builtin_amdgcn_mfma_f32_16x16x32_bf16(a[i], bv, acc[i][b][j], 0, 0, 0); }
    }
#pragma unroll
    for (int i = 0; i < 2; ++i)
#pragma unroll
        for (int j = 0; j < 4; ++j)
#pragma unroll
            for (int r = 0; r < 4; ++r) { const int row = row0 + wr * 32 + i * 16 + fq * 4 + r, col = wc * 64 + j * 16 + fr;
                epi(row, col, acc[i][0][j][r], acc[i][NBJ - 1][j][r]); }
}
struct RowId { __device__ __forceinline__ int operator()(int r) const { return r; } };
struct RowGather { const int* idx; __device__ __forceinline__ int operator()(int r) const { return idx[r]; } };

__device__ __forceinline__ void ph_inproj(KP p, int l, unsigned char* lds) {
    const bf16_t* A = (const bf16_t*)(p->ws + Z_A); const bf16_t* Bt = (const bf16_t*)(p->ws + Z_WIN); bf16_t* P = (bf16_t*)(p->ws + Z_P);
    constexpr int TM = R_ALL / 128, TN = DIN / 128;
    for (int it = bid_(); it < TM * TN; it += gsz_()) { const int mt = it / TN, nt = it % TN;
        auto epi = [&](int row, int col, float v, float) { P[(size_t)row * DIN + nt * 128 + col] = (bf16_t)f2bf(v); };
        gemm_simple_tile<1>(A, RowId{}, Bt, 1024, mt * 128, nt * 128, 0, epi); }
}

namespace pg8 {
constexpr int BM = 256, BK = 64, HALF = 128, HTB = HALF * BK * 2, STAGE_BYTES = 8 * HTB, NXCD = 8, WGM = 8;
__host__ __device__ __forceinline__ int lds_byte(int r, int c) { const int st = (r >> 4) * 2 + (c >> 5), rr = r & 15, cc = c & 31, ob = rr * 64 + cc * 2; return st * 1024 + (ob ^ (((ob >> 9) & 1) << 5)); }
__host__ __device__ __forceinline__ void stage_rc(int b, int& R, int& C) { const int st = b / 1024, sb = b % 1024, swz = sb ^ (((sb >> 9) & 1) << 5); R = (st >> 1) * 16 + swz / 64; C = (st & 1) * 32 + (swz % 64) / 2; }
__host__ __device__ __forceinline__ int perm32(int rho) { const int n = rho >> 4, i = rho & 15; return 8 * (i >> 2) + 4 * n + (i & 3); }
struct Unit { int pm, pn, ord; };
struct Gemm { const bf16_t* A; const bf16_t* Bt; int M, N, K; };
struct StaticOrder {
    int nM, nN, nwg, G, c;
    __host__ __device__ void init(int M, int N, int G_, int c_) { nM = M / BM; nN = N / BM; nwg = nM * nN; G = G_; c = c_; }
    __host__ __device__ bool next(int i, Unit& u) const {
        const long L = (long)i * G + c; if (L >= nwg) return false;
        int wgid = (int)L; { const int q = nwg / NXCD, r = nwg % NXCD, xcd = wgid % NXCD, off = wgid / NXCD; wgid = (xcd < r ? xcd * (q + 1) : r * (q + 1) + (xcd - r) * q) + off; }
        const int nig = WGM * nN, gid = wgid / nig, fm = gid * WGM, gsz = (nM - fm) < WGM ? (nM - fm) : WGM;
        u.pm = fm + ((wgid % nig) % gsz); u.pn = (wgid % nig) / gsz; u.ord = i; return true;
    }
};
__device__ __forceinline__ unsigned cvt_pk_bf16(float lo, float hi) { unsigned r; asm volatile("v_cvt_pk_bf16_f32 %0, %1, %2" : "=v"(r) : "v"(lo), "v"(hi)); return r; }

typedef int i32x4v __attribute__((ext_vector_type(4)));
typedef int i32x8v __attribute__((ext_vector_type(8)));
__device__ __forceinline__ i32x8v cat8(bf16x8 lo, bf16x8 hi) { const i32x4v a = __builtin_bit_cast(i32x4v, lo), b = __builtin_bit_cast(i32x4v, hi); return __builtin_shufflevector(a, b, 0, 1, 2, 3, 4, 5, 6, 7); }
__device__ __forceinline__ void glds16_s(const void* sbase, unsigned voff, unsigned lds_dst) { unsigned keep;
    asm volatile("s_mov_b32 %0, m0\n\ts_mov_b32 m0, %3\n\ts_nop 0\n\tglobal_load_lds_dwordx4 %1, %2\n\ts_mov_b32 m0, %0" : "=&s"(keep) : "v"(voff), "s"(sbase), "s"(lds_dst) : "memory"); }
template <class Epi, class Sched, bool GATHER, bool FP8 = false>
__device__ __forceinline__ void gemm_phase(LAS unsigned char* lds, const Gemm g, const Sched& S, const Epi& E, const LAS int* rtab) {
    const int tid = tid_(), wid = __builtin_amdgcn_readfirstlane(tid >> 6), lane = tid & 63, wr = wid >> 2, wc = wid & 3, fr = lane & 15, fq = lane >> 4;
    const int KB = FP8 ? g.K : g.K * 2, nt = KB / 128;
    unsigned voffA[2], voffB[2]; int RA[2], CA[2];
#pragma unroll
    for (int i = 0; i < 2; ++i) { int R, C; stage_rc(tid * 16 + i * 8192, R, C); const int Rb = (R & ~31) + perm32(R & 31);
        voffA[i] = (unsigned)(R * KB + C * 2); voffB[i] = (unsigned)(Rb * KB + C * 2); RA[i] = R; CA[i] = C; }
    unsigned rcpk = 0; if constexpr (GATHER) { rcpk = (unsigned)(RA[0] * 4) | ((unsigned)(CA[0] * 2) << 16); asm volatile("" : "+v"(rcpk)); }
    const size_t kstep = (size_t)128;
    const size_t hstep = (size_t)HALF * KB;
    const size_t hstepA = GATHER ? 0 : hstep;
    const size_t tstep = 2 * hstep;
    const unsigned ldsw = (unsigned)wid * 1024u;
    const unsigned ldsb = (unsigned)__builtin_amdgcn_readfirstlane((int)((unsigned)(size_t)lds + ldsw));
    const int aoff = lds_byte(wr * 64 + fr, fq * 8), boff = lds_byte(wc * 32 + fr, fq * 8);
#define PG8_SA(b, h) (((b) * 2 + (h)) * HTB)
#define PG8_SB(b, h) ((4 + (b) * 2 + (h)) * HTB)
#define PG8_STAGE(bufoff, gbase, voff) do { _Pragma("unroll") for (int _i = 0; _i < 2; ++_i) { if constexpr (FP8) glds16_s((const void*)(gbase), (voff)[_i], ldsb + (unsigned)((bufoff) + _i * 8192)); \
        else __builtin_amdgcn_global_load_lds((const unsigned*)((const char*)(gbase) + (voff)[_i]), (LAS unsigned*)(lds + (bufoff) + ldsw + _i * 8192), 16, 0, 0); } } while (0)
#define PG8_STAGE1(bufoff, gbase, v0) do {   \
        glds16_s((const void*)(gbase), (v0), ldsb + (unsigned)(bufoff)); glds16_s((const void*)((const char*)(gbase) + (size_t)64 * KB), (v0), ldsb + (unsigned)((bufoff) + 8192)); } while (0)
#define PG8_LDA(dst, b, h) do { _Pragma("unroll") for (int m = 0; m < 4; ++m) { if constexpr (FP8) dst##8[m] = cat8(*(const LAS bf16x8*)(lds + PG8_SA(b, h) + aoff + m * 2048), *(const LAS bf16x8*)(lds + PG8_SA(b, h) + aoff + m * 2048 + 1024)); \
        else { _Pragma("unroll") for (int k = 0; k < 2; ++k) dst[m][k] = *(const LAS bf16x8*)(lds + PG8_SA(b, h) + aoff + m * 2048 + k * 1024); } } } while (0)
#define PG8_LDB(dst, b, h) do { _Pragma("unroll") for (int n = 0; n < 2; ++n) { if constexpr (FP8) dst##8[n] = cat8(*(const LAS bf16x8*)(lds + PG8_SB(b, h) + boff + n * 2048), *(const LAS bf16x8*)(lds + PG8_SB(b, h) + boff + n * 2048 + 1024)); \
        else { _Pragma("unroll") for (int k = 0; k < 2; ++k) dst[n][k] = *(const LAS bf16x8*)(lds + PG8_SB(b, h) + boff + n * 2048 + k * 1024); } } } while (0)
#define PG8_MMA(ai, bj, At, Bt) do { __builtin_amdgcn_s_setprio(1); _Pragma("unroll") for (int m = 0; m < 4; ++m) _Pragma("unroll") for (int n = 0; n < 2; ++n) { \
        if constexpr (FP8) acc[ai][bj][m][n] = __builtin_amdgcn_mfma_scale_f32_16x16x128_f8f6f4(Bt##8[n], At##8[m], acc[ai][bj][m][n], 0, 0, 0, 0x7F7F7F7F, 0, 0x7F7F7F7F); \
        else { _Pragma("unroll") for (int k = 0; k < 2; ++k) acc[ai][bj][m][n] = __builtin_amdgcn_mfma_f32_16x16x32_bf16(Bt[n][k], At[m][k], acc[ai][bj][m][n], 0, 0, 0); } } \
        if constexpr (FP8) { asm volatile("" : "+v"(acc[ai][bj][0][0]), "+v"(acc[ai][bj][0][1]), "+v"(acc[ai][bj][1][0]), "+v"(acc[ai][bj][1][1]), "+v"(acc[ai][bj][2][0]), "+v"(acc[ai][bj][2][1]), "+v"(acc[ai][bj][3][0]), "+v"(acc[ai][bj][3][1])); } \
        __builtin_amdgcn_s_setprio(0); } while (0)
#define PG8_WAIT_V(n) asm volatile("s_waitcnt vmcnt(" #n ")" ::: "memory")
#define PG8_WAIT_L(n) asm volatile("s_waitcnt lgkmcnt(" #n ")" ::: "memory")
#define PG8_BAR __builtin_amdgcn_s_barrier()
#define PG8_SCHED __builtin_amdgcn_sched_barrier(0)
#define PG8_STAGE_A(bufoff, gbase, ord, h) do { unsigned _o[2]; if constexpr (GATHER) {   \
            unsigned _pk = rcpk; asm volatile("" : "+v"(_pk));   \
            const LAS unsigned char* _rp = (const LAS unsigned char*)rtab + ((ord) * 1024 + (h) * 512) + (_pk & 0xffffu); const unsigned _c2 = _pk >> 16; \
            _Pragma("unroll") for (int _i = 0; _i < 2; ++_i) _o[_i] = __umul24((unsigned)*(const LAS int*)(_rp + _i * 256), (unsigned)KB) + _c2; } \
        else { _o[0] = voffA[0]; _o[1] = voffA[1]; } if constexpr (FP8 && !GATHER) PG8_STAGE1(bufoff, gbase, voffA[0]); else PG8_STAGE(bufoff, gbase, _o); } while (0)
#define PG8_STAGE_B(bufoff, gbase) do { if constexpr (FP8) PG8_STAGE1(bufoff, gbase, voffB[0]); else PG8_STAGE(bufoff, gbase, voffB); } while (0)
    Unit cur, nxt; int ui = 0;
    if (!S.next(0, cur)) return;
    f32x4 acc[2][2][4][2];
#pragma unroll
    for (int a = 0; a < 2; ++a)
#pragma unroll
        for (int b = 0; b < 2; ++b)
#pragma unroll
            for (int m = 0; m < 4; ++m)
#pragma unroll
                for (int n = 0; n < 2; ++n) acc[a][b][m][n] = (f32x4){0.f, 0.f, 0.f, 0.f};
    bf16x8 At[4][2], B0[2][2], B1[2][2]; i32x8v At8[4], B08[2], B18[2];
    const char* cA = GATHER ? (const char*)g.A : (const char*)g.A + (size_t)cur.pm * tstep; const char* cB = (const char*)g.Bt + (size_t)cur.pn * tstep;
    PG8_STAGE_B(PG8_SB(0, 0), cB); PG8_STAGE_B(PG8_SB(0, 1), cB + hstep); PG8_STAGE_A(PG8_SA(0, 0), cA, 0, 0); PG8_STAGE_A(PG8_SA(0, 1), cA + hstepA, 0, 1);
    if (wr == 1) PG8_BAR;
    PG8_WAIT_V(2); PG8_BAR;
    PG8_STAGE_B(PG8_SB(1, 0), cB + kstep); PG8_STAGE_A(PG8_SA(1, 0), cA + kstep, 0, 0); PG8_STAGE_B(PG8_SB(1, 1), cB + hstep + kstep);
    PG8_WAIT_V(6); PG8_BAR;
    for (;;) {
        const bool has_next = S.next(ui + 1, nxt);
        const char* nA = GATHER ? (const char*)g.A : (has_next ? (const char*)g.A + (size_t)nxt.pm * tstep : cA); const char* nB = has_next ? (const char*)g.Bt + (size_t)nxt.pn * tstep : cB;
#pragma unroll 1
        for (int t = 0; t < nt; t += 2) {
            const bool last = (t == nt - 2);
            const char* a1 = cA + (size_t)(t + 1) * kstep;
            const char* a2 = last ? nA : cA + (size_t)(t + 2) * kstep; const char* b2 = last ? nB : cB + (size_t)(t + 2) * kstep;
            const char* a3 = a2 + kstep; const char* b3 = b2 + kstep;
            const int on = (last && has_next) ? ui + 1 : ui;
            PG8_LDB(B0, 0, 0); PG8_LDB(B1, 0, 1); PG8_SCHED; PG8_LDA(At, 0, 0); PG8_STAGE_A(PG8_SA(1, 1), a1 + hstepA, ui, 1);
            PG8_WAIT_V(8); PG8_WAIT_L(0); PG8_BAR; PG8_MMA(0, 0, At, B0); PG8_MMA(0, 1, At, B1); PG8_BAR; PG8_SCHED;
            PG8_LDA(At, 0, 1); PG8_STAGE_B(PG8_SB(0, 0), b2); PG8_STAGE_B(PG8_SB(0, 1), b2 + hstep); PG8_STAGE_A(PG8_SA(0, 0), a2, on, 0);
            PG8_WAIT_V(8); PG8_WAIT_L(0); PG8_BAR; PG8_MMA(1, 0, At, B0); PG8_MMA(1, 1, At, B1); PG8_BAR; PG8_SCHED;
            PG8_LDB(B0, 1, 0); PG8_LDB(B1, 1, 1); PG8_SCHED; PG8_LDA(At, 1, 0); PG8_STAGE_A(PG8_SA(0, 1), a2 + hstepA, on, 1);
            PG8_WAIT_V(8); PG8_WAIT_L(0); PG8_BAR; PG8_MMA(0, 0, At, B0); PG8_MMA(0, 1, At, B1); PG8_BAR; PG8_SCHED;
            PG8_LDA(At, 1, 1); PG8_STAGE_B(PG8_SB(1, 0), b3); PG8_STAGE_B(PG8_SB(1, 1), b3 + hstep); PG8_STAGE_A(PG8_SA(1, 0), a3, on, 0);
            PG8_WAIT_V(8); PG8_WAIT_L(0); PG8_BAR; PG8_MMA(1, 0, At, B0); PG8_MMA(1, 1, At, B1); PG8_BAR; PG8_SCHED;
        }
        if (wr == 0) PG8_BAR;
        E(acc, cur, wr, wc, fr, fq);
        if (!has_next) break;
#pragma unroll
        for (int a = 0; a < 2; ++a)
#pragma unroll
            for (int b = 0; b < 2; ++b)
#pragma unroll
                for (int m = 0; m < 4; ++m)
#pragma unroll
                    for (int n = 0; n < 2; ++n) acc[a][b][m][n] = (f32x4){0.f, 0.f, 0.f, 0.f};
        cur = nxt; cA = nA; cB = nB; ++ui;
        if (wr == 1) PG8_BAR;
    }
    PG8_WAIT_V(0);
    PG8_BAR;
#undef PG8_SA
#undef PG8_SB
#undef PG8_STAGE
#undef PG8_LDA
#undef PG8_LDB
#undef PG8_MMA
#undef PG8_WAIT_V
#undef PG8_WAIT_L
#undef PG8_BAR
#undef PG8_SCHED
#undef PG8_STAGE_A
#undef PG8_STAGE_B
#undef PG8_STAGE1
}
struct EpiBf16 {
    bf16_t* O; int ldc, ncolt; size_t slab;
    __device__ __forceinline__ void operator()(const f32x4 (&acc)[2][2][4][2], const Unit& u, int wr, int wc, int fr, int fq) const {
        const int row0 = u.pm * BM + wr * 64 + fr; const size_t col0 = (size_t)(u.pn % ncolt) * slab + wc * 32 + 8 * fq;
#pragma unroll
        for (int ai = 0; ai < 2; ++ai)
#pragma unroll
            for (int m = 0; m < 4; ++m) { bf16_t* rowp = O + (size_t)(row0 + ai * HALF + m * 16) * ldc + col0;
#pragma unroll
                for (int bj = 0; bj < 2; ++bj) { const f32x4 v0 = acc[ai][bj][m][0], v1 = acc[ai][bj][m][1];
                    u32x4 w; w.x = cvt_pk_bf16(v0[0], v0[1]); w.y = cvt_pk_bf16(v0[2], v0[3]); w.z = cvt_pk_bf16(v1[0], v1[1]); w.w = cvt_pk_bf16(v1[2], v1[3]);
                    *(u32x4*)(rowp + bj * HALF) = w; } }
    }
};
struct EpiRes {
    bf16_t* X; const float* xlat; const float* xctx; const float* modl; int pm_shift; float ascale; bool perm = false;
    __device__ __forceinline__ void operator()(const f32x4 (&acc)[2][2][4][2], const Unit& u, int wr, int wc, int fr, int fq) const {
        const int pm = u.pm - pm_shift; const int rsel = pm < 64 ? (pm >> 5) : 2;
        const int row0 = pm * BM + wr * 64 + fr, col0 = (u.pn & 3) * BM + (perm ? wc * 64 + 16 * fq : wc * 32 + 8 * fq), bjs = perm ? 8 : HALF;
        const float* gate = modl + (size_t)rsel * 6144 + col0;
        const float* xs = xlat ? (pm < 64 ? xlat + (size_t)row0 * D : xctx + (size_t)(row0 - R_LAT) * D) + col0 : nullptr;
        bf16_t* xo = X + (size_t)row0 * D + col0;
#pragma unroll
        for (int bj = 0; bj < 2; ++bj) { const f32x4 g0 = *(const f32x4*)(gate + bj * bjs) * ascale, g1 = *(const f32x4*)(gate + bj * bjs + 4) * ascale;
#pragma unroll
            for (int ai = 0; ai < 2; ++ai)
#pragma unroll
                for (int m = 0; m < 4; ++m) { const size_t o = (size_t)(ai * HALF + m * 16) * D + bj * bjs;
                    f32x4 x0, x1;
                    if (xs) { x0 = *(const f32x4*)(xs + o); x1 = *(const f32x4*)(xs + o + 4); } else unpack8(*(const u32x4*)(xo + o), x0, x1);
                    const f32x4 y0 = x0 + g0 * acc[ai][bj][m][0], y1 = x1 + g1 * acc[ai][bj][m][1];
                    u32x4 w; w.x = cvt_pk_bf16(y0[0], y0[1]); w.y = cvt_pk_bf16(y0[2], y0[3]); w.z = cvt_pk_bf16(y1[0], y1[1]); w.w = cvt_pk_bf16(y1[2], y1[3]);
                    *(u32x4*)(xo + o) = w; } }
    }
};
struct EpiGU8 {
    unsigned char* H8; const LAS float* wtab;
    __device__ __forceinline__ void operator()(const f32x4 (&acc)[2][2][4][2], const Unit& u, int wr, int wc, int fr, int fq) const {
        { const int t_ = tid_(); fr = t_ & 15; fq = (t_ >> 4) & 3; }
        const int row0 = u.pm * BM + wr * 64 + fr, col0 = (u.pn & 1) * 128 + wc * 32 + 8 * fq;
#pragma unroll
        for (int ai = 0; ai < 2; ++ai)
#pragma unroll
            for (int m = 0; m < 4; ++m) { const int row = row0 + ai * HALF + m * 16; const float w = wtab[u.ord * 256 + wr * 64 + fr + ai * HALF + m * 16] * H8_SCALE;
                float h[8];
#pragma unroll
                for (int n = 0; n < 2; ++n)
#pragma unroll
                    for (int j = 0; j < 4; ++j) { const float gv = acc[ai][0][m][n][j] * GU_DESCALE, uv = acc[ai][1][m][n][j] * GU_DESCALE;
                        h[n * 4 + j] = fminf(fmaxf(gv * __builtin_amdgcn_rcpf(1.f + __expf(-gv)) * uv * w, -440.f), 440.f); }
                int w0 = __builtin_amdgcn_cvt_pk_fp8_f32(h[0], h[1], 0, false); w0 = __builtin_amdgcn_cvt_pk_fp8_f32(h[2], h[3], w0, true);
                int w1 = __builtin_amdgcn_cvt_pk_fp8_f32(h[4], h[5], 0, false); w1 = __builtin_amdgcn_cvt_pk_fp8_f32(h[6], h[7], w1, true);
                u32x2 o; o.x = (unsigned)w0; o.y = (unsigned)w1;
                *(u32x2*)(H8 + (size_t)row * 256 + col0) = o; }
    }
};
struct EpiGU {
    bf16_t* H; const float* slot_w;
    __device__ __forceinline__ void operator()(const f32x4 (&acc)[2][2][4][2], const Unit& u, int wr, int wc, int fr, int fq) const {
        const int row0 = u.pm * BM + wr * 64 + fr, col0 = (u.pn & 1) * 128 + wc * 32 + 8 * fq;
#pragma unroll
        for (int ai = 0; ai < 2; ++ai)
#pragma unroll
            for (int m = 0; m < 4; ++m) { const int row = row0 + ai * HALF + m * 16; const float w = slot_w[row];
                float h[8];
#pragma unroll
                for (int n = 0; n < 2; ++n)
#pragma unroll
                    for (int j = 0; j < 4; ++j) { const float gv = acc[ai][0][m][n][j], uv = acc[ai][1][m][n][j]; h[n * 4 + j] = gv / (1.f + __expf(-gv)) * uv * w; }
                u32x4 o; o.x = cvt_pk_bf16(h[0], h[1]); o.y = cvt_pk_bf16(h[2], h[3]); o.z = cvt_pk_bf16(h[4], h[5]); o.w = cvt_pk_bf16(h[6], h[7]);
                *(u32x4*)(H + (size_t)row * 256 + col0) = o; }
    }
};
struct EpiY8 {
    unsigned char* Y8;
    __device__ __forceinline__ void operator()(const f32x4 (&acc)[2][2][4][2], const Unit& u, int wr, int wc, int fr, int fq) const {
        const int row0 = u.pm * BM + wr * 64 + fr; unsigned char* base = Y8 + ((size_t)(u.pn & 3) * MAXSLOT + row0) * 256 + wc * 64 + 16 * fq;
#pragma unroll
        for (int ai = 0; ai < 2; ++ai)
#pragma unroll
            for (int m = 0; m < 4; ++m) { unsigned w[4];
#pragma unroll
                for (int bj = 0; bj < 2; ++bj) { f32x4 v0 = acc[ai][bj][m][0] * (Y8_SCALE * DN_DESCALE), v1 = acc[ai][bj][m][1] * (Y8_SCALE * DN_DESCALE);
#pragma unroll
                    for (int q = 0; q < 4; ++q) { v0[q] = fminf(fmaxf(v0[q], -440.f), 440.f); v1[q] = fminf(fmaxf(v1[q], -440.f), 440.f); }
                    int w0 = __builtin_amdgcn_cvt_pk_fp8_f32(v0[0], v0[1], 0, false); w0 = __builtin_amdgcn_cvt_pk_fp8_f32(v0[2], v0[3], w0, true);
                    int w1 = __builtin_amdgcn_cvt_pk_fp8_f32(v1[0], v1[1], 0, false); w1 = __builtin_amdgcn_cvt_pk_fp8_f32(v1[2], v1[3], w1, true);
                    w[2 * bj] = (unsigned)w0; w[2 * bj + 1] = (unsigned)w1; }
                *(u32x4*)(base + (size_t)(ai * HALF + m * 16) * 256) = (u32x4){w[0], w[1], w[2], w[3]}; }
    }
};
struct EpiDown {
    bf16_t* Y; bf16_t* X; const float* modl5;
    __device__ __forceinline__ void operator()(const f32x4 (&acc)[2][2][4][2], const Unit& u, int wr, int wc, int fr, int fq) const {
        { const int t_ = tid_(); fr = t_ & 15; fq = (t_ >> 4) & 3; }
        if (u.pm < MAXSLOT / 256) { const EpiY8 e{(unsigned char*)Y}; e(acc, u, wr, wc, fr, fq); }
        else { const EpiRes e{X, nullptr, nullptr, modl5, MAXSLOT / 256, DN_DESCALE, true}; e(acc, u, wr, wc, fr, fq); }
    }
};
}


__device__ __forceinline__ void ph_inproj_f(KP p, int l, unsigned char* lds) {
    pg8::Gemm g{(const bf16_t*)(p->ws + Z_A), (const bf16_t*)(p->ws + win_off(l)), R_ALL, DIN, 1024};
    pg8::StaticOrder S; S.init(R_ALL, DIN, gsz_(), bid_());
    pg8::EpiBf16 E{(bf16_t*)(p->ws + Z_P), DIN, DIN / 256, 256};
    pg8::gemm_phase<pg8::EpiBf16, pg8::StaticOrder, false>((LAS unsigned char*)lds, g, S, E, nullptr);
    if (l == 0 && DEPTH > 1 && gsz_() == 256) { __syncthreads(); ph_cvt(p, 1, lds, 214, 42, 0, CVT_E1); }
}
__device__ __forceinline__ void ph_outproj_f(KP p, int l, unsigned char* lds) {
    const int T = (l == 0) ? R_ALL : R_LAT;
    pg8::Gemm g{(const bf16_t*)(p->ws + Z_YCAT), (const bf16_t*)(p->ws + wout_off(l)), T, 1024, 1024};
    pg8::StaticOrder S; S.init(T, 1024, gsz_(), bid_());
    bf16_t* X = (bf16_t*)(p->ws + WS_X);
    pg8::EpiRes E{X, l == 0 ? p->in[0] : nullptr, l == 0 ? p->in[2] : nullptr, (const float*)(p->ws + WS_MOD) + (size_t)l * 3 * 6144 + 2 * 1024, 0, 1.f};
    pg8::gemm_phase<pg8::EpiRes, pg8::StaticOrder, false>((LAS unsigned char*)lds, g, S, E, nullptr);
    if (l == 0 && DEPTH > 1) {
        const int G = gsz_(); __syncthreads();
        if (G == 256) ph_cvt(p, 1, lds, 8, 248, CVT_E2, 1 << 30); else ph_cvt(p, 1, lds); }
}
struct QkvLane { f32x4 gg0, gg1, gw0, gw1; };
__device__ __forceinline__ QkvLane qkv_lane_consts(KP p, int l, int lane) {
    QkvLane c; const int dch = (lane & 7) * 8; const int isk = lane >= 32;
    const float* gq = p->in[isk ? 11 : 10] + l * 64 + dch; const float* wq = p->in[isk ? 13 : 12] + l * 64 + dch;
    c.gg0 = *(const f32x4*)gq; c.gg1 = *(const f32x4*)(gq + 4); c.gw0 = *(const f32x4*)wq; c.gw1 = *(const f32x4*)(wq + 4); return c;
}
__device__ __forceinline__ void prep_qkv_row(KP p, int l, int row, int lane, const QkvLane& qc) {
    const bf16_t* pr = (const bf16_t*)(p->ws + Z_P) + (size_t)row * DIN;
    const bool isctx = row >= R_LAT; const int b = isctx ? ((row - R_LAT) >> 8) : (row >> 13), t = isctx ? ((row - R_LAT) & 255) : (row & 8191);
    const size_t krow = (size_t)b * NKEY + (isctx ? NSEQ + t : t);
    const int l7 = lane & 7, axis = l7 >> 2, half = (l7 >> 1) & 1;
    f32x4 cs0 = (f32x4){1.f, 1.f, 1.f, 1.f}, cs1 = cs0, sn0 = (f32x4){0.f, 0.f, 0.f, 0.f}, sn1 = sn0;
    if (!isctx) { const int pos = axis == 0 ? (t >> 6) : (t & 63); const float* rt = (const float*)(p->ws + WS_ROPE) + pos * 32 + (lane & 1) * 8;
        cs0 = *(const f32x4*)rt; cs1 = *(const f32x4*)(rt + 4); sn0 = *(const f32x4*)(rt + 16); sn1 = *(const f32x4*)(rt + 20); }
    const u32x4 ra = *(const u32x4*)(pr + lane * 8), rb = *(const u32x4*)(pr + 512 + lane * 8);
#pragma unroll
    for (int grp = 0; grp < 2; ++grp) {
        const u32x4 r = grp ? rb : ra;
        bf16_t* Qd = (bf16_t*)(p->ws + (isctx ? (grp ? Z_QWC : Z_QGC) : (grp ? Z_QW : Z_QG))) + (size_t)(isctx ? (b * NCTX + t) : row) * 256;
        bf16_t* Kd = (bf16_t*)(p->ws + (grp ? Z_KW : Z_KG)) + krow * 128; bf16_t* Vd = (bf16_t*)(p->ws + (grp ? Z_VW : Z_VG)) + krow * 128;
        if (lane >= 48) { *(u32x4*)(Vd + (lane - 48) * 8) = r; continue; }
        float x[8] = {bf2f(r.x & 0xffffu), bf2f(r.x >> 16), bf2f(r.y & 0xffffu), bf2f(r.y >> 16), bf2f(r.z & 0xffffu), bf2f(r.z >> 16), bf2f(r.w & 0xffffu), bf2f(r.w >> 16)};
        float ss = 0.f;
#pragma unroll
        for (int i = 0; i < 8; ++i) ss += x[i] * x[i];
        ss += __shfl_xor(ss, 1); ss += __shfl_xor(ss, 2); ss += __shfl_xor(ss, 4);
        const float rinv = rsqrtf(ss * (1.f / 64.f) + EPS);
        const f32x4 g0 = grp ? qc.gw0 : qc.gg0, g1 = grp ? qc.gw1 : qc.gg1;
        const float gv[8] = {g0.x, g0.y, g0.z, g0.w, g1.x, g1.y, g1.z, g1.w};
        const float cv[8] = {cs0.x, cs0.y, cs0.z, cs0.w, cs1.x, cs1.y, cs1.z, cs1.w}, sv[8] = {sn0.x, sn0.y, sn0.z, sn0.w, sn1.x, sn1.y, sn1.z, sn1.w};
        const float qs = (lane < 32) ? QSCALE : 1.f;
        float y[8];
#pragma unroll
        for (int i = 0; i < 8; ++i) { const float v = x[i] * rinv * gv[i]; const float o = __shfl_xor(v, 2);
            y[i] = ((half == 0) ? (v * cv[i] - o * sv[i]) : (o * sv[i] + v * cv[i])) * qs; }
        u32x4 ov; ov.x = pk2(y[0], y[1]); ov.y = pk2(y[2], y[3]); ov.z = pk2(y[4], y[5]); ov.w = pk2(y[6], y[7]);
        if (lane < 32) *(u32x4*)(Qd + lane * 8) = ov; else *(u32x4*)(Kd + (lane - 32) * 8) = ov;
    }
}

template <int R> __device__ __forceinline__ void dw_rows(const float* hcol, const float (&wj)[31], float (&acc)[32]) {
    if constexpr (R < 62) {
        const float hv = hcol[R * 256];
        constexpr int T0 = (R - 30 > 0) ? R - 30 : 0, T1 = (R < 31) ? R : 31;
#pragma unroll
        for (int tt = T0; tt <= T1; ++tt) acc[tt] += hv * wj[R - tt];
        dw_rows<R + 1>(hcol, wj, acc);
    }
}
__device__ __forceinline__ void conv_tile(KP p, int l, unsigned char* lds, int seq_row0, int seqlen, int t0) {
    float* hb = (float*)lds;
    const int tid = tid_(), lane = tid & 63, wid = tid >> 6;
    const bf16_t* P = (const bf16_t*)(p->ws + Z_P);
    for (int i = tid; i < 94 * 32; i += NTHREADS) { const int r = i >> 5, c8 = (i & 31) * 8, t = t0 - 15 + r;
        f32x4 h0 = (f32x4){0.f, 0.f, 0.f, 0.f}, h1 = h0;
        if (t >= 0 && t < seqlen) { const bf16_t* pr = P + (size_t)(seq_row0 + t) * DIN;
            const u32x4 vv = *(const u32x4*)(pr + C_CVV + c8), gg = *(const u32x4*)(pr + C_CVG + c8);
            h0.x = bf2f(vv.x & 0xffffu) * sigmoid_(bf2f(gg.x & 0xffffu)); h0.y = bf2f(vv.x >> 16) * sigmoid_(bf2f(gg.x >> 16));
            h0.z = bf2f(vv.y & 0xffffu) * sigmoid_(bf2f(gg.y & 0xffffu)); h0.w = bf2f(vv.y >> 16) * sigmoid_(bf2f(gg.y >> 16));
            h1.x = bf2f(vv.z & 0xffffu) * sigmoid_(bf2f(gg.z & 0xffffu)); h1.y = bf2f(vv.z >> 16) * sigmoid_(bf2f(gg.z >> 16));
            h1.z = bf2f(vv.w & 0xffffu) * sigmoid_(bf2f(gg.w & 0xffffu)); h1.w = bf2f(vv.w >> 16) * sigmoid_(bf2f(gg.w >> 16)); }
        *(f32x4*)(hb + r * 256 + c8) = h0; *(f32x4*)(hb + r * 256 + c8 + 4) = h1; }
    __syncthreads();
    { const int c = tid & 255, hf = tid >> 8;
      const float* w = p->in[15] + (size_t)l * 31 * 256 + c; const float bias = p->in[16][l * 256 + c];
      float wj[31];
#pragma unroll
      for (int j = 0; j < 31; ++j) wj[j] = w[j * 256];
      float acc[32];
#pragma unroll
      for (int tt = 0; tt < 32; ++tt) acc[tt] = bias;
      dw_rows<0>(hb + hf * 32 * 256 + c, wj, acc);
      __syncthreads();
#pragma unroll
      for (int tt = 0; tt < 32; ++tt) hb[(hf * 32 + tt) * 256 + c] = acc[tt];
    }
    __syncthreads();
    constexpr int AS = 264;
    bf16_t* ab = (bf16_t*)(lds + 94 * 256 * 4);
    for (int tt = wid; tt < 64; tt += 8) { const float* r = hb + tt * 256; const f32x4 v = ((const f32x4*)r)[lane];
        const float mean = wave_sum(v.x + v.y + v.z + v.w) * (1.f / 256.f);
        const float dx = v.x - mean, dy = v.y - mean, dz = v.z - mean, dw = v.w - mean;
        const float rstd = rsqrtf(wave_sum(dx * dx + dy * dy + dz * dz + dw * dw) * (1.f / 256.f) + EPS);
        const f32x4 g = ((const f32x4*)(p->in[17] + l * 256))[lane], bb = ((const f32x4*)(p->in[18] + l * 256))[lane];
        u32x2 o; o.x = pk2(silu_(dx * rstd * g.x + bb.x), silu_(dy * rstd * g.y + bb.y)); o.y = pk2(silu_(dz * rstd * g.z + bb.z), silu_(dw * rstd * g.w + bb.w));
        *(u32x2*)(ab + tt * AS + lane * 4) = o; }
    __syncthreads();
    { const int fr = lane & 15, fq = lane >> 4;
      const bf16_t* Wt = (const bf16_t*)(p->ws + wpw_off(l));
      bf16x8 bw[2][8];
#pragma unroll
      for (int j = 0; j < 2; ++j)
#pragma unroll
          for (int ks = 0; ks < 8; ++ks) bw[j][ks] = *(const bf16x8*)(Wt + (size_t)((wid * 2 + j) * 16 + fr) * 256 + ks * 32 + fq * 8);
      const float bias0 = p->in[20][l * 256 + wid * 32 + fr], bias1 = p->in[20][l * 256 + wid * 32 + 16 + fr];
      bf16_t* Y = (bf16_t*)(p->ws + Z_YCAT);
#pragma unroll 1
      for (int tr = 0; tr < 4; ++tr) { f32x4 a0 = (f32x4){0.f, 0.f, 0.f, 0.f}, a1 = a0;
#pragma unroll
          for (int ks = 0; ks < 8; ++ks) { const bf16x8 av = *(const bf16x8*)(ab + (tr * 16 + fr) * AS + ks * 32 + fq * 8);
              a0 = __builtin_amdgcn_mfma_f32_16x16x32_bf16(av, bw[0][ks], a0, 0, 0, 0); a1 = __builtin_amdgcn_mfma_f32_16x16x32_bf16(av, bw[1][ks], a1, 0, 0, 0); }
#pragma unroll
          for (int r = 0; r < 4; ++r) { const int t = t0 + tr * 16 + fq * 4 + r; bf16_t* yr = Y + (size_t)(seq_row0 + t) * D + 256 + wid * 32 + fr;
              yr[0] = (bf16_t)f2bf(a0[r] + bias0); yr[16] = (bf16_t)f2bf(a1[r] + bias1); } }
    }
    __syncthreads();
}

__device__ __forceinline__ int hgrn_chunk_row0(int b, int dir, int j) {
    if (j < 4) { const int cj = dir ? 3 - j : j; return R_LAT + b * NCTX + cj * 64; }
    const int jj = j - 4, cj = dir ? 127 - jj : jj; return b * NSEQ + cj * 64;
}
__device__ __forceinline__ void hgrn_load_chunk(KP p, int l, int row0, int dir, int head, float* qs, float* vs, float* ks, float* cs) {
    const int tid = tid_();
    const bf16_t* P = (const bf16_t*)(p->ws + Z_P);
    const float* lbv = (const float*)(p->ws + WS_LB) + (l * 2 + dir) * 256 + head * 64;
    for (int i = tid; i < 4096; i += NTHREADS) { const int tau = i >> 6, d = i & 63; const int row = row0 + (dir ? 63 - tau : tau);
        const bf16_t* pr = P + (size_t)row * DIN + head * 64 + d;
        if (qs) qs[i] = bf2f(pr[C_RQ]);
        vs[i] = bf2f(pr[C_RI]);
        const float z = bf2f(pr[dir ? C_RFB : C_RFF]); const float lb = lbv[d];
        const float lsp = fminf(z, 0.f) - log1pf(__expf(-fabsf(z)));
        float logf = lsp;
        if (lb > 0.f) { const float a = lsp, bq = __logf(lb) + (lsp - z); const float mx = fmaxf(a, bq); logf = mx + log1pf(__expf(-fabsf(a - bq))); }
        ks[i] = (1.f - lb) * sigmoid_(-z);
        cs[i] = logf; }
    __syncthreads();
    if (tid < 64) { float c = 0.f; for (int tau = 0; tau < 64; ++tau) { c += cs[tau * 64 + tid]; cs[tau * 64 + tid] = c; } }
    __syncthreads();
}
__device__ __forceinline__ void hgrn_pass1_unit(KP p, int l, unsigned char* lds, int unit) {
    float* vs = (float*)lds; float* ks = vs + 4096; float* cs = ks + 4096;
    const int tid = tid_();
    const int j = unit % NCHUNK, seq = unit / NCHUNK, dir = seq & 1, head = (seq >> 1) & 3, b = seq >> 3;
    hgrn_load_chunk(p, l, hgrn_chunk_row0(b, dir, j), dir, head, nullptr, vs, ks, cs);
    for (int i = tid; i < 4096; i += NTHREADS) { const int d = i & 63; ks[i] *= __expf(cs[63 * 64 + d] - cs[i]); }
    __syncthreads();
    float* U = (float*)(p->ws + Z_U) + ((size_t)seq * NCHUNK + j) * 4096; float* Gv = (float*)(p->ws + Z_G) + ((size_t)seq * NCHUNK + j) * 64;
    { const int d = tid >> 3, e0 = (tid & 7) * 8; float acc[8];
#pragma unroll
      for (int e = 0; e < 8; ++e) acc[e] = 0.f;
      for (int tau = 0; tau < 64; ++tau) { const float kv = ks[tau * 64 + d];
#pragma unroll
          for (int e = 0; e < 8; ++e) acc[e] += kv * vs[tau * 64 + e0 + e]; }
#pragma unroll
      for (int e = 0; e < 8; ++e) U[d * 64 + e0 + e] = acc[e]; }
    if (tid < 64) Gv[tid] = __expf(cs[63 * 64 + tid]);
    __syncthreads();
}
constexpr int HS = 72;
constexpr int HL_TOT = 0, HL_OSUM = 2048, HL_T0 = 18432, HL_TB = 64 * HS * 2;
__device__ __forceinline__ f32x4 mm64(const bf16_t* A, const bf16_t* Bt, int tr, int tc, int fr, int fq, f32x4 acc) {
#pragma unroll
    for (int k0 = 0; k0 < 64; k0 += 32) { const bf16x8 a = *(const bf16x8*)(A + (tr * 16 + fr) * HS + k0 + fq * 8), b = *(const bf16x8*)(Bt + (tc * 16 + fr) * HS + k0 + fq * 8);
        acc = __builtin_amdgcn_mfma_f32_16x16x32_bf16(a, b, acc, 0, 0, 0); }
    return acc;
}
__device__ __forceinline__ void hgrn_load8(KP p, int row0, int dir, int head, int tid, float (&q)[8], float (&vv)[8], float (&z)[8]) {
    const int d = tid & 63, seg = tid >> 6;
    const bf16_t* P = (const bf16_t*)(p->ws + Z_P);
#pragma unroll
    for (int i = 0; i < 8; ++i) { const int tau = seg * 8 + i; const int row = row0 + (dir ? 63 - tau : tau);
        const bf16_t* pr = P + (size_t)row * DIN + head * 64 + d;
        q[i] = bf2f(pr[C_RQ]); vv[i] = bf2f(pr[C_RI]); z[i] = bf2f(pr[dir ? C_RFB : C_RFF]); }
}
__device__ __forceinline__ void hgrn_gate8(KP p, int l, int dir, int head, int tid, float* tot, const float (&z)[8], float (&kg)[8], float (&c)[8], float& m, float& cl) {
    const int d = tid & 63, seg = tid >> 6;
    const float lb = ((const float*)(p->ws + WS_LB))[(l * 2 + dir) * 256 + head * 64 + d];
    float run = 0.f;
#pragma unroll
    for (int i = 0; i < 8; ++i) {
        const float ez = __expf(-fabsf(z[i])), rz = __builtin_amdgcn_rcpf(1.f + ez); const float sg = (z[i] >= 0.f) ? rz : ez * rz;
        const float f = lb + (1.f - lb) * sg;
        kg[i] = 1.f - f;
        run += __logf(f); c[i] = run; }
    tot[seg * 64 + d] = run;
    __syncthreads();
    float off = 0.f; m = 0.f; cl = 0.f;
#pragma unroll
    for (int s2 = 0; s2 < 8; ++s2) { const float t = tot[s2 * 64 + d]; if (s2 < seg) off += t; if (s2 < 4) m += t; cl += t; }
#pragma unroll
    for (int i = 0; i < 8; ++i) c[i] += off;
}
__device__ __forceinline__ void hgrn_pass1_f(KP p, int l, unsigned char* lds, int unit) {
    const int tid = tid_(), lane = tid & 63, wid = tid >> 6, fr = lane & 15, fq = lane >> 4, d = tid & 63, seg = tid >> 6;
    float* tot = (float*)(lds + HL_TOT); bf16_t* Vt = (bf16_t*)(lds + HL_T0); bf16_t* KbT = (bf16_t*)(lds + HL_T0 + HL_TB);
    const int j = unit % NCHUNK, seq = unit / NCHUNK, dir = seq & 1, head = (seq >> 1) & 3, b = seq >> 3;
    float q[8], vv[8], z[8], kg[8], c[8], m, cl;
    hgrn_load8(p, hgrn_chunk_row0(b, dir, j), dir, head, tid, q, vv, z);
    hgrn_gate8(p, l, dir, head, tid, tot, z, kg, c, m, cl);
    float kb[8];
#pragma unroll
    for (int i = 0; i < 8; ++i) kb[i] = kg[i] * __expf(cl - c[i]);
    *(u32x4*)(Vt + d * HS + seg * 8) = pack8(vv);
    *(u32x4*)(KbT + d * HS + seg * 8) = pack8(kb);
    float* U = (float*)(p->ws + Z_U) + ((size_t)seq * NCHUNK + j) * 4096; float* Gv = (float*)(p->ws + Z_G) + ((size_t)seq * NCHUNK + j) * 64;
    if (seg == 0) Gv[d] = __expf(cl);
    __syncthreads();
    const int tr = wid >> 1;
#pragma unroll
    for (int t2 = 0; t2 < 2; ++t2) { const int tc = (wid & 1) * 2 + t2;
        const f32x4 acc = mm64(Vt, KbT, tr, tc, fr, fq, (f32x4){0.f, 0.f, 0.f, 0.f});
#pragma unroll
        for (int r = 0; r < 4; ++r) U[(tr * 16 + fq * 4 + r) * 64 + tc * 16 + fr] = acc[r]; }
    __syncthreads();
}
struct HgrnIn1 { float v[8], zf[8], zb[8]; };
__device__ __forceinline__ void hgrn_p1_load(KP p, int unit, int tid, HgrnIn1& r) {
    const int cpos = unit % NCHUNK, head = (unit / NCHUNK) & 3, b = unit / (NCHUNK * 4), d = tid & 63, seg = tid >> 6;
    const int row0 = (cpos < 4) ? R_LAT + b * NCTX + cpos * 64 : b * NSEQ + (cpos - 4) * 64;
    const bf16_t* P = (const bf16_t*)(p->ws + Z_P) + (size_t)(row0 + seg * 8) * DIN + head * 64 + d;
#pragma unroll
    for (int i = 0; i < 8; ++i) { const bf16_t* pr = P + (size_t)i * DIN; r.v[i] = bf2f(pr[C_RI]); r.zf[i] = bf2f(pr[C_RFF]); r.zb[i] = bf2f(pr[C_RFB]); }
}
__device__ __forceinline__ void hgrn_p1_compute(KP p, int l, unsigned char* lds, int unit, int tid, const HgrnIn1& r) {
    const int lane = tid & 63, wid = tid >> 6, fr = lane & 15, fq = lane >> 4, d = tid & 63, seg = tid >> 6;
    float* totf = (float*)(lds + HL_TOT); float* totb = (float*)(lds + HL_OSUM);
    bf16_t* Vt = (bf16_t*)(lds + HL_T0); bf16_t* KfT = (bf16_t*)(lds + HL_T0 + HL_TB); bf16_t* KbT = (bf16_t*)(lds + HL_T0 + 2 * HL_TB);
    const int cpos = unit % NCHUNK, head = (unit / NCHUNK) & 3, b = unit / (NCHUNK * 4);
    const float* lbp = (const float*)(p->ws + WS_LB) + (l * 2) * 256 + head * 64 + d; const float lbf = lbp[0], lbb = lbp[256];
    float kf[8], kb[8], cf[8], cb[8], lfb[8], runf = 0.f, runb = 0.f;
#pragma unroll
    for (int i = 0; i < 8; ++i) {
        { const float z = r.zf[i], ez = __expf(-fabsf(z)), rz = __builtin_amdgcn_rcpf(1.f + ez), sg = (z >= 0.f) ? rz : ez * rz, f = lbf + (1.f - lbf) * sg; kf[i] = 1.f - f; runf += __logf(f); cf[i] = runf; }
        { const float z = r.zb[i], ez = __expf(-fabsf(z)), rz = __builtin_amdgcn_rcpf(1.f + ez), sg = (z >= 0.f) ? rz : ez * rz, f = lbb + (1.f - lbb) * sg; kb[i] = 1.f - f; lfb[i] = __logf(f); runb += lfb[i]; cb[i] = runb; } }
    totf[seg * 64 + d] = runf; totb[seg * 64 + d] = runb;
    __syncthreads();
    float offf = 0.f, offb = 0.f, clf = 0.f, clb = 0.f;
#pragma unroll
    for (int s2 = 0; s2 < 8; ++s2) { const float tf = totf[s2 * 64 + d], tb = totb[s2 * 64 + d]; if (s2 < seg) { offf += tf; offb += tb; } clf += tf; clb += tb; }
#pragma unroll
    for (int i = 0; i < 8; ++i) { kf[i] *= __expf(clf - (cf[i] + offf)); kb[i] *= __expf(cb[i] + offb - lfb[i]); }
    *(u32x4*)(Vt + d * HS + seg * 8) = pack8(r.v);
    *(u32x4*)(KfT + d * HS + seg * 8) = pack8(kf);
    *(u32x4*)(KbT + d * HS + seg * 8) = pack8(kb);
    const int jf = cpos, jb = (cpos < 4) ? 3 - cpos : 4 + 127 - (cpos - 4); const int seqf = (b * 4 + head) * 2;
    bf16_t* Uf = (bf16_t*)(p->ws + Z_U) + ((size_t)seqf * NCHUNK + jf) * 4096; bf16_t* Ub = (bf16_t*)(p->ws + Z_U) + ((size_t)(seqf + 1) * NCHUNK + jb) * 4096;
    float* Gf = (float*)(p->ws + Z_G) + ((size_t)seqf * NCHUNK + jf) * 64; float* Gb = (float*)(p->ws + Z_G) + ((size_t)(seqf + 1) * NCHUNK + jb) * 64;
    if (seg == 0) { Gf[d] = __expf(clf); Gb[d] = __expf(clb); }
    __syncthreads();
    const int tr = wid >> 1;
#pragma unroll
    for (int t2 = 0; t2 < 2; ++t2) { const int tc = (wid & 1) * 2 + t2;
        const f32x4 af = mm64(Vt, KfT, tr, tc, fr, fq, (f32x4){0.f, 0.f, 0.f, 0.f}), ab = mm64(Vt, KbT, tr, tc, fr, fq, (f32x4){0.f, 0.f, 0.f, 0.f});
#pragma unroll
        for (int q = 0; q < 4; ++q) { const int o = (tr * 16 + fq * 4 + q) * 64 + tc * 16 + fr; Uf[o] = (bf16_t)f2bf(af[q]); Ub[o] = (bf16_t)f2bf(ab[q]); } }
    __syncthreads();
}
__device__ __forceinline__ void hgrn_pass1_run(KP p, int l, unsigned char* lds, int u0, int un, int ustep) {
    if (un <= 0) return;
    const int tid = tid_();
    HgrnIn1 cur; hgrn_p1_load(p, u0, tid, cur);
    for (int k = 0; k < un; ++k) { const int u = u0 + k * ustep;
        HgrnIn1 nxt = cur; if (k + 1 < un) hgrn_p1_load(p, u + ustep, tid, nxt);
        hgrn_p1_compute(p, l, lds, u, tid, cur);
        cur = nxt; }
}
__device__ __forceinline__ void hgrn_scan_f(KP p) {
    const int tid = tid_();
    if (tid >= 256) return;
    for (int gi = bid_() * 256 + tid; gi < 16 * 4096; gi += gsz_() * 256) {
    const int seq = gi >> 12, ed = gi & 4095, d = ed & 63;
    bf16_t* U = (bf16_t*)(p->ws + Z_U) + (size_t)seq * NCHUNK * 4096 + ed; const float* Gv = (const float*)(p->ws + Z_G) + (size_t)seq * NCHUNK * 64 + d;
    float S = 0.f;
#pragma unroll 1
    for (int j = 0; j < NCHUNK; j += 12) {
        float u[12], g[12];
#pragma unroll
        for (int q = 0; q < 12; ++q) { u[q] = bf2f(U[(size_t)(j + q) * 4096]); g[q] = Gv[(j + q) * 64]; }
#pragma unroll
        for (int q = 0; q < 12; ++q) { U[(size_t)(j + q) * 4096] = (bf16_t)f2bf(S); S = g[q] * S + u[q]; }
    }
    }
}
struct HgrnIn3 { float q[8], v[8], zf[8], zb[8], gg[8]; u32x4 sf, sb; };
__device__ __forceinline__ void hgrn_p3_load(KP p, int unit, int tid, HgrnIn3& r) {
    const int cpos = unit % NCHUNK, head = (unit / NCHUNK) & 3, b = unit / (NCHUNK * 4), d = tid & 63, seg = tid >> 6;
    const int row0 = (cpos < 4) ? R_LAT + b * NCTX + cpos * 64 : b * NSEQ + (cpos - 4) * 64;
    const bf16_t* P = (const bf16_t*)(p->ws + Z_P) + (size_t)(row0 + seg * 8) * DIN + head * 64 + d;
#pragma unroll
    for (int i = 0; i < 8; ++i) { const bf16_t* pr = P + (size_t)i * DIN; r.q[i] = bf2f(pr[C_RQ]); r.v[i] = bf2f(pr[C_RI]); r.zf[i] = bf2f(pr[C_RFF]); r.zb[i] = bf2f(pr[C_RFB]);
        r.gg[i] = bf2f(((const bf16_t*)(p->ws + Z_P))[(size_t)(row0 + seg + 8 * i) * DIN + C_RG + head * 64 + d]); }
    const int jf = cpos, jb = (cpos < 4) ? 3 - cpos : 4 + 127 - (cpos - 4); const int seqf = (b * 4 + head) * 2;
    const bf16_t* U = (const bf16_t*)(p->ws + Z_U);
    r.sf = *(const u32x4*)(U + ((size_t)seqf * NCHUNK + jf) * 4096 + tid * 8); r.sb = *(const u32x4*)(U + ((size_t)(seqf + 1) * NCHUNK + jb) * 4096 + tid * 8);
}
__device__ __forceinline__ void hgrn_p3_compute(KP p, int l, unsigned char* lds, int unit, int tid, const HgrnIn3& r) {
    const int lane = tid & 63, wid = tid >> 6, fr = lane & 15, fq = lane >> 4, d = tid & 63, seg = tid >> 6;
    constexpr int HL_D1 = HL_T0 + 6 * HL_TB, HL_TOT1 = HL_D1 + 6 * HL_TB;
    static_assert(HL_TOT1 + 2048 <= LDS_WVTAB_OFF, "HGRN pass-3 LDS fits below the wave table");
    float* os0 = (float*)(lds + HL_OSUM); float* os1 = (float*)(lds + HL_T0);
    const int cpos = unit % NCHUNK, head = (unit / NCHUNK) & 3, b = unit / (NCHUNK * 4);
    const int row0 = (cpos < 4) ? R_LAT + b * NCTX + cpos * 64 : b * NSEQ + (cpos - 4) * 64;
    const int tr = wid >> 1;
    const float* lbp = (const float*)(p->ws + WS_LB) + (l * 2) * 256 + head * 64 + d;
    float kg[2][8], c[2][8];
#pragma unroll
    for (int dir = 0; dir < 2; ++dir) { float* tot = (float*)(lds + (dir ? HL_TOT1 : HL_TOT));
        const float lb = lbp[dir * 256]; float run = 0.f;
#pragma unroll
        for (int ii = 0; ii < 8; ++ii) { const int i = dir ? 7 - ii : ii;
            const float z = dir ? r.zb[i] : r.zf[i];
            const float ez = __expf(-fabsf(z)), rz = __builtin_amdgcn_rcpf(1.f + ez), sg = (z >= 0.f) ? rz : ez * rz, f = lb + (1.f - lb) * sg;
            kg[dir][i] = 1.f - f; run += __logf(f); c[dir][i] = run; }
        tot[seg * 64 + d] = run; }
    __syncthreads();
#pragma unroll
    for (int dir = 0; dir < 2; ++dir) { const float* tot = (const float*)(lds + (dir ? HL_TOT1 : HL_TOT)); unsigned char* tb = lds + (dir ? HL_D1 : HL_T0);
        bf16_t* Qt = (bf16_t*)tb; bf16_t* Kt = (bf16_t*)(tb + HL_TB); bf16_t* Qb = (bf16_t*)(tb + 2 * HL_TB); bf16_t* St = (bf16_t*)(tb + 3 * HL_TB); bf16_t* Vt = (bf16_t*)(tb + 4 * HL_TB);
        float off = 0.f, m = 0.f;
#pragma unroll
        for (int s2 = 0; s2 < 8; ++s2) { const float t = tot[s2 * 64 + d]; if (dir ? (s2 > seg) : (s2 < seg)) off += t; if (dir ? (s2 >= 4) : (s2 < 4)) m += t; }
        float vr[8];
#pragma unroll
        for (int i = 0; i < 8; ++i) { const float ci = c[dir][i] + off; const int tau = dir ? 63 - (seg * 8 + i) : seg * 8 + i; const float qv = r.q[i];
            Qt[tau * HS + d] = (bf16_t)f2bf(qv * __expf(fminf(ci - m, 80.f)));
            Kt[tau * HS + d] = (bf16_t)f2bf(kg[dir][i] * __expf(fminf(m - ci, 80.f)));
            Qb[tau * HS + d] = (bf16_t)f2bf(qv * __expf(ci));
            vr[i] = dir ? r.v[7 - i] : r.v[i]; }
        *(u32x4*)(Vt + d * HS + (dir ? 7 - seg : seg) * 8) = pack8(vr);
        *(u32x4*)(St + (tid >> 3) * HS + (tid & 7) * 8) = dir ? r.sb : r.sf; }
    __syncthreads();
    f32x4 oacc[2][2];
#pragma unroll
    for (int dir = 0; dir < 2; ++dir) { unsigned char* tb = lds + (dir ? HL_D1 : HL_T0);
        const bf16_t* Qt = (const bf16_t*)tb; const bf16_t* Kt = (const bf16_t*)(tb + HL_TB); const bf16_t* Qb = (const bf16_t*)(tb + 2 * HL_TB); const bf16_t* St = (const bf16_t*)(tb + 3 * HL_TB); bf16_t* Sc = (bf16_t*)(tb + 5 * HL_TB);
#pragma unroll
        for (int t2 = 0; t2 < 2; ++t2) { const int tc = (wid & 1) * 2 + t2;
            oacc[dir][t2] = mm64(Qb, St, tr, tc, fr, fq, (f32x4){0.f, 0.f, 0.f, 0.f});
            f32x4 sacc = (f32x4){0.f, 0.f, 0.f, 0.f};
            if (tc <= tr) sacc = mm64(Qt, Kt, tr, tc, fr, fq, sacc);
#pragma unroll
            for (int q = 0; q < 4; ++q) { const int tau = tr * 16 + fq * 4 + q, sig = tc * 16 + fr; Sc[tau * HS + sig] = (bf16_t)f2bf(sig <= tau ? sacc[q] : 0.f); } } }
    __syncthreads();
#pragma unroll
    for (int dir = 0; dir < 2; ++dir) { unsigned char* tb = lds + (dir ? HL_D1 : HL_T0); const bf16_t* Vt = (const bf16_t*)(tb + 4 * HL_TB); const bf16_t* Sc = (const bf16_t*)(tb + 5 * HL_TB);
        float* os = dir ? os1 : os0;
#pragma unroll
        for (int t2 = 0; t2 < 2; ++t2) { const int tc = (wid & 1) * 2 + t2;
            const f32x4 o = mm64(Sc, Vt, tr, tc, fr, fq, oacc[dir][t2]);
#pragma unroll
            for (int q = 0; q < 4; ++q) { const int tau = tr * 16 + fq * 4 + q, e = tc * 16 + fr, tok = dir ? 63 - tau : tau; os[tok * 64 + e] = o[q]; } } }
    __syncthreads();
    bf16_t* Y = (bf16_t*)(p->ws + Z_YCAT); const float ong = p->in[22][l * 64 + lane];
#pragma unroll
    for (int i = 0; i < 8; ++i) { const int tok = wid + 8 * i; const float v = os0[tok * 64 + lane] + os1[tok * 64 + lane];
        const float y = v * rsqrtf(wave_sum(v * v) * (1.f / 64.f) + EPS) * ong;
        Y[(size_t)(row0 + tok) * D + 768 + head * 64 + lane] = (bf16_t)f2bf(y * silu_(r.gg[i])); }
    __syncthreads();
}
__device__ __forceinline__ int hgrn_p3_unit(int k) { if (k < 1024) { const int bh = k >> 7, c = k & 127; return bh * NCHUNK + 4 + c; } const int k2 = k - 1024; return (k2 >> 2) * NCHUNK + (k2 & 3); }
__device__ __forceinline__ void hgrn_pass3_run(KP p, int l, unsigned char* lds) {
    const int tid = tid_(), G = gsz_(), nunits = 1024 + (l == 0 ? 32 : 0);
    int k = bid_(); if (k >= nunits) return;
    HgrnIn3 cur; hgrn_p3_load(p, hgrn_p3_unit(k), tid, cur);
    for (;;) { const int kn = k + G; const bool more = kn < nunits;
        HgrnIn3 nxt = cur; if (more) hgrn_p3_load(p, hgrn_p3_unit(kn), tid, nxt);
        hgrn_p3_compute(p, l, lds, hgrn_p3_unit(k), tid, cur);
        if (!more) break;
        cur = nxt; k = kn; }
}
__device__ __forceinline__ void ph_prep(KP p, int l, unsigned char* lds) {
    const int tid = tid_(), lane = tid & 63, wid = tid >> 6, bid = bid_(), G = gsz_();
    const int nconv = 256 + (l == 0 ? 8 : 0);
    for (int it = bid; it < nconv; it += G) {
        if (it < 256) conv_tile(p, l, lds, (it >> 7) * NSEQ, NSEQ, (it & 127) * 64);
        else { const int c = it - 256; conv_tile(p, l, lds, R_LAT + (c >> 2) * NCTX, NCTX, (c & 3) * 64); } }
    if (G == 256) {
        const int u0 = bid < 8 ? 2 * bid : bid < 56 ? 16 + 5 * (bid - 8) : 256 + 4 * (bid - 56), un = bid < 8 ? 2 : bid < 56 ? 5 : 4;
        hgrn_pass1_run(p, l, lds, u0, un, 1);
        const int g0 = bid < 104 ? 8 * bid : bid < 168 ? 832 + 9 * (bid - 104) : 1408 + 8 * (bid - 168), gn = (bid >= 104 && bid < 168) ? 9 : 8;
        const QkvLane qc = qkv_lane_consts(p, l, lane);
        for (int g = g0; g < g0 + gn; ++g) prep_qkv_row(p, l, g * 8 + wid, lane, qc);
    } else {
        hgrn_pass1_run(p, l, lds, bid, (8 * NCHUNK - bid + G - 1) / G, G);
        const QkvLane qc = qkv_lane_consts(p, l, lane);
        for (int row = bid * 8 + wid; row < R_ALL; row += G * 8) prep_qkv_row(p, l, row, lane, qc);
    }
}

__device__ __forceinline__ void hgrn_scan(KP p) {
    const int gi = bid_() * NTHREADS + tid_();
    if (gi >= 16 * 4096) return;
    const int seq = gi >> 12, de = gi & 4095, d = de >> 6;
    float* U = (float*)(p->ws + Z_U) + (size_t)seq * NCHUNK * 4096 + de; const float* Gv = (const float*)(p->ws + Z_G) + (size_t)seq * NCHUNK * 64 + d;
    float S = 0.f;
    for (int j = 0; j < NCHUNK; j += 4) {
        float u[4], g[4];
#pragma unroll
        for (int q = 0; q < 4; ++q) { u[q] = U[(size_t)(j + q) * 4096]; g[q] = Gv[(j + q) * 64]; }
#pragma unroll
        for (int q = 0; q < 4; ++q) { U[(size_t)(j + q) * 4096] = S; S = g[q] * S + u[q]; }
    }
}
__device__ __forceinline__ void attn_simple_unit(unsigned char* lds, const bf16_t* Qrow0  , const bf16_t* Kb, const bf16_t* Vb  ,
                                                 int mode, int NT, int first_key, int q0, bool use_sink, float sink_log2, bf16_t* Orow0  ) {
    float* Ks = (float*)lds; float* Vs = Ks + 4096;
    const int tid = tid_();
    float q[64], o[64], m = -INFINITY, lsum = 0.f;
    if (tid < 256) {
#pragma unroll
        for (int d = 0; d < 64; ++d) { q[d] = bf2f(Qrow0[(size_t)tid * 256 + d]); o[d] = 0.f; }
    }
    for (int tt = 0; tt < NT; ++tt) {
        int key0, pos0 = 0; bool masked = false;
        if (mode == 0) key0 = first_key + 64 * tt;
        else if (tt < 4) key0 = NSEQ + 64 * tt;
        else { pos0 = q0 - 128 + 64 * (tt - 4); key0 = pos0 < 0 ? 0 : (pos0 > NSEQ - 64 ? NSEQ - 64 : pos0); masked = true; }
        __syncthreads();
        for (int i = tid; i < 4096; i += NTHREADS) { const int kk = i >> 6, d = i & 63; Ks[i] = bf2f(Kb[(size_t)(key0 + kk) * 128 + d]); Vs[i] = bf2f(Vb[(size_t)(key0 + kk) * 128 + d]); }
        __syncthreads();
        if (tid < 256) {
            for (int kk = 0; kk < 64; ++kk) {
                if (masked) { const int kp = pos0 + kk, qp = q0 + tid; const int df = qp - kp; if (kp < 0 || kp >= NSEQ || df > 128 || df < -128) continue; }
                float s = 0.f;
#pragma unroll
                for (int d = 0; d < 64; ++d) s += q[d] * Ks[kk * 64 + d];
                if (s > m) { const float f = exp2f(m - s); lsum *= f;
#pragma unroll
                    for (int d = 0; d < 64; ++d) o[d] *= f;
                    m = s; }
                const float pe = exp2f(s - m); lsum += pe;
#pragma unroll
                for (int d = 0; d < 64; ++d) o[d] += pe * Vs[kk * 64 + d];
            }
        }
    }
    if (tid < 256) {
        if (use_sink) lsum += exp2f(sink_log2 - m);
        const float inv = 1.f / lsum;
#pragma unroll
        for (int d = 0; d < 64; ++d) Orow0[(size_t)tid * D + d] = (bf16_t)f2bf(o[d] * inv);
    }
    __syncthreads();
}
__device__ __forceinline__ void ph_attn(KP p, int l, unsigned char* lds) {
    hgrn_scan(p);
    bf16_t* Y = (bf16_t*)(p->ws + Z_YCAT);
    const bf16_t* Qg = (const bf16_t*)(p->ws + Z_QG); const bf16_t* Qw = (const bf16_t*)(p->ws + Z_QW); const bf16_t* Qgc = (const bf16_t*)(p->ws + Z_QGC); const bf16_t* Qwc = (const bf16_t*)(p->ws + Z_QWC);
    const bf16_t* Kg = (const bf16_t*)(p->ws + Z_KG); const bf16_t* Kw = (const bf16_t*)(p->ws + Z_KW); const bf16_t* Vg = (const bf16_t*)(p->ws + Z_VG); const bf16_t* Vw = (const bf16_t*)(p->ws + Z_VW);
    const int nunits = 512 + (l == 0 ? 16 : 0);
    for (int u = bid_(); u < nunits; u += gsz_()) {
        if (u < 256) {
            const int qb = u & 31, h = (u >> 5) & 3, b = u >> 7, row0 = b * NSEQ + qb * 256;
            attn_simple_unit(lds, Qg + (size_t)row0 * 256 + h * 64, Kg + (size_t)b * NKEY * 128 + (h >> 1) * 64, Vg + (size_t)b * NKEY * 128 + (h >> 1) * 64, 0, NKEY / 64, 0, qb * 256, false, 0.f, Y + (size_t)row0 * D + h * 64);
        } else if (u < 512) {
            const int v = u - 256, qb = v & 31, h = (v >> 5) & 3, b = v >> 7, row0 = b * NSEQ + qb * 256;
            attn_simple_unit(lds, Qw + (size_t)row0 * 256 + h * 64, Kw + (size_t)b * NKEY * 128 + (h >> 1) * 64, Vw + (size_t)b * NKEY * 128 + (h >> 1) * 64, 1, 12, 0, qb * 256, true, p->in[14][l * 4 + h] * LOG2E, Y + (size_t)row0 * D + 512 + h * 64);
        } else {
            const int v = u - 512, h = v & 3, b = (v >> 2) & 1, win = v >> 3, row0 = R_LAT + b * NCTX;
            const bf16_t* Qc = (win ? Qwc : Qgc) + (size_t)(b * NCTX) * 256 + h * 64;
            const bf16_t* Kc = (win ? Kw : Kg) + (size_t)b * NKEY * 128 + (h >> 1) * 64; const bf16_t* Vc = (win ? Vw : Vg) + (size_t)b * NKEY * 128 + (h >> 1) * 64;
            attn_simple_unit(lds, Qc, Kc, Vc, 0, 4, NSEQ, 0, win != 0, p->in[14][l * 4 + h] * LOG2E, Y + (size_t)row0 * D + (win ? 512 : 0) + h * 64);
        }
    }
}

namespace attn_body {
using bf16=__hip_bfloat16;
using bf16x8=__attribute__((ext_vector_type(8)))short;
using s16x4=__attribute__((ext_vector_type(4)))short;
using f32x16=__attribute__((ext_vector_type(16)))float;
using u32x4=__attribute__((ext_vector_type(4)))unsigned;
constexpr int D=64, QP=256, KP=128, OP=1024;
constexpr int NW=8,QBLK=32,QB=QBLK*NW,KVBLK=64;
__device__ __forceinline__ int crow(int r,int hi){return (r&3)+8*(r>>2)+4*hi;}
#define SBAR() __builtin_amdgcn_sched_barrier(0)
__device__ __forceinline__ void wmask(f32x16&p0,f32x16&p1,int tb,int qrel,int hi,int q0){
  const float NEG=-INFINITY; const int kb=64*tb+4*hi;
  #pragma unroll
  for(int r=0;r<16;++r){const int kl=kb+(r&3)+8*(r>>2); const int kp=q0-128+kl;
    if(kl<qrel||kl>qrel+256||kp<0||kp>=NSEQ)p0[r]=NEG;
    if(kl+32<qrel||kl+32>qrel+256||kp+32<0||kp+32>=NSEQ)p1[r]=NEG;}
}

constexpr int NSLOT=3, SLOTB=8192;
constexpr int LDS_K=0, LDS_V=NSLOT*SLOTB, LDS_WS=2*NSLOT*SLOTB, LDS_OST=LDS_WS+NW*64*4, LDS_BYTES=LDS_OST+NW*4096;
constexpr float C2=0.125f*1.4426950408889634f;
__device__ __forceinline__ void glds16(const void*gsrc,unsigned lds_dst){unsigned keep;
  asm volatile("s_mov_b32 %0, m0\n\ts_mov_b32 m0, %2\n\ts_nop 0\n\tglobal_load_lds_dwordx4 %1, off\n\ts_mov_b32 m0, %0":"=&s"(keep):"v"(gsrc),"s"(lds_dst):"memory");}
__device__ __forceinline__ float max3f(float a,float b,float c){float r;asm("v_max3_f32 %0, %1, %2, %3":"=v"(r):"v"(a),"v"(b),"v"(c));return r;}
__device__ __forceinline__ float max2f(float a,float b){float r;asm("v_max_f32_e32 %0, %1, %2":"=v"(r):"v"(a),"v"(b));return r;}
__device__ __forceinline__ float fadd_s(float a,float b){float r;asm("v_add_f32_e32 %0, %1, %2":"=v"(r):"v"(a),"v"(b));return r;}
__device__ __forceinline__ float fsub_s(float a,float b){float r;asm("v_sub_f32_e32 %0, %1, %2":"=v"(r):"v"(a),"v"(b));return r;}
typedef float f32x2_t __attribute__((ext_vector_type(2))); typedef __bf16 bf16x2_t __attribute__((ext_vector_type(2)));
__device__ __forceinline__ unsigned cvtpk_s(float lo,float hi){f32x2_t v={lo,hi};bf16x2_t b=__builtin_convertvector(v,bf16x2_t);return __builtin_bit_cast(unsigned,b);}
#define WAIT_BAR(N) asm volatile("s_waitcnt vmcnt(" #N ") lgkmcnt(0)\n\ts_barrier":::"memory")

__device__ __forceinline__ void qkt(f32x16&p0,f32x16&p1,const char*Kslot,const bf16x8*qr,const f32x16&negm,int r32,int hi){
  const char*kb=Kslot+hi*1024+r32*16;
  #pragma unroll
  for(int d0=0;d0<4;++d0){
    const bf16x8 b0=*reinterpret_cast<const bf16x8*>(kb+d0*2048);
    const bf16x8 b1=*reinterpret_cast<const bf16x8*>(kb+d0*2048+512);
    if(d0==0){p0=__builtin_amdgcn_mfma_f32_32x32x16_bf16(b0,qr[0],negm,0,0,0);p1=__builtin_amdgcn_mfma_f32_32x32x16_bf16(b1,qr[0],negm,0,0,0);}
    else{p0=__builtin_amdgcn_mfma_f32_32x32x16_bf16(b0,qr[d0],p0,0,0,0);p1=__builtin_amdgcn_mfma_f32_32x32x16_bf16(b1,qr[d0],p1,0,0,0);}}
}
typedef __attribute__((address_space(3))) const char* lds_cptr;
typedef short v4i16_t __attribute__((ext_vector_type(4)));
__device__ __forceinline__ void kload8(bf16x8*kf,lds_cptr kp){
  kf[0]=*(const __attribute__((address_space(3))) bf16x8*)(kp);      kf[1]=*(const __attribute__((address_space(3))) bf16x8*)(kp+512);
  kf[2]=*(const __attribute__((address_space(3))) bf16x8*)(kp+2048); kf[3]=*(const __attribute__((address_space(3))) bf16x8*)(kp+2560);
  kf[4]=*(const __attribute__((address_space(3))) bf16x8*)(kp+4096); kf[5]=*(const __attribute__((address_space(3))) bf16x8*)(kp+4608);
  kf[6]=*(const __attribute__((address_space(3))) bf16x8*)(kp+6144); kf[7]=*(const __attribute__((address_space(3))) bf16x8*)(kp+6656);
}
__device__ __forceinline__ void kload2(bf16x8*kf,lds_cptr kp,int j){ kf[2*j]=*(const __attribute__((address_space(3))) bf16x8*)(kp+j*2048); kf[2*j+1]=*(const __attribute__((address_space(3))) bf16x8*)(kp+j*2048+512); }
__device__ __forceinline__ s16x4 vtr(lds_cptr p){ return __builtin_bit_cast(s16x4,__builtin_amdgcn_ds_read_tr16_b64_v4i16((__attribute__((address_space(3))) v4i16_t*)p)); }
__device__ __forceinline__ float rowmax(const f32x16&p0,const f32x16&p1){
  float a=max3f(p0[0],p0[1],p1[0]),b=max3f(p0[2],p0[3],p1[1]);a=max3f(a,p1[2],p1[3]);
  #pragma unroll
  for(int r=4;r<16;r+=4){a=max3f(a,p0[r],p0[r+1]);b=max3f(b,p0[r+2],p0[r+3]);a=max3f(a,p1[r],p1[r+1]);b=max3f(b,p1[r+2],p1[r+3]);}
  const float m=max2f(a,b);
  auto rr=__builtin_amdgcn_permlane32_swap(__float_as_uint(m),__float_as_uint(m),false,false);
  return max2f(__uint_as_float(rr[0]),__uint_as_float(rr[1]));
}
__device__ __forceinline__ void pv(f32x16*o,int vb,bf16x8 pa0,bf16x8 pa1,bf16x8 pa2,bf16x8 pa3){
  #pragma unroll
  for(int d0=0;d0<2;++d0){s16x4 lo[4],hi[4];
    #pragma unroll
    for(int ks=0;ks<4;++ks){
      asm volatile("ds_read_b64_tr_b16 %0,%1 offset:%c2":"=&v"(lo[ks]):"v"(vb),"i"(d0*4096+ks*1024):"memory");
      asm volatile("ds_read_b64_tr_b16 %0,%1 offset:%c2":"=&v"(hi[ks]):"v"(vb),"i"(d0*4096+ks*1024+512):"memory");}
    asm volatile("s_waitcnt lgkmcnt(0)":::"memory");SBAR();
    #define PK(k) (bf16x8){lo[k][0],lo[k][1],lo[k][2],lo[k][3],hi[k][0],hi[k][1],hi[k][2],hi[k][3]}
    o[d0]=__builtin_amdgcn_mfma_f32_32x32x16_bf16(pa0,PK(0),o[d0],0,0,0);
    o[d0]=__builtin_amdgcn_mfma_f32_32x32x16_bf16(pa1,PK(1),o[d0],0,0,0);
    o[d0]=__builtin_amdgcn_mfma_f32_32x32x16_bf16(pa2,PK(2),o[d0],0,0,0);
    o[d0]=__builtin_amdgcn_mfma_f32_32x32x16_bf16(pa3,PK(3),o[d0],0,0,0);
    #undef PK
  }
}

#ifndef ATTN_STORE16
#define ATTN_STORE16(p,v) (*(u32x4*)(p)=(v))
#endif
template<int MODE,int NMASKT,int THRL> __device__ __forceinline__ void attn_unit(const bf16*Q0,const bf16*__restrict__ Kh,const bf16*__restrict__ Vh,bf16*O0,int NT,int key_first,int q0,bool use_sink,float sink_l2,char*shm){
  const int tid=tid_(),lane=tid&63,r32=lane&31,hi=lane>>5; const int wid=__builtin_amdgcn_readfirstlane(tid>>6);
  const bf16*Qw=Q0+(long)(wid*QBLK)*QP;
  auto krow=[&](int t)->long{ if(MODE==0) return (long)key_first+64*t; if(t<4) return (long)NSEQ+64*t; int p=q0-128+64*(t-4); p=p<0?0:(p>NSEQ-64?NSEQ-64:p); return (long)p; };
  const unsigned lds0=(unsigned)(uintptr_t)shm;
  float*wsf=(float*)(shm+LDS_WS)+wid*64;
  const bf16*ksrc=Kh+(long)lane*KP+wid*8;
  const bf16*vsrc=Vh+(long)(16*(wid&3)+(lane>>2))*KP+(wid>>2)*32+(lane&3)*8;
  const unsigned kdst=lds0+LDS_K+wid*1024, vdst=lds0+LDS_V+wid*1024;
  #define DMA_K(t,slot) glds16(ksrc+krow(t)*KP,(unsigned)__builtin_amdgcn_readfirstlane(kdst+(slot)))
  #define DMA_V(t,slot) glds16(vsrc+krow(t)*KP,(unsigned)__builtin_amdgcn_readfirstlane(vdst+(slot)))
  const int vb0=(int)(lds0+LDS_V)+((lane>>4)&1)*32+(lane&3)*8+(4*hi+((lane&15)>>2))*64;
  const char*Kbase=shm+LDS_K; bf16x8 kf[8];
  const lds_cptr shm3=(lds_cptr)shm; const lds_cptr kp0=shm3+LDS_K+hi*1024+r32*16; const lds_cptr vp0=shm3+LDS_V+((lane>>4)&1)*32+(lane&3)*8+(4*hi+((lane&15)>>2))*64;
  DMA_K(0,0);DMA_V(0,0);DMA_K(1,SLOTB);
  bf16x8 qr[4];
  #pragma unroll
  for(int d0=0;d0<4;++d0)qr[d0]=*reinterpret_cast<const bf16x8*>(&Qw[(long)r32*QP+d0*16+hi*8]);
  float mhat=0.f,l_reg=0.f;f32x16 o[2];o[0]=f32x16{};o[1]=f32x16{};f32x16 negm=f32x16{};asm volatile("":"+v"(negm));
  const int qrel=wid*QBLK+r32;
  #define CMASK(P0,P1,t) do{ if(NMASKT>0){int jb_=(t)-(NT-NMASKT); if(jb_>=0)wmask(P0,P1,jb_,qrel,hi,q0);} }while(0)
  bool resc=false;
  #define START(P0,P1) do{ const float rm=rowmax(P0,P1); resc=false; \
    { const float dl=rm; mhat=fadd_s(mhat,dl); \
      _Pragma("unroll") for(int r=0;r<16;++r){P0[r]=fsub_s(P0[r],dl);P1[r]=fsub_s(P1[r],dl);} \
      _Pragma("unroll") for(int r=0;r<16;++r)negm[r]=-mhat; asm volatile("":"+v"(negm)); } \
    _Pragma("unroll") for(int r=0;r<16;++r)P0[r]=__builtin_amdgcn_exp2f(P0[r]); }while(0)
  #define RESC() do{ if(resc){ asm volatile("s_waitcnt lgkmcnt(0)":::"memory"); \
      _Pragma("unroll") for(int d_=0;d_<2;++d_) _Pragma("unroll") for(int r=0;r<16;++r)o[d_][r]*=wsf[crow(r,hi)]; } }while(0)
  f32x16 pA0,pA1,pB0,pB1;
  int sl_prev=0,sl_cur=0,sl_next=SLOTB;
  #define ROT() do{sl_prev=sl_cur;sl_cur=sl_next;sl_next=(sl_next==(NSLOT-1)*SLOTB)?0:sl_next+SLOTB;}while(0)
  DMA_K(2,2*SLOTB);
  WAIT_BAR(3);
  qkt(pA0,pA1,Kbase,qr,negm,r32,hi);asm volatile("s_nop 15\n\ts_nop 7":"+v"(pA0),"+v"(pA1));CMASK(pA0,pA1,0);
  START(pA0,pA1);
  _Pragma("unroll") for(int r=0;r<16;++r)pA1[r]=__builtin_amdgcn_exp2f(pA1[r]);
  WAIT_BAR(0);
  DMA_K(3,0);DMA_V(1,SLOTB);
  ROT();
  kload8(kf,kp0+sl_cur);
  WAIT_BAR(2);
  s16x4 vlo[8],vhi[8]; u32x4 pw0,pw1,pw2,pw3;
  #define PKW(P,B) cvtpk_s(P[B],P[B+1])
  #define PAF(k) __builtin_bit_cast(bf16x8,pw##k)
  #define VFR(i) (bf16x8){vlo[i][0],vlo[i][1],vlo[i][2],vlo[i][3],vhi[i][0],vhi[i][1],vhi[i][2],vhi[i][3]}
  #define PIN(x) asm volatile("":"+v"(x))
  #define MX3(a,b,c) __builtin_fmaxf(__builtin_fmaxf((a),(b)),(c))
  #define GAPA(MF,A0,A1,A2,A3,W0,W1,PW) do{ MF; sacc+=A0; sacc+=A1; sacc+=A2; sacc+=A3; PIN(sacc); W0; W1; PIN(PW); SBAR(); }while(0)
  #define EX(v) __builtin_amdgcn_exp2f(v)
  #define GAPB(MF,X,B) do{ MF; X[B]=EX(X[B]); X[B+1]=EX(X[B+1]); X[B+2]=EX(X[B+2]); X[B+3]=EX(X[B+3]); PIN(X); SBAR(); }while(0)
  #define VRD(i) do{ vlo[i]=vtr(vp_+(((i)>>2)*4096+((i)&3)*1024)); vhi[i]=vtr(vp_+(((i)>>2)*4096+((i)&3)*1024+512)); }while(0)
  #define KRD(G,j) do{ if(G){ kload2(kf,kp0+sl_next,j); SBAR(); } }while(0)
  #define STEP(C0,C1,P0,P1,t,GK,GV,GL) do{ SBAR(); \
    const lds_cptr vp_=vp0+sl_prev; \
    VRD(0); SBAR(); float sacc=(P0[0]+P0[1]); \
    GAPA(C0=__builtin_amdgcn_mfma_f32_32x32x16_bf16(kf[0],qr[0],negm,0,0,0), P0[2],P0[3],P0[4],P0[5],     pw0[0]=PKW(P0,0), pw0[1]=PKW(P0,2), pw0); \
    VRD(4); SBAR(); GAPA(C1=__builtin_amdgcn_mfma_f32_32x32x16_bf16(kf[1],qr[0],negm,0,0,0), P0[6],P0[7],P0[8],P0[9],     pw0[2]=PKW(P0,4), pw0[3]=PKW(P0,6), pw0); \
    VRD(1); SBAR(); GAPA(C0=__builtin_amdgcn_mfma_f32_32x32x16_bf16(kf[2],qr[1],C0,0,0,0),   P0[10],P0[11],P0[12],P0[13], pw1[0]=PKW(P0,8), pw1[1]=PKW(P0,10), pw1); \
    VRD(5); SBAR(); GAPA(C1=__builtin_amdgcn_mfma_f32_32x32x16_bf16(kf[3],qr[1],C1,0,0,0),   P0[14],P0[15],P1[0],P1[1],   pw1[2]=PKW(P0,12),pw1[3]=PKW(P0,14), pw1); \
    VRD(2); SBAR(); GAPA(C0=__builtin_amdgcn_mfma_f32_32x32x16_bf16(kf[4],qr[2],C0,0,0,0),   P1[2],P1[3],P1[4],P1[5],     pw2[0]=PKW(P1,0), pw2[1]=PKW(P1,2), pw2); \
    VRD(6); SBAR(); GAPA(C1=__builtin_amdgcn_mfma_f32_32x32x16_bf16(kf[5],qr[2],C1,0,0,0),   P1[6],P1[7],P1[8],P1[9],     pw2[2]=PKW(P1,4), pw2[3]=PKW(P1,6), pw2); \
    VRD(3); SBAR(); GAPA(C0=__builtin_amdgcn_mfma_f32_32x32x16_bf16(kf[6],qr[3],C0,0,0,0),   P1[10],P1[11],P1[12],P1[13], pw3[0]=PKW(P1,8), pw3[1]=PKW(P1,10), pw3); \
    VRD(7); SBAR(); GAPA(C1=__builtin_amdgcn_mfma_f32_32x32x16_bf16(kf[7],qr[3],C1,0,0,0),   P1[14],P1[15],0.f,0.f,       pw3[2]=PKW(P1,12),pw3[3]=PKW(P1,14), pw3); \
    l_reg+=sacc; \
    if(GK){DMA_K((t)+3,sl_cur);} if(GV){DMA_V((t)+1,sl_next);} \
    CMASK(C0,C1,t); \
    { float a=MX3(C0[0],C0[1],C1[0]),b=MX3(C0[2],C0[3],C1[1]); a=MX3(a,C1[2],C1[3]); \
      _Pragma("unroll") for(int r=4;r<16;r+=4){a=MX3(a,C0[r],C0[r+1]);b=MX3(b,C0[r+2],C0[r+3]);a=MX3(a,C1[r],C1[r+1]);b=MX3(b,C1[r+2],C1[r+3]);} \
      float rm=__builtin_fmaxf(a,b); { auto rr=__builtin_amdgcn_permlane32_swap(__float_as_uint(rm),__float_as_uint(rm),false,false); rm=__builtin_fmaxf(__uint_as_float(rr[0]),__uint_as_float(rr[1])); } \
      resc=false; \
      if(__builtin_expect(__any(rm>(float)THRL),0)){ const float dl=__builtin_fmaxf(rm,0.f); mhat+=dl; \
        _Pragma("unroll") for(int r=0;r<16;++r){C0[r]-=dl;C1[r]-=dl;} \
        _Pragma("unroll") for(int r=0;r<16;++r)negm[r]=-mhat; asm volatile("":"+v"(negm)); \
        const float f=__builtin_amdgcn_exp2f(-dl); l_reg*=f; if(hi==0)wsf[r32]=f; resc=true; } } \
    SBAR(); \
    GAPB(o[0]=__builtin_amdgcn_mfma_f32_32x32x16_bf16(PAF(0),VFR(0),o[0],0,0,0), C0,0); \
    GAPB(o[1]=__builtin_amdgcn_mfma_f32_32x32x16_bf16(PAF(0),VFR(4),o[1],0,0,0), C0,4); \
    KRD(GL,0); GAPB(o[0]=__builtin_amdgcn_mfma_f32_32x32x16_bf16(PAF(1),VFR(1),o[0],0,0,0), C0,8); \
    KRD(GL,1); GAPB(o[1]=__builtin_amdgcn_mfma_f32_32x32x16_bf16(PAF(1),VFR(5),o[1],0,0,0), C0,12); \
    KRD(GL,2); GAPB(o[0]=__builtin_amdgcn_mfma_f32_32x32x16_bf16(PAF(2),VFR(2),o[0],0,0,0), C1,0); \
    KRD(GL,3); GAPB(o[1]=__builtin_amdgcn_mfma_f32_32x32x16_bf16(PAF(2),VFR(6),o[1],0,0,0), C1,4); \
    GAPB(o[0]=__builtin_amdgcn_mfma_f32_32x32x16_bf16(PAF(3),VFR(3),o[0],0,0,0), C1,8); \
    GAPB(o[1]=__builtin_amdgcn_mfma_f32_32x32x16_bf16(PAF(3),VFR(7),o[1],0,0,0), C1,12); \
    }while(0)
  int t=1;
  #undef CMASK
  #define CMASK(P0,P1,t) do{}while(0)
  for(;t+1+(NMASKT>4?NMASKT:4)<NT;t+=2){
    STEP(pB0,pB1,pA0,pA1,t,true,true,true);     WAIT_BAR(2); RESC(); ROT();
    STEP(pA0,pA1,pB0,pB1,t+1,true,true,true);   WAIT_BAR(2); RESC(); ROT();
  }
  #undef CMASK
  #define CMASK(P0,P1,t) do{ if(NMASKT>0){int jb_=(t)-(NT-NMASKT); if(jb_>=0)wmask(P0,P1,jb_,qrel,hi,q0);} }while(0)
  #define ENDW(tt) do{ if((tt)+3<NT){WAIT_BAR(2);} else if((tt)+2<NT){WAIT_BAR(1);} else {WAIT_BAR(0);} }while(0)
  for(;t+1<NT;t+=2){
    STEP(pB0,pB1,pA0,pA1,t,(t+3<NT),(t+1<NT),(t+1<NT));       ENDW(t);   RESC(); ROT();
    STEP(pA0,pA1,pB0,pB1,t+1,(t+4<NT),(t+2<NT),(t+2<NT));     ENDW(t+1); RESC(); ROT();
  }
  STEP(pB0,pB1,pA0,pA1,NT-1,false,false,false); RESC();
  { float sacc=pB0[0]+pB0[1]; _Pragma("unroll") for(int r=2;r<16;++r)sacc+=pB0[r]; _Pragma("unroll") for(int r=0;r<16;++r)sacc+=pB1[r]; l_reg+=sacc;
    pw0=(u32x4){PKW(pB0,0),PKW(pB0,2),PKW(pB0,4),PKW(pB0,6)};pw1=(u32x4){PKW(pB0,8),PKW(pB0,10),PKW(pB0,12),PKW(pB0,14)};pw2=(u32x4){PKW(pB1,0),PKW(pB1,2),PKW(pB1,4),PKW(pB1,6)};pw3=(u32x4){PKW(pB1,8),PKW(pB1,10),PKW(pB1,12),PKW(pB1,14)};
    SBAR(); pv(o,vb0+sl_cur,PAF(0),PAF(1),PAF(2),PAF(3)); }
  #undef PKW
  #undef PAF
  #undef VFR
  #undef PIN
  #undef MX3
  #undef GAPA
  #undef GAPB
  #undef EX
  #undef VRD
  #undef KRD
  #undef STEP
  #undef ENDW
  {auto rr=__builtin_amdgcn_permlane32_swap(__float_as_uint(l_reg),__float_as_uint(l_reg),false,false);l_reg=__uint_as_float(rr[0])+__uint_as_float(rr[1]);}
  if(use_sink)l_reg+=__builtin_amdgcn_exp2f(sink_l2-mhat);
  if(hi==0)wsf[32+r32]=l_reg;asm volatile("s_waitcnt lgkmcnt(0)":::"memory");
  float rli[16];
  #pragma unroll
  for(int r=0;r<16;++r)rli[r]=__builtin_amdgcn_rcpf(wsf[32+crow(r,hi)]);
  bf16*Ow=O0+(long)(wid*QBLK)*OP;
  { bf16*stg=(bf16*)(shm+LDS_OST)+wid*2048;
    #pragma unroll
    for(int r=0;r<16;++r){const int orow=crow(r,hi);
      #pragma unroll
      for(int d0=0;d0<2;++d0)stg[orow*64+d0*32+r32]=__float2bfloat16(o[d0][r]*rli[r]);}
    asm volatile("s_waitcnt lgkmcnt(0)":::"memory");
    #pragma unroll
    for(int i=0;i<4;++i){const int row=i*8+(lane>>3),ch=lane&7; const u32x4 v=*(const u32x4*)(stg+row*64+ch*8); ATTN_STORE16(Ow+(long)row*OP+ch*8,v);} }
  asm volatile("s_waitcnt lgkmcnt(0)\n\ts_barrier":::"memory");
  #undef DMA_K
  #undef DMA_V
  #undef CMASK
  #undef START
  #undef RESC
  #undef ROT
}
constexpr int ATTN_LDS_BYTES=LDS_BYTES;
#undef SBAR
#undef WAIT_BAR
}

__device__ __forceinline__ void ph_attn_f(KP p, int l, unsigned char* lds, bool do_scan = true) {
    if (do_scan) { if (FAST_HGRN) hgrn_scan_f(p); else hgrn_scan(p); }
    using attn_body::bf16;
    bf16* Y = (bf16*)(p->ws + Z_YCAT);
    const bf16* Qg = (const bf16*)(p->ws + Z_QG); const bf16* Qw = (const bf16*)(p->ws + Z_QW); const bf16* Qgc = (const bf16*)(p->ws + Z_QGC); const bf16* Qwc = (const bf16*)(p->ws + Z_QWC);
    const bf16* Kg = (const bf16*)(p->ws + Z_KG); const bf16* Kw = (const bf16*)(p->ws + Z_KW); const bf16* Vg = (const bf16*)(p->ws + Z_VG); const bf16* Vw = (const bf16*)(p->ws + Z_VW);
    const int G = gsz_(), bid = bid_();
    __syncthreads();
    for (int vb = bid; vb < 256; vb += G) {
        const int v = (G == 256) ? (((vb & 7) >> 1) * 64 + (vb & 1) * 32 + (vb >> 3)) : vb;
        const int b = v >> 7, kvh = (v >> 6) & 1, h = kvh * 2 + ((v >> 5) & 1), qb = v & 31, row0 = b * NSEQ + qb * 256;
        const size_t kvo = (size_t)b * NKEY * 128 + kvh * 64;
        attn_body::attn_unit<0, 0, 8>(Qg + (size_t)row0 * 256 + h * 64, Kg + kvo, Vg + kvo, Y + (size_t)row0 * D + h * 64, NKEY / 64, 0, 0, false, 0.f, (char*)lds);
        attn_body::attn_unit<1, 8, 8>(Qw + (size_t)row0 * 256 + h * 64, Kw + kvo, Vw + kvo, Y + (size_t)row0 * D + 512 + h * 64, 12, 0, qb * 256, true, p->in[14][l * 4 + h] * LOG2E, (char*)lds);
    }
    if (l == 0) for (int v = bid; v < 16; v += G) {
        const int h = v & 3, b = (v >> 2) & 1, win = v >> 3, row0 = R_LAT + b * NCTX;
        const size_t kvo = (size_t)b * NKEY * 128 + (h >> 1) * 64;
        attn_body::attn_unit<0, 0, 8>((win ? Qwc : Qgc) + (size_t)(b * NCTX) * 256 + h * 64, (win ? Kw : Kg) + kvo, (win ? Vw : Vg) + kvo, Y + (size_t)row0 * D + (win ? 512 : 0) + h * 64, 4, NSEQ, 0, win != 0, p->in[14][l * 4 + h] * LOG2E, (char*)lds);
    }
}

__device__ __forceinline__ void hgrn_pass3_unit(KP p, int l, unsigned char* lds, int unit) {
    float* qs = (float*)lds; float* vs = qs + 4096; float* ks = vs + 4096; float* cs = ks + 4096; float* Ss = cs + 4096; float* sc = Ss + 4096; float* os = sc + 4096;
    const int tid = tid_(), lane = tid & 63, wid = tid >> 6;
    const int cpos = unit % NCHUNK, head = (unit / NCHUNK) & 3, b = unit / (NCHUNK * 4);
    const int row0 = (cpos < 4) ? R_LAT + b * NCTX + cpos * 64 : b * NSEQ + (cpos - 4) * 64;
    for (int i = tid; i < 4096; i += NTHREADS) os[i] = 0.f;
    for (int dir = 0; dir < 2; ++dir) {
        const int j = (cpos < 4) ? (dir ? 3 - cpos : cpos) : 4 + (dir ? 127 - (cpos - 4) : (cpos - 4));
        const int seq = (b * 4 + head) * 2 + dir;
        __syncthreads();
        hgrn_load_chunk(p, l, row0, dir, head, qs, vs, ks, cs);
        const float* Sg = (const float*)(p->ws + Z_U) + ((size_t)seq * NCHUNK + j) * 4096;
        for (int i = tid; i < 4096; i += NTHREADS) Ss[i] = Sg[i];
        for (int i = tid; i < 4096; i += NTHREADS) { const int tau = i >> 6, sig = i & 63; float a = 0.f;
            if (sig <= tau) { for (int d = 0; d < 64; ++d) a += qs[tau * 64 + d] * ks[sig * 64 + d] * __expf(cs[tau * 64 + d] - cs[sig * 64 + d]); }
            sc[i] = a; }
        __syncthreads();
        { const int tau = tid >> 3, e0 = (tid & 7) * 8; float acc[8];
#pragma unroll
          for (int e = 0; e < 8; ++e) acc[e] = 0.f;
          for (int d = 0; d < 64; ++d) { const float qv = qs[tau * 64 + d] * __expf(cs[tau * 64 + d]);
#pragma unroll
              for (int e = 0; e < 8; ++e) acc[e] += qv * Ss[d * 64 + e0 + e]; }
          for (int sig = 0; sig <= tau; ++sig) { const float sv = sc[tau * 64 + sig];
#pragma unroll
              for (int e = 0; e < 8; ++e) acc[e] += sv * vs[sig * 64 + e0 + e]; }
          const int tok = dir ? 63 - tau : tau;
#pragma unroll
          for (int e = 0; e < 8; ++e) os[tok * 64 + e0 + e] += acc[e]; }
        __syncthreads();
    }
    const bf16_t* P = (const bf16_t*)(p->ws + Z_P); bf16_t* Y = (bf16_t*)(p->ws + Z_YCAT);
    for (int tok = wid; tok < 64; tok += 8) { const float v = os[tok * 64 + lane];
        const float y = v * rsqrtf(wave_sum(v * v) * (1.f / 64.f) + EPS) * p->in[22][l * 64 + lane];
        const float g = bf2f(P[(size_t)(row0 + tok) * DIN + C_RG + head * 64 + lane]);
        Y[(size_t)(row0 + tok) * D + 768 + head * 64 + lane] = (bf16_t)f2bf(y * silu_(g)); }
    __syncthreads();
}
__device__ __forceinline__ void ph_hgrn3(KP p, int l, unsigned char* lds) {
    hgrn_pass3_run(p, l, lds);
    if (l == 0 && DEPTH > 1 && gsz_() == 256) { __syncthreads(); ph_cvt(p, 1, lds, 32, 224, CVT_E1, CVT_E2); }
}

__device__ __forceinline__ void ph_outproj(KP p, int l, unsigned char* lds) {
    const bf16_t* A = (const bf16_t*)(p->ws + Z_YCAT); const bf16_t* Bt = (const bf16_t*)(p->ws + Z_WOUT); float* X = (float*)(p->ws + WS_X);
    const int T = (l == 0) ? R_ALL : R_LAT; const int TM = T / 128, TN = 8;
    for (int it = bid_(); it < TM * TN; it += gsz_()) { const int mt = it / TN, nt = it % TN;
        auto epi = [&](int row, int col, float v, float) { const int c = nt * 128 + col; X[(size_t)row * D + c] = xrow_src(p, l, row)[c] + mod_vec(p, l, row, 2)[c] * v; };
        gemm_simple_tile<1>(A, RowId{}, Bt, 1024, mt * 128, nt * 128, 0, epi); }
}

__device__ __forceinline__ void ph_norm2(KP p, int l, unsigned char* lds, int cnt_off = 0) {
    constexpr int RS = 1032, NSTG = 80;
    const int T = (l == 0) ? R_ALL : R_LAT;
    bf16_t* AH = (bf16_t*)lds; bf16_t* AL = AH + 16 * RS;
    float* PART = (float*)(lds + 2 * 16 * RS * 2); float* LOG = PART + 8 * 16 * 64;
    int* hist = (int*)(LOG + 16 * 64); int* hbase = hist + 64; int* s_e = hbase + 64; int* s_r = s_e + NSTG * 8; float* s_w = (float*)(s_r + NSTG * 8); float* msb = s_w + NSTG * 8;
    const int tid = tid_(), lane = tid & 63, wid = tid >> 6, fr = lane & 15, fq = lane >> 4, bid = bid_(), G = gsz_();
    bf16_t* Tok = (bf16_t*)(p->ws + Z_A); const bf16_t* X = (const bf16_t*)(p->ws + WS_X);
    const float* g2 = p->in[7] + l * D; const float* rw = p->in[23] + (size_t)l * 1024 * 64; const float* rbias = p->in[24] + l * 64;
    unsigned* cnt = (unsigned*)(p->ws + WS_CTL) + CW_CNT + cnt_off + l * 64;
    int* tok_e = (int*)(p->ws + WS_TOKE); int* tok_p = (int*)(p->ws + WS_TOKP); int* expl = (int*)(p->ws + WS_EXPL); float* expw = (float*)(p->ws + WS_EXPW);
    bf16x8 bh[4][4], bl[4][4];
    { const u32x4* RF = (const u32x4*)(p->ws + WS_RFRAG) + (size_t)((l * 8 + wid) * 16) * 128 + lane * 2;
#pragma unroll
      for (int t = 0; t < 4; ++t)
#pragma unroll
          for (int k = 0; k < 4; ++k) { bh[t][k] = __builtin_bit_cast(bf16x8, RF[(t * 4 + k) * 128]); bl[t][k] = __builtin_bit_cast(bf16x8, RF[(t * 4 + k) * 128 + 1]); } }
    const float mybias = rbias[lane];
    const int rpb = (T + G - 1) / G;
    for (int base = bid * rpb; base < T; base += G * rpb) {
        const int r1 = (base + rpb < T) ? base + rpb : T;
        if (tid < 64) hist[tid] = 0;
        for (int s0 = base; s0 < r1; s0 += 16) {
#pragma unroll
            for (int j2 = 0; j2 < 2; ++j2) { const int lr = wid * 2 + j2, row = s0 + lr;
                if (row < r1) {
                    const bf16_t* xrow = X + (size_t)row * D; const float* shift = mod_vec(p, l, row, 3); const float* scale = mod_vec(p, l, row, 4);
                    f32x4 v[4]; float ssq = 0.f;
#pragma unroll
                    for (int j = 0; j < 4; ++j) { const u32x2 r2 = ((const u32x2*)xrow)[lane + 64 * j]; v[j].x = bf2f(r2.x & 0xffffu); v[j].y = bf2f(r2.x >> 16); v[j].z = bf2f(r2.y & 0xffffu); v[j].w = bf2f(r2.y >> 16); ssq += v[j].x * v[j].x + v[j].y * v[j].y + v[j].z * v[j].z + v[j].w * v[j].w; }
                    const float rinv = rsqrtf(wave_sum(ssq) * (1.f / D) + EPS);
#pragma unroll
                    for (int j = 0; j < 4; ++j) { const int idx = lane + 64 * j;
                        const f32x4 gg = ((const f32x4*)g2)[idx], sh = ((const f32x4*)shift)[idx], sc = ((const f32x4*)scale)[idx];
                        f32x4 y; y.x = v[j].x * rinv * gg.x * (1.f + sc.x) + sh.x; y.y = v[j].y * rinv * gg.y * (1.f + sc.y) + sh.y;
                        y.z = v[j].z * rinv * gg.z * (1.f + sc.z) + sh.z; y.w = v[j].w * rinv * gg.w * (1.f + sc.w) + sh.w;
                        u32x2 h; h.x = pk2(y.x, y.y); h.y = pk2(y.z, y.w);
                        u32x2 lw; lw.x = pk2(y.x - bf2f(h.x & 0xffffu), y.y - bf2f(h.x >> 16)); lw.y = pk2(y.z - bf2f(h.y & 0xffffu), y.w - bf2f(h.y >> 16));
                        { int t8 = __builtin_amdgcn_cvt_pk_fp8_f32(clamp8(y.x * TOK8_SCALE), clamp8(y.y * TOK8_SCALE), 0, false); t8 = __builtin_amdgcn_cvt_pk_fp8_f32(clamp8(y.z * TOK8_SCALE), clamp8(y.w * TOK8_SCALE), t8, true);
                          ((unsigned*)((unsigned char*)Tok + (size_t)row * D))[idx] = (unsigned)t8; }
                        *(u32x2*)(AH + lr * RS + idx * 4) = h; *(u32x2*)(AL + lr * RS + idx * 4) = lw; }
                } else {
#pragma unroll
                    for (int j = 0; j < 4; ++j) { const int idx = lane + 64 * j; const u32x2 z = {0u, 0u}; *(u32x2*)(AH + lr * RS + idx * 4) = z; *(u32x2*)(AL + lr * RS + idx * 4) = z; } } }
            __syncthreads();
            { f32x4 acc[4];
#pragma unroll
              for (int t = 0; t < 4; ++t) acc[t] = (f32x4){0.f, 0.f, 0.f, 0.f};
#pragma unroll
              for (int k = 0; k < 4; ++k) { const int ko = (wid * 4 + k) * 32 + fq * 8;
                  const bf16x8 ah = *(const bf16x8*)(AH + fr * RS + ko), al = *(const bf16x8*)(AL + fr * RS + ko);
#pragma unroll
                  for (int t = 0; t < 4; ++t) { acc[t] = __builtin_amdgcn_mfma_f32_16x16x32_bf16(ah, bh[t][k], acc[t], 0, 0, 0);
                      acc[t] = __builtin_amdgcn_mfma_f32_16x16x32_bf16(ah, bl[t][k], acc[t], 0, 0, 0); acc[t] = __builtin_amdgcn_mfma_f32_16x16x32_bf16(al, bh[t][k], acc[t], 0, 0, 0); } }
#pragma unroll
              for (int t = 0; t < 4; ++t)
#pragma unroll
                  for (int r = 0; r < 4; ++r) PART[(wid * 16 + fq * 4 + r) * 64 + t * 16 + fr] = acc[t][r]; }
            __syncthreads();
#pragma unroll
            for (int q = 0; q < 2; ++q) { const int o = tid + q * NTHREADS; float a = 0.f;
#pragma unroll
                for (int w8 = 0; w8 < 8; ++w8) a += PART[w8 * 1024 + o];
                LOG[o] = a; }
            __syncthreads();
#pragma unroll 1
            for (int j2 = 0; j2 < 2; ++j2) { const int lr = wid * 2 + j2, row = s0 + lr;
                if (row >= r1) continue;
                const int sr = row - base;
                const float score = sigmoid_(LOG[lr * 64 + lane]), sel = score + mybias;
                const int e = lane, g = e >> 3;
                int rg = 0;
#pragma unroll
                for (int i = 1; i < 8; ++i) { const int src = (lane & ~7) | ((lane + i) & 7); const float o = __shfl(sel, src); rg += (o > sel) || (o == sel && src < e); }
                float top2 = (rg < 2) ? sel : 0.f;
                top2 += __shfl_xor(top2, 1); top2 += __shfl_xor(top2, 2); top2 += __shfl_xor(top2, 4);
                int grank = 0;
#pragma unroll
                for (int i = 1; i < 8; ++i) { const int og = (g + i) & 7; const float o = __shfl(top2, og * 8); grank += (o > top2) || (o == top2 && og < g); }
                const bool keep = grank < 4;
                const float ms = keep ? sel : -INFINITY;
                float* mrow = msb + wid * 64;
                mrow[lane] = ms;
                __builtin_amdgcn_wave_barrier();
                int rk = 0;
#pragma unroll 4
                for (int i = 0; i < 16; ++i) { const f32x4 o = *(const f32x4*)(mrow + 4 * i);
                    rk += (o.x > ms) || (o.x == ms && 4 * i + 0 < e); rk += (o.y > ms) || (o.y == ms && 4 * i + 1 < e);
                    rk += (o.z > ms) || (o.z == ms && 4 * i + 2 < e); rk += (o.w > ms) || (o.w == ms && 4 * i + 3 < e); }
                __builtin_amdgcn_wave_barrier();
                const bool chosen = keep && rk < 8;
                const float wsum = wave_sum(chosen ? score : 0.f);
                if (chosen) { const int r = atomicAdd(&hist[e], 1); s_e[sr * 8 + rk] = e; s_r[sr * 8 + rk] = r; s_w[sr * 8 + rk] = score / wsum * 2.5f; } }
        }
        __syncthreads();
        if (tid < 64) { const int h = hist[tid]; hbase[tid] = h ? (int)atomicAdd(&cnt[tid], (unsigned)h) : 0; }
        __syncthreads();
        for (int i = tid; i < (r1 - base) * 8; i += NTHREADS) { const int e = s_e[i]; const size_t o = (size_t)base * 8 + i;
            const int pos = hbase[e] + s_r[i]; tok_e[o] = e; tok_p[o] = pos; expl[(size_t)e * R_ALL + pos] = base + (i >> 3); expw[(size_t)e * R_ALL + pos] = s_w[i]; }
        __syncthreads();
    }
}

__device__ __forceinline__ void moe_pad_starts(KP p, int l, int* ps) {
    const unsigned* cnt = (const unsigned*)(p->ws + WS_CTL) + CW_CNT + l * 64;
    const int tid = tid_();
    if (tid < 64) { const int v = (int)((cnt[tid] + 255u) >> 8) << 8; int incl = v;
#pragma unroll
        for (int d = 1; d < 64; d <<= 1) { const int o = __shfl_up(incl, d); if (tid >= d) incl += o; }
        ps[tid] = incl - v; if (tid == 63) ps[64] = incl; }
    __syncthreads();
}
__device__ __forceinline__ int moe_expert_of_row(const int* ps, int row) { int e = 0;
#pragma unroll
    for (int step = 32; step >= 1; step >>= 1) if (row >= ps[e + step]) e += step;
    return e; }

__device__ __forceinline__ void ph_slots(KP p, int l, unsigned char* lds) {
    const int T = (l == 0) ? R_ALL : R_LAT;
    int* ps = (int*)lds; moe_pad_starts(p, l, ps);
    const unsigned* cnt = (const unsigned*)(p->ws + WS_CTL) + CW_CNT + l * 64;
    const int* tok_e = (const int*)(p->ws + WS_TOKE); const int* tok_p = (const int*)(p->ws + WS_TOKP); const float* tok_w = (const float*)(p->ws + WS_TOKW);
    int* tok_s = (int*)(p->ws + WS_TOKS); int* slot_t = (int*)(p->ws + WS_SLOTT); float* slot_w = (float*)(p->ws + WS_SLOTW);
    for (int i = bid_() * NTHREADS + tid_(); i < T * 8; i += gsz_() * NTHREADS) { const int e = tok_e[i], slot = ps[e] + tok_p[i]; tok_s[i] = slot; slot_t[slot] = i >> 3; slot_w[slot] = tok_w[i]; }
    for (int i = bid_() * NTHREADS + tid_(); i < T; i += gsz_() * NTHREADS) { slot_t[MAXSLOT + i] = i; slot_w[MAXSLOT + i] = 1.f; }
    for (int i = bid_() * NTHREADS + tid_(); i < 64 * 256; i += gsz_() * NTHREADS) { const int e = i >> 8, j = i & 255; const int r = ps[e] + (int)cnt[e] + j; if (r < ps[e + 1]) { slot_t[r] = 0; slot_w[r] = 0.f; } }
    __syncthreads();
}

__device__ __forceinline__ void ph_gateup(KP p, int l, unsigned char* lds) {
    const int T = (l == 0) ? R_ALL : R_LAT;
    int* ps = (int*)lds; moe_pad_starts(p, l, ps);
    const bf16_t* Tok = (const bf16_t*)(p->ws + Z_A); const bf16_t* Wgu = (const bf16_t*)(p->ws + Z_WGU); bf16_t* H = (bf16_t*)(p->ws + Z_H);
    const int* slot_t = (const int*)(p->ws + WS_SLOTT); const float* slot_w = (const float*)(p->ws + WS_SLOTW);
    const int n128 = ps[64] / 128, nitems = (n128 + T / 128) * 2;
    for (int it = bid_(); it < nitems; it += gsz_()) { const int rt = it >> 1, pn = it & 1;
        if (rt < n128) { const int e = moe_expert_of_row(ps, rt * 128);
            auto epi = [&](int row, int col, float g, float u) { H[(size_t)row * 256 + pn * 128 + col] = (bf16_t)f2bf(silu_(g) * u * slot_w[row]); };
            gemm_simple_tile<2>(Tok, RowGather{slot_t}, Wgu + (size_t)e * 524288, 1024, rt * 128, pn * 256, 128, epi);
        } else { const int t0 = (rt - n128) * 128;
            auto epi = [&](int row, int col, float g, float u) { H[(size_t)(MAXSLOT + row) * 256 + pn * 128 + col] = (bf16_t)f2bf(silu_(g) * u); };
            gemm_simple_tile<2>(Tok, RowId{}, Wgu + (size_t)64 * 524288, 1024, t0, pn * 256, 128, epi); }
    }
}
__device__ __forceinline__ void ph_down(KP p, int l, unsigned char* lds) {
    const int T = (l == 0) ? R_ALL : R_LAT;
    int* ps = (int*)lds; moe_pad_starts(p, l, ps);
    const bf16_t* H = (const bf16_t*)(p->ws + Z_H); const bf16_t* Wd = (const bf16_t*)(p->ws + WS_WD); bf16_t* Y = (bf16_t*)(p->ws + Z_Y); float* X = (float*)(p->ws + WS_X);
    const int n128 = ps[64] / 128, nitems = (n128 + T / 128) * 8;
    for (int it = bid_(); it < nitems; it += gsz_()) { const int rt = it >> 3, nt = it & 7;
        if (rt < n128) { const int e = moe_expert_of_row(ps, rt * 128);
            auto epi = [&](int row, int col, float v, float) { Y[(size_t)row * D + nt * 128 + col] = (bf16_t)f2bf(v); };
            gemm_simple_tile<1>(H, RowId{}, Wd + (size_t)e * 262144, 256, rt * 128, nt * 128, 0, epi);
        } else { const int t0 = (rt - n128) * 128;
            auto epi = [&](int row, int col, float v, float) { const int t = row - MAXSLOT, c = nt * 128 + col; X[(size_t)t * D + c] += mod_vec(p, l, t, 5)[c] * v; };
            gemm_simple_tile<1>(H, RowId{}, Wd + (size_t)64 * 262144, 256, MAXSLOT + t0, nt * 128, 0, epi); }
    }
}
__device__ __forceinline__ void ph_combine(KP p, int l, unsigned char* lds) {
    typedef float f32x2 __attribute__((ext_vector_type(2)));
    const int T = (l == 0) ? R_ALL : R_LAT;
    const int tid = tid_(), lane = tid & 63, wid = tid >> 6;
    const unsigned char* Y8 = (const unsigned char*)(p->ws + Z_Y); bf16_t* X = (bf16_t*)(p->ws + WS_X); const int* tok_e = (const int*)(p->ws + WS_TOKE); const int* tok_p = (const int*)(p->ws + WS_TOKP);
    int* ps = (int*)lds; moe_pad_starts(p, l, ps);
    const size_t yoff = (size_t)(lane >> 4) * MAXSLOT * 256 + (lane & 15) * 16;
    for (int row = bid_() * 8 + wid; row < T; row += gsz_() * 8) {
        const float* g5 = mod_vec(p, l, row, 5) + lane * 16;
        bf16_t* xr = X + (size_t)row * D + lane * 16;
        const int myslot = ps[tok_e[row * 8 + (lane & 7)]] + tok_p[row * 8 + (lane & 7)];
        u32x4 yv[8];
#pragma unroll
        for (int k = 0; k < 8; ++k) { const int sl = __shfl(myslot, k); yv[k] = *(const u32x4*)(Y8 + yoff + (size_t)sl * 256); }
        f32x4 xv[4], gv[4];
#pragma unroll
        for (int q = 0; q < 4; ++q) gv[q] = *(const f32x4*)(g5 + 4 * q);
        unpack8(*(const u32x4*)xr, xv[0], xv[1]); unpack8(*(const u32x4*)(xr + 8), xv[2], xv[3]);
        float a[16];
#pragma unroll
        for (int q = 0; q < 16; ++q) a[q] = 0.f;
#pragma unroll
        for (int k = 0; k < 8; ++k) { const unsigned w[4] = {yv[k].x, yv[k].y, yv[k].z, yv[k].w};
#pragma unroll
            for (int q = 0; q < 4; ++q) { const f32x2 lo = __builtin_amdgcn_cvt_pk_f32_fp8((int)w[q], false), hi = __builtin_amdgcn_cvt_pk_f32_fp8((int)w[q], true);
                a[4 * q] += lo.x; a[4 * q + 1] += lo.y; a[4 * q + 2] += hi.x; a[4 * q + 3] += hi.y; } }
#pragma unroll
        for (int q = 0; q < 4; ++q) { f32x4 av; av.x = a[4 * q]; av.y = a[4 * q + 1]; av.z = a[4 * q + 2]; av.w = a[4 * q + 3]; xv[q] = xv[q] + gv[q] * (av * (1.f / Y8_SCALE)); }
        if (l == DEPTH - 1) { float* dst = p->out + (size_t)row * D + lane * 16;
#pragma unroll
            for (int q = 0; q < 4; ++q) *(f32x4*)(dst + 4 * q) = xv[q]; }
        else { *(u32x4*)xr = (u32x4){pk2(xv[0].x, xv[0].y), pk2(xv[0].z, xv[0].w), pk2(xv[1].x, xv[1].y), pk2(xv[1].z, xv[1].w)};
               *(u32x4*)(xr + 8) = (u32x4){pk2(xv[2].x, xv[2].y), pk2(xv[2].z, xv[2].w), pk2(xv[3].x, xv[3].y), pk2(xv[3].z, xv[3].w)}; }
    }
}
struct MoeSched {
    int ntr, nrt, npn, G, c; const LAS int* tile_e;
    __device__ __forceinline__ bool map(int i, int& rt, int& pp) const {
        if (G == 256) { const int x = c & 7, j = c >> 3, tb = 32 / npn; rt = (i * 8 + x) * tb + j / npn; pp = j % npn; return rt < nrt; }
        const int L = i * G + c; if (L >= nrt * npn) return false;
        rt = L / npn; pp = L % npn; return true; }
    __device__ __forceinline__ bool next(int i, pg8::Unit& u) const {
        int rt, pp; if (!map(i, rt, pp)) return false;
        const bool routed = rt < ntr;
        const int e = routed ? __builtin_amdgcn_readfirstlane(tile_e[rt]) : 64;
        u.pm = routed ? rt : MAXSLOT / 256 + (rt - ntr); u.pn = e * npn + pp; u.ord = i; return true;
    }
};
constexpr int MOE_UNITS = 6;
constexpr int LDS_RTAB = 131072, LDS_WTAB = LDS_RTAB + MOE_UNITS * 1024, LDS_TILE_E = LDS_WTAB + MOE_UNITS * 1024, LDS_PS = LDS_TILE_E + 2400;
static_assert(LDS_PS + 129 * 4 <= LDS_BYTES - 16, "MoE tables fit above the staging buffers");
__device__ __forceinline__ MoeSched moe_setup(KP p, int l, unsigned char* lds, int npn, bool gather) {
    const int T = (l == 0) ? R_ALL : R_LAT;
    int* ps = (int*)(lds + LDS_PS); int* cl = ps + 65;
    const unsigned* cnt = (const unsigned*)(p->ws + WS_CTL) + CW_CNT + l * 64;
    const int tid = tid_();
    if (tid < 64) cl[tid] = (int)cnt[tid];
    moe_pad_starts(p, l, ps);
    LAS int* tile_e = (LAS int*)((LAS unsigned char*)lds + LDS_TILE_E); LAS int* rtab = (LAS int*)((LAS unsigned char*)lds + LDS_RTAB); LAS float* wtab = (LAS float*)((LAS unsigned char*)lds + LDS_WTAB);
    const int ntr = ps[64] / 256;
    for (int rt = tid; rt < ntr; rt += NTHREADS) tile_e[rt] = moe_expert_of_row(ps, rt * 256);
    __syncthreads();
    MoeSched S{ntr, ntr + T / 256, npn, gsz_(), bid_(), tile_e};
    if (gather) { const int* expl = (const int*)(p->ws + WS_EXPL); const float* expw = (const float*)(p->ws + WS_EXPW);
        int tok[3]; float w[3];
#pragma unroll
        for (int q = 0; q < 3; ++q) { const int idx = tid + q * NTHREADS, i = idx >> 8, r = idx & 255; tok[q] = 0; w[q] = 0.f;
            int rt, pp_;
            if (S.map(i, rt, pp_)) {
                if (rt < S.ntr) { const int e = tile_e[rt], pos = rt * 256 + r - ps[e];
                    if (pos < cl[e]) { tok[q] = expl[(size_t)e * R_ALL + pos]; w[q] = expw[(size_t)e * R_ALL + pos]; } }
                else { tok[q] = (rt - S.ntr) * 256 + r; w[q] = 1.f; } } }
#pragma unroll
        for (int q = 0; q < 3; ++q) { const int idx = tid + q * NTHREADS; rtab[idx] = tok[q]; wtab[idx] = w[q]; } }
    __syncthreads();
    return S;
}
__device__ __forceinline__ void ph_gateup_f(KP p, int l, unsigned char* lds) {
    const MoeSched S = moe_setup(p, l, lds, 2, true);
    pg8::Gemm g{(const bf16_t*)(p->ws + Z_A), (const bf16_t*)(p->ws + wgu_off(l)), 0, 0, 1024};
    pg8::EpiGU8 E{(unsigned char*)(p->ws + Z_H), (const LAS float*)((LAS unsigned char*)lds + LDS_WTAB)};
    pg8::gemm_phase<pg8::EpiGU8, MoeSched, true, true>((LAS unsigned char*)lds, g, S, E, (const LAS int*)((LAS unsigned char*)lds + LDS_RTAB));
}
__device__ __forceinline__ void ph_down_f(KP p, int l, unsigned char* lds) {
    const MoeSched S = moe_setup(p, l, lds, 4, false);
    pg8::Gemm g{(const bf16_t*)(p->ws + Z_H), (const bf16_t*)(p->ws + wd_off(l)), 0, 0, 256};
    bf16_t* X = (bf16_t*)(p->ws + WS_X);
    pg8::EpiDown E{(bf16_t*)(p->ws + Z_Y), X, (const float*)(p->ws + WS_MOD) + (size_t)l * 3 * 6144 + 5 * 1024};
    pg8::gemm_phase<pg8::EpiDown, MoeSched, false, true>((LAS unsigned char*)lds, g, S, E, nullptr);
}

#ifndef FAST_ATTN
#define FAST_ATTN 1
#endif
#ifndef FAST_GEMM
#define FAST_GEMM 15
#endif
constexpr int PH_PER_LAYER = 10, N_PHASES = 1 + DEPTH * PH_PER_LAYER;
__global__ void __launch_bounds__(NTHREADS, 2) mega(Params parg) {
    extern __shared__ __attribute__((aligned(16))) unsigned char lds[];
    const int lo = parg.ph_lo, hi = parg.ph_hi;
    volatile LAS unsigned* xbw = (volatile LAS unsigned*)(lds + LDS_BYTES - 16);
    if (threadIdx.x == 0) { xbw[0] = 0u; xbw[1] = 0u; xbw[2] = 0u; xbw[3] = 0u; }
    if ((threadIdx.x & 63) == 0) *(volatile LAS int*)((LAS unsigned char*)lds + LDS_WVTAB_OFF + 4 * hwkey_()) = (int)(threadIdx.x >> 6);
    __syncthreads();
    XcdBarrier bar; bar.bar = (unsigned*)(parg.ws + WS_CTL) + CW_BAR; bar.x = 0; bar.st = xbw;
    if (hi - lo > 1) bar = xcd_barrier_post((unsigned*)(parg.ws + WS_CTL) + CW_BAR, xbw);
#ifdef PHMASK
#define IN(k) ((((PHMASK) >> ((k) == 0 ? 0 : ((k) - 1) % PH_PER_LAYER + 1)) & 1) && lo <= (k) && (k) < hi)
#else
#define IN(k) (lo <= (k) && (k) < hi)
#endif
#define SEAM(k) do { if (IN(k) && IN((k) + 1)) xcd_barrier(bar); } while (0)
    if (IN(0)) { ph_pro(kparams(), lds); } SEAM(0);
#pragma unroll
    for (int l = 0; l < DEPTH; ++l) {
        const int b0 = 1 + l * PH_PER_LAYER;
        if (IN(b0 + 0)) { ph_norm1(kparams(), l, lds); } SEAM(b0 + 0);
        if (IN(b0 + 1)) { ph_inproj_f(kparams(), l, lds); } SEAM(b0 + 1);
        if (IN(b0 + 2)) { ph_prep(kparams(), l, lds); } SEAM(b0 + 2);
        if (IN(b0 + 3)) { ph_attn_f(kparams(), l, lds); } SEAM(b0 + 3);
        if (IN(b0 + 4)) { ph_hgrn3(kparams(), l, lds); } SEAM(b0 + 4);
        if (IN(b0 + 5)) { ph_outproj_f(kparams(), l, lds); } SEAM(b0 + 5);
        if (IN(b0 + 6)) { ph_norm2(kparams(), l, lds); } SEAM(b0 + 6);
        if (IN(b0 + 7)) { ph_gateup_f(kparams(), l, lds); } SEAM(b0 + 7);
        if (IN(b0 + 8)) { ph_down_f(kparams(), l, lds); } SEAM(b0 + 8);
        if (IN(b0 + 9)) { ph_combine(kparams(), l, lds); } SEAM(b0 + 9);
    }
#undef IN
#undef SEAM
}

#ifndef MK_ONE_LAUNCH
#define MK_ONE_LAUNCH 1
#endif
extern "C" void kernel_launch(void* const* d_in, const int* in_sizes, int n_in, void* d_out, int out_size, void* d_ws, size_t ws_size, hipStream_t stream) {
    static int grid = 0;
    if (grid == 0) {
        if (n_in != 31 || ws_size < WS_END2) { fprintf(stderr, "kernel_launch: unexpected n_in %d or ws_size %zu (< %zu)\n", n_in, ws_size, (size_t)WS_END2); grid = -1; return; }
        int dev = 0, cus = 0, per_cu = 0;
        if (hipGetDevice(&dev) != hipSuccess || hipDeviceGetAttribute(&cus, hipDeviceAttributeMultiprocessorCount, dev) != hipSuccess) { grid = -1; return; }
        if (hipFuncSetAttribute((const void*)mega, hipFuncAttributeMaxDynamicSharedMemorySize, LDS_BYTES) != hipSuccess) { fprintf(stderr, "kernel_launch: hipFuncSetAttribute failed\n"); grid = -1; return; }
        if (hipOccupancyMaxActiveBlocksPerMultiprocessor(&per_cu, (const void*)mega, NTHREADS, LDS_BYTES) != hipSuccess || per_cu < 1) fprintf(stderr, "kernel_launch: occupancy query says %d\n", per_cu);
        (void)hipGetLastError();
        grid = cus;
    }
    if (grid < 0) return;
    (void)hipMemsetAsync((char*)d_ws + WS_CTL, 0, CTL_ZERO_BYTES, stream);
    Params p{};
    for (int i = 0; i < 31; ++i) p.in[i] = (const float*)d_in[i];
    p.out = (float*)d_out; p.ws = (unsigned char*)d_ws;
#if MK_ONE_LAUNCH
    p.ph_lo = 0; p.ph_hi = N_PHASES;
    hipLaunchKernelGGL(mega, dim3(grid), dim3(NTHREADS), LDS_BYTES, stream, p);
#else
    for (int k = 0; k < N_PHASES; ++k) { p.ph_lo = k; p.ph_hi = k + 1; hipLaunchKernelGGL(mega, dim3(grid), dim3(NTHREADS), LDS_BYTES, stream, p); }
#endif
}
```

```cpp
#include <hip/hip_runtime.h>
#include <hip/hip_bf16.h>
#include <cmath>
#include <cstdint>
#include <cstdio>

#define LAS __attribute__((address_space(3)))

typedef unsigned short bf16_t;
typedef short bf16x8 __attribute__((ext_vector_type(8)));
typedef float f32x4 __attribute__((ext_vector_type(4)));
typedef unsigned u32x4 __attribute__((ext_vector_type(4)));
typedef unsigned u32x2 __attribute__((ext_vector_type(2)));

constexpr int D = 1024, NB = 2, NSEQ = 8192, NCTX = 256, DEPTH = 2;
constexpr int R_LAT = NB * NSEQ, R_CTX = NB * NCTX, R_ALL = R_LAT + R_CTX;
constexpr int DIN = 2816;
constexpr int NKEY = NSEQ + NCTX;
constexpr int NE = 64, TOPK = 8;
constexpr int MAXSLOT = 151552;
constexpr int HROWS = MAXSLOT + R_ALL;
constexpr int NCHUNK = 132;
constexpr float EPS = 1e-6f;
constexpr float TOK8_SCALE = 8.f, WGU8_SCALE = 256.f, H8_SCALE = 16.f, WD8_SCALE = 128.f;
constexpr float GU_DESCALE = 1.f / (TOK8_SCALE * WGU8_SCALE), DN_DESCALE = 1.f / (H8_SCALE * WD8_SCALE);
constexpr float Y8_SCALE = 32.f;
constexpr float QSCALE = 0.125f * 1.4426950408889634f;
constexpr float LOG2E = 1.4426950408889634f;

#ifndef FAST_HGRN
#define FAST_HGRN 1
#endif
constexpr int C_GQ = 0, C_GK = 256, C_GV = 384, C_WQ = 512, C_WK = 768, C_WV = 896, C_CVV = 1024, C_CVG = 1280, C_RQ = 1536, C_RI = 1792, C_RFF = 2048, C_RFB = 2304, C_RG = 2560;

constexpr size_t MiB = (size_t)1 << 20;
constexpr size_t WS_CTL = 0, CTL_ZERO_BYTES = 64 * 1024;
constexpr size_t WS_MOD = 1 * MiB;
constexpr size_t WS_LB = WS_MOD + 256 * 1024;
constexpr size_t WS_ROPE = WS_MOD + 512 * 1024;
constexpr size_t WS_TOKE = 2 * MiB, WS_TOKP = 3 * MiB, WS_TOKW = 4 * MiB, WS_TOKS = 5 * MiB;
constexpr size_t WS_SLOTT = 6 * MiB, WS_SLOTW = 7 * MiB;
constexpr size_t WS_RFRAG = 4 * MiB;
constexpr size_t WS_X = 8 * MiB;
constexpr size_t WS_WD = 74 * MiB;
constexpr size_t WS_Z = 107 * MiB;
constexpr size_t Z_A = WS_Z + 0 * MiB;
constexpr size_t Z_WGU = WS_Z + 33 * MiB;
constexpr size_t Z_WIN = WS_Z + 98 * MiB;
constexpr size_t Z_WOUT = WS_Z + 104 * MiB;
constexpr size_t Z_WPW = WS_Z + 106 * MiB;
__host__ __device__ constexpr size_t wgu_off(int l) { return WS_Z + 33 * MiB + (size_t)l * 34078720; }
__host__ __device__ constexpr size_t wd_off(int l) { return 74 * MiB + (size_t)l * 17039360; }
__host__ __device__ constexpr size_t win_off(int l) { return l == 0 ? WS_Z + 98 * MiB : WS_Z + (302 + 42) * MiB; }
__host__ __device__ constexpr size_t wout_off(int l) { return l == 0 ? WS_Z + 104 * MiB : WS_Z + (302 + 48) * MiB; }
__host__ __device__ constexpr size_t wpw_off(int l) { return l == 0 ? WS_Z + 106 * MiB : WS_Z + (302 + 51) * MiB; }
constexpr size_t Z_P = WS_Z + 107 * MiB;
constexpr size_t Z_YCAT = WS_Z + 198 * MiB;
constexpr size_t Z_QG = WS_Z + 231 * MiB, Z_QW = WS_Z + 239 * MiB;
constexpr size_t Z_KG = WS_Z + 247 * MiB, Z_VG = WS_Z + 252 * MiB, Z_KW = WS_Z + 257 * MiB, Z_VW = WS_Z + 262 * MiB;
constexpr size_t Z_QGC = WS_Z + 267 * MiB, Z_QWC = Z_QGC + 512 * 1024;
constexpr size_t Z_U = WS_Z + 268 * MiB;
constexpr size_t Z_G = WS_Z + 301 * MiB;
constexpr size_t Z_Y = WS_Z + 107 * MiB;
constexpr size_t Z_H = WS_Z + 302 * MiB;
constexpr size_t WS_END = WS_Z + 385 * MiB;
constexpr size_t WS_EXPL = WS_END, WS_EXPW = WS_END + 5 * MiB, WS_END2 = WS_END + 10 * MiB;
static_assert(Z_H + (size_t)HROWS * 512 <= WS_END, "H fits");
static_assert(Z_Y + (size_t)MAXSLOT * 1024 <= Z_U, "Y8 below the HGRN state buffers");
static_assert(Z_P + (size_t)R_ALL * DIN * 2 <= Z_YCAT, "P fits");

constexpr int CW_BAR = 0;
constexpr int CW_CNT = 4096;

constexpr int LDS_BYTES = 147456;
constexpr int NTHREADS = 512;

struct Params {
    const float* in[31];
    float* out;
    unsigned char* ws;
    int ph_lo, ph_hi;
};

typedef const __attribute__((address_space(4))) Params* KP;
__device__ __forceinline__ KP kparams() { KP k = (KP)__builtin_amdgcn_kernarg_segment_ptr(); asm volatile("" : "+s"(k)); return k; }

constexpr int LDS_WVTAB_OFF = 147456 - 16 - 256;
__device__ __forceinline__ int hwkey_() { return (int)__builtin_amdgcn_s_getreg((5 << 11) | 4) & 63; }
__device__ __forceinline__ int tid_() { extern __shared__ __attribute__((aligned(16))) unsigned char lds_all[];
    const int w = __builtin_amdgcn_readfirstlane(*(const LAS int*)((LAS unsigned char*)lds_all + LDS_WVTAB_OFF + 4 * hwkey_()));
    unsigned z; asm volatile("v_mov_b32 %0, 0" : "=v"(z));
    int t = (w << 6) | (int)__builtin_amdgcn_mbcnt_hi(~0u, __builtin_amdgcn_mbcnt_lo(~0u, z)); asm volatile("" : "+v"(t)); return t; }
__device__ __forceinline__ int bid_() { int b = blockIdx.x; asm volatile("" : "+s"(b)); return b; }
__device__ __forceinline__ int gsz_() { int g = gridDim.x; asm volatile("" : "+s"(g)); return g; }

__device__ __forceinline__ unsigned f2bf(float f) { unsigned u = __float_as_uint(f); return (u + 0x7fffu + ((u >> 16) & 1u)) >> 16; }
__device__ __forceinline__ float bf2f(unsigned h) { return __uint_as_float(h << 16); }
__device__ __forceinline__ unsigned pk2(float lo, float hi) { unsigned r; asm("v_cvt_pk_bf16_f32 %0, %1, %2" : "=v"(r) : "v"(lo), "v"(hi)); return r; }
__device__ __forceinline__ u32x4 pack8(const float (&x)[8]) { u32x4 o; o.x = pk2(x[0], x[1]); o.y = pk2(x[2], x[3]); o.z = pk2(x[4], x[5]); o.w = pk2(x[6], x[7]); return o; }
__device__ __forceinline__ void unpack8(const u32x4 r, f32x4& lo, f32x4& hi) { lo.x = bf2f(r.x & 0xffffu); lo.y = bf2f(r.x >> 16); lo.z = bf2f(r.y & 0xffffu); lo.w = bf2f(r.y >> 16); hi.x = bf2f(r.z & 0xffffu); hi.y = bf2f(r.z >> 16); hi.z = bf2f(r.w & 0xffffu); hi.w = bf2f(r.w >> 16); }
template <int CTRL> __device__ __forceinline__ float dpp_mov(float v) { return __builtin_bit_cast(float, __builtin_amdgcn_update_dpp(0, __builtin_bit_cast(int, v), CTRL, 0xF, 0xF, true)); }
__device__ __forceinline__ float wave_sum(float v) {
    v += dpp_mov<0xB1>(v); v += dpp_mov<0x4E>(v); v += dpp_mov<0x141>(v); v += dpp_mov<0x140>(v);
    { const auto rr = __builtin_amdgcn_permlane16_swap(__float_as_uint(v), __float_as_uint(v), false, false); v = __uint_as_float(rr[0]) + __uint_as_float(rr[1]); }
    { const auto rr = __builtin_amdgcn_permlane32_swap(__float_as_uint(v), __float_as_uint(v), false, false); v = __uint_as_float(rr[0]) + __uint_as_float(rr[1]); }
    return v;
}
__device__ __forceinline__ float clamp8(float v) { return fminf(fmaxf(v, -440.f), 440.f); }
__device__ __forceinline__ float sigmoid_(float x) { return __builtin_amdgcn_rcpf(1.f + __expf(-x)); }
__device__ __forceinline__ float silu_(float x) { return x * sigmoid_(x); }

__device__ __forceinline__ const float* xrow_src(KP p, int l, int row) {
    if (l == 0) return (row < R_LAT) ? p->in[0] + (size_t)row * D : p->in[2] + (size_t)(row - R_LAT) * D;
    return (const float*)(p->ws + WS_X) + (size_t)row * D;
}
__device__ __forceinline__ const float* mod_vec(KP p, int l, int row, int i) {
    const int r = (row < R_LAT) ? (row >> 13) : 2;
    return (const float*)(p->ws + WS_MOD) + ((size_t)l * 3 + r) * 6144 + i * 1024;
}

#define XB_TMO      128
#define XB_XCNT(j)  (256  + 64 * (j))
#define XB_XSUB(j)  (1280 + 64 * (j))
#define XB_XGEN(j)  (2304 + 64 * (j))
#define XB_TOP      3328
#define XB_TOPGEN   3392
#define XCD_BAR_WORDS 3456
#define XB_SPIN_CAP (1u << 18)
__device__ __forceinline__ unsigned xb_ld(unsigned* p)              { return __hip_atomic_load(p, __ATOMIC_RELAXED, __HIP_MEMORY_SCOPE_AGENT); }
__device__ __forceinline__ unsigned xb_add(unsigned* p, unsigned v) { return __hip_atomic_fetch_add(p, v, __ATOMIC_RELAXED, __HIP_MEMORY_SCOPE_AGENT); }
__device__ __forceinline__ unsigned xb_xcc_id() { return (unsigned)__builtin_amdgcn_s_getreg((3 << 11) | 20) & 0xFu; }
#define XB_SPIN(cond, bar) do { unsigned _sp = 0; while (cond) { __builtin_amdgcn_s_sleep(1); \
    if ((++_sp & 255u) == 0u) { if (xb_ld(&(bar)[XB_TMO])) break; if (_sp > XB_SPIN_CAP) { atomicAdd(&(bar)[XB_TMO], 1u); break; } } } } while (0)
struct XcdBarrier { unsigned* bar; unsigned x; volatile LAS unsigned* st; };
__device__ __forceinline__ XcdBarrier xcd_barrier_post(unsigned* bar, volatile LAS unsigned* st) {
    XcdBarrier b; b.bar = bar; b.x = xb_xcc_id(); b.st = st;
    if (tid_() == 0) (void)xb_add(&bar[XB_XCNT(b.x)], 1u);
    return b;
}
__device__ __forceinline__ void xcd_barrier_complete(unsigned* bar, unsigned x, unsigned& nloc, unsigned& nx) {
    const unsigned G = gridDim.x * gridDim.y * gridDim.z;
    unsigned sum, cnt, mine, sp = 0u;
    for (;;) {
        sum = 0u; cnt = 0u; mine = 0u;
#pragma unroll
        for (unsigned j = 0; j < 16; ++j) { const unsigned c = xb_ld(&bar[XB_XCNT(j)]); sum += c; cnt += (c > 0u) ? 1u : 0u; mine = (j == x) ? c : mine; }
        if (sum == G) break;
        __builtin_amdgcn_s_sleep(1);
        if ((++sp & 255u) == 0u) { if (xb_ld(&bar[XB_TMO])) break; if (sp > XB_SPIN_CAP) { atomicAdd(&bar[XB_TMO], 1u); break; } }
    }
    nloc = mine > 0u ? mine : 1u; nx = cnt > 0u ? cnt : 1u;
}
__device__ __forceinline__ void xcd_barrier(const XcdBarrier& b) {
    asm volatile("s_waitcnt vmcnt(0)" ::: "memory");
    __syncthreads();
    if (tid_() == 0) {
        unsigned* bar = b.bar;
        __builtin_amdgcn_s_waitcnt(0);
        unsigned nloc = b.st[0], nx = b.st[1];
        if (nloc == 0u) { xcd_barrier_complete(bar, b.x, nloc, nx); b.st[0] = nloc; b.st[1] = nx; }
        const unsigned old = xb_add(&bar[XB_XSUB(b.x)], 1u);
        const unsigned gen = old / nloc;
        if (old + 1u == (gen + 1u) * nloc) {
            __builtin_amdgcn_fence(__ATOMIC_RELEASE, "agent");
            asm volatile("s_waitcnt vmcnt(0)" ::: "memory");
            const unsigned og = xb_add(&bar[XB_TOP], 1u);
            const unsigned tg = og / nx;
            if (og + 1u == (tg + 1u) * nx) xb_add(&bar[XB_TOPGEN], 1u);
            else XB_SPIN(xb_ld(&bar[XB_TOPGEN]) == tg, bar);
            __builtin_amdgcn_fence(__ATOMIC_ACQUIRE, "agent");
            xb_add(&bar[XB_XGEN(b.x)], 1u);
            asm volatile("s_waitcnt vmcnt(0)" ::: "memory");
        } else {
            XB_SPIN(xb_ld(&bar[XB_XGEN(b.x)]) == gen, bar);
            __builtin_amdgcn_fence(__ATOMIC_ACQUIRE, "agent");
            asm volatile("s_waitcnt vmcnt(0)" ::: "memory");
        }
    }
    __syncthreads();
}

__device__ __forceinline__ void ph_pro(KP p, unsigned char* lds) {
    float* sc = (float*)lds;
    float* red = sc + 3 * 1024;
    const int tid = tid_(), lane = tid & 63, wid = tid >> 6;
    for (int i = tid; i < 3 * 1024; i += NTHREADS) { const int r = i >> 10, k = i & 1023; const float v = (r < 2) ? p->in[1][r * 1024 + k] : p->in[3][k]; sc[i] = silu_(v); }
    __syncthreads();
    float* mod = (float*)(p->ws + WS_MOD);
    for (int item = bid_(); item < DEPTH * 96 + DEPTH * 8; item += gsz_()) {
        if (item >= DEPTH * 96) {
            const int fi = item - DEPTH * 96, lf = fi >> 3, w = fi & 7, fr = lane & 15, fq = lane >> 4; const float* rw = p->in[23] + (size_t)lf * 1024 * 64;
            u32x4* RF = (u32x4*)(p->ws + WS_RFRAG);
#pragma unroll
            for (int s = 0; s < 2; ++s) { const int tk = wid * 2 + s, t = tk >> 2, k = tk & 3; float v[8], lo[8];
#pragma unroll
                for (int j = 0; j < 8; ++j) v[j] = rw[(size_t)((w * 4 + k) * 32 + fq * 8 + j) * 64 + t * 16 + fr];
                const u32x4 hh = pack8(v);
                const float hf[8] = {bf2f(hh.x & 0xffffu), bf2f(hh.x >> 16), bf2f(hh.y & 0xffffu), bf2f(hh.y >> 16), bf2f(hh.z & 0xffffu), bf2f(hh.z >> 16), bf2f(hh.w & 0xffffu), bf2f(hh.w >> 16)};
#pragma unroll
                for (int j = 0; j < 8; ++j) lo[j] = v[j] - hf[j];
                const size_t o = ((size_t)(((lf * 8 + w) * 4 + t) * 4 + k) * 64 + lane) * 2;
                RF[o] = hh; RF[o + 1] = pack8(lo); }
            continue; }
        const int l = item / 96, j0 = (item % 96) * 64;
        const float* w = p->in[4] + (size_t)l * 1024 * 6144;
        float a0 = 0.f, a1 = 0.f, a2 = 0.f;
        const int k0 = wid * 128;
#pragma unroll 1
        for (int k = k0; k < k0 + 128; k += 32) { float wv[32];
#pragma unroll
            for (int u = 0; u < 32; ++u) wv[u] = w[(size_t)(k + u) * 6144 + j0 + lane];
#pragma unroll
            for (int u = 0; u < 32; ++u) { a0 += sc[k + u] * wv[u]; a1 += sc[1024 + k + u] * wv[u]; a2 += sc[2048 + k + u] * wv[u]; } }
        red[(wid * 3 + 0) * 64 + lane] = a0; red[(wid * 3 + 1) * 64 + lane] = a1; red[(wid * 3 + 2) * 64 + lane] = a2;
        __syncthreads();
        if (tid < 192) { const int r = tid >> 6; float s = 0.f;
            for (int w8 = 0; w8 < 8; ++w8) s += red[(w8 * 3 + r) * 64 + lane];
            mod[((size_t)l * 3 + r) * 6144 + j0 + lane] = s + p->in[5][l * 6144 + j0 + lane]; }
        __syncthreads();
    }
    if (bid_() == 0) {
        float* rt = (float*)(p->ws + WS_ROPE);
        for (int i = tid; i < 128 * 16; i += NTHREADS) { const int pos = i >> 4, f = i & 15; const float inv = powf(10000.f, -(float)f * (1.f / 16.f)); float sn, cs; sincosf((float)pos * inv, &sn, &cs);
            rt[pos * 32 + f] = cs; rt[pos * 32 + 16 + f] = sn; }
    }
    if (bid_() == gsz_() - 1) {
        float* lb = (float*)(p->ws + WS_LB);
        for (int i = tid; i < 2 * 2 * 256; i += NTHREADS) { const int l = i >> 9, dir = (i >> 8) & 1, ch = i & 255;
            const float* lg = p->in[21];
            const float l0 = lg[(dir * 2 + 0) * 256 + ch], l1 = lg[(dir * 2 + 1) * 256 + ch]; const float m = fmaxf(l0, l1);
            const float e0 = expf(l0 - m), e1 = expf(l1 - m);
            lb[i] = (l == 0) ? 0.f : e1 / (e0 + e1); }
    }
}

constexpr int CVT_E1 = 1050, CVT_E2 = 2850;
struct CvtTile { const float* src; bf16_t* dst; int K, N, k0, n0, blk, bstride, boff; float f8scale; int perm; };
__device__ __forceinline__ int cvt_total() { return 16 * 44 + 16 * 16 + 4 * 4 + 2 * (64 * 64) + 2 * 64 + 64 * 64 + 64; }
__device__ __forceinline__ CvtTile cvt_decode(KP p, int l, int g) {
    bf16_t* Wgu = (bf16_t*)(p->ws + wgu_off(l)); bf16_t* Wd = (bf16_t*)(p->ws + wd_off(l));
    CvtTile t; int per, tn, r;
    if (g < 704) { r = g; t = {p->in[8] + (size_t)l * 1024 * DIN, (bf16_t*)(p->ws + win_off(l)), 1024, DIN, 0, 0, DIN, 0, 0, 0.f}; tn = 44; per = 704; }
    else if ((g -= 704) < 256) { r = g; t = {p->in[9] + (size_t)l * 1024 * 1024, (bf16_t*)(p->ws + wout_off(l)), 1024, 1024, 0, 0, 1024, 0, 0, 0.f}; tn = 16; per = 256; }
    else if ((g -= 256) < 16) { r = g; t = {p->in[19] + (size_t)l * 65536, (bf16_t*)(p->ws + wpw_off(l)), 256, 256, 0, 0, 256, 0, 0, 0.f}; tn = 4; per = 16; }
    else if ((g -= 16) < 4096) { const int m = g >> 6; r = g & 63; t = {p->in[25] + ((size_t)l * 64 + m) * 262144, (bf16_t*)((unsigned char*)Wgu + (size_t)m * 524288), 1024, 256, 0, 0, 128, 256, 0, WGU8_SCALE}; tn = 4; per = 64; }
    else if ((g -= 4096) < 4096) { const int m = g >> 6; r = g & 63; t = {p->in[26] + ((size_t)l * 64 + m) * 262144, (bf16_t*)((unsigned char*)Wgu + (size_t)m * 524288), 1024, 256, 0, 0, 128, 256, 128, WGU8_SCALE}; tn = 4; per = 64; }
    else if ((g -= 4096) < 64) { r = g; t = {p->in[28] + (size_t)l * 262144, (bf16_t*)((unsigned char*)Wgu + (size_t)64 * 524288), 1024, 256, 0, 0, 128, 256, 0, WGU8_SCALE}; tn = 4; per = 64; }
    else if ((g -= 64) < 64) { r = g; t = {p->in[29] + (size_t)l * 262144, (bf16_t*)((unsigned char*)Wgu + (size_t)64 * 524288), 1024, 256, 0, 0, 128, 256, 128, WGU8_SCALE}; tn = 4; per = 64; }
    else if ((g -= 64) < 4096) { const int m = g >> 6; r = g & 63; t = {p->in[27] + ((size_t)l * 64 + m) * 262144, (bf16_t*)((unsigned char*)Wd + (size_t)m * 262144), 256, 1024, 0, 0, 1024, 0, 0, WD8_SCALE, 1}; tn = 16; per = 64; }
    else { g -= 4096; r = g; t = {p->in[30] + (size_t)l * 262144, (bf16_t*)((unsigned char*)Wd + (size_t)64 * 262144), 256, 1024, 0, 0, 1024, 0, 0, WD8_SCALE, 1}; tn = 16; per = 64; }
    (void)per; t.k0 = (r / tn) * 64; t.n0 = (r % tn) * 64; return t;
}
__device__ __forceinline__ void ph_cvt(KP p, int l, unsigned char* lds, int first = 0, int nwg = 0, int t0 = 0, int t1 = 1 << 30) {
    float* tb = (float*)lds;
    const int tid = tid_(), G = nwg ? nwg : gsz_(), total = t1 < cvt_total() ? t1 : cvt_total();
    const int r0 = tid >> 4, c0 = (tid & 15) * 4, nn = tid >> 3, kc = (tid & 7) * 8;
    int g = bid_() - first, buf = 0;
    if (g < 0) return;
    g += t0;
    if (g >= total) return;
    CvtTile T = cvt_decode(p, l, g);
    f32x4 v0 = *(const f32x4*)(T.src + (size_t)(T.k0 + r0) * T.N + T.n0 + c0), v1 = *(const f32x4*)(T.src + (size_t)(T.k0 + r0 + 32) * T.N + T.n0 + c0);
    for (;;) {
        float* t = tb + buf * (64 * 65);
        t[r0 * 65 + c0] = v0.x; t[r0 * 65 + c0 + 1] = v0.y; t[r0 * 65 + c0 + 2] = v0.z; t[r0 * 65 + c0 + 3] = v0.w;
        t[(r0 + 32) * 65 + c0] = v1.x; t[(r0 + 32) * 65 + c0 + 1] = v1.y; t[(r0 + 32) * 65 + c0 + 2] = v1.z; t[(r0 + 32) * 65 + c0 + 3] = v1.w;
        const CvtTile C = T; const int gn = g + G; const bool more = gn < total;
        if (more) { T = cvt_decode(p, l, gn);
            v0 = *(const f32x4*)(T.src + (size_t)(T.k0 + r0) * T.N + T.n0 + c0); v1 = *(const f32x4*)(T.src + (size_t)(T.k0 + r0 + 32) * T.N + T.n0 + c0); }
        __syncthreads();
        { const int n = C.n0 + nn; int drow = (n / C.blk) * C.bstride + C.boff + (n % C.blk);
          if (C.perm) drow = (n & ~255) + ((n >> 3) & 1) * 128 + ((n >> 6) & 3) * 32 + ((n >> 4) & 3) * 8 + (n & 7);
          if (C.f8scale != 0.f) { const float sc = C.f8scale;
              int w0 = __builtin_amdgcn_cvt_pk_fp8_f32(clamp8(t[(kc + 0) * 65 + nn] * sc), clamp8(t[(kc + 1) * 65 + nn] * sc), 0, false); w0 = __builtin_amdgcn_cvt_pk_fp8_f32(clamp8(t[(kc + 2) * 65 + nn] * sc), clamp8(t[(kc + 3) * 65 + nn] * sc), w0, true);
              int w1 = __builtin_amdgcn_cvt_pk_fp8_f32(clamp8(t[(kc + 4) * 65 + nn] * sc), clamp8(t[(kc + 5) * 65 + nn] * sc), 0, false); w1 = __builtin_amdgcn_cvt_pk_fp8_f32(clamp8(t[(kc + 6) * 65 + nn] * sc), clamp8(t[(kc + 7) * 65 + nn] * sc), w1, true);
              u32x2 o8; o8.x = (unsigned)w0; o8.y = (unsigned)w1;
              *(u32x2*)((unsigned char*)C.dst + (size_t)drow * C.K + C.k0 + kc) = o8;
          } else {
          u32x4 o; o.x = pk2(t[(kc + 0) * 65 + nn], t[(kc + 1) * 65 + nn]); o.y = pk2(t[(kc + 2) * 65 + nn], t[(kc + 3) * 65 + nn]);
          o.z = pk2(t[(kc + 4) * 65 + nn], t[(kc + 5) * 65 + nn]); o.w = pk2(t[(kc + 6) * 65 + nn], t[(kc + 7) * 65 + nn]);
          *(u32x4*)(C.dst + (size_t)drow * C.K + C.k0 + kc) = o; } }
        if (!more) break;
        g = gn; buf ^= 1;
    }
    __syncthreads();
}
__device__ __forceinline__ void norm_mod_row(const float* xrow, const float* g, const float* shift, const float* scale, bf16_t* orow, float* fout, int lane) {
    f32x4 v[4]; float s = 0.f;
#pragma unroll
    for (int j = 0; j < 4; ++j) { v[j] = ((const f32x4*)xrow)[lane + 64 * j]; s += v[j].x * v[j].x + v[j].y * v[j].y + v[j].z * v[j].z + v[j].w * v[j].w; }
    const float rinv = rsqrtf(wave_sum(s) * (1.f / D) + EPS);
#pragma unroll
    for (int j = 0; j < 4; ++j) { const int idx = lane + 64 * j;
        const f32x4 gg = ((const f32x4*)g)[idx], sh = ((const f32x4*)shift)[idx], sc = ((const f32x4*)scale)[idx];
        f32x4 y; y.x = v[j].x * rinv * gg.x * (1.f + sc.x) + sh.x; y.y = v[j].y * rinv * gg.y * (1.f + sc.y) + sh.y;
        y.z = v[j].z * rinv * gg.z * (1.f + sc.z) + sh.z; y.w = v[j].w * rinv * gg.w * (1.f + sc.w) + sh.w;
        u32x2 o; o.x = pk2(y.x, y.y); o.y = pk2(y.z, y.w);
        ((u32x2*)orow)[idx] = o;
        if (fout) ((f32x4*)fout)[idx] = y; }
}
__device__ __forceinline__ void ph_norm1(KP p, int l, unsigned char* lds) {
    if (l == 0) ph_cvt(p, l, lds);
    const int tid = tid_(), lane = tid & 63, wid = tid >> 6;
    bf16_t* A = (bf16_t*)(p->ws + Z_A);
    const float* g = p->in[6] + l * D;
    if (l == 0) { for (int row = bid_() * 8 + wid; row < R_ALL; row += gsz_() * 8)
        norm_mod_row(xrow_src(p, l, row), g, mod_vec(p, l, row, 0), mod_vec(p, l, row, 1), A + (size_t)row * D, nullptr, lane); }
    else { const bf16_t* X = (const bf16_t*)(p->ws + WS_X);
        for (int row = bid_() * 8 + wid; row < R_ALL; row += gsz_() * 8) {
            const float* shift = mod_vec(p, l, row, 0); const float* scale = mod_vec(p, l, row, 1);
            f32x4 v[4]; unpack8(*(const u32x4*)(X + (size_t)row * D + lane * 8), v[0], v[1]); unpack8(*(const u32x4*)(X + (size_t)row * D + 512 + lane * 8), v[2], v[3]);
            float ss = 0.f;
#pragma unroll
            for (int j = 0; j < 4; ++j) ss += v[j].x * v[j].x + v[j].y * v[j].y + v[j].z * v[j].z + v[j].w * v[j].w;
            const float rinv = rsqrtf(wave_sum(ss) * (1.f / D) + EPS);
#pragma unroll
            for (int h = 0; h < 2; ++h) { const int c0 = h * 512 + lane * 8; unsigned o[4];
#pragma unroll
                for (int q = 0; q < 2; ++q) { const f32x4 gg = *(const f32x4*)(g + c0 + 4 * q), sh = *(const f32x4*)(shift + c0 + 4 * q), sc = *(const f32x4*)(scale + c0 + 4 * q);
                    const f32x4 y = v[2 * h + q] * rinv * gg * (sc + 1.f) + sh; o[2 * q] = pk2(y.x, y.y); o[2 * q + 1] = pk2(y.z, y.w); }
                *(u32x4*)(A + (size_t)row * D + c0) = (u32x4){o[0], o[1], o[2], o[3]}; } } }
}

template <int NBJ, class ARow, class Epi>
__device__ __forceinline__ void gemm_simple_tile(const bf16_t* A, const ARow& arow, const bf16_t* Bt, int K, int row0, int colb0, int bjstride, const Epi& epi) {
    const int tid = tid_(), lane = tid & 63, wid = tid >> 6, wr = wid >> 1, wc = wid & 1, fr = lane & 15, fq = lane >> 4;
    f32x4 acc[2][NBJ][4];
#pragma unroll
    for (int i = 0; i < 2; ++i)
#pragma unroll
        for (int b = 0; b < NBJ; ++b)
#pragma unroll
            for (int j = 0; j < 4; ++j) acc[i][b][j] = (f32x4){0.f, 0.f, 0.f, 0.f};
    const bf16_t* ap[2];
#pragma unroll
    for (int i = 0; i < 2; ++i) ap[i] = A + (size_t)arow(row0 + wr * 32 + i * 16 + fr) * K + fq * 8;
    const bf16_t* bp = Bt + (size_t)(colb0 + wc * 64 + fr) * K + fq * 8;
    for (int k = 0; k < K; k += 32) {
        bf16x8 a[2];
#pragma unroll
        for (int i = 0; i < 2; ++i) a[i] = *(const bf16x8*)(ap[i] + k);
#pragma unroll
        for (int b = 0; b < NBJ; ++b)
#pragma unroll
            for (int j = 0; j < 4; ++j) { const bf16x8 bv = *(const bf16x8*)(bp + (size_t)(b * bjstride + j * 16) * K + k);
#pragma unroll
                for (int i = 0; i < 2; ++i) acc[i][b][j] = __builtin_amdgcn_mfma_f32_16x16x32_bf16(a[i], bv, acc[i][b][j], 0, 0, 0); }
    }
#pragma unroll
    for (int i = 0; i < 2; ++i)
#pragma unroll
        for (int j = 0; j < 4; ++j)
#pragma unroll
            for (int r = 0; r < 4; ++r) { const int row = row0 + wr * 32 + i * 16 + fq * 4 + r, col = wc * 64 + j * 16 + fr;
                epi(row, col, acc[i][0][j][r], acc[i][NBJ - 1][j][r]); }
}
struct RowId { __device__ __forceinline__ int operator()(int r) const { return r; } };
struct RowGather { const int* idx; __device__ __forceinline__ int operator()(int r) const { return idx[r]; } };

__device__ __forceinline__ void ph_inproj(KP p, int l, unsigned char* lds) {
    const bf16_t* A = (const bf16_t*)(p->ws + Z_A); const bf16_t* Bt = (const bf16_t*)(p->ws + Z_WIN); bf16_t* P = (bf16_t*)(p->ws + Z_P);
    constexpr int TM = R_ALL / 128, TN = DIN / 128;
    for (int it = bid_(); it < TM * TN; it += gsz_()) { const int mt = it / TN, nt = it % TN;
        auto epi = [&](int row, int col, float v, float) { P[(size_t)row * DIN + nt * 128 + col] = (bf16_t)f2bf(v); };
        gemm_simple_tile<1>(A, RowId{}, Bt, 1024, mt * 128, nt * 128, 0, epi); }
}

namespace pg8 {
constexpr int BM = 256, BK = 64, HALF = 128, HTB = HALF * BK * 2, STAGE_BYTES = 8 * HTB, NXCD = 8, WGM = 8;
__host__ __device__ __forceinline__ int lds_byte(int r, int c) { const int st = (r >> 4) * 2 + (c >> 5), rr = r & 15, cc = c & 31, ob = rr * 64 + cc * 2; return st * 1024 + (ob ^ (((ob >> 9) & 1) << 5)); }
__host__ __device__ __forceinline__ void stage_rc(int b, int& R, int& C) { const int st = b / 1024, sb = b % 1024, swz = sb ^ (((sb >> 9) & 1) << 5); R = (st >> 1) * 16 + swz / 64; C = (st & 1) * 32 + (swz % 64) / 2; }
__host__ __device__ __forceinline__ int perm32(int rho) { const int n = rho >> 4, i = rho & 15; return 8 * (i >> 2) + 4 * n + (i & 3); }
struct Unit { int pm, pn, ord; };
struct Gemm { const bf16_t* A; const bf16_t* Bt; int M, N, K; };
struct StaticOrder {
    int nM, nN, nwg, G, c;
    __host__ __device__ void init(int M, int N, int G_, int c_) { nM = M / BM; nN = N / BM; nwg = nM * nN; G = G_; c = c_; }
    __host__ __device__ bool next(int i, Unit& u) const {
        const long L = (long)i * G + c; if (L >= nwg) return false;
        int wgid = (int)L; { const int q = nwg / NXCD, r = nwg % NXCD, xcd = wgid % NXCD, off = wgid / NXCD; wgid = (xcd < r ? xcd * (q + 1) : r * (q + 1) + (xcd - r) * q) + off; }
        const int nig = WGM * nN, gid = wgid / nig, fm = gid * WGM, gsz = (nM - fm) < WGM ? (nM - fm) : WGM;
        u.pm = fm + ((wgid % nig) % gsz); u.pn = (wgid % nig) / gsz; u.ord = i; return true;
    }
};
__device__ __forceinline__ unsigned cvt_pk_bf16(float lo, float hi) { unsigned r; asm volatile("v_cvt_pk_bf16_f32 %0, %1, %2" : "=v"(r) : "v"(lo), "v"(hi)); return r; }

typedef int i32x4v __attribute__((ext_vector_type(4)));
typedef int i32x8v __attribute__((ext_vector_type(8)));
__device__ __forceinline__ i32x8v cat8(bf16x8 lo, bf16x8 hi) { const i32x4v a = __builtin_bit_cast(i32x4v, lo), b = __builtin_bit_cast(i32x4v, hi); return __builtin_shufflevector(a, b, 0, 1, 2, 3, 4, 5, 6, 7); }
__device__ __forceinline__ void glds16_s(const void* sbase, unsigned voff, unsigned lds_dst) { unsigned keep;
    asm volatile("s_mov_b32 %0, m0\n\ts_mov_b32 m0, %3\n\ts_nop 0\n\tglobal_load_lds_dwordx4 %1, %2\n\ts_mov_b32 m0, %0" : "=&s"(keep) : "v"(voff), "s"(sbase), "s"(lds_dst) : "memory"); }
template <class Epi, class Sched, bool GATHER, bool FP8 = false>
__device__ __forceinline__ void gemm_phase(LAS unsigned char* lds, const Gemm g, const Sched& S, const Epi& E, const LAS int* rtab) {
    const int tid = tid_(), wid = __builtin_amdgcn_readfirstlane(tid >> 6), lane = tid & 63, wr = wid >> 2, wc = wid & 3, fr = lane & 15, fq = lane >> 4;
    const int KB = FP8 ? g.K : g.K * 2, nt = KB / 128;
    unsigned voffA[2], voffB[2]; int RA[2], CA[2];
#pragma unroll
    for (int i = 0; i < 2; ++i) { int R, C; stage_rc(tid * 16 + i * 8192, R, C); const int Rb = (R & ~31) + perm32(R & 31);
        voffA[i] = (unsigned)(R * KB + C * 2); voffB[i] = (unsigned)(Rb * KB + C * 2); RA[i] = R; CA[i] = C; }
    unsigned rcpk = 0; if constexpr (GATHER) { rcpk = (unsigned)(RA[0] * 4) | ((unsigned)(CA[0] * 2) << 16); asm volatile("" : "+v"(rcpk)); }
    const size_t kstep = (size_t)128;
    const size_t hstep = (size_t)HALF * KB;
    const size_t hstepA = GATHER ? 0 : hstep;
    const size_t tstep = 2 * hstep;
    const unsigned ldsw = (unsigned)wid * 1024u;
    const unsigned ldsb = (unsigned)__builtin_amdgcn_readfirstlane((int)((unsigned)(size_t)lds + ldsw));
    const int aoff = lds_byte(wr * 64 + fr, fq * 8), boff = lds_byte(wc * 32 + fr, fq * 8);
#define PG8_SA(b, h) (((b) * 2 + (h)) * HTB)
#define PG8_SB(b, h) ((4 + (b) * 2 + (h)) * HTB)
#define PG8_STAGE(bufoff, gbase, voff) do { _Pragma("unroll") for (int _i = 0; _i < 2; ++_i) { if constexpr (FP8) glds16_s((const void*)(gbase), (voff)[_i], ldsb + (unsigned)((bufoff) + _i * 8192)); \
        else __builtin_amdgcn_global_load_lds((const unsigned*)((const char*)(gbase) + (voff)[_i]), (LAS unsigned*)(lds + (bufoff) + ldsw + _i * 8192), 16, 0, 0); } } while (0)
#define PG8_STAGE1(bufoff, gbase, v0) do {   \
        glds16_s((const void*)(gbase), (v0), ldsb + (unsigned)(bufoff)); glds16_s((const void*)((const char*)(gbase) + (size_t)64 * KB), (v0), ldsb + (unsigned)((bufoff) + 8192)); } while (0)
#define PG8_LDA(dst, b, h) do { _Pragma("unroll") for (int m = 0; m < 4; ++m) { if constexpr (FP8) dst##8[m] = cat8(*(const LAS bf16x8*)(lds + PG8_SA(b, h) + aoff + m * 2048), *(const LAS bf16x8*)(lds + PG8_SA(b, h) + aoff + m * 2048 + 1024)); \
        else { _Pragma("unroll") for (int k = 0; k < 2; ++k) dst[m][k] = *(const LAS bf16x8*)(lds + PG8_SA(b, h) + aoff + m * 2048 + k * 1024); } } } while (0)
#define PG8_LDB(dst, b, h) do { _Pragma("unroll") for (int n = 0; n < 2; ++n) { if constexpr (FP8) dst##8[n] = cat8(*(const LAS bf16x8*)(lds + PG8_SB(b, h) + boff + n * 2048), *(const LAS bf16x8*)(lds + PG8_SB(b, h) + boff + n * 2048 + 1024)); \
        else { _Pragma("unroll") for (int k = 0; k < 2; ++k) dst[n][k] = *(const LAS bf16x8*)(lds + PG8_SB(b, h) + boff + n * 2048 + k * 1024); } } } while (0)
#define PG8_MMA(ai, bj, At, Bt) do { __builtin_amdgcn_s_setprio(1); _Pragma("unroll") for (int m = 0; m < 4; ++m) _Pragma("unroll") for (int n = 0; n < 2; ++n) { \
        if constexpr (FP8) acc[ai][bj][m][n] = __builtin_amdgcn_mfma_scale_f32_16x16x128_f8f6f4(Bt##8[n], At##8[m], acc[ai][bj][m][n], 0, 0, 0, 0x7F7F7F7F, 0, 0x7F7F7F7F); \
        else { _Pragma("unroll") for (int k = 0; k < 2; ++k) acc[ai][bj][m][n] = __builtin_amdgcn_mfma_f32_16x16x32_bf16(Bt[n][k], At[m][k], acc[ai][bj][m][n], 0, 0, 0); } } \
        if constexpr (FP8) { asm volatile("" : "+v"(acc[ai][bj][0][0]), "+v"(acc[ai][bj][0][1]), "+v"(acc[ai][bj][1][0]), "+v"(acc[ai][bj][1][1]), "+v"(acc[ai][bj][2][0]), "+v"(acc[ai][bj][2][1]), "+v"(acc[ai][bj][3][0]), "+v"(acc[ai][bj][3][1])); } \
        __builtin_amdgcn_s_setprio(0); } while (0)
#define PG8_WAIT_V(n) asm volatile("s_waitcnt vmcnt(" #n ")" ::: "memory")
#define PG8_WAIT_L(n) asm volatile("s_waitcnt lgkmcnt(" #n ")" ::: "memory")
#define PG8_BAR __builtin_amdgcn_s_barrier()
#define PG8_SCHED __builtin_amdgcn_sched_barrier(0)
#define PG8_STAGE_A(bufoff, gbase, ord, h) do { unsigned _o[2]; if constexpr (GATHER) {   \
            unsigned _pk = rcpk; asm volatile("" : "+v"(_pk));   \
            const LAS unsigned char* _rp = (const LAS unsigned char*)rtab + ((ord) * 1024 + (h) * 512) + (_pk & 0xffffu); const unsigned _c2 = _pk >> 16; \
            _Pragma("unroll") for (int _i = 0; _i < 2; ++_i) _o[_i] = __umul24((unsigned)*(const LAS int*)(_rp + _i * 256), (unsigned)KB) + _c2; } \
        else { _o[0] = voffA[0]; _o[1] = voffA[1]; } if constexpr (FP8 && !GATHER) PG8_STAGE1(bufoff, gbase, voffA[0]); else PG8_STAGE(bufoff, gbase, _o); } while (0)
#define PG8_STAGE_B(bufoff, gbase) do { if constexpr (FP8) PG8_STAGE1(bufoff, gbase, voffB[0]); else PG8_STAGE(bufoff, gbase, voffB); } while (0)
    Unit cur, nxt; int ui = 0;
    if (!S.next(0, cur)) return;
    f32x4 acc[2][2][4][2];
#pragma unroll
    for (int a = 0; a < 2; ++a)
#pragma unroll
        for (int b = 0; b < 2; ++b)
#pragma unroll
            for (int m = 0; m < 4; ++m)
#pragma unroll
                for (int n = 0; n < 2; ++n) acc[a][b][m][n] = (f32x4){0.f, 0.f, 0.f, 0.f};
    bf16x8 At[4][2], B0[2][2], B1[2][2]; i32x8v At8[4], B08[2], B18[2];
    const char* cA = GATHER ? (const char*)g.A : (const char*)g.A + (size_t)cur.pm * tstep; const char* cB = (const char*)g.Bt + (size_t)cur.pn * tstep;
    PG8_STAGE_B(PG8_SB(0, 0), cB); PG8_STAGE_B(PG8_SB(0, 1), cB + hstep); PG8_STAGE_A(PG8_SA(0, 0), cA, 0, 0); PG8_STAGE_A(PG8_SA(0, 1), cA + hstepA, 0, 1);
    if (wr == 1) PG8_BAR;
    PG8_WAIT_V(2); PG8_BAR;
    PG8_STAGE_B(PG8_SB(1, 0), cB + kstep); PG8_STAGE_A(PG8_SA(1, 0), cA + kstep, 0, 0); PG8_STAGE_B(PG8_SB(1, 1), cB + hstep + kstep);
    PG8_WAIT_V(6); PG8_BAR;
    for (;;) {
        const bool has_next = S.next(ui + 1, nxt);
        const char* nA = GATHER ? (const char*)g.A : (has_next ? (const char*)g.A + (size_t)nxt.pm * tstep : cA); const char* nB = has_next ? (const char*)g.Bt + (size_t)nxt.pn * tstep : cB;
#pragma unroll 1
        for (int t = 0; t < nt; t += 2) {
            const bool last = (t == nt - 2);
            const char* a1 = cA + (size_t)(t + 1) * kstep;
            const char* a2 = last ? nA : cA + (size_t)(t + 2) * kstep; const char* b2 = last ? nB : cB + (size_t)(t + 2) * kstep;
            const char* a3 = a2 + kstep; const char* b3 = b2 + kstep;
            const int on = (last && has_next) ? ui + 1 : ui;
            PG8_LDB(B0, 0, 0); PG8_LDB(B1, 0, 1); PG8_SCHED; PG8_LDA(At, 0, 0); PG8_STAGE_A(PG8_SA(1, 1), a1 + hstepA, ui, 1);
            PG8_WAIT_V(8); PG8_WAIT_L(0); PG8_BAR; PG8_MMA(0, 0, At, B0); PG8_MMA(0, 1, At, B1); PG8_BAR; PG8_SCHED;
            PG8_LDA(At, 0, 1); PG8_STAGE_B(PG8_SB(0, 0), b2); PG8_STAGE_B(PG8_SB(0, 1), b2 + hstep); PG8_STAGE_A(PG8_SA(0, 0), a2, on, 0);
            PG8_WAIT_V(8); PG8_WAIT_L(0); PG8_BAR; PG8_MMA(1, 0, At, B0); PG8_MMA(1, 1, At, B1); PG8_BAR; PG8_SCHED;
            PG8_LDB(B0, 1, 0); PG8_LDB(B1, 1, 1); PG8_SCHED; PG8_LDA(At, 1, 0); PG8_STAGE_A(PG8_SA(0, 1), a2 + hstepA, on, 1);
            PG8_WAIT_V(8); PG8_WAIT_L(0); PG8_BAR; PG8_MMA(0, 0, At, B0); PG8_MMA(0, 1, At, B1); PG8_BAR; PG8_SCHED;
            PG8_LDA(At, 1, 1); PG8_STAGE_B(PG8_SB(1, 0), b3); PG8_STAGE_B(PG8_SB(1, 1), b3 + hstep); PG8_STAGE_A(PG8_SA(1, 0), a3, on, 0);
            PG8_WAIT_V(8); PG8_WAIT_L(0); PG8_BAR; PG8_MMA(1, 0, At, B0); PG8_MMA(1, 1, At, B1); PG8_BAR; PG8_SCHED;
        }
        if (wr == 0) PG8_BAR;
        E(acc, cur, wr, wc, fr, fq);
        if (!has_next) break;
#pragma unroll
        for (int a = 0; a < 2; ++a)
#pragma unroll
            for (int b = 0; b < 2; ++b)
#pragma unroll
                for (int m = 0; m < 4; ++m)
#pragma unroll
                    for (int n = 0; n < 2; ++n) acc[a][b][m][n] = (f32x4){0.f, 0.f, 0.f, 0.f};
        cur = nxt; cA = nA; cB = nB; ++ui;
        if (wr == 1) PG8_BAR;
    }
    PG8_WAIT_V(0);
    PG8_BAR;
#undef PG8_SA
#undef PG8_SB
#undef PG8_STAGE
#undef PG8_LDA
#undef PG8_LDB
#undef PG8_MMA
#undef PG8_WAIT_V
#undef PG8_WAIT_L
#undef PG8_BAR
#undef PG8_SCHED
#undef PG8_STAGE_A
#undef PG8_STAGE_B
#undef PG8_STAGE1
}
struct EpiBf16 {
    bf16_t* O; int ldc, ncolt; size_t slab;
    __device__ __forceinline__ void operator()(const f32x4 (&acc)[2][2][4][2], const Unit& u, int wr, int wc, int fr, int fq) const {
        const int row0 = u.pm * BM + wr * 64 + fr; const size_t col0 = (size_t)(u.pn % ncolt) * slab + wc * 32 + 8 * fq;
#pragma unroll
        for (int ai = 0; ai < 2; ++ai)
#pragma unroll
            for (int m = 0; m < 4; ++m) { bf16_t* rowp = O + (size_t)(row0 + ai * HALF + m * 16) * ldc + col0;
#pragma unroll
                for (int bj = 0; bj < 2; ++bj) { const f32x4 v0 = acc[ai][bj][m][0], v1 = acc[ai][bj][m][1];
                    u32x4 w; w.x = cvt_pk_bf16(v0[0], v0[1]); w.y = cvt_pk_bf16(v0[2], v0[3]); w.z = cvt_pk_bf16(v1[0], v1[1]); w.w = cvt_pk_bf16(v1[2], v1[3]);
                    *(u32x4*)(rowp + bj * HALF) = w; } }
    }
};
struct EpiRes {
    bf16_t* X; const float* xlat; const float* xctx; const float* modl; int pm_shift; float ascale; bool perm = false;
    __device__ __forceinline__ void operator()(const f32x4 (&acc)[2][2][4][2], const Unit& u, int wr, int wc, int fr, int fq) const {
        const int pm = u.pm - pm_shift; const int rsel = pm < 64 ? (pm >> 5) : 2;
        const int row0 = pm * BM + wr * 64 + fr, col0 = (u.pn & 3) * BM + (perm ? wc * 64 + 16 * fq : wc * 32 + 8 * fq), bjs = perm ? 8 : HALF;
        const float* gate = modl + (size_t)rsel * 6144 + col0;
        const float* xs = xlat ? (pm < 64 ? xlat + (size_t)row0 * D : xctx + (size_t)(row0 - R_LAT) * D) + col0 : nullptr;
        bf16_t* xo = X + (size_t)row0 * D + col0;
#pragma unroll
        for (int bj = 0; bj < 2; ++bj) { const f32x4 g0 = *(const f32x4*)(gate + bj * bjs) * ascale, g1 = *(const f32x4*)(gate + bj * bjs + 4) * ascale;
#pragma unroll
            for (int ai = 0; ai < 2; ++ai)
#pragma unroll
                for (int m = 0; m < 4; ++m) { const size_t o = (size_t)(ai * HALF + m * 16) * D + bj * bjs;
                    f32x4 x0, x1;
                    if (xs) { x0 = *(const f32x4*)(xs + o); x1 = *(const f32x4*)(xs + o + 4); } else unpack8(*(const u32x4*)(xo + o), x0, x1);
                    const f32x4 y0 = x0 + g0 * acc[ai][bj][m][0], y1 = x1 + g1 * acc[ai][bj][m][1];
                    u32x4 w; w.x = cvt_pk_bf16(y0[0], y0[1]); w.y = cvt_pk_bf16(y0[2], y0[3]); w.z = cvt_pk_bf16(y1[0], y1[1]); w.w = cvt_pk_bf16(y1[2], y1[3]);
                    *(u32x4*)(xo + o) = w; } }
    }
};
struct EpiGU8 {
    unsigned char* H8; const LAS float* wtab;
    __device__ __forceinline__ void operator()(const f32x4 (&acc)[2][2][4][2], const Unit& u, int wr, int wc, int fr, int fq) const {
        { const int t_ = tid_(); fr = t_ & 15; fq = (t_ >> 4) & 3; }
        const int row0 = u.pm * BM + wr * 64 + fr, col0 = (u.pn & 1) * 128 + wc * 32 + 8 * fq;
#pragma unroll
        for (int ai = 0; ai < 2; ++ai)
#pragma unroll
            for (int m = 0; m < 4; ++m) { const int row = row0 + ai * HALF + m * 16; const float w = wtab[u.ord * 256 + wr * 64 + fr + ai * HALF + m * 16] * (H8_SCALE * GU_DESCALE * GU_DESCALE);
                float h[8];
#pragma unroll
                for (int n = 0; n < 2; ++n)
#pragma unroll
                    for (int j = 0; j < 4; ++j) { const float ag = acc[ai][0][m][n][j], au = acc[ai][1][m][n][j];
                        h[n * 4 + j] = __builtin_amdgcn_fmed3f((ag * au) * __builtin_amdgcn_rcpf(1.f + __builtin_amdgcn_exp2f(ag * (-GU_DESCALE * LOG2E))) * w, -440.f, 440.f); }
                int w0 = __builtin_amdgcn_cvt_pk_fp8_f32(h[0], h[1], 0, false); w0 = __builtin_amdgcn_cvt_pk_fp8_f32(h[2], h[3], w0, true);
                int w1 = __builtin_amdgcn_cvt_pk_fp8_f32(h[4], h[5], 0, false); w1 = __builtin_amdgcn_cvt_pk_fp8_f32(h[6], h[7], w1, true);
                u32x2 o; o.x = (unsigned)w0; o.y = (unsigned)w1;
                *(u32x2*)(H8 + (size_t)row * 256 + col0) = o; }
    }
};
struct EpiGU {
    bf16_t* H; const float* slot_w;
    __device__ __forceinline__ void operator()(const f32x4 (&acc)[2][2][4][2], const Unit& u, int wr, int wc, int fr, int fq) const {
        const int row0 = u.pm * BM + wr * 64 + fr, col0 = (u.pn & 1) * 128 + wc * 32 + 8 * fq;
#pragma unroll
        for (int ai = 0; ai < 2; ++ai)
#pragma unroll
            for (int m = 0; m < 4; ++m) { const int row = row0 + ai * HALF + m * 16; const float w = slot_w[row];
                float h[8];
#pragma unroll
                for (int n = 0; n < 2; ++n)
#pragma unroll
                    for (int j = 0; j < 4; ++j) { const float gv = acc[ai][0][m][n][j], uv = acc[ai][1][m][n][j]; h[n * 4 + j] = gv / (1.f + __expf(-gv)) * uv * w; }
                u32x4 o; o.x = cvt_pk_bf16(h[0], h[1]); o.y = cvt_pk_bf16(h[2], h[3]); o.z = cvt_pk_bf16(h[4], h[5]); o.w = cvt_pk_bf16(h[6], h[7]);
                *(u32x4*)(H + (size_t)row * 256 + col0) = o; }
    }
};
struct EpiY8 {
    unsigned char* Y8;
    __device__ __forceinline__ void operator()(const f32x4 (&acc)[2][2][4][2], const Unit& u, int wr, int wc, int fr, int fq) const {
        const int row0 = u.pm * BM + wr * 64 + fr; unsigned char* base = Y8 + ((size_t)(u.pn & 3) * MAXSLOT + row0) * 256 + wc * 64 + 16 * fq;
#pragma unroll
        for (int ai = 0; ai < 2; ++ai)
#pragma unroll
            for (int m = 0; m < 4; ++m) { unsigned w[4];
#pragma unroll
                for (int bj = 0; bj < 2; ++bj) { f32x4 v0 = acc[ai][bj][m][0] * (Y8_SCALE * DN_DESCALE), v1 = acc[ai][bj][m][1] * (Y8_SCALE * DN_DESCALE);
#pragma unroll
                    for (int q = 0; q < 4; ++q) { v0[q] = fminf(fmaxf(v0[q], -440.f), 440.f); v1[q] = fminf(fmaxf(v1[q], -440.f), 440.f); }
                    int w0 = __builtin_amdgcn_cvt_pk_fp8_f32(v0[0], v0[1], 0, false); w0 = __builtin_amdgcn_cvt_pk_fp8_f32(v0[2], v0[3], w0, true);
                    int w1 = __builtin_amdgcn_cvt_pk_fp8_f32(v1[0], v1[1], 0, false); w1 = __builtin_amdgcn_cvt_pk_fp8_f32(v1[2], v1[3], w1, true);
                    w[2 * bj] = (unsigned)w0; w[2 * bj + 1] = (unsigned)w1; }
                *(u32x4*)(base + (size_t)(ai * HALF + m * 16) * 256) = (u32x4){w[0], w[1], w[2], w[3]}; }
    }
};
struct EpiDown {
    bf16_t* Y; bf16_t* X; const float* modl5;
    __device__ __forceinline__ void operator()(const f32x4 (&acc)[2][2][4][2], const Unit& u, int wr, int wc, int fr, int fq) const {
        { const int t_ = tid_(); fr = t_ & 15; fq = (t_ >> 4) & 3; }
        if (u.pm < MAXSLOT / 256) { const EpiY8 e{(unsigned char*)Y}; e(acc, u, wr, wc, fr, fq); }
        else { const EpiRes e{X, nullptr, nullptr, modl5, MAXSLOT / 256, DN_DESCALE, true}; e(acc, u, wr, wc, fr, fq); }
    }
};
}


__device__ __forceinline__ void ph_inproj_f(KP p, int l, unsigned char* lds) {
    pg8::Gemm g{(const bf16_t*)(p->ws + Z_A), (const bf16_t*)(p->ws + win_off(l)), R_ALL, DIN, 1024};
    pg8::StaticOrder S; S.init(R_ALL, DIN, gsz_(), bid_());
    pg8::EpiBf16 E{(bf16_t*)(p->ws + Z_P), DIN, DIN / 256, 256};
    pg8::gemm_phase<pg8::EpiBf16, pg8::StaticOrder, false>((LAS unsigned char*)lds, g, S, E, nullptr);
    if (l == 0 && DEPTH > 1 && gsz_() == 256) { __syncthreads(); ph_cvt(p, 1, lds, 214, 42, 0, CVT_E1); }
}
__device__ __forceinline__ void ph_outproj_f(KP p, int l, unsigned char* lds) {
    const int T = (l == 0) ? R_ALL : R_LAT;
    pg8::Gemm g{(const bf16_t*)(p->ws + Z_YCAT), (const bf16_t*)(p->ws + wout_off(l)), T, 1024, 1024};
    pg8::StaticOrder S; S.init(T, 1024, gsz_(), bid_());
    bf16_t* X = (bf16_t*)(p->ws + WS_X);
    pg8::EpiRes E{X, l == 0 ? p->in[0] : nullptr, l == 0 ? p->in[2] : nullptr, (const float*)(p->ws + WS_MOD) + (size_t)l * 3 * 6144 + 2 * 1024, 0, 1.f};
    pg8::gemm_phase<pg8::EpiRes, pg8::StaticOrder, false>((LAS unsigned char*)lds, g, S, E, nullptr);
    if (l == 0 && DEPTH > 1) {
        const int G = gsz_(); __syncthreads();
        if (G == 256) ph_cvt(p, 1, lds, 8, 248, CVT_E2, 1 << 30); else ph_cvt(p, 1, lds); }
}
struct QkvLane { f32x4 gg0, gg1, gw0, gw1; };
__device__ __forceinline__ QkvLane qkv_lane_consts(KP p, int l, int lane) {
    QkvLane c; const int dch = (lane & 7) * 8; const int isk = lane >= 32;
    const float* gq = p->in[isk ? 11 : 10] + l * 64 + dch; const float* wq = p->in[isk ? 13 : 12] + l * 64 + dch;
    c.gg0 = *(const f32x4*)gq; c.gg1 = *(const f32x4*)(gq + 4); c.gw0 = *(const f32x4*)wq; c.gw1 = *(const f32x4*)(wq + 4); return c;
}
__device__ __forceinline__ void prep_qkv_row(KP p, int l, int row, int lane, const QkvLane& qc) {
    const bf16_t* pr = (const bf16_t*)(p->ws + Z_P) + (size_t)row * DIN;
    const bool isctx = row >= R_LAT; const int b = isctx ? ((row - R_LAT) >> 8) : (row >> 13), t = isctx ? ((row - R_LAT) & 255) : (row & 8191);
    const size_t krow = (size_t)b * NKEY + (isctx ? NSEQ + t : t);
    const int l7 = lane & 7, axis = l7 >> 2, half = (l7 >> 1) & 1;
    f32x4 cs0 = (f32x4){1.f, 1.f, 1.f, 1.f}, cs1 = cs0, sn0 = (f32x4){0.f, 0.f, 0.f, 0.f}, sn1 = sn0;
    if (!isctx) { const int pos = axis == 0 ? (t >> 6) : (t & 63); const float* rt = (const float*)(p->ws + WS_ROPE) + pos * 32 + (lane & 1) * 8;
        cs0 = *(const f32x4*)rt; cs1 = *(const f32x4*)(rt + 4); sn0 = *(const f32x4*)(rt + 16); sn1 = *(const f32x4*)(rt + 20); }
    const u32x4 ra = *(const u32x4*)(pr + lane * 8), rb = *(const u32x4*)(pr + 512 + lane * 8);
#pragma unroll
    for (int grp = 0; grp < 2; ++grp) {
        const u32x4 r = grp ? rb : ra;
        bf16_t* Qd = (bf16_t*)(p->ws + (isctx ? (grp ? Z_QWC : Z_QGC) : (grp ? Z_QW : Z_QG))) + (size_t)(isctx ? (b * NCTX + t) : row) * 256;
        bf16_t* Kd = (bf16_t*)(p->ws + (grp ? Z_KW : Z_KG)) + krow * 128; bf16_t* Vd = (bf16_t*)(p->ws + (grp ? Z_VW : Z_VG)) + krow * 128;
        if (lane >= 48) { *(u32x4*)(Vd + (lane - 48) * 8) = r; continue; }
        float x[8] = {bf2f(r.x & 0xffffu), bf2f(r.x >> 16), bf2f(r.y & 0xffffu), bf2f(r.y >> 16), bf2f(r.z & 0xffffu), bf2f(r.z >> 16), bf2f(r.w & 0xffffu), bf2f(r.w >> 16)};
        float ss = 0.f;
#pragma unroll
        for (int i = 0; i < 8; ++i) ss += x[i] * x[i];
        ss += __shfl_xor(ss, 1); ss += __shfl_xor(ss, 2); ss += __shfl_xor(ss, 4);
        const float rinv = rsqrtf(ss * (1.f / 64.f) + EPS);
        const f32x4 g0 = grp ? qc.gw0 : qc.gg0, g1 = grp ? qc.gw1 : qc.gg1;
        const float gv[8] = {g0.x, g0.y, g0.z, g0.w, g1.x, g1.y, g1.z, g1.w};
        const float cv[8] = {cs0.x, cs0.y, cs0.z, cs0.w, cs1.x, cs1.y, cs1.z, cs1.w}, sv[8] = {sn0.x, sn0.y, sn0.z, sn0.w, sn1.x, sn1.y, sn1.z, sn1.w};
        const float qs = (lane < 32) ? QSCALE : 1.f;
        float y[8];
#pragma unroll
        for (int i = 0; i < 8; ++i) { const float v = x[i] * rinv * gv[i]; const float o = __shfl_xor(v, 2);
            y[i] = ((half == 0) ? (v * cv[i] - o * sv[i]) : (o * sv[i] + v * cv[i])) * qs; }
        u32x4 ov; ov.x = pk2(y[0], y[1]); ov.y = pk2(y[2], y[3]); ov.z = pk2(y[4], y[5]); ov.w = pk2(y[6], y[7]);
        if (lane < 32) *(u32x4*)(Qd + lane * 8) = ov; else *(u32x4*)(Kd + (lane - 32) * 8) = ov;
    }
}

template <int R> __device__ __forceinline__ void dw_rows(const float* hcol, const float (&wj)[31], float (&acc)[32]) {
    if constexpr (R < 62) {
        const float hv = hcol[R * 256];
        constexpr int T0 = (R - 30 > 0) ? R - 30 : 0, T1 = (R < 31) ? R : 31;
#pragma unroll
        for (int tt = T0; tt <= T1; ++tt) acc[tt] += hv * wj[R - tt];
        dw_rows<R + 1>(hcol, wj, acc);
    }
}
__device__ __forceinline__ void conv_tile(KP p, int l, unsigned char* lds, int seq_row0, int seqlen, int t0) {
    float* hb = (float*)lds;
    const int tid = tid_(), lane = tid & 63, wid = tid >> 6;
    const bf16_t* P = (const bf16_t*)(p->ws + Z_P);
    for (int i = tid; i < 94 * 32; i += NTHREADS) { const int r = i >> 5, c8 = (i & 31) * 8, t = t0 - 15 + r;
        f32x4 h0 = (f32x4){0.f, 0.f, 0.f, 0.f}, h1 = h0;
        if (t >= 0 && t < seqlen) { const bf16_t* pr = P + (size_t)(seq_row0 + t) * DIN;
            const u32x4 vv = *(const u32x4*)(pr + C_CVV + c8), gg = *(const u32x4*)(pr + C_CVG + c8);
            h0.x = bf2f(vv.x & 0xffffu) * sigmoid_(bf2f(gg.x & 0xffffu)); h0.y = bf2f(vv.x >> 16) * sigmoid_(bf2f(gg.x >> 16));
            h0.z = bf2f(vv.y & 0xffffu) * sigmoid_(bf2f(gg.y & 0xffffu)); h0.w = bf2f(vv.y >> 16) * sigmoid_(bf2f(gg.y >> 16));
            h1.x = bf2f(vv.z & 0xffffu) * sigmoid_(bf2f(gg.z & 0xffffu)); h1.y = bf2f(vv.z >> 16) * sigmoid_(bf2f(gg.z >> 16));
            h1.z = bf2f(vv.w & 0xffffu) * sigmoid_(bf2f(gg.w & 0xffffu)); h1.w = bf2f(vv.w >> 16) * sigmoid_(bf2f(gg.w >> 16)); }
        *(f32x4*)(hb + r * 256 + c8) = h0; *(f32x4*)(hb + r * 256 + c8 + 4) = h1; }
    __syncthreads();
    { const int c = tid & 255, hf = tid >> 8;
      const float* w = p->in[15] + (size_t)l * 31 * 256 + c; const float bias = p->in[16][l * 256 + c];
      float wj[31];
#pragma unroll
      for (int j = 0; j < 31; ++j) wj[j] = w[j * 256];
      float acc[32];
#pragma unroll
      for (int tt = 0; tt < 32; ++tt) acc[tt] = bias;
      dw_rows<0>(hb + hf * 32 * 256 + c, wj, acc);
      __syncthreads();
#pragma unroll
      for (int tt = 0; tt < 32; ++tt) hb[(hf * 32 + tt) * 256 + c] = acc[tt];
    }
    __syncthreads();
    constexpr int AS = 264;
    bf16_t* ab = (bf16_t*)(lds + 94 * 256 * 4);
    for (int tt = wid; tt < 64; tt += 8) { const float* r = hb + tt * 256; const f32x4 v = ((const f32x4*)r)[lane];
        const float mean = wave_sum(v.x + v.y + v.z + v.w) * (1.f / 256.f);
        const float dx = v.x - mean, dy = v.y - mean, dz = v.z - mean, dw = v.w - mean;
        const float rstd = rsqrtf(wave_sum(dx * dx + dy * dy + dz * dz + dw * dw) * (1.f / 256.f) + EPS);
        const f32x4 g = ((const f32x4*)(p->in[17] + l * 256))[lane], bb = ((const f32x4*)(p->in[18] + l * 256))[lane];
        u32x2 o; o.x = pk2(silu_(dx * rstd * g.x + bb.x), silu_(dy * rstd * g.y + bb.y)); o.y = pk2(silu_(dz * rstd * g.z + bb.z), silu_(dw * rstd * g.w + bb.w));
        *(u32x2*)(ab + tt * AS + lane * 4) = o; }
    __syncthreads();
    { const int fr = lane & 15, fq = lane >> 4;
      const bf16_t* Wt = (const bf16_t*)(p->ws + wpw_off(l));
      bf16x8 bw[2][8];
#pragma unroll
      for (int j = 0; j < 2; ++j)
#pragma unroll
          for (int ks = 0; ks < 8; ++ks) bw[j][ks] = *(const bf16x8*)(Wt + (size_t)((wid * 2 + j) * 16 + fr) * 256 + ks * 32 + fq * 8);
      const float bias0 = p->in[20][l * 256 + wid * 32 + fr], bias1 = p->in[20][l * 256 + wid * 32 + 16 + fr];
      bf16_t* Y = (bf16_t*)(p->ws + Z_YCAT);
#pragma unroll 1
      for (int tr = 0; tr < 4; ++tr) { f32x4 a0 = (f32x4){0.f, 0.f, 0.f, 0.f}, a1 = a0;
#pragma unroll
          for (int ks = 0; ks < 8; ++ks) { const bf16x8 av = *(const bf16x8*)(ab + (tr * 16 + fr) * AS + ks * 32 + fq * 8);
              a0 = __builtin_amdgcn_mfma_f32_16x16x32_bf16(av, bw[0][ks], a0, 0, 0, 0); a1 = __builtin_amdgcn_mfma_f32_16x16x32_bf16(av, bw[1][ks], a1, 0, 0, 0); }
#pragma unroll
          for (int r = 0; r < 4; ++r) { const int t = t0 + tr * 16 + fq * 4 + r; bf16_t* yr = Y + (size_t)(seq_row0 + t) * D + 256 + wid * 32 + fr;
              yr[0] = (bf16_t)f2bf(a0[r] + bias0); yr[16] = (bf16_t)f2bf(a1[r] + bias1); } }
    }
    __syncthreads();
}

__device__ __forceinline__ int hgrn_chunk_row0(int b, int dir, int j) {
    if (j < 4) { const int cj = dir ? 3 - j : j; return R_LAT + b * NCTX + cj * 64; }
    const int jj = j - 4, cj = dir ? 127 - jj : jj; return b * NSEQ + cj * 64;
}
__device__ __forceinline__ void hgrn_load_chunk(KP p, int l, int row0, int dir, int head, float* qs, float* vs, float* ks, float* cs) {
    const int tid = tid_();
    const bf16_t* P = (const bf16_t*)(p->ws + Z_P);
    const float* lbv = (const float*)(p->ws + WS_LB) + (l * 2 + dir) * 256 + head * 64;
    for (int i = tid; i < 4096; i += NTHREADS) { const int tau = i >> 6, d = i & 63; const int row = row0 + (dir ? 63 - tau : tau);
        const bf16_t* pr = P + (size_t)row * DIN + head * 64 + d;
        if (qs) qs[i] = bf2f(pr[C_RQ]);
        vs[i] = bf2f(pr[C_RI]);
        const float z = bf2f(pr[dir ? C_RFB : C_RFF]); const float lb = lbv[d];
        const float lsp = fminf(z, 0.f) - log1pf(__expf(-fabsf(z)));
        float logf = lsp;
        if (lb > 0.f) { const float a = lsp, bq = __logf(lb) + (lsp - z); const float mx = fmaxf(a, bq); logf = mx + log1pf(__expf(-fabsf(a - bq))); }
        ks[i] = (1.f - lb) * sigmoid_(-z);
        cs[i] = logf; }
    __syncthreads();
    if (tid < 64) { float c = 0.f; for (int tau = 0; tau < 64; ++tau) { c += cs[tau * 64 + tid]; cs[tau * 64 + tid] = c; } }
    __syncthreads();
}
__device__ __forceinline__ void hgrn_pass1_unit(KP p, int l, unsigned char* lds, int unit) {
    float* vs = (float*)lds; float* ks = vs + 4096; float* cs = ks + 4096;
    const int tid = tid_();
    const int j = unit % NCHUNK, seq = unit / NCHUNK, dir = seq & 1, head = (seq >> 1) & 3, b = seq >> 3;
    hgrn_load_chunk(p, l, hgrn_chunk_row0(b, dir, j), dir, head, nullptr, vs, ks, cs);
    for (int i = tid; i < 4096; i += NTHREADS) { const int d = i & 63; ks[i] *= __expf(cs[63 * 64 + d] - cs[i]); }
    __syncthreads();
    float* U = (float*)(p->ws + Z_U) + ((size_t)seq * NCHUNK + j) * 4096; float* Gv = (float*)(p->ws + Z_G) + ((size_t)seq * NCHUNK + j) * 64;
    { const int d = tid >> 3, e0 = (tid & 7) * 8; float acc[8];
#pragma unroll
      for (int e = 0; e < 8; ++e) acc[e] = 0.f;
      for (int tau = 0; tau < 64; ++tau) { const float kv = ks[tau * 64 + d];
#pragma unroll
          for (int e = 0; e < 8; ++e) acc[e] += kv * vs[tau * 64 + e0 + e]; }
#pragma unroll
      for (int e = 0; e < 8; ++e) U[d * 64 + e0 + e] = acc[e]; }
    if (tid < 64) Gv[tid] = __expf(cs[63 * 64 + tid]);
    __syncthreads();
}
constexpr int HS = 72;
constexpr int HL_TOT = 0, HL_OSUM = 2048, HL_T0 = 18432, HL_TB = 64 * HS * 2;
__device__ __forceinline__ f32x4 mm64(const bf16_t* A, const bf16_t* Bt, int tr, int tc, int fr, int fq, f32x4 acc) {
#pragma unroll
    for (int k0 = 0; k0 < 64; k0 += 32) { const bf16x8 a = *(const bf16x8*)(A + (tr * 16 + fr) * HS + k0 + fq * 8), b = *(const bf16x8*)(Bt + (tc * 16 + fr) * HS + k0 + fq * 8);
        acc = __builtin_amdgcn_mfma_f32_16x16x32_bf16(a, b, acc, 0, 0, 0); }
    return acc;
}
__device__ __forceinline__ void hgrn_load8(KP p, int row0, int dir, int head, int tid, float (&q)[8], float (&vv)[8], float (&z)[8]) {
    const int d = tid & 63, seg = tid >> 6;
    const bf16_t* P = (const bf16_t*)(p->ws + Z_P);
#pragma unroll
    for (int i = 0; i < 8; ++i) { const int tau = seg * 8 + i; const int row = row0 + (dir ? 63 - tau : tau);
        const bf16_t* pr = P + (size_t)row * DIN + head * 64 + d;
        q[i] = bf2f(pr[C_RQ]); vv[i] = bf2f(pr[C_RI]); z[i] = bf2f(pr[dir ? C_RFB : C_RFF]); }
}
__device__ __forceinline__ void hgrn_gate8(KP p, int l, int dir, int head, int tid, float* tot, const float (&z)[8], float (&kg)[8], float (&c)[8], float& m, float& cl) {
    const int d = tid & 63, seg = tid >> 6;
    const float lb = ((const float*)(p->ws + WS_LB))[(l * 2 + dir) * 256 + head * 64 + d];
    float run = 0.f;
#pragma unroll
    for (int i = 0; i < 8; ++i) {
        const float ez = __expf(-fabsf(z[i])), rz = __builtin_amdgcn_rcpf(1.f + ez); const float sg = (z[i] >= 0.f) ? rz : ez * rz;
        const float f = lb + (1.f - lb) * sg;
        kg[i] = 1.f - f;
        run += __logf(f); c[i] = run; }
    tot[seg * 64 + d] = run;
    __syncthreads();
    float off = 0.f; m = 0.f; cl = 0.f;
#pragma unroll
    for (int s2 = 0; s2 < 8; ++s2) { const float t = tot[s2 * 64 + d]; if (s2 < seg) off += t; if (s2 < 4) m += t; cl += t; }
#pragma unroll
    for (int i = 0; i < 8; ++i) c[i] += off;
}
__device__ __forceinline__ void hgrn_pass1_f(KP p, int l, unsigned char* lds, int unit) {
    const int tid = tid_(), lane = tid & 63, wid = tid >> 6, fr = lane & 15, fq = lane >> 4, d = tid & 63, seg = tid >> 6;
    float* tot = (float*)(lds + HL_TOT); bf16_t* Vt = (bf16_t*)(lds + HL_T0); bf16_t* KbT = (bf16_t*)(lds + HL_T0 + HL_TB);
    const int j = unit % NCHUNK, seq = unit / NCHUNK, dir = seq & 1, head = (seq >> 1) & 3, b = seq >> 3;
    float q[8], vv[8], z[8], kg[8], c[8], m, cl;
    hgrn_load8(p, hgrn_chunk_row0(b, dir, j), dir, head, tid, q, vv, z);
    hgrn_gate8(p, l, dir, head, tid, tot, z, kg, c, m, cl);
    float kb[8];
#pragma unroll
    for (int i = 0; i < 8; ++i) kb[i] = kg[i] * __expf(cl - c[i]);
    *(u32x4*)(Vt + d * HS + seg * 8) = pack8(vv);
    *(u32x4*)(KbT + d * HS + seg * 8) = pack8(kb);
    float* U = (float*)(p->ws + Z_U) + ((size_t)seq * NCHUNK + j) * 4096; float* Gv = (float*)(p->ws + Z_G) + ((size_t)seq * NCHUNK + j) * 64;
    if (seg == 0) Gv[d] = __expf(cl);
    __syncthreads();
    const int tr = wid >> 1;
#pragma unroll
    for (int t2 = 0; t2 < 2; ++t2) { const int tc = (wid & 1) * 2 + t2;
        const f32x4 acc = mm64(Vt, KbT, tr, tc, fr, fq, (f32x4){0.f, 0.f, 0.f, 0.f});
#pragma unroll
        for (int r = 0; r < 4; ++r) U[(tr * 16 + fq * 4 + r) * 64 + tc * 16 + fr] = acc[r]; }
    __syncthreads();
}
struct HgrnIn1 { float v[8], zf[8], zb[8]; };
__device__ __forceinline__ void hgrn_p1_load(KP p, int unit, int tid, HgrnIn1& r) {
    const int cpos = unit % NCHUNK, head = (unit / NCHUNK) & 3, b = unit / (NCHUNK * 4), d = tid & 63, seg = tid >> 6;
    const int row0 = (cpos < 4) ? R_LAT + b * NCTX + cpos * 64 : b * NSEQ + (cpos - 4) * 64;
    const bf16_t* P = (const bf16_t*)(p->ws + Z_P) + (size_t)(row0 + seg * 8) * DIN + head * 64 + d;
#pragma unroll
    for (int i = 0; i < 8; ++i) { const bf16_t* pr = P + (size_t)i * DIN; r.v[i] = bf2f(pr[C_RI]); r.zf[i] = bf2f(pr[C_RFF]); r.zb[i] = bf2f(pr[C_RFB]); }
}
__device__ __forceinline__ void hgrn_p1_compute(KP p, int l, unsigned char* lds, int unit, int tid, const HgrnIn1& r) {
    const int lane = tid & 63, wid = tid >> 6, fr = lane & 15, fq = lane >> 4, d = tid & 63, seg = tid >> 6;
    float* totf = (float*)(lds + HL_TOT); float* totb = (float*)(lds + HL_OSUM);
    bf16_t* Vt = (bf16_t*)(lds + HL_T0); bf16_t* KfT = (bf16_t*)(lds + HL_T0 + HL_TB); bf16_t* KbT = (bf16_t*)(lds + HL_T0 + 2 * HL_TB);
    const int cpos = unit % NCHUNK, head = (unit / NCHUNK) & 3, b = unit / (NCHUNK * 4);
    const float* lbp = (const float*)(p->ws + WS_LB) + (l * 2) * 256 + head * 64 + d; const float lbf = lbp[0], lbb = lbp[256];
    float kf[8], kb[8], cf[8], cb[8], lfb[8], runf = 0.f, runb = 0.f;
#pragma unroll
    for (int i = 0; i < 8; ++i) {
        { const float z = r.zf[i], ez = __builtin_amdgcn_exp2f(-fabsf(z) * LOG2E), rz = __builtin_amdgcn_rcpf(1.f + ez), sg = (z >= 0.f) ? rz : ez * rz, f = lbf + (1.f - lbf) * sg; kf[i] = 1.f - f; runf += __builtin_amdgcn_logf(f); cf[i] = runf; }
        { const float z = r.zb[i], ez = __builtin_amdgcn_exp2f(-fabsf(z) * LOG2E), rz = __builtin_amdgcn_rcpf(1.f + ez), sg = (z >= 0.f) ? rz : ez * rz, f = lbb + (1.f - lbb) * sg; kb[i] = 1.f - f; lfb[i] = __builtin_amdgcn_logf(f); runb += lfb[i]; cb[i] = runb; } }
    totf[seg * 64 + d] = runf; totb[seg * 64 + d] = runb;
    __syncthreads();
    float offf = 0.f, offb = 0.f, clf = 0.f, clb = 0.f;
#pragma unroll
    for (int s2 = 0; s2 < 8; ++s2) { const float tf = totf[s2 * 64 + d], tb = totb[s2 * 64 + d]; if (s2 < seg) { offf += tf; offb += tb; } clf += tf; clb += tb; }
#pragma unroll
    for (int i = 0; i < 8; ++i) { kf[i] *= __builtin_amdgcn_exp2f(clf - (cf[i] + offf)); kb[i] *= __builtin_amdgcn_exp2f(cb[i] + offb - lfb[i]); }
    *(u32x4*)(Vt + d * HS + seg * 8) = pack8(r.v);
    *(u32x4*)(KfT + d * HS + seg * 8) = pack8(kf);
    *(u32x4*)(KbT + d * HS + seg * 8) = pack8(kb);
    const int jf = cpos, jb = (cpos < 4) ? 3 - cpos : 4 + 127 - (cpos - 4); const int seqf = (b * 4 + head) * 2;
    bf16_t* Uf = (bf16_t*)(p->ws + Z_U) + ((size_t)seqf * NCHUNK + jf) * 4096; bf16_t* Ub = (bf16_t*)(p->ws + Z_U) + ((size_t)(seqf + 1) * NCHUNK + jb) * 4096;
    float* Gf = (float*)(p->ws + Z_G) + ((size_t)seqf * NCHUNK + jf) * 64; float* Gb = (float*)(p->ws + Z_G) + ((size_t)(seqf + 1) * NCHUNK + jb) * 64;
    if (seg == 0) { Gf[d] = __builtin_amdgcn_exp2f(clf); Gb[d] = __builtin_amdgcn_exp2f(clb); }
    __syncthreads();
    const int tr = wid >> 1;
#pragma unroll
    for (int t2 = 0; t2 < 2; ++t2) { const int tc = (wid & 1) * 2 + t2;
        const f32x4 af = mm64(Vt, KfT, tr, tc, fr, fq, (f32x4){0.f, 0.f, 0.f, 0.f}), ab = mm64(Vt, KbT, tr, tc, fr, fq, (f32x4){0.f, 0.f, 0.f, 0.f});
#pragma unroll
        for (int q = 0; q < 4; ++q) { const int o = (tr * 16 + fq * 4 + q) * 64 + tc * 16 + fr; Uf[o] = (bf16_t)f2bf(af[q]); Ub[o] = (bf16_t)f2bf(ab[q]); } }
    __syncthreads();
}
__device__ __forceinline__ void hgrn_pass1_run(KP p, int l, unsigned char* lds, int u0, int un, int ustep) {
    if (un <= 0) return;
    const int tid = tid_();
    HgrnIn1 cur; hgrn_p1_load(p, u0, tid, cur);
    for (int k = 0; k < un; ++k) { const int u = u0 + k * ustep;
        HgrnIn1 nxt = cur; if (k + 1 < un) hgrn_p1_load(p, u + ustep, tid, nxt);
        hgrn_p1_compute(p, l, lds, u, tid, cur);
        cur = nxt; }
}
__device__ __forceinline__ void hgrn_scan_f(KP p) {
    const int tid = tid_();
    if (tid >= 256) return;
    for (int gi = bid_() * 256 + tid; gi < 16 * 4096; gi += gsz_() * 256) {
    const int seq = gi >> 12, ed = gi & 4095, d = ed & 63;
    bf16_t* U = (bf16_t*)(p->ws + Z_U) + (size_t)seq * NCHUNK * 4096 + ed; const float* Gv = (const float*)(p->ws + Z_G) + (size_t)seq * NCHUNK * 64 + d;
    float S = 0.f;
#pragma unroll 1
    for (int j = 0; j < NCHUNK; j += 12) {
        float u[12], g[12];
#pragma unroll
        for (int q = 0; q < 12; ++q) { u[q] = bf2f(U[(size_t)(j + q) * 4096]); g[q] = Gv[(j + q) * 64]; }
#pragma unroll
        for (int q = 0; q < 12; ++q) { U[(size_t)(j + q) * 4096] = (bf16_t)f2bf(S); S = g[q] * S + u[q]; }
    }
    }
}
struct HgrnIn3 { float q[8], v[8], zf[8], zb[8], gg[8]; u32x4 sf, sb; };
__device__ __forceinline__ void hgrn_p3_load(KP p, int unit, int tid, HgrnIn3& r) {
    const int cpos = unit % NCHUNK, head = (unit / NCHUNK) & 3, b = unit / (NCHUNK * 4), d = tid & 63, seg = tid >> 6;
    const int row0 = (cpos < 4) ? R_LAT + b * NCTX + cpos * 64 : b * NSEQ + (cpos - 4) * 64;
    const bf16_t* P = (const bf16_t*)(p->ws + Z_P) + (size_t)(row0 + seg * 8) * DIN + head * 64 + d;
#pragma unroll
    for (int i = 0; i < 8; ++i) { const bf16_t* pr = P + (size_t)i * DIN; r.q[i] = bf2f(pr[C_RQ]); r.v[i] = bf2f(pr[C_RI]); r.zf[i] = bf2f(pr[C_RFF]); r.zb[i] = bf2f(pr[C_RFB]);
        r.gg[i] = bf2f(((const bf16_t*)(p->ws + Z_P))[(size_t)(row0 + seg + 8 * i) * DIN + C_RG + head * 64 + d]); }
    const int jf = cpos, jb = (cpos < 4) ? 3 - cpos : 4 + 127 - (cpos - 4); const int seqf = (b * 4 + head) * 2;
    const bf16_t* U = (const bf16_t*)(p->ws + Z_U);
    r.sf = *(const u32x4*)(U + ((size_t)seqf * NCHUNK + jf) * 4096 + tid * 8); r.sb = *(const u32x4*)(U + ((size_t)(seqf + 1) * NCHUNK + jb) * 4096 + tid * 8);
}
__device__ __forceinline__ void hgrn_p3_compute(KP p, int l, unsigned char* lds, int unit, int tid, const HgrnIn3& r) {
    const int lane = tid & 63, wid = tid >> 6, fr = lane & 15, fq = lane >> 4, d = tid & 63, seg = tid >> 6;
    constexpr int HL_D1 = HL_T0 + 6 * HL_TB, HL_TOT1 = HL_D1 + 6 * HL_TB;
    static_assert(HL_TOT1 + 2048 <= LDS_WVTAB_OFF, "HGRN pass-3 LDS fits below the wave table");
    float* os0 = (float*)(lds + HL_OSUM); float* os1 = (float*)(lds + HL_T0);
    const int cpos = unit % NCHUNK, head = (unit / NCHUNK) & 3, b = unit / (NCHUNK * 4);
    const int row0 = (cpos < 4) ? R_LAT + b * NCTX + cpos * 64 : b * NSEQ + (cpos - 4) * 64;
    const int tr = wid >> 1;
    const float* lbp = (const float*)(p->ws + WS_LB) + (l * 2) * 256 + head * 64 + d;
    const int segs = __builtin_amdgcn_readfirstlane(seg);
    float kg[2][8], c[2][8];
#pragma unroll
    for (int dir = 0; dir < 2; ++dir) { float* tot = (float*)(lds + (dir ? HL_TOT1 : HL_TOT));
        const float lb = lbp[dir * 256], olb = 1.f - lb; float run = 0.f;
#pragma unroll
        for (int ii = 0; ii < 8; ++ii) { const int i = dir ? 7 - ii : ii;
            const float z = dir ? r.zb[i] : r.zf[i];
            const float ez = __builtin_amdgcn_exp2f(-fabsf(z) * LOG2E), rz = __builtin_amdgcn_rcpf(1.f + ez), sg = (z >= 0.f) ? rz : ez * rz, f = lb + olb * sg;
            kg[dir][i] = 1.f - f; run += __builtin_amdgcn_logf(f); c[dir][i] = run; }
        tot[seg * 64 + d] = run; }
    __syncthreads();
#pragma unroll
    for (int dir = 0; dir < 2; ++dir) { const float* tot = (const float*)(lds + (dir ? HL_TOT1 : HL_TOT)); unsigned char* tb = lds + (dir ? HL_D1 : HL_T0);
        bf16_t* Qt = (bf16_t*)tb; bf16_t* Kt = (bf16_t*)(tb + HL_TB); bf16_t* Qb = (bf16_t*)(tb + 2 * HL_TB); bf16_t* St = (bf16_t*)(tb + 3 * HL_TB); bf16_t* Vt = (bf16_t*)(tb + 4 * HL_TB);
        float off = 0.f, m = 0.f;
#pragma unroll
        for (int s2 = 0; s2 < 8; ++s2) { const float t = tot[s2 * 64 + d]; const float fl = (dir ? (s2 > segs) : (s2 < segs)) ? 1.f : 0.f; off = fmaf(t, fl, off); if (dir ? (s2 >= 4) : (s2 < 4)) m += t; }
        float vr[8], qb[8];
#pragma unroll
        for (int i = 0; i < 8; ++i) { const float ci = c[dir][i] + off; const int tau = dir ? 63 - (seg * 8 + i) : seg * 8 + i; const float qv = r.q[i];
            const unsigned qk = pk2(qv * __builtin_amdgcn_exp2f(fminf(ci - m, 115.f)), kg[dir][i] * __builtin_amdgcn_exp2f(fminf(m - ci, 115.f)));
            Qt[tau * HS + d] = (bf16_t)(qk & 0xffffu); Kt[tau * HS + d] = (bf16_t)(qk >> 16);
            qb[i] = qv * __builtin_amdgcn_exp2f(ci);
            vr[i] = dir ? r.v[7 - i] : r.v[i]; }
#pragma unroll
        for (int i = 0; i < 8; i += 2) { const int t0 = dir ? 63 - (seg * 8 + i) : seg * 8 + i, t1 = dir ? t0 - 1 : t0 + 1; const unsigned qq = pk2(qb[i], qb[i + 1]);
            Qb[t0 * HS + d] = (bf16_t)(qq & 0xffffu); Qb[t1 * HS + d] = (bf16_t)(qq >> 16); }
        *(u32x4*)(Vt + d * HS + (dir ? 7 - seg : seg) * 8) = pack8(vr);
        *(u32x4*)(St + (tid >> 3) * HS + (tid & 7) * 8) = dir ? r.sb : r.sf; }
    __syncthreads();
    f32x4 oacc[2][2];
#pragma unroll
    for (int dir = 0; dir < 2; ++dir) { unsigned char* tb = lds + (dir ? HL_D1 : HL_T0);
        const bf16_t* Qt = (const bf16_t*)tb; const bf16_t* Kt = (const bf16_t*)(tb + HL_TB); const bf16_t* Qb = (const bf16_t*)(tb + 2 * HL_TB); const bf16_t* St = (const bf16_t*)(tb + 3 * HL_TB); bf16_t* Sc = (bf16_t*)(tb + 5 * HL_TB);
#pragma unroll
        for (int t2 = 0; t2 < 2; ++t2) { const int tc = (wid & 1) * 2 + t2;
            oacc[dir][t2] = mm64(Qb, St, tr, tc, fr, fq, (f32x4){0.f, 0.f, 0.f, 0.f});
            f32x4 sacc = (f32x4){0.f, 0.f, 0.f, 0.f};
            if (tc <= tr) sacc = mm64(Qt, Kt, tr, tc, fr, fq, sacc);
#pragma unroll
            for (int q = 0; q < 4; q += 2) { const int tau = tr * 16 + fq * 4 + q, sig = tc * 16 + fr; const unsigned ss = pk2(sig <= tau ? sacc[q] : 0.f, sig <= tau + 1 ? sacc[q + 1] : 0.f);
                Sc[tau * HS + sig] = (bf16_t)(ss & 0xffffu); Sc[(tau + 1) * HS + sig] = (bf16_t)(ss >> 16); } } }
    __syncthreads();
#pragma unroll
    for (int dir = 0; dir < 2; ++dir) { unsigned char* tb = lds + (dir ? HL_D1 : HL_T0); const bf16_t* Vt = (const bf16_t*)(tb + 4 * HL_TB); const bf16_t* Sc = (const bf16_t*)(tb + 5 * HL_TB);
        float* os = dir ? os1 : os0;
#pragma unroll
        for (int t2 = 0; t2 < 2; ++t2) { const int tc = (wid & 1) * 2 + t2;
            const f32x4 o = mm64(Sc, Vt, tr, tc, fr, fq, oacc[dir][t2]);
#pragma unroll
            for (int q = 0; q < 4; ++q) { const int tau = tr * 16 + fq * 4 + q, e = tc * 16 + fr, tok = dir ? 63 - tau : tau; os[tok * 64 + e] = o[q]; } } }
    __syncthreads();
    bf16_t* Y = (bf16_t*)(p->ws + Z_YCAT); const float ong = p->in[22][l * 64 + lane];
    float yo[8];
#pragma unroll
    for (int i = 0; i < 8; ++i) { const int tok = wid + 8 * i; const float v = os0[tok * 64 + lane] + os1[tok * 64 + lane];
        yo[i] = v * rsqrtf(wave_sum(v * v) * (1.f / 64.f) + EPS) * ong * silu_(r.gg[i]); }
#pragma unroll
    for (int i = 0; i < 8; i += 2) { const unsigned yy = pk2(yo[i], yo[i + 1]); bf16_t* yp = Y + (size_t)(row0 + wid + 8 * i) * D + 768 + head * 64 + lane;
        yp[0] = (bf16_t)(yy & 0xffffu); yp[(size_t)8 * D] = (bf16_t)(yy >> 16); }
    __syncthreads();
}
__device__ __forceinline__ int hgrn_p3_unit(int k) { if (k < 1024) { const int bh = k >> 7, c = k & 127; return bh * NCHUNK + 4 + c; } const int k2 = k - 1024; return (k2 >> 2) * NCHUNK + (k2 & 3); }
__device__ __forceinline__ void hgrn_pass3_run(KP p, int l, unsigned char* lds) {
    const int tid = tid_(), G = gsz_(), nunits = 1024 + (l == 0 ? 32 : 0);
    int k = bid_(); if (k >= nunits) return;
    HgrnIn3 cur; hgrn_p3_load(p, hgrn_p3_unit(k), tid, cur);
    for (;;) { const int kn = k + G; const bool more = kn < nunits;
        HgrnIn3 nxt = cur; if (more) hgrn_p3_load(p, hgrn_p3_unit(kn), tid, nxt);
        hgrn_p3_compute(p, l, lds, hgrn_p3_unit(k), tid, cur);
        if (!more) break;
        cur = nxt; k = kn; }
}
__device__ __forceinline__ void ph_prep(KP p, int l, unsigned char* lds) {
    const int tid = tid_(), lane = tid & 63, wid = tid >> 6, bid = bid_(), G = gsz_();
    const int nconv = 256 + (l == 0 ? 8 : 0);
    for (int it = bid; it < nconv; it += G) {
        if (it < 256) conv_tile(p, l, lds, (it >> 7) * NSEQ, NSEQ, (it & 127) * 64);
        else { const int c = it - 256; conv_tile(p, l, lds, R_LAT + (c >> 2) * NCTX, NCTX, (c & 3) * 64); } }
    if (G == 256) {
        const int u0 = bid < 8 ? 2 * bid : bid < 56 ? 16 + 5 * (bid - 8) : 256 + 4 * (bid - 56), un = bid < 8 ? 2 : bid < 56 ? 5 : 4;
        hgrn_pass1_run(p, l, lds, u0, un, 1);
        const int g0 = bid < 104 ? 8 * bid : bid < 168 ? 832 + 9 * (bid - 104) : 1408 + 8 * (bid - 168), gn = (bid >= 104 && bid < 168) ? 9 : 8;
        const QkvLane qc = qkv_lane_consts(p, l, lane);
        for (int g = g0; g < g0 + gn; ++g) prep_qkv_row(p, l, g * 8 + wid, lane, qc);
    } else {
        hgrn_pass1_run(p, l, lds, bid, (8 * NCHUNK - bid + G - 1) / G, G);
        const QkvLane qc = qkv_lane_consts(p, l, lane);
        for (int row = bid * 8 + wid; row < R_ALL; row += G * 8) prep_qkv_row(p, l, row, lane, qc);
    }
}

__device__ __forceinline__ void hgrn_scan(KP p) {
    const int gi = bid_() * NTHREADS + tid_();
    if (gi >= 16 * 4096) return;
    const int seq = gi >> 12, de = gi & 4095, d = de >> 6;
    float* U = (float*)(p->ws + Z_U) + (size_t)seq * NCHUNK * 4096 + de; const float* Gv = (const float*)(p->ws + Z_G) + (size_t)seq * NCHUNK * 64 + d;
    float S = 0.f;
    for (int j = 0; j < NCHUNK; j += 4) {
        float u[4], g[4];
#pragma unroll
        for (int q = 0; q < 4; ++q) { u[q] = U[(size_t)(j + q) * 4096]; g[q] = Gv[(j + q) * 64]; }
#pragma unroll
        for (int q = 0; q < 4; ++q) { U[(size_t)(j + q) * 4096] = S; S = g[q] * S + u[q]; }
    }
}
__device__ __forceinline__ void attn_simple_unit(unsigned char* lds, const bf16_t* Qrow0  , const bf16_t* Kb, const bf16_t* Vb  ,
                                                 int mode, int NT, int first_key, int q0, bool use_sink, float sink_log2, bf16_t* Orow0  ) {
    float* Ks = (float*)lds; float* Vs = Ks + 4096;
    const int tid = tid_();
    float q[64], o[64], m = -INFINITY, lsum = 0.f;
    if (tid < 256) {
#pragma unroll
        for (int d = 0; d < 64; ++d) { q[d] = bf2f(Qrow0[(size_t)tid * 256 + d]); o[d] = 0.f; }
    }
    for (int tt = 0; tt < NT; ++tt) {
        int key0, pos0 = 0; bool masked = false;
        if (mode == 0) key0 = first_key + 64 * tt;
        else if (tt < 4) key0 = NSEQ + 64 * tt;
        else { pos0 = q0 - 128 + 64 * (tt - 4); key0 = pos0 < 0 ? 0 : (pos0 > NSEQ - 64 ? NSEQ - 64 : pos0); masked = true; }
        __syncthreads();
        for (int i = tid; i < 4096; i += NTHREADS) { const int kk = i >> 6, d = i & 63; Ks[i] = bf2f(Kb[(size_t)(key0 + kk) * 128 + d]); Vs[i] = bf2f(Vb[(size_t)(key0 + kk) * 128 + d]); }
        __syncthreads();
        if (tid < 256) {
            for (int kk = 0; kk < 64; ++kk) {
                if (masked) { const int kp = pos0 + kk, qp = q0 + tid; const int df = qp - kp; if (kp < 0 || kp >= NSEQ || df > 128 || df < -128) continue; }
                float s = 0.f;
#pragma unroll
                for (int d = 0; d < 64; ++d) s += q[d] * Ks[kk * 64 + d];
                if (s > m) { const float f = exp2f(m - s); lsum *= f;
#pragma unroll
                    for (int d = 0; d < 64; ++d) o[d] *= f;
                    m = s; }
                const float pe = exp2f(s - m); lsum += pe;
#pragma unroll
                for (int d = 0; d < 64; ++d) o[d] += pe * Vs[kk * 64 + d];
            }
        }
    }
    if (tid < 256) {
        if (use_sink) lsum += exp2f(sink_log2 - m);
        const float inv = 1.f / lsum;
#pragma unroll
        for (int d = 0; d < 64; ++d) Orow0[(size_t)tid * D + d] = (bf16_t)f2bf(o[d] * inv);
    }
    __syncthreads();
}
__device__ __forceinline__ void ph_attn(KP p, int l, unsigned char* lds) {
    hgrn_scan(p);
    bf16_t* Y = (bf16_t*)(p->ws + Z_YCAT);
    const bf16_t* Qg = (const bf16_t*)(p->ws + Z_QG); const bf16_t* Qw = (const bf16_t*)(p->ws + Z_QW); const bf16_t* Qgc = (const bf16_t*)(p->ws + Z_QGC); const bf16_t* Qwc = (const bf16_t*)(p->ws + Z_QWC);
    const bf16_t* Kg = (const bf16_t*)(p->ws + Z_KG); const bf16_t* Kw = (const bf16_t*)(p->ws + Z_KW); const bf16_t* Vg = (const bf16_t*)(p->ws + Z_VG); const bf16_t* Vw = (const bf16_t*)(p->ws + Z_VW);
    const int nunits = 512 + (l == 0 ? 16 : 0);
    for (int u = bid_(); u < nunits; u += gsz_()) {
        if (u < 256) {
            const int qb = u & 31, h = (u >> 5) & 3, b = u >> 7, row0 = b * NSEQ + qb * 256;
            attn_simple_unit(lds, Qg + (size_t)row0 * 256 + h * 64, Kg + (size_t)b * NKEY * 128 + (h >> 1) * 64, Vg + (size_t)b * NKEY * 128 + (h >> 1) * 64, 0, NKEY / 64, 0, qb * 256, false, 0.f, Y + (size_t)row0 * D + h * 64);
        } else if (u < 512) {
            const int v = u - 256, qb = v & 31, h = (v >> 5) & 3, b = v >> 7, row0 = b * NSEQ + qb * 256;
            attn_simple_unit(lds, Qw + (size_t)row0 * 256 + h * 64, Kw + (size_t)b * NKEY * 128 + (h >> 1) * 64, Vw + (size_t)b * NKEY * 128 + (h >> 1) * 64, 1, 12, 0, qb * 256, true, p->in[14][l * 4 + h] * LOG2E, Y + (size_t)row0 * D + 512 + h * 64);
        } else {
            const int v = u - 512, h = v & 3, b = (v >> 2) & 1, win = v >> 3, row0 = R_LAT + b * NCTX;
            const bf16_t* Qc = (win ? Qwc : Qgc) + (size_t)(b * NCTX) * 256 + h * 64;
            const bf16_t* Kc = (win ? Kw : Kg) + (size_t)b * NKEY * 128 + (h >> 1) * 64; const bf16_t* Vc = (win ? Vw : Vg) + (size_t)b * NKEY * 128 + (h >> 1) * 64;
            attn_simple_unit(lds, Qc, Kc, Vc, 0, 4, NSEQ, 0, win != 0, p->in[14][l * 4 + h] * LOG2E, Y + (size_t)row0 * D + (win ? 512 : 0) + h * 64);
        }
    }
}

namespace attn_body {
using bf16=__hip_bfloat16;
using bf16x8=__attribute__((ext_vector_type(8)))short;
using s16x4=__attribute__((ext_vector_type(4)))short;
using f32x16=__attribute__((ext_vector_type(16)))float;
using u32x4=__attribute__((ext_vector_type(4)))unsigned;
constexpr int D=64, QP=256, KP=128, OP=1024;
constexpr int NW=8,QBLK=32,QB=QBLK*NW,KVBLK=64;
__device__ __forceinline__ int crow(int r,int hi){return (r&3)+8*(r>>2)+4*hi;}
#define SBAR() __builtin_amdgcn_sched_barrier(0)
__device__ __forceinline__ void wmask(f32x16&p0,f32x16&p1,int tb,int qrel,int hi,int q0){
  const float NEG=-INFINITY; const int kb=64*tb+4*hi;
  #pragma unroll
  for(int r=0;r<16;++r){const int kl=kb+(r&3)+8*(r>>2); const int kp=q0-128+kl;
    if(kl<qrel||kl>qrel+256||kp<0||kp>=NSEQ)p0[r]=NEG;
    if(kl+32<qrel||kl+32>qrel+256||kp+32<0||kp+32>=NSEQ)p1[r]=NEG;}
}

constexpr int NSLOT=3, SLOTB=8192;
constexpr int LDS_K=0, LDS_V=NSLOT*SLOTB, LDS_WS=2*NSLOT*SLOTB, LDS_OST=LDS_WS+NW*64*4, LDS_BYTES=LDS_OST+NW*4096;
constexpr float C2=0.125f*1.4426950408889634f;
__device__ __forceinline__ void glds16(const void*gsrc,unsigned lds_dst){unsigned keep;
  asm volatile("s_mov_b32 %0, m0\n\ts_mov_b32 m0, %2\n\ts_nop 0\n\tglobal_load_lds_dwordx4 %1, off\n\ts_mov_b32 m0, %0":"=&s"(keep):"v"(gsrc),"s"(lds_dst):"memory");}
__device__ __forceinline__ float max3f(float a,float b,float c){float r;asm("v_max3_f32 %0, %1, %2, %3":"=v"(r):"v"(a),"v"(b),"v"(c));return r;}
__device__ __forceinline__ float max2f(float a,float b){float r;asm("v_max_f32_e32 %0, %1, %2":"=v"(r):"v"(a),"v"(b));return r;}
__device__ __forceinline__ float fadd_s(float a,float b){float r;asm("v_add_f32_e32 %0, %1, %2":"=v"(r):"v"(a),"v"(b));return r;}
__device__ __forceinline__ float fsub_s(float a,float b){float r;asm("v_sub_f32_e32 %0, %1, %2":"=v"(r):"v"(a),"v"(b));return r;}
typedef float f32x2_t __attribute__((ext_vector_type(2))); typedef __bf16 bf16x2_t __attribute__((ext_vector_type(2)));
__device__ __forceinline__ unsigned cvtpk_s(float lo,float hi){f32x2_t v={lo,hi};bf16x2_t b=__builtin_convertvector(v,bf16x2_t);return __builtin_bit_cast(unsigned,b);}
#define WAIT_BAR(N) asm volatile("s_waitcnt vmcnt(" #N ") lgkmcnt(0)\n\ts_barrier":::"memory")

__device__ __forceinline__ void qkt(f32x16&p0,f32x16&p1,const char*Kslot,const bf16x8*qr,const f32x16&negm,int r32,int hi){
  const char*kb=Kslot+hi*1024+r32*16;
  #pragma unroll
  for(int d0=0;d0<4;++d0){
    const bf16x8 b0=*reinterpret_cast<const bf16x8*>(kb+d0*2048);
    const bf16x8 b1=*reinterpret_cast<const bf16x8*>(kb+d0*2048+512);
    if(d0==0){p0=__builtin_amdgcn_mfma_f32_32x32x16_bf16(b0,qr[0],negm,0,0,0);p1=__builtin_amdgcn_mfma_f32_32x32x16_bf16(b1,qr[0],negm,0,0,0);}
    else{p0=__builtin_amdgcn_mfma_f32_32x32x16_bf16(b0,qr[d0],p0,0,0,0);p1=__builtin_amdgcn_mfma_f32_32x32x16_bf16(b1,qr[d0],p1,0,0,0);}}
}
typedef __attribute__((address_space(3))) const char* lds_cptr;
typedef short v4i16_t __attribute__((ext_vector_type(4)));
__device__ __forceinline__ void kload8(bf16x8*kf,lds_cptr kp){
  kf[0]=*(const __attribute__((address_space(3))) bf16x8*)(kp);      kf[1]=*(const __attribute__((address_space(3))) bf16x8*)(kp+512);
  kf[2]=*(const __attribute__((address_space(3))) bf16x8*)(kp+2048); kf[3]=*(const __attribute__((address_space(3))) bf16x8*)(kp+2560);
  kf[4]=*(const __attribute__((address_space(3))) bf16x8*)(kp+4096); kf[5]=*(const __attribute__((address_space(3))) bf16x8*)(kp+4608);
  kf[6]=*(const __attribute__((address_space(3))) bf16x8*)(kp+6144); kf[7]=*(const __attribute__((address_space(3))) bf16x8*)(kp+6656);
}
__device__ __forceinline__ void kload2(bf16x8*kf,lds_cptr kp,int j){ kf[2*j]=*(const __attribute__((address_space(3))) bf16x8*)(kp+j*2048); kf[2*j+1]=*(const __attribute__((address_space(3))) bf16x8*)(kp+j*2048+512); }
__device__ __forceinline__ s16x4 vtr(lds_cptr p){ return __builtin_bit_cast(s16x4,__builtin_amdgcn_ds_read_tr16_b64_v4i16((__attribute__((address_space(3))) v4i16_t*)p)); }
__device__ __forceinline__ float rowmax(const f32x16&p0,const f32x16&p1){
  float a=max3f(p0[0],p0[1],p1[0]),b=max3f(p0[2],p0[3],p1[1]);a=max3f(a,p1[2],p1[3]);
  #pragma unroll
  for(int r=4;r<16;r+=4){a=max3f(a,p0[r],p0[r+1]);b=max3f(b,p0[r+2],p0[r+3]);a=max3f(a,p1[r],p1[r+1]);b=max3f(b,p1[r+2],p1[r+3]);}
  const float m=max2f(a,b);
  auto rr=__builtin_amdgcn_permlane32_swap(__float_as_uint(m),__float_as_uint(m),false,false);
  return max2f(__uint_as_float(rr[0]),__uint_as_float(rr[1]));
}
__device__ __forceinline__ void pv(f32x16*o,int vb,bf16x8 pa0,bf16x8 pa1,bf16x8 pa2,bf16x8 pa3){
  #pragma unroll
  for(int d0=0;d0<2;++d0){s16x4 lo[4],hi[4];
    #pragma unroll
    for(int ks=0;ks<4;++ks){
      asm volatile("ds_read_b64_tr_b16 %0,%1 offset:%c2":"=&v"(lo[ks]):"v"(vb),"i"(d0*4096+ks*1024):"memory");
      asm volatile("ds_read_b64_tr_b16 %0,%1 offset:%c2":"=&v"(hi[ks]):"v"(vb),"i"(d0*4096+ks*1024+512):"memory");}
    asm volatile("s_waitcnt lgkmcnt(0)":::"memory");SBAR();
    #define PK(k) (bf16x8){lo[k][0],lo[k][1],lo[k][2],lo[k][3],hi[k][0],hi[k][1],hi[k][2],hi[k][3]}
    o[d0]=__builtin_amdgcn_mfma_f32_32x32x16_bf16(pa0,PK(0),o[d0],0,0,0);
    o[d0]=__builtin_amdgcn_mfma_f32_32x32x16_bf16(pa1,PK(1),o[d0],0,0,0);
    o[d0]=__builtin_amdgcn_mfma_f32_32x32x16_bf16(pa2,PK(2),o[d0],0,0,0);
    o[d0]=__builtin_amdgcn_mfma_f32_32x32x16_bf16(pa3,PK(3),o[d0],0,0,0);
    #undef PK
  }
}

#ifndef ATTN_STORE16
#define ATTN_STORE16(p,v) (*(u32x4*)(p)=(v))
#endif
template<int MODE,int NMASKT,int THRL> __device__ __forceinline__ void attn_unit(const bf16*Q0,const bf16*__restrict__ Kh,const bf16*__restrict__ Vh,bf16*O0,int NT,int key_first,int q0,bool use_sink,float sink_l2,char*shm){
  const int tid=tid_(),lane=tid&63,r32=lane&31,hi=lane>>5; const int wid=__builtin_amdgcn_readfirstlane(tid>>6);
  const bf16*Qw=Q0+(long)(wid*QBLK)*QP;
  auto krow=[&](int t)->long{ if(MODE==0) return (long)key_first+64*t; if(t<4) return (long)NSEQ+64*t; int p=q0-128+64*(t-4); p=p<0?0:(p>NSEQ-64?NSEQ-64:p); return (long)p; };
  const unsigned lds0=(unsigned)(uintptr_t)shm;
  float*wsf=(float*)(shm+LDS_WS)+wid*64;
  const bf16*ksrc=Kh+(long)lane*KP+wid*8;
  const bf16*vsrc=Vh+(long)(16*(wid&3)+(lane>>2))*KP+(wid>>2)*32+(lane&3)*8;
  const unsigned kdst=lds0+LDS_K+wid*1024, vdst=lds0+LDS_V+wid*1024;
  #define DMA_K(t,slot) glds16(ksrc+krow(t)*KP,(unsigned)__builtin_amdgcn_readfirstlane(kdst+(slot)))
  #define DMA_V(t,slot) glds16(vsrc+krow(t)*KP,(unsigned)__builtin_amdgcn_readfirstlane(vdst+(slot)))
  const int vb0=(int)(lds0+LDS_V)+((lane>>4)&1)*32+(lane&3)*8+(4*hi+((lane&15)>>2))*64;
  const char*Kbase=shm+LDS_K; bf16x8 kf[8];
  const lds_cptr shm3=(lds_cptr)shm; const lds_cptr kp0=shm3+LDS_K+hi*1024+r32*16; const lds_cptr vp0=shm3+LDS_V+((lane>>4)&1)*32+(lane&3)*8+(4*hi+((lane&15)>>2))*64;
  DMA_K(0,0);DMA_V(0,0);DMA_K(1,SLOTB);
  bf16x8 qr[4];
  #pragma unroll
  for(int d0=0;d0<4;++d0)qr[d0]=*reinterpret_cast<const bf16x8*>(&Qw[(long)r32*QP+d0*16+hi*8]);
  float mhat=0.f,l_reg=0.f;f32x16 o[2];o[0]=f32x16{};o[1]=f32x16{};f32x16 negm=f32x16{};asm volatile("":"+v"(negm));
  const int qrel=wid*QBLK+r32;
  #define CMASK(P0,P1,t) do{ if(NMASKT>0){int jb_=(t)-(NT-NMASKT); if(jb_>=0)wmask(P0,P1,jb_,qrel,hi,q0);} }while(0)
  bool resc=false;
  #define START(P0,P1) do{ const float rm=rowmax(P0,P1); resc=false; \
    { const float dl=rm; mhat=fadd_s(mhat,dl); \
      _Pragma("unroll") for(int r=0;r<16;++r){P0[r]=fsub_s(P0[r],dl);P1[r]=fsub_s(P1[r],dl);} \
      _Pragma("unroll") for(int r=0;r<16;++r)negm[r]=-mhat; asm volatile("":"+v"(negm)); } \
    _Pragma("unroll") for(int r=0;r<16;++r)P0[r]=__builtin_amdgcn_exp2f(P0[r]); }while(0)
  #define RESC() do{ if(resc){ asm volatile("s_waitcnt lgkmcnt(0)":::"memory"); \
      _Pragma("unroll") for(int d_=0;d_<2;++d_) _Pragma("unroll") for(int r=0;r<16;++r)o[d_][r]*=wsf[crow(r,hi)]; } }while(0)
  f32x16 pA0,pA1,pB0,pB1;
  int sl_prev=0,sl_cur=0,sl_next=SLOTB;
  #define ROT() do{sl_prev=sl_cur;sl_cur=sl_next;sl_next=(sl_next==(NSLOT-1)*SLOTB)?0:sl_next+SLOTB;}while(0)
  DMA_K(2,2*SLOTB);
  WAIT_BAR(3);
  qkt(pA0,pA1,Kbase,qr,negm,r32,hi);asm volatile("s_nop 15\n\ts_nop 7":"+v"(pA0),"+v"(pA1));CMASK(pA0,pA1,0);
  START(pA0,pA1);
  _Pragma("unroll") for(int r=0;r<16;++r)pA1[r]=__builtin_amdgcn_exp2f(pA1[r]);
  WAIT_BAR(0);
  DMA_K(3,0);DMA_V(1,SLOTB);
  ROT();
  kload8(kf,kp0+sl_cur);
  WAIT_BAR(2);
  s16x4 vlo[8],vhi[8]; u32x4 pw0,pw1,pw2,pw3;
  #define PKW(P,B) cvtpk_s(P[B],P[B+1])
  #define PAF(k) __builtin_bit_cast(bf16x8,pw##k)
  #define VFR(i) (bf16x8){vlo[i][0],vlo[i][1],vlo[i][2],vlo[i][3],vhi[i][0],vhi[i][1],vhi[i][2],vhi[i][3]}
  #define PIN(x) asm volatile("":"+v"(x))
  #define MX3(a,b,c) __builtin_fmaxf(__builtin_fmaxf((a),(b)),(c))
  #define GAPA(MF,A0,A1,A2,A3,W0,W1,PW) do{ MF; sacc+=A0; sacc+=A1; sacc+=A2; sacc+=A3; PIN(sacc); W0; W1; PIN(PW); SBAR(); }while(0)
  #define EX(v) __builtin_amdgcn_exp2f(v)
  #define GAPB(MF,X,B) do{ MF; X[B]=EX(X[B]); X[B+1]=EX(X[B+1]); X[B+2]=EX(X[B+2]); X[B+3]=EX(X[B+3]); PIN(X); SBAR(); }while(0)
  #define VRD(i) do{ vlo[i]=vtr(vp_+(((i)>>2)*4096+((i)&3)*1024)); vhi[i]=vtr(vp_+(((i)>>2)*4096+((i)&3)*1024+512)); }while(0)
  #define KRD(G,j) do{ if(G){ kload2(kf,kp0+sl_next,j); SBAR(); } }while(0)
  #define STEP(C0,C1,P0,P1,t,GK,GV,GL) do{ SBAR(); \
    const lds_cptr vp_=vp0+sl_prev; \
    VRD(0); SBAR(); float sacc=(P0[0]+P0[1]); \
    GAPA(C0=__builtin_amdgcn_mfma_f32_32x32x16_bf16(kf[0],qr[0],negm,0,0,0), P0[2],P0[3],P0[4],P0[5],     pw0[0]=PKW(P0,0), pw0[1]=PKW(P0,2), pw0); \
    VRD(4); SBAR(); GAPA(C1=__builtin_amdgcn_mfma_f32_32x32x16_bf16(kf[1],qr[0],negm,0,0,0), P0[6],P0[7],P0[8],P0[9],     pw0[2]=PKW(P0,4), pw0[3]=PKW(P0,6), pw0); \
    VRD(1); SBAR(); GAPA(C0=__builtin_amdgcn_mfma_f32_32x32x16_bf16(kf[2],qr[1],C0,0,0,0),   P0[10],P0[11],P0[12],P0[13], pw1[0]=PKW(P0,8), pw1[1]=PKW(P0,10), pw1); \
    VRD(5); SBAR(); GAPA(C1=__builtin_amdgcn_mfma_f32_32x32x16_bf16(kf[3],qr[1],C1,0,0,0),   P0[14],P0[15],P1[0],P1[1],   pw1[2]=PKW(P0,12),pw1[3]=PKW(P0,14), pw1); \
    VRD(2); SBAR(); GAPA(C0=__builtin_amdgcn_mfma_f32_32x32x16_bf16(kf[4],qr[2],C0,0,0,0),   P1[2],P1[3],P1[4],P1[5],     pw2[0]=PKW(P1,0), pw2[1]=PKW(P1,2), pw2); \
    VRD(6); SBAR(); GAPA(C1=__builtin_amdgcn_mfma_f32_32x32x16_bf16(kf[5],qr[2],C1,0,0,0),   P1[6],P1[7],P1[8],P1[9],     pw2[2]=PKW(P1,4), pw2[3]=PKW(P1,6), pw2); \
    VRD(3); SBAR(); GAPA(C0=__builtin_amdgcn_mfma_f32_32x32x16_bf16(kf[6],qr[3],C0,0,0,0),   P1[10],P1[11],P1[12],P1[13], pw3[0]=PKW(P1,8), pw3[1]=PKW(P1,10), pw3); \
    VRD(7); SBAR(); GAPA(C1=__builtin_amdgcn_mfma_f32_32x32x16_bf16(kf[7],qr[3],C1,0,0,0),   P1[14],P1[15],0.f,0.f,       pw3[2]=PKW(P1,12),pw3[3]=PKW(P1,14), pw3); \
    l_reg+=sacc; \
    if(GK){DMA_K((t)+3,sl_cur);} if(GV){DMA_V((t)+1,sl_next);} \
    CMASK(C0,C1,t); \
    { float a=MX3(C0[0],C0[1],C1[0]),b=MX3(C0[2],C0[3],C1[1]); a=MX3(a,C1[2],C1[3]); \
      _Pragma("unroll") for(int r=4;r<16;r+=4){a=MX3(a,C0[r],C0[r+1]);b=MX3(b,C0[r+2],C0[r+3]);a=MX3(a,C1[r],C1[r+1]);b=MX3(b,C1[r+2],C1[r+3]);} \
      float rm=__builtin_fmaxf(a,b); { auto rr=__builtin_amdgcn_permlane32_swap(__float_as_uint(rm),__float_as_uint(rm),false,false); rm=__builtin_fmaxf(__uint_as_float(rr[0]),__uint_as_float(rr[1])); } \
      resc=false; \
      if(__builtin_expect(__any(rm>(float)THRL),0)){ const float dl=__builtin_fmaxf(rm,0.f); mhat+=dl; \
        _Pragma("unroll") for(int r=0;r<16;++r){C0[r]-=dl;C1[r]-=dl;} \
        _Pragma("unroll") for(int r=0;r<16;++r)negm[r]=-mhat; asm volatile("":"+v"(negm)); \
        const float f=__builtin_amdgcn_exp2f(-dl); l_reg*=f; if(hi==0)wsf[r32]=f; resc=true; } } \
    SBAR(); \
    GAPB(o[0]=__builtin_amdgcn_mfma_f32_32x32x16_bf16(PAF(0),VFR(0),o[0],0,0,0), C0,0); \
    GAPB(o[1]=__builtin_amdgcn_mfma_f32_32x32x16_bf16(PAF(0),VFR(4),o[1],0,0,0), C0,4); \
    KRD(GL,0); GAPB(o[0]=__builtin_amdgcn_mfma_f32_32x32x16_bf16(PAF(1),VFR(1),o[0],0,0,0), C0,8); \
    KRD(GL,1); GAPB(o[1]=__builtin_amdgcn_mfma_f32_32x32x16_bf16(PAF(1),VFR(5),o[1],0,0,0), C0,12); \
    KRD(GL,2); GAPB(o[0]=__builtin_amdgcn_mfma_f32_32x32x16_bf16(PAF(2),VFR(2),o[0],0,0,0), C1,0); \
    KRD(GL,3); GAPB(o[1]=__builtin_amdgcn_mfma_f32_32x32x16_bf16(PAF(2),VFR(6),o[1],0,0,0), C1,4); \
    GAPB(o[0]=__builtin_amdgcn_mfma_f32_32x32x16_bf16(PAF(3),VFR(3),o[0],0,0,0), C1,8); \
    GAPB(o[1]=__builtin_amdgcn_mfma_f32_32x32x16_bf16(PAF(3),VFR(7),o[1],0,0,0), C1,12); \
    }while(0)
  int t=1;
  #undef CMASK
  #define CMASK(P0,P1,t) do{}while(0)
  for(;t+1+(NMASKT>4?NMASKT:4)<NT;t+=2){
    STEP(pB0,pB1,pA0,pA1,t,true,true,true);     WAIT_BAR(2); RESC(); ROT();
    STEP(pA0,pA1,pB0,pB1,t+1,true,true,true);   WAIT_BAR(2); RESC(); ROT();
  }
  #undef CMASK
  #define CMASK(P0,P1,t) do{ if(NMASKT>0){int jb_=(t)-(NT-NMASKT); if(jb_>=0)wmask(P0,P1,jb_,qrel,hi,q0);} }while(0)
  #define ENDW(tt) do{ if((tt)+3<NT){WAIT_BAR(2);} else if((tt)+2<NT){WAIT_BAR(1);} else {WAIT_BAR(0);} }while(0)
  for(;t+1<NT;t+=2){
    STEP(pB0,pB1,pA0,pA1,t,(t+3<NT),(t+1<NT),(t+1<NT));       ENDW(t);   RESC(); ROT();
    STEP(pA0,pA1,pB0,pB1,t+1,(t+4<NT),(t+2<NT),(t+2<NT));     ENDW(t+1); RESC(); ROT();
  }
  STEP(pB0,pB1,pA0,pA1,NT-1,false,false,false); RESC();
  { float sacc=pB0[0]+pB0[1]; _Pragma("unroll") for(int r=2;r<16;++r)sacc+=pB0[r]; _Pragma("unroll") for(int r=0;r<16;++r)sacc+=pB1[r]; l_reg+=sacc;
    pw0=(u32x4){PKW(pB0,0),PKW(pB0,2),PKW(pB0,4),PKW(pB0,6)};pw1=(u32x4){PKW(pB0,8),PKW(pB0,10),PKW(pB0,12),PKW(pB0,14)};pw2=(u32x4){PKW(pB1,0),PKW(pB1,2),PKW(pB1,4),PKW(pB1,6)};pw3=(u32x4){PKW(pB1,8),PKW(pB1,10),PKW(pB1,12),PKW(pB1,14)};
    SBAR(); pv(o,vb0+sl_cur,PAF(0),PAF(1),PAF(2),PAF(3)); }
  #undef PKW
  #undef PAF
  #undef VFR
  #undef PIN
  #undef MX3
  #undef GAPA
  #undef GAPB
  #undef EX
  #undef VRD
  #undef KRD
  #undef STEP
  #undef ENDW
  {auto rr=__builtin_amdgcn_permlane32_swap(__float_as_uint(l_reg),__float_as_uint(l_reg),false,false);l_reg=__uint_as_float(rr[0])+__uint_as_float(rr[1]);}
  if(use_sink)l_reg+=__builtin_amdgcn_exp2f(sink_l2-mhat);
  if(hi==0)wsf[32+r32]=l_reg;asm volatile("s_waitcnt lgkmcnt(0)":::"memory");
  float rli[16];
  #pragma unroll
  for(int r=0;r<16;++r)rli[r]=__builtin_amdgcn_rcpf(wsf[32+crow(r,hi)]);
  bf16*Ow=O0+(long)(wid*QBLK)*OP;
  { bf16*stg=(bf16*)(shm+LDS_OST)+wid*2048;
    #pragma unroll
    for(int r=0;r<16;++r){const int orow=crow(r,hi);
      #pragma unroll
      for(int d0=0;d0<2;++d0)stg[orow*64+d0*32+r32]=__float2bfloat16(o[d0][r]*rli[r]);}
    asm volatile("s_waitcnt lgkmcnt(0)":::"memory");
    #pragma unroll
    for(int i=0;i<4;++i){const int row=i*8+(lane>>3),ch=lane&7; const u32x4 v=*(const u32x4*)(stg+row*64+ch*8); ATTN_STORE16(Ow+(long)row*OP+ch*8,v);} }
  asm volatile("s_waitcnt lgkmcnt(0)\n\ts_barrier":::"memory");
  #undef DMA_K
  #undef DMA_V
  #undef CMASK
  #undef START
  #undef RESC
  #undef ROT
}
constexpr int ATTN_LDS_BYTES=LDS_BYTES;
#undef SBAR
#undef WAIT_BAR
}

__device__ __forceinline__ void ph_attn_f(KP p, int l, unsigned char* lds, bool do_scan = true) {
    if (do_scan) { if (FAST_HGRN) hgrn_scan_f(p); else hgrn_scan(p); }
    using attn_body::bf16;
    bf16* Y = (bf16*)(p->ws + Z_YCAT);
    const bf16* Qg = (const bf16*)(p->ws + Z_QG); const bf16* Qw = (const bf16*)(p->ws + Z_QW); const bf16* Qgc = (const bf16*)(p->ws + Z_QGC); const bf16* Qwc = (const bf16*)(p->ws + Z_QWC);
    const bf16* Kg = (const bf16*)(p->ws + Z_KG); const bf16* Kw = (const bf16*)(p->ws + Z_KW); const bf16* Vg = (const bf16*)(p->ws + Z_VG); const bf16* Vw = (const bf16*)(p->ws + Z_VW);
    const int G = gsz_(), bid = bid_();
    __syncthreads();
    for (int vb = bid; vb < 256; vb += G) {
        const int v = (G == 256) ? (((vb & 7) >> 1) * 64 + (vb & 1) * 32 + (vb >> 3)) : vb;
        const int b = v >> 7, kvh = (v >> 6) & 1, h = kvh * 2 + ((v >> 5) & 1), qb = v & 31, row0 = b * NSEQ + qb * 256;
        const size_t kvo = (size_t)b * NKEY * 128 + kvh * 64;
        attn_body::attn_unit<0, 0, 8>(Qg + (size_t)row0 * 256 + h * 64, Kg + kvo, Vg + kvo, Y + (size_t)row0 * D + h * 64, NKEY / 64, 0, 0, false, 0.f, (char*)lds);
        attn_body::attn_unit<1, 8, 8>(Qw + (size_t)row0 * 256 + h * 64, Kw + kvo, Vw + kvo, Y + (size_t)row0 * D + 512 + h * 64, 12, 0, qb * 256, true, p->in[14][l * 4 + h] * LOG2E, (char*)lds);
    }
    if (l == 0) for (int v = bid; v < 16; v += G) {
        const int h = v & 3, b = (v >> 2) & 1, win = v >> 3, row0 = R_LAT + b * NCTX;
        const size_t kvo = (size_t)b * NKEY * 128 + (h >> 1) * 64;
        attn_body::attn_unit<0, 0, 8>((win ? Qwc : Qgc) + (size_t)(b * NCTX) * 256 + h * 64, (win ? Kw : Kg) + kvo, (win ? Vw : Vg) + kvo, Y + (size_t)row0 * D + (win ? 512 : 0) + h * 64, 4, NSEQ, 0, win != 0, p->in[14][l * 4 + h] * LOG2E, (char*)lds);
    }
}

__device__ __forceinline__ void hgrn_pass3_unit(KP p, int l, unsigned char* lds, int unit) {
    float* qs = (float*)lds; float* vs = qs + 4096; float* ks = vs + 4096; float* cs = ks + 4096; float* Ss = cs + 4096; float* sc = Ss + 4096; float* os = sc + 4096;
    const int tid = tid_(), lane = tid & 63, wid = tid >> 6;
    const int cpos = unit % NCHUNK, head = (unit / NCHUNK) & 3, b = unit / (NCHUNK * 4);
    const int row0 = (cpos < 4) ? R_LAT + b * NCTX + cpos * 64 : b * NSEQ + (cpos - 4) * 64;
    for (int i = tid; i < 4096; i += NTHREADS) os[i] = 0.f;
    for (int dir = 0; dir < 2; ++dir) {
        const int j = (cpos < 4) ? (dir ? 3 - cpos : cpos) : 4 + (dir ? 127 - (cpos - 4) : (cpos - 4));
        const int seq = (b * 4 + head) * 2 + dir;
        __syncthreads();
        hgrn_load_chunk(p, l, row0, dir, head, qs, vs, ks, cs);
        const float* Sg = (const float*)(p->ws + Z_U) + ((size_t)seq * NCHUNK + j) * 4096;
        for (int i = tid; i < 4096; i += NTHREADS) Ss[i] = Sg[i];
        for (int i = tid; i < 4096; i += NTHREADS) { const int tau = i >> 6, sig = i & 63; float a = 0.f;
            if (sig <= tau) { for (int d = 0; d < 64; ++d) a += qs[tau * 64 + d] * ks[sig * 64 + d] * __expf(cs[tau * 64 + d] - cs[sig * 64 + d]); }
            sc[i] = a; }
        __syncthreads();
        { const int tau = tid >> 3, e0 = (tid & 7) * 8; float acc[8];
#pragma unroll
          for (int e = 0; e < 8; ++e) acc[e] = 0.f;
          for (int d = 0; d < 64; ++d) { const float qv = qs[tau * 64 + d] * __expf(cs[tau * 64 + d]);
#pragma unroll
              for (int e = 0; e < 8; ++e) acc[e] += qv * Ss[d * 64 + e0 + e]; }
          for (int sig = 0; sig <= tau; ++sig) { const float sv = sc[tau * 64 + sig];
#pragma unroll
              for (int e = 0; e < 8; ++e) acc[e] += sv * vs[sig * 64 + e0 + e]; }
          const int tok = dir ? 63 - tau : tau;
#pragma unroll
          for (int e = 0; e < 8; ++e) os[tok * 64 + e0 + e] += acc[e]; }
        __syncthreads();
    }
    const bf16_t* P = (const bf16_t*)(p->ws + Z_P); bf16_t* Y = (bf16_t*)(p->ws + Z_YCAT);
    for (int tok = wid; tok < 64; tok += 8) { const float v = os[tok * 64 + lane];
        const float y = v * rsqrtf(wave_sum(v * v) * (1.f / 64.f) + EPS) * p->in[22][l * 64 + lane];
        const float g = bf2f(P[(size_t)(row0 + tok) * DIN + C_RG + head * 64 + lane]);
        Y[(size_t)(row0 + tok) * D + 768 + head * 64 + lane] = (bf16_t)f2bf(y * silu_(g)); }
    __syncthreads();
}
__device__ __forceinline__ void ph_hgrn3(KP p, int l, unsigned char* lds) {
    hgrn_pass3_run(p, l, lds);
    if (l == 0 && DEPTH > 1 && gsz_() == 256) { __syncthreads(); ph_cvt(p, 1, lds, 32, 224, CVT_E1, CVT_E2); }
}

__device__ __forceinline__ void ph_outproj(KP p, int l, unsigned char* lds) {
    const bf16_t* A = (const bf16_t*)(p->ws + Z_YCAT); const bf16_t* Bt = (const bf16_t*)(p->ws + Z_WOUT); float* X = (float*)(p->ws + WS_X);
    const int T = (l == 0) ? R_ALL : R_LAT; const int TM = T / 128, TN = 8;
    for (int it = bid_(); it < TM * TN; it += gsz_()) { const int mt = it / TN, nt = it % TN;
        auto epi = [&](int row, int col, float v, float) { const int c = nt * 128 + col; X[(size_t)row * D + c] = xrow_src(p, l, row)[c] + mod_vec(p, l, row, 2)[c] * v; };
        gemm_simple_tile<1>(A, RowId{}, Bt, 1024, mt * 128, nt * 128, 0, epi); }
}

__device__ __forceinline__ void ph_norm2(KP p, int l, unsigned char* lds, int cnt_off = 0) {
    constexpr int RS = 1032, NSTG = 80;
    const int T = (l == 0) ? R_ALL : R_LAT;
    bf16_t* AH = (bf16_t*)lds; bf16_t* AL = AH + 16 * RS;
    float* PART = (float*)(lds + 2 * 16 * RS * 2); float* LOG = PART + 8 * 16 * 64;
    int* hist = (int*)(LOG + 16 * 64); int* hbase = hist + 64; int* s_e = hbase + 64; int* s_r = s_e + NSTG * 8; float* s_w = (float*)(s_r + NSTG * 8); float* msb = s_w + NSTG * 8;
    const int tid = tid_(), lane = tid & 63, wid = tid >> 6, fr = lane & 15, fq = lane >> 4, bid = bid_(), G = gsz_();
    bf16_t* Tok = (bf16_t*)(p->ws + Z_A); const bf16_t* X = (const bf16_t*)(p->ws + WS_X);
    const float* g2 = p->in[7] + l * D; const float* rw = p->in[23] + (size_t)l * 1024 * 64; const float* rbias = p->in[24] + l * 64;
    unsigned* cnt = (unsigned*)(p->ws + WS_CTL) + CW_CNT + cnt_off + l * 64;
    int* tok_e = (int*)(p->ws + WS_TOKE); int* tok_p = (int*)(p->ws + WS_TOKP); int* expl = (int*)(p->ws + WS_EXPL); float* expw = (float*)(p->ws + WS_EXPW);
    bf16x8 bh[4][4], bl[4][4];
    { const u32x4* RF = (const u32x4*)(p->ws + WS_RFRAG) + (size_t)((l * 8 + wid) * 16) * 128 + lane * 2;
#pragma unroll
      for (int t = 0; t < 4; ++t)
#pragma unroll
          for (int k = 0; k < 4; ++k) { bh[t][k] = __builtin_bit_cast(bf16x8, RF[(t * 4 + k) * 128]); bl[t][k] = __builtin_bit_cast(bf16x8, RF[(t * 4 + k) * 128 + 1]); } }
    const float mybias = rbias[lane];
    const int rpb = (T + G - 1) / G;
    for (int base = bid * rpb; base < T; base += G * rpb) {
        const int r1 = (base + rpb < T) ? base + rpb : T;
        if (tid < 64) hist[tid] = 0;
        for (int s0 = base; s0 < r1; s0 += 16) {
#pragma unroll
            for (int j2 = 0; j2 < 2; ++j2) { const int lr = wid * 2 + j2, row = s0 + lr;
                if (row < r1) {
                    const bf16_t* xrow = X + (size_t)row * D; const float* shift = mod_vec(p, l, row, 3); const float* scale = mod_vec(p, l, row, 4);
                    f32x4 v[4]; float ssq = 0.f;
#pragma unroll
                    for (int j = 0; j < 4; ++j) { const u32x2 r2 = ((const u32x2*)xrow)[lane + 64 * j]; v[j].x = bf2f(r2.x & 0xffffu); v[j].y = bf2f(r2.x >> 16); v[j].z = bf2f(r2.y & 0xffffu); v[j].w = bf2f(r2.y >> 16); ssq += v[j].x * v[j].x + v[j].y * v[j].y + v[j].z * v[j].z + v[j].w * v[j].w; }
                    const float rinv = rsqrtf(wave_sum(ssq) * (1.f / D) + EPS);
#pragma unroll
                    for (int j = 0; j < 4; ++j) { const int idx = lane + 64 * j;
                        const f32x4 gg = ((const f32x4*)g2)[idx], sh = ((const f32x4*)shift)[idx], sc = ((const f32x4*)scale)[idx];
                        f32x4 y; y.x = v[j].x * rinv * gg.x * (1.f + sc.x) + sh.x; y.y = v[j].y * rinv * gg.y * (1.f + sc.y) + sh.y;
                        y.z = v[j].z * rinv * gg.z * (1.f + sc.z) + sh.z; y.w = v[j].w * rinv * gg.w * (1.f + sc.w) + sh.w;
                        u32x2 h; h.x = pk2(y.x, y.y); h.y = pk2(y.z, y.w);
                        u32x2 lw; lw.x = pk2(y.x - bf2f(h.x & 0xffffu), y.y - bf2f(h.x >> 16)); lw.y = pk2(y.z - bf2f(h.y & 0xffffu), y.w - bf2f(h.y >> 16));
                        { int t8 = __builtin_amdgcn_cvt_pk_fp8_f32(clamp8(y.x * TOK8_SCALE), clamp8(y.y * TOK8_SCALE), 0, false); t8 = __builtin_amdgcn_cvt_pk_fp8_f32(clamp8(y.z * TOK8_SCALE), clamp8(y.w * TOK8_SCALE), t8, true);
                          ((unsigned*)((unsigned char*)Tok + (size_t)row * D))[idx] = (unsigned)t8; }
                        *(u32x2*)(AH + lr * RS + idx * 4) = h; *(u32x2*)(AL + lr * RS + idx * 4) = lw; }
                } else {
#pragma unroll
                    for (int j = 0; j < 4; ++j) { const int idx = lane + 64 * j; const u32x2 z = {0u, 0u}; *(u32x2*)(AH + lr * RS + idx * 4) = z; *(u32x2*)(AL + lr * RS + idx * 4) = z; } } }
            __syncthreads();
            { f32x4 acc[4];
#pragma unroll
              for (int t = 0; t < 4; ++t) acc[t] = (f32x4){0.f, 0.f, 0.f, 0.f};
#pragma unroll
              for (int k = 0; k < 4; ++k) { const int ko = (wid * 4 + k) * 32 + fq * 8;
                  const bf16x8 ah = *(const bf16x8*)(AH + fr * RS + ko), al = *(const bf16x8*)(AL + fr * RS + ko);
#pragma unroll
                  for (int t = 0; t < 4; ++t) { acc[t] = __builtin_amdgcn_mfma_f32_16x16x32_bf16(ah, bh[t][k], acc[t], 0, 0, 0);
                      acc[t] = __builtin_amdgcn_mfma_f32_16x16x32_bf16(ah, bl[t][k], acc[t], 0, 0, 0); acc[t] = __builtin_amdgcn_mfma_f32_16x16x32_bf16(al, bh[t][k], acc[t], 0, 0, 0); } }
#pragma unroll
              for (int t = 0; t < 4; ++t)
#pragma unroll
                  for (int r = 0; r < 4; ++r) PART[(wid * 16 + fq * 4 + r) * 64 + t * 16 + fr] = acc[t][r]; }
            __syncthreads();
#pragma unroll
            for (int q = 0; q < 2; ++q) { const int o = tid + q * NTHREADS; float a = 0.f;
#pragma unroll
                for (int w8 = 0; w8 < 8; ++w8) a += PART[w8 * 1024 + o];
                LOG[o] = a; }
            __syncthreads();
#pragma unroll 1
            for (int j2 = 0; j2 < 2; ++j2) { const int lr = wid * 2 + j2, row = s0 + lr;
                if (row >= r1) continue;
                const int sr = row - base;
                const float score = sigmoid_(LOG[lr * 64 + lane]), sel = score + mybias;
                const int e = lane, g = e >> 3;
                int rg = 0;
#pragma unroll
                for (int i = 1; i < 8; ++i) { const int src = (lane & ~7) | ((lane + i) & 7); const float o = __shfl(sel, src); rg += (o > sel) || (o == sel && src < e); }
                float top2 = (rg < 2) ? sel : 0.f;
                top2 += __shfl_xor(top2, 1); top2 += __shfl_xor(top2, 2); top2 += __shfl_xor(top2, 4);
                int grank = 0;
#pragma unroll
                for (int i = 1; i < 8; ++i) { const int og = (g + i) & 7; const float o = __shfl(top2, og * 8); grank += (o > top2) || (o == top2 && og < g); }
                const bool keep = grank < 4;
                const float ms = keep ? sel : -INFINITY;
                float* mrow = msb + wid * 64;
                mrow[lane] = ms;
                __builtin_amdgcn_wave_barrier();
                int rk = 0;
#pragma unroll 4
                for (int i = 0; i < 16; ++i) { const f32x4 o = *(const f32x4*)(mrow + 4 * i);
                    rk += (o.x > ms) || (o.x == ms && 4 * i + 0 < e); rk += (o.y > ms) || (o.y == ms && 4 * i + 1 < e);
                    rk += (o.z > ms) || (o.z == ms && 4 * i + 2 < e); rk += (o.w > ms) || (o.w == ms && 4 * i + 3 < e); }
                __builtin_amdgcn_wave_barrier();
                const bool chosen = keep && rk < 8;
                const float wsum = wave_sum(chosen ? score : 0.f);
                if (chosen) { const int r = atomicAdd(&hist[e], 1); s_e[sr * 8 + rk] = e; s_r[sr * 8 + rk] = r; s_w[sr * 8 + rk] = score / wsum * 2.5f; } }
        }
        __syncthreads();
        if (tid < 64) { const int h = hist[tid]; hbase[tid] = h ? (int)atomicAdd(&cnt[tid], (unsigned)h) : 0; }
        __syncthreads();
        for (int i = tid; i < (r1 - base) * 8; i += NTHREADS) { const int e = s_e[i]; const size_t o = (size_t)base * 8 + i;
            const int pos = hbase[e] + s_r[i]; tok_e[o] = e; tok_p[o] = pos; expl[(size_t)e * R_ALL + pos] = base + (i >> 3); expw[(size_t)e * R_ALL + pos] = s_w[i]; }
        __syncthreads();
    }
}

__device__ __forceinline__ void moe_pad_starts(KP p, int l, int* ps) {
    const unsigned* cnt = (const unsigned*)(p->ws + WS_CTL) + CW_CNT + l * 64;
    const int tid = tid_();
    if (tid < 64) { const int v = (int)((cnt[tid] + 255u) >> 8) << 8; int incl = v;
#pragma unroll
        for (int d = 1; d < 64; d <<= 1) { const int o = __shfl_up(incl, d); if (tid >= d) incl += o; }
        ps[tid] = incl - v; if (tid == 63) ps[64] = incl; }
    __syncthreads();
}
__device__ __forceinline__ int moe_expert_of_row(const int* ps, int row) { int e = 0;
#pragma unroll
    for (int step = 32; step >= 1; step >>= 1) if (row >= ps[e + step]) e += step;
    return e; }

__device__ __forceinline__ void ph_slots(KP p, int l, unsigned char* lds) {
    const int T = (l == 0) ? R_ALL : R_LAT;
    int* ps = (int*)lds; moe_pad_starts(p, l, ps);
    const unsigned* cnt = (const unsigned*)(p->ws + WS_CTL) + CW_CNT + l * 64;
    const int* tok_e = (const int*)(p->ws + WS_TOKE); const int* tok_p = (const int*)(p->ws + WS_TOKP); const float* tok_w = (const float*)(p->ws + WS_TOKW);
    int* tok_s = (int*)(p->ws + WS_TOKS); int* slot_t = (int*)(p->ws + WS_SLOTT); float* slot_w = (float*)(p->ws + WS_SLOTW);
    for (int i = bid_() * NTHREADS + tid_(); i < T * 8; i += gsz_() * NTHREADS) { const int e = tok_e[i], slot = ps[e] + tok_p[i]; tok_s[i] = slot; slot_t[slot] = i >> 3; slot_w[slot] = tok_w[i]; }
    for (int i = bid_() * NTHREADS + tid_(); i < T; i += gsz_() * NTHREADS) { slot_t[MAXSLOT + i] = i; slot_w[MAXSLOT + i] = 1.f; }
    for (int i = bid_() * NTHREADS + tid_(); i < 64 * 256; i += gsz_() * NTHREADS) { const int e = i >> 8, j = i & 255; const int r = ps[e] + (int)cnt[e] + j; if (r < ps[e + 1]) { slot_t[r] = 0; slot_w[r] = 0.f; } }
    __syncthreads();
}

__device__ __forceinline__ void ph_gateup(KP p, int l, unsigned char* lds) {
    const int T = (l == 0) ? R_ALL : R_LAT;
    int* ps = (int*)lds; moe_pad_starts(p, l, ps);
    const bf16_t* Tok = (const bf16_t*)(p->ws + Z_A); const bf16_t* Wgu = (const bf16_t*)(p->ws + Z_WGU); bf16_t* H = (bf16_t*)(p->ws + Z_H);
    const int* slot_t = (const int*)(p->ws + WS_SLOTT); const float* slot_w = (const float*)(p->ws + WS_SLOTW);
    const int n128 = ps[64] / 128, nitems = (n128 + T / 128) * 2;
    for (int it = bid_(); it < nitems; it += gsz_()) { const int rt = it >> 1, pn = it & 1;
        if (rt < n128) { const int e = moe_expert_of_row(ps, rt * 128);
            auto epi = [&](int row, int col, float g, float u) { H[(size_t)row * 256 + pn * 128 + col] = (bf16_t)f2bf(silu_(g) * u * slot_w[row]); };
            gemm_simple_tile<2>(Tok, RowGather{slot_t}, Wgu + (size_t)e * 524288, 1024, rt * 128, pn * 256, 128, epi);
        } else { const int t0 = (rt - n128) * 128;
            auto epi = [&](int row, int col, float g, float u) { H[(size_t)(MAXSLOT + row) * 256 + pn * 128 + col] = (bf16_t)f2bf(silu_(g) * u); };
            gemm_simple_tile<2>(Tok, RowId{}, Wgu + (size_t)64 * 524288, 1024, t0, pn * 256, 128, epi); }
    }
}
__device__ __forceinline__ void ph_down(KP p, int l, unsigned char* lds) {
    const int T = (l == 0) ? R_ALL : R_LAT;
    int* ps = (int*)lds; moe_pad_starts(p, l, ps);
    const bf16_t* H = (const bf16_t*)(p->ws + Z_H); const bf16_t* Wd = (const bf16_t*)(p->ws + WS_WD); bf16_t* Y = (bf16_t*)(p->ws + Z_Y); float* X = (float*)(p->ws + WS_X);
    const int n128 = ps[64] / 128, nitems = (n128 + T / 128) * 8;
    for (int it = bid_(); it < nitems; it += gsz_()) { const int rt = it >> 3, nt = it & 7;
        if (rt < n128) { const int e = moe_expert_of_row(ps, rt * 128);
            auto epi = [&](int row, int col, float v, float) { Y[(size_t)row * D + nt * 128 + col] = (bf16_t)f2bf(v); };
            gemm_simple_tile<1>(H, RowId{}, Wd + (size_t)e * 262144, 256, rt * 128, nt * 128, 0, epi);
        } else { const int t0 = (rt - n128) * 128;
            auto epi = [&](int row, int col, float v, float) { const int t = row - MAXSLOT, c = nt * 128 + col; X[(size_t)t * D + c] += mod_vec(p, l, t, 5)[c] * v; };
            gemm_simple_tile<1>(H, RowId{}, Wd + (size_t)64 * 262144, 256, MAXSLOT + t0, nt * 128, 0, epi); }
    }
}
__device__ __forceinline__ void ph_combine(KP p, int l, unsigned char* lds) {
    typedef float f32x2 __attribute__((ext_vector_type(2)));
    const int T = (l == 0) ? R_ALL : R_LAT;
    const int tid = tid_(), lane = tid & 63, wid = tid >> 6;
    const unsigned char* Y8 = (const unsigned char*)(p->ws + Z_Y); bf16_t* X = (bf16_t*)(p->ws + WS_X); const int* tok_e = (const int*)(p->ws + WS_TOKE); const int* tok_p = (const int*)(p->ws + WS_TOKP);
    int* ps = (int*)lds; moe_pad_starts(p, l, ps);
    const size_t yoff = (size_t)(lane >> 4) * MAXSLOT * 256 + (lane & 15) * 16;
    for (int row = bid_() * 8 + wid; row < T; row += gsz_() * 8) {
        const float* g5 = mod_vec(p, l, row, 5) + lane * 16;
        bf16_t* xr = X + (size_t)row * D + lane * 16;
        const int myslot = ps[tok_e[row * 8 + (lane & 7)]] + tok_p[row * 8 + (lane & 7)];
        u32x4 yv[8];
#pragma unroll
        for (int k = 0; k < 8; ++k) { const int sl = __shfl(myslot, k); yv[k] = *(const u32x4*)(Y8 + yoff + (size_t)sl * 256); }
        f32x4 xv[4], gv[4];
#pragma unroll
        for (int q = 0; q < 4; ++q) gv[q] = *(const f32x4*)(g5 + 4 * q);
        unpack8(*(const u32x4*)xr, xv[0], xv[1]); unpack8(*(const u32x4*)(xr + 8), xv[2], xv[3]);
        float a[16];
#pragma unroll
        for (int q = 0; q < 16; ++q) a[q] = 0.f;
#pragma unroll
        for (int k = 0; k < 8; ++k) { const unsigned w[4] = {yv[k].x, yv[k].y, yv[k].z, yv[k].w};
#pragma unroll
            for (int q = 0; q < 4; ++q) { const f32x2 lo = __builtin_amdgcn_cvt_pk_f32_fp8((int)w[q], false), hi = __builtin_amdgcn_cvt_pk_f32_fp8((int)w[q], true);
                a[4 * q] += lo.x; a[4 * q + 1] += lo.y; a[4 * q + 2] += hi.x; a[4 * q + 3] += hi.y; } }
#pragma unroll
        for (int q = 0; q < 4; ++q) { f32x4 av; av.x = a[4 * q]; av.y = a[4 * q + 1]; av.z = a[4 * q + 2]; av.w = a[4 * q + 3]; xv[q] = xv[q] + gv[q] * (av * (1.f / Y8_SCALE)); }
        if (l == DEPTH - 1) { float* dst = p->out + (size_t)row * D + lane * 16;
#pragma unroll
            for (int q = 0; q < 4; ++q) *(f32x4*)(dst + 4 * q) = xv[q]; }
        else { *(u32x4*)xr = (u32x4){pk2(xv[0].x, xv[0].y), pk2(xv[0].z, xv[0].w), pk2(xv[1].x, xv[1].y), pk2(xv[1].z, xv[1].w)};
               *(u32x4*)(xr + 8) = (u32x4){pk2(xv[2].x, xv[2].y), pk2(xv[2].z, xv[2].w), pk2(xv[3].x, xv[3].y), pk2(xv[3].z, xv[3].w)}; }
    }
}
struct MoeSched {
    int ntr, nrt, npn, G, c; const LAS int* tile_e;
    __device__ __forceinline__ bool map(int i, int& rt, int& pp) const {
        if (G == 256) { const int x = c & 7, j = c >> 3, tb = 32 / npn; rt = (i * 8 + x) * tb + j / npn; pp = j % npn; return rt < nrt; }
        const int L = i * G + c; if (L >= nrt * npn) return false;
        rt = L / npn; pp = L % npn; return true; }
    __device__ __forceinline__ bool next(int i, pg8::Unit& u) const {
        int rt, pp; if (!map(i, rt, pp)) return false;
        const bool routed = rt < ntr;
        const int e = routed ? __builtin_amdgcn_readfirstlane(tile_e[rt]) : 64;
        u.pm = routed ? rt : MAXSLOT / 256 + (rt - ntr); u.pn = e * npn + pp; u.ord = i; return true;
    }
};
constexpr int MOE_UNITS = 6;
constexpr int LDS_RTAB = 131072, LDS_WTAB = LDS_RTAB + MOE_UNITS * 1024, LDS_TILE_E = LDS_WTAB + MOE_UNITS * 1024, LDS_PS = LDS_TILE_E + 2400;
static_assert(LDS_PS + 129 * 4 <= LDS_BYTES - 16, "MoE tables fit above the staging buffers");
__device__ __forceinline__ MoeSched moe_setup(KP p, int l, unsigned char* lds, int npn, bool gather) {
    const int T = (l == 0) ? R_ALL : R_LAT;
    int* ps = (int*)(lds + LDS_PS); int* cl = ps + 65;
    const unsigned* cnt = (const unsigned*)(p->ws + WS_CTL) + CW_CNT + l * 64;
    const int tid = tid_();
    if (tid < 64) cl[tid] = (int)cnt[tid];
    moe_pad_starts(p, l, ps);
    LAS int* tile_e = (LAS int*)((LAS unsigned char*)lds + LDS_TILE_E); LAS int* rtab = (LAS int*)((LAS unsigned char*)lds + LDS_RTAB); LAS float* wtab = (LAS float*)((LAS unsigned char*)lds + LDS_WTAB);
    const int ntr = ps[64] / 256;
    for (int rt = tid; rt < ntr; rt += NTHREADS) tile_e[rt] = moe_expert_of_row(ps, rt * 256);
    __syncthreads();
    MoeSched S{ntr, ntr + T / 256, npn, gsz_(), bid_(), tile_e};
    if (gather) { const int* expl = (const int*)(p->ws + WS_EXPL); const float* expw = (const float*)(p->ws + WS_EXPW);
        int tok[3]; float w[3];
#pragma unroll
        for (int q = 0; q < 3; ++q) { const int idx = tid + q * NTHREADS, i = idx >> 8, r = idx & 255; tok[q] = 0; w[q] = 0.f;
            int rt, pp_;
            if (S.map(i, rt, pp_)) {
                if (rt < S.ntr) { const int e = tile_e[rt], pos = rt * 256 + r - ps[e];
                    if (pos < cl[e]) { tok[q] = expl[(size_t)e * R_ALL + pos]; w[q] = expw[(size_t)e * R_ALL + pos]; } }
                else { tok[q] = (rt - S.ntr) * 256 + r; w[q] = 1.f; } } }
#pragma unroll
        for (int q = 0; q < 3; ++q) { const int idx = tid + q * NTHREADS; rtab[idx] = tok[q]; wtab[idx] = w[q]; } }
    __syncthreads();
    return S;
}
__device__ __forceinline__ void ph_gateup_f(KP p, int l, unsigned char* lds) {
    const MoeSched S = moe_setup(p, l, lds, 2, true);
    pg8::Gemm g{(const bf16_t*)(p->ws + Z_A), (const bf16_t*)(p->ws + wgu_off(l)), 0, 0, 1024};
    pg8::EpiGU8 E{(unsigned char*)(p->ws + Z_H), (const LAS float*)((LAS unsigned char*)lds + LDS_WTAB)};
    pg8::gemm_phase<pg8::EpiGU8, MoeSched, true, true>((LAS unsigned char*)lds, g, S, E, (const LAS int*)((LAS unsigned char*)lds + LDS_RTAB));
}
__device__ __forceinline__ void ph_down_f(KP p, int l, unsigned char* lds) {
    const MoeSched S = moe_setup(p, l, lds, 4, false);
    pg8::Gemm g{(const bf16_t*)(p->ws + Z_H), (const bf16_t*)(p->ws + wd_off(l)), 0, 0, 256};
    bf16_t* X = (bf16_t*)(p->ws + WS_X);
    pg8::EpiDown E{(bf16_t*)(p->ws + Z_Y), X, (const float*)(p->ws + WS_MOD) + (size_t)l * 3 * 6144 + 5 * 1024};
    pg8::gemm_phase<pg8::EpiDown, MoeSched, false, true>((LAS unsigned char*)lds, g, S, E, nullptr);
}

#ifndef FAST_ATTN
#define FAST_ATTN 1
#endif
#ifndef FAST_GEMM
#define FAST_GEMM 15
#endif
constexpr int PH_PER_LAYER = 10, N_PHASES = 1 + DEPTH * PH_PER_LAYER;
__global__ void __launch_bounds__(NTHREADS, 2) mega(Params parg) {
    extern __shared__ __attribute__((aligned(16))) unsigned char lds[];
    const int lo = parg.ph_lo, hi = parg.ph_hi;
    volatile LAS unsigned* xbw = (volatile LAS unsigned*)(lds + LDS_BYTES - 16);
    if (threadIdx.x == 0) { xbw[0] = 0u; xbw[1] = 0u; xbw[2] = 0u; xbw[3] = 0u; }
    if ((threadIdx.x & 63) == 0) *(volatile LAS int*)((LAS unsigned char*)lds + LDS_WVTAB_OFF + 4 * hwkey_()) = (int)(threadIdx.x >> 6);
    __syncthreads();
    XcdBarrier bar; bar.bar = (unsigned*)(parg.ws + WS_CTL) + CW_BAR; bar.x = 0; bar.st = xbw;
    if (hi - lo > 1) bar = xcd_barrier_post((unsigned*)(parg.ws + WS_CTL) + CW_BAR, xbw);
#ifdef PHMASK
#define IN(k) ((((PHMASK) >> ((k) == 0 ? 0 : ((k) - 1) % PH_PER_LAYER + 1)) & 1) && lo <= (k) && (k) < hi)
#else
#define IN(k) (lo <= (k) && (k) < hi)
#endif
#define SEAM(k) do { if (IN(k) && IN((k) + 1)) xcd_barrier(bar); } while (0)
    if (IN(0)) { ph_pro(kparams(), lds); } SEAM(0);
#pragma unroll
    for (int l = 0; l < DEPTH; ++l) {
        const int b0 = 1 + l * PH_PER_LAYER;
        if (IN(b0 + 0)) { ph_norm1(kparams(), l, lds); } SEAM(b0 + 0);
        if (IN(b0 + 1)) { ph_inproj_f(kparams(), l, lds); } SEAM(b0 + 1);
        if (IN(b0 + 2)) { ph_prep(kparams(), l, lds); } SEAM(b0 + 2);
        if (IN(b0 + 3)) { ph_attn_f(kparams(), l, lds); } SEAM(b0 + 3);
        if (IN(b0 + 4)) { ph_hgrn3(kparams(), l, lds); } SEAM(b0 + 4);
        if (IN(b0 + 5)) { ph_outproj_f(kparams(), l, lds); } SEAM(b0 + 5);
        if (IN(b0 + 6)) { ph_norm2(kparams(), l, lds); } SEAM(b0 + 6);
        if (IN(b0 + 7)) { ph_gateup_f(kparams(), l, lds); } SEAM(b0 + 7);
        if (IN(b0 + 8)) { ph_down_f(kparams(), l, lds); } SEAM(b0 + 8);
        if (IN(b0 + 9)) { ph_combine(kparams(), l, lds); } SEAM(b0 + 9);
    }
#undef IN
#undef SEAM
}

#ifndef MK_ONE_LAUNCH
#define MK_ONE_LAUNCH 1
#endif
extern "C" void kernel_launch(void* const* d_in, const int* in_sizes, int n_in, void* d_out, int out_size, void* d_ws, size_t ws_size, hipStream_t stream) {
    static int grid = 0;
    if (grid == 0) {
        if (n_in != 31 || ws_size < WS_END2) { fprintf(stderr, "kernel_launch: unexpected n_in %d or ws_size %zu (< %zu)\n", n_in, ws_size, (size_t)WS_END2); grid = -1; return; }
        int dev = 0, cus = 0, per_cu = 0;
        if (hipGetDevice(&dev) != hipSuccess || hipDeviceGetAttribute(&cus, hipDeviceAttributeMultiprocessorCount, dev) != hipSuccess) { grid = -1; return; }
        if (hipFuncSetAttribute((const void*)mega, hipFuncAttributeMaxDynamicSharedMemorySize, LDS_BYTES) != hipSuccess) { fprintf(stderr, "kernel_launch: hipFuncSetAttribute failed\n"); grid = -1; return; }
        if (hipOccupancyMaxActiveBlocksPerMultiprocessor(&per_cu, (const void*)mega, NTHREADS, LDS_BYTES) != hipSuccess || per_cu < 1) fprintf(stderr, "kernel_launch: occupancy query says %d\n", per_cu);
        (void)hipGetLastError();
        grid = cus;
    }
    if (grid < 0) return;
    (void)hipMemsetAsync((char*)d_ws + WS_CTL, 0, CTL_ZERO_BYTES, stream);
    Params p{};
    for (int i = 0; i < 31; ++i) p.in[i] = (const float*)d_in[i];
    p.out = (float*)d_out; p.ws = (unsigned char*)d_ws;
#if MK_ONE_LAUNCH
    p.ph_lo = 0; p.ph_hi = N_PHASES;
    hipLaunchKernelGGL(mega, dim3(grid), dim3(NTHREADS), LDS_BYTES, stream, p);
#else
    for (int k = 0; k < N_PHASES; ++k) { p.ph_lo = k; p.ph_hi = k + 1; hipLaunchKernelGGL(mega, dim3(grid), dim3(NTHREADS), LDS_BYTES, stream, p); }
#endif
}
```

```cpp
#include <hip/hip_runtime.h>
#include <hip/hip_bf16.h>
#include <cmath>
#include <cstdint>
#include <cstdio>

#define LAS __attribute__((address_space(3)))

typedef unsigned short bf16_t;
typedef short bf16x8 __attribute__((ext_vector_type(8)));
typedef float f32x4 __attribute__((ext_vector_type(4)));
typedef unsigned u32x4 __attribute__((ext_vector_type(4)));
typedef unsigned u32x2 __attribute__((ext_vector_type(2)));

constexpr int D = 1024, NB = 2, NSEQ = 8192, NCTX = 256, DEPTH = 2;
constexpr int R_LAT = NB * NSEQ, R_CTX = NB * NCTX, R_ALL = R_LAT + R_CTX;
constexpr int DIN = 2816;
constexpr int NKEY = NSEQ + NCTX;
constexpr int NE = 64, TOPK = 8;
constexpr int MAXSLOT = 151552;
constexpr int HROWS = MAXSLOT + R_ALL;
constexpr int NCHUNK = 132;
constexpr float EPS = 1e-6f;
constexpr float TOK8_SCALE = 8.f, WGU8_SCALE = 256.f, H8_SCALE = 16.f, WD8_SCALE = 128.f;
constexpr float GU_DESCALE = 1.f / (TOK8_SCALE * WGU8_SCALE), DN_DESCALE = 1.f / (H8_SCALE * WD8_SCALE);
constexpr float Y8_SCALE = 32.f;
constexpr float QSCALE = 0.125f * 1.4426950408889634f;
constexpr float LOG2E = 1.4426950408889634f;

#ifndef FAST_HGRN
#define FAST_HGRN 1
#endif
constexpr int C_GQ = 0, C_GK = 256, C_GV = 384, C_WQ = 512, C_WK = 768, C_WV = 896, C_CVV = 1024, C_CVG = 1280, C_RQ = 1536, C_RI = 1792, C_RFF = 2048, C_RFB = 2304, C_RG = 2560;

constexpr size_t MiB = (size_t)1 << 20;
constexpr size_t WS_CTL = 0, CTL_ZERO_BYTES = 64 * 1024;
constexpr size_t WS_MOD = 1 * MiB;
constexpr size_t WS_LB = WS_MOD + 256 * 1024;
constexpr size_t WS_ROPE = WS_MOD + 512 * 1024;
constexpr size_t WS_TOKE = 2 * MiB, WS_TOKP = 3 * MiB, WS_TOKW = 4 * MiB, WS_TOKS = 5 * MiB;
constexpr size_t WS_SLOTT = 6 * MiB, WS_SLOTW = 7 * MiB;
constexpr size_t WS_RFRAG = 4 * MiB;
constexpr size_t WS_X = 8 * MiB;
constexpr size_t WS_WD = 74 * MiB;
constexpr size_t WS_Z = 107 * MiB;
constexpr size_t Z_A = WS_Z + 0 * MiB;
constexpr size_t Z_WGU = WS_Z + 33 * MiB;
constexpr size_t Z_WIN = WS_Z + 98 * MiB;
constexpr size_t Z_WOUT = WS_Z + 104 * MiB;
constexpr size_t Z_WPW = WS_Z + 106 * MiB;
__host__ __device__ constexpr size_t wgu_off(int l) { return WS_Z + 33 * MiB + (size_t)l * 34078720; }
__host__ __device__ constexpr size_t wd_off(int l) { return 74 * MiB + (size_t)l * 17039360; }
__host__ __device__ constexpr size_t win_off(int l) { return l == 0 ? WS_Z + 98 * MiB : WS_Z + (302 + 42) * MiB; }
__host__ __device__ constexpr size_t wout_off(int l) { return l == 0 ? WS_Z + 104 * MiB : WS_Z + (302 + 48) * MiB; }
__host__ __device__ constexpr size_t wpw_off(int l) { return l == 0 ? WS_Z + 106 * MiB : WS_Z + (302 + 51) * MiB; }
constexpr size_t Z_P = WS_Z + 107 * MiB;
constexpr size_t Z_YCAT = WS_Z + 198 * MiB;
constexpr size_t Z_QG = WS_Z + 231 * MiB, Z_QW = WS_Z + 239 * MiB;
constexpr size_t Z_KG = WS_Z + 247 * MiB, Z_VG = WS_Z + 252 * MiB, Z_KW = WS_Z + 257 * MiB, Z_VW = WS_Z + 262 * MiB;
constexpr size_t Z_QGC = WS_Z + 267 * MiB, Z_QWC = Z_QGC + 512 * 1024;
constexpr size_t Z_U = WS_Z + 268 * MiB;
constexpr size_t Z_G = WS_Z + 301 * MiB;
constexpr size_t Z_Y = WS_Z + 107 * MiB;
constexpr size_t Z_H = WS_Z + 302 * MiB;
constexpr size_t WS_END = WS_Z + 385 * MiB;
constexpr size_t WS_EXPL = WS_END, WS_EXPW = WS_END + 5 * MiB, WS_END2 = WS_END + 10 * MiB;
static_assert(Z_H + (size_t)HROWS * 512 <= WS_END, "H fits");
static_assert(Z_Y + (size_t)MAXSLOT * 1024 <= Z_U, "Y8 below the HGRN state buffers");
static_assert(Z_P + (size_t)R_ALL * DIN * 2 <= Z_YCAT, "P fits");

constexpr int CW_BAR = 0;
constexpr int CW_CNT = 4096;

constexpr int LDS_BYTES = 147456;
constexpr int NTHREADS = 512;

struct Params {
    const float* in[31];
    float* out;
    unsigned char* ws;
    int ph_lo, ph_hi;
};

typedef const __attribute__((address_space(4))) Params* KP;
__device__ __forceinline__ KP kparams() { KP k = (KP)__builtin_amdgcn_kernarg_segment_ptr(); asm volatile("" : "+s"(k)); return k; }

constexpr int LDS_WVTAB_OFF = 147456 - 16 - 256;
__device__ __forceinline__ int hwkey_() { return (int)__builtin_amdgcn_s_getreg((5 << 11) | 4) & 63; }
__device__ __forceinline__ int tid_() { extern __shared__ __attribute__((aligned(16))) unsigned char lds_all[];
    const int w = __builtin_amdgcn_readfirstlane(*(const LAS int*)((LAS unsigned char*)lds_all + LDS_WVTAB_OFF + 4 * hwkey_()));
    unsigned z; asm volatile("v_mov_b32 %0, 0" : "=v"(z));
    int t = (w << 6) | (int)__builtin_amdgcn_mbcnt_hi(~0u, __builtin_amdgcn_mbcnt_lo(~0u, z)); asm volatile("" : "+v"(t)); return t; }
__device__ __forceinline__ int bid_() { int b = blockIdx.x; asm volatile("" : "+s"(b)); return b; }
__device__ __forceinline__ int gsz_() { int g = gridDim.x; asm volatile("" : "+s"(g)); return g; }

__device__ __forceinline__ unsigned f2bf(float f) { unsigned u = __float_as_uint(f); return (u + 0x7fffu + ((u >> 16) & 1u)) >> 16; }
__device__ __forceinline__ float bf2f(unsigned h) { return __uint_as_float(h << 16); }
__device__ __forceinline__ unsigned pk2(float lo, float hi) { unsigned r; asm("v_cvt_pk_bf16_f32 %0, %1, %2" : "=v"(r) : "v"(lo), "v"(hi)); return r; }
__device__ __forceinline__ u32x4 pack8(const float (&x)[8]) { u32x4 o; o.x = pk2(x[0], x[1]); o.y = pk2(x[2], x[3]); o.z = pk2(x[4], x[5]); o.w = pk2(x[6], x[7]); return o; }
__device__ __forceinline__ void unpack8(const u32x4 r, f32x4& lo, f32x4& hi) { lo.x = bf2f(r.x & 0xffffu); lo.y = bf2f(r.x >> 16); lo.z = bf2f(r.y & 0xffffu); lo.w = bf2f(r.y >> 16); hi.x = bf2f(r.z & 0xffffu); hi.y = bf2f(r.z >> 16); hi.z = bf2f(r.w & 0xffffu); hi.w = bf2f(r.w >> 16); }
template <int CTRL> __device__ __forceinline__ float dpp_mov(float v) { return __builtin_bit_cast(float, __builtin_amdgcn_update_dpp(0, __builtin_bit_cast(int, v), CTRL, 0xF, 0xF, true)); }
__device__ __forceinline__ float wave_sum(float v) {
    v += dpp_mov<0xB1>(v); v += dpp_mov<0x4E>(v); v += dpp_mov<0x141>(v); v += dpp_mov<0x140>(v);
    { const auto rr = __builtin_amdgcn_permlane16_swap(__float_as_uint(v), __float_as_uint(v), false, false); v = __uint_as_float(rr[0]) + __uint_as_float(rr[1]); }
    { const auto rr = __builtin_amdgcn_permlane32_swap(__float_as_uint(v), __float_as_uint(v), false, false); v = __uint_as_float(rr[0]) + __uint_as_float(rr[1]); }
    return v;
}
__device__ __forceinline__ float clamp8(float v) { return fminf(fmaxf(v, -440.f), 440.f); }
__device__ __forceinline__ float sigmoid_(float x) { return __builtin_amdgcn_rcpf(1.f + __expf(-x)); }
__device__ __forceinline__ float silu_(float x) { return x * sigmoid_(x); }

__device__ __forceinline__ const float* xrow_src(KP p, int l, int row) {
    if (l == 0) return (row < R_LAT) ? p->in[0] + (size_t)row * D : p->in[2] + (size_t)(row - R_LAT) * D;
    return (const float*)(p->ws + WS_X) + (size_t)row * D;
}
__device__ __forceinline__ const float* mod_vec(KP p, int l, int row, int i) {
    const int r = (row < R_LAT) ? (row >> 13) : 2;
    return (const float*)(p->ws + WS_MOD) + ((size_t)l * 3 + r) * 6144 + i * 1024;
}

#define XB_TMO      128
#define XB_XCNT(j)  (256  + 64 * (j))
#define XB_XSUB(j)  (1280 + 64 * (j))
#define XB_XGEN(j)  (2304 + 64 * (j))
#define XB_TOP      3328
#define XB_TOPGEN   3392
#define XCD_BAR_WORDS 3456
#define XB_SPIN_CAP (1u << 18)
__device__ __forceinline__ unsigned xb_ld(unsigned* p)              { return __hip_atomic_load(p, __ATOMIC_RELAXED, __HIP_MEMORY_SCOPE_AGENT); }
__device__ __forceinline__ unsigned xb_add(unsigned* p, unsigned v) { return __hip_atomic_fetch_add(p, v, __ATOMIC_RELAXED, __HIP_MEMORY_SCOPE_AGENT); }
__device__ __forceinline__ unsigned xb_xcc_id() { return (unsigned)__builtin_amdgcn_s_getreg((3 << 11) | 20) & 0xFu; }
#define XB_SPIN(cond, bar) do { unsigned _sp = 0; while (cond) { __builtin_amdgcn_s_sleep(1); \
    if ((++_sp & 255u) == 0u) { if (xb_ld(&(bar)[XB_TMO])) break; if (_sp > XB_SPIN_CAP) { atomicAdd(&(bar)[XB_TMO], 1u); break; } } } } while (0)
struct XcdBarrier { unsigned* bar; unsigned x; volatile LAS unsigned* st; };
__device__ __forceinline__ XcdBarrier xcd_barrier_post(unsigned* bar, volatile LAS unsigned* st) {
    XcdBarrier b; b.bar = bar; b.x = xb_xcc_id(); b.st = st;
    if (tid_() == 0) (void)xb_add(&bar[XB_XCNT(b.x)], 1u);
    return b;
}
__device__ __forceinline__ void xcd_barrier_complete(unsigned* bar, unsigned x, unsigned& nloc, unsigned& nx) {
    const unsigned G = gridDim.x * gridDim.y * gridDim.z;
    unsigned sum, cnt, mine, sp = 0u;
    for (;;) {
        sum = 0u; cnt = 0u; mine = 0u;
#pragma unroll
        for (unsigned j = 0; j < 16; ++j) { const unsigned c = xb_ld(&bar[XB_XCNT(j)]); sum += c; cnt += (c > 0u) ? 1u : 0u; mine = (j == x) ? c : mine; }
        if (sum == G) break;
        __builtin_amdgcn_s_sleep(1);
        if ((++sp & 255u) == 0u) { if (xb_ld(&bar[XB_TMO])) break; if (sp > XB_SPIN_CAP) { atomicAdd(&bar[XB_TMO], 1u); break; } }
    }
    nloc = mine > 0u ? mine : 1u; nx = cnt > 0u ? cnt : 1u;
}
__device__ __forceinline__ void xcd_barrier(const XcdBarrier& b) {
    asm volatile("s_waitcnt vmcnt(0)" ::: "memory");
    __syncthreads();
    if (tid_() == 0) {
        unsigned* bar = b.bar;
        __builtin_amdgcn_s_waitcnt(0);
        unsigned nloc = b.st[0], nx = b.st[1];
        if (nloc == 0u) { xcd_barrier_complete(bar, b.x, nloc, nx); b.st[0] = nloc; b.st[1] = nx; }
        const unsigned old = xb_add(&bar[XB_XSUB(b.x)], 1u);
        const unsigned gen = old / nloc;
        if (old + 1u == (gen + 1u) * nloc) {
            __builtin_amdgcn_fence(__ATOMIC_RELEASE, "agent");
            asm volatile("s_waitcnt vmcnt(0)" ::: "memory");
            const unsigned og = xb_add(&bar[XB_TOP], 1u);
            const unsigned tg = og / nx;
            if (og + 1u == (tg + 1u) * nx) xb_add(&bar[XB_TOPGEN], 1u);
            else XB_SPIN(xb_ld(&bar[XB_TOPGEN]) == tg, bar);
            __builtin_amdgcn_fence(__ATOMIC_ACQUIRE, "agent");
            xb_add(&bar[XB_XGEN(b.x)], 1u);
            asm volatile("s_waitcnt vmcnt(0)" ::: "memory");
        } else {
            XB_SPIN(xb_ld(&bar[XB_XGEN(b.x)]) == gen, bar);
            __builtin_amdgcn_fence(__ATOMIC_ACQUIRE, "agent");
            asm volatile("s_waitcnt vmcnt(0)" ::: "memory");
        }
    }
    __syncthreads();
}

__device__ __forceinline__ void ph_pro(KP p, unsigned char* lds) {
    float* sc = (float*)lds;
    float* red = sc + 3 * 1024;
    const int tid = tid_(), lane = tid & 63, wid = tid >> 6;
    for (int i = tid; i < 3 * 1024; i += NTHREADS) { const int r = i >> 10, k = i & 1023; const float v = (r < 2) ? p->in[1][r * 1024 + k] : p->in[3][k]; sc[i] = silu_(v); }
    __syncthreads();
    float* mod = (float*)(p->ws + WS_MOD);
    for (int item = bid_(); item < DEPTH * 96 + DEPTH * 8; item += gsz_()) {
        if (item >= DEPTH * 96) {
            const int fi = item - DEPTH * 96, lf = fi >> 3, w = fi & 7, fr = lane & 15, fq = lane >> 4; const float* rw = p->in[23] + (size_t)lf * 1024 * 64;
            u32x4* RF = (u32x4*)(p->ws + WS_RFRAG);
#pragma unroll
            for (int s = 0; s < 2; ++s) { const int tk = wid * 2 + s, t = tk >> 2, k = tk & 3; float v[8], lo[8];
#pragma unroll
                for (int j = 0; j < 8; ++j) v[j] = rw[(size_t)((w * 4 + k) * 32 + fq * 8 + j) * 64 + t * 16 + fr];
                const u32x4 hh = pack8(v);
                const float hf[8] = {bf2f(hh.x & 0xffffu), bf2f(hh.x >> 16), bf2f(hh.y & 0xffffu), bf2f(hh.y >> 16), bf2f(hh.z & 0xffffu), bf2f(hh.z >> 16), bf2f(hh.w & 0xffffu), bf2f(hh.w >> 16)};
#pragma unroll
                for (int j = 0; j < 8; ++j) lo[j] = v[j] - hf[j];
                const size_t o = ((size_t)(((lf * 8 + w) * 4 + t) * 4 + k) * 64 + lane) * 2;
                RF[o] = hh; RF[o + 1] = pack8(lo); }
            continue; }
        const int l = item / 96, j0 = (item % 96) * 64;
        const float* w = p->in[4] + (size_t)l * 1024 * 6144;
        float a0 = 0.f, a1 = 0.f, a2 = 0.f;
        const int k0 = wid * 128;
#pragma unroll 1
        for (int k = k0; k < k0 + 128; k += 32) { float wv[32];
#pragma unroll
            for (int u = 0; u < 32; ++u) wv[u] = w[(size_t)(k + u) * 6144 + j0 + lane];
#pragma unroll
            for (int u = 0; u < 32; ++u) { a0 += sc[k + u] * wv[u]; a1 += sc[1024 + k + u] * wv[u]; a2 += sc[2048 + k + u] * wv[u]; } }
        red[(wid * 3 + 0) * 64 + lane] = a0; red[(wid * 3 + 1) * 64 + lane] = a1; red[(wid * 3 + 2) * 64 + lane] = a2;
        __syncthreads();
        if (tid < 192) { const int r = tid >> 6; float s = 0.f;
            for (int w8 = 0; w8 < 8; ++w8) s += red[(w8 * 3 + r) * 64 + lane];
            mod[((size_t)l * 3 + r) * 6144 + j0 + lane] = s + p->in[5][l * 6144 + j0 + lane]; }
        __syncthreads();
    }
    if (bid_() == 0) {
        float* rt = (float*)(p->ws + WS_ROPE);
        for (int i = tid; i < 128 * 16; i += NTHREADS) { const int pos = i >> 4, f = i & 15; const float inv = powf(10000.f, -(float)f * (1.f / 16.f)); float sn, cs; sincosf((float)pos * inv, &sn, &cs);
            rt[pos * 32 + f] = cs; rt[pos * 32 + 16 + f] = sn; }
    }
    if (bid_() == gsz_() - 1) {
        float* lb = (float*)(p->ws + WS_LB);
        for (int i = tid; i < 2 * 2 * 256; i += NTHREADS) { const int l = i >> 9, dir = (i >> 8) & 1, ch = i & 255;
            const float* lg = p->in[21];
            const float l0 = lg[(dir * 2 + 0) * 256 + ch], l1 = lg[(dir * 2 + 1) * 256 + ch]; const float m = fmaxf(l0, l1);
            const float e0 = expf(l0 - m), e1 = expf(l1 - m);
            lb[i] = (l == 0) ? 0.f : e1 / (e0 + e1); }
    }
}

constexpr int CVT_E1 = 1050, CVT_E2 = 2850;
struct CvtTile { const float* src; bf16_t* dst; int K, N, k0, n0, blk, bstride, boff; float f8scale; int perm; };
__device__ __forceinline__ int cvt_total() { return 16 * 44 + 16 * 16 + 4 * 4 + 2 * (64 * 64) + 2 * 64 + 64 * 64 + 64; }
__device__ __forceinline__ CvtTile cvt_decode(KP p, int l, int g) {
    bf16_t* Wgu = (bf16_t*)(p->ws + wgu_off(l)); bf16_t* Wd = (bf16_t*)(p->ws + wd_off(l));
    CvtTile t; int per, tn, r;
    if (g < 704) { r = g; t = {p->in[8] + (size_t)l * 1024 * DIN, (bf16_t*)(p->ws + win_off(l)), 1024, DIN, 0, 0, DIN, 0, 0, 0.f}; tn = 44; per = 704; }
    else if ((g -= 704) < 256) { r = g; t = {p->in[9] + (size_t)l * 1024 * 1024, (bf16_t*)(p->ws + wout_off(l)), 1024, 1024, 0, 0, 1024, 0, 0, 0.f}; tn = 16; per = 256; }
    else if ((g -= 256) < 16) { r = g; t = {p->in[19] + (size_t)l * 65536, (bf16_t*)(p->ws + wpw_off(l)), 256, 256, 0, 0, 256, 0, 0, 0.f}; tn = 4; per = 16; }
    else if ((g -= 16) < 4096) { const int m = g >> 6; r = g & 63; t = {p->in[25] + ((size_t)l * 64 + m) * 262144, (bf16_t*)((unsigned char*)Wgu + (size_t)m * 524288), 1024, 256, 0, 0, 128, 256, 0, WGU8_SCALE}; tn = 4; per = 64; }
    else if ((g -= 4096) < 4096) { const int m = g >> 6; r = g & 63; t = {p->in[26] + ((size_t)l * 64 + m) * 262144, (bf16_t*)((unsigned char*)Wgu + (size_t)m * 524288), 1024, 256, 0, 0, 128, 256, 128, WGU8_SCALE}; tn = 4; per = 64; }
    else if ((g -= 4096) < 64) { r = g; t = {p->in[28] + (size_t)l * 262144, (bf16_t*)((unsigned char*)Wgu + (size_t)64 * 524288), 1024, 256, 0, 0, 128, 256, 0, WGU8_SCALE}; tn = 4; per = 64; }
    else if ((g -= 64) < 64) { r = g; t = {p->in[29] + (size_t)l * 262144, (bf16_t*)((unsigned char*)Wgu + (size_t)64 * 524288), 1024, 256, 0, 0, 128, 256, 128, WGU8_SCALE}; tn = 4; per = 64; }
    else if ((g -= 64) < 4096) { const int m = g >> 6; r = g & 63; t = {p->in[27] + ((size_t)l * 64 + m) * 262144, (bf16_t*)((unsigned char*)Wd + (size_t)m * 262144), 256, 1024, 0, 0, 1024, 0, 0, WD8_SCALE, 1}; tn = 16; per = 64; }
    else { g -= 4096; r = g; t = {p->in[30] + (size_t)l * 262144, (bf16_t*)((unsigned char*)Wd + (size_t)64 * 262144), 256, 1024, 0, 0, 1024, 0, 0, WD8_SCALE, 1}; tn = 16; per = 64; }
    (void)per; t.k0 = (r / tn) * 64; t.n0 = (r % tn) * 64; return t;
}
__device__ __forceinline__ void ph_cvt(KP p, int l, unsigned char* lds, int first = 0, int nwg = 0, int t0 = 0, int t1 = 1 << 30) {
    float* tb = (float*)lds;
    const int tid = tid_(), G = nwg ? nwg : gsz_(), total = t1 < cvt_total() ? t1 : cvt_total();
    const int r0 = tid >> 4, c0 = (tid & 15) * 4, nn = tid >> 3, kc = (tid & 7) * 8;
    int g = bid_() - first, buf = 0;
    if (g < 0) return;
    g += t0;
    if (g >= total) return;
    CvtTile T = cvt_decode(p, l, g);
    f32x4 v0 = *(const f32x4*)(T.src + (size_t)(T.k0 + r0) * T.N + T.n0 + c0), v1 = *(const f32x4*)(T.src + (size_t)(T.k0 + r0 + 32) * T.N + T.n0 + c0);
    for (;;) {
        float* t = tb + buf * (64 * 65);
        t[r0 * 65 + c0] = v0.x; t[r0 * 65 + c0 + 1] = v0.y; t[r0 * 65 + c0 + 2] = v0.z; t[r0 * 65 + c0 + 3] = v0.w;
        t[(r0 + 32) * 65 + c0] = v1.x; t[(r0 + 32) * 65 + c0 + 1] = v1.y; t[(r0 + 32) * 65 + c0 + 2] = v1.z; t[(r0 + 32) * 65 + c0 + 3] = v1.w;
        const CvtTile C = T; const int gn = g + G; const bool more = gn < total;
        if (more) { T = cvt_decode(p, l, gn);
            v0 = *(const f32x4*)(T.src + (size_t)(T.k0 + r0) * T.N + T.n0 + c0); v1 = *(const f32x4*)(T.src + (size_t)(T.k0 + r0 + 32) * T.N + T.n0 + c0); }
        __syncthreads();
        { const int n = C.n0 + nn; int drow = (n / C.blk) * C.bstride + C.boff + (n % C.blk);
          if (C.perm) drow = (n & ~255) + ((n >> 3) & 1) * 128 + ((n >> 6) & 3) * 32 + ((n >> 4) & 3) * 8 + (n & 7);
          if (C.f8scale != 0.f) { const float sc = C.f8scale;
              int w0 = __builtin_amdgcn_cvt_pk_fp8_f32(clamp8(t[(kc + 0) * 65 + nn] * sc), clamp8(t[(kc + 1) * 65 + nn] * sc), 0, false); w0 = __builtin_amdgcn_cvt_pk_fp8_f32(clamp8(t[(kc + 2) * 65 + nn] * sc), clamp8(t[(kc + 3) * 65 + nn] * sc), w0, true);
              int w1 = __builtin_amdgcn_cvt_pk_fp8_f32(clamp8(t[(kc + 4) * 65 + nn] * sc), clamp8(t[(kc + 5) * 65 + nn] * sc), 0, false); w1 = __builtin_amdgcn_cvt_pk_fp8_f32(clamp8(t[(kc + 6) * 65 + nn] * sc), clamp8(t[(kc + 7) * 65 + nn] * sc), w1, true);
              u32x2 o8; o8.x = (unsigned)w0; o8.y = (unsigned)w1;
              *(u32x2*)((unsigned char*)C.dst + (size_t)drow * C.K + C.k0 + kc) = o8;
          } else {
          u32x4 o; o.x = pk2(t[(kc + 0) * 65 + nn], t[(kc + 1) * 65 + nn]); o.y = pk2(t[(kc + 2) * 65 + nn], t[(kc + 3) * 65 + nn]);
          o.z = pk2(t[(kc + 4) * 65 + nn], t[(kc + 5) * 65 + nn]); o.w = pk2(t[(kc + 6) * 65 + nn], t[(kc + 7) * 65 + nn]);
          *(u32x4*)(C.dst + (size_t)drow * C.K + C.k0 + kc) = o; } }
        if (!more) break;
        g = gn; buf ^= 1;
    }
    __syncthreads();
}
__device__ __forceinline__ void norm_mod_row(const float* xrow, const float* g, const float* shift, const float* scale, bf16_t* orow, float* fout, int lane) {
    f32x4 v[4]; float s = 0.f;
#pragma unroll
    for (int j = 0; j < 4; ++j) { v[j] = ((const f32x4*)xrow)[lane + 64 * j]; s += v[j].x * v[j].x + v[j].y * v[j].y + v[j].z * v[j].z + v[j].w * v[j].w; }
    const float rinv = rsqrtf(wave_sum(s) * (1.f / D) + EPS);
#pragma unroll
    for (int j = 0; j < 4; ++j) { const int idx = lane + 64 * j;
        const f32x4 gg = ((const f32x4*)g)[idx], sh = ((const f32x4*)shift)[idx], sc = ((const f32x4*)scale)[idx];
        f32x4 y; y.x = v[j].x * rinv * gg.x * (1.f + sc.x) + sh.x; y.y = v[j].y * rinv * gg.y * (1.f + sc.y) + sh.y;
        y.z = v[j].z * rinv * gg.z * (1.f + sc.z) + sh.z; y.w = v[j].w * rinv * gg.w * (1.f + sc.w) + sh.w;
        u32x2 o; o.x = pk2(y.x, y.y); o.y = pk2(y.z, y.w);
        ((u32x2*)orow)[idx] = o;
        if (fout) ((f32x4*)fout)[idx] = y; }
}
__device__ __forceinline__ void ph_norm1(KP p, int l, unsigned char* lds) {
    if (l == 0) ph_cvt(p, l, lds);
    const int tid = tid_(), lane = tid & 63, wid = tid >> 6;
    bf16_t* A = (bf16_t*)(p->ws + Z_A);
    const float* g = p->in[6] + l * D;
    if (l == 0) { for (int row = bid_() * 8 + wid; row < R_ALL; row += gsz_() * 8)
        norm_mod_row(xrow_src(p, l, row), g, mod_vec(p, l, row, 0), mod_vec(p, l, row, 1), A + (size_t)row * D, nullptr, lane); }
    else { const bf16_t* X = (const bf16_t*)(p->ws + WS_X);
        for (int row = bid_() * 8 + wid; row < R_ALL; row += gsz_() * 8) {
            const float* shift = mod_vec(p, l, row, 0); const float* scale = mod_vec(p, l, row, 1);
            f32x4 v[4]; unpack8(*(const u32x4*)(X + (size_t)row * D + lane * 8), v[0], v[1]); unpack8(*(const u32x4*)(X + (size_t)row * D + 512 + lane * 8), v[2], v[3]);
            float ss = 0.f;
#pragma unroll
            for (int j = 0; j < 4; ++j) ss += v[j].x * v[j].x + v[j].y * v[j].y + v[j].z * v[j].z + v[j].w * v[j].w;
            const float rinv = rsqrtf(wave_sum(ss) * (1.f / D) + EPS);
#pragma unroll
            for (int h = 0; h < 2; ++h) { const int c0 = h * 512 + lane * 8; unsigned o[4];
#pragma unroll
                for (int q = 0; q < 2; ++q) { const f32x4 gg = *(const f32x4*)(g + c0 + 4 * q), sh = *(const f32x4*)(shift + c0 + 4 * q), sc = *(const f32x4*)(scale + c0 + 4 * q);
                    const f32x4 y = v[2 * h + q] * rinv * gg * (sc + 1.f) + sh; o[2 * q] = pk2(y.x, y.y); o[2 * q + 1] = pk2(y.z, y.w); }
                *(u32x4*)(A + (size_t)row * D + c0) = (u32x4){o[0], o[1], o[2], o[3]}; } } }
}

template <int NBJ, class ARow, class Epi>
__device__ __forceinline__ void gemm_simple_tile(const bf16_t* A, const ARow& arow, const bf16_t* Bt, int K, int row0, int colb0, int bjstride, const Epi& epi) {
    const int tid = tid_(), lane = tid & 63, wid = tid >> 6, wr = wid >> 1, wc = wid & 1, fr = lane & 15, fq = lane >> 4;
    f32x4 acc[2][NBJ][4];
#pragma unroll
    for (int i = 0; i < 2; ++i)
#pragma unroll
        for (int b = 0; b < NBJ; ++b)
#pragma unroll
            for (int j = 0; j < 4; ++j) acc[i][b][j] = (f32x4){0.f, 0.f, 0.f, 0.f};
    const bf16_t* ap[2];
#pragma unroll
    for (int i = 0; i < 2; ++i) ap[i] = A + (size_t)arow(row0 + wr * 32 + i * 16 + fr) * K + fq * 8;
    const bf16_t* bp = Bt + (size_t)(colb0 + wc * 64 + fr) * K + fq * 8;
    for (int k = 0; k < K; k += 32) {
        bf16x8 a[2];
#pragma unroll
        for (int i = 0; i < 2; ++i) a[i] = *(const bf16x8*)(ap[i] + k);
#pragma unroll
        for (int b = 0; b < NBJ; ++b)
#pragma unroll
            for (int j = 0; j < 4; ++j) { const bf16x8 bv = *(const bf16x8*)(bp + (size_t)(b * bjstride + j * 16) * K + k);
#pragma unroll
                for (int i = 0; i < 2; ++i) acc[i][b][j] = __builtin_amdgcn_mfma_f32_16x16x32_bf16(a[i], bv, acc[i][b][j], 0, 0, 0); }
    }
#pragma unroll
    for (int i = 0; i < 2; ++i)
#pragma unroll
        for (int j = 0; j < 4; ++j)
#pragma unroll
            for (int r = 0; r < 4; ++r) { const int row = row0 + wr * 32 + i * 16 + fq * 4 + r, col = wc * 64 + j * 16 + fr;
                epi(row, col, acc[i][0][j][r], acc[i][NBJ - 1][j][r]); }
}
struct RowId { __device__ __forceinline__ int operator()(int r) const { return r; } };
struct RowGather { const int* idx; __device__ __forceinline__ int operator()(int r) const { return idx[r]; } };

__device__ __forceinline__ void ph_inproj(KP p, int l, unsigned char* lds) {
    const bf16_t* A = (const bf16_t*)(p->ws + Z_A); const bf16_t* Bt = (const bf16_t*)(p->ws + Z_WIN); bf16_t* P = (bf16_t*)(p->ws + Z_P);
    constexpr int TM = R_ALL / 128, TN = DIN / 128;
    for (int it = bid_(); it < TM * TN; it += gsz_()) { const int mt = it / TN, nt = it % TN;
        auto epi = [&](int row, int col, float v, float) { P[(size_t)row * DIN + nt * 128 + col] = (bf16_t)f2bf(v); };
        gemm_simple_tile<1>(A, RowId{}, Bt, 1024, mt * 128, nt * 128, 0, epi); }
}

namespace pg8 {
constexpr int BM = 256, BK = 64, HALF = 128, HTB = HALF * BK * 2, STAGE_BYTES = 8 * HTB, NXCD = 8, WGM = 8;
__host__ __device__ __forceinline__ int lds_byte(int r, int c) { const int st = (r >> 4) * 2 + (c >> 5), rr = r & 15, cc = c & 31, ob = rr * 64 + cc * 2; return st * 1024 + (ob ^ (((ob >> 9) & 1) << 5)); }
__host__ __device__ __forceinline__ void stage_rc(int b, int& R, int& C) { const int st = b / 1024, sb = b % 1024, swz = sb ^ (((sb >> 9) & 1) << 5); R = (st >> 1) * 16 + swz / 64; C = (st & 1) * 32 + (swz % 64) / 2; }
__host__ __device__ __forceinline__ int perm32(int rho) { const int n = rho >> 4, i = rho & 15; return 8 * (i >> 2) + 4 * n + (i & 3); }
struct Unit { int pm, pn, ord; };
struct Gemm { const bf16_t* A; const bf16_t* Bt; int M, N, K; };
struct StaticOrder {
    int nM, nN, nwg, G, c;
    __host__ __device__ void init(int M, int N, int G_, int c_) { nM = M / BM; nN = N / BM; nwg = nM * nN; G = G_; c = c_; }
    __host__ __device__ bool next(int i, Unit& u) const {
        const long L = (long)i * G + c; if (L >= nwg) return false;
        int wgid = (int)L; { const int q = nwg / NXCD, r = nwg % NXCD, xcd = wgid % NXCD, off = wgid / NXCD; wgid = (xcd < r ? xcd * (q + 1) : r * (q + 1) + (xcd - r) * q) + off; }
        const int nig = WGM * nN, gid = wgid / nig, fm = gid * WGM, gsz = (nM - fm) < WGM ? (nM - fm) : WGM;
        u.pm = fm + ((wgid % nig) % gsz); u.pn = (wgid % nig) / gsz; u.ord = i; return true;
    }
};
__device__ __forceinline__ unsigned cvt_pk_bf16(float lo, float hi) { unsigned r; asm volatile("v_cvt_pk_bf16_f32 %0, %1, %2" : "=v"(r) : "v"(lo), "v"(hi)); return r; }

typedef int i32x4v __attribute__((ext_vector_type(4)));
typedef int i32x8v __attribute__((ext_vector_type(8)));
__device__ __forceinline__ i32x8v cat8(bf16x8 lo, bf16x8 hi) { const i32x4v a = __builtin_bit_cast(i32x4v, lo), b = __builtin_bit_cast(i32x4v, hi); return __builtin_shufflevector(a, b, 0, 1, 2, 3, 4, 5, 6, 7); }
__device__ __forceinline__ void glds16_s(const void* sbase, unsigned voff, unsigned lds_dst) { unsigned keep;
    asm volatile("s_mov_b32 %0, m0\n\ts_mov_b32 m0, %3\n\ts_nop 0\n\tglobal_load_lds_dwordx4 %1, %2\n\ts_mov_b32 m0, %0" : "=&s"(keep) : "v"(voff), "s"(sbase), "s"(lds_dst) : "memory"); }
template <class Epi, class Sched, bool GATHER, bool FP8 = false>
__device__ __forceinline__ void gemm_phase(LAS unsigned char* lds, const Gemm g, const Sched& S, const Epi& E, const LAS int* rtab) {
    const int tid = tid_(), wid = __builtin_amdgcn_readfirstlane(tid >> 6), lane = tid & 63, wr = wid >> 2, wc = wid & 3, fr = lane & 15, fq = lane >> 4;
    const int KB = FP8 ? g.K : g.K * 2, nt = KB / 128;
    unsigned voffA[2], voffB[2]; int RA[2], CA[2];
#pragma unroll
    for (int i = 0; i < 2; ++i) { int R, C; stage_rc(tid * 16 + i * 8192, R, C); const int Rb = (R & ~31) + perm32(R & 31);
        voffA[i] = (unsigned)(R * KB + C * 2); voffB[i] = (unsigned)(Rb * KB + C * 2); RA[i] = R; CA[i] = C; }
    unsigned rcpk = 0; if constexpr (GATHER) { rcpk = (unsigned)(RA[0] * 4) | ((unsigned)(CA[0] * 2) << 16); asm volatile("" : "+v"(rcpk)); }
    const size_t kstep = (size_t)128;
    const size_t hstep = (size_t)HALF * KB;
    const size_t hstepA = GATHER ? 0 : hstep;
    const size_t tstep = 2 * hstep;
    const unsigned ldsw = (unsigned)wid * 1024u;
    const unsigned ldsb = (unsigned)__builtin_amdgcn_readfirstlane((int)((unsigned)(size_t)lds + ldsw));
    const int aoff = lds_byte(wr * 64 + fr, fq * 8), boff = lds_byte(wc * 32 + fr, fq * 8);
#define PG8_SA(b, h) (((b) * 2 + (h)) * HTB)
#define PG8_SB(b, h) ((4 + (b) * 2 + (h)) * HTB)
#define PG8_STAGE(bufoff, gbase, voff) do { _Pragma("unroll") for (int _i = 0; _i < 2; ++_i) { if constexpr (FP8) glds16_s((const void*)(gbase), (voff)[_i], ldsb + (unsigned)((bufoff) + _i * 8192)); \
        else __builtin_amdgcn_global_load_lds((const unsigned*)((const char*)(gbase) + (voff)[_i]), (LAS unsigned*)(lds + (bufoff) + ldsw + _i * 8192), 16, 0, 0); } } while (0)
#define PG8_STAGE1(bufoff, gbase, v0) do {   \
        glds16_s((const void*)(gbase), (v0), ldsb + (unsigned)(bufoff)); glds16_s((const void*)((const char*)(gbase) + (size_t)64 * KB), (v0), ldsb + (unsigned)((bufoff) + 8192)); } while (0)
#define PG8_LDA(dst, b, h) do { _Pragma("unroll") for (int m = 0; m < 4; ++m) { if constexpr (FP8) dst##8[m] = cat8(*(const LAS bf16x8*)(lds + PG8_SA(b, h) + aoff + m * 2048), *(const LAS bf16x8*)(lds + PG8_SA(b, h) + aoff + m * 2048 + 1024)); \
        else { _Pragma("unroll") for (int k = 0; k < 2; ++k) dst[m][k] = *(const LAS bf16x8*)(lds + PG8_SA(b, h) + aoff + m * 2048 + k * 1024); } } } while (0)
#define PG8_LDB(dst, b, h) do { _Pragma("unroll") for (int n = 0; n < 2; ++n) { if constexpr (FP8) dst##8[n] = cat8(*(const LAS bf16x8*)(lds + PG8_SB(b, h) + boff + n * 2048), *(const LAS bf16x8*)(lds + PG8_SB(b, h) + boff + n * 2048 + 1024)); \
        else { _Pragma("unroll") for (int k = 0; k < 2; ++k) dst[n][k] = *(const LAS bf16x8*)(lds + PG8_SB(b, h) + boff + n * 2048 + k * 1024); } } } while (0)
#define PG8_MMA(ai, bj, At, Bt) do { __builtin_amdgcn_s_setprio(1); _Pragma("unroll") for (int m = 0; m < 4; ++m) _Pragma("unroll") for (int n = 0; n < 2; ++n) { \
        if constexpr (FP8) acc[ai][bj][m][n] = __builtin_amdgcn_mfma_scale_f32_16x16x128_f8f6f4(Bt##8[n], At##8[m], acc[ai][bj][m][n], 0, 0, 0, 0x7F7F7F7F, 0, 0x7F7F7F7F); \
        else { _Pragma("unroll") for (int k = 0; k < 2; ++k) acc[ai][bj][m][n] = __builtin_amdgcn_mfma_f32_16x16x32_bf16(Bt[n][k], At[m][k], acc[ai][bj][m][n], 0, 0, 0); } } \
        if constexpr (FP8) { asm volatile("" : "+v"(acc[ai][bj][0][0]), "+v"(acc[ai][bj][0][1]), "+v"(acc[ai][bj][1][0]), "+v"(acc[ai][bj][1][1]), "+v"(acc[ai][bj][2][0]), "+v"(acc[ai][bj][2][1]), "+v"(acc[ai][bj][3][0]), "+v"(acc[ai][bj][3][1])); } \
        __builtin_amdgcn_s_setprio(0); } while (0)
#define PG8_WAIT_V(n) asm volatile("s_waitcnt vmcnt(" #n ")" ::: "memory")
#define PG8_WAIT_L(n) asm volatile("s_waitcnt lgkmcnt(" #n ")" ::: "memory")
#define PG8_BAR __builtin_amdgcn_s_barrier()
#define PG8_SCHED __builtin_amdgcn_sched_barrier(0)
#define PG8_STAGE_A(bufoff, gbase, ord, h) do { unsigned _o[2]; if constexpr (GATHER) {   \
            unsigned _pk = rcpk; asm volatile("" : "+v"(_pk));   \
            const LAS unsigned char* _rp = (const LAS unsigned char*)rtab + ((ord) * 1024 + (h) * 512) + (_pk & 0xffffu); const unsigned _c2 = _pk >> 16; \
            _Pragma("unroll") for (int _i = 0; _i < 2; ++_i) _o[_i] = __umul24((unsigned)*(const LAS int*)(_rp + _i * 256), (unsigned)KB) + _c2; } \
        else { _o[0] = voffA[0]; _o[1] = voffA[1]; } if constexpr (FP8 && !GATHER) PG8_STAGE1(bufoff, gbase, voffA[0]); else PG8_STAGE(bufoff, gbase, _o); } while (0)
#define PG8_STAGE_B(bufoff, gbase) do { if constexpr (FP8) PG8_STAGE1(bufoff, gbase, voffB[0]); else PG8_STAGE(bufoff, gbase, voffB); } while (0)
    Unit cur, nxt; int ui = 0;
    if (!S.next(0, cur)) return;
    f32x4 acc[2][2][4][2];
#pragma unroll
    for (int a = 0; a < 2; ++a)
#pragma unroll
        for (int b = 0; b < 2; ++b)
#pragma unroll
            for (int m = 0; m < 4; ++m)
#pragma unroll
                for (int n = 0; n < 2; ++n) acc[a][b][m][n] = (f32x4){0.f, 0.f, 0.f, 0.f};
    bf16x8 At[4][2], B0[2][2], B1[2][2]; i32x8v At8[4], B08[2], B18[2];
    const char* cA = GATHER ? (const char*)g.A : (const char*)g.A + (size_t)cur.pm * tstep; const char* cB = (const char*)g.Bt + (size_t)cur.pn * tstep;
    PG8_STAGE_B(PG8_SB(0, 0), cB); PG8_STAGE_B(PG8_SB(0, 1), cB + hstep); PG8_STAGE_A(PG8_SA(0, 0), cA, 0, 0); PG8_STAGE_A(PG8_SA(0, 1), cA + hstepA, 0, 1);
    if (wr == 1) PG8_BAR;
    PG8_WAIT_V(2); PG8_BAR;
    PG8_STAGE_B(PG8_SB(1, 0), cB + kstep); PG8_STAGE_A(PG8_SA(1, 0), cA + kstep, 0, 0); PG8_STAGE_B(PG8_SB(1, 1), cB + hstep + kstep);
    PG8_WAIT_V(6); PG8_BAR;
    for (;;) {
        const bool has_next = S.next(ui + 1, nxt);
        const char* nA = GATHER ? (const char*)g.A : (has_next ? (const char*)g.A + (size_t)nxt.pm * tstep : cA); const char* nB = has_next ? (const char*)g.Bt + (size_t)nxt.pn * tstep : cB;
#pragma unroll 1
        for (int t = 0; t < nt; t += 2) {
            const bool last = (t == nt - 2);
            const char* a1 = cA + (size_t)(t + 1) * kstep;
            const char* a2 = last ? nA : cA + (size_t)(t + 2) * kstep; const char* b2 = last ? nB : cB + (size_t)(t + 2) * kstep;
            const char* a3 = a2 + kstep; const char* b3 = b2 + kstep;
            const int on = (last && has_next) ? ui + 1 : ui;
            PG8_LDB(B0, 0, 0); PG8_LDB(B1, 0, 1); PG8_SCHED; PG8_LDA(At, 0, 0); PG8_STAGE_A(PG8_SA(1, 1), a1 + hstepA, ui, 1);
            PG8_WAIT_V(8); PG8_WAIT_L(0); PG8_BAR; PG8_MMA(0, 0, At, B0); PG8_MMA(0, 1, At, B1); PG8_BAR; PG8_SCHED;
            PG8_LDA(At, 0, 1); PG8_STAGE_B(PG8_SB(0, 0), b2); PG8_STAGE_B(PG8_SB(0, 1), b2 + hstep); PG8_STAGE_A(PG8_SA(0, 0), a2, on, 0);
            PG8_WAIT_V(8); PG8_WAIT_L(0); PG8_BAR; PG8_MMA(1, 0, At, B0); PG8_MMA(1, 1, At, B1); PG8_BAR; PG8_SCHED;
            PG8_LDB(B0, 1, 0); PG8_LDB(B1, 1, 1); PG8_SCHED; PG8_LDA(At, 1, 0); PG8_STAGE_A(PG8_SA(0, 1), a2 + hstepA, on, 1);
            PG8_WAIT_V(8); PG8_WAIT_L(0); PG8_BAR; PG8_MMA(0, 0, At, B0); PG8_MMA(0, 1, At, B1); PG8_BAR; PG8_SCHED;
            PG8_LDA(At, 1, 1); PG8_STAGE_B(PG8_SB(1, 0), b3); PG8_STAGE_B(PG8_SB(1, 1), b3 + hstep); PG8_STAGE_A(PG8_SA(1, 0), a3, on, 0);
            PG8_WAIT_V(8); PG8_WAIT_L(0); PG8_BAR; PG8_MMA(1, 0, At, B0); PG8_MMA(1, 1, At, B1); PG8_BAR; PG8_SCHED;
        }
        if (wr == 0) PG8_BAR;
        E(acc, cur, wr, wc, fr, fq);
        if (!has_next) break;
#pragma unroll
        for (int a = 0; a < 2; ++a)
#pragma unroll
            for (int b = 0; b < 2; ++b)
#pragma unroll
                for (int m = 0; m < 4; ++m)
#pragma unroll
                    for (int n = 0; n < 2; ++n) acc[a][b][m][n] = (f32x4){0.f, 0.f, 0.f, 0.f};
        cur = nxt; cA = nA; cB = nB; ++ui;
        if (wr == 1) PG8_BAR;
    }
    PG8_WAIT_V(0);
    PG8_BAR;
#undef PG8_SA
#undef PG8_SB
#undef PG8_STAGE
#undef PG8_LDA
#undef PG8_LDB
#undef PG8_MMA
#undef PG8_WAIT_V
#undef PG8_WAIT_L
#undef PG8_BAR
#undef PG8_SCHED
#undef PG8_STAGE_A
#undef PG8_STAGE_B
#undef PG8_STAGE1
}
struct EpiBf16 {
    bf16_t* O; int ldc, ncolt; size_t slab;
    __device__ __forceinline__ void operator()(const f32x4 (&acc)[2][2][4][2], const Unit& u, int wr, int wc, int fr, int fq) const {
        const int row0 = u.pm * BM + wr * 64 + fr; const size_t col0 = (size_t)(u.pn % ncolt) * slab + wc * 32 + 8 * fq;
#pragma unroll
        for (int ai = 0; ai < 2; ++ai)
#pragma unroll
            for (int m = 0; m < 4; ++m) { bf16_t* rowp = O + (size_t)(row0 + ai * HALF + m * 16) * ldc + col0;
#pragma unroll
                for (int bj = 0; bj < 2; ++bj) { const f32x4 v0 = acc[ai][bj][m][0], v1 = acc[ai][bj][m][1];
                    u32x4 w; w.x = cvt_pk_bf16(v0[0], v0[1]); w.y = cvt_pk_bf16(v0[2], v0[3]); w.z = cvt_pk_bf16(v1[0], v1[1]); w.w = cvt_pk_bf16(v1[2], v1[3]);
                    *(u32x4*)(rowp + bj * HALF) = w; } }
    }
};
struct EpiRes {
    bf16_t* X; const float* xlat; const float* xctx; const float* modl; int pm_shift; float ascale; bool perm = false;
    __device__ __forceinline__ void operator()(const f32x4 (&acc)[2][2][4][2], const Unit& u, int wr, int wc, int fr, int fq) const {
        const int pm = u.pm - pm_shift; const int rsel = pm < 64 ? (pm >> 5) : 2;
        const int row0 = pm * BM + wr * 64 + fr, col0 = (u.pn & 3) * BM + (perm ? wc * 64 + 16 * fq : wc * 32 + 8 * fq), bjs = perm ? 8 : HALF;
        const float* gate = modl + (size_t)rsel * 6144 + col0;
        const float* xs = xlat ? (pm < 64 ? xlat + (size_t)row0 * D : xctx + (size_t)(row0 - R_LAT) * D) + col0 : nullptr;
        bf16_t* xo = X + (size_t)row0 * D + col0;
#pragma unroll
        for (int bj = 0; bj < 2; ++bj) { const f32x4 g0 = *(const f32x4*)(gate + bj * bjs) * ascale, g1 = *(const f32x4*)(gate + bj * bjs + 4) * ascale;
#pragma unroll
            for (int ai = 0; ai < 2; ++ai)
#pragma unroll
                for (int m = 0; m < 4; ++m) { const size_t o = (size_t)(ai * HALF + m * 16) * D + bj * bjs;
                    f32x4 x0, x1;
                    if (xs) { x0 = *(const f32x4*)(xs + o); x1 = *(const f32x4*)(xs + o + 4); } else unpack8(*(const u32x4*)(xo + o), x0, x1);
                    const f32x4 y0 = x0 + g0 * acc[ai][bj][m][0], y1 = x1 + g1 * acc[ai][bj][m][1];
                    u32x4 w; w.x = cvt_pk_bf16(y0[0], y0[1]); w.y = cvt_pk_bf16(y0[2], y0[3]); w.z = cvt_pk_bf16(y1[0], y1[1]); w.w = cvt_pk_bf16(y1[2], y1[3]);
                    *(u32x4*)(xo + o) = w; } }
    }
};
struct EpiGU8 {
    unsigned char* H8; const LAS float* wtab;
    __device__ __forceinline__ void operator()(const f32x4 (&acc)[2][2][4][2], const Unit& u, int wr, int wc, int fr, int fq) const {
        { const int t_ = tid_(); fr = t_ & 15; fq = (t_ >> 4) & 3; }
        const int row0 = u.pm * BM + wr * 64 + fr, col0 = (u.pn & 1) * 128 + wc * 32 + 8 * fq;
#pragma unroll
        for (int ai = 0; ai < 2; ++ai)
#pragma unroll
            for (int m = 0; m < 4; ++m) { const int row = row0 + ai * HALF + m * 16; const float w = wtab[u.ord * 256 + wr * 64 + fr + ai * HALF + m * 16] * (H8_SCALE * GU_DESCALE * GU_DESCALE);
                float h[8];
#pragma unroll
                for (int n = 0; n < 2; ++n)
#pragma unroll
                    for (int j = 0; j < 4; ++j) { const float ag = acc[ai][0][m][n][j], au = acc[ai][1][m][n][j];
                        h[n * 4 + j] = __builtin_amdgcn_fmed3f((ag * au) * __builtin_amdgcn_rcpf(1.f + __builtin_amdgcn_exp2f(ag * (-GU_DESCALE * LOG2E))) * w, -440.f, 440.f); }
                int w0 = __builtin_amdgcn_cvt_pk_fp8_f32(h[0], h[1], 0, false); w0 = __builtin_amdgcn_cvt_pk_fp8_f32(h[2], h[3], w0, true);
                int w1 = __builtin_amdgcn_cvt_pk_fp8_f32(h[4], h[5], 0, false); w1 = __builtin_amdgcn_cvt_pk_fp8_f32(h[6], h[7], w1, true);
                u32x2 o; o.x = (unsigned)w0; o.y = (unsigned)w1;
                *(u32x2*)(H8 + (size_t)row * 256 + col0) = o; }
    }
};
struct EpiGU {
    bf16_t* H; const float* slot_w;
    __device__ __forceinline__ void operator()(const f32x4 (&acc)[2][2][4][2], const Unit& u, int wr, int wc, int fr, int fq) const {
        const int row0 = u.pm * BM + wr * 64 + fr, col0 = (u.pn & 1) * 128 + wc * 32 + 8 * fq;
#pragma unroll
        for (int ai = 0; ai < 2; ++ai)
#pragma unroll
            for (int m = 0; m < 4; ++m) { const int row = row0 + ai * HALF + m * 16; const float w = slot_w[row];
                float h[8];
#pragma unroll
                for (int n = 0; n < 2; ++n)
#pragma unroll
                    for (int j = 0; j < 4; ++j) { const float gv = acc[ai][0][m][n][j], uv = acc[ai][1][m][n][j]; h[n * 4 + j] = gv / (1.f + __expf(-gv)) * uv * w; }
                u32x4 o; o.x = cvt_pk_bf16(h[0], h[1]); o.y = cvt_pk_bf16(h[2], h[3]); o.z = cvt_pk_bf16(h[4], h[5]); o.w = cvt_pk_bf16(h[6], h[7]);
                *(u32x4*)(H + (size_t)row * 256 + col0) = o; }
    }
};
struct EpiY8 {
    unsigned char* Y8;
    __device__ __forceinline__ void operator()(const f32x4 (&acc)[2][2][4][2], const Unit& u, int wr, int wc, int fr, int fq) const {
        const int row0 = u.pm * BM + wr * 64 + fr; unsigned char* base = Y8 + ((size_t)(u.pn & 3) * MAXSLOT + row0) * 256 + wc * 64 + 16 * fq;
#pragma unroll
        for (int ai = 0; ai < 2; ++ai)
#pragma unroll
            for (int m = 0; m < 4; ++m) { unsigned w[4];
#pragma unroll
                for (int bj = 0; bj < 2; ++bj) { f32x4 v0 = acc[ai][bj][m][0] * (Y8_SCALE * DN_DESCALE), v1 = acc[ai][bj][m][1] * (Y8_SCALE * DN_DESCALE);
#pragma unroll
                    for (int q = 0; q < 4; ++q) { v0[q] = fminf(fmaxf(v0[q], -440.f), 440.f); v1[q] = fminf(fmaxf(v1[q], -440.f), 440.f); }
                    int w0 = __builtin_amdgcn_cvt_pk_fp8_f32(v0[0], v0[1], 0, false); w0 = __builtin_amdgcn_cvt_pk_fp8_f32(v0[2], v0[3], w0, true);
                    int w1 = __builtin_amdgcn_cvt_pk_fp8_f32(v1[0], v1[1], 0, false); w1 = __builtin_amdgcn_cvt_pk_fp8_f32(v1[2], v1[3], w1, true);
                    w[2 * bj] = (unsigned)w0; w[2 * bj + 1] = (unsigned)w1; }
                *(u32x4*)(base + (size_t)(ai * HALF + m * 16) * 256) = (u32x4){w[0], w[1], w[2], w[3]}; }
    }
};
struct EpiDown {
    bf16_t* Y; bf16_t* X; const float* modl5;
    __device__ __forceinline__ void operator()(const f32x4 (&acc)[2][2][4][2], const Unit& u, int wr, int wc, int fr, int fq) const {
        { const int t_ = tid_(); fr = t_ & 15; fq = (t_ >> 4) & 3; }
        if (u.pm < MAXSLOT / 256) { const EpiY8 e{(unsigned char*)Y}; e(acc, u, wr, wc, fr, fq); }
        else { const EpiRes e{X, nullptr, nullptr, modl5, MAXSLOT / 256, DN_DESCALE, true}; e(acc, u, wr, wc, fr, fq); }
    }
};
}


__device__ __forceinline__ void ph_inproj_f(KP p, int l, unsigned char* lds) {
    pg8::Gemm g{(const bf16_t*)(p->ws + Z_A), (const bf16_t*)(p->ws + win_off(l)), R_ALL, DIN, 1024};
    pg8::StaticOrder S; S.init(R_ALL, DIN, gsz_(), bid_());
    pg8::EpiBf16 E{(bf16_t*)(p->ws + Z_P), DIN, DIN / 256, 256};
    pg8::gemm_phase<pg8::EpiBf16, pg8::StaticOrder, false>((LAS unsigned char*)lds, g, S, E, nullptr);
    if (l == 0 && DEPTH > 1 && gsz_() == 256) { __syncthreads(); ph_cvt(p, 1, lds, 214, 42, 0, CVT_E1); }
}
__device__ __forceinline__ void ph_outproj_f(KP p, int l, unsigned char* lds) {
    const int T = (l == 0) ? R_ALL : R_LAT;
    pg8::Gemm g{(const bf16_t*)(p->ws + Z_YCAT), (const bf16_t*)(p->ws + wout_off(l)), T, 1024, 1024};
    pg8::StaticOrder S; S.init(T, 1024, gsz_(), bid_());
    bf16_t* X = (bf16_t*)(p->ws + WS_X);
    pg8::EpiRes E{X, l == 0 ? p->in[0] : nullptr, l == 0 ? p->in[2] : nullptr, (const float*)(p->ws + WS_MOD) + (size_t)l * 3 * 6144 + 2 * 1024, 0, 1.f};
    pg8::gemm_phase<pg8::EpiRes, pg8::StaticOrder, false>((LAS unsigned char*)lds, g, S, E, nullptr);
    if (l == 0 && DEPTH > 1) {
        const int G = gsz_(); __syncthreads();
        if (G == 256) ph_cvt(p, 1, lds, 8, 248, CVT_E2, 1 << 30); else ph_cvt(p, 1, lds); }
}
struct QkvLane { f32x4 gg0, gg1, gw0, gw1; };
__device__ __forceinline__ QkvLane qkv_lane_consts(KP p, int l, int lane) {
    QkvLane c; const int dch = (lane & 7) * 8; const int isk = lane >= 32;
    const float* gq = p->in[isk ? 11 : 10] + l * 64 + dch; const float* wq = p->in[isk ? 13 : 12] + l * 64 + dch;
    c.gg0 = *(const f32x4*)gq; c.gg1 = *(const f32x4*)(gq + 4); c.gw0 = *(const f32x4*)wq; c.gw1 = *(const f32x4*)(wq + 4); return c;
}
__device__ __forceinline__ void prep_qkv_row(KP p, int l, int row, int lane, const QkvLane& qc) {
    const bf16_t* pr = (const bf16_t*)(p->ws + Z_P) + (size_t)row * DIN;
    const bool isctx = row >= R_LAT; const int b = isctx ? ((row - R_LAT) >> 8) : (row >> 13), t = isctx ? ((row - R_LAT) & 255) : (row & 8191);
    const size_t krow = (size_t)b * NKEY + (isctx ? NSEQ + t : t);
    const int l7 = lane & 7, axis = l7 >> 2, half = (l7 >> 1) & 1;
    f32x4 cs0 = (f32x4){1.f, 1.f, 1.f, 1.f}, cs1 = cs0, sn0 = (f32x4){0.f, 0.f, 0.f, 0.f}, sn1 = sn0;
    if (!isctx) { const int pos = axis == 0 ? (t >> 6) : (t & 63); const float* rt = (const float*)(p->ws + WS_ROPE) + pos * 32 + (lane & 1) * 8;
        cs0 = *(const f32x4*)rt; cs1 = *(const f32x4*)(rt + 4); sn0 = *(const f32x4*)(rt + 16); sn1 = *(const f32x4*)(rt + 20); }
    const u32x4 ra = *(const u32x4*)(pr + lane * 8), rb = *(const u32x4*)(pr + 512 + lane * 8);
#pragma unroll
    for (int grp = 0; grp < 2; ++grp) {
        const u32x4 r = grp ? rb : ra;
        bf16_t* Qd = (bf16_t*)(p->ws + (isctx ? (grp ? Z_QWC : Z_QGC) : (grp ? Z_QW : Z_QG))) + (size_t)(isctx ? (b * NCTX + t) : row) * 256;
        bf16_t* Kd = (bf16_t*)(p->ws + (grp ? Z_KW : Z_KG)) + krow * 128; bf16_t* Vd = (bf16_t*)(p->ws + (grp ? Z_VW : Z_VG)) + krow * 128;
        if (lane >= 48) { *(u32x4*)(Vd + (lane - 48) * 8) = r; continue; }
        float x[8] = {bf2f(r.x & 0xffffu), bf2f(r.x >> 16), bf2f(r.y & 0xffffu), bf2f(r.y >> 16), bf2f(r.z & 0xffffu), bf2f(r.z >> 16), bf2f(r.w & 0xffffu), bf2f(r.w >> 16)};
        float ss = 0.f;
#pragma unroll
        for (int i = 0; i < 8; ++i) ss += x[i] * x[i];
        ss += __shfl_xor(ss, 1); ss += __shfl_xor(ss, 2); ss += __shfl_xor(ss, 4);
        const float rinv = rsqrtf(ss * (1.f / 64.f) + EPS);
        const f32x4 g0 = grp ? qc.gw0 : qc.gg0, g1 = grp ? qc.gw1 : qc.gg1;
        const float gv[8] = {g0.x, g0.y, g0.z, g0.w, g1.x, g1.y, g1.z, g1.w};
        const float cv[8] = {cs0.x, cs0.y, cs0.z, cs0.w, cs1.x, cs1.y, cs1.z, cs1.w}, sv[8] = {sn0.x, sn0.y, sn0.z, sn0.w, sn1.x, sn1.y, sn1.z, sn1.w};
        const float qs = (lane < 32) ? QSCALE : 1.f;
        float y[8];
#pragma unroll
        for (int i = 0; i < 8; ++i) { const float v = x[i] * rinv * gv[i]; const float o = __shfl_xor(v, 2);
            y[i] = ((half == 0) ? (v * cv[i] - o * sv[i]) : (o * sv[i] + v * cv[i])) * qs; }
        u32x4 ov; ov.x = pk2(y[0], y[1]); ov.y = pk2(y[2], y[3]); ov.z = pk2(y[4], y[5]); ov.w = pk2(y[6], y[7]);
        if (lane < 32) *(u32x4*)(Qd + lane * 8) = ov; else *(u32x4*)(Kd + (lane - 32) * 8) = ov;
    }
}

template <int R> __device__ __forceinline__ void dw_rows(const float* hcol, const float (&wj)[31], float (&acc)[32]) {
    if constexpr (R < 62) {
        const float hv = hcol[R * 256];
        constexpr int T0 = (R - 30 > 0) ? R - 30 : 0, T1 = (R < 31) ? R : 31;
#pragma unroll
        for (int tt = T0; tt <= T1; ++tt) acc[tt] += hv * wj[R - tt];
        dw_rows<R + 1>(hcol, wj, acc);
    }
}
__device__ __forceinline__ void conv_tile(KP p, int l, unsigned char* lds, int seq_row0, int seqlen, int t0) {
    float* hb = (float*)lds;
    const int tid = tid_(), lane = tid & 63, wid = tid >> 6;
    const bf16_t* P = (const bf16_t*)(p->ws + Z_P);
    for (int i = tid; i < 94 * 32; i += NTHREADS) { const int r = i >> 5, c8 = (i & 31) * 8, t = t0 - 15 + r;
        f32x4 h0 = (f32x4){0.f, 0.f, 0.f, 0.f}, h1 = h0;
        if (t >= 0 && t < seqlen) { const bf16_t* pr = P + (size_t)(seq_row0 + t) * DIN;
            const u32x4 vv = *(const u32x4*)(pr + C_CVV + c8), gg = *(const u32x4*)(pr + C_CVG + c8);
            h0.x = bf2f(vv.x & 0xffffu) * sigmoid_(bf2f(gg.x & 0xffffu)); h0.y = bf2f(vv.x >> 16) * sigmoid_(bf2f(gg.x >> 16));
            h0.z = bf2f(vv.y & 0xffffu) * sigmoid_(bf2f(gg.y & 0xffffu)); h0.w = bf2f(vv.y >> 16) * sigmoid_(bf2f(gg.y >> 16));
            h1.x = bf2f(vv.z & 0xffffu) * sigmoid_(bf2f(gg.z & 0xffffu)); h1.y = bf2f(vv.z >> 16) * sigmoid_(bf2f(gg.z >> 16));
            h1.z = bf2f(vv.w & 0xffffu) * sigmoid_(bf2f(gg.w & 0xffffu)); h1.w = bf2f(vv.w >> 16) * sigmoid_(bf2f(gg.w >> 16)); }
        *(f32x4*)(hb + r * 256 + c8) = h0; *(f32x4*)(hb + r * 256 + c8 + 4) = h1; }
    __syncthreads();
    { const int c = tid & 255, hf = tid >> 8;
      const float* w = p->in[15] + (size_t)l * 31 * 256 + c; const float bias = p->in[16][l * 256 + c];
      float wj[31];
#pragma unroll
      for (int j = 0; j < 31; ++j) wj[j] = w[j * 256];
      float acc[32];
#pragma unroll
      for (int tt = 0; tt < 32; ++tt) acc[tt] = bias;
      dw_rows<0>(hb + hf * 32 * 256 + c, wj, acc);
      __syncthreads();
#pragma unroll
      for (int tt = 0; tt < 32; ++tt) hb[(hf * 32 + tt) * 256 + c] = acc[tt];
    }
    __syncthreads();
    constexpr int AS = 264;
    bf16_t* ab = (bf16_t*)(lds + 94 * 256 * 4);
    for (int tt = wid; tt < 64; tt += 8) { const float* r = hb + tt * 256; const f32x4 v = ((const f32x4*)r)[lane];
        const float mean = wave_sum(v.x + v.y + v.z + v.w) * (1.f / 256.f);
        const float dx = v.x - mean, dy = v.y - mean, dz = v.z - mean, dw = v.w - mean;
        const float rstd = rsqrtf(wave_sum(dx * dx + dy * dy + dz * dz + dw * dw) * (1.f / 256.f) + EPS);
        const f32x4 g = ((const f32x4*)(p->in[17] + l * 256))[lane], bb = ((const f32x4*)(p->in[18] + l * 256))[lane];
        u32x2 o; o.x = pk2(silu_(dx * rstd * g.x + bb.x), silu_(dy * rstd * g.y + bb.y)); o.y = pk2(silu_(dz * rstd * g.z + bb.z), silu_(dw * rstd * g.w + bb.w));
        *(u32x2*)(ab + tt * AS + lane * 4) = o; }
    __syncthreads();
    { const int fr = lane & 15, fq = lane >> 4;
      const bf16_t* Wt = (const bf16_t*)(p->ws + wpw_off(l));
      bf16x8 bw[2][8];
#pragma unroll
      for (int j = 0; j < 2; ++j)
#pragma unroll
          for (int ks = 0; ks < 8; ++ks) bw[j][ks] = *(const bf16x8*)(Wt + (size_t)((wid * 2 + j) * 16 + fr) * 256 + ks * 32 + fq * 8);
      const float bias0 = p->in[20][l * 256 + wid * 32 + fr], bias1 = p->in[20][l * 256 + wid * 32 + 16 + fr];
      bf16_t* Y = (bf16_t*)(p->ws + Z_YCAT);
#pragma unroll 1
      for (int tr = 0; tr < 4; ++tr) { f32x4 a0 = (f32x4){0.f, 0.f, 0.f, 0.f}, a1 = a0;
#pragma unroll
          for (int ks = 0; ks < 8; ++ks) { const bf16x8 av = *(const bf16x8*)(ab + (tr * 16 + fr) * AS + ks * 32 + fq * 8);
              a0 = __builtin_amdgcn_mfma_f32_16x16x32_bf16(av, bw[0][ks], a0, 0, 0, 0); a1 = __builtin_amdgcn_mfma_f32_16x16x32_bf16(av, bw[1][ks], a1, 0, 0, 0); }
#pragma unroll
          for (int r = 0; r < 4; ++r) { const int t = t0 + tr * 16 + fq * 4 + r; bf16_t* yr = Y + (size_t)(seq_row0 + t) * D + 256 + wid * 32 + fr;
              yr[0] = (bf16_t)f2bf(a0[r] + bias0); yr[16] = (bf16_t)f2bf(a1[r] + bias1); } }
    }
    __syncthreads();
}

__device__ __forceinline__ int hgrn_chunk_row0(int b, int dir, int j) {
    if (j < 4) { const int cj = dir ? 3 - j : j; return R_LAT + b * NCTX + cj * 64; }
    const int jj = j - 4, cj = dir ? 127 - jj : jj; return b * NSEQ + cj * 64;
}
__device__ __forceinline__ void hgrn_load_chunk(KP p, int l, int row0, int dir, int head, float* qs, float* vs, float* ks, float* cs) {
    const int tid = tid_();
    const bf16_t* P = (const bf16_t*)(p->ws + Z_P);
    const float* lbv = (const float*)(p->ws + WS_LB) + (l * 2 + dir) * 256 + head * 64;
    for (int i = tid; i < 4096; i += NTHREADS) { const int tau = i >> 6, d = i & 63; const int row = row0 + (dir ? 63 - tau : tau);
        const bf16_t* pr = P + (size_t)row * DIN + head * 64 + d;
        if (qs) qs[i] = bf2f(pr[C_RQ]);
        vs[i] = bf2f(pr[C_RI]);
        const float z = bf2f(pr[dir ? C_RFB : C_RFF]); const float lb = lbv[d];
        const float lsp = fminf(z, 0.f) - log1pf(__expf(-fabsf(z)));
        float logf = lsp;
        if (lb > 0.f) { const float a = lsp, bq = __logf(lb) + (lsp - z); const float mx = fmaxf(a, bq); logf = mx + log1pf(__expf(-fabsf(a - bq))); }
        ks[i] = (1.f - lb) * sigmoid_(-z);
        cs[i] = logf; }
    __syncthreads();
    if (tid < 64) { float c = 0.f; for (int tau = 0; tau < 64; ++tau) { c += cs[tau * 64 + tid]; cs[tau * 64 + tid] = c; } }
    __syncthreads();
}
__device__ __forceinline__ void hgrn_pass1_unit(KP p, int l, unsigned char* lds, int unit) {
    float* vs = (float*)lds; float* ks = vs + 4096; float* cs = ks + 4096;
    const int tid = tid_();
    const int j = unit % NCHUNK, seq = unit / NCHUNK, dir = seq & 1, head = (seq >> 1) & 3, b = seq >> 3;
    hgrn_load_chunk(p, l, hgrn_chunk_row0(b, dir, j), dir, head, nullptr, vs, ks, cs);
    for (int i = tid; i < 4096; i += NTHREADS) { const int d = i & 63; ks[i] *= __expf(cs[63 * 64 + d] - cs[i]); }
    __syncthreads();
    float* U = (float*)(p->ws + Z_U) + ((size_t)seq * NCHUNK + j) * 4096; float* Gv = (float*)(p->ws + Z_G) + ((size_t)seq * NCHUNK + j) * 64;
    { const int d = tid >> 3, e0 = (tid & 7) * 8; float acc[8];
#pragma unroll
      for (int e = 0; e < 8; ++e) acc[e] = 0.f;
      for (int tau = 0; tau < 64; ++tau) { const float kv = ks[tau * 64 + d];
#pragma unroll
          for (int e = 0; e < 8; ++e) acc[e] += kv * vs[tau * 64 + e0 + e]; }
#pragma unroll
      for (int e = 0; e < 8; ++e) U[d * 64 + e0 + e] = acc[e]; }
    if (tid < 64) Gv[tid] = __expf(cs[63 * 64 + tid]);
    __syncthreads();
}
constexpr int HS = 72;
constexpr int HL_TOT = 0, HL_OSUM = 2048, HL_T0 = 18432, HL_TB = 64 * HS * 2;
__device__ __forceinline__ f32x4 mm64(const bf16_t* A, const bf16_t* Bt, int tr, int tc, int fr, int fq, f32x4 acc) {
#pragma unroll
    for (int k0 = 0; k0 < 64; k0 += 32) { const bf16x8 a = *(const bf16x8*)(A + (tr * 16 + fr) * HS + k0 + fq * 8), b = *(const bf16x8*)(Bt + (tc * 16 + fr) * HS + k0 + fq * 8);
        acc = __builtin_amdgcn_mfma_f32_16x16x32_bf16(a, b, acc, 0, 0, 0); }
    return acc;
}
__device__ __forceinline__ void hgrn_load8(KP p, int row0, int dir, int head, int tid, float (&q)[8], float (&vv)[8], float (&z)[8]) {
    const int d = tid & 63, seg = tid >> 6;
    const bf16_t* P = (const bf16_t*)(p->ws + Z_P);
#pragma unroll
    for (int i = 0; i < 8; ++i) { const int tau = seg * 8 + i; const int row = row0 + (dir ? 63 - tau : tau);
        const bf16_t* pr = P + (size_t)row * DIN + head * 64 + d;
        q[i] = bf2f(pr[C_RQ]); vv[i] = bf2f(pr[C_RI]); z[i] = bf2f(pr[dir ? C_RFB : C_RFF]); }
}
__device__ __forceinline__ void hgrn_gate8(KP p, int l, int dir, int head, int tid, float* tot, const float (&z)[8], float (&kg)[8], float (&c)[8], float& m, float& cl) {
    const int d = tid & 63, seg = tid >> 6;
    const float lb = ((const float*)(p->ws + WS_LB))[(l * 2 + dir) * 256 + head * 64 + d];
    float run = 0.f;
#pragma unroll
    for (int i = 0; i < 8; ++i) {
        const float ez = __expf(-fabsf(z[i])), rz = __builtin_amdgcn_rcpf(1.f + ez); const float sg = (z[i] >= 0.f) ? rz : ez * rz;
        const float f = lb + (1.f - lb) * sg;
        kg[i] = 1.f - f;
        run += __logf(f); c[i] = run; }
    tot[seg * 64 + d] = run;
    __syncthreads();
    float off = 0.f; m = 0.f; cl = 0.f;
#pragma unroll
    for (int s2 = 0; s2 < 8; ++s2) { const float t = tot[s2 * 64 + d]; if (s2 < seg) off += t; if (s2 < 4) m += t; cl += t; }
#pragma unroll
    for (int i = 0; i < 8; ++i) c[i] += off;
}
__device__ __forceinline__ void hgrn_pass1_f(KP p, int l, unsigned char* lds, int unit) {
    const int tid = tid_(), lane = tid & 63, wid = tid >> 6, fr = lane & 15, fq = lane >> 4, d = tid & 63, seg = tid >> 6;
    float* tot = (float*)(lds + HL_TOT); bf16_t* Vt = (bf16_t*)(lds + HL_T0); bf16_t* KbT = (bf16_t*)(lds + HL_T0 + HL_TB);
    const int j = unit % NCHUNK, seq = unit / NCHUNK, dir = seq & 1, head = (seq >> 1) & 3, b = seq >> 3;
    float q[8], vv[8], z[8], kg[8], c[8], m, cl;
    hgrn_load8(p, hgrn_chunk_row0(b, dir, j), dir, head, tid, q, vv, z);
    hgrn_gate8(p, l, dir, head, tid, tot, z, kg, c, m, cl);
    float kb[8];
#pragma unroll
    for (int i = 0; i < 8; ++i) kb[i] = kg[i] * __expf(cl - c[i]);
    *(u32x4*)(Vt + d * HS + seg * 8) = pack8(vv);
    *(u32x4*)(KbT + d * HS + seg * 8) = pack8(kb);
    float* U = (float*)(p->ws + Z_U) + ((size_t)seq * NCHUNK + j) * 4096; float* Gv = (float*)(p->ws + Z_G) + ((size_t)seq * NCHUNK + j) * 64;
    if (seg == 0) Gv[d] = __expf(cl);
    __syncthreads();
    const int tr = wid >> 1;
#pragma unroll
    for (int t2 = 0; t2 < 2; ++t2) { const int tc = (wid & 1) * 2 + t2;
        const f32x4 acc = mm64(Vt, KbT, tr, tc, fr, fq, (f32x4){0.f, 0.f, 0.f, 0.f});
#pragma unroll
        for (int r = 0; r < 4; ++r) U[(tr * 16 + fq * 4 + r) * 64 + tc * 16 + fr] = acc[r]; }
    __syncthreads();
}
struct HgrnIn1 { float v[8], zf[8], zb[8]; };
__device__ __forceinline__ void hgrn_p1_load(KP p, int unit, int tid, HgrnIn1& r) {
    const int cpos = unit % NCHUNK, head = (unit / NCHUNK) & 3, b = unit / (NCHUNK * 4), d = tid & 63, seg = tid >> 6;
    const int row0 = (cpos < 4) ? R_LAT + b * NCTX + cpos * 64 : b * NSEQ + (cpos - 4) * 64;
    const bf16_t* P = (const bf16_t*)(p->ws + Z_P) + (size_t)(row0 + seg * 8) * DIN + head * 64 + d;
#pragma unroll
    for (int i = 0; i < 8; ++i) { const bf16_t* pr = P + (size_t)i * DIN; r.v[i] = bf2f(pr[C_RI]); r.zf[i] = bf2f(pr[C_RFF]); r.zb[i] = bf2f(pr[C_RFB]); }
}
__device__ __forceinline__ void hgrn_p1_compute(KP p, int l, unsigned char* lds, int unit, int tid, const HgrnIn1& r) {
    const int lane = tid & 63, wid = tid >> 6, fr = lane & 15, fq = lane >> 4, d = tid & 63, seg = tid >> 6;
    float* totf = (float*)(lds + HL_TOT); float* totb = (float*)(lds + HL_OSUM);
    bf16_t* Vt = (bf16_t*)(lds + HL_T0); bf16_t* KfT = (bf16_t*)(lds + HL_T0 + HL_TB); bf16_t* KbT = (bf16_t*)(lds + HL_T0 + 2 * HL_TB);
    const int cpos = unit % NCHUNK, head = (unit / NCHUNK) & 3, b = unit / (NCHUNK * 4);
    const float* lbp = (const float*)(p->ws + WS_LB) + (l * 2) * 256 + head * 64 + d; const float lbf = lbp[0], lbb = lbp[256];
    float kf[8], kb[8], cf[8], cb[8], lfb[8], runf = 0.f, runb = 0.f;
#pragma unroll
    for (int i = 0; i < 8; ++i) {
        { const float z = r.zf[i], ez = __builtin_amdgcn_exp2f(-fabsf(z) * LOG2E), rz = __builtin_amdgcn_rcpf(1.f + ez), sg = (z >= 0.f) ? rz : ez * rz, f = lbf + (1.f - lbf) * sg; kf[i] = 1.f - f; runf += __builtin_amdgcn_logf(f); cf[i] = runf; }
        { const float z = r.zb[i], ez = __builtin_amdgcn_exp2f(-fabsf(z) * LOG2E), rz = __builtin_amdgcn_rcpf(1.f + ez), sg = (z >= 0.f) ? rz : ez * rz, f = lbb + (1.f - lbb) * sg; kb[i] = 1.f - f; lfb[i] = __builtin_amdgcn_logf(f); runb += lfb[i]; cb[i] = runb; } }
    totf[seg * 64 + d] = runf; totb[seg * 64 + d] = runb;
    __syncthreads();
    float offf = 0.f, offb = 0.f, clf = 0.f, clb = 0.f;
#pragma unroll
    for (int s2 = 0; s2 < 8; ++s2) { const float tf = totf[s2 * 64 + d], tb = totb[s2 * 64 + d]; if (s2 < seg) { offf += tf; offb += tb; } clf += tf; clb += tb; }
#pragma unroll
    for (int i = 0; i < 8; ++i) { kf[i] *= __builtin_amdgcn_exp2f(clf - (cf[i] + offf)); kb[i] *= __builtin_amdgcn_exp2f(cb[i] + offb - lfb[i]); }
    *(u32x4*)(Vt + d * HS + seg * 8) = pack8(r.v);
    *(u32x4*)(KfT + d * HS + seg * 8) = pack8(kf);
    *(u32x4*)(KbT + d * HS + seg * 8) = pack8(kb);
    const int jf = cpos, jb = (cpos < 4) ? 3 - cpos : 4 + 127 - (cpos - 4); const int seqf = (b * 4 + head) * 2;
    bf16_t* Uf = (bf16_t*)(p->ws + Z_U) + ((size_t)seqf * NCHUNK + jf) * 4096; bf16_t* Ub = (bf16_t*)(p->ws + Z_U) + ((size_t)(seqf + 1) * NCHUNK + jb) * 4096;
    float* Gf = (float*)(p->ws + Z_G) + ((size_t)seqf * NCHUNK + jf) * 64; float* Gb = (float*)(p->ws + Z_G) + ((size_t)(seqf + 1) * NCHUNK + jb) * 64;
    if (seg == 0) { Gf[d] = __builtin_amdgcn_exp2f(clf); Gb[d] = __builtin_amdgcn_exp2f(clb); }
    __syncthreads();
    const int tr = wid >> 1;
#pragma unroll
    for (int t2 = 0; t2 < 2; ++t2) { const int tc = (wid & 1) * 2 + t2;
        const f32x4 af = mm64(Vt, KfT, tr, tc, fr, fq, (f32x4){0.f, 0.f, 0.f, 0.f}), ab = mm64(Vt, KbT, tr, tc, fr, fq, (f32x4){0.f, 0.f, 0.f, 0.f});
#pragma unroll
        for (int q = 0; q < 4; ++q) { const int o = (tr * 16 + fq * 4 + q) * 64 + tc * 16 + fr; Uf[o] = (bf16_t)f2bf(af[q]); Ub[o] = (bf16_t)f2bf(ab[q]); } }
    __syncthreads();
}
__device__ __forceinline__ void hgrn_pass1_run(KP p, int l, unsigned char* lds, int u0, int un, int ustep) {
    if (un <= 0) return;
    const int tid = tid_();
    HgrnIn1 cur; hgrn_p1_load(p, u0, tid, cur);
    for (int k = 0; k < un; ++k) { const int u = u0 + k * ustep;
        HgrnIn1 nxt = cur; if (k + 1 < un) hgrn_p1_load(p, u + ustep, tid, nxt);
        hgrn_p1_compute(p, l, lds, u, tid, cur);
        cur = nxt; }
}
__device__ __forceinline__ void hgrn_scan_f(KP p) {
    const int tid = tid_();
    if (tid >= 256) return;
    for (int gi = bid_() * 256 + tid; gi < 16 * 4096; gi += gsz_() * 256) {
    const int seq = gi >> 12, ed = gi & 4095, d = ed & 63;
    bf16_t* U = (bf16_t*)(p->ws + Z_U) + (size_t)seq * NCHUNK * 4096 + ed; const float* Gv = (const float*)(p->ws + Z_G) + (size_t)seq * NCHUNK * 64 + d;
    float S = 0.f;
#pragma unroll 1
    for (int j = 0; j < NCHUNK; j += 12) {
        float u[12], g[12];
#pragma unroll
        for (int q = 0; q < 12; ++q) { u[q] = bf2f(U[(size_t)(j + q) * 4096]); g[q] = Gv[(j + q) * 64]; }
#pragma unroll
        for (int q = 0; q < 12; ++q) { U[(size_t)(j + q) * 4096] = (bf16_t)f2bf(S); S = g[q] * S + u[q]; }
    }
    }
}
struct HgrnIn3 { float q[8], v[8], zf[8], zb[8], gg[8]; u32x4 sf, sb; };
__device__ __forceinline__ void hgrn_p3_load(KP p, int unit, int tid, HgrnIn3& r) {
    const int cpos = unit % NCHUNK, head = (unit / NCHUNK) & 3, b = unit / (NCHUNK * 4), d = tid & 63, seg = tid >> 6;
    const int row0 = (cpos < 4) ? R_LAT + b * NCTX + cpos * 64 : b * NSEQ + (cpos - 4) * 64;
    const bf16_t* P = (const bf16_t*)(p->ws + Z_P) + (size_t)(row0 + seg * 8) * DIN + head * 64 + d;
#pragma unroll
    for (int i = 0; i < 8; ++i) { const bf16_t* pr = P + (size_t)i * DIN; r.q[i] = bf2f(pr[C_RQ]); r.v[i] = bf2f(pr[C_RI]); r.zf[i] = bf2f(pr[C_RFF]); r.zb[i] = bf2f(pr[C_RFB]);
        r.gg[i] = bf2f(((const bf16_t*)(p->ws + Z_P))[(size_t)(row0 + seg + 8 * i) * DIN + C_RG + head * 64 + d]); }
    const int jf = cpos, jb = (cpos < 4) ? 3 - cpos : 4 + 127 - (cpos - 4); const int seqf = (b * 4 + head) * 2;
    const bf16_t* U = (const bf16_t*)(p->ws + Z_U);
    r.sf = *(const u32x4*)(U + ((size_t)seqf * NCHUNK + jf) * 4096 + tid * 8); r.sb = *(const u32x4*)(U + ((size_t)(seqf + 1) * NCHUNK + jb) * 4096 + tid * 8);
}
__device__ __forceinline__ void hgrn_p3_compute(KP p, int l, unsigned char* lds, int unit, int tid, const HgrnIn3& r) {
    const int lane = tid & 63, wid = tid >> 6, fr = lane & 15, fq = lane >> 4, d = tid & 63, seg = tid >> 6;
    constexpr int HL_D1 = HL_T0 + 6 * HL_TB, HL_TOT1 = HL_D1 + 6 * HL_TB;
    static_assert(HL_TOT1 + 2048 <= LDS_WVTAB_OFF, "HGRN pass-3 LDS fits below the wave table");
    float* os0 = (float*)(lds + HL_OSUM); float* os1 = (float*)(lds + HL_T0);
    const int cpos = unit % NCHUNK, head = (unit / NCHUNK) & 3, b = unit / (NCHUNK * 4);
    const int row0 = (cpos < 4) ? R_LAT + b * NCTX + cpos * 64 : b * NSEQ + (cpos - 4) * 64;
    const int tr = wid >> 1;
    const float* lbp = (const float*)(p->ws + WS_LB) + (l * 2) * 256 + head * 64 + d;
    const int segs = __builtin_amdgcn_readfirstlane(seg);
    float kg[2][8], c[2][8];
#pragma unroll
    for (int dir = 0; dir < 2; ++dir) { float* tot = (float*)(lds + (dir ? HL_TOT1 : HL_TOT));
        const float lb = lbp[dir * 256], olb = 1.f - lb; float run = 0.f;
#pragma unroll
        for (int ii = 0; ii < 8; ++ii) { const int i = dir ? 7 - ii : ii;
            const float z = dir ? r.zb[i] : r.zf[i];
            const float ez = __builtin_amdgcn_exp2f(-fabsf(z) * LOG2E), rz = __builtin_amdgcn_rcpf(1.f + ez), sg = (z >= 0.f) ? rz : ez * rz, f = lb + olb * sg;
            kg[dir][i] = 1.f - f; run += __builtin_amdgcn_logf(f); c[dir][i] = run; }
        tot[seg * 64 + d] = run; }
    __syncthreads();
#pragma unroll
    for (int dir = 0; dir < 2; ++dir) { const float* tot = (const float*)(lds + (dir ? HL_TOT1 : HL_TOT)); unsigned char* tb = lds + (dir ? HL_D1 : HL_T0);
        bf16_t* Qt = (bf16_t*)tb; bf16_t* Kt = (bf16_t*)(tb + HL_TB); bf16_t* Qb = (bf16_t*)(tb + 2 * HL_TB); bf16_t* St = (bf16_t*)(tb + 3 * HL_TB); bf16_t* Vt = (bf16_t*)(tb + 4 * HL_TB);
        float off = 0.f, m = 0.f;
#pragma unroll
        for (int s2 = 0; s2 < 8; ++s2) { const float t = tot[s2 * 64 + d]; const float fl = (dir ? (s2 > segs) : (s2 < segs)) ? 1.f : 0.f; off = fmaf(t, fl, off); if (dir ? (s2 >= 4) : (s2 < 4)) m += t; }
        float vr[8], qb[8];
#pragma unroll
        for (int i = 0; i < 8; ++i) { const float ci = c[dir][i] + off; const int tau = dir ? 63 - (seg * 8 + i) : seg * 8 + i; const float qv = r.q[i];
            const unsigned qk = pk2(qv * __builtin_amdgcn_exp2f(fminf(ci - m, 115.f)), kg[dir][i] * __builtin_amdgcn_exp2f(fminf(m - ci, 115.f)));
            Qt[tau * HS + d] = (bf16_t)(qk & 0xffffu); Kt[tau * HS + d] = (bf16_t)(qk >> 16);
            qb[i] = qv * __builtin_amdgcn_exp2f(ci);
            vr[i] = dir ? r.v[7 - i] : r.v[i]; }
#pragma unroll
        for (int i = 0; i < 8; i += 2) { const int t0 = dir ? 63 - (seg * 8 + i) : seg * 8 + i, t1 = dir ? t0 - 1 : t0 + 1; const unsigned qq = pk2(qb[i], qb[i + 1]);
            Qb[t0 * HS + d] = (bf16_t)(qq & 0xffffu); Qb[t1 * HS + d] = (bf16_t)(qq >> 16); }
        *(u32x4*)(Vt + d * HS + (dir ? 7 - seg : seg) * 8) = pack8(vr);
        *(u32x4*)(St + (tid >> 3) * HS + (tid & 7) * 8) = dir ? r.sb : r.sf; }
    __syncthreads();
    f32x4 oacc[2][2];
#pragma unroll
    for (int dir = 0; dir < 2; ++dir) { unsigned char* tb = lds + (dir ? HL_D1 : HL_T0);
        const bf16_t* Qt = (const bf16_t*)tb; const bf16_t* Kt = (const bf16_t*)(tb + HL_TB); const bf16_t* Qb = (const bf16_t*)(tb + 2 * HL_TB); const bf16_t* St = (const bf16_t*)(tb + 3 * HL_TB); bf16_t* Sc = (bf16_t*)(tb + 5 * HL_TB);
#pragma unroll
        for (int t2 = 0; t2 < 2; ++t2) { const int tc = (wid & 1) * 2 + t2;
            oacc[dir][t2] = mm64(Qb, St, tr, tc, fr, fq, (f32x4){0.f, 0.f, 0.f, 0.f});
            f32x4 sacc = (f32x4){0.f, 0.f, 0.f, 0.f};
            if (tc <= tr) sacc = mm64(Qt, Kt, tr, tc, fr, fq, sacc);
#pragma unroll
            for (int q = 0; q < 4; q += 2) { const int tau = tr * 16 + fq * 4 + q, sig = tc * 16 + fr; const unsigned ss = pk2(sig <= tau ? sacc[q] : 0.f, sig <= tau + 1 ? sacc[q + 1] : 0.f);
                Sc[tau * HS + sig] = (bf16_t)(ss & 0xffffu); Sc[(tau + 1) * HS + sig] = (bf16_t)(ss >> 16); } } }
    __syncthreads();
#pragma unroll
    for (int dir = 0; dir < 2; ++dir) { unsigned char* tb = lds + (dir ? HL_D1 : HL_T0); const bf16_t* Vt = (const bf16_t*)(tb + 4 * HL_TB); const bf16_t* Sc = (const bf16_t*)(tb + 5 * HL_TB);
        float* os = dir ? os1 : os0;
#pragma unroll
        for (int t2 = 0; t2 < 2; ++t2) { const int tc = (wid & 1) * 2 + t2;
            const f32x4 o = mm64(Sc, Vt, tr, tc, fr, fq, oacc[dir][t2]);
#pragma unroll
            for (int q = 0; q < 4; ++q) { const int tau = tr * 16 + fq * 4 + q, e = tc * 16 + fr, tok = dir ? 63 - tau : tau; os[tok * 64 + e] = o[q]; } } }
    __syncthreads();
    bf16_t* Y = (bf16_t*)(p->ws + Z_YCAT); const float ong = p->in[22][l * 64 + lane];
    float yo[8];
#pragma unroll
    for (int i = 0; i < 8; ++i) { const int tok = wid + 8 * i; const float v = os0[tok * 64 + lane] + os1[tok * 64 + lane];
        yo[i] = v * rsqrtf(wave_sum(v * v) * (1.f / 64.f) + EPS) * ong * silu_(r.gg[i]); }
#pragma unroll
    for (int i = 0; i < 8; i += 2) { const unsigned yy = pk2(yo[i], yo[i + 1]); bf16_t* yp = Y + (size_t)(row0 + wid + 8 * i) * D + 768 + head * 64 + lane;
        yp[0] = (bf16_t)(yy & 0xffffu); yp[(size_t)8 * D] = (bf16_t)(yy >> 16); }
    __syncthreads();
}
__device__ __forceinline__ int hgrn_p3_unit(int k) { if (k < 1024) { const int bh = k >> 7, c = k & 127; return bh * NCHUNK + 4 + c; } const int k2 = k - 1024; return (k2 >> 2) * NCHUNK + (k2 & 3); }
__device__ __forceinline__ void hgrn_pass3_run(KP p, int l, unsigned char* lds) {
    const int tid = tid_(), G = gsz_(), nunits = 1024 + (l == 0 ? 32 : 0);
    int k = bid_(); if (k >= nunits) return;
    HgrnIn3 cur; hgrn_p3_load(p, hgrn_p3_unit(k), tid, cur);
    for (;;) { const int kn = k + G; const bool more = kn < nunits;
        HgrnIn3 nxt = cur; if (more) hgrn_p3_load(p, hgrn_p3_unit(kn), tid, nxt);
        hgrn_p3_compute(p, l, lds, hgrn_p3_unit(k), tid, cur);
        if (!more) break;
        cur = nxt; k = kn; }
}
__device__ __forceinline__ void ph_prep(KP p, int l, unsigned char* lds) {
    const int tid = tid_(), lane = tid & 63, wid = tid >> 6, bid = bid_(), G = gsz_();
    const int nconv = 256 + (l == 0 ? 8 : 0);
    for (int it = bid; it < nconv; it += G) {
        if (it < 256) conv_tile(p, l, lds, (it >> 7) * NSEQ, NSEQ, (it & 127) * 64);
        else { const int c = it - 256; conv_tile(p, l, lds, R_LAT + (c >> 2) * NCTX, NCTX, (c & 3) * 64); } }
    if (G == 256) {
        const int u0 = bid < 8 ? 2 * bid : bid < 56 ? 16 + 5 * (bid - 8) : 256 + 4 * (bid - 56), un = bid < 8 ? 2 : bid < 56 ? 5 : 4;
        hgrn_pass1_run(p, l, lds, u0, un, 1);
        const int g0 = bid < 104 ? 8 * bid : bid < 168 ? 832 + 9 * (bid - 104) : 1408 + 8 * (bid - 168), gn = (bid >= 104 && bid < 168) ? 9 : 8;
        const QkvLane qc = qkv_lane_consts(p, l, lane);
        for (int g = g0; g < g0 + gn; ++g) prep_qkv_row(p, l, g * 8 + wid, lane, qc);
    } else {
        hgrn_pass1_run(p, l, lds, bid, (8 * NCHUNK - bid + G - 1) / G, G);
        const QkvLane qc = qkv_lane_consts(p, l, lane);
        for (int row = bid * 8 + wid; row < R_ALL; row += G * 8) prep_qkv_row(p, l, row, lane, qc);
    }
}

__device__ __forceinline__ void hgrn_scan(KP p) {
    const int gi = bid_() * NTHREADS + tid_();
    if (gi >= 16 * 4096) return;
    const int seq = gi >> 12, de = gi & 4095, d = de >> 6;
    float* U = (float*)(p->ws + Z_U) + (size_t)seq * NCHUNK * 4096 + de; const float* Gv = (const float*)(p->ws + Z_G) + (size_t)seq * NCHUNK * 64 + d;
    float S = 0.f;
    for (int j = 0; j < NCHUNK; j += 4) {
        float u[4], g[4];
#pragma unroll
        for (int q = 0; q < 4; ++q) { u[q] = U[(size_t)(j + q) * 4096]; g[q] = Gv[(j + q) * 64]; }
#pragma unroll
        for (int q = 0; q < 4; ++q) { U[(size_t)(j + q) * 4096] = S; S = g[q] * S + u[q]; }
    }
}
__device__ __forceinline__ void attn_simple_unit(unsigned char* lds, const bf16_t* Qrow0  , const bf16_t* Kb, const bf16_t* Vb  ,
                                                 int mode, int NT, int first_key, int q0, bool use_sink, float sink_log2, bf16_t* Orow0  ) {
    float* Ks = (float*)lds; float* Vs = Ks + 4096;
    const int tid = tid_();
    float q[64], o[64], m = -INFINITY, lsum = 0.f;
    if (tid < 256) {
#pragma unroll
        for (int d = 0; d < 64; ++d) { q[d] = bf2f(Qrow0[(size_t)tid * 256 + d]); o[d] = 0.f; }
    }
    for (int tt = 0; tt < NT; ++tt) {
        int key0, pos0 = 0; bool masked = false;
        if (mode == 0) key0 = first_key + 64 * tt;
        else if (tt < 4) key0 = NSEQ + 64 * tt;
        else { pos0 = q0 - 128 + 64 * (tt - 4); key0 = pos0 < 0 ? 0 : (pos0 > NSEQ - 64 ? NSEQ - 64 : pos0); masked = true; }
        __syncthreads();
        for (int i = tid; i < 4096; i += NTHREADS) { const int kk = i >> 6, d = i & 63; Ks[i] = bf2f(Kb[(size_t)(key0 + kk) * 128 + d]); Vs[i] = bf2f(Vb[(size_t)(key0 + kk) * 128 + d]); }
        __syncthreads();
        if (tid < 256) {
            for (int kk = 0; kk < 64; ++kk) {
                if (masked) { const int kp = pos0 + kk, qp = q0 + tid; const int df = qp - kp; if (kp < 0 || kp >= NSEQ || df > 128 || df < -128) continue; }
                float s = 0.f;
#pragma unroll
                for (int d = 0; d < 64; ++d) s += q[d] * Ks[kk * 64 + d];
                if (s > m) { const float f = exp2f(m - s); lsum *= f;
#pragma unroll
                    for (int d = 0; d < 64; ++d) o[d] *= f;
                    m = s; }
                const float pe = exp2f(s - m); lsum += pe;
#pragma unroll
                for (int d = 0; d < 64; ++d) o[d] += pe * Vs[kk * 64 + d];
            }
        }
    }
    if (tid < 256) {
        if (use_sink) lsum += exp2f(sink_log2 - m);
        const float inv = 1.f / lsum;
#pragma unroll
        for (int d = 0; d < 64; ++d) Orow0[(size_t)tid * D + d] = (bf16_t)f2bf(o[d] * inv);
    }
    __syncthreads();
}
__device__ __forceinline__ void ph_attn(KP p, int l, unsigned char* lds) {
    hgrn_scan(p);
    bf16_t* Y = (bf16_t*)(p->ws + Z_YCAT);
    const bf16_t* Qg = (const bf16_t*)(p->ws + Z_QG); const bf16_t* Qw = (const bf16_t*)(p->ws + Z_QW); const bf16_t* Qgc = (const bf16_t*)(p->ws + Z_QGC); const bf16_t* Qwc = (const bf16_t*)(p->ws + Z_QWC);
    const bf16_t* Kg = (const bf16_t*)(p->ws + Z_KG); const bf16_t* Kw = (const bf16_t*)(p->ws + Z_KW); const bf16_t* Vg = (const bf16_t*)(p->ws + Z_VG); const bf16_t* Vw = (const bf16_t*)(p->ws + Z_VW);
    const int nunits = 512 + (l == 0 ? 16 : 0);
    for (int u = bid_(); u < nunits; u += gsz_()) {
        if (u < 256) {
            const int qb = u & 31, h = (u >> 5) & 3, b = u >> 7, row0 = b * NSEQ + qb * 256;
            attn_simple_unit(lds, Qg + (size_t)row0 * 256 + h * 64, Kg + (size_t)b * NKEY * 128 + (h >> 1) * 64, Vg + (size_t)b * NKEY * 128 + (h >> 1) * 64, 0, NKEY / 64, 0, qb * 256, false, 0.f, Y + (size_t)row0 * D + h * 64);
        } else if (u < 512) {
            const int v = u - 256, qb = v & 31, h = (v >> 5) & 3, b = v >> 7, row0 = b * NSEQ + qb * 256;
            attn_simple_unit(lds, Qw + (size_t)row0 * 256 + h * 64, Kw + (size_t)b * NKEY * 128 + (h >> 1) * 64, Vw + (size_t)b * NKEY * 128 + (h >> 1) * 64, 1, 12, 0, qb * 256, true, p->in[14][l * 4 + h] * LOG2E, Y + (size_t)row0 * D + 512 + h * 64);
        } else {
            const int v = u - 512, h = v & 3, b = (v >> 2) & 1, win = v >> 3, row0 = R_LAT + b * NCTX;
            const bf16_t* Qc = (win ? Qwc : Qgc) + (size_t)(b * NCTX) * 256 + h * 64;
            const bf16_t* Kc = (win ? Kw : Kg) + (size_t)b * NKEY * 128 + (h >> 1) * 64; const bf16_t* Vc = (win ? Vw : Vg) + (size_t)b * NKEY * 128 + (h >> 1) * 64;
            attn_simple_unit(lds, Qc, Kc, Vc, 0, 4, NSEQ, 0, win != 0, p->in[14][l * 4 + h] * LOG2E, Y + (size_t)row0 * D + (win ? 512 : 0) + h * 64);
        }
    }
}

namespace attn_body {
using bf16=__hip_bfloat16;
using bf16x8=__attribute__((ext_vector_type(8)))short;
using s16x4=__attribute__((ext_vector_type(4)))short;
using f32x16=__attribute__((ext_vector_type(16)))float;
using u32x4=__attribute__((ext_vector_type(4)))unsigned;
constexpr int D=64, QP=256, KP=128, OP=1024;
constexpr int NW=8,QBLK=32,QB=QBLK*NW,KVBLK=64;
__device__ __forceinline__ int crow(int r,int hi){return (r&3)+8*(r>>2)+4*hi;}
#define SBAR() __builtin_amdgcn_sched_barrier(0)
__device__ __forceinline__ void wmask(f32x16&p0,f32x16&p1,int tb,int qrel,int hi,int q0){
  const float NEG=-INFINITY; const int kb=64*tb+4*hi;
  #pragma unroll
  for(int r=0;r<16;++r){const int kl=kb+(r&3)+8*(r>>2); const int kp=q0-128+kl;
    if(kl<qrel||kl>qrel+256||kp<0||kp>=NSEQ)p0[r]=NEG;
    if(kl+32<qrel||kl+32>qrel+256||kp+32<0||kp+32>=NSEQ)p1[r]=NEG;}
}

constexpr int NSLOT=3, SLOTB=8192;
constexpr int LDS_K=0, LDS_V=NSLOT*SLOTB, LDS_WS=2*NSLOT*SLOTB, LDS_OST=LDS_WS+NW*64*4, LDS_BYTES=LDS_OST+NW*4096;
constexpr float C2=0.125f*1.4426950408889634f;
__device__ __forceinline__ void glds16(const void*gsrc,unsigned lds_dst){unsigned keep;
  asm volatile("s_mov_b32 %0, m0\n\ts_mov_b32 m0, %2\n\ts_nop 0\n\tglobal_load_lds_dwordx4 %1, off\n\ts_mov_b32 m0, %0":"=&s"(keep):"v"(gsrc),"s"(lds_dst):"memory");}
__device__ __forceinline__ float max3f(float a,float b,float c){float r;asm("v_max3_f32 %0, %1, %2, %3":"=v"(r):"v"(a),"v"(b),"v"(c));return r;}
__device__ __forceinline__ float max2f(float a,float b){float r;asm("v_max_f32_e32 %0, %1, %2":"=v"(r):"v"(a),"v"(b));return r;}
__device__ __forceinline__ float fadd_s(float a,float b){float r;asm("v_add_f32_e32 %0, %1, %2":"=v"(r):"v"(a),"v"(b));return r;}
__device__ __forceinline__ float fsub_s(float a,float b){float r;asm("v_sub_f32_e32 %0, %1, %2":"=v"(r):"v"(a),"v"(b));return r;}
typedef float f32x2_t __attribute__((ext_vector_type(2))); typedef __bf16 bf16x2_t __attribute__((ext_vector_type(2)));
__device__ __forceinline__ unsigned cvtpk_s(float lo,float hi){f32x2_t v={lo,hi};bf16x2_t b=__builtin_convertvector(v,bf16x2_t);return __builtin_bit_cast(unsigned,b);}
#define WAIT_BAR(N) asm volatile("s_waitcnt vmcnt(" #N ") lgkmcnt(0)\n\ts_barrier":::"memory")

__device__ __forceinline__ void qkt(f32x16&p0,f32x16&p1,const char*Kslot,const bf16x8*qr,const f32x16&negm,int r32,int hi){
  const char*kb=Kslot+hi*1024+r32*16;
  #pragma unroll
  for(int d0=0;d0<4;++d0){
    const bf16x8 b0=*reinterpret_cast<const bf16x8*>(kb+d0*2048);
    const bf16x8 b1=*reinterpret_cast<const bf16x8*>(kb+d0*2048+512);
    if(d0==0){p0=__builtin_amdgcn_mfma_f32_32x32x16_bf16(b0,qr[0],negm,0,0,0);p1=__builtin_amdgcn_mfma_f32_32x32x16_bf16(b1,qr[0],negm,0,0,0);}
    else{p0=__builtin_amdgcn_mfma_f32_32x32x16_bf16(b0,qr[d0],p0,0,0,0);p1=__builtin_amdgcn_mfma_f32_32x32x16_bf16(b1,qr[d0],p1,0,0,0);}}
}
typedef __attribute__((address_space(3))) const char* lds_cptr;
typedef short v4i16_t __attribute__((ext_vector_type(4)));
__device__ __forceinline__ void kload8(bf16x8*kf,lds_cptr kp){
  kf[0]=*(const __attribute__((address_space(3))) bf16x8*)(kp);      kf[1]=*(const __attribute__((address_space(3))) bf16x8*)(kp+512);
  kf[2]=*(const __attribute__((address_space(3))) bf16x8*)(kp+2048); kf[3]=*(const __attribute__((address_space(3))) bf16x8*)(kp+2560);
  kf[4]=*(const __attribute__((address_space(3))) bf16x8*)(kp+4096); kf[5]=*(const __attribute__((address_space(3))) bf16x8*)(kp+4608);
  kf[6]=*(const __attribute__((address_space(3))) bf16x8*)(kp+6144); kf[7]=*(const __attribute__((address_space(3))) bf16x8*)(kp+6656);
}
__device__ __forceinline__ void kload2(bf16x8*kf,lds_cptr kp,int j){ kf[2*j]=*(const __attribute__((address_space(3))) bf16x8*)(kp+j*2048); kf[2*j+1]=*(const __attribute__((address_space(3))) bf16x8*)(kp+j*2048+512); }
__device__ __forceinline__ s16x4 vtr(lds_cptr p){ return __builtin_bit_cast(s16x4,__builtin_amdgcn_ds_read_tr16_b64_v4i16((__attribute__((address_space(3))) v4i16_t*)p)); }
__device__ __forceinline__ float rowmax(const f32x16&p0,const f32x16&p1){
  float a=max3f(p0[0],p0[1],p1[0]),b=max3f(p0[2],p0[3],p1[1]);a=max3f(a,p1[2],p1[3]);
  #pragma unroll
  for(int r=4;r<16;r+=4){a=max3f(a,p0[r],p0[r+1]);b=max3f(b,p0[r+2],p0[r+3]);a=max3f(a,p1[r],p1[r+1]);b=max3f(b,p1[r+2],p1[r+3]);}
  const float m=max2f(a,b);
  auto rr=__builtin_amdgcn_permlane32_swap(__float_as_uint(m),__float_as_uint(m),false,false);
  return max2f(__uint_as_float(rr[0]),__uint_as_float(rr[1]));
}
__device__ __forceinline__ void pv(f32x16*o,int vb,bf16x8 pa0,bf16x8 pa1,bf16x8 pa2,bf16x8 pa3){
  #pragma unroll
  for(int d0=0;d0<2;++d0){s16x4 lo[4],hi[4];
    #pragma unroll
    for(int ks=0;ks<4;++ks){
      asm volatile("ds_read_b64_tr_b16 %0,%1 offset:%c2":"=&v"(lo[ks]):"v"(vb),"i"(d0*4096+ks*1024):"memory");
      asm volatile("ds_read_b64_tr_b16 %0,%1 offset:%c2":"=&v"(hi[ks]):"v"(vb),"i"(d0*4096+ks*1024+512):"memory");}
    asm volatile("s_waitcnt lgkmcnt(0)":::"memory");SBAR();
    #define PK(k) (bf16x8){lo[k][0],lo[k][1],lo[k][2],lo[k][3],hi[k][0],hi[k][1],hi[k][2],hi[k][3]}
    o[d0]=__builtin_amdgcn_mfma_f32_32x32x16_bf16(pa0,PK(0),o[d0],0,0,0);
    o[d0]=__builtin_amdgcn_mfma_f32_32x32x16_bf16(pa1,PK(1),o[d0],0,0,0);
    o[d0]=__builtin_amdgcn_mfma_f32_32x32x16_bf16(pa2,PK(2),o[d0],0,0,0);
    o[d0]=__builtin_amdgcn_mfma_f32_32x32x16_bf16(pa3,PK(3),o[d0],0,0,0);
    #undef PK
  }
}

#ifndef ATTN_STORE16
#define ATTN_STORE16(p,v) (*(u32x4*)(p)=(v))
#endif
template<int MODE,int NMASKT,int THRL> __device__ __forceinline__ void attn_unit(const bf16*Q0,const bf16*__restrict__ Kh,const bf16*__restrict__ Vh,bf16*O0,int NT,int key_first,int q0,bool use_sink,float sink_l2,char*shm){
  const int tid=tid_(),lane=tid&63,r32=lane&31,hi=lane>>5; const int wid=__builtin_amdgcn_readfirstlane(tid>>6);
  const bf16*Qw=Q0+(long)(wid*QBLK)*QP;
  auto krow=[&](int t)->long{ if(MODE==0) return (long)key_first+64*t; if(t<4) return (long)NSEQ+64*t; int p=q0-128+64*(t-4); p=p<0?0:(p>NSEQ-64?NSEQ-64:p); return (long)p; };
  const unsigned lds0=(unsigned)(uintptr_t)shm;
  float*wsf=(float*)(shm+LDS_WS)+wid*64;
  const bf16*ksrc=Kh+(long)lane*KP+wid*8;
  const bf16*vsrc=Vh+(long)(16*(wid&3)+(lane>>2))*KP+(wid>>2)*32+(lane&3)*8;
  const unsigned kdst=lds0+LDS_K+wid*1024, vdst=lds0+LDS_V+wid*1024;
  #define DMA_K(t,slot) glds16(ksrc+krow(t)*KP,(unsigned)__builtin_amdgcn_readfirstlane(kdst+(slot)))
  #define DMA_V(t,slot) glds16(vsrc+krow(t)*KP,(unsigned)__builtin_amdgcn_readfirstlane(vdst+(slot)))
  const int vb0=(int)(lds0+LDS_V)+((lane>>4)&1)*32+(lane&3)*8+(4*hi+((lane&15)>>2))*64;
  const char*Kbase=shm+LDS_K; bf16x8 kf[8];
  const lds_cptr shm3=(lds_cptr)shm; const lds_cptr kp0=shm3+LDS_K+hi*1024+r32*16; const lds_cptr vp0=shm3+LDS_V+((lane>>4)&1)*32+(lane&3)*8+(4*hi+((lane&15)>>2))*64;
  DMA_K(0,0);DMA_V(0,0);DMA_K(1,SLOTB);
  bf16x8 qr[4];
  #pragma unroll
  for(int d0=0;d0<4;++d0)qr[d0]=*reinterpret_cast<const bf16x8*>(&Qw[(long)r32*QP+d0*16+hi*8]);
  float mhat=0.f,l_reg=0.f;f32x16 o[2];o[0]=f32x16{};o[1]=f32x16{};f32x16 negm=f32x16{};asm volatile("":"+v"(negm));
  const int qrel=wid*QBLK+r32;
  #define CMASK(P0,P1,t) do{ if(NMASKT>0){int jb_=(t)-(NT-NMASKT); if(jb_>=0)wmask(P0,P1,jb_,qrel,hi,q0);} }while(0)
  bool resc=false;
  #define START(P0,P1) do{ const float rm=rowmax(P0,P1); resc=false; \
    { const float dl=rm; mhat=fadd_s(mhat,dl); \
      _Pragma("unroll") for(int r=0;r<16;++r){P0[r]=fsub_s(P0[r],dl);P1[r]=fsub_s(P1[r],dl);} \
      _Pragma("unroll") for(int r=0;r<16;++r)negm[r]=-mhat; asm volatile("":"+v"(negm)); } \
    _Pragma("unroll") for(int r=0;r<16;++r)P0[r]=__builtin_amdgcn_exp2f(P0[r]); }while(0)
  #define RESC() do{ if(resc){ asm volatile("s_waitcnt lgkmcnt(0)":::"memory"); \
      _Pragma("unroll") for(int d_=0;d_<2;++d_) _Pragma("unroll") for(int r=0;r<16;++r)o[d_][r]*=wsf[crow(r,hi)]; } }while(0)
  f32x16 pA0,pA1,pB0,pB1;
  int sl_prev=0,sl_cur=0,sl_next=SLOTB;
  #define ROT() do{sl_prev=sl_cur;sl_cur=sl_next;sl_next=(sl_next==(NSLOT-1)*SLOTB)?0:sl_next+SLOTB;}while(0)
  DMA_K(2,2*SLOTB);
  WAIT_BAR(3);
  qkt(pA0,pA1,Kbase,qr,negm,r32,hi);asm volatile("s_nop 15\n\ts_nop 7":"+v"(pA0),"+v"(pA1));CMASK(pA0,pA1,0);
  START(pA0,pA1);
  _Pragma("unroll") for(int r=0;r<16;++r)pA1[r]=__builtin_amdgcn_exp2f(pA1[r]);
  WAIT_BAR(0);
  DMA_K(3,0);DMA_V(1,SLOTB);
  ROT();
  kload8(kf,kp0+sl_cur);
  WAIT_BAR(2);
  s16x4 vlo[8],vhi[8]; u32x4 pw0,pw1,pw2,pw3;
  #define PKW(P,B) cvtpk_s(P[B],P[B+1])
  #define PAF(k) __builtin_bit_cast(bf16x8,pw##k)
  #define VFR(i) (bf16x8){vlo[i][0],vlo[i][1],vlo[i][2],vlo[i][3],vhi[i][0],vhi[i][1],vhi[i][2],vhi[i][3]}
  #define PIN(x) asm volatile("":"+v"(x))
  #define MX3(a,b,c) __builtin_fmaxf(__builtin_fmaxf((a),(b)),(c))
  #define GAPA(MF,A0,A1,A2,A3,W0,W1,PW) do{ MF; sacc+=A0; sacc+=A1; sacc+=A2; sacc+=A3; PIN(sacc); W0; W1; PIN(PW); SBAR(); }while(0)
  #define EX(v) __builtin_amdgcn_exp2f(v)
  #define GAPB(MF,X,B) do{ MF; X[B]=EX(X[B]); X[B+1]=EX(X[B+1]); X[B+2]=EX(X[B+2]); X[B+3]=EX(X[B+3]); PIN(X); SBAR(); }while(0)
  #define VRD(i) do{ vlo[i]=vtr(vp_+(((i)>>2)*4096+((i)&3)*1024)); vhi[i]=vtr(vp_+(((i)>>2)*4096+((i)&3)*1024+512)); }while(0)
  #define KRD(G,j) do{ if(G){ kload2(kf,kp0+sl_next,j); SBAR(); } }while(0)
  #define STEP(C0,C1,P0,P1,t,GK,GV,GL) do{ SBAR(); \
    const lds_cptr vp_=vp0+sl_prev; \
    VRD(0); SBAR(); float sacc=(P0[0]+P0[1]); \
    GAPA(C0=__builtin_amdgcn_mfma_f32_32x32x16_bf16(kf[0],qr[0],negm,0,0,0), P0[2],P0[3],P0[4],P0[5],     pw0[0]=PKW(P0,0), pw0[1]=PKW(P0,2), pw0); \
    VRD(4); SBAR(); GAPA(C1=__builtin_amdgcn_mfma_f32_32x32x16_bf16(kf[1],qr[0],negm,0,0,0), P0[6],P0[7],P0[8],P0[9],     pw0[2]=PKW(P0,4), pw0[3]=PKW(P0,6), pw0); \
    VRD(1); SBAR(); GAPA(C0=__builtin_amdgcn_mfma_f32_32x32x16_bf16(kf[2],qr[1],C0,0,0,0),   P0[10],P0[11],P0[12],P0[13], pw1[0]=PKW(P0,8), pw1[1]=PKW(P0,10), pw1); \
    VRD(5); SBAR(); GAPA(C1=__builtin_amdgcn_mfma_f32_32x32x16_bf16(kf[3],qr[1],C1,0,0,0),   P0[14],P0[15],P1[0],P1[1],   pw1[2]=PKW(P0,12),pw1[3]=PKW(P0,14), pw1); \
    VRD(2); SBAR(); GAPA(C0=__builtin_amdgcn_mfma_f32_32x32x16_bf16(kf[4],qr[2],C0,0,0,0),   P1[2],P1[3],P1[4],P1[5],     pw2[0]=PKW(P1,0), pw2[1]=PKW(P1,2), pw2); \
    VRD(6); SBAR(); GAPA(C1=__builtin_amdgcn_mfma_f32_32x32x16_bf16(kf[5],qr[2],C1,0,0,0),   P1[6],P1[7],P1[8],P1[9],     pw2[2]=PKW(P1,4), pw2[3]=PKW(P1,6), pw2); \
    VRD(3); SBAR(); GAPA(C0=__builtin_amdgcn_mfma_f32_32x32x16_bf16(kf[6],qr[3],C0,0,0,0),   P1[10],P1[11],P1[12],P1[13], pw3[0]=PKW(P1,8), pw3[1]=PKW(P1,10), pw3); \
    VRD(7); SBAR(); GAPA(C1=__builtin_amdgcn_mfma_f32_32x32x16_bf16(kf[7],qr[3],C1,0,0,0),   P1[14],P1[15],0.f,0.f,       pw3[2]=PKW(P1,12),pw3[3]=PKW(P1,14), pw3); \
    l_reg+=sacc; \
    if(GK){DMA_K((t)+3,sl_cur);} if(GV){DMA_V((t)+1,sl_next);} \
    CMASK(C0,C1,t); \
    { float a=MX3(C0[0],C0[1],C1[0]),b=MX3(C0[2],C0[3],C1[1]); a=MX3(a,C1[2],C1[3]); \
      _Pragma("unroll") for(int r=4;r<16;r+=4){a=MX3(a,C0[r],C0[r+1]);b=MX3(b,C0[r+2],C0[r+3]);a=MX3(a,C1[r],C1[r+1]);b=MX3(b,C1[r+2],C1[r+3]);} \
      float rm=__builtin_fmaxf(a,b); { auto rr=__builtin_amdgcn_permlane32_swap(__float_as_uint(rm),__float_as_uint(rm),false,false); rm=__builtin_fmaxf(__uint_as_float(rr[0]),__uint_as_float(rr[1])); } \
      resc=false; \
      if(__builtin_expect(__any(rm>(float)THRL),0)){ const float dl=__builtin_fmaxf(rm,0.f); mhat+=dl; \
        _Pragma("unroll") for(int r=0;r<16;++r){C0[r]-=dl;C1[r]-=dl;} \
        _Pragma("unroll") for(int r=0;r<16;++r)negm[r]=-mhat; asm volatile("":"+v"(negm)); \
        const float f=__builtin_amdgcn_exp2f(-dl); l_reg*=f; if(hi==0)wsf[r32]=f; resc=true; } } \
    SBAR(); \
    GAPB(o[0]=__builtin_amdgcn_mfma_f32_32x32x16_bf16(PAF(0),VFR(0),o[0],0,0,0), C0,0); \
    GAPB(o[1]=__builtin_amdgcn_mfma_f32_32x32x16_bf16(PAF(0),VFR(4),o[1],0,0,0), C0,4); \
    KRD(GL,0); GAPB(o[0]=__builtin_amdgcn_mfma_f32_32x32x16_bf16(PAF(1),VFR(1),o[0],0,0,0), C0,8); \
    KRD(GL,1); GAPB(o[1]=__builtin_amdgcn_mfma_f32_32x32x16_bf16(PAF(1),VFR(5),o[1],0,0,0), C0,12); \
    KRD(GL,2); GAPB(o[0]=__builtin_amdgcn_mfma_f32_32x32x16_bf16(PAF(2),VFR(2),o[0],0,0,0), C1,0); \
    KRD(GL,3); GAPB(o[1]=__builtin_amdgcn_mfma_f32_32x32x16_bf16(PAF(2),VFR(6),o[1],0,0,0), C1,4); \
    GAPB(o[0]=__builtin_amdgcn_mfma_f32_32x32x16_bf16(PAF(3),VFR(3),o[0],0,0,0), C1,8); \
    GAPB(o[1]=__builtin_amdgcn_mfma_f32_32x32x16_bf16(PAF(3),VFR(7),o[1],0,0,0), C1,12); \
    }while(0)
  int t=1;
  #undef CMASK
  #define CMASK(P0,P1,t) do{}while(0)
  for(;t+1+(NMASKT>4?NMASKT:4)<NT;t+=2){
    STEP(pB0,pB1,pA0,pA1,t,true,true,true);     WAIT_BAR(2); RESC(); ROT();
    STEP(pA0,pA1,pB0,pB1,t+1,true,true,true);   WAIT_BAR(2); RESC(); ROT();
  }
  #undef CMASK
  #define CMASK(P0,P1,t) do{ if(NMASKT>0){int jb_=(t)-(NT-NMASKT); if(jb_>=0)wmask(P0,P1,jb_,qrel,hi,q0);} }while(0)
  #define ENDW(tt) do{ if((tt)+3<NT){WAIT_BAR(2);} else if((tt)+2<NT){WAIT_BAR(1);} else {WAIT_BAR(0);} }while(0)
  for(;t+1<NT;t+=2){
    STEP(pB0,pB1,pA0,pA1,t,(t+3<NT),(t+1<NT),(t+1<NT));       ENDW(t);   RESC(); ROT();
    STEP(pA0,pA1,pB0,pB1,t+1,(t+4<NT),(t+2<NT),(t+2<NT));     ENDW(t+1); RESC(); ROT();
  }
  STEP(pB0,pB1,pA0,pA1,NT-1,false,false,false); RESC();
  { float sacc=pB0[0]+pB0[1]; _Pragma("unroll") for(int r=2;r<16;++r)sacc+=pB0[r]; _Pragma("unroll") for(int r=0;r<16;++r)sacc+=pB1[r]; l_reg+=sacc;
    pw0=(u32x4){PKW(pB0,0),PKW(pB0,2),PKW(pB0,4),PKW(pB0,6)};pw1=(u32x4){PKW(pB0,8),PKW(pB0,10),PKW(pB0,12),PKW(pB0,14)};pw2=(u32x4){PKW(pB1,0),PKW(pB1,2),PKW(pB1,4),PKW(pB1,6)};pw3=(u32x4){PKW(pB1,8),PKW(pB1,10),PKW(pB1,12),PKW(pB1,14)};
    SBAR(); pv(o,vb0+sl_cur,PAF(0),PAF(1),PAF(2),PAF(3)); }
  #undef PKW
  #undef PAF
  #undef VFR
  #undef PIN
  #undef MX3
  #undef GAPA
  #undef GAPB
  #undef EX
  #undef VRD
  #undef KRD
  #undef STEP
  #undef ENDW
  {auto rr=__builtin_amdgcn_permlane32_swap(__float_as_uint(l_reg),__float_as_uint(l_reg),false,false);l_reg=__uint_as_float(rr[0])+__uint_as_float(rr[1]);}
  if(use_sink)l_reg+=__builtin_amdgcn_exp2f(sink_l2-mhat);
  if(hi==0)wsf[32+r32]=l_reg;asm volatile("s_waitcnt lgkmcnt(0)":::"memory");
  float rli[16];
  #pragma unroll
  for(int r=0;r<16;++r)rli[r]=__builtin_amdgcn_rcpf(wsf[32+crow(r,hi)]);
  bf16*Ow=O0+(long)(wid*QBLK)*OP;
  { bf16*stg=(bf16*)(shm+LDS_OST)+wid*2048;
    #pragma unroll
    for(int r=0;r<16;++r){const int orow=crow(r,hi);
      #pragma unroll
      for(int d0=0;d0<2;++d0)stg[orow*64+d0*32+r32]=__float2bfloat16(o[d0][r]*rli[r]);}
    asm volatile("s_waitcnt lgkmcnt(0)":::"memory");
    #pragma unroll
    for(int i=0;i<4;++i){const int row=i*8+(lane>>3),ch=lane&7; const u32x4 v=*(const u32x4*)(stg+row*64+ch*8); ATTN_STORE16(Ow+(long)row*OP+ch*8,v);} }
  asm volatile("s_waitcnt lgkmcnt(0)\n\ts_barrier":::"memory");
  #undef DMA_K
  #undef DMA_V
  #undef CMASK
  #undef START
  #undef RESC
  #undef ROT
}
constexpr int ATTN_LDS_BYTES=LDS_BYTES;
#undef SBAR
#undef WAIT_BAR
}

__device__ __forceinline__ void ph_attn_f(KP p, int l, unsigned char* lds, bool do_scan = true) {
    if (do_scan) { if (FAST_HGRN) hgrn_scan_f(p); else hgrn_scan(p); }
    using attn_body::bf16;
    bf16* Y = (bf16*)(p->ws + Z_YCAT);
    const bf16* Qg = (const bf16*)(p->ws + Z_QG); const bf16* Qw = (const bf16*)(p->ws + Z_QW); const bf16* Qgc = (const bf16*)(p->ws + Z_QGC); const bf16* Qwc = (const bf16*)(p->ws + Z_QWC);
    const bf16* Kg = (const bf16*)(p->ws + Z_KG); const bf16* Kw = (const bf16*)(p->ws + Z_KW); const bf16* Vg = (const bf16*)(p->ws + Z_VG); const bf16* Vw = (const bf16*)(p->ws + Z_VW);
    const int G = gsz_(), bid = bid_();
    __syncthreads();
    for (int vb = bid; vb < 256; vb += G) {
        const int v = (G == 256) ? (((vb & 7) >> 1) * 64 + (vb & 1) * 32 + (vb >> 3)) : vb;
        const int b = v >> 7, kvh = (v >> 6) & 1, h = kvh * 2 + ((v >> 5) & 1), qb = v & 31, row0 = b * NSEQ + qb * 256;
        const size_t kvo = (size_t)b * NKEY * 128 + kvh * 64;
        attn_body::attn_unit<0, 0, 8>(Qg + (size_t)row0 * 256 + h * 64, Kg + kvo, Vg + kvo, Y + (size_t)row0 * D + h * 64, NKEY / 64, 0, 0, false, 0.f, (char*)lds);
        attn_body::attn_unit<1, 8, 8>(Qw + (size_t)row0 * 256 + h * 64, Kw + kvo, Vw + kvo, Y + (size_t)row0 * D + 512 + h * 64, 12, 0, qb * 256, true, p->in[14][l * 4 + h] * LOG2E, (char*)lds);
    }
    if (l == 0) for (int v = bid; v < 16; v += G) {
        const int h = v & 3, b = (v >> 2) & 1, win = v >> 3, row0 = R_LAT + b * NCTX;
        const size_t kvo = (size_t)b * NKEY * 128 + (h >> 1) * 64;
        attn_body::attn_unit<0, 0, 8>((win ? Qwc : Qgc) + (size_t)(b * NCTX) * 256 + h * 64, (win ? Kw : Kg) + kvo, (win ? Vw : Vg) + kvo, Y + (size_t)row0 * D + (win ? 512 : 0) + h * 64, 4, NSEQ, 0, win != 0, p->in[14][l * 4 + h] * LOG2E, (char*)lds);
    }
}

__device__ __forceinline__ void hgrn_pass3_unit(KP p, int l, unsigned char* lds, int unit) {
    float* qs = (float*)lds; float* vs = qs + 4096; float* ks = vs + 4096; float* cs = ks + 4096; float* Ss = cs + 4096; float* sc = Ss + 4096; float* os = sc + 4096;
    const int tid = tid_(), lane = tid & 63, wid = tid >> 6;
    const int cpos = unit % NCHUNK, head = (unit / NCHUNK) & 3, b = unit / (NCHUNK * 4);
    const int row0 = (cpos < 4) ? R_LAT + b * NCTX + cpos * 64 : b * NSEQ + (cpos - 4) * 64;
    for (int i = tid; i < 4096; i += NTHREADS) os[i] = 0.f;
    for (int dir = 0; dir < 2; ++dir) {
        const int j = (cpos < 4) ? (dir ? 3 - cpos : cpos) : 4 + (dir ? 127 - (cpos - 4) : (cpos - 4));
        const int seq = (b * 4 + head) * 2 + dir;
        __syncthreads();
        hgrn_load_chunk(p, l, row0, dir, head, qs, vs, ks, cs);
        const float* Sg = (const float*)(p->ws + Z_U) + ((size_t)seq * NCHUNK + j) * 4096;
        for (int i = tid; i < 4096; i += NTHREADS) Ss[i] = Sg[i];
        for (int i = tid; i < 4096; i += NTHREADS) { const int tau = i >> 6, sig = i & 63; float a = 0.f;
            if (sig <= tau) { for (int d = 0; d < 64; ++d) a += qs[tau * 64 + d] * ks[sig * 64 + d] * __expf(cs[tau * 64 + d] - cs[sig * 64 + d]); }
            sc[i] = a; }
        __syncthreads();
        { const int tau = tid >> 3, e0 = (tid & 7) * 8; float acc[8];
#pragma unroll
          for (int e = 0; e < 8; ++e) acc[e] = 0.f;
          for (int d = 0; d < 64; ++d) { const float qv = qs[tau * 64 + d] * __expf(cs[tau * 64 + d]);
#pragma unroll
              for (int e = 0; e < 8; ++e) acc[e] += qv * Ss[d * 64 + e0 + e]; }
          for (int sig = 0; sig <= tau; ++sig) { const float sv = sc[tau * 64 + sig];
#pragma unroll
              for (int e = 0; e < 8; ++e) acc[e] += sv * vs[sig * 64 + e0 + e]; }
          const int tok = dir ? 63 - tau : tau;
#pragma unroll
          for (int e = 0; e < 8; ++e) os[tok * 64 + e0 + e] += acc[e]; }
        __syncthreads();
    }
    const bf16_t* P = (const bf16_t*)(p->ws + Z_P); bf16_t* Y = (bf16_t*)(p->ws + Z_YCAT);
    for (int tok = wid; tok < 64; tok += 8) { const float v = os[tok * 64 + lane];
        const float y = v * rsqrtf(wave_sum(v * v) * (1.f / 64.f) + EPS) * p->in[22][l * 64 + lane];
        const float g = bf2f(P[(size_t)(row0 + tok) * DIN + C_RG + head * 64 + lane]);
        Y[(size_t)(row0 + tok) * D + 768 + head * 64 + lane] = (bf16_t)f2bf(y * silu_(g)); }
    __syncthreads();
}
__device__ __forceinline__ void ph_hgrn3(KP p, int l, unsigned char* lds) {
    hgrn_pass3_run(p, l, lds);
    if (l == 0 && DEPTH > 1 && gsz_() == 256) { __syncthreads(); ph_cvt(p, 1, lds, 32, 224, CVT_E1, CVT_E2); }
}

__device__ __forceinline__ void ph_outproj(KP p, int l, unsigned char* lds) {
    const bf16_t* A = (const bf16_t*)(p->ws + Z_YCAT); const bf16_t* Bt = (const bf16_t*)(p->ws + Z_WOUT); float* X = (float*)(p->ws + WS_X);
    const int T = (l == 0) ? R_ALL : R_LAT; const int TM = T / 128, TN = 8;
    for (int it = bid_(); it < TM * TN; it += gsz_()) { const int mt = it / TN, nt = it % TN;
        auto epi = [&](int row, int col, float v, float) { const int c = nt * 128 + col; X[(size_t)row * D + c] = xrow_src(p, l, row)[c] + mod_vec(p, l, row, 2)[c] * v; };
        gemm_simple_tile<1>(A, RowId{}, Bt, 1024, mt * 128, nt * 128, 0, epi); }
}

__device__ __forceinline__ void ph_norm2(KP p, int l, unsigned char* lds, int cnt_off = 0) {
    constexpr int RS = 1032, NSTG = 80;
    const int T = (l == 0) ? R_ALL : R_LAT;
    bf16_t* AH = (bf16_t*)lds; bf16_t* AL = AH + 16 * RS;
    float* PART = (float*)(lds + 2 * 16 * RS * 2); float* LOG = PART + 8 * 16 * 64;
    int* hist = (int*)(LOG + 16 * 64); int* hbase = hist + 64; int* s_e = hbase + 64; int* s_r = s_e + NSTG * 8; float* s_w = (float*)(s_r + NSTG * 8); float* msb = s_w + NSTG * 8;
    const int tid = tid_(), lane = tid & 63, wid = tid >> 6, fr = lane & 15, fq = lane >> 4, bid = bid_(), G = gsz_();
    bf16_t* Tok = (bf16_t*)(p->ws + Z_A); const bf16_t* X = (const bf16_t*)(p->ws + WS_X);
    const float* g2 = p->in[7] + l * D; const float* rw = p->in[23] + (size_t)l * 1024 * 64; const float* rbias = p->in[24] + l * 64;
    unsigned* cnt = (unsigned*)(p->ws + WS_CTL) + CW_CNT + cnt_off + l * 64;
    int* tok_e = (int*)(p->ws + WS_TOKE); int* tok_p = (int*)(p->ws + WS_TOKP); int* expl = (int*)(p->ws + WS_EXPL); float* expw = (float*)(p->ws + WS_EXPW);
    bf16x8 bh[4][4], bl[4][4];
    { const u32x4* RF = (const u32x4*)(p->ws + WS_RFRAG) + (size_t)((l * 8 + wid) * 16) * 128 + lane * 2;
#pragma unroll
      for (int t = 0; t < 4; ++t)
#pragma unroll
          for (int k = 0; k < 4; ++k) { bh[t][k] = __builtin_bit_cast(bf16x8, RF[(t * 4 + k) * 128]); bl[t][k] = __builtin_bit_cast(bf16x8, RF[(t * 4 + k) * 128 + 1]); } }
    const float mybias = rbias[lane];
    const int rpb = (T + G - 1) / G;
    for (int base = bid * rpb; base < T; base += G * rpb) {
        const int r1 = (base + rpb < T) ? base + rpb : T;
        if (tid < 64) hist[tid] = 0;
        for (int s0 = base; s0 < r1; s0 += 16) {
#pragma unroll
            for (int j2 = 0; j2 < 2; ++j2) { const int lr = wid * 2 + j2, row = s0 + lr;
                if (row < r1) {
                    const bf16_t* xrow = X + (size_t)row * D; const float* shift = mod_vec(p, l, row, 3); const float* scale = mod_vec(p, l, row, 4);
                    f32x4 v[4]; float ssq = 0.f;
#pragma unroll
                    for (int j = 0; j < 4; ++j) { const u32x2 r2 = ((const u32x2*)xrow)[lane + 64 * j]; v[j].x = bf2f(r2.x & 0xffffu); v[j].y = bf2f(r2.x >> 16); v[j].z = bf2f(r2.y & 0xffffu); v[j].w = bf2f(r2.y >> 16); ssq += v[j].x * v[j].x + v[j].y * v[j].y + v[j].z * v[j].z + v[j].w * v[j].w; }
                    const float rinv = rsqrtf(wave_sum(ssq) * (1.f / D) + EPS);
#pragma unroll
                    for (int j = 0; j < 4; ++j) { const int idx = lane + 64 * j;
                        const f32x4 gg = ((const f32x4*)g2)[idx], sh = ((const f32x4*)shift)[idx], sc = ((const f32x4*)scale)[idx];
                        f32x4 y; y.x = v[j].x * rinv * gg.x * (1.f + sc.x) + sh.x; y.y = v[j].y * rinv * gg.y * (1.f + sc.y) + sh.y;
                        y.z = v[j].z * rinv * gg.z * (1.f + sc.z) + sh.z; y.w = v[j].w * rinv * gg.w * (1.f + sc.w) + sh.w;
                        u32x2 h; h.x = pk2(y.x, y.y); h.y = pk2(y.z, y.w);
                        u32x2 lw; lw.x = pk2(y.x - bf2f(h.x & 0xffffu), y.y - bf2f(h.x >> 16)); lw.y = pk2(y.z - bf2f(h.y & 0xffffu), y.w - bf2f(h.y >> 16));
                        { int t8 = __builtin_amdgcn_cvt_pk_fp8_f32(clamp8(y.x * TOK8_SCALE), clamp8(y.y * TOK8_SCALE), 0, false); t8 = __builtin_amdgcn_cvt_pk_fp8_f32(clamp8(y.z * TOK8_SCALE), clamp8(y.w * TOK8_SCALE), t8, true);
                          ((unsigned*)((unsigned char*)Tok + (size_t)row * D))[idx] = (unsigned)t8; }
                        *(u32x2*)(AH + lr * RS + idx * 4) = h; *(u32x2*)(AL + lr * RS + idx * 4) = lw; }
                } else {
#pragma unroll
                    for (int j = 0; j < 4; ++j) { const int idx = lane + 64 * j; const u32x2 z = {0u, 0u}; *(u32x2*)(AH + lr * RS + idx * 4) = z; *(u32x2*)(AL + lr * RS + idx * 4) = z; } } }
            __syncthreads();
            { f32x4 acc[4];
#pragma unroll
              for (int t = 0; t < 4; ++t) acc[t] = (f32x4){0.f, 0.f, 0.f, 0.f};
#pragma unroll
              for (int k = 0; k < 4; ++k) { const int ko = (wid * 4 + k) * 32 + fq * 8;
                  const bf16x8 ah = *(const bf16x8*)(AH + fr * RS + ko), al = *(const bf16x8*)(AL + fr * RS + ko);
#pragma unroll
                  for (int t = 0; t < 4; ++t) { acc[t] = __builtin_amdgcn_mfma_f32_16x16x32_bf16(ah, bh[t][k], acc[t], 0, 0, 0);
                      acc[t] = __builtin_amdgcn_mfma_f32_16x16x32_bf16(ah, bl[t][k], acc[t], 0, 0, 0); acc[t] = __builtin_amdgcn_mfma_f32_16x16x32_bf16(al, bh[t][k], acc[t], 0, 0, 0); } }
#pragma unroll
              for (int t = 0; t < 4; ++t)
#pragma unroll
                  for (int r = 0; r < 4; ++r) PART[(wid * 16 + fq * 4 + r) * 64 + t * 16 + fr] = acc[t][r]; }
            __syncthreads();
#pragma unroll
            for (int q = 0; q < 2; ++q) { const int o = tid + q * NTHREADS; float a = 0.f;
#pragma unroll
                for (int w8 = 0; w8 < 8; ++w8) a += PART[w8 * 1024 + o];
                LOG[o] = a; }
            __syncthreads();
#pragma unroll 1
            for (int j2 = 0; j2 < 2; ++j2) { const int lr = wid * 2 + j2, row = s0 + lr;
                if (row >= r1) continue;
                const int sr = row - base;
                const float score = sigmoid_(LOG[lr * 64 + lane]), sel = score + mybias;
                const int e = lane, g = e >> 3;
                int rg = 0;
#pragma unroll
                for (int i = 1; i < 8; ++i) { const int src = (lane & ~7) | ((lane + i) & 7); const float o = __shfl(sel, src); rg += (int)(o > sel) | ((int)(o == sel) & (int)(src < e)); }
                float top2 = (rg < 2) ? sel : 0.f;
                top2 += __shfl_xor(top2, 1); top2 += __shfl_xor(top2, 2); top2 += __shfl_xor(top2, 4);
                int grank = 0;
#pragma unroll
                for (int i = 1; i < 8; ++i) { const int og = (g + i) & 7; const float o = __shfl(top2, og * 8); grank += (int)(o > top2) | ((int)(o == top2) & (int)(og < g)); }
                const bool keep = grank < 4;
                const float ms = keep ? sel : -INFINITY;
                float* mrow = msb + wid * 64;
                mrow[lane] = ms;
                __builtin_amdgcn_wave_barrier();
                int rk = 0;
#pragma unroll 4
                for (int i = 0; i < 16; ++i) { const f32x4 o = *(const f32x4*)(mrow + 4 * i);
                    rk += (int)(o.x > ms) | ((int)(o.x == ms) & (int)(4 * i + 0 < e)); rk += (int)(o.y > ms) | ((int)(o.y == ms) & (int)(4 * i + 1 < e));
                    rk += (int)(o.z > ms) | ((int)(o.z == ms) & (int)(4 * i + 2 < e)); rk += (int)(o.w > ms) | ((int)(o.w == ms) & (int)(4 * i + 3 < e)); }
                __builtin_amdgcn_wave_barrier();
                const bool chosen = keep && rk < 8;
                const float wsum = wave_sum(chosen ? score : 0.f);
                if (chosen) { const int r = atomicAdd(&hist[e], 1); s_e[sr * 8 + rk] = e; s_r[sr * 8 + rk] = r; s_w[sr * 8 + rk] = score / wsum * 2.5f; } }
        }
        __syncthreads();
        if (tid < 64) { const int h = hist[tid]; hbase[tid] = h ? (int)atomicAdd(&cnt[tid], (unsigned)h) : 0; }
        __syncthreads();
        for (int i = tid; i < (r1 - base) * 8; i += NTHREADS) { const int e = s_e[i]; const size_t o = (size_t)base * 8 + i;
            const int pos = hbase[e] + s_r[i]; tok_e[o] = e; tok_p[o] = pos; expl[(size_t)e * R_ALL + pos] = base + (i >> 3); expw[(size_t)e * R_ALL + pos] = s_w[i]; }
        __syncthreads();
    }
}

__device__ __forceinline__ void moe_pad_starts(KP p, int l, int* ps) {
    const unsigned* cnt = (const unsigned*)(p->ws + WS_CTL) + CW_CNT + l * 64;
    const int tid = tid_();
    if (tid < 64) { const int v = (int)((cnt[tid] + 255u) >> 8) << 8; int incl = v;
#pragma unroll
        for (int d = 1; d < 64; d <<= 1) { const int o = __shfl_up(incl, d); if (tid >= d) incl += o; }
        ps[tid] = incl - v; if (tid == 63) ps[64] = incl; }
    __syncthreads();
}
__device__ __forceinline__ int moe_expert_of_row(const int* ps, int row) { int e = 0;
#pragma unroll
    for (int step = 32; step >= 1; step >>= 1) if (row >= ps[e + step]) e += step;
    return e; }

__device__ __forceinline__ void ph_slots(KP p, int l, unsigned char* lds) {
    const int T = (l == 0) ? R_ALL : R_LAT;
    int* ps = (int*)lds; moe_pad_starts(p, l, ps);
    const unsigned* cnt = (const unsigned*)(p->ws + WS_CTL) + CW_CNT + l * 64;
    const int* tok_e = (const int*)(p->ws + WS_TOKE); const int* tok_p = (const int*)(p->ws + WS_TOKP); const float* tok_w = (const float*)(p->ws + WS_TOKW);
    int* tok_s = (int*)(p->ws + WS_TOKS); int* slot_t = (int*)(p->ws + WS_SLOTT); float* slot_w = (float*)(p->ws + WS_SLOTW);
    for (int i = bid_() * NTHREADS + tid_(); i < T * 8; i += gsz_() * NTHREADS) { const int e = tok_e[i], slot = ps[e] + tok_p[i]; tok_s[i] = slot; slot_t[slot] = i >> 3; slot_w[slot] = tok_w[i]; }
    for (int i = bid_() * NTHREADS + tid_(); i < T; i += gsz_() * NTHREADS) { slot_t[MAXSLOT + i] = i; slot_w[MAXSLOT + i] = 1.f; }
    for (int i = bid_() * NTHREADS + tid_(); i < 64 * 256; i += gsz_() * NTHREADS) { const int e = i >> 8, j = i & 255; const int r = ps[e] + (int)cnt[e] + j; if (r < ps[e + 1]) { slot_t[r] = 0; slot_w[r] = 0.f; } }
    __syncthreads();
}

__device__ __forceinline__ void ph_gateup(KP p, int l, unsigned char* lds) {
    const int T = (l == 0) ? R_ALL : R_LAT;
    int* ps = (int*)lds; moe_pad_starts(p, l, ps);
    const bf16_t* Tok = (const bf16_t*)(p->ws + Z_A); const bf16_t* Wgu = (const bf16_t*)(p->ws + Z_WGU); bf16_t* H = (bf16_t*)(p->ws + Z_H);
    const int* slot_t = (const int*)(p->ws + WS_SLOTT); const float* slot_w = (const float*)(p->ws + WS_SLOTW);
    const int n128 = ps[64] / 128, nitems = (n128 + T / 128) * 2;
    for (int it = bid_(); it < nitems; it += gsz_()) { const int rt = it >> 1, pn = it & 1;
        if (rt < n128) { const int e = moe_expert_of_row(ps, rt * 128);
            auto epi = [&](int row, int col, float g, float u) { H[(size_t)row * 256 + pn * 128 + col] = (bf16_t)f2bf(silu_(g) * u * slot_w[row]); };
            gemm_simple_tile<2>(Tok, RowGather{slot_t}, Wgu + (size_t)e * 524288, 1024, rt * 128, pn * 256, 128, epi);
        } else { const int t0 = (rt - n128) * 128;
            auto epi = [&](int row, int col, float g, float u) { H[(size_t)(MAXSLOT + row) * 256 + pn * 128 + col] = (bf16_t)f2bf(silu_(g) * u); };
            gemm_simple_tile<2>(Tok, RowId{}, Wgu + (size_t)64 * 524288, 1024, t0, pn * 256, 128, epi); }
    }
}
__device__ __forceinline__ void ph_down(KP p, int l, unsigned char* lds) {
    const int T = (l == 0) ? R_ALL : R_LAT;
    int* ps = (int*)lds; moe_pad_starts(p, l, ps);
    const bf16_t* H = (const bf16_t*)(p->ws + Z_H); const bf16_t* Wd = (const bf16_t*)(p->ws + WS_WD); bf16_t* Y = (bf16_t*)(p->ws + Z_Y); float* X = (float*)(p->ws + WS_X);
    const int n128 = ps[64] / 128, nitems = (n128 + T / 128) * 8;
    for (int it = bid_(); it < nitems; it += gsz_()) { const int rt = it >> 3, nt = it & 7;
        if (rt < n128) { const int e = moe_expert_of_row(ps, rt * 128);
            auto epi = [&](int row, int col, float v, float) { Y[(size_t)row * D + nt * 128 + col] = (bf16_t)f2bf(v); };
            gemm_simple_tile<1>(H, RowId{}, Wd + (size_t)e * 262144, 256, rt * 128, nt * 128, 0, epi);
        } else { const int t0 = (rt - n128) * 128;
            auto epi = [&](int row, int col, float v, float) { const int t = row - MAXSLOT, c = nt * 128 + col; X[(size_t)t * D + c] += mod_vec(p, l, t, 5)[c] * v; };
            gemm_simple_tile<1>(H, RowId{}, Wd + (size_t)64 * 262144, 256, MAXSLOT + t0, nt * 128, 0, epi); }
    }
}
__device__ __forceinline__ void ph_combine(KP p, int l, unsigned char* lds) {
    typedef float f32x2 __attribute__((ext_vector_type(2)));
    const int T = (l == 0) ? R_ALL : R_LAT;
    const int tid = tid_(), lane = tid & 63, wid = tid >> 6;
    const unsigned char* Y8 = (const unsigned char*)(p->ws + Z_Y); bf16_t* X = (bf16_t*)(p->ws + WS_X); const int* tok_e = (const int*)(p->ws + WS_TOKE); const int* tok_p = (const int*)(p->ws + WS_TOKP);
    int* ps = (int*)lds; moe_pad_starts(p, l, ps);
    const size_t yoff = (size_t)(lane >> 4) * MAXSLOT * 256 + (lane & 15) * 16;
    for (int row = bid_() * 8 + wid; row < T; row += gsz_() * 8) {
        const float* g5 = mod_vec(p, l, row, 5) + lane * 16;
        bf16_t* xr = X + (size_t)row * D + lane * 16;
        const int myslot = ps[tok_e[row * 8 + (lane & 7)]] + tok_p[row * 8 + (lane & 7)];
        u32x4 yv[8];
#pragma unroll
        for (int k = 0; k < 8; ++k) { const int sl = __shfl(myslot, k); yv[k] = *(const u32x4*)(Y8 + yoff + (size_t)sl * 256); }
        f32x4 xv[4], gv[4];
#pragma unroll
        for (int q = 0; q < 4; ++q) gv[q] = *(const f32x4*)(g5 + 4 * q);
        unpack8(*(const u32x4*)xr, xv[0], xv[1]); unpack8(*(const u32x4*)(xr + 8), xv[2], xv[3]);
        float a[16];
#pragma unroll
        for (int q = 0; q < 16; ++q) a[q] = 0.f;
#pragma unroll
        for (int k = 0; k < 8; ++k) { const unsigned w[4] = {yv[k].x, yv[k].y, yv[k].z, yv[k].w};
#pragma unroll
            for (int q = 0; q < 4; ++q) { const f32x2 lo = __builtin_amdgcn_cvt_pk_f32_fp8((int)w[q], false), hi = __builtin_amdgcn_cvt_pk_f32_fp8((int)w[q], true);
                a[4 * q] += lo.x; a[4 * q + 1] += lo.y; a[4 * q + 2] += hi.x; a[4 * q + 3] += hi.y; } }
#pragma unroll
        for (int q = 0; q < 4; ++q) { f32x4 av; av.x = a[4 * q]; av.y = a[4 * q + 1]; av.z = a[4 * q + 2]; av.w = a[4 * q + 3]; xv[q] = xv[q] + gv[q] * (av * (1.f / Y8_SCALE)); }
        if (l == DEPTH - 1) { float* dst = p->out + (size_t)row * D + lane * 16;
#pragma unroll
            for (int q = 0; q < 4; ++q) *(f32x4*)(dst + 4 * q) = xv[q]; }
        else { *(u32x4*)xr = (u32x4){pk2(xv[0].x, xv[0].y), pk2(xv[0].z, xv[0].w), pk2(xv[1].x, xv[1].y), pk2(xv[1].z, xv[1].w)};
               *(u32x4*)(xr + 8) = (u32x4){pk2(xv[2].x, xv[2].y), pk2(xv[2].z, xv[2].w), pk2(xv[3].x, xv[3].y), pk2(xv[3].z, xv[3].w)}; }
    }
}
struct MoeSched {
    int ntr, nrt, npn, G, c; const LAS int* tile_e;
    __device__ __forceinline__ bool map(int i, int& rt, int& pp) const {
        if (G == 256) { const int x = c & 7, j = c >> 3, tb = 32 / npn; rt = (i * 8 + x) * tb + j / npn; pp = j % npn; return rt < nrt; }
        const int L = i * G + c; if (L >= nrt * npn) return false;
        rt = L / npn; pp = L % npn; return true; }
    __device__ __forceinline__ bool next(int i, pg8::Unit& u) const {
        int rt, pp; if (!map(i, rt, pp)) return false;
        const bool routed = rt < ntr;
        const int e = routed ? __builtin_amdgcn_readfirstlane(tile_e[rt]) : 64;
        u.pm = routed ? rt : MAXSLOT / 256 + (rt - ntr); u.pn = e * npn + pp; u.ord = i; return true;
    }
};
constexpr int MOE_UNITS = 6;
constexpr int LDS_RTAB = 131072, LDS_WTAB = LDS_RTAB + MOE_UNITS * 1024, LDS_TILE_E = LDS_WTAB + MOE_UNITS * 1024, LDS_PS = LDS_TILE_E + 2400;
static_assert(LDS_PS + 129 * 4 <= LDS_BYTES - 16, "MoE tables fit above the staging buffers");
__device__ __forceinline__ MoeSched moe_setup(KP p, int l, unsigned char* lds, int npn, bool gather) {
    const int T = (l == 0) ? R_ALL : R_LAT;
    int* ps = (int*)(lds + LDS_PS); int* cl = ps + 65;
    const unsigned* cnt = (const unsigned*)(p->ws + WS_CTL) + CW_CNT + l * 64;
    const int tid = tid_();
    if (tid < 64) cl[tid] = (int)cnt[tid];
    moe_pad_starts(p, l, ps);
    LAS int* tile_e = (LAS int*)((LAS unsigned char*)lds + LDS_TILE_E); LAS int* rtab = (LAS int*)((LAS unsigned char*)lds + LDS_RTAB); LAS float* wtab = (LAS float*)((LAS unsigned char*)lds + LDS_WTAB);
    const int ntr = ps[64] / 256;
    for (int rt = tid; rt < ntr; rt += NTHREADS) tile_e[rt] = moe_expert_of_row(ps, rt * 256);
    __syncthreads();
    MoeSched S{ntr, ntr + T / 256, npn, gsz_(), bid_(), tile_e};
    if (gather) { const int* expl = (const int*)(p->ws + WS_EXPL); const float* expw = (const float*)(p->ws + WS_EXPW);
        int tok[3]; float w[3];
#pragma unroll
        for (int q = 0; q < 3; ++q) { const int idx = tid + q * NTHREADS, i = idx >> 8, r = idx & 255; tok[q] = 0; w[q] = 0.f;
            int rt, pp_;
            if (S.map(i, rt, pp_)) {
                if (rt < S.ntr) { const int e = tile_e[rt], pos = rt * 256 + r - ps[e];
                    if (pos < cl[e]) { tok[q] = expl[(size_t)e * R_ALL + pos]; w[q] = expw[(size_t)e * R_ALL + pos]; } }
                else { tok[q] = (rt - S.ntr) * 256 + r; w[q] = 1.f; } } }
#pragma unroll
        for (int q = 0; q < 3; ++q) { const int idx = tid + q * NTHREADS; rtab[idx] = tok[q]; wtab[idx] = w[q]; } }
    __syncthreads();
    return S;
}
__device__ __forceinline__ void ph_gateup_f(KP p, int l, unsigned char* lds) {
    const MoeSched S = moe_setup(p, l, lds, 2, true);
    pg8::Gemm g{(const bf16_t*)(p->ws + Z_A), (const bf16_t*)(p->ws + wgu_off(l)), 0, 0, 1024};
    pg8::EpiGU8 E{(unsigned char*)(p->ws + Z_H), (const LAS float*)((LAS unsigned char*)lds + LDS_WTAB)};
    pg8::gemm_phase<pg8::EpiGU8, MoeSched, true, true>((LAS unsigned char*)lds, g, S, E, (const LAS int*)((LAS unsigned char*)lds + LDS_RTAB));
}
__device__ __forceinline__ void ph_down_f(KP p, int l, unsigned char* lds) {
    const MoeSched S = moe_setup(p, l, lds, 4, false);
    pg8::Gemm g{(const bf16_t*)(p->ws + Z_H), (const bf16_t*)(p->ws + wd_off(l)), 0, 0, 256};
    bf16_t* X = (bf16_t*)(p->ws + WS_X);
    pg8::EpiDown E{(bf16_t*)(p->ws + Z_Y), X, (const float*)(p->ws + WS_MOD) + (size_t)l * 3 * 6144 + 5 * 1024};
    pg8::gemm_phase<pg8::EpiDown, MoeSched, false, true>((LAS unsigned char*)lds, g, S, E, nullptr);
}

#ifndef FAST_ATTN
#define FAST_ATTN 1
#endif
#ifndef FAST_GEMM
#define FAST_GEMM 15
#endif
constexpr int PH_PER_LAYER = 10, N_PHASES = 1 + DEPTH * PH_PER_LAYER;
__global__ void __launch_bounds__(NTHREADS, 2) mega(Params parg) {
    extern __shared__ __attribute__((aligned(16))) unsigned char lds[];
    const int lo = parg.ph_lo, hi = parg.ph_hi;
    volatile LAS unsigned* xbw = (volatile LAS unsigned*)(lds + LDS_BYTES - 16);
    if (threadIdx.x == 0) { xbw[0] = 0u; xbw[1] = 0u; xbw[2] = 0u; xbw[3] = 0u; }
    if ((threadIdx.x & 63) == 0) *(volatile LAS int*)((LAS unsigned char*)lds + LDS_WVTAB_OFF + 4 * hwkey_()) = (int)(threadIdx.x >> 6);
    __syncthreads();
    XcdBarrier bar; bar.bar = (unsigned*)(parg.ws + WS_CTL) + CW_BAR; bar.x = 0; bar.st = xbw;
    if (hi - lo > 1) bar = xcd_barrier_post((unsigned*)(parg.ws + WS_CTL) + CW_BAR, xbw);
#ifdef PHMASK
#define IN(k) ((((PHMASK) >> ((k) == 0 ? 0 : ((k) - 1) % PH_PER_LAYER + 1)) & 1) && lo <= (k) && (k) < hi)
#else
#define IN(k) (lo <= (k) && (k) < hi)
#endif
#define SEAM(k) do { if (IN(k) && IN((k) + 1)) xcd_barrier(bar); } while (0)
    if (IN(0)) { ph_pro(kparams(), lds); } SEAM(0);
#pragma unroll
    for (int l = 0; l < DEPTH; ++l) {
        const int b0 = 1 + l * PH_PER_LAYER;
        if (IN(b0 + 0)) { ph_norm1(kparams(), l, lds); } SEAM(b0 + 0);
        if (IN(b0 + 1)) { ph_inproj_f(kparams(), l, lds); } SEAM(b0 + 1);
        if (IN(b0 + 2)) { ph_prep(kparams(), l, lds); } SEAM(b0 + 2);
        if (IN(b0 + 3)) { ph_attn_f(kparams(), l, lds); } SEAM(b0 + 3);
        if (IN(b0 + 4)) { ph_hgrn3(kparams(), l, lds); } SEAM(b0 + 4);
        if (IN(b0 + 5)) { ph_outproj_f(kparams(), l, lds); } SEAM(b0 + 5);
        if (IN(b0 + 6)) { ph_norm2(kparams(), l, lds); } SEAM(b0 + 6);
        if (IN(b0 + 7)) { ph_gateup_f(kparams(), l, lds); } SEAM(b0 + 7);
        if (IN(b0 + 8)) { ph_down_f(kparams(), l, lds); } SEAM(b0 + 8);
        if (IN(b0 + 9)) { ph_combine(kparams(), l, lds); } SEAM(b0 + 9);
    }
#undef IN
#undef SEAM
}

#ifndef MK_ONE_LAUNCH
#define MK_ONE_LAUNCH 1
#endif
extern "C" void kernel_launch(void* const* d_in, const int* in_sizes, int n_in, void* d_out, int out_size, void* d_ws, size_t ws_size, hipStream_t stream) {
    static int grid = 0;
    if (grid == 0) {
        if (n_in != 31 || ws_size < WS_END2) { fprintf(stderr, "kernel_launch: unexpected n_in %d or ws_size %zu (< %zu)\n", n_in, ws_size, (size_t)WS_END2); grid = -1; return; }
        int dev = 0, cus = 0, per_cu = 0;
        if (hipGetDevice(&dev) != hipSuccess || hipDeviceGetAttribute(&cus, hipDeviceAttributeMultiprocessorCount, dev) != hipSuccess) { grid = -1; return; }
        if (hipFuncSetAttribute((const void*)mega, hipFuncAttributeMaxDynamicSharedMemorySize, LDS_BYTES) != hipSuccess) { fprintf(stderr, "kernel_launch: hipFuncSetAttribute failed\n"); grid = -1; return; }
        if (hipOccupancyMaxActiveBlocksPerMultiprocessor(&per_cu, (const void*)mega, NTHREADS, LDS_BYTES) != hipSuccess || per_cu < 1) fprintf(stderr, "kernel_launch: occupancy query says %d\n", per_cu);
        (void)hipGetLastError();
        grid = cus;
    }
    if (grid < 0) return;
    (void)hipMemsetAsync((char*)d_ws + WS_CTL, 0, CTL_ZERO_BYTES, stream);
    Params p{};
    for (int i = 0; i < 31; ++i) p.in[i] = (const float*)d_in[i];
    p.out = (float*)d_out; p.ws = (unsigned char*)d_ws;
#if MK_ONE_LAUNCH
    p.ph_lo = 0; p.ph_hi = N_PHASES;
    hipLaunchKernelGGL(mega, dim3(grid), dim3(NTHREADS), LDS_BYTES, stream, p);
#else
    for (int k = 0; k < N_PHASES; ++k) { p.ph_lo = k; p.ph_hi = k + 1; hipLaunchKernelGGL(mega, dim3(grid), dim3(NTHREADS), LDS_BYTES, stream, p); }
#endif
}
```

```cpp
#include <hip/hip_runtime.h>
#include <hip/hip_bf16.h>
#include <cmath>
#include <cstdint>
#include <cstdio>

#define LAS __attribute__((address_space(3)))

typedef unsigned short bf16_t;
typedef short bf16x8 __attribute__((ext_vector_type(8)));
typedef float f32x4 __attribute__((ext_vector_type(4)));
typedef unsigned u32x4 __attribute__((ext_vector_type(4)));
typedef unsigned u32x2 __attribute__((ext_vector_type(2)));

constexpr int D = 1024, NB = 2, NSEQ = 8192, NCTX = 256, DEPTH = 2;
constexpr int R_LAT = NB * NSEQ, R_CTX = NB * NCTX, R_ALL = R_LAT + R_CTX;
constexpr int DIN = 2816;
constexpr int NKEY = NSEQ + NCTX;
constexpr int NE = 64, TOPK = 8;
constexpr int MAXSLOT = 151552;
constexpr int HROWS = MAXSLOT + R_ALL;
constexpr int NCHUNK = 132;
constexpr float EPS = 1e-6f;
constexpr float TOK8_SCALE = 8.f, WGU8_SCALE = 256.f, H8_SCALE = 16.f, WD8_SCALE = 128.f;
constexpr float GU_DESCALE = 1.f / (TOK8_SCALE * WGU8_SCALE), DN_DESCALE = 1.f / (H8_SCALE * WD8_SCALE);
constexpr float Y8_SCALE = 32.f;
constexpr float QSCALE = 0.125f * 1.4426950408889634f;
constexpr float LOG2E = 1.4426950408889634f;

#ifndef FAST_HGRN
#define FAST_HGRN 1
#endif
constexpr int C_GQ = 0, C_GK = 256, C_GV = 384, C_WQ = 512, C_WK = 768, C_WV = 896, C_CVV = 1024, C_CVG = 1280, C_RQ = 1536, C_RI = 1792, C_RFF = 2048, C_RFB = 2304, C_RG = 2560;

constexpr size_t MiB = (size_t)1 << 20;
constexpr size_t WS_CTL = 0, CTL_ZERO_BYTES = 64 * 1024;
constexpr size_t WS_MOD = 1 * MiB;
constexpr size_t WS_LB = WS_MOD + 256 * 1024;
constexpr size_t WS_ROPE = WS_MOD + 512 * 1024;
constexpr size_t WS_TOKE = 2 * MiB, WS_TOKP = 3 * MiB, WS_TOKW = 4 * MiB, WS_TOKS = 5 * MiB;
constexpr size_t WS_SLOTT = 6 * MiB, WS_SLOTW = 7 * MiB;
constexpr size_t WS_RFRAG = 4 * MiB;
constexpr size_t WS_X = 8 * MiB;
constexpr size_t WS_WD = 74 * MiB;
constexpr size_t WS_Z = 107 * MiB;
constexpr size_t Z_A = WS_Z + 0 * MiB;
constexpr size_t Z_WGU = WS_Z + 33 * MiB;
constexpr size_t Z_WIN = WS_Z + 98 * MiB;
constexpr size_t Z_WOUT = WS_Z + 104 * MiB;
constexpr size_t Z_WPW = WS_Z + 106 * MiB;
__host__ __device__ constexpr size_t wgu_off(int l) { return WS_Z + 33 * MiB + (size_t)l * 34078720; }
__host__ __device__ constexpr size_t wd_off(int l) { return 74 * MiB + (size_t)l * 17039360; }
__host__ __device__ constexpr size_t win_off(int l) { return l == 0 ? WS_Z + 98 * MiB : WS_Z + (302 + 42) * MiB; }
__host__ __device__ constexpr size_t wout_off(int l) { return l == 0 ? WS_Z + 104 * MiB : WS_Z + (302 + 48) * MiB; }
__host__ __device__ constexpr size_t wpw_off(int l) { return l == 0 ? WS_Z + 106 * MiB : WS_Z + (302 + 51) * MiB; }
constexpr size_t Z_P = WS_Z + 107 * MiB;
constexpr size_t Z_YCAT = WS_Z + 198 * MiB;
constexpr size_t Z_QG = WS_Z + 231 * MiB, Z_QW = WS_Z + 239 * MiB;
constexpr size_t Z_KG = WS_Z + 247 * MiB, Z_VG = WS_Z + 252 * MiB, Z_KW = WS_Z + 257 * MiB, Z_VW = WS_Z + 262 * MiB;
constexpr size_t Z_QGC = WS_Z + 267 * MiB, Z_QWC = Z_QGC + 512 * 1024;
constexpr size_t Z_U = WS_Z + 268 * MiB;
constexpr size_t Z_G = WS_Z + 301 * MiB;
constexpr size_t Z_Y = WS_Z + 107 * MiB;
constexpr size_t Z_H = WS_Z + 302 * MiB;
constexpr size_t WS_END = WS_Z + 385 * MiB;
constexpr size_t WS_EXPL = WS_END, WS_EXPW = WS_END + 5 * MiB, WS_END2 = WS_END + 10 * MiB;
static_assert(Z_H + (size_t)HROWS * 512 <= WS_END, "H fits");
static_assert(Z_Y + (size_t)MAXSLOT * 1024 <= Z_U, "Y8 below the HGRN state buffers");
static_assert(Z_P + (size_t)R_ALL * DIN * 2 <= Z_YCAT, "P fits");

constexpr int CW_BAR = 0;
constexpr int CW_CNT = 4096;

constexpr int LDS_BYTES = 147456;
constexpr int NTHREADS = 512;

struct Params {
    const float* in[31];
    float* out;
    unsigned char* ws;
    int ph_lo, ph_hi;
};

typedef const __attribute__((address_space(4))) Params* KP;
__device__ __forceinline__ KP kparams() { KP k = (KP)__builtin_amdgcn_kernarg_segment_ptr(); asm volatile("" : "+s"(k)); return k; }

constexpr int LDS_WVTAB_OFF = 147456 - 16 - 256;
__device__ __forceinline__ int hwkey_() { return (int)__builtin_amdgcn_s_getreg((5 << 11) | 4) & 63; }
__device__ __forceinline__ int tid_() { extern __shared__ __attribute__((aligned(16))) unsigned char lds_all[];
    const int w = __builtin_amdgcn_readfirstlane(*(const LAS int*)((LAS unsigned char*)lds_all + LDS_WVTAB_OFF + 4 * hwkey_()));
    unsigned z; asm volatile("v_mov_b32 %0, 0" : "=v"(z));
    int t = (w << 6) | (int)__builtin_amdgcn_mbcnt_hi(~0u, __builtin_amdgcn_mbcnt_lo(~0u, z)); asm volatile("" : "+v"(t)); return t; }
__device__ __forceinline__ int bid_() { int b = blockIdx.x; asm volatile("" : "+s"(b)); return b; }
__device__ __forceinline__ int gsz_() { int g = gridDim.x; asm volatile("" : "+s"(g)); return g; }

__device__ __forceinline__ unsigned f2bf(float f) { unsigned u = __float_as_uint(f); return (u + 0x7fffu + ((u >> 16) & 1u)) >> 16; }
__device__ __forceinline__ float bf2f(unsigned h) { return __uint_as_float(h << 16); }
__device__ __forceinline__ unsigned pk2(float lo, float hi) { unsigned r; asm("v_cvt_pk_bf16_f32 %0, %1, %2" : "=v"(r) : "v"(lo), "v"(hi)); return r; }
__device__ __forceinline__ u32x4 pack8(const float (&x)[8]) { u32x4 o; o.x = pk2(x[0], x[1]); o.y = pk2(x[2], x[3]); o.z = pk2(x[4], x[5]); o.w = pk2(x[6], x[7]); return o; }
__device__ __forceinline__ void unpack8(const u32x4 r, f32x4& lo, f32x4& hi) { lo.x = bf2f(r.x & 0xffffu); lo.y = bf2f(r.x >> 16); lo.z = bf2f(r.y & 0xffffu); lo.w = bf2f(r.y >> 16); hi.x = bf2f(r.z & 0xffffu); hi.y = bf2f(r.z >> 16); hi.z = bf2f(r.w & 0xffffu); hi.w = bf2f(r.w >> 16); }
template <int CTRL> __device__ __forceinline__ float dpp_mov(float v) { return __builtin_bit_cast(float, __builtin_amdgcn_update_dpp(0, __builtin_bit_cast(int, v), CTRL, 0xF, 0xF, true)); }
__device__ __forceinline__ float wave_sum(float v) {
    v += dpp_mov<0xB1>(v); v += dpp_mov<0x4E>(v); v += dpp_mov<0x141>(v); v += dpp_mov<0x140>(v);
    { const auto rr = __builtin_amdgcn_permlane16_swap(__float_as_uint(v), __float_as_uint(v), false, false); v = __uint_as_float(rr[0]) + __uint_as_float(rr[1]); }
    { const auto rr = __builtin_amdgcn_permlane32_swap(__float_as_uint(v), __float_as_uint(v), false, false); v = __uint_as_float(rr[0]) + __uint_as_float(rr[1]); }
    return v;
}
__device__ __forceinline__ float clamp8(float v) { return fminf(fmaxf(v, -440.f), 440.f); }
__device__ __forceinline__ float sigmoid_(float x) { return __builtin_amdgcn_rcpf(1.f + __expf(-x)); }
__device__ __forceinline__ float silu_(float x) { return x * sigmoid_(x); }

__device__ __forceinline__ const float* xrow_src(KP p, int l, int row) {
    if (l == 0) return (row < R_LAT) ? p->in[0] + (size_t)row * D : p->in[2] + (size_t)(row - R_LAT) * D;
    return (const float*)(p->ws + WS_X) + (size_t)row * D;
}
__device__ __forceinline__ const float* mod_vec(KP p, int l, int row, int i) {
    const int r = (row < R_LAT) ? (row >> 13) : 2;
    return (const float*)(p->ws + WS_MOD) + ((size_t)l * 3 + r) * 6144 + i * 1024;
}

#define XB_TMO      128
#define XB_XCNT(j)  (256  + 64 * (j))
#define XB_XSUB(j)  (1280 + 64 * (j))
#define XB_XGEN(j)  (2304 + 64 * (j))
#define XB_TOP      3328
#define XB_TOPGEN   3392
#define XCD_BAR_WORDS 3456
#define XB_SPIN_CAP (1u << 18)
__device__ __forceinline__ unsigned xb_ld(unsigned* p)              { return __hip_atomic_load(p, __ATOMIC_RELAXED, __HIP_MEMORY_SCOPE_AGENT); }
__device__ __forceinline__ unsigned xb_add(unsigned* p, unsigned v) { return __hip_atomic_fetch_add(p, v, __ATOMIC_RELAXED, __HIP_MEMORY_SCOPE_AGENT); }
__device__ __forceinline__ unsigned xb_xcc_id() { return (unsigned)__builtin_amdgcn_s_getreg((3 << 11) | 20) & 0xFu; }
#define XB_SPIN(cond, bar) do { unsigned _sp = 0; while (cond) { __builtin_amdgcn_s_sleep(1); \
    if ((++_sp & 255u) == 0u) { if (xb_ld(&(bar)[XB_TMO])) break; if (_sp > XB_SPIN_CAP) { atomicAdd(&(bar)[XB_TMO], 1u); break; } } } } while (0)
struct XcdBarrier { unsigned* bar; unsigned x; volatile LAS unsigned* st; };
__device__ __forceinline__ XcdBarrier xcd_barrier_post(unsigned* bar, volatile LAS unsigned* st) {
    XcdBarrier b; b.bar = bar; b.x = xb_xcc_id(); b.st = st;
    if (tid_() == 0) (void)xb_add(&bar[XB_XCNT(b.x)], 1u);
    return b;
}
__device__ __forceinline__ void xcd_barrier_complete(unsigned* bar, unsigned x, unsigned& nloc, unsigned& nx) {
    const unsigned G = gridDim.x * gridDim.y * gridDim.z;
    unsigned sum, cnt, mine, sp = 0u;
    for (;;) {
        sum = 0u; cnt = 0u; mine = 0u;
#pragma unroll
        for (unsigned j = 0; j < 16; ++j) { const unsigned c = xb_ld(&bar[XB_XCNT(j)]); sum += c; cnt += (c > 0u) ? 1u : 0u; mine = (j == x) ? c : mine; }
        if (sum == G) break;
        __builtin_amdgcn_s_sleep(1);
        if ((++sp & 255u) == 0u) { if (xb_ld(&bar[XB_TMO])) break; if (sp > XB_SPIN_CAP) { atomicAdd(&bar[XB_TMO], 1u); break; } }
    }
    nloc = mine > 0u ? mine : 1u; nx = cnt > 0u ? cnt : 1u;
}
__device__ __forceinline__ void xcd_barrier(const XcdBarrier& b) {
    asm volatile("s_waitcnt vmcnt(0)" ::: "memory");
    __syncthreads();
    if (tid_() == 0) {
        unsigned* bar = b.bar;
        __builtin_amdgcn_s_waitcnt(0);
        unsigned nloc = b.st[0], nx = b.st[1];
        if (nloc == 0u) { xcd_barrier_complete(bar, b.x, nloc, nx); b.st[0] = nloc; b.st[1] = nx; }
        const unsigned old = xb_add(&bar[XB_XSUB(b.x)], 1u);
        const unsigned gen = old / nloc;
        if (old + 1u == (gen + 1u) * nloc) {
            __builtin_amdgcn_fence(__ATOMIC_RELEASE, "agent");
            asm volatile("s_waitcnt vmcnt(0)" ::: "memory");
            const unsigned og = xb_add(&bar[XB_TOP], 1u);
            const unsigned tg = og / nx;
            if (og + 1u == (tg + 1u) * nx) xb_add(&bar[XB_TOPGEN], 1u);
            else XB_SPIN(xb_ld(&bar[XB_TOPGEN]) == tg, bar);
            __builtin_amdgcn_fence(__ATOMIC_ACQUIRE, "agent");
            xb_add(&bar[XB_XGEN(b.x)], 1u);
            asm volatile("s_waitcnt vmcnt(0)" ::: "memory");
        } else {
            XB_SPIN(xb_ld(&bar[XB_XGEN(b.x)]) == gen, bar);
            __builtin_amdgcn_fence(__ATOMIC_ACQUIRE, "agent");
            asm volatile("s_waitcnt vmcnt(0)" ::: "memory");
        }
    }
    __syncthreads();
}

__device__ __forceinline__ void ph_pro(KP p, unsigned char* lds) {
    float* sc = (float*)lds;
    float* red = sc + 3 * 1024;
    const int tid = tid_(), lane = tid & 63, wid = tid >> 6;
    for (int i = tid; i < 3 * 1024; i += NTHREADS) { const int r = i >> 10, k = i & 1023; const float v = (r < 2) ? p->in[1][r * 1024 + k] : p->in[3][k]; sc[i] = silu_(v); }
    __syncthreads();
    float* mod = (float*)(p->ws + WS_MOD);
    for (int item = bid_(); item < DEPTH * 96 + DEPTH * 8; item += gsz_()) {
        if (item >= DEPTH * 96) {
            const int fi = item - DEPTH * 96, lf = fi >> 3, w = fi & 7, fr = lane & 15, fq = lane >> 4; const float* rw = p->in[23] + (size_t)lf * 1024 * 64;
            u32x4* RF = (u32x4*)(p->ws + WS_RFRAG);
#pragma unroll
            for (int s = 0; s < 2; ++s) { const int tk = wid * 2 + s, t = tk >> 2, k = tk & 3; float v[8], lo[8];
#pragma unroll
                for (int j = 0; j < 8; ++j) v[j] = rw[(size_t)((w * 4 + k) * 32 + fq * 8 + j) * 64 + t * 16 + fr];
                const u32x4 hh = pack8(v);
                const float hf[8] = {bf2f(hh.x & 0xffffu), bf2f(hh.x >> 16), bf2f(hh.y & 0xffffu), bf2f(hh.y >> 16), bf2f(hh.z & 0xffffu), bf2f(hh.z >> 16), bf2f(hh.w & 0xffffu), bf2f(hh.w >> 16)};
#pragma unroll
                for (int j = 0; j < 8; ++j) lo[j] = v[j] - hf[j];
                const size_t o = ((size_t)(((lf * 8 + w) * 4 + t) * 4 + k) * 64 + lane) * 2;
                RF[o] = hh; RF[o + 1] = pack8(lo); }
            continue; }
        const int l = item / 96, j0 = (item % 96) * 64;
        const float* w = p->in[4] + (size_t)l * 1024 * 6144;
        float a0 = 0.f, a1 = 0.f, a2 = 0.f;
        const int k0 = wid * 128;
#pragma unroll 1
        for (int k = k0; k < k0 + 128; k += 32) { float wv[32];
#pragma unroll
            for (int u = 0; u < 32; ++u) wv[u] = w[(size_t)(k + u) * 6144 + j0 + lane];
#pragma unroll
            for (int u = 0; u < 32; ++u) { a0 += sc[k + u] * wv[u]; a1 += sc[1024 + k + u] * wv[u]; a2 += sc[2048 + k + u] * wv[u]; } }
        red[(wid * 3 + 0) * 64 + lane] = a0; red[(wid * 3 + 1) * 64 + lane] = a1; red[(wid * 3 + 2) * 64 + lane] = a2;
        __syncthreads();
        if (tid < 192) { const int r = tid >> 6; float s = 0.f;
            for (int w8 = 0; w8 < 8; ++w8) s += red[(w8 * 3 + r) * 64 + lane];
            mod[((size_t)l * 3 + r) * 6144 + j0 + lane] = s + p->in[5][l * 6144 + j0 + lane]; }
        __syncthreads();
    }
    if (bid_() == 0) {
        float* rt = (float*)(p->ws + WS_ROPE);
        for (int i = tid; i < 128 * 16; i += NTHREADS) { const int pos = i >> 4, f = i & 15; const float inv = powf(10000.f, -(float)f * (1.f / 16.f)); float sn, cs; sincosf((float)pos * inv, &sn, &cs);
            rt[pos * 32 + f] = cs; rt[pos * 32 + 16 + f] = sn; }
    }
    if (bid_() == gsz_() - 1) {
        float* lb = (float*)(p->ws + WS_LB);
        for (int i = tid; i < 2 * 2 * 256; i += NTHREADS) { const int l = i >> 9, dir = (i >> 8) & 1, ch = i & 255;
            const float* lg = p->in[21];
            const float l0 = lg[(dir * 2 + 0) * 256 + ch], l1 = lg[(dir * 2 + 1) * 256 + ch]; const float m = fmaxf(l0, l1);
            const float e0 = expf(l0 - m), e1 = expf(l1 - m);
            lb[i] = (l == 0) ? 0.f : e1 / (e0 + e1); }
    }
}

constexpr int CVT_E1 = 1050, CVT_E2 = 2850;
struct CvtTile { const float* src; bf16_t* dst; int K, N, k0, n0, blk, bstride, boff; float f8scale; int perm; };
__device__ __forceinline__ int cvt_total() { return 16 * 44 + 16 * 16 + 4 * 4 + 2 * (64 * 64) + 2 * 64 + 64 * 64 + 64; }
__device__ __forceinline__ CvtTile cvt_decode(KP p, int l, int g) {
    bf16_t* Wgu = (bf16_t*)(p->ws + wgu_off(l)); bf16_t* Wd = (bf16_t*)(p->ws + wd_off(l));
    CvtTile t; int per, tn, r;
    if (g < 704) { r = g; t = {p->in[8] + (size_t)l * 1024 * DIN, (bf16_t*)(p->ws + win_off(l)), 1024, DIN, 0, 0, DIN, 0, 0, 0.f}; tn = 44; per = 704; }
    else if ((g -= 704) < 256) { r = g; t = {p->in[9] + (size_t)l * 1024 * 1024, (bf16_t*)(p->ws + wout_off(l)), 1024, 1024, 0, 0, 1024, 0, 0, 0.f}; tn = 16; per = 256; }
    else if ((g -= 256) < 16) { r = g; t = {p->in[19] + (size_t)l * 65536, (bf16_t*)(p->ws + wpw_off(l)), 256, 256, 0, 0, 256, 0, 0, 0.f}; tn = 4; per = 16; }
    else if ((g -= 16) < 4096) { const int m = g >> 6; r = g & 63; t = {p->in[25] + ((size_t)l * 64 + m) * 262144, (bf16_t*)((unsigned char*)Wgu + (size_t)m * 524288), 1024, 256, 0, 0, 128, 256, 0, WGU8_SCALE}; tn = 4; per = 64; }
    else if ((g -= 4096) < 4096) { const int m = g >> 6; r = g & 63; t = {p->in[26] + ((size_t)l * 64 + m) * 262144, (bf16_t*)((unsigned char*)Wgu + (size_t)m * 524288), 1024, 256, 0, 0, 128, 256, 128, WGU8_SCALE}; tn = 4; per = 64; }
    else if ((g -= 4096) < 64) { r = g; t = {p->in[28] + (size_t)l * 262144, (bf16_t*)((unsigned char*)Wgu + (size_t)64 * 524288), 1024, 256, 0, 0, 128, 256, 0, WGU8_SCALE}; tn = 4; per = 64; }
    else if ((g -= 64) < 64) { r = g; t = {p->in[29] + (size_t)l * 262144, (bf16_t*)((unsigned char*)Wgu + (size_t)64 * 524288), 1024, 256, 0, 0, 128, 256, 128, WGU8_SCALE}; tn = 4; per = 64; }
    else if ((g -= 64) < 4096) { const int m = g >> 6; r = g & 63; t = {p->in[27] + ((size_t)l * 64 + m) * 262144, (bf16_t*)((unsigned char*)Wd + (size_t)m * 262144), 256, 1024, 0, 0, 1024, 0, 0, WD8_SCALE, 1}; tn = 16; per = 64; }
    else { g -= 4096; r = g; t = {p->in[30] + (size_t)l * 262144, (bf16_t*)((unsigned char*)Wd + (size_t)64 * 262144), 256, 1024, 0, 0, 1024, 0, 0, WD8_SCALE, 1}; tn = 16; per = 64; }
    (void)per; t.k0 = (r / tn) * 64; t.n0 = (r % tn) * 64; return t;
}
__device__ __forceinline__ void ph_cvt(KP p, int l, unsigned char* lds, int first = 0, int nwg = 0, int t0 = 0, int t1 = 1 << 30) {
    float* tb = (float*)lds;
    const int tid = tid_(), G = nwg ? nwg : gsz_(), total = t1 < cvt_total() ? t1 : cvt_total();
    const int r0 = tid >> 4, c0 = (tid & 15) * 4, nn = tid >> 3, kc = (tid & 7) * 8;
    int g = bid_() - first, buf = 0;
    if (g < 0) return;
    g += t0;
    if (g >= total) return;
    CvtTile T = cvt_decode(p, l, g);
    f32x4 v0 = *(const f32x4*)(T.src + (size_t)(T.k0 + r0) * T.N + T.n0 + c0), v1 = *(const f32x4*)(T.src + (size_t)(T.k0 + r0 + 32) * T.N + T.n0 + c0);
    for (;;) {
        float* t = tb + buf * (64 * 65);
        t[r0 * 65 + c0] = v0.x; t[r0 * 65 + c0 + 1] = v0.y; t[r0 * 65 + c0 + 2] = v0.z; t[r0 * 65 + c0 + 3] = v0.w;
        t[(r0 + 32) * 65 + c0] = v1.x; t[(r0 + 32) * 65 + c0 + 1] = v1.y; t[(r0 + 32) * 65 + c0 + 2] = v1.z; t[(r0 + 32) * 65 + c0 + 3] = v1.w;
        const CvtTile C = T; const int gn = g + G; const bool more = gn < total;
        if (more) { T = cvt_decode(p, l, gn);
            v0 = *(const f32x4*)(T.src + (size_t)(T.k0 + r0) * T.N + T.n0 + c0); v1 = *(const f32x4*)(T.src + (size_t)(T.k0 + r0 + 32) * T.N + T.n0 + c0); }
        __syncthreads();
        { const int n = C.n0 + nn; int drow = (n / C.blk) * C.bstride + C.boff + (n % C.blk);
          if (C.perm) drow = (n & ~255) + ((n >> 3) & 1) * 128 + ((n >> 6) & 3) * 32 + ((n >> 4) & 3) * 8 + (n & 7);
          if (C.f8scale != 0.f) { const float sc = C.f8scale;
              int w0 = __builtin_amdgcn_cvt_pk_fp8_f32(clamp8(t[(kc + 0) * 65 + nn] * sc), clamp8(t[(kc + 1) * 65 + nn] * sc), 0, false); w0 = __builtin_amdgcn_cvt_pk_fp8_f32(clamp8(t[(kc + 2) * 65 + nn] * sc), clamp8(t[(kc + 3) * 65 + nn] * sc), w0, true);
              int w1 = __builtin_amdgcn_cvt_pk_fp8_f32(clamp8(t[(kc + 4) * 65 + nn] * sc), clamp8(t[(kc + 5) * 65 + nn] * sc), 0, false); w1 = __builtin_amdgcn_cvt_pk_fp8_f32(clamp8(t[(kc + 6) * 65 + nn] * sc), clamp8(t[(kc + 7) * 65 + nn] * sc), w1, true);
              u32x2 o8; o8.x = (unsigned)w0; o8.y = (unsigned)w1;
              *(u32x2*)((unsigned char*)C.dst + (size_t)drow * C.K + C.k0 + kc) = o8;
          } else {
          u32x4 o; o.x = pk2(t[(kc + 0) * 65 + nn], t[(kc + 1) * 65 + nn]); o.y = pk2(t[(kc + 2) * 65 + nn], t[(kc + 3) * 65 + nn]);
          o.z = pk2(t[(kc + 4) * 65 + nn], t[(kc + 5) * 65 + nn]); o.w = pk2(t[(kc + 6) * 65 + nn], t[(kc + 7) * 65 + nn]);
          *(u32x4*)(C.dst + (size_t)drow * C.K + C.k0 + kc) = o; } }
        if (!more) break;
        g = gn; buf ^= 1;
    }
    __syncthreads();
}
__device__ __forceinline__ void norm_mod_row(const float* xrow, const float* g, const float* shift, const float* scale, bf16_t* orow, float* fout, int lane) {
    f32x4 v[4]; float s = 0.f;
#pragma unroll
    for (int j = 0; j < 4; ++j) { v[j] = ((const f32x4*)xrow)[lane + 64 * j]; s += v[j].x * v[j].x + v[j].y * v[j].y + v[j].z * v[j].z + v[j].w * v[j].w; }
    const float rinv = rsqrtf(wave_sum(s) * (1.f / D) + EPS);
#pragma unroll
    for (int j = 0; j < 4; ++j) { const int idx = lane + 64 * j;
        const f32x4 gg = ((const f32x4*)g)[idx], sh = ((const f32x4*)shift)[idx], sc = ((const f32x4*)scale)[idx];
        f32x4 y; y.x = v[j].x * rinv * gg.x * (1.f + sc.x) + sh.x; y.y = v[j].y * rinv * gg.y * (1.f + sc.y) + sh.y;
        y.z = v[j].z * rinv * gg.z * (1.f + sc.z) + sh.z; y.w = v[j].w * rinv * gg.w * (1.f + sc.w) + sh.w;
        u32x2 o; o.x = pk2(y.x, y.y); o.y = pk2(y.z, y.w);
        ((u32x2*)orow)[idx] = o;
        if (fout) ((f32x4*)fout)[idx] = y; }
}
__device__ __forceinline__ void ph_norm1(KP p, int l, unsigned char* lds) {
    if (l == 0) ph_cvt(p, l, lds);
    const int tid = tid_(), lane = tid & 63, wid = tid >> 6;
    bf16_t* A = (bf16_t*)(p->ws + Z_A);
    const float* g = p->in[6] + l * D;
    if (l == 0) { for (int row = bid_() * 8 + wid; row < R_ALL; row += gsz_() * 8)
        norm_mod_row(xrow_src(p, l, row), g, mod_vec(p, l, row, 0), mod_vec(p, l, row, 1), A + (size_t)row * D, nullptr, lane); }
    else { const bf16_t* X = (const bf16_t*)(p->ws + WS_X);
        for (int row = bid_() * 8 + wid; row < R_ALL; row += gsz_() * 8) {
            const float* shift = mod_vec(p, l, row, 0); const float* scale = mod_vec(p, l, row, 1);
            f32x4 v[4]; unpack8(*(const u32x4*)(X + (size_t)row * D + lane * 8), v[0], v[1]); unpack8(*(const u32x4*)(X + (size_t)row * D + 512 + lane * 8), v[2], v[3]);
            float ss = 0.f;
#pragma unroll
            for (int j = 0; j < 4; ++j) ss += v[j].x * v[j].x + v[j].y * v[j].y + v[j].z * v[j].z + v[j].w * v[j].w;
            const float rinv = rsqrtf(wave_sum(ss) * (1.f / D) + EPS);
#pragma unroll
            for (int h = 0; h < 2; ++h) { const int c0 = h * 512 + lane * 8; unsigned o[4];
#pragma unroll
                for (int q = 0; q < 2; ++q) { const f32x4 gg = *(const f32x4*)(g + c0 + 4 * q), sh = *(const f32x4*)(shift + c0 + 4 * q), sc = *(const f32x4*)(scale + c0 + 4 * q);
                    const f32x4 y = v[2 * h + q] * rinv * gg * (sc + 1.f) + sh; o[2 * q] = pk2(y.x, y.y); o[2 * q + 1] = pk2(y.z, y.w); }
                *(u32x4*)(A + (size_t)row * D + c0) = (u32x4){o[0], o[1], o[2], o[3]}; } } }
}

template <int NBJ, class ARow, class Epi>
__device__ __forceinline__ void gemm_simple_tile(const bf16_t* A, const ARow& arow, const bf16_t* Bt, int K, int row0, int colb0, int bjstride, const Epi& epi) {
    const int tid = tid_(), lane = tid & 63, wid = tid >> 6, wr = wid >> 1, wc = wid & 1, fr = lane & 15, fq = lane >> 4;
    f32x4 acc[2][NBJ][4];
#pragma unroll
    for (int i = 0; i < 2; ++i)
#pragma unroll
        for (int b = 0; b < NBJ; ++b)
#pragma unroll
            for (int j = 0; j < 4; ++j) acc[i][b][j] = (f32x4){0.f, 0.f, 0.f, 0.f};
    const bf16_t* ap[2];
#pragma unroll
    for (int i = 0; i < 2; ++i) ap[i] = A + (size_t)arow(row0 + wr * 32 + i * 16 + fr) * K + fq * 8;
    const bf16_t* bp = Bt + (size_t)(colb0 + wc * 64 + fr) * K + fq * 8;
    for (int k = 0; k < K; k += 32) {
        bf16x8 a[2];
#pragma unroll
        for (int i = 0; i < 2; ++i) a[i] = *(const bf16x8*)(ap[i] + k);
#pragma unroll
        for (int b = 0; b < NBJ; ++b)
#pragma unroll
            for (int j = 0; j < 4; ++j) { const bf16x8 bv = *(const bf16x8*)(bp + (size_t)(b * bjstride + j * 16) * K + k);
#pragma unroll
                for (int i = 0; i < 2; ++i) acc[i][b][j] = __builtin_amdgcn_mfma_f32_16x16x32_bf16(a[i], bv, acc[i][b][j], 0, 0, 0); }
    }
#pragma unroll
    for (int i = 0; i < 2; ++i)
#pragma unroll
        for (int j = 0; j < 4; ++j)
#pragma unroll
            for (int r = 0; r < 4; ++r) { const int row = row0 + wr * 32 + i * 16 + fq * 4 + r, col = wc * 64 + j * 16 + fr;
                epi(row, col, acc[i][0][j][r], acc[i][NBJ - 1][j][r]); }
}
struct RowId { __device__ __forceinline__ int operator()(int r) const { return r; } };
struct RowGather { const int* idx; __device__ __forceinline__ int operator()(int r) const { return idx[r]; } };

__device__ __forceinline__ void ph_inproj(KP p, int l, unsigned char* lds) {
    const bf16_t* A = (const bf16_t*)(p->ws + Z_A); const bf16_t* Bt = (const bf16_t*)(p->ws + Z_WIN); bf16_t* P = (bf16_t*)(p->ws + Z_P);
    constexpr int TM = R_ALL / 128, TN = DIN / 128;
    for (int it = bid_(); it < TM * TN; it += gsz_()) { const int mt = it / TN, nt = it % TN;
        auto epi = [&](int row, int col, float v, float) { P[(size_t)row * DIN + nt * 128 + col] = (bf16_t)f2bf(v); };
        gemm_simple_tile<1>(A, RowId{}, Bt, 1024, mt * 128, nt * 128, 0, epi); }
}

namespace pg8 {
constexpr int BM = 256, BK = 64, HALF = 128, HTB = HALF * BK * 2, STAGE_BYTES = 8 * HTB, NXCD = 8, WGM = 8;
__host__ __device__ __forceinline__ int lds_byte(int r, int c) { const int st = (r >> 4) * 2 + (c >> 5), rr = r & 15, cc = c & 31, ob = rr * 64 + cc * 2; return st * 1024 + (ob ^ (((ob >> 9) & 1) << 5)); }
__host__ __device__ __forceinline__ void stage_rc(int b, int& R, int& C) { const int st = b / 1024, sb = b % 1024, swz = sb ^ (((sb >> 9) & 1) << 5); R = (st >> 1) * 16 + swz / 64; C = (st & 1) * 32 + (swz % 64) / 2; }
__host__ __device__ __forceinline__ int perm32(int rho) { const int n = rho >> 4, i = rho & 15; return 8 * (i >> 2) + 4 * n + (i & 3); }
struct Unit { int pm, pn, ord; };
struct Gemm { const bf16_t* A; const bf16_t* Bt; int M, N, K; };
struct StaticOrder {
    int nM, nN, nwg, G, c;
    __host__ __device__ void init(int M, int N, int G_, int c_) { nM = M / BM; nN = N / BM; nwg = nM * nN; G = G_; c = c_; }
    __host__ __device__ bool next(int i, Unit& u) const {
        const long L = (long)i * G + c; if (L >= nwg) return false;
        int wgid = (int)L; { const int q = nwg / NXCD, r = nwg % NXCD, xcd = wgid % NXCD, off = wgid / NXCD; wgid = (xcd < r ? xcd * (q + 1) : r * (q + 1) + (xcd - r) * q) + off; }
        const int nig = WGM * nN, gid = wgid / nig, fm = gid * WGM, gsz = (nM - fm) < WGM ? (nM - fm) : WGM;
        u.pm = fm + ((wgid % nig) % gsz); u.pn = (wgid % nig) / gsz; u.ord = i; return true;
    }
};
__device__ __forceinline__ unsigned cvt_pk_bf16(float lo, float hi) { unsigned r; asm volatile("v_cvt_pk_bf16_f32 %0, %1, %2" : "=v"(r) : "v"(lo), "v"(hi)); return r; }

typedef int i32x4v __attribute__((ext_vector_type(4)));
typedef int i32x8v __attribute__((ext_vector_type(8)));
__device__ __forceinline__ i32x8v cat8(bf16x8 lo, bf16x8 hi) { const i32x4v a = __builtin_bit_cast(i32x4v, lo), b = __builtin_bit_cast(i32x4v, hi); return __builtin_shufflevector(a, b, 0, 1, 2, 3, 4, 5, 6, 7); }
__device__ __forceinline__ void glds16_s(const void* sbase, unsigned voff, unsigned lds_dst) { unsigned keep;
    asm volatile("s_mov_b32 %0, m0\n\ts_mov_b32 m0, %3\n\ts_nop 0\n\tglobal_load_lds_dwordx4 %1, %2\n\ts_mov_b32 m0, %0" : "=&s"(keep) : "v"(voff), "s"(sbase), "s"(lds_dst) : "memory"); }
template <class Epi, class Sched, bool GATHER, bool FP8 = false>
__device__ __forceinline__ void gemm_phase(LAS unsigned char* lds, const Gemm g, const Sched& S, const Epi& E, const LAS int* rtab) {
    const int tid = tid_(), wid = __builtin_amdgcn_readfirstlane(tid >> 6), lane = tid & 63, wr = wid >> 2, wc = wid & 3, fr = lane & 15, fq = lane >> 4;
    const int KB = FP8 ? g.K : g.K * 2, nt = KB / 128;
    unsigned voffA[2], voffB[2]; int RA[2], CA[2];
#pragma unroll
    for (int i = 0; i < 2; ++i) { int R, C; stage_rc(tid * 16 + i * 8192, R, C); const int Rb = (R & ~31) + perm32(R & 31);
        voffA[i] = (unsigned)(R * KB + C * 2); voffB[i] = (unsigned)(Rb * KB + C * 2); RA[i] = R; CA[i] = C; }
    unsigned rcpk = 0; if constexpr (GATHER) { rcpk = (unsigned)(RA[0] * 4) | ((unsigned)(CA[0] * 2) << 16); asm volatile("" : "+v"(rcpk)); }
    const size_t kstep = (size_t)128;
    const size_t hstep = (size_t)HALF * KB;
    const size_t hstepA = GATHER ? 0 : hstep;
    const size_t tstep = 2 * hstep;
    const unsigned ldsw = (unsigned)wid * 1024u;
    const unsigned ldsb = (unsigned)__builtin_amdgcn_readfirstlane((int)((unsigned)(size_t)lds + ldsw));
    const int aoff = lds_byte(wr * 64 + fr, fq * 8), boff = lds_byte(wc * 32 + fr, fq * 8);
#define PG8_SA(b, h) (((b) * 2 + (h)) * HTB)
#define PG8_SB(b, h) ((4 + (b) * 2 + (h)) * HTB)
#define PG8_STAGE(bufoff, gbase, voff) do { _Pragma("unroll") for (int _i = 0; _i < 2; ++_i) { if constexpr (FP8) glds16_s((const void*)(gbase), (voff)[_i], ldsb + (unsigned)((bufoff) + _i * 8192)); \
        else __builtin_amdgcn_global_load_lds((const unsigned*)((const char*)(gbase) + (voff)[_i]), (LAS unsigned*)(lds + (bufoff) + ldsw + _i * 8192), 16, 0, 0); } } while (0)
#define PG8_STAGE1(bufoff, gbase, v0) do {   \
        glds16_s((const void*)(gbase), (v0), ldsb + (unsigned)(bufoff)); glds16_s((const void*)((const char*)(gbase) + (size_t)64 * KB), (v0), ldsb + (unsigned)((bufoff) + 8192)); } while (0)
#define PG8_LDA(dst, b, h) do { _Pragma("unroll") for (int m = 0; m < 4; ++m) { if constexpr (FP8) dst##8[m] = cat8(*(const LAS bf16x8*)(lds + PG8_SA(b, h) + aoff + m * 2048), *(const LAS bf16x8*)(lds + PG8_SA(b, h) + aoff + m * 2048 + 1024)); \
        else { _Pragma("unroll") for (int k = 0; k < 2; ++k) dst[m][k] = *(const LAS bf16x8*)(lds + PG8_SA(b, h) + aoff + m * 2048 + k * 1024); } } } while (0)
#define PG8_LDB(dst, b, h) do { _Pragma("unroll") for (int n = 0; n < 2; ++n) { if constexpr (FP8) dst##8[n] = cat8(*(const LAS bf16x8*)(lds + PG8_SB(b, h) + boff + n * 2048), *(const LAS bf16x8*)(lds + PG8_SB(b, h) + boff + n * 2048 + 1024)); \
        else { _Pragma("unroll") for (int k = 0; k < 2; ++k) dst[n][k] = *(const LAS bf16x8*)(lds + PG8_SB(b, h) + boff + n * 2048 + k * 1024); } } } while (0)
#define PG8_MMA(ai, bj, At, Bt) do { __builtin_amdgcn_s_setprio(1); _Pragma("unroll") for (int m = 0; m < 4; ++m) _Pragma("unroll") for (int n = 0; n < 2; ++n) { \
        if constexpr (FP8) acc[ai][bj][m][n] = __builtin_amdgcn_mfma_scale_f32_16x16x128_f8f6f4(Bt##8[n], At##8[m], acc[ai][bj][m][n], 0, 0, 0, 0x7F7F7F7F, 0, 0x7F7F7F7F); \
        else { _Pragma("unroll") for (int k = 0; k < 2; ++k) acc[ai][bj][m][n] = __builtin_amdgcn_mfma_f32_16x16x32_bf16(Bt[n][k], At[m][k], acc[ai][bj][m][n], 0, 0, 0); } } \
        if constexpr (FP8) { asm volatile("" : "+v"(acc[ai][bj][0][0]), "+v"(acc[ai][bj][0][1]), "+v"(acc[ai][bj][1][0]), "+v"(acc[ai][bj][1][1]), "+v"(acc[ai][bj][2][0]), "+v"(acc[ai][bj][2][1]), "+v"(acc[ai][bj][3][0]), "+v"(acc[ai][bj][3][1])); } \
        __builtin_amdgcn_s_setprio(0); } while (0)
#define PG8_WAIT_V(n) asm volatile("s_waitcnt vmcnt(" #n ")" ::: "memory")
#define PG8_WAIT_L(n) asm volatile("s_waitcnt lgkmcnt(" #n ")" ::: "memory")
#define PG8_BAR __builtin_amdgcn_s_barrier()
#define PG8_SCHED __builtin_amdgcn_sched_barrier(0)
#define PG8_STAGE_A(bufoff, gbase, ord, h) do { unsigned _o[2]; if constexpr (GATHER) {   \
            unsigned _pk = rcpk; asm volatile("" : "+v"(_pk));   \
            const LAS unsigned char* _rp = (const LAS unsigned char*)rtab + ((ord) * 1024 + (h) * 512) + (_pk & 0xffffu); const unsigned _c2 = _pk >> 16; \
            _Pragma("unroll") for (int _i = 0; _i < 2; ++_i) _o[_i] = __umul24((unsigned)*(const LAS int*)(_rp + _i * 256), (unsigned)KB) + _c2; } \
        else { _o[0] = voffA[0]; _o[1] = voffA[1]; } if constexpr (FP8 && !GATHER) PG8_STAGE1(bufoff, gbase, voffA[0]); else PG8_STAGE(bufoff, gbase, _o); } while (0)
#define PG8_STAGE_B(bufoff, gbase) do { if constexpr (FP8) PG8_STAGE1(bufoff, gbase, voffB[0]); else PG8_STAGE(bufoff, gbase, voffB); } while (0)
    Unit cur, nxt; int ui = 0;
    if (!S.next(0, cur)) return;
    f32x4 acc[2][2][4][2];
#pragma unroll
    for (int a = 0; a < 2; ++a)
#pragma unroll
        for (int b = 0; b < 2; ++b)
#pragma unroll
            for (int m = 0; m < 4; ++m)
#pragma unroll
                for (int n = 0; n < 2; ++n) acc[a][b][m][n] = (f32x4){0.f, 0.f, 0.f, 0.f};
    bf16x8 At[4][2], B0[2][2], B1[2][2]; i32x8v At8[4], B08[2], B18[2];
    const char* cA = GATHER ? (const char*)g.A : (const char*)g.A + (size_t)cur.pm * tstep; const char* cB = (const char*)g.Bt + (size_t)cur.pn * tstep;
    PG8_STAGE_B(PG8_SB(0, 0), cB); PG8_STAGE_B(PG8_SB(0, 1), cB + hstep); PG8_STAGE_A(PG8_SA(0, 0), cA, 0, 0); PG8_STAGE_A(PG8_SA(0, 1), cA + hstepA, 0, 1);
    if (wr == 1) PG8_BAR;
    PG8_WAIT_V(2); PG8_BAR;
    PG8_STAGE_B(PG8_SB(1, 0), cB + kstep); PG8_STAGE_A(PG8_SA(1, 0), cA + kstep, 0, 0); PG8_STAGE_B(PG8_SB(1, 1), cB + hstep + kstep);
    PG8_WAIT_V(6); PG8_BAR;
    for (;;) {
        const bool has_next = S.next(ui + 1, nxt);
        const char* nA = GATHER ? (const char*)g.A : (has_next ? (const char*)g.A + (size_t)nxt.pm * tstep : cA); const char* nB = has_next ? (const char*)g.Bt + (size_t)nxt.pn * tstep : cB;
#pragma unroll 1
        for (int t = 0; t < nt; t += 2) {
            const bool last = (t == nt - 2);
            const char* a1 = cA + (size_t)(t + 1) * kstep;
            const char* a2 = last ? nA : cA + (size_t)(t + 2) * kstep; const char* b2 = last ? nB : cB + (size_t)(t + 2) * kstep;
            const char* a3 = a2 + kstep; const char* b3 = b2 + kstep;
            const int on = (last && has_next) ? ui + 1 : ui;
            PG8_LDB(B0, 0, 0); PG8_LDB(B1, 0, 1); PG8_SCHED; PG8_LDA(At, 0, 0); PG8_STAGE_A(PG8_SA(1, 1), a1 + hstepA, ui, 1);
            PG8_WAIT_V(8); PG8_WAIT_L(0); PG8_BAR; PG8_MMA(0, 0, At, B0); PG8_MMA(0, 1, At, B1); PG8_BAR; PG8_SCHED;
            PG8_LDA(At, 0, 1); PG8_STAGE_B(PG8_SB(0, 0), b2); PG8_STAGE_B(PG8_SB(0, 1), b2 + hstep); PG8_STAGE_A(PG8_SA(0, 0), a2, on, 0);
            PG8_WAIT_V(8); PG8_WAIT_L(0); PG8_BAR; PG8_MMA(1, 0, At, B0); PG8_MMA(1, 1, At, B1); PG8_BAR; PG8_SCHED;
            PG8_LDB(B0, 1, 0); PG8_LDB(B1, 1, 1); PG8_SCHED; PG8_LDA(At, 1, 0); PG8_STAGE_A(PG8_SA(0, 1), a2 + hstepA, on, 1);
            PG8_WAIT_V(8); PG8_WAIT_L(0); PG8_BAR; PG8_MMA(0, 0, At, B0); PG8_MMA(0, 1, At, B1); PG8_BAR; PG8_SCHED;
            PG8_LDA(At, 1, 1); PG8_STAGE_B(PG8_SB(1, 0), b3); PG8_STAGE_B(PG8_SB(1, 1), b3 + hstep); PG8_STAGE_A(PG8_SA(1, 0), a3, on, 0);
            PG8_WAIT_V(8); PG8_WAIT_L(0); PG8_BAR; PG8_MMA(1, 0, At, B0); PG8_MMA(1, 1, At, B1); PG8_BAR; PG8_SCHED;
        }
        if (wr == 0) PG8_BAR;
        E(acc, cur, wr, wc, fr, fq);
        if (!has_next) break;
#pragma unroll
        for (int a = 0; a < 2; ++a)
#pragma unroll
            for (int b = 0; b < 2; ++b)
#pragma unroll
                for (int m = 0; m < 4; ++m)
#pragma unroll
                    for (int n = 0; n < 2; ++n) acc[a][b][m][n] = (f32x4){0.f, 0.f, 0.f, 0.f};
        cur = nxt; cA = nA; cB = nB; ++ui;
        if (wr == 1) PG8_BAR;
    }
    PG8_WAIT_V(0);
    PG8_BAR;
#undef PG8_SA
#undef PG8_SB
#undef PG8_STAGE
#undef PG8_LDA
#undef PG8_LDB
#undef PG8_MMA
#undef PG8_WAIT_V
#undef PG8_WAIT_L
#undef PG8_BAR
#undef PG8_SCHED
#undef PG8_STAGE_A
#undef PG8_STAGE_B
#undef PG8_STAGE1
}
struct EpiBf16 {
    bf16_t* O; int ldc, ncolt; size_t slab;
    __device__ __forceinline__ void operator()(const f32x4 (&acc)[2][2][4][2], const Unit& u, int wr, int wc, int fr, int fq) const {
        const int row0 = u.pm * BM + wr * 64 + fr; const size_t col0 = (size_t)(u.pn % ncolt) * slab + wc * 32 + 8 * fq;
#pragma unroll
        for (int ai = 0; ai < 2; ++ai)
#pragma unroll
            for (int m = 0; m < 4; ++m) { bf16_t* rowp = O + (size_t)(row0 + ai * HALF + m * 16) * ldc + col0;
#pragma unroll
                for (int bj = 0; bj < 2; ++bj) { const f32x4 v0 = acc[ai][bj][m][0], v1 = acc[ai][bj][m][1];
                    u32x4 w; w.x = cvt_pk_bf16(v0[0], v0[1]); w.y = cvt_pk_bf16(v0[2], v0[3]); w.z = cvt_pk_bf16(v1[0], v1[1]); w.w = cvt_pk_bf16(v1[2], v1[3]);
                    *(u32x4*)(rowp + bj * HALF) = w; } }
    }
};
struct EpiRes {
    bf16_t* X; const float* xlat; const float* xctx; const float* modl; int pm_shift; float ascale; bool perm = false;
    __device__ __forceinline__ void operator()(const f32x4 (&acc)[2][2][4][2], const Unit& u, int wr, int wc, int fr, int fq) const {
        const int pm = u.pm - pm_shift; const int rsel = pm < 64 ? (pm >> 5) : 2;
        const int row0 = pm * BM + wr * 64 + fr, col0 = (u.pn & 3) * BM + (perm ? wc * 64 + 16 * fq : wc * 32 + 8 * fq), bjs = perm ? 8 : HALF;
        const float* gate = modl + (size_t)rsel * 6144 + col0;
        const float* xs = xlat ? (pm < 64 ? xlat + (size_t)row0 * D : xctx + (size_t)(row0 - R_LAT) * D) + col0 : nullptr;
        bf16_t* xo = X + (size_t)row0 * D + col0;
#pragma unroll
        for (int bj = 0; bj < 2; ++bj) { const f32x4 g0 = *(const f32x4*)(gate + bj * bjs) * ascale, g1 = *(const f32x4*)(gate + bj * bjs + 4) * ascale;
#pragma unroll
            for (int ai = 0; ai < 2; ++ai)
#pragma unroll
                for (int m = 0; m < 4; ++m) { const size_t o = (size_t)(ai * HALF + m * 16) * D + bj * bjs;
                    f32x4 x0, x1;
                    if (xs) { x0 = *(const f32x4*)(xs + o); x1 = *(const f32x4*)(xs + o + 4); } else unpack8(*(const u32x4*)(xo + o), x0, x1);
                    const f32x4 y0 = x0 + g0 * acc[ai][bj][m][0], y1 = x1 + g1 * acc[ai][bj][m][1];
                    u32x4 w; w.x = cvt_pk_bf16(y0[0], y0[1]); w.y = cvt_pk_bf16(y0[2], y0[3]); w.z = cvt_pk_bf16(y1[0], y1[1]); w.w = cvt_pk_bf16(y1[2], y1[3]);
                    *(u32x4*)(xo + o) = w; } }
    }
};
struct EpiGU8 {
    unsigned char* H8; const LAS float* wtab;
    __device__ __forceinline__ void operator()(const f32x4 (&acc)[2][2][4][2], const Unit& u, int wr, int wc, int fr, int fq) const {
        { const int t_ = tid_(); fr = t_ & 15; fq = (t_ >> 4) & 3; }
        const int row0 = u.pm * BM + wr * 64 + fr, col0 = (u.pn & 1) * 128 + wc * 32 + 8 * fq;
#pragma unroll
        for (int ai = 0; ai < 2; ++ai)
#pragma unroll
            for (int m = 0; m < 4; ++m) { const int row = row0 + ai * HALF + m * 16; const float w = wtab[u.ord * 256 + wr * 64 + fr + ai * HALF + m * 16] * (H8_SCALE * GU_DESCALE * GU_DESCALE);
                float h[8];
#pragma unroll
                for (int n = 0; n < 2; ++n)
#pragma unroll
                    for (int j = 0; j < 4; ++j) { const float ag = acc[ai][0][m][n][j], au = acc[ai][1][m][n][j];
                        h[n * 4 + j] = __builtin_amdgcn_fmed3f((ag * au) * __builtin_amdgcn_rcpf(1.f + __builtin_amdgcn_exp2f(ag * (-GU_DESCALE * LOG2E))) * w, -440.f, 440.f); }
                int w0 = __builtin_amdgcn_cvt_pk_fp8_f32(h[0], h[1], 0, false); w0 = __builtin_amdgcn_cvt_pk_fp8_f32(h[2], h[3], w0, true);
                int w1 = __builtin_amdgcn_cvt_pk_fp8_f32(h[4], h[5], 0, false); w1 = __builtin_amdgcn_cvt_pk_fp8_f32(h[6], h[7], w1, true);
                u32x2 o; o.x = (unsigned)w0; o.y = (unsigned)w1;
                *(u32x2*)(H8 + (size_t)row * 256 + col0) = o; }
    }
};
struct EpiGU {
    bf16_t* H; const float* slot_w;
    __device__ __forceinline__ void operator()(const f32x4 (&acc)[2][2][4][2], const Unit& u, int wr, int wc, int fr, int fq) const {
        const int row0 = u.pm * BM + wr * 64 + fr, col0 = (u.pn & 1) * 128 + wc * 32 + 8 * fq;
#pragma unroll
        for (int ai = 0; ai < 2; ++ai)
#pragma unroll
            for (int m = 0; m < 4; ++m) { const int row = row0 + ai * HALF + m * 16; const float w = slot_w[row];
                float h[8];
#pragma unroll
                for (int n = 0; n < 2; ++n)
#pragma unroll
                    for (int j = 0; j < 4; ++j) { const float gv = acc[ai][0][m][n][j], uv = acc[ai][1][m][n][j]; h[n * 4 + j] = gv / (1.f + __expf(-gv)) * uv * w; }
                u32x4 o; o.x = cvt_pk_bf16(h[0], h[1]); o.y = cvt_pk_bf16(h[2], h[3]); o.z = cvt_pk_bf16(h[4], h[5]); o.w = cvt_pk_bf16(h[6], h[7]);
                *(u32x4*)(H + (size_t)row * 256 + col0) = o; }
    }
};
struct EpiY8 {
    unsigned char* Y8;
    __device__ __forceinline__ void operator()(const f32x4 (&acc)[2][2][4][2], const Unit& u, int wr, int wc, int fr, int fq) const {
        const int row0 = u.pm * BM + wr * 64 + fr; unsigned char* base = Y8 + ((size_t)(u.pn & 3) * MAXSLOT + row0) * 256 + wc * 64 + 16 * fq;
#pragma unroll
        for (int ai = 0; ai < 2; ++ai)
#pragma unroll
            for (int m = 0; m < 4; ++m) { unsigned w[4];
#pragma unroll
                for (int bj = 0; bj < 2; ++bj) { f32x4 v0 = acc[ai][bj][m][0] * (Y8_SCALE * DN_DESCALE), v1 = acc[ai][bj][m][1] * (Y8_SCALE * DN_DESCALE);
#pragma unroll
                    for (int q = 0; q < 4; ++q) { v0[q] = fminf(fmaxf(v0[q], -440.f), 440.f); v1[q] = fminf(fmaxf(v1[q], -440.f), 440.f); }
                    int w0 = __builtin_amdgcn_cvt_pk_fp8_f32(v0[0], v0[1], 0, false); w0 = __builtin_amdgcn_cvt_pk_fp8_f32(v0[2], v0[3], w0, true);
                    int w1 = __builtin_amdgcn_cvt_pk_fp8_f32(v1[0], v1[1], 0, false); w1 = __builtin_amdgcn_cvt_pk_fp8_f32(v1[2], v1[3], w1, true);
                    w[2 * bj] = (unsigned)w0; w[2 * bj + 1] = (unsigned)w1; }
                *(u32x4*)(base + (size_t)(ai * HALF + m * 16) * 256) = (u32x4){w[0], w[1], w[2], w[3]}; }
    }
};
struct EpiDown {
    bf16_t* Y; bf16_t* X; const float* modl5;
    __device__ __forceinline__ void operator()(const f32x4 (&acc)[2][2][4][2], const Unit& u, int wr, int wc, int fr, int fq) const {
        { const int t_ = tid_(); fr = t_ & 15; fq = (t_ >> 4) & 3; }
        if (u.pm < MAXSLOT / 256) { const EpiY8 e{(unsigned char*)Y}; e(acc, u, wr, wc, fr, fq); }
        else { const EpiRes e{X, nullptr, nullptr, modl5, MAXSLOT / 256, DN_DESCALE, true}; e(acc, u, wr, wc, fr, fq); }
    }
};
}


__device__ __forceinline__ void ph_inproj_f(KP p, int l, unsigned char* lds) {
    pg8::Gemm g{(const bf16_t*)(p->ws + Z_A), (const bf16_t*)(p->ws + win_off(l)), R_ALL, DIN, 1024};
    pg8::StaticOrder S; S.init(R_ALL, DIN, gsz_(), bid_());
    pg8::EpiBf16 E{(bf16_t*)(p->ws + Z_P), DIN, DIN / 256, 256};
    pg8::gemm_phase<pg8::EpiBf16, pg8::StaticOrder, false>((LAS unsigned char*)lds, g, S, E, nullptr);
    if (l == 0 && DEPTH > 1 && gsz_() == 256) { __syncthreads(); ph_cvt(p, 1, lds, 214, 42, 0, CVT_E1); }
}
__device__ __forceinline__ void ph_outproj_f(KP p, int l, unsigned char* lds) {
    const int T = (l == 0) ? R_ALL : R_LAT;
    pg8::Gemm g{(const bf16_t*)(p->ws + Z_YCAT), (const bf16_t*)(p->ws + wout_off(l)), T, 1024, 1024};
    pg8::StaticOrder S; S.init(T, 1024, gsz_(), bid_());
    bf16_t* X = (bf16_t*)(p->ws + WS_X);
    pg8::EpiRes E{X, l == 0 ? p->in[0] : nullptr, l == 0 ? p->in[2] : nullptr, (const float*)(p->ws + WS_MOD) + (size_t)l * 3 * 6144 + 2 * 1024, 0, 1.f};
    pg8::gemm_phase<pg8::EpiRes, pg8::StaticOrder, false>((LAS unsigned char*)lds, g, S, E, nullptr);
    if (l == 0 && DEPTH > 1) {
        const int G = gsz_(); __syncthreads();
        if (G == 256) ph_cvt(p, 1, lds, 8, 248, CVT_E2, 1 << 30); else ph_cvt(p, 1, lds); }
}
struct QkvLane { f32x4 gg0, gg1, gw0, gw1; };
__device__ __forceinline__ QkvLane qkv_lane_consts(KP p, int l, int lane) {
    QkvLane c; const int dch = (lane & 7) * 8; const int isk = lane >= 32;
    const float* gq = p->in[isk ? 11 : 10] + l * 64 + dch; const float* wq = p->in[isk ? 13 : 12] + l * 64 + dch;
    c.gg0 = *(const f32x4*)gq; c.gg1 = *(const f32x4*)(gq + 4); c.gw0 = *(const f32x4*)wq; c.gw1 = *(const f32x4*)(wq + 4); return c;
}
__device__ __forceinline__ void prep_qkv_row(KP p, int l, int row, int lane, const QkvLane& qc) {
    const bf16_t* pr = (const bf16_t*)(p->ws + Z_P) + (size_t)row * DIN;
    const bool isctx = row >= R_LAT; const int b = isctx ? ((row - R_LAT) >> 8) : (row >> 13), t = isctx ? ((row - R_LAT) & 255) : (row & 8191);
    const size_t krow = (size_t)b * NKEY + (isctx ? NSEQ + t : t);
    const int l7 = lane & 7, axis = l7 >> 2, half = (l7 >> 1) & 1;
    f32x4 cs0 = (f32x4){1.f, 1.f, 1.f, 1.f}, cs1 = cs0, sn0 = (f32x4){0.f, 0.f, 0.f, 0.f}, sn1 = sn0;
    if (!isctx) { const int pos = axis == 0 ? (t >> 6) : (t & 63); const float* rt = (const float*)(p->ws + WS_ROPE) + pos * 32 + (lane & 1) * 8;
        cs0 = *(const f32x4*)rt; cs1 = *(const f32x4*)(rt + 4); sn0 = *(const f32x4*)(rt + 16); sn1 = *(const f32x4*)(rt + 20); }
    const u32x4 ra = *(const u32x4*)(pr + lane * 8), rb = *(const u32x4*)(pr + 512 + lane * 8);
#pragma unroll
    for (int grp = 0; grp < 2; ++grp) {
        const u32x4 r = grp ? rb : ra;
        bf16_t* Qd = (bf16_t*)(p->ws + (isctx ? (grp ? Z_QWC : Z_QGC) : (grp ? Z_QW : Z_QG))) + (size_t)(isctx ? (b * NCTX + t) : row) * 256;
        bf16_t* Kd = (bf16_t*)(p->ws + (grp ? Z_KW : Z_KG)) + krow * 128; bf16_t* Vd = (bf16_t*)(p->ws + (grp ? Z_VW : Z_VG)) + krow * 128;
        if (lane >= 48) { *(u32x4*)(Vd + (lane - 48) * 8) = r; continue; }
        float x[8] = {bf2f(r.x & 0xffffu), bf2f(r.x >> 16), bf2f(r.y & 0xffffu), bf2f(r.y >> 16), bf2f(r.z & 0xffffu), bf2f(r.z >> 16), bf2f(r.w & 0xffffu), bf2f(r.w >> 16)};
        float ss = 0.f;
#pragma unroll
        for (int i = 0; i < 8; ++i) ss += x[i] * x[i];
        ss += __shfl_xor(ss, 1); ss += __shfl_xor(ss, 2); ss += __shfl_xor(ss, 4);
        const float rinv = rsqrtf(ss * (1.f / 64.f) + EPS);
        const f32x4 g0 = grp ? qc.gw0 : qc.gg0, g1 = grp ? qc.gw1 : qc.gg1;
        const float gv[8] = {g0.x, g0.y, g0.z, g0.w, g1.x, g1.y, g1.z, g1.w};
        const float cv[8] = {cs0.x, cs0.y, cs0.z, cs0.w, cs1.x, cs1.y, cs1.z, cs1.w}, sv[8] = {sn0.x, sn0.y, sn0.z, sn0.w, sn1.x, sn1.y, sn1.z, sn1.w};
        const float qs = (lane < 32) ? QSCALE : 1.f;
        float y[8];
#pragma unroll
        for (int i = 0; i < 8; ++i) { const float v = x[i] * rinv * gv[i]; const float o = __shfl_xor(v, 2);
            y[i] = ((half == 0) ? (v * cv[i] - o * sv[i]) : (o * sv[i] + v * cv[i])) * qs; }
        u32x4 ov; ov.x = pk2(y[0], y[1]); ov.y = pk2(y[2], y[3]); ov.z = pk2(y[4], y[5]); ov.w = pk2(y[6], y[7]);
        if (lane < 32) *(u32x4*)(Qd + lane * 8) = ov; else *(u32x4*)(Kd + (lane - 32) * 8) = ov;
    }
}

template <int R> __device__ __forceinline__ void dw_rows(const float* hcol, const float (&wj)[31], float (&acc)[32]) {
    if constexpr (R < 62) {
        const float hv = hcol[R * 256];
        constexpr int T0 = (R - 30 > 0) ? R - 30 : 0, T1 = (R < 31) ? R : 31;
#pragma unroll
        for (int tt = T0; tt <= T1; ++tt) acc[tt] += hv * wj[R - tt];
        dw_rows<R + 1>(hcol, wj, acc);
    }
}
__device__ __forceinline__ void conv_tile(KP p, int l, unsigned char* lds, int seq_row0, int seqlen, int t0) {
    float* hb = (float*)lds;
    const int tid = tid_(), lane = tid & 63, wid = tid >> 6;
    const bf16_t* P = (const bf16_t*)(p->ws + Z_P);
    for (int i = tid; i < 94 * 32; i += NTHREADS) { const int r = i >> 5, c8 = (i & 31) * 8, t = t0 - 15 + r;
        f32x4 h0 = (f32x4){0.f, 0.f, 0.f, 0.f}, h1 = h0;
        if (t >= 0 && t < seqlen) { const bf16_t* pr = P + (size_t)(seq_row0 + t) * DIN;
            const u32x4 vv = *(const u32x4*)(pr + C_CVV + c8), gg = *(const u32x4*)(pr + C_CVG + c8);
            h0.x = bf2f(vv.x & 0xffffu) * sigmoid_(bf2f(gg.x & 0xffffu)); h0.y = bf2f(vv.x >> 16) * sigmoid_(bf2f(gg.x >> 16));
            h0.z = bf2f(vv.y & 0xffffu) * sigmoid_(bf2f(gg.y & 0xffffu)); h0.w = bf2f(vv.y >> 16) * sigmoid_(bf2f(gg.y >> 16));
            h1.x = bf2f(vv.z & 0xffffu) * sigmoid_(bf2f(gg.z & 0xffffu)); h1.y = bf2f(vv.z >> 16) * sigmoid_(bf2f(gg.z >> 16));
            h1.z = bf2f(vv.w & 0xffffu) * sigmoid_(bf2f(gg.w & 0xffffu)); h1.w = bf2f(vv.w >> 16) * sigmoid_(bf2f(gg.w >> 16)); }
        *(f32x4*)(hb + r * 256 + c8) = h0; *(f32x4*)(hb + r * 256 + c8 + 4) = h1; }
    __syncthreads();
    { const int c = tid & 255, hf = tid >> 8;
      const float* w = p->in[15] + (size_t)l * 31 * 256 + c; const float bias = p->in[16][l * 256 + c];
      float wj[31];
#pragma unroll
      for (int j = 0; j < 31; ++j) wj[j] = w[j * 256];
      float acc[32];
#pragma unroll
      for (int tt = 0; tt < 32; ++tt) acc[tt] = bias;
      dw_rows<0>(hb + hf * 32 * 256 + c, wj, acc);
      __syncthreads();
#pragma unroll
      for (int tt = 0; tt < 32; ++tt) hb[(hf * 32 + tt) * 256 + c] = acc[tt];
    }
    __syncthreads();
    constexpr int AS = 264;
    bf16_t* ab = (bf16_t*)(lds + 94 * 256 * 4);
    for (int tt = wid; tt < 64; tt += 8) { const float* r = hb + tt * 256; const f32x4 v = ((const f32x4*)r)[lane];
        const float mean = wave_sum(v.x + v.y + v.z + v.w) * (1.f / 256.f);
        const float dx = v.x - mean, dy = v.y - mean, dz = v.z - mean, dw = v.w - mean;
        const float rstd = rsqrtf(wave_sum(dx * dx + dy * dy + dz * dz + dw * dw) * (1.f / 256.f) + EPS);
        const f32x4 g = ((const f32x4*)(p->in[17] + l * 256))[lane], bb = ((const f32x4*)(p->in[18] + l * 256))[lane];
        u32x2 o; o.x = pk2(silu_(dx * rstd * g.x + bb.x), silu_(dy * rstd * g.y + bb.y)); o.y = pk2(silu_(dz * rstd * g.z + bb.z), silu_(dw * rstd * g.w + bb.w));
        *(u32x2*)(ab + tt * AS + lane * 4) = o; }
    __syncthreads();
    { const int fr = lane & 15, fq = lane >> 4;
      const bf16_t* Wt = (const bf16_t*)(p->ws + wpw_off(l));
      bf16x8 bw[2][8];
#pragma unroll
      for (int j = 0; j < 2; ++j)
#pragma unroll
          for (int ks = 0; ks < 8; ++ks) bw[j][ks] = *(const bf16x8*)(Wt + (size_t)((wid * 2 + j) * 16 + fr) * 256 + ks * 32 + fq * 8);
      const float bias0 = p->in[20][l * 256 + wid * 32 + fr], bias1 = p->in[20][l * 256 + wid * 32 + 16 + fr];
      bf16_t* Y = (bf16_t*)(p->ws + Z_YCAT);
#pragma unroll 1
      for (int tr = 0; tr < 4; ++tr) { f32x4 a0 = (f32x4){0.f, 0.f, 0.f, 0.f}, a1 = a0;
#pragma unroll
          for (int ks = 0; ks < 8; ++ks) { const bf16x8 av = *(const bf16x8*)(ab + (tr * 16 + fr) * AS + ks * 32 + fq * 8);
              a0 = __builtin_amdgcn_mfma_f32_16x16x32_bf16(av, bw[0][ks], a0, 0, 0, 0); a1 = __builtin_amdgcn_mfma_f32_16x16x32_bf16(av, bw[1][ks], a1, 0, 0, 0); }
#pragma unroll
          for (int r = 0; r < 4; ++r) { const int t = t0 + tr * 16 + fq * 4 + r; bf16_t* yr = Y + (size_t)(seq_row0 + t) * D + 256 + wid * 32 + fr;
              yr[0] = (bf16_t)f2bf(a0[r] + bias0); yr[16] = (bf16_t)f2bf(a1[r] + bias1); } }
    }
    __syncthreads();
}

__device__ __forceinline__ int hgrn_chunk_row0(int b, int dir, int j) {
    if (j < 4) { const int cj = dir ? 3 - j : j; return R_LAT + b * NCTX + cj * 64; }
    const int jj = j - 4, cj = dir ? 127 - jj : jj; return b * NSEQ + cj * 64;
}
__device__ __forceinline__ void hgrn_load_chunk(KP p, int l, int row0, int dir, int head, float* qs, float* vs, float* ks, float* cs) {
    const int tid = tid_();
    const bf16_t* P = (const bf16_t*)(p->ws + Z_P);
    const float* lbv = (const float*)(p->ws + WS_LB) + (l * 2 + dir) * 256 + head * 64;
    for (int i = tid; i < 4096; i += NTHREADS) { const int tau = i >> 6, d = i & 63; const int row = row0 + (dir ? 63 - tau : tau);
        const bf16_t* pr = P + (size_t)row * DIN + head * 64 + d;
        if (qs) qs[i] = bf2f(pr[C_RQ]);
        vs[i] = bf2f(pr[C_RI]);
        const float z = bf2f(pr[dir ? C_RFB : C_RFF]); const float lb = lbv[d];
        const float lsp = fminf(z, 0.f) - log1pf(__expf(-fabsf(z)));
        float logf = lsp;
        if (lb > 0.f) { const float a = lsp, bq = __logf(lb) + (lsp - z); const float mx = fmaxf(a, bq); logf = mx + log1pf(__expf(-fabsf(a - bq))); }
        ks[i] = (1.f - lb) * sigmoid_(-z);
        cs[i] = logf; }
    __syncthreads();
    if (tid < 64) { float c = 0.f; for (int tau = 0; tau < 64; ++tau) { c += cs[tau * 64 + tid]; cs[tau * 64 + tid] = c; } }
    __syncthreads();
}
__device__ __forceinline__ void hgrn_pass1_unit(KP p, int l, unsigned char* lds, int unit) {
    float* vs = (float*)lds; float* ks = vs + 4096; float* cs = ks + 4096;
    const int tid = tid_();
    const int j = unit % NCHUNK, seq = unit / NCHUNK, dir = seq & 1, head = (seq >> 1) & 3, b = seq >> 3;
    hgrn_load_chunk(p, l, hgrn_chunk_row0(b, dir, j), dir, head, nullptr, vs, ks, cs);
    for (int i = tid; i < 4096; i += NTHREADS) { const int d = i & 63; ks[i] *= __expf(cs[63 * 64 + d] - cs[i]); }
    __syncthreads();
    float* U = (float*)(p->ws + Z_U) + ((size_t)seq * NCHUNK + j) * 4096; float* Gv = (float*)(p->ws + Z_G) + ((size_t)seq * NCHUNK + j) * 64;
    { const int d = tid >> 3, e0 = (tid & 7) * 8; float acc[8];
#pragma unroll
      for (int e = 0; e < 8; ++e) acc[e] = 0.f;
      for (int tau = 0; tau < 64; ++tau) { const float kv = ks[tau * 64 + d];
#pragma unroll
          for (int e = 0; e < 8; ++e) acc[e] += kv * vs[tau * 64 + e0 + e]; }
#pragma unroll
      for (int e = 0; e < 8; ++e) U[d * 64 + e0 + e] = acc[e]; }
    if (tid < 64) Gv[tid] = __expf(cs[63 * 64 + tid]);
    __syncthreads();
}
constexpr int HS = 72;
constexpr int HL_TOT = 0, HL_OSUM = 2048, HL_T0 = 18432, HL_TB = 64 * HS * 2;
__device__ __forceinline__ f32x4 mm64(const bf16_t* A, const bf16_t* Bt, int tr, int tc, int fr, int fq, f32x4 acc) {
#pragma unroll
    for (int k0 = 0; k0 < 64; k0 += 32) { const bf16x8 a = *(const bf16x8*)(A + (tr * 16 + fr) * HS + k0 + fq * 8), b = *(const bf16x8*)(Bt + (tc * 16 + fr) * HS + k0 + fq * 8);
        acc = __builtin_amdgcn_mfma_f32_16x16x32_bf16(a, b, acc, 0, 0, 0); }
    return acc;
}
__device__ __forceinline__ void hgrn_load8(KP p, int row0, int dir, int head, int tid, float (&q)[8], float (&vv)[8], float (&z)[8]) {
    const int d = tid & 63, seg = tid >> 6;
    const bf16_t* P = (const bf16_t*)(p->ws + Z_P);
#pragma unroll
    for (int i = 0; i < 8; ++i) { const int tau = seg * 8 + i; const int row = row0 + (dir ? 63 - tau : tau);
        const bf16_t* pr = P + (size_t)row * DIN + head * 64 + d;
        q[i] = bf2f(pr[C_RQ]); vv[i] = bf2f(pr[C_RI]); z[i] = bf2f(pr[dir ? C_RFB : C_RFF]); }
}
__device__ __forceinline__ void hgrn_gate8(KP p, int l, int dir, int head, int tid, float* tot, const float (&z)[8], float (&kg)[8], float (&c)[8], float& m, float& cl) {
    const int d = tid & 63, seg = tid >> 6;
    const float lb = ((const float*)(p->ws + WS_LB))[(l * 2 + dir) * 256 + head * 64 + d];
    float run = 0.f;
#pragma unroll
    for (int i = 0; i < 8; ++i) {
        const float ez = __expf(-fabsf(z[i])), rz = __builtin_amdgcn_rcpf(1.f + ez); const float sg = (z[i] >= 0.f) ? rz : ez * rz;
        const float f = lb + (1.f - lb) * sg;
        kg[i] = 1.f - f;
        run += __logf(f); c[i] = run; }
    tot[seg * 64 + d] = run;
    __syncthreads();
    float off = 0.f; m = 0.f; cl = 0.f;
#pragma unroll
    for (int s2 = 0; s2 < 8; ++s2) { const float t = tot[s2 * 64 + d]; if (s2 < seg) off += t; if (s2 < 4) m += t; cl += t; }
#pragma unroll
    for (int i = 0; i < 8; ++i) c[i] += off;
}
__device__ __forceinline__ void hgrn_pass1_f(KP p, int l, unsigned char* lds, int unit) {
    const int tid = tid_(), lane = tid & 63, wid = tid >> 6, fr = lane & 15, fq = lane >> 4, d = tid & 63, seg = tid >> 6;
    float* tot = (float*)(lds + HL_TOT); bf16_t* Vt = (bf16_t*)(lds + HL_T0); bf16_t* KbT = (bf16_t*)(lds + HL_T0 + HL_TB);
    const int j = unit % NCHUNK, seq = unit / NCHUNK, dir = seq & 1, head = (seq >> 1) & 3, b = seq >> 3;
    float q[8], vv[8], z[8], kg[8], c[8], m, cl;
    hgrn_load8(p, hgrn_chunk_row0(b, dir, j), dir, head, tid, q, vv, z);
    hgrn_gate8(p, l, dir, head, tid, tot, z, kg, c, m, cl);
    float kb[8];
#pragma unroll
    for (int i = 0; i < 8; ++i) kb[i] = kg[i] * __expf(cl - c[i]);
    *(u32x4*)(Vt + d * HS + seg * 8) = pack8(vv);
    *(u32x4*)(KbT + d * HS + seg * 8) = pack8(kb);
    float* U = (float*)(p->ws + Z_U) + ((size_t)seq * NCHUNK + j) * 4096; float* Gv = (float*)(p->ws + Z_G) + ((size_t)seq * NCHUNK + j) * 64;
    if (seg == 0) Gv[d] = __expf(cl);
    __syncthreads();
    const int tr = wid >> 1;
#pragma unroll
    for (int t2 = 0; t2 < 2; ++t2) { const int tc = (wid & 1) * 2 + t2;
        const f32x4 acc = mm64(Vt, KbT, tr, tc, fr, fq, (f32x4){0.f, 0.f, 0.f, 0.f});
#pragma unroll
        for (int r = 0; r < 4; ++r) U[(tr * 16 + fq * 4 + r) * 64 + tc * 16 + fr] = acc[r]; }
    __syncthreads();
}
struct HgrnIn1 { float v[8], zf[8], zb[8]; };
__device__ __forceinline__ void hgrn_p1_load(KP p, int unit, int tid, HgrnIn1& r) {
    const int cpos = unit % NCHUNK, head = (unit / NCHUNK) & 3, b = unit / (NCHUNK * 4), d = tid & 63, seg = tid >> 6;
    const int row0 = (cpos < 4) ? R_LAT + b * NCTX + cpos * 64 : b * NSEQ + (cpos - 4) * 64;
    const bf16_t* P = (const bf16_t*)(p->ws + Z_P) + (size_t)(row0 + seg * 8) * DIN + head * 64 + d;
#pragma unroll
    for (int i = 0; i < 8; ++i) { const bf16_t* pr = P + (size_t)i * DIN; r.v[i] = bf2f(pr[C_RI]); r.zf[i] = bf2f(pr[C_RFF]); r.zb[i] = bf2f(pr[C_RFB]); }
}
__device__ __forceinline__ void hgrn_p1_compute(KP p, int l, unsigned char* lds, int unit, int tid, const HgrnIn1& r) {
    const int lane = tid & 63, wid = tid >> 6, fr = lane & 15, fq = lane >> 4, d = tid & 63, seg = tid >> 6;
    float* totf = (float*)(lds + HL_TOT); float* totb = (float*)(lds + HL_OSUM);
    bf16_t* Vt = (bf16_t*)(lds + HL_T0); bf16_t* KfT = (bf16_t*)(lds + HL_T0 + HL_TB); bf16_t* KbT = (bf16_t*)(lds + HL_T0 + 2 * HL_TB);
    const int cpos = unit % NCHUNK, head = (unit / NCHUNK) & 3, b = unit / (NCHUNK * 4);
    const float* lbp = (const float*)(p->ws + WS_LB) + (l * 2) * 256 + head * 64 + d; const float lbf = lbp[0], lbb = lbp[256];
    float kf[8], kb[8], cf[8], cb[8], lfb[8], runf = 0.f, runb = 0.f;
#pragma unroll
    for (int i = 0; i < 8; ++i) {
        { const float z = r.zf[i], ez = __builtin_amdgcn_exp2f(-fabsf(z) * LOG2E), rz = __builtin_amdgcn_rcpf(1.f + ez), sg = (z >= 0.f) ? rz : ez * rz, f = lbf + (1.f - lbf) * sg; kf[i] = 1.f - f; runf += __builtin_amdgcn_logf(f); cf[i] = runf; }
        { const float z = r.zb[i], ez = __builtin_amdgcn_exp2f(-fabsf(z) * LOG2E), rz = __builtin_amdgcn_rcpf(1.f + ez), sg = (z >= 0.f) ? rz : ez * rz, f = lbb + (1.f - lbb) * sg; kb[i] = 1.f - f; lfb[i] = __builtin_amdgcn_logf(f); runb += lfb[i]; cb[i] = runb; } }
    totf[seg * 64 + d] = runf; totb[seg * 64 + d] = runb;
    __syncthreads();
    float offf = 0.f, offb = 0.f, clf = 0.f, clb = 0.f;
#pragma unroll
    for (int s2 = 0; s2 < 8; ++s2) { const float tf = totf[s2 * 64 + d], tb = totb[s2 * 64 + d]; if (s2 < seg) { offf += tf; offb += tb; } clf += tf; clb += tb; }
#pragma unroll
    for (int i = 0; i < 8; ++i) { kf[i] *= __builtin_amdgcn_exp2f(clf - (cf[i] + offf)); kb[i] *= __builtin_amdgcn_exp2f(cb[i] + offb - lfb[i]); }
    *(u32x4*)(Vt + d * HS + seg * 8) = pack8(r.v);
    *(u32x4*)(KfT + d * HS + seg * 8) = pack8(kf);
    *(u32x4*)(KbT + d * HS + seg * 8) = pack8(kb);
    const int jf = cpos, jb = (cpos < 4) ? 3 - cpos : 4 + 127 - (cpos - 4); const int seqf = (b * 4 + head) * 2;
    bf16_t* Uf = (bf16_t*)(p->ws + Z_U) + ((size_t)seqf * NCHUNK + jf) * 4096; bf16_t* Ub = (bf16_t*)(p->ws + Z_U) + ((size_t)(seqf + 1) * NCHUNK + jb) * 4096;
    float* Gf = (float*)(p->ws + Z_G) + ((size_t)seqf * NCHUNK + jf) * 64; float* Gb = (float*)(p->ws + Z_G) + ((size_t)(seqf + 1) * NCHUNK + jb) * 64;
    if (seg == 0) { Gf[d] = __builtin_amdgcn_exp2f(clf); Gb[d] = __builtin_amdgcn_exp2f(clb); }
    __syncthreads();
    const int tr = wid >> 1;
#pragma unroll
    for (int t2 = 0; t2 < 2; ++t2) { const int tc = (wid & 1) * 2 + t2;
        const f32x4 af = mm64(Vt, KfT, tr, tc, fr, fq, (f32x4){0.f, 0.f, 0.f, 0.f}), ab = mm64(Vt, KbT, tr, tc, fr, fq, (f32x4){0.f, 0.f, 0.f, 0.f});
#pragma unroll
        for (int q = 0; q < 4; ++q) { const int o = (tr * 16 + fq * 4 + q) * 64 + tc * 16 + fr; Uf[o] = (bf16_t)f2bf(af[q]); Ub[o] = (bf16_t)f2bf(ab[q]); } }
    __syncthreads();
}
__device__ __forceinline__ void hgrn_pass1_run(KP p, int l, unsigned char* lds, int u0, int un, int ustep) {
    if (un <= 0) return;
    const int tid = tid_();
    HgrnIn1 cur; hgrn_p1_load(p, u0, tid, cur);
    for (int k = 0; k < un; ++k) { const int u = u0 + k * ustep;
        HgrnIn1 nxt = cur; if (k + 1 < un) hgrn_p1_load(p, u + ustep, tid, nxt);
        hgrn_p1_compute(p, l, lds, u, tid, cur);
        cur = nxt; }
}
__device__ __forceinline__ void hgrn_scan_f(KP p) {
    const int tid = tid_();
    if (tid >= 256) return;
    for (int gi = bid_() * 256 + tid; gi < 16 * 4096; gi += gsz_() * 256) {
    const int seq = gi >> 12, ed = gi & 4095, d = ed & 63;
    bf16_t* U = (bf16_t*)(p->ws + Z_U) + (size_t)seq * NCHUNK * 4096 + ed; const float* Gv = (const float*)(p->ws + Z_G) + (size_t)seq * NCHUNK * 64 + d;
    float S = 0.f;
#pragma unroll 1
    for (int j = 0; j < NCHUNK; j += 12) {
        float u[12], g[12];
#pragma unroll
        for (int q = 0; q < 12; ++q) { u[q] = bf2f(U[(size_t)(j + q) * 4096]); g[q] = Gv[(j + q) * 64]; }
#pragma unroll
        for (int q = 0; q < 12; ++q) { U[(size_t)(j + q) * 4096] = (bf16_t)f2bf(S); S = g[q] * S + u[q]; }
    }
    }
}
struct HgrnIn3 { float q[8], v[8], zf[8], zb[8], gg[8]; u32x4 sf, sb; };
__device__ __forceinline__ void hgrn_p3_load(KP p, int unit, int tid, HgrnIn3& r) {
    const int cpos = unit % NCHUNK, head = (unit / NCHUNK) & 3, b = unit / (NCHUNK * 4), d = tid & 63, seg = tid >> 6;
    const int row0 = (cpos < 4) ? R_LAT + b * NCTX + cpos * 64 : b * NSEQ + (cpos - 4) * 64;
    const bf16_t* P = (const bf16_t*)(p->ws + Z_P) + (size_t)(row0 + seg * 8) * DIN + head * 64 + d;
#pragma unroll
    for (int i = 0; i < 8; ++i) { const bf16_t* pr = P + (size_t)i * DIN; r.q[i] = bf2f(pr[C_RQ]); r.v[i] = bf2f(pr[C_RI]); r.zf[i] = bf2f(pr[C_RFF]); r.zb[i] = bf2f(pr[C_RFB]);
        r.gg[i] = bf2f(((const bf16_t*)(p->ws + Z_P))[(size_t)(row0 + seg + 8 * i) * DIN + C_RG + head * 64 + d]); }
    const int jf = cpos, jb = (cpos < 4) ? 3 - cpos : 4 + 127 - (cpos - 4); const int seqf = (b * 4 + head) * 2;
    const bf16_t* U = (const bf16_t*)(p->ws + Z_U);
    r.sf = *(const u32x4*)(U + ((size_t)seqf * NCHUNK + jf) * 4096 + tid * 8); r.sb = *(const u32x4*)(U + ((size_t)(seqf + 1) * NCHUNK + jb) * 4096 + tid * 8);
}
__device__ __forceinline__ void hgrn_p3_compute(KP p, int l, unsigned char* lds, int unit, int tid, const HgrnIn3& r) {
    const int lane = tid & 63, wid = tid >> 6, fr = lane & 15, fq = lane >> 4, d = tid & 63, seg = tid >> 6;
    constexpr int HL_D1 = HL_T0 + 6 * HL_TB, HL_TOT1 = HL_D1 + 6 * HL_TB;
    static_assert(HL_TOT1 + 2048 <= LDS_WVTAB_OFF, "HGRN pass-3 LDS fits below the wave table");
    float* os0 = (float*)(lds + HL_OSUM); float* os1 = (float*)(lds + HL_T0);
    const int cpos = unit % NCHUNK, head = (unit / NCHUNK) & 3, b = unit / (NCHUNK * 4);
    const int row0 = (cpos < 4) ? R_LAT + b * NCTX + cpos * 64 : b * NSEQ + (cpos - 4) * 64;
    const int tr = wid >> 1;
    const float* lbp = (const float*)(p->ws + WS_LB) + (l * 2) * 256 + head * 64 + d;
    const int segs = __builtin_amdgcn_readfirstlane(seg);
    float kg[2][8], c[2][8];
#pragma unroll
    for (int dir = 0; dir < 2; ++dir) { float* tot = (float*)(lds + (dir ? HL_TOT1 : HL_TOT));
        const float lb = lbp[dir * 256], olb = 1.f - lb; float run = 0.f;
#pragma unroll
        for (int ii = 0; ii < 8; ++ii) { const int i = dir ? 7 - ii : ii;
            const float z = dir ? r.zb[i] : r.zf[i];
            const float ez = __builtin_amdgcn_exp2f(-fabsf(z) * LOG2E), rz = __builtin_amdgcn_rcpf(1.f + ez), sg = (z >= 0.f) ? rz : ez * rz, f = lb + olb * sg;
            kg[dir][i] = 1.f - f; run += __builtin_amdgcn_logf(f); c[dir][i] = run; }
        tot[seg * 64 + d] = run; }
    __syncthreads();
#pragma unroll
    for (int dir = 0; dir < 2; ++dir) { const float* tot = (const float*)(lds + (dir ? HL_TOT1 : HL_TOT)); unsigned char* tb = lds + (dir ? HL_D1 : HL_T0);
        bf16_t* Qt = (bf16_t*)tb; bf16_t* Kt = (bf16_t*)(tb + HL_TB); bf16_t* Qb = (bf16_t*)(tb + 2 * HL_TB); bf16_t* St = (bf16_t*)(tb + 3 * HL_TB); bf16_t* Vt = (bf16_t*)(tb + 4 * HL_TB);
        float off = 0.f, m = 0.f;
#pragma unroll
        for (int s2 = 0; s2 < 8; ++s2) { const float t = tot[s2 * 64 + d]; const float fl = (dir ? (s2 > segs) : (s2 < segs)) ? 1.f : 0.f; off = fmaf(t, fl, off); if (dir ? (s2 >= 4) : (s2 < 4)) m += t; }
        float vr[8], qb[8];
#pragma unroll
        for (int i = 0; i < 8; ++i) { const float ci = c[dir][i] + off; const int tau = dir ? 63 - (seg * 8 + i) : seg * 8 + i; const float qv = r.q[i];
            const unsigned qk = pk2(qv * __builtin_amdgcn_exp2f(fminf(ci - m, 115.f)), kg[dir][i] * __builtin_amdgcn_exp2f(fminf(m - ci, 115.f)));
            Qt[tau * HS + d] = (bf16_t)(qk & 0xffffu); Kt[tau * HS + d] = (bf16_t)(qk >> 16);
            qb[i] = qv * __builtin_amdgcn_exp2f(ci);
            vr[i] = dir ? r.v[7 - i] : r.v[i]; }
#pragma unroll
        for (int i = 0; i < 8; i += 2) { const int t0 = dir ? 63 - (seg * 8 + i) : seg * 8 + i, t1 = dir ? t0 - 1 : t0 + 1; const unsigned qq = pk2(qb[i], qb[i + 1]);
            Qb[t0 * HS + d] = (bf16_t)(qq & 0xffffu); Qb[t1 * HS + d] = (bf16_t)(qq >> 16); }
        *(u32x4*)(Vt + d * HS + (dir ? 7 - seg : seg) * 8) = pack8(vr);
        *(u32x4*)(St + (tid >> 3) * HS + (tid & 7) * 8) = dir ? r.sb : r.sf; }
    __syncthreads();
    f32x4 oacc[2][2];
#pragma unroll
    for (int dir = 0; dir < 2; ++dir) { unsigned char* tb = lds + (dir ? HL_D1 : HL_T0);
        const bf16_t* Qt = (const bf16_t*)tb; const bf16_t* Kt = (const bf16_t*)(tb + HL_TB); const bf16_t* Qb = (const bf16_t*)(tb + 2 * HL_TB); const bf16_t* St = (const bf16_t*)(tb + 3 * HL_TB); bf16_t* Sc = (bf16_t*)(tb + 5 * HL_TB);
#pragma unroll
        for (int t2 = 0; t2 < 2; ++t2) { const int tc = (wid & 1) * 2 + t2;
            oacc[dir][t2] = mm64(Qb, St, tr, tc, fr, fq, (f32x4){0.f, 0.f, 0.f, 0.f});
            f32x4 sacc = (f32x4){0.f, 0.f, 0.f, 0.f};
            if (tc <= tr) sacc = mm64(Qt, Kt, tr, tc, fr, fq, sacc);
#pragma unroll
            for (int q = 0; q < 4; q += 2) { const int tau = tr * 16 + fq * 4 + q, sig = tc * 16 + fr; const unsigned ss = pk2(sig <= tau ? sacc[q] : 0.f, sig <= tau + 1 ? sacc[q + 1] : 0.f);
                Sc[tau * HS + sig] = (bf16_t)(ss & 0xffffu); Sc[(tau + 1) * HS + sig] = (bf16_t)(ss >> 16); } } }
    __syncthreads();
#pragma unroll
    for (int dir = 0; dir < 2; ++dir) { unsigned char* tb = lds + (dir ? HL_D1 : HL_T0); const bf16_t* Vt = (const bf16_t*)(tb + 4 * HL_TB); const bf16_t* Sc = (const bf16_t*)(tb + 5 * HL_TB);
        float* os = dir ? os1 : os0;
#pragma unroll
        for (int t2 = 0; t2 < 2; ++t2) { const int tc = (wid & 1) * 2 + t2;
            const f32x4 o = mm64(Sc, Vt, tr, tc, fr, fq, oacc[dir][t2]);
#pragma unroll
            for (int q = 0; q < 4; ++q) { const int tau = tr * 16 + fq * 4 + q, e = tc * 16 + fr, tok = dir ? 63 - tau : tau; os[tok * 64 + e] = o[q]; } } }
    __syncthreads();
    bf16_t* Y = (bf16_t*)(p->ws + Z_YCAT); const float ong = p->in[22][l * 64 + lane];
    float yo[8];
#pragma unroll
    for (int i = 0; i < 8; ++i) { const int tok = wid + 8 * i; const float v = os0[tok * 64 + lane] + os1[tok * 64 + lane];
        yo[i] = v * rsqrtf(wave_sum(v * v) * (1.f / 64.f) + EPS) * ong * silu_(r.gg[i]); }
#pragma unroll
    for (int i = 0; i < 8; i += 2) { const unsigned yy = pk2(yo[i], yo[i + 1]); bf16_t* yp = Y + (size_t)(row0 + wid + 8 * i) * D + 768 + head * 64 + lane;
        yp[0] = (bf16_t)(yy & 0xffffu); yp[(size_t)8 * D] = (bf16_t)(yy >> 16); }
    __syncthreads();
}
__device__ __forceinline__ int hgrn_p3_unit(int k) { if (k < 1024) { const int bh = k >> 7, c = k & 127; return bh * NCHUNK + 4 + c; } const int k2 = k - 1024; return (k2 >> 2) * NCHUNK + (k2 & 3); }
__device__ __forceinline__ void hgrn_pass3_run(KP p, int l, unsigned char* lds) {
    const int tid = tid_(), G = gsz_(), nunits = 1024 + (l == 0 ? 32 : 0);
    int k = bid_(); if (k >= nunits) return;
    HgrnIn3 cur; hgrn_p3_load(p, hgrn_p3_unit(k), tid, cur);
    for (;;) { const int kn = k + G; const bool more = kn < nunits;
        HgrnIn3 nxt = cur; if (more) hgrn_p3_load(p, hgrn_p3_unit(kn), tid, nxt);
        hgrn_p3_compute(p, l, lds, hgrn_p3_unit(k), tid, cur);
        if (!more) break;
        cur = nxt; k = kn; }
}
__device__ __forceinline__ void ph_prep(KP p, int l, unsigned char* lds) {
    const int tid = tid_(), lane = tid & 63, wid = tid >> 6, bid = bid_(), G = gsz_();
    const int nconv = 256 + (l == 0 ? 8 : 0);
    for (int it = bid; it < nconv; it += G) {
        if (it < 256) conv_tile(p, l, lds, (it >> 7) * NSEQ, NSEQ, (it & 127) * 64);
        else { const int c = it - 256; conv_tile(p, l, lds, R_LAT + (c >> 2) * NCTX, NCTX, (c & 3) * 64); } }
    if (G == 256) {
        const int u0 = bid < 8 ? 2 * bid : bid < 56 ? 16 + 5 * (bid - 8) : 256 + 4 * (bid - 56), un = bid < 8 ? 2 : bid < 56 ? 5 : 4;
        hgrn_pass1_run(p, l, lds, u0, un, 1);
        const int g0 = bid < 104 ? 8 * bid : bid < 168 ? 832 + 9 * (bid - 104) : 1408 + 8 * (bid - 168), gn = (bid >= 104 && bid < 168) ? 9 : 8;
        const QkvLane qc = qkv_lane_consts(p, l, lane);
        for (int g = g0; g < g0 + gn; ++g) prep_qkv_row(p, l, g * 8 + wid, lane, qc);
    } else {
        hgrn_pass1_run(p, l, lds, bid, (8 * NCHUNK - bid + G - 1) / G, G);
        const QkvLane qc = qkv_lane_consts(p, l, lane);
        for (int row = bid * 8 + wid; row < R_ALL; row += G * 8) prep_qkv_row(p, l, row, lane, qc);
    }
}

__device__ __forceinline__ void hgrn_scan(KP p) {
    const int gi = bid_() * NTHREADS + tid_();
    if (gi >= 16 * 4096) return;
    const int seq = gi >> 12, de = gi & 4095, d = de >> 6;
    float* U = (float*)(p->ws + Z_U) + (size_t)seq * NCHUNK * 4096 + de; const float* Gv = (const float*)(p->ws + Z_G) + (size_t)seq * NCHUNK * 64 + d;
    float S = 0.f;
    for (int j = 0; j < NCHUNK; j += 4) {
        float u[4], g[4];
#pragma unroll
        for (int q = 0; q < 4; ++q) { u[q] = U[(size_t)(j + q) * 4096]; g[q] = Gv[(j + q) * 64]; }
#pragma unroll
        for (int q = 0; q < 4; ++q) { U[(size_t)(j + q) * 4096] = S; S = g[q] * S + u[q]; }
    }
}
__device__ __forceinline__ void attn_simple_unit(unsigned char* lds, const bf16_t* Qrow0  , const bf16_t* Kb, const bf16_t* Vb  ,
                                                 int mode, int NT, int first_key, int q0, bool use_sink, float sink_log2, bf16_t* Orow0  ) {
    float* Ks = (float*)lds; float* Vs = Ks + 4096;
    const int tid = tid_();
    float q[64], o[64], m = -INFINITY, lsum = 0.f;
    if (tid < 256) {
#pragma unroll
        for (int d = 0; d < 64; ++d) { q[d] = bf2f(Qrow0[(size_t)tid * 256 + d]); o[d] = 0.f; }
    }
    for (int tt = 0; tt < NT; ++tt) {
        int key0, pos0 = 0; bool masked = false;
        if (mode == 0) key0 = first_key + 64 * tt;
        else if (tt < 4) key0 = NSEQ + 64 * tt;
        else { pos0 = q0 - 128 + 64 * (tt - 4); key0 = pos0 < 0 ? 0 : (pos0 > NSEQ - 64 ? NSEQ - 64 : pos0); masked = true; }
        __syncthreads();
        for (int i = tid; i < 4096; i += NTHREADS) { const int kk = i >> 6, d = i & 63; Ks[i] = bf2f(Kb[(size_t)(key0 + kk) * 128 + d]); Vs[i] = bf2f(Vb[(size_t)(key0 + kk) * 128 + d]); }
        __syncthreads();
        if (tid < 256) {
            for (int kk = 0; kk < 64; ++kk) {
                if (masked) { const int kp = pos0 + kk, qp = q0 + tid; const int df = qp - kp; if (kp < 0 || kp >= NSEQ || df > 128 || df < -128) continue; }
                float s = 0.f;
#pragma unroll
                for (int d = 0; d < 64; ++d) s += q[d] * Ks[kk * 64 + d];
                if (s > m) { const float f = exp2f(m - s); lsum *= f;
#pragma unroll
                    for (int d = 0; d < 64; ++d) o[d] *= f;
                    m = s; }
                const float pe = exp2f(s - m); lsum += pe;
#pragma unroll
                for (int d = 0; d < 64; ++d) o[d] += pe * Vs[kk * 64 + d];
            }
        }
    }
    if (tid < 256) {
        if (use_sink) lsum += exp2f(sink_log2 - m);
        const float inv = 1.f / lsum;
#pragma unroll
        for (int d = 0; d < 64; ++d) Orow0[(size_t)tid * D + d] = (bf16_t)f2bf(o[d] * inv);
    }
    __syncthreads();
}
__device__ __forceinline__ void ph_attn(KP p, int l, unsigned char* lds) {
    hgrn_scan(p);
    bf16_t* Y = (bf16_t*)(p->ws + Z_YCAT);
    const bf16_t* Qg = (const bf16_t*)(p->ws + Z_QG); const bf16_t* Qw = (const bf16_t*)(p->ws + Z_QW); const bf16_t* Qgc = (const bf16_t*)(p->ws + Z_QGC); const bf16_t* Qwc = (const bf16_t*)(p->ws + Z_QWC);
    const bf16_t* Kg = (const bf16_t*)(p->ws + Z_KG); const bf16_t* Kw = (const bf16_t*)(p->ws + Z_KW); const bf16_t* Vg = (const bf16_t*)(p->ws + Z_VG); const bf16_t* Vw = (const bf16_t*)(p->ws + Z_VW);
    const int nunits = 512 + (l == 0 ? 16 : 0);
    for (int u = bid_(); u < nunits; u += gsz_()) {
        if (u < 256) {
            const int qb = u & 31, h = (u >> 5) & 3, b = u >> 7, row0 = b * NSEQ + qb * 256;
            attn_simple_unit(lds, Qg + (size_t)row0 * 256 + h * 64, Kg + (size_t)b * NKEY * 128 + (h >> 1) * 64, Vg + (size_t)b * NKEY * 128 + (h >> 1) * 64, 0, NKEY / 64, 0, qb * 256, false, 0.f, Y + (size_t)row0 * D + h * 64);
        } else if (u < 512) {
            const int v = u - 256, qb = v & 31, h = (v >> 5) & 3, b = v >> 7, row0 = b * NSEQ + qb * 256;
            attn_simple_unit(lds, Qw + (size_t)row0 * 256 + h * 64, Kw + (size_t)b * NKEY * 128 + (h >> 1) * 64, Vw + (size_t)b * NKEY * 128 + (h >> 1) * 64, 1, 12, 0, qb * 256, true, p->in[14][l * 4 + h] * LOG2E, Y + (size_t)row0 * D + 512 + h * 64);
        } else {
            const int v = u - 512, h = v & 3, b = (v >> 2) & 1, win = v >> 3, row0 = R_LAT + b * NCTX;
            const bf16_t* Qc = (win ? Qwc : Qgc) + (size_t)(b * NCTX) * 256 + h * 64;
            const bf16_t* Kc = (win ? Kw : Kg) + (size_t)b * NKEY * 128 + (h >> 1) * 64; const bf16_t* Vc = (win ? Vw : Vg) + (size_t)b * NKEY * 128 + (h >> 1) * 64;
            attn_simple_unit(lds, Qc, Kc, Vc, 0, 4, NSEQ, 0, win != 0, p->in[14][l * 4 + h] * LOG2E, Y + (size_t)row0 * D + (win ? 512 : 0) + h * 64);
        }
    }
}

namespace attn_body {
using bf16=__hip_bfloat16;
using bf16x8=__attribute__((ext_vector_type(8)))short;
using s16x4=__attribute__((ext_vector_type(4)))short;
using f32x16=__attribute__((ext_vector_type(16)))float;
using u32x4=__attribute__((ext_vector_type(4)))unsigned;
constexpr int D=64, QP=256, KP=128, OP=1024;
constexpr int NW=8,QBLK=32,QB=QBLK*NW,KVBLK=64;
__device__ __forceinline__ int crow(int r,int hi){return (r&3)+8*(r>>2)+4*hi;}
#define SBAR() __builtin_amdgcn_sched_barrier(0)
__device__ __forceinline__ void wmask(f32x16&p0,f32x16&p1,int tb,int qrel,int hi,int q0){
  const float NEG=-INFINITY; const int kb=64*tb+4*hi; const int a0=kb-qrel, k0=q0-128+kb;
  #pragma unroll
  for(int r=0;r<16;++r){const int c=(r&3)+8*(r>>2);
    const bool bad0=((unsigned)(a0+c)>256u)|((unsigned)(k0+c)>=(unsigned)NSEQ);
    const bool bad1=((unsigned)(a0+c+32)>256u)|((unsigned)(k0+c+32)>=(unsigned)NSEQ);
    p0[r]=bad0?NEG:p0[r]; p1[r]=bad1?NEG:p1[r];}
}

constexpr int NSLOT=3, SLOTB=8192;
constexpr int LDS_K=0, LDS_V=NSLOT*SLOTB, LDS_WS=2*NSLOT*SLOTB, LDS_OST=LDS_WS+NW*64*4, LDS_BYTES=LDS_OST+NW*4096;
constexpr float C2=0.125f*1.4426950408889634f;
__device__ __forceinline__ void glds16(const void*gsrc,unsigned lds_dst){unsigned keep;
  asm volatile("s_mov_b32 %0, m0\n\ts_mov_b32 m0, %2\n\ts_nop 0\n\tglobal_load_lds_dwordx4 %1, off\n\ts_mov_b32 m0, %0":"=&s"(keep):"v"(gsrc),"s"(lds_dst):"memory");}
__device__ __forceinline__ float max3f(float a,float b,float c){float r;asm("v_max3_f32 %0, %1, %2, %3":"=v"(r):"v"(a),"v"(b),"v"(c));return r;}
__device__ __forceinline__ float max2f(float a,float b){float r;asm("v_max_f32_e32 %0, %1, %2":"=v"(r):"v"(a),"v"(b));return r;}
__device__ __forceinline__ float fadd_s(float a,float b){float r;asm("v_add_f32_e32 %0, %1, %2":"=v"(r):"v"(a),"v"(b));return r;}
__device__ __forceinline__ float fsub_s(float a,float b){float r;asm("v_sub_f32_e32 %0, %1, %2":"=v"(r):"v"(a),"v"(b));return r;}
typedef float f32x2_t __attribute__((ext_vector_type(2))); typedef __bf16 bf16x2_t __attribute__((ext_vector_type(2)));
__device__ __forceinline__ unsigned cvtpk_s(float lo,float hi){f32x2_t v={lo,hi};bf16x2_t b=__builtin_convertvector(v,bf16x2_t);return __builtin_bit_cast(unsigned,b);}
#define WAIT_BAR(N) asm volatile("s_waitcnt vmcnt(" #N ") lgkmcnt(0)\n\ts_barrier":::"memory")

__device__ __forceinline__ void qkt(f32x16&p0,f32x16&p1,const char*Kslot,const bf16x8*qr,const f32x16&negm,int r32,int hi){
  const char*kb=Kslot+hi*1024+r32*16;
  #pragma unroll
  for(int d0=0;d0<4;++d0){
    const bf16x8 b0=*reinterpret_cast<const bf16x8*>(kb+d0*2048);
    const bf16x8 b1=*reinterpret_cast<const bf16x8*>(kb+d0*2048+512);
    if(d0==0){p0=__builtin_amdgcn_mfma_f32_32x32x16_bf16(b0,qr[0],negm,0,0,0);p1=__builtin_amdgcn_mfma_f32_32x32x16_bf16(b1,qr[0],negm,0,0,0);}
    else{p0=__builtin_amdgcn_mfma_f32_32x32x16_bf16(b0,qr[d0],p0,0,0,0);p1=__builtin_amdgcn_mfma_f32_32x32x16_bf16(b1,qr[d0],p1,0,0,0);}}
}
typedef __attribute__((address_space(3))) const char* lds_cptr;
typedef short v4i16_t __attribute__((ext_vector_type(4)));
__device__ __forceinline__ void kload8(bf16x8*kf,lds_cptr kp){
  kf[0]=*(const __attribute__((address_space(3))) bf16x8*)(kp);      kf[1]=*(const __attribute__((address_space(3))) bf16x8*)(kp+512);
  kf[2]=*(const __attribute__((address_space(3))) bf16x8*)(kp+2048); kf[3]=*(const __attribute__((address_space(3))) bf16x8*)(kp+2560);
  kf[4]=*(const __attribute__((address_space(3))) bf16x8*)(kp+4096); kf[5]=*(const __attribute__((address_space(3))) bf16x8*)(kp+4608);
  kf[6]=*(const __attribute__((address_space(3))) bf16x8*)(kp+6144); kf[7]=*(const __attribute__((address_space(3))) bf16x8*)(kp+6656);
}
__device__ __forceinline__ void kload2(bf16x8*kf,lds_cptr kp,int j){ kf[2*j]=*(const __attribute__((address_space(3))) bf16x8*)(kp+j*2048); kf[2*j+1]=*(const __attribute__((address_space(3))) bf16x8*)(kp+j*2048+512); }
__device__ __forceinline__ s16x4 vtr(lds_cptr p){ return __builtin_bit_cast(s16x4,__builtin_amdgcn_ds_read_tr16_b64_v4i16((__attribute__((address_space(3))) v4i16_t*)p)); }
__device__ __forceinline__ float rowmax(const f32x16&p0,const f32x16&p1){
  float a=max3f(p0[0],p0[1],p1[0]),b=max3f(p0[2],p0[3],p1[1]);a=max3f(a,p1[2],p1[3]);
  #pragma unroll
  for(int r=4;r<16;r+=4){a=max3f(a,p0[r],p0[r+1]);b=max3f(b,p0[r+2],p0[r+3]);a=max3f(a,p1[r],p1[r+1]);b=max3f(b,p1[r+2],p1[r+3]);}
  const float m=max2f(a,b);
  auto rr=__builtin_amdgcn_permlane32_swap(__float_as_uint(m),__float_as_uint(m),false,false);
  return max2f(__uint_as_float(rr[0]),__uint_as_float(rr[1]));
}
__device__ __forceinline__ void pv(f32x16*o,int vb,bf16x8 pa0,bf16x8 pa1,bf16x8 pa2,bf16x8 pa3){
  #pragma unroll
  for(int d0=0;d0<2;++d0){s16x4 lo[4],hi[4];
    #pragma unroll
    for(int ks=0;ks<4;++ks){
      asm volatile("ds_read_b64_tr_b16 %0,%1 offset:%c2":"=&v"(lo[ks]):"v"(vb),"i"(d0*4096+ks*1024):"memory");
      asm volatile("ds_read_b64_tr_b16 %0,%1 offset:%c2":"=&v"(hi[ks]):"v"(vb),"i"(d0*4096+ks*1024+512):"memory");}
    asm volatile("s_waitcnt lgkmcnt(0)":::"memory");SBAR();
    #define PK(k) (bf16x8){lo[k][0],lo[k][1],lo[k][2],lo[k][3],hi[k][0],hi[k][1],hi[k][2],hi[k][3]}
    o[d0]=__builtin_amdgcn_mfma_f32_32x32x16_bf16(pa0,PK(0),o[d0],0,0,0);
    o[d0]=__builtin_amdgcn_mfma_f32_32x32x16_bf16(pa1,PK(1),o[d0],0,0,0);
    o[d0]=__builtin_amdgcn_mfma_f32_32x32x16_bf16(pa2,PK(2),o[d0],0,0,0);
    o[d0]=__builtin_amdgcn_mfma_f32_32x32x16_bf16(pa3,PK(3),o[d0],0,0,0);
    #undef PK
  }
}

#ifndef ATTN_STORE16
#define ATTN_STORE16(p,v) (*(u32x4*)(p)=(v))
#endif
template<int MODE,int NMASKT,int THRL> __device__ __forceinline__ void attn_unit(const bf16*Q0,const bf16*__restrict__ Kh,const bf16*__restrict__ Vh,bf16*O0,int NT,int key_first,int q0,bool use_sink,float sink_l2,char*shm){
  const int tid=tid_(),lane=tid&63,r32=lane&31,hi=lane>>5; const int wid=__builtin_amdgcn_readfirstlane(tid>>6);
  const bf16*Qw=Q0+(long)(wid*QBLK)*QP;
  auto krow=[&](int t)->long{ if(MODE==0) return (long)key_first+64*t; if(t<4) return (long)NSEQ+64*t; int p=q0-128+64*(t-4); p=p<0?0:(p>NSEQ-64?NSEQ-64:p); return (long)p; };
  const unsigned lds0=(unsigned)(uintptr_t)shm;
  float*wsf=(float*)(shm+LDS_WS)+wid*64;
  const bf16*ksrc=Kh+(long)lane*KP+wid*8;
  const bf16*vsrc=Vh+(long)(16*(wid&3)+(lane>>2))*KP+(wid>>2)*32+(lane&3)*8;
  const unsigned kdst=lds0+LDS_K+wid*1024, vdst=lds0+LDS_V+wid*1024;
  #define DMA_K(t,slot) glds16(ksrc+krow(t)*KP,(unsigned)__builtin_amdgcn_readfirstlane(kdst+(slot)))
  #define DMA_V(t,slot) glds16(vsrc+krow(t)*KP,(unsigned)__builtin_amdgcn_readfirstlane(vdst+(slot)))
  const int vb0=(int)(lds0+LDS_V)+((lane>>4)&1)*32+(lane&3)*8+(4*hi+((lane&15)>>2))*64;
  const char*Kbase=shm+LDS_K; bf16x8 kf[8];
  const lds_cptr shm3=(lds_cptr)shm; const lds_cptr kp0=shm3+LDS_K+hi*1024+r32*16; const lds_cptr vp0=shm3+LDS_V+((lane>>4)&1)*32+(lane&3)*8+(4*hi+((lane&15)>>2))*64;
  DMA_K(0,0);DMA_V(0,0);DMA_K(1,SLOTB);
  bf16x8 qr[4];
  #pragma unroll
  for(int d0=0;d0<4;++d0)qr[d0]=*reinterpret_cast<const bf16x8*>(&Qw[(long)r32*QP+d0*16+hi*8]);
  float mhat=0.f,l_reg=0.f;f32x16 o[2];o[0]=f32x16{};o[1]=f32x16{};f32x16 negm=f32x16{};asm volatile("":"+v"(negm));
  const int qrel=wid*QBLK+r32;
  #define CMASK(P0,P1,t) do{ if(NMASKT>0){int jb_=(t)-(NT-NMASKT); if(jb_>=0)wmask(P0,P1,jb_,qrel,hi,q0);} }while(0)
  bool resc=false;
  #define START(P0,P1) do{ const float rm=rowmax(P0,P1); resc=false; \
    { const float dl=rm; mhat=fadd_s(mhat,dl); \
      _Pragma("unroll") for(int r=0;r<16;++r){P0[r]=fsub_s(P0[r],dl);P1[r]=fsub_s(P1[r],dl);} \
      _Pragma("unroll") for(int r=0;r<16;++r)negm[r]=-mhat; asm volatile("":"+v"(negm)); } \
    _Pragma("unroll") for(int r=0;r<16;++r)P0[r]=__builtin_amdgcn_exp2f(P0[r]); }while(0)
  #define RESC() do{ if(resc){ asm volatile("s_waitcnt lgkmcnt(0)":::"memory"); \
      _Pragma("unroll") for(int d_=0;d_<2;++d_) _Pragma("unroll") for(int r=0;r<16;++r)o[d_][r]*=wsf[crow(r,hi)]; } }while(0)
  f32x16 pA0,pA1,pB0,pB1;
  int sl_prev=0,sl_cur=0,sl_next=SLOTB;
  #define ROT() do{sl_prev=sl_cur;sl_cur=sl_next;sl_next=(sl_next==(NSLOT-1)*SLOTB)?0:sl_next+SLOTB;}while(0)
  DMA_K(2,2*SLOTB);
  WAIT_BAR(3);
  qkt(pA0,pA1,Kbase,qr,negm,r32,hi);asm volatile("s_nop 15\n\ts_nop 7":"+v"(pA0),"+v"(pA1));CMASK(pA0,pA1,0);
  START(pA0,pA1);
  _Pragma("unroll") for(int r=0;r<16;++r)pA1[r]=__builtin_amdgcn_exp2f(pA1[r]);
  WAIT_BAR(0);
  DMA_K(3,0);DMA_V(1,SLOTB);
  ROT();
  kload8(kf,kp0+sl_cur);
  WAIT_BAR(2);
  s16x4 vlo[8],vhi[8]; u32x4 pw0,pw1,pw2,pw3;
  #define PKW(P,B) cvtpk_s(P[B],P[B+1])
  #define PAF(k) __builtin_bit_cast(bf16x8,pw##k)
  #define VFR(i) (bf16x8){vlo[i][0],vlo[i][1],vlo[i][2],vlo[i][3],vhi[i][0],vhi[i][1],vhi[i][2],vhi[i][3]}
  #define PIN(x) asm volatile("":"+v"(x))
  #define MX3(a,b,c) __builtin_fmaxf(__builtin_fmaxf((a),(b)),(c))
  #define GAPA(MF,A0,A1,A2,A3,W0,W1,PW) do{ MF; sacc+=A0; sacc+=A1; sacc+=A2; sacc+=A3; PIN(sacc); W0; W1; PIN(PW); SBAR(); }while(0)
  #define EX(v) __builtin_amdgcn_exp2f(v)
  #define GAPB(MF,X,B) do{ MF; X[B]=EX(X[B]); X[B+1]=EX(X[B+1]); X[B+2]=EX(X[B+2]); X[B+3]=EX(X[B+3]); PIN(X); SBAR(); }while(0)
  #define VRD(i) do{ vlo[i]=vtr(vp_+(((i)>>2)*4096+((i)&3)*1024)); vhi[i]=vtr(vp_+(((i)>>2)*4096+((i)&3)*1024+512)); }while(0)
  #define KRD(G,j) do{ if(G){ kload2(kf,kp0+sl_next,j); SBAR(); } }while(0)
  #define STEP(C0,C1,P0,P1,t,GK,GV,GL) do{ SBAR(); \
    const lds_cptr vp_=vp0+sl_prev; \
    VRD(0); SBAR(); float sacc=(P0[0]+P0[1]); \
    GAPA(C0=__builtin_amdgcn_mfma_f32_32x32x16_bf16(kf[0],qr[0],negm,0,0,0), P0[2],P0[3],P0[4],P0[5],     pw0[0]=PKW(P0,0), pw0[1]=PKW(P0,2), pw0); \
    VRD(4); SBAR(); GAPA(C1=__builtin_amdgcn_mfma_f32_32x32x16_bf16(kf[1],qr[0],negm,0,0,0), P0[6],P0[7],P0[8],P0[9],     pw0[2]=PKW(P0,4), pw0[3]=PKW(P0,6), pw0); \
    VRD(1); SBAR(); GAPA(C0=__builtin_amdgcn_mfma_f32_32x32x16_bf16(kf[2],qr[1],C0,0,0,0),   P0[10],P0[11],P0[12],P0[13], pw1[0]=PKW(P0,8), pw1[1]=PKW(P0,10), pw1); \
    VRD(5); SBAR(); GAPA(C1=__builtin_amdgcn_mfma_f32_32x32x16_bf16(kf[3],qr[1],C1,0,0,0),   P0[14],P0[15],P1[0],P1[1],   pw1[2]=PKW(P0,12),pw1[3]=PKW(P0,14), pw1); \
    VRD(2); SBAR(); GAPA(C0=__builtin_amdgcn_mfma_f32_32x32x16_bf16(kf[4],qr[2],C0,0,0,0),   P1[2],P1[3],P1[4],P1[5],     pw2[0]=PKW(P1,0), pw2[1]=PKW(P1,2), pw2); \
    VRD(6); SBAR(); GAPA(C1=__builtin_amdgcn_mfma_f32_32x32x16_bf16(kf[5],qr[2],C1,0,0,0),   P1[6],P1[7],P1[8],P1[9],     pw2[2]=PKW(P1,4), pw2[3]=PKW(P1,6), pw2); \
    VRD(3); SBAR(); GAPA(C0=__builtin_amdgcn_mfma_f32_32x32x16_bf16(kf[6],qr[3],C0,0,0,0),   P1[10],P1[11],P1[12],P1[13], pw3[0]=PKW(P1,8), pw3[1]=PKW(P1,10), pw3); \
    VRD(7); SBAR(); GAPA(C1=__builtin_amdgcn_mfma_f32_32x32x16_bf16(kf[7],qr[3],C1,0,0,0),   P1[14],P1[15],0.f,0.f,       pw3[2]=PKW(P1,12),pw3[3]=PKW(P1,14), pw3); \
    l_reg+=sacc; \
    if(GK){DMA_K((t)+3,sl_cur);} if(GV){DMA_V((t)+1,sl_next);} \
    CMASK(C0,C1,t); \
    { float a=MX3(C0[0],C0[1],C1[0]),b=MX3(C0[2],C0[3],C1[1]); a=MX3(a,C1[2],C1[3]); \
      _Pragma("unroll") for(int r=4;r<16;r+=4){a=MX3(a,C0[r],C0[r+1]);b=MX3(b,C0[r+2],C0[r+3]);a=MX3(a,C1[r],C1[r+1]);b=MX3(b,C1[r+2],C1[r+3]);} \
      float rm=__builtin_fmaxf(a,b); { auto rr=__builtin_amdgcn_permlane32_swap(__float_as_uint(rm),__float_as_uint(rm),false,false); rm=__builtin_fmaxf(__uint_as_float(rr[0]),__uint_as_float(rr[1])); } \
      resc=false; \
      if(__builtin_expect(__any(rm>(float)THRL),0)){ const float dl=__builtin_fmaxf(rm,0.f); mhat+=dl; \
        _Pragma("unroll") for(int r=0;r<16;++r){C0[r]-=dl;C1[r]-=dl;} \
        _Pragma("unroll") for(int r=0;r<16;++r)negm[r]=-mhat; asm volatile("":"+v"(negm)); \
        const float f=__builtin_amdgcn_exp2f(-dl); l_reg*=f; if(hi==0)wsf[r32]=f; resc=true; } } \
    SBAR(); \
    GAPB(o[0]=__builtin_amdgcn_mfma_f32_32x32x16_bf16(PAF(0),VFR(0),o[0],0,0,0), C0,0); \
    GAPB(o[1]=__builtin_amdgcn_mfma_f32_32x32x16_bf16(PAF(0),VFR(4),o[1],0,0,0), C0,4); \
    KRD(GL,0); GAPB(o[0]=__builtin_amdgcn_mfma_f32_32x32x16_bf16(PAF(1),VFR(1),o[0],0,0,0), C0,8); \
    KRD(GL,1); GAPB(o[1]=__builtin_amdgcn_mfma_f32_32x32x16_bf16(PAF(1),VFR(5),o[1],0,0,0), C0,12); \
    KRD(GL,2); GAPB(o[0]=__builtin_amdgcn_mfma_f32_32x32x16_bf16(PAF(2),VFR(2),o[0],0,0,0), C1,0); \
    KRD(GL,3); GAPB(o[1]=__builtin_amdgcn_mfma_f32_32x32x16_bf16(PAF(2),VFR(6),o[1],0,0,0), C1,4); \
    GAPB(o[0]=__builtin_amdgcn_mfma_f32_32x32x16_bf16(PAF(3),VFR(3),o[0],0,0,0), C1,8); \
    GAPB(o[1]=__builtin_amdgcn_mfma_f32_32x32x16_bf16(PAF(3),VFR(7),o[1],0,0,0), C1,12); \
    }while(0)
  int t=1;
  #undef CMASK
  #define CMASK(P0,P1,t) do{}while(0)
  for(;t+1+(NMASKT>4?NMASKT:4)<NT;t+=2){
    STEP(pB0,pB1,pA0,pA1,t,true,true,true);     WAIT_BAR(2); RESC(); ROT();
    STEP(pA0,pA1,pB0,pB1,t+1,true,true,true);   WAIT_BAR(2); RESC(); ROT();
  }
  #undef CMASK
  #define CMASK(P0,P1,t) do{ if(NMASKT>0){int jb_=(t)-(NT-NMASKT); if(jb_>=0)wmask(P0,P1,jb_,qrel,hi,q0);} }while(0)
  #define ENDW(tt) do{ if((tt)+3<NT){WAIT_BAR(2);} else if((tt)+2<NT){WAIT_BAR(1);} else {WAIT_BAR(0);} }while(0)
  for(;t+1<NT;t+=2){
    STEP(pB0,pB1,pA0,pA1,t,(t+3<NT),(t+1<NT),(t+1<NT));       ENDW(t);   RESC(); ROT();
    STEP(pA0,pA1,pB0,pB1,t+1,(t+4<NT),(t+2<NT),(t+2<NT));     ENDW(t+1); RESC(); ROT();
  }
  STEP(pB0,pB1,pA0,pA1,NT-1,false,false,false); RESC();
  { float sacc=pB0[0]+pB0[1]; _Pragma("unroll") for(int r=2;r<16;++r)sacc+=pB0[r]; _Pragma("unroll") for(int r=0;r<16;++r)sacc+=pB1[r]; l_reg+=sacc;
    pw0=(u32x4){PKW(pB0,0),PKW(pB0,2),PKW(pB0,4),PKW(pB0,6)};pw1=(u32x4){PKW(pB0,8),PKW(pB0,10),PKW(pB0,12),PKW(pB0,14)};pw2=(u32x4){PKW(pB1,0),PKW(pB1,2),PKW(pB1,4),PKW(pB1,6)};pw3=(u32x4){PKW(pB1,8),PKW(pB1,10),PKW(pB1,12),PKW(pB1,14)};
    SBAR(); pv(o,vb0+sl_cur,PAF(0),PAF(1),PAF(2),PAF(3)); }
  #undef PKW
  #undef PAF
  #undef VFR
  #undef PIN
  #undef MX3
  #undef GAPA
  #undef GAPB
  #undef EX
  #undef VRD
  #undef KRD
  #undef STEP
  #undef ENDW
  {auto rr=__builtin_amdgcn_permlane32_swap(__float_as_uint(l_reg),__float_as_uint(l_reg),false,false);l_reg=__uint_as_float(rr[0])+__uint_as_float(rr[1]);}
  if(use_sink)l_reg+=__builtin_amdgcn_exp2f(sink_l2-mhat);
  if(hi==0)wsf[32+r32]=l_reg;asm volatile("s_waitcnt lgkmcnt(0)":::"memory");
  float rli[16];
  #pragma unroll
  for(int r=0;r<16;++r)rli[r]=__builtin_amdgcn_rcpf(wsf[32+crow(r,hi)]);
  bf16*Ow=O0+(long)(wid*QBLK)*OP;
  { bf16*stg=(bf16*)(shm+LDS_OST)+wid*2048;
    #pragma unroll
    for(int r=0;r<16;++r){const int orow=crow(r,hi);
      #pragma unroll
      for(int d0=0;d0<2;++d0)stg[orow*64+d0*32+r32]=__float2bfloat16(o[d0][r]*rli[r]);}
    asm volatile("s_waitcnt lgkmcnt(0)":::"memory");
    #pragma unroll
    for(int i=0;i<4;++i){const int row=i*8+(lane>>3),ch=lane&7; const u32x4 v=*(const u32x4*)(stg+row*64+ch*8); ATTN_STORE16(Ow+(long)row*OP+ch*8,v);} }
  asm volatile("s_waitcnt lgkmcnt(0)\n\ts_barrier":::"memory");
  #undef DMA_K
  #undef DMA_V
  #undef CMASK
  #undef START
  #undef RESC
  #undef ROT
}
constexpr int ATTN_LDS_BYTES=LDS_BYTES;
#undef SBAR
#undef WAIT_BAR
}

__device__ __forceinline__ void ph_attn_f(KP p, int l, unsigned char* lds, bool do_scan = true) {
    if (do_scan) { if (FAST_HGRN) hgrn_scan_f(p); else hgrn_scan(p); }
    using attn_body::bf16;
    bf16* Y = (bf16*)(p->ws + Z_YCAT);
    const bf16* Qg = (const bf16*)(p->ws + Z_QG); const bf16* Qw = (const bf16*)(p->ws + Z_QW); const bf16* Qgc = (const bf16*)(p->ws + Z_QGC); const bf16* Qwc = (const bf16*)(p->ws + Z_QWC);
    const bf16* Kg = (const bf16*)(p->ws + Z_KG); const bf16* Kw = (const bf16*)(p->ws + Z_KW); const bf16* Vg = (const bf16*)(p->ws + Z_VG); const bf16* Vw = (const bf16*)(p->ws + Z_VW);
    const int G = gsz_(), bid = bid_();
    __syncthreads();
    for (int vb = bid; vb < 256; vb += G) {
        const int v = (G == 256) ? (((vb & 7) >> 1) * 64 + (vb & 1) * 32 + (vb >> 3)) : vb;
        const int b = v >> 7, kvh = (v >> 6) & 1, h = kvh * 2 + ((v >> 5) & 1), qb = v & 31, row0 = b * NSEQ + qb * 256;
        const size_t kvo = (size_t)b * NKEY * 128 + kvh * 64;
        attn_body::attn_unit<0, 0, 8>(Qg + (size_t)row0 * 256 + h * 64, Kg + kvo, Vg + kvo, Y + (size_t)row0 * D + h * 64, NKEY / 64, 0, 0, false, 0.f, (char*)lds);
        attn_body::attn_unit<1, 8, 8>(Qw + (size_t)row0 * 256 + h * 64, Kw + kvo, Vw + kvo, Y + (size_t)row0 * D + 512 + h * 64, 12, 0, qb * 256, true, p->in[14][l * 4 + h] * LOG2E, (char*)lds);
    }
    if (l == 0) for (int v = bid; v < 16; v += G) {
        const int h = v & 3, b = (v >> 2) & 1, win = v >> 3, row0 = R_LAT + b * NCTX;
        const size_t kvo = (size_t)b * NKEY * 128 + (h >> 1) * 64;
        attn_body::attn_unit<0, 0, 8>((win ? Qwc : Qgc) + (size_t)(b * NCTX) * 256 + h * 64, (win ? Kw : Kg) + kvo, (win ? Vw : Vg) + kvo, Y + (size_t)row0 * D + (win ? 512 : 0) + h * 64, 4, NSEQ, 0, win != 0, p->in[14][l * 4 + h] * LOG2E, (char*)lds);
    }
}

__device__ __forceinline__ void hgrn_pass3_unit(KP p, int l, unsigned char* lds, int unit) {
    float* qs = (float*)lds; float* vs = qs + 4096; float* ks = vs + 4096; float* cs = ks + 4096; float* Ss = cs + 4096; float* sc = Ss + 4096; float* os = sc + 4096;
    const int tid = tid_(), lane = tid & 63, wid = tid >> 6;
    const int cpos = unit % NCHUNK, head = (unit / NCHUNK) & 3, b = unit / (NCHUNK * 4);
    const int row0 = (cpos < 4) ? R_LAT + b * NCTX + cpos * 64 : b * NSEQ + (cpos - 4) * 64;
    for (int i = tid; i < 4096; i += NTHREADS) os[i] = 0.f;
    for (int dir = 0; dir < 2; ++dir) {
        const int j = (cpos < 4) ? (dir ? 3 - cpos : cpos) : 4 + (dir ? 127 - (cpos - 4) : (cpos - 4));
        const int seq = (b * 4 + head) * 2 + dir;
        __syncthreads();
        hgrn_load_chunk(p, l, row0, dir, head, qs, vs, ks, cs);
        const float* Sg = (const float*)(p->ws + Z_U) + ((size_t)seq * NCHUNK + j) * 4096;
        for (int i = tid; i < 4096; i += NTHREADS) Ss[i] = Sg[i];
        for (int i = tid; i < 4096; i += NTHREADS) { const int tau = i >> 6, sig = i & 63; float a = 0.f;
            if (sig <= tau) { for (int d = 0; d < 64; ++d) a += qs[tau * 64 + d] * ks[sig * 64 + d] * __expf(cs[tau * 64 + d] - cs[sig * 64 + d]); }
            sc[i] = a; }
        __syncthreads();
        { const int tau = tid >> 3, e0 = (tid & 7) * 8; float acc[8];
#pragma unroll
          for (int e = 0; e < 8; ++e) acc[e] = 0.f;
          for (int d = 0; d < 64; ++d) { const float qv = qs[tau * 64 + d] * __expf(cs[tau * 64 + d]);
#pragma unroll
              for (int e = 0; e < 8; ++e) acc[e] += qv * Ss[d * 64 + e0 + e]; }
          for (int sig = 0; sig <= tau; ++sig) { const float sv = sc[tau * 64 + sig];
#pragma unroll
              for (int e = 0; e < 8; ++e) acc[e] += sv * vs[sig * 64 + e0 + e]; }
          const int tok = dir ? 63 - tau : tau;
#pragma unroll
          for (int e = 0; e < 8; ++e) os[tok * 64 + e0 + e] += acc[e]; }
        __syncthreads();
    }
    const bf16_t* P = (const bf16_t*)(p->ws + Z_P); bf16_t* Y = (bf16_t*)(p->ws + Z_YCAT);
    for (int tok = wid; tok < 64; tok += 8) { const float v = os[tok * 64 + lane];
        const float y = v * rsqrtf(wave_sum(v * v) * (1.f / 64.f) + EPS) * p->in[22][l * 64 + lane];
        const float g = bf2f(P[(size_t)(row0 + tok) * DIN + C_RG + head * 64 + lane]);
        Y[(size_t)(row0 + tok) * D + 768 + head * 64 + lane] = (bf16_t)f2bf(y * silu_(g)); }
    __syncthreads();
}
__device__ __forceinline__ void ph_hgrn3(KP p, int l, unsigned char* lds) {
    hgrn_pass3_run(p, l, lds);
    if (l == 0 && DEPTH > 1 && gsz_() == 256) { __syncthreads(); ph_cvt(p, 1, lds, 32, 224, CVT_E1, CVT_E2); }
}

__device__ __forceinline__ void ph_outproj(KP p, int l, unsigned char* lds) {
    const bf16_t* A = (const bf16_t*)(p->ws + Z_YCAT); const bf16_t* Bt = (const bf16_t*)(p->ws + Z_WOUT); float* X = (float*)(p->ws + WS_X);
    const int T = (l == 0) ? R_ALL : R_LAT; const int TM = T / 128, TN = 8;
    for (int it = bid_(); it < TM * TN; it += gsz_()) { const int mt = it / TN, nt = it % TN;
        auto epi = [&](int row, int col, float v, float) { const int c = nt * 128 + col; X[(size_t)row * D + c] = xrow_src(p, l, row)[c] + mod_vec(p, l, row, 2)[c] * v; };
        gemm_simple_tile<1>(A, RowId{}, Bt, 1024, mt * 128, nt * 128, 0, epi); }
}

__device__ __forceinline__ void ph_norm2(KP p, int l, unsigned char* lds, int cnt_off = 0) {
    constexpr int RS = 1032, NSTG = 80;
    const int T = (l == 0) ? R_ALL : R_LAT;
    bf16_t* AH = (bf16_t*)lds; bf16_t* AL = AH + 16 * RS;
    float* PART = (float*)(lds + 2 * 16 * RS * 2); float* LOG = PART + 8 * 16 * 64;
    int* hist = (int*)(LOG + 16 * 64); int* hbase = hist + 64; int* s_e = hbase + 64; int* s_r = s_e + NSTG * 8; float* s_w = (float*)(s_r + NSTG * 8); float* msb = s_w + NSTG * 8;
    const int tid = tid_(), lane = tid & 63, wid = tid >> 6, fr = lane & 15, fq = lane >> 4, bid = bid_(), G = gsz_();
    bf16_t* Tok = (bf16_t*)(p->ws + Z_A); const bf16_t* X = (const bf16_t*)(p->ws + WS_X);
    const float* g2 = p->in[7] + l * D; const float* rw = p->in[23] + (size_t)l * 1024 * 64; const float* rbias = p->in[24] + l * 64;
    unsigned* cnt = (unsigned*)(p->ws + WS_CTL) + CW_CNT + cnt_off + l * 64;
    int* tok_e = (int*)(p->ws + WS_TOKE); int* tok_p = (int*)(p->ws + WS_TOKP); int* expl = (int*)(p->ws + WS_EXPL); float* expw = (float*)(p->ws + WS_EXPW);
    bf16x8 bh[4][4], bl[4][4];
    { const u32x4* RF = (const u32x4*)(p->ws + WS_RFRAG) + (size_t)((l * 8 + wid) * 16) * 128 + lane * 2;
#pragma unroll
      for (int t = 0; t < 4; ++t)
#pragma unroll
          for (int k = 0; k < 4; ++k) { bh[t][k] = __builtin_bit_cast(bf16x8, RF[(t * 4 + k) * 128]); bl[t][k] = __builtin_bit_cast(bf16x8, RF[(t * 4 + k) * 128 + 1]); } }
    const float mybias = rbias[lane];
    const int rpb = (T + G - 1) / G;
    for (int base = bid * rpb; base < T; base += G * rpb) {
        const int r1 = (base + rpb < T) ? base + rpb : T;
        if (tid < 64) hist[tid] = 0;
        for (int s0 = base; s0 < r1; s0 += 16) {
#pragma unroll
            for (int j2 = 0; j2 < 2; ++j2) { const int lr = wid * 2 + j2, row = s0 + lr;
                if (row < r1) {
                    const bf16_t* xrow = X + (size_t)row * D; const float* shift = mod_vec(p, l, row, 3); const float* scale = mod_vec(p, l, row, 4);
                    f32x4 v[4]; float ssq = 0.f;
#pragma unroll
                    for (int j = 0; j < 4; ++j) { const u32x2 r2 = ((const u32x2*)xrow)[lane + 64 * j]; v[j].x = bf2f(r2.x & 0xffffu); v[j].y = bf2f(r2.x >> 16); v[j].z = bf2f(r2.y & 0xffffu); v[j].w = bf2f(r2.y >> 16); ssq += v[j].x * v[j].x + v[j].y * v[j].y + v[j].z * v[j].z + v[j].w * v[j].w; }
                    const float rinv = rsqrtf(wave_sum(ssq) * (1.f / D) + EPS);
#pragma unroll
                    for (int j = 0; j < 4; ++j) { const int idx = lane + 64 * j;
                        const f32x4 gg = ((const f32x4*)g2)[idx], sh = ((const f32x4*)shift)[idx], sc = ((const f32x4*)scale)[idx];
                        f32x4 y; y.x = v[j].x * rinv * gg.x * (1.f + sc.x) + sh.x; y.y = v[j].y * rinv * gg.y * (1.f + sc.y) + sh.y;
                        y.z = v[j].z * rinv * gg.z * (1.f + sc.z) + sh.z; y.w = v[j].w * rinv * gg.w * (1.f + sc.w) + sh.w;
                        u32x2 h; h.x = pk2(y.x, y.y); h.y = pk2(y.z, y.w);
                        u32x2 lw; lw.x = pk2(y.x - bf2f(h.x & 0xffffu), y.y - bf2f(h.x >> 16)); lw.y = pk2(y.z - bf2f(h.y & 0xffffu), y.w - bf2f(h.y >> 16));
                        { int t8 = __builtin_amdgcn_cvt_pk_fp8_f32(clamp8(y.x * TOK8_SCALE), clamp8(y.y * TOK8_SCALE), 0, false); t8 = __builtin_amdgcn_cvt_pk_fp8_f32(clamp8(y.z * TOK8_SCALE), clamp8(y.w * TOK8_SCALE), t8, true);
                          ((unsigned*)((unsigned char*)Tok + (size_t)row * D))[idx] = (unsigned)t8; }
                        *(u32x2*)(AH + lr * RS + idx * 4) = h; *(u32x2*)(AL + lr * RS + idx * 4) = lw; }
                } else {
#pragma unroll
                    for (int j = 0; j < 4; ++j) { const int idx = lane + 64 * j; const u32x2 z = {0u, 0u}; *(u32x2*)(AH + lr * RS + idx * 4) = z; *(u32x2*)(AL + lr * RS + idx * 4) = z; } } }
            __syncthreads();
            { f32x4 acc[4];
#pragma unroll
              for (int t = 0; t < 4; ++t) acc[t] = (f32x4){0.f, 0.f, 0.f, 0.f};
#pragma unroll
              for (int k = 0; k < 4; ++k) { const int ko = (wid * 4 + k) * 32 + fq * 8;
                  const bf16x8 ah = *(const bf16x8*)(AH + fr * RS + ko), al = *(const bf16x8*)(AL + fr * RS + ko);
#pragma unroll
                  for (int t = 0; t < 4; ++t) { acc[t] = __builtin_amdgcn_mfma_f32_16x16x32_bf16(ah, bh[t][k], acc[t], 0, 0, 0);
                      acc[t] = __builtin_amdgcn_mfma_f32_16x16x32_bf16(ah, bl[t][k], acc[t], 0, 0, 0); acc[t] = __builtin_amdgcn_mfma_f32_16x16x32_bf16(al, bh[t][k], acc[t], 0, 0, 0); } }
#pragma unroll
              for (int t = 0; t < 4; ++t)
#pragma unroll
                  for (int r = 0; r < 4; ++r) PART[(wid * 16 + fq * 4 + r) * 64 + t * 16 + fr] = acc[t][r]; }
            __syncthreads();
#pragma unroll
            for (int q = 0; q < 2; ++q) { const int o = tid + q * NTHREADS; float a = 0.f;
#pragma unroll
                for (int w8 = 0; w8 < 8; ++w8) a += PART[w8 * 1024 + o];
                LOG[o] = a; }
            __syncthreads();
#pragma unroll 1
            for (int j2 = 0; j2 < 2; ++j2) { const int lr = wid * 2 + j2, row = s0 + lr;
                if (row >= r1) continue;
                const int sr = row - base;
                const float score = sigmoid_(LOG[lr * 64 + lane]), sel = score + mybias;
                const int e = lane, g = e >> 3;
                int rg = 0;
#pragma unroll
                for (int i = 1; i < 8; ++i) { const int src = (lane & ~7) | ((lane + i) & 7); const float o = __shfl(sel, src); rg += (int)(o > sel) | ((int)(o == sel) & (int)(src < e)); }
                float top2 = (rg < 2) ? sel : 0.f;
                top2 += __shfl_xor(top2, 1); top2 += __shfl_xor(top2, 2); top2 += __shfl_xor(top2, 4);
                int grank = 0;
#pragma unroll
                for (int i = 1; i < 8; ++i) { const int og = (g + i) & 7; const float o = __shfl(top2, og * 8); grank += (int)(o > top2) | ((int)(o == top2) & (int)(og < g)); }
                const bool keep = grank < 4;
                const float ms = keep ? sel : -INFINITY;
                float* mrow = msb + wid * 64;
                mrow[lane] = ms;
                __builtin_amdgcn_wave_barrier();
                int rk = 0;
#pragma unroll 4
                for (int i = 0; i < 16; ++i) { const f32x4 o = *(const f32x4*)(mrow + 4 * i);
                    rk += (int)(o.x > ms) | ((int)(o.x == ms) & (int)(4 * i + 0 < e)); rk += (int)(o.y > ms) | ((int)(o.y == ms) & (int)(4 * i + 1 < e));
                    rk += (int)(o.z > ms) | ((int)(o.z == ms) & (int)(4 * i + 2 < e)); rk += (int)(o.w > ms) | ((int)(o.w == ms) & (int)(4 * i + 3 < e)); }
                __builtin_amdgcn_wave_barrier();
                const bool chosen = keep && rk < 8;
                const float wsum = wave_sum(chosen ? score : 0.f);
                if (chosen) { const int r = atomicAdd(&hist[e], 1); s_e[sr * 8 + rk] = e; s_r[sr * 8 + rk] = r; s_w[sr * 8 + rk] = score / wsum * 2.5f; } }
        }
        __syncthreads();
        if (tid < 64) { const int h = hist[tid]; hbase[tid] = h ? (int)atomicAdd(&cnt[tid], (unsigned)h) : 0; }
        __syncthreads();
        for (int i = tid; i < (r1 - base) * 8; i += NTHREADS) { const int e = s_e[i]; const size_t o = (size_t)base * 8 + i;
            const int pos = hbase[e] + s_r[i]; tok_e[o] = e; tok_p[o] = pos; expl[(size_t)e * R_ALL + pos] = base + (i >> 3); expw[(size_t)e * R_ALL + pos] = s_w[i]; }
        __syncthreads();
    }
}

__device__ __forceinline__ void moe_pad_starts(KP p, int l, int* ps) {
    const unsigned* cnt = (const unsigned*)(p->ws + WS_CTL) + CW_CNT + l * 64;
    const int tid = tid_();
    if (tid < 64) { const int v = (int)((cnt[tid] + 255u) >> 8) << 8; int incl = v;
#pragma unroll
        for (int d = 1; d < 64; d <<= 1) { const int o = __shfl_up(incl, d); if (tid >= d) incl += o; }
        ps[tid] = incl - v; if (tid == 63) ps[64] = incl; }
    __syncthreads();
}
__device__ __forceinline__ int moe_expert_of_row(const int* ps, int row) { int e = 0;
#pragma unroll
    for (int step = 32; step >= 1; step >>= 1) if (row >= ps[e + step]) e += step;
    return e; }

__device__ __forceinline__ void ph_slots(KP p, int l, unsigned char* lds) {
    const int T = (l == 0) ? R_ALL : R_LAT;
    int* ps = (int*)lds; moe_pad_starts(p, l, ps);
    const unsigned* cnt = (const unsigned*)(p->ws + WS_CTL) + CW_CNT + l * 64;
    const int* tok_e = (const int*)(p->ws + WS_TOKE); const int* tok_p = (const int*)(p->ws + WS_TOKP); const float* tok_w = (const float*)(p->ws + WS_TOKW);
    int* tok_s = (int*)(p->ws + WS_TOKS); int* slot_t = (int*)(p->ws + WS_SLOTT); float* slot_w = (float*)(p->ws + WS_SLOTW);
    for (int i = bid_() * NTHREADS + tid_(); i < T * 8; i += gsz_() * NTHREADS) { const int e = tok_e[i], slot = ps[e] + tok_p[i]; tok_s[i] = slot; slot_t[slot] = i >> 3; slot_w[slot] = tok_w[i]; }
    for (int i = bid_() * NTHREADS + tid_(); i < T; i += gsz_() * NTHREADS) { slot_t[MAXSLOT + i] = i; slot_w[MAXSLOT + i] = 1.f; }
    for (int i = bid_() * NTHREADS + tid_(); i < 64 * 256; i += gsz_() * NTHREADS) { const int e = i >> 8, j = i & 255; const int r = ps[e] + (int)cnt[e] + j; if (r < ps[e + 1]) { slot_t[r] = 0; slot_w[r] = 0.f; } }
    __syncthreads();
}

__device__ __forceinline__ void ph_gateup(KP p, int l, unsigned char* lds) {
    const int T = (l == 0) ? R_ALL : R_LAT;
    int* ps = (int*)lds; moe_pad_starts(p, l, ps);
    const bf16_t* Tok = (const bf16_t*)(p->ws + Z_A); const bf16_t* Wgu = (const bf16_t*)(p->ws + Z_WGU); bf16_t* H = (bf16_t*)(p->ws + Z_H);
    const int* slot_t = (const int*)(p->ws + WS_SLOTT); const float* slot_w = (const float*)(p->ws + WS_SLOTW);
    const int n128 = ps[64] / 128, nitems = (n128 + T / 128) * 2;
    for (int it = bid_(); it < nitems; it += gsz_()) { const int rt = it >> 1, pn = it & 1;
        if (rt < n128) { const int e = moe_expert_of_row(ps, rt * 128);
            auto epi = [&](int row, int col, float g, float u) { H[(size_t)row * 256 + pn * 128 + col] = (bf16_t)f2bf(silu_(g) * u * slot_w[row]); };
            gemm_simple_tile<2>(Tok, RowGather{slot_t}, Wgu + (size_t)e * 524288, 1024, rt * 128, pn * 256, 128, epi);
        } else { const int t0 = (rt - n128) * 128;
            auto epi = [&](int row, int col, float g, float u) { H[(size_t)(MAXSLOT + row) * 256 + pn * 128 + col] = (bf16_t)f2bf(silu_(g) * u); };
            gemm_simple_tile<2>(Tok, RowId{}, Wgu + (size_t)64 * 524288, 1024, t0, pn * 256, 128, epi); }
    }
}
__device__ __forceinline__ void ph_down(KP p, int l, unsigned char* lds) {
    const int T = (l == 0) ? R_ALL : R_LAT;
    int* ps = (int*)lds; moe_pad_starts(p, l, ps);
    const bf16_t* H = (const bf16_t*)(p->ws + Z_H); const bf16_t* Wd = (const bf16_t*)(p->ws + WS_WD); bf16_t* Y = (bf16_t*)(p->ws + Z_Y); float* X = (float*)(p->ws + WS_X);
    const int n128 = ps[64] / 128, nitems = (n128 + T / 128) * 8;
    for (int it = bid_(); it < nitems; it += gsz_()) { const int rt = it >> 3, nt = it & 7;
        if (rt < n128) { const int e = moe_expert_of_row(ps, rt * 128);
            auto epi = [&](int row, int col, float v, float) { Y[(size_t)row * D + nt * 128 + col] = (bf16_t)f2bf(v); };
            gemm_simple_tile<1>(H, RowId{}, Wd + (size_t)e * 262144, 256, rt * 128, nt * 128, 0, epi);
        } else { const int t0 = (rt - n128) * 128;
            auto epi = [&](int row, int col, float v, float) { const int t = row - MAXSLOT, c = nt * 128 + col; X[(size_t)t * D + c] += mod_vec(p, l, t, 5)[c] * v; };
            gemm_simple_tile<1>(H, RowId{}, Wd + (size_t)64 * 262144, 256, MAXSLOT + t0, nt * 128, 0, epi); }
    }
}
__device__ __forceinline__ void ph_combine(KP p, int l, unsigned char* lds) {
    typedef float f32x2 __attribute__((ext_vector_type(2)));
    const int T = (l == 0) ? R_ALL : R_LAT;
    const int tid = tid_(), lane = tid & 63, wid = tid >> 6;
    const unsigned char* Y8 = (const unsigned char*)(p->ws + Z_Y); bf16_t* X = (bf16_t*)(p->ws + WS_X); const int* tok_e = (const int*)(p->ws + WS_TOKE); const int* tok_p = (const int*)(p->ws + WS_TOKP);
    int* ps = (int*)lds; moe_pad_starts(p, l, ps);
    const size_t yoff = (size_t)(lane >> 4) * MAXSLOT * 256 + (lane & 15) * 16;
    for (int row = bid_() * 8 + wid; row < T; row += gsz_() * 8) {
        const float* g5 = mod_vec(p, l, row, 5) + lane * 16;
        bf16_t* xr = X + (size_t)row * D + lane * 16;
        const int myslot = ps[tok_e[row * 8 + (lane & 7)]] + tok_p[row * 8 + (lane & 7)];
        u32x4 yv[8];
#pragma unroll
        for (int k = 0; k < 8; ++k) { const int sl = __shfl(myslot, k); yv[k] = *(const u32x4*)(Y8 + yoff + (size_t)sl * 256); }
        f32x4 xv[4], gv[4];
#pragma unroll
        for (int q = 0; q < 4; ++q) gv[q] = *(const f32x4*)(g5 + 4 * q);
        unpack8(*(const u32x4*)xr, xv[0], xv[1]); unpack8(*(const u32x4*)(xr + 8), xv[2], xv[3]);
        float a[16];
#pragma unroll
        for (int q = 0; q < 16; ++q) a[q] = 0.f;
#pragma unroll
        for (int k = 0; k < 8; ++k) { const unsigned w[4] = {yv[k].x, yv[k].y, yv[k].z, yv[k].w};
#pragma unroll
            for (int q = 0; q < 4; ++q) { const f32x2 lo = __builtin_amdgcn_cvt_pk_f32_fp8((int)w[q], false), hi = __builtin_amdgcn_cvt_pk_f32_fp8((int)w[q], true);
                a[4 * q] += lo.x; a[4 * q + 1] += lo.y; a[4 * q + 2] += hi.x; a[4 * q + 3] += hi.y; } }
#pragma unroll
        for (int q = 0; q < 4; ++q) { f32x4 av; av.x = a[4 * q]; av.y = a[4 * q + 1]; av.z = a[4 * q + 2]; av.w = a[4 * q + 3]; xv[q] = xv[q] + gv[q] * (av * (1.f / Y8_SCALE)); }
        if (l == DEPTH - 1) { float* dst = p->out + (size_t)row * D + lane * 16;
#pragma unroll
            for (int q = 0; q < 4; ++q) *(f32x4*)(dst + 4 * q) = xv[q]; }
        else { *(u32x4*)xr = (u32x4){pk2(xv[0].x, xv[0].y), pk2(xv[0].z, xv[0].w), pk2(xv[1].x, xv[1].y), pk2(xv[1].z, xv[1].w)};
               *(u32x4*)(xr + 8) = (u32x4){pk2(xv[2].x, xv[2].y), pk2(xv[2].z, xv[2].w), pk2(xv[3].x, xv[3].y), pk2(xv[3].z, xv[3].w)}; }
    }
}
struct MoeSched {
    int ntr, nrt, npn, G, c; const LAS int* tile_e;
    __device__ __forceinline__ bool map(int i, int& rt, int& pp) const {
        if (G == 256) { const int x = c & 7, j = c >> 3, tb = 32 / npn; rt = (i * 8 + x) * tb + j / npn; pp = j % npn; return rt < nrt; }
        const int L = i * G + c; if (L >= nrt * npn) return false;
        rt = L / npn; pp = L % npn; return true; }
    __device__ __forceinline__ bool next(int i, pg8::Unit& u) const {
        int rt, pp; if (!map(i, rt, pp)) return false;
        const bool routed = rt < ntr;
        const int e = routed ? __builtin_amdgcn_readfirstlane(tile_e[rt]) : 64;
        u.pm = routed ? rt : MAXSLOT / 256 + (rt - ntr); u.pn = e * npn + pp; u.ord = i; return true;
    }
};
constexpr int MOE_UNITS = 6;
constexpr int LDS_RTAB = 131072, LDS_WTAB = LDS_RTAB + MOE_UNITS * 1024, LDS_TILE_E = LDS_WTAB + MOE_UNITS * 1024, LDS_PS = LDS_TILE_E + 2400;
static_assert(LDS_PS + 129 * 4 <= LDS_BYTES - 16, "MoE tables fit above the staging buffers");
__device__ __forceinline__ MoeSched moe_setup(KP p, int l, unsigned char* lds, int npn, bool gather) {
    const int T = (l == 0) ? R_ALL : R_LAT;
    int* ps = (int*)(lds + LDS_PS); int* cl = ps + 65;
    const unsigned* cnt = (const unsigned*)(p->ws + WS_CTL) + CW_CNT + l * 64;
    const int tid = tid_();
    if (tid < 64) cl[tid] = (int)cnt[tid];
    moe_pad_starts(p, l, ps);
    LAS int* tile_e = (LAS int*)((LAS unsigned char*)lds + LDS_TILE_E); LAS int* rtab = (LAS int*)((LAS unsigned char*)lds + LDS_RTAB); LAS float* wtab = (LAS float*)((LAS unsigned char*)lds + LDS_WTAB);
    const int ntr = ps[64] / 256;
    for (int rt = tid; rt < ntr; rt += NTHREADS) tile_e[rt] = moe_expert_of_row(ps, rt * 256);
    __syncthreads();
    MoeSched S{ntr, ntr + T / 256, npn, gsz_(), bid_(), tile_e};
    if (gather) { const int* expl = (const int*)(p->ws + WS_EXPL); const float* expw = (const float*)(p->ws + WS_EXPW);
        int tok[3]; float w[3];
#pragma unroll
        for (int q = 0; q < 3; ++q) { const int idx = tid + q * NTHREADS, i = idx >> 8, r = idx & 255; tok[q] = 0; w[q] = 0.f;
            int rt, pp_;
            if (S.map(i, rt, pp_)) {
                if (rt < S.ntr) { const int e = tile_e[rt], pos = rt * 256 + r - ps[e];
                    if (pos < cl[e]) { tok[q] = expl[(size_t)e * R_ALL + pos]; w[q] = expw[(size_t)e * R_ALL + pos]; } }
                else { tok[q] = (rt - S.ntr) * 256 + r; w[q] = 1.f; } } }
#pragma unroll
        for (int q = 0; q < 3; ++q) { const int idx = tid + q * NTHREADS; rtab[idx] = tok[q]; wtab[idx] = w[q]; } }
    __syncthreads();
    return S;
}
__device__ __forceinline__ void ph_gateup_f(KP p, int l, unsigned char* lds) {
    const MoeSched S = moe_setup(p, l, lds, 2, true);
    pg8::Gemm g{(const bf16_t*)(p->ws + Z_A), (const bf16_t*)(p->ws + wgu_off(l)), 0, 0, 1024};
    pg8::EpiGU8 E{(unsigned char*)(p->ws + Z_H), (const LAS float*)((LAS unsigned char*)lds + LDS_WTAB)};
    pg8::gemm_phase<pg8::EpiGU8, MoeSched, true, true>((LAS unsigned char*)lds, g, S, E, (const LAS int*)((LAS unsigned char*)lds + LDS_RTAB));
}
__device__ __forceinline__ void ph_down_f(KP p, int l, unsigned char* lds) {
    const MoeSched S = moe_setup(p, l, lds, 4, false);
    pg8::Gemm g{(const bf16_t*)(p->ws + Z_H), (const bf16_t*)(p->ws + wd_off(l)), 0, 0, 256};
    bf16_t* X = (bf16_t*)(p->ws + WS_X);
    pg8::EpiDown E{(bf16_t*)(p->ws + Z_Y), X, (const float*)(p->ws + WS_MOD) + (size_t)l * 3 * 6144 + 5 * 1024};
    pg8::gemm_phase<pg8::EpiDown, MoeSched, false, true>((LAS unsigned char*)lds, g, S, E, nullptr);
}

#ifndef FAST_ATTN
#define FAST_ATTN 1
#endif
#ifndef FAST_GEMM
#define FAST_GEMM 15
#endif
constexpr int PH_PER_LAYER = 10, N_PHASES = 1 + DEPTH * PH_PER_LAYER;
__global__ void __launch_bounds__(NTHREADS, 2) mega(Params parg) {
    extern __shared__ __attribute__((aligned(16))) unsigned char lds[];
    const int lo = parg.ph_lo, hi = parg.ph_hi;
    volatile LAS unsigned* xbw = (volatile LAS unsigned*)(lds + LDS_BYTES - 16);
    if (threadIdx.x == 0) { xbw[0] = 0u; xbw[1] = 0u; xbw[2] = 0u; xbw[3] = 0u; }
    if ((threadIdx.x & 63) == 0) *(volatile LAS int*)((LAS unsigned char*)lds + LDS_WVTAB_OFF + 4 * hwkey_()) = (int)(threadIdx.x >> 6);
    __syncthreads();
    XcdBarrier bar; bar.bar = (unsigned*)(parg.ws + WS_CTL) + CW_BAR; bar.x = 0; bar.st = xbw;
    if (hi - lo > 1) bar = xcd_barrier_post((unsigned*)(parg.ws + WS_CTL) + CW_BAR, xbw);
#ifdef PHMASK
#define IN(k) ((((PHMASK) >> ((k) == 0 ? 0 : ((k) - 1) % PH_PER_LAYER + 1)) & 1) && lo <= (k) && (k) < hi)
#else
#define IN(k) (lo <= (k) && (k) < hi)
#endif
#define SEAM(k) do { if (IN(k) && IN((k) + 1)) xcd_barrier(bar); } while (0)
    if (IN(0)) { ph_pro(kparams(), lds); } SEAM(0);
#pragma unroll
    for (int l = 0; l < DEPTH; ++l) {
        const int b0 = 1 + l * PH_PER_LAYER;
        if (IN(b0 + 0)) { ph_norm1(kparams(), l, lds); } SEAM(b0 + 0);
        if (IN(b0 + 1)) { ph_inproj_f(kparams(), l, lds); } SEAM(b0 + 1);
        if (IN(b0 + 2)) { ph_prep(kparams(), l, lds); } SEAM(b0 + 2);
        if (IN(b0 + 3)) { ph_attn_f(kparams(), l, lds); } SEAM(b0 + 3);
        if (IN(b0 + 4)) { ph_hgrn3(kparams(), l, lds); } SEAM(b0 + 4);
        if (IN(b0 + 5)) { ph_outproj_f(kparams(), l, lds); } SEAM(b0 + 5);
        if (IN(b0 + 6)) { ph_norm2(kparams(), l, lds); } SEAM(b0 + 6);
        if (IN(b0 + 7)) { ph_gateup_f(kparams(), l, lds); } SEAM(b0 + 7);
        if (IN(b0 + 8)) { ph_down_f(kparams(), l, lds); } SEAM(b0 + 8);
        if (IN(b0 + 9)) { ph_combine(kparams(), l, lds); } SEAM(b0 + 9);
    }
#undef IN
#undef SEAM
}

#ifndef MK_ONE_LAUNCH
#define MK_ONE_LAUNCH 1
#endif
extern "C" void kernel_launch(void* const* d_in, const int* in_sizes, int n_in, void* d_out, int out_size, void* d_ws, size_t ws_size, hipStream_t stream) {
    static int grid = 0;
    if (grid == 0) {
        if (n_in != 31 || ws_size < WS_END2) { fprintf(stderr, "kernel_launch: unexpected n_in %d or ws_size %zu (< %zu)\n", n_in, ws_size, (size_t)WS_END2); grid = -1; return; }
        int dev = 0, cus = 0, per_cu = 0;
        if (hipGetDevice(&dev) != hipSuccess || hipDeviceGetAttribute(&cus, hipDeviceAttributeMultiprocessorCount, dev) != hipSuccess) { grid = -1; return; }
        if (hipFuncSetAttribute((const void*)mega, hipFuncAttributeMaxDynamicSharedMemorySize, LDS_BYTES) != hipSuccess) { fprintf(stderr, "kernel_launch: hipFuncSetAttribute failed\n"); grid = -1; return; }
        if (hipOccupancyMaxActiveBlocksPerMultiprocessor(&per_cu, (const void*)mega, NTHREADS, LDS_BYTES) != hipSuccess || per_cu < 1) fprintf(stderr, "kernel_launch: occupancy query says %d\n", per_cu);
        (void)hipGetLastError();
        grid = cus;
    }
    if (grid < 0) return;
    (void)hipMemsetAsync((char*)d_ws + WS_CTL, 0, CTL_ZERO_BYTES, stream);
    Params p{};
    for (int i = 0; i < 31; ++i) p.in[i] = (const float*)d_in[i];
    p.out = (float*)d_out; p.ws = (unsigned char*)d_ws;
#if MK_ONE_LAUNCH
    p.ph_lo = 0; p.ph_hi = N_PHASES;
    hipLaunchKernelGGL(mega, dim3(grid), dim3(NTHREADS), LDS_BYTES, stream, p);
#else
    for (int k = 0; k < N_PHASES; ++k) { p.ph_lo = k; p.ph_hi = k + 1; hipLaunchKernelGGL(mega, dim3(grid), dim3(NTHREADS), LDS_BYTES, stream, p); }
#endif
}
```

```cpp
#include <hip/hip_runtime.h>
#include <hip/hip_bf16.h>
#include <cmath>
#include <cstdint>
#include <cstdio>

#define LAS __attribute__((address_space(3)))

typedef unsigned short bf16_t;
typedef short bf16x8 __attribute__((ext_vector_type(8)));
typedef float f32x4 __attribute__((ext_vector_type(4)));
typedef unsigned u32x4 __attribute__((ext_vector_type(4)));
typedef unsigned u32x2 __attribute__((ext_vector_type(2)));

constexpr int D = 1024, NB = 2, NSEQ = 8192, NCTX = 256, DEPTH = 2;
constexpr int R_LAT = NB * NSEQ, R_CTX = NB * NCTX, R_ALL = R_LAT + R_CTX;
constexpr int DIN = 2816;
constexpr int NKEY = NSEQ + NCTX;
constexpr int NE = 64, TOPK = 8;
constexpr int MAXSLOT = 151552;
constexpr int HROWS = MAXSLOT + R_ALL;
constexpr int NCHUNK = 132;
constexpr float EPS = 1e-6f;
constexpr float TOK8_SCALE = 8.f, WGU8_SCALE = 256.f, H8_SCALE = 16.f, WD8_SCALE = 128.f;
constexpr float GU_DESCALE = 1.f / (TOK8_SCALE * WGU8_SCALE), DN_DESCALE = 1.f / (H8_SCALE * WD8_SCALE);
constexpr float Y8_SCALE = 32.f;
constexpr float QSCALE = 0.125f * 1.4426950408889634f;
constexpr float LOG2E = 1.4426950408889634f;

#ifndef FAST_HGRN
#define FAST_HGRN 1
#endif
constexpr int C_GQ = 0, C_GK = 256, C_GV = 384, C_WQ = 512, C_WK = 768, C_WV = 896, C_CVV = 1024, C_CVG = 1280, C_RQ = 1536, C_RI = 1792, C_RFF = 2048, C_RFB = 2304, C_RG = 2560;

constexpr size_t MiB = (size_t)1 << 20;
constexpr size_t WS_CTL = 0, CTL_ZERO_BYTES = 64 * 1024;
constexpr size_t WS_MOD = 1 * MiB;
constexpr size_t WS_LB = WS_MOD + 256 * 1024;
constexpr size_t WS_ROPE = WS_MOD + 512 * 1024;
constexpr size_t WS_TOKE = 2 * MiB, WS_TOKP = 3 * MiB, WS_TOKW = 4 * MiB, WS_TOKS = 5 * MiB;
constexpr size_t WS_SLOTT = 6 * MiB, WS_SLOTW = 7 * MiB;
constexpr size_t WS_RFRAG = 4 * MiB;
constexpr size_t WS_X = 8 * MiB;
constexpr size_t WS_WD = 74 * MiB;
constexpr size_t WS_Z = 107 * MiB;
constexpr size_t Z_A = WS_Z + 0 * MiB;
constexpr size_t Z_WGU = WS_Z + 33 * MiB;
constexpr size_t Z_WIN = WS_Z + 98 * MiB;
constexpr size_t Z_WOUT = WS_Z + 104 * MiB;
constexpr size_t Z_WPW = WS_Z + 106 * MiB;
__host__ __device__ constexpr size_t wgu_off(int l) { return WS_Z + 33 * MiB + (size_t)l * 34078720; }
__host__ __device__ constexpr size_t wd_off(int l) { return 74 * MiB + (size_t)l * 17039360; }
__host__ __device__ constexpr size_t win_off(int l) { return l == 0 ? WS_Z + 98 * MiB : WS_Z + (302 + 42) * MiB; }
__host__ __device__ constexpr size_t wout_off(int l) { return l == 0 ? WS_Z + 104 * MiB : WS_Z + (302 + 48) * MiB; }
__host__ __device__ constexpr size_t wpw_off(int l) { return l == 0 ? WS_Z + 106 * MiB : WS_Z + (302 + 51) * MiB; }
constexpr size_t Z_P = WS_Z + 107 * MiB;
constexpr size_t Z_YCAT = WS_Z + 198 * MiB;
constexpr size_t Z_QG = WS_Z + 231 * MiB, Z_QW = WS_Z + 239 * MiB;
constexpr size_t Z_KG = WS_Z + 247 * MiB, Z_VG = WS_Z + 252 * MiB, Z_KW = WS_Z + 257 * MiB, Z_VW = WS_Z + 262 * MiB;
constexpr size_t Z_QGC = WS_Z + 267 * MiB, Z_QWC = Z_QGC + 512 * 1024;
constexpr size_t Z_U = WS_Z + 268 * MiB;
constexpr size_t Z_G = WS_Z + 301 * MiB;
constexpr size_t Z_Y = WS_Z + 107 * MiB;
constexpr size_t Z_H = WS_Z + 302 * MiB;
constexpr size_t WS_END = WS_Z + 385 * MiB;
constexpr size_t WS_EXPL = WS_END, WS_EXPW = WS_END + 5 * MiB, WS_END2 = WS_END + 10 * MiB;
static_assert(Z_H + (size_t)HROWS * 512 <= WS_END, "H fits");
static_assert(Z_Y + (size_t)MAXSLOT * 1024 <= Z_U, "Y8 below the HGRN state buffers");
static_assert(Z_P + (size_t)R_ALL * DIN * 2 <= Z_YCAT, "P fits");

constexpr int CW_BAR = 0;
constexpr int CW_CNT = 4096;

constexpr int LDS_BYTES = 147456;
constexpr int NTHREADS = 512;

struct Params {
    const float* in[31];
    float* out;
    unsigned char* ws;
    int ph_lo, ph_hi;
};

typedef const __attribute__((address_space(4))) Params* KP;
__device__ __forceinline__ KP kparams() { KP k = (KP)__builtin_amdgcn_kernarg_segment_ptr(); asm volatile("" : "+s"(k)); return k; }

constexpr int LDS_WVTAB_OFF = 147456 - 16 - 256;
__device__ __forceinline__ int hwkey_() { return (int)__builtin_amdgcn_s_getreg((5 << 11) | 4) & 63; }
__device__ __forceinline__ int tid_() { extern __shared__ __attribute__((aligned(16))) unsigned char lds_all[];
    const int w = __builtin_amdgcn_readfirstlane(*(const LAS int*)((LAS unsigned char*)lds_all + LDS_WVTAB_OFF + 4 * hwkey_()));
    unsigned z; asm volatile("v_mov_b32 %0, 0" : "=v"(z));
    int t = (w << 6) | (int)__builtin_amdgcn_mbcnt_hi(~0u, __builtin_amdgcn_mbcnt_lo(~0u, z)); asm volatile("" : "+v"(t)); return t; }
__device__ __forceinline__ int bid_() { int b = blockIdx.x; asm volatile("" : "+s"(b)); return b; }
__device__ __forceinline__ int gsz_() { int g = gridDim.x; asm volatile("" : "+s"(g)); return g; }

__device__ __forceinline__ unsigned f2bf(float f) { unsigned u = __float_as_uint(f); return (u + 0x7fffu + ((u >> 16) & 1u)) >> 16; }
__device__ __forceinline__ float bf2f(unsigned h) { return __uint_as_float(h << 16); }
__device__ __forceinline__ unsigned pk2(float lo, float hi) { unsigned r; asm("v_cvt_pk_bf16_f32 %0, %1, %2" : "=v"(r) : "v"(lo), "v"(hi)); return r; }
__device__ __forceinline__ u32x4 pack8(const float (&x)[8]) { u32x4 o; o.x = pk2(x[0], x[1]); o.y = pk2(x[2], x[3]); o.z = pk2(x[4], x[5]); o.w = pk2(x[6], x[7]); return o; }
__device__ __forceinline__ void unpack8(const u32x4 r, f32x4& lo, f32x4& hi) { lo.x = bf2f(r.x & 0xffffu); lo.y = bf2f(r.x >> 16); lo.z = bf2f(r.y & 0xffffu); lo.w = bf2f(r.y >> 16); hi.x = bf2f(r.z & 0xffffu); hi.y = bf2f(r.z >> 16); hi.z = bf2f(r.w & 0xffffu); hi.w = bf2f(r.w >> 16); }
template <int CTRL> __device__ __forceinline__ float dpp_mov(float v) { return __builtin_bit_cast(float, __builtin_amdgcn_update_dpp(0, __builtin_bit_cast(int, v), CTRL, 0xF, 0xF, true)); }
__device__ __forceinline__ float wave_sum(float v) {
    v += dpp_mov<0xB1>(v); v += dpp_mov<0x4E>(v); v += dpp_mov<0x141>(v); v += dpp_mov<0x140>(v);
    { const auto rr = __builtin_amdgcn_permlane16_swap(__float_as_uint(v), __float_as_uint(v), false, false); v = __uint_as_float(rr[0]) + __uint_as_float(rr[1]); }
    { const auto rr = __builtin_amdgcn_permlane32_swap(__float_as_uint(v), __float_as_uint(v), false, false); v = __uint_as_float(rr[0]) + __uint_as_float(rr[1]); }
    return v;
}
__device__ __forceinline__ float clamp8(float v) { return fminf(fmaxf(v, -440.f), 440.f); }
__device__ __forceinline__ float sigmoid_(float x) { return __builtin_amdgcn_rcpf(1.f + __expf(-x)); }
__device__ __forceinline__ float silu_(float x) { return x * sigmoid_(x); }

__device__ __forceinline__ const float* xrow_src(KP p, int l, int row) {
    if (l == 0) return (row < R_LAT) ? p->in[0] + (size_t)row * D : p->in[2] + (size_t)(row - R_LAT) * D;
    return (const float*)(p->ws + WS_X) + (size_t)row * D;
}
__device__ __forceinline__ const float* mod_vec(KP p, int l, int row, int i) {
    const int r = (row < R_LAT) ? (row >> 13) : 2;
    return (const float*)(p->ws + WS_MOD) + ((size_t)l * 3 + r) * 6144 + i * 1024;
}

#define XB_TMO      128
#define XB_XCNT(j)  (256  + 64 * (j))
#define XB_XSUB(j)  (1280 + 64 * (j))
#define XB_XGEN(j)  (2304 + 64 * (j))
#define XB_TOP      3328
#define XB_TOPGEN   3392
#define XCD_BAR_WORDS 3456
#define XB_SPIN_CAP (1u << 18)
__device__ __forceinline__ unsigned xb_ld(unsigned* p)              { return __hip_atomic_load(p, __ATOMIC_RELAXED, __HIP_MEMORY_SCOPE_AGENT); }
__device__ __forceinline__ unsigned xb_add(unsigned* p, unsigned v) { return __hip_atomic_fetch_add(p, v, __ATOMIC_RELAXED, __HIP_MEMORY_SCOPE_AGENT); }
__device__ __forceinline__ unsigned xb_xcc_id() { return (unsigned)__builtin_amdgcn_s_getreg((3 << 11) | 20) & 0xFu; }
#define XB_SPIN(cond, bar) do { unsigned _sp = 0; while (cond) { __builtin_amdgcn_s_sleep(1); \
    if ((++_sp & 255u) == 0u) { if (xb_ld(&(bar)[XB_TMO])) break; if (_sp > XB_SPIN_CAP) { atomicAdd(&(bar)[XB_TMO], 1u); break; } } } } while (0)
struct XcdBarrier { unsigned* bar; unsigned x; volatile LAS unsigned* st; };
__device__ __forceinline__ XcdBarrier xcd_barrier_post(unsigned* bar, volatile LAS unsigned* st) {
    XcdBarrier b; b.bar = bar; b.x = xb_xcc_id(); b.st = st;
    if (tid_() == 0) (void)xb_add(&bar[XB_XCNT(b.x)], 1u);
    return b;
}
__device__ __forceinline__ void xcd_barrier_complete(unsigned* bar, unsigned x, unsigned& nloc, unsigned& nx) {
    const unsigned G = gridDim.x * gridDim.y * gridDim.z;
    unsigned sum, cnt, mine, sp = 0u;
    for (;;) {
        sum = 0u; cnt = 0u; mine = 0u;
#pragma unroll
        for (unsigned j = 0; j < 16; ++j) { const unsigned c = xb_ld(&bar[XB_XCNT(j)]); sum += c; cnt += (c > 0u) ? 1u : 0u; mine = (j == x) ? c : mine; }
        if (sum == G) break;
        __builtin_amdgcn_s_sleep(1);
        if ((++sp & 255u) == 0u) { if (xb_ld(&bar[XB_TMO])) break; if (sp > XB_SPIN_CAP) { atomicAdd(&bar[XB_TMO], 1u); break; } }
    }
    nloc = mine > 0u ? mine : 1u; nx = cnt > 0u ? cnt : 1u;
}
__device__ __forceinline__ void xcd_barrier(const XcdBarrier& b) {
    asm volatile("s_waitcnt vmcnt(0)" ::: "memory");
    __syncthreads();
    if (tid_() == 0) {
        unsigned* bar = b.bar;
        __builtin_amdgcn_s_waitcnt(0);
        unsigned nloc = b.st[0], nx = b.st[1];
        if (nloc == 0u) { xcd_barrier_complete(bar, b.x, nloc, nx); b.st[0] = nloc; b.st[1] = nx; }
        const unsigned old = xb_add(&bar[XB_XSUB(b.x)], 1u);
        const unsigned gen = old / nloc;
        if (old + 1u == (gen + 1u) * nloc) {
            __builtin_amdgcn_fence(__ATOMIC_RELEASE, "agent");
            asm volatile("s_waitcnt vmcnt(0)" ::: "memory");
            const unsigned og = xb_add(&bar[XB_TOP], 1u);
            const unsigned tg = og / nx;
            if (og + 1u == (tg + 1u) * nx) xb_add(&bar[XB_TOPGEN], 1u);
            else XB_SPIN(xb_ld(&bar[XB_TOPGEN]) == tg, bar);
            __builtin_amdgcn_fence(__ATOMIC_ACQUIRE, "agent");
            xb_add(&bar[XB_XGEN(b.x)], 1u);
            asm volatile("s_waitcnt vmcnt(0)" ::: "memory");
        } else {
            XB_SPIN(xb_ld(&bar[XB_XGEN(b.x)]) == gen, bar);
            __builtin_amdgcn_fence(__ATOMIC_ACQUIRE, "agent");
            asm volatile("s_waitcnt vmcnt(0)" ::: "memory");
        }
    }
    __syncthreads();
}

__device__ __forceinline__ void ph_pro(KP p, unsigned char* lds) {
    float* sc = (float*)lds;
    float* red = sc + 3 * 1024;
    const int tid = tid_(), lane = tid & 63, wid = tid >> 6;
    for (int i = tid; i < 3 * 1024; i += NTHREADS) { const int r = i >> 10, k = i & 1023; const float v = (r < 2) ? p->in[1][r * 1024 + k] : p->in[3][k]; sc[i] = silu_(v); }
    __syncthreads();
    float* mod = (float*)(p->ws + WS_MOD);
    for (int item = bid_(); item < DEPTH * 96 + DEPTH * 8; item += gsz_()) {
        if (item >= DEPTH * 96) {
            const int fi = item - DEPTH * 96, lf = fi >> 3, w = fi & 7, fr = lane & 15, fq = lane >> 4; const float* rw = p->in[23] + (size_t)lf * 1024 * 64;
            u32x4* RF = (u32x4*)(p->ws + WS_RFRAG);
#pragma unroll
            for (int s = 0; s < 2; ++s) { const int tk = wid * 2 + s, t = tk >> 2, k = tk & 3; float v[8], lo[8];
#pragma unroll
                for (int j = 0; j < 8; ++j) v[j] = rw[(size_t)((w * 4 + k) * 32 + fq * 8 + j) * 64 + t * 16 + fr];
                const u32x4 hh = pack8(v);
                const float hf[8] = {bf2f(hh.x & 0xffffu), bf2f(hh.x >> 16), bf2f(hh.y & 0xffffu), bf2f(hh.y >> 16), bf2f(hh.z & 0xffffu), bf2f(hh.z >> 16), bf2f(hh.w & 0xffffu), bf2f(hh.w >> 16)};
#pragma unroll
                for (int j = 0; j < 8; ++j) lo[j] = v[j] - hf[j];
                const size_t o = ((size_t)(((lf * 8 + w) * 4 + t) * 4 + k) * 64 + lane) * 2;
                RF[o] = hh; RF[o + 1] = pack8(lo); }
            continue; }
        const int l = item / 96, j0 = (item % 96) * 64;
        const float* w = p->in[4] + (size_t)l * 1024 * 6144;
        float a0 = 0.f, a1 = 0.f, a2 = 0.f;
        const int k0 = wid * 128;
#pragma unroll 1
        for (int k = k0; k < k0 + 128; k += 32) { float wv[32];
#pragma unroll
            for (int u = 0; u < 32; ++u) wv[u] = w[(size_t)(k + u) * 6144 + j0 + lane];
#pragma unroll
            for (int u = 0; u < 32; ++u) { a0 += sc[k + u] * wv[u]; a1 += sc[1024 + k + u] * wv[u]; a2 += sc[2048 + k + u] * wv[u]; } }
        red[(wid * 3 + 0) * 64 + lane] = a0; red[(wid * 3 + 1) * 64 + lane] = a1; red[(wid * 3 + 2) * 64 + lane] = a2;
        __syncthreads();
        if (tid < 192) { const int r = tid >> 6; float s = 0.f;
            for (int w8 = 0; w8 < 8; ++w8) s += red[(w8 * 3 + r) * 64 + lane];
            mod[((size_t)l * 3 + r) * 6144 + j0 + lane] = s + p->in[5][l * 6144 + j0 + lane]; }
        __syncthreads();
    }
    if (bid_() == 0) {
        float* rt = (float*)(p->ws + WS_ROPE);
        for (int i = tid; i < 128 * 16; i += NTHREADS) { const int pos = i >> 4, f = i & 15; const float inv = powf(10000.f, -(float)f * (1.f / 16.f)); float sn, cs; sincosf((float)pos * inv, &sn, &cs);
            rt[pos * 32 + f] = cs; rt[pos * 32 + 16 + f] = sn; }
    }
    if (bid_() == gsz_() - 1) {
        float* lb = (float*)(p->ws + WS_LB);
        for (int i = tid; i < 2 * 2 * 256; i += NTHREADS) { const int l = i >> 9, dir = (i >> 8) & 1, ch = i & 255;
            const float* lg = p->in[21];
            const float l0 = lg[(dir * 2 + 0) * 256 + ch], l1 = lg[(dir * 2 + 1) * 256 + ch]; const float m = fmaxf(l0, l1);
            const float e0 = expf(l0 - m), e1 = expf(l1 - m);
            lb[i] = (l == 0) ? 0.f : e1 / (e0 + e1); }
    }
}

constexpr int CVT_E1 = 1050, CVT_E2 = 2850;
struct CvtTile { const float* src; bf16_t* dst; int K, N, k0, n0, blk, bstride, boff; float f8scale; int perm; };
__device__ __forceinline__ int cvt_total() { return 16 * 44 + 16 * 16 + 4 * 4 + 2 * (64 * 64) + 2 * 64 + 64 * 64 + 64; }
__device__ __forceinline__ CvtTile cvt_decode(KP p, int l, int g) {
    bf16_t* Wgu = (bf16_t*)(p->ws + wgu_off(l)); bf16_t* Wd = (bf16_t*)(p->ws + wd_off(l));
    CvtTile t; int per, tn, r;
    if (g < 704) { r = g; t = {p->in[8] + (size_t)l * 1024 * DIN, (bf16_t*)(p->ws + win_off(l)), 1024, DIN, 0, 0, DIN, 0, 0, 0.f}; tn = 44; per = 704; }
    else if ((g -= 704) < 256) { r = g; t = {p->in[9] + (size_t)l * 1024 * 1024, (bf16_t*)(p->ws + wout_off(l)), 1024, 1024, 0, 0, 1024, 0, 0, 0.f}; tn = 16; per = 256; }
    else if ((g -= 256) < 16) { r = g; t = {p->in[19] + (size_t)l * 65536, (bf16_t*)(p->ws + wpw_off(l)), 256, 256, 0, 0, 256, 0, 0, 0.f}; tn = 4; per = 16; }
    else if ((g -= 16) < 4096) { const int m = g >> 6; r = g & 63; t = {p->in[25] + ((size_t)l * 64 + m) * 262144, (bf16_t*)((unsigned char*)Wgu + (size_t)m * 524288), 1024, 256, 0, 0, 128, 256, 0, WGU8_SCALE}; tn = 4; per = 64; }
    else if ((g -= 4096) < 4096) { const int m = g >> 6; r = g & 63; t = {p->in[26] + ((size_t)l * 64 + m) * 262144, (bf16_t*)((unsigned char*)Wgu + (size_t)m * 524288), 1024, 256, 0, 0, 128, 256, 128, WGU8_SCALE}; tn = 4; per = 64; }
    else if ((g -= 4096) < 64) { r = g; t = {p->in[28] + (size_t)l * 262144, (bf16_t*)((unsigned char*)Wgu + (size_t)64 * 524288), 1024, 256, 0, 0, 128, 256, 0, WGU8_SCALE}; tn = 4; per = 64; }
    else if ((g -= 64) < 64) { r = g; t = {p->in[29] + (size_t)l * 262144, (bf16_t*)((unsigned char*)Wgu + (size_t)64 * 524288), 1024, 256, 0, 0, 128, 256, 128, WGU8_SCALE}; tn = 4; per = 64; }
    else if ((g -= 64) < 4096) { const int m = g >> 6; r = g & 63; t = {p->in[27] + ((size_t)l * 64 + m) * 262144, (bf16_t*)((unsigned char*)Wd + (size_t)m * 262144), 256, 1024, 0, 0, 1024, 0, 0, WD8_SCALE, 1}; tn = 16; per = 64; }
    else { g -= 4096; r = g; t = {p->in[30] + (size_t)l * 262144, (bf16_t*)((unsigned char*)Wd + (size_t)64 * 262144), 256, 1024, 0, 0, 1024, 0, 0, WD8_SCALE, 1}; tn = 16; per = 64; }
    (void)per; t.k0 = (r / tn) * 64; t.n0 = (r % tn) * 64; return t;
}
__device__ __forceinline__ void ph_cvt(KP p, int l, unsigned char* lds, int first = 0, int nwg = 0, int t0 = 0, int t1 = 1 << 30) {
    float* tb = (float*)lds;
    const int tid = tid_(), G = nwg ? nwg : gsz_(), total = t1 < cvt_total() ? t1 : cvt_total();
    const int r0 = tid >> 4, c0 = (tid & 15) * 4, nn = tid >> 3, kc = (tid & 7) * 8;
    int g = bid_() - first, buf = 0;
    if (g < 0) return;
    g += t0;
    if (g >= total) return;
    CvtTile T = cvt_decode(p, l, g);
    f32x4 v0 = *(const f32x4*)(T.src + (size_t)(T.k0 + r0) * T.N + T.n0 + c0), v1 = *(const f32x4*)(T.src + (size_t)(T.k0 + r0 + 32) * T.N + T.n0 + c0);
    for (;;) {
        float* t = tb + buf * (64 * 65);
        t[r0 * 65 + c0] = v0.x; t[r0 * 65 + c0 + 1] = v0.y; t[r0 * 65 + c0 + 2] = v0.z; t[r0 * 65 + c0 + 3] = v0.w;
        t[(r0 + 32) * 65 + c0] = v1.x; t[(r0 + 32) * 65 + c0 + 1] = v1.y; t[(r0 + 32) * 65 + c0 + 2] = v1.z; t[(r0 + 32) * 65 + c0 + 3] = v1.w;
        const CvtTile C = T; const int gn = g + G; const bool more = gn < total;
        if (more) { T = cvt_decode(p, l, gn);
            v0 = *(const f32x4*)(T.src + (size_t)(T.k0 + r0) * T.N + T.n0 + c0); v1 = *(const f32x4*)(T.src + (size_t)(T.k0 + r0 + 32) * T.N + T.n0 + c0); }
        __syncthreads();
        { const int n = C.n0 + nn; int drow = (n / C.blk) * C.bstride + C.boff + (n % C.blk);
          if (C.perm) drow = (n & ~255) + ((n >> 3) & 1) * 128 + ((n >> 6) & 3) * 32 + ((n >> 4) & 3) * 8 + (n & 7);
          if (C.f8scale != 0.f) { const float sc = C.f8scale;
              int w0 = __builtin_amdgcn_cvt_pk_fp8_f32(clamp8(t[(kc + 0) * 65 + nn] * sc), clamp8(t[(kc + 1) * 65 + nn] * sc), 0, false); w0 = __builtin_amdgcn_cvt_pk_fp8_f32(clamp8(t[(kc + 2) * 65 + nn] * sc), clamp8(t[(kc + 3) * 65 + nn] * sc), w0, true);
              int w1 = __builtin_amdgcn_cvt_pk_fp8_f32(clamp8(t[(kc + 4) * 65 + nn] * sc), clamp8(t[(kc + 5) * 65 + nn] * sc), 0, false); w1 = __builtin_amdgcn_cvt_pk_fp8_f32(clamp8(t[(kc + 6) * 65 + nn] * sc), clamp8(t[(kc + 7) * 65 + nn] * sc), w1, true);
              u32x2 o8; o8.x = (unsigned)w0; o8.y = (unsigned)w1;
              *(u32x2*)((unsigned char*)C.dst + (size_t)drow * C.K + C.k0 + kc) = o8;
          } else {
          u32x4 o; o.x = pk2(t[(kc + 0) * 65 + nn], t[(kc + 1) * 65 + nn]); o.y = pk2(t[(kc + 2) * 65 + nn], t[(kc + 3) * 65 + nn]);
          o.z = pk2(t[(kc + 4) * 65 + nn], t[(kc + 5) * 65 + nn]); o.w = pk2(t[(kc + 6) * 65 + nn], t[(kc + 7) * 65 + nn]);
          *(u32x4*)(C.dst + (size_t)drow * C.K + C.k0 + kc) = o; } }
        if (!more) break;
        g = gn; buf ^= 1;
    }
    __syncthreads();
}
__device__ __forceinline__ void norm_mod_row(const float* xrow, const float* g, const float* shift, const float* scale, bf16_t* orow, float* fout, int lane) {
    f32x4 v[4]; float s = 0.f;
#pragma unroll
    for (int j = 0; j < 4; ++j) { v[j] = ((const f32x4*)xrow)[lane + 64 * j]; s += v[j].x * v[j].x + v[j].y * v[j].y + v[j].z * v[j].z + v[j].w * v[j].w; }
    const float rinv = rsqrtf(wave_sum(s) * (1.f / D) + EPS);
#pragma unroll
    for (int j = 0; j < 4; ++j) { const int idx = lane + 64 * j;
        const f32x4 gg = ((const f32x4*)g)[idx], sh = ((const f32x4*)shift)[idx], sc = ((const f32x4*)scale)[idx];
        f32x4 y; y.x = v[j].x * rinv * gg.x * (1.f + sc.x) + sh.x; y.y = v[j].y * rinv * gg.y * (1.f + sc.y) + sh.y;
        y.z = v[j].z * rinv * gg.z * (1.f + sc.z) + sh.z; y.w = v[j].w * rinv * gg.w * (1.f + sc.w) + sh.w;
        u32x2 o; o.x = pk2(y.x, y.y); o.y = pk2(y.z, y.w);
        ((u32x2*)orow)[idx] = o;
        if (fout) ((f32x4*)fout)[idx] = y; }
}
__device__ __forceinline__ void ph_norm1(KP p, int l, unsigned char* lds) {
    if (l == 0) ph_cvt(p, l, lds);
    const int tid = tid_(), lane = tid & 63, wid = tid >> 6;
    bf16_t* A = (bf16_t*)(p->ws + Z_A);
    const float* g = p->in[6] + l * D;
    if (l == 0) { for (int row = bid_() * 8 + wid; row < R_ALL; row += gsz_() * 8)
        norm_mod_row(xrow_src(p, l, row), g, mod_vec(p, l, row, 0), mod_vec(p, l, row, 1), A + (size_t)row * D, nullptr, lane); }
    else { const bf16_t* X = (const bf16_t*)(p->ws + WS_X);
        for (int row = bid_() * 8 + wid; row < R_ALL; row += gsz_() * 8) {
            const float* shift = mod_vec(p, l, row, 0); const float* scale = mod_vec(p, l, row, 1);
            f32x4 v[4]; unpack8(*(const u32x4*)(X + (size_t)row * D + lane * 8), v[0], v[1]); unpack8(*(const u32x4*)(X + (size_t)row * D + 512 + lane * 8), v[2], v[3]);
            float ss = 0.f;
#pragma unroll
            for (int j = 0; j < 4; ++j) ss += v[j].x * v[j].x + v[j].y * v[j].y + v[j].z * v[j].z + v[j].w * v[j].w;
            const float rinv = rsqrtf(wave_sum(ss) * (1.f / D) + EPS);
#pragma unroll
            for (int h = 0; h < 2; ++h) { const int c0 = h * 512 + lane * 8; unsigned o[4];
#pragma unroll
                for (int q = 0; q < 2; ++q) { const f32x4 gg = *(const f32x4*)(g + c0 + 4 * q), sh = *(const f32x4*)(shift + c0 + 4 * q), sc = *(const f32x4*)(scale + c0 + 4 * q);
                    const f32x4 y = v[2 * h + q] * rinv * gg * (sc + 1.f) + sh; o[2 * q] = pk2(y.x, y.y); o[2 * q + 1] = pk2(y.z, y.w); }
                *(u32x4*)(A + (size_t)row * D + c0) = (u32x4){o[0], o[1], o[2], o[3]}; } } }
}

template <int NBJ, class ARow, class Epi>
__device__ __forceinline__ void gemm_simple_tile(const bf16_t* A, const ARow& arow, const bf16_t* Bt, int K, int row0, int colb0, int bjstride, const Epi& epi) {
    const int tid = tid_(), lane = tid & 63, wid = tid >> 6, wr = wid >> 1, wc = wid & 1, fr = lane & 15, fq = lane >> 4;
    f32x4 acc[2][NBJ][4];
#pragma unroll
    for (int i = 0; i < 2; ++i)
#pragma unroll
        for (int b = 0; b < NBJ; ++b)
#pragma unroll
            for (int j = 0; j < 4; ++j) acc[i][b][j] = (f32x4){0.f, 0.f, 0.f, 0.f};
    const bf16_t* ap[2];
#pragma unroll
    for (int i = 0; i < 2; ++i) ap[i] = A + (size_t)arow(row0 + wr * 32 + i * 16 + fr) * K + fq * 8;
    const bf16_t* bp = Bt + (size_t)(colb0 + wc * 64 + fr) * K + fq * 8;
    for (int k = 0; k < K; k += 32) {
        bf16x8 a[2];
#pragma unroll
        for (int i = 0; i < 2; ++i) a[i] = *(const bf16x8*)(ap[i] + k);
#pragma unroll
        for (int b = 0; b < NBJ; ++b)
#pragma unroll
            for (int j = 0; j < 4; ++j) { const bf16x8 bv = *(const bf16x8*)(bp + (size_t)(b * bjstride + j * 16) * K + k);
#pragma unroll
                for (int i = 0; i < 2; ++i) acc[i][b][j] = __builtin_amdgcn_mfma_f32_16x16x32_bf16(a[i], bv, acc[i][b][j], 0, 0, 0); }
    }
#pragma unroll
    for (int i = 0; i < 2; ++i)
#pragma unroll
        for (int j = 0; j < 4; ++j)
#pragma unroll
            for (int r = 0; r < 4; ++r) { const int row = row0 + wr * 32 + i * 16 + fq * 4 + r, col = wc * 64 + j * 16 + fr;
                epi(row, col, acc[i][0][j][r], acc[i][NBJ - 1][j][r]); }
}
struct RowId { __device__ __forceinline__ int operator()(int r) const { return r; } };
struct RowGather { const int* idx; __device__ __forceinline__ int operator()(int r) const { return idx[r]; } };

__device__ __forceinline__ void ph_inproj(KP p, int l, unsigned char* lds) {
    const bf16_t* A = (const bf16_t*)(p->ws + Z_A); const bf16_t* Bt = (const bf16_t*)(p->ws + Z_WIN); bf16_t* P = (bf16_t*)(p->ws + Z_P);
    constexpr int TM = R_ALL / 128, TN = DIN / 128;
    for (int it = bid_(); it < TM * TN; it += gsz_()) { const int mt = it / TN, nt = it % TN;
        auto epi = [&](int row, int col, float v, float) { P[(size_t)row * DIN + nt * 128 + col] = (bf16_t)f2bf(v); };
        gemm_simple_tile<1>(A, RowId{}, Bt, 1024, mt * 128, nt * 128, 0, epi); }
}

namespace pg8 {
constexpr int BM = 256, BK = 64, HALF = 128, HTB = HALF * BK * 2, STAGE_BYTES = 8 * HTB, NXCD = 8, WGM = 8;
__host__ __device__ __forceinline__ int lds_byte(int r, int c) { const int st = (r >> 4) * 2 + (c >> 5), rr = r & 15, cc = c & 31, ob = rr * 64 + cc * 2; return st * 1024 + (ob ^ (((ob >> 9) & 1) << 5)); }
__host__ __device__ __forceinline__ void stage_rc(int b, int& R, int& C) { const int st = b / 1024, sb = b % 1024, swz = sb ^ (((sb >> 9) & 1) << 5); R = (st >> 1) * 16 + swz / 64; C = (st & 1) * 32 + (swz % 64) / 2; }
__host__ __device__ __forceinline__ int perm32(int rho) { const int n = rho >> 4, i = rho & 15; return 8 * (i >> 2) + 4 * n + (i & 3); }
struct Unit { int pm, pn, ord; };
struct Gemm { const bf16_t* A; const bf16_t* Bt; int M, N, K; };
struct StaticOrder {
    int nM, nN, nwg, G, c;
    __host__ __device__ void init(int M, int N, int G_, int c_) { nM = M / BM; nN = N / BM; nwg = nM * nN; G = G_; c = c_; }
    __host__ __device__ bool next(int i, Unit& u) const {
        const long L = (long)i * G + c; if (L >= nwg) return false;
        int wgid = (int)L; { const int q = nwg / NXCD, r = nwg % NXCD, xcd = wgid % NXCD, off = wgid / NXCD; wgid = (xcd < r ? xcd * (q + 1) : r * (q + 1) + (xcd - r) * q) + off; }
        const int nig = WGM * nN, gid = wgid / nig, fm = gid * WGM, gsz = (nM - fm) < WGM ? (nM - fm) : WGM;
        u.pm = fm + ((wgid % nig) % gsz); u.pn = (wgid % nig) / gsz; u.ord = i; return true;
    }
};
__device__ __forceinline__ unsigned cvt_pk_bf16(float lo, float hi) { unsigned r; asm volatile("v_cvt_pk_bf16_f32 %0, %1, %2" : "=v"(r) : "v"(lo), "v"(hi)); return r; }

typedef int i32x4v __attribute__((ext_vector_type(4)));
typedef int i32x8v __attribute__((ext_vector_type(8)));
__device__ __forceinline__ i32x8v cat8(bf16x8 lo, bf16x8 hi) { const i32x4v a = __builtin_bit_cast(i32x4v, lo), b = __builtin_bit_cast(i32x4v, hi); return __builtin_shufflevector(a, b, 0, 1, 2, 3, 4, 5, 6, 7); }
__device__ __forceinline__ void glds16_s(const void* sbase, unsigned voff, unsigned lds_dst) { unsigned keep;
    asm volatile("s_mov_b32 %0, m0\n\ts_mov_b32 m0, %3\n\ts_nop 0\n\tglobal_load_lds_dwordx4 %1, %2\n\ts_mov_b32 m0, %0" : "=&s"(keep) : "v"(voff), "s"(sbase), "s"(lds_dst) : "memory"); }
template <class Epi, class Sched, bool GATHER, bool FP8 = false>
__device__ __forceinline__ void gemm_phase(LAS unsigned char* lds, const Gemm g, const Sched& S, const Epi& E, const LAS int* rtab) {
    const int tid = tid_(), wid = __builtin_amdgcn_readfirstlane(tid >> 6), lane = tid & 63, wr = wid >> 2, wc = wid & 3, fr = lane & 15, fq = lane >> 4;
    const int KB = FP8 ? g.K : g.K * 2, nt = KB / 128;
    unsigned voffA[2], voffB[2]; int RA[2], CA[2];
#pragma unroll
    for (int i = 0; i < 2; ++i) { int R, C; stage_rc(tid * 16 + i * 8192, R, C); const int Rb = (R & ~31) + perm32(R & 31);
        voffA[i] = (unsigned)(R * KB + C * 2); voffB[i] = (unsigned)(Rb * KB + C * 2); RA[i] = R; CA[i] = C; }
    unsigned rcpk = 0; if constexpr (GATHER) { rcpk = (unsigned)(RA[0] * 4) | ((unsigned)(CA[0] * 2) << 16); asm volatile("" : "+v"(rcpk)); }
    const size_t kstep = (size_t)128;
    const size_t hstep = (size_t)HALF * KB;
    const size_t hstepA = GATHER ? 0 : hstep;
    const size_t tstep = 2 * hstep;
    const unsigned ldsw = (unsigned)wid * 1024u;
    const unsigned ldsb = (unsigned)__builtin_amdgcn_readfirstlane((int)((unsigned)(size_t)lds + ldsw));
    const int aoff = lds_byte(wr * 64 + fr, fq * 8), boff = lds_byte(wc * 32 + fr, fq * 8);
#define PG8_SA(b, h) (((b) * 2 + (h)) * HTB)
#define PG8_SB(b, h) ((4 + (b) * 2 + (h)) * HTB)
#define PG8_STAGE(bufoff, gbase, voff) do { _Pragma("unroll") for (int _i = 0; _i < 2; ++_i) { if constexpr (FP8) glds16_s((const void*)(gbase), (voff)[_i], ldsb + (unsigned)((bufoff) + _i * 8192)); \
        else __builtin_amdgcn_global_load_lds((const unsigned*)((const char*)(gbase) + (voff)[_i]), (LAS unsigned*)(lds + (bufoff) + ldsw + _i * 8192), 16, 0, 0); } } while (0)
#define PG8_STAGE1(bufoff, gbase, v0) do {   \
        glds16_s((const void*)(gbase), (v0), ldsb + (unsigned)(bufoff)); glds16_s((const void*)((const char*)(gbase) + (size_t)64 * KB), (v0), ldsb + (unsigned)((bufoff) + 8192)); } while (0)
#define PG8_LDA(dst, b, h) do { _Pragma("unroll") for (int m = 0; m < 4; ++m) { if constexpr (FP8) dst##8[m] = cat8(*(const LAS bf16x8*)(lds + PG8_SA(b, h) + aoff + m * 2048), *(const LAS bf16x8*)(lds + PG8_SA(b, h) + aoff + m * 2048 + 1024)); \
        else { _Pragma("unroll") for (int k = 0; k < 2; ++k) dst[m][k] = *(const LAS bf16x8*)(lds + PG8_SA(b, h) + aoff + m * 2048 + k * 1024); } } } while (0)
#define PG8_LDB(dst, b, h) do { _Pragma("unroll") for (int n = 0; n < 2; ++n) { if constexpr (FP8) dst##8[n] = cat8(*(const LAS bf16x8*)(lds + PG8_SB(b, h) + boff + n * 2048), *(const LAS bf16x8*)(lds + PG8_SB(b, h) + boff + n * 2048 + 1024)); \
        else { _Pragma("unroll") for (int k = 0; k < 2; ++k) dst[n][k] = *(const LAS bf16x8*)(lds + PG8_SB(b, h) + boff + n * 2048 + k * 1024); } } } while (0)
#define PG8_MMA(ai, bj, At, Bt) do { __builtin_amdgcn_s_setprio(1); _Pragma("unroll") for (int m = 0; m < 4; ++m) _Pragma("unroll") for (int n = 0; n < 2; ++n) { \
        if constexpr (FP8) acc[ai][bj][m][n] = __builtin_amdgcn_mfma_scale_f32_16x16x128_f8f6f4(Bt##8[n], At##8[m], acc[ai][bj][m][n], 0, 0, 0, 0x7F7F7F7F, 0, 0x7F7F7F7F); \
        else { _Pragma("unroll") for (int k = 0; k < 2; ++k) acc[ai][bj][m][n] = __builtin_amdgcn_mfma_f32_16x16x32_bf16(Bt[n][k], At[m][k], acc[ai][bj][m][n], 0, 0, 0); } } \
        if constexpr (FP8) { asm volatile("" : "+v"(acc[ai][bj][0][0]), "+v"(acc[ai][bj][0][1]), "+v"(acc[ai][bj][1][0]), "+v"(acc[ai][bj][1][1]), "+v"(acc[ai][bj][2][0]), "+v"(acc[ai][bj][2][1]), "+v"(acc[ai][bj][3][0]), "+v"(acc[ai][bj][3][1])); } \
        __builtin_amdgcn_s_setprio(0); } while (0)
#define PG8_WAIT_V(n) asm volatile("s_waitcnt vmcnt(" #n ")" ::: "memory")
#define PG8_WAIT_L(n) asm volatile("s_waitcnt lgkmcnt(" #n ")" ::: "memory")
#define PG8_BAR __builtin_amdgcn_s_barrier()
#define PG8_SCHED __builtin_amdgcn_sched_barrier(0)
#define PG8_STAGE_A(bufoff, gbase, ord, h) do { unsigned _o[2]; if constexpr (GATHER) {   \
            unsigned _pk = rcpk; asm volatile("" : "+v"(_pk));   \
            const LAS unsigned char* _rp = (const LAS unsigned char*)rtab + ((ord) * 1024 + (h) * 512) + (_pk & 0xffffu); const unsigned _c2 = _pk >> 16; \
            _Pragma("unroll") for (int _i = 0; _i < 2; ++_i) _o[_i] = __umul24((unsigned)*(const LAS int*)(_rp + _i * 256), (unsigned)KB) + _c2; } \
        else { _o[0] = voffA[0]; _o[1] = voffA[1]; } if constexpr (FP8 && !GATHER) PG8_STAGE1(bufoff, gbase, voffA[0]); else PG8_STAGE(bufoff, gbase, _o); } while (0)
#define PG8_STAGE_B(bufoff, gbase) do { if constexpr (FP8) PG8_STAGE1(bufoff, gbase, voffB[0]); else PG8_STAGE(bufoff, gbase, voffB); } while (0)
    Unit cur, nxt; int ui = 0;
    if (!S.next(0, cur)) return;
    f32x4 acc[2][2][4][2];
#pragma unroll
    for (int a = 0; a < 2; ++a)
#pragma unroll
        for (int b = 0; b < 2; ++b)
#pragma unroll
            for (int m = 0; m < 4; ++m)
#pragma unroll
                for (int n = 0; n < 2; ++n) acc[a][b][m][n] = (f32x4){0.f, 0.f, 0.f, 0.f};
    bf16x8 At[4][2], B0[2][2], B1[2][2]; i32x8v At8[4], B08[2], B18[2];
    const char* cA = GATHER ? (const char*)g.A : (const char*)g.A + (size_t)cur.pm * tstep; const char* cB = (const char*)g.Bt + (size_t)cur.pn * tstep;
    PG8_STAGE_B(PG8_SB(0, 0), cB); PG8_STAGE_B(PG8_SB(0, 1), cB + hstep); PG8_STAGE_A(PG8_SA(0, 0), cA, 0, 0); PG8_STAGE_A(PG8_SA(0, 1), cA + hstepA, 0, 1);
    if (wr == 1) PG8_BAR;
    PG8_WAIT_V(2); PG8_BAR;
    PG8_STAGE_B(PG8_SB(1, 0), cB + kstep); PG8_STAGE_A(PG8_SA(1, 0), cA + kstep, 0, 0); PG8_STAGE_B(PG8_SB(1, 1), cB + hstep + kstep);
    PG8_WAIT_V(6); PG8_BAR;
    for (;;) {
        const bool has_next = S.next(ui + 1, nxt);
        const char* nA = GATHER ? (const char*)g.A : (has_next ? (const char*)g.A + (size_t)nxt.pm * tstep : cA); const char* nB = has_next ? (const char*)g.Bt + (size_t)nxt.pn * tstep : cB;
#pragma unroll 1
        for (int t = 0; t < nt; t += 2) {
            const bool last = (t == nt - 2);
            const char* a1 = cA + (size_t)(t + 1) * kstep;
            const char* a2 = last ? nA : cA + (size_t)(t + 2) * kstep; const char* b2 = last ? nB : cB + (size_t)(t + 2) * kstep;
            const char* a3 = a2 + kstep; const char* b3 = b2 + kstep;
            const int on = (last && has_next) ? ui + 1 : ui;
            PG8_LDB(B0, 0, 0); PG8_LDB(B1, 0, 1); PG8_SCHED; PG8_LDA(At, 0, 0); PG8_STAGE_A(PG8_SA(1, 1), a1 + hstepA, ui, 1);
            PG8_WAIT_V(8); PG8_WAIT_L(0); PG8_BAR; PG8_MMA(0, 0, At, B0); PG8_MMA(0, 1, At, B1); PG8_BAR; PG8_SCHED;
            PG8_LDA(At, 0, 1); PG8_STAGE_B(PG8_SB(0, 0), b2); PG8_STAGE_B(PG8_SB(0, 1), b2 + hstep); PG8_STAGE_A(PG8_SA(0, 0), a2, on, 0);
            PG8_WAIT_V(8); PG8_WAIT_L(0); PG8_BAR; PG8_MMA(1, 0, At, B0); PG8_MMA(1, 1, At, B1); PG8_BAR; PG8_SCHED;
            PG8_LDB(B0, 1, 0); PG8_LDB(B1, 1, 1); PG8_SCHED; PG8_LDA(At, 1, 0); PG8_STAGE_A(PG8_SA(0, 1), a2 + hstepA, on, 1);
            PG8_WAIT_V(8); PG8_WAIT_L(0); PG8_BAR; PG8_MMA(0, 0, At, B0); PG8_MMA(0, 1, At, B1); PG8_BAR; PG8_SCHED;
            PG8_LDA(At, 1, 1); PG8_STAGE_B(PG8_SB(1, 0), b3); PG8_STAGE_B(PG8_SB(1, 1), b3 + hstep); PG8_STAGE_A(PG8_SA(1, 0), a3, on, 0);
            PG8_WAIT_V(8); PG8_WAIT_L(0); PG8_BAR; PG8_MMA(1, 0, At, B0); PG8_MMA(1, 1, At, B1); PG8_BAR; PG8_SCHED;
        }
        if (wr == 0) PG8_BAR;
        E(acc, cur, wr, wc, fr, fq);
        if (!has_next) break;
#pragma unroll
        for (int a = 0; a < 2; ++a)
#pragma unroll
            for (int b = 0; b < 2; ++b)
#pragma unroll
                for (int m = 0; m < 4; ++m)
#pragma unroll
                    for (int n = 0; n < 2; ++n) acc[a][b][m][n] = (f32x4){0.f, 0.f, 0.f, 0.f};
        cur = nxt; cA = nA; cB = nB; ++ui;
        if (wr == 1) PG8_BAR;
    }
    PG8_WAIT_V(0);
    PG8_BAR;
#undef PG8_SA
#undef PG8_SB
#undef PG8_STAGE
#undef PG8_LDA
#undef PG8_LDB
#undef PG8_MMA
#undef PG8_WAIT_V
#undef PG8_WAIT_L
#undef PG8_BAR
#undef PG8_SCHED
#undef PG8_STAGE_A
#undef PG8_STAGE_B
#undef PG8_STAGE1
}
struct EpiBf16 {
    bf16_t* O; int ldc, ncolt; size_t slab;
    __device__ __forceinline__ void operator()(const f32x4 (&acc)[2][2][4][2], const Unit& u, int wr, int wc, int fr, int fq) const {
        const int row0 = u.pm * BM + wr * 64 + fr; const size_t col0 = (size_t)(u.pn % ncolt) * slab + wc * 32 + 8 * fq;
#pragma unroll
        for (int ai = 0; ai < 2; ++ai)
#pragma unroll
            for (int m = 0; m < 4; ++m) { bf16_t* rowp = O + (size_t)(row0 + ai * HALF + m * 16) * ldc + col0;
#pragma unroll
                for (int bj = 0; bj < 2; ++bj) { const f32x4 v0 = acc[ai][bj][m][0], v1 = acc[ai][bj][m][1];
                    u32x4 w; w.x = cvt_pk_bf16(v0[0], v0[1]); w.y = cvt_pk_bf16(v0[2], v0[3]); w.z = cvt_pk_bf16(v1[0], v1[1]); w.w = cvt_pk_bf16(v1[2], v1[3]);
                    *(u32x4*)(rowp + bj * HALF) = w; } }
    }
};
struct EpiRes {
    bf16_t* X; const float* xlat; const float* xctx; const float* modl; int pm_shift; float ascale; bool perm = false;
    __device__ __forceinline__ void operator()(const f32x4 (&acc)[2][2][4][2], const Unit& u, int wr, int wc, int fr, int fq) const {
        const int pm = u.pm - pm_shift; const int rsel = pm < 64 ? (pm >> 5) : 2;
        const int row0 = pm * BM + wr * 64 + fr, col0 = (u.pn & 3) * BM + (perm ? wc * 64 + 16 * fq : wc * 32 + 8 * fq), bjs = perm ? 8 : HALF;
        const float* gate = modl + (size_t)rsel * 6144 + col0;
        const float* xs = xlat ? (pm < 64 ? xlat + (size_t)row0 * D : xctx + (size_t)(row0 - R_LAT) * D) + col0 : nullptr;
        bf16_t* xo = X + (size_t)row0 * D + col0;
#pragma unroll
        for (int bj = 0; bj < 2; ++bj) { const f32x4 g0 = *(const f32x4*)(gate + bj * bjs) * ascale, g1 = *(const f32x4*)(gate + bj * bjs + 4) * ascale;
#pragma unroll
            for (int ai = 0; ai < 2; ++ai)
#pragma unroll
                for (int m = 0; m < 4; ++m) { const size_t o = (size_t)(ai * HALF + m * 16) * D + bj * bjs;
                    f32x4 x0, x1;
                    if (xs) { x0 = *(const f32x4*)(xs + o); x1 = *(const f32x4*)(xs + o + 4); } else unpack8(*(const u32x4*)(xo + o), x0, x1);
                    const f32x4 y0 = x0 + g0 * acc[ai][bj][m][0], y1 = x1 + g1 * acc[ai][bj][m][1];
                    u32x4 w; w.x = cvt_pk_bf16(y0[0], y0[1]); w.y = cvt_pk_bf16(y0[2], y0[3]); w.z = cvt_pk_bf16(y1[0], y1[1]); w.w = cvt_pk_bf16(y1[2], y1[3]);
                    *(u32x4*)(xo + o) = w; } }
    }
};
struct EpiGU8 {
    unsigned char* H8; const LAS float* wtab;
    __device__ __forceinline__ void operator()(const f32x4 (&acc)[2][2][4][2], const Unit& u, int wr, int wc, int fr, int fq) const {
        { const int t_ = tid_(); fr = t_ & 15; fq = (t_ >> 4) & 3; }
        const int row0 = u.pm * BM + wr * 64 + fr, col0 = (u.pn & 1) * 128 + wc * 32 + 8 * fq;
#pragma unroll
        for (int ai = 0; ai < 2; ++ai)
#pragma unroll
            for (int m = 0; m < 4; ++m) { const int row = row0 + ai * HALF + m * 16; const float w = wtab[u.ord * 256 + wr * 64 + fr + ai * HALF + m * 16] * (H8_SCALE * GU_DESCALE * GU_DESCALE);
                float h[8];
#pragma unroll
                for (int n = 0; n < 2; ++n)
#pragma unroll
                    for (int j = 0; j < 4; ++j) { const float ag = acc[ai][0][m][n][j], au = acc[ai][1][m][n][j];
                        h[n * 4 + j] = __builtin_amdgcn_fmed3f((ag * au) * __builtin_amdgcn_rcpf(1.f + __builtin_amdgcn_exp2f(ag * (-GU_DESCALE * LOG2E))) * w, -440.f, 440.f); }
                int w0 = __builtin_amdgcn_cvt_pk_fp8_f32(h[0], h[1], 0, false); w0 = __builtin_amdgcn_cvt_pk_fp8_f32(h[2], h[3], w0, true);
                int w1 = __builtin_amdgcn_cvt_pk_fp8_f32(h[4], h[5], 0, false); w1 = __builtin_amdgcn_cvt_pk_fp8_f32(h[6], h[7], w1, true);
                u32x2 o; o.x = (unsigned)w0; o.y = (unsigned)w1;
                *(u32x2*)(H8 + (size_t)row * 256 + col0) = o; }
    }
};
struct EpiGU {
    bf16_t* H; const float* slot_w;
    __device__ __forceinline__ void operator()(const f32x4 (&acc)[2][2][4][2], const Unit& u, int wr, int wc, int fr, int fq) const {
        const int row0 = u.pm * BM + wr * 64 + fr, col0 = (u.pn & 1) * 128 + wc * 32 + 8 * fq;
#pragma unroll
        for (int ai = 0; ai < 2; ++ai)
#pragma unroll
            for (int m = 0; m < 4; ++m) { const int row = row0 + ai * HALF + m * 16; const float w = slot_w[row];
                float h[8];
#pragma unroll
                for (int n = 0; n < 2; ++n)
#pragma unroll
                    for (int j = 0; j < 4; ++j) { const float gv = acc[ai][0][m][n][j], uv = acc[ai][1][m][n][j]; h[n * 4 + j] = gv / (1.f + __expf(-gv)) * uv * w; }
                u32x4 o; o.x = cvt_pk_bf16(h[0], h[1]); o.y = cvt_pk_bf16(h[2], h[3]); o.z = cvt_pk_bf16(h[4], h[5]); o.w = cvt_pk_bf16(h[6], h[7]);
                *(u32x4*)(H + (size_t)row * 256 + col0) = o; }
    }
};
struct EpiY8 {
    unsigned char* Y8;
    __device__ __forceinline__ void operator()(const f32x4 (&acc)[2][2][4][2], const Unit& u, int wr, int wc, int fr, int fq) const {
        const int row0 = u.pm * BM + wr * 64 + fr; unsigned char* base = Y8 + ((size_t)(u.pn & 3) * MAXSLOT + row0) * 256 + wc * 64 + 16 * fq;
#pragma unroll
        for (int ai = 0; ai < 2; ++ai)
#pragma unroll
            for (int m = 0; m < 4; ++m) { unsigned w[4];
#pragma unroll
                for (int bj = 0; bj < 2; ++bj) { f32x4 v0 = acc[ai][bj][m][0] * (Y8_SCALE * DN_DESCALE), v1 = acc[ai][bj][m][1] * (Y8_SCALE * DN_DESCALE);
#pragma unroll
                    for (int q = 0; q < 4; ++q) { v0[q] = fminf(fmaxf(v0[q], -440.f), 440.f); v1[q] = fminf(fmaxf(v1[q], -440.f), 440.f); }
                    int w0 = __builtin_amdgcn_cvt_pk_fp8_f32(v0[0], v0[1], 0, false); w0 = __builtin_amdgcn_cvt_pk_fp8_f32(v0[2], v0[3], w0, true);
                    int w1 = __builtin_amdgcn_cvt_pk_fp8_f32(v1[0], v1[1], 0, false); w1 = __builtin_amdgcn_cvt_pk_fp8_f32(v1[2], v1[3], w1, true);
                    w[2 * bj] = (unsigned)w0; w[2 * bj + 1] = (unsigned)w1; }
                *(u32x4*)(base + (size_t)(ai * HALF + m * 16) * 256) = (u32x4){w[0], w[1], w[2], w[3]}; }
    }
};
struct EpiDown {
    bf16_t* Y; bf16_t* X; const float* modl5;
    __device__ __forceinline__ void operator()(const f32x4 (&acc)[2][2][4][2], const Unit& u, int wr, int wc, int fr, int fq) const {
        { const int t_ = tid_(); fr = t_ & 15; fq = (t_ >> 4) & 3; }
        if (u.pm < MAXSLOT / 256) { const EpiY8 e{(unsigned char*)Y}; e(acc, u, wr, wc, fr, fq); }
        else { const EpiRes e{X, nullptr, nullptr, modl5, MAXSLOT / 256, DN_DESCALE, true}; e(acc, u, wr, wc, fr, fq); }
    }
};
}


__device__ __forceinline__ void ph_inproj_f(KP p, int l, unsigned char* lds) {
    pg8::Gemm g{(const bf16_t*)(p->ws + Z_A), (const bf16_t*)(p->ws + win_off(l)), R_ALL, DIN, 1024};
    pg8::StaticOrder S; S.init(R_ALL, DIN, gsz_(), bid_());
    pg8::EpiBf16 E{(bf16_t*)(p->ws + Z_P), DIN, DIN / 256, 256};
    pg8::gemm_phase<pg8::EpiBf16, pg8::StaticOrder, false>((LAS unsigned char*)lds, g, S, E, nullptr);
    if (l == 0 && DEPTH > 1 && gsz_() == 256) { __syncthreads(); ph_cvt(p, 1, lds, 214, 42, 0, CVT_E1); }
}
__device__ __forceinline__ void ph_outproj_f(KP p, int l, unsigned char* lds) {
    const int T = (l == 0) ? R_ALL : R_LAT;
    pg8::Gemm g{(const bf16_t*)(p->ws + Z_YCAT), (const bf16_t*)(p->ws + wout_off(l)), T, 1024, 1024};
    pg8::StaticOrder S; S.init(T, 1024, gsz_(), bid_());
    bf16_t* X = (bf16_t*)(p->ws + WS_X);
    pg8::EpiRes E{X, l == 0 ? p->in[0] : nullptr, l == 0 ? p->in[2] : nullptr, (const float*)(p->ws + WS_MOD) + (size_t)l * 3 * 6144 + 2 * 1024, 0, 1.f};
    pg8::gemm_phase<pg8::EpiRes, pg8::StaticOrder, false>((LAS unsigned char*)lds, g, S, E, nullptr);
    if (l == 0 && DEPTH > 1) {
        const int G = gsz_(); __syncthreads();
        if (G == 256) ph_cvt(p, 1, lds, 8, 248, CVT_E2, 1 << 30); else ph_cvt(p, 1, lds); }
}
struct QkvLane { f32x4 gg0, gg1, gw0, gw1; };
__device__ __forceinline__ QkvLane qkv_lane_consts(KP p, int l, int lane) {
    QkvLane c; const int dch = (lane & 7) * 8; const int isk = lane >= 32;
    const float* gq = p->in[isk ? 11 : 10] + l * 64 + dch; const float* wq = p->in[isk ? 13 : 12] + l * 64 + dch;
    c.gg0 = *(const f32x4*)gq; c.gg1 = *(const f32x4*)(gq + 4); c.gw0 = *(const f32x4*)wq; c.gw1 = *(const f32x4*)(wq + 4); return c;
}
__device__ __forceinline__ void prep_qkv_row(KP p, int l, int row, int lane, const QkvLane& qc) {
    const bf16_t* pr = (const bf16_t*)(p->ws + Z_P) + (size_t)row * DIN;
    const bool isctx = row >= R_LAT; const int b = isctx ? ((row - R_LAT) >> 8) : (row >> 13), t = isctx ? ((row - R_LAT) & 255) : (row & 8191);
    const size_t krow = (size_t)b * NKEY + (isctx ? NSEQ + t : t);
    const int l7 = lane & 7, axis = l7 >> 2, half = (l7 >> 1) & 1;
    f32x4 cs0 = (f32x4){1.f, 1.f, 1.f, 1.f}, cs1 = cs0, sn0 = (f32x4){0.f, 0.f, 0.f, 0.f}, sn1 = sn0;
    if (!isctx) { const int pos = axis == 0 ? (t >> 6) : (t & 63); const float* rt = (const float*)(p->ws + WS_ROPE) + pos * 32 + (lane & 1) * 8;
        cs0 = *(const f32x4*)rt; cs1 = *(const f32x4*)(rt + 4); sn0 = *(const f32x4*)(rt + 16); sn1 = *(const f32x4*)(rt + 20); }
    const u32x4 ra = *(const u32x4*)(pr + lane * 8), rb = *(const u32x4*)(pr + 512 + lane * 8);
#pragma unroll
    for (int grp = 0; grp < 2; ++grp) {
        const u32x4 r = grp ? rb : ra;
        bf16_t* Qd = (bf16_t*)(p->ws + (isctx ? (grp ? Z_QWC : Z_QGC) : (grp ? Z_QW : Z_QG))) + (size_t)(isctx ? (b * NCTX + t) : row) * 256;
        bf16_t* Kd = (bf16_t*)(p->ws + (grp ? Z_KW : Z_KG)) + krow * 128; bf16_t* Vd = (bf16_t*)(p->ws + (grp ? Z_VW : Z_VG)) + krow * 128;
        if (lane >= 48) { *(u32x4*)(Vd + (lane - 48) * 8) = r; continue; }
        float x[8] = {bf2f(r.x & 0xffffu), bf2f(r.x >> 16), bf2f(r.y & 0xffffu), bf2f(r.y >> 16), bf2f(r.z & 0xffffu), bf2f(r.z >> 16), bf2f(r.w & 0xffffu), bf2f(r.w >> 16)};
        float ss = 0.f;
#pragma unroll
        for (int i = 0; i < 8; ++i) ss += x[i] * x[i];
        ss += dpp_mov<0xB1>(ss); ss += dpp_mov<0x4E>(ss); ss += dpp_mov<0x141>(ss);
        const float rinv = rsqrtf(ss * (1.f / 64.f) + EPS);
        const f32x4 g0 = grp ? qc.gw0 : qc.gg0, g1 = grp ? qc.gw1 : qc.gg1;
        const float gv[8] = {g0.x, g0.y, g0.z, g0.w, g1.x, g1.y, g1.z, g1.w};
        const float cv[8] = {cs0.x, cs0.y, cs0.z, cs0.w, cs1.x, cs1.y, cs1.z, cs1.w}, sv[8] = {sn0.x, sn0.y, sn0.z, sn0.w, sn1.x, sn1.y, sn1.z, sn1.w};
        const float qs = (lane < 32) ? QSCALE : 1.f;
        float y[8];
#pragma unroll
        for (int i = 0; i < 8; ++i) { const float v = x[i] * rinv * gv[i]; const float o = dpp_mov<0x4E>(v);
            y[i] = ((half == 0) ? (v * cv[i] - o * sv[i]) : (o * sv[i] + v * cv[i])) * qs; }
        u32x4 ov; ov.x = pk2(y[0], y[1]); ov.y = pk2(y[2], y[3]); ov.z = pk2(y[4], y[5]); ov.w = pk2(y[6], y[7]);
        if (lane < 32) *(u32x4*)(Qd + lane * 8) = ov; else *(u32x4*)(Kd + (lane - 32) * 8) = ov;
    }
}

template <int R> __device__ __forceinline__ void dw_rows(const float* hcol, const float (&wj)[31], float (&acc)[32]) {
    if constexpr (R < 62) {
        const float hv = hcol[R * 256];
        constexpr int T0 = (R - 30 > 0) ? R - 30 : 0, T1 = (R < 31) ? R : 31;
#pragma unroll
        for (int tt = T0; tt <= T1; ++tt) acc[tt] += hv * wj[R - tt];
        dw_rows<R + 1>(hcol, wj, acc);
    }
}
__device__ __forceinline__ void conv_tile(KP p, int l, unsigned char* lds, int seq_row0, int seqlen, int t0) {
    float* hb = (float*)lds;
    const int tid = tid_(), lane = tid & 63, wid = tid >> 6;
    const bf16_t* P = (const bf16_t*)(p->ws + Z_P);
    for (int i = tid; i < 94 * 32; i += NTHREADS) { const int r = i >> 5, c8 = (i & 31) * 8, t = t0 - 15 + r;
        f32x4 h0 = (f32x4){0.f, 0.f, 0.f, 0.f}, h1 = h0;
        if (t >= 0 && t < seqlen) { const bf16_t* pr = P + (size_t)(seq_row0 + t) * DIN;
            const u32x4 vv = *(const u32x4*)(pr + C_CVV + c8), gg = *(const u32x4*)(pr + C_CVG + c8);
            h0.x = bf2f(vv.x & 0xffffu) * sigmoid_(bf2f(gg.x & 0xffffu)); h0.y = bf2f(vv.x >> 16) * sigmoid_(bf2f(gg.x >> 16));
            h0.z = bf2f(vv.y & 0xffffu) * sigmoid_(bf2f(gg.y & 0xffffu)); h0.w = bf2f(vv.y >> 16) * sigmoid_(bf2f(gg.y >> 16));
            h1.x = bf2f(vv.z & 0xffffu) * sigmoid_(bf2f(gg.z & 0xffffu)); h1.y = bf2f(vv.z >> 16) * sigmoid_(bf2f(gg.z >> 16));
            h1.z = bf2f(vv.w & 0xffffu) * sigmoid_(bf2f(gg.w & 0xffffu)); h1.w = bf2f(vv.w >> 16) * sigmoid_(bf2f(gg.w >> 16)); }
        *(f32x4*)(hb + r * 256 + c8) = h0; *(f32x4*)(hb + r * 256 + c8 + 4) = h1; }
    __syncthreads();
    { const int c = tid & 255, hf = tid >> 8;
      const float* w = p->in[15] + (size_t)l * 31 * 256 + c; const float bias = p->in[16][l * 256 + c];
      float wj[31];
#pragma unroll
      for (int j = 0; j < 31; ++j) wj[j] = w[j * 256];
      float acc[32];
#pragma unroll
      for (int tt = 0; tt < 32; ++tt) acc[tt] = bias;
      dw_rows<0>(hb + hf * 32 * 256 + c, wj, acc);
      __syncthreads();
#pragma unroll
      for (int tt = 0; tt < 32; ++tt) hb[(hf * 32 + tt) * 256 + c] = acc[tt];
    }
    __syncthreads();
    constexpr int AS = 264;
    bf16_t* ab = (bf16_t*)(lds + 94 * 256 * 4);
    for (int tt = wid; tt < 64; tt += 8) { const float* r = hb + tt * 256; const f32x4 v = ((const f32x4*)r)[lane];
        const float mean = wave_sum(v.x + v.y + v.z + v.w) * (1.f / 256.f);
        const float dx = v.x - mean, dy = v.y - mean, dz = v.z - mean, dw = v.w - mean;
        const float rstd = rsqrtf(wave_sum(dx * dx + dy * dy + dz * dz + dw * dw) * (1.f / 256.f) + EPS);
        const f32x4 g = ((const f32x4*)(p->in[17] + l * 256))[lane], bb = ((const f32x4*)(p->in[18] + l * 256))[lane];
        u32x2 o; o.x = pk2(silu_(dx * rstd * g.x + bb.x), silu_(dy * rstd * g.y + bb.y)); o.y = pk2(silu_(dz * rstd * g.z + bb.z), silu_(dw * rstd * g.w + bb.w));
        *(u32x2*)(ab + tt * AS + lane * 4) = o; }
    __syncthreads();
    { const int fr = lane & 15, fq = lane >> 4;
      const bf16_t* Wt = (const bf16_t*)(p->ws + wpw_off(l));
      bf16x8 bw[2][8];
#pragma unroll
      for (int j = 0; j < 2; ++j)
#pragma unroll
          for (int ks = 0; ks < 8; ++ks) bw[j][ks] = *(const bf16x8*)(Wt + (size_t)((wid * 2 + j) * 16 + fr) * 256 + ks * 32 + fq * 8);
      const float bias0 = p->in[20][l * 256 + wid * 32 + fr], bias1 = p->in[20][l * 256 + wid * 32 + 16 + fr];
      bf16_t* Y = (bf16_t*)(p->ws + Z_YCAT);
#pragma unroll 1
      for (int tr = 0; tr < 4; ++tr) { f32x4 a0 = (f32x4){0.f, 0.f, 0.f, 0.f}, a1 = a0;
#pragma unroll
          for (int ks = 0; ks < 8; ++ks) { const bf16x8 av = *(const bf16x8*)(ab + (tr * 16 + fr) * AS + ks * 32 + fq * 8);
              a0 = __builtin_amdgcn_mfma_f32_16x16x32_bf16(av, bw[0][ks], a0, 0, 0, 0); a1 = __builtin_amdgcn_mfma_f32_16x16x32_bf16(av, bw[1][ks], a1, 0, 0, 0); }
#pragma unroll
          for (int r = 0; r < 4; ++r) { const int t = t0 + tr * 16 + fq * 4 + r; bf16_t* yr = Y + (size_t)(seq_row0 + t) * D + 256 + wid * 32 + fr;
              yr[0] = (bf16_t)f2bf(a0[r] + bias0); yr[16] = (bf16_t)f2bf(a1[r] + bias1); } }
    }
    __syncthreads();
}

__device__ __forceinline__ int hgrn_chunk_row0(int b, int dir, int j) {
    if (j < 4) { const int cj = dir ? 3 - j : j; return R_LAT + b * NCTX + cj * 64; }
    const int jj = j - 4, cj = dir ? 127 - jj : jj; return b * NSEQ + cj * 64;
}
__device__ __forceinline__ void hgrn_load_chunk(KP p, int l, int row0, int dir, int head, float* qs, float* vs, float* ks, float* cs) {
    const int tid = tid_();
    const bf16_t* P = (const bf16_t*)(p->ws + Z_P);
    const float* lbv = (const float*)(p->ws + WS_LB) + (l * 2 + dir) * 256 + head * 64;
    for (int i = tid; i < 4096; i += NTHREADS) { const int tau = i >> 6, d = i & 63; const int row = row0 + (dir ? 63 - tau : tau);
        const bf16_t* pr = P + (size_t)row * DIN + head * 64 + d;
        if (qs) qs[i] = bf2f(pr[C_RQ]);
        vs[i] = bf2f(pr[C_RI]);
        const float z = bf2f(pr[dir ? C_RFB : C_RFF]); const float lb = lbv[d];
        const float lsp = fminf(z, 0.f) - log1pf(__expf(-fabsf(z)));
        float logf = lsp;
        if (lb > 0.f) { const float a = lsp, bq = __logf(lb) + (lsp - z); const float mx = fmaxf(a, bq); logf = mx + log1pf(__expf(-fabsf(a - bq))); }
        ks[i] = (1.f - lb) * sigmoid_(-z);
        cs[i] = logf; }
    __syncthreads();
    if (tid < 64) { float c = 0.f; for (int tau = 0; tau < 64; ++tau) { c += cs[tau * 64 + tid]; cs[tau * 64 + tid] = c; } }
    __syncthreads();
}
__device__ __forceinline__ void hgrn_pass1_unit(KP p, int l, unsigned char* lds, int unit) {
    float* vs = (float*)lds; float* ks = vs + 4096; float* cs = ks + 4096;
    const int tid = tid_();
    const int j = unit % NCHUNK, seq = unit / NCHUNK, dir = seq & 1, head = (seq >> 1) & 3, b = seq >> 3;
    hgrn_load_chunk(p, l, hgrn_chunk_row0(b, dir, j), dir, head, nullptr, vs, ks, cs);
    for (int i = tid; i < 4096; i += NTHREADS) { const int d = i & 63; ks[i] *= __expf(cs[63 * 64 + d] - cs[i]); }
    __syncthreads();
    float* U = (float*)(p->ws + Z_U) + ((size_t)seq * NCHUNK + j) * 4096; float* Gv = (float*)(p->ws + Z_G) + ((size_t)seq * NCHUNK + j) * 64;
    { const int d = tid >> 3, e0 = (tid & 7) * 8; float acc[8];
#pragma unroll
      for (int e = 0; e < 8; ++e) acc[e] = 0.f;
      for (int tau = 0; tau < 64; ++tau) { const float kv = ks[tau * 64 + d];
#pragma unroll
          for (int e = 0; e < 8; ++e) acc[e] += kv * vs[tau * 64 + e0 + e]; }
#pragma unroll
      for (int e = 0; e < 8; ++e) U[d * 64 + e0 + e] = acc[e]; }
    if (tid < 64) Gv[tid] = __expf(cs[63 * 64 + tid]);
    __syncthreads();
}
constexpr int HS = 72;
constexpr int HL_TOT = 0, HL_OSUM = 2048, HL_T0 = 18432, HL_TB = 64 * HS * 2;
__device__ __forceinline__ f32x4 mm64(const bf16_t* A, const bf16_t* Bt, int tr, int tc, int fr, int fq, f32x4 acc) {
#pragma unroll
    for (int k0 = 0; k0 < 64; k0 += 32) { const bf16x8 a = *(const bf16x8*)(A + (tr * 16 + fr) * HS + k0 + fq * 8), b = *(const bf16x8*)(Bt + (tc * 16 + fr) * HS + k0 + fq * 8);
        acc = __builtin_amdgcn_mfma_f32_16x16x32_bf16(a, b, acc, 0, 0, 0); }
    return acc;
}
__device__ __forceinline__ void hgrn_load8(KP p, int row0, int dir, int head, int tid, float (&q)[8], float (&vv)[8], float (&z)[8]) {
    const int d = tid & 63, seg = tid >> 6;
    const bf16_t* P = (const bf16_t*)(p->ws + Z_P);
#pragma unroll
    for (int i = 0; i < 8; ++i) { const int tau = seg * 8 + i; const int row = row0 + (dir ? 63 - tau : tau);
        const bf16_t* pr = P + (size_t)row * DIN + head * 64 + d;
        q[i] = bf2f(pr[C_RQ]); vv[i] = bf2f(pr[C_RI]); z[i] = bf2f(pr[dir ? C_RFB : C_RFF]); }
}
__device__ __forceinline__ void hgrn_gate8(KP p, int l, int dir, int head, int tid, float* tot, const float (&z)[8], float (&kg)[8], float (&c)[8], float& m, float& cl) {
    const int d = tid & 63, seg = tid >> 6;
    const float lb = ((const float*)(p->ws + WS_LB))[(l * 2 + dir) * 256 + head * 64 + d];
    float run = 0.f;
#pragma unroll
    for (int i = 0; i < 8; ++i) {
        const float ez = __expf(-fabsf(z[i])), rz = __builtin_amdgcn_rcpf(1.f + ez); const float sg = (z[i] >= 0.f) ? rz : ez * rz;
        const float f = lb + (1.f - lb) * sg;
        kg[i] = 1.f - f;
        run += __logf(f); c[i] = run; }
    tot[seg * 64 + d] = run;
    __syncthreads();
    float off = 0.f; m = 0.f; cl = 0.f;
#pragma unroll
    for (int s2 = 0; s2 < 8; ++s2) { const float t = tot[s2 * 64 + d]; if (s2 < seg) off += t; if (s2 < 4) m += t; cl += t; }
#pragma unroll
    for (int i = 0; i < 8; ++i) c[i] += off;
}
__device__ __forceinline__ void hgrn_pass1_f(KP p, int l, unsigned char* lds, int unit) {
    const int tid = tid_(), lane = tid & 63, wid = tid >> 6, fr = lane & 15, fq = lane >> 4, d = tid & 63, seg = tid >> 6;
    float* tot = (float*)(lds + HL_TOT); bf16_t* Vt = (bf16_t*)(lds + HL_T0); bf16_t* KbT = (bf16_t*)(lds + HL_T0 + HL_TB);
    const int j = unit % NCHUNK, seq = unit / NCHUNK, dir = seq & 1, head = (seq >> 1) & 3, b = seq >> 3;
    float q[8], vv[8], z[8], kg[8], c[8], m, cl;
    hgrn_load8(p, hgrn_chunk_row0(b, dir, j), dir, head, tid, q, vv, z);
    hgrn_gate8(p, l, dir, head, tid, tot, z, kg, c, m, cl);
    float kb[8];
#pragma unroll
    for (int i = 0; i < 8; ++i) kb[i] = kg[i] * __expf(cl - c[i]);
    *(u32x4*)(Vt + d * HS + seg * 8) = pack8(vv);
    *(u32x4*)(KbT + d * HS + seg * 8) = pack8(kb);
    float* U = (float*)(p->ws + Z_U) + ((size_t)seq * NCHUNK + j) * 4096; float* Gv = (float*)(p->ws + Z_G) + ((size_t)seq * NCHUNK + j) * 64;
    if (seg == 0) Gv[d] = __expf(cl);
    __syncthreads();
    const int tr = wid >> 1;
#pragma unroll
    for (int t2 = 0; t2 < 2; ++t2) { const int tc = (wid & 1) * 2 + t2;
        const f32x4 acc = mm64(Vt, KbT, tr, tc, fr, fq, (f32x4){0.f, 0.f, 0.f, 0.f});
#pragma unroll
        for (int r = 0; r < 4; ++r) U[(tr * 16 + fq * 4 + r) * 64 + tc * 16 + fr] = acc[r]; }
    __syncthreads();
}
struct HgrnIn1 { float v[8], zf[8], zb[8]; };
__device__ __forceinline__ void hgrn_p1_load(KP p, int unit, int tid, HgrnIn1& r) {
    const int cpos = unit % NCHUNK, head = (unit / NCHUNK) & 3, b = unit / (NCHUNK * 4), d = tid & 63, seg = tid >> 6;
    const int row0 = (cpos < 4) ? R_LAT + b * NCTX + cpos * 64 : b * NSEQ + (cpos - 4) * 64;
    const bf16_t* P = (const bf16_t*)(p->ws + Z_P) + (size_t)(row0 + seg * 8) * DIN + head * 64 + d;
#pragma unroll
    for (int i = 0; i < 8; ++i) { const bf16_t* pr = P + (size_t)i * DIN; r.v[i] = bf2f(pr[C_RI]); r.zf[i] = bf2f(pr[C_RFF]); r.zb[i] = bf2f(pr[C_RFB]); }
}
__device__ __forceinline__ void hgrn_p1_compute(KP p, int l, unsigned char* lds, int unit, int tid, const HgrnIn1& r) {
    const int lane = tid & 63, wid = tid >> 6, fr = lane & 15, fq = lane >> 4, d = tid & 63, seg = tid >> 6;
    float* totf = (float*)(lds + HL_TOT); float* totb = (float*)(lds + HL_OSUM);
    bf16_t* Vt = (bf16_t*)(lds + HL_T0); bf16_t* KfT = (bf16_t*)(lds + HL_T0 + HL_TB); bf16_t* KbT = (bf16_t*)(lds + HL_T0 + 2 * HL_TB);
    const int cpos = unit % NCHUNK, head = (unit / NCHUNK) & 3, b = unit / (NCHUNK * 4);
    const float* lbp = (const float*)(p->ws + WS_LB) + (l * 2) * 256 + head * 64 + d; const float lbf = lbp[0], lbb = lbp[256];
    float kf[8], kb[8], cf[8], cb[8], lfb[8], runf = 0.f, runb = 0.f;
#pragma unroll
    for (int i = 0; i < 8; ++i) {
        { const float z = r.zf[i], ez = __builtin_amdgcn_exp2f(-fabsf(z) * LOG2E), rz = __builtin_amdgcn_rcpf(1.f + ez), sg = (z >= 0.f) ? rz : ez * rz, f = lbf + (1.f - lbf) * sg; kf[i] = 1.f - f; runf += __builtin_amdgcn_logf(f); cf[i] = runf; }
        { const float z = r.zb[i], ez = __builtin_amdgcn_exp2f(-fabsf(z) * LOG2E), rz = __builtin_amdgcn_rcpf(1.f + ez), sg = (z >= 0.f) ? rz : ez * rz, f = lbb + (1.f - lbb) * sg; kb[i] = 1.f - f; lfb[i] = __builtin_amdgcn_logf(f); runb += lfb[i]; cb[i] = runb; } }
    totf[seg * 64 + d] = runf; totb[seg * 64 + d] = runb;
    __syncthreads();
    float offf = 0.f, offb = 0.f, clf = 0.f, clb = 0.f;
#pragma unroll
    for (int s2 = 0; s2 < 8; ++s2) { const float tf = totf[s2 * 64 + d], tb = totb[s2 * 64 + d]; if (s2 < seg) { offf += tf; offb += tb; } clf += tf; clb += tb; }
#pragma unroll
    for (int i = 0; i < 8; ++i) { kf[i] *= __builtin_amdgcn_exp2f(clf - (cf[i] + offf)); kb[i] *= __builtin_amdgcn_exp2f(cb[i] + offb - lfb[i]); }
    *(u32x4*)(Vt + d * HS + seg * 8) = pack8(r.v);
    *(u32x4*)(KfT + d * HS + seg * 8) = pack8(kf);
    *(u32x4*)(KbT + d * HS + seg * 8) = pack8(kb);
    const int jf = cpos, jb = (cpos < 4) ? 3 - cpos : 4 + 127 - (cpos - 4); const int seqf = (b * 4 + head) * 2;
    bf16_t* Uf = (bf16_t*)(p->ws + Z_U) + ((size_t)seqf * NCHUNK + jf) * 4096; bf16_t* Ub = (bf16_t*)(p->ws + Z_U) + ((size_t)(seqf + 1) * NCHUNK + jb) * 4096;
    float* Gf = (float*)(p->ws + Z_G) + ((size_t)seqf * NCHUNK + jf) * 64; float* Gb = (float*)(p->ws + Z_G) + ((size_t)(seqf + 1) * NCHUNK + jb) * 64;
    if (seg == 0) { Gf[d] = __builtin_amdgcn_exp2f(clf); Gb[d] = __builtin_amdgcn_exp2f(clb); }
    __syncthreads();
    const int tr = wid >> 1;
#pragma unroll
    for (int t2 = 0; t2 < 2; ++t2) { const int tc = (wid & 1) * 2 + t2;
        const f32x4 af = mm64(Vt, KfT, tr, tc, fr, fq, (f32x4){0.f, 0.f, 0.f, 0.f}), ab = mm64(Vt, KbT, tr, tc, fr, fq, (f32x4){0.f, 0.f, 0.f, 0.f});
#pragma unroll
        for (int q = 0; q < 4; ++q) { const int o = (tr * 16 + fq * 4 + q) * 64 + tc * 16 + fr; Uf[o] = (bf16_t)f2bf(af[q]); Ub[o] = (bf16_t)f2bf(ab[q]); } }
    __syncthreads();
}
__device__ __forceinline__ void hgrn_pass1_run(KP p, int l, unsigned char* lds, int u0, int un, int ustep) {
    if (un <= 0) return;
    const int tid = tid_();
    HgrnIn1 cur; hgrn_p1_load(p, u0, tid, cur);
    for (int k = 0; k < un; ++k) { const int u = u0 + k * ustep;
        HgrnIn1 nxt = cur; if (k + 1 < un) hgrn_p1_load(p, u + ustep, tid, nxt);
        hgrn_p1_compute(p, l, lds, u, tid, cur);
        cur = nxt; }
}
__device__ __forceinline__ void hgrn_scan_f(KP p) {
    const int tid = tid_();
    if (tid >= 256) return;
    for (int gi = bid_() * 256 + tid; gi < 16 * 4096; gi += gsz_() * 256) {
    const int seq = gi >> 12, ed = gi & 4095, d = ed & 63;
    bf16_t* U = (bf16_t*)(p->ws + Z_U) + (size_t)seq * NCHUNK * 4096 + ed; const float* Gv = (const float*)(p->ws + Z_G) + (size_t)seq * NCHUNK * 64 + d;
    float S = 0.f;
#pragma unroll 1
    for (int j = 0; j < NCHUNK; j += 12) {
        float u[12], g[12];
#pragma unroll
        for (int q = 0; q < 12; ++q) { u[q] = bf2f(U[(size_t)(j + q) * 4096]); g[q] = Gv[(j + q) * 64]; }
#pragma unroll
        for (int q = 0; q < 12; ++q) { U[(size_t)(j + q) * 4096] = (bf16_t)f2bf(S); S = g[q] * S + u[q]; }
    }
    }
}
struct HgrnIn3 { float q[8], v[8], zf[8], zb[8], gg[8]; u32x4 sf, sb; };
__device__ __forceinline__ void hgrn_p3_load(KP p, int unit, int tid, HgrnIn3& r) {
    const int cpos = unit % NCHUNK, head = (unit / NCHUNK) & 3, b = unit / (NCHUNK * 4), d = tid & 63, seg = tid >> 6;
    const int row0 = (cpos < 4) ? R_LAT + b * NCTX + cpos * 64 : b * NSEQ + (cpos - 4) * 64;
    const bf16_t* P = (const bf16_t*)(p->ws + Z_P) + (size_t)(row0 + seg * 8) * DIN + head * 64 + d;
#pragma unroll
    for (int i = 0; i < 8; ++i) { const bf16_t* pr = P + (size_t)i * DIN; r.q[i] = bf2f(pr[C_RQ]); r.v[i] = bf2f(pr[C_RI]); r.zf[i] = bf2f(pr[C_RFF]); r.zb[i] = bf2f(pr[C_RFB]);
        r.gg[i] = bf2f(((const bf16_t*)(p->ws + Z_P))[(size_t)(row0 + seg + 8 * i) * DIN + C_RG + head * 64 + d]); }
    const int jf = cpos, jb = (cpos < 4) ? 3 - cpos : 4 + 127 - (cpos - 4); const int seqf = (b * 4 + head) * 2;
    const bf16_t* U = (const bf16_t*)(p->ws + Z_U);
    r.sf = *(const u32x4*)(U + ((size_t)seqf * NCHUNK + jf) * 4096 + tid * 8); r.sb = *(const u32x4*)(U + ((size_t)(seqf + 1) * NCHUNK + jb) * 4096 + tid * 8);
}
__device__ __forceinline__ void hgrn_p3_compute(KP p, int l, unsigned char* lds, int unit, int tid, const HgrnIn3& r) {
    const int lane = tid & 63, wid = tid >> 6, fr = lane & 15, fq = lane >> 4, d = tid & 63, seg = tid >> 6;
    constexpr int HL_D1 = HL_T0 + 6 * HL_TB, HL_TOT1 = HL_D1 + 6 * HL_TB;
    static_assert(HL_TOT1 + 2048 <= LDS_WVTAB_OFF, "HGRN pass-3 LDS fits below the wave table");
    float* os0 = (float*)(lds + HL_OSUM); float* os1 = (float*)(lds + HL_T0);
    const int cpos = unit % NCHUNK, head = (unit / NCHUNK) & 3, b = unit / (NCHUNK * 4);
    const int row0 = (cpos < 4) ? R_LAT + b * NCTX + cpos * 64 : b * NSEQ + (cpos - 4) * 64;
    const int tr = wid >> 1;
    const float* lbp = (const float*)(p->ws + WS_LB) + (l * 2) * 256 + head * 64 + d;
    const int segs = __builtin_amdgcn_readfirstlane(seg);
    float kg[2][8], c[2][8];
#pragma unroll
    for (int dir = 0; dir < 2; ++dir) { float* tot = (float*)(lds + (dir ? HL_TOT1 : HL_TOT));
        const float lb = lbp[dir * 256], olb = 1.f - lb; float run = 0.f;
#pragma unroll
        for (int ii = 0; ii < 8; ++ii) { const int i = dir ? 7 - ii : ii;
            const float z = dir ? r.zb[i] : r.zf[i];
            const float ez = __builtin_amdgcn_exp2f(-fabsf(z) * LOG2E), rz = __builtin_amdgcn_rcpf(1.f + ez), sg = (z >= 0.f) ? rz : ez * rz, f = lb + olb * sg;
            kg[dir][i] = 1.f - f; run += __builtin_amdgcn_logf(f); c[dir][i] = run; }
        tot[seg * 64 + d] = run; }
    __syncthreads();
#pragma unroll
    for (int dir = 0; dir < 2; ++dir) { const float* tot = (const float*)(lds + (dir ? HL_TOT1 : HL_TOT)); unsigned char* tb = lds + (dir ? HL_D1 : HL_T0);
        bf16_t* Qt = (bf16_t*)tb; bf16_t* Kt = (bf16_t*)(tb + HL_TB); bf16_t* Qb = (bf16_t*)(tb + 2 * HL_TB); bf16_t* St = (bf16_t*)(tb + 3 * HL_TB); bf16_t* Vt = (bf16_t*)(tb + 4 * HL_TB);
        float off = 0.f, m = 0.f;
#pragma unroll
        for (int s2 = 0; s2 < 8; ++s2) { const float t = tot[s2 * 64 + d]; const float fl = (dir ? (s2 > segs) : (s2 < segs)) ? 1.f : 0.f; off = fmaf(t, fl, off); if (dir ? (s2 >= 4) : (s2 < 4)) m += t; }
        float vr[8], qb[8];
#pragma unroll
        for (int i = 0; i < 8; ++i) { const float ci = c[dir][i] + off; const int tau = dir ? 63 - (seg * 8 + i) : seg * 8 + i; const float qv = r.q[i];
            const unsigned qk = pk2(qv * __builtin_amdgcn_exp2f(fminf(ci - m, 115.f)), kg[dir][i] * __builtin_amdgcn_exp2f(fminf(m - ci, 115.f)));
            Qt[tau * HS + d] = (bf16_t)(qk & 0xffffu); Kt[tau * HS + d] = (bf16_t)(qk >> 16);
            qb[i] = qv * __builtin_amdgcn_exp2f(ci);
            vr[i] = dir ? r.v[7 - i] : r.v[i]; }
#pragma unroll
        for (int i = 0; i < 8; i += 2) { const int t0 = dir ? 63 - (seg * 8 + i) : seg * 8 + i, t1 = dir ? t0 - 1 : t0 + 1; const unsigned qq = pk2(qb[i], qb[i + 1]);
            Qb[t0 * HS + d] = (bf16_t)(qq & 0xffffu); Qb[t1 * HS + d] = (bf16_t)(qq >> 16); }
        *(u32x4*)(Vt + d * HS + (dir ? 7 - seg : seg) * 8) = pack8(vr);
        *(u32x4*)(St + (tid >> 3) * HS + (tid & 7) * 8) = dir ? r.sb : r.sf; }
    __syncthreads();
    f32x4 oacc[2][2];
#pragma unroll
    for (int dir = 0; dir < 2; ++dir) { unsigned char* tb = lds + (dir ? HL_D1 : HL_T0);
        const bf16_t* Qt = (const bf16_t*)tb; const bf16_t* Kt = (const bf16_t*)(tb + HL_TB); const bf16_t* Qb = (const bf16_t*)(tb + 2 * HL_TB); const bf16_t* St = (const bf16_t*)(tb + 3 * HL_TB); bf16_t* Sc = (bf16_t*)(tb + 5 * HL_TB);
#pragma unroll
        for (int t2 = 0; t2 < 2; ++t2) { const int tc = (wid & 1) * 2 + t2;
            oacc[dir][t2] = mm64(Qb, St, tr, tc, fr, fq, (f32x4){0.f, 0.f, 0.f, 0.f});
            f32x4 sacc = (f32x4){0.f, 0.f, 0.f, 0.f};
            if (tc <= tr) sacc = mm64(Qt, Kt, tr, tc, fr, fq, sacc);
#pragma unroll
            for (int q = 0; q < 4; q += 2) { const int tau = tr * 16 + fq * 4 + q, sig = tc * 16 + fr; const unsigned ss = pk2(sig <= tau ? sacc[q] : 0.f, sig <= tau + 1 ? sacc[q + 1] : 0.f);
                Sc[tau * HS + sig] = (bf16_t)(ss & 0xffffu); Sc[(tau + 1) * HS + sig] = (bf16_t)(ss >> 16); } } }
    __syncthreads();
#pragma unroll
    for (int dir = 0; dir < 2; ++dir) { unsigned char* tb = lds + (dir ? HL_D1 : HL_T0); const bf16_t* Vt = (const bf16_t*)(tb + 4 * HL_TB); const bf16_t* Sc = (const bf16_t*)(tb + 5 * HL_TB);
        float* os = dir ? os1 : os0;
#pragma unroll
        for (int t2 = 0; t2 < 2; ++t2) { const int tc = (wid & 1) * 2 + t2;
            const f32x4 o = mm64(Sc, Vt, tr, tc, fr, fq, oacc[dir][t2]);
#pragma unroll
            for (int q = 0; q < 4; ++q) { const int tau = tr * 16 + fq * 4 + q, e = tc * 16 + fr, tok = dir ? 63 - tau : tau; os[tok * 64 + e] = o[q]; } } }
    __syncthreads();
    bf16_t* Y = (bf16_t*)(p->ws + Z_YCAT); const float ong = p->in[22][l * 64 + lane];
    float yo[8];
#pragma unroll
    for (int i = 0; i < 8; ++i) { const int tok = wid + 8 * i; const float v = os0[tok * 64 + lane] + os1[tok * 64 + lane];
        yo[i] = v * rsqrtf(wave_sum(v * v) * (1.f / 64.f) + EPS) * ong * silu_(r.gg[i]); }
#pragma unroll
    for (int i = 0; i < 8; i += 2) { const unsigned yy = pk2(yo[i], yo[i + 1]); bf16_t* yp = Y + (size_t)(row0 + wid + 8 * i) * D + 768 + head * 64 + lane;
        yp[0] = (bf16_t)(yy & 0xffffu); yp[(size_t)8 * D] = (bf16_t)(yy >> 16); }
    __syncthreads();
}
__device__ __forceinline__ int hgrn_p3_unit(int k) { if (k < 1024) { const int bh = k >> 7, c = k & 127; return bh * NCHUNK + 4 + c; } const int k2 = k - 1024; return (k2 >> 2) * NCHUNK + (k2 & 3); }
__device__ __forceinline__ void hgrn_pass3_run(KP p, int l, unsigned char* lds) {
    const int tid = tid_(), G = gsz_(), nunits = 1024 + (l == 0 ? 32 : 0);
    int k = bid_(); if (k >= nunits) return;
    HgrnIn3 cur; hgrn_p3_load(p, hgrn_p3_unit(k), tid, cur);
    for (;;) { const int kn = k + G; const bool more = kn < nunits;
        HgrnIn3 nxt = cur; if (more) hgrn_p3_load(p, hgrn_p3_unit(kn), tid, nxt);
        hgrn_p3_compute(p, l, lds, hgrn_p3_unit(k), tid, cur);
        if (!more) break;
        cur = nxt; k = kn; }
}
__device__ __forceinline__ void ph_prep(KP p, int l, unsigned char* lds) {
    const int tid = tid_(), lane = tid & 63, wid = tid >> 6, bid = bid_(), G = gsz_();
    const int nconv = 256 + (l == 0 ? 8 : 0);
    for (int it = bid; it < nconv; it += G) {
        if (it < 256) conv_tile(p, l, lds, (it >> 7) * NSEQ, NSEQ, (it & 127) * 64);
        else { const int c = it - 256; conv_tile(p, l, lds, R_LAT + (c >> 2) * NCTX, NCTX, (c & 3) * 64); } }
    if (G == 256) {
        const int u0 = bid < 8 ? 2 * bid : bid < 56 ? 16 + 5 * (bid - 8) : 256 + 4 * (bid - 56), un = bid < 8 ? 2 : bid < 56 ? 5 : 4;
        hgrn_pass1_run(p, l, lds, u0, un, 1);
        const int g0 = bid < 104 ? 8 * bid : bid < 168 ? 832 + 9 * (bid - 104) : 1408 + 8 * (bid - 168), gn = (bid >= 104 && bid < 168) ? 9 : 8;
        const QkvLane qc = qkv_lane_consts(p, l, lane);
        for (int g = g0; g < g0 + gn; ++g) prep_qkv_row(p, l, g * 8 + wid, lane, qc);
    } else {
        hgrn_pass1_run(p, l, lds, bid, (8 * NCHUNK - bid + G - 1) / G, G);
        const QkvLane qc = qkv_lane_consts(p, l, lane);
        for (int row = bid * 8 + wid; row < R_ALL; row += G * 8) prep_qkv_row(p, l, row, lane, qc);
    }
}

__device__ __forceinline__ void hgrn_scan(KP p) {
    const int gi = bid_() * NTHREADS + tid_();
    if (gi >= 16 * 4096) return;
    const int seq = gi >> 12, de = gi & 4095, d = de >> 6;
    float* U = (float*)(p->ws + Z_U) + (size_t)seq * NCHUNK * 4096 + de; const float* Gv = (const float*)(p->ws + Z_G) + (size_t)seq * NCHUNK * 64 + d;
    float S = 0.f;
    for (int j = 0; j < NCHUNK; j += 4) {
        float u[4], g[4];
#pragma unroll
        for (int q = 0; q < 4; ++q) { u[q] = U[(size_t)(j + q) * 4096]; g[q] = Gv[(j + q) * 64]; }
#pragma unroll
        for (int q = 0; q < 4; ++q) { U[(size_t)(j + q) * 4096] = S; S = g[q] * S + u[q]; }
    }
}
__device__ __forceinline__ void attn_simple_unit(unsigned char* lds, const bf16_t* Qrow0  , const bf16_t* Kb, const bf16_t* Vb  ,
                                                 int mode, int NT, int first_key, int q0, bool use_sink, float sink_log2, bf16_t* Orow0  ) {
    float* Ks = (float*)lds; float* Vs = Ks + 4096;
    const int tid = tid_();
    float q[64], o[64], m = -INFINITY, lsum = 0.f;
    if (tid < 256) {
#pragma unroll
        for (int d = 0; d < 64; ++d) { q[d] = bf2f(Qrow0[(size_t)tid * 256 + d]); o[d] = 0.f; }
    }
    for (int tt = 0; tt < NT; ++tt) {
        int key0, pos0 = 0; bool masked = false;
        if (mode == 0) key0 = first_key + 64 * tt;
        else if (tt < 4) key0 = NSEQ + 64 * tt;
        else { pos0 = q0 - 128 + 64 * (tt - 4); key0 = pos0 < 0 ? 0 : (pos0 > NSEQ - 64 ? NSEQ - 64 : pos0); masked = true; }
        __syncthreads();
        for (int i = tid; i < 4096; i += NTHREADS) { const int kk = i >> 6, d = i & 63; Ks[i] = bf2f(Kb[(size_t)(key0 + kk) * 128 + d]); Vs[i] = bf2f(Vb[(size_t)(key0 + kk) * 128 + d]); }
        __syncthreads();
        if (tid < 256) {
            for (int kk = 0; kk < 64; ++kk) {
                if (masked) { const int kp = pos0 + kk, qp = q0 + tid; const int df = qp - kp; if (kp < 0 || kp >= NSEQ || df > 128 || df < -128) continue; }
                float s = 0.f;
#pragma unroll
                for (int d = 0; d < 64; ++d) s += q[d] * Ks[kk * 64 + d];
                if (s > m) { const float f = exp2f(m - s); lsum *= f;
#pragma unroll
                    for (int d = 0; d < 64; ++d) o[d] *= f;
                    m = s; }
                const float pe = exp2f(s - m); lsum += pe;
#pragma unroll
                for (int d = 0; d < 64; ++d) o[d] += pe * Vs[kk * 64 + d];
            }
        }
    }
    if (tid < 256) {
        if (use_sink) lsum += exp2f(sink_log2 - m);
        const float inv = 1.f / lsum;
#pragma unroll
        for (int d = 0; d < 64; ++d) Orow0[(size_t)tid * D + d] = (bf16_t)f2bf(o[d] * inv);
    }
    __syncthreads();
}
__device__ __forceinline__ void ph_attn(KP p, int l, unsigned char* lds) {
    hgrn_scan(p);
    bf16_t* Y = (bf16_t*)(p->ws + Z_YCAT);
    const bf16_t* Qg = (const bf16_t*)(p->ws + Z_QG); const bf16_t* Qw = (const bf16_t*)(p->ws + Z_QW); const bf16_t* Qgc = (const bf16_t*)(p->ws + Z_QGC); const bf16_t* Qwc = (const bf16_t*)(p->ws + Z_QWC);
    const bf16_t* Kg = (const bf16_t*)(p->ws + Z_KG); const bf16_t* Kw = (const bf16_t*)(p->ws + Z_KW); const bf16_t* Vg = (const bf16_t*)(p->ws + Z_VG); const bf16_t* Vw = (const bf16_t*)(p->ws + Z_VW);
    const int nunits = 512 + (l == 0 ? 16 : 0);
    for (int u = bid_(); u < nunits; u += gsz_()) {
        if (u < 256) {
            const int qb = u & 31, h = (u >> 5) & 3, b = u >> 7, row0 = b * NSEQ + qb * 256;
            attn_simple_unit(lds, Qg + (size_t)row0 * 256 + h * 64, Kg + (size_t)b * NKEY * 128 + (h >> 1) * 64, Vg + (size_t)b * NKEY * 128 + (h >> 1) * 64, 0, NKEY / 64, 0, qb * 256, false, 0.f, Y + (size_t)row0 * D + h * 64);
        } else if (u < 512) {
            const int v = u - 256, qb = v & 31, h = (v >> 5) & 3, b = v >> 7, row0 = b * NSEQ + qb * 256;
            attn_simple_unit(lds, Qw + (size_t)row0 * 256 + h * 64, Kw + (size_t)b * NKEY * 128 + (h >> 1) * 64, Vw + (size_t)b * NKEY * 128 + (h >> 1) * 64, 1, 12, 0, qb * 256, true, p->in[14][l * 4 + h] * LOG2E, Y + (size_t)row0 * D + 512 + h * 64);
        } else {
            const int v = u - 512, h = v & 3, b = (v >> 2) & 1, win = v >> 3, row0 = R_LAT + b * NCTX;
            const bf16_t* Qc = (win ? Qwc : Qgc) + (size_t)(b * NCTX) * 256 + h * 64;
            const bf16_t* Kc = (win ? Kw : Kg) + (size_t)b * NKEY * 128 + (h >> 1) * 64; const bf16_t* Vc = (win ? Vw : Vg) + (size_t)b * NKEY * 128 + (h >> 1) * 64;
            attn_simple_unit(lds, Qc, Kc, Vc, 0, 4, NSEQ, 0, win != 0, p->in[14][l * 4 + h] * LOG2E, Y + (size_t)row0 * D + (win ? 512 : 0) + h * 64);
        }
    }
}

namespace attn_body {
using bf16=__hip_bfloat16;
using bf16x8=__attribute__((ext_vector_type(8)))short;
using s16x4=__attribute__((ext_vector_type(4)))short;
using f32x16=__attribute__((ext_vector_type(16)))float;
using u32x4=__attribute__((ext_vector_type(4)))unsigned;
constexpr int D=64, QP=256, KP=128, OP=1024;
constexpr int NW=8,QBLK=32,QB=QBLK*NW,KVBLK=64;
__device__ __forceinline__ int crow(int r,int hi){return (r&3)+8*(r>>2)+4*hi;}
#define SBAR() __builtin_amdgcn_sched_barrier(0)
__device__ __forceinline__ void wmask(f32x16&p0,f32x16&p1,int tb,int qrel,int hi,int q0){
  const float NEG=-INFINITY; const int kb=64*tb+4*hi; const int a0=kb-qrel, k0=q0-128+kb;
  #pragma unroll
  for(int r=0;r<16;++r){const int c=(r&3)+8*(r>>2);
    const bool bad0=((unsigned)(a0+c)>256u)|((unsigned)(k0+c)>=(unsigned)NSEQ);
    const bool bad1=((unsigned)(a0+c+32)>256u)|((unsigned)(k0+c+32)>=(unsigned)NSEQ);
    p0[r]=bad0?NEG:p0[r]; p1[r]=bad1?NEG:p1[r];}
}

constexpr int NSLOT=3, SLOTB=8192;
constexpr int LDS_K=0, LDS_V=NSLOT*SLOTB, LDS_WS=2*NSLOT*SLOTB, LDS_OST=LDS_WS+NW*64*4, LDS_BYTES=LDS_OST+NW*4096;
constexpr float C2=0.125f*1.4426950408889634f;
__device__ __forceinline__ void glds16(const void*gsrc,unsigned lds_dst){unsigned keep;
  asm volatile("s_mov_b32 %0, m0\n\ts_mov_b32 m0, %2\n\ts_nop 0\n\tglobal_load_lds_dwordx4 %1, off\n\ts_mov_b32 m0, %0":"=&s"(keep):"v"(gsrc),"s"(lds_dst):"memory");}
__device__ __forceinline__ float max3f(float a,float b,float c){float r;asm("v_max3_f32 %0, %1, %2, %3":"=v"(r):"v"(a),"v"(b),"v"(c));return r;}
__device__ __forceinline__ float max2f(float a,float b){float r;asm("v_max_f32_e32 %0, %1, %2":"=v"(r):"v"(a),"v"(b));return r;}
__device__ __forceinline__ float fadd_s(float a,float b){float r;asm("v_add_f32_e32 %0, %1, %2":"=v"(r):"v"(a),"v"(b));return r;}
__device__ __forceinline__ float fsub_s(float a,float b){float r;asm("v_sub_f32_e32 %0, %1, %2":"=v"(r):"v"(a),"v"(b));return r;}
typedef float f32x2_t __attribute__((ext_vector_type(2))); typedef __bf16 bf16x2_t __attribute__((ext_vector_type(2)));
__device__ __forceinline__ unsigned cvtpk_s(float lo,float hi){f32x2_t v={lo,hi};bf16x2_t b=__builtin_convertvector(v,bf16x2_t);return __builtin_bit_cast(unsigned,b);}
#define WAIT_BAR(N) asm volatile("s_waitcnt vmcnt(" #N ") lgkmcnt(0)\n\ts_barrier":::"memory")

__device__ __forceinline__ void qkt(f32x16&p0,f32x16&p1,const char*Kslot,const bf16x8*qr,const f32x16&negm,int r32,int hi){
  const char*kb=Kslot+hi*1024+r32*16;
  #pragma unroll
  for(int d0=0;d0<4;++d0){
    const bf16x8 b0=*reinterpret_cast<const bf16x8*>(kb+d0*2048);
    const bf16x8 b1=*reinterpret_cast<const bf16x8*>(kb+d0*2048+512);
    if(d0==0){p0=__builtin_amdgcn_mfma_f32_32x32x16_bf16(b0,qr[0],negm,0,0,0);p1=__builtin_amdgcn_mfma_f32_32x32x16_bf16(b1,qr[0],negm,0,0,0);}
    else{p0=__builtin_amdgcn_mfma_f32_32x32x16_bf16(b0,qr[d0],p0,0,0,0);p1=__builtin_amdgcn_mfma_f32_32x32x16_bf16(b1,qr[d0],p1,0,0,0);}}
}
typedef __attribute__((address_space(3))) const char* lds_cptr;
typedef short v4i16_t __attribute__((ext_vector_type(4)));
__device__ __forceinline__ void kload8(bf16x8*kf,lds_cptr kp){
  kf[0]=*(const __attribute__((address_space(3))) bf16x8*)(kp);      kf[1]=*(const __attribute__((address_space(3))) bf16x8*)(kp+512);
  kf[2]=*(const __attribute__((address_space(3))) bf16x8*)(kp+2048); kf[3]=*(const __attribute__((address_space(3))) bf16x8*)(kp+2560);
  kf[4]=*(const __attribute__((address_space(3))) bf16x8*)(kp+4096); kf[5]=*(const __attribute__((address_space(3))) bf16x8*)(kp+4608);
  kf[6]=*(const __attribute__((address_space(3))) bf16x8*)(kp+6144); kf[7]=*(const __attribute__((address_space(3))) bf16x8*)(kp+6656);
}
__device__ __forceinline__ void kload2(bf16x8*kf,lds_cptr kp,int j){ kf[2*j]=*(const __attribute__((address_space(3))) bf16x8*)(kp+j*2048); kf[2*j+1]=*(const __attribute__((address_space(3))) bf16x8*)(kp+j*2048+512); }
__device__ __forceinline__ s16x4 vtr(lds_cptr p){ return __builtin_bit_cast(s16x4,__builtin_amdgcn_ds_read_tr16_b64_v4i16((__attribute__((address_space(3))) v4i16_t*)p)); }
__device__ __forceinline__ float rowmax(const f32x16&p0,const f32x16&p1){
  float a=max3f(p0[0],p0[1],p1[0]),b=max3f(p0[2],p0[3],p1[1]);a=max3f(a,p1[2],p1[3]);
  #pragma unroll
  for(int r=4;r<16;r+=4){a=max3f(a,p0[r],p0[r+1]);b=max3f(b,p0[r+2],p0[r+3]);a=max3f(a,p1[r],p1[r+1]);b=max3f(b,p1[r+2],p1[r+3]);}
  const float m=max2f(a,b);
  auto rr=__builtin_amdgcn_permlane32_swap(__float_as_uint(m),__float_as_uint(m),false,false);
  return max2f(__uint_as_float(rr[0]),__uint_as_float(rr[1]));
}
__device__ __forceinline__ void pv(f32x16*o,int vb,bf16x8 pa0,bf16x8 pa1,bf16x8 pa2,bf16x8 pa3){
  #pragma unroll
  for(int d0=0;d0<2;++d0){s16x4 lo[4],hi[4];
    #pragma unroll
    for(int ks=0;ks<4;++ks){
      asm volatile("ds_read_b64_tr_b16 %0,%1 offset:%c2":"=&v"(lo[ks]):"v"(vb),"i"(d0*4096+ks*1024):"memory");
      asm volatile("ds_read_b64_tr_b16 %0,%1 offset:%c2":"=&v"(hi[ks]):"v"(vb),"i"(d0*4096+ks*1024+512):"memory");}
    asm volatile("s_waitcnt lgkmcnt(0)":::"memory");SBAR();
    #define PK(k) (bf16x8){lo[k][0],lo[k][1],lo[k][2],lo[k][3],hi[k][0],hi[k][1],hi[k][2],hi[k][3]}
    o[d0]=__builtin_amdgcn_mfma_f32_32x32x16_bf16(pa0,PK(0),o[d0],0,0,0);
    o[d0]=__builtin_amdgcn_mfma_f32_32x32x16_bf16(pa1,PK(1),o[d0],0,0,0);
    o[d0]=__builtin_amdgcn_mfma_f32_32x32x16_bf16(pa2,PK(2),o[d0],0,0,0);
    o[d0]=__builtin_amdgcn_mfma_f32_32x32x16_bf16(pa3,PK(3),o[d0],0,0,0);
    #undef PK
  }
}

#ifndef ATTN_STORE16
#define ATTN_STORE16(p,v) (*(u32x4*)(p)=(v))
#endif
template<int MODE,int NMASKT,int THRL> __device__ __forceinline__ void attn_unit(const bf16*Q0,const bf16*__restrict__ Kh,const bf16*__restrict__ Vh,bf16*O0,int NT,int key_first,int q0,bool use_sink,float sink_l2,char*shm){
  const int tid=tid_(),lane=tid&63,r32=lane&31,hi=lane>>5; const int wid=__builtin_amdgcn_readfirstlane(tid>>6);
  const bf16*Qw=Q0+(long)(wid*QBLK)*QP;
  auto krow=[&](int t)->long{ if(MODE==0) return (long)key_first+64*t; if(t<4) return (long)NSEQ+64*t; int p=q0-128+64*(t-4); p=p<0?0:(p>NSEQ-64?NSEQ-64:p); return (long)p; };
  const unsigned lds0=(unsigned)(uintptr_t)shm;
  float*wsf=(float*)(shm+LDS_WS)+wid*64;
  const bf16*ksrc=Kh+(long)lane*KP+wid*8;
  const bf16*vsrc=Vh+(long)(16*(wid&3)+(lane>>2))*KP+(wid>>2)*32+(lane&3)*8;
  const unsigned kdst=lds0+LDS_K+wid*1024, vdst=lds0+LDS_V+wid*1024;
  #define DMA_K(t,slot) glds16(ksrc+krow(t)*KP,(unsigned)__builtin_amdgcn_readfirstlane(kdst+(slot)))
  #define DMA_V(t,slot) glds16(vsrc+krow(t)*KP,(unsigned)__builtin_amdgcn_readfirstlane(vdst+(slot)))
  const int vb0=(int)(lds0+LDS_V)+((lane>>4)&1)*32+(lane&3)*8+(4*hi+((lane&15)>>2))*64;
  const char*Kbase=shm+LDS_K; bf16x8 kf[8];
  const lds_cptr shm3=(lds_cptr)shm; const lds_cptr kp0=shm3+LDS_K+hi*1024+r32*16; const lds_cptr vp0=shm3+LDS_V+((lane>>4)&1)*32+(lane&3)*8+(4*hi+((lane&15)>>2))*64;
  DMA_K(0,0);DMA_V(0,0);DMA_K(1,SLOTB);
  bf16x8 qr[4];
  #pragma unroll
  for(int d0=0;d0<4;++d0)qr[d0]=*reinterpret_cast<const bf16x8*>(&Qw[(long)r32*QP+d0*16+hi*8]);
  float mhat=0.f,l_reg=0.f;f32x16 o[2];o[0]=f32x16{};o[1]=f32x16{};f32x16 negm=f32x16{};asm volatile("":"+v"(negm));
  const int qrel=wid*QBLK+r32;
  #define CMASK(P0,P1,t) do{ if(NMASKT>0){int jb_=(t)-(NT-NMASKT); if(jb_>=0)wmask(P0,P1,jb_,qrel,hi,q0);} }while(0)
  bool resc=false;
  #define START(P0,P1) do{ const float rm=rowmax(P0,P1); resc=false; \
    { const float dl=rm; mhat=fadd_s(mhat,dl); \
      _Pragma("unroll") for(int r=0;r<16;++r){P0[r]=fsub_s(P0[r],dl);P1[r]=fsub_s(P1[r],dl);} \
      _Pragma("unroll") for(int r=0;r<16;++r)negm[r]=-mhat; asm volatile("":"+v"(negm)); } \
    _Pragma("unroll") for(int r=0;r<16;++r)P0[r]=__builtin_amdgcn_exp2f(P0[r]); }while(0)
  #define RESC() do{ if(resc){ asm volatile("s_waitcnt lgkmcnt(0)":::"memory"); \
      _Pragma("unroll") for(int d_=0;d_<2;++d_) _Pragma("unroll") for(int r=0;r<16;++r)o[d_][r]*=wsf[crow(r,hi)]; } }while(0)
  f32x16 pA0,pA1,pB0,pB1;
  int sl_prev=0,sl_cur=0,sl_next=SLOTB;
  #define ROT() do{sl_prev=sl_cur;sl_cur=sl_next;sl_next=(sl_next==(NSLOT-1)*SLOTB)?0:sl_next+SLOTB;}while(0)
  DMA_K(2,2*SLOTB);
  WAIT_BAR(3);
  qkt(pA0,pA1,Kbase,qr,negm,r32,hi);asm volatile("s_nop 15\n\ts_nop 7":"+v"(pA0),"+v"(pA1));CMASK(pA0,pA1,0);
  START(pA0,pA1);
  _Pragma("unroll") for(int r=0;r<16;++r)pA1[r]=__builtin_amdgcn_exp2f(pA1[r]);
  WAIT_BAR(0);
  DMA_K(3,0);DMA_V(1,SLOTB);
  ROT();
  kload8(kf,kp0+sl_cur);
  WAIT_BAR(2);
  s16x4 vlo[8],vhi[8]; u32x4 pw0,pw1,pw2,pw3;
  #define PKW(P,B) cvtpk_s(P[B],P[B+1])
  #define PAF(k) __builtin_bit_cast(bf16x8,pw##k)
  #define VFR(i) (bf16x8){vlo[i][0],vlo[i][1],vlo[i][2],vlo[i][3],vhi[i][0],vhi[i][1],vhi[i][2],vhi[i][3]}
  #define PIN(x) asm volatile("":"+v"(x))
  #define MX3(a,b,c) __builtin_fmaxf(__builtin_fmaxf((a),(b)),(c))
  #define GAPA(MF,A0,A1,A2,A3,W0,W1,PW) do{ MF; sacc+=A0; sacc+=A1; sacc+=A2; sacc+=A3; PIN(sacc); W0; W1; PIN(PW); SBAR(); }while(0)
  #define EX(v) __builtin_amdgcn_exp2f(v)
  #define GAPB(MF,X,B) do{ MF; X[B]=EX(X[B]); X[B+1]=EX(X[B+1]); X[B+2]=EX(X[B+2]); X[B+3]=EX(X[B+3]); PIN(X); SBAR(); }while(0)
  #define VRD(i) do{ vlo[i]=vtr(vp_+(((i)>>2)*4096+((i)&3)*1024)); vhi[i]=vtr(vp_+(((i)>>2)*4096+((i)&3)*1024+512)); }while(0)
  #define KRD(G,j) do{ if(G){ kload2(kf,kp0+sl_next,j); SBAR(); } }while(0)
  #define STEP(C0,C1,P0,P1,t,GK,GV,GL) do{ SBAR(); \
    const lds_cptr vp_=vp0+sl_prev; \
    VRD(0); SBAR(); float sacc=(P0[0]+P0[1]); \
    GAPA(C0=__builtin_amdgcn_mfma_f32_32x32x16_bf16(kf[0],qr[0],negm,0,0,0), P0[2],P0[3],P0[4],P0[5],     pw0[0]=PKW(P0,0), pw0[1]=PKW(P0,2), pw0); \
    VRD(4); SBAR(); GAPA(C1=__builtin_amdgcn_mfma_f32_32x32x16_bf16(kf[1],qr[0],negm,0,0,0), P0[6],P0[7],P0[8],P0[9],     pw0[2]=PKW(P0,4), pw0[3]=PKW(P0,6), pw0); \
    VRD(1); SBAR(); GAPA(C0=__builtin_amdgcn_mfma_f32_32x32x16_bf16(kf[2],qr[1],C0,0,0,0),   P0[10],P0[11],P0[12],P0[13], pw1[0]=PKW(P0,8), pw1[1]=PKW(P0,10), pw1); \
    VRD(5); SBAR(); GAPA(C1=__builtin_amdgcn_mfma_f32_32x32x16_bf16(kf[3],qr[1],C1,0,0,0),   P0[14],P0[15],P1[0],P1[1],   pw1[2]=PKW(P0,12),pw1[3]=PKW(P0,14), pw1); \
    VRD(2); SBAR(); GAPA(C0=__builtin_amdgcn_mfma_f32_32x32x16_bf16(kf[4],qr[2],C0,0,0,0),   P1[2],P1[3],P1[4],P1[5],     pw2[0]=PKW(P1,0), pw2[1]=PKW(P1,2), pw2); \
    VRD(6); SBAR(); GAPA(C1=__builtin_amdgcn_mfma_f32_32x32x16_bf16(kf[5],qr[2],C1,0,0,0),   P1[6],P1[7],P1[8],P1[9],     pw2[2]=PKW(P1,4), pw2[3]=PKW(P1,6), pw2); \
    VRD(3); SBAR(); GAPA(C0=__builtin_amdgcn_mfma_f32_32x32x16_bf16(kf[6],qr[3],C0,0,0,0),   P1[10],P1[11],P1[12],P1[13], pw3[0]=PKW(P1,8), pw3[1]=PKW(P1,10), pw3); \
    VRD(7); SBAR(); GAPA(C1=__builtin_amdgcn_mfma_f32_32x32x16_bf16(kf[7],qr[3],C1,0,0,0),   P1[14],P1[15],0.f,0.f,       pw3[2]=PKW(P1,12),pw3[3]=PKW(P1,14), pw3); \
    l_reg+=sacc; \
    if(GK){DMA_K((t)+3,sl_cur);} if(GV){DMA_V((t)+1,sl_next);} \
    CMASK(C0,C1,t); \
    { float a=MX3(C0[0],C0[1],C1[0]),b=MX3(C0[2],C0[3],C1[1]); a=MX3(a,C1[2],C1[3]); \
      _Pragma("unroll") for(int r=4;r<16;r+=4){a=MX3(a,C0[r],C0[r+1]);b=MX3(b,C0[r+2],C0[r+3]);a=MX3(a,C1[r],C1[r+1]);b=MX3(b,C1[r+2],C1[r+3]);} \
      float rm=__builtin_fmaxf(a,b); { auto rr=__builtin_amdgcn_permlane32_swap(__float_as_uint(rm),__float_as_uint(rm),false,false); rm=__builtin_fmaxf(__uint_as_float(rr[0]),__uint_as_float(rr[1])); } \
      resc=false; \
      if(__builtin_expect(__any(rm>(float)THRL),0)){ const float dl=__builtin_fmaxf(rm,0.f); mhat+=dl; \
        _Pragma("unroll") for(int r=0;r<16;++r){C0[r]-=dl;C1[r]-=dl;} \
        _Pragma("unroll") for(int r=0;r<16;++r)negm[r]=-mhat; asm volatile("":"+v"(negm)); \
        const float f=__builtin_amdgcn_exp2f(-dl); l_reg*=f; if(hi==0)wsf[r32]=f; resc=true; } } \
    SBAR(); \
    GAPB(o[0]=__builtin_amdgcn_mfma_f32_32x32x16_bf16(PAF(0),VFR(0),o[0],0,0,0), C0,0); \
    GAPB(o[1]=__builtin_amdgcn_mfma_f32_32x32x16_bf16(PAF(0),VFR(4),o[1],0,0,0), C0,4); \
    KRD(GL,0); GAPB(o[0]=__builtin_amdgcn_mfma_f32_32x32x16_bf16(PAF(1),VFR(1),o[0],0,0,0), C0,8); \
    KRD(GL,1); GAPB(o[1]=__builtin_amdgcn_mfma_f32_32x32x16_bf16(PAF(1),VFR(5),o[1],0,0,0), C0,12); \
    KRD(GL,2); GAPB(o[0]=__builtin_amdgcn_mfma_f32_32x32x16_bf16(PAF(2),VFR(2),o[0],0,0,0), C1,0); \
    KRD(GL,3); GAPB(o[1]=__builtin_amdgcn_mfma_f32_32x32x16_bf16(PAF(2),VFR(6),o[1],0,0,0), C1,4); \
    GAPB(o[0]=__builtin_amdgcn_mfma_f32_32x32x16_bf16(PAF(3),VFR(3),o[0],0,0,0), C1,8); \
    GAPB(o[1]=__builtin_amdgcn_mfma_f32_32x32x16_bf16(PAF(3),VFR(7),o[1],0,0,0), C1,12); \
    }while(0)
  int t=1;
  #undef CMASK
  #define CMASK(P0,P1,t) do{}while(0)
  for(;t+1+(NMASKT>4?NMASKT:4)<NT;t+=2){
    STEP(pB0,pB1,pA0,pA1,t,true,true,true);     WAIT_BAR(2); RESC(); ROT();
    STEP(pA0,pA1,pB0,pB1,t+1,true,true,true);   WAIT_BAR(2); RESC(); ROT();
  }
  #undef CMASK
  #define CMASK(P0,P1,t) do{ if(NMASKT>0){int jb_=(t)-(NT-NMASKT); if(jb_>=0)wmask(P0,P1,jb_,qrel,hi,q0);} }while(0)
  #define ENDW(tt) do{ if((tt)+3<NT){WAIT_BAR(2);} else if((tt)+2<NT){WAIT_BAR(1);} else {WAIT_BAR(0);} }while(0)
  for(;t+1<NT;t+=2){
    STEP(pB0,pB1,pA0,pA1,t,(t+3<NT),(t+1<NT),(t+1<NT));       ENDW(t);   RESC(); ROT();
    STEP(pA0,pA1,pB0,pB1,t+1,(t+4<NT),(t+2<NT),(t+2<NT));     ENDW(t+1); RESC(); ROT();
  }
  STEP(pB0,pB1,pA0,pA1,NT-1,false,false,false); RESC();
  { float sacc=pB0[0]+pB0[1]; _Pragma("unroll") for(int r=2;r<16;++r)sacc+=pB0[r]; _Pragma("unroll") for(int r=0;r<16;++r)sacc+=pB1[r]; l_reg+=sacc;
    pw0=(u32x4){PKW(pB0,0),PKW(pB0,2),PKW(pB0,4),PKW(pB0,6)};pw1=(u32x4){PKW(pB0,8),PKW(pB0,10),PKW(pB0,12),PKW(pB0,14)};pw2=(u32x4){PKW(pB1,0),PKW(pB1,2),PKW(pB1,4),PKW(pB1,6)};pw3=(u32x4){PKW(pB1,8),PKW(pB1,10),PKW(pB1,12),PKW(pB1,14)};
    SBAR(); pv(o,vb0+sl_cur,PAF(0),PAF(1),PAF(2),PAF(3)); }
  #undef PKW
  #undef PAF
  #undef VFR
  #undef PIN
  #undef MX3
  #undef GAPA
  #undef GAPB
  #undef EX
  #undef VRD
  #undef KRD
  #undef STEP
  #undef ENDW
  {auto rr=__builtin_amdgcn_permlane32_swap(__float_as_uint(l_reg),__float_as_uint(l_reg),false,false);l_reg=__uint_as_float(rr[0])+__uint_as_float(rr[1]);}
  if(use_sink)l_reg+=__builtin_amdgcn_exp2f(sink_l2-mhat);
  if(hi==0)wsf[32+r32]=l_reg;asm volatile("s_waitcnt lgkmcnt(0)":::"memory");
  float rli[16];
  #pragma unroll
  for(int r=0;r<16;++r)rli[r]=__builtin_amdgcn_rcpf(wsf[32+crow(r,hi)]);
  bf16*Ow=O0+(long)(wid*QBLK)*OP;
  { bf16*stg=(bf16*)(shm+LDS_OST)+wid*2048;
    #pragma unroll
    for(int r=0;r<16;++r){const int orow=crow(r,hi);
      #pragma unroll
      for(int d0=0;d0<2;++d0)stg[orow*64+d0*32+r32]=__float2bfloat16(o[d0][r]*rli[r]);}
    asm volatile("s_waitcnt lgkmcnt(0)":::"memory");
    #pragma unroll
    for(int i=0;i<4;++i){const int row=i*8+(lane>>3),ch=lane&7; const u32x4 v=*(const u32x4*)(stg+row*64+ch*8); ATTN_STORE16(Ow+(long)row*OP+ch*8,v);} }
  asm volatile("s_waitcnt lgkmcnt(0)\n\ts_barrier":::"memory");
  #undef DMA_K
  #undef DMA_V
  #undef CMASK
  #undef START
  #undef RESC
  #undef ROT
}
constexpr int ATTN_LDS_BYTES=LDS_BYTES;
#undef SBAR
#undef WAIT_BAR
}

__device__ __forceinline__ void ph_attn_f(KP p, int l, unsigned char* lds, bool do_scan = true) {
    if (do_scan) { if (FAST_HGRN) hgrn_scan_f(p); else hgrn_scan(p); }
    using attn_body::bf16;
    bf16* Y = (bf16*)(p->ws + Z_YCAT);
    const bf16* Qg = (const bf16*)(p->ws + Z_QG); const bf16* Qw = (const bf16*)(p->ws + Z_QW); const bf16* Qgc = (const bf16*)(p->ws + Z_QGC); const bf16* Qwc = (const bf16*)(p->ws + Z_QWC);
    const bf16* Kg = (const bf16*)(p->ws + Z_KG); const bf16* Kw = (const bf16*)(p->ws + Z_KW); const bf16* Vg = (const bf16*)(p->ws + Z_VG); const bf16* Vw = (const bf16*)(p->ws + Z_VW);
    const int G = gsz_(), bid = bid_();
    __syncthreads();
    for (int vb = bid; vb < 256; vb += G) {
        const int v = (G == 256) ? (((vb & 7) >> 1) * 64 + (vb & 1) * 32 + (vb >> 3)) : vb;
        const int b = v >> 7, kvh = (v >> 6) & 1, h = kvh * 2 + ((v >> 5) & 1), qb = v & 31, row0 = b * NSEQ + qb * 256;
        const size_t kvo = (size_t)b * NKEY * 128 + kvh * 64;
        attn_body::attn_unit<0, 0, 8>(Qg + (size_t)row0 * 256 + h * 64, Kg + kvo, Vg + kvo, Y + (size_t)row0 * D + h * 64, NKEY / 64, 0, 0, false, 0.f, (char*)lds);
        attn_body::attn_unit<1, 8, 8>(Qw + (size_t)row0 * 256 + h * 64, Kw + kvo, Vw + kvo, Y + (size_t)row0 * D + 512 + h * 64, 12, 0, qb * 256, true, p->in[14][l * 4 + h] * LOG2E, (char*)lds);
    }
    if (l == 0) for (int v = bid; v < 16; v += G) {
        const int h = v & 3, b = (v >> 2) & 1, win = v >> 3, row0 = R_LAT + b * NCTX;
        const size_t kvo = (size_t)b * NKEY * 128 + (h >> 1) * 64;
        attn_body::attn_unit<0, 0, 8>((win ? Qwc : Qgc) + (size_t)(b * NCTX) * 256 + h * 64, (win ? Kw : Kg) + kvo, (win ? Vw : Vg) + kvo, Y + (size_t)row0 * D + (win ? 512 : 0) + h * 64, 4, NSEQ, 0, win != 0, p->in[14][l * 4 + h] * LOG2E, (char*)lds);
    }
}

__device__ __forceinline__ void hgrn_pass3_unit(KP p, int l, unsigned char* lds, int unit) {
    float* qs = (float*)lds; float* vs = qs + 4096; float* ks = vs + 4096; float* cs = ks + 4096; float* Ss = cs + 4096; float* sc = Ss + 4096; float* os = sc + 4096;
    const int tid = tid_(), lane = tid & 63, wid = tid >> 6;
    const int cpos = unit % NCHUNK, head = (unit / NCHUNK) & 3, b = unit / (NCHUNK * 4);
    const int row0 = (cpos < 4) ? R_LAT + b * NCTX + cpos * 64 : b * NSEQ + (cpos - 4) * 64;
    for (int i = tid; i < 4096; i += NTHREADS) os[i] = 0.f;
    for (int dir = 0; dir < 2; ++dir) {
        const int j = (cpos < 4) ? (dir ? 3 - cpos : cpos) : 4 + (dir ? 127 - (cpos - 4) : (cpos - 4));
        const int seq = (b * 4 + head) * 2 + dir;
        __syncthreads();
        hgrn_load_chunk(p, l, row0, dir, head, qs, vs, ks, cs);
        const float* Sg = (const float*)(p->ws + Z_U) + ((size_t)seq * NCHUNK + j) * 4096;
        for (int i = tid; i < 4096; i += NTHREADS) Ss[i] = Sg[i];
        for (int i = tid; i < 4096; i += NTHREADS) { const int tau = i >> 6, sig = i & 63; float a = 0.f;
            if (sig <= tau) { for (int d = 0; d < 64; ++d) a += qs[tau * 64 + d] * ks[sig * 64 + d] * __expf(cs[tau * 64 + d] - cs[sig * 64 + d]); }
            sc[i] = a; }
        __syncthreads();
        { const int tau = tid >> 3, e0 = (tid & 7) * 8; float acc[8];
#pragma unroll
          for (int e = 0; e < 8; ++e) acc[e] = 0.f;
          for (int d = 0; d < 64; ++d) { const float qv = qs[tau * 64 + d] * __expf(cs[tau * 64 + d]);
#pragma unroll
              for (int e = 0; e < 8; ++e) acc[e] += qv * Ss[d * 64 + e0 + e]; }
          for (int sig = 0; sig <= tau; ++sig) { const float sv = sc[tau * 64 + sig];
#pragma unroll
              for (int e = 0; e < 8; ++e) acc[e] += sv * vs[sig * 64 + e0 + e]; }
          const int tok = dir ? 63 - tau : tau;
#pragma unroll
          for (int e = 0; e < 8; ++e) os[tok * 64 + e0 + e] += acc[e]; }
        __syncthreads();
    }
    const bf16_t* P = (const bf16_t*)(p->ws + Z_P); bf16_t* Y = (bf16_t*)(p->ws + Z_YCAT);
    for (int tok = wid; tok < 64; tok += 8) { const float v = os[tok * 64 + lane];
        const float y = v * rsqrtf(wave_sum(v * v) * (1.f / 64.f) + EPS) * p->in[22][l * 64 + lane];
        const float g = bf2f(P[(size_t)(row0 + tok) * DIN + C_RG + head * 64 + lane]);
        Y[(size_t)(row0 + tok) * D + 768 + head * 64 + lane] = (bf16_t)f2bf(y * silu_(g)); }
    __syncthreads();
}
__device__ __forceinline__ void ph_hgrn3(KP p, int l, unsigned char* lds) {
    hgrn_pass3_run(p, l, lds);
    if (l == 0 && DEPTH > 1 && gsz_() == 256) { __syncthreads(); ph_cvt(p, 1, lds, 32, 224, CVT_E1, CVT_E2); }
}

__device__ __forceinline__ void ph_outproj(KP p, int l, unsigned char* lds) {
    const bf16_t* A = (const bf16_t*)(p->ws + Z_YCAT); const bf16_t* Bt = (const bf16_t*)(p->ws + Z_WOUT); float* X = (float*)(p->ws + WS_X);
    const int T = (l == 0) ? R_ALL : R_LAT; const int TM = T / 128, TN = 8;
    for (int it = bid_(); it < TM * TN; it += gsz_()) { const int mt = it / TN, nt = it % TN;
        auto epi = [&](int row, int col, float v, float) { const int c = nt * 128 + col; X[(size_t)row * D + c] = xrow_src(p, l, row)[c] + mod_vec(p, l, row, 2)[c] * v; };
        gemm_simple_tile<1>(A, RowId{}, Bt, 1024, mt * 128, nt * 128, 0, epi); }
}

__device__ __forceinline__ void ph_norm2(KP p, int l, unsigned char* lds, int cnt_off = 0) {
    constexpr int RS = 1032, NSTG = 80;
    const int T = (l == 0) ? R_ALL : R_LAT;
    bf16_t* AH = (bf16_t*)lds; bf16_t* AL = AH + 16 * RS;
    float* PART = (float*)(lds + 2 * 16 * RS * 2); float* LOG = PART + 8 * 16 * 64;
    int* hist = (int*)(LOG + 16 * 64); int* hbase = hist + 64; int* s_e = hbase + 64; int* s_r = s_e + NSTG * 8; float* s_w = (float*)(s_r + NSTG * 8); float* msb = s_w + NSTG * 8;
    const int tid = tid_(), lane = tid & 63, wid = tid >> 6, fr = lane & 15, fq = lane >> 4, bid = bid_(), G = gsz_();
    bf16_t* Tok = (bf16_t*)(p->ws + Z_A); const bf16_t* X = (const bf16_t*)(p->ws + WS_X);
    const float* g2 = p->in[7] + l * D; const float* rw = p->in[23] + (size_t)l * 1024 * 64; const float* rbias = p->in[24] + l * 64;
    unsigned* cnt = (unsigned*)(p->ws + WS_CTL) + CW_CNT + cnt_off + l * 64;
    int* tok_e = (int*)(p->ws + WS_TOKE); int* tok_p = (int*)(p->ws + WS_TOKP); int* expl = (int*)(p->ws + WS_EXPL); float* expw = (float*)(p->ws + WS_EXPW);
    bf16x8 bh[4][4], bl[4][4];
    { const u32x4* RF = (const u32x4*)(p->ws + WS_RFRAG) + (size_t)((l * 8 + wid) * 16) * 128 + lane * 2;
#pragma unroll
      for (int t = 0; t < 4; ++t)
#pragma unroll
          for (int k = 0; k < 4; ++k) { bh[t][k] = __builtin_bit_cast(bf16x8, RF[(t * 4 + k) * 128]); bl[t][k] = __builtin_bit_cast(bf16x8, RF[(t * 4 + k) * 128 + 1]); } }
    const float mybias = rbias[lane];
    const int rpb = (T + G - 1) / G;
    for (int base = bid * rpb; base < T; base += G * rpb) {
        const int r1 = (base + rpb < T) ? base + rpb : T;
        if (tid < 64) hist[tid] = 0;
        for (int s0 = base; s0 < r1; s0 += 16) {
#pragma unroll
            for (int j2 = 0; j2 < 2; ++j2) { const int lr = wid * 2 + j2, row = s0 + lr;
                if (row < r1) {
                    const bf16_t* xrow = X + (size_t)row * D; const float* shift = mod_vec(p, l, row, 3); const float* scale = mod_vec(p, l, row, 4);
                    f32x4 v[4]; float ssq = 0.f;
#pragma unroll
                    for (int j = 0; j < 4; ++j) { const u32x2 r2 = ((const u32x2*)xrow)[lane + 64 * j]; v[j].x = bf2f(r2.x & 0xffffu); v[j].y = bf2f(r2.x >> 16); v[j].z = bf2f(r2.y & 0xffffu); v[j].w = bf2f(r2.y >> 16); ssq += v[j].x * v[j].x + v[j].y * v[j].y + v[j].z * v[j].z + v[j].w * v[j].w; }
                    const float rinv = rsqrtf(wave_sum(ssq) * (1.f / D) + EPS);
#pragma unroll
                    for (int j = 0; j < 4; ++j) { const int idx = lane + 64 * j;
                        const f32x4 gg = ((const f32x4*)g2)[idx], sh = ((const f32x4*)shift)[idx], sc = ((const f32x4*)scale)[idx];
                        f32x4 y; y.x = v[j].x * rinv * gg.x * (1.f + sc.x) + sh.x; y.y = v[j].y * rinv * gg.y * (1.f + sc.y) + sh.y;
                        y.z = v[j].z * rinv * gg.z * (1.f + sc.z) + sh.z; y.w = v[j].w * rinv * gg.w * (1.f + sc.w) + sh.w;
                        u32x2 h; h.x = pk2(y.x, y.y); h.y = pk2(y.z, y.w);
                        u32x2 lw; lw.x = pk2(y.x - bf2f(h.x & 0xffffu), y.y - bf2f(h.x >> 16)); lw.y = pk2(y.z - bf2f(h.y & 0xffffu), y.w - bf2f(h.y >> 16));
                        { int t8 = __builtin_amdgcn_cvt_pk_fp8_f32(clamp8(y.x * TOK8_SCALE), clamp8(y.y * TOK8_SCALE), 0, false); t8 = __builtin_amdgcn_cvt_pk_fp8_f32(clamp8(y.z * TOK8_SCALE), clamp8(y.w * TOK8_SCALE), t8, true);
                          ((unsigned*)((unsigned char*)Tok + (size_t)row * D))[idx] = (unsigned)t8; }
                        *(u32x2*)(AH + lr * RS + idx * 4) = h; *(u32x2*)(AL + lr * RS + idx * 4) = lw; }
                } else {
#pragma unroll
                    for (int j = 0; j < 4; ++j) { const int idx = lane + 64 * j; const u32x2 z = {0u, 0u}; *(u32x2*)(AH + lr * RS + idx * 4) = z; *(u32x2*)(AL + lr * RS + idx * 4) = z; } } }
            __syncthreads();
            { f32x4 acc[4];
#pragma unroll
              for (int t = 0; t < 4; ++t) acc[t] = (f32x4){0.f, 0.f, 0.f, 0.f};
#pragma unroll
              for (int k = 0; k < 4; ++k) { const int ko = (wid * 4 + k) * 32 + fq * 8;
                  const bf16x8 ah = *(const bf16x8*)(AH + fr * RS + ko), al = *(const bf16x8*)(AL + fr * RS + ko);
#pragma unroll
                  for (int t = 0; t < 4; ++t) { acc[t] = __builtin_amdgcn_mfma_f32_16x16x32_bf16(ah, bh[t][k], acc[t], 0, 0, 0);
                      acc[t] = __builtin_amdgcn_mfma_f32_16x16x32_bf16(ah, bl[t][k], acc[t], 0, 0, 0); acc[t] = __builtin_amdgcn_mfma_f32_16x16x32_bf16(al, bh[t][k], acc[t], 0, 0, 0); } }
#pragma unroll
              for (int t = 0; t < 4; ++t)
#pragma unroll
                  for (int r = 0; r < 4; ++r) PART[(wid * 16 + fq * 4 + r) * 64 + t * 16 + fr] = acc[t][r]; }
            __syncthreads();
#pragma unroll
            for (int q = 0; q < 2; ++q) { const int o = tid + q * NTHREADS; float a = 0.f;
#pragma unroll
                for (int w8 = 0; w8 < 8; ++w8) a += PART[w8 * 1024 + o];
                LOG[o] = a; }
            __syncthreads();
#pragma unroll 1
            for (int j2 = 0; j2 < 2; ++j2) { const int lr = wid * 2 + j2, row = s0 + lr;
                if (row >= r1) continue;
                const int sr = row - base;
                const float score = sigmoid_(LOG[lr * 64 + lane]), sel = score + mybias;
                const int e = lane, g = e >> 3;
                int rg = 0;
                {
                  const float m7 = dpp_mov<0x141>(sel); const int b0 = e & 1, b1 = (e >> 1) & 1, b2 = (e >> 2) & 1;
                  const float o1 = dpp_mov<0xB1>(sel), o2 = dpp_mov<0x4E>(sel), o3 = dpp_mov<0x1B>(sel), o6 = dpp_mov<0xB1>(m7), o5 = dpp_mov<0x4E>(m7), o4 = dpp_mov<0x1B>(m7);
                  rg += (int)(o1 > sel) | ((int)(o1 == sel) & b0); rg += (int)(o2 > sel) | ((int)(o2 == sel) & b1); rg += (int)(o3 > sel) | ((int)(o3 == sel) & b1);
                  rg += (int)(o4 > sel) | ((int)(o4 == sel) & b2); rg += (int)(o5 > sel) | ((int)(o5 == sel) & b2); rg += (int)(o6 > sel) | ((int)(o6 == sel) & b2); rg += (int)(m7 > sel) | ((int)(m7 == sel) & b2); }
                float top2 = (rg < 2) ? sel : 0.f;
                top2 += dpp_mov<0xB1>(top2); top2 += dpp_mov<0x4E>(top2); top2 += dpp_mov<0x141>(top2);
                int grank = 0;
#pragma unroll
                for (int i = 1; i < 8; ++i) { const int og = (g + i) & 7; const float o = __shfl(top2, og * 8); grank += (int)(o > top2) | ((int)(o == top2) & (int)(og < g)); }
                const bool keep = grank < 4;
                const float ms = keep ? sel : -INFINITY;
                float* mrow = msb + wid * 64;
                mrow[lane] = ms;
                __builtin_amdgcn_wave_barrier();
                int rk = 0;
#pragma unroll 4
                for (int i = 0; i < 16; ++i) { const f32x4 o = *(const f32x4*)(mrow + 4 * i);
                    rk += (int)(o.x > ms) | ((int)(o.x == ms) & (int)(4 * i + 0 < e)); rk += (int)(o.y > ms) | ((int)(o.y == ms) & (int)(4 * i + 1 < e));
                    rk += (int)(o.z > ms) | ((int)(o.z == ms) & (int)(4 * i + 2 < e)); rk += (int)(o.w > ms) | ((int)(o.w == ms) & (int)(4 * i + 3 < e)); }
                __builtin_amdgcn_wave_barrier();
                const bool chosen = keep && rk < 8;
                const float wsum = wave_sum(chosen ? score : 0.f);
                if (chosen) { const int r = atomicAdd(&hist[e], 1); s_e[sr * 8 + rk] = e; s_r[sr * 8 + rk] = r; s_w[sr * 8 + rk] = score / wsum * 2.5f; } }
        }
        __syncthreads();
        if (tid < 64) { const int h = hist[tid]; hbase[tid] = h ? (int)atomicAdd(&cnt[tid], (unsigned)h) : 0; }
        __syncthreads();
        for (int i = tid; i < (r1 - base) * 8; i += NTHREADS) { const int e = s_e[i]; const size_t o = (size_t)base * 8 + i;
            const int pos = hbase[e] + s_r[i]; tok_e[o] = e; tok_p[o] = pos; expl[(size_t)e * R_ALL + pos] = base + (i >> 3); expw[(size_t)e * R_ALL + pos] = s_w[i]; }
        __syncthreads();
    }
}

__device__ __forceinline__ void moe_pad_starts(KP p, int l, int* ps) {
    const unsigned* cnt = (const unsigned*)(p->ws + WS_CTL) + CW_CNT + l * 64;
    const int tid = tid_();
    if (tid < 64) { const int v = (int)((cnt[tid] + 255u) >> 8) << 8; int incl = v;
#pragma unroll
        for (int d = 1; d < 64; d <<= 1) { const int o = __shfl_up(incl, d); if (tid >= d) incl += o; }
        ps[tid] = incl - v; if (tid == 63) ps[64] = incl; }
    __syncthreads();
}
__device__ __forceinline__ int moe_expert_of_row(const int* ps, int row) { int e = 0;
#pragma unroll
    for (int step = 32; step >= 1; step >>= 1) if (row >= ps[e + step]) e += step;
    return e; }

__device__ __forceinline__ void ph_slots(KP p, int l, unsigned char* lds) {
    const int T = (l == 0) ? R_ALL : R_LAT;
    int* ps = (int*)lds; moe_pad_starts(p, l, ps);
    const unsigned* cnt = (const unsigned*)(p->ws + WS_CTL) + CW_CNT + l * 64;
    const int* tok_e = (const int*)(p->ws + WS_TOKE); const int* tok_p = (const int*)(p->ws + WS_TOKP); const float* tok_w = (const float*)(p->ws + WS_TOKW);
    int* tok_s = (int*)(p->ws + WS_TOKS); int* slot_t = (int*)(p->ws + WS_SLOTT); float* slot_w = (float*)(p->ws + WS_SLOTW);
    for (int i = bid_() * NTHREADS + tid_(); i < T * 8; i += gsz_() * NTHREADS) { const int e = tok_e[i], slot = ps[e] + tok_p[i]; tok_s[i] = slot; slot_t[slot] = i >> 3; slot_w[slot] = tok_w[i]; }
    for (int i = bid_() * NTHREADS + tid_(); i < T; i += gsz_() * NTHREADS) { slot_t[MAXSLOT + i] = i; slot_w[MAXSLOT + i] = 1.f; }
    for (int i = bid_() * NTHREADS + tid_(); i < 64 * 256; i += gsz_() * NTHREADS) { const int e = i >> 8, j = i & 255; const int r = ps[e] + (int)cnt[e] + j; if (r < ps[e + 1]) { slot_t[r] = 0; slot_w[r] = 0.f; } }
    __syncthreads();
}

__device__ __forceinline__ void ph_gateup(KP p, int l, unsigned char* lds) {
    const int T = (l == 0) ? R_ALL : R_LAT;
    int* ps = (int*)lds; moe_pad_starts(p, l, ps);
    const bf16_t* Tok = (const bf16_t*)(p->ws + Z_A); const bf16_t* Wgu = (const bf16_t*)(p->ws + Z_WGU); bf16_t* H = (bf16_t*)(p->ws + Z_H);
    const int* slot_t = (const int*)(p->ws + WS_SLOTT); const float* slot_w = (const float*)(p->ws + WS_SLOTW);
    const int n128 = ps[64] / 128, nitems = (n128 + T / 128) * 2;
    for (int it = bid_(); it < nitems; it += gsz_()) { const int rt = it >> 1, pn = it & 1;
        if (rt < n128) { const int e = moe_expert_of_row(ps, rt * 128);
            auto epi = [&](int row, int col, float g, float u) { H[(size_t)row * 256 + pn * 128 + col] = (bf16_t)f2bf(silu_(g) * u * slot_w[row]); };
            gemm_simple_tile<2>(Tok, RowGather{slot_t}, Wgu + (size_t)e * 524288, 1024, rt * 128, pn * 256, 128, epi);
        } else { const int t0 = (rt - n128) * 128;
            auto epi = [&](int row, int col, float g, float u) { H[(size_t)(MAXSLOT + row) * 256 + pn * 128 + col] = (bf16_t)f2bf(silu_(g) * u); };
            gemm_simple_tile<2>(Tok, RowId{}, Wgu + (size_t)64 * 524288, 1024, t0, pn * 256, 128, epi); }
    }
}
__device__ __forceinline__ void ph_down(KP p, int l, unsigned char* lds) {
    const int T = (l == 0) ? R_ALL : R_LAT;
    int* ps = (int*)lds; moe_pad_starts(p, l, ps);
    const bf16_t* H = (const bf16_t*)(p->ws + Z_H); const bf16_t* Wd = (const bf16_t*)(p->ws + WS_WD); bf16_t* Y = (bf16_t*)(p->ws + Z_Y); float* X = (float*)(p->ws + WS_X);
    const int n128 = ps[64] / 128, nitems = (n128 + T / 128) * 8;
    for (int it = bid_(); it < nitems; it += gsz_()) { const int rt = it >> 3, nt = it & 7;
        if (rt < n128) { const int e = moe_expert_of_row(ps, rt * 128);
            auto epi = [&](int row, int col, float v, float) { Y[(size_t)row * D + nt * 128 + col] = (bf16_t)f2bf(v); };
            gemm_simple_tile<1>(H, RowId{}, Wd + (size_t)e * 262144, 256, rt * 128, nt * 128, 0, epi);
        } else { const int t0 = (rt - n128) * 128;
            auto epi = [&](int row, int col, float v, float) { const int t = row - MAXSLOT, c = nt * 128 + col; X[(size_t)t * D + c] += mod_vec(p, l, t, 5)[c] * v; };
            gemm_simple_tile<1>(H, RowId{}, Wd + (size_t)64 * 262144, 256, MAXSLOT + t0, nt * 128, 0, epi); }
    }
}
__device__ __forceinline__ void ph_combine(KP p, int l, unsigned char* lds) {
    typedef float f32x2 __attribute__((ext_vector_type(2)));
    const int T = (l == 0) ? R_ALL : R_LAT;
    const int tid = tid_(), lane = tid & 63, wid = tid >> 6;
    const unsigned char* Y8 = (const unsigned char*)(p->ws + Z_Y); bf16_t* X = (bf16_t*)(p->ws + WS_X); const int* tok_e = (const int*)(p->ws + WS_TOKE); const int* tok_p = (const int*)(p->ws + WS_TOKP);
    int* ps = (int*)lds; moe_pad_starts(p, l, ps);
    const size_t yoff = (size_t)(lane >> 4) * MAXSLOT * 256 + (lane & 15) * 16;
    for (int row = bid_() * 8 + wid; row < T; row += gsz_() * 8) {
        const float* g5 = mod_vec(p, l, row, 5) + lane * 16;
        bf16_t* xr = X + (size_t)row * D + lane * 16;
        const int myslot = ps[tok_e[row * 8 + (lane & 7)]] + tok_p[row * 8 + (lane & 7)];
        u32x4 yv[8];
#pragma unroll
        for (int k = 0; k < 8; ++k) { const int sl = __builtin_amdgcn_readlane(myslot, k); yv[k] = *(const u32x4*)(Y8 + yoff + (size_t)sl * 256); }
        f32x4 xv[4], gv[4];
#pragma unroll
        for (int q = 0; q < 4; ++q) gv[q] = *(const f32x4*)(g5 + 4 * q);
        unpack8(*(const u32x4*)xr, xv[0], xv[1]); unpack8(*(const u32x4*)(xr + 8), xv[2], xv[3]);
        float a[16];
#pragma unroll
        for (int q = 0; q < 16; ++q) a[q] = 0.f;
#pragma unroll
        for (int k = 0; k < 8; ++k) { const unsigned w[4] = {yv[k].x, yv[k].y, yv[k].z, yv[k].w};
#pragma unroll
            for (int q = 0; q < 4; ++q) { const f32x2 lo = __builtin_amdgcn_cvt_pk_f32_fp8((int)w[q], false), hi = __builtin_amdgcn_cvt_pk_f32_fp8((int)w[q], true);
                a[4 * q] += lo.x; a[4 * q + 1] += lo.y; a[4 * q + 2] += hi.x; a[4 * q + 3] += hi.y; } }
#pragma unroll
        for (int q = 0; q < 4; ++q) { f32x4 av; av.x = a[4 * q]; av.y = a[4 * q + 1]; av.z = a[4 * q + 2]; av.w = a[4 * q + 3]; xv[q] = xv[q] + gv[q] * (av * (1.f / Y8_SCALE)); }
        if (l == DEPTH - 1) { float* dst = p->out + (size_t)row * D + lane * 16;
#pragma unroll
            for (int q = 0; q < 4; ++q) *(f32x4*)(dst + 4 * q) = xv[q]; }
        else { *(u32x4*)xr = (u32x4){pk2(xv[0].x, xv[0].y), pk2(xv[0].z, xv[0].w), pk2(xv[1].x, xv[1].y), pk2(xv[1].z, xv[1].w)};
               *(u32x4*)(xr + 8) = (u32x4){pk2(xv[2].x, xv[2].y), pk2(xv[2].z, xv[2].w), pk2(xv[3].x, xv[3].y), pk2(xv[3].z, xv[3].w)}; }
    }
}
struct MoeSched {
    int ntr, nrt, npn, G, c; const LAS int* tile_e;
    __device__ __forceinline__ bool map(int i, int& rt, int& pp) const {
        if (G == 256) { const int x = c & 7, j = c >> 3, tb = 32 / npn; rt = (i * 8 + x) * tb + j / npn; pp = j % npn; return rt < nrt; }
        const int L = i * G + c; if (L >= nrt * npn) return false;
        rt = L / npn; pp = L % npn; return true; }
    __device__ __forceinline__ bool next(int i, pg8::Unit& u) const {
        int rt, pp; if (!map(i, rt, pp)) return false;
        const bool routed = rt < ntr;
        const int e = routed ? __builtin_amdgcn_readfirstlane(tile_e[rt]) : 64;
        u.pm = routed ? rt : MAXSLOT / 256 + (rt - ntr); u.pn = e * npn + pp; u.ord = i; return true;
    }
};
constexpr int MOE_UNITS = 6;
constexpr int LDS_RTAB = 131072, LDS_WTAB = LDS_RTAB + MOE_UNITS * 1024, LDS_TILE_E = LDS_WTAB + MOE_UNITS * 1024, LDS_PS = LDS_TILE_E + 2400;
static_assert(LDS_PS + 129 * 4 <= LDS_BYTES - 16, "MoE tables fit above the staging buffers");
__device__ __forceinline__ MoeSched moe_setup(KP p, int l, unsigned char* lds, int npn, bool gather) {
    const int T = (l == 0) ? R_ALL : R_LAT;
    int* ps = (int*)(lds + LDS_PS); int* cl = ps + 65;
    const unsigned* cnt = (const unsigned*)(p->ws + WS_CTL) + CW_CNT + l * 64;
    const int tid = tid_();
    if (tid < 64) cl[tid] = (int)cnt[tid];
    moe_pad_starts(p, l, ps);
    LAS int* tile_e = (LAS int*)((LAS unsigned char*)lds + LDS_TILE_E); LAS int* rtab = (LAS int*)((LAS unsigned char*)lds + LDS_RTAB); LAS float* wtab = (LAS float*)((LAS unsigned char*)lds + LDS_WTAB);
    const int ntr = ps[64] / 256;
    for (int rt = tid; rt < ntr; rt += NTHREADS) tile_e[rt] = moe_expert_of_row(ps, rt * 256);
    __syncthreads();
    MoeSched S{ntr, ntr + T / 256, npn, gsz_(), bid_(), tile_e};
    if (gather) { const int* expl = (const int*)(p->ws + WS_EXPL); const float* expw = (const float*)(p->ws + WS_EXPW);
        int tok[3]; float w[3];
#pragma unroll
        for (int q = 0; q < 3; ++q) { const int idx = tid + q * NTHREADS, i = idx >> 8, r = idx & 255; tok[q] = 0; w[q] = 0.f;
            int rt, pp_;
            if (S.map(i, rt, pp_)) {
                if (rt < S.ntr) { const int e = tile_e[rt], pos = rt * 256 + r - ps[e];
                    if (pos < cl[e]) { tok[q] = expl[(size_t)e * R_ALL + pos]; w[q] = expw[(size_t)e * R_ALL + pos]; } }
                else { tok[q] = (rt - S.ntr) * 256 + r; w[q] = 1.f; } } }
#pragma unroll
        for (int q = 0; q < 3; ++q) { const int idx = tid + q * NTHREADS; rtab[idx] = tok[q]; wtab[idx] = w[q]; } }
    __syncthreads();
    return S;
}
__device__ __forceinline__ void ph_gateup_f(KP p, int l, unsigned char* lds) {
    const MoeSched S = moe_setup(p, l, lds, 2, true);
    pg8::Gemm g{(const bf16_t*)(p->ws + Z_A), (const bf16_t*)(p->ws + wgu_off(l)), 0, 0, 1024};
    pg8::EpiGU8 E{(unsigned char*)(p->ws + Z_H), (const LAS float*)((LAS unsigned char*)lds + LDS_WTAB)};
    pg8::gemm_phase<pg8::EpiGU8, MoeSched, true, true>((LAS unsigned char*)lds, g, S, E, (const LAS int*)((LAS unsigned char*)lds + LDS_RTAB));
}
__device__ __forceinline__ void ph_down_f(KP p, int l, unsigned char* lds) {
    const MoeSched S = moe_setup(p, l, lds, 4, false);
    pg8::Gemm g{(const bf16_t*)(p->ws + Z_H), (const bf16_t*)(p->ws + wd_off(l)), 0, 0, 256};
    bf16_t* X = (bf16_t*)(p->ws + WS_X);
    pg8::EpiDown E{(bf16_t*)(p->ws + Z_Y), X, (const float*)(p->ws + WS_MOD) + (size_t)l * 3 * 6144 + 5 * 1024};
    pg8::gemm_phase<pg8::EpiDown, MoeSched, false, true>((LAS unsigned char*)lds, g, S, E, nullptr);
}

#ifndef FAST_ATTN
#define FAST_ATTN 1
#endif
#ifndef FAST_GEMM
#define FAST_GEMM 15
#endif
constexpr int PH_PER_LAYER = 10, N_PHASES = 1 + DEPTH * PH_PER_LAYER;
__global__ void __launch_bounds__(NTHREADS, 2) mega(Params parg) {
    extern __shared__ __attribute__((aligned(16))) unsigned char lds[];
    const int lo = parg.ph_lo, hi = parg.ph_hi;
    volatile LAS unsigned* xbw = (volatile LAS unsigned*)(lds + LDS_BYTES - 16);
    if (threadIdx.x == 0) { xbw[0] = 0u; xbw[1] = 0u; xbw[2] = 0u; xbw[3] = 0u; }
    if ((threadIdx.x & 63) == 0) *(volatile LAS int*)((LAS unsigned char*)lds + LDS_WVTAB_OFF + 4 * hwkey_()) = (int)(threadIdx.x >> 6);
    __syncthreads();
    XcdBarrier bar; bar.bar = (unsigned*)(parg.ws + WS_CTL) + CW_BAR; bar.x = 0; bar.st = xbw;
    if (hi - lo > 1) bar = xcd_barrier_post((unsigned*)(parg.ws + WS_CTL) + CW_BAR, xbw);
#ifdef PHMASK
#define IN(k) ((((PHMASK) >> ((k) == 0 ? 0 : ((k) - 1) % PH_PER_LAYER + 1)) & 1) && lo <= (k) && (k) < hi)
#else
#define IN(k) (lo <= (k) && (k) < hi)
#endif
#define SEAM(k) do { if (IN(k) && IN((k) + 1)) xcd_barrier(bar); } while (0)
    if (IN(0)) { ph_pro(kparams(), lds); } SEAM(0);
#pragma unroll
    for (int l = 0; l < DEPTH; ++l) {
        const int b0 = 1 + l * PH_PER_LAYER;
        if (IN(b0 + 0)) { ph_norm1(kparams(), l, lds); } SEAM(b0 + 0);
        if (IN(b0 + 1)) { ph_inproj_f(kparams(), l, lds); } SEAM(b0 + 1);
        if (IN(b0 + 2)) { ph_prep(kparams(), l, lds); } SEAM(b0 + 2);
        if (IN(b0 + 3)) { ph_attn_f(kparams(), l, lds); } SEAM(b0 + 3);
        if (IN(b0 + 4)) { ph_hgrn3(kparams(), l, lds); } SEAM(b0 + 4);
        if (IN(b0 + 5)) { ph_outproj_f(kparams(), l, lds); } SEAM(b0 + 5);
        if (IN(b0 + 6)) { ph_norm2(kparams(), l, lds); } SEAM(b0 + 6);
        if (IN(b0 + 7)) { ph_gateup_f(kparams(), l, lds); } SEAM(b0 + 7);
        if (IN(b0 + 8)) { ph_down_f(kparams(), l, lds); } SEAM(b0 + 8);
        if (IN(b0 + 9)) { ph_combine(kparams(), l, lds); } SEAM(b0 + 9);
    }
#undef IN
#undef SEAM
}

#ifndef MK_ONE_LAUNCH
#define MK_ONE_LAUNCH 1
#endif
extern "C" void kernel_launch(void* const* d_in, const int* in_sizes, int n_in, void* d_out, int out_size, void* d_ws, size_t ws_size, hipStream_t stream) {
    static int grid = 0;
    if (grid == 0) {
        if (n_in != 31 || ws_size < WS_END2) { fprintf(stderr, "kernel_launch: unexpected n_in %d or ws_size %zu (< %zu)\n", n_in, ws_size, (size_t)WS_END2); grid = -1; return; }
        int dev = 0, cus = 0, per_cu = 0;
        if (hipGetDevice(&dev) != hipSuccess || hipDeviceGetAttribute(&cus, hipDeviceAttributeMultiprocessorCount, dev) != hipSuccess) { grid = -1; return; }
        if (hipFuncSetAttribute((const void*)mega, hipFuncAttributeMaxDynamicSharedMemorySize, LDS_BYTES) != hipSuccess) { fprintf(stderr, "kernel_launch: hipFuncSetAttribute failed\n"); grid = -1; return; }
        if (hipOccupancyMaxActiveBlocksPerMultiprocessor(&per_cu, (const void*)mega, NTHREADS, LDS_BYTES) != hipSuccess || per_cu < 1) fprintf(stderr, "kernel_launch: occupancy query says %d\n", per_cu);
        (void)hipGetLastError();
        grid = cus;
    }
    if (grid < 0) return;
    (void)hipMemsetAsync((char*)d_ws + WS_CTL, 0, CTL_ZERO_BYTES, stream);
    Params p{};
    for (int i = 0; i < 31; ++i) p.in[i] = (const float*)d_in[i];
    p.out = (float*)d_out; p.ws = (unsigned char*)d_ws;
#if MK_ONE_LAUNCH
    p.ph_lo = 0; p.ph_hi = N_PHASES;
    hipLaunchKernelGGL(mega, dim3(grid), dim3(NTHREADS), LDS_BYTES, stream, p);
#else
    for (int k = 0; k < N_PHASES; ++k) { p.ph_lo = k; p.ph_hi = k + 1; hipLaunchKernelGGL(mega, dim3(grid), dim3(NTHREADS), LDS_BYTES, stream, p); }
#endif
}
```
